# Optimizing an MI355X kernel written in HIP

```python
import math
import numpy as np
import jax
import jax.numpy as jnp
from jax import lax

D_MODEL = 1024
BATCH = 16
SEQ = 2048
DEPTH = 2

S5_GROUP = 16
S5_CHANNELS = D_MODEL // 4
S5_GROUPS = S5_CHANNELS // S5_GROUP
S5_STATE = 64
SB_HEAD_DIM = 64
SB_HEADS = (D_MODEL - S5_CHANNELS) // SB_HEAD_DIM
SB_WIDTH = SB_HEADS * SB_HEAD_DIM
EVEN_IN = S5_CHANNELS + 3 * SB_WIDTH
EVEN_MIX = S5_CHANNELS + SB_WIDTH
Q_BLOCK = 128
NSA_HEADS = 16
NSA_KV_HEADS = 4
NSA_GROUP = NSA_HEADS // NSA_KV_HEADS
NSA_HEAD_DIM = 64
NSA_Q_WIDTH = NSA_HEADS * NSA_HEAD_DIM
NSA_KV_WIDTH = NSA_KV_HEADS * NSA_HEAD_DIM
NSA_BRANCHES = 3
ODD_IN = NSA_Q_WIDTH + 2 * NSA_BRANCHES * NSA_KV_WIDTH + NSA_BRANCHES * NSA_HEADS
CMP_BLOCK = 32
CMP_STRIDE = 16
CMP_HIDDEN = 128
SEL_BLOCK = 64
SEL_TOPK = 16
SEL_Q_CHUNK = 16
WINDOW = 512
FORCE_BONUS = 1000.0
PEER_HEADS = 8
PEER_KEYS = 128
PEER_EXPERTS = PEER_KEYS * PEER_KEYS
PEER_KEY_DIM = 256
PEER_HALF = PEER_KEY_DIM // 2
PEER_TOPK = 16
PEER_CHUNK = 128
DN_ALPHA = (2 * DEPTH) ** 0.25
DN_BETA = (8 * DEPTH) ** -0.25
LN_EPS = 1e-5
N_EVEN = (DEPTH + 1) // 2
N_ODD = DEPTH // 2

kernel_name = 'hybrid_s5_stickbreak_nsa_peer_deepnorm'


def layer_norm(x, g, b):
    xf = x.astype(jnp.float32)
    mu = jnp.mean(xf, axis=-1, keepdims=True)
    var = jnp.mean(jnp.square(xf - mu), axis=-1, keepdims=True)
    return ((xf - mu) * lax.rsqrt(var + LN_EPS) * g + b).astype(x.dtype)


def masked_softmax(s, mask):
    s = jnp.where(mask, s, -jnp.inf)
    m = jnp.max(s, axis=-1, keepdims=True)
    m = jnp.where(jnp.isfinite(m), m, 0.0)
    e = jnp.where(mask, jnp.exp(s - m), 0.0)
    return e / jnp.maximum(jnp.sum(e, axis=-1, keepdims=True), 1e-30)


def alibi_slopes(n):
    return jnp.asarray(2.0 ** (-8.0 * np.arange(1, n + 1) / n), jnp.float32)


def cmp_to_sel_matrix(n_cmp, n_sel):
    cs = np.arange(n_cmp)[:, None] * CMP_STRIDE
    ss = np.arange(n_sel)[None, :] * SEL_BLOCK
    ov = np.clip(np.minimum(cs + CMP_BLOCK, ss + SEL_BLOCK) - np.maximum(cs, ss), 0, None) / CMP_BLOCK
    return jnp.asarray(ov, jnp.float32)


def s5_mixer(u, lam_re, lam_im, log_dt, b_re, b_im, c_re, c_im, d_skip, w_glu, b_glu):
    f32 = jnp.float32
    bsz, L, _ = u.shape
    uf = u.astype(f32)
    ug = uf.reshape(bsz, L, S5_GROUPS, S5_GROUP)
    lr = lam_re.astype(f32)
    li = lam_im.astype(f32)
    dt = jnp.exp(log_dt.astype(f32))[:, None]
    mag = jnp.exp(lr * dt)
    ab_re = mag * jnp.cos(li * dt)
    ab_im = mag * jnp.sin(li * dt)
    nr = ab_re - 1.0
    den = lr * lr + li * li
    f_re = (nr * lr + ab_im * li) / den
    f_im = (ab_im * lr - nr * li) / den
    bb_re = f_re[..., None] * b_re.astype(f32) - f_im[..., None] * b_im.astype(f32)
    bb_im = f_re[..., None] * b_im.astype(f32) + f_im[..., None] * b_re.astype(f32)
    bu_re = jnp.einsum('blgi,gpi->blgp', ug, bb_re)
    bu_im = jnp.einsum('blgi,gpi->blgp', ug, bb_im)
    a_re = jnp.broadcast_to(ab_re, bu_re.shape)
    a_im = jnp.broadcast_to(ab_im, bu_im.shape)

    def combine(e1, e2):
        a1r, a1i, b1r, b1i = e1
        a2r, a2i, b2r, b2i = e2
        return (a2r * a1r - a2i * a1i,
                a2r * a1i + a2i * a1r,
                a2r * b1r - a2i * b1i + b2r,
                a2r * b1i + a2i * b1r + b2i)

    _, _, x_re, x_im = lax.associative_scan(combine, (a_re, a_im, bu_re, bu_im), axis=1)
    y = (jnp.einsum('blgp,gip->blgi', x_re, c_re.astype(f32))
         - jnp.einsum('blgp,gip->blgi', x_im, c_im.astype(f32)))
    y = y.reshape(bsz, L, S5_CHANNELS) + d_skip.astype(f32) * uf
    y = jax.nn.gelu(y)
    y = y * jax.nn.sigmoid(y @ w_glu.astype(f32) + b_glu.astype(f32))
    return y.astype(u.dtype)


def stick_breaking_attention(q, k, v):
    L = q.shape[1]
    scale = SB_HEAD_DIM ** -0.5
    outs = []
    for blk in range(L // Q_BLOCK):
        t0 = blk * Q_BLOCK
        t1 = t0 + Q_BLOCK
        z = jnp.einsum('bqhd,bkhd->bhqk', q[:, t0:t1], k[:, :t1]).astype(jnp.float32) * scale
        tq = t0 + jnp.arange(Q_BLOCK)[:, None]
        sk = jnp.arange(t1)[None, :]
        mask = sk < tq
        log1m = jnp.where(mask, jax.nn.log_sigmoid(-z), 0.0)
        tail = lax.cumsum(log1m, axis=3, reverse=True) - log1m
        w = jnp.where(mask, jnp.exp(jax.nn.log_sigmoid(z) + tail), 0.0)
        outs.append(jnp.einsum('bhqk,bkhd->bqhd', w.astype(v.dtype), v[:, :t1]))
    return jnp.concatenate(outs, axis=1)


def even_mixer(x, w_in, lam_re, lam_im, log_dt, b_re, b_im, c_re, c_im, d_skip, w_glu, b_glu, w_out):
    bsz, L, _ = x.shape
    proj = x @ w_in
    u = proj[..., :S5_CHANNELS]
    o = S5_CHANNELS
    q = proj[..., o:o + SB_WIDTH].reshape(bsz, L, SB_HEADS, SB_HEAD_DIM)
    k = proj[..., o + SB_WIDTH:o + 2 * SB_WIDTH].reshape(bsz, L, SB_HEADS, SB_HEAD_DIM)
    v = proj[..., o + 2 * SB_WIDTH:].reshape(bsz, L, SB_HEADS, SB_HEAD_DIM)
    y_a = s5_mixer(u, lam_re, lam_im, log_dt, b_re, b_im, c_re, c_im, d_skip, w_glu, b_glu)
    y_b = stick_breaking_attention(q, k, v).reshape(bsz, L, SB_WIDTH).astype(x.dtype)
    return jnp.concatenate([y_a, y_b], axis=-1) @ w_out


def nsa_mixer(x, w_in, pe_k, w1_k, w2_k, pe_v, w1_v, w2_v, w_out):
    f32 = jnp.float32
    bsz, L, _ = x.shape
    G, R, hd = NSA_KV_HEADS, NSA_GROUP, NSA_HEAD_DIM
    scale = hd ** -0.5
    proj = x @ w_in
    q = proj[..., :NSA_Q_WIDTH].reshape(bsz, L, G, R, hd)
    kv = proj[..., NSA_Q_WIDTH:NSA_Q_WIDTH + 2 * NSA_BRANCHES * NSA_KV_WIDTH].reshape(bsz, L, 2 * NSA_BRANCHES, G, hd)
    kc, vc, ks, vs, kw, vw = [kv[:, :, j] for j in range(2 * NSA_BRANCHES)]
    gates = jax.nn.sigmoid(proj[..., NSA_Q_WIDTH + 2 * NSA_BRANCHES * NSA_KV_WIDTH:].astype(f32))
    gates = gates.reshape(bsz, L, NSA_BRANCHES, G, R)
    slopes = alibi_slopes(NSA_HEADS).reshape(G, R)
    pos = jnp.arange(L)

    n_cmp = (L - CMP_BLOCK) // CMP_STRIDE + 1
    starts = jnp.arange(n_cmp) * CMP_STRIDE
    idx = starts[:, None] + jnp.arange(CMP_BLOCK)[None, :]

    def compress(t, pe, w1, w2):
        blocks = t[:, idx] + pe[None, None, :, None, :]
        blocks = jnp.moveaxis(blocks, 3, 2).reshape(bsz, n_cmp, G, CMP_BLOCK * hd)
        return jax.nn.gelu(blocks @ w1) @ w2

    k_cmp = compress(kc, pe_k, w1_k, w2_k)
    v_cmp = compress(vc, pe_v, w1_v, w2_v)
    ends = starts + CMP_BLOCK - 1
    dist_c = (pos[:, None] - ends[None, :]).astype(f32)
    s_c = jnp.einsum('btgrd,bngd->bgrtn', q, k_cmp).astype(f32) * scale
    s_c = s_c - slopes[:, :, None, None] * dist_c
    p_c = masked_softmax(s_c, dist_c >= 0)
    o_cmp = jnp.einsum('bgrtn,bngd->btgrd', p_c.astype(v_cmp.dtype), v_cmp)

    n_sel = L // SEL_BLOCK
    k_sel = min(SEL_TOPK, n_sel)
    imp = jnp.einsum('bgrtn,nj->bgtj', p_c, cmp_to_sel_matrix(n_cmp, n_sel))
    jb = jnp.arange(n_sel)[None, :]
    cur = (pos // SEL_BLOCK)[:, None]
    causal = jb * SEL_BLOCK <= pos[:, None]
    forced = (jb == 0) | (jb == cur) | (jb == cur - 1)
    imp = jnp.where(causal, imp + jnp.where(forced, FORCE_BONUS, 0.0), -jnp.inf)
    _, sel_idx = lax.top_k(imp, k_sel)

    ks_blk = jnp.moveaxis(ks.reshape(bsz, n_sel, SEL_BLOCK, G, hd), 3, 1)
    vs_blk = jnp.moveaxis(vs.reshape(bsz, n_sel, SEL_BLOCK, G, hd), 3, 1)
    gather_bg = jax.vmap(jax.vmap(lambda tbl, ix: tbl[ix]))
    n_chunk = L // SEL_Q_CHUNK
    q_ch = jnp.moveaxis(q.reshape(bsz, n_chunk, SEL_Q_CHUNK, G, R, hd), 1, 0)
    idx_ch = jnp.moveaxis(sel_idx.reshape(bsz, G, n_chunk, SEL_Q_CHUNK, k_sel), 2, 0)
    pos_ch = pos.reshape(n_chunk, SEL_Q_CHUNK)
    m_keys = k_sel * SEL_BLOCK

    def sel_chunk(args):
        qc, ic, tc = args
        kg = gather_bg(ks_blk, ic).reshape(bsz, G, SEL_Q_CHUNK, m_keys, hd)
        vg = gather_bg(vs_blk, ic).reshape(bsz, G, SEL_Q_CHUNK, m_keys, hd)
        kpos = (ic[..., None] * SEL_BLOCK + jnp.arange(SEL_BLOCK)).reshape(bsz, G, SEL_Q_CHUNK, m_keys)
        dist = (tc[None, None, :, None] - kpos).astype(f32)
        s = jnp.einsum('bcgrd,bgcmd->bgrcm', qc, kg).astype(f32) * scale
        s = s - slopes[None, :, :, None, None] * dist[:, :, None]
        p = masked_softmax(s, dist[:, :, None] >= 0)
        return jnp.einsum('bgrcm,bgcmd->bcgrd', p.astype(vg.dtype), vg)

    o_slc = lax.map(sel_chunk, (q_ch, idx_ch, pos_ch))
    o_slc = jnp.moveaxis(o_slc, 0, 1).reshape(bsz, L, G, R, hd)

    kw_pad = jnp.pad(kw, ((0, 0), (WINDOW, 0), (0, 0), (0, 0)))
    vw_pad = jnp.pad(vw, ((0, 0), (WINDOW, 0), (0, 0), (0, 0)))
    n_qb = L // Q_BLOCK
    span = WINDOW + Q_BLOCK
    q_b = jnp.moveaxis(q.reshape(bsz, n_qb, Q_BLOCK, G, R, hd), 1, 0)

    def win_block(args):
        qb, i = args
        t0 = i * Q_BLOCK
        kb = lax.dynamic_slice_in_dim(kw_pad, t0, span, axis=1)
        vb = lax.dynamic_slice_in_dim(vw_pad, t0, span, axis=1)
        tq = t0 + jnp.arange(Q_BLOCK)
        sk = t0 - WINDOW + jnp.arange(span)
        dist = tq[:, None] - sk[None, :]
        mask = (dist >= 0) & (dist < WINDOW) & (sk[None, :] >= 0)
        s = jnp.einsum('bqgrd,bkgd->bgrqk', qb, kb).astype(f32) * scale
        s = s - slopes[:, :, None, None] * dist.astype(f32)
        p = masked_softmax(s, mask)
        return jnp.einsum('bgrqk,bkgd->bqgrd', p.astype(vb.dtype), vb)

    o_win = lax.map(win_block, (q_b, jnp.arange(n_qb)))
    o_win = jnp.moveaxis(o_win, 0, 1).reshape(bsz, L, G, R, hd)

    o = (gates[:, :, 0, :, :, None] * o_cmp + gates[:, :, 1, :, :, None] * o_slc
         + gates[:, :, 2, :, :, None] * o_win)
    return o.reshape(bsz, L, NSA_Q_WIDTH).astype(x.dtype) @ w_out


def peer_ffn(x, w_q, sub_keys, u_tab, v_tab):
    f32 = jnp.float32
    bsz, L, D = x.shape
    tok = x.reshape(-1, PEER_CHUNK, D)

    def chunk(xc):
        q = (xc @ w_q).reshape(PEER_CHUNK, PEER_HEADS, 2, PEER_HALF)
        s1 = jnp.einsum('chd,hkd->chk', q[:, :, 0], sub_keys[:, 0]).astype(f32)
        s2 = jnp.einsum('chd,hkd->chk', q[:, :, 1], sub_keys[:, 1]).astype(f32)
        v1, i1 = lax.top_k(s1, PEER_TOPK)
        v2, i2 = lax.top_k(s2, PEER_TOPK)
        cand = (v1[..., :, None] + v2[..., None, :]).reshape(PEER_CHUNK, PEER_HEADS, PEER_TOPK * PEER_TOPK)
        top, flat = lax.top_k(cand, PEER_TOPK)
        e1 = jnp.take_along_axis(i1, flat // PEER_TOPK, axis=-1)
        e2 = jnp.take_along_axis(i2, flat % PEER_TOPK, axis=-1)
        expert = e1 * PEER_KEYS + e2
        g = jax.nn.softmax(top, axis=-1)
        h = jax.nn.gelu(jnp.einsum('cd,chkd->chk', xc, u_tab[expert]).astype(f32))
        return jnp.einsum('chk,chkd->cd', (g * h).astype(v_tab.dtype), v_tab[expert])

    return lax.map(chunk, tok).reshape(bsz, L, D)


def setup_inputs(seed: int = 0) -> dict:
    key = jax.random.key(seed)
    ks = iter(jax.random.split(key, 48))
    f32 = jnp.float32

    def nrm(shape, std):
        return jax.random.normal(next(ks), shape, f32) * std

    D = D_MODEL
    x = nrm((BATCH, SEQ, D), 1.0)
    even_w_in = nrm((N_EVEN, D, EVEN_IN), D ** -0.5)
    even_lam_re = -0.5 + nrm((N_EVEN, S5_GROUPS, S5_STATE), 0.01)
    even_lam_im = math.pi * jnp.arange(S5_STATE, dtype=f32) + nrm((N_EVEN, S5_GROUPS, S5_STATE), 0.01)
    even_log_dt = jax.random.uniform(next(ks), (N_EVEN, S5_GROUPS), f32, math.log(1e-3), math.log(1e-1))
    b_std = (2.0 * S5_GROUP) ** -0.5
    even_b_re = nrm((N_EVEN, S5_GROUPS, S5_STATE, S5_GROUP), b_std)
    even_b_im = nrm((N_EVEN, S5_GROUPS, S5_STATE, S5_GROUP), b_std)
    c_std = (0.5 * S5_STATE) ** -0.5
    even_c_re = nrm((N_EVEN, S5_GROUPS, S5_GROUP, S5_STATE), c_std)
    even_c_im = nrm((N_EVEN, S5_GROUPS, S5_GROUP, S5_STATE), c_std)
    even_d = nrm((N_EVEN, S5_CHANNELS), 1.0)
    even_w_glu = nrm((N_EVEN, S5_CHANNELS, S5_CHANNELS), S5_CHANNELS ** -0.5)
    even_b_glu = nrm((N_EVEN, S5_CHANNELS), 0.02)
    even_w_out = nrm((N_EVEN, EVEN_MIX, D), EVEN_MIX ** -0.5 * DN_BETA)
    odd_w_in = nrm((N_ODD, D, ODD_IN), D ** -0.5)
    odd_pe_k = nrm((N_ODD, CMP_BLOCK, NSA_HEAD_DIM), 0.1)
    odd_w1_k = nrm((N_ODD, CMP_BLOCK * NSA_HEAD_DIM, CMP_HIDDEN), (CMP_BLOCK * NSA_HEAD_DIM) ** -0.5)
    odd_w2_k = nrm((N_ODD, CMP_HIDDEN, NSA_HEAD_DIM), CMP_HIDDEN ** -0.5)
    odd_pe_v = nrm((N_ODD, CMP_BLOCK, NSA_HEAD_DIM), 0.1)
    odd_w1_v = nrm((N_ODD, CMP_BLOCK * NSA_HEAD_DIM, CMP_HIDDEN), (CMP_BLOCK * NSA_HEAD_DIM) ** -0.5)
    odd_w2_v = nrm((N_ODD, CMP_HIDDEN, NSA_HEAD_DIM), CMP_HIDDEN ** -0.5)
    odd_w_out = nrm((N_ODD, NSA_Q_WIDTH, D), NSA_Q_WIDTH ** -0.5 * DN_BETA)
    peer_w_q = nrm((DEPTH, D, PEER_HEADS * PEER_KEY_DIM), D ** -0.5)
    peer_sub_keys = nrm((DEPTH, PEER_HEADS, 2, PEER_KEYS, PEER_HALF), PEER_HALF ** -0.5)
    peer_u = nrm((DEPTH, PEER_EXPERTS, D), D ** -0.5)
    peer_v = nrm((DEPTH, PEER_EXPERTS, D), DN_BETA)
    ln1_g = 1.0 + nrm((DEPTH, D), 0.02)
    ln1_b = nrm((DEPTH, D), 0.02)
    ln2_g = 1.0 + nrm((DEPTH, D), 0.02)
    ln2_b = nrm((DEPTH, D), 0.02)
    return {'x': x, 'even_w_in': even_w_in, 'even_lam_re': even_lam_re, 'even_lam_im': even_lam_im,
            'even_log_dt': even_log_dt, 'even_b_re': even_b_re, 'even_b_im': even_b_im,
            'even_c_re': even_c_re, 'even_c_im': even_c_im, 'even_d': even_d,
            'even_w_glu': even_w_glu, 'even_b_glu': even_b_glu, 'even_w_out': even_w_out,
            'odd_w_in': odd_w_in, 'odd_pe_k': odd_pe_k, 'odd_w1_k': odd_w1_k, 'odd_w2_k': odd_w2_k,
            'odd_pe_v': odd_pe_v, 'odd_w1_v': odd_w1_v, 'odd_w2_v': odd_w2_v, 'odd_w_out': odd_w_out,
            'peer_w_q': peer_w_q, 'peer_sub_keys': peer_sub_keys, 'peer_u': peer_u, 'peer_v': peer_v,
            'ln1_g': ln1_g, 'ln1_b': ln1_b, 'ln2_g': ln2_g, 'ln2_b': ln2_b}


def reference(x, even_w_in, even_lam_re, even_lam_im, even_log_dt, even_b_re, even_b_im,
              even_c_re, even_c_im, even_d, even_w_glu, even_b_glu, even_w_out,
              odd_w_in, odd_pe_k, odd_w1_k, odd_w2_k, odd_pe_v, odd_w1_v, odd_w2_v, odd_w_out,
              peer_w_q, peer_sub_keys, peer_u, peer_v, ln1_g, ln1_b, ln2_g, ln2_b):
    h = x
    for i in range(DEPTH):
        j = i // 2
        if i % 2 == 0:
            mix = even_mixer(h, even_w_in[j], even_lam_re[j], even_lam_im[j], even_log_dt[j],
                             even_b_re[j], even_b_im[j], even_c_re[j], even_c_im[j], even_d[j],
                             even_w_glu[j], even_b_glu[j], even_w_out[j])
        else:
            mix = nsa_mixer(h, odd_w_in[j], odd_pe_k[j], odd_w1_k[j], odd_w2_k[j],
                            odd_pe_v[j], odd_w1_v[j], odd_w2_v[j], odd_w_out[j])
        h = layer_norm(DN_ALPHA * h + mix, ln1_g[i], ln1_b[i])
        ffn = peer_ffn(h, peer_w_q[i], peer_sub_keys[i], peer_u[i], peer_v[i])
        h = layer_norm(DN_ALPHA * h + ffn, ln2_g[i], ln2_b[i])
    return h
```

```cpp
#include <hip/hip_runtime.h>
#include <math.h>
#include <stdint.h>

namespace {

constexpr int NB = 16, NL = 2048, ND = 1024, NT = NB * NL;
constexpr int EVEN_IN = 2560, ODD_IN = 2608;
constexpr float ALPHA = 1.41421356237f;
constexpr float LN_EPS = 1e-5f;

__device__ __forceinline__ float gelu_tanh(float x) {
    float u = 0.7978845608028654f * (x + 0.044715f * x * x * x);
    return 0.5f * x * (1.f + tanhf(u));
}
__device__ __forceinline__ float sigmoidf_(float x) { return 1.f / (1.f + expf(-x)); }

template <int MODE>
__global__ __launch_bounds__(256) void gemm_f32(const float* __restrict__ A, int lda, const float* __restrict__ Bm, int ldb,
                                                float* C, int ldc, int M, int N, int K, float alpha) {
    __shared__ float As[16][132];
    __shared__ float Bs[16][132];
    const int bm = blockIdx.y * 128, bn = blockIdx.x * 128;
    const int tid = threadIdx.x, tx = tid & 15, ty = tid >> 4;
    float acc[8][8];
#pragma unroll
    for (int i = 0; i < 8; ++i)
#pragma unroll
        for (int j = 0; j < 8; ++j) acc[i][j] = 0.f;
    const int arow = tid >> 1, akk = (tid & 1) * 8;
    const int bkk = tid >> 4, bcol = (tid & 15) * 8;
    for (int k0 = 0; k0 < K; k0 += 16) {
        const float* ap = A + (size_t)(bm + arow) * lda + k0 + akk;
        float4 a0 = *(const float4*)ap, a1 = *(const float4*)(ap + 4);
        float4 b0 = make_float4(0.f, 0.f, 0.f, 0.f), b1 = b0;
        if (bn + bcol < N) {
            const float* bp = Bm + (size_t)(k0 + bkk) * ldb + bn + bcol;
            b0 = *(const float4*)bp; b1 = *(const float4*)(bp + 4);
        }
        __syncthreads();
        As[akk + 0][arow] = a0.x; As[akk + 1][arow] = a0.y; As[akk + 2][arow] = a0.z; As[akk + 3][arow] = a0.w;
        As[akk + 4][arow] = a1.x; As[akk + 5][arow] = a1.y; As[akk + 6][arow] = a1.z; As[akk + 7][arow] = a1.w;
        *(float4*)&Bs[bkk][bcol] = b0; *(float4*)&Bs[bkk][bcol + 4] = b1;
        __syncthreads();
#pragma unroll
        for (int kk = 0; kk < 16; ++kk) {
            float4 av0 = *(const float4*)&As[kk][ty * 4], av1 = *(const float4*)&As[kk][64 + ty * 4];
            float4 bv0 = *(const float4*)&Bs[kk][tx * 4], bv1 = *(const float4*)&Bs[kk][64 + tx * 4];
            float a[8] = {av0.x, av0.y, av0.z, av0.w, av1.x, av1.y, av1.z, av1.w};
            float b[8] = {bv0.x, bv0.y, bv0.z, bv0.w, bv1.x, bv1.y, bv1.z, bv1.w};
#pragma unroll
            for (int i = 0; i < 8; ++i)
#pragma unroll
                for (int j = 0; j < 8; ++j) acc[i][j] += a[i] * b[j];
        }
    }
#pragma unroll
    for (int i = 0; i < 8; ++i) {
        const int row = bm + (i < 4 ? ty * 4 + i : 64 + ty * 4 + (i - 4));
#pragma unroll
        for (int jh = 0; jh < 2; ++jh) {
            const int col = bn + jh * 64 + tx * 4;
            if (col < N) {
                float* cp = C + (size_t)row * ldc + col;
                float4 v = make_float4(acc[i][jh * 4 + 0], acc[i][jh * 4 + 1], acc[i][jh * 4 + 2], acc[i][jh * 4 + 3]);
                if (MODE == 1) {
                    float4 o = *(const float4*)cp;
                    v.x += alpha * o.x; v.y += alpha * o.y; v.z += alpha * o.z; v.w += alpha * o.w;
                }
                *(float4*)cp = v;
            }
        }
    }
}

__global__ __launch_bounds__(64) void s5_scan_naive(const float* __restrict__ proj, const float* __restrict__ lam_re,
                                                    const float* __restrict__ lam_im, const float* __restrict__ log_dt,
                                                    const float* __restrict__ b_re, const float* __restrict__ b_im,
                                                    const float* __restrict__ c_re, const float* __restrict__ c_im,
                                                    const float* __restrict__ dskip, float* __restrict__ ya) {
    const int bg = blockIdx.x, b = bg >> 4, g = bg & 15, lane = threadIdx.x;
    __shared__ float us[64][16];
    __shared__ float xr[64][65], xi[64][65];
    __shared__ float cr[16][64], ci[16][64];
    const float lr = lam_re[g * 64 + lane], li = lam_im[g * 64 + lane];
    const float dt = expf(log_dt[g]);
    const float mag = expf(lr * dt);
    const float are = mag * cosf(li * dt), aim = mag * sinf(li * dt);
    const float nr = are - 1.f, den = lr * lr + li * li;
    const float fre = (nr * lr + aim * li) / den, fim = (aim * lr - nr * li) / den;
    float bbr[16], bbi[16];
#pragma unroll
    for (int i = 0; i < 16; ++i) {
        const float br = b_re[(g * 64 + lane) * 16 + i], bi = b_im[(g * 64 + lane) * 16 + i];
        bbr[i] = fre * br - fim * bi; bbi[i] = fre * bi + fim * br;
    }
    for (int idx = lane; idx < 1024; idx += 64) { cr[idx >> 6][idx & 63] = c_re[g * 1024 + idx]; ci[idx >> 6][idx & 63] = c_im[g * 1024 + idx]; }
    float dsk[16];
#pragma unroll
    for (int i = 0; i < 16; ++i) dsk[i] = dskip[g * 16 + i];
    float xre = 0.f, xim = 0.f;
    for (int t0 = 0; t0 < NL; t0 += 64) {
        __syncthreads();
        for (int idx = lane; idx < 1024; idx += 64) { const int t = idx >> 4, i = idx & 15; us[t][i] = proj[(size_t)(b * NL + t0 + t) * EVEN_IN + g * 16 + i]; }
        __syncthreads();
        for (int t = 0; t < 64; ++t) {
            float bur = 0.f, bui = 0.f;
#pragma unroll
            for (int i = 0; i < 16; ++i) { const float u = us[t][i]; bur += bbr[i] * u; bui += bbi[i] * u; }
            const float nre = are * xre - aim * xim + bur, nim = are * xim + aim * xre + bui;
            xre = nre; xim = nim;
            xr[t][lane] = xre; xi[t][lane] = xim;
        }
        __syncthreads();
        float y[16];
#pragma unroll
        for (int i = 0; i < 16; ++i) y[i] = 0.f;
        for (int p = 0; p < 64; ++p) {
            const float a = xr[lane][p], bq = xi[lane][p];
#pragma unroll
            for (int i = 0; i < 16; ++i) y[i] += cr[i][p] * a - ci[i][p] * bq;
        }
#pragma unroll
        for (int i = 0; i < 16; ++i) {
            const float v = y[i] + dsk[i] * us[lane][i];
            ya[(size_t)(b * NL + t0 + lane) * 256 + g * 16 + i] = gelu_tanh(v);
        }
    }
}

__global__ __launch_bounds__(256) void glu_naive(const float* __restrict__ ya, const float* __restrict__ wglu, const float* __restrict__ bglu, float* __restrict__ Y) {
    __shared__ float ys[16][256];
    const int t0 = blockIdx.x * 16, c = threadIdx.x;
    for (int i = 0; i < 16; ++i) ys[i][c] = ya[(size_t)(t0 + i) * 256 + c];
    __syncthreads();
    float acc[16];
#pragma unroll
    for (int i = 0; i < 16; ++i) acc[i] = 0.f;
    for (int k = 0; k < 256; ++k) {
        const float w = wglu[k * 256 + c];
#pragma unroll
        for (int i = 0; i < 16; ++i) acc[i] += ys[i][k] * w;
    }
    const float bb = bglu[c];
#pragma unroll
    for (int i = 0; i < 16; ++i) Y[(size_t)(t0 + i) * ND + c] = ys[i][c] * sigmoidf_(acc[i] + bb);
}

__global__ __launch_bounds__(64) void sb_attn_naive(const float* __restrict__ proj, float* __restrict__ Y) {
    const int qt = blockIdx.x, h = blockIdx.y, b = blockIdx.z, lane = threadIdx.x;
    const int t = qt * 64 + lane;
    __shared__ float ks[64][64], vs[64][64];
    const float* base = proj + (size_t)b * NL * EVEN_IN;
    float q[64], acc[64];
#pragma unroll
    for (int d = 0; d < 64; d += 4) {
        const float4 v = *(const float4*)(base + (size_t)t * EVEN_IN + 256 + h * 64 + d);
        q[d] = v.x; q[d + 1] = v.y; q[d + 2] = v.z; q[d + 3] = v.w;
    }
#pragma unroll
    for (int d = 0; d < 64; ++d) acc[d] = 0.f;
    float tail = 0.f;
    for (int c = qt; c >= 0; --c) {
        __syncthreads();
        for (int i = 0; i < 64; ++i) {
            ks[i][lane] = base[(size_t)(c * 64 + i) * EVEN_IN + 1024 + h * 64 + lane];
            vs[i][lane] = base[(size_t)(c * 64 + i) * EVEN_IN + 1792 + h * 64 + lane];
        }
        __syncthreads();
        for (int s = 63; s >= 0; --s) {
            const int key = c * 64 + s;
            float z = 0.f;
#pragma unroll
            for (int d = 0; d < 64; ++d) z += q[d] * ks[s][d];
            z *= 0.125f;
            const bool valid = key < t;
            const float sp = fmaxf(z, 0.f) + log1pf(expf(-fabsf(z)));
            const float w = valid ? expf(z - sp + tail) : 0.f;
#pragma unroll
            for (int d = 0; d < 64; ++d) acc[d] += w * vs[s][d];
            if (valid) tail -= sp;
        }
        if (__all(tail < -120.f)) break;
    }
#pragma unroll
    for (int d = 0; d < 64; d += 4)
        *(float4*)(Y + (size_t)(b * NL + t) * ND + 256 + h * 64 + d) = make_float4(acc[d], acc[d + 1], acc[d + 2], acc[d + 3]);
}

__global__ __launch_bounds__(256) void ln_naive(const float* R, const float* __restrict__ g, const float* __restrict__ bta, float* out) {
    __shared__ float red[8];
    const int row = blockIdx.x, tid = threadIdx.x, lane = tid & 63, w = tid >> 6;
    const float4 v = *(const float4*)(R + (size_t)row * ND + tid * 4);
    float s = v.x + v.y + v.z + v.w;
    for (int o = 32; o; o >>= 1) s += __shfl_xor(s, o);
    if (lane == 0) red[w] = s;
    __syncthreads();
    const float mean = (red[0] + red[1] + red[2] + red[3]) * (1.f / ND);
    const float dx = v.x - mean, dy = v.y - mean, dz = v.z - mean, dw = v.w - mean;
    float s2 = dx * dx + dy * dy + dz * dz + dw * dw;
    for (int o = 32; o; o >>= 1) s2 += __shfl_xor(s2, o);
    if (lane == 0) red[4 + w] = s2;
    __syncthreads();
    const float var = (red[4] + red[5] + red[6] + red[7]) * (1.f / ND);
    const float rs = rsqrtf(var + LN_EPS);
    const float4 gg = *(const float4*)(g + tid * 4), bb = *(const float4*)(bta + tid * 4);
    *(float4*)(out + (size_t)row * ND + tid * 4) = make_float4(dx * rs * gg.x + bb.x, dy * rs * gg.y + bb.y, dz * rs * gg.z + bb.z, dw * rs * gg.w + bb.w);
}

__device__ __forceinline__ void wave_argmax(float& bv, int& bi) {
#pragma unroll
    for (int o = 32; o; o >>= 1) {
        const float ov = __shfl_xor(bv, o); const int oi = __shfl_xor(bi, o);
        if (ov > bv || (ov == bv && oi < bi)) { bv = ov; bi = oi; }
    }
}
__global__ __launch_bounds__(256) void peer_route_naive(const float* __restrict__ qbuf, const float* __restrict__ subk, int* __restrict__ eidx, float* __restrict__ egate) {
    const int wave = threadIdx.x >> 6, lane = threadIdx.x & 63;
    const int token = blockIdx.x >> 1, head = (blockIdx.x & 1) * 4 + wave;
    __shared__ float qs[4][256];
    const float* qp = qbuf + (size_t)token * 2048 + head * 256;
    for (int i = 0; i < 4; ++i) qs[wave][lane + 64 * i] = qp[lane + 64 * i];
    __syncthreads();
    float myv[2]; int myi[2];
#pragma unroll
    for (int c = 0; c < 2; ++c) {
        float sc[2];
#pragma unroll
        for (int w2 = 0; w2 < 2; ++w2) {
            const float* kr = subk + ((size_t)(head * 2 + c) * 128 + lane + 64 * w2) * 128;
            float a = 0.f;
            for (int d = 0; d < 128; d += 4) {
                const float4 kv = *(const float4*)(kr + d);
                a += qs[wave][c * 128 + d] * kv.x + qs[wave][c * 128 + d + 1] * kv.y + qs[wave][c * 128 + d + 2] * kv.z + qs[wave][c * 128 + d + 3] * kv.w;
            }
            sc[w2] = a;
        }
        float a0 = sc[0], a1 = sc[1];
        float mv = -INFINITY; int mi = 0;
        for (int r = 0; r < 16; ++r) {
            float bv; int bi;
            if (a0 >= a1) { bv = a0; bi = lane; } else { bv = a1; bi = lane + 64; }
            wave_argmax(bv, bi);
            if (lane == r) { mv = bv; mi = bi; }
            if (bi == lane) a0 = -INFINITY; else if (bi == lane + 64) a1 = -INFINITY;
        }
        myv[c] = mv; myi[c] = mi;
    }
    const float va = __shfl(myv[0], lane >> 2);
    float cand[4];
#pragma unroll
    for (int j = 0; j < 4; ++j) cand[j] = va + __shfl(myv[1], (lane & 3) * 4 + j);
    float topv = -INFINITY; int topf = 0;
    for (int r = 0; r < 16; ++r) {
        float bv = cand[0]; int bi = lane * 4;
#pragma unroll
        for (int j = 1; j < 4; ++j) if (cand[j] > bv) { bv = cand[j]; bi = lane * 4 + j; }
        wave_argmax(bv, bi);
        if (lane == r) { topv = bv; topf = bi; }
#pragma unroll
        for (int j = 0; j < 4; ++j) if (bi == lane * 4 + j) cand[j] = -INFINITY;
    }
    const int e1 = __shfl(myi[0], topf >> 4), e2 = __shfl(myi[1], topf & 15);
    const float top0 = __shfl(topv, 0);
    float ex = (lane < 16) ? expf(topv - top0) : 0.f;
    float sum = ex;
    for (int o = 32; o; o >>= 1) sum += __shfl_xor(sum, o);
    if (lane < 16) {
        eidx[(size_t)token * 128 + head * 16 + lane] = e1 * 128 + e2;
        egate[(size_t)token * 128 + head * 16 + lane] = ex / sum;
    }
}

__global__ __launch_bounds__(256) void peer_expert_naive(float* R, const int* __restrict__ eidx, const float* __restrict__ egate,
                                                         const float* __restrict__ utab, const float* __restrict__ vtab) {
    const int wave = threadIdx.x >> 6, lane = threadIdx.x & 63;
    const int token = blockIdx.x * 4 + wave;
    float4 x[4], acc[4];
#pragma unroll
    for (int j = 0; j < 4; ++j) { x[j] = *(const float4*)(R + (size_t)token * ND + j * 256 + lane * 4); acc[j] = make_float4(0.f, 0.f, 0.f, 0.f); }
    for (int e0 = 0; e0 < 128; e0 += 4) {
        float dot[4]; int ex[4]; float gt[4];
#pragma unroll
        for (int k = 0; k < 4; ++k) {
            ex[k] = eidx[(size_t)token * 128 + e0 + k]; gt[k] = egate[(size_t)token * 128 + e0 + k];
            const float* ur = utab + (size_t)ex[k] * ND + lane * 4;
            float a = 0.f;
#pragma unroll
            for (int j = 0; j < 4; ++j) { const float4 u = *(const float4*)(ur + j * 256); a += x[j].x * u.x + x[j].y * u.y + x[j].z * u.z + x[j].w * u.w; }
            dot[k] = a;
        }
#pragma unroll
        for (int k = 0; k < 4; ++k) {
            float a = dot[k];
            for (int o = 32; o; o >>= 1) a += __shfl_xor(a, o);
            const float coef = gt[k] * gelu_tanh(a);
            const float* vr = vtab + (size_t)ex[k] * ND + lane * 4;
#pragma unroll
            for (int j = 0; j < 4; ++j) { const float4 v = *(const float4*)(vr + j * 256); acc[j].x += coef * v.x; acc[j].y += coef * v.y; acc[j].z += coef * v.z; acc[j].w += coef * v.w; }
        }
    }
#pragma unroll
    for (int j = 0; j < 4; ++j)
        *(float4*)(R + (size_t)token * ND + j * 256 + lane * 4) = make_float4(ALPHA * x[j].x + acc[j].x, ALPHA * x[j].y + acc[j].y, ALPHA * x[j].z + acc[j].z, ALPHA * x[j].w + acc[j].w);
}

__global__ __launch_bounds__(128) void nsa_compress_naive(const float* __restrict__ proj, int coloff, const float* __restrict__ pe,
                                                          const float* __restrict__ w1, const float* __restrict__ w2, float* __restrict__ outc) {
    const int blk = blockIdx.x, g = blk & 3, n = (blk >> 2) % 127, b = blk / (4 * 127), tid = threadIdx.x;
    __shared__ float in[2048];
    __shared__ float hid[128];
    for (int idx = tid; idx < 2048; idx += 128) {
        const int l = idx >> 6, d = idx & 63;
        in[idx] = proj[(size_t)(b * NL + 16 * n + l) * ODD_IN + coloff + g * 64 + d] + pe[l * 64 + d];
    }
    __syncthreads();
    float a = 0.f;
    for (int i = 0; i < 2048; ++i) a += in[i] * w1[(size_t)i * 128 + tid];
    hid[tid] = gelu_tanh(a);
    __syncthreads();
    if (tid < 64) {
        float o = 0.f;
        for (int j = 0; j < 128; ++j) o += hid[j] * w2[j * 64 + tid];
        outc[((size_t)(b * 127 + n) * 4 + g) * 64 + tid] = o;
    }
}

__global__ __launch_bounds__(256) void nsa_cmp_naive(const float* __restrict__ proj, const float* __restrict__ kcmp, const float* __restrict__ vcmp,
                                                     float* __restrict__ O, unsigned* __restrict__ selmask) {
    const int tile = blockIdx.x, g = blockIdx.y, b = blockIdx.z, tid = threadIdx.x;
    const int tk = tid >> 2, r = tid & 3, t = tile * 64 + tk, hd = g * 4 + r;
    __shared__ float kc_s[127 * 64];
    __shared__ float imp_s[64][33];
    for (int idx = tid; idx < 127 * 64; idx += 256) { const int n = idx >> 6, d = idx & 63; kc_s[idx] = kcmp[((size_t)(b * 127 + n) * 4 + g) * 64 + d]; }
    const float* prow = proj + (size_t)(b * NL + t) * ODD_IN;
    float q[64];
#pragma unroll
    for (int d = 0; d < 64; d += 4) { const float4 v = *(const float4*)(prow + hd * 64 + d); q[d] = v.x; q[d + 1] = v.y; q[d + 2] = v.z; q[d + 3] = v.w; }
    const float slope = exp2f(-0.5f * (float)(hd + 1));
    int nvalid = (t >= 31) ? ((t - 31) / 16 + 1) : 0;
    if (nvalid > 127) nvalid = 127;
    __syncthreads();
    float m = -INFINITY, l = 0.f;
    for (int n = 0; n < nvalid; ++n) {
        float s = 0.f;
#pragma unroll
        for (int d = 0; d < 64; ++d) s += q[d] * kc_s[n * 64 + d];
        s = s * 0.125f - slope * (float)(t - (16 * n + 31));
        const float mn = fmaxf(m, s);
        l = l * expf(m - mn) + expf(s - mn);
        m = mn;
    }
    const float inv_l = (nvalid > 0) ? 1.f / fmaxf(l, 1e-30f) : 0.f;
    float acc[64];
#pragma unroll
    for (int d = 0; d < 64; ++d) acc[d] = 0.f;
    float prev3 = 0.f;
    for (int j = 0; j < 32; ++j) {
        float pj[4];
#pragma unroll
        for (int nn = 0; nn < 4; ++nn) {
            const int n = 4 * j + nn;
            float p = 0.f;
            if (n < nvalid) {
                float s = 0.f;
#pragma unroll
                for (int d = 0; d < 64; ++d) s += q[d] * kc_s[n * 64 + d];
                s = s * 0.125f - slope * (float)(t - (16 * n + 31));
                p = expf(s - m) * inv_l;
                const float* vr = vcmp + ((size_t)(b * 127 + n) * 4 + g) * 64;
#pragma unroll
                for (int d = 0; d < 64; ++d) acc[d] += p * vr[d];
            }
            pj[nn] = p;
        }
        float im = 0.5f * prev3 + pj[0] + pj[1] + pj[2] + 0.5f * pj[3];
        prev3 = pj[3];
        im += __shfl_xor(im, 1);
        im += __shfl_xor(im, 2);
        if (r == 0) imp_s[tk][j] = im;
    }
    const float g0 = sigmoidf_(prow[2560 + hd]);
#pragma unroll
    for (int d = 0; d < 64; d += 4)
        *(float4*)(O + (size_t)(b * NL + t) * ND + hd * 64 + d) = make_float4(g0 * acc[d], g0 * acc[d + 1], g0 * acc[d + 2], g0 * acc[d + 3]);
    __syncthreads();
    const int cur = tile;
    unsigned bits = 0;
    for (int jj = 0; jj < 8; ++jj) {
        const int j = r * 8 + jj;
        const bool fj = (j == 0) || (j == cur) || (j == cur - 1);
        const float vj = (j <= cur) ? imp_s[tk][j] + (fj ? 1000.f : 0.f) : -INFINITY;
        int rank = 0;
        for (int k = 0; k < 32; ++k) {
            const bool fk = (k == 0) || (k == cur) || (k == cur - 1);
            const float vk = (k <= cur) ? imp_s[tk][k] + (fk ? 1000.f : 0.f) : -INFINITY;
            rank += (vk > vj || (vk == vj && k < j)) ? 1 : 0;
        }
        if (rank < 16) bits |= 1u << j;
    }
    bits |= __shfl_xor(bits, 1);
    bits |= __shfl_xor(bits, 2);
    if (r == 0) selmask[(size_t)(b * 4 + g) * NL + t] = bits;
}

__global__ __launch_bounds__(256) void nsa_selwin_naive(const float* __restrict__ proj, const unsigned* __restrict__ selmask, float* O) {
    const int tile = blockIdx.x, g = blockIdx.y, b = blockIdx.z, tid = threadIdx.x;
    const int tk = tid >> 2, r = tid & 3, t = tile * 64 + tk, hd = g * 4 + r;
    __shared__ float k_s[64][64], v_s[64][64];
    const float* pb = proj + (size_t)b * NL * ODD_IN;
    const float* prow = pb + (size_t)t * ODD_IN;
    float q[64], acc[64];
#pragma unroll
    for (int d = 0; d < 64; d += 4) { const float4 v = *(const float4*)(prow + hd * 64 + d); q[d] = v.x; q[d + 1] = v.y; q[d + 2] = v.z; q[d + 3] = v.w; }
    const float slope = exp2f(-0.5f * (float)(hd + 1));
    const unsigned mask = selmask[(size_t)(b * 4 + g) * NL + t];
    float* orow = O + (size_t)(b * NL + t) * ND + hd * 64;
    for (int branch = 0; branch < 2; ++branch) {
        const int kcol = (branch == 0 ? 1536 : 2048) + g * 64, vcol = kcol + 256;
        const int j0 = (branch == 0) ? 0 : (tile >= 8 ? tile - 8 : 0);
        float m = -1e30f, l = 0.f;
#pragma unroll
        for (int d = 0; d < 64; ++d) acc[d] = 0.f;
        for (int j = j0; j <= tile; ++j) {
            __syncthreads();
            for (int i = 0; i < 16; ++i) {
                const int idx = tid + 256 * i, key = idx >> 6, d = idx & 63;
                k_s[key][d] = pb[(size_t)(64 * j + key) * ODD_IN + kcol + d];
                v_s[key][d] = pb[(size_t)(64 * j + key) * ODD_IN + vcol + d];
            }
            __syncthreads();
            const bool take = (branch == 0) ? ((mask >> j) & 1u) : true;
            if (take) {
                for (int s = 0; s < 64; ++s) {
                    const int dist = t - (64 * j + s);
                    const bool valid = (branch == 0) ? (dist >= 0) : (dist >= 0 && dist < 512);
                    float sc = 0.f;
#pragma unroll
                    for (int d = 0; d < 64; ++d) sc += q[d] * k_s[s][d];
                    sc = sc * 0.125f - slope * (float)dist;
                    const float mn = valid ? fmaxf(m, sc) : m;
                    const float scale = expf(m - mn);
                    const float p = valid ? expf(sc - mn) : 0.f;
                    l = l * scale + p;
#pragma unroll
                    for (int d = 0; d < 64; ++d) acc[d] = acc[d] * scale + p * v_s[s][d];
                    m = mn;
                }
            }
        }
        const float gt = sigmoidf_(prow[2560 + (branch + 1) * 16 + hd]);
        const float f = gt / fmaxf(l, 1e-30f);
#pragma unroll
        for (int d = 0; d < 64; d += 4) {
            float4 o = *(const float4*)(orow + d);
            o.x += f * acc[d]; o.y += f * acc[d + 1]; o.z += f * acc[d + 2]; o.w += f * acc[d + 3];
            *(float4*)(orow + d) = o;
        }
    }
}

}

extern "C" void kernel_launch(void* const* d_in, const int* in_sizes, int n_in, void* d_out, int out_size, void* d_ws, size_t ws_size, hipStream_t stream) {
    const float* x = (const float*)d_in[0];
    const float* even_w_in = (const float*)d_in[1];
    const float* lam_re = (const float*)d_in[2];
    const float* lam_im = (const float*)d_in[3];
    const float* log_dt = (const float*)d_in[4];
    const float* b_re = (const float*)d_in[5];
    const float* b_im = (const float*)d_in[6];
    const float* c_re = (const float*)d_in[7];
    const float* c_im = (const float*)d_in[8];
    const float* even_d = (const float*)d_in[9];
    const float* w_glu = (const float*)d_in[10];
    const float* b_glu = (const float*)d_in[11];
    const float* even_w_out = (const float*)d_in[12];
    const float* odd_w_in = (const float*)d_in[13];
    const float* pe_k = (const float*)d_in[14];
    const float* w1_k = (const float*)d_in[15];
    const float* w2_k = (const float*)d_in[16];
    const float* pe_v = (const float*)d_in[17];
    const float* w1_v = (const float*)d_in[18];
    const float* w2_v = (const float*)d_in[19];
    const float* odd_w_out = (const float*)d_in[20];
    const float* peer_w_q = (const float*)d_in[21];
    const float* peer_sub = (const float*)d_in[22];
    const float* peer_u = (const float*)d_in[23];
    const float* peer_v = (const float*)d_in[24];
    const float* ln1_g = (const float*)d_in[25];
    const float* ln1_b = (const float*)d_in[26];
    const float* ln2_g = (const float*)d_in[27];
    const float* ln2_b = (const float*)d_in[28];
    float* R = (float*)d_out;

    const size_t SZ_PROJ = (size_t)NT * ODD_IN * 4;
    const size_t SZ_Y = (size_t)NT * ND * 4;
    const size_t SZ_YA = (size_t)NT * 256 * 4;
    const size_t SZ_CMP = (size_t)NB * 127 * 4 * 64 * 4;
    const size_t SZ_SEL = (size_t)NB * 4 * NL * 4;
    const size_t need = SZ_PROJ + SZ_Y + SZ_YA + 2 * SZ_CMP + SZ_SEL;
    if (ws_size < need || n_in != 29 || out_size != NT * ND) return;
    char* ws = (char*)d_ws;
    float* PROJ = (float*)ws;
    float* Y = (float*)(ws + SZ_PROJ);
    float* YA = (float*)(ws + SZ_PROJ + SZ_Y);
    float* KCMP = (float*)(ws + SZ_PROJ + SZ_Y + SZ_YA);
    float* VCMP = (float*)(ws + SZ_PROJ + SZ_Y + SZ_YA + SZ_CMP);
    unsigned* SEL = (unsigned*)(ws + SZ_PROJ + SZ_Y + SZ_YA + 2 * SZ_CMP);
    int* EIDX = (int*)Y;
    float* EGATE = (float*)((char*)Y + (size_t)NT * 128 * 4);

    hipMemcpyAsync(R, x, (size_t)NT * ND * 4, hipMemcpyDeviceToDevice, stream);

    auto peer = [&](int layer) {
        const float* wq = peer_w_q + (size_t)layer * ND * 2048;
        const float* sk = peer_sub + (size_t)layer * 8 * 2 * 128 * 128;
        const float* ut = peer_u + (size_t)layer * 16384 * ND;
        const float* vt = peer_v + (size_t)layer * 16384 * ND;
        gemm_f32<0><<<dim3(2048 / 128, NT / 128), 256, 0, stream>>>(R, ND, wq, 2048, PROJ, 2048, NT, 2048, ND, 0.f);
        peer_route_naive<<<NT * 2, 256, 0, stream>>>(PROJ, sk, EIDX, EGATE);
        peer_expert_naive<<<NT / 4, 256, 0, stream>>>(R, EIDX, EGATE, ut, vt);
        ln_naive<<<NT, 256, 0, stream>>>(R, ln2_g + layer * ND, ln2_b + layer * ND, R);
    };

    gemm_f32<0><<<dim3(EVEN_IN / 128, NT / 128), 256, 0, stream>>>(R, ND, even_w_in, EVEN_IN, PROJ, EVEN_IN, NT, EVEN_IN, ND, 0.f);
    s5_scan_naive<<<NB * 16, 64, 0, stream>>>(PROJ, lam_re, lam_im, log_dt, b_re, b_im, c_re, c_im, even_d, YA);
    glu_naive<<<NT / 16, 256, 0, stream>>>(YA, w_glu, b_glu, Y);
    sb_attn_naive<<<dim3(NL / 64, 12, NB), 64, 0, stream>>>(PROJ, Y);
    gemm_f32<1><<<dim3(ND / 128, NT / 128), 256, 0, stream>>>(Y, ND, even_w_out, ND, R, ND, NT, ND, ND, ALPHA);
    ln_naive<<<NT, 256, 0, stream>>>(R, ln1_g, ln1_b, R);
    peer(0);

    gemm_f32<0><<<dim3((ODD_IN + 127) / 128, NT / 128), 256, 0, stream>>>(R, ND, odd_w_in, ODD_IN, PROJ, ODD_IN, NT, ODD_IN, ND, 0.f);
    nsa_compress_naive<<<NB * 127 * 4, 128, 0, stream>>>(PROJ, 1024, pe_k, w1_k, w2_k, KCMP);
    nsa_compress_naive<<<NB * 127 * 4, 128, 0, stream>>>(PROJ, 1280, pe_v, w1_v, w2_v, VCMP);
    nsa_cmp_naive<<<dim3(NL / 64, 4, NB), 256, 0, stream>>>(PROJ, KCMP, VCMP, Y, SEL);
    nsa_selwin_naive<<<dim3(NL / 64, 4, NB), 256, 0, stream>>>(PROJ, SEL, Y);
    gemm_f32<1><<<dim3(ND / 128, NT / 128), 256, 0, stream>>>(Y, ND, odd_w_out, ND, R, ND, NT, ND, ND, ALPHA);
    ln_naive<<<NT, 256, 0, stream>>>(R, ln1_g + ND, ln1_b + ND, R);
    peer(1);
}
```

```cpp
#include <hip/hip_runtime.h>
#include <hip/hip_cooperative_groups.h>
#include <math.h>
#include <stdint.h>
#include <cstdio>
namespace cg = cooperative_groups;

namespace {

constexpr int NB = 16, NL = 2048, ND = 1024, NT = NB * NL;
constexpr int EVEN_IN = 2560, ODD_IN = 2608;
constexpr float ALPHA = 1.41421356237f;
constexpr float LN_EPS = 1e-5f;
constexpr int NTHR = 512;
constexpr int LDS_BYTES = 163840;
#ifndef PHMASK
#define PHMASK 0xFFFFFFFFu
#endif
#define PH(n) if (PHMASK & (1u << (n)))

__device__ __forceinline__ float gelu_tanh(float x) {
    float u = 0.7978845608028654f * (x + 0.044715f * x * x * x);
    return 0.5f * x * (1.f + tanhf(u));
}
__device__ __forceinline__ float sigmoidf_(float x) { return 1.f / (1.f + expf(-x)); }
__device__ __forceinline__ void wave_lds_fence() { asm volatile("s_waitcnt lgkmcnt(0)" ::: "memory"); }

template <int MODE>
__device__ __forceinline__ void gemm_f32_phase(const float* A, int lda, const float* __restrict__ Bm, int ldb, float* C, int ldc, int M, int N, int K, float alpha, float* lds) {
    const int half = threadIdx.x >> 8, tid = threadIdx.x & 255, tx = tid & 15, ty = tid >> 4;
    float(*As)[132] = (float(*)[132])(lds + half * (2 * 16 * 132));
    float(*Bs)[132] = As + 16;
    const int ntx = (N + 127) / 128, ntiles = ntx * (M / 128), npairs = (ntiles + 1) / 2;
    const int arow = tid >> 1, akk = (tid & 1) * 8;
    const int bkk = tid >> 4, bcol = (tid & 15) * 8;
    for (int pr = blockIdx.x; pr < npairs; pr += gridDim.x) {
        const int vb = pr * 2 + half;
        const bool live = vb < ntiles;
        const int bm = live ? (vb / ntx) * 128 : 0, bn = live ? (vb % ntx) * 128 : 0;
        float acc[8][8];
#pragma unroll
        for (int i = 0; i < 8; ++i)
#pragma unroll
            for (int j = 0; j < 8; ++j) acc[i][j] = 0.f;
        for (int k0 = 0; k0 < K; k0 += 16) {
            const float* ap = A + (size_t)(bm + arow) * lda + k0 + akk;
            float4 a0 = *(const float4*)ap, a1 = *(const float4*)(ap + 4);
            float4 b0 = make_float4(0.f, 0.f, 0.f, 0.f), b1 = b0;
            if (bn + bcol < N) {
                const float* bp = Bm + (size_t)(k0 + bkk) * ldb + bn + bcol;
                b0 = *(const float4*)bp; b1 = *(const float4*)(bp + 4);
            }
            __syncthreads();
            As[akk + 0][arow] = a0.x; As[akk + 1][arow] = a0.y; As[akk + 2][arow] = a0.z; As[akk + 3][arow] = a0.w;
            As[akk + 4][arow] = a1.x; As[akk + 5][arow] = a1.y; As[akk + 6][arow] = a1.z; As[akk + 7][arow] = a1.w;
            *(float4*)&Bs[bkk][bcol] = b0; *(float4*)&Bs[bkk][bcol + 4] = b1;
            __syncthreads();
#pragma unroll 2
            for (int kk = 0; kk < 16; ++kk) {
                float4 av0 = *(const float4*)&As[kk][ty * 4], av1 = *(const float4*)&As[kk][64 + ty * 4];
                float4 bv0 = *(const float4*)&Bs[kk][tx * 4], bv1 = *(const float4*)&Bs[kk][64 + tx * 4];
                float a[8] = {av0.x, av0.y, av0.z, av0.w, av1.x, av1.y, av1.z, av1.w};
                float b[8] = {bv0.x, bv0.y, bv0.z, bv0.w, bv1.x, bv1.y, bv1.z, bv1.w};
#pragma unroll
                for (int i = 0; i < 8; ++i)
#pragma unroll
                    for (int j = 0; j < 8; ++j) acc[i][j] += a[i] * b[j];
            }
        }
        if (live) {
#pragma unroll
            for (int i = 0; i < 8; ++i) {
                const int row = bm + (i < 4 ? ty * 4 + i : 64 + ty * 4 + (i - 4));
#pragma unroll
                for (int jh = 0; jh < 2; ++jh) {
                    const int col = bn + jh * 64 + tx * 4;
                    if (col < N) {
                        float* cp = C + (size_t)row * ldc + col;
                        float4 v = make_float4(acc[i][jh * 4 + 0], acc[i][jh * 4 + 1], acc[i][jh * 4 + 2], acc[i][jh * 4 + 3]);
                        if (MODE == 1) {
                            float4 o = *(const float4*)cp;
                            v.x += alpha * o.x; v.y += alpha * o.y; v.z += alpha * o.z; v.w += alpha * o.w;
                        }
                        *(float4*)cp = v;
                    }
                }
            }
        }
    }
    __syncthreads();
}

__device__ __forceinline__ void s5_scan_wave(int bg, const float* __restrict__ proj, const float* __restrict__ lam_re, const float* __restrict__ lam_im,
                             const float* __restrict__ log_dt, const float* __restrict__ b_re, const float* __restrict__ b_im,
                             const float* __restrict__ c_re, const float* __restrict__ c_im, const float* __restrict__ dskip,
                             float* __restrict__ ya, float* lds) {
    const int b = bg >> 4, g = bg & 15, lane = threadIdx.x & 63;
    float(*us)[16] = (float(*)[16])lds;
    float(*xr)[65] = (float(*)[65])(lds + 1024);
    float(*xi)[65] = (float(*)[65])(lds + 1024 + 4160);
    float(*cr)[64] = (float(*)[64])(lds + 1024 + 8320);
    float(*ci)[64] = (float(*)[64])(lds + 1024 + 8320 + 1024);
    const float lr = lam_re[g * 64 + lane], li = lam_im[g * 64 + lane];
    const float dt = expf(log_dt[g]);
    const float mag = expf(lr * dt);
    const float are = mag * cosf(li * dt), aim = mag * sinf(li * dt);
    const float nr = are - 1.f, den = lr * lr + li * li;
    const float fre = (nr * lr + aim * li) / den, fim = (aim * lr - nr * li) / den;
    float bbr[16], bbi[16];
#pragma unroll
    for (int i = 0; i < 16; ++i) {
        const float br = b_re[(g * 64 + lane) * 16 + i], bi = b_im[(g * 64 + lane) * 16 + i];
        bbr[i] = fre * br - fim * bi; bbi[i] = fre * bi + fim * br;
    }
    for (int idx = lane; idx < 1024; idx += 64) { cr[idx >> 6][idx & 63] = c_re[g * 1024 + idx]; ci[idx >> 6][idx & 63] = c_im[g * 1024 + idx]; }
    float dsk[16];
#pragma unroll
    for (int i = 0; i < 16; ++i) dsk[i] = dskip[g * 16 + i];
    float xre = 0.f, xim = 0.f;
    for (int t0 = 0; t0 < NL; t0 += 64) {
        wave_lds_fence();
        for (int idx = lane; idx < 1024; idx += 64) { const int t = idx >> 4, i = idx & 15; us[t][i] = proj[(size_t)(b * NL + t0 + t) * EVEN_IN + g * 16 + i]; }
        wave_lds_fence();
        for (int t = 0; t < 64; ++t) {
            float bur = 0.f, bui = 0.f;
#pragma unroll
            for (int i = 0; i < 16; ++i) { const float u = us[t][i]; bur += bbr[i] * u; bui += bbi[i] * u; }
            const float nre = are * xre - aim * xim + bur, nim = are * xim + aim * xre + bui;
            xre = nre; xim = nim;
            xr[t][lane] = xre; xi[t][lane] = xim;
        }
        wave_lds_fence();
        float y[16];
#pragma unroll
        for (int i = 0; i < 16; ++i) y[i] = 0.f;
        for (int p = 0; p < 64; ++p) {
            const float a = xr[lane][p], bq = xi[lane][p];
#pragma unroll
            for (int i = 0; i < 16; ++i) y[i] += cr[i][p] * a - ci[i][p] * bq;
        }
#pragma unroll
        for (int i = 0; i < 16; ++i) {
            const float v = y[i] + dsk[i] * us[lane][i];
            ya[(size_t)(b * NL + t0 + lane) * 256 + g * 16 + i] = gelu_tanh(v);
        }
    }
}

__device__ __forceinline__ void sb_attn_wave(int task, const float* __restrict__ proj, float* __restrict__ Y, float* wl) {
    const int qt = task & 31, h = (task >> 5) % 12, b = task / 384, lane = threadIdx.x & 63;
    const int t = qt * 64 + lane;
    float(*ks)[64] = (float(*)[64])wl;
    float(*vs)[64] = (float(*)[64])(wl + 2048);
    const float* base = proj + (size_t)b * NL * EVEN_IN;
    float q[64], acc[64];
#pragma unroll
    for (int d = 0; d < 64; d += 4) {
        const float4 v = *(const float4*)(base + (size_t)t * EVEN_IN + 256 + h * 64 + d);
        q[d] = v.x; q[d + 1] = v.y; q[d + 2] = v.z; q[d + 3] = v.w;
    }
#pragma unroll
    for (int d = 0; d < 64; ++d) acc[d] = 0.f;
    float tail = 0.f;
    for (int c = 2 * qt + 1; c >= 0; --c) {
        wave_lds_fence();
        for (int i = 0; i < 32; ++i) {
            ks[i][lane] = base[(size_t)(c * 32 + i) * EVEN_IN + 1024 + h * 64 + lane];
            vs[i][lane] = base[(size_t)(c * 32 + i) * EVEN_IN + 1792 + h * 64 + lane];
        }
        wave_lds_fence();
        for (int s = 31; s >= 0; --s) {
            const int key = c * 32 + s;
            float z = 0.f;
#pragma unroll
            for (int d = 0; d < 64; ++d) z += q[d] * ks[s][d];
            z *= 0.125f;
            const bool valid = key < t;
            const float sp = fmaxf(z, 0.f) + log1pf(expf(-fabsf(z)));
            const float w = valid ? expf(z - sp + tail) : 0.f;
#pragma unroll
            for (int d = 0; d < 64; ++d) acc[d] += w * vs[s][d];
            if (valid) tail -= sp;
        }
        if (__all(tail < -120.f)) break;
    }
#pragma unroll
    for (int d = 0; d < 64; d += 4)
        *(float4*)(Y + (size_t)(b * NL + t) * ND + 256 + h * 64 + d) = make_float4(acc[d], acc[d + 1], acc[d + 2], acc[d + 3]);
}

__device__ __forceinline__ void glu_phase(const float* __restrict__ ya, const float* __restrict__ wglu, const float* __restrict__ bglu, float* __restrict__ Y, float* lds) {
    const int half = threadIdx.x >> 8, c = threadIdx.x & 255;
    float(*ys)[256] = (float(*)[256])(lds + half * 4096);
    for (int it = blockIdx.x; it < NT / 32; it += gridDim.x) {
        const int t0 = it * 32 + half * 16;
        __syncthreads();
        for (int i = 0; i < 16; ++i) ys[i][c] = ya[(size_t)(t0 + i) * 256 + c];
        __syncthreads();
        float acc[16];
#pragma unroll
        for (int i = 0; i < 16; ++i) acc[i] = 0.f;
        for (int k = 0; k < 256; ++k) {
            const float w = wglu[k * 256 + c];
#pragma unroll
            for (int i = 0; i < 16; ++i) acc[i] += ys[i][k] * w;
        }
        const float bb = bglu[c];
#pragma unroll
        for (int i = 0; i < 16; ++i) Y[(size_t)(t0 + i) * ND + c] = ys[i][c] * sigmoidf_(acc[i] + bb);
    }
    __syncthreads();
}

__device__ __forceinline__ void ln_row_wave(float4 (&v)[4], const float* __restrict__ g, const float* __restrict__ bta, float* out, int lane) {
    float s = 0.f;
#pragma unroll
    for (int j = 0; j < 4; ++j) s += v[j].x + v[j].y + v[j].z + v[j].w;
    for (int o = 32; o; o >>= 1) s += __shfl_xor(s, o);
    const float mean = s * (1.f / ND);
    float s2 = 0.f;
#pragma unroll
    for (int j = 0; j < 4; ++j) {
        v[j].x -= mean; v[j].y -= mean; v[j].z -= mean; v[j].w -= mean;
        s2 += v[j].x * v[j].x + v[j].y * v[j].y + v[j].z * v[j].z + v[j].w * v[j].w;
    }
    for (int o = 32; o; o >>= 1) s2 += __shfl_xor(s2, o);
    const float rs = rsqrtf(s2 * (1.f / ND) + LN_EPS);
#pragma unroll
    for (int j = 0; j < 4; ++j) {
        const float4 gg = *(const float4*)(g + j * 256 + lane * 4), bb = *(const float4*)(bta + j * 256 + lane * 4);
        *(float4*)(out + j * 256 + lane * 4) = make_float4(v[j].x * rs * gg.x + bb.x, v[j].y * rs * gg.y + bb.y, v[j].z * rs * gg.z + bb.z, v[j].w * rs * gg.w + bb.w);
    }
}
__device__ __forceinline__ void ln_phase(float* R, const float* __restrict__ g, const float* __restrict__ bta) {
    const int wave = threadIdx.x >> 6, lane = threadIdx.x & 63;
    for (int row = blockIdx.x * 8 + wave; row < NT; row += gridDim.x * 8) {
        float4 v[4];
#pragma unroll
        for (int j = 0; j < 4; ++j) v[j] = *(const float4*)(R + (size_t)row * ND + j * 256 + lane * 4);
        ln_row_wave(v, g, bta, R + (size_t)row * ND, lane);
    }
}

__device__ __forceinline__ void wave_argmax(float& bv, int& bi) {
#pragma unroll
    for (int o = 32; o; o >>= 1) {
        const float ov = __shfl_xor(bv, o); const int oi = __shfl_xor(bi, o);
        if (ov > bv || (ov == bv && oi < bi)) { bv = ov; bi = oi; }
    }
}
__device__ __forceinline__ void peer_route_phase(const float* __restrict__ qbuf, const float* __restrict__ subk, int* __restrict__ eidx, float* __restrict__ egate, float* lds) {
    const int head = threadIdx.x >> 6, lane = threadIdx.x & 63;
    float* qs = lds + head * 256;
    for (int token = blockIdx.x; token < NT; token += gridDim.x) {
        const float* qp = qbuf + (size_t)token * 2048 + head * 256;
        wave_lds_fence();
        for (int i = 0; i < 4; ++i) qs[lane + 64 * i] = qp[lane + 64 * i];
        wave_lds_fence();
        float myv[2]; int myi[2];
#pragma unroll
        for (int c = 0; c < 2; ++c) {
            float sc[2];
#pragma unroll
            for (int w2 = 0; w2 < 2; ++w2) {
                const float* kr = subk + ((size_t)(head * 2 + c) * 128 + lane + 64 * w2) * 128;
                float a = 0.f;
#pragma unroll 4
                for (int d = 0; d < 128; d += 4) {
                    const float4 kv = *(const float4*)(kr + d);
                    a += qs[c * 128 + d] * kv.x + qs[c * 128 + d + 1] * kv.y + qs[c * 128 + d + 2] * kv.z + qs[c * 128 + d + 3] * kv.w;
                }
                sc[w2] = a;
            }
            float a0 = sc[0], a1 = sc[1];
            float mv = -INFINITY; int mi = 0;
            for (int r = 0; r < 16; ++r) {
                float bv; int bi;
                if (a0 >= a1) { bv = a0; bi = lane; } else { bv = a1; bi = lane + 64; }
                wave_argmax(bv, bi);
                if (lane == r) { mv = bv; mi = bi; }
                if (bi == lane) a0 = -INFINITY; else if (bi == lane + 64) a1 = -INFINITY;
            }
            myv[c] = mv; myi[c] = mi;
        }
        const float va = __shfl(myv[0], lane >> 2);
        float cand[4];
#pragma unroll
        for (int j = 0; j < 4; ++j) cand[j] = va + __shfl(myv[1], (lane & 3) * 4 + j);
        float topv = -INFINITY; int topf = 0;
        for (int r = 0; r < 16; ++r) {
            float bv = cand[0]; int bi = lane * 4;
#pragma unroll
            for (int j = 1; j < 4; ++j) if (cand[j] > bv) { bv = cand[j]; bi = lane * 4 + j; }
            wave_argmax(bv, bi);
            if (lane == r) { topv = bv; topf = bi; }
#pragma unroll
            for (int j = 0; j < 4; ++j) if (bi == lane * 4 + j) cand[j] = -INFINITY;
        }
        const int e1 = __shfl(myi[0], topf >> 4), e2 = __shfl(myi[1], topf & 15);
        const float top0 = __shfl(topv, 0);
        float ex = (lane < 16) ? expf(topv - top0) : 0.f;
        float sum = ex;
        for (int o = 32; o; o >>= 1) sum += __shfl_xor(sum, o);
        if (lane < 16) {
            eidx[(size_t)token * 128 + head * 16 + lane] = e1 * 128 + e2;
            egate[(size_t)token * 128 + head * 16 + lane] = ex / sum;
        }
    }
}

__device__ __forceinline__ void peer_expert_phase(float* R, const int* __restrict__ eidx, const float* __restrict__ egate, const float* __restrict__ utab,
                                  const float* __restrict__ vtab, const float* __restrict__ lg, const float* __restrict__ lb) {
    const int wave = threadIdx.x >> 6, lane = threadIdx.x & 63;
    for (int token = blockIdx.x * 8 + wave; token < NT; token += gridDim.x * 8) {
        float4 x[4], acc[4];
#pragma unroll
        for (int j = 0; j < 4; ++j) { x[j] = *(const float4*)(R + (size_t)token * ND + j * 256 + lane * 4); acc[j] = make_float4(0.f, 0.f, 0.f, 0.f); }
        for (int e0 = 0; e0 < 128; e0 += 4) {
            float dot[4]; int ex[4]; float gt[4];
#pragma unroll
            for (int k = 0; k < 4; ++k) {
                ex[k] = eidx[(size_t)token * 128 + e0 + k]; gt[k] = egate[(size_t)token * 128 + e0 + k];
                const float* ur = utab + (size_t)ex[k] * ND + lane * 4;
                float a = 0.f;
#pragma unroll
                for (int j = 0; j < 4; ++j) { const float4 u = *(const float4*)(ur + j * 256); a += x[j].x * u.x + x[j].y * u.y + x[j].z * u.z + x[j].w * u.w; }
                dot[k] = a;
            }
#pragma unroll
            for (int k = 0; k < 4; ++k) {
                float a = dot[k];
                for (int o = 32; o; o >>= 1) a += __shfl_xor(a, o);
                const float coef = gt[k] * gelu_tanh(a);
                const float* vr = vtab + (size_t)ex[k] * ND + lane * 4;
#pragma unroll
                for (int j = 0; j < 4; ++j) { const float4 v = *(const float4*)(vr + j * 256); acc[j].x += coef * v.x; acc[j].y += coef * v.y; acc[j].z += coef * v.z; acc[j].w += coef * v.w; }
            }
        }
#pragma unroll
        for (int j = 0; j < 4; ++j) { x[j].x = ALPHA * x[j].x + acc[j].x; x[j].y = ALPHA * x[j].y + acc[j].y; x[j].z = ALPHA * x[j].z + acc[j].z; x[j].w = ALPHA * x[j].w + acc[j].w; }
        ln_row_wave(x, lg, lb, R + (size_t)token * ND, lane);
    }
}

__device__ __forceinline__ void nsa_compress_phase(const float* __restrict__ proj, int coloff, const float* __restrict__ pe, const float* __restrict__ w1,
                                   const float* __restrict__ w2, float* __restrict__ outc, float* lds) {
    const int qtr = threadIdx.x >> 7, tid = threadIdx.x & 127;
    float* in = lds + qtr * 2176;
    float* hid = in + 2048;
    for (int it = blockIdx.x; it < NB * 127; it += gridDim.x) {
        const int g = qtr, n = it % 127, b = it / 127;
        __syncthreads();
        for (int idx = tid; idx < 2048; idx += 128) {
            const int l = idx >> 6, d = idx & 63;
            in[idx] = proj[(size_t)(b * NL + 16 * n + l) * ODD_IN + coloff + g * 64 + d] + pe[l * 64 + d];
        }
        __syncthreads();
        float a = 0.f;
        for (int i = 0; i < 2048; ++i) a += in[i] * w1[(size_t)i * 128 + tid];
        hid[tid] = gelu_tanh(a);
        __syncthreads();
        if (tid < 64) {
            float o = 0.f;
            for (int j = 0; j < 128; ++j) o += hid[j] * w2[j * 64 + tid];
            outc[((size_t)(b * 127 + n) * 4 + g) * 64 + tid] = o;
        }
    }
    __syncthreads();
}

__device__ __forceinline__ void nsa_cmp_phase(const float* __restrict__ proj, const float* __restrict__ kcmp, const float* __restrict__ vcmp,
                              float* __restrict__ O, unsigned* __restrict__ selmask, float* lds) {
    const int half = threadIdx.x >> 8, tid = threadIdx.x & 255;
    float* kc_s = lds + half * 18368;
    float* vc_s = kc_s + 127 * 64;
    float(*imp_s)[33] = (float(*)[33])(vc_s + 127 * 64);
    const int tk = tid >> 2, r = tid & 3;
    for (int it = blockIdx.x; it < 32 * 4 * NB / 2; it += gridDim.x) {
        const int vb = it * 2 + half;
        const int tile = vb & 31, g = (vb >> 5) & 3, b = vb >> 7;
        const int t = tile * 64 + tk, hd = g * 4 + r;
        __syncthreads();
        for (int idx = tid; idx < 127 * 64; idx += 256) { const int n = idx >> 6, d = idx & 63; kc_s[idx] = kcmp[((size_t)(b * 127 + n) * 4 + g) * 64 + d]; vc_s[idx] = vcmp[((size_t)(b * 127 + n) * 4 + g) * 64 + d]; }
        const float* prow = proj + (size_t)(b * NL + t) * ODD_IN;
        float q[64];
#pragma unroll
        for (int d = 0; d < 64; d += 4) { const float4 v = *(const float4*)(prow + hd * 64 + d); q[d] = v.x; q[d + 1] = v.y; q[d + 2] = v.z; q[d + 3] = v.w; }
        const float slope = exp2f(-0.5f * (float)(hd + 1));
        int nvalid = (t >= 31) ? ((t - 31) / 16 + 1) : 0;
        if (nvalid > 127) nvalid = 127;
        __syncthreads();
        float m = -INFINITY, l = 0.f;
        for (int n = 0; n < nvalid; ++n) {
            float s = 0.f;
#pragma unroll
            for (int d = 0; d < 64; ++d) s += q[d] * kc_s[n * 64 + d];
            s = s * 0.125f - slope * (float)(t - (16 * n + 31));
            const float mn = fmaxf(m, s);
            l = l * expf(m - mn) + expf(s - mn);
            m = mn;
        }
        const float inv_l = (nvalid > 0) ? 1.f / fmaxf(l, 1e-30f) : 0.f;
        float acc[64];
#pragma unroll
        for (int d = 0; d < 64; ++d) acc[d] = 0.f;
        float prev3 = 0.f;
        for (int j = 0; j < 32; ++j) {
            float pj[4];
#pragma unroll
            for (int nn = 0; nn < 4; ++nn) {
                const int n = 4 * j + nn;
                float p = 0.f;
                if (n < nvalid) {
                    float s = 0.f;
#pragma unroll
                    for (int d = 0; d < 64; ++d) s += q[d] * kc_s[n * 64 + d];
                    s = s * 0.125f - slope * (float)(t - (16 * n + 31));
                    p = expf(s - m) * inv_l;
                    const float* vr = vc_s + n * 64;
#pragma unroll
                    for (int d = 0; d < 64; ++d) acc[d] += p * vr[d];
                }
                pj[nn] = p;
            }
            float im = 0.5f * prev3 + pj[0] + pj[1] + pj[2] + 0.5f * pj[3];
            prev3 = pj[3];
            im += __shfl_xor(im, 1);
            im += __shfl_xor(im, 2);
            if (r == 0) imp_s[tk][j] = im;
        }
        const float g0 = sigmoidf_(prow[2560 + hd]);
#pragma unroll
        for (int d = 0; d < 64; d += 4)
            *(float4*)(O + (size_t)(b * NL + t) * ND + hd * 64 + d) = make_float4(g0 * acc[d], g0 * acc[d + 1], g0 * acc[d + 2], g0 * acc[d + 3]);
        __syncthreads();
        const int cur = tile;
        unsigned bits = 0;
        for (int jj = 0; jj < 8; ++jj) {
            const int j = r * 8 + jj;
            const bool fj = (j == 0) || (j == cur) || (j == cur - 1);
            const float vj = (j <= cur) ? imp_s[tk][j] + (fj ? 1000.f : 0.f) : -INFINITY;
            int rank = 0;
            for (int k = 0; k < 32; ++k) {
                const bool fk = (k == 0) || (k == cur) || (k == cur - 1);
                const float vk = (k <= cur) ? imp_s[tk][k] + (fk ? 1000.f : 0.f) : -INFINITY;
                rank += (vk > vj || (vk == vj && k < j)) ? 1 : 0;
            }
            if (rank < 16) bits |= 1u << j;
        }
        bits |= __shfl_xor(bits, 1);
        bits |= __shfl_xor(bits, 2);
        if (r == 0) selmask[(size_t)(b * 4 + g) * NL + t] = bits;
    }
    __syncthreads();
}

__device__ __forceinline__ void nsa_selwin_phase(const float* __restrict__ proj, const unsigned* __restrict__ selmask, float* O, float* lds) {
    const int half = threadIdx.x >> 8, tid = threadIdx.x & 255;
    float(*k_s)[64] = (float(*)[64])(lds + half * 8192);
    float(*v_s)[64] = (float(*)[64])(lds + half * 8192 + 4096);
    const int tk = tid >> 2, r = tid & 3;
    for (int it = blockIdx.x; it < 32 * 32; it += gridDim.x) {
        const int tile = 31 - (it >> 5);
        const int bgi = (it & 31) * 2 + half, g = bgi & 3, b = bgi >> 2;
        const int t = tile * 64 + tk, hd = g * 4 + r;
        const float* pb = proj + (size_t)b * NL * ODD_IN;
        const float* prow = pb + (size_t)t * ODD_IN;
        float q[64], acc[64];
#pragma unroll
        for (int d = 0; d < 64; d += 4) { const float4 v = *(const float4*)(prow + hd * 64 + d); q[d] = v.x; q[d + 1] = v.y; q[d + 2] = v.z; q[d + 3] = v.w; }
        const float slope = exp2f(-0.5f * (float)(hd + 1));
        const unsigned mask = selmask[(size_t)(b * 4 + g) * NL + t];
        float* orow = O + (size_t)(b * NL + t) * ND + hd * 64;
        for (int branch = 0; branch < 2; ++branch) {
            const int kcol = (branch == 0 ? 1536 : 2048) + g * 64, vcol = kcol + 256;
            const int j0 = (branch == 0) ? 0 : (tile >= 8 ? tile - 8 : 0);
            float m = -1e30f, l = 0.f;
#pragma unroll
            for (int d = 0; d < 64; ++d) acc[d] = 0.f;
            for (int j = j0; j <= tile; ++j) {
                __syncthreads();
                for (int i = 0; i < 16; ++i) {
                    const int idx = tid + 256 * i, key = idx >> 6, d = idx & 63;
                    k_s[key][d] = pb[(size_t)(64 * j + key) * ODD_IN + kcol + d];
                    v_s[key][d] = pb[(size_t)(64 * j + key) * ODD_IN + vcol + d];
                }
                __syncthreads();
                const bool take = (branch == 0) ? ((mask >> j) & 1u) : true;
                if (take) {
                    for (int s = 0; s < 64; ++s) {
                        const int dist = t - (64 * j + s);
                        const bool valid = (branch == 0) ? (dist >= 0) : (dist >= 0 && dist < 512);
                        float sc = 0.f;
#pragma unroll
                        for (int d = 0; d < 64; ++d) sc += q[d] * k_s[s][d];
                        sc = sc * 0.125f - slope * (float)dist;
                        const float mn = valid ? fmaxf(m, sc) : m;
                        const float scale = expf(m - mn);
                        const float p = valid ? expf(sc - mn) : 0.f;
                        l = l * scale + p;
#pragma unroll
                        for (int d = 0; d < 64; ++d) acc[d] = acc[d] * scale + p * v_s[s][d];
                        m = mn;
                    }
                }
            }
            const float gt = sigmoidf_(prow[2560 + (branch + 1) * 16 + hd]);
            const float f = gt / fmaxf(l, 1e-30f);
#pragma unroll
            for (int d = 0; d < 64; d += 4) {
                float4 o = *(const float4*)(orow + d);
                o.x += f * acc[d]; o.y += f * acc[d + 1]; o.z += f * acc[d + 2]; o.w += f * acc[d + 3];
                *(float4*)(orow + d) = o;
            }
        }
    }
    __syncthreads();
}

struct Params {
    const float* in[29];
    float* out;
    char* ws;
    unsigned long long pad;
};

constexpr size_t SZ_PROJ = (size_t)NT * ODD_IN * 4;
constexpr size_t SZ_Y = (size_t)NT * ND * 4;
constexpr size_t SZ_YA = (size_t)NT * 256 * 4;
constexpr size_t SZ_CMP = (size_t)NB * 127 * 4 * 64 * 4;
constexpr size_t SZ_SEL = (size_t)NB * 4 * NL * 4;
constexpr size_t WS_NEED = SZ_PROJ + SZ_Y + SZ_YA + 2 * SZ_CMP + SZ_SEL;

__global__ void __launch_bounds__(NTHR) fwd_megakernel(Params p) {
    extern __shared__ __attribute__((aligned(16))) unsigned char lds_raw[];
    float* lds = (float*)lds_raw;
    cg::grid_group grid = cg::this_grid();
    const float* x = p.in[0];
    float* R = p.out;
    char* ws = p.ws;
    float* PROJ = (float*)ws;
    float* Y = (float*)(ws + SZ_PROJ);
    float* YA = (float*)(ws + SZ_PROJ + SZ_Y);
    float* KCMP = (float*)(ws + SZ_PROJ + SZ_Y + SZ_YA);
    float* VCMP = (float*)(ws + SZ_PROJ + SZ_Y + SZ_YA + SZ_CMP);
    unsigned* SEL = (unsigned*)(ws + SZ_PROJ + SZ_Y + SZ_YA + 2 * SZ_CMP);
    int* EIDX = (int*)Y;
    float* EGATE = (float*)((char*)Y + (size_t)NT * 128 * 4);
    const int wave = threadIdx.x >> 6;

    for (size_t i = (size_t)blockIdx.x * NTHR + threadIdx.x; i < (size_t)NT * ND / 4; i += (size_t)gridDim.x * NTHR)
        ((float4*)R)[i] = ((const float4*)x)[i];
    PH(0) gemm_f32_phase<0>(x, ND, p.in[1], EVEN_IN, PROJ, EVEN_IN, NT, EVEN_IN, ND, 0.f, lds);
    grid.sync();
    PH(1) if (wave == 0) {
        for (int bg = blockIdx.x; bg < NB * 16; bg += gridDim.x)
            s5_scan_wave(bg, PROJ, p.in[2], p.in[3], p.in[4], p.in[5], p.in[6], p.in[7], p.in[8], p.in[9], YA, lds);
    } else PH(2) {
        for (int task = blockIdx.x * 7 + (wave - 1); task < NB * 12 * 32; task += gridDim.x * 7)
            sb_attn_wave(task, PROJ, Y, lds + 11392 + (wave - 1) * 4096);
    }
    grid.sync();
    PH(3) glu_phase(YA, p.in[10], p.in[11], Y, lds);
    grid.sync();
    PH(4) gemm_f32_phase<1>(Y, ND, p.in[12], ND, R, ND, NT, ND, ND, ALPHA, lds);
    grid.sync();
    PH(5) ln_phase(R, p.in[25], p.in[26]);
    grid.sync();
#define PEER_FFN(layer, last) \
    PH(12) gemm_f32_phase<0>(R, ND, p.in[21] + (size_t)(layer) * ND * 2048, 2048, PROJ, 2048, NT, 2048, ND, 0.f, lds); \
    grid.sync(); \
    PH(13) peer_route_phase(PROJ, p.in[22] + (size_t)(layer) * 8 * 2 * 128 * 128, EIDX, EGATE, lds); \
    grid.sync(); \
    PH(14) peer_expert_phase(R, EIDX, EGATE, p.in[23] + (size_t)(layer) * 16384 * ND, p.in[24] + (size_t)(layer) * 16384 * ND, p.in[27] + (layer) * ND, p.in[28] + (layer) * ND); \
    if (!(last)) grid.sync();
    PEER_FFN(0, false)
    PH(6) gemm_f32_phase<0>(R, ND, p.in[13], ODD_IN, PROJ, ODD_IN, NT, ODD_IN, ND, 0.f, lds);
    grid.sync();
    PH(7) nsa_compress_phase(PROJ, 1024, p.in[14], p.in[15], p.in[16], KCMP, lds);
    PH(7) nsa_compress_phase(PROJ, 1280, p.in[17], p.in[18], p.in[19], VCMP, lds);
    grid.sync();
    PH(8) nsa_cmp_phase(PROJ, KCMP, VCMP, Y, SEL, lds);
    grid.sync();
    PH(9) nsa_selwin_phase(PROJ, SEL, Y, lds);
    grid.sync();
    PH(10) gemm_f32_phase<1>(Y, ND, p.in[20], ND, R, ND, NT, ND, ND, ALPHA, lds);
    grid.sync();
    PH(11) ln_phase(R, p.in[25] + ND, p.in[26] + ND);
    grid.sync();
    PEER_FFN(1, true)
}

}

extern "C" void kernel_launch(void* const* d_in, const int* in_sizes, int n_in, void* d_out, int out_size, void* d_ws, size_t ws_size, hipStream_t stream) {
    static int grid_blocks = 0;
    if (grid_blocks == 0) {
        if (n_in != 29 || out_size != NT * ND || ws_size < WS_NEED) { fprintf(stderr, "kernel_launch: unexpected shapes / workspace (%zu < %zu)\n", ws_size, (size_t)WS_NEED); grid_blocks = -1; return; }
        int dev = 0, cus = 0, per_cu = 0;
        hipGetDevice(&dev);
        hipDeviceGetAttribute(&cus, hipDeviceAttributeMultiprocessorCount, dev);
        hipFuncSetAttribute((const void*)fwd_megakernel, hipFuncAttributeMaxDynamicSharedMemorySize, LDS_BYTES);
        hipOccupancyMaxActiveBlocksPerMultiprocessor(&per_cu, (const void*)fwd_megakernel, NTHR, LDS_BYTES);
        if (per_cu < 1) { fprintf(stderr, "kernel_launch: occupancy query says %d blocks/CU\n", per_cu); grid_blocks = -1; return; }
        grid_blocks = cus;
    }
    if (grid_blocks < 0) return;
    Params p{};
    for (int i = 0; i < 29; ++i) p.in[i] = (const float*)d_in[i];
    p.out = (float*)d_out; p.ws = (char*)d_ws; p.pad = 0;
    void* args[] = {&p};
    hipError_t e = hipLaunchCooperativeKernel((const void*)fwd_megakernel, dim3(grid_blocks), dim3(NTHR), args, LDS_BYTES, stream);
    if (e != hipSuccess) fprintf(stderr, "cooperative launch failed: %s (grid %d)\n", hipGetErrorString(e), grid_blocks);
}
```

```cpp
#include <hip/hip_runtime.h>
#include <hip/hip_cooperative_groups.h>
#include <math.h>
#include <stdint.h>
#include <cstdio>
namespace cg = cooperative_groups;

namespace pg8 {
#define PG8_LAS __attribute__((address_space(3)))
typedef unsigned short bf16_t;
typedef short bf16x8 __attribute__((ext_vector_type(8)));
typedef float f32x4 __attribute__((ext_vector_type(4)));
typedef unsigned u32x4 __attribute__((ext_vector_type(4)));
constexpr int BM = 256, BK = 64, HALF = 128, HTB = HALF * BK * 2  , STAGE_BYTES = 8 * HTB, NXCD = 8, WGM = 8;

__host__ __device__ __forceinline__ int lds_byte(int r, int c) { const int st = (r >> 4) * 2 + (c >> 5), rr = r & 15, cc = c & 31, ob = rr * 64 + cc * 2; return st * 1024 + (ob ^ (((ob >> 9) & 1) << 5)); }
__host__ __device__ __forceinline__ void stage_rc(int b, int& R, int& C) { const int st = b / 1024, sb = b % 1024, swz = sb ^ (((sb >> 9) & 1) << 5); R = (st >> 1) * 16 + swz / 64; C = (st & 1) * 32 + (swz % 64) / 2; }
__host__ __device__ __forceinline__ int perm32(int rho) { const int n = rho >> 4, i = rho & 15; return 8 * (i >> 2) + 4 * n + (i & 3); }

struct Unit { int pm, pn; };
struct Gemm { const bf16_t* A; const bf16_t* Bt; int M, N, K; };

struct StaticOrder {
    int nM, nN, nwg, G, c;
    __host__ __device__ void init(int M, int N, int G_, int c_) { nM = M / BM; nN = N / BM; nwg = nM * nN; G = G_; c = c_; }
    __host__ __device__ bool next(int i, Unit& u) const {
        const long L = (long)i * G + c; if (L >= nwg) return false;
        int wgid = (int)L; { const int q = nwg / NXCD, r = nwg % NXCD, xcd = wgid % NXCD, off = wgid / NXCD; wgid = (xcd < r ? xcd * (q + 1) : r * (q + 1) + (xcd - r) * q) + off; }
        const int nig = WGM * nN, gid = wgid / nig, fm = gid * WGM, gsz = (nM - fm) < WGM ? (nM - fm) : WGM;
        u.pm = fm + ((wgid % nig) % gsz); u.pn = (wgid % nig) / gsz; return true;
    }
    __device__ __forceinline__ void a_ready(const Unit&) const {}
    __device__ __forceinline__ void done(const Unit&) const {}
};
__device__ __forceinline__ unsigned cvt_pk_bf16(float lo, float hi) { unsigned r; asm volatile("v_cvt_pk_bf16_f32 %0, %1, %2" : "=v"(r) : "v"(lo), "v"(hi)); return r; }
template <class Epi, class Sched, bool STAMP = false>
__device__ __forceinline__ void gemm_phase(PG8_LAS unsigned char* lds, const Gemm g, const Sched& S, const Epi& E, unsigned long long* stamps) {
    const int tid = threadIdx.x, wid = __builtin_amdgcn_readfirstlane(tid >> 6), lane = tid & 63, wr = wid >> 2, wc = wid & 3, fr = lane & 15, fq = lane >> 4;
    const int K = g.K, nt = K / BK;
    int ts_lo = 0, ts_hi = 0, nts = 0; const unsigned long long rt_entry = STAMP ? (unsigned long long)wall_clock64() : 0ull;
#define PG8_STAMP() do { if (STAMP && wid == 0 && nts < 64) { const unsigned long long _c = (unsigned long long)clock64(); \
        ts_lo = (lane == nts) ? (int)(unsigned)_c : ts_lo; ts_hi = (lane == nts) ? (int)(unsigned)(_c >> 32) : ts_hi; ++nts; } } while (0)
    PG8_STAMP();
    unsigned voffA[2], voffB[2];
#pragma unroll
    for (int i = 0; i < 2; ++i) { int R, C; stage_rc(tid * 16 + i * 8192, R, C); const int Rb = Epi::PERM ? ((R & ~31) + perm32(R & 31)) : R;
        voffA[i] = (unsigned)(R * K + C) * 2u; voffB[i] = (unsigned)(Rb * K + C) * 2u; }
    const size_t kstep = (size_t)(BK * 2);
    const size_t hstep = (size_t)HALF * K * 2;
    const size_t tstep = 2 * hstep;
    const unsigned ldsw = (unsigned)wid * 1024u;
    const int aoff = lds_byte(wr * 64 + fr, fq * 8), boff = lds_byte(wc * 32 + fr, fq * 8);
#define PG8_SA(b, h) (((b) * 2 + (h)) * HTB)
#define PG8_SB(b, h) ((4 + (b) * 2 + (h)) * HTB)
#define PG8_STAGE(bufoff, gbase, voff) do { _Pragma("unroll") for (int _i = 0; _i < 2; ++_i) \
        __builtin_amdgcn_global_load_lds((const unsigned*)((const char*)(gbase) + (voff)[_i]), (PG8_LAS unsigned*)(lds + (bufoff) + ldsw + _i * 8192), 16, 0, 0); } while (0)
#define PG8_LDA(dst, b, h) do { _Pragma("unroll") for (int m = 0; m < 4; ++m) _Pragma("unroll") for (int k = 0; k < 2; ++k) dst[m][k] = *(const PG8_LAS bf16x8*)(lds + PG8_SA(b, h) + aoff + m * 2048 + k * 1024); } while (0)
#define PG8_LDB(dst, b, h) do { _Pragma("unroll") for (int n = 0; n < 2; ++n) _Pragma("unroll") for (int k = 0; k < 2; ++k) dst[n][k] = *(const PG8_LAS bf16x8*)(lds + PG8_SB(b, h) + boff + n * 2048 + k * 1024); } while (0)
#define PG8_MMA(ai, bj, At, Bt) do { __builtin_amdgcn_s_setprio(1); _Pragma("unroll") for (int m = 0; m < 4; ++m) _Pragma("unroll") for (int n = 0; n < 2; ++n) _Pragma("unroll") for (int k = 0; k < 2; ++k) \
        acc[ai][bj][m][n] = __builtin_amdgcn_mfma_f32_16x16x32_bf16(Bt[n][k], At[m][k], acc[ai][bj][m][n], 0, 0, 0); __builtin_amdgcn_s_setprio(0); } while (0)
#define PG8_WAIT_V(n) asm volatile("s_waitcnt vmcnt(" #n ")" ::: "memory")
#define PG8_WAIT_L(n) asm volatile("s_waitcnt lgkmcnt(" #n ")" ::: "memory")
#define PG8_BAR __builtin_amdgcn_s_barrier()
#define PG8_SCHED __builtin_amdgcn_sched_barrier(0)
    Unit cur, nxt; int ui = 0;
    if (!S.next(0, cur)) return;
    f32x4 acc[2][2][4][2];
#pragma unroll
    for (int a = 0; a < 2; ++a)
#pragma unroll
        for (int b = 0; b < 2; ++b)
#pragma unroll
            for (int m = 0; m < 4; ++m)
#pragma unroll
                for (int n = 0; n < 2; ++n) acc[a][b][m][n] = (f32x4){0.f, 0.f, 0.f, 0.f};
    bf16x8 At[4][2], B0[2][2], B1[2][2];
    const char* cA = (const char*)g.A + (size_t)cur.pm * tstep; const char* cB = (const char*)g.Bt + (size_t)cur.pn * tstep;
    S.a_ready(cur);
    PG8_STAGE(PG8_SB(0, 0), cB, voffB); PG8_STAGE(PG8_SA(0, 0), cA, voffA); PG8_STAGE(PG8_SB(0, 1), cB + hstep, voffB); PG8_STAGE(PG8_SA(0, 1), cA + hstep, voffA);
    if (wr == 1) PG8_BAR;
    PG8_WAIT_V(4); PG8_BAR;
    PG8_STAGE(PG8_SB(1, 0), cB + kstep, voffB); PG8_STAGE(PG8_SA(1, 0), cA + kstep, voffA); PG8_STAGE(PG8_SB(1, 1), cB + hstep + kstep, voffB);
    PG8_WAIT_V(6); PG8_BAR;
    PG8_STAMP();
    for (;;) {
        const bool has_next = S.next(ui + 1, nxt);
        const char* nA = has_next ? (const char*)g.A + (size_t)nxt.pm * tstep : cA; const char* nB = has_next ? (const char*)g.Bt + (size_t)nxt.pn * tstep : cB;
        for (int t = 0; t < nt; t += 2) {
            const bool last = (t == nt - 2);
            const char* a1 = cA + (size_t)(t + 1) * kstep;
            const char* a2 = last ? nA : cA + (size_t)(t + 2) * kstep; const char* b2 = last ? nB : cB + (size_t)(t + 2) * kstep;
            const char* a3 = a2 + kstep; const char* b3 = b2 + kstep;
            if (last && has_next) S.a_ready(nxt);
            PG8_LDB(B0, 0, 0); PG8_SCHED; PG8_LDA(At, 0, 0); PG8_STAGE(PG8_SA(1, 1), a1 + hstep, voffA);
            PG8_WAIT_L(8); PG8_BAR; PG8_WAIT_L(0); PG8_MMA(0, 0, At, B0); PG8_BAR; PG8_SCHED;
            PG8_LDB(B1, 0, 1); PG8_STAGE(PG8_SB(0, 0), b2, voffB);
            PG8_BAR; PG8_WAIT_L(0); PG8_MMA(0, 1, At, B1); PG8_BAR;
            PG8_LDA(At, 0, 1); PG8_STAGE(PG8_SA(0, 0), a2, voffA);
            PG8_BAR; PG8_WAIT_L(0); PG8_MMA(1, 0, At, B0); PG8_BAR; PG8_SCHED;
            PG8_STAGE(PG8_SB(0, 1), b2 + hstep, voffB);
            PG8_WAIT_V(6); PG8_BAR; PG8_MMA(1, 1, At, B1); PG8_BAR;
            PG8_LDB(B0, 1, 0); PG8_SCHED; PG8_LDA(At, 1, 0); PG8_STAGE(PG8_SA(0, 1), a2 + hstep, voffA);
            PG8_WAIT_L(8); PG8_BAR; PG8_WAIT_L(0); PG8_MMA(0, 0, At, B0); PG8_BAR; PG8_SCHED;
            PG8_LDB(B1, 1, 1); PG8_STAGE(PG8_SB(1, 0), b3, voffB);
            PG8_BAR; PG8_WAIT_L(0); PG8_MMA(0, 1, At, B1); PG8_BAR;
            PG8_LDA(At, 1, 1); PG8_STAGE(PG8_SA(1, 0), a3, voffA);
            PG8_BAR; PG8_WAIT_L(0); PG8_MMA(1, 0, At, B0); PG8_BAR; PG8_SCHED;
            PG8_STAGE(PG8_SB(1, 1), b3 + hstep, voffB);
            PG8_WAIT_V(6); PG8_BAR; PG8_MMA(1, 1, At, B1); PG8_BAR;
        }
        PG8_STAMP();
        if constexpr (!Epi::AFTER_DRAIN) { E(acc, cur, wr, wc, fr, fq); S.done(cur); }
        PG8_STAMP();
        if (!has_next) break;
#pragma unroll
        for (int a = 0; a < 2; ++a)
#pragma unroll
            for (int b = 0; b < 2; ++b)
#pragma unroll
                for (int m = 0; m < 4; ++m)
#pragma unroll
                    for (int n = 0; n < 2; ++n) acc[a][b][m][n] = (f32x4){0.f, 0.f, 0.f, 0.f};
        cur = nxt; cA = nA; cB = nB; ++ui;
    }
    PG8_WAIT_V(0);
    if (wr == 0) PG8_BAR;
    PG8_BAR;
    if constexpr (Epi::AFTER_DRAIN) { E.fused(acc, cur, wr, wc, fr, fq, lds, wid, lane); S.done(cur); }
    PG8_STAMP();
    if (STAMP && wid == 0) { stamps[lane] = lane < nts ? (((unsigned long long)(unsigned)ts_hi << 32) | (unsigned)ts_lo) : 0ull;
        if (lane == 62) stamps[62] = rt_entry; if (lane == 63) stamps[63] = (unsigned long long)wall_clock64(); }
#undef PG8_STAMP
#undef PG8_SA
#undef PG8_SB
#undef PG8_STAGE
#undef PG8_LDA
#undef PG8_LDB
#undef PG8_MMA
#undef PG8_WAIT_V
#undef PG8_WAIT_L
#undef PG8_BAR
#undef PG8_SCHED
}
}

namespace {
using pg8::bf16_t;
typedef float f32x4 __attribute__((ext_vector_type(4)));
typedef unsigned u32x4 __attribute__((ext_vector_type(4)));

constexpr int NB = 16, NL = 2048, ND = 1024, NT = NB * NL;
constexpr int EVEN_IN = 2560, ODD_IN = 2608, ODD_PAD = 2816;
constexpr float ALPHA = 1.41421356237f;
constexpr float LN_EPS = 1e-5f;
constexpr int NTHR = 512;
constexpr int LDS_BYTES = 163840;
#ifndef PHMASK
#define PHMASK 0xFFFFFFFFu
#endif
#define PH(n) if (PHMASK & (1u << (n)))

__device__ __forceinline__ float bf2f(bf16_t v) { return __uint_as_float((unsigned)v << 16); }
__device__ __forceinline__ bf16_t f2bf(float f) { unsigned u = __float_as_uint(f); u += 0x7FFFu + ((u >> 16) & 1u); return (bf16_t)(u >> 16); }
__device__ __forceinline__ unsigned pack2(float lo, float hi) { return (unsigned)f2bf(lo) | ((unsigned)f2bf(hi) << 16); }
__device__ __forceinline__ void ld8(const bf16_t* p, float* o) {
    const uint4 v = *(const uint4*)p;
    o[0] = __uint_as_float(v.x << 16); o[1] = __uint_as_float(v.x & 0xffff0000u);
    o[2] = __uint_as_float(v.y << 16); o[3] = __uint_as_float(v.y & 0xffff0000u);
    o[4] = __uint_as_float(v.z << 16); o[5] = __uint_as_float(v.z & 0xffff0000u);
    o[6] = __uint_as_float(v.w << 16); o[7] = __uint_as_float(v.w & 0xffff0000u);
}
__device__ __forceinline__ void st8(bf16_t* p, const float* o) {
    uint4 v; v.x = pack2(o[0], o[1]); v.y = pack2(o[2], o[3]); v.z = pack2(o[4], o[5]); v.w = pack2(o[6], o[7]);
    *(uint4*)p = v;
}

struct EpiBf16s {
    static constexpr bool PERM = true, AFTER_DRAIN = false;
    bf16_t* O; int ldc;
    __device__ __forceinline__ void operator()(const f32x4 (&acc)[2][2][4][2], const pg8::Unit& u, int wr, int wc, int fr, int fq) const {
        const int row0 = u.pm * 256 + wr * 64 + fr, col0 = u.pn * 256 + wc * 32 + 8 * fq;
#pragma unroll
        for (int ai = 0; ai < 2; ++ai)
#pragma unroll
            for (int m = 0; m < 4; ++m) { bf16_t* rowp = O + (size_t)(row0 + ai * 128 + m * 16) * ldc + col0;
#pragma unroll
                for (int bj = 0; bj < 2; ++bj) { const f32x4 v0 = acc[ai][bj][m][0], v1 = acc[ai][bj][m][1];
                    u32x4 w; w.x = pg8::cvt_pk_bf16(v0[0], v0[1]); w.y = pg8::cvt_pk_bf16(v0[2], v0[3]); w.z = pg8::cvt_pk_bf16(v1[0], v1[1]); w.w = pg8::cvt_pk_bf16(v1[2], v1[3]);
                    *(u32x4*)(rowp + bj * 128) = w; } }
    }
};
struct EpiRes {
    static constexpr bool PERM = false, AFTER_DRAIN = false;
    float* C; int ldc; float alpha;
    __device__ __forceinline__ void operator()(const f32x4 (&acc)[2][2][4][2], const pg8::Unit& u, int wr, int wc, int fr, int fq) const {
        const int row0 = u.pm * 256 + wr * 64 + fr, col0 = u.pn * 256 + wc * 32 + 4 * fq;
#pragma unroll
        for (int ai = 0; ai < 2; ++ai)
#pragma unroll
            for (int m = 0; m < 4; ++m) { float* rowp = C + (size_t)(row0 + ai * 128 + m * 16) * ldc + col0;
#pragma unroll
                for (int bj = 0; bj < 2; ++bj)
#pragma unroll
                    for (int n = 0; n < 2; ++n) { f32x4* cp = (f32x4*)(rowp + bj * 128 + n * 16); *cp = *cp * alpha + acc[ai][bj][m][n]; } }
    }
};
template <class Epi>
__device__ __forceinline__ void gemm_bf16_phase(unsigned char* lds, const bf16_t* A, const bf16_t* Bt, int M, int N, int K, const Epi& E) {
    pg8::Gemm g{A, Bt, M, N, K};
    pg8::StaticOrder S; S.init(M, N, (int)gridDim.x, (int)blockIdx.x);
    pg8::gemm_phase<Epi, pg8::StaticOrder, false>((PG8_LAS unsigned char*)lds, g, S, E, nullptr);
    __syncthreads();
}

__device__ __forceinline__ void convert_wt_phase(const float* __restrict__ W, int K, int N, int Npad, bf16_t* __restrict__ Wt, float* lds) {
    float(*tile)[65] = (float(*)[65])lds;
    const int tid = threadIdx.x, ntn = Npad / 64, ntiles = (K / 64) * ntn;
    for (int it = blockIdx.x; it < ntiles; it += gridDim.x) {
        const int k0 = (it / ntn) * 64, n0 = (it % ntn) * 64;
        __syncthreads();
#pragma unroll
        for (int h = 0; h < 2; ++h) {
            const int r = (tid >> 4) + h * 32, c4 = (tid & 15) * 4;
            float4 v = make_float4(0.f, 0.f, 0.f, 0.f);
            if (n0 + c4 < N) v = *(const float4*)(W + (size_t)(k0 + r) * N + n0 + c4);
            tile[r][c4] = v.x; tile[r][c4 + 1] = v.y; tile[r][c4 + 2] = v.z; tile[r][c4 + 3] = v.w;
        }
        __syncthreads();
        const int n = tid >> 3, k8 = (tid & 7) * 8;
        float o[8];
#pragma unroll
        for (int j = 0; j < 8; ++j) o[j] = tile[k8 + j][n];
        st8(Wt + (size_t)(n0 + n) * K + k0 + k8, o);
    }
    __syncthreads();
}
__device__ __forceinline__ float gelu_tanh(float x) {
    float u = 0.7978845608028654f * (x + 0.044715f * x * x * x);
    return 0.5f * x * (1.f + tanhf(u));
}
__device__ __forceinline__ float sigmoidf_(float x) { return 1.f / (1.f + expf(-x)); }
__device__ __forceinline__ void wave_lds_fence() { asm volatile("s_waitcnt lgkmcnt(0)" ::: "memory"); }

__device__ __forceinline__ void s5_scan_wave(int bg, const bf16_t* __restrict__ proj, const float* __restrict__ lam_re, const float* __restrict__ lam_im,
                             const float* __restrict__ log_dt, const float* __restrict__ b_re, const float* __restrict__ b_im,
                             const float* __restrict__ c_re, const float* __restrict__ c_im, const float* __restrict__ dskip,
                             float* __restrict__ ya, float* lds) {
    const int b = bg >> 4, g = bg & 15, lane = threadIdx.x & 63;
    float(*us)[16] = (float(*)[16])lds;
    float(*xr)[65] = (float(*)[65])(lds + 1024);
    float(*xi)[65] = (float(*)[65])(lds + 1024 + 4160);
    float(*cr)[64] = (float(*)[64])(lds + 1024 + 8320);
    float(*ci)[64] = (float(*)[64])(lds + 1024 + 8320 + 1024);
    const float lr = lam_re[g * 64 + lane], li = lam_im[g * 64 + lane];
    const float dt = expf(log_dt[g]);
    const float mag = expf(lr * dt);
    const float are = mag * cosf(li * dt), aim = mag * sinf(li * dt);
    const float nr = are - 1.f, den = lr * lr + li * li;
    const float fre = (nr * lr + aim * li) / den, fim = (aim * lr - nr * li) / den;
    float bbr[16], bbi[16];
#pragma unroll
    for (int i = 0; i < 16; ++i) {
        const float br = b_re[(g * 64 + lane) * 16 + i], bi = b_im[(g * 64 + lane) * 16 + i];
        bbr[i] = fre * br - fim * bi; bbi[i] = fre * bi + fim * br;
    }
    for (int idx = lane; idx < 1024; idx += 64) { cr[idx >> 6][idx & 63] = c_re[g * 1024 + idx]; ci[idx >> 6][idx & 63] = c_im[g * 1024 + idx]; }
    float dsk[16];
#pragma unroll
    for (int i = 0; i < 16; ++i) dsk[i] = dskip[g * 16 + i];
    float xre = 0.f, xim = 0.f;
    for (int t0 = 0; t0 < NL; t0 += 64) {
        wave_lds_fence();
        for (int idx = lane; idx < 1024; idx += 64) { const int t = idx >> 4, i = idx & 15; us[t][i] = bf2f(proj[(size_t)(b * NL + t0 + t) * EVEN_IN + g * 16 + i]); }
        wave_lds_fence();
        for (int t = 0; t < 64; ++t) {
            float bur = 0.f, bui = 0.f;
#pragma unroll
            for (int i = 0; i < 16; ++i) { const float u = us[t][i]; bur += bbr[i] * u; bui += bbi[i] * u; }
            const float nre = are * xre - aim * xim + bur, nim = are * xim + aim * xre + bui;
            xre = nre; xim = nim;
            xr[t][lane] = xre; xi[t][lane] = xim;
        }
        wave_lds_fence();
        float y[16];
#pragma unroll
        for (int i = 0; i < 16; ++i) y[i] = 0.f;
        for (int p = 0; p < 64; ++p) {
            const float a = xr[lane][p], bq = xi[lane][p];
#pragma unroll
            for (int i = 0; i < 16; ++i) y[i] += cr[i][p] * a - ci[i][p] * bq;
        }
#pragma unroll
        for (int i = 0; i < 16; ++i) {
            const float v = y[i] + dsk[i] * us[lane][i];
            ya[(size_t)(b * NL + t0 + lane) * 256 + g * 16 + i] = gelu_tanh(v);
        }
    }
}

__device__ __forceinline__ void sb_attn_wave(int task, const bf16_t* __restrict__ proj, bf16_t* __restrict__ Y, float* wl) {
    const int qt = task & 31, h = (task >> 5) % 12, b = task / 384, lane = threadIdx.x & 63;
    const int t = qt * 64 + lane;
    float(*ks)[64] = (float(*)[64])wl;
    float(*vs)[64] = (float(*)[64])(wl + 2048);
    const bf16_t* base = proj + (size_t)b * NL * EVEN_IN;
    float q[64], acc[64];
#pragma unroll
    for (int d = 0; d < 64; d += 8) ld8(base + (size_t)t * EVEN_IN + 256 + h * 64 + d, q + d);
#pragma unroll
    for (int d = 0; d < 64; ++d) acc[d] = 0.f;
    float tail = 0.f;
    for (int c = 2 * qt + 1; c >= 0; --c) {
        wave_lds_fence();
        for (int i = 0; i < 32; ++i) {
            ks[i][lane] = bf2f(base[(size_t)(c * 32 + i) * EVEN_IN + 1024 + h * 64 + lane]);
            vs[i][lane] = bf2f(base[(size_t)(c * 32 + i) * EVEN_IN + 1792 + h * 64 + lane]);
        }
        wave_lds_fence();
        for (int s = 31; s >= 0; --s) {
            const int key = c * 32 + s;
            float z = 0.f;
#pragma unroll
            for (int d = 0; d < 64; ++d) z += q[d] * ks[s][d];
            z *= 0.125f;
            const bool valid = key < t;
            const float sp = fmaxf(z, 0.f) + log1pf(expf(-fabsf(z)));
            const float w = valid ? expf(z - sp + tail) : 0.f;
#pragma unroll
            for (int d = 0; d < 64; ++d) acc[d] += w * vs[s][d];
            if (valid) tail -= sp;
        }
        if (__all(tail < -120.f)) break;
    }
#pragma unroll
    for (int d = 0; d < 64; d += 8) st8(Y + (size_t)(b * NL + t) * ND + 256 + h * 64 + d, acc + d);
}

__device__ __forceinline__ void glu_phase(const float* __restrict__ ya, const float* __restrict__ wglu, const float* __restrict__ bglu, bf16_t* __restrict__ Y, float* lds) {
    const int half = threadIdx.x >> 8, c = threadIdx.x & 255;
    float(*ys)[256] = (float(*)[256])(lds + half * 4096);
    for (int it = blockIdx.x; it < NT / 32; it += gridDim.x) {
        const int t0 = it * 32 + half * 16;
        __syncthreads();
        for (int i = 0; i < 16; ++i) ys[i][c] = ya[(size_t)(t0 + i) * 256 + c];
        __syncthreads();
        float acc[16];
#pragma unroll
        for (int i = 0; i < 16; ++i) acc[i] = 0.f;
        for (int k = 0; k < 256; ++k) {
            const float w = wglu[k * 256 + c];
#pragma unroll
            for (int i = 0; i < 16; ++i) acc[i] += ys[i][k] * w;
        }
        const float bb = bglu[c];
#pragma unroll
        for (int i = 0; i < 16; ++i) Y[(size_t)(t0 + i) * ND + c] = f2bf(ys[i][c] * sigmoidf_(acc[i] + bb));
    }
    __syncthreads();
}

__device__ __forceinline__ void ln_row_wave(float4 (&v)[4], const float* __restrict__ g, const float* __restrict__ bta, float* out, bf16_t* outb, int lane) {
    float s = 0.f;
#pragma unroll
    for (int j = 0; j < 4; ++j) s += v[j].x + v[j].y + v[j].z + v[j].w;
    for (int o = 32; o; o >>= 1) s += __shfl_xor(s, o);
    const float mean = s * (1.f / ND);
    float s2 = 0.f;
#pragma unroll
    for (int j = 0; j < 4; ++j) {
        v[j].x -= mean; v[j].y -= mean; v[j].z -= mean; v[j].w -= mean;
        s2 += v[j].x * v[j].x + v[j].y * v[j].y + v[j].z * v[j].z + v[j].w * v[j].w;
    }
    for (int o = 32; o; o >>= 1) s2 += __shfl_xor(s2, o);
    const float rs = rsqrtf(s2 * (1.f / ND) + LN_EPS);
#pragma unroll
    for (int j = 0; j < 4; ++j) {
        const float4 gg = *(const float4*)(g + j * 256 + lane * 4), bb = *(const float4*)(bta + j * 256 + lane * 4);
        const float4 o = make_float4(v[j].x * rs * gg.x + bb.x, v[j].y * rs * gg.y + bb.y, v[j].z * rs * gg.z + bb.z, v[j].w * rs * gg.w + bb.w);
        *(float4*)(out + j * 256 + lane * 4) = o;
        if (outb) { uint2 w; w.x = pack2(o.x, o.y); w.y = pack2(o.z, o.w); *(uint2*)(outb + j * 256 + lane * 4) = w; }
    }
}
__device__ __forceinline__ void ln_phase(float* R, bf16_t* Hb, const float* __restrict__ g, const float* __restrict__ bta) {
    const int wave = threadIdx.x >> 6, lane = threadIdx.x & 63;
    for (int row = blockIdx.x * 8 + wave; row < NT; row += gridDim.x * 8) {
        float4 v[4];
#pragma unroll
        for (int j = 0; j < 4; ++j) v[j] = *(const float4*)(R + (size_t)row * ND + j * 256 + lane * 4);
        ln_row_wave(v, g, bta, R + (size_t)row * ND, Hb + (size_t)row * ND, lane);
    }
}

__device__ __forceinline__ void wave_argmax(float& bv, int& bi) {
#pragma unroll
    for (int o = 32; o; o >>= 1) {
        const float ov = __shfl_xor(bv, o); const int oi = __shfl_xor(bi, o);
        if (ov > bv || (ov == bv && oi < bi)) { bv = ov; bi = oi; }
    }
}
__device__ __forceinline__ void peer_route_phase(const bf16_t* __restrict__ qbuf, const float* __restrict__ subk, int* __restrict__ eidx, float* __restrict__ egate, float* lds) {
    const int head = threadIdx.x >> 6, lane = threadIdx.x & 63;
    float* qs = lds + head * 256;
    for (int token = blockIdx.x; token < NT; token += gridDim.x) {
        const bf16_t* qp = qbuf + (size_t)token * 2048 + head * 256;
        wave_lds_fence();
        for (int i = 0; i < 4; ++i) qs[lane + 64 * i] = bf2f(qp[lane + 64 * i]);
        wave_lds_fence();
        float myv[2]; int myi[2];
#pragma unroll
        for (int c = 0; c < 2; ++c) {
            float sc[2];
#pragma unroll
            for (int w2 = 0; w2 < 2; ++w2) {
                const float* kr = subk + ((size_t)(head * 2 + c) * 128 + lane + 64 * w2) * 128;
                float a = 0.f;
#pragma unroll 4
                for (int d = 0; d < 128; d += 4) {
                    const float4 kv = *(const float4*)(kr + d);
                    a += qs[c * 128 + d] * kv.x + qs[c * 128 + d + 1] * kv.y + qs[c * 128 + d + 2] * kv.z + qs[c * 128 + d + 3] * kv.w;
                }
                sc[w2] = a;
            }
            float a0 = sc[0], a1 = sc[1];
            float mv = -INFINITY; int mi = 0;
            for (int r = 0; r < 16; ++r) {
                float bv; int bi;
                if (a0 >= a1) { bv = a0; bi = lane; } else { bv = a1; bi = lane + 64; }
                wave_argmax(bv, bi);
                if (lane == r) { mv = bv; mi = bi; }
                if (bi == lane) a0 = -INFINITY; else if (bi == lane + 64) a1 = -INFINITY;
            }
            myv[c] = mv; myi[c] = mi;
        }
        const float va = __shfl(myv[0], lane >> 2);
        float cand[4];
#pragma unroll
        for (int j = 0; j < 4; ++j) cand[j] = va + __shfl(myv[1], (lane & 3) * 4 + j);
        float topv = -INFINITY; int topf = 0;
        for (int r = 0; r < 16; ++r) {
            float bv = cand[0]; int bi = lane * 4;
#pragma unroll
            for (int j = 1; j < 4; ++j) if (cand[j] > bv) { bv = cand[j]; bi = lane * 4 + j; }
            wave_argmax(bv, bi);
            if (lane == r) { topv = bv; topf = bi; }
#pragma unroll
            for (int j = 0; j < 4; ++j) if (bi == lane * 4 + j) cand[j] = -INFINITY;
        }
        const int e1 = __shfl(myi[0], topf >> 4), e2 = __shfl(myi[1], topf & 15);
        const float top0 = __shfl(topv, 0);
        float ex = (lane < 16) ? expf(topv - top0) : 0.f;
        float sum = ex;
        for (int o = 32; o; o >>= 1) sum += __shfl_xor(sum, o);
        if (lane < 16) {
            eidx[(size_t)token * 128 + head * 16 + lane] = e1 * 128 + e2;
            egate[(size_t)token * 128 + head * 16 + lane] = ex / sum;
        }
    }
}

__device__ __forceinline__ void peer_expert_phase(float* R, const int* __restrict__ eidx, const float* __restrict__ egate, const float* __restrict__ utab,
                                  const float* __restrict__ vtab, const float* __restrict__ lg, const float* __restrict__ lb, bf16_t* Hb) {
    const int wave = threadIdx.x >> 6, lane = threadIdx.x & 63;
    for (int token = blockIdx.x * 8 + wave; token < NT; token += gridDim.x * 8) {
        float4 x[4], acc[4];
#pragma unroll
        for (int j = 0; j < 4; ++j) { x[j] = *(const float4*)(R + (size_t)token * ND + j * 256 + lane * 4); acc[j] = make_float4(0.f, 0.f, 0.f, 0.f); }
        for (int e0 = 0; e0 < 128; e0 += 4) {
            float dot[4]; int ex[4]; float gt[4];
#pragma unroll
            for (int k = 0; k < 4; ++k) {
                ex[k] = eidx[(size_t)token * 128 + e0 + k]; gt[k] = egate[(size_t)token * 128 + e0 + k];
                const float* ur = utab + (size_t)ex[k] * ND + lane * 4;
                float a = 0.f;
#pragma unroll
                for (int j = 0; j < 4; ++j) { const float4 u = *(const float4*)(ur + j * 256); a += x[j].x * u.x + x[j].y * u.y + x[j].z * u.z + x[j].w * u.w; }
                dot[k] = a;
            }
#pragma unroll
            for (int k = 0; k < 4; ++k) {
                float a = dot[k];
                for (int o = 32; o; o >>= 1) a += __shfl_xor(a, o);
                const float coef = gt[k] * gelu_tanh(a);
                const float* vr = vtab + (size_t)ex[k] * ND + lane * 4;
#pragma unroll
                for (int j = 0; j < 4; ++j) { const float4 v = *(const float4*)(vr + j * 256); acc[j].x += coef * v.x; acc[j].y += coef * v.y; acc[j].z += coef * v.z; acc[j].w += coef * v.w; }
            }
        }
#pragma unroll
        for (int j = 0; j < 4; ++j) { x[j].x = ALPHA * x[j].x + acc[j].x; x[j].y = ALPHA * x[j].y + acc[j].y; x[j].z = ALPHA * x[j].z + acc[j].z; x[j].w = ALPHA * x[j].w + acc[j].w; }
        ln_row_wave(x, lg, lb, R + (size_t)token * ND, Hb ? Hb + (size_t)token * ND : nullptr, lane);
    }
}

__device__ __forceinline__ void nsa_compress_phase(const bf16_t* __restrict__ proj, int coloff, const float* __restrict__ pe, const float* __restrict__ w1,
                                   const float* __restrict__ w2, float* __restrict__ outc, float* lds) {
    const int qtr = threadIdx.x >> 7, tid = threadIdx.x & 127;
    float* in = lds + qtr * 2176;
    float* hid = in + 2048;
    for (int it = blockIdx.x; it < NB * 127; it += gridDim.x) {
        const int g = qtr, n = it % 127, b = it / 127;
        __syncthreads();
        for (int idx = tid; idx < 2048; idx += 128) {
            const int l = idx >> 6, d = idx & 63;
            in[idx] = bf2f(proj[(size_t)(b * NL + 16 * n + l) * ODD_PAD + coloff + g * 64 + d]) + pe[l * 64 + d];
        }
        __syncthreads();
        float a = 0.f;
        for (int i = 0; i < 2048; ++i) a += in[i] * w1[(size_t)i * 128 + tid];
        hid[tid] = gelu_tanh(a);
        __syncthreads();
        if (tid < 64) {
            float o = 0.f;
            for (int j = 0; j < 128; ++j) o += hid[j] * w2[j * 64 + tid];
            outc[((size_t)(b * 127 + n) * 4 + g) * 64 + tid] = o;
        }
    }
    __syncthreads();
}

__device__ __forceinline__ void nsa_cmp_phase(const bf16_t* __restrict__ proj, const float* __restrict__ kcmp, const float* __restrict__ vcmp,
                              float* __restrict__ O, unsigned* __restrict__ selmask, float* lds) {
    const int half = threadIdx.x >> 8, tid = threadIdx.x & 255;
    float* kc_s = lds + half * 18368;
    float* vc_s = kc_s + 127 * 64;
    float(*imp_s)[33] = (float(*)[33])(vc_s + 127 * 64);
    const int tk = tid >> 2, r = tid & 3;
    for (int it = blockIdx.x; it < 32 * 4 * NB / 2; it += gridDim.x) {
        const int vb = it * 2 + half;
        const int tile = vb & 31, g = (vb >> 5) & 3, b = vb >> 7;
        const int t = tile * 64 + tk, hd = g * 4 + r;
        __syncthreads();
        for (int idx = tid; idx < 127 * 64; idx += 256) { const int n = idx >> 6, d = idx & 63; kc_s[idx] = kcmp[((size_t)(b * 127 + n) * 4 + g) * 64 + d]; vc_s[idx] = vcmp[((size_t)(b * 127 + n) * 4 + g) * 64 + d]; }
        const bf16_t* prow = proj + (size_t)(b * NL + t) * ODD_PAD;
        float q[64];
#pragma unroll
        for (int d = 0; d < 64; d += 8) ld8(prow + hd * 64 + d, q + d);
        const float slope = exp2f(-0.5f * (float)(hd + 1));
        int nvalid = (t >= 31) ? ((t - 31) / 16 + 1) : 0;
        if (nvalid > 127) nvalid = 127;
        __syncthreads();
        float m = -INFINITY, l = 0.f;
        for (int n = 0; n < nvalid; ++n) {
            float s = 0.f;
#pragma unroll
            for (int d = 0; d < 64; ++d) s += q[d] * kc_s[n * 64 + d];
            s = s * 0.125f - slope * (float)(t - (16 * n + 31));
            const float mn = fmaxf(m, s);
            l = l * expf(m - mn) + expf(s - mn);
            m = mn;
        }
        const float inv_l = (nvalid > 0) ? 1.f / fmaxf(l, 1e-30f) : 0.f;
        float acc[64];
#pragma unroll
        for (int d = 0; d < 64; ++d) acc[d] = 0.f;
        float prev3 = 0.f;
        for (int j = 0; j < 32; ++j) {
            float pj[4];
#pragma unroll
            for (int nn = 0; nn < 4; ++nn) {
                const int n = 4 * j + nn;
                float p = 0.f;
                if (n < nvalid) {
                    float s = 0.f;
#pragma unroll
                    for (int d = 0; d < 64; ++d) s += q[d] * kc_s[n * 64 + d];
                    s = s * 0.125f - slope * (float)(t - (16 * n + 31));
                    p = expf(s - m) * inv_l;
                    const float* vr = vc_s + n * 64;
#pragma unroll
                    for (int d = 0; d < 64; ++d) acc[d] += p * vr[d];
                }
                pj[nn] = p;
            }
            float im = 0.5f * prev3 + pj[0] + pj[1] + pj[2] + 0.5f * pj[3];
            prev3 = pj[3];
            im += __shfl_xor(im, 1);
            im += __shfl_xor(im, 2);
            if (r == 0) imp_s[tk][j] = im;
        }
        const float g0 = sigmoidf_(bf2f(prow[2560 + hd]));
#pragma unroll
        for (int d = 0; d < 64; d += 4)
            *(float4*)(O + (size_t)(b * NL + t) * ND + hd * 64 + d) = make_float4(g0 * acc[d], g0 * acc[d + 1], g0 * acc[d + 2], g0 * acc[d + 3]);
        __syncthreads();
        const int cur = tile;
        unsigned bits = 0;
        for (int jj = 0; jj < 8; ++jj) {
            const int j = r * 8 + jj;
            const bool fj = (j == 0) || (j == cur) || (j == cur - 1);
            const float vj = (j <= cur) ? imp_s[tk][j] + (fj ? 1000.f : 0.f) : -INFINITY;
            int rank = 0;
            for (int k = 0; k < 32; ++k) {
                const bool fk = (k == 0) || (k == cur) || (k == cur - 1);
                const float vk = (k <= cur) ? imp_s[tk][k] + (fk ? 1000.f : 0.f) : -INFINITY;
                rank += (vk > vj || (vk == vj && k < j)) ? 1 : 0;
            }
            if (rank < 16) bits |= 1u << j;
        }
        bits |= __shfl_xor(bits, 1);
        bits |= __shfl_xor(bits, 2);
        if (r == 0) selmask[(size_t)(b * 4 + g) * NL + t] = bits;
    }
    __syncthreads();
}

__device__ __forceinline__ void nsa_selwin_phase(const bf16_t* __restrict__ proj, const unsigned* __restrict__ selmask, float* O, bf16_t* __restrict__ Ob, float* lds) {
    const int half = threadIdx.x >> 8, tid = threadIdx.x & 255;
    float(*k_s)[64] = (float(*)[64])(lds + half * 8192);
    float(*v_s)[64] = (float(*)[64])(lds + half * 8192 + 4096);
    const int tk = tid >> 2, r = tid & 3;
    for (int it = blockIdx.x; it < 32 * 32; it += gridDim.x) {
        const int tile = 31 - (it >> 5);
        const int bgi = (it & 31) * 2 + half, g = bgi & 3, b = bgi >> 2;
        const int t = tile * 64 + tk, hd = g * 4 + r;
        const bf16_t* pb = proj + (size_t)b * NL * ODD_PAD;
        const bf16_t* prow = pb + (size_t)t * ODD_PAD;
        float q[64], acc[64];
#pragma unroll
        for (int d = 0; d < 64; d += 8) ld8(prow + hd * 64 + d, q + d);
        const float slope = exp2f(-0.5f * (float)(hd + 1));
        const unsigned mask = selmask[(size_t)(b * 4 + g) * NL + t];
        float* orow = O + (size_t)(b * NL + t) * ND + hd * 64;
        for (int branch = 0; branch < 2; ++branch) {
            const int kcol = (branch == 0 ? 1536 : 2048) + g * 64, vcol = kcol + 256;
            const int j0 = (branch == 0) ? 0 : (tile >= 8 ? tile - 8 : 0);
            float m = -1e30f, l = 0.f;
#pragma unroll
            for (int d = 0; d < 64; ++d) acc[d] = 0.f;
            for (int j = j0; j <= tile; ++j) {
                __syncthreads();
                for (int i = 0; i < 16; ++i) {
                    const int idx = tid + 256 * i, key = idx >> 6, d = idx & 63;
                    k_s[key][d] = bf2f(pb[(size_t)(64 * j + key) * ODD_PAD + kcol + d]);
                    v_s[key][d] = bf2f(pb[(size_t)(64 * j + key) * ODD_PAD + vcol + d]);
                }
                __syncthreads();
                const bool take = (branch == 0) ? ((mask >> j) & 1u) : true;
                if (take) {
                    for (int s = 0; s < 64; ++s) {
                        const int dist = t - (64 * j + s);
                        const bool valid = (branch == 0) ? (dist >= 0) : (dist >= 0 && dist < 512);
                        float sc = 0.f;
#pragma unroll
                        for (int d = 0; d < 64; ++d) sc += q[d] * k_s[s][d];
                        sc = sc * 0.125f - slope * (float)dist;
                        const float mn = valid ? fmaxf(m, sc) : m;
                        const float scale = expf(m - mn);
                        const float p = valid ? expf(sc - mn) : 0.f;
                        l = l * scale + p;
#pragma unroll
                        for (int d = 0; d < 64; ++d) acc[d] = acc[d] * scale + p * v_s[s][d];
                        m = mn;
                    }
                }
            }
            const float gt = sigmoidf_(bf2f(prow[2560 + (branch + 1) * 16 + hd]));
            const float f = gt / fmaxf(l, 1e-30f);
#pragma unroll
            for (int d = 0; d < 64; d += 4) {
                float4 o = *(const float4*)(orow + d);
                o.x += f * acc[d]; o.y += f * acc[d + 1]; o.z += f * acc[d + 2]; o.w += f * acc[d + 3];
                if (branch == 0) *(float4*)(orow + d) = o;
                else { uint2 w; w.x = pack2(o.x, o.y); w.y = pack2(o.z, o.w); *(uint2*)(Ob + (size_t)(b * NL + t) * ND + hd * 64 + d) = w; }
            }
        }
    }
    __syncthreads();
}

struct Params {
    const float* in[29];
    float* out;
    char* ws;
    unsigned long long pad;
};

constexpr size_t SZ_PROJ = (size_t)NT * ODD_PAD * 2;
constexpr size_t SZ_YF = (size_t)NT * ND * 4;
constexpr size_t SZ_YB = (size_t)NT * ND * 2;
constexpr size_t SZ_HB = (size_t)NT * ND * 2;
constexpr size_t SZ_YA = (size_t)NT * 256 * 4;
constexpr size_t SZ_CMP = (size_t)NB * 127 * 4 * 64 * 4;
constexpr size_t SZ_SEL = (size_t)NB * 4 * NL * 4;
constexpr size_t OFF_YF = SZ_PROJ, OFF_YB = OFF_YF + SZ_YF, OFF_HB = OFF_YB + SZ_YB, OFF_YA = OFF_HB + SZ_HB, OFF_KC = OFF_YA + SZ_YA, OFF_VC = OFF_KC + SZ_CMP,
                 OFF_SEL = OFF_VC + SZ_CMP, OFF_WT = OFF_SEL + SZ_SEL;
constexpr size_t WT_IN0 = 0, WT_OUT0 = WT_IN0 + (size_t)EVEN_IN * ND * 2, WT_Q0 = WT_OUT0 + (size_t)ND * ND * 2, WT_Q1 = WT_Q0 + (size_t)2048 * ND * 2,
                 WT_IN1 = WT_Q1 + (size_t)2048 * ND * 2, WT_OUT1 = WT_IN1 + (size_t)ODD_PAD * ND * 2, WT_END = WT_OUT1 + (size_t)ND * ND * 2;
constexpr size_t WS_NEED = OFF_WT + WT_END;

__global__ void __launch_bounds__(NTHR) fwd_megakernel(Params p) {
    extern __shared__ __attribute__((aligned(16))) unsigned char lds_raw[];
    float* lds = (float*)lds_raw;
    cg::grid_group grid = cg::this_grid();
    const float* x = p.in[0];
    float* R = p.out;
    char* ws = p.ws;
    bf16_t* PROJ = (bf16_t*)ws;
    float* YF = (float*)(ws + OFF_YF);
    bf16_t* YB = (bf16_t*)(ws + OFF_YB);
    bf16_t* HB = (bf16_t*)(ws + OFF_HB);
    float* YA = (float*)(ws + OFF_YA);
    float* KCMP = (float*)(ws + OFF_KC);
    float* VCMP = (float*)(ws + OFF_VC);
    unsigned* SEL = (unsigned*)(ws + OFF_SEL);
    bf16_t* WIN0 = (bf16_t*)(ws + OFF_WT + WT_IN0);
    bf16_t* WOUT0 = (bf16_t*)(ws + OFF_WT + WT_OUT0);
    bf16_t* WQ0 = (bf16_t*)(ws + OFF_WT + WT_Q0);
    bf16_t* WQ1 = (bf16_t*)(ws + OFF_WT + WT_Q1);
    bf16_t* WIN1 = (bf16_t*)(ws + OFF_WT + WT_IN1);
    bf16_t* WOUT1 = (bf16_t*)(ws + OFF_WT + WT_OUT1);
    int* EIDX = (int*)YF;
    float* EGATE = (float*)((char*)YF + (size_t)NT * 128 * 4);
    const int wave = threadIdx.x >> 6;

    for (size_t i = (size_t)blockIdx.x * NTHR + threadIdx.x; i < (size_t)NT * ND / 4; i += (size_t)gridDim.x * NTHR) {
        const float4 v = ((const float4*)x)[i];
        ((float4*)R)[i] = v;
        uint2 w; w.x = pack2(v.x, v.y); w.y = pack2(v.z, v.w);
        ((uint2*)HB)[i] = w;
    }
    convert_wt_phase(p.in[1], ND, EVEN_IN, EVEN_IN, WIN0, lds);
    convert_wt_phase(p.in[12], ND, ND, ND, WOUT0, lds);
    convert_wt_phase(p.in[21], ND, 2048, 2048, WQ0, lds);
    convert_wt_phase(p.in[21] + (size_t)ND * 2048, ND, 2048, 2048, WQ1, lds);
    convert_wt_phase(p.in[13], ND, ODD_IN, ODD_PAD, WIN1, lds);
    convert_wt_phase(p.in[20], ND, ND, ND, WOUT1, lds);
    grid.sync();
    PH(0) gemm_bf16_phase(lds_raw, HB, WIN0, NT, EVEN_IN, ND, EpiBf16s{PROJ, EVEN_IN});
    grid.sync();
    PH(1) if (wave == 0) {
        for (int bg = blockIdx.x; bg < NB * 16; bg += gridDim.x)
            s5_scan_wave(bg, PROJ, p.in[2], p.in[3], p.in[4], p.in[5], p.in[6], p.in[7], p.in[8], p.in[9], YA, lds);
    } else PH(2) {
        for (int task = blockIdx.x * 7 + (wave - 1); task < NB * 12 * 32; task += gridDim.x * 7)
            sb_attn_wave(task, PROJ, YB, lds + 11392 + (wave - 1) * 4096);
    }
    grid.sync();
    PH(3) glu_phase(YA, p.in[10], p.in[11], YB, lds);
    grid.sync();
    PH(4) gemm_bf16_phase(lds_raw, YB, WOUT0, NT, ND, ND, EpiRes{R, ND, ALPHA});
    grid.sync();
    PH(5) ln_phase(R, HB, p.in[25], p.in[26]);
    grid.sync();
#define PEER_FFN(layer, WQ, last) \
    PH(12) gemm_bf16_phase(lds_raw, HB, WQ, NT, 2048, ND, EpiBf16s{PROJ, 2048}); \
    grid.sync(); \
    PH(13) peer_route_phase(PROJ, p.in[22] + (size_t)(layer) * 8 * 2 * 128 * 128, EIDX, EGATE, lds); \
    grid.sync(); \
    PH(14) peer_expert_phase(R, EIDX, EGATE, p.in[23] + (size_t)(layer) * 16384 * ND, p.in[24] + (size_t)(layer) * 16384 * ND, p.in[27] + (layer) * ND, p.in[28] + (layer) * ND, (last) ? nullptr : HB); \
    if (!(last)) grid.sync();
    PEER_FFN(0, WQ0, false)
    PH(6) gemm_bf16_phase(lds_raw, HB, WIN1, NT, ODD_PAD, ND, EpiBf16s{PROJ, ODD_PAD});
    grid.sync();
    PH(7) nsa_compress_phase(PROJ, 1024, p.in[14], p.in[15], p.in[16], KCMP, lds);
    PH(7) nsa_compress_phase(PROJ, 1280, p.in[17], p.in[18], p.in[19], VCMP, lds);
    grid.sync();
    PH(8) nsa_cmp_phase(PROJ, KCMP, VCMP, YF, SEL, lds);
    grid.sync();
    PH(9) nsa_selwin_phase(PROJ, SEL, YF, YB, lds);
    grid.sync();
    PH(10) gemm_bf16_phase(lds_raw, YB, WOUT1, NT, ND, ND, EpiRes{R, ND, ALPHA});
    grid.sync();
    PH(11) ln_phase(R, HB, p.in[25] + ND, p.in[26] + ND);
    grid.sync();
    PEER_FFN(1, WQ1, true)
}

}

extern "C" void kernel_launch(void* const* d_in, const int* in_sizes, int n_in, void* d_out, int out_size, void* d_ws, size_t ws_size, hipStream_t stream) {
    static int grid_blocks = 0;
    if (grid_blocks == 0) {
        if (n_in != 29 || out_size != NT * ND || ws_size < WS_NEED) { fprintf(stderr, "kernel_launch: unexpected shapes / workspace (%zu < %zu)\n", ws_size, (size_t)WS_NEED); grid_blocks = -1; return; }
        int dev = 0, cus = 0, per_cu = 0;
        hipGetDevice(&dev);
        hipDeviceGetAttribute(&cus, hipDeviceAttributeMultiprocessorCount, dev);
        hipFuncSetAttribute((const void*)fwd_megakernel, hipFuncAttributeMaxDynamicSharedMemorySize, LDS_BYTES);
        hipOccupancyMaxActiveBlocksPerMultiprocessor(&per_cu, (const void*)fwd_megakernel, NTHR, LDS_BYTES);
        if (per_cu < 1) { fprintf(stderr, "kernel_launch: occupancy query says %d blocks/CU\n", per_cu); grid_blocks = -1; return; }
        grid_blocks = cus;
    }
    if (grid_blocks < 0) return;
    Params p{};
    for (int i = 0; i < 29; ++i) p.in[i] = (const float*)d_in[i];
    p.out = (float*)d_out; p.ws = (char*)d_ws; p.pad = 0;
    void* args[] = {&p};
    hipError_t e = hipLaunchCooperativeKernel((const void*)fwd_megakernel, dim3(grid_blocks), dim3(NTHR), args, LDS_BYTES, stream);
    if (e != hipSuccess) fprintf(stderr, "cooperative launch failed: %s (grid %d)\n", hipGetErrorString(e), grid_blocks);
}
```

```cpp
#include <hip/hip_runtime.h>
#include <hip/hip_cooperative_groups.h>
#include <math.h>
#include <stdint.h>
#include <cstdio>
namespace cg = cooperative_groups;

__device__ __forceinline__ int tidx() { int t = threadIdx.x; asm volatile("" : "+v"(t)); return t; }
namespace pg8 {
#define PG8_LAS __attribute__((address_space(3)))
typedef unsigned short bf16_t;
typedef short bf16x8 __attribute__((ext_vector_type(8)));
typedef float f32x4 __attribute__((ext_vector_type(4)));
typedef unsigned u32x4 __attribute__((ext_vector_type(4)));
constexpr int BM = 256, BK = 64, HALF = 128, HTB = HALF * BK * 2  , STAGE_BYTES = 8 * HTB, NXCD = 8, WGM = 8;

__host__ __device__ __forceinline__ int lds_byte(int r, int c) { const int st = (r >> 4) * 2 + (c >> 5), rr = r & 15, cc = c & 31, ob = rr * 64 + cc * 2; return st * 1024 + (ob ^ (((ob >> 9) & 1) << 5)); }
__host__ __device__ __forceinline__ void stage_rc(int b, int& R, int& C) { const int st = b / 1024, sb = b % 1024, swz = sb ^ (((sb >> 9) & 1) << 5); R = (st >> 1) * 16 + swz / 64; C = (st & 1) * 32 + (swz % 64) / 2; }
__host__ __device__ __forceinline__ int perm32(int rho) { const int n = rho >> 4, i = rho & 15; return 8 * (i >> 2) + 4 * n + (i & 3); }

struct Unit { int pm, pn; };
struct Gemm { const bf16_t* A; const bf16_t* Bt; int M, N, K; };

struct StaticOrder {
    int nM, nN, nwg, G, c;
    __host__ __device__ void init(int M, int N, int G_, int c_) { nM = M / BM; nN = N / BM; nwg = nM * nN; G = G_; c = c_; }
    __host__ __device__ bool next(int i, Unit& u) const {
        const long L = (long)i * G + c; if (L >= nwg) return false;
        int wgid = (int)L; { const int q = nwg / NXCD, r = nwg % NXCD, xcd = wgid % NXCD, off = wgid / NXCD; wgid = (xcd < r ? xcd * (q + 1) : r * (q + 1) + (xcd - r) * q) + off; }
        const int nig = WGM * nN, gid = wgid / nig, fm = gid * WGM, gsz = (nM - fm) < WGM ? (nM - fm) : WGM;
        u.pm = fm + ((wgid % nig) % gsz); u.pn = (wgid % nig) / gsz; return true;
    }
    __device__ __forceinline__ void a_ready(const Unit&) const {}
    __device__ __forceinline__ void done(const Unit&) const {}
};
__device__ __forceinline__ unsigned cvt_pk_bf16(float lo, float hi) { unsigned r; asm volatile("v_cvt_pk_bf16_f32 %0, %1, %2" : "=v"(r) : "v"(lo), "v"(hi)); return r; }
template <class Epi, class Sched, bool STAMP = false>
__device__ __forceinline__ void gemm_phase(PG8_LAS unsigned char* lds, const Gemm g, const Sched& S, const Epi& E, unsigned long long* stamps) {
    const int tid = tidx(), wid = __builtin_amdgcn_readfirstlane(tid >> 6), lane = tid & 63, wr = wid >> 2, wc = wid & 3, fr = lane & 15, fq = lane >> 4;
    const int K = g.K, nt = K / BK;
    int ts_lo = 0, ts_hi = 0, nts = 0; const unsigned long long rt_entry = STAMP ? (unsigned long long)wall_clock64() : 0ull;
#define PG8_STAMP() do { if (STAMP && wid == 0 && nts < 64) { const unsigned long long _c = (unsigned long long)clock64(); \
        ts_lo = (lane == nts) ? (int)(unsigned)_c : ts_lo; ts_hi = (lane == nts) ? (int)(unsigned)(_c >> 32) : ts_hi; ++nts; } } while (0)
    PG8_STAMP();
    unsigned voffA[2], voffB[2];
#pragma unroll
    for (int i = 0; i < 2; ++i) { int R, C; stage_rc(tid * 16 + i * 8192, R, C); const int Rb = Epi::PERM ? ((R & ~31) + perm32(R & 31)) : R;
        voffA[i] = (unsigned)(R * K + C) * 2u; voffB[i] = (unsigned)(Rb * K + C) * 2u; }
    const size_t kstep = (size_t)(BK * 2);
    const size_t hstep = (size_t)HALF * K * 2;
    const size_t tstep = 2 * hstep;
    const unsigned ldsw = (unsigned)wid * 1024u;
    const int aoff = lds_byte(wr * 64 + fr, fq * 8), boff = lds_byte(wc * 32 + fr, fq * 8);
#define PG8_SA(b, h) (((b) * 2 + (h)) * HTB)
#define PG8_SB(b, h) ((4 + (b) * 2 + (h)) * HTB)
#define PG8_STAGE(bufoff, gbase, voff) do { _Pragma("unroll") for (int _i = 0; _i < 2; ++_i) \
        __builtin_amdgcn_global_load_lds((const unsigned*)((const char*)(gbase) + (voff)[_i]), (PG8_LAS unsigned*)(lds + (bufoff) + ldsw + _i * 8192), 16, 0, 0); } while (0)
#define PG8_LDA(dst, b, h) do { _Pragma("unroll") for (int m = 0; m < 4; ++m) _Pragma("unroll") for (int k = 0; k < 2; ++k) dst[m][k] = *(const PG8_LAS bf16x8*)(lds + PG8_SA(b, h) + aoff + m * 2048 + k * 1024); } while (0)
#define PG8_LDB(dst, b, h) do { _Pragma("unroll") for (int n = 0; n < 2; ++n) _Pragma("unroll") for (int k = 0; k < 2; ++k) dst[n][k] = *(const PG8_LAS bf16x8*)(lds + PG8_SB(b, h) + boff + n * 2048 + k * 1024); } while (0)
#define PG8_MMA(ai, bj, At, Bt) do { __builtin_amdgcn_s_setprio(1); _Pragma("unroll") for (int m = 0; m < 4; ++m) _Pragma("unroll") for (int n = 0; n < 2; ++n) _Pragma("unroll") for (int k = 0; k < 2; ++k) \
        acc[ai][bj][m][n] = __builtin_amdgcn_mfma_f32_16x16x32_bf16(Bt[n][k], At[m][k], acc[ai][bj][m][n], 0, 0, 0); __builtin_amdgcn_s_setprio(0); } while (0)
#define PG8_WAIT_V(n) asm volatile("s_waitcnt vmcnt(" #n ")" ::: "memory")
#define PG8_WAIT_L(n) asm volatile("s_waitcnt lgkmcnt(" #n ")" ::: "memory")
#define PG8_BAR __builtin_amdgcn_s_barrier()
#define PG8_SCHED __builtin_amdgcn_sched_barrier(0)
    Unit cur, nxt; int ui = 0;
    if (!S.next(0, cur)) return;
    f32x4 acc[2][2][4][2];
#pragma unroll
    for (int a = 0; a < 2; ++a)
#pragma unroll
        for (int b = 0; b < 2; ++b)
#pragma unroll
            for (int m = 0; m < 4; ++m)
#pragma unroll
                for (int n = 0; n < 2; ++n) acc[a][b][m][n] = (f32x4){0.f, 0.f, 0.f, 0.f};
    bf16x8 At[4][2], B0[2][2], B1[2][2];
    const char* cA = (const char*)g.A + (size_t)cur.pm * tstep; const char* cB = (const char*)g.Bt + (size_t)cur.pn * tstep;
    S.a_ready(cur);
    PG8_STAGE(PG8_SB(0, 0), cB, voffB); PG8_STAGE(PG8_SA(0, 0), cA, voffA); PG8_STAGE(PG8_SB(0, 1), cB + hstep, voffB); PG8_STAGE(PG8_SA(0, 1), cA + hstep, voffA);
    if (wr == 1) PG8_BAR;
    PG8_WAIT_V(4); PG8_BAR;
    PG8_STAGE(PG8_SB(1, 0), cB + kstep, voffB); PG8_STAGE(PG8_SA(1, 0), cA + kstep, voffA); PG8_STAGE(PG8_SB(1, 1), cB + hstep + kstep, voffB);
    PG8_WAIT_V(6); PG8_BAR;
    PG8_STAMP();
    for (;;) {
        const bool has_next = S.next(ui + 1, nxt);
        const char* nA = has_next ? (const char*)g.A + (size_t)nxt.pm * tstep : cA; const char* nB = has_next ? (const char*)g.Bt + (size_t)nxt.pn * tstep : cB;
        for (int t = 0; t < nt; t += 2) {
            const bool last = (t == nt - 2);
            const char* a1 = cA + (size_t)(t + 1) * kstep;
            const char* a2 = last ? nA : cA + (size_t)(t + 2) * kstep; const char* b2 = last ? nB : cB + (size_t)(t + 2) * kstep;
            const char* a3 = a2 + kstep; const char* b3 = b2 + kstep;
            if (last && has_next) S.a_ready(nxt);
            PG8_LDB(B0, 0, 0); PG8_SCHED; PG8_LDA(At, 0, 0); PG8_STAGE(PG8_SA(1, 1), a1 + hstep, voffA);
            PG8_WAIT_L(8); PG8_BAR; PG8_WAIT_L(0); PG8_MMA(0, 0, At, B0); PG8_BAR; PG8_SCHED;
            PG8_LDB(B1, 0, 1); PG8_STAGE(PG8_SB(0, 0), b2, voffB);
            PG8_BAR; PG8_WAIT_L(0); PG8_MMA(0, 1, At, B1); PG8_BAR;
            PG8_LDA(At, 0, 1); PG8_STAGE(PG8_SA(0, 0), a2, voffA);
            PG8_BAR; PG8_WAIT_L(0); PG8_MMA(1, 0, At, B0); PG8_BAR; PG8_SCHED;
            PG8_STAGE(PG8_SB(0, 1), b2 + hstep, voffB);
            PG8_WAIT_V(6); PG8_BAR; PG8_MMA(1, 1, At, B1); PG8_BAR;
            PG8_LDB(B0, 1, 0); PG8_SCHED; PG8_LDA(At, 1, 0); PG8_STAGE(PG8_SA(0, 1), a2 + hstep, voffA);
            PG8_WAIT_L(8); PG8_BAR; PG8_WAIT_L(0); PG8_MMA(0, 0, At, B0); PG8_BAR; PG8_SCHED;
            PG8_LDB(B1, 1, 1); PG8_STAGE(PG8_SB(1, 0), b3, voffB);
            PG8_BAR; PG8_WAIT_L(0); PG8_MMA(0, 1, At, B1); PG8_BAR;
            PG8_LDA(At, 1, 1); PG8_STAGE(PG8_SA(1, 0), a3, voffA);
            PG8_BAR; PG8_WAIT_L(0); PG8_MMA(1, 0, At, B0); PG8_BAR; PG8_SCHED;
            PG8_STAGE(PG8_SB(1, 1), b3 + hstep, voffB);
            PG8_WAIT_V(6); PG8_BAR; PG8_MMA(1, 1, At, B1); PG8_BAR;
        }
        PG8_STAMP();
        if constexpr (!Epi::AFTER_DRAIN) { E(acc, cur, wr, wc, fr, fq); S.done(cur); }
        PG8_STAMP();
        if (!has_next) break;
#pragma unroll
        for (int a = 0; a < 2; ++a)
#pragma unroll
            for (int b = 0; b < 2; ++b)
#pragma unroll
                for (int m = 0; m < 4; ++m)
#pragma unroll
                    for (int n = 0; n < 2; ++n) acc[a][b][m][n] = (f32x4){0.f, 0.f, 0.f, 0.f};
        cur = nxt; cA = nA; cB = nB; ++ui;
    }
    PG8_WAIT_V(0);
    if (wr == 0) PG8_BAR;
    PG8_BAR;
    if constexpr (Epi::AFTER_DRAIN) { E.fused(acc, cur, wr, wc, fr, fq, lds, wid, lane); S.done(cur); }
    PG8_STAMP();
    if (STAMP && wid == 0) { stamps[lane] = lane < nts ? (((unsigned long long)(unsigned)ts_hi << 32) | (unsigned)ts_lo) : 0ull;
        if (lane == 62) stamps[62] = rt_entry; if (lane == 63) stamps[63] = (unsigned long long)wall_clock64(); }
#undef PG8_STAMP
#undef PG8_SA
#undef PG8_SB
#undef PG8_STAGE
#undef PG8_LDA
#undef PG8_LDB
#undef PG8_MMA
#undef PG8_WAIT_V
#undef PG8_WAIT_L
#undef PG8_BAR
#undef PG8_SCHED
}
}

namespace {
using pg8::bf16_t;
typedef float f32x4 __attribute__((ext_vector_type(4)));
typedef unsigned u32x4 __attribute__((ext_vector_type(4)));

constexpr int NB = 16, NL = 2048, ND = 1024, NT = NB * NL;
constexpr int EVEN_IN = 2560, ODD_IN = 2608, ODD_PAD = 2816;
constexpr float ALPHA = 1.41421356237f;
constexpr float LN_EPS = 1e-5f;
constexpr int NTHR = 512;
constexpr int LDS_BYTES = 163840;
#ifndef PHMASK
#define PHMASK 0xFFFFFFFFu
#endif
#define PH(n) if (PHMASK & (1u << (n)))

__device__ __forceinline__ float bf2f(bf16_t v) { return __uint_as_float((unsigned)v << 16); }
__device__ __forceinline__ bf16_t f2bf(float f) { unsigned u = __float_as_uint(f); u += 0x7FFFu + ((u >> 16) & 1u); return (bf16_t)(u >> 16); }
__device__ __forceinline__ unsigned pack2(float lo, float hi) { return (unsigned)f2bf(lo) | ((unsigned)f2bf(hi) << 16); }
__device__ __forceinline__ void ld8(const bf16_t* p, float* o) {
    const uint4 v = *(const uint4*)p;
    o[0] = __uint_as_float(v.x << 16); o[1] = __uint_as_float(v.x & 0xffff0000u);
    o[2] = __uint_as_float(v.y << 16); o[3] = __uint_as_float(v.y & 0xffff0000u);
    o[4] = __uint_as_float(v.z << 16); o[5] = __uint_as_float(v.z & 0xffff0000u);
    o[6] = __uint_as_float(v.w << 16); o[7] = __uint_as_float(v.w & 0xffff0000u);
}
__device__ __forceinline__ void st8(bf16_t* p, const float* o) {
    uint4 v; v.x = pack2(o[0], o[1]); v.y = pack2(o[2], o[3]); v.z = pack2(o[4], o[5]); v.w = pack2(o[6], o[7]);
    *(uint4*)p = v;
}

struct EpiBf16s {
    static constexpr bool PERM = true, AFTER_DRAIN = false;
    bf16_t* O; int ldc;
    __device__ __forceinline__ void operator()(const f32x4 (&acc)[2][2][4][2], const pg8::Unit& u, int wr, int wc, int fr, int fq) const {
        const int row0 = u.pm * 256 + wr * 64 + fr, col0 = u.pn * 256 + wc * 32 + 8 * fq;
#pragma unroll
        for (int ai = 0; ai < 2; ++ai)
#pragma unroll
            for (int m = 0; m < 4; ++m) { bf16_t* rowp = O + (size_t)(row0 + ai * 128 + m * 16) * ldc + col0;
#pragma unroll
                for (int bj = 0; bj < 2; ++bj) { const f32x4 v0 = acc[ai][bj][m][0], v1 = acc[ai][bj][m][1];
                    u32x4 w; w.x = pg8::cvt_pk_bf16(v0[0], v0[1]); w.y = pg8::cvt_pk_bf16(v0[2], v0[3]); w.z = pg8::cvt_pk_bf16(v1[0], v1[1]); w.w = pg8::cvt_pk_bf16(v1[2], v1[3]);
                    *(u32x4*)(rowp + bj * 128) = w; } }
    }
};
struct EpiRes {
    static constexpr bool PERM = false, AFTER_DRAIN = false;
    float* C; int ldc; float alpha;
    __device__ __forceinline__ void operator()(const f32x4 (&acc)[2][2][4][2], const pg8::Unit& u, int wr, int wc, int fr, int fq) const {
        const int row0 = u.pm * 256 + wr * 64 + fr, col0 = u.pn * 256 + wc * 32 + 4 * fq;
#pragma unroll
        for (int ai = 0; ai < 2; ++ai)
#pragma unroll
            for (int m = 0; m < 4; ++m) { float* rowp = C + (size_t)(row0 + ai * 128 + m * 16) * ldc + col0;
#pragma unroll
                for (int bj = 0; bj < 2; ++bj)
#pragma unroll
                    for (int n = 0; n < 2; ++n) { f32x4* cp = (f32x4*)(rowp + bj * 128 + n * 16); *cp = *cp * alpha + acc[ai][bj][m][n]; } }
    }
};
template <class Epi>
__device__ __forceinline__ void gemm_bf16_phase(unsigned char* lds, const bf16_t* A, const bf16_t* Bt, int M, int N, int K, const Epi& E) {
    pg8::Gemm g{A, Bt, M, N, K};
    pg8::StaticOrder S; S.init(M, N, (int)gridDim.x, (int)blockIdx.x);
    pg8::gemm_phase<Epi, pg8::StaticOrder, false>((PG8_LAS unsigned char*)lds, g, S, E, nullptr);
    __syncthreads();
}

__device__ __forceinline__ void convert_wt_phase(const float* __restrict__ W, int K, int N, int Npad, bf16_t* __restrict__ Wt, float* lds) {
    float(*tile)[65] = (float(*)[65])lds;
    const int tid = tidx(), ntn = Npad / 64, ntiles = (K / 64) * ntn;
    for (int it = blockIdx.x; it < ntiles; it += gridDim.x) {
        const int k0 = (it / ntn) * 64, n0 = (it % ntn) * 64;
        __syncthreads();
#pragma unroll
        for (int h = 0; h < 2; ++h) {
            const int r = (tid >> 4) + h * 32, c4 = (tid & 15) * 4;
            float4 v = make_float4(0.f, 0.f, 0.f, 0.f);
            if (n0 + c4 < N) v = *(const float4*)(W + (size_t)(k0 + r) * N + n0 + c4);
            tile[r][c4] = v.x; tile[r][c4 + 1] = v.y; tile[r][c4 + 2] = v.z; tile[r][c4 + 3] = v.w;
        }
        __syncthreads();
        const int n = tid >> 3, k8 = (tid & 7) * 8;
        float o[8];
#pragma unroll
        for (int j = 0; j < 8; ++j) o[j] = tile[k8 + j][n];
        st8(Wt + (size_t)(n0 + n) * K + k0 + k8, o);
    }
    __syncthreads();
}
__device__ __forceinline__ float gelu_tanh(float x) {
    float u = 0.7978845608028654f * (x + 0.044715f * x * x * x);
    return 0.5f * x * (1.f + tanhf(u));
}
__device__ __forceinline__ float sigmoidf_(float x) { return 1.f / (1.f + expf(-x)); }
__device__ __forceinline__ void wave_lds_fence() { asm volatile("s_waitcnt lgkmcnt(0)" ::: "memory"); }

__device__ __forceinline__ void s5_scan_wave(int bg, const bf16_t* __restrict__ proj, const float* __restrict__ lam_re, const float* __restrict__ lam_im,
                             const float* __restrict__ log_dt, const float* __restrict__ b_re, const float* __restrict__ b_im,
                             const float* __restrict__ c_re, const float* __restrict__ c_im, const float* __restrict__ dskip,
                             float* __restrict__ ya, float* lds) {
    const int b = bg >> 4, g = bg & 15, lane = tidx() & 63;
    float(*us)[16] = (float(*)[16])lds;
    float(*xr)[65] = (float(*)[65])(lds + 1024);
    float(*xi)[65] = (float(*)[65])(lds + 1024 + 4160);
    float(*cr)[64] = (float(*)[64])(lds + 1024 + 8320);
    float(*ci)[64] = (float(*)[64])(lds + 1024 + 8320 + 1024);
    const float lr = lam_re[g * 64 + lane], li = lam_im[g * 64 + lane];
    const float dt = expf(log_dt[g]);
    const float mag = expf(lr * dt);
    const float are = mag * cosf(li * dt), aim = mag * sinf(li * dt);
    const float nr = are - 1.f, den = lr * lr + li * li;
    const float fre = (nr * lr + aim * li) / den, fim = (aim * lr - nr * li) / den;
    float bbr[16], bbi[16];
#pragma unroll
    for (int i = 0; i < 16; ++i) {
        const float br = b_re[(g * 64 + lane) * 16 + i], bi = b_im[(g * 64 + lane) * 16 + i];
        bbr[i] = fre * br - fim * bi; bbi[i] = fre * bi + fim * br;
    }
    for (int idx = lane; idx < 1024; idx += 64) { cr[idx >> 6][idx & 63] = c_re[g * 1024 + idx]; ci[idx >> 6][idx & 63] = c_im[g * 1024 + idx]; }
    float dsk[16];
#pragma unroll
    for (int i = 0; i < 16; ++i) dsk[i] = dskip[g * 16 + i];
    float xre = 0.f, xim = 0.f;
    for (int t0 = 0; t0 < NL; t0 += 64) {
        wave_lds_fence();
        for (int idx = lane; idx < 1024; idx += 64) { const int t = idx >> 4, i = idx & 15; us[t][i] = bf2f(proj[(size_t)(b * NL + t0 + t) * EVEN_IN + g * 16 + i]); }
        wave_lds_fence();
        for (int t = 0; t < 64; ++t) {
            float bur = 0.f, bui = 0.f;
#pragma unroll
            for (int i = 0; i < 16; ++i) { const float u = us[t][i]; bur += bbr[i] * u; bui += bbi[i] * u; }
            const float nre = are * xre - aim * xim + bur, nim = are * xim + aim * xre + bui;
            xre = nre; xim = nim;
            xr[t][lane] = xre; xi[t][lane] = xim;
        }
        wave_lds_fence();
        float y[16];
#pragma unroll
        for (int i = 0; i < 16; ++i) y[i] = 0.f;
        for (int p = 0; p < 64; ++p) {
            const float a = xr[lane][p], bq = xi[lane][p];
#pragma unroll
            for (int i = 0; i < 16; ++i) y[i] += cr[i][p] * a - ci[i][p] * bq;
        }
#pragma unroll
        for (int i = 0; i < 16; ++i) {
            const float v = y[i] + dsk[i] * us[lane][i];
            ya[(size_t)(b * NL + t0 + lane) * 256 + g * 16 + i] = gelu_tanh(v);
        }
    }
}

__device__ __forceinline__ void sb_attn_wave(int task, const bf16_t* __restrict__ proj, bf16_t* __restrict__ Y, float* wl) {
    const int qt = task & 31, h = (task >> 5) % 12, b = task / 384, lane = tidx() & 63;
    const int t = qt * 64 + lane;
    float(*ks)[64] = (float(*)[64])wl;
    float(*vs)[64] = (float(*)[64])(wl + 2048);
    const bf16_t* base = proj + (size_t)b * NL * EVEN_IN;
    float q[64], acc[64];
#pragma unroll
    for (int d = 0; d < 64; d += 8) ld8(base + (size_t)t * EVEN_IN + 256 + h * 64 + d, q + d);
#pragma unroll
    for (int d = 0; d < 64; ++d) acc[d] = 0.f;
    float tail = 0.f;
    for (int c = 2 * qt + 1; c >= 0; --c) {
        wave_lds_fence();
        for (int i = 0; i < 32; ++i) {
            ks[i][lane] = bf2f(base[(size_t)(c * 32 + i) * EVEN_IN + 1024 + h * 64 + lane]);
            vs[i][lane] = bf2f(base[(size_t)(c * 32 + i) * EVEN_IN + 1792 + h * 64 + lane]);
        }
        wave_lds_fence();
        for (int s = 31; s >= 0; --s) {
            const int key = c * 32 + s;
            float z = 0.f;
#pragma unroll
            for (int d = 0; d < 64; ++d) z += q[d] * ks[s][d];
            z *= 0.125f;
            const bool valid = key < t;
            const float sp = fmaxf(z, 0.f) + log1pf(expf(-fabsf(z)));
            const float w = valid ? expf(z - sp + tail) : 0.f;
#pragma unroll
            for (int d = 0; d < 64; ++d) acc[d] += w * vs[s][d];
            if (valid) tail -= sp;
        }
        if (__all(tail < -120.f)) break;
    }
#pragma unroll
    for (int d = 0; d < 64; d += 8) st8(Y + (size_t)(b * NL + t) * ND + 256 + h * 64 + d, acc + d);
}

__device__ __forceinline__ void glu_phase(const float* __restrict__ ya, const float* __restrict__ wglu, const float* __restrict__ bglu, bf16_t* __restrict__ Y, float* lds) {
    const int half = tidx() >> 8, c = tidx() & 255;
    float(*ys)[256] = (float(*)[256])(lds + half * 4096);
    for (int it = blockIdx.x; it < NT / 32; it += gridDim.x) {
        const int t0 = it * 32 + half * 16;
        __syncthreads();
        for (int i = 0; i < 16; ++i) ys[i][c] = ya[(size_t)(t0 + i) * 256 + c];
        __syncthreads();
        float acc[16];
#pragma unroll
        for (int i = 0; i < 16; ++i) acc[i] = 0.f;
        for (int k = 0; k < 256; ++k) {
            const float w = wglu[k * 256 + c];
#pragma unroll
            for (int i = 0; i < 16; ++i) acc[i] += ys[i][k] * w;
        }
        const float bb = bglu[c];
#pragma unroll
        for (int i = 0; i < 16; ++i) Y[(size_t)(t0 + i) * ND + c] = f2bf(ys[i][c] * sigmoidf_(acc[i] + bb));
    }
    __syncthreads();
}

__device__ __forceinline__ void ln_row_wave(float4 (&v)[4], const float* __restrict__ g, const float* __restrict__ bta, float* out, bf16_t* outb, int lane) {
    float s = 0.f;
#pragma unroll
    for (int j = 0; j < 4; ++j) s += v[j].x + v[j].y + v[j].z + v[j].w;
    for (int o = 32; o; o >>= 1) s += __shfl_xor(s, o);
    const float mean = s * (1.f / ND);
    float s2 = 0.f;
#pragma unroll
    for (int j = 0; j < 4; ++j) {
        v[j].x -= mean; v[j].y -= mean; v[j].z -= mean; v[j].w -= mean;
        s2 += v[j].x * v[j].x + v[j].y * v[j].y + v[j].z * v[j].z + v[j].w * v[j].w;
    }
    for (int o = 32; o; o >>= 1) s2 += __shfl_xor(s2, o);
    const float rs = rsqrtf(s2 * (1.f / ND) + LN_EPS);
#pragma unroll
    for (int j = 0; j < 4; ++j) {
        const float4 gg = *(const float4*)(g + j * 256 + lane * 4), bb = *(const float4*)(bta + j * 256 + lane * 4);
        const float4 o = make_float4(v[j].x * rs * gg.x + bb.x, v[j].y * rs * gg.y + bb.y, v[j].z * rs * gg.z + bb.z, v[j].w * rs * gg.w + bb.w);
        *(float4*)(out + j * 256 + lane * 4) = o;
        if (outb) { uint2 w; w.x = pack2(o.x, o.y); w.y = pack2(o.z, o.w); *(uint2*)(outb + j * 256 + lane * 4) = w; }
    }
}
__device__ __forceinline__ void ln_phase(float* R, bf16_t* Hb, const float* __restrict__ g, const float* __restrict__ bta) {
    const int wave = tidx() >> 6, lane = tidx() & 63;
    for (int row = blockIdx.x * 8 + wave; row < NT; row += gridDim.x * 8) {
        float4 v[4];
#pragma unroll
        for (int j = 0; j < 4; ++j) v[j] = *(const float4*)(R + (size_t)row * ND + j * 256 + lane * 4);
        ln_row_wave(v, g, bta, R + (size_t)row * ND, Hb + (size_t)row * ND, lane);
    }
}

__device__ __forceinline__ void wave_argmax(float& bv, int& bi) {
#pragma unroll
    for (int o = 32; o; o >>= 1) {
        const float ov = __shfl_xor(bv, o); const int oi = __shfl_xor(bi, o);
        if (ov > bv || (ov == bv && oi < bi)) { bv = ov; bi = oi; }
    }
}
__device__ __forceinline__ void peer_route_phase(const bf16_t* __restrict__ qbuf, const float* __restrict__ subk, int* __restrict__ eidx, float* __restrict__ egate, float* lds) {
    const int head = tidx() >> 6, lane = tidx() & 63;
    float* qs = lds + head * 256;
    for (int token = blockIdx.x; token < NT; token += gridDim.x) {
        const bf16_t* qp = qbuf + (size_t)token * 2048 + head * 256;
        wave_lds_fence();
        for (int i = 0; i < 4; ++i) qs[lane + 64 * i] = bf2f(qp[lane + 64 * i]);
        wave_lds_fence();
        float myv[2]; int myi[2];
#pragma unroll
        for (int c = 0; c < 2; ++c) {
            float sc[2];
#pragma unroll
            for (int w2 = 0; w2 < 2; ++w2) {
                const float* kr = subk + ((size_t)(head * 2 + c) * 128 + lane + 64 * w2) * 128;
                float a = 0.f;
#pragma unroll 4
                for (int d = 0; d < 128; d += 4) {
                    const float4 kv = *(const float4*)(kr + d);
                    a += qs[c * 128 + d] * kv.x + qs[c * 128 + d + 1] * kv.y + qs[c * 128 + d + 2] * kv.z + qs[c * 128 + d + 3] * kv.w;
                }
                sc[w2] = a;
            }
            float a0 = sc[0], a1 = sc[1];
            float mv = -INFINITY; int mi = 0;
            for (int r = 0; r < 16; ++r) {
                float bv; int bi;
                if (a0 >= a1) { bv = a0; bi = lane; } else { bv = a1; bi = lane + 64; }
                wave_argmax(bv, bi);
                if (lane == r) { mv = bv; mi = bi; }
                if (bi == lane) a0 = -INFINITY; else if (bi == lane + 64) a1 = -INFINITY;
            }
            myv[c] = mv; myi[c] = mi;
        }
        const float va = __shfl(myv[0], lane >> 2);
        float cand[4];
#pragma unroll
        for (int j = 0; j < 4; ++j) cand[j] = va + __shfl(myv[1], (lane & 3) * 4 + j);
        float topv = -INFINITY; int topf = 0;
        for (int r = 0; r < 16; ++r) {
            float bv = cand[0]; int bi = lane * 4;
#pragma unroll
            for (int j = 1; j < 4; ++j) if (cand[j] > bv) { bv = cand[j]; bi = lane * 4 + j; }
            wave_argmax(bv, bi);
            if (lane == r) { topv = bv; topf = bi; }
#pragma unroll
            for (int j = 0; j < 4; ++j) if (bi == lane * 4 + j) cand[j] = -INFINITY;
        }
        const int e1 = __shfl(myi[0], topf >> 4), e2 = __shfl(myi[1], topf & 15);
        const float top0 = __shfl(topv, 0);
        float ex = (lane < 16) ? expf(topv - top0) : 0.f;
        float sum = ex;
        for (int o = 32; o; o >>= 1) sum += __shfl_xor(sum, o);
        if (lane < 16) {
            eidx[(size_t)token * 128 + head * 16 + lane] = e1 * 128 + e2;
            egate[(size_t)token * 128 + head * 16 + lane] = ex / sum;
        }
    }
}

__device__ __forceinline__ void peer_expert_phase(float* R, const int* __restrict__ eidx, const float* __restrict__ egate, const float* __restrict__ utab,
                                  const float* __restrict__ vtab, const float* __restrict__ lg, const float* __restrict__ lb, bf16_t* Hb) {
    const int wave = tidx() >> 6, lane = tidx() & 63;
    for (int token = blockIdx.x * 8 + wave; token < NT; token += gridDim.x * 8) {
        float4 x[4], acc[4];
#pragma unroll
        for (int j = 0; j < 4; ++j) { x[j] = *(const float4*)(R + (size_t)token * ND + j * 256 + lane * 4); acc[j] = make_float4(0.f, 0.f, 0.f, 0.f); }
        for (int e0 = 0; e0 < 128; e0 += 4) {
            float dot[4]; int ex[4]; float gt[4];
#pragma unroll
            for (int k = 0; k < 4; ++k) {
                ex[k] = eidx[(size_t)token * 128 + e0 + k]; gt[k] = egate[(size_t)token * 128 + e0 + k];
                const float* ur = utab + (size_t)ex[k] * ND + lane * 4;
                float a = 0.f;
#pragma unroll
                for (int j = 0; j < 4; ++j) { const float4 u = *(const float4*)(ur + j * 256); a += x[j].x * u.x + x[j].y * u.y + x[j].z * u.z + x[j].w * u.w; }
                dot[k] = a;
            }
#pragma unroll
            for (int k = 0; k < 4; ++k) {
                float a = dot[k];
                for (int o = 32; o; o >>= 1) a += __shfl_xor(a, o);
                const float coef = gt[k] * gelu_tanh(a);
                const float* vr = vtab + (size_t)ex[k] * ND + lane * 4;
#pragma unroll
                for (int j = 0; j < 4; ++j) { const float4 v = *(const float4*)(vr + j * 256); acc[j].x += coef * v.x; acc[j].y += coef * v.y; acc[j].z += coef * v.z; acc[j].w += coef * v.w; }
            }
        }
#pragma unroll
        for (int j = 0; j < 4; ++j) { x[j].x = ALPHA * x[j].x + acc[j].x; x[j].y = ALPHA * x[j].y + acc[j].y; x[j].z = ALPHA * x[j].z + acc[j].z; x[j].w = ALPHA * x[j].w + acc[j].w; }
        ln_row_wave(x, lg, lb, R + (size_t)token * ND, Hb ? Hb + (size_t)token * ND : nullptr, lane);
    }
}


typedef short bf16x8_t __attribute__((ext_vector_type(8)));
__device__ __forceinline__ int f2key(float f) { const int b = __float_as_int(f); return b ^ ((b >> 31) & 0x7fffffff); }
__device__ __forceinline__ float key2f(int k) { return __int_as_float(k ^ ((k >> 31) & 0x7fffffff)); }
#define CE_DESC_I(a, b) do { const int _hi = max(a, b), _lo = min(a, b); a = _hi; b = _lo; } while (0)
template <int N, int K, int J> __device__ __forceinline__ void bstage(int (&v)[N]) {
#pragma unroll
    for (int i = 0; i < N; ++i) {
        const int l = i ^ J;
        if (l > i) { if ((i & K) == 0) CE_DESC_I(v[i], v[l]); else CE_DESC_I(v[l], v[i]); }
    }
}
__device__ __forceinline__ void sort16_desc(int (&v)[16]) {
    bstage<16, 2, 1>(v); bstage<16, 4, 2>(v); bstage<16, 4, 1>(v); bstage<16, 8, 4>(v); bstage<16, 8, 2>(v); bstage<16, 8, 1>(v);
    bstage<16, 16, 8>(v); bstage<16, 16, 4>(v); bstage<16, 16, 2>(v); bstage<16, 16, 1>(v);
}
__device__ __forceinline__ void sort8_desc(int (&v)[8]) {
    bstage<8, 2, 1>(v); bstage<8, 4, 2>(v); bstage<8, 4, 1>(v); bstage<8, 8, 4>(v); bstage<8, 8, 2>(v); bstage<8, 8, 1>(v);
}
__device__ __forceinline__ void bitonic_merge16_desc(int (&v)[16]) {
    bstage<16, 16, 8>(v); bstage<16, 16, 4>(v); bstage<16, 16, 2>(v); bstage<16, 16, 1>(v);
}
__device__ __forceinline__ void xmerge16(int (&v)[16], int off) {
    int m[16];
#pragma unroll
    for (int i = 0; i < 16; ++i) m[i] = max(v[i], __shfl_xor(v[15 - i], off));
    bitonic_merge16_desc(m);
#pragma unroll
    for (int i = 0; i < 16; ++i) v[i] = m[i];
}
__device__ __forceinline__ void opaque16(int (&v)[16]) {
#pragma unroll
    for (int i = 0; i < 16; ++i) asm volatile("" : "+v"(v[i]));
}
__device__ __forceinline__ int lookup16(const int (&arr)[16], int a) {
    int r = arr[0];
#pragma unroll
    for (int i = 1; i < 16; ++i) r = (a == i) ? arr[i] : r;
    return r;
}
__device__ __forceinline__ void peer_route2_phase(const bf16_t* __restrict__ qbuf, const bf16_t* __restrict__ skb, int* __restrict__ eidx, float* __restrict__ egate, unsigned char* lds) {
    const int tid = tidx(), wave = tid >> 6, lane = tid & 63, fr = lane & 15, fq = lane >> 4;
    for (int chunk = blockIdx.x; chunk < NT / 128; chunk += gridDim.x) {
        const int token = chunk * 128 + wave * 16 + fr;
        int* tl = (int*)(lds + 34816) + (wave * 16 + fr) * 48;
        for (int h = 0; h < 8; ++h) {
            int K1[16], K2[16];
#pragma unroll
            for (int c = 0; c < 2; ++c) {
                __syncthreads();
#pragma unroll
                for (int i = 0; i < 4; ++i) {
                    const int idx = tid + 512 * i, row = idx >> 4, ch = idx & 15;
                    *(uint4*)(lds + row * 272 + ch * 16) = *(const uint4*)(skb + ((size_t)(h * 2 + c) * 128 + row) * 128 + ch * 8);
                }
                __syncthreads();
                bf16x8_t qf[4];
#pragma unroll
                for (int sI = 0; sI < 4; ++sI) qf[sI] = *(const bf16x8_t*)(qbuf + (size_t)token * 2048 + h * 256 + c * 128 + 32 * sI + 8 * fq);
                int va[16], vb[16];
#pragma unroll
                for (int n = 0; n < 8; ++n) {
                    f32x4 S = {0.f, 0.f, 0.f, 0.f};
#pragma unroll
                    for (int sI = 0; sI < 4; ++sI) {
                        const bf16x8_t kf = *(const bf16x8_t*)(lds + (16 * n + fr) * 272 + (32 * sI + 8 * fq) * 2);
                        S = __builtin_amdgcn_mfma_f32_16x16x32_bf16(kf, qf[sI], S, 0, 0, 0);
                    }
#pragma unroll
                    for (int j = 0; j < 4; ++j) {
                        const int key = (f2key(S[j]) & ~127) | (16 * n + 4 * fq + j);
                        if (n < 4) va[n * 4 + j] = key; else vb[(n - 4) * 4 + j] = key;
                    }
                }
                sort16_desc(va); sort16_desc(vb);
                int m[16];
#pragma unroll
                for (int i = 0; i < 16; ++i) m[i] = max(va[i], vb[15 - i]);
                bitonic_merge16_desc(m);
                xmerge16(m, 16); xmerge16(m, 32);
#pragma unroll
                for (int i = 0; i < 16; ++i) { if (c == 0) K1[i] = m[i]; else K2[i] = m[i]; }
                if (fq == 0) {
#pragma unroll
                    for (int i = 0; i < 4; ++i) *(int4*)(tl + c * 16 + 4 * i) = make_int4(m[4 * i], m[4 * i + 1], m[4 * i + 2], m[4 * i + 3]);
                }
            }
            wave_lds_fence();
            float vaf[4];
#pragma unroll
            for (int k = 0; k < 4; ++k) vaf[k] = key2f(tl[4 * k + fq]);
            int A[16];
#pragma unroll
            for (int b = 0; b < 16; ++b) {
                const bool valid = (fq + 1) * (b + 1) <= 16;
                const int key = (f2key(vaf[0] + key2f(K2[b])) & ~127) | (fq << 5) | b;
                A[b] = valid ? key : INT_MIN;
            }
            int Bq[8];
#pragma unroll
            for (int b = 0; b < 3; ++b) {
                const bool valid = (fq + 5) * (b + 1) <= 16;
                const int key = (f2key(vaf[1] + key2f(K2[b])) & ~127) | (fq << 5) | (16 + b);
                Bq[b] = valid ? key : INT_MIN;
            }
            Bq[3] = (f2key(vaf[2] + key2f(K2[0])) & ~127) | (fq << 5) | 19;
            Bq[4] = (f2key(vaf[3] + key2f(K2[0])) & ~127) | (fq << 5) | 20;
            Bq[5] = INT_MIN; Bq[6] = INT_MIN; Bq[7] = INT_MIN;
            sort8_desc(Bq);
#pragma unroll
            for (int i = 8; i < 16; ++i) A[i] = max(A[i], Bq[15 - i]);
            bitonic_merge16_desc(A);
            xmerge16(A, 16); xmerge16(A, 32);
            if (fq == 0) {
#pragma unroll
                for (int i = 0; i < 4; ++i) *(int4*)(tl + 32 + 4 * i) = make_int4(A[4 * i], A[4 * i + 1], A[4 * i + 2], A[4 * i + 3]);
            }
            wave_lds_fence();
            const int4 myT = *(const int4*)(tl + 32 + 4 * fq);
            const int tsel[4] = {myT.x, myT.y, myT.z, myT.w};
            const float top0 = key2f(A[0]);
            float sum = 0.f;
#pragma unroll
            for (int r = 0; r < 16; ++r) sum += __expf(key2f(A[r]) - top0);
            const float inv = 1.f / sum;
            int eo[4]; float go[4];
#pragma unroll
            for (int kk = 0; kk < 4; ++kk) {
                const int t = tsel[kk];
                const int id = t & 127, ofq = id >> 5, slot = id & 31;
                const int k = slot < 16 ? 0 : (slot < 19 ? 1 : (slot == 19 ? 2 : 3));
                const int b = slot < 16 ? slot : (slot < 19 ? slot - 16 : 0);
                const int a = ofq + 4 * k;
                const int e1 = tl[a] & 127, e2 = tl[16 + b] & 127;
                eo[kk] = e1 * 128 + e2;
                go[kk] = __expf(key2f(t) - top0) * inv;
            }
            *(int4*)(eidx + (size_t)token * 128 + h * 16 + 4 * fq) = make_int4(eo[0], eo[1], eo[2], eo[3]);
            *(float4*)(egate + (size_t)token * 128 + h * 16 + 4 * fq) = make_float4(go[0], go[1], go[2], go[3]);
            wave_lds_fence();
        }
    }
    __syncthreads();
}

typedef __bf16 bf16x2_t __attribute__((ext_vector_type(2)));
__device__ __forceinline__ float dot2bf(unsigned a, unsigned b, float acc) { return __builtin_amdgcn_fdot2_f32_bf16(__builtin_bit_cast(bf16x2_t, a), __builtin_bit_cast(bf16x2_t, b), acc, false); }
__device__ __forceinline__ float gelu_fast(float x) {
    const float u = 0.7978845608028654f * (x + 0.044715f * x * x * x);
    return x / (1.f + __expf(-2.f * u));
}
__device__ __forceinline__ void peer_expert2_phase(float* R, const int* __restrict__ eidx, const float* __restrict__ egate, const bf16_t* __restrict__ ub,
                                                   const bf16_t* __restrict__ vb, const float* __restrict__ lg, const float* __restrict__ lb, bf16_t* Hb) {
    const int wave = tidx() >> 6, lane = tidx() & 63;
    for (int token = blockIdx.x * 8 + wave; token < NT; token += gridDim.x * 8) {
        float xf[16];
        {
            const float* rp = R + (size_t)token * ND + lane * 8;
            const float4 a0 = *(const float4*)rp, a1 = *(const float4*)(rp + 4), b0 = *(const float4*)(rp + 512), b1 = *(const float4*)(rp + 516);
            xf[0] = a0.x; xf[1] = a0.y; xf[2] = a0.z; xf[3] = a0.w; xf[4] = a1.x; xf[5] = a1.y; xf[6] = a1.z; xf[7] = a1.w;
            xf[8] = b0.x; xf[9] = b0.y; xf[10] = b0.z; xf[11] = b0.w; xf[12] = b1.x; xf[13] = b1.y; xf[14] = b1.z; xf[15] = b1.w;
        }
        unsigned xp[8];
#pragma unroll
        for (int j = 0; j < 8; ++j) xp[j] = pack2(xf[2 * j], xf[2 * j + 1]);
        float acc[16];
#pragma unroll
        for (int j = 0; j < 16; ++j) acc[j] = 0.f;
        const int e_lo = eidx[(size_t)token * 128 + lane], e_hi = eidx[(size_t)token * 128 + 64 + lane];
        const float g_lo = egate[(size_t)token * 128 + lane], g_hi = egate[(size_t)token * 128 + 64 + lane];
        for (int grp = 0; grp < 16; ++grp) {
            const int esel = grp < 8 ? e_lo : e_hi;
            const float gsel = grp < 8 ? g_lo : g_hi;
            const int lbase = (grp & 7) * 8;
            uint4 u0[8], u1[8];
            int exs[8];
#pragma unroll
            for (int k = 0; k < 8; ++k) {
                exs[k] = __builtin_amdgcn_readlane(esel, lbase + k);
                const bf16_t* up = ub + (size_t)exs[k] * ND + lane * 8;
                u0[k] = *(const uint4*)up; u1[k] = *(const uint4*)(up + 512);
            }
            float d[8];
#pragma unroll
            for (int k = 0; k < 8; ++k) {
                float a = dot2bf(u0[k].x, xp[0], 0.f), b = dot2bf(u0[k].y, xp[1], 0.f);
                a = dot2bf(u0[k].z, xp[2], a); b = dot2bf(u0[k].w, xp[3], b);
                a = dot2bf(u1[k].x, xp[4], a); b = dot2bf(u1[k].y, xp[5], b);
                a = dot2bf(u1[k].z, xp[6], a); b = dot2bf(u1[k].w, xp[7], b);
                d[k] = a + b;
            }
            const bool hi5 = lane & 32, hi4 = lane & 16, hi3 = lane & 8;
            float r4[4], r2[2], r1;
#pragma unroll
            for (int k = 0; k < 4; ++k) { const float send = hi5 ? d[k] : d[k + 4], keep = hi5 ? d[k + 4] : d[k]; r4[k] = keep + __shfl_xor(send, 32); }
#pragma unroll
            for (int k = 0; k < 2; ++k) { const float send = hi4 ? r4[k] : r4[k + 2], keep = hi4 ? r4[k + 2] : r4[k]; r2[k] = keep + __shfl_xor(send, 16); }
            { const float send = hi3 ? r2[0] : r2[1], keep = hi3 ? r2[1] : r2[0]; r1 = keep + __shfl_xor(send, 8); }
            r1 += __shfl_xor(r1, 4); r1 += __shfl_xor(r1, 2); r1 += __shfl_xor(r1, 1);
            uint4 v0[8], v1[8];
#pragma unroll
            for (int k = 0; k < 8; ++k) {
                const bf16_t* vp = vb + (size_t)exs[k] * ND + lane * 8;
                v0[k] = *(const uint4*)vp; v1[k] = *(const uint4*)(vp + 512);
            }
            const float gk = __shfl(gsel, lbase + (lane >> 3));
            const float coef = gk * gelu_fast(r1);
#pragma unroll
            for (int k = 0; k < 8; ++k) {
                const float ck = __int_as_float(__builtin_amdgcn_readlane(__float_as_int(coef), 8 * k));
                const unsigned w[8] = {v0[k].x, v0[k].y, v0[k].z, v0[k].w, v1[k].x, v1[k].y, v1[k].z, v1[k].w};
#pragma unroll
                for (int j = 0; j < 8; ++j) {
                    acc[2 * j] += ck * __uint_as_float(w[j] << 16);
                    acc[2 * j + 1] += ck * __uint_as_float(w[j] & 0xffff0000u);
                }
            }
        }
        {
            const float* rp = R + (size_t)token * ND + lane * 8;
            const float4 a0 = *(const float4*)rp, a1 = *(const float4*)(rp + 4), b0 = *(const float4*)(rp + 512), b1 = *(const float4*)(rp + 516);
            xf[0] = a0.x; xf[1] = a0.y; xf[2] = a0.z; xf[3] = a0.w; xf[4] = a1.x; xf[5] = a1.y; xf[6] = a1.z; xf[7] = a1.w;
            xf[8] = b0.x; xf[9] = b0.y; xf[10] = b0.z; xf[11] = b0.w; xf[12] = b1.x; xf[13] = b1.y; xf[14] = b1.z; xf[15] = b1.w;
        }
        float s = 0.f;
#pragma unroll
        for (int j = 0; j < 16; ++j) { xf[j] = ALPHA * xf[j] + acc[j]; s += xf[j]; }
        for (int o = 32; o; o >>= 1) s += __shfl_xor(s, o);
        const float mean = s * (1.f / ND);
        float s2 = 0.f;
#pragma unroll
        for (int j = 0; j < 16; ++j) { xf[j] -= mean; s2 += xf[j] * xf[j]; }
        for (int o = 32; o; o >>= 1) s2 += __shfl_xor(s2, o);
        const float rs = rsqrtf(s2 * (1.f / ND) + LN_EPS);
#pragma unroll
        for (int hf = 0; hf < 2; ++hf) {
            const int c0 = hf * 512 + lane * 8;
            const float4 g0 = *(const float4*)(lg + c0), g1 = *(const float4*)(lg + c0 + 4), b0 = *(const float4*)(lb + c0), b1 = *(const float4*)(lb + c0 + 4);
            float o[8];
            o[0] = xf[hf * 8 + 0] * rs * g0.x + b0.x; o[1] = xf[hf * 8 + 1] * rs * g0.y + b0.y; o[2] = xf[hf * 8 + 2] * rs * g0.z + b0.z; o[3] = xf[hf * 8 + 3] * rs * g0.w + b0.w;
            o[4] = xf[hf * 8 + 4] * rs * g1.x + b1.x; o[5] = xf[hf * 8 + 5] * rs * g1.y + b1.y; o[6] = xf[hf * 8 + 6] * rs * g1.z + b1.z; o[7] = xf[hf * 8 + 7] * rs * g1.w + b1.w;
            float* op = R + (size_t)token * ND + c0;
            *(float4*)op = make_float4(o[0], o[1], o[2], o[3]); *(float4*)(op + 4) = make_float4(o[4], o[5], o[6], o[7]);
            if (Hb) st8(Hb + (size_t)token * ND + c0, o);
        }
    }
}

__device__ __forceinline__ void nsa_compress_phase(const bf16_t* __restrict__ proj, int coloff, const float* __restrict__ pe, const float* __restrict__ w1,
                                   const float* __restrict__ w2, float* __restrict__ outc, float* lds) {
    const int qtr = tidx() >> 7, tid = tidx() & 127;
    float* in = lds + qtr * 2176;
    float* hid = in + 2048;
    for (int it = blockIdx.x; it < NB * 127; it += gridDim.x) {
        const int g = qtr, n = it % 127, b = it / 127;
        __syncthreads();
        for (int idx = tid; idx < 2048; idx += 128) {
            const int l = idx >> 6, d = idx & 63;
            in[idx] = bf2f(proj[(size_t)(b * NL + 16 * n + l) * ODD_PAD + coloff + g * 64 + d]) + pe[l * 64 + d];
        }
        __syncthreads();
        float a = 0.f;
        for (int i = 0; i < 2048; ++i) a += in[i] * w1[(size_t)i * 128 + tid];
        hid[tid] = gelu_tanh(a);
        __syncthreads();
        if (tid < 64) {
            float o = 0.f;
            for (int j = 0; j < 128; ++j) o += hid[j] * w2[j * 64 + tid];
            outc[((size_t)(b * 127 + n) * 4 + g) * 64 + tid] = o;
        }
    }
    __syncthreads();
}

__device__ __forceinline__ void nsa_cmp_phase(const bf16_t* __restrict__ proj, const float* __restrict__ kcmp, const float* __restrict__ vcmp,
                              bf16_t* __restrict__ O, unsigned* __restrict__ selmask, float* lds) {
    const int half = tidx() >> 8, tid = tidx() & 255;
    float* kc_s = lds + half * 18368;
    float* vc_s = kc_s + 127 * 64;
    float(*imp_s)[33] = (float(*)[33])(vc_s + 127 * 64);
    const int tk = tid >> 2, r = tid & 3;
    for (int it = blockIdx.x; it < 32 * 4 * NB / 2; it += gridDim.x) {
        const int vb = it * 2 + half;
        const int tile = vb & 31, g = (vb >> 5) & 3, b = vb >> 7;
        const int t = tile * 64 + tk, hd = g * 4 + r;
        __syncthreads();
        for (int idx = tid; idx < 127 * 64; idx += 256) { const int n = idx >> 6, d = idx & 63; kc_s[idx] = kcmp[((size_t)(b * 127 + n) * 4 + g) * 64 + d]; vc_s[idx] = vcmp[((size_t)(b * 127 + n) * 4 + g) * 64 + d]; }
        const bf16_t* prow = proj + (size_t)(b * NL + t) * ODD_PAD;
        float q[64];
#pragma unroll
        for (int d = 0; d < 64; d += 8) ld8(prow + hd * 64 + d, q + d);
        const float slope = exp2f(-0.5f * (float)(hd + 1));
        int nvalid = (t >= 31) ? ((t - 31) / 16 + 1) : 0;
        if (nvalid > 127) nvalid = 127;
        __syncthreads();
        float m = -INFINITY, l = 0.f;
        for (int n = 0; n < nvalid; ++n) {
            float s = 0.f;
#pragma unroll
            for (int d = 0; d < 64; ++d) s += q[d] * kc_s[n * 64 + d];
            s = s * 0.125f - slope * (float)(t - (16 * n + 31));
            const float mn = fmaxf(m, s);
            l = l * expf(m - mn) + expf(s - mn);
            m = mn;
        }
        const float inv_l = (nvalid > 0) ? 1.f / fmaxf(l, 1e-30f) : 0.f;
        float acc[64];
#pragma unroll
        for (int d = 0; d < 64; ++d) acc[d] = 0.f;
        float prev3 = 0.f;
        for (int j = 0; j < 32; ++j) {
            float pj[4];
#pragma unroll
            for (int nn = 0; nn < 4; ++nn) {
                const int n = 4 * j + nn;
                float p = 0.f;
                if (n < nvalid) {
                    float s = 0.f;
#pragma unroll
                    for (int d = 0; d < 64; ++d) s += q[d] * kc_s[n * 64 + d];
                    s = s * 0.125f - slope * (float)(t - (16 * n + 31));
                    p = expf(s - m) * inv_l;
                    const float* vr = vc_s + n * 64;
#pragma unroll
                    for (int d = 0; d < 64; ++d) acc[d] += p * vr[d];
                }
                pj[nn] = p;
            }
            float im = 0.5f * prev3 + pj[0] + pj[1] + pj[2] + 0.5f * pj[3];
            prev3 = pj[3];
            im += __shfl_xor(im, 1);
            im += __shfl_xor(im, 2);
            if (r == 0) imp_s[tk][j] = im;
        }
        const float g0 = sigmoidf_(bf2f(prow[2560 + hd]));
#pragma unroll
        for (int d = 0; d < 64; ++d) acc[d] *= g0;
#pragma unroll
        for (int d = 0; d < 64; d += 8) st8(O + (size_t)(b * NL + t) * ND + hd * 64 + d, acc + d);
        __syncthreads();
        const int cur = tile;
        unsigned bits = 0;
        for (int jj = 0; jj < 8; ++jj) {
            const int j = r * 8 + jj;
            const bool fj = (j == 0) || (j == cur) || (j == cur - 1);
            const float vj = (j <= cur) ? imp_s[tk][j] + (fj ? 1000.f : 0.f) : -INFINITY;
            int rank = 0;
            for (int k = 0; k < 32; ++k) {
                const bool fk = (k == 0) || (k == cur) || (k == cur - 1);
                const float vk = (k <= cur) ? imp_s[tk][k] + (fk ? 1000.f : 0.f) : -INFINITY;
                rank += (vk > vj || (vk == vj && k < j)) ? 1 : 0;
            }
            if (rank < 16) bits |= 1u << j;
        }
        bits |= __shfl_xor(bits, 1);
        bits |= __shfl_xor(bits, 2);
        if (r == 0) selmask[(size_t)(b * 4 + g) * NL + t] = bits;
    }
    __syncthreads();
}

__device__ __forceinline__ void nsa_selwin_phase(const bf16_t* __restrict__ proj, const unsigned* __restrict__ selmask, bf16_t* O, float* lds) {
    const int half = tidx() >> 8, tid = tidx() & 255;
    float(*k_s)[64] = (float(*)[64])(lds + half * 8192);
    float(*v_s)[64] = (float(*)[64])(lds + half * 8192 + 4096);
    const int tk = tid >> 2, r = tid & 3;
    for (int it = blockIdx.x; it < 32 * 32; it += gridDim.x) {
        const int tile = 31 - (it >> 5);
        const int bgi = (it & 31) * 2 + half, g = bgi & 3, b = bgi >> 2;
        const int t = tile * 64 + tk, hd = g * 4 + r;
        const bf16_t* pb = proj + (size_t)b * NL * ODD_PAD;
        const bf16_t* prow = pb + (size_t)t * ODD_PAD;
        float q[64], acc[64];
#pragma unroll
        for (int d = 0; d < 64; d += 8) ld8(prow + hd * 64 + d, q + d);
        const float slope = exp2f(-0.5f * (float)(hd + 1));
        const unsigned mask = selmask[(size_t)(b * 4 + g) * NL + t];
        bf16_t* orow = O + (size_t)(b * NL + t) * ND + hd * 64;
        for (int branch = 0; branch < 2; ++branch) {
            const int kcol = (branch == 0 ? 1536 : 2048) + g * 64, vcol = kcol + 256;
            const int j0 = (branch == 0) ? 0 : (tile >= 8 ? tile - 8 : 0);
            float m = -1e30f, l = 0.f;
#pragma unroll
            for (int d = 0; d < 64; ++d) acc[d] = 0.f;
            for (int j = j0; j <= tile; ++j) {
                __syncthreads();
                for (int i = 0; i < 16; ++i) {
                    const int idx = tid + 256 * i, key = idx >> 6, d = idx & 63;
                    k_s[key][d] = bf2f(pb[(size_t)(64 * j + key) * ODD_PAD + kcol + d]);
                    v_s[key][d] = bf2f(pb[(size_t)(64 * j + key) * ODD_PAD + vcol + d]);
                }
                __syncthreads();
                const bool take = (branch == 0) ? ((mask >> j) & 1u) : true;
                if (take) {
                    for (int s = 0; s < 64; ++s) {
                        const int dist = t - (64 * j + s);
                        const bool valid = (branch == 0) ? (dist >= 0) : (dist >= 0 && dist < 512);
                        float sc = 0.f;
#pragma unroll
                        for (int d = 0; d < 64; ++d) sc += q[d] * k_s[s][d];
                        sc = sc * 0.125f - slope * (float)dist;
                        const float mn = valid ? fmaxf(m, sc) : m;
                        const float scale = expf(m - mn);
                        const float p = valid ? expf(sc - mn) : 0.f;
                        l = l * scale + p;
#pragma unroll
                        for (int d = 0; d < 64; ++d) acc[d] = acc[d] * scale + p * v_s[s][d];
                        m = mn;
                    }
                }
            }
            const float gt = sigmoidf_(bf2f(prow[2560 + (branch + 1) * 16 + hd]));
            const float f = gt / fmaxf(l, 1e-30f);
#pragma unroll
            for (int d = 0; d < 64; d += 8) {
                float o[8];
                ld8(orow + d, o);
#pragma unroll
                for (int j = 0; j < 8; ++j) o[j] += f * acc[d + j];
                st8(orow + d, o);
            }
        }
    }
    __syncthreads();
}

struct Params {
    const float* in[29];
    float* out;
    char* ws;
    unsigned long long pad;
};

constexpr size_t SZ_PROJ = (size_t)NT * ODD_PAD * 2;
constexpr size_t SZ_YB = (size_t)NT * ND * 2;
constexpr size_t SZ_HB = (size_t)NT * ND * 2;
constexpr size_t SZ_YA = (size_t)NT * 256 * 4;
constexpr size_t SZ_CMP = (size_t)NB * 127 * 4 * 64 * 4;
constexpr size_t SZ_SEL = (size_t)NB * 4 * NL * 4;
constexpr size_t SZ_TAB = (size_t)16384 * ND * 2;
constexpr size_t SZ_SKB = (size_t)2 * 8 * 2 * 128 * 128 * 2;
constexpr size_t OFF_YB = SZ_PROJ, OFF_HB = OFF_YB + SZ_YB, OFF_YA = OFF_HB + SZ_HB, OFF_KC = OFF_YA + SZ_YA, OFF_VC = OFF_KC + SZ_CMP,
                 OFF_SEL = OFF_VC + SZ_CMP, OFF_TAB = OFF_SEL + SZ_SEL, OFF_SKB = OFF_TAB + 4 * SZ_TAB, OFF_WT = OFF_SKB + SZ_SKB;
constexpr size_t WT_IN0 = 0, WT_OUT0 = WT_IN0 + (size_t)EVEN_IN * ND * 2, WT_Q0 = WT_OUT0 + (size_t)ND * ND * 2, WT_Q1 = WT_Q0 + (size_t)2048 * ND * 2,
                 WT_IN1 = WT_Q1 + (size_t)2048 * ND * 2, WT_OUT1 = WT_IN1 + (size_t)ODD_PAD * ND * 2, WT_END = WT_OUT1 + (size_t)ND * ND * 2;
constexpr size_t WS_NEED = OFF_WT + WT_END;

__global__ void __launch_bounds__(NTHR) fwd_megakernel(Params p) {
    extern __shared__ __attribute__((aligned(16))) unsigned char lds_raw[];
    float* lds = (float*)lds_raw;
    cg::grid_group grid = cg::this_grid();
    const float* x = p.in[0];
    float* R = p.out;
    char* ws = p.ws;
    bf16_t* PROJ = (bf16_t*)ws;
    bf16_t* YB = (bf16_t*)(ws + OFF_YB);
    bf16_t* HB = (bf16_t*)(ws + OFF_HB);
    float* YA = (float*)(ws + OFF_YA);
    float* KCMP = (float*)(ws + OFF_KC);
    float* VCMP = (float*)(ws + OFF_VC);
    unsigned* SEL = (unsigned*)(ws + OFF_SEL);
    bf16_t* WIN0 = (bf16_t*)(ws + OFF_WT + WT_IN0);
    bf16_t* WOUT0 = (bf16_t*)(ws + OFF_WT + WT_OUT0);
    bf16_t* WQ0 = (bf16_t*)(ws + OFF_WT + WT_Q0);
    bf16_t* WQ1 = (bf16_t*)(ws + OFF_WT + WT_Q1);
    bf16_t* WIN1 = (bf16_t*)(ws + OFF_WT + WT_IN1);
    bf16_t* WOUT1 = (bf16_t*)(ws + OFF_WT + WT_OUT1);
    int* EIDX = (int*)YB;
    float* EGATE = (float*)((char*)YB + (size_t)NT * 128 * 4);
    bf16_t* TAB = (bf16_t*)(ws + OFF_TAB);
    bf16_t* SKB = (bf16_t*)(ws + OFF_SKB);
    const int wave = tidx() >> 6;

    for (size_t i = (size_t)blockIdx.x * NTHR + tidx(); i < (size_t)NT * ND / 4; i += (size_t)gridDim.x * NTHR) {
        const float4 v = ((const float4*)x)[i];
        ((float4*)R)[i] = v;
        uint2 w; w.x = pack2(v.x, v.y); w.y = pack2(v.z, v.w);
        ((uint2*)HB)[i] = w;
    }
    {
        const size_t per = (size_t)16384 * ND / 8;
        for (size_t i = (size_t)blockIdx.x * NTHR + tidx(); i < 4 * per; i += (size_t)gridDim.x * NTHR) {
            const int tb = (int)(i / per); const size_t off = (i % per) * 8;
            const float* src = ((tb & 1) ? p.in[24] : p.in[23]) + (size_t)(tb >> 1) * 16384 * ND + off;
            const float4 a = *(const float4*)src, b = *(const float4*)(src + 4);
            uint4 w; w.x = pack2(a.x, a.y); w.y = pack2(a.z, a.w); w.z = pack2(b.x, b.y); w.w = pack2(b.z, b.w);
            *(uint4*)(TAB + (size_t)tb * 16384 * ND + off) = w;
        }
        for (int i = blockIdx.x * NTHR + tidx(); i < 2 * 8 * 2 * 128 * 128 / 4; i += gridDim.x * NTHR) {
            const float4 a = ((const float4*)p.in[22])[i];
            uint2 w; w.x = pack2(a.x, a.y); w.y = pack2(a.z, a.w);
            ((uint2*)SKB)[i] = w;
        }
    }
    convert_wt_phase(p.in[1], ND, EVEN_IN, EVEN_IN, WIN0, lds);
    convert_wt_phase(p.in[12], ND, ND, ND, WOUT0, lds);
    convert_wt_phase(p.in[21], ND, 2048, 2048, WQ0, lds);
    convert_wt_phase(p.in[21] + (size_t)ND * 2048, ND, 2048, 2048, WQ1, lds);
    convert_wt_phase(p.in[13], ND, ODD_IN, ODD_PAD, WIN1, lds);
    convert_wt_phase(p.in[20], ND, ND, ND, WOUT1, lds);
    grid.sync();
    PH(0) gemm_bf16_phase(lds_raw, HB, WIN0, NT, EVEN_IN, ND, EpiBf16s{PROJ, EVEN_IN});
    grid.sync();
    PH(1) if (wave == 0) {
        for (int bg = blockIdx.x; bg < NB * 16; bg += gridDim.x)
            s5_scan_wave(bg, PROJ, p.in[2], p.in[3], p.in[4], p.in[5], p.in[6], p.in[7], p.in[8], p.in[9], YA, lds);
    } else PH(2) {
        for (int task = blockIdx.x * 7 + (wave - 1); task < NB * 12 * 32; task += gridDim.x * 7)
            sb_attn_wave(task, PROJ, YB, lds + 11392 + (wave - 1) * 4096);
    }
    grid.sync();
    PH(3) glu_phase(YA, p.in[10], p.in[11], YB, lds);
    grid.sync();
    PH(4) gemm_bf16_phase(lds_raw, YB, WOUT0, NT, ND, ND, EpiRes{R, ND, ALPHA});
    grid.sync();
    PH(5) ln_phase(R, HB, p.in[25], p.in[26]);
    grid.sync();
#define PEER_FFN(layer, WQ, last) \
    PH(12) gemm_bf16_phase(lds_raw, HB, WQ, NT, 2048, ND, EpiBf16s{PROJ, 2048}); \
    grid.sync(); \
    PH(13) peer_route2_phase(PROJ, SKB + (size_t)(layer) * 8 * 2 * 128 * 128, EIDX, EGATE, lds_raw); \
    grid.sync(); \
    PH(14) peer_expert2_phase(R, EIDX, EGATE, TAB + (size_t)(2 * (layer)) * 16384 * ND, TAB + (size_t)(2 * (layer) + 1) * 16384 * ND, p.in[27] + (layer) * ND, p.in[28] + (layer) * ND, (last) ? nullptr : HB); \
    if (!(last)) grid.sync();
    PEER_FFN(0, WQ0, false)
    PH(6) gemm_bf16_phase(lds_raw, HB, WIN1, NT, ODD_PAD, ND, EpiBf16s{PROJ, ODD_PAD});
    grid.sync();
    PH(7) nsa_compress_phase(PROJ, 1024, p.in[14], p.in[15], p.in[16], KCMP, lds);
    PH(7) nsa_compress_phase(PROJ, 1280, p.in[17], p.in[18], p.in[19], VCMP, lds);
    grid.sync();
    PH(8) nsa_cmp_phase(PROJ, KCMP, VCMP, YB, SEL, lds);
    grid.sync();
    PH(9) nsa_selwin_phase(PROJ, SEL, YB, lds);
    grid.sync();
    PH(10) gemm_bf16_phase(lds_raw, YB, WOUT1, NT, ND, ND, EpiRes{R, ND, ALPHA});
    grid.sync();
    PH(11) ln_phase(R, HB, p.in[25] + ND, p.in[26] + ND);
    grid.sync();
    PEER_FFN(1, WQ1, true)
}

}

extern "C" void kernel_launch(void* const* d_in, const int* in_sizes, int n_in, void* d_out, int out_size, void* d_ws, size_t ws_size, hipStream_t stream) {
    static int grid_blocks = 0;
    if (grid_blocks == 0) {
        if (n_in != 29 || out_size != NT * ND || ws_size < WS_NEED) { fprintf(stderr, "kernel_launch: unexpected shapes / workspace (%zu < %zu)\n", ws_size, (size_t)WS_NEED); grid_blocks = -1; return; }
        int dev = 0, cus = 0, per_cu = 0;
        hipGetDevice(&dev);
        hipDeviceGetAttribute(&cus, hipDeviceAttributeMultiprocessorCount, dev);
        hipFuncSetAttribute((const void*)fwd_megakernel, hipFuncAttributeMaxDynamicSharedMemorySize, LDS_BYTES);
        hipOccupancyMaxActiveBlocksPerMultiprocessor(&per_cu, (const void*)fwd_megakernel, NTHR, LDS_BYTES);
        if (per_cu < 1) { fprintf(stderr, "kernel_launch: occupancy query says %d blocks/CU\n", per_cu); grid_blocks = -1; return; }
        grid_blocks = cus;
    }
    if (grid_blocks < 0) return;
    Params p{};
    for (int i = 0; i < 29; ++i) p.in[i] = (const float*)d_in[i];
    p.out = (float*)d_out; p.ws = (char*)d_ws; p.pad = 0;
    void* args[] = {&p};
    hipError_t e = hipLaunchCooperativeKernel((const void*)fwd_megakernel, dim3(grid_blocks), dim3(NTHR), args, LDS_BYTES, stream);
    if (e != hipSuccess) fprintf(stderr, "cooperative launch failed: %s (grid %d)\n", hipGetErrorString(e), grid_blocks);
}
```

```cpp
#include <hip/hip_runtime.h>
#include <hip/hip_cooperative_groups.h>
#include <math.h>
#include <stdint.h>
#include <cstdio>
namespace cg = cooperative_groups;

__device__ __forceinline__ int tidx() { int t = threadIdx.x; asm volatile("" : "+v"(t)); return t; }
namespace pg8 {
#define PG8_LAS __attribute__((address_space(3)))
typedef unsigned short bf16_t;
typedef short bf16x8 __attribute__((ext_vector_type(8)));
typedef float f32x4 __attribute__((ext_vector_type(4)));
typedef unsigned u32x4 __attribute__((ext_vector_type(4)));
constexpr int BM = 256, BK = 64, HALF = 128, HTB = HALF * BK * 2  , STAGE_BYTES = 8 * HTB, NXCD = 8, WGM = 8;

__host__ __device__ __forceinline__ int lds_byte(int r, int c) { const int st = (r >> 4) * 2 + (c >> 5), rr = r & 15, cc = c & 31, ob = rr * 64 + cc * 2; return st * 1024 + (ob ^ (((ob >> 9) & 1) << 5)); }
__host__ __device__ __forceinline__ void stage_rc(int b, int& R, int& C) { const int st = b / 1024, sb = b % 1024, swz = sb ^ (((sb >> 9) & 1) << 5); R = (st >> 1) * 16 + swz / 64; C = (st & 1) * 32 + (swz % 64) / 2; }
__host__ __device__ __forceinline__ int perm32(int rho) { const int n = rho >> 4, i = rho & 15; return 8 * (i >> 2) + 4 * n + (i & 3); }

struct Unit { int pm, pn; };
struct Gemm { const bf16_t* A; const bf16_t* Bt; int M, N, K; };

struct StaticOrder {
    int nM, nN, nwg, G, c;
    __host__ __device__ void init(int M, int N, int G_, int c_) { nM = M / BM; nN = N / BM; nwg = nM * nN; G = G_; c = c_; }
    __host__ __device__ bool next(int i, Unit& u) const {
        const long L = (long)i * G + c; if (L >= nwg) return false;
        int wgid = (int)L; { const int q = nwg / NXCD, r = nwg % NXCD, xcd = wgid % NXCD, off = wgid / NXCD; wgid = (xcd < r ? xcd * (q + 1) : r * (q + 1) + (xcd - r) * q) + off; }
        const int nig = WGM * nN, gid = wgid / nig, fm = gid * WGM, gsz = (nM - fm) < WGM ? (nM - fm) : WGM;
        u.pm = fm + ((wgid % nig) % gsz); u.pn = (wgid % nig) / gsz; return true;
    }
    __device__ __forceinline__ void a_ready(const Unit&) const {}
    __device__ __forceinline__ void done(const Unit&) const {}
};
__device__ __forceinline__ unsigned cvt_pk_bf16(float lo, float hi) { unsigned r; asm volatile("v_cvt_pk_bf16_f32 %0, %1, %2" : "=v"(r) : "v"(lo), "v"(hi)); return r; }
template <class Epi, class Sched, bool STAMP = false>
__device__ __forceinline__ void gemm_phase(PG8_LAS unsigned char* lds, const Gemm g, const Sched& S, const Epi& E, unsigned long long* stamps) {
    const int tid = tidx(), wid = __builtin_amdgcn_readfirstlane(tid >> 6), lane = tid & 63, wr = wid >> 2, wc = wid & 3, fr = lane & 15, fq = lane >> 4;
    const int K = g.K, nt = K / BK;
    int ts_lo = 0, ts_hi = 0, nts = 0; const unsigned long long rt_entry = STAMP ? (unsigned long long)wall_clock64() : 0ull;
#define PG8_STAMP() do { if (STAMP && wid == 0 && nts < 64) { const unsigned long long _c = (unsigned long long)clock64(); \
        ts_lo = (lane == nts) ? (int)(unsigned)_c : ts_lo; ts_hi = (lane == nts) ? (int)(unsigned)(_c >> 32) : ts_hi; ++nts; } } while (0)
    PG8_STAMP();
    unsigned voffA[2], voffB[2];
#pragma unroll
    for (int i = 0; i < 2; ++i) { int R, C; stage_rc(tid * 16 + i * 8192, R, C); const int Rb = Epi::PERM ? ((R & ~31) + perm32(R & 31)) : R;
        voffA[i] = (unsigned)(R * K + C) * 2u; voffB[i] = (unsigned)(Rb * K + C) * 2u; }
    const size_t kstep = (size_t)(BK * 2);
    const size_t hstep = (size_t)HALF * K * 2;
    const size_t tstep = 2 * hstep;
    const unsigned ldsw = (unsigned)wid * 1024u;
    const int aoff = lds_byte(wr * 64 + fr, fq * 8), boff = lds_byte(wc * 32 + fr, fq * 8);
#define PG8_SA(b, h) (((b) * 2 + (h)) * HTB)
#define PG8_SB(b, h) ((4 + (b) * 2 + (h)) * HTB)
#define PG8_STAGE(bufoff, gbase, voff) do { _Pragma("unroll") for (int _i = 0; _i < 2; ++_i) \
        __builtin_amdgcn_global_load_lds((const unsigned*)((const char*)(gbase) + (voff)[_i]), (PG8_LAS unsigned*)(lds + (bufoff) + ldsw + _i * 8192), 16, 0, 0); } while (0)
#define PG8_LDA(dst, b, h) do { _Pragma("unroll") for (int m = 0; m < 4; ++m) _Pragma("unroll") for (int k = 0; k < 2; ++k) dst[m][k] = *(const PG8_LAS bf16x8*)(lds + PG8_SA(b, h) + aoff + m * 2048 + k * 1024); } while (0)
#define PG8_LDB(dst, b, h) do { _Pragma("unroll") for (int n = 0; n < 2; ++n) _Pragma("unroll") for (int k = 0; k < 2; ++k) dst[n][k] = *(const PG8_LAS bf16x8*)(lds + PG8_SB(b, h) + boff + n * 2048 + k * 1024); } while (0)
#define PG8_MMA(ai, bj, At, Bt) do { __builtin_amdgcn_s_setprio(1); _Pragma("unroll") for (int m = 0; m < 4; ++m) _Pragma("unroll") for (int n = 0; n < 2; ++n) _Pragma("unroll") for (int k = 0; k < 2; ++k) \
        acc[ai][bj][m][n] = __builtin_amdgcn_mfma_f32_16x16x32_bf16(Bt[n][k], At[m][k], acc[ai][bj][m][n], 0, 0, 0); __builtin_amdgcn_s_setprio(0); } while (0)
#define PG8_WAIT_V(n) asm volatile("s_waitcnt vmcnt(" #n ")" ::: "memory")
#define PG8_WAIT_L(n) asm volatile("s_waitcnt lgkmcnt(" #n ")" ::: "memory")
#define PG8_BAR __builtin_amdgcn_s_barrier()
#define PG8_SCHED __builtin_amdgcn_sched_barrier(0)
    Unit cur, nxt; int ui = 0;
    if (!S.next(0, cur)) return;
    f32x4 acc[2][2][4][2];
#pragma unroll
    for (int a = 0; a < 2; ++a)
#pragma unroll
        for (int b = 0; b < 2; ++b)
#pragma unroll
            for (int m = 0; m < 4; ++m)
#pragma unroll
                for (int n = 0; n < 2; ++n) acc[a][b][m][n] = (f32x4){0.f, 0.f, 0.f, 0.f};
    bf16x8 At[4][2], B0[2][2], B1[2][2];
    const char* cA = (const char*)g.A + (size_t)cur.pm * tstep; const char* cB = (const char*)g.Bt + (size_t)cur.pn * tstep;
    S.a_ready(cur);
    PG8_STAGE(PG8_SB(0, 0), cB, voffB); PG8_STAGE(PG8_SA(0, 0), cA, voffA); PG8_STAGE(PG8_SB(0, 1), cB + hstep, voffB); PG8_STAGE(PG8_SA(0, 1), cA + hstep, voffA);
    if (wr == 1) PG8_BAR;
    PG8_WAIT_V(4); PG8_BAR;
    PG8_STAGE(PG8_SB(1, 0), cB + kstep, voffB); PG8_STAGE(PG8_SA(1, 0), cA + kstep, voffA); PG8_STAGE(PG8_SB(1, 1), cB + hstep + kstep, voffB);
    PG8_WAIT_V(6); PG8_BAR;
    PG8_STAMP();
    for (;;) {
        const bool has_next = S.next(ui + 1, nxt);
        const char* nA = has_next ? (const char*)g.A + (size_t)nxt.pm * tstep : cA; const char* nB = has_next ? (const char*)g.Bt + (size_t)nxt.pn * tstep : cB;
        for (int t = 0; t < nt; t += 2) {
            const bool last = (t == nt - 2);
            const char* a1 = cA + (size_t)(t + 1) * kstep;
            const char* a2 = last ? nA : cA + (size_t)(t + 2) * kstep; const char* b2 = last ? nB : cB + (size_t)(t + 2) * kstep;
            const char* a3 = a2 + kstep; const char* b3 = b2 + kstep;
            if (last && has_next) S.a_ready(nxt);
            PG8_LDB(B0, 0, 0); PG8_SCHED; PG8_LDA(At, 0, 0); PG8_STAGE(PG8_SA(1, 1), a1 + hstep, voffA);
            PG8_WAIT_L(8); PG8_BAR; PG8_WAIT_L(0); PG8_MMA(0, 0, At, B0); PG8_BAR; PG8_SCHED;
            PG8_LDB(B1, 0, 1); PG8_STAGE(PG8_SB(0, 0), b2, voffB);
            PG8_BAR; PG8_WAIT_L(0); PG8_MMA(0, 1, At, B1); PG8_BAR;
            PG8_LDA(At, 0, 1); PG8_STAGE(PG8_SA(0, 0), a2, voffA);
            PG8_BAR; PG8_WAIT_L(0); PG8_MMA(1, 0, At, B0); PG8_BAR; PG8_SCHED;
            PG8_STAGE(PG8_SB(0, 1), b2 + hstep, voffB);
            PG8_WAIT_V(6); PG8_BAR; PG8_MMA(1, 1, At, B1); PG8_BAR;
            PG8_LDB(B0, 1, 0); PG8_SCHED; PG8_LDA(At, 1, 0); PG8_STAGE(PG8_SA(0, 1), a2 + hstep, voffA);
            PG8_WAIT_L(8); PG8_BAR; PG8_WAIT_L(0); PG8_MMA(0, 0, At, B0); PG8_BAR; PG8_SCHED;
            PG8_LDB(B1, 1, 1); PG8_STAGE(PG8_SB(1, 0), b3, voffB);
            PG8_BAR; PG8_WAIT_L(0); PG8_MMA(0, 1, At, B1); PG8_BAR;
            PG8_LDA(At, 1, 1); PG8_STAGE(PG8_SA(1, 0), a3, voffA);
            PG8_BAR; PG8_WAIT_L(0); PG8_MMA(1, 0, At, B0); PG8_BAR; PG8_SCHED;
            PG8_STAGE(PG8_SB(1, 1), b3 + hstep, voffB);
            PG8_WAIT_V(6); PG8_BAR; PG8_MMA(1, 1, At, B1); PG8_BAR;
        }
        PG8_STAMP();
        if constexpr (!Epi::AFTER_DRAIN) { E(acc, cur, wr, wc, fr, fq); S.done(cur); }
        PG8_STAMP();
        if (!has_next) break;
#pragma unroll
        for (int a = 0; a < 2; ++a)
#pragma unroll
            for (int b = 0; b < 2; ++b)
#pragma unroll
                for (int m = 0; m < 4; ++m)
#pragma unroll
                    for (int n = 0; n < 2; ++n) acc[a][b][m][n] = (f32x4){0.f, 0.f, 0.f, 0.f};
        cur = nxt; cA = nA; cB = nB; ++ui;
    }
    PG8_WAIT_V(0);
    if (wr == 0) PG8_BAR;
    PG8_BAR;
    if constexpr (Epi::AFTER_DRAIN) { E.fused(acc, cur, wr, wc, fr, fq, lds, wid, lane); S.done(cur); }
    PG8_STAMP();
    if (STAMP && wid == 0) { stamps[lane] = lane < nts ? (((unsigned long long)(unsigned)ts_hi << 32) | (unsigned)ts_lo) : 0ull;
        if (lane == 62) stamps[62] = rt_entry; if (lane == 63) stamps[63] = (unsigned long long)wall_clock64(); }
#undef PG8_STAMP
#undef PG8_SA
#undef PG8_SB
#undef PG8_STAGE
#undef PG8_LDA
#undef PG8_LDB
#undef PG8_MMA
#undef PG8_WAIT_V
#undef PG8_WAIT_L
#undef PG8_BAR
#undef PG8_SCHED
}
}

namespace {
using pg8::bf16_t;
typedef float f32x4 __attribute__((ext_vector_type(4)));
typedef unsigned u32x4 __attribute__((ext_vector_type(4)));

constexpr int NB = 16, NL = 2048, ND = 1024, NT = NB * NL;
constexpr int EVEN_IN = 2560, ODD_IN = 2608, ODD_PAD = 2304;
constexpr float ALPHA = 1.41421356237f;
constexpr float LN_EPS = 1e-5f;
constexpr int NTHR = 512;
constexpr int LDS_BYTES = 163840;
#ifndef PHMASK
#define PHMASK 0xFFFFFFFFu
#endif
#define PH(n) if (PHMASK & (1u << (n)))

__device__ __forceinline__ float bf2f(bf16_t v) { return __uint_as_float((unsigned)v << 16); }
__device__ __forceinline__ bf16_t f2bf(float f) { unsigned u = __float_as_uint(f); u += 0x7FFFu + ((u >> 16) & 1u); return (bf16_t)(u >> 16); }
__device__ __forceinline__ unsigned pack2(float lo, float hi) { return (unsigned)f2bf(lo) | ((unsigned)f2bf(hi) << 16); }
__device__ __forceinline__ void ld8(const bf16_t* p, float* o) {
    const uint4 v = *(const uint4*)p;
    o[0] = __uint_as_float(v.x << 16); o[1] = __uint_as_float(v.x & 0xffff0000u);
    o[2] = __uint_as_float(v.y << 16); o[3] = __uint_as_float(v.y & 0xffff0000u);
    o[4] = __uint_as_float(v.z << 16); o[5] = __uint_as_float(v.z & 0xffff0000u);
    o[6] = __uint_as_float(v.w << 16); o[7] = __uint_as_float(v.w & 0xffff0000u);
}
__device__ __forceinline__ void st8(bf16_t* p, const float* o) {
    uint4 v; v.x = pack2(o[0], o[1]); v.y = pack2(o[2], o[3]); v.z = pack2(o[4], o[5]); v.w = pack2(o[6], o[7]);
    *(uint4*)p = v;
}

struct EpiBf16s {
    static constexpr bool PERM = true, AFTER_DRAIN = false;
    bf16_t* O; int ldc;
    __device__ __forceinline__ void operator()(const f32x4 (&acc)[2][2][4][2], const pg8::Unit& u, int wr, int wc, int fr, int fq) const {
        const int row0 = u.pm * 256 + wr * 64 + fr, col0 = u.pn * 256 + wc * 32 + 8 * fq;
#pragma unroll
        for (int ai = 0; ai < 2; ++ai)
#pragma unroll
            for (int m = 0; m < 4; ++m) { bf16_t* rowp = O + (size_t)(row0 + ai * 128 + m * 16) * ldc + col0;
#pragma unroll
                for (int bj = 0; bj < 2; ++bj) { const f32x4 v0 = acc[ai][bj][m][0], v1 = acc[ai][bj][m][1];
                    u32x4 w; w.x = pg8::cvt_pk_bf16(v0[0], v0[1]); w.y = pg8::cvt_pk_bf16(v0[2], v0[3]); w.z = pg8::cvt_pk_bf16(v1[0], v1[1]); w.w = pg8::cvt_pk_bf16(v1[2], v1[3]);
                    *(u32x4*)(rowp + bj * 128) = w; } }
    }
};
struct EpiRes {
    static constexpr bool PERM = false, AFTER_DRAIN = false;
    float* C; int ldc; float alpha;
    __device__ __forceinline__ void operator()(const f32x4 (&acc)[2][2][4][2], const pg8::Unit& u, int wr, int wc, int fr, int fq) const {
        const int row0 = u.pm * 256 + wr * 64 + fr, col0 = u.pn * 256 + wc * 32 + 4 * fq;
#pragma unroll
        for (int ai = 0; ai < 2; ++ai)
#pragma unroll
            for (int m = 0; m < 4; ++m) { float* rowp = C + (size_t)(row0 + ai * 128 + m * 16) * ldc + col0;
#pragma unroll
                for (int bj = 0; bj < 2; ++bj)
#pragma unroll
                    for (int n = 0; n < 2; ++n) { f32x4* cp = (f32x4*)(rowp + bj * 128 + n * 16); *cp = *cp * alpha + acc[ai][bj][m][n]; } }
    }
};
template <class Epi>
__device__ __forceinline__ void gemm_bf16_phase(unsigned char* lds, const bf16_t* A, const bf16_t* Bt, int M, int N, int K, const Epi& E) {
    pg8::Gemm g{A, Bt, M, N, K};
    pg8::StaticOrder S; S.init(M, N, (int)gridDim.x, (int)blockIdx.x);
    pg8::gemm_phase<Epi, pg8::StaticOrder, false>((PG8_LAS unsigned char*)lds, g, S, E, nullptr);
    __syncthreads();
}

struct ColMap { int d0[3], s0[3], len[3]; };
__device__ __forceinline__ void convert_wt_phase(const float* __restrict__ W, int K, int N, int Npad, const ColMap cm, bf16_t* __restrict__ Wt, float* lds) {
    float(*tile)[65] = (float(*)[65])lds;
    const int tid = tidx(), ntn = Npad / 64, ntiles = (K / 64) * ntn;
    for (int it = blockIdx.x; it < ntiles; it += gridDim.x) {
        const int k0 = (it / ntn) * 64, n0 = (it % ntn) * 64;
        __syncthreads();
#pragma unroll
        for (int h = 0; h < 2; ++h) {
            const int r = (tid >> 4) + h * 32, c4 = (tid & 15) * 4, nd = n0 + c4;
            int ns = -1;
#pragma unroll
            for (int sg = 0; sg < 3; ++sg) if (nd >= cm.d0[sg] && nd < cm.d0[sg] + cm.len[sg]) ns = cm.s0[sg] + (nd - cm.d0[sg]);
            float4 v = make_float4(0.f, 0.f, 0.f, 0.f);
            if (ns >= 0) v = *(const float4*)(W + (size_t)(k0 + r) * N + ns);
            tile[r][c4] = v.x; tile[r][c4 + 1] = v.y; tile[r][c4 + 2] = v.z; tile[r][c4 + 3] = v.w;
        }
        __syncthreads();
        const int n = tid >> 3, k8 = (tid & 7) * 8;
        float o[8];
#pragma unroll
        for (int j = 0; j < 8; ++j) o[j] = tile[k8 + j][n];
        st8(Wt + (size_t)(n0 + n) * K + k0 + k8, o);
    }
    __syncthreads();
}
__device__ __forceinline__ float gelu_tanh(float x) {
    float u = 0.7978845608028654f * (x + 0.044715f * x * x * x);
    return 0.5f * x * (1.f + tanhf(u));
}
__device__ __forceinline__ float sigmoidf_(float x) { return 1.f / (1.f + expf(-x)); }
__device__ __forceinline__ void wave_lds_fence() { asm volatile("s_waitcnt lgkmcnt(0)" ::: "memory"); }

__device__ __forceinline__ void s5_scan_wave(int bg, const bf16_t* __restrict__ proj, const float* __restrict__ lam_re, const float* __restrict__ lam_im,
                             const float* __restrict__ log_dt, const float* __restrict__ b_re, const float* __restrict__ b_im,
                             const float* __restrict__ c_re, const float* __restrict__ c_im, const float* __restrict__ dskip,
                             float* __restrict__ ya, float* lds) {
    const int b = bg >> 4, g = bg & 15, lane = tidx() & 63;
    float(*us)[16] = (float(*)[16])lds;
    float(*xr)[65] = (float(*)[65])(lds + 1024);
    float(*xi)[65] = (float(*)[65])(lds + 1024 + 4160);
    float(*cr)[64] = (float(*)[64])(lds + 1024 + 8320);
    float(*ci)[64] = (float(*)[64])(lds + 1024 + 8320 + 1024);
    const float lr = lam_re[g * 64 + lane], li = lam_im[g * 64 + lane];
    const float dt = expf(log_dt[g]);
    const float mag = expf(lr * dt);
    const float are = mag * cosf(li * dt), aim = mag * sinf(li * dt);
    const float nr = are - 1.f, den = lr * lr + li * li;
    const float fre = (nr * lr + aim * li) / den, fim = (aim * lr - nr * li) / den;
    float bbr[16], bbi[16];
#pragma unroll
    for (int i = 0; i < 16; ++i) {
        const float br = b_re[(g * 64 + lane) * 16 + i], bi = b_im[(g * 64 + lane) * 16 + i];
        bbr[i] = fre * br - fim * bi; bbi[i] = fre * bi + fim * br;
    }
    for (int idx = lane; idx < 1024; idx += 64) { cr[idx >> 6][idx & 63] = c_re[g * 1024 + idx]; ci[idx >> 6][idx & 63] = c_im[g * 1024 + idx]; }
    float dsk[16];
#pragma unroll
    for (int i = 0; i < 16; ++i) dsk[i] = dskip[g * 16 + i];
    float xre = 0.f, xim = 0.f;
    for (int t0 = 0; t0 < NL; t0 += 64) {
        wave_lds_fence();
        for (int idx = lane; idx < 1024; idx += 64) { const int t = idx >> 4, i = idx & 15; us[t][i] = bf2f(proj[(size_t)(b * NL + t0 + t) * EVEN_IN + g * 16 + i]); }
        wave_lds_fence();
        for (int t = 0; t < 64; ++t) {
            float bur = 0.f, bui = 0.f;
#pragma unroll
            for (int i = 0; i < 16; ++i) { const float u = us[t][i]; bur += bbr[i] * u; bui += bbi[i] * u; }
            const float nre = are * xre - aim * xim + bur, nim = are * xim + aim * xre + bui;
            xre = nre; xim = nim;
            xr[t][lane] = xre; xi[t][lane] = xim;
        }
        wave_lds_fence();
        float y[16];
#pragma unroll
        for (int i = 0; i < 16; ++i) y[i] = 0.f;
        for (int p = 0; p < 64; ++p) {
            const float a = xr[lane][p], bq = xi[lane][p];
#pragma unroll
            for (int i = 0; i < 16; ++i) y[i] += cr[i][p] * a - ci[i][p] * bq;
        }
#pragma unroll
        for (int i = 0; i < 16; ++i) {
            const float v = y[i] + dsk[i] * us[lane][i];
            ya[(size_t)(b * NL + t0 + lane) * 256 + g * 16 + i] = gelu_tanh(v);
        }
    }
}

__device__ __forceinline__ void sb_attn_wave(int task, const bf16_t* __restrict__ proj, bf16_t* __restrict__ Y, float* wl) {
    const int qt = task & 31, h = (task >> 5) % 12, b = task / 384, lane = tidx() & 63;
    const int t = qt * 64 + lane;
    float(*ks)[64] = (float(*)[64])wl;
    float(*vs)[64] = (float(*)[64])(wl + 2048);
    const bf16_t* base = proj + (size_t)b * NL * EVEN_IN;
    float q[64], acc[64];
#pragma unroll
    for (int d = 0; d < 64; d += 8) ld8(base + (size_t)t * EVEN_IN + 256 + h * 64 + d, q + d);
#pragma unroll
    for (int d = 0; d < 64; ++d) acc[d] = 0.f;
    float tail = 0.f;
    for (int c = 2 * qt + 1; c >= 0; --c) {
        wave_lds_fence();
        for (int i = 0; i < 32; ++i) {
            ks[i][lane] = bf2f(base[(size_t)(c * 32 + i) * EVEN_IN + 1024 + h * 64 + lane]);
            vs[i][lane] = bf2f(base[(size_t)(c * 32 + i) * EVEN_IN + 1792 + h * 64 + lane]);
        }
        wave_lds_fence();
        for (int s = 31; s >= 0; --s) {
            const int key = c * 32 + s;
            float z = 0.f;
#pragma unroll
            for (int d = 0; d < 64; ++d) z += q[d] * ks[s][d];
            z *= 0.125f;
            const bool valid = key < t;
            const float sp = fmaxf(z, 0.f) + log1pf(expf(-fabsf(z)));
            const float w = valid ? expf(z - sp + tail) : 0.f;
#pragma unroll
            for (int d = 0; d < 64; ++d) acc[d] += w * vs[s][d];
            if (valid) tail -= sp;
        }
        if (__all(tail < -120.f)) break;
    }
#pragma unroll
    for (int d = 0; d < 64; d += 8) st8(Y + (size_t)(b * NL + t) * ND + 256 + h * 64 + d, acc + d);
}

__device__ __forceinline__ void glu_phase(const float* __restrict__ ya, const float* __restrict__ wglu, const float* __restrict__ bglu, bf16_t* __restrict__ Y, float* lds) {
    const int half = tidx() >> 8, c = tidx() & 255;
    float(*ys)[256] = (float(*)[256])(lds + half * 4096);
    for (int it = blockIdx.x; it < NT / 32; it += gridDim.x) {
        const int t0 = it * 32 + half * 16;
        __syncthreads();
        for (int i = 0; i < 16; ++i) ys[i][c] = ya[(size_t)(t0 + i) * 256 + c];
        __syncthreads();
        float acc[16];
#pragma unroll
        for (int i = 0; i < 16; ++i) acc[i] = 0.f;
        for (int k = 0; k < 256; ++k) {
            const float w = wglu[k * 256 + c];
#pragma unroll
            for (int i = 0; i < 16; ++i) acc[i] += ys[i][k] * w;
        }
        const float bb = bglu[c];
#pragma unroll
        for (int i = 0; i < 16; ++i) Y[(size_t)(t0 + i) * ND + c] = f2bf(ys[i][c] * sigmoidf_(acc[i] + bb));
    }
    __syncthreads();
}

__device__ __forceinline__ void ln_row_wave(float4 (&v)[4], const float* __restrict__ g, const float* __restrict__ bta, float* out, bf16_t* outb, int lane) {
    float s = 0.f;
#pragma unroll
    for (int j = 0; j < 4; ++j) s += v[j].x + v[j].y + v[j].z + v[j].w;
    for (int o = 32; o; o >>= 1) s += __shfl_xor(s, o);
    const float mean = s * (1.f / ND);
    float s2 = 0.f;
#pragma unroll
    for (int j = 0; j < 4; ++j) {
        v[j].x -= mean; v[j].y -= mean; v[j].z -= mean; v[j].w -= mean;
        s2 += v[j].x * v[j].x + v[j].y * v[j].y + v[j].z * v[j].z + v[j].w * v[j].w;
    }
    for (int o = 32; o; o >>= 1) s2 += __shfl_xor(s2, o);
    const float rs = rsqrtf(s2 * (1.f / ND) + LN_EPS);
#pragma unroll
    for (int j = 0; j < 4; ++j) {
        const float4 gg = *(const float4*)(g + j * 256 + lane * 4), bb = *(const float4*)(bta + j * 256 + lane * 4);
        const float4 o = make_float4(v[j].x * rs * gg.x + bb.x, v[j].y * rs * gg.y + bb.y, v[j].z * rs * gg.z + bb.z, v[j].w * rs * gg.w + bb.w);
        *(float4*)(out + j * 256 + lane * 4) = o;
        if (outb) { uint2 w; w.x = pack2(o.x, o.y); w.y = pack2(o.z, o.w); *(uint2*)(outb + j * 256 + lane * 4) = w; }
    }
}
__device__ __forceinline__ void ln_phase(float* R, bf16_t* Hb, const float* __restrict__ g, const float* __restrict__ bta) {
    const int wave = tidx() >> 6, lane = tidx() & 63;
    for (int row = blockIdx.x * 8 + wave; row < NT; row += gridDim.x * 8) {
        float4 v[4];
#pragma unroll
        for (int j = 0; j < 4; ++j) v[j] = *(const float4*)(R + (size_t)row * ND + j * 256 + lane * 4);
        ln_row_wave(v, g, bta, R + (size_t)row * ND, Hb + (size_t)row * ND, lane);
    }
}

__device__ __forceinline__ void wave_argmax(float& bv, int& bi) {
#pragma unroll
    for (int o = 32; o; o >>= 1) {
        const float ov = __shfl_xor(bv, o); const int oi = __shfl_xor(bi, o);
        if (ov > bv || (ov == bv && oi < bi)) { bv = ov; bi = oi; }
    }
}
__device__ __forceinline__ void peer_route_phase(const bf16_t* __restrict__ qbuf, const float* __restrict__ subk, int* __restrict__ eidx, float* __restrict__ egate, float* lds) {
    const int head = tidx() >> 6, lane = tidx() & 63;
    float* qs = lds + head * 256;
    for (int token = blockIdx.x; token < NT; token += gridDim.x) {
        const bf16_t* qp = qbuf + (size_t)token * 2048 + head * 256;
        wave_lds_fence();
        for (int i = 0; i < 4; ++i) qs[lane + 64 * i] = bf2f(qp[lane + 64 * i]);
        wave_lds_fence();
        float myv[2]; int myi[2];
#pragma unroll
        for (int c = 0; c < 2; ++c) {
            float sc[2];
#pragma unroll
            for (int w2 = 0; w2 < 2; ++w2) {
                const float* kr = subk + ((size_t)(head * 2 + c) * 128 + lane + 64 * w2) * 128;
                float a = 0.f;
#pragma unroll 4
                for (int d = 0; d < 128; d += 4) {
                    const float4 kv = *(const float4*)(kr + d);
                    a += qs[c * 128 + d] * kv.x + qs[c * 128 + d + 1] * kv.y + qs[c * 128 + d + 2] * kv.z + qs[c * 128 + d + 3] * kv.w;
                }
                sc[w2] = a;
            }
            float a0 = sc[0], a1 = sc[1];
            float mv = -INFINITY; int mi = 0;
            for (int r = 0; r < 16; ++r) {
                float bv; int bi;
                if (a0 >= a1) { bv = a0; bi = lane; } else { bv = a1; bi = lane + 64; }
                wave_argmax(bv, bi);
                if (lane == r) { mv = bv; mi = bi; }
                if (bi == lane) a0 = -INFINITY; else if (bi == lane + 64) a1 = -INFINITY;
            }
            myv[c] = mv; myi[c] = mi;
        }
        const float va = __shfl(myv[0], lane >> 2);
        float cand[4];
#pragma unroll
        for (int j = 0; j < 4; ++j) cand[j] = va + __shfl(myv[1], (lane & 3) * 4 + j);
        float topv = -INFINITY; int topf = 0;
        for (int r = 0; r < 16; ++r) {
            float bv = cand[0]; int bi = lane * 4;
#pragma unroll
            for (int j = 1; j < 4; ++j) if (cand[j] > bv) { bv = cand[j]; bi = lane * 4 + j; }
            wave_argmax(bv, bi);
            if (lane == r) { topv = bv; topf = bi; }
#pragma unroll
            for (int j = 0; j < 4; ++j) if (bi == lane * 4 + j) cand[j] = -INFINITY;
        }
        const int e1 = __shfl(myi[0], topf >> 4), e2 = __shfl(myi[1], topf & 15);
        const float top0 = __shfl(topv, 0);
        float ex = (lane < 16) ? expf(topv - top0) : 0.f;
        float sum = ex;
        for (int o = 32; o; o >>= 1) sum += __shfl_xor(sum, o);
        if (lane < 16) {
            eidx[(size_t)token * 128 + head * 16 + lane] = e1 * 128 + e2;
            egate[(size_t)token * 128 + head * 16 + lane] = ex / sum;
        }
    }
}

__device__ __forceinline__ void peer_expert_phase(float* R, const int* __restrict__ eidx, const float* __restrict__ egate, const float* __restrict__ utab,
                                  const float* __restrict__ vtab, const float* __restrict__ lg, const float* __restrict__ lb, bf16_t* Hb) {
    const int wave = tidx() >> 6, lane = tidx() & 63;
    for (int token = blockIdx.x * 8 + wave; token < NT; token += gridDim.x * 8) {
        float4 x[4], acc[4];
#pragma unroll
        for (int j = 0; j < 4; ++j) { x[j] = *(const float4*)(R + (size_t)token * ND + j * 256 + lane * 4); acc[j] = make_float4(0.f, 0.f, 0.f, 0.f); }
        for (int e0 = 0; e0 < 128; e0 += 4) {
            float dot[4]; int ex[4]; float gt[4];
#pragma unroll
            for (int k = 0; k < 4; ++k) {
                ex[k] = eidx[(size_t)token * 128 + e0 + k]; gt[k] = egate[(size_t)token * 128 + e0 + k];
                const float* ur = utab + (size_t)ex[k] * ND + lane * 4;
                float a = 0.f;
#pragma unroll
                for (int j = 0; j < 4; ++j) { const float4 u = *(const float4*)(ur + j * 256); a += x[j].x * u.x + x[j].y * u.y + x[j].z * u.z + x[j].w * u.w; }
                dot[k] = a;
            }
#pragma unroll
            for (int k = 0; k < 4; ++k) {
                float a = dot[k];
                for (int o = 32; o; o >>= 1) a += __shfl_xor(a, o);
                const float coef = gt[k] * gelu_tanh(a);
                const float* vr = vtab + (size_t)ex[k] * ND + lane * 4;
#pragma unroll
                for (int j = 0; j < 4; ++j) { const float4 v = *(const float4*)(vr + j * 256); acc[j].x += coef * v.x; acc[j].y += coef * v.y; acc[j].z += coef * v.z; acc[j].w += coef * v.w; }
            }
        }
#pragma unroll
        for (int j = 0; j < 4; ++j) { x[j].x = ALPHA * x[j].x + acc[j].x; x[j].y = ALPHA * x[j].y + acc[j].y; x[j].z = ALPHA * x[j].z + acc[j].z; x[j].w = ALPHA * x[j].w + acc[j].w; }
        ln_row_wave(x, lg, lb, R + (size_t)token * ND, Hb ? Hb + (size_t)token * ND : nullptr, lane);
    }
}


typedef short bf16x8_t __attribute__((ext_vector_type(8)));
__device__ __forceinline__ int f2key(float f) { const int b = __float_as_int(f); return b ^ ((b >> 31) & 0x7fffffff); }
__device__ __forceinline__ float key2f(int k) { return __int_as_float(k ^ ((k >> 31) & 0x7fffffff)); }
#define CE_DESC_I(a, b) do { const int _hi = max(a, b), _lo = min(a, b); a = _hi; b = _lo; } while (0)
template <int N, int K, int J> __device__ __forceinline__ void bstage(int (&v)[N]) {
#pragma unroll
    for (int i = 0; i < N; ++i) {
        const int l = i ^ J;
        if (l > i) { if ((i & K) == 0) CE_DESC_I(v[i], v[l]); else CE_DESC_I(v[l], v[i]); }
    }
}
__device__ __forceinline__ void sort16_desc(int (&v)[16]) {
    bstage<16, 2, 1>(v); bstage<16, 4, 2>(v); bstage<16, 4, 1>(v); bstage<16, 8, 4>(v); bstage<16, 8, 2>(v); bstage<16, 8, 1>(v);
    bstage<16, 16, 8>(v); bstage<16, 16, 4>(v); bstage<16, 16, 2>(v); bstage<16, 16, 1>(v);
}
__device__ __forceinline__ void sort8_desc(int (&v)[8]) {
    bstage<8, 2, 1>(v); bstage<8, 4, 2>(v); bstage<8, 4, 1>(v); bstage<8, 8, 4>(v); bstage<8, 8, 2>(v); bstage<8, 8, 1>(v);
}
__device__ __forceinline__ void bitonic_merge16_desc(int (&v)[16]) {
    bstage<16, 16, 8>(v); bstage<16, 16, 4>(v); bstage<16, 16, 2>(v); bstage<16, 16, 1>(v);
}
__device__ __forceinline__ void xmerge16(int (&v)[16], int off) {
    int m[16];
#pragma unroll
    for (int i = 0; i < 16; ++i) m[i] = max(v[i], __shfl_xor(v[15 - i], off));
    bitonic_merge16_desc(m);
#pragma unroll
    for (int i = 0; i < 16; ++i) v[i] = m[i];
}
__device__ __forceinline__ void opaque16(int (&v)[16]) {
#pragma unroll
    for (int i = 0; i < 16; ++i) asm volatile("" : "+v"(v[i]));
}
__device__ __forceinline__ int lookup16(const int (&arr)[16], int a) {
    int r = arr[0];
#pragma unroll
    for (int i = 1; i < 16; ++i) r = (a == i) ? arr[i] : r;
    return r;
}
__device__ __forceinline__ void peer_route2_phase(const bf16_t* __restrict__ qbuf, const bf16_t* __restrict__ skb, int* __restrict__ eidx, float* __restrict__ egate, unsigned char* lds) {
    const int tid = tidx(), wave = tid >> 6, lane = tid & 63, fr = lane & 15, fq = lane >> 4;
    for (int chunk = blockIdx.x; chunk < NT / 128; chunk += gridDim.x) {
        const int token = chunk * 128 + wave * 16 + fr;
        int* tl = (int*)(lds + 34816) + (wave * 16 + fr) * 48;
        for (int h = 0; h < 8; ++h) {
            int K1[16], K2[16];
#pragma unroll
            for (int c = 0; c < 2; ++c) {
                __syncthreads();
#pragma unroll
                for (int i = 0; i < 4; ++i) {
                    const int idx = tid + 512 * i, row = idx >> 4, ch = idx & 15;
                    *(uint4*)(lds + row * 272 + ch * 16) = *(const uint4*)(skb + ((size_t)(h * 2 + c) * 128 + row) * 128 + ch * 8);
                }
                __syncthreads();
                bf16x8_t qf[4];
#pragma unroll
                for (int sI = 0; sI < 4; ++sI) qf[sI] = *(const bf16x8_t*)(qbuf + (size_t)token * 2048 + h * 256 + c * 128 + 32 * sI + 8 * fq);
                int va[16], vb[16];
#pragma unroll
                for (int n = 0; n < 8; ++n) {
                    f32x4 S = {0.f, 0.f, 0.f, 0.f};
#pragma unroll
                    for (int sI = 0; sI < 4; ++sI) {
                        const bf16x8_t kf = *(const bf16x8_t*)(lds + (16 * n + fr) * 272 + (32 * sI + 8 * fq) * 2);
                        S = __builtin_amdgcn_mfma_f32_16x16x32_bf16(kf, qf[sI], S, 0, 0, 0);
                    }
#pragma unroll
                    for (int j = 0; j < 4; ++j) {
                        const int key = (f2key(S[j]) & ~127) | (16 * n + 4 * fq + j);
                        if (n < 4) va[n * 4 + j] = key; else vb[(n - 4) * 4 + j] = key;
                    }
                }
                sort16_desc(va); sort16_desc(vb);
                int m[16];
#pragma unroll
                for (int i = 0; i < 16; ++i) m[i] = max(va[i], vb[15 - i]);
                bitonic_merge16_desc(m);
                xmerge16(m, 16); xmerge16(m, 32);
#pragma unroll
                for (int i = 0; i < 16; ++i) { if (c == 0) K1[i] = m[i]; else K2[i] = m[i]; }
                if (fq == 0) {
#pragma unroll
                    for (int i = 0; i < 4; ++i) *(int4*)(tl + c * 16 + 4 * i) = make_int4(m[4 * i], m[4 * i + 1], m[4 * i + 2], m[4 * i + 3]);
                }
            }
            wave_lds_fence();
            float vaf[4];
#pragma unroll
            for (int k = 0; k < 4; ++k) vaf[k] = key2f(tl[4 * k + fq]);
            int A[16];
#pragma unroll
            for (int b = 0; b < 16; ++b) {
                const bool valid = (fq + 1) * (b + 1) <= 16;
                const int key = (f2key(vaf[0] + key2f(K2[b])) & ~127) | (fq << 5) | b;
                A[b] = valid ? key : INT_MIN;
            }
            int Bq[8];
#pragma unroll
            for (int b = 0; b < 3; ++b) {
                const bool valid = (fq + 5) * (b + 1) <= 16;
                const int key = (f2key(vaf[1] + key2f(K2[b])) & ~127) | (fq << 5) | (16 + b);
                Bq[b] = valid ? key : INT_MIN;
            }
            Bq[3] = (f2key(vaf[2] + key2f(K2[0])) & ~127) | (fq << 5) | 19;
            Bq[4] = (f2key(vaf[3] + key2f(K2[0])) & ~127) | (fq << 5) | 20;
            Bq[5] = INT_MIN; Bq[6] = INT_MIN; Bq[7] = INT_MIN;
            sort8_desc(Bq);
#pragma unroll
            for (int i = 8; i < 16; ++i) A[i] = max(A[i], Bq[15 - i]);
            bitonic_merge16_desc(A);
            xmerge16(A, 16); xmerge16(A, 32);
            if (fq == 0) {
#pragma unroll
                for (int i = 0; i < 4; ++i) *(int4*)(tl + 32 + 4 * i) = make_int4(A[4 * i], A[4 * i + 1], A[4 * i + 2], A[4 * i + 3]);
            }
            wave_lds_fence();
            const int4 myT = *(const int4*)(tl + 32 + 4 * fq);
            const int tsel[4] = {myT.x, myT.y, myT.z, myT.w};
            const float top0 = key2f(A[0]);
            float sum = 0.f;
#pragma unroll
            for (int r = 0; r < 16; ++r) sum += __expf(key2f(A[r]) - top0);
            const float inv = 1.f / sum;
            int eo[4]; float go[4];
#pragma unroll
            for (int kk = 0; kk < 4; ++kk) {
                const int t = tsel[kk];
                const int id = t & 127, ofq = id >> 5, slot = id & 31;
                const int k = slot < 16 ? 0 : (slot < 19 ? 1 : (slot == 19 ? 2 : 3));
                const int b = slot < 16 ? slot : (slot < 19 ? slot - 16 : 0);
                const int a = ofq + 4 * k;
                const int e1 = tl[a] & 127, e2 = tl[16 + b] & 127;
                eo[kk] = e1 * 128 + e2;
                go[kk] = __expf(key2f(t) - top0) * inv;
            }
            *(int4*)(eidx + (size_t)token * 128 + h * 16 + 4 * fq) = make_int4(eo[0], eo[1], eo[2], eo[3]);
            *(float4*)(egate + (size_t)token * 128 + h * 16 + 4 * fq) = make_float4(go[0], go[1], go[2], go[3]);
            wave_lds_fence();
        }
    }
    __syncthreads();
}

typedef __bf16 bf16x2_t __attribute__((ext_vector_type(2)));
__device__ __forceinline__ float dot2bf(unsigned a, unsigned b, float acc) { return __builtin_amdgcn_fdot2_f32_bf16(__builtin_bit_cast(bf16x2_t, a), __builtin_bit_cast(bf16x2_t, b), acc, false); }
__device__ __forceinline__ float gelu_fast(float x) {
    const float u = 0.7978845608028654f * (x + 0.044715f * x * x * x);
    return x / (1.f + __expf(-2.f * u));
}
__device__ __forceinline__ void peer_expert2_phase(float* R, const int* __restrict__ eidx, const float* __restrict__ egate, const bf16_t* __restrict__ ub,
                                                   const bf16_t* __restrict__ vb, const float* __restrict__ lg, const float* __restrict__ lb, bf16_t* Hb) {
    const int wave = tidx() >> 6, lane = tidx() & 63;
    for (int token = blockIdx.x * 8 + wave; token < NT; token += gridDim.x * 8) {
        float xf[16];
        {
            const float* rp = R + (size_t)token * ND + lane * 8;
            const float4 a0 = *(const float4*)rp, a1 = *(const float4*)(rp + 4), b0 = *(const float4*)(rp + 512), b1 = *(const float4*)(rp + 516);
            xf[0] = a0.x; xf[1] = a0.y; xf[2] = a0.z; xf[3] = a0.w; xf[4] = a1.x; xf[5] = a1.y; xf[6] = a1.z; xf[7] = a1.w;
            xf[8] = b0.x; xf[9] = b0.y; xf[10] = b0.z; xf[11] = b0.w; xf[12] = b1.x; xf[13] = b1.y; xf[14] = b1.z; xf[15] = b1.w;
        }
        unsigned xp[8];
#pragma unroll
        for (int j = 0; j < 8; ++j) xp[j] = pack2(xf[2 * j], xf[2 * j + 1]);
        float acc[16];
#pragma unroll
        for (int j = 0; j < 16; ++j) acc[j] = 0.f;
        const int e_lo = eidx[(size_t)token * 128 + lane], e_hi = eidx[(size_t)token * 128 + 64 + lane];
        const float g_lo = egate[(size_t)token * 128 + lane], g_hi = egate[(size_t)token * 128 + 64 + lane];
        for (int grp = 0; grp < 16; ++grp) {
            const int esel = grp < 8 ? e_lo : e_hi;
            const float gsel = grp < 8 ? g_lo : g_hi;
            const int lbase = (grp & 7) * 8;
            uint4 u0[8], u1[8];
            int exs[8];
#pragma unroll
            for (int k = 0; k < 8; ++k) {
                exs[k] = __builtin_amdgcn_readlane(esel, lbase + k);
                const bf16_t* up = ub + (size_t)exs[k] * ND + lane * 8;
                u0[k] = *(const uint4*)up; u1[k] = *(const uint4*)(up + 512);
            }
            float d[8];
#pragma unroll
            for (int k = 0; k < 8; ++k) {
                float a = dot2bf(u0[k].x, xp[0], 0.f), b = dot2bf(u0[k].y, xp[1], 0.f);
                a = dot2bf(u0[k].z, xp[2], a); b = dot2bf(u0[k].w, xp[3], b);
                a = dot2bf(u1[k].x, xp[4], a); b = dot2bf(u1[k].y, xp[5], b);
                a = dot2bf(u1[k].z, xp[6], a); b = dot2bf(u1[k].w, xp[7], b);
                d[k] = a + b;
            }
            const bool hi5 = lane & 32, hi4 = lane & 16, hi3 = lane & 8;
            float r4[4], r2[2], r1;
#pragma unroll
            for (int k = 0; k < 4; ++k) { const float send = hi5 ? d[k] : d[k + 4], keep = hi5 ? d[k + 4] : d[k]; r4[k] = keep + __shfl_xor(send, 32); }
#pragma unroll
            for (int k = 0; k < 2; ++k) { const float send = hi4 ? r4[k] : r4[k + 2], keep = hi4 ? r4[k + 2] : r4[k]; r2[k] = keep + __shfl_xor(send, 16); }
            { const float send = hi3 ? r2[0] : r2[1], keep = hi3 ? r2[1] : r2[0]; r1 = keep + __shfl_xor(send, 8); }
            r1 += __shfl_xor(r1, 4); r1 += __shfl_xor(r1, 2); r1 += __shfl_xor(r1, 1);
            uint4 v0[8], v1[8];
#pragma unroll
            for (int k = 0; k < 8; ++k) {
                const bf16_t* vp = vb + (size_t)exs[k] * ND + lane * 8;
                v0[k] = *(const uint4*)vp; v1[k] = *(const uint4*)(vp + 512);
            }
            const float gk = __shfl(gsel, lbase + (lane >> 3));
            const float coef = gk * gelu_fast(r1);
#pragma unroll
            for (int k = 0; k < 8; ++k) {
                const float ck = __int_as_float(__builtin_amdgcn_readlane(__float_as_int(coef), 8 * k));
                const unsigned w[8] = {v0[k].x, v0[k].y, v0[k].z, v0[k].w, v1[k].x, v1[k].y, v1[k].z, v1[k].w};
#pragma unroll
                for (int j = 0; j < 8; ++j) {
                    acc[2 * j] += ck * __uint_as_float(w[j] << 16);
                    acc[2 * j + 1] += ck * __uint_as_float(w[j] & 0xffff0000u);
                }
            }
        }
        {
            const float* rp = R + (size_t)token * ND + lane * 8;
            const float4 a0 = *(const float4*)rp, a1 = *(const float4*)(rp + 4), b0 = *(const float4*)(rp + 512), b1 = *(const float4*)(rp + 516);
            xf[0] = a0.x; xf[1] = a0.y; xf[2] = a0.z; xf[3] = a0.w; xf[4] = a1.x; xf[5] = a1.y; xf[6] = a1.z; xf[7] = a1.w;
            xf[8] = b0.x; xf[9] = b0.y; xf[10] = b0.z; xf[11] = b0.w; xf[12] = b1.x; xf[13] = b1.y; xf[14] = b1.z; xf[15] = b1.w;
        }
        float s = 0.f;
#pragma unroll
        for (int j = 0; j < 16; ++j) { xf[j] = ALPHA * xf[j] + acc[j]; s += xf[j]; }
        for (int o = 32; o; o >>= 1) s += __shfl_xor(s, o);
        const float mean = s * (1.f / ND);
        float s2 = 0.f;
#pragma unroll
        for (int j = 0; j < 16; ++j) { xf[j] -= mean; s2 += xf[j] * xf[j]; }
        for (int o = 32; o; o >>= 1) s2 += __shfl_xor(s2, o);
        const float rs = rsqrtf(s2 * (1.f / ND) + LN_EPS);
#pragma unroll
        for (int hf = 0; hf < 2; ++hf) {
            const int c0 = hf * 512 + lane * 8;
            const float4 g0 = *(const float4*)(lg + c0), g1 = *(const float4*)(lg + c0 + 4), b0 = *(const float4*)(lb + c0), b1 = *(const float4*)(lb + c0 + 4);
            float o[8];
            o[0] = xf[hf * 8 + 0] * rs * g0.x + b0.x; o[1] = xf[hf * 8 + 1] * rs * g0.y + b0.y; o[2] = xf[hf * 8 + 2] * rs * g0.z + b0.z; o[3] = xf[hf * 8 + 3] * rs * g0.w + b0.w;
            o[4] = xf[hf * 8 + 4] * rs * g1.x + b1.x; o[5] = xf[hf * 8 + 5] * rs * g1.y + b1.y; o[6] = xf[hf * 8 + 6] * rs * g1.z + b1.z; o[7] = xf[hf * 8 + 7] * rs * g1.w + b1.w;
            float* op = R + (size_t)token * ND + c0;
            *(float4*)op = make_float4(o[0], o[1], o[2], o[3]); *(float4*)(op + 4) = make_float4(o[4], o[5], o[6], o[7]);
            if (Hb) st8(Hb + (size_t)token * ND + c0, o);
        }
    }
}

__device__ __forceinline__ void nsa_compress_phase(const bf16_t* __restrict__ proj, int coloff, const float* __restrict__ pe, const float* __restrict__ w1,
                                   const float* __restrict__ w2, float* __restrict__ outc, float* lds) {
    const int qtr = tidx() >> 7, tid = tidx() & 127;
    float* in = lds + qtr * 2176;
    float* hid = in + 2048;
    for (int it = blockIdx.x; it < NB * 127; it += gridDim.x) {
        const int g = qtr, n = it % 127, b = it / 127;
        __syncthreads();
        for (int idx = tid; idx < 2048; idx += 128) {
            const int l = idx >> 6, d = idx & 63;
            in[idx] = bf2f(proj[(size_t)(b * NL + 16 * n + l) * ODD_PAD + coloff + g * 64 + d]) + pe[l * 64 + d];
        }
        __syncthreads();
        float a = 0.f;
        for (int i = 0; i < 2048; ++i) a += in[i] * w1[(size_t)i * 128 + tid];
        hid[tid] = gelu_tanh(a);
        __syncthreads();
        if (tid < 64) {
            float o = 0.f;
            for (int j = 0; j < 128; ++j) o += hid[j] * w2[j * 64 + tid];
            outc[((size_t)(b * 127 + n) * 4 + g) * 64 + tid] = o;
        }
    }
    __syncthreads();
}

__device__ __forceinline__ void nsa_cmp_phase(const bf16_t* __restrict__ proj, const float* __restrict__ kcmp, const float* __restrict__ vcmp,
                              bf16_t* __restrict__ O, unsigned* __restrict__ selmask, float* lds) {
    const int half = tidx() >> 8, tid = tidx() & 255;
    float* kc_s = lds + half * 18368;
    float* vc_s = kc_s + 127 * 64;
    float(*imp_s)[33] = (float(*)[33])(vc_s + 127 * 64);
    const int tk = tid >> 2, r = tid & 3;
    for (int it = blockIdx.x; it < 32 * 4 * NB / 2; it += gridDim.x) {
        const int vb = it * 2 + half;
        const int tile = vb & 31, g = (vb >> 5) & 3, b = vb >> 7;
        const int t = tile * 64 + tk, hd = g * 4 + r;
        __syncthreads();
        for (int idx = tid; idx < 127 * 64; idx += 256) { const int n = idx >> 6, d = idx & 63; kc_s[idx] = kcmp[((size_t)(b * 127 + n) * 4 + g) * 64 + d]; vc_s[idx] = vcmp[((size_t)(b * 127 + n) * 4 + g) * 64 + d]; }
        const bf16_t* prow = proj + (size_t)(b * NL + t) * ODD_PAD;
        float q[64];
#pragma unroll
        for (int d = 0; d < 64; d += 8) ld8(prow + hd * 64 + d, q + d);
        const float slope = exp2f(-0.5f * (float)(hd + 1));
        int nvalid = (t >= 31) ? ((t - 31) / 16 + 1) : 0;
        if (nvalid > 127) nvalid = 127;
        __syncthreads();
        float m = -INFINITY, l = 0.f;
        for (int n = 0; n < nvalid; ++n) {
            float s = 0.f;
#pragma unroll
            for (int d = 0; d < 64; ++d) s += q[d] * kc_s[n * 64 + d];
            s = s * 0.125f - slope * (float)(t - (16 * n + 31));
            const float mn = fmaxf(m, s);
            l = l * expf(m - mn) + expf(s - mn);
            m = mn;
        }
        const float inv_l = (nvalid > 0) ? 1.f / fmaxf(l, 1e-30f) : 0.f;
        float acc[64];
#pragma unroll
        for (int d = 0; d < 64; ++d) acc[d] = 0.f;
        float prev3 = 0.f;
        for (int j = 0; j < 32; ++j) {
            float pj[4];
#pragma unroll
            for (int nn = 0; nn < 4; ++nn) {
                const int n = 4 * j + nn;
                float p = 0.f;
                if (n < nvalid) {
                    float s = 0.f;
#pragma unroll
                    for (int d = 0; d < 64; ++d) s += q[d] * kc_s[n * 64 + d];
                    s = s * 0.125f - slope * (float)(t - (16 * n + 31));
                    p = expf(s - m) * inv_l;
                    const float* vr = vc_s + n * 64;
#pragma unroll
                    for (int d = 0; d < 64; ++d) acc[d] += p * vr[d];
                }
                pj[nn] = p;
            }
            float im = 0.5f * prev3 + pj[0] + pj[1] + pj[2] + 0.5f * pj[3];
            prev3 = pj[3];
            im += __shfl_xor(im, 1);
            im += __shfl_xor(im, 2);
            if (r == 0) imp_s[tk][j] = im;
        }
        const float g0 = sigmoidf_(bf2f(prow[2048 + hd]));
#pragma unroll
        for (int d = 0; d < 64; ++d) acc[d] *= g0;
#pragma unroll
        for (int d = 0; d < 64; d += 8) st8(O + (size_t)(b * NL + t) * ND + hd * 64 + d, acc + d);
        __syncthreads();
        const int cur = tile;
        unsigned bits = 0;
        for (int jj = 0; jj < 8; ++jj) {
            const int j = r * 8 + jj;
            const bool fj = (j == 0) || (j == cur) || (j == cur - 1);
            const float vj = (j <= cur) ? imp_s[tk][j] + (fj ? 1000.f : 0.f) : -INFINITY;
            int rank = 0;
            for (int k = 0; k < 32; ++k) {
                const bool fk = (k == 0) || (k == cur) || (k == cur - 1);
                const float vk = (k <= cur) ? imp_s[tk][k] + (fk ? 1000.f : 0.f) : -INFINITY;
                rank += (vk > vj || (vk == vj && k < j)) ? 1 : 0;
            }
            if (rank < 16) bits |= 1u << j;
        }
        bits |= __shfl_xor(bits, 1);
        bits |= __shfl_xor(bits, 2);
        if (r == 0) selmask[(size_t)(b * 4 + g) * NL + t] = bits;
    }
    __syncthreads();
}

__device__ __forceinline__ void nsa_selwin_phase(const bf16_t* __restrict__ proj, const unsigned* __restrict__ selmask, bf16_t* O, float* lds) {
    const int half = tidx() >> 8, tid = tidx() & 255;
    float(*k_s)[64] = (float(*)[64])(lds + half * 8192);
    float(*v_s)[64] = (float(*)[64])(lds + half * 8192 + 4096);
    const int tk = tid >> 2, r = tid & 3;
    for (int it = blockIdx.x; it < 32 * 32; it += gridDim.x) {
        const int tile = 31 - (it >> 5);
        const int bgi = (it & 31) * 2 + half, g = bgi & 3, b = bgi >> 2;
        const int t = tile * 64 + tk, hd = g * 4 + r;
        const bf16_t* pb = proj + (size_t)b * NL * ODD_PAD;
        const bf16_t* prow = pb + (size_t)t * ODD_PAD;
        float q[64], acc[64];
#pragma unroll
        for (int d = 0; d < 64; d += 8) ld8(prow + hd * 64 + d, q + d);
        const float slope = exp2f(-0.5f * (float)(hd + 1));
        const unsigned mask = selmask[(size_t)(b * 4 + g) * NL + t];
        bf16_t* orow = O + (size_t)(b * NL + t) * ND + hd * 64;
        for (int branch = 0; branch < 2; ++branch) {
            const int kcol = (branch == 0 ? 1536 : 2048) + g * 64, vcol = kcol + 256;
            const int j0 = (branch == 0) ? 0 : (tile >= 8 ? tile - 8 : 0);
            float m = -1e30f, l = 0.f;
#pragma unroll
            for (int d = 0; d < 64; ++d) acc[d] = 0.f;
            for (int j = j0; j <= tile; ++j) {
                __syncthreads();
                for (int i = 0; i < 16; ++i) {
                    const int idx = tid + 256 * i, key = idx >> 6, d = idx & 63;
                    k_s[key][d] = bf2f(pb[(size_t)(64 * j + key) * ODD_PAD + kcol + d]);
                    v_s[key][d] = bf2f(pb[(size_t)(64 * j + key) * ODD_PAD + vcol + d]);
                }
                __syncthreads();
                const bool take = (branch == 0) ? ((mask >> j) & 1u) : true;
                if (take) {
                    for (int s = 0; s < 64; ++s) {
                        const int dist = t - (64 * j + s);
                        const bool valid = (branch == 0) ? (dist >= 0) : (dist >= 0 && dist < 512);
                        float sc = 0.f;
#pragma unroll
                        for (int d = 0; d < 64; ++d) sc += q[d] * k_s[s][d];
                        sc = sc * 0.125f - slope * (float)dist;
                        const float mn = valid ? fmaxf(m, sc) : m;
                        const float scale = expf(m - mn);
                        const float p = valid ? expf(sc - mn) : 0.f;
                        l = l * scale + p;
#pragma unroll
                        for (int d = 0; d < 64; ++d) acc[d] = acc[d] * scale + p * v_s[s][d];
                        m = mn;
                    }
                }
            }
            const float gt = sigmoidf_(bf2f(prow[2560 + (branch + 1) * 16 + hd]));
            const float f = gt / fmaxf(l, 1e-30f);
#pragma unroll
            for (int d = 0; d < 64; d += 8) {
                float o[8];
                ld8(orow + d, o);
#pragma unroll
                for (int j = 0; j < 8; ++j) o[j] += f * acc[d + j];
                st8(orow + d, o);
            }
        }
    }
    __syncthreads();
}


typedef float f32x16 __attribute__((ext_vector_type(16)));
typedef float f32x2_t __attribute__((ext_vector_type(2)));
#define MFMA32(a, b, c) __builtin_amdgcn_mfma_f32_32x32x16_bf16((a), (b), (c), 0, 0, 0)
__device__ __forceinline__ unsigned cvtpk(float lo, float hi) { const f32x2_t f = {lo, hi}; return __builtin_bit_cast(unsigned, __builtin_convertvector(f, bf16x2_t)); }
__device__ __forceinline__ int crow32(int reg, int h) { return (reg & 3) + 8 * (reg >> 2) + 4 * h; }
constexpr float LOG2E = 1.4426950408889634f;
__device__ __forceinline__ void nsa_attn_phase(const bf16_t* __restrict__ proj, const bf16_t* __restrict__ vt, const unsigned* __restrict__ selmask, bf16_t* O, unsigned char* lds) {
    const int tid = tidx(), wave = __builtin_amdgcn_readfirstlane(tid >> 6), lane = tid & 63, l31 = lane & 31, h = lane >> 5;
    const int r = wave & 3, thalf = wave >> 2;
    const int skey = tid >> 3, spart = tid & 7;
    for (int it = blockIdx.x; it < 32 * 64; it += gridDim.x) {
        const int tile = 31 - (it >> 6), bg = it & 63, g = bg & 3, b = bg >> 2;
        const int hd = g * 4 + r, tokoff = thalf * 32 + l31, tok = tile * 64 + tokoff;
        const size_t trow = (size_t)(b * NL + tok);
        const float slope = exp2f(-0.5f * (float)(hd + 1));
        bf16x8_t Qf[4];
#pragma unroll
        for (int ds = 0; ds < 4; ++ds) {
            float q[8];
            ld8(proj + trow * ODD_PAD + hd * 64 + 16 * ds + 8 * h, q);
            u32x4 w; w.x = cvtpk(q[0] * 0.125f, q[1] * 0.125f); w.y = cvtpk(q[2] * 0.125f, q[3] * 0.125f); w.z = cvtpk(q[4] * 0.125f, q[5] * 0.125f); w.w = cvtpk(q[6] * 0.125f, q[7] * 0.125f);
            Qf[ds] = __builtin_bit_cast(bf16x8_t, w);
        }
        float sc[16];
#pragma unroll
        for (int reg = 0; reg < 16; ++reg) sc[reg] = slope * (float)crow32(reg, h);
        const unsigned mymask = selmask[(size_t)(b * 4 + g) * NL + tok];
        __syncthreads();
        if (wave == 0) {
            unsigned m = selmask[(size_t)(b * 4 + g) * NL + tile * 64 + lane];
            for (int o = 32; o; o >>= 1) m |= __shfl_xor(m, o);
            if (lane == 0) *(unsigned*)(lds + 35840) = m;
        }
        __syncthreads();
        const unsigned causal = (tile == 31) ? 0xffffffffu : ((2u << tile) - 1u);
        const unsigned U = *(const unsigned*)(lds + 35840) & causal;
        float outv[32];
#pragma unroll
        for (int i = 0; i < 32; ++i) outv[i] = 0.f;
#pragma unroll 1
        for (int branch = 0; branch < 2; ++branch) {
            unsigned todo = (branch == 0) ? U : (causal & ~((1u << (tile >= 8 ? tile - 8 : 0)) - 1u));
            const bf16_t* kbase = proj + (size_t)b * NL * ODD_PAD + (branch == 0 ? 1536 : 1792) + g * 64 + (size_t)skey * ODD_PAD + 8 * spart;
            const bf16_t* vbase = vt + (size_t)(branch * 256 + g * 64 + skey) * NT + (size_t)b * NL + 8 * spart;
            float m_run = -1e30f, l_run = 0.f;
            f32x16 Oa[2];
#pragma unroll
            for (int i = 0; i < 16; ++i) { Oa[0][i] = 0.f; Oa[1][i] = 0.f; }
            int jcur = __ffs(todo) - 1; todo &= todo - 1;
            uint4 kreg = *(const uint4*)(kbase + (size_t)(64 * jcur) * ODD_PAD);
            uint4 vreg = *(const uint4*)(vbase + 64 * jcur);
            int buf = 0;
            __syncthreads();
            *(uint4*)(lds + skey * 144 + spart * 16) = kreg;
            *(uint2*)(lds + 18432 + skey * 136 + spart * 16) = make_uint2(vreg.x, vreg.y);
            *(uint2*)(lds + 18432 + skey * 136 + spart * 16 + 8) = make_uint2(vreg.z, vreg.w);
            __syncthreads();
            for (;;) {
                const int jnext = todo ? (__ffs(todo) - 1) : -1;
                todo &= todo - 1;
                if (jnext >= 0) { kreg = *(const uint4*)(kbase + (size_t)(64 * jnext) * ODD_PAD); vreg = *(const uint4*)(vbase + 64 * jnext); }
                const unsigned char* Ks = lds + buf * 9216;
                const unsigned char* Vs = lds + 18432 + buf * 8704;
                const bool mysel = (branch == 1) || ((mymask >> jcur) & 1u);
                if (__any(mysel)) {
                    const bool diag = (jcur == tile), wedge = (branch == 1) && (jcur == tile - 8);
                    const float init = mysel ? slope * (float)(64 * (jcur - tile)) : -1e30f;
                    float sv[32];
#pragma unroll
                    for (int kt = 0; kt < 2; ++kt) {
                        f32x16 acc;
                        const float i0 = init + slope * (float)(32 * kt);
#pragma unroll
                        for (int i = 0; i < 16; ++i) acc[i] = i0;
#pragma unroll
                        for (int ds = 0; ds < 4; ++ds) {
                            const bf16x8_t a = *(const bf16x8_t*)(Ks + (32 * kt + l31) * 144 + (16 * ds + 8 * h) * 2);
                            acc = MFMA32(a, Qf[ds], acc);
                        }
#pragma unroll
                        for (int reg = 0; reg < 16; ++reg) {
                            float sval = acc[reg] + sc[reg];
                            const int keyoff = 32 * kt + crow32(reg, h);
                            if (diag) sval = (keyoff <= tokoff) ? sval : -1e30f;
                            if (wedge) sval = (keyoff > tokoff) ? sval : -1e30f;
                            sv[kt * 16 + reg] = sval;
                        }
                    }
                    float mx = sv[0];
#pragma unroll
                    for (int i = 1; i < 32; ++i) mx = fmaxf(mx, sv[i]);
                    mx = fmaxf(mx, __shfl_xor(mx, 32));
                    const float m_new = fmaxf(m_run, mx), m_use = fmaxf(m_new, -1e29f);
                    const float alpha = __builtin_amdgcn_exp2f((m_run - m_use) * LOG2E);
                    const float moff = -m_use * LOG2E;
                    float psum = 0.f;
#pragma unroll
                    for (int i = 0; i < 32; ++i) { sv[i] = __builtin_amdgcn_exp2f(fmaf(sv[i], LOG2E, moff)); psum += sv[i]; }
                    l_run = l_run * alpha + psum; m_run = m_new;
#pragma unroll
                    for (int i = 0; i < 16; ++i) { Oa[0][i] *= alpha; Oa[1][i] *= alpha; }
                    bf16x8_t Pf[4];
#pragma unroll
                    for (int ks = 0; ks < 4; ++ks) {
                        u32x4 w; w.x = cvtpk(sv[ks * 8 + 0], sv[ks * 8 + 1]); w.y = cvtpk(sv[ks * 8 + 2], sv[ks * 8 + 3]); w.z = cvtpk(sv[ks * 8 + 4], sv[ks * 8 + 5]); w.w = cvtpk(sv[ks * 8 + 6], sv[ks * 8 + 7]);
                        Pf[ks] = __builtin_bit_cast(bf16x8_t, w);
                    }
#pragma unroll
                    for (int mt = 0; mt < 2; ++mt)
#pragma unroll
                        for (int ks = 0; ks < 4; ++ks) {
                            const unsigned char* vp = Vs + (32 * mt + l31) * 136 + (16 * ks + 4 * h) * 2;
                            const uint2 lo = *(const uint2*)vp, hi = *(const uint2*)(vp + 16);
                            u32x4 w; w.x = lo.x; w.y = lo.y; w.z = hi.x; w.w = hi.y;
                            Oa[mt] = MFMA32(__builtin_bit_cast(bf16x8_t, w), Pf[ks], Oa[mt]);
                        }
                }
                if (jnext < 0) break;
                *(uint4*)(lds + (buf ^ 1) * 9216 + skey * 144 + spart * 16) = kreg;
                *(uint2*)(lds + 18432 + (buf ^ 1) * 8704 + skey * 136 + spart * 16) = make_uint2(vreg.x, vreg.y);
                *(uint2*)(lds + 18432 + (buf ^ 1) * 8704 + skey * 136 + spart * 16 + 8) = make_uint2(vreg.z, vreg.w);
                __syncthreads();
                buf ^= 1; jcur = jnext;
            }
            const float l_tot = l_run + __shfl_xor(l_run, 32);
            const float gt = sigmoidf_(bf2f(proj[trow * ODD_PAD + 2048 + (branch + 1) * 16 + hd]));
            const float f = gt / fmaxf(l_tot, 1e-30f);
#pragma unroll
            for (int i = 0; i < 16; ++i) { outv[i] += f * Oa[0][i]; outv[16 + i] += f * Oa[1][i]; }
        }
        bf16_t* orow = O + trow * ND + hd * 64;
#pragma unroll
        for (int mt = 0; mt < 2; ++mt)
#pragma unroll
            for (int q4 = 0; q4 < 4; ++q4) {
                bf16_t* op = orow + 32 * mt + 8 * q4 + 4 * h;
                const uint2 old = *(const uint2*)op;
                const float o0 = __uint_as_float(old.x << 16) + outv[mt * 16 + q4 * 4 + 0], o1 = __uint_as_float(old.x & 0xffff0000u) + outv[mt * 16 + q4 * 4 + 1];
                const float o2 = __uint_as_float(old.y << 16) + outv[mt * 16 + q4 * 4 + 2], o3 = __uint_as_float(old.y & 0xffff0000u) + outv[mt * 16 + q4 * 4 + 3];
                *(uint2*)op = make_uint2(cvtpk(o0, o1), cvtpk(o2, o3));
            }
    }
    __syncthreads();
}

struct Params {
    const float* in[29];
    float* out;
    char* ws;
    unsigned long long pad;
};

constexpr size_t SZ_PROJ = (size_t)NT * EVEN_IN * 2;
constexpr size_t SZ_VT = (size_t)512 * NT * 2;
constexpr size_t SZ_YB = (size_t)NT * ND * 2;
constexpr size_t SZ_HB = (size_t)NT * ND * 2;
constexpr size_t SZ_YA = (size_t)NT * 256 * 4;
constexpr size_t SZ_CMP = (size_t)NB * 127 * 4 * 64 * 4;
constexpr size_t SZ_SEL = (size_t)NB * 4 * NL * 4;
constexpr size_t SZ_TAB = (size_t)16384 * ND * 2;
constexpr size_t SZ_SKB = (size_t)2 * 8 * 2 * 128 * 128 * 2;
constexpr size_t OFF_VT = SZ_PROJ, OFF_YB = OFF_VT + SZ_VT, OFF_HB = OFF_YB + SZ_YB, OFF_YA = OFF_HB + SZ_HB, OFF_KC = OFF_YA + SZ_YA, OFF_VC = OFF_KC + SZ_CMP,
                 OFF_SEL = OFF_VC + SZ_CMP, OFF_TAB = OFF_SEL + SZ_SEL, OFF_SKB = OFF_TAB + 2 * SZ_TAB, OFF_WT = OFF_SKB + SZ_SKB;
constexpr size_t WT_IN0 = 0, WT_OUT0 = WT_IN0 + (size_t)EVEN_IN * ND * 2, WT_Q0 = WT_OUT0 + (size_t)ND * ND * 2, WT_Q1 = WT_Q0 + (size_t)2048 * ND * 2,
                 WT_IN1 = WT_Q1 + (size_t)2048 * ND * 2, WT_V1 = WT_IN1 + (size_t)ODD_PAD * ND * 2, WT_OUT1 = WT_V1 + (size_t)512 * ND * 2, WT_END = WT_OUT1 + (size_t)ND * ND * 2;
constexpr size_t WS_NEED = OFF_WT + WT_END;

__device__ __forceinline__ void convert_tables(const float* __restrict__ u, const float* __restrict__ v, bf16_t* __restrict__ TAB) {
    const size_t per = (size_t)16384 * ND / 8;
    for (size_t i = (size_t)blockIdx.x * NTHR + tidx(); i < 2 * per; i += (size_t)gridDim.x * NTHR) {
        const int tb = (int)(i / per); const size_t off = (i % per) * 8;
        const float* src = (tb ? v : u) + off;
        const float4 a = *(const float4*)src, b = *(const float4*)(src + 4);
        uint4 w; w.x = pack2(a.x, a.y); w.y = pack2(a.z, a.w); w.z = pack2(b.x, b.y); w.w = pack2(b.z, b.w);
        *(uint4*)(TAB + (size_t)tb * 16384 * ND + off) = w;
    }
}

__global__ void __launch_bounds__(NTHR) fwd_megakernel(Params p) {
    extern __shared__ __attribute__((aligned(16))) unsigned char lds_raw[];
    float* lds = (float*)lds_raw;
    cg::grid_group grid = cg::this_grid();
    const float* x = p.in[0];
    float* R = p.out;
    char* ws = p.ws;
    bf16_t* PROJ = (bf16_t*)ws;
    bf16_t* YB = (bf16_t*)(ws + OFF_YB);
    bf16_t* HB = (bf16_t*)(ws + OFF_HB);
    float* YA = (float*)(ws + OFF_YA);
    float* KCMP = (float*)(ws + OFF_KC);
    float* VCMP = (float*)(ws + OFF_VC);
    unsigned* SEL = (unsigned*)(ws + OFF_SEL);
    bf16_t* WIN0 = (bf16_t*)(ws + OFF_WT + WT_IN0);
    bf16_t* WOUT0 = (bf16_t*)(ws + OFF_WT + WT_OUT0);
    bf16_t* WQ0 = (bf16_t*)(ws + OFF_WT + WT_Q0);
    bf16_t* WQ1 = (bf16_t*)(ws + OFF_WT + WT_Q1);
    bf16_t* WIN1 = (bf16_t*)(ws + OFF_WT + WT_IN1);
    bf16_t* WOUT1 = (bf16_t*)(ws + OFF_WT + WT_OUT1);
    bf16_t* WV1 = (bf16_t*)(ws + OFF_WT + WT_V1);
    bf16_t* VT = (bf16_t*)(ws + OFF_VT);
    int* EIDX = (int*)YB;
    float* EGATE = (float*)((char*)YB + (size_t)NT * 128 * 4);
    bf16_t* TAB = (bf16_t*)(ws + OFF_TAB);
    bf16_t* SKB = (bf16_t*)(ws + OFF_SKB);
    const int wave = tidx() >> 6;

    for (size_t i = (size_t)blockIdx.x * NTHR + tidx(); i < (size_t)NT * ND / 4; i += (size_t)gridDim.x * NTHR) {
        const float4 v = ((const float4*)x)[i];
        ((float4*)R)[i] = v;
        uint2 w; w.x = pack2(v.x, v.y); w.y = pack2(v.z, v.w);
        ((uint2*)HB)[i] = w;
    }
    convert_tables(p.in[23], p.in[24], TAB);
    for (int i = blockIdx.x * NTHR + tidx(); i < 2 * 8 * 2 * 128 * 128 / 4; i += gridDim.x * NTHR) {
        const float4 a = ((const float4*)p.in[22])[i];
        uint2 w; w.x = pack2(a.x, a.y); w.y = pack2(a.z, a.w);
        ((uint2*)SKB)[i] = w;
    }
    convert_wt_phase(p.in[1], ND, EVEN_IN, EVEN_IN, ColMap{{0, 0, 0}, {0, 0, 0}, {EVEN_IN, 0, 0}}, WIN0, lds);
    convert_wt_phase(p.in[12], ND, ND, ND, ColMap{{0, 0, 0}, {0, 0, 0}, {ND, 0, 0}}, WOUT0, lds);
    convert_wt_phase(p.in[21], ND, 2048, 2048, ColMap{{0, 0, 0}, {0, 0, 0}, {2048, 0, 0}}, WQ0, lds);
    convert_wt_phase(p.in[21] + (size_t)ND * 2048, ND, 2048, 2048, ColMap{{0, 0, 0}, {0, 0, 0}, {2048, 0, 0}}, WQ1, lds);
    convert_wt_phase(p.in[13], ND, ODD_IN, ODD_PAD, ColMap{{0, 1792, 2048}, {0, 2048, 2560}, {1792, 256, 48}}, WIN1, lds);
    convert_wt_phase(p.in[13], ND, ODD_IN, 512, ColMap{{0, 256, 0}, {1792, 2304, 0}, {256, 256, 0}}, WV1, lds);
    convert_wt_phase(p.in[20], ND, ND, ND, ColMap{{0, 0, 0}, {0, 0, 0}, {ND, 0, 0}}, WOUT1, lds);
    grid.sync();
    PH(0) gemm_bf16_phase(lds_raw, HB, WIN0, NT, EVEN_IN, ND, EpiBf16s{PROJ, EVEN_IN});
    grid.sync();
    PH(1) if (wave == 0) {
        for (int bg = blockIdx.x; bg < NB * 16; bg += gridDim.x)
            s5_scan_wave(bg, PROJ, p.in[2], p.in[3], p.in[4], p.in[5], p.in[6], p.in[7], p.in[8], p.in[9], YA, lds);
    } else PH(2) {
        for (int task = blockIdx.x * 7 + (wave - 1); task < NB * 12 * 32; task += gridDim.x * 7)
            sb_attn_wave(task, PROJ, YB, lds + 11392 + (wave - 1) * 4096);
    }
    grid.sync();
    PH(3) glu_phase(YA, p.in[10], p.in[11], YB, lds);
    grid.sync();
    PH(4) gemm_bf16_phase(lds_raw, YB, WOUT0, NT, ND, ND, EpiRes{R, ND, ALPHA});
    grid.sync();
    PH(5) ln_phase(R, HB, p.in[25], p.in[26]);
    grid.sync();
#define PEER_FFN(layer, WQ, last) \
    PH(12) gemm_bf16_phase(lds_raw, HB, WQ, NT, 2048, ND, EpiBf16s{PROJ, 2048}); \
    grid.sync(); \
    PH(13) peer_route2_phase(PROJ, SKB + (size_t)(layer) * 8 * 2 * 128 * 128, EIDX, EGATE, lds_raw); \
    grid.sync(); \
    PH(14) peer_expert2_phase(R, EIDX, EGATE, TAB, TAB + (size_t)16384 * ND, p.in[27] + (layer) * ND, p.in[28] + (layer) * ND, (last) ? nullptr : HB); \
    if (!(last)) grid.sync();
    PEER_FFN(0, WQ0, false)
    convert_tables(p.in[23] + (size_t)16384 * ND, p.in[24] + (size_t)16384 * ND, TAB);
    PH(6) gemm_bf16_phase(lds_raw, HB, WIN1, NT, ODD_PAD, ND, EpiBf16s{PROJ, ODD_PAD});
    PH(6) gemm_bf16_phase(lds_raw, WV1, HB, 512, NT, ND, EpiBf16s{VT, NT});
    grid.sync();
    PH(7) nsa_compress_phase(PROJ, 1024, p.in[14], p.in[15], p.in[16], KCMP, lds);
    PH(7) nsa_compress_phase(PROJ, 1280, p.in[17], p.in[18], p.in[19], VCMP, lds);
    grid.sync();
    PH(8) nsa_cmp_phase(PROJ, KCMP, VCMP, YB, SEL, lds);
    grid.sync();
    PH(9) nsa_attn_phase(PROJ, VT, SEL, YB, lds_raw);
    grid.sync();
    PH(10) gemm_bf16_phase(lds_raw, YB, WOUT1, NT, ND, ND, EpiRes{R, ND, ALPHA});
    grid.sync();
    PH(11) ln_phase(R, HB, p.in[25] + ND, p.in[26] + ND);
    grid.sync();
    PEER_FFN(1, WQ1, true)
}

}

extern "C" void kernel_launch(void* const* d_in, const int* in_sizes, int n_in, void* d_out, int out_size, void* d_ws, size_t ws_size, hipStream_t stream) {
    static int grid_blocks = 0;
    if (grid_blocks == 0) {
        if (n_in != 29 || out_size != NT * ND || ws_size < WS_NEED) { fprintf(stderr, "kernel_launch: unexpected shapes / workspace (%zu < %zu)\n", ws_size, (size_t)WS_NEED); grid_blocks = -1; return; }
        int dev = 0, cus = 0, per_cu = 0;
        hipGetDevice(&dev);
        hipDeviceGetAttribute(&cus, hipDeviceAttributeMultiprocessorCount, dev);
        hipFuncSetAttribute((const void*)fwd_megakernel, hipFuncAttributeMaxDynamicSharedMemorySize, LDS_BYTES);
        hipOccupancyMaxActiveBlocksPerMultiprocessor(&per_cu, (const void*)fwd_megakernel, NTHR, LDS_BYTES);
        if (per_cu < 1) { fprintf(stderr, "kernel_launch: occupancy query says %d blocks/CU\n", per_cu); grid_blocks = -1; return; }
        grid_blocks = cus;
    }
    if (grid_blocks < 0) return;
    Params p{};
    for (int i = 0; i < 29; ++i) p.in[i] = (const float*)d_in[i];
    p.out = (float*)d_out; p.ws = (char*)d_ws; p.pad = 0;
    void* args[] = {&p};
    hipError_t e = hipLaunchCooperativeKernel((const void*)fwd_megakernel, dim3(grid_blocks), dim3(NTHR), args, LDS_BYTES, stream);
    if (e != hipSuccess) fprintf(stderr, "cooperative launch failed: %s (grid %d)\n", hipGetErrorString(e), grid_blocks);
}
```

```cpp
#include <hip/hip_runtime.h>
#include <hip/hip_cooperative_groups.h>
#include <math.h>
#include <stdint.h>
#include <cstdio>
namespace cg = cooperative_groups;

__device__ __forceinline__ int tidx() { int t = threadIdx.x; asm volatile("" : "+v"(t)); return t; }
namespace pg8 {
#define PG8_LAS __attribute__((address_space(3)))
typedef unsigned short bf16_t;
typedef short bf16x8 __attribute__((ext_vector_type(8)));
typedef float f32x4 __attribute__((ext_vector_type(4)));
typedef unsigned u32x4 __attribute__((ext_vector_type(4)));
constexpr int BM = 256, BK = 64, HALF = 128, HTB = HALF * BK * 2  , STAGE_BYTES = 8 * HTB, NXCD = 8, WGM = 8;

__host__ __device__ __forceinline__ int lds_byte(int r, int c) { const int st = (r >> 4) * 2 + (c >> 5), rr = r & 15, cc = c & 31, ob = rr * 64 + cc * 2; return st * 1024 + (ob ^ (((ob >> 9) & 1) << 5)); }
__host__ __device__ __forceinline__ void stage_rc(int b, int& R, int& C) { const int st = b / 1024, sb = b % 1024, swz = sb ^ (((sb >> 9) & 1) << 5); R = (st >> 1) * 16 + swz / 64; C = (st & 1) * 32 + (swz % 64) / 2; }
__host__ __device__ __forceinline__ int perm32(int rho) { const int n = rho >> 4, i = rho & 15; return 8 * (i >> 2) + 4 * n + (i & 3); }

struct Unit { int pm, pn; };
struct Gemm { const bf16_t* A; const bf16_t* Bt; int M, N, K; };

struct StaticOrder {
    int nM, nN, nwg, G, c;
    __host__ __device__ void init(int M, int N, int G_, int c_) { nM = M / BM; nN = N / BM; nwg = nM * nN; G = G_; c = c_; }
    __host__ __device__ bool next(int i, Unit& u) const {
        const long L = (long)i * G + c; if (L >= nwg) return false;
        int wgid = (int)L; { const int q = nwg / NXCD, r = nwg % NXCD, xcd = wgid % NXCD, off = wgid / NXCD; wgid = (xcd < r ? xcd * (q + 1) : r * (q + 1) + (xcd - r) * q) + off; }
        const int nig = WGM * nN, gid = wgid / nig, fm = gid * WGM, gsz = (nM - fm) < WGM ? (nM - fm) : WGM;
        u.pm = fm + ((wgid % nig) % gsz); u.pn = (wgid % nig) / gsz; return true;
    }
    __device__ __forceinline__ void a_ready(const Unit&) const {}
    __device__ __forceinline__ void done(const Unit&) const {}
};
__device__ __forceinline__ unsigned cvt_pk_bf16(float lo, float hi) { unsigned r; asm volatile("v_cvt_pk_bf16_f32 %0, %1, %2" : "=v"(r) : "v"(lo), "v"(hi)); return r; }
template <class Epi, class Sched, bool STAMP = false>
__device__ __forceinline__ void gemm_phase(PG8_LAS unsigned char* lds, const Gemm g, const Sched& S, const Epi& E, unsigned long long* stamps) {
    const int tid = tidx(), wid = __builtin_amdgcn_readfirstlane(tid >> 6), lane = tid & 63, wr = wid >> 2, wc = wid & 3, fr = lane & 15, fq = lane >> 4;
    const int K = g.K, nt = K / BK;
    int ts_lo = 0, ts_hi = 0, nts = 0; const unsigned long long rt_entry = STAMP ? (unsigned long long)wall_clock64() : 0ull;
#define PG8_STAMP() do { if (STAMP && wid == 0 && nts < 64) { const unsigned long long _c = (unsigned long long)clock64(); \
        ts_lo = (lane == nts) ? (int)(unsigned)_c : ts_lo; ts_hi = (lane == nts) ? (int)(unsigned)(_c >> 32) : ts_hi; ++nts; } } while (0)
    PG8_STAMP();
    unsigned voffA[2], voffB[2];
#pragma unroll
    for (int i = 0; i < 2; ++i) { int R, C; stage_rc(tid * 16 + i * 8192, R, C); const int Rb = Epi::PERM ? ((R & ~31) + perm32(R & 31)) : R;
        voffA[i] = (unsigned)(R * K + C) * 2u; voffB[i] = (unsigned)(Rb * K + C) * 2u; }
    const size_t kstep = (size_t)(BK * 2);
    const size_t hstep = (size_t)HALF * K * 2;
    const size_t tstep = 2 * hstep;
    const unsigned ldsw = (unsigned)wid * 1024u;
    const int aoff = lds_byte(wr * 64 + fr, fq * 8), boff = lds_byte(wc * 32 + fr, fq * 8);
#define PG8_SA(b, h) (((b) * 2 + (h)) * HTB)
#define PG8_SB(b, h) ((4 + (b) * 2 + (h)) * HTB)
#define PG8_STAGE(bufoff, gbase, voff) do { _Pragma("unroll") for (int _i = 0; _i < 2; ++_i) \
        __builtin_amdgcn_global_load_lds((const unsigned*)((const char*)(gbase) + (voff)[_i]), (PG8_LAS unsigned*)(lds + (bufoff) + ldsw + _i * 8192), 16, 0, 0); } while (0)
#define PG8_LDA(dst, b, h) do { _Pragma("unroll") for (int m = 0; m < 4; ++m) _Pragma("unroll") for (int k = 0; k < 2; ++k) dst[m][k] = *(const PG8_LAS bf16x8*)(lds + PG8_SA(b, h) + aoff + m * 2048 + k * 1024); } while (0)
#define PG8_LDB(dst, b, h) do { _Pragma("unroll") for (int n = 0; n < 2; ++n) _Pragma("unroll") for (int k = 0; k < 2; ++k) dst[n][k] = *(const PG8_LAS bf16x8*)(lds + PG8_SB(b, h) + boff + n * 2048 + k * 1024); } while (0)
#define PG8_MMA(ai, bj, At, Bt) do { __builtin_amdgcn_s_setprio(1); _Pragma("unroll") for (int m = 0; m < 4; ++m) _Pragma("unroll") for (int n = 0; n < 2; ++n) _Pragma("unroll") for (int k = 0; k < 2; ++k) \
        acc[ai][bj][m][n] = __builtin_amdgcn_mfma_f32_16x16x32_bf16(Bt[n][k], At[m][k], acc[ai][bj][m][n], 0, 0, 0); __builtin_amdgcn_s_setprio(0); } while (0)
#define PG8_WAIT_V(n) asm volatile("s_waitcnt vmcnt(" #n ")" ::: "memory")
#define PG8_WAIT_L(n) asm volatile("s_waitcnt lgkmcnt(" #n ")" ::: "memory")
#define PG8_BAR __builtin_amdgcn_s_barrier()
#define PG8_SCHED __builtin_amdgcn_sched_barrier(0)
    Unit cur, nxt; int ui = 0;
    if (!S.next(0, cur)) return;
    f32x4 acc[2][2][4][2];
#pragma unroll
    for (int a = 0; a < 2; ++a)
#pragma unroll
        for (int b = 0; b < 2; ++b)
#pragma unroll
            for (int m = 0; m < 4; ++m)
#pragma unroll
                for (int n = 0; n < 2; ++n) acc[a][b][m][n] = (f32x4){0.f, 0.f, 0.f, 0.f};
    bf16x8 At[4][2], B0[2][2], B1[2][2];
    const char* cA = (const char*)g.A + (size_t)cur.pm * tstep; const char* cB = (const char*)g.Bt + (size_t)cur.pn * tstep;
    S.a_ready(cur);
    PG8_STAGE(PG8_SB(0, 0), cB, voffB); PG8_STAGE(PG8_SA(0, 0), cA, voffA); PG8_STAGE(PG8_SB(0, 1), cB + hstep, voffB); PG8_STAGE(PG8_SA(0, 1), cA + hstep, voffA);
    if (wr == 1) PG8_BAR;
    PG8_WAIT_V(4); PG8_BAR;
    PG8_STAGE(PG8_SB(1, 0), cB + kstep, voffB); PG8_STAGE(PG8_SA(1, 0), cA + kstep, voffA); PG8_STAGE(PG8_SB(1, 1), cB + hstep + kstep, voffB);
    PG8_WAIT_V(6); PG8_BAR;
    PG8_STAMP();
    for (;;) {
        const bool has_next = S.next(ui + 1, nxt);
        const char* nA = has_next ? (const char*)g.A + (size_t)nxt.pm * tstep : cA; const char* nB = has_next ? (const char*)g.Bt + (size_t)nxt.pn * tstep : cB;
        for (int t = 0; t < nt; t += 2) {
            const bool last = (t == nt - 2);
            const char* a1 = cA + (size_t)(t + 1) * kstep;
            const char* a2 = last ? nA : cA + (size_t)(t + 2) * kstep; const char* b2 = last ? nB : cB + (size_t)(t + 2) * kstep;
            const char* a3 = a2 + kstep; const char* b3 = b2 + kstep;
            if (last && has_next) S.a_ready(nxt);
            PG8_LDB(B0, 0, 0); PG8_SCHED; PG8_LDA(At, 0, 0); PG8_STAGE(PG8_SA(1, 1), a1 + hstep, voffA);
            PG8_WAIT_L(8); PG8_BAR; PG8_WAIT_L(0); PG8_MMA(0, 0, At, B0); PG8_BAR; PG8_SCHED;
            PG8_LDB(B1, 0, 1); PG8_STAGE(PG8_SB(0, 0), b2, voffB);
            PG8_BAR; PG8_WAIT_L(0); PG8_MMA(0, 1, At, B1); PG8_BAR;
            PG8_LDA(At, 0, 1); PG8_STAGE(PG8_SA(0, 0), a2, voffA);
            PG8_BAR; PG8_WAIT_L(0); PG8_MMA(1, 0, At, B0); PG8_BAR; PG8_SCHED;
            PG8_STAGE(PG8_SB(0, 1), b2 + hstep, voffB);
            PG8_WAIT_V(6); PG8_BAR; PG8_MMA(1, 1, At, B1); PG8_BAR;
            PG8_LDB(B0, 1, 0); PG8_SCHED; PG8_LDA(At, 1, 0); PG8_STAGE(PG8_SA(0, 1), a2 + hstep, voffA);
            PG8_WAIT_L(8); PG8_BAR; PG8_WAIT_L(0); PG8_MMA(0, 0, At, B0); PG8_BAR; PG8_SCHED;
            PG8_LDB(B1, 1, 1); PG8_STAGE(PG8_SB(1, 0), b3, voffB);
            PG8_BAR; PG8_WAIT_L(0); PG8_MMA(0, 1, At, B1); PG8_BAR;
            PG8_LDA(At, 1, 1); PG8_STAGE(PG8_SA(1, 0), a3, voffA);
            PG8_BAR; PG8_WAIT_L(0); PG8_MMA(1, 0, At, B0); PG8_BAR; PG8_SCHED;
            PG8_STAGE(PG8_SB(1, 1), b3 + hstep, voffB);
            PG8_WAIT_V(6); PG8_BAR; PG8_MMA(1, 1, At, B1); PG8_BAR;
        }
        PG8_STAMP();
        if constexpr (!Epi::AFTER_DRAIN) { E(acc, cur, wr, wc, fr, fq); S.done(cur); }
        PG8_STAMP();
        if (!has_next) break;
#pragma unroll
        for (int a = 0; a < 2; ++a)
#pragma unroll
            for (int b = 0; b < 2; ++b)
#pragma unroll
                for (int m = 0; m < 4; ++m)
#pragma unroll
                    for (int n = 0; n < 2; ++n) acc[a][b][m][n] = (f32x4){0.f, 0.f, 0.f, 0.f};
        cur = nxt; cA = nA; cB = nB; ++ui;
    }
    PG8_WAIT_V(0);
    if (wr == 0) PG8_BAR;
    PG8_BAR;
    if constexpr (Epi::AFTER_DRAIN) { E.fused(acc, cur, wr, wc, fr, fq, lds, wid, lane); S.done(cur); }
    PG8_STAMP();
    if (STAMP && wid == 0) { stamps[lane] = lane < nts ? (((unsigned long long)(unsigned)ts_hi << 32) | (unsigned)ts_lo) : 0ull;
        if (lane == 62) stamps[62] = rt_entry; if (lane == 63) stamps[63] = (unsigned long long)wall_clock64(); }
#undef PG8_STAMP
#undef PG8_SA
#undef PG8_SB
#undef PG8_STAGE
#undef PG8_LDA
#undef PG8_LDB
#undef PG8_MMA
#undef PG8_WAIT_V
#undef PG8_WAIT_L
#undef PG8_BAR
#undef PG8_SCHED
}
}

namespace {
using pg8::bf16_t;
typedef float f32x4 __attribute__((ext_vector_type(4)));
typedef unsigned u32x4 __attribute__((ext_vector_type(4)));

constexpr int NB = 16, NL = 2048, ND = 1024, NT = NB * NL;
constexpr int EVEN_IN = 2560, ODD_IN = 2608, ODD_PAD = 2304;
constexpr float ALPHA = 1.41421356237f;
constexpr float LN_EPS = 1e-5f;
constexpr float U_SCALE = 256.f, V_SCALE = 16.f;
constexpr int NTHR = 512;
constexpr int LDS_BYTES = 163840;
#ifndef PHMASK
#define PHMASK 0xFFFFFFFFu
#endif
#define PH(n) if (PHMASK & (1u << (n)))

__device__ __forceinline__ float bf2f(bf16_t v) { return __uint_as_float((unsigned)v << 16); }
__device__ __forceinline__ bf16_t f2bf(float f) { unsigned u = __float_as_uint(f); u += 0x7FFFu + ((u >> 16) & 1u); return (bf16_t)(u >> 16); }
__device__ __forceinline__ unsigned pack2(float lo, float hi) { return (unsigned)f2bf(lo) | ((unsigned)f2bf(hi) << 16); }
__device__ __forceinline__ void ld8(const bf16_t* p, float* o) {
    const uint4 v = *(const uint4*)p;
    o[0] = __uint_as_float(v.x << 16); o[1] = __uint_as_float(v.x & 0xffff0000u);
    o[2] = __uint_as_float(v.y << 16); o[3] = __uint_as_float(v.y & 0xffff0000u);
    o[4] = __uint_as_float(v.z << 16); o[5] = __uint_as_float(v.z & 0xffff0000u);
    o[6] = __uint_as_float(v.w << 16); o[7] = __uint_as_float(v.w & 0xffff0000u);
}
__device__ __forceinline__ void st8(bf16_t* p, const float* o) {
    uint4 v; v.x = pack2(o[0], o[1]); v.y = pack2(o[2], o[3]); v.z = pack2(o[4], o[5]); v.w = pack2(o[6], o[7]);
    *(uint4*)p = v;
}

struct EpiBf16s {
    static constexpr bool PERM = true, AFTER_DRAIN = false;
    bf16_t* O; int ldc;
    __device__ __forceinline__ void operator()(const f32x4 (&acc)[2][2][4][2], const pg8::Unit& u, int wr, int wc, int fr, int fq) const {
        const int row0 = u.pm * 256 + wr * 64 + fr, col0 = u.pn * 256 + wc * 32 + 8 * fq;
#pragma unroll
        for (int ai = 0; ai < 2; ++ai)
#pragma unroll
            for (int m = 0; m < 4; ++m) { bf16_t* rowp = O + (size_t)(row0 + ai * 128 + m * 16) * ldc + col0;
#pragma unroll
                for (int bj = 0; bj < 2; ++bj) { const f32x4 v0 = acc[ai][bj][m][0], v1 = acc[ai][bj][m][1];
                    u32x4 w; w.x = pg8::cvt_pk_bf16(v0[0], v0[1]); w.y = pg8::cvt_pk_bf16(v0[2], v0[3]); w.z = pg8::cvt_pk_bf16(v1[0], v1[1]); w.w = pg8::cvt_pk_bf16(v1[2], v1[3]);
                    *(u32x4*)(rowp + bj * 128) = w; } }
    }
};
struct EpiRes {
    static constexpr bool PERM = false, AFTER_DRAIN = false;
    float* C; int ldc; float alpha;
    __device__ __forceinline__ void operator()(const f32x4 (&acc)[2][2][4][2], const pg8::Unit& u, int wr, int wc, int fr, int fq) const {
        const int row0 = u.pm * 256 + wr * 64 + fr, col0 = u.pn * 256 + wc * 32 + 4 * fq;
#pragma unroll
        for (int ai = 0; ai < 2; ++ai)
#pragma unroll
            for (int m = 0; m < 4; ++m) { float* rowp = C + (size_t)(row0 + ai * 128 + m * 16) * ldc + col0;
#pragma unroll
                for (int bj = 0; bj < 2; ++bj)
#pragma unroll
                    for (int n = 0; n < 2; ++n) { f32x4* cp = (f32x4*)(rowp + bj * 128 + n * 16); *cp = *cp * alpha + acc[ai][bj][m][n]; } }
    }
};
template <class Epi>
__device__ __forceinline__ void gemm_bf16_phase(unsigned char* lds, const bf16_t* A, const bf16_t* Bt, int M, int N, int K, const Epi& E) {
    pg8::Gemm g{A, Bt, M, N, K};
    pg8::StaticOrder S; S.init(M, N, (int)gridDim.x, (int)blockIdx.x);
    pg8::gemm_phase<Epi, pg8::StaticOrder, false>((PG8_LAS unsigned char*)lds, g, S, E, nullptr);
    __syncthreads();
}

struct ColMap { int d0[3], s0[3], len[3]; };
__device__ __forceinline__ void convert_wt_phase(const float* __restrict__ W, int K, int N, int Npad, const ColMap cm, bf16_t* __restrict__ Wt, float* lds) {
    float(*tile)[65] = (float(*)[65])lds;
    const int tid = tidx(), ntn = Npad / 64, ntiles = (K / 64) * ntn;
    for (int it = blockIdx.x; it < ntiles; it += gridDim.x) {
        const int k0 = (it / ntn) * 64, n0 = (it % ntn) * 64;
        __syncthreads();
#pragma unroll
        for (int h = 0; h < 2; ++h) {
            const int r = (tid >> 4) + h * 32, c4 = (tid & 15) * 4, nd = n0 + c4;
            int ns = -1;
#pragma unroll
            for (int sg = 0; sg < 3; ++sg) if (nd >= cm.d0[sg] && nd < cm.d0[sg] + cm.len[sg]) ns = cm.s0[sg] + (nd - cm.d0[sg]);
            float4 v = make_float4(0.f, 0.f, 0.f, 0.f);
            if (ns >= 0) v = *(const float4*)(W + (size_t)(k0 + r) * N + ns);
            tile[r][c4] = v.x; tile[r][c4 + 1] = v.y; tile[r][c4 + 2] = v.z; tile[r][c4 + 3] = v.w;
        }
        __syncthreads();
        const int n = tid >> 3, k8 = (tid & 7) * 8;
        float o[8];
#pragma unroll
        for (int j = 0; j < 8; ++j) o[j] = tile[k8 + j][n];
        st8(Wt + (size_t)(n0 + n) * K + k0 + k8, o);
    }
    __syncthreads();
}
__device__ __forceinline__ float gelu_tanh(float x) {
    float u = 0.7978845608028654f * (x + 0.044715f * x * x * x);
    return 0.5f * x * (1.f + tanhf(u));
}
__device__ __forceinline__ float sigmoidf_(float x) { return 1.f / (1.f + expf(-x)); }
__device__ __forceinline__ void wave_lds_fence() { asm volatile("s_waitcnt lgkmcnt(0)" ::: "memory"); }

__device__ __forceinline__ void s5_scan_wave(int bg, const bf16_t* __restrict__ proj, const float* __restrict__ lam_re, const float* __restrict__ lam_im,
                             const float* __restrict__ log_dt, const float* __restrict__ b_re, const float* __restrict__ b_im,
                             const float* __restrict__ c_re, const float* __restrict__ c_im, const float* __restrict__ dskip,
                             float* __restrict__ ya, float* lds) {
    const int b = bg >> 4, g = bg & 15, lane = tidx() & 63;
    float(*us)[16] = (float(*)[16])lds;
    float(*xr)[65] = (float(*)[65])(lds + 1024);
    float(*xi)[65] = (float(*)[65])(lds + 1024 + 4160);
    float(*cr)[64] = (float(*)[64])(lds + 1024 + 8320);
    float(*ci)[64] = (float(*)[64])(lds + 1024 + 8320 + 1024);
    const float lr = lam_re[g * 64 + lane], li = lam_im[g * 64 + lane];
    const float dt = expf(log_dt[g]);
    const float mag = expf(lr * dt);
    const float are = mag * cosf(li * dt), aim = mag * sinf(li * dt);
    const float nr = are - 1.f, den = lr * lr + li * li;
    const float fre = (nr * lr + aim * li) / den, fim = (aim * lr - nr * li) / den;
    float bbr[16], bbi[16];
#pragma unroll
    for (int i = 0; i < 16; ++i) {
        const float br = b_re[(g * 64 + lane) * 16 + i], bi = b_im[(g * 64 + lane) * 16 + i];
        bbr[i] = fre * br - fim * bi; bbi[i] = fre * bi + fim * br;
    }
    for (int idx = lane; idx < 1024; idx += 64) { cr[idx >> 6][idx & 63] = c_re[g * 1024 + idx]; ci[idx >> 6][idx & 63] = c_im[g * 1024 + idx]; }
    float dsk[16];
#pragma unroll
    for (int i = 0; i < 16; ++i) dsk[i] = dskip[g * 16 + i];
    float xre = 0.f, xim = 0.f;
    for (int t0 = 0; t0 < NL; t0 += 64) {
        wave_lds_fence();
        for (int idx = lane; idx < 1024; idx += 64) { const int t = idx >> 4, i = idx & 15; us[t][i] = bf2f(proj[(size_t)(b * NL + t0 + t) * EVEN_IN + g * 16 + i]); }
        wave_lds_fence();
        for (int t = 0; t < 64; ++t) {
            float bur = 0.f, bui = 0.f;
#pragma unroll
            for (int i = 0; i < 16; ++i) { const float u = us[t][i]; bur += bbr[i] * u; bui += bbi[i] * u; }
            const float nre = are * xre - aim * xim + bur, nim = are * xim + aim * xre + bui;
            xre = nre; xim = nim;
            xr[t][lane] = xre; xi[t][lane] = xim;
        }
        wave_lds_fence();
        float y[16];
#pragma unroll
        for (int i = 0; i < 16; ++i) y[i] = 0.f;
        for (int p = 0; p < 64; ++p) {
            const float a = xr[lane][p], bq = xi[lane][p];
#pragma unroll
            for (int i = 0; i < 16; ++i) y[i] += cr[i][p] * a - ci[i][p] * bq;
        }
#pragma unroll
        for (int i = 0; i < 16; ++i) {
            const float v = y[i] + dsk[i] * us[lane][i];
            ya[(size_t)(b * NL + t0 + lane) * 256 + g * 16 + i] = gelu_tanh(v);
        }
    }
}

__device__ __forceinline__ void sb_attn_wave(int task, const bf16_t* __restrict__ proj, bf16_t* __restrict__ Y, float* wl) {
    const int qt = task & 31, h = (task >> 5) % 12, b = task / 384, lane = tidx() & 63;
    const int t = qt * 64 + lane;
    float(*ks)[64] = (float(*)[64])wl;
    float(*vs)[64] = (float(*)[64])(wl + 2048);
    const bf16_t* base = proj + (size_t)b * NL * EVEN_IN;
    float q[64], acc[64];
#pragma unroll
    for (int d = 0; d < 64; d += 8) ld8(base + (size_t)t * EVEN_IN + 256 + h * 64 + d, q + d);
#pragma unroll
    for (int d = 0; d < 64; ++d) acc[d] = 0.f;
    float tail = 0.f;
    for (int c = 2 * qt + 1; c >= 0; --c) {
        wave_lds_fence();
        for (int i = 0; i < 32; ++i) {
            ks[i][lane] = bf2f(base[(size_t)(c * 32 + i) * EVEN_IN + 1024 + h * 64 + lane]);
            vs[i][lane] = bf2f(base[(size_t)(c * 32 + i) * EVEN_IN + 1792 + h * 64 + lane]);
        }
        wave_lds_fence();
        for (int s = 31; s >= 0; --s) {
            const int key = c * 32 + s;
            float z = 0.f;
#pragma unroll
            for (int d = 0; d < 64; ++d) z += q[d] * ks[s][d];
            z *= 0.125f;
            const bool valid = key < t;
            const float sp = fmaxf(z, 0.f) + log1pf(expf(-fabsf(z)));
            const float w = valid ? expf(z - sp + tail) : 0.f;
#pragma unroll
            for (int d = 0; d < 64; ++d) acc[d] += w * vs[s][d];
            if (valid) tail -= sp;
        }
        if (__all(tail < -120.f)) break;
    }
#pragma unroll
    for (int d = 0; d < 64; d += 8) st8(Y + (size_t)(b * NL + t) * ND + 256 + h * 64 + d, acc + d);
}

__device__ __forceinline__ void glu_phase(const float* __restrict__ ya, const float* __restrict__ wglu, const float* __restrict__ bglu, bf16_t* __restrict__ Y, float* lds) {
    const int half = tidx() >> 8, c = tidx() & 255;
    float(*ys)[256] = (float(*)[256])(lds + half * 4096);
    for (int it = blockIdx.x; it < NT / 32; it += gridDim.x) {
        const int t0 = it * 32 + half * 16;
        __syncthreads();
        for (int i = 0; i < 16; ++i) ys[i][c] = ya[(size_t)(t0 + i) * 256 + c];
        __syncthreads();
        float acc[16];
#pragma unroll
        for (int i = 0; i < 16; ++i) acc[i] = 0.f;
        for (int k = 0; k < 256; ++k) {
            const float w = wglu[k * 256 + c];
#pragma unroll
            for (int i = 0; i < 16; ++i) acc[i] += ys[i][k] * w;
        }
        const float bb = bglu[c];
#pragma unroll
        for (int i = 0; i < 16; ++i) Y[(size_t)(t0 + i) * ND + c] = f2bf(ys[i][c] * sigmoidf_(acc[i] + bb));
    }
    __syncthreads();
}

__device__ __forceinline__ void ln_row_wave(float4 (&v)[4], const float* __restrict__ g, const float* __restrict__ bta, float* out, bf16_t* outb, int lane) {
    float s = 0.f;
#pragma unroll
    for (int j = 0; j < 4; ++j) s += v[j].x + v[j].y + v[j].z + v[j].w;
    for (int o = 32; o; o >>= 1) s += __shfl_xor(s, o);
    const float mean = s * (1.f / ND);
    float s2 = 0.f;
#pragma unroll
    for (int j = 0; j < 4; ++j) {
        v[j].x -= mean; v[j].y -= mean; v[j].z -= mean; v[j].w -= mean;
        s2 += v[j].x * v[j].x + v[j].y * v[j].y + v[j].z * v[j].z + v[j].w * v[j].w;
    }
    for (int o = 32; o; o >>= 1) s2 += __shfl_xor(s2, o);
    const float rs = rsqrtf(s2 * (1.f / ND) + LN_EPS);
#pragma unroll
    for (int j = 0; j < 4; ++j) {
        const float4 gg = *(const float4*)(g + j * 256 + lane * 4), bb = *(const float4*)(bta + j * 256 + lane * 4);
        const float4 o = make_float4(v[j].x * rs * gg.x + bb.x, v[j].y * rs * gg.y + bb.y, v[j].z * rs * gg.z + bb.z, v[j].w * rs * gg.w + bb.w);
        *(float4*)(out + j * 256 + lane * 4) = o;
        if (outb) { uint2 w; w.x = pack2(o.x, o.y); w.y = pack2(o.z, o.w); *(uint2*)(outb + j * 256 + lane * 4) = w; }
    }
}
__device__ __forceinline__ void ln_phase(float* R, bf16_t* Hb, const float* __restrict__ g, const float* __restrict__ bta) {
    const int wave = tidx() >> 6, lane = tidx() & 63;
    for (int row = blockIdx.x * 8 + wave; row < NT; row += gridDim.x * 8) {
        float4 v[4];
#pragma unroll
        for (int j = 0; j < 4; ++j) v[j] = *(const float4*)(R + (size_t)row * ND + j * 256 + lane * 4);
        ln_row_wave(v, g, bta, R + (size_t)row * ND, Hb + (size_t)row * ND, lane);
    }
}

__device__ __forceinline__ void wave_argmax(float& bv, int& bi) {
#pragma unroll
    for (int o = 32; o; o >>= 1) {
        const float ov = __shfl_xor(bv, o); const int oi = __shfl_xor(bi, o);
        if (ov > bv || (ov == bv && oi < bi)) { bv = ov; bi = oi; }
    }
}
__device__ __forceinline__ void peer_route_phase(const bf16_t* __restrict__ qbuf, const float* __restrict__ subk, int* __restrict__ eidx, float* __restrict__ egate, float* lds) {
    const int head = tidx() >> 6, lane = tidx() & 63;
    float* qs = lds + head * 256;
    for (int token = blockIdx.x; token < NT; token += gridDim.x) {
        const bf16_t* qp = qbuf + (size_t)token * 2048 + head * 256;
        wave_lds_fence();
        for (int i = 0; i < 4; ++i) qs[lane + 64 * i] = bf2f(qp[lane + 64 * i]);
        wave_lds_fence();
        float myv[2]; int myi[2];
#pragma unroll
        for (int c = 0; c < 2; ++c) {
            float sc[2];
#pragma unroll
            for (int w2 = 0; w2 < 2; ++w2) {
                const float* kr = subk + ((size_t)(head * 2 + c) * 128 + lane + 64 * w2) * 128;
                float a = 0.f;
#pragma unroll 4
                for (int d = 0; d < 128; d += 4) {
                    const float4 kv = *(const float4*)(kr + d);
                    a += qs[c * 128 + d] * kv.x + qs[c * 128 + d + 1] * kv.y + qs[c * 128 + d + 2] * kv.z + qs[c * 128 + d + 3] * kv.w;
                }
                sc[w2] = a;
            }
            float a0 = sc[0], a1 = sc[1];
            float mv = -INFINITY; int mi = 0;
            for (int r = 0; r < 16; ++r) {
                float bv; int bi;
                if (a0 >= a1) { bv = a0; bi = lane; } else { bv = a1; bi = lane + 64; }
                wave_argmax(bv, bi);
                if (lane == r) { mv = bv; mi = bi; }
                if (bi == lane) a0 = -INFINITY; else if (bi == lane + 64) a1 = -INFINITY;
            }
            myv[c] = mv; myi[c] = mi;
        }
        const float va = __shfl(myv[0], lane >> 2);
        float cand[4];
#pragma unroll
        for (int j = 0; j < 4; ++j) cand[j] = va + __shfl(myv[1], (lane & 3) * 4 + j);
        float topv = -INFINITY; int topf = 0;
        for (int r = 0; r < 16; ++r) {
            float bv = cand[0]; int bi = lane * 4;
#pragma unroll
            for (int j = 1; j < 4; ++j) if (cand[j] > bv) { bv = cand[j]; bi = lane * 4 + j; }
            wave_argmax(bv, bi);
            if (lane == r) { topv = bv; topf = bi; }
#pragma unroll
            for (int j = 0; j < 4; ++j) if (bi == lane * 4 + j) cand[j] = -INFINITY;
        }
        const int e1 = __shfl(myi[0], topf >> 4), e2 = __shfl(myi[1], topf & 15);
        const float top0 = __shfl(topv, 0);
        float ex = (lane < 16) ? expf(topv - top0) : 0.f;
        float sum = ex;
        for (int o = 32; o; o >>= 1) sum += __shfl_xor(sum, o);
        if (lane < 16) {
            eidx[(size_t)token * 128 + head * 16 + lane] = e1 * 128 + e2;
            egate[(size_t)token * 128 + head * 16 + lane] = ex / sum;
        }
    }
}

__device__ __forceinline__ void peer_expert_phase(float* R, const int* __restrict__ eidx, const float* __restrict__ egate, const float* __restrict__ utab,
                                  const float* __restrict__ vtab, const float* __restrict__ lg, const float* __restrict__ lb, bf16_t* Hb) {
    const int wave = tidx() >> 6, lane = tidx() & 63;
    for (int token = blockIdx.x * 8 + wave; token < NT; token += gridDim.x * 8) {
        float4 x[4], acc[4];
#pragma unroll
        for (int j = 0; j < 4; ++j) { x[j] = *(const float4*)(R + (size_t)token * ND + j * 256 + lane * 4); acc[j] = make_float4(0.f, 0.f, 0.f, 0.f); }
        for (int e0 = 0; e0 < 128; e0 += 4) {
            float dot[4]; int ex[4]; float gt[4];
#pragma unroll
            for (int k = 0; k < 4; ++k) {
                ex[k] = eidx[(size_t)token * 128 + e0 + k]; gt[k] = egate[(size_t)token * 128 + e0 + k];
                const float* ur = utab + (size_t)ex[k] * ND + lane * 4;
                float a = 0.f;
#pragma unroll
                for (int j = 0; j < 4; ++j) { const float4 u = *(const float4*)(ur + j * 256); a += x[j].x * u.x + x[j].y * u.y + x[j].z * u.z + x[j].w * u.w; }
                dot[k] = a;
            }
#pragma unroll
            for (int k = 0; k < 4; ++k) {
                float a = dot[k];
                for (int o = 32; o; o >>= 1) a += __shfl_xor(a, o);
                const float coef = gt[k] * gelu_tanh(a);
                const float* vr = vtab + (size_t)ex[k] * ND + lane * 4;
#pragma unroll
                for (int j = 0; j < 4; ++j) { const float4 v = *(const float4*)(vr + j * 256); acc[j].x += coef * v.x; acc[j].y += coef * v.y; acc[j].z += coef * v.z; acc[j].w += coef * v.w; }
            }
        }
#pragma unroll
        for (int j = 0; j < 4; ++j) { x[j].x = ALPHA * x[j].x + acc[j].x; x[j].y = ALPHA * x[j].y + acc[j].y; x[j].z = ALPHA * x[j].z + acc[j].z; x[j].w = ALPHA * x[j].w + acc[j].w; }
        ln_row_wave(x, lg, lb, R + (size_t)token * ND, Hb ? Hb + (size_t)token * ND : nullptr, lane);
    }
}


typedef short bf16x8_t __attribute__((ext_vector_type(8)));
__device__ __forceinline__ int f2key(float f) { const int b = __float_as_int(f); return b ^ ((b >> 31) & 0x7fffffff); }
__device__ __forceinline__ float key2f(int k) { return __int_as_float(k ^ ((k >> 31) & 0x7fffffff)); }
#define CE_DESC_I(a, b) do { const int _hi = max(a, b), _lo = min(a, b); a = _hi; b = _lo; } while (0)
template <int N, int K, int J> __device__ __forceinline__ void bstage(int (&v)[N]) {
#pragma unroll
    for (int i = 0; i < N; ++i) {
        const int l = i ^ J;
        if (l > i) { if ((i & K) == 0) CE_DESC_I(v[i], v[l]); else CE_DESC_I(v[l], v[i]); }
    }
}
__device__ __forceinline__ void sort16_desc(int (&v)[16]) {
    bstage<16, 2, 1>(v); bstage<16, 4, 2>(v); bstage<16, 4, 1>(v); bstage<16, 8, 4>(v); bstage<16, 8, 2>(v); bstage<16, 8, 1>(v);
    bstage<16, 16, 8>(v); bstage<16, 16, 4>(v); bstage<16, 16, 2>(v); bstage<16, 16, 1>(v);
}
__device__ __forceinline__ void sort8_desc(int (&v)[8]) {
    bstage<8, 2, 1>(v); bstage<8, 4, 2>(v); bstage<8, 4, 1>(v); bstage<8, 8, 4>(v); bstage<8, 8, 2>(v); bstage<8, 8, 1>(v);
}
__device__ __forceinline__ void bitonic_merge16_desc(int (&v)[16]) {
    bstage<16, 16, 8>(v); bstage<16, 16, 4>(v); bstage<16, 16, 2>(v); bstage<16, 16, 1>(v);
}
__device__ __forceinline__ void xmerge16(int (&v)[16], int off) {
    int m[16];
#pragma unroll
    for (int i = 0; i < 16; ++i) m[i] = max(v[i], __shfl_xor(v[15 - i], off));
    bitonic_merge16_desc(m);
#pragma unroll
    for (int i = 0; i < 16; ++i) v[i] = m[i];
}
__device__ __forceinline__ void opaque16(int (&v)[16]) {
#pragma unroll
    for (int i = 0; i < 16; ++i) asm volatile("" : "+v"(v[i]));
}
__device__ __forceinline__ int lookup16(const int (&arr)[16], int a) {
    int r = arr[0];
#pragma unroll
    for (int i = 1; i < 16; ++i) r = (a == i) ? arr[i] : r;
    return r;
}
__device__ __forceinline__ void peer_route2_phase(const bf16_t* __restrict__ qbuf, const bf16_t* __restrict__ skb, int* __restrict__ eidx, float* __restrict__ egate, unsigned char* lds) {
    const int tid = tidx(), wave = tid >> 6, lane = tid & 63, fr = lane & 15, fq = lane >> 4;
    for (int chunk = blockIdx.x; chunk < NT / 128; chunk += gridDim.x) {
        const int token = chunk * 128 + wave * 16 + fr;
        int* tl = (int*)(lds + 34816) + (wave * 16 + fr) * 48;
        for (int h = 0; h < 8; ++h) {
            int K1[16], K2[16];
#pragma unroll
            for (int c = 0; c < 2; ++c) {
                __syncthreads();
#pragma unroll
                for (int i = 0; i < 4; ++i) {
                    const int idx = tid + 512 * i, row = idx >> 4, ch = idx & 15;
                    *(uint4*)(lds + row * 272 + ch * 16) = *(const uint4*)(skb + ((size_t)(h * 2 + c) * 128 + row) * 128 + ch * 8);
                }
                __syncthreads();
                bf16x8_t qf[4];
#pragma unroll
                for (int sI = 0; sI < 4; ++sI) qf[sI] = *(const bf16x8_t*)(qbuf + (size_t)token * 2048 + h * 256 + c * 128 + 32 * sI + 8 * fq);
                int va[16], vb[16];
#pragma unroll
                for (int n = 0; n < 8; ++n) {
                    f32x4 S = {0.f, 0.f, 0.f, 0.f};
#pragma unroll
                    for (int sI = 0; sI < 4; ++sI) {
                        const bf16x8_t kf = *(const bf16x8_t*)(lds + (16 * n + fr) * 272 + (32 * sI + 8 * fq) * 2);
                        S = __builtin_amdgcn_mfma_f32_16x16x32_bf16(kf, qf[sI], S, 0, 0, 0);
                    }
#pragma unroll
                    for (int j = 0; j < 4; ++j) {
                        const int key = (f2key(S[j]) & ~127) | (16 * n + 4 * fq + j);
                        if (n < 4) va[n * 4 + j] = key; else vb[(n - 4) * 4 + j] = key;
                    }
                }
                sort16_desc(va); sort16_desc(vb);
                int m[16];
#pragma unroll
                for (int i = 0; i < 16; ++i) m[i] = max(va[i], vb[15 - i]);
                bitonic_merge16_desc(m);
                xmerge16(m, 16); xmerge16(m, 32);
#pragma unroll
                for (int i = 0; i < 16; ++i) { if (c == 0) K1[i] = m[i]; else K2[i] = m[i]; }
                if (fq == 0) {
#pragma unroll
                    for (int i = 0; i < 4; ++i) *(int4*)(tl + c * 16 + 4 * i) = make_int4(m[4 * i], m[4 * i + 1], m[4 * i + 2], m[4 * i + 3]);
                }
            }
            wave_lds_fence();
            float vaf[4];
#pragma unroll
            for (int k = 0; k < 4; ++k) vaf[k] = key2f(tl[4 * k + fq]);
            int A[16];
#pragma unroll
            for (int b = 0; b < 16; ++b) {
                const bool valid = (fq + 1) * (b + 1) <= 16;
                const int key = (f2key(vaf[0] + key2f(K2[b])) & ~127) | (fq << 5) | b;
                A[b] = valid ? key : INT_MIN;
            }
            int Bq[8];
#pragma unroll
            for (int b = 0; b < 3; ++b) {
                const bool valid = (fq + 5) * (b + 1) <= 16;
                const int key = (f2key(vaf[1] + key2f(K2[b])) & ~127) | (fq << 5) | (16 + b);
                Bq[b] = valid ? key : INT_MIN;
            }
            Bq[3] = (f2key(vaf[2] + key2f(K2[0])) & ~127) | (fq << 5) | 19;
            Bq[4] = (f2key(vaf[3] + key2f(K2[0])) & ~127) | (fq << 5) | 20;
            Bq[5] = INT_MIN; Bq[6] = INT_MIN; Bq[7] = INT_MIN;
            sort8_desc(Bq);
#pragma unroll
            for (int i = 8; i < 16; ++i) A[i] = max(A[i], Bq[15 - i]);
            bitonic_merge16_desc(A);
            xmerge16(A, 16); xmerge16(A, 32);
            if (fq == 0) {
#pragma unroll
                for (int i = 0; i < 4; ++i) *(int4*)(tl + 32 + 4 * i) = make_int4(A[4 * i], A[4 * i + 1], A[4 * i + 2], A[4 * i + 3]);
            }
            wave_lds_fence();
            const int4 myT = *(const int4*)(tl + 32 + 4 * fq);
            const int tsel[4] = {myT.x, myT.y, myT.z, myT.w};
            const float top0 = key2f(A[0]);
            float sum = 0.f;
#pragma unroll
            for (int r = 0; r < 16; ++r) sum += __expf(key2f(A[r]) - top0);
            const float inv = 1.f / sum;
            int eo[4]; float go[4];
#pragma unroll
            for (int kk = 0; kk < 4; ++kk) {
                const int t = tsel[kk];
                const int id = t & 127, ofq = id >> 5, slot = id & 31;
                const int k = slot < 16 ? 0 : (slot < 19 ? 1 : (slot == 19 ? 2 : 3));
                const int b = slot < 16 ? slot : (slot < 19 ? slot - 16 : 0);
                const int a = ofq + 4 * k;
                const int e1 = tl[a] & 127, e2 = tl[16 + b] & 127;
                eo[kk] = e1 * 128 + e2;
                go[kk] = __expf(key2f(t) - top0) * inv;
            }
            *(int4*)(eidx + (size_t)token * 128 + h * 16 + 4 * fq) = make_int4(eo[0], eo[1], eo[2], eo[3]);
            *(float4*)(egate + (size_t)token * 128 + h * 16 + 4 * fq) = make_float4(go[0], go[1], go[2], go[3]);
            wave_lds_fence();
        }
    }
    __syncthreads();
}

typedef __bf16 bf16x2_t __attribute__((ext_vector_type(2)));
typedef float f32x2_t __attribute__((ext_vector_type(2)));
__device__ __forceinline__ float dot2bf(unsigned a, unsigned b, float acc) { return __builtin_amdgcn_fdot2_f32_bf16(__builtin_bit_cast(bf16x2_t, a), __builtin_bit_cast(bf16x2_t, b), acc, false); }
__device__ __forceinline__ float gelu_fast(float x) {
    const float u = 0.7978845608028654f * (x + 0.044715f * x * x * x);
    return x / (1.f + __expf(-2.f * u));
}
__device__ __forceinline__ void peer_expert2_phase(float* R, const int* __restrict__ eidx, const float* __restrict__ egate, const bf16_t* __restrict__ ub,
                                                   const bf16_t* __restrict__ vb, const float* __restrict__ lg, const float* __restrict__ lb, bf16_t* Hb) {
    const int wave = tidx() >> 6, lane = tidx() & 63;
    for (int token = blockIdx.x * 8 + wave; token < NT; token += gridDim.x * 8) {
        float xf[16];
        {
            const float* rp = R + (size_t)token * ND + lane * 8;
            const float4 a0 = *(const float4*)rp, a1 = *(const float4*)(rp + 4), b0 = *(const float4*)(rp + 512), b1 = *(const float4*)(rp + 516);
            xf[0] = a0.x; xf[1] = a0.y; xf[2] = a0.z; xf[3] = a0.w; xf[4] = a1.x; xf[5] = a1.y; xf[6] = a1.z; xf[7] = a1.w;
            xf[8] = b0.x; xf[9] = b0.y; xf[10] = b0.z; xf[11] = b0.w; xf[12] = b1.x; xf[13] = b1.y; xf[14] = b1.z; xf[15] = b1.w;
        }
        unsigned xp[8];
#pragma unroll
        for (int j = 0; j < 8; ++j) xp[j] = pack2(xf[2 * j], xf[2 * j + 1]);
        float acc[16];
#pragma unroll
        for (int j = 0; j < 16; ++j) acc[j] = 0.f;
        const int e_lo = eidx[(size_t)token * 128 + lane], e_hi = eidx[(size_t)token * 128 + 64 + lane];
        const float g_lo = egate[(size_t)token * 128 + lane], g_hi = egate[(size_t)token * 128 + 64 + lane];
        for (int grp = 0; grp < 16; ++grp) {
            const int esel = grp < 8 ? e_lo : e_hi;
            const float gsel = grp < 8 ? g_lo : g_hi;
            const int lbase = (grp & 7) * 8;
            uint4 u0[8], u1[8];
            int exs[8];
#pragma unroll
            for (int k = 0; k < 8; ++k) {
                exs[k] = __builtin_amdgcn_readlane(esel, lbase + k);
                const bf16_t* up = ub + (size_t)exs[k] * ND + lane * 8;
                u0[k] = *(const uint4*)up; u1[k] = *(const uint4*)(up + 512);
            }
            float d[8];
#pragma unroll
            for (int k = 0; k < 8; ++k) {
                float a = dot2bf(u0[k].x, xp[0], 0.f), b = dot2bf(u0[k].y, xp[1], 0.f);
                a = dot2bf(u0[k].z, xp[2], a); b = dot2bf(u0[k].w, xp[3], b);
                a = dot2bf(u1[k].x, xp[4], a); b = dot2bf(u1[k].y, xp[5], b);
                a = dot2bf(u1[k].z, xp[6], a); b = dot2bf(u1[k].w, xp[7], b);
                d[k] = a + b;
            }
            const bool hi5 = lane & 32, hi4 = lane & 16, hi3 = lane & 8;
            float r4[4], r2[2], r1;
#pragma unroll
            for (int k = 0; k < 4; ++k) { const float send = hi5 ? d[k] : d[k + 4], keep = hi5 ? d[k + 4] : d[k]; r4[k] = keep + __shfl_xor(send, 32); }
#pragma unroll
            for (int k = 0; k < 2; ++k) { const float send = hi4 ? r4[k] : r4[k + 2], keep = hi4 ? r4[k + 2] : r4[k]; r2[k] = keep + __shfl_xor(send, 16); }
            { const float send = hi3 ? r2[0] : r2[1], keep = hi3 ? r2[1] : r2[0]; r1 = keep + __shfl_xor(send, 8); }
            r1 += __shfl_xor(r1, 4); r1 += __shfl_xor(r1, 2); r1 += __shfl_xor(r1, 1);
            uint4 v0[8], v1[8];
#pragma unroll
            for (int k = 0; k < 8; ++k) {
                const bf16_t* vp = vb + (size_t)exs[k] * ND + lane * 8;
                v0[k] = *(const uint4*)vp; v1[k] = *(const uint4*)(vp + 512);
            }
            const float gk = __shfl(gsel, lbase + (lane >> 3));
            const float coef = gk * gelu_fast(r1);
#pragma unroll
            for (int k = 0; k < 8; ++k) {
                const float ck = __int_as_float(__builtin_amdgcn_readlane(__float_as_int(coef), 8 * k));
                const unsigned w[8] = {v0[k].x, v0[k].y, v0[k].z, v0[k].w, v1[k].x, v1[k].y, v1[k].z, v1[k].w};
#pragma unroll
                for (int j = 0; j < 8; ++j) {
                    acc[2 * j] += ck * __uint_as_float(w[j] << 16);
                    acc[2 * j + 1] += ck * __uint_as_float(w[j] & 0xffff0000u);
                }
            }
        }
        {
            const float* rp = R + (size_t)token * ND + lane * 8;
            const float4 a0 = *(const float4*)rp, a1 = *(const float4*)(rp + 4), b0 = *(const float4*)(rp + 512), b1 = *(const float4*)(rp + 516);
            xf[0] = a0.x; xf[1] = a0.y; xf[2] = a0.z; xf[3] = a0.w; xf[4] = a1.x; xf[5] = a1.y; xf[6] = a1.z; xf[7] = a1.w;
            xf[8] = b0.x; xf[9] = b0.y; xf[10] = b0.z; xf[11] = b0.w; xf[12] = b1.x; xf[13] = b1.y; xf[14] = b1.z; xf[15] = b1.w;
        }
        float s = 0.f;
#pragma unroll
        for (int j = 0; j < 16; ++j) { xf[j] = ALPHA * xf[j] + acc[j]; s += xf[j]; }
        for (int o = 32; o; o >>= 1) s += __shfl_xor(s, o);
        const float mean = s * (1.f / ND);
        float s2 = 0.f;
#pragma unroll
        for (int j = 0; j < 16; ++j) { xf[j] -= mean; s2 += xf[j] * xf[j]; }
        for (int o = 32; o; o >>= 1) s2 += __shfl_xor(s2, o);
        const float rs = rsqrtf(s2 * (1.f / ND) + LN_EPS);
#pragma unroll
        for (int hf = 0; hf < 2; ++hf) {
            const int c0 = hf * 512 + lane * 8;
            const float4 g0 = *(const float4*)(lg + c0), g1 = *(const float4*)(lg + c0 + 4), b0 = *(const float4*)(lb + c0), b1 = *(const float4*)(lb + c0 + 4);
            float o[8];
            o[0] = xf[hf * 8 + 0] * rs * g0.x + b0.x; o[1] = xf[hf * 8 + 1] * rs * g0.y + b0.y; o[2] = xf[hf * 8 + 2] * rs * g0.z + b0.z; o[3] = xf[hf * 8 + 3] * rs * g0.w + b0.w;
            o[4] = xf[hf * 8 + 4] * rs * g1.x + b1.x; o[5] = xf[hf * 8 + 5] * rs * g1.y + b1.y; o[6] = xf[hf * 8 + 6] * rs * g1.z + b1.z; o[7] = xf[hf * 8 + 7] * rs * g1.w + b1.w;
            float* op = R + (size_t)token * ND + c0;
            *(float4*)op = make_float4(o[0], o[1], o[2], o[3]); *(float4*)(op + 4) = make_float4(o[4], o[5], o[6], o[7]);
            if (Hb) st8(Hb + (size_t)token * ND + c0, o);
        }
    }
}


__device__ __forceinline__ void peer_expert3_phase(float* R, const int* __restrict__ eidx, const float* __restrict__ egate, const unsigned char* __restrict__ ub,
                                                   const unsigned char* __restrict__ vb, const float* __restrict__ lg, const float* __restrict__ lb, bf16_t* Hb) {
    const int wave = tidx() >> 6, lane = tidx() & 63;
    for (int token = blockIdx.x * 8 + wave; token < NT; token += gridDim.x * 8) {
        float xf[16];
        {
            const float* rp = R + (size_t)token * ND + lane * 16;
#pragma unroll
            for (int q = 0; q < 4; ++q) { const float4 a = *(const float4*)(rp + 4 * q); xf[4 * q] = a.x; xf[4 * q + 1] = a.y; xf[4 * q + 2] = a.z; xf[4 * q + 3] = a.w; }
        }
        float acc[16];
#pragma unroll
        for (int j = 0; j < 16; ++j) acc[j] = 0.f;
        const int e_lo = eidx[(size_t)token * 128 + lane], e_hi = eidx[(size_t)token * 128 + 64 + lane];
        const float g_lo = egate[(size_t)token * 128 + lane], g_hi = egate[(size_t)token * 128 + 64 + lane];
        for (int grp = 0; grp < 16; ++grp) {
            const int esel = grp < 8 ? e_lo : e_hi;
            const float gsel = grp < 8 ? g_lo : g_hi;
            const int lbase = (grp & 7) * 8;
            uint4 u[8], v[8];
#pragma unroll
            for (int k = 0; k < 8; ++k) {
                const int ex = __builtin_amdgcn_readlane(esel, lbase + k);
                u[k] = *(const uint4*)(ub + (size_t)ex * ND + lane * 16);
                v[k] = *(const uint4*)(vb + (size_t)ex * ND + lane * 16);
            }
            float d[8];
#pragma unroll
            for (int k = 0; k < 8; ++k) {
                const unsigned w[4] = {u[k].x, u[k].y, u[k].z, u[k].w};
                float a = 0.f, b = 0.f;
#pragma unroll
                for (int q = 0; q < 4; ++q) {
                    const f32x2_t lo = __builtin_amdgcn_cvt_pk_f32_fp8((int)w[q], false), hi = __builtin_amdgcn_cvt_pk_f32_fp8((int)w[q], true);
                    a = fmaf(xf[4 * q], lo.x, a); b = fmaf(xf[4 * q + 1], lo.y, b); a = fmaf(xf[4 * q + 2], hi.x, a); b = fmaf(xf[4 * q + 3], hi.y, b);
                }
                d[k] = a + b;
            }
            const bool hi5 = lane & 32, hi4 = lane & 16, hi3 = lane & 8;
            float r4[4], r2[2], r1;
#pragma unroll
            for (int k = 0; k < 4; ++k) { const float send = hi5 ? d[k] : d[k + 4], keep = hi5 ? d[k + 4] : d[k]; r4[k] = keep + __shfl_xor(send, 32); }
#pragma unroll
            for (int k = 0; k < 2; ++k) { const float send = hi4 ? r4[k] : r4[k + 2], keep = hi4 ? r4[k + 2] : r4[k]; r2[k] = keep + __shfl_xor(send, 16); }
            { const float send = hi3 ? r2[0] : r2[1], keep = hi3 ? r2[1] : r2[0]; r1 = keep + __shfl_xor(send, 8); }
            r1 += __shfl_xor(r1, 4); r1 += __shfl_xor(r1, 2); r1 += __shfl_xor(r1, 1);
            const float gk = __shfl(gsel, lbase + (lane >> 3));
            const float coef = gk * gelu_fast(r1 * (1.f / U_SCALE)) * (1.f / V_SCALE);
#pragma unroll
            for (int k = 0; k < 8; ++k) {
                const float ck = __int_as_float(__builtin_amdgcn_readlane(__float_as_int(coef), 8 * k));
                const unsigned w[4] = {v[k].x, v[k].y, v[k].z, v[k].w};
#pragma unroll
                for (int q = 0; q < 4; ++q) {
                    const f32x2_t lo = __builtin_amdgcn_cvt_pk_f32_fp8((int)w[q], false), hi = __builtin_amdgcn_cvt_pk_f32_fp8((int)w[q], true);
                    acc[4 * q] = fmaf(ck, lo.x, acc[4 * q]); acc[4 * q + 1] = fmaf(ck, lo.y, acc[4 * q + 1]);
                    acc[4 * q + 2] = fmaf(ck, hi.x, acc[4 * q + 2]); acc[4 * q + 3] = fmaf(ck, hi.y, acc[4 * q + 3]);
                }
            }
        }
        float s = 0.f;
#pragma unroll
        for (int j = 0; j < 16; ++j) { xf[j] = ALPHA * xf[j] + acc[j]; s += xf[j]; }
        for (int o = 32; o; o >>= 1) s += __shfl_xor(s, o);
        const float mean = s * (1.f / ND);
        float s2 = 0.f;
#pragma unroll
        for (int j = 0; j < 16; ++j) { xf[j] -= mean; s2 += xf[j] * xf[j]; }
        for (int o = 32; o; o >>= 1) s2 += __shfl_xor(s2, o);
        const float rs = rsqrtf(s2 * (1.f / ND) + LN_EPS);
        float o[16];
#pragma unroll
        for (int q = 0; q < 4; ++q) {
            const float4 gg = *(const float4*)(lg + lane * 16 + 4 * q), bb = *(const float4*)(lb + lane * 16 + 4 * q);
            o[4 * q] = xf[4 * q] * rs * gg.x + bb.x; o[4 * q + 1] = xf[4 * q + 1] * rs * gg.y + bb.y; o[4 * q + 2] = xf[4 * q + 2] * rs * gg.z + bb.z; o[4 * q + 3] = xf[4 * q + 3] * rs * gg.w + bb.w;
            *(float4*)(R + (size_t)token * ND + lane * 16 + 4 * q) = make_float4(o[4 * q], o[4 * q + 1], o[4 * q + 2], o[4 * q + 3]);
        }
        if (Hb) { st8(Hb + (size_t)token * ND + lane * 16, o); st8(Hb + (size_t)token * ND + lane * 16 + 8, o + 8); }
    }
}

__device__ __forceinline__ void nsa_compress_phase(const bf16_t* __restrict__ proj, int coloff, const float* __restrict__ pe, const float* __restrict__ w1,
                                   const float* __restrict__ w2, float* __restrict__ outc, float* lds) {
    const int qtr = tidx() >> 7, tid = tidx() & 127;
    float* in = lds + qtr * 2176;
    float* hid = in + 2048;
    for (int it = blockIdx.x; it < NB * 127; it += gridDim.x) {
        const int g = qtr, n = it % 127, b = it / 127;
        __syncthreads();
        for (int idx = tid; idx < 2048; idx += 128) {
            const int l = idx >> 6, d = idx & 63;
            in[idx] = bf2f(proj[(size_t)(b * NL + 16 * n + l) * ODD_PAD + coloff + g * 64 + d]) + pe[l * 64 + d];
        }
        __syncthreads();
        float a = 0.f;
        for (int i = 0; i < 2048; ++i) a += in[i] * w1[(size_t)i * 128 + tid];
        hid[tid] = gelu_tanh(a);
        __syncthreads();
        if (tid < 64) {
            float o = 0.f;
            for (int j = 0; j < 128; ++j) o += hid[j] * w2[j * 64 + tid];
            outc[((size_t)(b * 127 + n) * 4 + g) * 64 + tid] = o;
        }
    }
    __syncthreads();
}

__device__ __forceinline__ void nsa_cmp_phase(const bf16_t* __restrict__ proj, const float* __restrict__ kcmp, const float* __restrict__ vcmp,
                              bf16_t* __restrict__ O, unsigned* __restrict__ selmask, float* lds) {
    const int half = tidx() >> 8, tid = tidx() & 255;
    float* kc_s = lds + half * 18368;
    float* vc_s = kc_s + 127 * 64;
    float(*imp_s)[33] = (float(*)[33])(vc_s + 127 * 64);
    const int tk = tid >> 2, r = tid & 3;
    for (int it = blockIdx.x; it < 32 * 4 * NB / 2; it += gridDim.x) {
        const int vb = it * 2 + half;
        const int tile = vb & 31, g = (vb >> 5) & 3, b = vb >> 7;
        const int t = tile * 64 + tk, hd = g * 4 + r;
        __syncthreads();
        for (int idx = tid; idx < 127 * 64; idx += 256) { const int n = idx >> 6, d = idx & 63; kc_s[idx] = kcmp[((size_t)(b * 127 + n) * 4 + g) * 64 + d]; vc_s[idx] = vcmp[((size_t)(b * 127 + n) * 4 + g) * 64 + d]; }
        const bf16_t* prow = proj + (size_t)(b * NL + t) * ODD_PAD;
        float q[64];
#pragma unroll
        for (int d = 0; d < 64; d += 8) ld8(prow + hd * 64 + d, q + d);
        const float slope = exp2f(-0.5f * (float)(hd + 1));
        int nvalid = (t >= 31) ? ((t - 31) / 16 + 1) : 0;
        if (nvalid > 127) nvalid = 127;
        __syncthreads();
        float m = -INFINITY, l = 0.f;
        for (int n = 0; n < nvalid; ++n) {
            float s = 0.f;
#pragma unroll
            for (int d = 0; d < 64; ++d) s += q[d] * kc_s[n * 64 + d];
            s = s * 0.125f - slope * (float)(t - (16 * n + 31));
            const float mn = fmaxf(m, s);
            l = l * expf(m - mn) + expf(s - mn);
            m = mn;
        }
        const float inv_l = (nvalid > 0) ? 1.f / fmaxf(l, 1e-30f) : 0.f;
        float acc[64];
#pragma unroll
        for (int d = 0; d < 64; ++d) acc[d] = 0.f;
        float prev3 = 0.f;
        for (int j = 0; j < 32; ++j) {
            float pj[4];
#pragma unroll
            for (int nn = 0; nn < 4; ++nn) {
                const int n = 4 * j + nn;
                float p = 0.f;
                if (n < nvalid) {
                    float s = 0.f;
#pragma unroll
                    for (int d = 0; d < 64; ++d) s += q[d] * kc_s[n * 64 + d];
                    s = s * 0.125f - slope * (float)(t - (16 * n + 31));
                    p = expf(s - m) * inv_l;
                    const float* vr = vc_s + n * 64;
#pragma unroll
                    for (int d = 0; d < 64; ++d) acc[d] += p * vr[d];
                }
                pj[nn] = p;
            }
            float im = 0.5f * prev3 + pj[0] + pj[1] + pj[2] + 0.5f * pj[3];
            prev3 = pj[3];
            im += __shfl_xor(im, 1);
            im += __shfl_xor(im, 2);
            if (r == 0) imp_s[tk][j] = im;
        }
        const float g0 = sigmoidf_(bf2f(prow[2048 + hd]));
#pragma unroll
        for (int d = 0; d < 64; ++d) acc[d] *= g0;
#pragma unroll
        for (int d = 0; d < 64; d += 8) st8(O + (size_t)(b * NL + t) * ND + hd * 64 + d, acc + d);
        __syncthreads();
        const int cur = tile;
        unsigned bits = 0;
        for (int jj = 0; jj < 8; ++jj) {
            const int j = r * 8 + jj;
            const bool fj = (j == 0) || (j == cur) || (j == cur - 1);
            const float vj = (j <= cur) ? imp_s[tk][j] + (fj ? 1000.f : 0.f) : -INFINITY;
            int rank = 0;
            for (int k = 0; k < 32; ++k) {
                const bool fk = (k == 0) || (k == cur) || (k == cur - 1);
                const float vk = (k <= cur) ? imp_s[tk][k] + (fk ? 1000.f : 0.f) : -INFINITY;
                rank += (vk > vj || (vk == vj && k < j)) ? 1 : 0;
            }
            if (rank < 16) bits |= 1u << j;
        }
        bits |= __shfl_xor(bits, 1);
        bits |= __shfl_xor(bits, 2);
        if (r == 0) selmask[(size_t)(b * 4 + g) * NL + t] = bits;
    }
    __syncthreads();
}

__device__ __forceinline__ void nsa_selwin_phase(const bf16_t* __restrict__ proj, const unsigned* __restrict__ selmask, bf16_t* O, float* lds) {
    const int half = tidx() >> 8, tid = tidx() & 255;
    float(*k_s)[64] = (float(*)[64])(lds + half * 8192);
    float(*v_s)[64] = (float(*)[64])(lds + half * 8192 + 4096);
    const int tk = tid >> 2, r = tid & 3;
    for (int it = blockIdx.x; it < 32 * 32; it += gridDim.x) {
        const int tile = 31 - (it >> 5);
        const int bgi = (it & 31) * 2 + half, g = bgi & 3, b = bgi >> 2;
        const int t = tile * 64 + tk, hd = g * 4 + r;
        const bf16_t* pb = proj + (size_t)b * NL * ODD_PAD;
        const bf16_t* prow = pb + (size_t)t * ODD_PAD;
        float q[64], acc[64];
#pragma unroll
        for (int d = 0; d < 64; d += 8) ld8(prow + hd * 64 + d, q + d);
        const float slope = exp2f(-0.5f * (float)(hd + 1));
        const unsigned mask = selmask[(size_t)(b * 4 + g) * NL + t];
        bf16_t* orow = O + (size_t)(b * NL + t) * ND + hd * 64;
        for (int branch = 0; branch < 2; ++branch) {
            const int kcol = (branch == 0 ? 1536 : 2048) + g * 64, vcol = kcol + 256;
            const int j0 = (branch == 0) ? 0 : (tile >= 8 ? tile - 8 : 0);
            float m = -1e30f, l = 0.f;
#pragma unroll
            for (int d = 0; d < 64; ++d) acc[d] = 0.f;
            for (int j = j0; j <= tile; ++j) {
                __syncthreads();
                for (int i = 0; i < 16; ++i) {
                    const int idx = tid + 256 * i, key = idx >> 6, d = idx & 63;
                    k_s[key][d] = bf2f(pb[(size_t)(64 * j + key) * ODD_PAD + kcol + d]);
                    v_s[key][d] = bf2f(pb[(size_t)(64 * j + key) * ODD_PAD + vcol + d]);
                }
                __syncthreads();
                const bool take = (branch == 0) ? ((mask >> j) & 1u) : true;
                if (take) {
                    for (int s = 0; s < 64; ++s) {
                        const int dist = t - (64 * j + s);
                        const bool valid = (branch == 0) ? (dist >= 0) : (dist >= 0 && dist < 512);
                        float sc = 0.f;
#pragma unroll
                        for (int d = 0; d < 64; ++d) sc += q[d] * k_s[s][d];
                        sc = sc * 0.125f - slope * (float)dist;
                        const float mn = valid ? fmaxf(m, sc) : m;
                        const float scale = expf(m - mn);
                        const float p = valid ? expf(sc - mn) : 0.f;
                        l = l * scale + p;
#pragma unroll
                        for (int d = 0; d < 64; ++d) acc[d] = acc[d] * scale + p * v_s[s][d];
                        m = mn;
                    }
                }
            }
            const float gt = sigmoidf_(bf2f(prow[2560 + (branch + 1) * 16 + hd]));
            const float f = gt / fmaxf(l, 1e-30f);
#pragma unroll
            for (int d = 0; d < 64; d += 8) {
                float o[8];
                ld8(orow + d, o);
#pragma unroll
                for (int j = 0; j < 8; ++j) o[j] += f * acc[d + j];
                st8(orow + d, o);
            }
        }
    }
    __syncthreads();
}


typedef float f32x16 __attribute__((ext_vector_type(16)));
#define MFMA32(a, b, c) __builtin_amdgcn_mfma_f32_32x32x16_bf16((a), (b), (c), 0, 0, 0)
__device__ __forceinline__ unsigned cvtpk(float lo, float hi) { const f32x2_t f = {lo, hi}; return __builtin_bit_cast(unsigned, __builtin_convertvector(f, bf16x2_t)); }
__device__ __forceinline__ int crow32(int reg, int h) { return (reg & 3) + 8 * (reg >> 2) + 4 * h; }
constexpr float LOG2E = 1.4426950408889634f;
__device__ __forceinline__ void nsa_attn_phase(const bf16_t* __restrict__ proj, const bf16_t* __restrict__ vt, const unsigned* __restrict__ selmask, bf16_t* O, unsigned char* lds) {
    const int tid = tidx(), wave = __builtin_amdgcn_readfirstlane(tid >> 6), lane = tid & 63, l31 = lane & 31, h = lane >> 5;
    const int r = wave & 3, thalf = wave >> 2;
    const int skey = tid >> 3, spart = tid & 7;
    for (int it = blockIdx.x; it < 32 * 64; it += gridDim.x) {
        const int tile = 31 - (it >> 6), bg = it & 63, g = bg & 3, b = bg >> 2;
        const int hd = g * 4 + r, tokoff = thalf * 32 + l31, tok = tile * 64 + tokoff;
        const size_t trow = (size_t)(b * NL + tok);
        const float slope = exp2f(-0.5f * (float)(hd + 1));
        bf16x8_t Qf[4];
#pragma unroll
        for (int ds = 0; ds < 4; ++ds) {
            float q[8];
            ld8(proj + trow * ODD_PAD + hd * 64 + 16 * ds + 8 * h, q);
            u32x4 w; w.x = cvtpk(q[0] * 0.125f, q[1] * 0.125f); w.y = cvtpk(q[2] * 0.125f, q[3] * 0.125f); w.z = cvtpk(q[4] * 0.125f, q[5] * 0.125f); w.w = cvtpk(q[6] * 0.125f, q[7] * 0.125f);
            Qf[ds] = __builtin_bit_cast(bf16x8_t, w);
        }
        float sc[16];
#pragma unroll
        for (int reg = 0; reg < 16; ++reg) sc[reg] = slope * (float)crow32(reg, h);
        const unsigned mymask = selmask[(size_t)(b * 4 + g) * NL + tok];
        __syncthreads();
        if (wave == 0) {
            unsigned m = selmask[(size_t)(b * 4 + g) * NL + tile * 64 + lane];
            for (int o = 32; o; o >>= 1) m |= __shfl_xor(m, o);
            if (lane == 0) *(unsigned*)(lds + 35840) = m;
        }
        __syncthreads();
        const unsigned causal = (tile == 31) ? 0xffffffffu : ((2u << tile) - 1u);
        const unsigned U = *(const unsigned*)(lds + 35840) & causal;
        float outv[32];
#pragma unroll
        for (int i = 0; i < 32; ++i) outv[i] = 0.f;
#pragma unroll 1
        for (int branch = 0; branch < 2; ++branch) {
            unsigned todo = (branch == 0) ? U : (causal & ~((1u << (tile >= 8 ? tile - 8 : 0)) - 1u));
            const bf16_t* kbase = proj + (size_t)b * NL * ODD_PAD + (branch == 0 ? 1536 : 1792) + g * 64 + (size_t)skey * ODD_PAD + 8 * spart;
            const bf16_t* vbase = vt + (size_t)(branch * 256 + g * 64 + skey) * NT + (size_t)b * NL + 8 * spart;
            float m_run = -1e30f, l_run = 0.f;
            f32x16 Oa[2];
#pragma unroll
            for (int i = 0; i < 16; ++i) { Oa[0][i] = 0.f; Oa[1][i] = 0.f; }
            int jcur = __ffs(todo) - 1; todo &= todo - 1;
            uint4 kreg = *(const uint4*)(kbase + (size_t)(64 * jcur) * ODD_PAD);
            uint4 vreg = *(const uint4*)(vbase + 64 * jcur);
            int buf = 0;
            __syncthreads();
            *(uint4*)(lds + skey * 144 + spart * 16) = kreg;
            *(uint2*)(lds + 18432 + skey * 136 + spart * 16) = make_uint2(vreg.x, vreg.y);
            *(uint2*)(lds + 18432 + skey * 136 + spart * 16 + 8) = make_uint2(vreg.z, vreg.w);
            __syncthreads();
            for (;;) {
                const int jnext = todo ? (__ffs(todo) - 1) : -1;
                todo &= todo - 1;
                if (jnext >= 0) { kreg = *(const uint4*)(kbase + (size_t)(64 * jnext) * ODD_PAD); vreg = *(const uint4*)(vbase + 64 * jnext); }
                const unsigned char* Ks = lds + buf * 9216;
                const unsigned char* Vs = lds + 18432 + buf * 8704;
                const bool mysel = (branch == 1) || ((mymask >> jcur) & 1u);
                if (__any(mysel)) {
                    const bool diag = (jcur == tile), wedge = (branch == 1) && (jcur == tile - 8);
                    const float init = mysel ? slope * (float)(64 * (jcur - tile)) : -1e30f;
                    float sv[32];
#pragma unroll
                    for (int kt = 0; kt < 2; ++kt) {
                        f32x16 acc;
                        const float i0 = init + slope * (float)(32 * kt);
#pragma unroll
                        for (int i = 0; i < 16; ++i) acc[i] = i0;
#pragma unroll
                        for (int ds = 0; ds < 4; ++ds) {
                            const bf16x8_t a = *(const bf16x8_t*)(Ks + (32 * kt + l31) * 144 + (16 * ds + 8 * h) * 2);
                            acc = MFMA32(a, Qf[ds], acc);
                        }
#pragma unroll
                        for (int reg = 0; reg < 16; ++reg) {
                            float sval = acc[reg] + sc[reg];
                            const int keyoff = 32 * kt + crow32(reg, h);
                            if (diag) sval = (keyoff <= tokoff) ? sval : -1e30f;
                            if (wedge) sval = (keyoff > tokoff) ? sval : -1e30f;
                            sv[kt * 16 + reg] = sval;
                        }
                    }
                    float mx = sv[0];
#pragma unroll
                    for (int i = 1; i < 32; ++i) mx = fmaxf(mx, sv[i]);
                    mx = fmaxf(mx, __shfl_xor(mx, 32));
                    const float m_new = fmaxf(m_run, mx), m_use = fmaxf(m_new, -1e29f);
                    const float alpha = __builtin_amdgcn_exp2f((m_run - m_use) * LOG2E);
                    const float moff = -m_use * LOG2E;
                    float psum = 0.f;
#pragma unroll
                    for (int i = 0; i < 32; ++i) { sv[i] = __builtin_amdgcn_exp2f(fmaf(sv[i], LOG2E, moff)); psum += sv[i]; }
                    l_run = l_run * alpha + psum; m_run = m_new;
#pragma unroll
                    for (int i = 0; i < 16; ++i) { Oa[0][i] *= alpha; Oa[1][i] *= alpha; }
                    bf16x8_t Pf[4];
#pragma unroll
                    for (int ks = 0; ks < 4; ++ks) {
                        u32x4 w; w.x = cvtpk(sv[ks * 8 + 0], sv[ks * 8 + 1]); w.y = cvtpk(sv[ks * 8 + 2], sv[ks * 8 + 3]); w.z = cvtpk(sv[ks * 8 + 4], sv[ks * 8 + 5]); w.w = cvtpk(sv[ks * 8 + 6], sv[ks * 8 + 7]);
                        Pf[ks] = __builtin_bit_cast(bf16x8_t, w);
                    }
#pragma unroll
                    for (int mt = 0; mt < 2; ++mt)
#pragma unroll
                        for (int ks = 0; ks < 4; ++ks) {
                            const unsigned char* vp = Vs + (32 * mt + l31) * 136 + (16 * ks + 4 * h) * 2;
                            const uint2 lo = *(const uint2*)vp, hi = *(const uint2*)(vp + 16);
                            u32x4 w; w.x = lo.x; w.y = lo.y; w.z = hi.x; w.w = hi.y;
                            Oa[mt] = MFMA32(__builtin_bit_cast(bf16x8_t, w), Pf[ks], Oa[mt]);
                        }
                }
                if (jnext < 0) break;
                *(uint4*)(lds + (buf ^ 1) * 9216 + skey * 144 + spart * 16) = kreg;
                *(uint2*)(lds + 18432 + (buf ^ 1) * 8704 + skey * 136 + spart * 16) = make_uint2(vreg.x, vreg.y);
                *(uint2*)(lds + 18432 + (buf ^ 1) * 8704 + skey * 136 + spart * 16 + 8) = make_uint2(vreg.z, vreg.w);
                __syncthreads();
                buf ^= 1; jcur = jnext;
            }
            const float l_tot = l_run + __shfl_xor(l_run, 32);
            const float gt = sigmoidf_(bf2f(proj[trow * ODD_PAD + 2048 + (branch + 1) * 16 + hd]));
            const float f = gt / fmaxf(l_tot, 1e-30f);
#pragma unroll
            for (int i = 0; i < 16; ++i) { outv[i] += f * Oa[0][i]; outv[16 + i] += f * Oa[1][i]; }
        }
        bf16_t* orow = O + trow * ND + hd * 64;
#pragma unroll
        for (int mt = 0; mt < 2; ++mt)
#pragma unroll
            for (int q4 = 0; q4 < 4; ++q4) {
                bf16_t* op = orow + 32 * mt + 8 * q4 + 4 * h;
                const uint2 old = *(const uint2*)op;
                const float o0 = __uint_as_float(old.x << 16) + outv[mt * 16 + q4 * 4 + 0], o1 = __uint_as_float(old.x & 0xffff0000u) + outv[mt * 16 + q4 * 4 + 1];
                const float o2 = __uint_as_float(old.y << 16) + outv[mt * 16 + q4 * 4 + 2], o3 = __uint_as_float(old.y & 0xffff0000u) + outv[mt * 16 + q4 * 4 + 3];
                *(uint2*)op = make_uint2(cvtpk(o0, o1), cvtpk(o2, o3));
            }
    }
    __syncthreads();
}

struct Params {
    const float* in[29];
    float* out;
    char* ws;
    unsigned long long pad;
};

constexpr size_t SZ_PROJ = (size_t)NT * EVEN_IN * 2;
constexpr size_t SZ_VT = (size_t)512 * NT * 2;
constexpr size_t SZ_YB = (size_t)NT * ND * 2;
constexpr size_t SZ_HB = (size_t)NT * ND * 2;
constexpr size_t SZ_YA = (size_t)NT * 256 * 4;
constexpr size_t SZ_CMP = (size_t)NB * 127 * 4 * 64 * 4;
constexpr size_t SZ_SEL = (size_t)NB * 4 * NL * 4;
constexpr size_t SZ_TAB = (size_t)16384 * ND;
constexpr size_t SZ_SKB = (size_t)2 * 8 * 2 * 128 * 128 * 2;
constexpr size_t OFF_VT = SZ_PROJ, OFF_YB = OFF_VT + SZ_VT, OFF_HB = OFF_YB + SZ_YB, OFF_YA = OFF_HB + SZ_HB, OFF_KC = OFF_YA + SZ_YA, OFF_VC = OFF_KC + SZ_CMP,
                 OFF_SEL = OFF_VC + SZ_CMP, OFF_TAB = OFF_SEL + SZ_SEL, OFF_SKB = OFF_TAB + 2 * SZ_TAB, OFF_WT = OFF_SKB + SZ_SKB;
constexpr size_t WT_IN0 = 0, WT_OUT0 = WT_IN0 + (size_t)EVEN_IN * ND * 2, WT_Q0 = WT_OUT0 + (size_t)ND * ND * 2, WT_Q1 = WT_Q0 + (size_t)2048 * ND * 2,
                 WT_IN1 = WT_Q1 + (size_t)2048 * ND * 2, WT_V1 = WT_IN1 + (size_t)ODD_PAD * ND * 2, WT_OUT1 = WT_V1 + (size_t)512 * ND * 2, WT_END = WT_OUT1 + (size_t)ND * ND * 2;
constexpr size_t WS_NEED = OFF_WT + WT_END;

__device__ __forceinline__ void convert_tables(const float* __restrict__ u, const float* __restrict__ v, unsigned char* __restrict__ TAB) {
    const size_t per = (size_t)16384 * ND / 16;
    for (size_t i = (size_t)blockIdx.x * NTHR + tidx(); i < 2 * per; i += (size_t)gridDim.x * NTHR) {
        const int tb = (int)(i / per); const size_t off = (i % per) * 16;
        const float* src = (tb ? v : u) + off;
        const float sc = tb ? V_SCALE : U_SCALE;
        uint4 w; unsigned* wp = (unsigned*)&w;
#pragma unroll
        for (int q = 0; q < 4; ++q) {
            const float4 a = *(const float4*)(src + 4 * q);
            int pk = __builtin_amdgcn_cvt_pk_fp8_f32(a.x * sc, a.y * sc, 0, false);
            pk = __builtin_amdgcn_cvt_pk_fp8_f32(a.z * sc, a.w * sc, pk, true);
            wp[q] = (unsigned)pk;
        }
        *(uint4*)(TAB + (size_t)tb * 16384 * ND + off) = w;
    }
}

__global__ void __launch_bounds__(NTHR) fwd_megakernel(Params p) {
    extern __shared__ __attribute__((aligned(16))) unsigned char lds_raw[];
    float* lds = (float*)lds_raw;
    cg::grid_group grid = cg::this_grid();
    const float* x = p.in[0];
    float* R = p.out;
    char* ws = p.ws;
    bf16_t* PROJ = (bf16_t*)ws;
    bf16_t* YB = (bf16_t*)(ws + OFF_YB);
    bf16_t* HB = (bf16_t*)(ws + OFF_HB);
    float* YA = (float*)(ws + OFF_YA);
    float* KCMP = (float*)(ws + OFF_KC);
    float* VCMP = (float*)(ws + OFF_VC);
    unsigned* SEL = (unsigned*)(ws + OFF_SEL);
    bf16_t* WIN0 = (bf16_t*)(ws + OFF_WT + WT_IN0);
    bf16_t* WOUT0 = (bf16_t*)(ws + OFF_WT + WT_OUT0);
    bf16_t* WQ0 = (bf16_t*)(ws + OFF_WT + WT_Q0);
    bf16_t* WQ1 = (bf16_t*)(ws + OFF_WT + WT_Q1);
    bf16_t* WIN1 = (bf16_t*)(ws + OFF_WT + WT_IN1);
    bf16_t* WOUT1 = (bf16_t*)(ws + OFF_WT + WT_OUT1);
    bf16_t* WV1 = (bf16_t*)(ws + OFF_WT + WT_V1);
    bf16_t* VT = (bf16_t*)(ws + OFF_VT);
    int* EIDX = (int*)YB;
    float* EGATE = (float*)((char*)YB + (size_t)NT * 128 * 4);
    unsigned char* TAB = (unsigned char*)(ws + OFF_TAB);
    bf16_t* SKB = (bf16_t*)(ws + OFF_SKB);
    const int wave = tidx() >> 6;

    for (size_t i = (size_t)blockIdx.x * NTHR + tidx(); i < (size_t)NT * ND / 4; i += (size_t)gridDim.x * NTHR) {
        const float4 v = ((const float4*)x)[i];
        ((float4*)R)[i] = v;
        uint2 w; w.x = pack2(v.x, v.y); w.y = pack2(v.z, v.w);
        ((uint2*)HB)[i] = w;
    }
    convert_tables(p.in[23], p.in[24], TAB);
    for (int i = blockIdx.x * NTHR + tidx(); i < 2 * 8 * 2 * 128 * 128 / 4; i += gridDim.x * NTHR) {
        const float4 a = ((const float4*)p.in[22])[i];
        uint2 w; w.x = pack2(a.x, a.y); w.y = pack2(a.z, a.w);
        ((uint2*)SKB)[i] = w;
    }
    convert_wt_phase(p.in[1], ND, EVEN_IN, EVEN_IN, ColMap{{0, 0, 0}, {0, 0, 0}, {EVEN_IN, 0, 0}}, WIN0, lds);
    convert_wt_phase(p.in[12], ND, ND, ND, ColMap{{0, 0, 0}, {0, 0, 0}, {ND, 0, 0}}, WOUT0, lds);
    convert_wt_phase(p.in[21], ND, 2048, 2048, ColMap{{0, 0, 0}, {0, 0, 0}, {2048, 0, 0}}, WQ0, lds);
    convert_wt_phase(p.in[21] + (size_t)ND * 2048, ND, 2048, 2048, ColMap{{0, 0, 0}, {0, 0, 0}, {2048, 0, 0}}, WQ1, lds);
    convert_wt_phase(p.in[13], ND, ODD_IN, ODD_PAD, ColMap{{0, 1792, 2048}, {0, 2048, 2560}, {1792, 256, 48}}, WIN1, lds);
    convert_wt_phase(p.in[13], ND, ODD_IN, 512, ColMap{{0, 256, 0}, {1792, 2304, 0}, {256, 256, 0}}, WV1, lds);
    convert_wt_phase(p.in[20], ND, ND, ND, ColMap{{0, 0, 0}, {0, 0, 0}, {ND, 0, 0}}, WOUT1, lds);
    grid.sync();
    PH(0) gemm_bf16_phase(lds_raw, HB, WIN0, NT, EVEN_IN, ND, EpiBf16s{PROJ, EVEN_IN});
    grid.sync();
    PH(1) if (wave == 0) {
        for (int bg = blockIdx.x; bg < NB * 16; bg += gridDim.x)
            s5_scan_wave(bg, PROJ, p.in[2], p.in[3], p.in[4], p.in[5], p.in[6], p.in[7], p.in[8], p.in[9], YA, lds);
    } else PH(2) {
        for (int task = blockIdx.x * 7 + (wave - 1); task < NB * 12 * 32; task += gridDim.x * 7)
            sb_attn_wave(task, PROJ, YB, lds + 11392 + (wave - 1) * 4096);
    }
    grid.sync();
    PH(3) glu_phase(YA, p.in[10], p.in[11], YB, lds);
    grid.sync();
    PH(4) gemm_bf16_phase(lds_raw, YB, WOUT0, NT, ND, ND, EpiRes{R, ND, ALPHA});
    grid.sync();
    PH(5) ln_phase(R, HB, p.in[25], p.in[26]);
    grid.sync();
#define PEER_FFN(layer, WQ, last) \
    PH(12) gemm_bf16_phase(lds_raw, HB, WQ, NT, 2048, ND, EpiBf16s{PROJ, 2048}); \
    grid.sync(); \
    PH(13) peer_route2_phase(PROJ, SKB + (size_t)(layer) * 8 * 2 * 128 * 128, EIDX, EGATE, lds_raw); \
    grid.sync(); \
    PH(14) peer_expert3_phase(R, EIDX, EGATE, TAB, TAB + (size_t)16384 * ND, p.in[27] + (layer) * ND, p.in[28] + (layer) * ND, (last) ? nullptr : HB); \
    if (!(last)) grid.sync();
    PEER_FFN(0, WQ0, false)
    convert_tables(p.in[23] + (size_t)16384 * ND, p.in[24] + (size_t)16384 * ND, TAB);
    PH(6) gemm_bf16_phase(lds_raw, HB, WIN1, NT, ODD_PAD, ND, EpiBf16s{PROJ, ODD_PAD});
    PH(6) gemm_bf16_phase(lds_raw, WV1, HB, 512, NT, ND, EpiBf16s{VT, NT});
    grid.sync();
    PH(7) nsa_compress_phase(PROJ, 1024, p.in[14], p.in[15], p.in[16], KCMP, lds);
    PH(7) nsa_compress_phase(PROJ, 1280, p.in[17], p.in[18], p.in[19], VCMP, lds);
    grid.sync();
    PH(8) nsa_cmp_phase(PROJ, KCMP, VCMP, YB, SEL, lds);
    grid.sync();
    PH(9) nsa_attn_phase(PROJ, VT, SEL, YB, lds_raw);
    grid.sync();
    PH(10) gemm_bf16_phase(lds_raw, YB, WOUT1, NT, ND, ND, EpiRes{R, ND, ALPHA});
    grid.sync();
    PH(11) ln_phase(R, HB, p.in[25] + ND, p.in[26] + ND);
    grid.sync();
    PEER_FFN(1, WQ1, true)
}

}

extern "C" void kernel_launch(void* const* d_in, const int* in_sizes, int n_in, void* d_out, int out_size, void* d_ws, size_t ws_size, hipStream_t stream) {
    static int grid_blocks = 0;
    if (grid_blocks == 0) {
        if (n_in != 29 || out_size != NT * ND || ws_size < WS_NEED) { fprintf(stderr, "kernel_launch: unexpected shapes / workspace (%zu < %zu)\n", ws_size, (size_t)WS_NEED); grid_blocks = -1; return; }
        int dev = 0, cus = 0, per_cu = 0;
        hipGetDevice(&dev);
        hipDeviceGetAttribute(&cus, hipDeviceAttributeMultiprocessorCount, dev);
        hipFuncSetAttribute((const void*)fwd_megakernel, hipFuncAttributeMaxDynamicSharedMemorySize, LDS_BYTES);
        hipOccupancyMaxActiveBlocksPerMultiprocessor(&per_cu, (const void*)fwd_megakernel, NTHR, LDS_BYTES);
        if (per_cu < 1) { fprintf(stderr, "kernel_launch: occupancy query says %d blocks/CU\n", per_cu); grid_blocks = -1; return; }
        grid_blocks = cus;
    }
    if (grid_blocks < 0) return;
    Params p{};
    for (int i = 0; i < 29; ++i) p.in[i] = (const float*)d_in[i];
    p.out = (float*)d_out; p.ws = (char*)d_ws; p.pad = 0;
    void* args[] = {&p};
    hipError_t e = hipLaunchCooperativeKernel((const void*)fwd_megakernel, dim3(grid_blocks), dim3(NTHR), args, LDS_BYTES, stream);
    if (e != hipSuccess) fprintf(stderr, "cooperative launch failed: %s (grid %d)\n", hipGetErrorString(e), grid_blocks);
}
```

```cpp
#include <hip/hip_runtime.h>
#include <hip/hip_cooperative_groups.h>
#include <math.h>
#include <stdint.h>
#include <cstdio>
namespace cg = cooperative_groups;

__device__ __forceinline__ int tidx() { int t = threadIdx.x; asm volatile("" : "+v"(t)); return t; }
#define XB_TMO      128
#define XB_XCNT(j)  (256  + 64 * (j))
#define XB_XSUB(j)  (1280 + 64 * (j))
#define XB_XGEN(j)  (2304 + 64 * (j))
#define XB_TOP      3328
#define XB_TOPGEN   3392
#define XCD_BAR_WORDS 3456
#define XB_SPIN_CAP (1u << 18)
#define LAS __attribute__((address_space(3)))

__device__ __forceinline__ unsigned xb_ld(unsigned* p)              { return __hip_atomic_load(p, __ATOMIC_RELAXED, __HIP_MEMORY_SCOPE_AGENT); }
__device__ __forceinline__ unsigned xb_add(unsigned* p, unsigned v) { return __hip_atomic_fetch_add(p, v, __ATOMIC_RELAXED, __HIP_MEMORY_SCOPE_AGENT); }
__device__ __forceinline__ unsigned xb_xcc_id() { return (unsigned)__builtin_amdgcn_s_getreg((3 << 11) | 20) & 0xFu; }
#define XB_SPIN(cond, bar) do { unsigned _sp = 0; while (cond) { __builtin_amdgcn_s_sleep(1); \
    if ((++_sp & 255u) == 0u) { if (xb_ld(&(bar)[XB_TMO])) break; if (_sp > XB_SPIN_CAP) { atomicAdd(&(bar)[XB_TMO], 1u); break; } } } } while (0)

struct XcdBarrier {
    unsigned* bar; unsigned x;
    volatile LAS unsigned* st;
};

__device__ __forceinline__ XcdBarrier xcd_barrier_post(unsigned* bar, volatile LAS unsigned* st) {
    XcdBarrier b; b.bar = bar; b.x = xb_xcc_id(); b.st = st;
    if (tidx() == 0) (void)xb_add(&bar[XB_XCNT(b.x)], 1u);
    return b;
}
__device__ __forceinline__ void xcd_barrier_complete(unsigned* bar, unsigned x, unsigned& nloc, unsigned& nx) {
    const unsigned G = gridDim.x * gridDim.y * gridDim.z;
    unsigned sum, cnt, mine, sp = 0u;
    for (;;) {
        sum = 0u; cnt = 0u; mine = 0u;
#pragma unroll
        for (unsigned j = 0; j < 16; ++j) { const unsigned c = xb_ld(&bar[XB_XCNT(j)]); sum += c; cnt += (c > 0u) ? 1u : 0u; mine = (j == x) ? c : mine; }
        if (sum == G) break;
        __builtin_amdgcn_s_sleep(1);
        if ((++sp & 255u) == 0u) { if (xb_ld(&bar[XB_TMO])) break; if (sp > XB_SPIN_CAP) { atomicAdd(&bar[XB_TMO], 1u); break; } }
    }
    nloc = mine > 0u ? mine : 1u; nx = cnt > 0u ? cnt : 1u;
}

__device__ __forceinline__ void xcd_barrier(const XcdBarrier& b) {
    asm volatile("s_waitcnt vmcnt(0)" ::: "memory");
    __syncthreads();
    if (tidx() == 0) {
        unsigned* bar = b.bar;
        __builtin_amdgcn_s_waitcnt(0);
        unsigned nloc = b.st[0], nx = b.st[1];
        if (nloc == 0u) { xcd_barrier_complete(bar, b.x, nloc, nx); b.st[0] = nloc; b.st[1] = nx; }
        const unsigned old = xb_add(&bar[XB_XSUB(b.x)], 1u);
        const unsigned gen = old / nloc;
        if (old + 1u == (gen + 1u) * nloc) {
            __builtin_amdgcn_fence(__ATOMIC_RELEASE, "agent");
            asm volatile("s_waitcnt vmcnt(0)" ::: "memory");
            const unsigned og = xb_add(&bar[XB_TOP], 1u);
            const unsigned tg = og / nx;
            if (og + 1u == (tg + 1u) * nx) xb_add(&bar[XB_TOPGEN], 1u);
            else XB_SPIN(xb_ld(&bar[XB_TOPGEN]) == tg, bar);
            __builtin_amdgcn_fence(__ATOMIC_ACQUIRE, "agent");
            xb_add(&bar[XB_XGEN(b.x)], 1u);
            asm volatile("s_waitcnt vmcnt(0)" ::: "memory");
        } else {
            XB_SPIN(xb_ld(&bar[XB_XGEN(b.x)]) == gen, bar);
            __builtin_amdgcn_fence(__ATOMIC_ACQUIRE, "agent");
            asm volatile("s_waitcnt vmcnt(0)" ::: "memory");
        }
    }
    __syncthreads();
}

namespace pg8 {
#define PG8_LAS __attribute__((address_space(3)))
typedef unsigned short bf16_t;
typedef short bf16x8 __attribute__((ext_vector_type(8)));
typedef float f32x4 __attribute__((ext_vector_type(4)));
typedef unsigned u32x4 __attribute__((ext_vector_type(4)));
constexpr int BM = 256, BK = 64, HALF = 128, HTB = HALF * BK * 2  , STAGE_BYTES = 8 * HTB, NXCD = 8, WGM = 8;

__host__ __device__ __forceinline__ int lds_byte(int r, int c) { const int st = (r >> 4) * 2 + (c >> 5), rr = r & 15, cc = c & 31, ob = rr * 64 + cc * 2; return st * 1024 + (ob ^ (((ob >> 9) & 1) << 5)); }
__host__ __device__ __forceinline__ void stage_rc(int b, int& R, int& C) { const int st = b / 1024, sb = b % 1024, swz = sb ^ (((sb >> 9) & 1) << 5); R = (st >> 1) * 16 + swz / 64; C = (st & 1) * 32 + (swz % 64) / 2; }
__host__ __device__ __forceinline__ int perm32(int rho) { const int n = rho >> 4, i = rho & 15; return 8 * (i >> 2) + 4 * n + (i & 3); }

struct Unit { int pm, pn; };
struct Gemm { const bf16_t* A; const bf16_t* Bt; int M, N, K; };

struct StaticOrder {
    int nM, nN, nwg, G, c;
    __host__ __device__ void init(int M, int N, int G_, int c_) { nM = M / BM; nN = N / BM; nwg = nM * nN; G = G_; c = c_; }
    __host__ __device__ bool next(int i, Unit& u) const {
        const long L = (long)i * G + c; if (L >= nwg) return false;
        int wgid = (int)L; { const int q = nwg / NXCD, r = nwg % NXCD, xcd = wgid % NXCD, off = wgid / NXCD; wgid = (xcd < r ? xcd * (q + 1) : r * (q + 1) + (xcd - r) * q) + off; }
        const int nig = WGM * nN, gid = wgid / nig, fm = gid * WGM, gsz = (nM - fm) < WGM ? (nM - fm) : WGM;
        u.pm = fm + ((wgid % nig) % gsz); u.pn = (wgid % nig) / gsz; return true;
    }
    __device__ __forceinline__ void a_ready(const Unit&) const {}
    __device__ __forceinline__ void done(const Unit&) const {}
};
__device__ __forceinline__ unsigned cvt_pk_bf16(float lo, float hi) { unsigned r; asm volatile("v_cvt_pk_bf16_f32 %0, %1, %2" : "=v"(r) : "v"(lo), "v"(hi)); return r; }
template <class Epi, class Sched, bool STAMP = false>
__device__ __forceinline__ void gemm_phase(PG8_LAS unsigned char* lds, const Gemm g, const Sched& S, const Epi& E, unsigned long long* stamps) {
    const int tid = tidx(), wid = __builtin_amdgcn_readfirstlane(tid >> 6), lane = tid & 63, wr = wid >> 2, wc = wid & 3, fr = lane & 15, fq = lane >> 4;
    const int K = g.K, nt = K / BK;
    int ts_lo = 0, ts_hi = 0, nts = 0; const unsigned long long rt_entry = STAMP ? (unsigned long long)wall_clock64() : 0ull;
#define PG8_STAMP() do { if (STAMP && wid == 0 && nts < 64) { const unsigned long long _c = (unsigned long long)clock64(); \
        ts_lo = (lane == nts) ? (int)(unsigned)_c : ts_lo; ts_hi = (lane == nts) ? (int)(unsigned)(_c >> 32) : ts_hi; ++nts; } } while (0)
    PG8_STAMP();
    unsigned voffA[2], voffB[2];
#pragma unroll
    for (int i = 0; i < 2; ++i) { int R, C; stage_rc(tid * 16 + i * 8192, R, C); const int Rb = Epi::PERM ? ((R & ~31) + perm32(R & 31)) : R;
        voffA[i] = (unsigned)(R * K + C) * 2u; voffB[i] = (unsigned)(Rb * K + C) * 2u; }
    const size_t kstep = (size_t)(BK * 2);
    const size_t hstep = (size_t)HALF * K * 2;
    const size_t tstep = 2 * hstep;
    const unsigned ldsw = (unsigned)wid * 1024u;
    const int aoff = lds_byte(wr * 64 + fr, fq * 8), boff = lds_byte(wc * 32 + fr, fq * 8);
#define PG8_SA(b, h) (((b) * 2 + (h)) * HTB)
#define PG8_SB(b, h) ((4 + (b) * 2 + (h)) * HTB)
#define PG8_STAGE(bufoff, gbase, voff) do { _Pragma("unroll") for (int _i = 0; _i < 2; ++_i) \
        __builtin_amdgcn_global_load_lds((const unsigned*)((const char*)(gbase) + (voff)[_i]), (PG8_LAS unsigned*)(lds + (bufoff) + ldsw + _i * 8192), 16, 0, 0); } while (0)
#define PG8_LDA(dst, b, h) do { _Pragma("unroll") for (int m = 0; m < 4; ++m) _Pragma("unroll") for (int k = 0; k < 2; ++k) dst[m][k] = *(const PG8_LAS bf16x8*)(lds + PG8_SA(b, h) + aoff + m * 2048 + k * 1024); } while (0)
#define PG8_LDB(dst, b, h) do { _Pragma("unroll") for (int n = 0; n < 2; ++n) _Pragma("unroll") for (int k = 0; k < 2; ++k) dst[n][k] = *(const PG8_LAS bf16x8*)(lds + PG8_SB(b, h) + boff + n * 2048 + k * 1024); } while (0)
#define PG8_MMA(ai, bj, At, Bt) do { __builtin_amdgcn_s_setprio(1); _Pragma("unroll") for (int m = 0; m < 4; ++m) _Pragma("unroll") for (int n = 0; n < 2; ++n) _Pragma("unroll") for (int k = 0; k < 2; ++k) \
        acc[ai][bj][m][n] = __builtin_amdgcn_mfma_f32_16x16x32_bf16(Bt[n][k], At[m][k], acc[ai][bj][m][n], 0, 0, 0); __builtin_amdgcn_s_setprio(0); } while (0)
#define PG8_WAIT_V(n) asm volatile("s_waitcnt vmcnt(" #n ")" ::: "memory")
#define PG8_WAIT_L(n) asm volatile("s_waitcnt lgkmcnt(" #n ")" ::: "memory")
#define PG8_BAR __builtin_amdgcn_s_barrier()
#define PG8_SCHED __builtin_amdgcn_sched_barrier(0)
    Unit cur, nxt; int ui = 0;
    if (!S.next(0, cur)) return;
    f32x4 acc[2][2][4][2];
#pragma unroll
    for (int a = 0; a < 2; ++a)
#pragma unroll
        for (int b = 0; b < 2; ++b)
#pragma unroll
            for (int m = 0; m < 4; ++m)
#pragma unroll
                for (int n = 0; n < 2; ++n) acc[a][b][m][n] = (f32x4){0.f, 0.f, 0.f, 0.f};
    bf16x8 At[4][2], B0[2][2], B1[2][2];
    const char* cA = (const char*)g.A + (size_t)cur.pm * tstep; const char* cB = (const char*)g.Bt + (size_t)cur.pn * tstep;
    S.a_ready(cur);
    PG8_STAGE(PG8_SB(0, 0), cB, voffB); PG8_STAGE(PG8_SA(0, 0), cA, voffA); PG8_STAGE(PG8_SB(0, 1), cB + hstep, voffB); PG8_STAGE(PG8_SA(0, 1), cA + hstep, voffA);
    if (wr == 1) PG8_BAR;
    PG8_WAIT_V(4); PG8_BAR;
    PG8_STAGE(PG8_SB(1, 0), cB + kstep, voffB); PG8_STAGE(PG8_SA(1, 0), cA + kstep, voffA); PG8_STAGE(PG8_SB(1, 1), cB + hstep + kstep, voffB);
    PG8_WAIT_V(6); PG8_BAR;
    PG8_STAMP();
    for (;;) {
        const bool has_next = S.next(ui + 1, nxt);
        const char* nA = has_next ? (const char*)g.A + (size_t)nxt.pm * tstep : cA; const char* nB = has_next ? (const char*)g.Bt + (size_t)nxt.pn * tstep : cB;
        for (int t = 0; t < nt; t += 2) {
            const bool last = (t == nt - 2);
            const char* a1 = cA + (size_t)(t + 1) * kstep;
            const char* a2 = last ? nA : cA + (size_t)(t + 2) * kstep; const char* b2 = last ? nB : cB + (size_t)(t + 2) * kstep;
            const char* a3 = a2 + kstep; const char* b3 = b2 + kstep;
            if (last && has_next) S.a_ready(nxt);
            PG8_LDB(B0, 0, 0); PG8_SCHED; PG8_LDA(At, 0, 0); PG8_STAGE(PG8_SA(1, 1), a1 + hstep, voffA);
            PG8_WAIT_L(8); PG8_BAR; PG8_WAIT_L(0); PG8_MMA(0, 0, At, B0); PG8_BAR; PG8_SCHED;
            PG8_LDB(B1, 0, 1); PG8_STAGE(PG8_SB(0, 0), b2, voffB);
            PG8_BAR; PG8_WAIT_L(0); PG8_MMA(0, 1, At, B1); PG8_BAR;
            PG8_LDA(At, 0, 1); PG8_STAGE(PG8_SA(0, 0), a2, voffA);
            PG8_BAR; PG8_WAIT_L(0); PG8_MMA(1, 0, At, B0); PG8_BAR; PG8_SCHED;
            PG8_STAGE(PG8_SB(0, 1), b2 + hstep, voffB);
            PG8_WAIT_V(6); PG8_BAR; PG8_MMA(1, 1, At, B1); PG8_BAR;
            PG8_LDB(B0, 1, 0); PG8_SCHED; PG8_LDA(At, 1, 0); PG8_STAGE(PG8_SA(0, 1), a2 + hstep, voffA);
            PG8_WAIT_L(8); PG8_BAR; PG8_WAIT_L(0); PG8_MMA(0, 0, At, B0); PG8_BAR; PG8_SCHED;
            PG8_LDB(B1, 1, 1); PG8_STAGE(PG8_SB(1, 0), b3, voffB);
            PG8_BAR; PG8_WAIT_L(0); PG8_MMA(0, 1, At, B1); PG8_BAR;
            PG8_LDA(At, 1, 1); PG8_STAGE(PG8_SA(1, 0), a3, voffA);
            PG8_BAR; PG8_WAIT_L(0); PG8_MMA(1, 0, At, B0); PG8_BAR; PG8_SCHED;
            PG8_STAGE(PG8_SB(1, 1), b3 + hstep, voffB);
            PG8_WAIT_V(6); PG8_BAR; PG8_MMA(1, 1, At, B1); PG8_BAR;
        }
        PG8_STAMP();
        if constexpr (!Epi::AFTER_DRAIN) { E(acc, cur, wr, wc, fr, fq); S.done(cur); }
        PG8_STAMP();
        if (!has_next) break;
#pragma unroll
        for (int a = 0; a < 2; ++a)
#pragma unroll
            for (int b = 0; b < 2; ++b)
#pragma unroll
                for (int m = 0; m < 4; ++m)
#pragma unroll
                    for (int n = 0; n < 2; ++n) acc[a][b][m][n] = (f32x4){0.f, 0.f, 0.f, 0.f};
        cur = nxt; cA = nA; cB = nB; ++ui;
    }
    PG8_WAIT_V(0);
    if (wr == 0) PG8_BAR;
    PG8_BAR;
    if constexpr (Epi::AFTER_DRAIN) { E.fused(acc, cur, wr, wc, fr, fq, lds, wid, lane); S.done(cur); }
    PG8_STAMP();
    if (STAMP && wid == 0) { stamps[lane] = lane < nts ? (((unsigned long long)(unsigned)ts_hi << 32) | (unsigned)ts_lo) : 0ull;
        if (lane == 62) stamps[62] = rt_entry; if (lane == 63) stamps[63] = (unsigned long long)wall_clock64(); }
#undef PG8_STAMP
#undef PG8_SA
#undef PG8_SB
#undef PG8_STAGE
#undef PG8_LDA
#undef PG8_LDB
#undef PG8_MMA
#undef PG8_WAIT_V
#undef PG8_WAIT_L
#undef PG8_BAR
#undef PG8_SCHED
}
}

namespace {
using pg8::bf16_t;
typedef float f32x4 __attribute__((ext_vector_type(4)));
typedef unsigned u32x4 __attribute__((ext_vector_type(4)));

constexpr int NB = 16, NL = 2048, ND = 1024, NT = NB * NL;
constexpr int EVEN_IN = 2560, ODD_IN = 2608, ODD_PAD = 2304;
constexpr float ALPHA = 1.41421356237f;
constexpr float LN_EPS = 1e-5f;
constexpr float U_SCALE = 256.f, V_SCALE = 16.f;
constexpr int NTHR = 512;
constexpr int LDS_BYTES = 163840;
#ifndef PROBE
#define PROBE 0
#endif
#define PDUP(bit) for (int _rep = 0; _rep < ((PROBE >> (bit)) & 1) + 1; ++_rep)
#ifndef PHMASK
#define PHMASK 0xFFFFFFFFu
#endif
#define PH(n) if (PHMASK & (1u << (n)))

__device__ __forceinline__ float bf2f(bf16_t v) { return __uint_as_float((unsigned)v << 16); }
__device__ __forceinline__ bf16_t f2bf(float f) { unsigned u = __float_as_uint(f); u += 0x7FFFu + ((u >> 16) & 1u); return (bf16_t)(u >> 16); }
__device__ __forceinline__ unsigned pack2(float lo, float hi) { return (unsigned)f2bf(lo) | ((unsigned)f2bf(hi) << 16); }
__device__ __forceinline__ void ld8(const bf16_t* p, float* o) {
    const uint4 v = *(const uint4*)p;
    o[0] = __uint_as_float(v.x << 16); o[1] = __uint_as_float(v.x & 0xffff0000u);
    o[2] = __uint_as_float(v.y << 16); o[3] = __uint_as_float(v.y & 0xffff0000u);
    o[4] = __uint_as_float(v.z << 16); o[5] = __uint_as_float(v.z & 0xffff0000u);
    o[6] = __uint_as_float(v.w << 16); o[7] = __uint_as_float(v.w & 0xffff0000u);
}
__device__ __forceinline__ void st8(bf16_t* p, const float* o) {
    uint4 v; v.x = pack2(o[0], o[1]); v.y = pack2(o[2], o[3]); v.z = pack2(o[4], o[5]); v.w = pack2(o[6], o[7]);
    *(uint4*)p = v;
}

struct EpiBf16s {
    static constexpr bool PERM = true, AFTER_DRAIN = false;
    bf16_t* O; int ldc;
    __device__ __forceinline__ void operator()(const f32x4 (&acc)[2][2][4][2], const pg8::Unit& u, int wr, int wc, int fr, int fq) const {
        const int row0 = u.pm * 256 + wr * 64 + fr, col0 = u.pn * 256 + wc * 32 + 8 * fq;
#pragma unroll
        for (int ai = 0; ai < 2; ++ai)
#pragma unroll
            for (int m = 0; m < 4; ++m) { bf16_t* rowp = O + (size_t)(row0 + ai * 128 + m * 16) * ldc + col0;
#pragma unroll
                for (int bj = 0; bj < 2; ++bj) { const f32x4 v0 = acc[ai][bj][m][0], v1 = acc[ai][bj][m][1];
                    u32x4 w; w.x = pg8::cvt_pk_bf16(v0[0], v0[1]); w.y = pg8::cvt_pk_bf16(v0[2], v0[3]); w.z = pg8::cvt_pk_bf16(v1[0], v1[1]); w.w = pg8::cvt_pk_bf16(v1[2], v1[3]);
                    *(u32x4*)(rowp + bj * 128) = w; } }
    }
};
struct EpiRes {
    static constexpr bool PERM = false, AFTER_DRAIN = false;
    float* C; int ldc; float alpha; float* Cout;
    __device__ __forceinline__ void operator()(const f32x4 (&acc)[2][2][4][2], const pg8::Unit& u, int wr, int wc, int fr, int fq) const {
        const int row0 = u.pm * 256 + wr * 64 + fr, col0 = u.pn * 256 + wc * 32 + 4 * fq; const size_t dlt = Cout - C;
#pragma unroll
        for (int ai = 0; ai < 2; ++ai)
#pragma unroll
            for (int m = 0; m < 4; ++m) { float* rowp = C + (size_t)(row0 + ai * 128 + m * 16) * ldc + col0;
#pragma unroll
                for (int bj = 0; bj < 2; ++bj)
#pragma unroll
                    for (int n = 0; n < 2; ++n) { f32x4* cp = (f32x4*)(rowp + bj * 128 + n * 16); *(cp + dlt / 4) = *cp * alpha + acc[ai][bj][m][n]; } }
    }
};
template <class Epi>
__device__ __forceinline__ void gemm_bf16_phase(unsigned char* lds, const bf16_t* A, const bf16_t* Bt, int M, int N, int K, const Epi& E) {
    pg8::Gemm g{A, Bt, M, N, K};
    pg8::StaticOrder S; S.init(M, N, (int)gridDim.x, (int)blockIdx.x);
    pg8::gemm_phase<Epi, pg8::StaticOrder, false>((PG8_LAS unsigned char*)lds, g, S, E, nullptr);
    __syncthreads();
}

struct ColMap { int d0[3], s0[3], len[3]; };
__device__ __forceinline__ void convert_wt_phase(const float* __restrict__ W, int K, int N, int Npad, const ColMap cm, bf16_t* __restrict__ Wt, float* lds) {
    float(*tile)[65] = (float(*)[65])lds;
    const int tid = tidx(), ntn = Npad / 64, ntiles = (K / 64) * ntn;
    for (int it = blockIdx.x; it < ntiles; it += gridDim.x) {
        const int k0 = (it / ntn) * 64, n0 = (it % ntn) * 64;
        __syncthreads();
#pragma unroll
        for (int h = 0; h < 2; ++h) {
            const int r = (tid >> 4) + h * 32, c4 = (tid & 15) * 4, nd = n0 + c4;
            int ns = -1;
#pragma unroll
            for (int sg = 0; sg < 3; ++sg) if (nd >= cm.d0[sg] && nd < cm.d0[sg] + cm.len[sg]) ns = cm.s0[sg] + (nd - cm.d0[sg]);
            float4 v = make_float4(0.f, 0.f, 0.f, 0.f);
            if (ns >= 0) v = *(const float4*)(W + (size_t)(k0 + r) * N + ns);
            tile[r][c4] = v.x; tile[r][c4 + 1] = v.y; tile[r][c4 + 2] = v.z; tile[r][c4 + 3] = v.w;
        }
        __syncthreads();
        const int n = tid >> 3, k8 = (tid & 7) * 8;
        float o[8];
#pragma unroll
        for (int j = 0; j < 8; ++j) o[j] = tile[k8 + j][n];
        st8(Wt + (size_t)(n0 + n) * K + k0 + k8, o);
    }
    __syncthreads();
}
__device__ __forceinline__ float gelu_tanh(float x) {
    float u = 0.7978845608028654f * (x + 0.044715f * x * x * x);
    return 0.5f * x * (1.f + tanhf(u));
}
__device__ __forceinline__ float sigmoidf_(float x) { return 1.f / (1.f + expf(-x)); }
__device__ __forceinline__ void wave_lds_fence() { asm volatile("s_waitcnt lgkmcnt(0)" ::: "memory"); }

__device__ __forceinline__ void s5_scan_wave(int bg, const bf16_t* __restrict__ proj, const float* __restrict__ lam_re, const float* __restrict__ lam_im,
                             const float* __restrict__ log_dt, const float* __restrict__ b_re, const float* __restrict__ b_im,
                             const float* __restrict__ c_re, const float* __restrict__ c_im, const float* __restrict__ dskip,
                             float* __restrict__ ya, float* lds) {
    const int b = bg >> 4, g = bg & 15, lane = tidx() & 63;
    float(*us)[16] = (float(*)[16])lds;
    float(*xr)[65] = (float(*)[65])(lds + 1024);
    float(*xi)[65] = (float(*)[65])(lds + 1024 + 4160);
    float(*cr)[64] = (float(*)[64])(lds + 1024 + 8320);
    float(*ci)[64] = (float(*)[64])(lds + 1024 + 8320 + 1024);
    const float lr = lam_re[g * 64 + lane], li = lam_im[g * 64 + lane];
    const float dt = expf(log_dt[g]);
    const float mag = expf(lr * dt);
    const float are = mag * cosf(li * dt), aim = mag * sinf(li * dt);
    const float nr = are - 1.f, den = lr * lr + li * li;
    const float fre = (nr * lr + aim * li) / den, fim = (aim * lr - nr * li) / den;
    float bbr[16], bbi[16];
#pragma unroll
    for (int i = 0; i < 16; ++i) {
        const float br = b_re[(g * 64 + lane) * 16 + i], bi = b_im[(g * 64 + lane) * 16 + i];
        bbr[i] = fre * br - fim * bi; bbi[i] = fre * bi + fim * br;
    }
    for (int idx = lane; idx < 1024; idx += 64) { cr[idx >> 6][idx & 63] = c_re[g * 1024 + idx]; ci[idx >> 6][idx & 63] = c_im[g * 1024 + idx]; }
    float dsk[16];
#pragma unroll
    for (int i = 0; i < 16; ++i) dsk[i] = dskip[g * 16 + i];
    float xre = 0.f, xim = 0.f;
    for (int t0 = 0; t0 < NL; t0 += 64) {
        wave_lds_fence();
        for (int idx = lane; idx < 1024; idx += 64) { const int t = idx >> 4, i = idx & 15; us[t][i] = bf2f(proj[(size_t)(b * NL + t0 + t) * EVEN_IN + g * 16 + i]); }
        wave_lds_fence();
        for (int t = 0; t < 64; ++t) {
            float bur = 0.f, bui = 0.f;
#pragma unroll
            for (int i = 0; i < 16; ++i) { const float u = us[t][i]; bur += bbr[i] * u; bui += bbi[i] * u; }
            const float nre = are * xre - aim * xim + bur, nim = are * xim + aim * xre + bui;
            xre = nre; xim = nim;
            xr[t][lane] = xre; xi[t][lane] = xim;
        }
        wave_lds_fence();
        float y[16];
#pragma unroll
        for (int i = 0; i < 16; ++i) y[i] = 0.f;
        for (int p = 0; p < 64; ++p) {
            const float a = xr[lane][p], bq = xi[lane][p];
#pragma unroll
            for (int i = 0; i < 16; ++i) y[i] += cr[i][p] * a - ci[i][p] * bq;
        }
#pragma unroll
        for (int i = 0; i < 16; ++i) {
            const float v = y[i] + dsk[i] * us[lane][i];
            ya[(size_t)(b * NL + t0 + lane) * 256 + g * 16 + i] = gelu_tanh(v);
        }
    }
}

__device__ __forceinline__ void sb_attn_wave(int task, const bf16_t* __restrict__ proj, bf16_t* __restrict__ Y, float* wl) {
    const int qt = task & 31, h = (task >> 5) % 12, b = task / 384, lane = tidx() & 63;
    const int t = qt * 64 + lane;
    float(*ks)[64] = (float(*)[64])wl;
    float(*vs)[64] = (float(*)[64])(wl + 2048);
    const bf16_t* base = proj + (size_t)b * NL * EVEN_IN;
    float q[64], acc[64];
#pragma unroll
    for (int d = 0; d < 64; d += 8) ld8(base + (size_t)t * EVEN_IN + 256 + h * 64 + d, q + d);
#pragma unroll
    for (int d = 0; d < 64; ++d) acc[d] = 0.f;
    float tail = 0.f;
    for (int c = 2 * qt + 1; c >= 0; --c) {
        wave_lds_fence();
        for (int i = 0; i < 32; ++i) {
            ks[i][lane] = bf2f(base[(size_t)(c * 32 + i) * EVEN_IN + 1024 + h * 64 + lane]);
            vs[i][lane] = bf2f(base[(size_t)(c * 32 + i) * EVEN_IN + 1792 + h * 64 + lane]);
        }
        wave_lds_fence();
        for (int s = 31; s >= 0; --s) {
            const int key = c * 32 + s;
            float z = 0.f;
#pragma unroll
            for (int d = 0; d < 64; ++d) z += q[d] * ks[s][d];
            z *= 0.125f;
            const bool valid = key < t;
            const float sp = fmaxf(z, 0.f) + log1pf(expf(-fabsf(z)));
            const float w = valid ? expf(z - sp + tail) : 0.f;
#pragma unroll
            for (int d = 0; d < 64; ++d) acc[d] += w * vs[s][d];
            if (valid) tail -= sp;
        }
        if (__all(tail < -120.f)) break;
    }
#pragma unroll
    for (int d = 0; d < 64; d += 8) st8(Y + (size_t)(b * NL + t) * ND + 256 + h * 64 + d, acc + d);
}

__device__ __forceinline__ void glu_phase(const float* __restrict__ ya, const float* __restrict__ wglu, const float* __restrict__ bglu, bf16_t* __restrict__ Y, float* lds) {
    const int half = tidx() >> 8, c = tidx() & 255;
    float(*ys)[256] = (float(*)[256])(lds + half * 4096);
    for (int it = blockIdx.x; it < NT / 32; it += gridDim.x) {
        const int t0 = it * 32 + half * 16;
        __syncthreads();
        for (int i = 0; i < 16; ++i) ys[i][c] = ya[(size_t)(t0 + i) * 256 + c];
        __syncthreads();
        float acc[16];
#pragma unroll
        for (int i = 0; i < 16; ++i) acc[i] = 0.f;
        for (int k = 0; k < 256; ++k) {
            const float w = wglu[k * 256 + c];
#pragma unroll
            for (int i = 0; i < 16; ++i) acc[i] += ys[i][k] * w;
        }
        const float bb = bglu[c];
#pragma unroll
        for (int i = 0; i < 16; ++i) Y[(size_t)(t0 + i) * ND + c] = f2bf(ys[i][c] * sigmoidf_(acc[i] + bb));
    }
    __syncthreads();
}

__device__ __forceinline__ void ln_row_wave(float4 (&v)[4], const float* __restrict__ g, const float* __restrict__ bta, float* out, bf16_t* outb, int lane) {
    float s = 0.f;
#pragma unroll
    for (int j = 0; j < 4; ++j) s += v[j].x + v[j].y + v[j].z + v[j].w;
    for (int o = 32; o; o >>= 1) s += __shfl_xor(s, o);
    const float mean = s * (1.f / ND);
    float s2 = 0.f;
#pragma unroll
    for (int j = 0; j < 4; ++j) {
        v[j].x -= mean; v[j].y -= mean; v[j].z -= mean; v[j].w -= mean;
        s2 += v[j].x * v[j].x + v[j].y * v[j].y + v[j].z * v[j].z + v[j].w * v[j].w;
    }
    for (int o = 32; o; o >>= 1) s2 += __shfl_xor(s2, o);
    const float rs = rsqrtf(s2 * (1.f / ND) + LN_EPS);
#pragma unroll
    for (int j = 0; j < 4; ++j) {
        const float4 gg = *(const float4*)(g + j * 256 + lane * 4), bb = *(const float4*)(bta + j * 256 + lane * 4);
        const float4 o = make_float4(v[j].x * rs * gg.x + bb.x, v[j].y * rs * gg.y + bb.y, v[j].z * rs * gg.z + bb.z, v[j].w * rs * gg.w + bb.w);
        *(float4*)(out + j * 256 + lane * 4) = o;
        if (outb) { uint2 w; w.x = pack2(o.x, o.y); w.y = pack2(o.z, o.w); *(uint2*)(outb + j * 256 + lane * 4) = w; }
    }
}
__device__ __forceinline__ void ln_phase(float* R, bf16_t* Hb, const float* __restrict__ g, const float* __restrict__ bta) {
    const int wave = tidx() >> 6, lane = tidx() & 63;
    for (int row = blockIdx.x * 8 + wave; row < NT; row += gridDim.x * 8) {
        float4 v[4];
#pragma unroll
        for (int j = 0; j < 4; ++j) v[j] = *(const float4*)(R + (size_t)row * ND + j * 256 + lane * 4);
        ln_row_wave(v, g, bta, R + (size_t)row * ND, Hb + (size_t)row * ND, lane);
    }
}

__device__ __forceinline__ void wave_argmax(float& bv, int& bi) {
#pragma unroll
    for (int o = 32; o; o >>= 1) {
        const float ov = __shfl_xor(bv, o); const int oi = __shfl_xor(bi, o);
        if (ov > bv || (ov == bv && oi < bi)) { bv = ov; bi = oi; }
    }
}
__device__ __forceinline__ void peer_route_phase(const bf16_t* __restrict__ qbuf, const float* __restrict__ subk, int* __restrict__ eidx, float* __restrict__ egate, float* lds) {
    const int head = tidx() >> 6, lane = tidx() & 63;
    float* qs = lds + head * 256;
    for (int token = blockIdx.x; token < NT; token += gridDim.x) {
        const bf16_t* qp = qbuf + (size_t)token * 2048 + head * 256;
        wave_lds_fence();
        for (int i = 0; i < 4; ++i) qs[lane + 64 * i] = bf2f(qp[lane + 64 * i]);
        wave_lds_fence();
        float myv[2]; int myi[2];
#pragma unroll
        for (int c = 0; c < 2; ++c) {
            float sc[2];
#pragma unroll
            for (int w2 = 0; w2 < 2; ++w2) {
                const float* kr = subk + ((size_t)(head * 2 + c) * 128 + lane + 64 * w2) * 128;
                float a = 0.f;
#pragma unroll 4
                for (int d = 0; d < 128; d += 4) {
                    const float4 kv = *(const float4*)(kr + d);
                    a += qs[c * 128 + d] * kv.x + qs[c * 128 + d + 1] * kv.y + qs[c * 128 + d + 2] * kv.z + qs[c * 128 + d + 3] * kv.w;
                }
                sc[w2] = a;
            }
            float a0 = sc[0], a1 = sc[1];
            float mv = -INFINITY; int mi = 0;
            for (int r = 0; r < 16; ++r) {
                float bv; int bi;
                if (a0 >= a1) { bv = a0; bi = lane; } else { bv = a1; bi = lane + 64; }
                wave_argmax(bv, bi);
                if (lane == r) { mv = bv; mi = bi; }
                if (bi == lane) a0 = -INFINITY; else if (bi == lane + 64) a1 = -INFINITY;
            }
            myv[c] = mv; myi[c] = mi;
        }
        const float va = __shfl(myv[0], lane >> 2);
        float cand[4];
#pragma unroll
        for (int j = 0; j < 4; ++j) cand[j] = va + __shfl(myv[1], (lane & 3) * 4 + j);
        float topv = -INFINITY; int topf = 0;
        for (int r = 0; r < 16; ++r) {
            float bv = cand[0]; int bi = lane * 4;
#pragma unroll
            for (int j = 1; j < 4; ++j) if (cand[j] > bv) { bv = cand[j]; bi = lane * 4 + j; }
            wave_argmax(bv, bi);
            if (lane == r) { topv = bv; topf = bi; }
#pragma unroll
            for (int j = 0; j < 4; ++j) if (bi == lane * 4 + j) cand[j] = -INFINITY;
        }
        const int e1 = __shfl(myi[0], topf >> 4), e2 = __shfl(myi[1], topf & 15);
        const float top0 = __shfl(topv, 0);
        float ex = (lane < 16) ? expf(topv - top0) : 0.f;
        float sum = ex;
        for (int o = 32; o; o >>= 1) sum += __shfl_xor(sum, o);
        if (lane < 16) {
            eidx[(size_t)token * 128 + head * 16 + lane] = e1 * 128 + e2;
            egate[(size_t)token * 128 + head * 16 + lane] = ex / sum;
        }
    }
}

__device__ __forceinline__ void peer_expert_phase(float* R, const int* __restrict__ eidx, const float* __restrict__ egate, const float* __restrict__ utab,
                                  const float* __restrict__ vtab, const float* __restrict__ lg, const float* __restrict__ lb, bf16_t* Hb) {
    const int wave = tidx() >> 6, lane = tidx() & 63;
    for (int token = blockIdx.x * 8 + wave; token < NT; token += gridDim.x * 8) {
        float4 x[4], acc[4];
#pragma unroll
        for (int j = 0; j < 4; ++j) { x[j] = *(const float4*)(R + (size_t)token * ND + j * 256 + lane * 4); acc[j] = make_float4(0.f, 0.f, 0.f, 0.f); }
        for (int e0 = 0; e0 < 128; e0 += 4) {
            float dot[4]; int ex[4]; float gt[4];
#pragma unroll
            for (int k = 0; k < 4; ++k) {
                ex[k] = eidx[(size_t)token * 128 + e0 + k]; gt[k] = egate[(size_t)token * 128 + e0 + k];
                const float* ur = utab + (size_t)ex[k] * ND + lane * 4;
                float a = 0.f;
#pragma unroll
                for (int j = 0; j < 4; ++j) { const float4 u = *(const float4*)(ur + j * 256); a += x[j].x * u.x + x[j].y * u.y + x[j].z * u.z + x[j].w * u.w; }
                dot[k] = a;
            }
#pragma unroll
            for (int k = 0; k < 4; ++k) {
                float a = dot[k];
                for (int o = 32; o; o >>= 1) a += __shfl_xor(a, o);
                const float coef = gt[k] * gelu_tanh(a);
                const float* vr = vtab + (size_t)ex[k] * ND + lane * 4;
#pragma unroll
                for (int j = 0; j < 4; ++j) { const float4 v = *(const float4*)(vr + j * 256); acc[j].x += coef * v.x; acc[j].y += coef * v.y; acc[j].z += coef * v.z; acc[j].w += coef * v.w; }
            }
        }
#pragma unroll
        for (int j = 0; j < 4; ++j) { x[j].x = ALPHA * x[j].x + acc[j].x; x[j].y = ALPHA * x[j].y + acc[j].y; x[j].z = ALPHA * x[j].z + acc[j].z; x[j].w = ALPHA * x[j].w + acc[j].w; }
        ln_row_wave(x, lg, lb, R + (size_t)token * ND, Hb ? Hb + (size_t)token * ND : nullptr, lane);
    }
}


typedef short bf16x8_t __attribute__((ext_vector_type(8)));
__device__ __forceinline__ int f2key(float f) { const int b = __float_as_int(f); return b ^ ((b >> 31) & 0x7fffffff); }
__device__ __forceinline__ float key2f(int k) { return __int_as_float(k ^ ((k >> 31) & 0x7fffffff)); }
#define CE_DESC_I(a, b) do { const int _hi = max(a, b), _lo = min(a, b); a = _hi; b = _lo; } while (0)
template <int N, int K, int J> __device__ __forceinline__ void bstage(int (&v)[N]) {
#pragma unroll
    for (int i = 0; i < N; ++i) {
        const int l = i ^ J;
        if (l > i) { if ((i & K) == 0) CE_DESC_I(v[i], v[l]); else CE_DESC_I(v[l], v[i]); }
    }
}
__device__ __forceinline__ void sort16_desc(int (&v)[16]) {
    bstage<16, 2, 1>(v); bstage<16, 4, 2>(v); bstage<16, 4, 1>(v); bstage<16, 8, 4>(v); bstage<16, 8, 2>(v); bstage<16, 8, 1>(v);
    bstage<16, 16, 8>(v); bstage<16, 16, 4>(v); bstage<16, 16, 2>(v); bstage<16, 16, 1>(v);
}
__device__ __forceinline__ void sort8_desc(int (&v)[8]) {
    bstage<8, 2, 1>(v); bstage<8, 4, 2>(v); bstage<8, 4, 1>(v); bstage<8, 8, 4>(v); bstage<8, 8, 2>(v); bstage<8, 8, 1>(v);
}
__device__ __forceinline__ void bitonic_merge16_desc(int (&v)[16]) {
    bstage<16, 16, 8>(v); bstage<16, 16, 4>(v); bstage<16, 16, 2>(v); bstage<16, 16, 1>(v);
}
__device__ __forceinline__ void xmerge16(int (&v)[16], int off) {
    int m[16];
#pragma unroll
    for (int i = 0; i < 16; ++i) m[i] = max(v[i], __shfl_xor(v[15 - i], off));
    bitonic_merge16_desc(m);
#pragma unroll
    for (int i = 0; i < 16; ++i) v[i] = m[i];
}
__device__ __forceinline__ void opaque16(int (&v)[16]) {
#pragma unroll
    for (int i = 0; i < 16; ++i) asm volatile("" : "+v"(v[i]));
}
__device__ __forceinline__ int lookup16(const int (&arr)[16], int a) {
    int r = arr[0];
#pragma unroll
    for (int i = 1; i < 16; ++i) r = (a == i) ? arr[i] : r;
    return r;
}
__device__ __forceinline__ void peer_route2_phase(const bf16_t* __restrict__ qbuf, const bf16_t* __restrict__ skb, int* __restrict__ eidx, float* __restrict__ egate, unsigned char* lds) {
    const int tid = tidx(), wave = tid >> 6, lane = tid & 63, fr = lane & 15, fq = lane >> 4;
    for (int chunk = blockIdx.x; chunk < NT / 128; chunk += gridDim.x) {
        const int token = chunk * 128 + wave * 16 + fr;
        int* tl = (int*)(lds + 34816) + (wave * 16 + fr) * 48;
        for (int h = 0; h < 8; ++h) {
            int K1[16], K2[16];
#pragma unroll
            for (int c = 0; c < 2; ++c) {
                __syncthreads();
#pragma unroll
                for (int i = 0; i < 4; ++i) {
                    const int idx = tid + 512 * i, row = idx >> 4, ch = idx & 15;
                    *(uint4*)(lds + row * 272 + ch * 16) = *(const uint4*)(skb + ((size_t)(h * 2 + c) * 128 + row) * 128 + ch * 8);
                }
                __syncthreads();
                bf16x8_t qf[4];
#pragma unroll
                for (int sI = 0; sI < 4; ++sI) qf[sI] = *(const bf16x8_t*)(qbuf + (size_t)token * 2048 + h * 256 + c * 128 + 32 * sI + 8 * fq);
                int va[16], vb[16];
#pragma unroll
                for (int n = 0; n < 8; ++n) {
                    f32x4 S = {0.f, 0.f, 0.f, 0.f};
#pragma unroll
                    for (int sI = 0; sI < 4; ++sI) {
                        const bf16x8_t kf = *(const bf16x8_t*)(lds + (16 * n + fr) * 272 + (32 * sI + 8 * fq) * 2);
                        S = __builtin_amdgcn_mfma_f32_16x16x32_bf16(kf, qf[sI], S, 0, 0, 0);
                    }
#pragma unroll
                    for (int j = 0; j < 4; ++j) {
                        const int key = (f2key(S[j]) & ~127) | (16 * n + 4 * fq + j);
                        if (n < 4) va[n * 4 + j] = key; else vb[(n - 4) * 4 + j] = key;
                    }
                }
                sort16_desc(va); sort16_desc(vb);
                int m[16];
#pragma unroll
                for (int i = 0; i < 16; ++i) m[i] = max(va[i], vb[15 - i]);
                bitonic_merge16_desc(m);
                xmerge16(m, 16); xmerge16(m, 32);
#pragma unroll
                for (int i = 0; i < 16; ++i) { if (c == 0) K1[i] = m[i]; else K2[i] = m[i]; }
                if (fq == 0) {
#pragma unroll
                    for (int i = 0; i < 4; ++i) *(int4*)(tl + c * 16 + 4 * i) = make_int4(m[4 * i], m[4 * i + 1], m[4 * i + 2], m[4 * i + 3]);
                }
            }
            wave_lds_fence();
            float vaf[4];
#pragma unroll
            for (int k = 0; k < 4; ++k) vaf[k] = key2f(tl[4 * k + fq]);
            int A[16];
#pragma unroll
            for (int b = 0; b < 16; ++b) {
                const bool valid = (fq + 1) * (b + 1) <= 16;
                const int key = (f2key(vaf[0] + key2f(K2[b])) & ~127) | (fq << 5) | b;
                A[b] = valid ? key : INT_MIN;
            }
            int Bq[8];
#pragma unroll
            for (int b = 0; b < 3; ++b) {
                const bool valid = (fq + 5) * (b + 1) <= 16;
                const int key = (f2key(vaf[1] + key2f(K2[b])) & ~127) | (fq << 5) | (16 + b);
                Bq[b] = valid ? key : INT_MIN;
            }
            Bq[3] = (f2key(vaf[2] + key2f(K2[0])) & ~127) | (fq << 5) | 19;
            Bq[4] = (f2key(vaf[3] + key2f(K2[0])) & ~127) | (fq << 5) | 20;
            Bq[5] = INT_MIN; Bq[6] = INT_MIN; Bq[7] = INT_MIN;
            sort8_desc(Bq);
#pragma unroll
            for (int i = 8; i < 16; ++i) A[i] = max(A[i], Bq[15 - i]);
            bitonic_merge16_desc(A);
            xmerge16(A, 16); xmerge16(A, 32);
            if (fq == 0) {
#pragma unroll
                for (int i = 0; i < 4; ++i) *(int4*)(tl + 32 + 4 * i) = make_int4(A[4 * i], A[4 * i + 1], A[4 * i + 2], A[4 * i + 3]);
            }
            wave_lds_fence();
            const int4 myT = *(const int4*)(tl + 32 + 4 * fq);
            const int tsel[4] = {myT.x, myT.y, myT.z, myT.w};
            const float top0 = key2f(A[0]);
            float sum = 0.f;
#pragma unroll
            for (int r = 0; r < 16; ++r) sum += __expf(key2f(A[r]) - top0);
            const float inv = 1.f / sum;
            int eo[4]; float go[4];
#pragma unroll
            for (int kk = 0; kk < 4; ++kk) {
                const int t = tsel[kk];
                const int id = t & 127, ofq = id >> 5, slot = id & 31;
                const int k = slot < 16 ? 0 : (slot < 19 ? 1 : (slot == 19 ? 2 : 3));
                const int b = slot < 16 ? slot : (slot < 19 ? slot - 16 : 0);
                const int a = ofq + 4 * k;
                const int e1 = tl[a] & 127, e2 = tl[16 + b] & 127;
                eo[kk] = e1 * 128 + e2;
                go[kk] = __expf(key2f(t) - top0) * inv;
            }
            *(int4*)(eidx + (size_t)token * 128 + h * 16 + 4 * fq) = make_int4(eo[0], eo[1], eo[2], eo[3]);
            *(float4*)(egate + (size_t)token * 128 + h * 16 + 4 * fq) = make_float4(go[0], go[1], go[2], go[3]);
            wave_lds_fence();
        }
    }
    __syncthreads();
}

typedef __bf16 bf16x2_t __attribute__((ext_vector_type(2)));
typedef float f32x2_t __attribute__((ext_vector_type(2)));
__device__ __forceinline__ float dot2bf(unsigned a, unsigned b, float acc) { return __builtin_amdgcn_fdot2_f32_bf16(__builtin_bit_cast(bf16x2_t, a), __builtin_bit_cast(bf16x2_t, b), acc, false); }
__device__ __forceinline__ float gelu_fast(float x) {
    const float u = 0.7978845608028654f * (x + 0.044715f * x * x * x);
    return x / (1.f + __expf(-2.f * u));
}
__device__ __forceinline__ void peer_expert2_phase(float* R, const int* __restrict__ eidx, const float* __restrict__ egate, const bf16_t* __restrict__ ub,
                                                   const bf16_t* __restrict__ vb, const float* __restrict__ lg, const float* __restrict__ lb, bf16_t* Hb) {
    const int wave = tidx() >> 6, lane = tidx() & 63;
    for (int token = blockIdx.x * 8 + wave; token < NT; token += gridDim.x * 8) {
        float xf[16];
        {
            const float* rp = R + (size_t)token * ND + lane * 8;
            const float4 a0 = *(const float4*)rp, a1 = *(const float4*)(rp + 4), b0 = *(const float4*)(rp + 512), b1 = *(const float4*)(rp + 516);
            xf[0] = a0.x; xf[1] = a0.y; xf[2] = a0.z; xf[3] = a0.w; xf[4] = a1.x; xf[5] = a1.y; xf[6] = a1.z; xf[7] = a1.w;
            xf[8] = b0.x; xf[9] = b0.y; xf[10] = b0.z; xf[11] = b0.w; xf[12] = b1.x; xf[13] = b1.y; xf[14] = b1.z; xf[15] = b1.w;
        }
        unsigned xp[8];
#pragma unroll
        for (int j = 0; j < 8; ++j) xp[j] = pack2(xf[2 * j], xf[2 * j + 1]);
        float acc[16];
#pragma unroll
        for (int j = 0; j < 16; ++j) acc[j] = 0.f;
        const int e_lo = eidx[(size_t)token * 128 + lane], e_hi = eidx[(size_t)token * 128 + 64 + lane];
        const float g_lo = egate[(size_t)token * 128 + lane], g_hi = egate[(size_t)token * 128 + 64 + lane];
        for (int grp = 0; grp < 16; ++grp) {
            const int esel = grp < 8 ? e_lo : e_hi;
            const float gsel = grp < 8 ? g_lo : g_hi;
            const int lbase = (grp & 7) * 8;
            uint4 u0[8], u1[8];
            int exs[8];
#pragma unroll
            for (int k = 0; k < 8; ++k) {
                exs[k] = __builtin_amdgcn_readlane(esel, lbase + k);
                const bf16_t* up = ub + (size_t)exs[k] * ND + lane * 8;
                u0[k] = *(const uint4*)up; u1[k] = *(const uint4*)(up + 512);
            }
            float d[8];
#pragma unroll
            for (int k = 0; k < 8; ++k) {
                float a = dot2bf(u0[k].x, xp[0], 0.f), b = dot2bf(u0[k].y, xp[1], 0.f);
                a = dot2bf(u0[k].z, xp[2], a); b = dot2bf(u0[k].w, xp[3], b);
                a = dot2bf(u1[k].x, xp[4], a); b = dot2bf(u1[k].y, xp[5], b);
                a = dot2bf(u1[k].z, xp[6], a); b = dot2bf(u1[k].w, xp[7], b);
                d[k] = a + b;
            }
            const bool hi5 = lane & 32, hi4 = lane & 16, hi3 = lane & 8;
            float r4[4], r2[2], r1;
#pragma unroll
            for (int k = 0; k < 4; ++k) { const float send = hi5 ? d[k] : d[k + 4], keep = hi5 ? d[k + 4] : d[k]; r4[k] = keep + __shfl_xor(send, 32); }
#pragma unroll
            for (int k = 0; k < 2; ++k) { const float send = hi4 ? r4[k] : r4[k + 2], keep = hi4 ? r4[k + 2] : r4[k]; r2[k] = keep + __shfl_xor(send, 16); }
            { const float send = hi3 ? r2[0] : r2[1], keep = hi3 ? r2[1] : r2[0]; r1 = keep + __shfl_xor(send, 8); }
            r1 += __shfl_xor(r1, 4); r1 += __shfl_xor(r1, 2); r1 += __shfl_xor(r1, 1);
            uint4 v0[8], v1[8];
#pragma unroll
            for (int k = 0; k < 8; ++k) {
                const bf16_t* vp = vb + (size_t)exs[k] * ND + lane * 8;
                v0[k] = *(const uint4*)vp; v1[k] = *(const uint4*)(vp + 512);
            }
            const float gk = __shfl(gsel, lbase + (lane >> 3));
            const float coef = gk * gelu_fast(r1);
#pragma unroll
            for (int k = 0; k < 8; ++k) {
                const float ck = __int_as_float(__builtin_amdgcn_readlane(__float_as_int(coef), 8 * k));
                const unsigned w[8] = {v0[k].x, v0[k].y, v0[k].z, v0[k].w, v1[k].x, v1[k].y, v1[k].z, v1[k].w};
#pragma unroll
                for (int j = 0; j < 8; ++j) {
                    acc[2 * j] += ck * __uint_as_float(w[j] << 16);
                    acc[2 * j + 1] += ck * __uint_as_float(w[j] & 0xffff0000u);
                }
            }
        }
        {
            const float* rp = R + (size_t)token * ND + lane * 8;
            const float4 a0 = *(const float4*)rp, a1 = *(const float4*)(rp + 4), b0 = *(const float4*)(rp + 512), b1 = *(const float4*)(rp + 516);
            xf[0] = a0.x; xf[1] = a0.y; xf[2] = a0.z; xf[3] = a0.w; xf[4] = a1.x; xf[5] = a1.y; xf[6] = a1.z; xf[7] = a1.w;
            xf[8] = b0.x; xf[9] = b0.y; xf[10] = b0.z; xf[11] = b0.w; xf[12] = b1.x; xf[13] = b1.y; xf[14] = b1.z; xf[15] = b1.w;
        }
        float s = 0.f;
#pragma unroll
        for (int j = 0; j < 16; ++j) { xf[j] = ALPHA * xf[j] + acc[j]; s += xf[j]; }
        for (int o = 32; o; o >>= 1) s += __shfl_xor(s, o);
        const float mean = s * (1.f / ND);
        float s2 = 0.f;
#pragma unroll
        for (int j = 0; j < 16; ++j) { xf[j] -= mean; s2 += xf[j] * xf[j]; }
        for (int o = 32; o; o >>= 1) s2 += __shfl_xor(s2, o);
        const float rs = rsqrtf(s2 * (1.f / ND) + LN_EPS);
#pragma unroll
        for (int hf = 0; hf < 2; ++hf) {
            const int c0 = hf * 512 + lane * 8;
            const float4 g0 = *(const float4*)(lg + c0), g1 = *(const float4*)(lg + c0 + 4), b0 = *(const float4*)(lb + c0), b1 = *(const float4*)(lb + c0 + 4);
            float o[8];
            o[0] = xf[hf * 8 + 0] * rs * g0.x + b0.x; o[1] = xf[hf * 8 + 1] * rs * g0.y + b0.y; o[2] = xf[hf * 8 + 2] * rs * g0.z + b0.z; o[3] = xf[hf * 8 + 3] * rs * g0.w + b0.w;
            o[4] = xf[hf * 8 + 4] * rs * g1.x + b1.x; o[5] = xf[hf * 8 + 5] * rs * g1.y + b1.y; o[6] = xf[hf * 8 + 6] * rs * g1.z + b1.z; o[7] = xf[hf * 8 + 7] * rs * g1.w + b1.w;
            float* op = R + (size_t)token * ND + c0;
            *(float4*)op = make_float4(o[0], o[1], o[2], o[3]); *(float4*)(op + 4) = make_float4(o[4], o[5], o[6], o[7]);
            if (Hb) st8(Hb + (size_t)token * ND + c0, o);
        }
    }
}


__device__ __forceinline__ void peer_expert3_phase(float* R, const int* __restrict__ eidx, const float* __restrict__ egate, const unsigned char* __restrict__ ub,
                                                   const unsigned char* __restrict__ vb, const float* __restrict__ lg, const float* __restrict__ lb, bf16_t* Hb, float* Rout) {
    const int wave = tidx() >> 6, lane = tidx() & 63;
    for (int token = blockIdx.x * 8 + wave; token < NT; token += gridDim.x * 8) {
        float xf[16];
        {
            const float* rp = R + (size_t)token * ND + lane * 16;
#pragma unroll
            for (int q = 0; q < 4; ++q) { const float4 a = *(const float4*)(rp + 4 * q); xf[4 * q] = a.x; xf[4 * q + 1] = a.y; xf[4 * q + 2] = a.z; xf[4 * q + 3] = a.w; }
        }
        float acc[16];
#pragma unroll
        for (int j = 0; j < 16; ++j) acc[j] = 0.f;
        const int e_lo = eidx[(size_t)token * 128 + lane], e_hi = eidx[(size_t)token * 128 + 64 + lane];
        const float g_lo = egate[(size_t)token * 128 + lane], g_hi = egate[(size_t)token * 128 + 64 + lane];
        for (int grp = 0; grp < 16; ++grp) {
            const int esel = grp < 8 ? e_lo : e_hi;
            const float gsel = grp < 8 ? g_lo : g_hi;
            const int lbase = (grp & 7) * 8;
            uint4 u[8], v[8];
#pragma unroll
            for (int k = 0; k < 8; ++k) {
                const int ex = __builtin_amdgcn_readlane(esel, lbase + k);
                u[k] = *(const uint4*)(ub + (size_t)ex * ND + lane * 16);
                v[k] = *(const uint4*)(vb + (size_t)ex * ND + lane * 16);
            }
            float d[8];
#pragma unroll
            for (int k = 0; k < 8; ++k) {
                const unsigned w[4] = {u[k].x, u[k].y, u[k].z, u[k].w};
                float a = 0.f, b = 0.f;
#pragma unroll
                for (int q = 0; q < 4; ++q) {
                    const f32x2_t lo = __builtin_amdgcn_cvt_pk_f32_fp8((int)w[q], false), hi = __builtin_amdgcn_cvt_pk_f32_fp8((int)w[q], true);
                    a = fmaf(xf[4 * q], lo.x, a); b = fmaf(xf[4 * q + 1], lo.y, b); a = fmaf(xf[4 * q + 2], hi.x, a); b = fmaf(xf[4 * q + 3], hi.y, b);
                }
                d[k] = a + b;
            }
            const bool hi5 = lane & 32, hi4 = lane & 16, hi3 = lane & 8;
            float r4[4], r2[2], r1;
#pragma unroll
            for (int k = 0; k < 4; ++k) { const float send = hi5 ? d[k] : d[k + 4], keep = hi5 ? d[k + 4] : d[k]; r4[k] = keep + __shfl_xor(send, 32); }
#pragma unroll
            for (int k = 0; k < 2; ++k) { const float send = hi4 ? r4[k] : r4[k + 2], keep = hi4 ? r4[k + 2] : r4[k]; r2[k] = keep + __shfl_xor(send, 16); }
            { const float send = hi3 ? r2[0] : r2[1], keep = hi3 ? r2[1] : r2[0]; r1 = keep + __shfl_xor(send, 8); }
            r1 += __shfl_xor(r1, 4); r1 += __shfl_xor(r1, 2); r1 += __shfl_xor(r1, 1);
            const float gk = __shfl(gsel, lbase + (lane >> 3));
            const float coef = gk * gelu_fast(r1 * (1.f / U_SCALE)) * (1.f / V_SCALE);
#pragma unroll
            for (int k = 0; k < 8; ++k) {
                const float ck = __int_as_float(__builtin_amdgcn_readlane(__float_as_int(coef), 8 * k));
                const unsigned w[4] = {v[k].x, v[k].y, v[k].z, v[k].w};
#pragma unroll
                for (int q = 0; q < 4; ++q) {
                    const f32x2_t lo = __builtin_amdgcn_cvt_pk_f32_fp8((int)w[q], false), hi = __builtin_amdgcn_cvt_pk_f32_fp8((int)w[q], true);
                    acc[4 * q] = fmaf(ck, lo.x, acc[4 * q]); acc[4 * q + 1] = fmaf(ck, lo.y, acc[4 * q + 1]);
                    acc[4 * q + 2] = fmaf(ck, hi.x, acc[4 * q + 2]); acc[4 * q + 3] = fmaf(ck, hi.y, acc[4 * q + 3]);
                }
            }
        }
        float s = 0.f;
#pragma unroll
        for (int j = 0; j < 16; ++j) { xf[j] = ALPHA * xf[j] + acc[j]; s += xf[j]; }
        for (int o = 32; o; o >>= 1) s += __shfl_xor(s, o);
        const float mean = s * (1.f / ND);
        float s2 = 0.f;
#pragma unroll
        for (int j = 0; j < 16; ++j) { xf[j] -= mean; s2 += xf[j] * xf[j]; }
        for (int o = 32; o; o >>= 1) s2 += __shfl_xor(s2, o);
        const float rs = rsqrtf(s2 * (1.f / ND) + LN_EPS);
        float o[16];
#pragma unroll
        for (int q = 0; q < 4; ++q) {
            const float4 gg = *(const float4*)(lg + lane * 16 + 4 * q), bb = *(const float4*)(lb + lane * 16 + 4 * q);
            o[4 * q] = xf[4 * q] * rs * gg.x + bb.x; o[4 * q + 1] = xf[4 * q + 1] * rs * gg.y + bb.y; o[4 * q + 2] = xf[4 * q + 2] * rs * gg.z + bb.z; o[4 * q + 3] = xf[4 * q + 3] * rs * gg.w + bb.w;
            *(float4*)(Rout + (size_t)token * ND + lane * 16 + 4 * q) = make_float4(o[4 * q], o[4 * q + 1], o[4 * q + 2], o[4 * q + 3]);
        }
        if (Hb) { st8(Hb + (size_t)token * ND + lane * 16, o); st8(Hb + (size_t)token * ND + lane * 16 + 8, o + 8); }
    }
}

__device__ __forceinline__ void nsa_compress_phase(const bf16_t* __restrict__ proj, int coloff, const float* __restrict__ pe, const float* __restrict__ w1,
                                   const float* __restrict__ w2, float* __restrict__ outc, float* lds) {
    const int qtr = tidx() >> 7, tid = tidx() & 127;
    float* in = lds + qtr * 2176;
    float* hid = in + 2048;
    for (int it = blockIdx.x; it < NB * 127; it += gridDim.x) {
        const int g = qtr, n = it % 127, b = it / 127;
        __syncthreads();
        for (int idx = tid; idx < 2048; idx += 128) {
            const int l = idx >> 6, d = idx & 63;
            in[idx] = bf2f(proj[(size_t)(b * NL + 16 * n + l) * ODD_PAD + coloff + g * 64 + d]) + pe[l * 64 + d];
        }
        __syncthreads();
        float a = 0.f;
        for (int i = 0; i < 2048; ++i) a += in[i] * w1[(size_t)i * 128 + tid];
        hid[tid] = gelu_tanh(a);
        __syncthreads();
        if (tid < 64) {
            float o = 0.f;
            for (int j = 0; j < 128; ++j) o += hid[j] * w2[j * 64 + tid];
            outc[((size_t)(b * 127 + n) * 4 + g) * 64 + tid] = o;
        }
    }
    __syncthreads();
}

__device__ __forceinline__ void nsa_cmp_phase(const bf16_t* __restrict__ proj, const float* __restrict__ kcmp, const float* __restrict__ vcmp,
                              bf16_t* __restrict__ O, unsigned* __restrict__ selmask, float* lds) {
    const int half = tidx() >> 8, tid = tidx() & 255;
    float* kc_s = lds + half * 18368;
    float* vc_s = kc_s + 127 * 64;
    float(*imp_s)[33] = (float(*)[33])(vc_s + 127 * 64);
    const int tk = tid >> 2, r = tid & 3;
    for (int it = blockIdx.x; it < 32 * 4 * NB / 2; it += gridDim.x) {
        const int vb = it * 2 + half;
        const int tile = vb & 31, g = (vb >> 5) & 3, b = vb >> 7;
        const int t = tile * 64 + tk, hd = g * 4 + r;
        __syncthreads();
        for (int idx = tid; idx < 127 * 64; idx += 256) { const int n = idx >> 6, d = idx & 63; kc_s[idx] = kcmp[((size_t)(b * 127 + n) * 4 + g) * 64 + d]; vc_s[idx] = vcmp[((size_t)(b * 127 + n) * 4 + g) * 64 + d]; }
        const bf16_t* prow = proj + (size_t)(b * NL + t) * ODD_PAD;
        float q[64];
#pragma unroll
        for (int d = 0; d < 64; d += 8) ld8(prow + hd * 64 + d, q + d);
        const float slope = exp2f(-0.5f * (float)(hd + 1));
        int nvalid = (t >= 31) ? ((t - 31) / 16 + 1) : 0;
        if (nvalid > 127) nvalid = 127;
        __syncthreads();
        float m = -INFINITY, l = 0.f;
        for (int n = 0; n < nvalid; ++n) {
            float s = 0.f;
#pragma unroll
            for (int d = 0; d < 64; ++d) s += q[d] * kc_s[n * 64 + d];
            s = s * 0.125f - slope * (float)(t - (16 * n + 31));
            const float mn = fmaxf(m, s);
            l = l * expf(m - mn) + expf(s - mn);
            m = mn;
        }
        const float inv_l = (nvalid > 0) ? 1.f / fmaxf(l, 1e-30f) : 0.f;
        float acc[64];
#pragma unroll
        for (int d = 0; d < 64; ++d) acc[d] = 0.f;
        float prev3 = 0.f;
        for (int j = 0; j < 32; ++j) {
            float pj[4];
#pragma unroll
            for (int nn = 0; nn < 4; ++nn) {
                const int n = 4 * j + nn;
                float p = 0.f;
                if (n < nvalid) {
                    float s = 0.f;
#pragma unroll
                    for (int d = 0; d < 64; ++d) s += q[d] * kc_s[n * 64 + d];
                    s = s * 0.125f - slope * (float)(t - (16 * n + 31));
                    p = expf(s - m) * inv_l;
                    const float* vr = vc_s + n * 64;
#pragma unroll
                    for (int d = 0; d < 64; ++d) acc[d] += p * vr[d];
                }
                pj[nn] = p;
            }
            float im = 0.5f * prev3 + pj[0] + pj[1] + pj[2] + 0.5f * pj[3];
            prev3 = pj[3];
            im += __shfl_xor(im, 1);
            im += __shfl_xor(im, 2);
            if (r == 0) imp_s[tk][j] = im;
        }
        const float g0 = sigmoidf_(bf2f(prow[2048 + hd]));
#pragma unroll
        for (int d = 0; d < 64; ++d) acc[d] *= g0;
#pragma unroll
        for (int d = 0; d < 64; d += 8) st8(O + (size_t)(b * NL + t) * ND + hd * 64 + d, acc + d);
        __syncthreads();
        const int cur = tile;
        unsigned bits = 0;
        for (int jj = 0; jj < 8; ++jj) {
            const int j = r * 8 + jj;
            const bool fj = (j == 0) || (j == cur) || (j == cur - 1);
            const float vj = (j <= cur) ? imp_s[tk][j] + (fj ? 1000.f : 0.f) : -INFINITY;
            int rank = 0;
            for (int k = 0; k < 32; ++k) {
                const bool fk = (k == 0) || (k == cur) || (k == cur - 1);
                const float vk = (k <= cur) ? imp_s[tk][k] + (fk ? 1000.f : 0.f) : -INFINITY;
                rank += (vk > vj || (vk == vj && k < j)) ? 1 : 0;
            }
            if (rank < 16) bits |= 1u << j;
        }
        bits |= __shfl_xor(bits, 1);
        bits |= __shfl_xor(bits, 2);
        if (r == 0) selmask[(size_t)(b * 4 + g) * NL + t] = bits;
    }
    __syncthreads();
}

__device__ __forceinline__ void nsa_selwin_phase(const bf16_t* __restrict__ proj, const unsigned* __restrict__ selmask, bf16_t* O, float* lds) {
    const int half = tidx() >> 8, tid = tidx() & 255;
    float(*k_s)[64] = (float(*)[64])(lds + half * 8192);
    float(*v_s)[64] = (float(*)[64])(lds + half * 8192 + 4096);
    const int tk = tid >> 2, r = tid & 3;
    for (int it = blockIdx.x; it < 32 * 32; it += gridDim.x) {
        const int tile = 31 - (it >> 5);
        const int bgi = (it & 31) * 2 + half, g = bgi & 3, b = bgi >> 2;
        const int t = tile * 64 + tk, hd = g * 4 + r;
        const bf16_t* pb = proj + (size_t)b * NL * ODD_PAD;
        const bf16_t* prow = pb + (size_t)t * ODD_PAD;
        float q[64], acc[64];
#pragma unroll
        for (int d = 0; d < 64; d += 8) ld8(prow + hd * 64 + d, q + d);
        const float slope = exp2f(-0.5f * (float)(hd + 1));
        const unsigned mask = selmask[(size_t)(b * 4 + g) * NL + t];
        bf16_t* orow = O + (size_t)(b * NL + t) * ND + hd * 64;
        for (int branch = 0; branch < 2; ++branch) {
            const int kcol = (branch == 0 ? 1536 : 2048) + g * 64, vcol = kcol + 256;
            const int j0 = (branch == 0) ? 0 : (tile >= 8 ? tile - 8 : 0);
            float m = -1e30f, l = 0.f;
#pragma unroll
            for (int d = 0; d < 64; ++d) acc[d] = 0.f;
            for (int j = j0; j <= tile; ++j) {
                __syncthreads();
                for (int i = 0; i < 16; ++i) {
                    const int idx = tid + 256 * i, key = idx >> 6, d = idx & 63;
                    k_s[key][d] = bf2f(pb[(size_t)(64 * j + key) * ODD_PAD + kcol + d]);
                    v_s[key][d] = bf2f(pb[(size_t)(64 * j + key) * ODD_PAD + vcol + d]);
                }
                __syncthreads();
                const bool take = (branch == 0) ? ((mask >> j) & 1u) : true;
                if (take) {
                    for (int s = 0; s < 64; ++s) {
                        const int dist = t - (64 * j + s);
                        const bool valid = (branch == 0) ? (dist >= 0) : (dist >= 0 && dist < 512);
                        float sc = 0.f;
#pragma unroll
                        for (int d = 0; d < 64; ++d) sc += q[d] * k_s[s][d];
                        sc = sc * 0.125f - slope * (float)dist;
                        const float mn = valid ? fmaxf(m, sc) : m;
                        const float scale = expf(m - mn);
                        const float p = valid ? expf(sc - mn) : 0.f;
                        l = l * scale + p;
#pragma unroll
                        for (int d = 0; d < 64; ++d) acc[d] = acc[d] * scale + p * v_s[s][d];
                        m = mn;
                    }
                }
            }
            const float gt = sigmoidf_(bf2f(prow[2560 + (branch + 1) * 16 + hd]));
            const float f = gt / fmaxf(l, 1e-30f);
#pragma unroll
            for (int d = 0; d < 64; d += 8) {
                float o[8];
                ld8(orow + d, o);
#pragma unroll
                for (int j = 0; j < 8; ++j) o[j] += f * acc[d + j];
                st8(orow + d, o);
            }
        }
    }
    __syncthreads();
}


typedef float f32x16 __attribute__((ext_vector_type(16)));
#define MFMA32(a, b, c) __builtin_amdgcn_mfma_f32_32x32x16_bf16((a), (b), (c), 0, 0, 0)
__device__ __forceinline__ unsigned cvtpk(float lo, float hi) { const f32x2_t f = {lo, hi}; return __builtin_bit_cast(unsigned, __builtin_convertvector(f, bf16x2_t)); }
__device__ __forceinline__ int crow32(int reg, int h) { return (reg & 3) + 8 * (reg >> 2) + 4 * h; }
constexpr float LOG2E = 1.4426950408889634f;
__device__ __forceinline__ void nsa_attn_phase(const bf16_t* __restrict__ proj, const bf16_t* __restrict__ vt, const unsigned* __restrict__ selmask, bf16_t* O, unsigned char* lds) {
    const int tid = tidx(), wave = __builtin_amdgcn_readfirstlane(tid >> 6), lane = tid & 63, l31 = lane & 31, h = lane >> 5;
    const int r = wave & 3, thalf = wave >> 2;
    const int skey = tid >> 3, spart = tid & 7;
    for (int it = blockIdx.x; it < 32 * 64; it += gridDim.x) {
        const int tile = 31 - (it >> 6), bg = it & 63, g = bg & 3, b = bg >> 2;
        const int hd = g * 4 + r, tokoff = thalf * 32 + l31, tok = tile * 64 + tokoff;
        const size_t trow = (size_t)(b * NL + tok);
        const float slope = exp2f(-0.5f * (float)(hd + 1));
        bf16x8_t Qf[4];
#pragma unroll
        for (int ds = 0; ds < 4; ++ds) {
            float q[8];
            ld8(proj + trow * ODD_PAD + hd * 64 + 16 * ds + 8 * h, q);
            u32x4 w; w.x = cvtpk(q[0] * 0.125f, q[1] * 0.125f); w.y = cvtpk(q[2] * 0.125f, q[3] * 0.125f); w.z = cvtpk(q[4] * 0.125f, q[5] * 0.125f); w.w = cvtpk(q[6] * 0.125f, q[7] * 0.125f);
            Qf[ds] = __builtin_bit_cast(bf16x8_t, w);
        }
        float sc[16];
#pragma unroll
        for (int reg = 0; reg < 16; ++reg) sc[reg] = slope * (float)crow32(reg, h);
        const unsigned mymask = selmask[(size_t)(b * 4 + g) * NL + tok];
        __syncthreads();
        if (wave == 0) {
            unsigned m = selmask[(size_t)(b * 4 + g) * NL + tile * 64 + lane];
            for (int o = 32; o; o >>= 1) m |= __shfl_xor(m, o);
            if (lane == 0) *(unsigned*)(lds + 35840) = m;
        }
        __syncthreads();
        const unsigned causal = (tile == 31) ? 0xffffffffu : ((2u << tile) - 1u);
        const unsigned U = *(const unsigned*)(lds + 35840) & causal;
        float outv[32];
#pragma unroll
        for (int i = 0; i < 32; ++i) outv[i] = 0.f;
#pragma unroll 1
        for (int branch = 0; branch < 2; ++branch) {
            unsigned todo = (branch == 0) ? U : (causal & ~((1u << (tile >= 8 ? tile - 8 : 0)) - 1u));
            const bf16_t* kbase = proj + (size_t)b * NL * ODD_PAD + (branch == 0 ? 1536 : 1792) + g * 64 + (size_t)skey * ODD_PAD + 8 * spart;
            const bf16_t* vbase = vt + (size_t)(branch * 256 + g * 64 + skey) * NT + (size_t)b * NL + 8 * spart;
            float m_run = -1e30f, l_run = 0.f;
            f32x16 Oa[2];
#pragma unroll
            for (int i = 0; i < 16; ++i) { Oa[0][i] = 0.f; Oa[1][i] = 0.f; }
            int jcur = __ffs(todo) - 1; todo &= todo - 1;
            uint4 kreg = *(const uint4*)(kbase + (size_t)(64 * jcur) * ODD_PAD);
            uint4 vreg = *(const uint4*)(vbase + 64 * jcur);
            int buf = 0;
            __syncthreads();
            *(uint4*)(lds + skey * 144 + spart * 16) = kreg;
            *(uint2*)(lds + 18432 + skey * 136 + spart * 16) = make_uint2(vreg.x, vreg.y);
            *(uint2*)(lds + 18432 + skey * 136 + spart * 16 + 8) = make_uint2(vreg.z, vreg.w);
            __syncthreads();
            for (;;) {
                const int jnext = todo ? (__ffs(todo) - 1) : -1;
                todo &= todo - 1;
                if (jnext >= 0) { kreg = *(const uint4*)(kbase + (size_t)(64 * jnext) * ODD_PAD); vreg = *(const uint4*)(vbase + 64 * jnext); }
                const unsigned char* Ks = lds + buf * 9216;
                const unsigned char* Vs = lds + 18432 + buf * 8704;
                const bool mysel = (branch == 1) || ((mymask >> jcur) & 1u);
                if (__any(mysel)) {
                    const bool diag = (jcur == tile), wedge = (branch == 1) && (jcur == tile - 8);
                    const float init = mysel ? slope * (float)(64 * (jcur - tile)) : -1e30f;
                    float sv[32];
#pragma unroll
                    for (int kt = 0; kt < 2; ++kt) {
                        f32x16 acc;
                        const float i0 = init + slope * (float)(32 * kt);
#pragma unroll
                        for (int i = 0; i < 16; ++i) acc[i] = i0;
#pragma unroll
                        for (int ds = 0; ds < 4; ++ds) {
                            const bf16x8_t a = *(const bf16x8_t*)(Ks + (32 * kt + l31) * 144 + (16 * ds + 8 * h) * 2);
                            acc = MFMA32(a, Qf[ds], acc);
                        }
#pragma unroll
                        for (int reg = 0; reg < 16; ++reg) {
                            float sval = acc[reg] + sc[reg];
                            const int keyoff = 32 * kt + crow32(reg, h);
                            if (diag) sval = (keyoff <= tokoff) ? sval : -1e30f;
                            if (wedge) sval = (keyoff > tokoff) ? sval : -1e30f;
                            sv[kt * 16 + reg] = sval;
                        }
                    }
                    float mx = sv[0];
#pragma unroll
                    for (int i = 1; i < 32; ++i) mx = fmaxf(mx, sv[i]);
                    mx = fmaxf(mx, __shfl_xor(mx, 32));
                    const float m_new = fmaxf(m_run, mx), m_use = fmaxf(m_new, -1e29f);
                    const float alpha = __builtin_amdgcn_exp2f((m_run - m_use) * LOG2E);
                    const float moff = -m_use * LOG2E;
                    float psum = 0.f;
#pragma unroll
                    for (int i = 0; i < 32; ++i) { sv[i] = __builtin_amdgcn_exp2f(fmaf(sv[i], LOG2E, moff)); psum += sv[i]; }
                    l_run = l_run * alpha + psum; m_run = m_new;
#pragma unroll
                    for (int i = 0; i < 16; ++i) { Oa[0][i] *= alpha; Oa[1][i] *= alpha; }
                    bf16x8_t Pf[4];
#pragma unroll
                    for (int ks = 0; ks < 4; ++ks) {
                        u32x4 w; w.x = cvtpk(sv[ks * 8 + 0], sv[ks * 8 + 1]); w.y = cvtpk(sv[ks * 8 + 2], sv[ks * 8 + 3]); w.z = cvtpk(sv[ks * 8 + 4], sv[ks * 8 + 5]); w.w = cvtpk(sv[ks * 8 + 6], sv[ks * 8 + 7]);
                        Pf[ks] = __builtin_bit_cast(bf16x8_t, w);
                    }
#pragma unroll
                    for (int mt = 0; mt < 2; ++mt)
#pragma unroll
                        for (int ks = 0; ks < 4; ++ks) {
                            const unsigned char* vp = Vs + (32 * mt + l31) * 136 + (16 * ks + 4 * h) * 2;
                            const uint2 lo = *(const uint2*)vp, hi = *(const uint2*)(vp + 16);
                            u32x4 w; w.x = lo.x; w.y = lo.y; w.z = hi.x; w.w = hi.y;
                            Oa[mt] = MFMA32(__builtin_bit_cast(bf16x8_t, w), Pf[ks], Oa[mt]);
                        }
                }
                if (jnext < 0) break;
                *(uint4*)(lds + (buf ^ 1) * 9216 + skey * 144 + spart * 16) = kreg;
                *(uint2*)(lds + 18432 + (buf ^ 1) * 8704 + skey * 136 + spart * 16) = make_uint2(vreg.x, vreg.y);
                *(uint2*)(lds + 18432 + (buf ^ 1) * 8704 + skey * 136 + spart * 16 + 8) = make_uint2(vreg.z, vreg.w);
                __syncthreads();
                buf ^= 1; jcur = jnext;
            }
            const float l_tot = l_run + __shfl_xor(l_run, 32);
            const float gt = sigmoidf_(bf2f(proj[trow * ODD_PAD + 2048 + (branch + 1) * 16 + hd]));
            const float f = gt / fmaxf(l_tot, 1e-30f);
#pragma unroll
            for (int i = 0; i < 16; ++i) { outv[i] += f * Oa[0][i]; outv[16 + i] += f * Oa[1][i]; }
        }
        bf16_t* orow = O + trow * ND + hd * 64;
#pragma unroll
        for (int mt = 0; mt < 2; ++mt)
#pragma unroll
            for (int q4 = 0; q4 < 4; ++q4) {
                bf16_t* op = orow + 32 * mt + 8 * q4 + 4 * h;
                const uint2 old = *(const uint2*)op;
                const float o0 = __uint_as_float(old.x << 16) + outv[mt * 16 + q4 * 4 + 0], o1 = __uint_as_float(old.x & 0xffff0000u) + outv[mt * 16 + q4 * 4 + 1];
                const float o2 = __uint_as_float(old.y << 16) + outv[mt * 16 + q4 * 4 + 2], o3 = __uint_as_float(old.y & 0xffff0000u) + outv[mt * 16 + q4 * 4 + 3];
                *(uint2*)op = make_uint2(cvtpk(o0, o1), cvtpk(o2, o3));
            }
    }
    __syncthreads();
}


__device__ __forceinline__ void nsa_compress2_phase(const bf16_t* __restrict__ proj, const bf16_t* __restrict__ w1t  , const bf16_t* __restrict__ w2t  ,
                                                    const float* __restrict__ bias1  , bf16_t* __restrict__ kcmp  , bf16_t* __restrict__ vcmpT  ,
                                                    unsigned char* lds) {
    const int tid = tidx(), wave = __builtin_amdgcn_readfirstlane(tid >> 6), lane = tid & 63, fr = lane & 15, fq = lane >> 4;
    unsigned char* xs = lds;
    unsigned char* hs = lds + 34816;
    for (int it = blockIdx.x; it < 1024; it += gridDim.x) {
        const int which = it >> 9, ntile = it & 7, g = (it >> 3) & 3, b = (it >> 5) & 15;
        const int t0 = 256 * ntile, coloff = (which ? 1280 : 1024) + g * 64;
        __syncthreads();
        for (int pc = tid; pc < 272 * 8; pc += NTHR) {
            const int tk = pc >> 3, c = pc & 7;
            int tsrc = t0 + tk; tsrc = tsrc > NL - 1 ? NL - 1 : tsrc;
            *(uint4*)(xs + tk * 128 + ((c ^ ((tk >> 4) & 7)) << 4)) = *(const uint4*)(proj + (size_t)(b * NL + tsrc) * ODD_PAD + coloff + 8 * c);
        }
        __syncthreads();
        f32x4 acc = {0.f, 0.f, 0.f, 0.f};
        const bf16_t* wrow = w1t + ((size_t)which * 128 + 16 * wave + fr) * 2048 + 8 * fq;
#pragma unroll 8
        for (int ks = 0; ks < 64; ++ks) {
            const int l = ks >> 1, tk = 16 * fr + l, c = 4 * (ks & 1) + fq;
            const bf16x8_t a = *(const bf16x8_t*)(xs + tk * 128 + ((c ^ ((tk >> 4) & 7)) << 4));
            const bf16x8_t bfrag = *(const bf16x8_t*)(wrow + 32 * ks);
            acc = __builtin_amdgcn_mfma_f32_16x16x32_bf16(a, bfrag, acc, 0, 0, 0);
        }
        {
            const float bj = bias1[which * 128 + 16 * wave + fr];
#pragma unroll
            for (int reg = 0; reg < 4; ++reg) *(bf16_t*)(hs + (4 * fq + reg) * 272 + (16 * wave + fr) * 2) = f2bf(gelu_fast(acc[reg] + bj));
        }
        __syncthreads();
        if (wave < 4) {
            f32x4 o = {0.f, 0.f, 0.f, 0.f};
#pragma unroll
            for (int ks = 0; ks < 4; ++ks) {
                const bf16x8_t a = *(const bf16x8_t*)(hs + fr * 272 + (32 * ks + 8 * fq) * 2);
                const bf16x8_t bfrag = *(const bf16x8_t*)(w2t + ((size_t)which * 64 + 16 * wave + fr) * 128 + 32 * ks + 8 * fq);
                o = __builtin_amdgcn_mfma_f32_16x16x32_bf16(a, bfrag, o, 0, 0, 0);
            }
            const int c = 16 * wave + fr;
#pragma unroll
            for (int reg = 0; reg < 4; ++reg) {
                const int n = 16 * ntile + 4 * fq + reg;
                const bf16_t val = (n < 127) ? f2bf(o[reg]) : (bf16_t)0;
                if (which == 0) kcmp[((size_t)(b * 4 + g) * 128 + n) * 64 + c] = val;
                else vcmpT[((size_t)(b * 4 + g) * 64 + c) * 128 + n] = val;
            }
        }
    }
    __syncthreads();
}

__device__ __forceinline__ void nsa_cmp2_phase(const bf16_t* __restrict__ proj, const bf16_t* __restrict__ kcmp, const bf16_t* __restrict__ vcmpT,
                                               bf16_t* __restrict__ O, unsigned* __restrict__ selmask, unsigned char* lds) {
    const int tid = tidx(), wave = __builtin_amdgcn_readfirstlane(tid >> 6), lane = tid & 63, l31 = lane & 31, h = lane >> 5;
    const int r = wave & 3, thalf = wave >> 2;
    unsigned char* Kc = lds;
    unsigned char* Vc = lds + 18432;
    float* impS = (float*)(lds + 35328);
    float* invS = (float*)(lds + 35328 + 32768);
    for (int it = blockIdx.x; it < 32 * 64; it += gridDim.x) {
        const int tile = 31 - (it >> 6), bg = it & 63, g = bg & 3, b = bg >> 2;
        const int hd = g * 4 + r, tokoff = thalf * 32 + l31, tok = tile * 64 + tokoff;
        const size_t trow = (size_t)(b * NL + tok);
        const float slope = exp2f(-0.5f * (float)(hd + 1));
        __syncthreads();
#pragma unroll
        for (int i = 0; i < 2; ++i) {
            const int pc = tid + 512 * i;
            { const int row = pc >> 3, c = pc & 7; *(uint4*)(Kc + row * 144 + c * 16) = *(const uint4*)(kcmp + ((size_t)(b * 4 + g) * 128 + row) * 64 + 8 * c); }
            { const int row = pc >> 4, c = pc & 15; const uint4 v = *(const uint4*)(vcmpT + ((size_t)(b * 4 + g) * 64 + row) * 128 + 8 * c);
              *(uint2*)(Vc + row * 264 + c * 16) = make_uint2(v.x, v.y); *(uint2*)(Vc + row * 264 + c * 16 + 8) = make_uint2(v.z, v.w); }
        }
        bf16x8_t Qf[4];
#pragma unroll
        for (int ds = 0; ds < 4; ++ds) {
            float q[8];
            ld8(proj + trow * ODD_PAD + hd * 64 + 16 * ds + 8 * h, q);
            u32x4 w; w.x = cvtpk(q[0] * 0.125f, q[1] * 0.125f); w.y = cvtpk(q[2] * 0.125f, q[3] * 0.125f); w.z = cvtpk(q[4] * 0.125f, q[5] * 0.125f); w.w = cvtpk(q[6] * 0.125f, q[7] * 0.125f);
            Qf[ds] = __builtin_bit_cast(bf16x8_t, w);
        }
        int nvalid = (tok >= 31) ? ((tok - 31) / 16 + 1) : 0;
        nvalid = nvalid > 127 ? 127 : nvalid;
        __syncthreads();
        float mx = -1e30f;
#pragma unroll 1
        for (int kt = 0; kt < 4; ++kt) {
            f32x16 acc;
            const float i0 = slope * (float)(512 * kt);
#pragma unroll
            for (int i = 0; i < 16; ++i) acc[i] = i0;
#pragma unroll
            for (int ds = 0; ds < 4; ++ds) {
                const bf16x8_t a = *(const bf16x8_t*)(Kc + (32 * kt + l31) * 144 + (16 * ds + 8 * h) * 2);
                acc = MFMA32(a, Qf[ds], acc);
            }
#pragma unroll
            for (int reg = 0; reg < 16; ++reg) {
                const int n = 32 * kt + crow32(reg, h);
                const float sval = acc[reg] + slope * (float)(16 * crow32(reg, h));
                mx = fmaxf(mx, (n < nvalid) ? sval : -1e30f);
            }
        }
        mx = fmaxf(mx, __shfl_xor(mx, 32));
        const float moff = -fmaxf(mx, -1e29f) * LOG2E;
        float psum = 0.f, prev_pe = 0.f;
        f32x16 Oa[2];
#pragma unroll
        for (int i = 0; i < 16; ++i) { Oa[0][i] = 0.f; Oa[1][i] = 0.f; }
#pragma unroll 1
        for (int kt = 0; kt < 4; ++kt) {
            f32x16 acc;
            const float i0 = slope * (float)(512 * kt);
#pragma unroll
            for (int i = 0; i < 16; ++i) acc[i] = i0;
#pragma unroll
            for (int ds = 0; ds < 4; ++ds) {
                const bf16x8_t a = *(const bf16x8_t*)(Kc + (32 * kt + l31) * 144 + (16 * ds + 8 * h) * 2);
                acc = MFMA32(a, Qf[ds], acc);
            }
            float sv[16];
#pragma unroll
            for (int reg = 0; reg < 16; ++reg) {
                const int n = 32 * kt + crow32(reg, h);
                const float sval = acc[reg] + slope * (float)(16 * crow32(reg, h));
                sv[reg] = __builtin_amdgcn_exp2f(fmaf((n < nvalid) ? sval : -1e30f, LOG2E, moff));
                psum += sv[reg];
            }
#pragma unroll
            for (int q = 0; q < 4; ++q) {
                const float e = 0.5f * sv[q * 4 + 3];
                const float own = sv[q * 4] + sv[q * 4 + 1] + sv[q * 4 + 2] + e;
                const float pe = __shfl_xor(e, 32);
                impS[(r * 64 + tokoff) * 32 + 8 * kt + 2 * q + h] = own + (h ? pe : prev_pe);
                prev_pe = pe;
            }
#pragma unroll
            for (int s2 = 0; s2 < 2; ++s2) {
                u32x4 w; w.x = cvtpk(sv[s2 * 8 + 0], sv[s2 * 8 + 1]); w.y = cvtpk(sv[s2 * 8 + 2], sv[s2 * 8 + 3]); w.z = cvtpk(sv[s2 * 8 + 4], sv[s2 * 8 + 5]); w.w = cvtpk(sv[s2 * 8 + 6], sv[s2 * 8 + 7]);
                const bf16x8_t pf = __builtin_bit_cast(bf16x8_t, w);
#pragma unroll
                for (int mt = 0; mt < 2; ++mt) {
                    const unsigned char* vp = Vc + (32 * mt + l31) * 264 + (32 * kt + 16 * s2 + 4 * h) * 2;
                    const uint2 lo = *(const uint2*)vp, hi = *(const uint2*)(vp + 16);
                    u32x4 a; a.x = lo.x; a.y = lo.y; a.z = hi.x; a.w = hi.y;
                    Oa[mt] = MFMA32(__builtin_bit_cast(bf16x8_t, a), pf, Oa[mt]);
                }
            }
        }
        psum += __shfl_xor(psum, 32);
        const float inv = (nvalid > 0) ? 1.f / fmaxf(psum, 1e-30f) : 0.f;
        if (h == 0) invS[r * 64 + tokoff] = inv;
        const float g0 = sigmoidf_(bf2f(proj[trow * ODD_PAD + 2048 + hd])) * inv;
        bf16_t* orow = O + trow * ND + hd * 64;
#pragma unroll
        for (int mt = 0; mt < 2; ++mt)
#pragma unroll
            for (int q4 = 0; q4 < 4; ++q4)
                *(uint2*)(orow + 32 * mt + 8 * q4 + 4 * h) = make_uint2(cvtpk(g0 * Oa[mt][q4 * 4], g0 * Oa[mt][q4 * 4 + 1]), cvtpk(g0 * Oa[mt][q4 * 4 + 2], g0 * Oa[mt][q4 * 4 + 3]));
        __syncthreads();
        float* impT = (float*)Kc;
#pragma unroll
        for (int i = 0; i < 4; ++i) {
            const int pc = tid + 512 * i, tk = pc >> 5, j = pc & 31, cur = tile;
            const float ij = impS[(0 * 64 + tk) * 32 + j] * invS[tk] + impS[(1 * 64 + tk) * 32 + j] * invS[64 + tk] + impS[(2 * 64 + tk) * 32 + j] * invS[128 + tk] + impS[(3 * 64 + tk) * 32 + j] * invS[192 + tk];
            const bool fj = (j == 0) || (j == cur) || (j == cur - 1);
            impT[tk * 33 + j] = (j <= cur) ? ij + (fj ? 1000.f : 0.f) : -INFINITY;
        }
        __syncthreads();
        if (tid < 256) {
            const int tk = tid >> 2, rr = tid & 3;
            unsigned bits = 0;
#pragma unroll 1
            for (int jj = 0; jj < 8; ++jj) {
                const int j = rr * 8 + jj;
                const float vj = impT[tk * 33 + j];
                int rank = 0;
#pragma unroll 8
                for (int k = 0; k < 32; ++k) {
                    const float vk = impT[tk * 33 + k];
                    rank += (vk > vj || (vk == vj && k < j)) ? 1 : 0;
                }
                if (rank < 16) bits |= 1u << j;
            }
            bits |= __shfl_xor(bits, 1);
            bits |= __shfl_xor(bits, 2);
            if (rr == 0) selmask[(size_t)(b * 4 + g) * NL + tile * 64 + tk] = bits;
        }
    }
    __syncthreads();
}


constexpr int P0W = 1792;
constexpr float LN2F = 0.6931471805599453f;
__device__ __forceinline__ void sb_attn2_phase(const bf16_t* __restrict__ proj, const bf16_t* __restrict__ vt, bf16_t* __restrict__ Y, unsigned char* lds) {
    const int tid = tidx(), wave = __builtin_amdgcn_readfirstlane(tid >> 6), lane = tid & 63, l31 = lane & 31, h = lane >> 5;
    const int skey = tid >> 3, spart = tid & 7;
    for (int it = blockIdx.x; it < NB * 12 * 8; it += gridDim.x) {
        const int tile = 7 - (it / 192), bh = it % 192, hh = bh % 12, b = bh / 12;
        const int qlo = tile * 256 + 32 * wave, tq = qlo + l31;
        const size_t trow = (size_t)(b * NL + tq);
        bf16x8_t Qf[4];
#pragma unroll
        for (int ds = 0; ds < 4; ++ds) {
            float q[8];
            ld8(proj + trow * P0W + 256 + hh * 64 + 16 * ds + 8 * h, q);
            u32x4 w; w.x = cvtpk(q[0] * 0.125f, q[1] * 0.125f); w.y = cvtpk(q[2] * 0.125f, q[3] * 0.125f); w.z = cvtpk(q[4] * 0.125f, q[5] * 0.125f); w.w = cvtpk(q[6] * 0.125f, q[7] * 0.125f);
            Qf[ds] = __builtin_bit_cast(bf16x8_t, w);
        }
        const bf16_t* kbase = proj + (size_t)b * NL * P0W + 1024 + hh * 64 + (size_t)skey * P0W + 8 * spart;
        const bf16_t* vbase = vt + (size_t)(hh * 64 + skey) * NT + (size_t)b * NL + 8 * spart;
        f32x16 Oa[2];
#pragma unroll
        for (int i = 0; i < 16; ++i) { Oa[0][i] = 0.f; Oa[1][i] = 0.f; }
        float carry = 0.f;
        int j = tile * 4 + 3, buf = 0;
        uint4 kreg = *(const uint4*)(kbase + (size_t)(64 * j) * P0W);
        uint4 vreg = *(const uint4*)(vbase + 64 * j);
        __syncthreads();
        *(uint4*)(lds + skey * 144 + spart * 16) = kreg;
        *(uint2*)(lds + 18432 + skey * 136 + spart * 16) = make_uint2(vreg.x, vreg.y);
        *(uint2*)(lds + 18432 + skey * 136 + spart * 16 + 8) = make_uint2(vreg.z, vreg.w);
        __syncthreads();
        for (;;) {
            const int jn = j - 1;
            if (jn >= 0) { kreg = *(const uint4*)(kbase + (size_t)(64 * jn) * P0W); vreg = *(const uint4*)(vbase + 64 * jn); }
            const unsigned char* Ks = lds + buf * 9216;
            const unsigned char* Vs = lds + 18432 + buf * 8704;
            const bool live = (64 * j <= qlo + 30) && !__all(carry < -110.f);
            if (live) {
#pragma unroll
                for (int kti = 0; kti < 2; ++kti) {
                    const int kt = 1 - kti;
                    f32x16 acc;
#pragma unroll
                    for (int i = 0; i < 16; ++i) acc[i] = 0.f;
#pragma unroll
                    for (int ds = 0; ds < 4; ++ds) {
                        const bf16x8_t a = *(const bf16x8_t*)(Ks + (32 * kt + l31) * 144 + (16 * ds + 8 * h) * 2);
                        acc = MFMA32(a, Qf[ds], acc);
                    }
                    float m1[16], lz[16];
#pragma unroll
                    for (int reg = 0; reg < 16; ++reg) {
                        const float z = acc[reg];
                        const bool valid = (64 * j + 32 * kt + crow32(reg, h)) < tq;
                        const float e = __builtin_amdgcn_exp2f(-fabsf(z) * LOG2E);
                        const float sp = fmaxf(z, 0.f) + __builtin_amdgcn_logf(1.f + e) * LN2F;
                        m1[reg] = valid ? -sp : 0.f;
                        lz[reg] = valid ? z - sp : -1e30f;
                    }
                    float G[4], T[4];
#pragma unroll
                    for (int q = 0; q < 4; ++q) G[q] = (m1[4 * q] + m1[4 * q + 1]) + (m1[4 * q + 2] + m1[4 * q + 3]);
                    float Gp[4];
#pragma unroll
                    for (int q = 0; q < 4; ++q) { Gp[q] = __shfl_xor(G[q], 32); T[q] = G[q] + Gp[q]; }
                    float base[4];
                    base[3] = carry; base[2] = base[3] + T[3]; base[1] = base[2] + T[2]; base[0] = base[1] + T[1];
                    const float tot = base[0] + T[0];
#pragma unroll
                    for (int q = 0; q < 4; ++q) {
                        const float bq = base[q] + (h ? 0.f : Gp[q]);
                        const float t3 = bq, t2 = t3 + m1[4 * q + 3], t1 = t2 + m1[4 * q + 2], t0 = t1 + m1[4 * q + 1];
                        lz[4 * q + 3] = __builtin_amdgcn_exp2f((lz[4 * q + 3] + t3) * LOG2E);
                        lz[4 * q + 2] = __builtin_amdgcn_exp2f((lz[4 * q + 2] + t2) * LOG2E);
                        lz[4 * q + 1] = __builtin_amdgcn_exp2f((lz[4 * q + 1] + t1) * LOG2E);
                        lz[4 * q + 0] = __builtin_amdgcn_exp2f((lz[4 * q + 0] + t0) * LOG2E);
                    }
                    carry = tot;
#pragma unroll
                    for (int s2 = 0; s2 < 2; ++s2) {
                        u32x4 w; w.x = cvtpk(lz[s2 * 8 + 0], lz[s2 * 8 + 1]); w.y = cvtpk(lz[s2 * 8 + 2], lz[s2 * 8 + 3]); w.z = cvtpk(lz[s2 * 8 + 4], lz[s2 * 8 + 5]); w.w = cvtpk(lz[s2 * 8 + 6], lz[s2 * 8 + 7]);
                        const bf16x8_t pf = __builtin_bit_cast(bf16x8_t, w);
#pragma unroll
                        for (int mt = 0; mt < 2; ++mt) {
                            const unsigned char* vp = Vs + (32 * mt + l31) * 136 + (32 * kt + 16 * s2 + 4 * h) * 2;
                            const uint2 lo = *(const uint2*)vp, hi = *(const uint2*)(vp + 16);
                            u32x4 a; a.x = lo.x; a.y = lo.y; a.z = hi.x; a.w = hi.y;
                            Oa[mt] = MFMA32(__builtin_bit_cast(bf16x8_t, a), pf, Oa[mt]);
                        }
                    }
                }
            }
            if (jn >= 0) {
                *(uint4*)(lds + (buf ^ 1) * 9216 + skey * 144 + spart * 16) = kreg;
                *(uint2*)(lds + 18432 + (buf ^ 1) * 8704 + skey * 136 + spart * 16) = make_uint2(vreg.x, vreg.y);
                *(uint2*)(lds + 18432 + (buf ^ 1) * 8704 + skey * 136 + spart * 16 + 8) = make_uint2(vreg.z, vreg.w);
            }
            volatile int* flg = (volatile int*)(lds + 35840) + (j & 1) * 8;
            const int wdone = __all(carry < -110.f);
            if (lane == 0) flg[wave] = wdone;
            __syncthreads();
            const int alldone = flg[0] & flg[1] & flg[2] & flg[3] & flg[4] & flg[5] & flg[6] & flg[7];
            if (alldone || jn < 0) break;
            buf ^= 1; j = jn;
        }
        bf16_t* orow = Y + trow * ND + 256 + hh * 64;
#pragma unroll
        for (int mt = 0; mt < 2; ++mt)
#pragma unroll
            for (int q4 = 0; q4 < 4; ++q4)
                *(uint2*)(orow + 32 * mt + 8 * q4 + 4 * h) = make_uint2(cvtpk(Oa[mt][q4 * 4], Oa[mt][q4 * 4 + 1]), cvtpk(Oa[mt][q4 * 4 + 2], Oa[mt][q4 * 4 + 3]));
    }
    __syncthreads();
}

__device__ __forceinline__ void s5_scan2_phase(const bf16_t* __restrict__ proj, const float* __restrict__ lam_re, const float* __restrict__ lam_im, const float* __restrict__ log_dt,
                                               const float* __restrict__ b_re, const float* __restrict__ b_im, const float* __restrict__ c_re, const float* __restrict__ c_im,
                                               const float* __restrict__ dskip, float* __restrict__ ya, float* lds) {
    const int tid = tidx(), wave = __builtin_amdgcn_readfirstlane(tid >> 6), lane = tid & 63;
    float* cr = lds;
    float* ci = lds + 1024;
    float* Es = lds + 2048;
    float* us = lds + 3072 + wave * 512;
    float* xr = lds + 7168 + wave * 4160;
    float* xi = xr + 2080;
    for (int bg = blockIdx.x; bg < NB * 16; bg += gridDim.x) {
        const int b = bg >> 4, g = bg & 15;
        const float lr = lam_re[g * 64 + lane], li = lam_im[g * 64 + lane];
        const float dt = expf(log_dt[g]);
        const float mag = expf(lr * dt);
        const float are = mag * cosf(li * dt), aim = mag * sinf(li * dt);
        const float nr = are - 1.f, den = lr * lr + li * li;
        const float fre = (nr * lr + aim * li) / den, fim = (aim * lr - nr * li) / den;
        float bbr[16], bbi[16];
#pragma unroll
        for (int i = 0; i < 16; ++i) {
            const float br = b_re[(g * 64 + lane) * 16 + i], bi = b_im[(g * 64 + lane) * 16 + i];
            bbr[i] = fre * br - fim * bi; bbi[i] = fre * bi + fim * br;
        }
        __syncthreads();
        for (int idx = tid; idx < 1024; idx += NTHR) { cr[idx] = c_re[g * 1024 + idx]; ci[idx] = c_im[g * 1024 + idx]; }
        const bf16_t* ub = proj + (size_t)(b * NL + 256 * wave) * P0W + g * 16;
        float xre = 0.f, xim = 0.f;
        for (int c0 = 0; c0 < 256; c0 += 32) {
            wave_lds_fence();
            { float u8[8]; const int t = lane >> 1, hf = lane & 1; ld8(ub + (size_t)(c0 + t) * P0W + 8 * hf, u8);
#pragma unroll
              for (int i = 0; i < 8; ++i) us[t * 16 + 8 * hf + i] = u8[i]; }
            wave_lds_fence();
            for (int t = 0; t < 32; ++t) {
                float bur = 0.f, bui = 0.f;
#pragma unroll
                for (int i = 0; i < 16; ++i) { const float u = us[t * 16 + i]; bur += bbr[i] * u; bui += bbi[i] * u; }
                const float nre = are * xre - aim * xim + bur, nim = are * xim + aim * xre + bui;
                xre = nre; xim = nim;
            }
        }
        Es[(wave * 64 + lane) * 2] = xre; Es[(wave * 64 + lane) * 2 + 1] = xim;
        float pr = are, pi = aim;
#pragma unroll
        for (int i = 0; i < 8; ++i) { const float nr2 = pr * pr - pi * pi, ni2 = 2.f * pr * pi; pr = nr2; pi = ni2; }
        __syncthreads();
        xre = 0.f; xim = 0.f;
        for (int w2 = 0; w2 < wave; ++w2) {
            const float er = Es[(w2 * 64 + lane) * 2], ei = Es[(w2 * 64 + lane) * 2 + 1];
            const float nre = pr * xre - pi * xim + er, nim = pr * xim + pi * xre + ei;
            xre = nre; xim = nim;
        }
        const int tt = lane & 31, ih = lane >> 5;
        float dsk[8];
#pragma unroll
        for (int i = 0; i < 8; ++i) dsk[i] = dskip[g * 16 + 8 * ih + i];
        for (int c0 = 0; c0 < 256; c0 += 32) {
            wave_lds_fence();
            { float u8[8]; const int t = lane >> 1, hf = lane & 1; ld8(ub + (size_t)(c0 + t) * P0W + 8 * hf, u8);
#pragma unroll
              for (int i = 0; i < 8; ++i) us[t * 16 + 8 * hf + i] = u8[i]; }
            wave_lds_fence();
            for (int t = 0; t < 32; ++t) {
                float bur = 0.f, bui = 0.f;
#pragma unroll
                for (int i = 0; i < 16; ++i) { const float u = us[t * 16 + i]; bur += bbr[i] * u; bui += bbi[i] * u; }
                const float nre = are * xre - aim * xim + bur, nim = are * xim + aim * xre + bui;
                xre = nre; xim = nim;
                xr[t * 65 + lane] = xre; xi[t * 65 + lane] = xim;
            }
            wave_lds_fence();
            float y[8];
#pragma unroll
            for (int i = 0; i < 8; ++i) y[i] = 0.f;
            for (int p = 0; p < 64; ++p) {
                const float a = xr[tt * 65 + p], bq = xi[tt * 65 + p];
#pragma unroll
                for (int i = 0; i < 8; ++i) y[i] += cr[(8 * ih + i) * 64 + p] * a - ci[(8 * ih + i) * 64 + p] * bq;
            }
            float o[8];
#pragma unroll
            for (int i = 0; i < 8; ++i) o[i] = gelu_fast(y[i] + dsk[i] * us[tt * 16 + 8 * ih + i]);
            float* yp = ya + (size_t)(b * NL + 256 * wave + c0 + tt) * 256 + g * 16 + 8 * ih;
            *(float4*)yp = make_float4(o[0], o[1], o[2], o[3]); *(float4*)(yp + 4) = make_float4(o[4], o[5], o[6], o[7]);
        }
    }
    __syncthreads();
}

struct Params {
    const float* in[29];
    float* out;
    char* ws;
    unsigned long long pad;
};

constexpr size_t SZ_PROJ = (size_t)NT * EVEN_IN * 2;
constexpr size_t SZ_VT = (size_t)768 * NT * 2;
constexpr size_t SZ_YB = (size_t)NT * ND * 2;
constexpr size_t SZ_HB = (size_t)NT * ND * 2;
constexpr size_t SZ_YA = (size_t)NT * 256 * 4;
constexpr size_t SZ_CMP = (size_t)NB * 4 * 128 * 64 * 2;
constexpr size_t SZ_SEL = (size_t)NB * 4 * NL * 4;
constexpr size_t SZ_TAB = (size_t)16384 * ND;
constexpr size_t SZ_SKB = (size_t)2 * 8 * 2 * 128 * 128 * 2;
constexpr size_t OFF_VT = SZ_PROJ, OFF_YB = OFF_VT + SZ_VT, OFF_HB = OFF_YB + SZ_YB, OFF_YA = OFF_HB + SZ_HB, OFF_KC = OFF_YA + SZ_YA, OFF_VC = OFF_KC + SZ_CMP,
                 OFF_SEL = OFF_VC + SZ_CMP, OFF_TAB = OFF_SEL + SZ_SEL, OFF_SKB = OFF_TAB + 2 * SZ_TAB, OFF_WT = OFF_SKB + SZ_SKB;
constexpr size_t WT_IN0 = 0, WT_OUT0 = WT_IN0 + (size_t)EVEN_IN * ND * 2, WT_Q0 = WT_OUT0 + (size_t)ND * ND * 2, WT_Q1 = WT_Q0 + (size_t)2048 * ND * 2,
                 WT_IN1 = WT_Q1 + (size_t)2048 * ND * 2, WT_V1 = WT_IN1 + (size_t)ODD_PAD * ND * 2, WT_OUT1 = WT_V1 + (size_t)512 * ND * 2, WT_W1 = WT_OUT1 + (size_t)ND * ND * 2, WT_W2 = WT_W1 + (size_t)2 * 128 * 2048 * 2, WT_B1 = WT_W2 + (size_t)2 * 64 * 128 * 2, WT_V0 = WT_B1 + 2 * 128 * 4, WT_END = WT_V0 + (size_t)768 * ND * 2;
constexpr size_t OFF_BAR = OFF_WT + ((WT_END + 255) & ~(size_t)255);
constexpr size_t WS_NEED = OFF_BAR + XCD_BAR_WORDS * 4;

__device__ __forceinline__ void convert_tables(const float* __restrict__ u, const float* __restrict__ v, unsigned char* __restrict__ TAB) {
    const size_t per = (size_t)16384 * ND / 16;
    for (size_t i = (size_t)blockIdx.x * NTHR + tidx(); i < 2 * per; i += (size_t)gridDim.x * NTHR) {
        const int tb = (int)(i / per); const size_t off = (i % per) * 16;
        const float* src = (tb ? v : u) + off;
        const float sc = tb ? V_SCALE : U_SCALE;
        uint4 w; unsigned* wp = (unsigned*)&w;
#pragma unroll
        for (int q = 0; q < 4; ++q) {
            const float4 a = *(const float4*)(src + 4 * q);
            int pk = __builtin_amdgcn_cvt_pk_fp8_f32(a.x * sc, a.y * sc, 0, false);
            pk = __builtin_amdgcn_cvt_pk_fp8_f32(a.z * sc, a.w * sc, pk, true);
            wp[q] = (unsigned)pk;
        }
        *(uint4*)(TAB + (size_t)tb * 16384 * ND + off) = w;
    }
}

__global__ void __launch_bounds__(NTHR) fwd_megakernel(Params p) {
    extern __shared__ __attribute__((aligned(16))) unsigned char lds_raw[];
    float* lds = (float*)lds_raw;
    cg::grid_group grid = cg::this_grid();
    const float* x = p.in[0];
    float* R = p.out;
    char* ws = p.ws;
    bf16_t* PROJ = (bf16_t*)ws;
    bf16_t* YB = (bf16_t*)(ws + OFF_YB);
    bf16_t* HB = (bf16_t*)(ws + OFF_HB);
    float* YA = (float*)(ws + OFF_YA);
    bf16_t* KCMP = (bf16_t*)(ws + OFF_KC);
    bf16_t* VCMP = (bf16_t*)(ws + OFF_VC);
    bf16_t* W1T = (bf16_t*)(ws + OFF_WT + WT_W1);
    bf16_t* W2T = (bf16_t*)(ws + OFF_WT + WT_W2);
    float* BIAS1 = (float*)(ws + OFF_WT + WT_B1);
    unsigned* SEL = (unsigned*)(ws + OFF_SEL);
    bf16_t* WIN0 = (bf16_t*)(ws + OFF_WT + WT_IN0);
    bf16_t* WOUT0 = (bf16_t*)(ws + OFF_WT + WT_OUT0);
    bf16_t* WQ0 = (bf16_t*)(ws + OFF_WT + WT_Q0);
    bf16_t* WQ1 = (bf16_t*)(ws + OFF_WT + WT_Q1);
    bf16_t* WIN1 = (bf16_t*)(ws + OFF_WT + WT_IN1);
    bf16_t* WOUT1 = (bf16_t*)(ws + OFF_WT + WT_OUT1);
    bf16_t* WV1 = (bf16_t*)(ws + OFF_WT + WT_V1);
    bf16_t* VT = (bf16_t*)(ws + OFF_VT);
    bf16_t* WV0 = (bf16_t*)(ws + OFF_WT + WT_V0);
    int* EIDX = (int*)YB;
    float* EGATE = (float*)((char*)YB + (size_t)NT * 128 * 4);
    unsigned char* TAB = (unsigned char*)(ws + OFF_TAB);
    bf16_t* SKB = (bf16_t*)(ws + OFF_SKB);
    const int wave = tidx() >> 6;
    if (tidx() == 0) *(uint4*)(lds_raw + LDS_BYTES - 16) = make_uint4(0u, 0u, 0u, 0u);
    __syncthreads();
    XcdBarrier xbar = xcd_barrier_post((unsigned*)(ws + OFF_BAR), (volatile LAS unsigned*)(lds_raw + LDS_BYTES - 16));

    for (size_t i = (size_t)blockIdx.x * NTHR + tidx(); i < (size_t)NT * ND / 4; i += (size_t)gridDim.x * NTHR) {
        const float4 v = ((const float4*)x)[i];
        ((float4*)R)[i] = v;
        uint2 w; w.x = pack2(v.x, v.y); w.y = pack2(v.z, v.w);
        ((uint2*)HB)[i] = w;
    }
    convert_tables(p.in[23], p.in[24], TAB);
    for (int i = blockIdx.x * NTHR + tidx(); i < 2 * 8 * 2 * 128 * 128 / 4; i += gridDim.x * NTHR) {
        const float4 a = ((const float4*)p.in[22])[i];
        uint2 w; w.x = pack2(a.x, a.y); w.y = pack2(a.z, a.w);
        ((uint2*)SKB)[i] = w;
    }
    convert_wt_phase(p.in[1], ND, EVEN_IN, P0W, ColMap{{0, 0, 0}, {0, 0, 0}, {P0W, 0, 0}}, WIN0, lds);
    convert_wt_phase(p.in[1], ND, EVEN_IN, 768, ColMap{{0, 0, 0}, {P0W, 0, 0}, {768, 0, 0}}, WV0, lds);
    convert_wt_phase(p.in[12], ND, ND, ND, ColMap{{0, 0, 0}, {0, 0, 0}, {ND, 0, 0}}, WOUT0, lds);
    convert_wt_phase(p.in[21], ND, 2048, 2048, ColMap{{0, 0, 0}, {0, 0, 0}, {2048, 0, 0}}, WQ0, lds);
    convert_wt_phase(p.in[21] + (size_t)ND * 2048, ND, 2048, 2048, ColMap{{0, 0, 0}, {0, 0, 0}, {2048, 0, 0}}, WQ1, lds);
    convert_wt_phase(p.in[13], ND, ODD_IN, ODD_PAD, ColMap{{0, 1792, 2048}, {0, 2048, 2560}, {1792, 256, 48}}, WIN1, lds);
    convert_wt_phase(p.in[13], ND, ODD_IN, 512, ColMap{{0, 256, 0}, {1792, 2304, 0}, {256, 256, 0}}, WV1, lds);
    convert_wt_phase(p.in[20], ND, ND, ND, ColMap{{0, 0, 0}, {0, 0, 0}, {ND, 0, 0}}, WOUT1, lds);
    convert_wt_phase(p.in[15], 2048, 128, 128, ColMap{{0, 0, 0}, {0, 0, 0}, {128, 0, 0}}, W1T, lds);
    convert_wt_phase(p.in[18], 2048, 128, 128, ColMap{{0, 0, 0}, {0, 0, 0}, {128, 0, 0}}, W1T + 128 * 2048, lds);
    convert_wt_phase(p.in[16], 128, 64, 64, ColMap{{0, 0, 0}, {0, 0, 0}, {64, 0, 0}}, W2T, lds);
    convert_wt_phase(p.in[19], 128, 64, 64, ColMap{{0, 0, 0}, {0, 0, 0}, {64, 0, 0}}, W2T + 64 * 128, lds);
    if (blockIdx.x < 2 && tidx() < 128) {
        const float* pe = blockIdx.x ? p.in[17] : p.in[14];
        const float* w1 = blockIdx.x ? p.in[18] : p.in[15];
        float a = 0.f;
        for (int i = 0; i < 2048; ++i) a += pe[i] * w1[(size_t)i * 128 + tidx()];
        BIAS1[blockIdx.x * 128 + tidx()] = a;
    }
    grid.sync();
    PDUP(0) { PH(0) gemm_bf16_phase(lds_raw, HB, WIN0, NT, P0W, ND, EpiBf16s{PROJ, P0W});
    PH(0) gemm_bf16_phase(lds_raw, WV0, HB, 768, NT, ND, EpiBf16s{VT, NT}); }
    xcd_barrier(xbar);
    PDUP(1) { PH(1) s5_scan2_phase(PROJ, p.in[2], p.in[3], p.in[4], p.in[5], p.in[6], p.in[7], p.in[8], p.in[9], YA, lds);
    PH(2) sb_attn2_phase(PROJ, VT, YB, lds_raw);
    if (_rep == 0 && ((PROBE >> 1) & 1)) xcd_barrier(xbar); }
    xcd_barrier(xbar);
    PDUP(2) PH(3) glu_phase(YA, p.in[10], p.in[11], YB, lds);
    xcd_barrier(xbar);
    if ((PROBE >> 3) & 1) { gemm_bf16_phase(lds_raw, YB, WOUT0, NT, ND, ND, EpiRes{R, ND, ALPHA, (float*)PROJ}); xcd_barrier(xbar); }
    PH(4) gemm_bf16_phase(lds_raw, YB, WOUT0, NT, ND, ND, EpiRes{R, ND, ALPHA, R});
    xcd_barrier(xbar);
    PH(5) ln_phase(R, HB, p.in[25], p.in[26]);
    xcd_barrier(xbar);
#define PEER_FFN(layer, WQ, last) \
    PDUP(0) PH(12) gemm_bf16_phase(lds_raw, HB, WQ, NT, 2048, ND, EpiBf16s{PROJ, 2048}); \
    xcd_barrier(xbar); \
    PDUP(4) PH(13) peer_route2_phase(PROJ, SKB + (size_t)(layer) * 8 * 2 * 128 * 128, EIDX, EGATE, lds_raw); \
    xcd_barrier(xbar); \
    if ((PROBE >> 5) & 1) { peer_expert3_phase(R, EIDX, EGATE, TAB, TAB + (size_t)16384 * ND, p.in[27] + (layer) * ND, p.in[28] + (layer) * ND, nullptr, (float*)PROJ); xcd_barrier(xbar); } \
    PH(14) peer_expert3_phase(R, EIDX, EGATE, TAB, TAB + (size_t)16384 * ND, p.in[27] + (layer) * ND, p.in[28] + (layer) * ND, (last) ? nullptr : HB, R); \
    if (!(last)) xcd_barrier(xbar);
    PEER_FFN(0, WQ0, false)
    convert_tables(p.in[23] + (size_t)16384 * ND, p.in[24] + (size_t)16384 * ND, TAB);
    PDUP(0) { PH(6) gemm_bf16_phase(lds_raw, HB, WIN1, NT, ODD_PAD, ND, EpiBf16s{PROJ, ODD_PAD});
    PH(6) gemm_bf16_phase(lds_raw, WV1, HB, 512, NT, ND, EpiBf16s{VT, NT}); }
    xcd_barrier(xbar);
    PDUP(6) PH(7) nsa_compress2_phase(PROJ, W1T, W2T, BIAS1, KCMP, VCMP, lds_raw);
    xcd_barrier(xbar);
    PDUP(7) { PH(8) nsa_cmp2_phase(PROJ, KCMP, VCMP, YB, SEL, lds_raw);
    xcd_barrier(xbar);
    PH(9) nsa_attn_phase(PROJ, VT, SEL, YB, lds_raw);
    if (_rep == 0 && ((PROBE >> 7) & 1)) xcd_barrier(xbar); }
    xcd_barrier(xbar);
    if ((PROBE >> 3) & 1) { gemm_bf16_phase(lds_raw, YB, WOUT1, NT, ND, ND, EpiRes{R, ND, ALPHA, (float*)PROJ}); xcd_barrier(xbar); }
    PH(10) gemm_bf16_phase(lds_raw, YB, WOUT1, NT, ND, ND, EpiRes{R, ND, ALPHA, R});
    xcd_barrier(xbar);
    PH(11) ln_phase(R, HB, p.in[25] + ND, p.in[26] + ND);
    xcd_barrier(xbar);
    PEER_FFN(1, WQ1, true)
}

}

extern "C" void kernel_launch(void* const* d_in, const int* in_sizes, int n_in, void* d_out, int out_size, void* d_ws, size_t ws_size, hipStream_t stream) {
    static int grid_blocks = 0;
    if (grid_blocks == 0) {
        if (n_in != 29 || out_size != NT * ND || ws_size < WS_NEED) { fprintf(stderr, "kernel_launch: unexpected shapes / workspace (%zu < %zu)\n", ws_size, (size_t)WS_NEED); grid_blocks = -1; return; }
        int dev = 0, cus = 0, per_cu = 0;
        hipGetDevice(&dev);
        hipDeviceGetAttribute(&cus, hipDeviceAttributeMultiprocessorCount, dev);
        hipFuncSetAttribute((const void*)fwd_megakernel, hipFuncAttributeMaxDynamicSharedMemorySize, LDS_BYTES);
        hipOccupancyMaxActiveBlocksPerMultiprocessor(&per_cu, (const void*)fwd_megakernel, NTHR, LDS_BYTES);
        if (per_cu < 1) { fprintf(stderr, "kernel_launch: occupancy query says %d blocks/CU\n", per_cu); grid_blocks = -1; return; }
        grid_blocks = cus;
    }
    if (grid_blocks < 0) return;
    hipMemsetAsync((char*)d_ws + OFF_BAR, 0, XCD_BAR_WORDS * 4, stream);
    Params p{};
    for (int i = 0; i < 29; ++i) p.in[i] = (const float*)d_in[i];
    p.out = (float*)d_out; p.ws = (char*)d_ws; p.pad = 0;
    void* args[] = {&p};
    hipError_t e = hipLaunchCooperativeKernel((const void*)fwd_megakernel, dim3(grid_blocks), dim3(NTHR), args, LDS_BYTES, stream);
    if (e != hipSuccess) fprintf(stderr, "cooperative launch failed: %s (grid %d)\n", hipGetErrorString(e), grid_blocks);
}
```

```cpp
#include <hip/hip_runtime.h>
#include <hip/hip_cooperative_groups.h>
#include <math.h>
#include <stdint.h>
#include <cstdio>
namespace cg = cooperative_groups;

__device__ __forceinline__ int tidx() { int t = threadIdx.x; asm volatile("" : "+v"(t)); return t; }
#define XB_TMO      128
#define XB_XCNT(j)  (256  + 64 * (j))
#define XB_XSUB(j)  (1280 + 64 * (j))
#define XB_XGEN(j)  (2304 + 64 * (j))
#define XB_TOP      3328
#define XB_TOPGEN   3392
#define XCD_BAR_WORDS 3456
#define XB_SPIN_CAP (1u << 18)
#define LAS __attribute__((address_space(3)))

__device__ __forceinline__ unsigned xb_ld(unsigned* p)              { return __hip_atomic_load(p, __ATOMIC_RELAXED, __HIP_MEMORY_SCOPE_AGENT); }
__device__ __forceinline__ unsigned xb_add(unsigned* p, unsigned v) { return __hip_atomic_fetch_add(p, v, __ATOMIC_RELAXED, __HIP_MEMORY_SCOPE_AGENT); }
__device__ __forceinline__ unsigned xb_xcc_id() { return (unsigned)__builtin_amdgcn_s_getreg((3 << 11) | 20) & 0xFu; }
#define XB_SPIN(cond, bar) do { unsigned _sp = 0; while (cond) { __builtin_amdgcn_s_sleep(1); \
    if ((++_sp & 255u) == 0u) { if (xb_ld(&(bar)[XB_TMO])) break; if (_sp > XB_SPIN_CAP) { atomicAdd(&(bar)[XB_TMO], 1u); break; } } } } while (0)

struct XcdBarrier {
    unsigned* bar; unsigned x;
    volatile LAS unsigned* st;
};

__device__ __forceinline__ XcdBarrier xcd_barrier_post(unsigned* bar, volatile LAS unsigned* st) {
    XcdBarrier b; b.bar = bar; b.x = xb_xcc_id(); b.st = st;
    if (tidx() == 0) (void)xb_add(&bar[XB_XCNT(b.x)], 1u);
    return b;
}
__device__ __forceinline__ void xcd_barrier_complete(unsigned* bar, unsigned x, unsigned& nloc, unsigned& nx) {
    const unsigned G = gridDim.x * gridDim.y * gridDim.z;
    unsigned sum, cnt, mine, sp = 0u;
    for (;;) {
        sum = 0u; cnt = 0u; mine = 0u;
#pragma unroll
        for (unsigned j = 0; j < 16; ++j) { const unsigned c = xb_ld(&bar[XB_XCNT(j)]); sum += c; cnt += (c > 0u) ? 1u : 0u; mine = (j == x) ? c : mine; }
        if (sum == G) break;
        __builtin_amdgcn_s_sleep(1);
        if ((++sp & 255u) == 0u) { if (xb_ld(&bar[XB_TMO])) break; if (sp > XB_SPIN_CAP) { atomicAdd(&bar[XB_TMO], 1u); break; } }
    }
    nloc = mine > 0u ? mine : 1u; nx = cnt > 0u ? cnt : 1u;
}

__device__ __forceinline__ void xcd_barrier(const XcdBarrier& b) {
    asm volatile("s_waitcnt vmcnt(0)" ::: "memory");
    __syncthreads();
    if (tidx() == 0) {
        unsigned* bar = b.bar;
        __builtin_amdgcn_s_waitcnt(0);
        unsigned nloc = b.st[0], nx = b.st[1];
        if (nloc == 0u) { xcd_barrier_complete(bar, b.x, nloc, nx); b.st[0] = nloc; b.st[1] = nx; }
        const unsigned old = xb_add(&bar[XB_XSUB(b.x)], 1u);
        const unsigned gen = old / nloc;
        if (old + 1u == (gen + 1u) * nloc) {
            __builtin_amdgcn_fence(__ATOMIC_RELEASE, "agent");
            asm volatile("s_waitcnt vmcnt(0)" ::: "memory");
            const unsigned og = xb_add(&bar[XB_TOP], 1u);
            const unsigned tg = og / nx;
            if (og + 1u == (tg + 1u) * nx) xb_add(&bar[XB_TOPGEN], 1u);
            else XB_SPIN(xb_ld(&bar[XB_TOPGEN]) == tg, bar);
            __builtin_amdgcn_fence(__ATOMIC_ACQUIRE, "agent");
            xb_add(&bar[XB_XGEN(b.x)], 1u);
            asm volatile("s_waitcnt vmcnt(0)" ::: "memory");
        } else {
            XB_SPIN(xb_ld(&bar[XB_XGEN(b.x)]) == gen, bar);
            __builtin_amdgcn_fence(__ATOMIC_ACQUIRE, "agent");
            asm volatile("s_waitcnt vmcnt(0)" ::: "memory");
        }
    }
    __syncthreads();
}

namespace pg8 {
#define PG8_LAS __attribute__((address_space(3)))
typedef unsigned short bf16_t;
typedef short bf16x8 __attribute__((ext_vector_type(8)));
typedef float f32x4 __attribute__((ext_vector_type(4)));
typedef unsigned u32x4 __attribute__((ext_vector_type(4)));
constexpr int BM = 256, BK = 64, HALF = 128, HTB = HALF * BK * 2  , STAGE_BYTES = 8 * HTB, NXCD = 8, WGM = 8;

__host__ __device__ __forceinline__ int lds_byte(int r, int c) { const int st = (r >> 4) * 2 + (c >> 5), rr = r & 15, cc = c & 31, ob = rr * 64 + cc * 2; return st * 1024 + (ob ^ (((ob >> 9) & 1) << 5)); }
__host__ __device__ __forceinline__ void stage_rc(int b, int& R, int& C) { const int st = b / 1024, sb = b % 1024, swz = sb ^ (((sb >> 9) & 1) << 5); R = (st >> 1) * 16 + swz / 64; C = (st & 1) * 32 + (swz % 64) / 2; }
__host__ __device__ __forceinline__ int perm32(int rho) { const int n = rho >> 4, i = rho & 15; return 8 * (i >> 2) + 4 * n + (i & 3); }

struct Unit { int pm, pn; };
struct Gemm { const bf16_t* A; const bf16_t* Bt; int M, N, K; };

struct StaticOrder {
    int nM, nN, nwg, G, c;
    __host__ __device__ void init(int M, int N, int G_, int c_) { nM = M / BM; nN = N / BM; nwg = nM * nN; G = G_; c = c_; }
    __host__ __device__ bool next(int i, Unit& u) const {
        const long L = (long)i * G + c; if (L >= nwg) return false;
        int wgid = (int)L; { const int q = nwg / NXCD, r = nwg % NXCD, xcd = wgid % NXCD, off = wgid / NXCD; wgid = (xcd < r ? xcd * (q + 1) : r * (q + 1) + (xcd - r) * q) + off; }
        const int nig = WGM * nN, gid = wgid / nig, fm = gid * WGM, gsz = (nM - fm) < WGM ? (nM - fm) : WGM;
        u.pm = fm + ((wgid % nig) % gsz); u.pn = (wgid % nig) / gsz; return true;
    }
    __device__ __forceinline__ void a_ready(const Unit&) const {}
    __device__ __forceinline__ void done(const Unit&) const {}
};
__device__ __forceinline__ unsigned cvt_pk_bf16(float lo, float hi) { unsigned r; asm volatile("v_cvt_pk_bf16_f32 %0, %1, %2" : "=v"(r) : "v"(lo), "v"(hi)); return r; }
template <class Epi, class Sched, bool STAMP = false>
__device__ __forceinline__ void gemm_phase(PG8_LAS unsigned char* lds, const Gemm g, const Sched& S, const Epi& E, unsigned long long* stamps) {
    const int tid = tidx(), wid = __builtin_amdgcn_readfirstlane(tid >> 6), lane = tid & 63, wr = wid >> 2, wc = wid & 3, fr = lane & 15, fq = lane >> 4;
    const int K = g.K, nt = K / BK;
    int ts_lo = 0, ts_hi = 0, nts = 0; const unsigned long long rt_entry = STAMP ? (unsigned long long)wall_clock64() : 0ull;
#define PG8_STAMP() do { if (STAMP && wid == 0 && nts < 64) { const unsigned long long _c = (unsigned long long)clock64(); \
        ts_lo = (lane == nts) ? (int)(unsigned)_c : ts_lo; ts_hi = (lane == nts) ? (int)(unsigned)(_c >> 32) : ts_hi; ++nts; } } while (0)
    PG8_STAMP();
    unsigned voffA[2], voffB[2];
#pragma unroll
    for (int i = 0; i < 2; ++i) { int R, C; stage_rc(tid * 16 + i * 8192, R, C); const int Rb = Epi::PERM ? ((R & ~31) + perm32(R & 31)) : R;
        voffA[i] = (unsigned)(R * K + C) * 2u; voffB[i] = (unsigned)(Rb * K + C) * 2u; }
    const size_t kstep = (size_t)(BK * 2);
    const size_t hstep = (size_t)HALF * K * 2;
    const size_t tstep = 2 * hstep;
    const unsigned ldsw = (unsigned)wid * 1024u;
    const int aoff = lds_byte(wr * 64 + fr, fq * 8), boff = lds_byte(wc * 32 + fr, fq * 8);
#define PG8_SA(b, h) (((b) * 2 + (h)) * HTB)
#define PG8_SB(b, h) ((4 + (b) * 2 + (h)) * HTB)
#define PG8_STAGE(bufoff, gbase, voff) do { _Pragma("unroll") for (int _i = 0; _i < 2; ++_i) \
        __builtin_amdgcn_global_load_lds((const unsigned*)((const char*)(gbase) + (voff)[_i]), (PG8_LAS unsigned*)(lds + (bufoff) + ldsw + _i * 8192), 16, 0, 0); } while (0)
#define PG8_LDA(dst, b, h) do { _Pragma("unroll") for (int m = 0; m < 4; ++m) _Pragma("unroll") for (int k = 0; k < 2; ++k) dst[m][k] = *(const PG8_LAS bf16x8*)(lds + PG8_SA(b, h) + aoff + m * 2048 + k * 1024); } while (0)
#define PG8_LDB(dst, b, h) do { _Pragma("unroll") for (int n = 0; n < 2; ++n) _Pragma("unroll") for (int k = 0; k < 2; ++k) dst[n][k] = *(const PG8_LAS bf16x8*)(lds + PG8_SB(b, h) + boff + n * 2048 + k * 1024); } while (0)
#define PG8_MMA(ai, bj, At, Bt) do { __builtin_amdgcn_s_setprio(1); _Pragma("unroll") for (int m = 0; m < 4; ++m) _Pragma("unroll") for (int n = 0; n < 2; ++n) _Pragma("unroll") for (int k = 0; k < 2; ++k) \
        acc[ai][bj][m][n] = __builtin_amdgcn_mfma_f32_16x16x32_bf16(Bt[n][k], At[m][k], acc[ai][bj][m][n], 0, 0, 0); __builtin_amdgcn_s_setprio(0); } while (0)
#define PG8_WAIT_V(n) asm volatile("s_waitcnt vmcnt(" #n ")" ::: "memory")
#define PG8_WAIT_L(n) asm volatile("s_waitcnt lgkmcnt(" #n ")" ::: "memory")
#define PG8_BAR __builtin_amdgcn_s_barrier()
#define PG8_SCHED __builtin_amdgcn_sched_barrier(0)
    Unit cur, nxt; int ui = 0;
    if (!S.next(0, cur)) return;
    f32x4 acc[2][2][4][2];
#pragma unroll
    for (int a = 0; a < 2; ++a)
#pragma unroll
        for (int b = 0; b < 2; ++b)
#pragma unroll
            for (int m = 0; m < 4; ++m)
#pragma unroll
                for (int n = 0; n < 2; ++n) acc[a][b][m][n] = (f32x4){0.f, 0.f, 0.f, 0.f};
    bf16x8 At[4][2], B0[2][2], B1[2][2];
    const char* cA = (const char*)g.A + (size_t)cur.pm * tstep; const char* cB = (const char*)g.Bt + (size_t)cur.pn * tstep;
    S.a_ready(cur);
    PG8_STAGE(PG8_SB(0, 0), cB, voffB); PG8_STAGE(PG8_SA(0, 0), cA, voffA); PG8_STAGE(PG8_SB(0, 1), cB + hstep, voffB); PG8_STAGE(PG8_SA(0, 1), cA + hstep, voffA);
    if (wr == 1) PG8_BAR;
    PG8_WAIT_V(4); PG8_BAR;
    PG8_STAGE(PG8_SB(1, 0), cB + kstep, voffB); PG8_STAGE(PG8_SA(1, 0), cA + kstep, voffA); PG8_STAGE(PG8_SB(1, 1), cB + hstep + kstep, voffB);
    PG8_WAIT_V(6); PG8_BAR;
    PG8_STAMP();
    for (;;) {
        const bool has_next = S.next(ui + 1, nxt);
        const char* nA = has_next ? (const char*)g.A + (size_t)nxt.pm * tstep : cA; const char* nB = has_next ? (const char*)g.Bt + (size_t)nxt.pn * tstep : cB;
        for (int t = 0; t < nt; t += 2) {
            const bool last = (t == nt - 2);
            const char* a1 = cA + (size_t)(t + 1) * kstep;
            const char* a2 = last ? nA : cA + (size_t)(t + 2) * kstep; const char* b2 = last ? nB : cB + (size_t)(t + 2) * kstep;
            const char* a3 = a2 + kstep; const char* b3 = b2 + kstep;
            if (last && has_next) S.a_ready(nxt);
            PG8_LDB(B0, 0, 0); PG8_SCHED; PG8_LDA(At, 0, 0); PG8_STAGE(PG8_SA(1, 1), a1 + hstep, voffA);
            PG8_WAIT_L(8); PG8_BAR; PG8_WAIT_L(0); PG8_MMA(0, 0, At, B0); PG8_BAR; PG8_SCHED;
            PG8_LDB(B1, 0, 1); PG8_STAGE(PG8_SB(0, 0), b2, voffB);
            PG8_BAR; PG8_WAIT_L(0); PG8_MMA(0, 1, At, B1); PG8_BAR;
            PG8_LDA(At, 0, 1); PG8_STAGE(PG8_SA(0, 0), a2, voffA);
            PG8_BAR; PG8_WAIT_L(0); PG8_MMA(1, 0, At, B0); PG8_BAR; PG8_SCHED;
            PG8_STAGE(PG8_SB(0, 1), b2 + hstep, voffB);
            PG8_WAIT_V(6); PG8_BAR; PG8_MMA(1, 1, At, B1); PG8_BAR;
            PG8_LDB(B0, 1, 0); PG8_SCHED; PG8_LDA(At, 1, 0); PG8_STAGE(PG8_SA(0, 1), a2 + hstep, voffA);
            PG8_WAIT_L(8); PG8_BAR; PG8_WAIT_L(0); PG8_MMA(0, 0, At, B0); PG8_BAR; PG8_SCHED;
            PG8_LDB(B1, 1, 1); PG8_STAGE(PG8_SB(1, 0), b3, voffB);
            PG8_BAR; PG8_WAIT_L(0); PG8_MMA(0, 1, At, B1); PG8_BAR;
            PG8_LDA(At, 1, 1); PG8_STAGE(PG8_SA(1, 0), a3, voffA);
            PG8_BAR; PG8_WAIT_L(0); PG8_MMA(1, 0, At, B0); PG8_BAR; PG8_SCHED;
            PG8_STAGE(PG8_SB(1, 1), b3 + hstep, voffB);
            PG8_WAIT_V(6); PG8_BAR; PG8_MMA(1, 1, At, B1); PG8_BAR;
        }
        PG8_STAMP();
        if constexpr (!Epi::AFTER_DRAIN) { E(acc, cur, wr, wc, fr, fq); S.done(cur); }
        PG8_STAMP();
        if (!has_next) break;
#pragma unroll
        for (int a = 0; a < 2; ++a)
#pragma unroll
            for (int b = 0; b < 2; ++b)
#pragma unroll
                for (int m = 0; m < 4; ++m)
#pragma unroll
                    for (int n = 0; n < 2; ++n) acc[a][b][m][n] = (f32x4){0.f, 0.f, 0.f, 0.f};
        cur = nxt; cA = nA; cB = nB; ++ui;
    }
    PG8_WAIT_V(0);
    if (wr == 0) PG8_BAR;
    PG8_BAR;
    if constexpr (Epi::AFTER_DRAIN) { E.fused(acc, cur, wr, wc, fr, fq, lds, wid, lane); S.done(cur); }
    PG8_STAMP();
    if (STAMP && wid == 0) { stamps[lane] = lane < nts ? (((unsigned long long)(unsigned)ts_hi << 32) | (unsigned)ts_lo) : 0ull;
        if (lane == 62) stamps[62] = rt_entry; if (lane == 63) stamps[63] = (unsigned long long)wall_clock64(); }
#undef PG8_STAMP
#undef PG8_SA
#undef PG8_SB
#undef PG8_STAGE
#undef PG8_LDA
#undef PG8_LDB
#undef PG8_MMA
#undef PG8_WAIT_V
#undef PG8_WAIT_L
#undef PG8_BAR
#undef PG8_SCHED
}
}

namespace {
using pg8::bf16_t;
typedef float f32x4 __attribute__((ext_vector_type(4)));
typedef unsigned u32x4 __attribute__((ext_vector_type(4)));

constexpr int NB = 16, NL = 2048, ND = 1024, NT = NB * NL;
constexpr int EVEN_IN = 2560, ODD_IN = 2608, ODD_PAD = 2304;
constexpr float ALPHA = 1.41421356237f;
constexpr float LN_EPS = 1e-5f;
constexpr float U_SCALE = 256.f, V_SCALE = 16.f;
constexpr int NTHR = 512;
constexpr int LDS_BYTES = 163840;
#ifndef PROBE
#define PROBE 0
#endif
#define PDUP(bit) for (int _rep = 0; _rep < ((PROBE >> (bit)) & 1) + 1; ++_rep)
#ifndef PHMASK
#define PHMASK 0xFFFFFFFFu
#endif
#define PH(n) if (PHMASK & (1u << (n)))

__device__ __forceinline__ float bf2f(bf16_t v) { return __uint_as_float((unsigned)v << 16); }
__device__ __forceinline__ bf16_t f2bf(float f) { unsigned u = __float_as_uint(f); u += 0x7FFFu + ((u >> 16) & 1u); return (bf16_t)(u >> 16); }
__device__ __forceinline__ unsigned pack2(float lo, float hi) { return (unsigned)f2bf(lo) | ((unsigned)f2bf(hi) << 16); }
__device__ __forceinline__ void ld8(const bf16_t* p, float* o) {
    const uint4 v = *(const uint4*)p;
    o[0] = __uint_as_float(v.x << 16); o[1] = __uint_as_float(v.x & 0xffff0000u);
    o[2] = __uint_as_float(v.y << 16); o[3] = __uint_as_float(v.y & 0xffff0000u);
    o[4] = __uint_as_float(v.z << 16); o[5] = __uint_as_float(v.z & 0xffff0000u);
    o[6] = __uint_as_float(v.w << 16); o[7] = __uint_as_float(v.w & 0xffff0000u);
}
__device__ __forceinline__ void st8(bf16_t* p, const float* o) {
    uint4 v; v.x = pack2(o[0], o[1]); v.y = pack2(o[2], o[3]); v.z = pack2(o[4], o[5]); v.w = pack2(o[6], o[7]);
    *(uint4*)p = v;
}

struct EpiBf16s {
    static constexpr bool PERM = true, AFTER_DRAIN = false;
    bf16_t* O; int ldc;
    __device__ __forceinline__ void operator()(const f32x4 (&acc)[2][2][4][2], const pg8::Unit& u, int wr, int wc, int fr, int fq) const {
        const int row0 = u.pm * 256 + wr * 64 + fr, col0 = u.pn * 256 + wc * 32 + 8 * fq;
#pragma unroll
        for (int ai = 0; ai < 2; ++ai)
#pragma unroll
            for (int m = 0; m < 4; ++m) { bf16_t* rowp = O + (size_t)(row0 + ai * 128 + m * 16) * ldc + col0;
#pragma unroll
                for (int bj = 0; bj < 2; ++bj) { const f32x4 v0 = acc[ai][bj][m][0], v1 = acc[ai][bj][m][1];
                    u32x4 w; w.x = pg8::cvt_pk_bf16(v0[0], v0[1]); w.y = pg8::cvt_pk_bf16(v0[2], v0[3]); w.z = pg8::cvt_pk_bf16(v1[0], v1[1]); w.w = pg8::cvt_pk_bf16(v1[2], v1[3]);
                    *(u32x4*)(rowp + bj * 128) = w; } }
    }
};
struct EpiRes {
    static constexpr bool PERM = false, AFTER_DRAIN = false;
    float* C; int ldc; float alpha; float* Cout;
    __device__ __forceinline__ void operator()(const f32x4 (&acc)[2][2][4][2], const pg8::Unit& u, int wr, int wc, int fr, int fq) const {
        const int row0 = u.pm * 256 + wr * 64 + fr, col0 = u.pn * 256 + wc * 32 + 4 * fq; const size_t dlt = Cout - C;
#pragma unroll
        for (int ai = 0; ai < 2; ++ai)
#pragma unroll
            for (int m = 0; m < 4; ++m) { float* rowp = C + (size_t)(row0 + ai * 128 + m * 16) * ldc + col0;
#pragma unroll
                for (int bj = 0; bj < 2; ++bj)
#pragma unroll
                    for (int n = 0; n < 2; ++n) { f32x4* cp = (f32x4*)(rowp + bj * 128 + n * 16); *(cp + dlt / 4) = *cp * alpha + acc[ai][bj][m][n]; } }
    }
};
template <class Epi>
__device__ __forceinline__ void gemm_bf16_phase(unsigned char* lds, const bf16_t* A, const bf16_t* Bt, int M, int N, int K, const Epi& E) {
    pg8::Gemm g{A, Bt, M, N, K};
    pg8::StaticOrder S; S.init(M, N, (int)gridDim.x, (int)blockIdx.x);
    pg8::gemm_phase<Epi, pg8::StaticOrder, false>((PG8_LAS unsigned char*)lds, g, S, E, nullptr);
    __syncthreads();
}

struct ColMap { int d0[3], s0[3], len[3]; };
__device__ __forceinline__ void convert_wt_phase(const float* __restrict__ W, int K, int N, int Npad, const ColMap cm, bf16_t* __restrict__ Wt, float* lds) {
    float(*tile)[65] = (float(*)[65])lds;
    const int tid = tidx(), ntn = Npad / 64, ntiles = (K / 64) * ntn;
    for (int it = blockIdx.x; it < ntiles; it += gridDim.x) {
        const int k0 = (it / ntn) * 64, n0 = (it % ntn) * 64;
        __syncthreads();
#pragma unroll
        for (int h = 0; h < 2; ++h) {
            const int r = (tid >> 4) + h * 32, c4 = (tid & 15) * 4, nd = n0 + c4;
            int ns = -1;
#pragma unroll
            for (int sg = 0; sg < 3; ++sg) if (nd >= cm.d0[sg] && nd < cm.d0[sg] + cm.len[sg]) ns = cm.s0[sg] + (nd - cm.d0[sg]);
            float4 v = make_float4(0.f, 0.f, 0.f, 0.f);
            if (ns >= 0) v = *(const float4*)(W + (size_t)(k0 + r) * N + ns);
            tile[r][c4] = v.x; tile[r][c4 + 1] = v.y; tile[r][c4 + 2] = v.z; tile[r][c4 + 3] = v.w;
        }
        __syncthreads();
        const int n = tid >> 3, k8 = (tid & 7) * 8;
        float o[8];
#pragma unroll
        for (int j = 0; j < 8; ++j) o[j] = tile[k8 + j][n];
        st8(Wt + (size_t)(n0 + n) * K + k0 + k8, o);
    }
    __syncthreads();
}
__device__ __forceinline__ float gelu_tanh(float x) {
    float u = 0.7978845608028654f * (x + 0.044715f * x * x * x);
    return 0.5f * x * (1.f + tanhf(u));
}
__device__ __forceinline__ float sigmoidf_(float x) { return 1.f / (1.f + expf(-x)); }
__device__ __forceinline__ void wave_lds_fence() { asm volatile("s_waitcnt lgkmcnt(0)" ::: "memory"); }

__device__ __forceinline__ void s5_scan_wave(int bg, const bf16_t* __restrict__ proj, const float* __restrict__ lam_re, const float* __restrict__ lam_im,
                             const float* __restrict__ log_dt, const float* __restrict__ b_re, const float* __restrict__ b_im,
                             const float* __restrict__ c_re, const float* __restrict__ c_im, const float* __restrict__ dskip,
                             float* __restrict__ ya, float* lds) {
    const int b = bg >> 4, g = bg & 15, lane = tidx() & 63;
    float(*us)[16] = (float(*)[16])lds;
    float(*xr)[65] = (float(*)[65])(lds + 1024);
    float(*xi)[65] = (float(*)[65])(lds + 1024 + 4160);
    float(*cr)[64] = (float(*)[64])(lds + 1024 + 8320);
    float(*ci)[64] = (float(*)[64])(lds + 1024 + 8320 + 1024);
    const float lr = lam_re[g * 64 + lane], li = lam_im[g * 64 + lane];
    const float dt = expf(log_dt[g]);
    const float mag = expf(lr * dt);
    const float are = mag * cosf(li * dt), aim = mag * sinf(li * dt);
    const float nr = are - 1.f, den = lr * lr + li * li;
    const float fre = (nr * lr + aim * li) / den, fim = (aim * lr - nr * li) / den;
    float bbr[16], bbi[16];
#pragma unroll
    for (int i = 0; i < 16; ++i) {
        const float br = b_re[(g * 64 + lane) * 16 + i], bi = b_im[(g * 64 + lane) * 16 + i];
        bbr[i] = fre * br - fim * bi; bbi[i] = fre * bi + fim * br;
    }
    for (int idx = lane; idx < 1024; idx += 64) { cr[idx >> 6][idx & 63] = c_re[g * 1024 + idx]; ci[idx >> 6][idx & 63] = c_im[g * 1024 + idx]; }
    float dsk[16];
#pragma unroll
    for (int i = 0; i < 16; ++i) dsk[i] = dskip[g * 16 + i];
    float xre = 0.f, xim = 0.f;
    for (int t0 = 0; t0 < NL; t0 += 64) {
        wave_lds_fence();
        for (int idx = lane; idx < 1024; idx += 64) { const int t = idx >> 4, i = idx & 15; us[t][i] = bf2f(proj[(size_t)(b * NL + t0 + t) * EVEN_IN + g * 16 + i]); }
        wave_lds_fence();
        for (int t = 0; t < 64; ++t) {
            float bur = 0.f, bui = 0.f;
#pragma unroll
            for (int i = 0; i < 16; ++i) { const float u = us[t][i]; bur += bbr[i] * u; bui += bbi[i] * u; }
            const float nre = are * xre - aim * xim + bur, nim = are * xim + aim * xre + bui;
            xre = nre; xim = nim;
            xr[t][lane] = xre; xi[t][lane] = xim;
        }
        wave_lds_fence();
        float y[16];
#pragma unroll
        for (int i = 0; i < 16; ++i) y[i] = 0.f;
        for (int p = 0; p < 64; ++p) {
            const float a = xr[lane][p], bq = xi[lane][p];
#pragma unroll
            for (int i = 0; i < 16; ++i) y[i] += cr[i][p] * a - ci[i][p] * bq;
        }
#pragma unroll
        for (int i = 0; i < 16; ++i) {
            const float v = y[i] + dsk[i] * us[lane][i];
            ya[(size_t)(b * NL + t0 + lane) * 256 + g * 16 + i] = gelu_tanh(v);
        }
    }
}

__device__ __forceinline__ void sb_attn_wave(int task, const bf16_t* __restrict__ proj, bf16_t* __restrict__ Y, float* wl) {
    const int qt = task & 31, h = (task >> 5) % 12, b = task / 384, lane = tidx() & 63;
    const int t = qt * 64 + lane;
    float(*ks)[64] = (float(*)[64])wl;
    float(*vs)[64] = (float(*)[64])(wl + 2048);
    const bf16_t* base = proj + (size_t)b * NL * EVEN_IN;
    float q[64], acc[64];
#pragma unroll
    for (int d = 0; d < 64; d += 8) ld8(base + (size_t)t * EVEN_IN + 256 + h * 64 + d, q + d);
#pragma unroll
    for (int d = 0; d < 64; ++d) acc[d] = 0.f;
    float tail = 0.f;
    for (int c = 2 * qt + 1; c >= 0; --c) {
        wave_lds_fence();
        for (int i = 0; i < 32; ++i) {
            ks[i][lane] = bf2f(base[(size_t)(c * 32 + i) * EVEN_IN + 1024 + h * 64 + lane]);
            vs[i][lane] = bf2f(base[(size_t)(c * 32 + i) * EVEN_IN + 1792 + h * 64 + lane]);
        }
        wave_lds_fence();
        for (int s = 31; s >= 0; --s) {
            const int key = c * 32 + s;
            float z = 0.f;
#pragma unroll
            for (int d = 0; d < 64; ++d) z += q[d] * ks[s][d];
            z *= 0.125f;
            const bool valid = key < t;
            const float sp = fmaxf(z, 0.f) + log1pf(expf(-fabsf(z)));
            const float w = valid ? expf(z - sp + tail) : 0.f;
#pragma unroll
            for (int d = 0; d < 64; ++d) acc[d] += w * vs[s][d];
            if (valid) tail -= sp;
        }
        if (__all(tail < -120.f)) break;
    }
#pragma unroll
    for (int d = 0; d < 64; d += 8) st8(Y + (size_t)(b * NL + t) * ND + 256 + h * 64 + d, acc + d);
}

__device__ __forceinline__ void glu_phase(const float* __restrict__ ya, const float* __restrict__ wglu, const float* __restrict__ bglu, bf16_t* __restrict__ Y, float* lds) {
    const int half = tidx() >> 8, c = tidx() & 255;
    float(*ys)[256] = (float(*)[256])(lds + half * 4096);
    for (int it = blockIdx.x; it < NT / 32; it += gridDim.x) {
        const int t0 = it * 32 + half * 16;
        __syncthreads();
        for (int i = 0; i < 16; ++i) ys[i][c] = ya[(size_t)(t0 + i) * 256 + c];
        __syncthreads();
        float acc[16];
#pragma unroll
        for (int i = 0; i < 16; ++i) acc[i] = 0.f;
        for (int k = 0; k < 256; ++k) {
            const float w = wglu[k * 256 + c];
#pragma unroll
            for (int i = 0; i < 16; ++i) acc[i] += ys[i][k] * w;
        }
        const float bb = bglu[c];
#pragma unroll
        for (int i = 0; i < 16; ++i) Y[(size_t)(t0 + i) * ND + c] = f2bf(ys[i][c] * sigmoidf_(acc[i] + bb));
    }
    __syncthreads();
}

__device__ __forceinline__ void ln_row_wave(float4 (&v)[4], const float* __restrict__ g, const float* __restrict__ bta, float* out, bf16_t* outb, int lane) {
    float s = 0.f;
#pragma unroll
    for (int j = 0; j < 4; ++j) s += v[j].x + v[j].y + v[j].z + v[j].w;
    for (int o = 32; o; o >>= 1) s += __shfl_xor(s, o);
    const float mean = s * (1.f / ND);
    float s2 = 0.f;
#pragma unroll
    for (int j = 0; j < 4; ++j) {
        v[j].x -= mean; v[j].y -= mean; v[j].z -= mean; v[j].w -= mean;
        s2 += v[j].x * v[j].x + v[j].y * v[j].y + v[j].z * v[j].z + v[j].w * v[j].w;
    }
    for (int o = 32; o; o >>= 1) s2 += __shfl_xor(s2, o);
    const float rs = rsqrtf(s2 * (1.f / ND) + LN_EPS);
#pragma unroll
    for (int j = 0; j < 4; ++j) {
        const float4 gg = *(const float4*)(g + j * 256 + lane * 4), bb = *(const float4*)(bta + j * 256 + lane * 4);
        const float4 o = make_float4(v[j].x * rs * gg.x + bb.x, v[j].y * rs * gg.y + bb.y, v[j].z * rs * gg.z + bb.z, v[j].w * rs * gg.w + bb.w);
        *(float4*)(out + j * 256 + lane * 4) = o;
        if (outb) { uint2 w; w.x = pack2(o.x, o.y); w.y = pack2(o.z, o.w); *(uint2*)(outb + j * 256 + lane * 4) = w; }
    }
}
__device__ __forceinline__ void ln_phase(float* R, bf16_t* Hb, const float* __restrict__ g, const float* __restrict__ bta) {
    const int wave = tidx() >> 6, lane = tidx() & 63;
    for (int row = blockIdx.x * 8 + wave; row < NT; row += gridDim.x * 8) {
        float4 v[4];
#pragma unroll
        for (int j = 0; j < 4; ++j) v[j] = *(const float4*)(R + (size_t)row * ND + j * 256 + lane * 4);
        ln_row_wave(v, g, bta, R + (size_t)row * ND, Hb + (size_t)row * ND, lane);
    }
}

__device__ __forceinline__ void wave_argmax(float& bv, int& bi) {
#pragma unroll
    for (int o = 32; o; o >>= 1) {
        const float ov = __shfl_xor(bv, o); const int oi = __shfl_xor(bi, o);
        if (ov > bv || (ov == bv && oi < bi)) { bv = ov; bi = oi; }
    }
}
__device__ __forceinline__ void peer_route_phase(const bf16_t* __restrict__ qbuf, const float* __restrict__ subk, int* __restrict__ eidx, float* __restrict__ egate, float* lds) {
    const int head = tidx() >> 6, lane = tidx() & 63;
    float* qs = lds + head * 256;
    for (int token = blockIdx.x; token < NT; token += gridDim.x) {
        const bf16_t* qp = qbuf + (size_t)token * 2048 + head * 256;
        wave_lds_fence();
        for (int i = 0; i < 4; ++i) qs[lane + 64 * i] = bf2f(qp[lane + 64 * i]);
        wave_lds_fence();
        float myv[2]; int myi[2];
#pragma unroll
        for (int c = 0; c < 2; ++c) {
            float sc[2];
#pragma unroll
            for (int w2 = 0; w2 < 2; ++w2) {
                const float* kr = subk + ((size_t)(head * 2 + c) * 128 + lane + 64 * w2) * 128;
                float a = 0.f;
#pragma unroll 4
                for (int d = 0; d < 128; d += 4) {
                    const float4 kv = *(const float4*)(kr + d);
                    a += qs[c * 128 + d] * kv.x + qs[c * 128 + d + 1] * kv.y + qs[c * 128 + d + 2] * kv.z + qs[c * 128 + d + 3] * kv.w;
                }
                sc[w2] = a;
            }
            float a0 = sc[0], a1 = sc[1];
            float mv = -INFINITY; int mi = 0;
            for (int r = 0; r < 16; ++r) {
                float bv; int bi;
                if (a0 >= a1) { bv = a0; bi = lane; } else { bv = a1; bi = lane + 64; }
                wave_argmax(bv, bi);
                if (lane == r) { mv = bv; mi = bi; }
                if (bi == lane) a0 = -INFINITY; else if (bi == lane + 64) a1 = -INFINITY;
            }
            myv[c] = mv; myi[c] = mi;
        }
        const float va = __shfl(myv[0], lane >> 2);
        float cand[4];
#pragma unroll
        for (int j = 0; j < 4; ++j) cand[j] = va + __shfl(myv[1], (lane & 3) * 4 + j);
        float topv = -INFINITY; int topf = 0;
        for (int r = 0; r < 16; ++r) {
            float bv = cand[0]; int bi = lane * 4;
#pragma unroll
            for (int j = 1; j < 4; ++j) if (cand[j] > bv) { bv = cand[j]; bi = lane * 4 + j; }
            wave_argmax(bv, bi);
            if (lane == r) { topv = bv; topf = bi; }
#pragma unroll
            for (int j = 0; j < 4; ++j) if (bi == lane * 4 + j) cand[j] = -INFINITY;
        }
        const int e1 = __shfl(myi[0], topf >> 4), e2 = __shfl(myi[1], topf & 15);
        const float top0 = __shfl(topv, 0);
        float ex = (lane < 16) ? expf(topv - top0) : 0.f;
        float sum = ex;
        for (int o = 32; o; o >>= 1) sum += __shfl_xor(sum, o);
        if (lane < 16) {
            eidx[(size_t)token * 128 + head * 16 + lane] = e1 * 128 + e2;
            egate[(size_t)token * 128 + head * 16 + lane] = ex / sum;
        }
    }
}

__device__ __forceinline__ void peer_expert_phase(float* R, const int* __restrict__ eidx, const float* __restrict__ egate, const float* __restrict__ utab,
                                  const float* __restrict__ vtab, const float* __restrict__ lg, const float* __restrict__ lb, bf16_t* Hb) {
    const int wave = tidx() >> 6, lane = tidx() & 63;
    for (int token = blockIdx.x * 8 + wave; token < NT; token += gridDim.x * 8) {
        float4 x[4], acc[4];
#pragma unroll
        for (int j = 0; j < 4; ++j) { x[j] = *(const float4*)(R + (size_t)token * ND + j * 256 + lane * 4); acc[j] = make_float4(0.f, 0.f, 0.f, 0.f); }
        for (int e0 = 0; e0 < 128; e0 += 4) {
            float dot[4]; int ex[4]; float gt[4];
#pragma unroll
            for (int k = 0; k < 4; ++k) {
                ex[k] = eidx[(size_t)token * 128 + e0 + k]; gt[k] = egate[(size_t)token * 128 + e0 + k];
                const float* ur = utab + (size_t)ex[k] * ND + lane * 4;
                float a = 0.f;
#pragma unroll
                for (int j = 0; j < 4; ++j) { const float4 u = *(const float4*)(ur + j * 256); a += x[j].x * u.x + x[j].y * u.y + x[j].z * u.z + x[j].w * u.w; }
                dot[k] = a;
            }
#pragma unroll
            for (int k = 0; k < 4; ++k) {
                float a = dot[k];
                for (int o = 32; o; o >>= 1) a += __shfl_xor(a, o);
                const float coef = gt[k] * gelu_tanh(a);
                const float* vr = vtab + (size_t)ex[k] * ND + lane * 4;
#pragma unroll
                for (int j = 0; j < 4; ++j) { const float4 v = *(const float4*)(vr + j * 256); acc[j].x += coef * v.x; acc[j].y += coef * v.y; acc[j].z += coef * v.z; acc[j].w += coef * v.w; }
            }
        }
#pragma unroll
        for (int j = 0; j < 4; ++j) { x[j].x = ALPHA * x[j].x + acc[j].x; x[j].y = ALPHA * x[j].y + acc[j].y; x[j].z = ALPHA * x[j].z + acc[j].z; x[j].w = ALPHA * x[j].w + acc[j].w; }
        ln_row_wave(x, lg, lb, R + (size_t)token * ND, Hb ? Hb + (size_t)token * ND : nullptr, lane);
    }
}


typedef short bf16x8_t __attribute__((ext_vector_type(8)));
__device__ __forceinline__ int f2key(float f) { const int b = __float_as_int(f); return b ^ ((b >> 31) & 0x7fffffff); }
__device__ __forceinline__ float key2f(int k) { return __int_as_float(k ^ ((k >> 31) & 0x7fffffff)); }
#define CE_DESC_I(a, b) do { const int _hi = max(a, b), _lo = min(a, b); a = _hi; b = _lo; } while (0)
template <int N, int K, int J> __device__ __forceinline__ void bstage(int (&v)[N]) {
#pragma unroll
    for (int i = 0; i < N; ++i) {
        const int l = i ^ J;
        if (l > i) { if ((i & K) == 0) CE_DESC_I(v[i], v[l]); else CE_DESC_I(v[l], v[i]); }
    }
}
__device__ __forceinline__ void sort16_desc(int (&v)[16]) {
    bstage<16, 2, 1>(v); bstage<16, 4, 2>(v); bstage<16, 4, 1>(v); bstage<16, 8, 4>(v); bstage<16, 8, 2>(v); bstage<16, 8, 1>(v);
    bstage<16, 16, 8>(v); bstage<16, 16, 4>(v); bstage<16, 16, 2>(v); bstage<16, 16, 1>(v);
}
__device__ __forceinline__ void sort8_desc(int (&v)[8]) {
    bstage<8, 2, 1>(v); bstage<8, 4, 2>(v); bstage<8, 4, 1>(v); bstage<8, 8, 4>(v); bstage<8, 8, 2>(v); bstage<8, 8, 1>(v);
}
__device__ __forceinline__ void bitonic_merge16_desc(int (&v)[16]) {
    bstage<16, 16, 8>(v); bstage<16, 16, 4>(v); bstage<16, 16, 2>(v); bstage<16, 16, 1>(v);
}
__device__ __forceinline__ void xmerge16(int (&v)[16], int off) {
    int m[16];
#pragma unroll
    for (int i = 0; i < 16; ++i) m[i] = max(v[i], __shfl_xor(v[15 - i], off));
    bitonic_merge16_desc(m);
#pragma unroll
    for (int i = 0; i < 16; ++i) v[i] = m[i];
}
__device__ __forceinline__ void opaque16(int (&v)[16]) {
#pragma unroll
    for (int i = 0; i < 16; ++i) asm volatile("" : "+v"(v[i]));
}
__device__ __forceinline__ int lookup16(const int (&arr)[16], int a) {
    int r = arr[0];
#pragma unroll
    for (int i = 1; i < 16; ++i) r = (a == i) ? arr[i] : r;
    return r;
}
__device__ __forceinline__ void peer_route2_phase(const bf16_t* __restrict__ qbuf, const bf16_t* __restrict__ skb, int* __restrict__ eidx, float* __restrict__ egate, unsigned char* lds) {
    const int tid = tidx(), wave = tid >> 6, lane = tid & 63, fr = lane & 15, fq = lane >> 4;
    for (int chunk = blockIdx.x; chunk < NT / 128; chunk += gridDim.x) {
        const int token = chunk * 128 + wave * 16 + fr;
        int* tl = (int*)(lds + 34816) + (wave * 16 + fr) * 48;
        for (int h = 0; h < 8; ++h) {
            int K1[16], K2[16];
#pragma unroll
            for (int c = 0; c < 2; ++c) {
                __syncthreads();
#pragma unroll
                for (int i = 0; i < 4; ++i) {
                    const int idx = tid + 512 * i, row = idx >> 4, ch = idx & 15;
                    *(uint4*)(lds + row * 272 + ch * 16) = *(const uint4*)(skb + ((size_t)(h * 2 + c) * 128 + row) * 128 + ch * 8);
                }
                __syncthreads();
                bf16x8_t qf[4];
#pragma unroll
                for (int sI = 0; sI < 4; ++sI) qf[sI] = *(const bf16x8_t*)(qbuf + (size_t)token * 2048 + h * 256 + c * 128 + 32 * sI + 8 * fq);
                int va[16], vb[16];
#pragma unroll
                for (int n = 0; n < 8; ++n) {
                    f32x4 S = {0.f, 0.f, 0.f, 0.f};
#pragma unroll
                    for (int sI = 0; sI < 4; ++sI) {
                        const bf16x8_t kf = *(const bf16x8_t*)(lds + (16 * n + fr) * 272 + (32 * sI + 8 * fq) * 2);
                        S = __builtin_amdgcn_mfma_f32_16x16x32_bf16(kf, qf[sI], S, 0, 0, 0);
                    }
#pragma unroll
                    for (int j = 0; j < 4; ++j) {
                        const int key = (f2key(S[j]) & ~127) | (16 * n + 4 * fq + j);
                        if (n < 4) va[n * 4 + j] = key; else vb[(n - 4) * 4 + j] = key;
                    }
                }
                sort16_desc(va); sort16_desc(vb);
                int m[16];
#pragma unroll
                for (int i = 0; i < 16; ++i) m[i] = max(va[i], vb[15 - i]);
                bitonic_merge16_desc(m);
                xmerge16(m, 16); xmerge16(m, 32);
#pragma unroll
                for (int i = 0; i < 16; ++i) { if (c == 0) K1[i] = m[i]; else K2[i] = m[i]; }
                if (fq == 0) {
#pragma unroll
                    for (int i = 0; i < 4; ++i) *(int4*)(tl + c * 16 + 4 * i) = make_int4(m[4 * i], m[4 * i + 1], m[4 * i + 2], m[4 * i + 3]);
                }
            }
            wave_lds_fence();
            float vaf[4];
#pragma unroll
            for (int k = 0; k < 4; ++k) vaf[k] = key2f(tl[4 * k + fq]);
            int A[16];
#pragma unroll
            for (int b = 0; b < 16; ++b) {
                const bool valid = (fq + 1) * (b + 1) <= 16;
                const int key = (f2key(vaf[0] + key2f(K2[b])) & ~127) | (fq << 5) | b;
                A[b] = valid ? key : INT_MIN;
            }
            int Bq[8];
#pragma unroll
            for (int b = 0; b < 3; ++b) {
                const bool valid = (fq + 5) * (b + 1) <= 16;
                const int key = (f2key(vaf[1] + key2f(K2[b])) & ~127) | (fq << 5) | (16 + b);
                Bq[b] = valid ? key : INT_MIN;
            }
            Bq[3] = (f2key(vaf[2] + key2f(K2[0])) & ~127) | (fq << 5) | 19;
            Bq[4] = (f2key(vaf[3] + key2f(K2[0])) & ~127) | (fq << 5) | 20;
            Bq[5] = INT_MIN; Bq[6] = INT_MIN; Bq[7] = INT_MIN;
            sort8_desc(Bq);
#pragma unroll
            for (int i = 8; i < 16; ++i) A[i] = max(A[i], Bq[15 - i]);
            bitonic_merge16_desc(A);
            xmerge16(A, 16); xmerge16(A, 32);
            if (fq == 0) {
#pragma unroll
                for (int i = 0; i < 4; ++i) *(int4*)(tl + 32 + 4 * i) = make_int4(A[4 * i], A[4 * i + 1], A[4 * i + 2], A[4 * i + 3]);
            }
            wave_lds_fence();
            const int4 myT = *(const int4*)(tl + 32 + 4 * fq);
            const int tsel[4] = {myT.x, myT.y, myT.z, myT.w};
            const float top0 = key2f(A[0]);
            float sum = 0.f;
#pragma unroll
            for (int r = 0; r < 16; ++r) sum += __expf(key2f(A[r]) - top0);
            const float inv = 1.f / sum;
            int eo[4]; float go[4];
#pragma unroll
            for (int kk = 0; kk < 4; ++kk) {
                const int t = tsel[kk];
                const int id = t & 127, ofq = id >> 5, slot = id & 31;
                const int k = slot < 16 ? 0 : (slot < 19 ? 1 : (slot == 19 ? 2 : 3));
                const int b = slot < 16 ? slot : (slot < 19 ? slot - 16 : 0);
                const int a = ofq + 4 * k;
                const int e1 = tl[a] & 127, e2 = tl[16 + b] & 127;
                eo[kk] = e1 * 128 + e2;
                go[kk] = __expf(key2f(t) - top0) * inv;
            }
            *(int4*)(eidx + (size_t)token * 128 + h * 16 + 4 * fq) = make_int4(eo[0], eo[1], eo[2], eo[3]);
            *(float4*)(egate + (size_t)token * 128 + h * 16 + 4 * fq) = make_float4(go[0], go[1], go[2], go[3]);
            wave_lds_fence();
        }
    }
    __syncthreads();
}

typedef __bf16 bf16x2_t __attribute__((ext_vector_type(2)));
typedef float f32x2_t __attribute__((ext_vector_type(2)));
__device__ __forceinline__ float dot2bf(unsigned a, unsigned b, float acc) { return __builtin_amdgcn_fdot2_f32_bf16(__builtin_bit_cast(bf16x2_t, a), __builtin_bit_cast(bf16x2_t, b), acc, false); }
__device__ __forceinline__ float gelu_fast(float x) {
    const float u = 0.7978845608028654f * (x + 0.044715f * x * x * x);
    return x / (1.f + __expf(-2.f * u));
}
__device__ __forceinline__ void peer_expert2_phase(float* R, const int* __restrict__ eidx, const float* __restrict__ egate, const bf16_t* __restrict__ ub,
                                                   const bf16_t* __restrict__ vb, const float* __restrict__ lg, const float* __restrict__ lb, bf16_t* Hb) {
    const int wave = tidx() >> 6, lane = tidx() & 63;
    for (int token = blockIdx.x * 8 + wave; token < NT; token += gridDim.x * 8) {
        float xf[16];
        {
            const float* rp = R + (size_t)token * ND + lane * 8;
            const float4 a0 = *(const float4*)rp, a1 = *(const float4*)(rp + 4), b0 = *(const float4*)(rp + 512), b1 = *(const float4*)(rp + 516);
            xf[0] = a0.x; xf[1] = a0.y; xf[2] = a0.z; xf[3] = a0.w; xf[4] = a1.x; xf[5] = a1.y; xf[6] = a1.z; xf[7] = a1.w;
            xf[8] = b0.x; xf[9] = b0.y; xf[10] = b0.z; xf[11] = b0.w; xf[12] = b1.x; xf[13] = b1.y; xf[14] = b1.z; xf[15] = b1.w;
        }
        unsigned xp[8];
#pragma unroll
        for (int j = 0; j < 8; ++j) xp[j] = pack2(xf[2 * j], xf[2 * j + 1]);
        float acc[16];
#pragma unroll
        for (int j = 0; j < 16; ++j) acc[j] = 0.f;
        const int e_lo = eidx[(size_t)token * 128 + lane], e_hi = eidx[(size_t)token * 128 + 64 + lane];
        const float g_lo = egate[(size_t)token * 128 + lane], g_hi = egate[(size_t)token * 128 + 64 + lane];
        for (int grp = 0; grp < 16; ++grp) {
            const int esel = grp < 8 ? e_lo : e_hi;
            const float gsel = grp < 8 ? g_lo : g_hi;
            const int lbase = (grp & 7) * 8;
            uint4 u0[8], u1[8];
            int exs[8];
#pragma unroll
            for (int k = 0; k < 8; ++k) {
                exs[k] = __builtin_amdgcn_readlane(esel, lbase + k);
                const bf16_t* up = ub + (size_t)exs[k] * ND + lane * 8;
                u0[k] = *(const uint4*)up; u1[k] = *(const uint4*)(up + 512);
            }
            float d[8];
#pragma unroll
            for (int k = 0; k < 8; ++k) {
                float a = dot2bf(u0[k].x, xp[0], 0.f), b = dot2bf(u0[k].y, xp[1], 0.f);
                a = dot2bf(u0[k].z, xp[2], a); b = dot2bf(u0[k].w, xp[3], b);
                a = dot2bf(u1[k].x, xp[4], a); b = dot2bf(u1[k].y, xp[5], b);
                a = dot2bf(u1[k].z, xp[6], a); b = dot2bf(u1[k].w, xp[7], b);
                d[k] = a + b;
            }
            const bool hi5 = lane & 32, hi4 = lane & 16, hi3 = lane & 8;
            float r4[4], r2[2], r1;
#pragma unroll
            for (int k = 0; k < 4; ++k) { const float send = hi5 ? d[k] : d[k + 4], keep = hi5 ? d[k + 4] : d[k]; r4[k] = keep + __shfl_xor(send, 32); }
#pragma unroll
            for (int k = 0; k < 2; ++k) { const float send = hi4 ? r4[k] : r4[k + 2], keep = hi4 ? r4[k + 2] : r4[k]; r2[k] = keep + __shfl_xor(send, 16); }
            { const float send = hi3 ? r2[0] : r2[1], keep = hi3 ? r2[1] : r2[0]; r1 = keep + __shfl_xor(send, 8); }
            r1 += __shfl_xor(r1, 4); r1 += __shfl_xor(r1, 2); r1 += __shfl_xor(r1, 1);
            uint4 v0[8], v1[8];
#pragma unroll
            for (int k = 0; k < 8; ++k) {
                const bf16_t* vp = vb + (size_t)exs[k] * ND + lane * 8;
                v0[k] = *(const uint4*)vp; v1[k] = *(const uint4*)(vp + 512);
            }
            const float gk = __shfl(gsel, lbase + (lane >> 3));
            const float coef = gk * gelu_fast(r1);
#pragma unroll
            for (int k = 0; k < 8; ++k) {
                const float ck = __int_as_float(__builtin_amdgcn_readlane(__float_as_int(coef), 8 * k));
                const unsigned w[8] = {v0[k].x, v0[k].y, v0[k].z, v0[k].w, v1[k].x, v1[k].y, v1[k].z, v1[k].w};
#pragma unroll
                for (int j = 0; j < 8; ++j) {
                    acc[2 * j] += ck * __uint_as_float(w[j] << 16);
                    acc[2 * j + 1] += ck * __uint_as_float(w[j] & 0xffff0000u);
                }
            }
        }
        {
            const float* rp = R + (size_t)token * ND + lane * 8;
            const float4 a0 = *(const float4*)rp, a1 = *(const float4*)(rp + 4), b0 = *(const float4*)(rp + 512), b1 = *(const float4*)(rp + 516);
            xf[0] = a0.x; xf[1] = a0.y; xf[2] = a0.z; xf[3] = a0.w; xf[4] = a1.x; xf[5] = a1.y; xf[6] = a1.z; xf[7] = a1.w;
            xf[8] = b0.x; xf[9] = b0.y; xf[10] = b0.z; xf[11] = b0.w; xf[12] = b1.x; xf[13] = b1.y; xf[14] = b1.z; xf[15] = b1.w;
        }
        float s = 0.f;
#pragma unroll
        for (int j = 0; j < 16; ++j) { xf[j] = ALPHA * xf[j] + acc[j]; s += xf[j]; }
        for (int o = 32; o; o >>= 1) s += __shfl_xor(s, o);
        const float mean = s * (1.f / ND);
        float s2 = 0.f;
#pragma unroll
        for (int j = 0; j < 16; ++j) { xf[j] -= mean; s2 += xf[j] * xf[j]; }
        for (int o = 32; o; o >>= 1) s2 += __shfl_xor(s2, o);
        const float rs = rsqrtf(s2 * (1.f / ND) + LN_EPS);
#pragma unroll
        for (int hf = 0; hf < 2; ++hf) {
            const int c0 = hf * 512 + lane * 8;
            const float4 g0 = *(const float4*)(lg + c0), g1 = *(const float4*)(lg + c0 + 4), b0 = *(const float4*)(lb + c0), b1 = *(const float4*)(lb + c0 + 4);
            float o[8];
            o[0] = xf[hf * 8 + 0] * rs * g0.x + b0.x; o[1] = xf[hf * 8 + 1] * rs * g0.y + b0.y; o[2] = xf[hf * 8 + 2] * rs * g0.z + b0.z; o[3] = xf[hf * 8 + 3] * rs * g0.w + b0.w;
            o[4] = xf[hf * 8 + 4] * rs * g1.x + b1.x; o[5] = xf[hf * 8 + 5] * rs * g1.y + b1.y; o[6] = xf[hf * 8 + 6] * rs * g1.z + b1.z; o[7] = xf[hf * 8 + 7] * rs * g1.w + b1.w;
            float* op = R + (size_t)token * ND + c0;
            *(float4*)op = make_float4(o[0], o[1], o[2], o[3]); *(float4*)(op + 4) = make_float4(o[4], o[5], o[6], o[7]);
            if (Hb) st8(Hb + (size_t)token * ND + c0, o);
        }
    }
}


__device__ __forceinline__ void peer_expert3_phase(float* R, const int* __restrict__ eidx, const float* __restrict__ egate, const unsigned char* __restrict__ ub,
                                                   const unsigned char* __restrict__ vb, const float* __restrict__ lg, const float* __restrict__ lb, bf16_t* Hb, float* Rout) {
    const int wave = tidx() >> 6, lane = tidx() & 63;
    for (int token = blockIdx.x * 8 + wave; token < NT; token += gridDim.x * 8) {
        float xf[16];
        {
            const float* rp = R + (size_t)token * ND + lane * 16;
#pragma unroll
            for (int q = 0; q < 4; ++q) { const float4 a = *(const float4*)(rp + 4 * q); xf[4 * q] = a.x; xf[4 * q + 1] = a.y; xf[4 * q + 2] = a.z; xf[4 * q + 3] = a.w; }
        }
        float acc[16];
#pragma unroll
        for (int j = 0; j < 16; ++j) acc[j] = 0.f;
        const int e_lo = eidx[(size_t)token * 128 + lane], e_hi = eidx[(size_t)token * 128 + 64 + lane];
        const float g_lo = egate[(size_t)token * 128 + lane], g_hi = egate[(size_t)token * 128 + 64 + lane];
        for (int grp = 0; grp < 16; ++grp) {
            const int esel = grp < 8 ? e_lo : e_hi;
            const float gsel = grp < 8 ? g_lo : g_hi;
            const int lbase = (grp & 7) * 8;
            uint4 u[8], v[8];
#pragma unroll
            for (int k = 0; k < 8; ++k) {
                const int ex = __builtin_amdgcn_readlane(esel, lbase + k);
                u[k] = *(const uint4*)(ub + (size_t)ex * ND + lane * 16);
                v[k] = *(const uint4*)(vb + (size_t)ex * ND + lane * 16);
            }
            float d[8];
#pragma unroll
            for (int k = 0; k < 8; ++k) {
                const unsigned w[4] = {u[k].x, u[k].y, u[k].z, u[k].w};
                float a = 0.f, b = 0.f;
#pragma unroll
                for (int q = 0; q < 4; ++q) {
                    const f32x2_t lo = __builtin_amdgcn_cvt_pk_f32_fp8((int)w[q], false), hi = __builtin_amdgcn_cvt_pk_f32_fp8((int)w[q], true);
                    a = fmaf(xf[4 * q], lo.x, a); b = fmaf(xf[4 * q + 1], lo.y, b); a = fmaf(xf[4 * q + 2], hi.x, a); b = fmaf(xf[4 * q + 3], hi.y, b);
                }
                d[k] = a + b;
            }
            const bool hi5 = lane & 32, hi4 = lane & 16, hi3 = lane & 8;
            float r4[4], r2[2], r1;
#pragma unroll
            for (int k = 0; k < 4; ++k) { const float send = hi5 ? d[k] : d[k + 4], keep = hi5 ? d[k + 4] : d[k]; r4[k] = keep + __shfl_xor(send, 32); }
#pragma unroll
            for (int k = 0; k < 2; ++k) { const float send = hi4 ? r4[k] : r4[k + 2], keep = hi4 ? r4[k + 2] : r4[k]; r2[k] = keep + __shfl_xor(send, 16); }
            { const float send = hi3 ? r2[0] : r2[1], keep = hi3 ? r2[1] : r2[0]; r1 = keep + __shfl_xor(send, 8); }
            r1 += __shfl_xor(r1, 4); r1 += __shfl_xor(r1, 2); r1 += __shfl_xor(r1, 1);
            const float gk = __shfl(gsel, lbase + (lane >> 3));
            const float coef = gk * gelu_fast(r1 * (1.f / U_SCALE)) * (1.f / V_SCALE);
#pragma unroll
            for (int k = 0; k < 8; ++k) {
                const float ck = __int_as_float(__builtin_amdgcn_readlane(__float_as_int(coef), 8 * k));
                const unsigned w[4] = {v[k].x, v[k].y, v[k].z, v[k].w};
#pragma unroll
                for (int q = 0; q < 4; ++q) {
                    const f32x2_t lo = __builtin_amdgcn_cvt_pk_f32_fp8((int)w[q], false), hi = __builtin_amdgcn_cvt_pk_f32_fp8((int)w[q], true);
                    acc[4 * q] = fmaf(ck, lo.x, acc[4 * q]); acc[4 * q + 1] = fmaf(ck, lo.y, acc[4 * q + 1]);
                    acc[4 * q + 2] = fmaf(ck, hi.x, acc[4 * q + 2]); acc[4 * q + 3] = fmaf(ck, hi.y, acc[4 * q + 3]);
                }
            }
        }
        float s = 0.f;
#pragma unroll
        for (int j = 0; j < 16; ++j) { xf[j] = ALPHA * xf[j] + acc[j]; s += xf[j]; }
        for (int o = 32; o; o >>= 1) s += __shfl_xor(s, o);
        const float mean = s * (1.f / ND);
        float s2 = 0.f;
#pragma unroll
        for (int j = 0; j < 16; ++j) { xf[j] -= mean; s2 += xf[j] * xf[j]; }
        for (int o = 32; o; o >>= 1) s2 += __shfl_xor(s2, o);
        const float rs = rsqrtf(s2 * (1.f / ND) + LN_EPS);
        float o[16];
#pragma unroll
        for (int q = 0; q < 4; ++q) {
            const float4 gg = *(const float4*)(lg + lane * 16 + 4 * q), bb = *(const float4*)(lb + lane * 16 + 4 * q);
            o[4 * q] = xf[4 * q] * rs * gg.x + bb.x; o[4 * q + 1] = xf[4 * q + 1] * rs * gg.y + bb.y; o[4 * q + 2] = xf[4 * q + 2] * rs * gg.z + bb.z; o[4 * q + 3] = xf[4 * q + 3] * rs * gg.w + bb.w;
            *(float4*)(Rout + (size_t)token * ND + lane * 16 + 4 * q) = make_float4(o[4 * q], o[4 * q + 1], o[4 * q + 2], o[4 * q + 3]);
        }
        if (Hb) { st8(Hb + (size_t)token * ND + lane * 16, o); st8(Hb + (size_t)token * ND + lane * 16 + 8, o + 8); }
    }
}

__device__ __forceinline__ void nsa_compress_phase(const bf16_t* __restrict__ proj, int coloff, const float* __restrict__ pe, const float* __restrict__ w1,
                                   const float* __restrict__ w2, float* __restrict__ outc, float* lds) {
    const int qtr = tidx() >> 7, tid = tidx() & 127;
    float* in = lds + qtr * 2176;
    float* hid = in + 2048;
    for (int it = blockIdx.x; it < NB * 127; it += gridDim.x) {
        const int g = qtr, n = it % 127, b = it / 127;
        __syncthreads();
        for (int idx = tid; idx < 2048; idx += 128) {
            const int l = idx >> 6, d = idx & 63;
            in[idx] = bf2f(proj[(size_t)(b * NL + 16 * n + l) * ODD_PAD + coloff + g * 64 + d]) + pe[l * 64 + d];
        }
        __syncthreads();
        float a = 0.f;
        for (int i = 0; i < 2048; ++i) a += in[i] * w1[(size_t)i * 128 + tid];
        hid[tid] = gelu_tanh(a);
        __syncthreads();
        if (tid < 64) {
            float o = 0.f;
            for (int j = 0; j < 128; ++j) o += hid[j] * w2[j * 64 + tid];
            outc[((size_t)(b * 127 + n) * 4 + g) * 64 + tid] = o;
        }
    }
    __syncthreads();
}

__device__ __forceinline__ void nsa_cmp_phase(const bf16_t* __restrict__ proj, const float* __restrict__ kcmp, const float* __restrict__ vcmp,
                              bf16_t* __restrict__ O, unsigned* __restrict__ selmask, float* lds) {
    const int half = tidx() >> 8, tid = tidx() & 255;
    float* kc_s = lds + half * 18368;
    float* vc_s = kc_s + 127 * 64;
    float(*imp_s)[33] = (float(*)[33])(vc_s + 127 * 64);
    const int tk = tid >> 2, r = tid & 3;
    for (int it = blockIdx.x; it < 32 * 4 * NB / 2; it += gridDim.x) {
        const int vb = it * 2 + half;
        const int tile = vb & 31, g = (vb >> 5) & 3, b = vb >> 7;
        const int t = tile * 64 + tk, hd = g * 4 + r;
        __syncthreads();
        for (int idx = tid; idx < 127 * 64; idx += 256) { const int n = idx >> 6, d = idx & 63; kc_s[idx] = kcmp[((size_t)(b * 127 + n) * 4 + g) * 64 + d]; vc_s[idx] = vcmp[((size_t)(b * 127 + n) * 4 + g) * 64 + d]; }
        const bf16_t* prow = proj + (size_t)(b * NL + t) * ODD_PAD;
        float q[64];
#pragma unroll
        for (int d = 0; d < 64; d += 8) ld8(prow + hd * 64 + d, q + d);
        const float slope = exp2f(-0.5f * (float)(hd + 1));
        int nvalid = (t >= 31) ? ((t - 31) / 16 + 1) : 0;
        if (nvalid > 127) nvalid = 127;
        __syncthreads();
        float m = -INFINITY, l = 0.f;
        for (int n = 0; n < nvalid; ++n) {
            float s = 0.f;
#pragma unroll
            for (int d = 0; d < 64; ++d) s += q[d] * kc_s[n * 64 + d];
            s = s * 0.125f - slope * (float)(t - (16 * n + 31));
            const float mn = fmaxf(m, s);
            l = l * expf(m - mn) + expf(s - mn);
            m = mn;
        }
        const float inv_l = (nvalid > 0) ? 1.f / fmaxf(l, 1e-30f) : 0.f;
        float acc[64];
#pragma unroll
        for (int d = 0; d < 64; ++d) acc[d] = 0.f;
        float prev3 = 0.f;
        for (int j = 0; j < 32; ++j) {
            float pj[4];
#pragma unroll
            for (int nn = 0; nn < 4; ++nn) {
                const int n = 4 * j + nn;
                float p = 0.f;
                if (n < nvalid) {
                    float s = 0.f;
#pragma unroll
                    for (int d = 0; d < 64; ++d) s += q[d] * kc_s[n * 64 + d];
                    s = s * 0.125f - slope * (float)(t - (16 * n + 31));
                    p = expf(s - m) * inv_l;
                    const float* vr = vc_s + n * 64;
#pragma unroll
                    for (int d = 0; d < 64; ++d) acc[d] += p * vr[d];
                }
                pj[nn] = p;
            }
            float im = 0.5f * prev3 + pj[0] + pj[1] + pj[2] + 0.5f * pj[3];
            prev3 = pj[3];
            im += __shfl_xor(im, 1);
            im += __shfl_xor(im, 2);
            if (r == 0) imp_s[tk][j] = im;
        }
        const float g0 = sigmoidf_(bf2f(prow[2048 + hd]));
#pragma unroll
        for (int d = 0; d < 64; ++d) acc[d] *= g0;
#pragma unroll
        for (int d = 0; d < 64; d += 8) st8(O + (size_t)(b * NL + t) * ND + hd * 64 + d, acc + d);
        __syncthreads();
        const int cur = tile;
        unsigned bits = 0;
        for (int jj = 0; jj < 8; ++jj) {
            const int j = r * 8 + jj;
            const bool fj = (j == 0) || (j == cur) || (j == cur - 1);
            const float vj = (j <= cur) ? imp_s[tk][j] + (fj ? 1000.f : 0.f) : -INFINITY;
            int rank = 0;
            for (int k = 0; k < 32; ++k) {
                const bool fk = (k == 0) || (k == cur) || (k == cur - 1);
                const float vk = (k <= cur) ? imp_s[tk][k] + (fk ? 1000.f : 0.f) : -INFINITY;
                rank += (vk > vj || (vk == vj && k < j)) ? 1 : 0;
            }
            if (rank < 16) bits |= 1u << j;
        }
        bits |= __shfl_xor(bits, 1);
        bits |= __shfl_xor(bits, 2);
        if (r == 0) selmask[(size_t)(b * 4 + g) * NL + t] = bits;
    }
    __syncthreads();
}

__device__ __forceinline__ void nsa_selwin_phase(const bf16_t* __restrict__ proj, const unsigned* __restrict__ selmask, bf16_t* O, float* lds) {
    const int half = tidx() >> 8, tid = tidx() & 255;
    float(*k_s)[64] = (float(*)[64])(lds + half * 8192);
    float(*v_s)[64] = (float(*)[64])(lds + half * 8192 + 4096);
    const int tk = tid >> 2, r = tid & 3;
    for (int it = blockIdx.x; it < 32 * 32; it += gridDim.x) {
        const int tile = 31 - (it >> 5);
        const int bgi = (it & 31) * 2 + half, g = bgi & 3, b = bgi >> 2;
        const int t = tile * 64 + tk, hd = g * 4 + r;
        const bf16_t* pb = proj + (size_t)b * NL * ODD_PAD;
        const bf16_t* prow = pb + (size_t)t * ODD_PAD;
        float q[64], acc[64];
#pragma unroll
        for (int d = 0; d < 64; d += 8) ld8(prow + hd * 64 + d, q + d);
        const float slope = exp2f(-0.5f * (float)(hd + 1));
        const unsigned mask = selmask[(size_t)(b * 4 + g) * NL + t];
        bf16_t* orow = O + (size_t)(b * NL + t) * ND + hd * 64;
        for (int branch = 0; branch < 2; ++branch) {
            const int kcol = (branch == 0 ? 1536 : 2048) + g * 64, vcol = kcol + 256;
            const int j0 = (branch == 0) ? 0 : (tile >= 8 ? tile - 8 : 0);
            float m = -1e30f, l = 0.f;
#pragma unroll
            for (int d = 0; d < 64; ++d) acc[d] = 0.f;
            for (int j = j0; j <= tile; ++j) {
                __syncthreads();
                for (int i = 0; i < 16; ++i) {
                    const int idx = tid + 256 * i, key = idx >> 6, d = idx & 63;
                    k_s[key][d] = bf2f(pb[(size_t)(64 * j + key) * ODD_PAD + kcol + d]);
                    v_s[key][d] = bf2f(pb[(size_t)(64 * j + key) * ODD_PAD + vcol + d]);
                }
                __syncthreads();
                const bool take = (branch == 0) ? ((mask >> j) & 1u) : true;
                if (take) {
                    for (int s = 0; s < 64; ++s) {
                        const int dist = t - (64 * j + s);
                        const bool valid = (branch == 0) ? (dist >= 0) : (dist >= 0 && dist < 512);
                        float sc = 0.f;
#pragma unroll
                        for (int d = 0; d < 64; ++d) sc += q[d] * k_s[s][d];
                        sc = sc * 0.125f - slope * (float)dist;
                        const float mn = valid ? fmaxf(m, sc) : m;
                        const float scale = expf(m - mn);
                        const float p = valid ? expf(sc - mn) : 0.f;
                        l = l * scale + p;
#pragma unroll
                        for (int d = 0; d < 64; ++d) acc[d] = acc[d] * scale + p * v_s[s][d];
                        m = mn;
                    }
                }
            }
            const float gt = sigmoidf_(bf2f(prow[2560 + (branch + 1) * 16 + hd]));
            const float f = gt / fmaxf(l, 1e-30f);
#pragma unroll
            for (int d = 0; d < 64; d += 8) {
                float o[8];
                ld8(orow + d, o);
#pragma unroll
                for (int j = 0; j < 8; ++j) o[j] += f * acc[d + j];
                st8(orow + d, o);
            }
        }
    }
    __syncthreads();
}


typedef float f32x16 __attribute__((ext_vector_type(16)));
#define MFMA32(a, b, c) __builtin_amdgcn_mfma_f32_32x32x16_bf16((a), (b), (c), 0, 0, 0)
__device__ __forceinline__ unsigned cvtpk(float lo, float hi) { const f32x2_t f = {lo, hi}; return __builtin_bit_cast(unsigned, __builtin_convertvector(f, bf16x2_t)); }
__device__ __forceinline__ int crow32(int reg, int h) { return (reg & 3) + 8 * (reg >> 2) + 4 * h; }
constexpr float LOG2E = 1.4426950408889634f;
__device__ __forceinline__ void nsa_attn_phase(const bf16_t* __restrict__ proj, const bf16_t* __restrict__ vt, const unsigned* __restrict__ selmask, bf16_t* O, unsigned char* lds) {
    const int tid = tidx(), wave = __builtin_amdgcn_readfirstlane(tid >> 6), lane = tid & 63, l31 = lane & 31, h = lane >> 5;
    const int r = wave & 3, thalf = wave >> 2;
    const int skey = tid >> 3, spart = tid & 7;
    for (int it = blockIdx.x; it < 32 * 64; it += gridDim.x) {
        const int tile = 31 - (it >> 6), bg = it & 63, g = bg & 3, b = bg >> 2;
        const int hd = g * 4 + r, tokoff = thalf * 32 + l31, tok = tile * 64 + tokoff;
        const size_t trow = (size_t)(b * NL + tok);
        const float slope = exp2f(-0.5f * (float)(hd + 1));
        bf16x8_t Qf[4];
#pragma unroll
        for (int ds = 0; ds < 4; ++ds) {
            float q[8];
            ld8(proj + trow * ODD_PAD + hd * 64 + 16 * ds + 8 * h, q);
            u32x4 w; w.x = cvtpk(q[0] * 0.125f, q[1] * 0.125f); w.y = cvtpk(q[2] * 0.125f, q[3] * 0.125f); w.z = cvtpk(q[4] * 0.125f, q[5] * 0.125f); w.w = cvtpk(q[6] * 0.125f, q[7] * 0.125f);
            Qf[ds] = __builtin_bit_cast(bf16x8_t, w);
        }
        float sc[16];
#pragma unroll
        for (int reg = 0; reg < 16; ++reg) sc[reg] = slope * (float)crow32(reg, h);
        const unsigned mymask = selmask[(size_t)(b * 4 + g) * NL + tok];
        __syncthreads();
        if (wave == 0) {
            unsigned m = selmask[(size_t)(b * 4 + g) * NL + tile * 64 + lane];
            for (int o = 32; o; o >>= 1) m |= __shfl_xor(m, o);
            if (lane == 0) *(unsigned*)(lds + 35840) = m;
        }
        __syncthreads();
        const unsigned causal = (tile == 31) ? 0xffffffffu : ((2u << tile) - 1u);
        const unsigned U = *(const unsigned*)(lds + 35840) & causal;
        float outv[32];
#pragma unroll
        for (int i = 0; i < 32; ++i) outv[i] = 0.f;
#pragma unroll 1
        for (int branch = 0; branch < 2; ++branch) {
            unsigned todo = (branch == 0) ? U : (causal & ~((1u << (tile >= 8 ? tile - 8 : 0)) - 1u));
            const bf16_t* kbase = proj + (size_t)b * NL * ODD_PAD + (branch == 0 ? 1536 : 1792) + g * 64 + (size_t)skey * ODD_PAD + 8 * spart;
            const bf16_t* vbase = vt + (size_t)(branch * 256 + g * 64 + skey) * NT + (size_t)b * NL + 8 * spart;
            float m_run = -1e30f, l_run = 0.f;
            f32x16 Oa[2];
#pragma unroll
            for (int i = 0; i < 16; ++i) { Oa[0][i] = 0.f; Oa[1][i] = 0.f; }
            int jcur = __ffs(todo) - 1; todo &= todo - 1;
            uint4 kreg = *(const uint4*)(kbase + (size_t)(64 * jcur) * ODD_PAD);
            uint4 vreg = *(const uint4*)(vbase + 64 * jcur);
            int buf = 0;
            __syncthreads();
            *(uint4*)(lds + skey * 144 + spart * 16) = kreg;
            *(uint2*)(lds + 18432 + skey * 136 + spart * 16) = make_uint2(vreg.x, vreg.y);
            *(uint2*)(lds + 18432 + skey * 136 + spart * 16 + 8) = make_uint2(vreg.z, vreg.w);
            __syncthreads();
            for (;;) {
                const int jnext = todo ? (__ffs(todo) - 1) : -1;
                todo &= todo - 1;
                if (jnext >= 0) { kreg = *(const uint4*)(kbase + (size_t)(64 * jnext) * ODD_PAD); vreg = *(const uint4*)(vbase + 64 * jnext); }
                const unsigned char* Ks = lds + buf * 9216;
                const unsigned char* Vs = lds + 18432 + buf * 8704;
                const bool mysel = (branch == 1) || ((mymask >> jcur) & 1u);
                if (__any(mysel)) {
                    const bool diag = (jcur == tile), wedge = (branch == 1) && (jcur == tile - 8);
                    const float init = mysel ? slope * (float)(64 * (jcur - tile)) : -1e30f;
                    float sv[32];
#pragma unroll
                    for (int kt = 0; kt < 2; ++kt) {
                        f32x16 acc;
                        const float i0 = init + slope * (float)(32 * kt);
#pragma unroll
                        for (int i = 0; i < 16; ++i) acc[i] = i0;
#pragma unroll
                        for (int ds = 0; ds < 4; ++ds) {
                            const bf16x8_t a = *(const bf16x8_t*)(Ks + (32 * kt + l31) * 144 + (16 * ds + 8 * h) * 2);
                            acc = MFMA32(a, Qf[ds], acc);
                        }
#pragma unroll
                        for (int reg = 0; reg < 16; ++reg) {
                            float sval = acc[reg] + sc[reg];
                            const int keyoff = 32 * kt + crow32(reg, h);
                            if (diag) sval = (keyoff <= tokoff) ? sval : -1e30f;
                            if (wedge) sval = (keyoff > tokoff) ? sval : -1e30f;
                            sv[kt * 16 + reg] = sval;
                        }
                    }
                    float mx = sv[0];
#pragma unroll
                    for (int i = 1; i < 32; ++i) mx = fmaxf(mx, sv[i]);
                    mx = fmaxf(mx, __shfl_xor(mx, 32));
                    const float m_new = fmaxf(m_run, mx), m_use = fmaxf(m_new, -1e29f);
                    const float alpha = __builtin_amdgcn_exp2f((m_run - m_use) * LOG2E);
                    const float moff = -m_use * LOG2E;
                    float psum = 0.f;
#pragma unroll
                    for (int i = 0; i < 32; ++i) { sv[i] = __builtin_amdgcn_exp2f(fmaf(sv[i], LOG2E, moff)); psum += sv[i]; }
                    l_run = l_run * alpha + psum; m_run = m_new;
#pragma unroll
                    for (int i = 0; i < 16; ++i) { Oa[0][i] *= alpha; Oa[1][i] *= alpha; }
                    bf16x8_t Pf[4];
#pragma unroll
                    for (int ks = 0; ks < 4; ++ks) {
                        u32x4 w; w.x = cvtpk(sv[ks * 8 + 0], sv[ks * 8 + 1]); w.y = cvtpk(sv[ks * 8 + 2], sv[ks * 8 + 3]); w.z = cvtpk(sv[ks * 8 + 4], sv[ks * 8 + 5]); w.w = cvtpk(sv[ks * 8 + 6], sv[ks * 8 + 7]);
                        Pf[ks] = __builtin_bit_cast(bf16x8_t, w);
                    }
#pragma unroll
                    for (int mt = 0; mt < 2; ++mt)
#pragma unroll
                        for (int ks = 0; ks < 4; ++ks) {
                            const unsigned char* vp = Vs + (32 * mt + l31) * 136 + (16 * ks + 4 * h) * 2;
                            const uint2 lo = *(const uint2*)vp, hi = *(const uint2*)(vp + 16);
                            u32x4 w; w.x = lo.x; w.y = lo.y; w.z = hi.x; w.w = hi.y;
                            Oa[mt] = MFMA32(__builtin_bit_cast(bf16x8_t, w), Pf[ks], Oa[mt]);
                        }
                }
                if (jnext < 0) break;
                *(uint4*)(lds + (buf ^ 1) * 9216 + skey * 144 + spart * 16) = kreg;
                *(uint2*)(lds + 18432 + (buf ^ 1) * 8704 + skey * 136 + spart * 16) = make_uint2(vreg.x, vreg.y);
                *(uint2*)(lds + 18432 + (buf ^ 1) * 8704 + skey * 136 + spart * 16 + 8) = make_uint2(vreg.z, vreg.w);
                __syncthreads();
                buf ^= 1; jcur = jnext;
            }
            const float l_tot = l_run + __shfl_xor(l_run, 32);
            const float gt = sigmoidf_(bf2f(proj[trow * ODD_PAD + 2048 + (branch + 1) * 16 + hd]));
            const float f = gt / fmaxf(l_tot, 1e-30f);
#pragma unroll
            for (int i = 0; i < 16; ++i) { outv[i] += f * Oa[0][i]; outv[16 + i] += f * Oa[1][i]; }
        }
        bf16_t* orow = O + trow * ND + hd * 64;
#pragma unroll
        for (int mt = 0; mt < 2; ++mt)
#pragma unroll
            for (int q4 = 0; q4 < 4; ++q4) {
                bf16_t* op = orow + 32 * mt + 8 * q4 + 4 * h;
                const uint2 old = *(const uint2*)op;
                const float o0 = __uint_as_float(old.x << 16) + outv[mt * 16 + q4 * 4 + 0], o1 = __uint_as_float(old.x & 0xffff0000u) + outv[mt * 16 + q4 * 4 + 1];
                const float o2 = __uint_as_float(old.y << 16) + outv[mt * 16 + q4 * 4 + 2], o3 = __uint_as_float(old.y & 0xffff0000u) + outv[mt * 16 + q4 * 4 + 3];
                *(uint2*)op = make_uint2(cvtpk(o0, o1), cvtpk(o2, o3));
            }
    }
    __syncthreads();
}


__device__ __forceinline__ void nsa_compress2_phase(const bf16_t* __restrict__ proj, const bf16_t* __restrict__ w1t  , const bf16_t* __restrict__ w2t  ,
                                                    const float* __restrict__ bias1  , bf16_t* __restrict__ kcmp  , bf16_t* __restrict__ vcmpT  ,
                                                    unsigned char* lds) {
    const int tid = tidx(), wave = __builtin_amdgcn_readfirstlane(tid >> 6), lane = tid & 63, fr = lane & 15, fq = lane >> 4;
    unsigned char* xs = lds;
    unsigned char* hs = lds + 34816;
    for (int it = blockIdx.x; it < 1024; it += gridDim.x) {
        const int which = it >> 9, ntile = it & 7, g = (it >> 3) & 3, b = (it >> 5) & 15;
        const int t0 = 256 * ntile, coloff = (which ? 1280 : 1024) + g * 64;
        __syncthreads();
        for (int pc = tid; pc < 272 * 8; pc += NTHR) {
            const int tk = pc >> 3, c = pc & 7;
            int tsrc = t0 + tk; tsrc = tsrc > NL - 1 ? NL - 1 : tsrc;
            *(uint4*)(xs + tk * 128 + ((c ^ ((tk >> 4) & 7)) << 4)) = *(const uint4*)(proj + (size_t)(b * NL + tsrc) * ODD_PAD + coloff + 8 * c);
        }
        __syncthreads();
        f32x4 acc = {0.f, 0.f, 0.f, 0.f};
        const bf16_t* wrow = w1t + ((size_t)which * 128 + 16 * wave + fr) * 2048 + 8 * fq;
#pragma unroll 8
        for (int ks = 0; ks < 64; ++ks) {
            const int l = ks >> 1, tk = 16 * fr + l, c = 4 * (ks & 1) + fq;
            const bf16x8_t a = *(const bf16x8_t*)(xs + tk * 128 + ((c ^ ((tk >> 4) & 7)) << 4));
            const bf16x8_t bfrag = *(const bf16x8_t*)(wrow + 32 * ks);
            acc = __builtin_amdgcn_mfma_f32_16x16x32_bf16(a, bfrag, acc, 0, 0, 0);
        }
        {
            const float bj = bias1[which * 128 + 16 * wave + fr];
#pragma unroll
            for (int reg = 0; reg < 4; ++reg) *(bf16_t*)(hs + (4 * fq + reg) * 272 + (16 * wave + fr) * 2) = f2bf(gelu_fast(acc[reg] + bj));
        }
        __syncthreads();
        if (wave < 4) {
            f32x4 o = {0.f, 0.f, 0.f, 0.f};
#pragma unroll
            for (int ks = 0; ks < 4; ++ks) {
                const bf16x8_t a = *(const bf16x8_t*)(hs + fr * 272 + (32 * ks + 8 * fq) * 2);
                const bf16x8_t bfrag = *(const bf16x8_t*)(w2t + ((size_t)which * 64 + 16 * wave + fr) * 128 + 32 * ks + 8 * fq);
                o = __builtin_amdgcn_mfma_f32_16x16x32_bf16(a, bfrag, o, 0, 0, 0);
            }
            const int c = 16 * wave + fr;
#pragma unroll
            for (int reg = 0; reg < 4; ++reg) {
                const int n = 16 * ntile + 4 * fq + reg;
                const bf16_t val = (n < 127) ? f2bf(o[reg]) : (bf16_t)0;
                if (which == 0) kcmp[((size_t)(b * 4 + g) * 128 + n) * 64 + c] = val;
                else vcmpT[((size_t)(b * 4 + g) * 64 + c) * 128 + n] = val;
            }
        }
    }
    __syncthreads();
}

__device__ __forceinline__ void nsa_cmp2_phase(const bf16_t* __restrict__ proj, const bf16_t* __restrict__ kcmp, const bf16_t* __restrict__ vcmpT,
                                               bf16_t* __restrict__ O, unsigned* __restrict__ selmask, unsigned char* lds) {
    const int tid = tidx(), wave = __builtin_amdgcn_readfirstlane(tid >> 6), lane = tid & 63, l31 = lane & 31, h = lane >> 5;
    const int r = wave & 3, thalf = wave >> 2;
    unsigned char* Kc = lds;
    unsigned char* Vc = lds + 18432;
    float* impS = (float*)(lds + 35328);
    float* invS = (float*)(lds + 35328 + 32768);
    for (int it = blockIdx.x; it < 32 * 64; it += gridDim.x) {
        const int tile = 31 - (it >> 6), bg = it & 63, g = bg & 3, b = bg >> 2;
        const int hd = g * 4 + r, tokoff = thalf * 32 + l31, tok = tile * 64 + tokoff;
        const size_t trow = (size_t)(b * NL + tok);
        const float slope = exp2f(-0.5f * (float)(hd + 1));
        __syncthreads();
#pragma unroll
        for (int i = 0; i < 2; ++i) {
            const int pc = tid + 512 * i;
            { const int row = pc >> 3, c = pc & 7; *(uint4*)(Kc + row * 144 + c * 16) = *(const uint4*)(kcmp + ((size_t)(b * 4 + g) * 128 + row) * 64 + 8 * c); }
            { const int row = pc >> 4, c = pc & 15; const uint4 v = *(const uint4*)(vcmpT + ((size_t)(b * 4 + g) * 64 + row) * 128 + 8 * c);
              *(uint2*)(Vc + row * 264 + c * 16) = make_uint2(v.x, v.y); *(uint2*)(Vc + row * 264 + c * 16 + 8) = make_uint2(v.z, v.w); }
        }
        bf16x8_t Qf[4];
#pragma unroll
        for (int ds = 0; ds < 4; ++ds) {
            float q[8];
            ld8(proj + trow * ODD_PAD + hd * 64 + 16 * ds + 8 * h, q);
            u32x4 w; w.x = cvtpk(q[0] * 0.125f, q[1] * 0.125f); w.y = cvtpk(q[2] * 0.125f, q[3] * 0.125f); w.z = cvtpk(q[4] * 0.125f, q[5] * 0.125f); w.w = cvtpk(q[6] * 0.125f, q[7] * 0.125f);
            Qf[ds] = __builtin_bit_cast(bf16x8_t, w);
        }
        int nvalid = (tok >= 31) ? ((tok - 31) / 16 + 1) : 0;
        nvalid = nvalid > 127 ? 127 : nvalid;
        __syncthreads();
        float mx = -1e30f;
#pragma unroll 1
        for (int kt = 0; kt < 4; ++kt) {
            f32x16 acc;
            const float i0 = slope * (float)(512 * kt);
#pragma unroll
            for (int i = 0; i < 16; ++i) acc[i] = i0;
#pragma unroll
            for (int ds = 0; ds < 4; ++ds) {
                const bf16x8_t a = *(const bf16x8_t*)(Kc + (32 * kt + l31) * 144 + (16 * ds + 8 * h) * 2);
                acc = MFMA32(a, Qf[ds], acc);
            }
#pragma unroll
            for (int reg = 0; reg < 16; ++reg) {
                const int n = 32 * kt + crow32(reg, h);
                const float sval = acc[reg] + slope * (float)(16 * crow32(reg, h));
                mx = fmaxf(mx, (n < nvalid) ? sval : -1e30f);
            }
        }
        mx = fmaxf(mx, __shfl_xor(mx, 32));
        const float moff = -fmaxf(mx, -1e29f) * LOG2E;
        float psum = 0.f, prev_pe = 0.f;
        f32x16 Oa[2];
#pragma unroll
        for (int i = 0; i < 16; ++i) { Oa[0][i] = 0.f; Oa[1][i] = 0.f; }
#pragma unroll 1
        for (int kt = 0; kt < 4; ++kt) {
            f32x16 acc;
            const float i0 = slope * (float)(512 * kt);
#pragma unroll
            for (int i = 0; i < 16; ++i) acc[i] = i0;
#pragma unroll
            for (int ds = 0; ds < 4; ++ds) {
                const bf16x8_t a = *(const bf16x8_t*)(Kc + (32 * kt + l31) * 144 + (16 * ds + 8 * h) * 2);
                acc = MFMA32(a, Qf[ds], acc);
            }
            float sv[16];
#pragma unroll
            for (int reg = 0; reg < 16; ++reg) {
                const int n = 32 * kt + crow32(reg, h);
                const float sval = acc[reg] + slope * (float)(16 * crow32(reg, h));
                sv[reg] = __builtin_amdgcn_exp2f(fmaf((n < nvalid) ? sval : -1e30f, LOG2E, moff));
                psum += sv[reg];
            }
#pragma unroll
            for (int q = 0; q < 4; ++q) {
                const float e = 0.5f * sv[q * 4 + 3];
                const float own = sv[q * 4] + sv[q * 4 + 1] + sv[q * 4 + 2] + e;
                const float pe = __shfl_xor(e, 32);
                impS[(r * 64 + tokoff) * 32 + 8 * kt + 2 * q + h] = own + (h ? pe : prev_pe);
                prev_pe = pe;
            }
#pragma unroll
            for (int s2 = 0; s2 < 2; ++s2) {
                u32x4 w; w.x = cvtpk(sv[s2 * 8 + 0], sv[s2 * 8 + 1]); w.y = cvtpk(sv[s2 * 8 + 2], sv[s2 * 8 + 3]); w.z = cvtpk(sv[s2 * 8 + 4], sv[s2 * 8 + 5]); w.w = cvtpk(sv[s2 * 8 + 6], sv[s2 * 8 + 7]);
                const bf16x8_t pf = __builtin_bit_cast(bf16x8_t, w);
#pragma unroll
                for (int mt = 0; mt < 2; ++mt) {
                    const unsigned char* vp = Vc + (32 * mt + l31) * 264 + (32 * kt + 16 * s2 + 4 * h) * 2;
                    const uint2 lo = *(const uint2*)vp, hi = *(const uint2*)(vp + 16);
                    u32x4 a; a.x = lo.x; a.y = lo.y; a.z = hi.x; a.w = hi.y;
                    Oa[mt] = MFMA32(__builtin_bit_cast(bf16x8_t, a), pf, Oa[mt]);
                }
            }
        }
        psum += __shfl_xor(psum, 32);
        const float inv = (nvalid > 0) ? 1.f / fmaxf(psum, 1e-30f) : 0.f;
        if (h == 0) invS[r * 64 + tokoff] = inv;
        const float g0 = sigmoidf_(bf2f(proj[trow * ODD_PAD + 2048 + hd])) * inv;
        bf16_t* orow = O + trow * ND + hd * 64;
#pragma unroll
        for (int mt = 0; mt < 2; ++mt)
#pragma unroll
            for (int q4 = 0; q4 < 4; ++q4)
                *(uint2*)(orow + 32 * mt + 8 * q4 + 4 * h) = make_uint2(cvtpk(g0 * Oa[mt][q4 * 4], g0 * Oa[mt][q4 * 4 + 1]), cvtpk(g0 * Oa[mt][q4 * 4 + 2], g0 * Oa[mt][q4 * 4 + 3]));
        __syncthreads();
        float* impT = (float*)Kc;
#pragma unroll
        for (int i = 0; i < 4; ++i) {
            const int pc = tid + 512 * i, tk = pc >> 5, j = pc & 31, cur = tile;
            const float ij = impS[(0 * 64 + tk) * 32 + j] * invS[tk] + impS[(1 * 64 + tk) * 32 + j] * invS[64 + tk] + impS[(2 * 64 + tk) * 32 + j] * invS[128 + tk] + impS[(3 * 64 + tk) * 32 + j] * invS[192 + tk];
            const bool fj = (j == 0) || (j == cur) || (j == cur - 1);
            impT[tk * 33 + j] = (j <= cur) ? ij + (fj ? 1000.f : 0.f) : -INFINITY;
        }
        __syncthreads();
        if (tid < 256) {
            const int tk = tid >> 2, rr = tid & 3;
            unsigned bits = 0;
#pragma unroll 1
            for (int jj = 0; jj < 8; ++jj) {
                const int j = rr * 8 + jj;
                const float vj = impT[tk * 33 + j];
                int rank = 0;
#pragma unroll 8
                for (int k = 0; k < 32; ++k) {
                    const float vk = impT[tk * 33 + k];
                    rank += (vk > vj || (vk == vj && k < j)) ? 1 : 0;
                }
                if (rank < 16) bits |= 1u << j;
            }
            bits |= __shfl_xor(bits, 1);
            bits |= __shfl_xor(bits, 2);
            if (rr == 0) selmask[(size_t)(b * 4 + g) * NL + tile * 64 + tk] = bits;
        }
    }
    __syncthreads();
}


constexpr int P0W = 1792;
constexpr float LN2F = 0.6931471805599453f;
__device__ __forceinline__ void sb_attn2_phase(const bf16_t* __restrict__ proj, const bf16_t* __restrict__ vt, bf16_t* __restrict__ Y, unsigned char* lds) {
    const int tid = tidx(), wave = __builtin_amdgcn_readfirstlane(tid >> 6), lane = tid & 63, l31 = lane & 31, h = lane >> 5;
    const int skey = tid >> 3, spart = tid & 7;
    for (int it = blockIdx.x; it < NB * 12 * 8; it += gridDim.x) {
        const int tile = 7 - (it / 192), bh = it % 192, hh = bh % 12, b = bh / 12;
        const int qlo = tile * 256 + 32 * wave, tq = qlo + l31;
        const size_t trow = (size_t)(b * NL + tq);
        bf16x8_t Qf[4];
#pragma unroll
        for (int ds = 0; ds < 4; ++ds) {
            float q[8];
            ld8(proj + trow * P0W + 256 + hh * 64 + 16 * ds + 8 * h, q);
            u32x4 w; w.x = cvtpk(q[0] * 0.125f, q[1] * 0.125f); w.y = cvtpk(q[2] * 0.125f, q[3] * 0.125f); w.z = cvtpk(q[4] * 0.125f, q[5] * 0.125f); w.w = cvtpk(q[6] * 0.125f, q[7] * 0.125f);
            Qf[ds] = __builtin_bit_cast(bf16x8_t, w);
        }
        const bf16_t* kbase = proj + (size_t)b * NL * P0W + 1024 + hh * 64 + (size_t)skey * P0W + 8 * spart;
        const bf16_t* vbase = vt + (size_t)(hh * 64 + skey) * NT + (size_t)b * NL + 8 * spart;
        f32x16 Oa[2];
#pragma unroll
        for (int i = 0; i < 16; ++i) { Oa[0][i] = 0.f; Oa[1][i] = 0.f; }
        float carry = 0.f;
        int j = tile * 4 + 3, buf = 0;
        uint4 kreg = *(const uint4*)(kbase + (size_t)(64 * j) * P0W);
        uint4 vreg = *(const uint4*)(vbase + 64 * j);
        __syncthreads();
        *(uint4*)(lds + skey * 144 + spart * 16) = kreg;
        *(uint2*)(lds + 18432 + skey * 136 + spart * 16) = make_uint2(vreg.x, vreg.y);
        *(uint2*)(lds + 18432 + skey * 136 + spart * 16 + 8) = make_uint2(vreg.z, vreg.w);
        __syncthreads();
        for (;;) {
            const int jn = j - 1;
            if (jn >= 0) { kreg = *(const uint4*)(kbase + (size_t)(64 * jn) * P0W); vreg = *(const uint4*)(vbase + 64 * jn); }
            const unsigned char* Ks = lds + buf * 9216;
            const unsigned char* Vs = lds + 18432 + buf * 8704;
            const bool live = (64 * j <= qlo + 30) && !__all(carry < -110.f);
            if (live) {
#pragma unroll
                for (int kti = 0; kti < 2; ++kti) {
                    const int kt = 1 - kti;
                    f32x16 acc;
#pragma unroll
                    for (int i = 0; i < 16; ++i) acc[i] = 0.f;
#pragma unroll
                    for (int ds = 0; ds < 4; ++ds) {
                        const bf16x8_t a = *(const bf16x8_t*)(Ks + (32 * kt + l31) * 144 + (16 * ds + 8 * h) * 2);
                        acc = MFMA32(a, Qf[ds], acc);
                    }
                    float m1[16], lz[16];
#pragma unroll
                    for (int reg = 0; reg < 16; ++reg) {
                        const float z = acc[reg];
                        const bool valid = (64 * j + 32 * kt + crow32(reg, h)) < tq;
                        const float e = __builtin_amdgcn_exp2f(-fabsf(z) * LOG2E);
                        const float sp = fmaxf(z, 0.f) + __builtin_amdgcn_logf(1.f + e) * LN2F;
                        m1[reg] = valid ? -sp : 0.f;
                        lz[reg] = valid ? z - sp : -1e30f;
                    }
                    float G[4], T[4];
#pragma unroll
                    for (int q = 0; q < 4; ++q) G[q] = (m1[4 * q] + m1[4 * q + 1]) + (m1[4 * q + 2] + m1[4 * q + 3]);
                    float Gp[4];
#pragma unroll
                    for (int q = 0; q < 4; ++q) { Gp[q] = __shfl_xor(G[q], 32); T[q] = G[q] + Gp[q]; }
                    float base[4];
                    base[3] = carry; base[2] = base[3] + T[3]; base[1] = base[2] + T[2]; base[0] = base[1] + T[1];
                    const float tot = base[0] + T[0];
#pragma unroll
                    for (int q = 0; q < 4; ++q) {
                        const float bq = base[q] + (h ? 0.f : Gp[q]);
                        const float t3 = bq, t2 = t3 + m1[4 * q + 3], t1 = t2 + m1[4 * q + 2], t0 = t1 + m1[4 * q + 1];
                        lz[4 * q + 3] = __builtin_amdgcn_exp2f((lz[4 * q + 3] + t3) * LOG2E);
                        lz[4 * q + 2] = __builtin_amdgcn_exp2f((lz[4 * q + 2] + t2) * LOG2E);
                        lz[4 * q + 1] = __builtin_amdgcn_exp2f((lz[4 * q + 1] + t1) * LOG2E);
                        lz[4 * q + 0] = __builtin_amdgcn_exp2f((lz[4 * q + 0] + t0) * LOG2E);
                    }
                    carry = tot;
#pragma unroll
                    for (int s2 = 0; s2 < 2; ++s2) {
                        u32x4 w; w.x = cvtpk(lz[s2 * 8 + 0], lz[s2 * 8 + 1]); w.y = cvtpk(lz[s2 * 8 + 2], lz[s2 * 8 + 3]); w.z = cvtpk(lz[s2 * 8 + 4], lz[s2 * 8 + 5]); w.w = cvtpk(lz[s2 * 8 + 6], lz[s2 * 8 + 7]);
                        const bf16x8_t pf = __builtin_bit_cast(bf16x8_t, w);
#pragma unroll
                        for (int mt = 0; mt < 2; ++mt) {
                            const unsigned char* vp = Vs + (32 * mt + l31) * 136 + (32 * kt + 16 * s2 + 4 * h) * 2;
                            const uint2 lo = *(const uint2*)vp, hi = *(const uint2*)(vp + 16);
                            u32x4 a; a.x = lo.x; a.y = lo.y; a.z = hi.x; a.w = hi.y;
                            Oa[mt] = MFMA32(__builtin_bit_cast(bf16x8_t, a), pf, Oa[mt]);
                        }
                    }
                }
            }
            if (jn >= 0) {
                *(uint4*)(lds + (buf ^ 1) * 9216 + skey * 144 + spart * 16) = kreg;
                *(uint2*)(lds + 18432 + (buf ^ 1) * 8704 + skey * 136 + spart * 16) = make_uint2(vreg.x, vreg.y);
                *(uint2*)(lds + 18432 + (buf ^ 1) * 8704 + skey * 136 + spart * 16 + 8) = make_uint2(vreg.z, vreg.w);
            }
            volatile int* flg = (volatile int*)(lds + 35840) + (j & 1) * 8;
            const int wdone = __all(carry < -110.f);
            if (lane == 0) flg[wave] = wdone;
            __syncthreads();
            const int alldone = flg[0] & flg[1] & flg[2] & flg[3] & flg[4] & flg[5] & flg[6] & flg[7];
            if (alldone || jn < 0) break;
            buf ^= 1; j = jn;
        }
        bf16_t* orow = Y + trow * ND + 256 + hh * 64;
#pragma unroll
        for (int mt = 0; mt < 2; ++mt)
#pragma unroll
            for (int q4 = 0; q4 < 4; ++q4)
                *(uint2*)(orow + 32 * mt + 8 * q4 + 4 * h) = make_uint2(cvtpk(Oa[mt][q4 * 4], Oa[mt][q4 * 4 + 1]), cvtpk(Oa[mt][q4 * 4 + 2], Oa[mt][q4 * 4 + 3]));
    }
    __syncthreads();
}

__device__ __forceinline__ void s5_scan2_phase(const bf16_t* __restrict__ proj, const float* __restrict__ lam_re, const float* __restrict__ lam_im, const float* __restrict__ log_dt,
                                               const float* __restrict__ b_re, const float* __restrict__ b_im, const float* __restrict__ c_re, const float* __restrict__ c_im,
                                               const float* __restrict__ dskip, bf16_t* __restrict__ ya, float* lds) {
    const int tid = tidx(), wave = __builtin_amdgcn_readfirstlane(tid >> 6), lane = tid & 63;
    float* cr = lds;
    float* ci = lds + 1024;
    float* Es = lds + 2048;
    float* us = lds + 3072 + wave * 512;
    float* xr = lds + 7168 + wave * 4160;
    float* xi = xr + 2080;
    for (int bg = blockIdx.x; bg < NB * 16; bg += gridDim.x) {
        const int b = bg >> 4, g = bg & 15;
        const float lr = lam_re[g * 64 + lane], li = lam_im[g * 64 + lane];
        const float dt = expf(log_dt[g]);
        const float mag = expf(lr * dt);
        const float are = mag * cosf(li * dt), aim = mag * sinf(li * dt);
        const float nr = are - 1.f, den = lr * lr + li * li;
        const float fre = (nr * lr + aim * li) / den, fim = (aim * lr - nr * li) / den;
        float bbr[16], bbi[16];
#pragma unroll
        for (int i = 0; i < 16; ++i) {
            const float br = b_re[(g * 64 + lane) * 16 + i], bi = b_im[(g * 64 + lane) * 16 + i];
            bbr[i] = fre * br - fim * bi; bbi[i] = fre * bi + fim * br;
        }
        __syncthreads();
        for (int idx = tid; idx < 1024; idx += NTHR) { cr[idx] = c_re[g * 1024 + idx]; ci[idx] = c_im[g * 1024 + idx]; }
        const bf16_t* ub = proj + (size_t)(b * NL + 256 * wave) * P0W + g * 16;
        float xre = 0.f, xim = 0.f;
        for (int c0 = 0; c0 < 256; c0 += 32) {
            wave_lds_fence();
            { float u8[8]; const int t = lane >> 1, hf = lane & 1; ld8(ub + (size_t)(c0 + t) * P0W + 8 * hf, u8);
#pragma unroll
              for (int i = 0; i < 8; ++i) us[t * 16 + 8 * hf + i] = u8[i]; }
            wave_lds_fence();
            for (int t = 0; t < 32; ++t) {
                float bur = 0.f, bui = 0.f;
#pragma unroll
                for (int i = 0; i < 16; ++i) { const float u = us[t * 16 + i]; bur += bbr[i] * u; bui += bbi[i] * u; }
                const float nre = are * xre - aim * xim + bur, nim = are * xim + aim * xre + bui;
                xre = nre; xim = nim;
            }
        }
        Es[(wave * 64 + lane) * 2] = xre; Es[(wave * 64 + lane) * 2 + 1] = xim;
        float pr = are, pi = aim;
#pragma unroll
        for (int i = 0; i < 8; ++i) { const float nr2 = pr * pr - pi * pi, ni2 = 2.f * pr * pi; pr = nr2; pi = ni2; }
        __syncthreads();
        xre = 0.f; xim = 0.f;
        for (int w2 = 0; w2 < wave; ++w2) {
            const float er = Es[(w2 * 64 + lane) * 2], ei = Es[(w2 * 64 + lane) * 2 + 1];
            const float nre = pr * xre - pi * xim + er, nim = pr * xim + pi * xre + ei;
            xre = nre; xim = nim;
        }
        const int tt = lane & 31, ih = lane >> 5;
        float dsk[8];
#pragma unroll
        for (int i = 0; i < 8; ++i) dsk[i] = dskip[g * 16 + 8 * ih + i];
        for (int c0 = 0; c0 < 256; c0 += 32) {
            wave_lds_fence();
            { float u8[8]; const int t = lane >> 1, hf = lane & 1; ld8(ub + (size_t)(c0 + t) * P0W + 8 * hf, u8);
#pragma unroll
              for (int i = 0; i < 8; ++i) us[t * 16 + 8 * hf + i] = u8[i]; }
            wave_lds_fence();
            for (int t = 0; t < 32; ++t) {
                float bur = 0.f, bui = 0.f;
#pragma unroll
                for (int i = 0; i < 16; ++i) { const float u = us[t * 16 + i]; bur += bbr[i] * u; bui += bbi[i] * u; }
                const float nre = are * xre - aim * xim + bur, nim = are * xim + aim * xre + bui;
                xre = nre; xim = nim;
                xr[t * 65 + lane] = xre; xi[t * 65 + lane] = xim;
            }
            wave_lds_fence();
            float y[8];
#pragma unroll
            for (int i = 0; i < 8; ++i) y[i] = 0.f;
            for (int p = 0; p < 64; ++p) {
                const float a = xr[tt * 65 + p], bq = xi[tt * 65 + p];
#pragma unroll
                for (int i = 0; i < 8; ++i) y[i] += cr[(8 * ih + i) * 64 + p] * a - ci[(8 * ih + i) * 64 + p] * bq;
            }
            float o[8];
#pragma unroll
            for (int i = 0; i < 8; ++i) o[i] = gelu_fast(y[i] + dsk[i] * us[tt * 16 + 8 * ih + i]);
            st8(ya + (size_t)(b * NL + 256 * wave + c0 + tt) * 256 + g * 16 + 8 * ih, o);
        }
    }
    __syncthreads();
}


__device__ __forceinline__ void glu2_phase(const bf16_t* __restrict__ ya, const bf16_t* __restrict__ wgt, const float* __restrict__ bglu, bf16_t* __restrict__ Y, unsigned char* lds) {
    const int tid = tidx(), wave = __builtin_amdgcn_readfirstlane(tid >> 6), lane = tid & 63, fr = lane & 15, fq = lane >> 4;
    __syncthreads();
    for (int pc = tid; pc < 256 * 32; pc += NTHR) { const int row = pc >> 5, c = pc & 31; *(uint4*)(lds + row * 528 + c * 16) = *(const uint4*)(wgt + row * 256 + c * 8); }
    __syncthreads();
    for (int chunk = blockIdx.x; chunk < NT / 128; chunk += gridDim.x) {
        const size_t tok = (size_t)chunk * 128 + wave * 16 + fr;
        bf16x8_t yb[8];
#pragma unroll
        for (int ks = 0; ks < 8; ++ks) yb[ks] = *(const bf16x8_t*)(ya + tok * 256 + 32 * ks + 8 * fq);
#pragma unroll 2
        for (int nt = 0; nt < 16; ++nt) {
            f32x4 acc = {0.f, 0.f, 0.f, 0.f};
#pragma unroll
            for (int ks = 0; ks < 8; ++ks) {
                const bf16x8_t a = *(const bf16x8_t*)(lds + (16 * nt + fr) * 528 + (32 * ks + 8 * fq) * 2);
                acc = __builtin_amdgcn_mfma_f32_16x16x32_bf16(a, yb[ks], acc, 0, 0, 0);
            }
            const int n0 = 16 * nt + 4 * fq;
            const uint2 yv = *(const uint2*)(ya + tok * 256 + n0);
            const float4 bb = *(const float4*)(bglu + n0);
            const float o0 = __uint_as_float(yv.x << 16) * sigmoidf_(acc[0] + bb.x), o1 = __uint_as_float(yv.x & 0xffff0000u) * sigmoidf_(acc[1] + bb.y);
            const float o2 = __uint_as_float(yv.y << 16) * sigmoidf_(acc[2] + bb.z), o3 = __uint_as_float(yv.y & 0xffff0000u) * sigmoidf_(acc[3] + bb.w);
            *(uint2*)(Y + tok * ND + n0) = make_uint2(cvtpk(o0, o1), cvtpk(o2, o3));
        }
    }
    __syncthreads();
}


__device__ __forceinline__ void cmadd(float& re, float& im, float ar, float ai, float br, float bi) {
    const float nr = fmaf(ar, re, fmaf(-ai, im, br)), ni = fmaf(ar, im, fmaf(ai, re, bi));
    re = nr; im = ni;
}
__device__ __forceinline__ void s5_scan3_phase(const bf16_t* __restrict__ proj, const float* __restrict__ lam_re, const float* __restrict__ lam_im, const float* __restrict__ log_dt,
                                               const float* __restrict__ b_re, const float* __restrict__ b_im, const float* __restrict__ c_re, const float* __restrict__ c_im,
                                               const float* __restrict__ dskip, bf16_t* __restrict__ ya, unsigned char* lds) {
    const int tid = tidx(), wave = __builtin_amdgcn_readfirstlane(tid >> 6), lane = tid & 63, l31 = lane & 31, h = lane >> 5, fr = lane & 15, fq = lane >> 4;
    unsigned char* Xs = lds + wave * 10752;
    float* Es = (float*)(lds + 86016);
    __syncthreads();
    for (int i = lane; i < 32 * 21; i += 64) *(uint4*)(Xs + i * 16) = make_uint4(0u, 0u, 0u, 0u);
    for (int bg = blockIdx.x; bg < NB * 16; bg += gridDim.x) {
        const int b = bg >> 4, g = bg & 15;
        const float dt = expf(log_dt[g]);
        float are[2], aim[2]; bf16x8_t Bre[2], Bim[2];
#pragma unroll
        for (int k = 0; k < 2; ++k) {
            const int p = 32 * k + l31;
            const float lr = lam_re[g * 64 + p], li = lam_im[g * 64 + p];
            const float mag = expf(lr * dt);
            are[k] = mag * cosf(li * dt); aim[k] = mag * sinf(li * dt);
            const float nr = are[k] - 1.f, den = lr * lr + li * li;
            const float fre = (nr * lr + aim[k] * li) / den, fim = (aim[k] * lr - nr * li) / den;
            float vr[8], vi[8];
#pragma unroll
            for (int j = 0; j < 8; ++j) {
                const float br = b_re[(g * 64 + p) * 16 + 8 * h + j], bi = b_im[(g * 64 + p) * 16 + 8 * h + j];
                vr[j] = fre * br - fim * bi; vi[j] = fre * bi + fim * br;
            }
            u32x4 w; w.x = cvtpk(vr[0], vr[1]); w.y = cvtpk(vr[2], vr[3]); w.z = cvtpk(vr[4], vr[5]); w.w = cvtpk(vr[6], vr[7]); Bre[k] = __builtin_bit_cast(bf16x8_t, w);
            w.x = cvtpk(vi[0], vi[1]); w.y = cvtpk(vi[2], vi[3]); w.z = cvtpk(vi[4], vi[5]); w.w = cvtpk(vi[6], vi[7]); Bim[k] = __builtin_bit_cast(bf16x8_t, w);
        }
        bf16x8_t Cm[5];
        {
            const float di = dskip[g * 16 + fr];
#pragma unroll
            for (int ks = 0; ks < 5; ++ks) {
                float cv[8];
#pragma unroll
                for (int j = 0; j < 8; ++j) {
                    const int kk = 32 * ks + 8 * fq + j;
                    cv[j] = kk < 64 ? c_re[(g * 16 + fr) * 64 + kk] : (kk < 128 ? -c_im[(g * 16 + fr) * 64 + kk - 64] : ((kk - 128) == fr ? di : 0.f));
                }
                u32x4 w; w.x = cvtpk(cv[0], cv[1]); w.y = cvtpk(cv[2], cv[3]); w.z = cvtpk(cv[4], cv[5]); w.w = cvtpk(cv[6], cv[7]); Cm[ks] = __builtin_bit_cast(bf16x8_t, w);
            }
        }
        float a4r[2], a4i[2], a5r[2], a5i[2], a32r[2], a32i[2], a256r[2], a256i[2];
#pragma unroll
        for (int k = 0; k < 2; ++k) {
            float pr = are[k], pi = aim[k], t;
            t = pr * pr - pi * pi; pi = 2.f * pr * pi; pr = t;
            t = pr * pr - pi * pi; pi = 2.f * pr * pi; pr = t;
            a4r[k] = pr; a4i[k] = pi;
            a5r[k] = pr * are[k] - pi * aim[k]; a5i[k] = pr * aim[k] + pi * are[k];
#pragma unroll
            for (int i = 0; i < 3; ++i) { t = pr * pr - pi * pi; pi = 2.f * pr * pi; pr = t; }
            a32r[k] = pr; a32i[k] = pi;
#pragma unroll
            for (int i = 0; i < 3; ++i) { t = pr * pr - pi * pi; pi = 2.f * pr * pi; pr = t; }
            a256r[k] = pr; a256i[k] = pi;
        }
        const bf16_t* ub = proj + (size_t)(b * NL + 256 * wave) * P0W + g * 16 + 8 * h;
        float sre[2] = {0.f, 0.f}, sim[2] = {0.f, 0.f};
#pragma unroll 1
        for (int c0 = 0; c0 < 256; c0 += 32) {
            const bf16x8_t uf = *(const bf16x8_t*)(ub + (size_t)(c0 + l31) * P0W);
#pragma unroll
            for (int k = 0; k < 2; ++k) {
                f32x16 z;
#pragma unroll
                for (int i = 0; i < 16; ++i) z[i] = 0.f;
                const f32x16 bur = MFMA32(uf, Bre[k], z), bui = MFMA32(uf, Bim[k], z);
                float er = 0.f, ei = 0.f;
#pragma unroll
                for (int reg = 0; reg < 16; ++reg) {
                    if (reg == 0) { er = bur[0]; ei = bui[0]; }
                    else if ((reg & 3) == 0) cmadd(er, ei, a5r[k], a5i[k], bur[reg], bui[reg]);
                    else cmadd(er, ei, are[k], aim[k], bur[reg], bui[reg]);
                }
                { float tr = er, ti = ei; cmadd(tr, ti, a4r[k], a4i[k], 0.f, 0.f); er = h ? er : tr; ei = h ? ei : ti; }
                er += __shfl_xor(er, 32); ei += __shfl_xor(ei, 32);
                cmadd(sre[k], sim[k], a32r[k], a32i[k], er, ei);
            }
        }
        __syncthreads();
        if (h == 0) {
#pragma unroll
            for (int k = 0; k < 2; ++k) { Es[(wave * 64 + 32 * k + l31) * 2] = sre[k]; Es[(wave * 64 + 32 * k + l31) * 2 + 1] = sim[k]; }
        }
        __syncthreads();
        float xre[2] = {0.f, 0.f}, xim[2] = {0.f, 0.f};
        for (int w2 = 0; w2 < wave; ++w2) {
#pragma unroll
            for (int k = 0; k < 2; ++k) cmadd(xre[k], xim[k], a256r[k], a256i[k], Es[(w2 * 64 + 32 * k + l31) * 2], Es[(w2 * 64 + 32 * k + l31) * 2 + 1]);
        }
#pragma unroll 1
        for (int c0 = 0; c0 < 256; c0 += 32) {
            const bf16x8_t uf = *(const bf16x8_t*)(ub + (size_t)(c0 + l31) * P0W);
            wave_lds_fence();
            *(bf16x8_t*)(Xs + l31 * 336 + 256 + 16 * h) = uf;
#pragma unroll
            for (int k = 0; k < 2; ++k) {
                f32x16 z;
#pragma unroll
                for (int i = 0; i < 16; ++i) z[i] = 0.f;
                const f32x16 bur = MFMA32(uf, Bre[k], z), bui = MFMA32(uf, Bim[k], z);
                float cr = xre[k], ci = xim[k];
#pragma unroll
                for (int q = 0; q < 4; ++q) {
                    float ar_[4], ai_[4], br_[4], bi_[4];
                    float xr_ = cr, xi_ = ci;
#pragma unroll
                    for (int r2 = 0; r2 < 4; ++r2) { cmadd(xr_, xi_, are[k], aim[k], bur[4 * q + r2], bui[4 * q + r2]); ar_[r2] = xr_; ai_[r2] = xi_; }
                    float yr_ = __shfl_xor(xr_, 32), yi_ = __shfl_xor(xi_, 32);
#pragma unroll
                    for (int r2 = 0; r2 < 4; ++r2) { cmadd(yr_, yi_, are[k], aim[k], bur[4 * q + r2], bui[4 * q + r2]); br_[r2] = yr_; bi_[r2] = yi_; }
                    const float zr_ = __shfl_xor(yr_, 32), zi_ = __shfl_xor(yi_, 32);
                    cr = h ? yr_ : zr_; ci = h ? yi_ : zi_;
#pragma unroll
                    for (int r2 = 0; r2 < 4; ++r2) {
                        const int t = 8 * q + 4 * h + r2;
                        *(bf16_t*)(Xs + t * 336 + (32 * k + l31) * 2) = f2bf(h ? br_[r2] : ar_[r2]);
                        *(bf16_t*)(Xs + t * 336 + (64 + 32 * k + l31) * 2) = f2bf(h ? bi_[r2] : ai_[r2]);
                    }
                }
                xre[k] = cr; xim[k] = ci;
            }
            wave_lds_fence();
#pragma unroll
            for (int mt = 0; mt < 2; ++mt) {
                f32x4 y = {0.f, 0.f, 0.f, 0.f};
#pragma unroll
                for (int ks = 0; ks < 5; ++ks) {
                    const bf16x8_t a = *(const bf16x8_t*)(Xs + (16 * mt + fr) * 336 + (32 * ks + 8 * fq) * 2);
                    y = __builtin_amdgcn_mfma_f32_16x16x32_bf16(a, Cm[ks], y, 0, 0, 0);
                }
#pragma unroll
                for (int reg = 0; reg < 4; ++reg)
                    ya[(size_t)(b * NL + 256 * wave + c0 + 16 * mt + 4 * fq + reg) * 256 + g * 16 + fr] = f2bf(gelu_fast(y[reg]));
            }
        }
    }
    __syncthreads();
}

struct Params {
    const float* in[29];
    float* out;
    char* ws;
    unsigned long long pad;
};

constexpr size_t SZ_PROJ = (size_t)NT * EVEN_IN * 2;
constexpr size_t SZ_VT = (size_t)768 * NT * 2;
constexpr size_t SZ_YB = (size_t)NT * ND * 2;
constexpr size_t SZ_HB = (size_t)NT * ND * 2;
constexpr size_t SZ_YA = (size_t)NT * 256 * 2;
constexpr size_t SZ_CMP = (size_t)NB * 4 * 128 * 64 * 2;
constexpr size_t SZ_SEL = (size_t)NB * 4 * NL * 4;
constexpr size_t SZ_TAB = (size_t)16384 * ND;
constexpr size_t SZ_SKB = (size_t)2 * 8 * 2 * 128 * 128 * 2;
constexpr size_t OFF_VT = SZ_PROJ, OFF_YB = OFF_VT + SZ_VT, OFF_HB = OFF_YB + SZ_YB, OFF_YA = OFF_HB + SZ_HB, OFF_KC = OFF_YA + SZ_YA, OFF_VC = OFF_KC + SZ_CMP,
                 OFF_SEL = OFF_VC + SZ_CMP, OFF_TAB = OFF_SEL + SZ_SEL, OFF_SKB = OFF_TAB + 2 * SZ_TAB, OFF_WT = OFF_SKB + SZ_SKB;
constexpr size_t WT_IN0 = 0, WT_OUT0 = WT_IN0 + (size_t)EVEN_IN * ND * 2, WT_Q0 = WT_OUT0 + (size_t)ND * ND * 2, WT_Q1 = WT_Q0 + (size_t)2048 * ND * 2,
                 WT_IN1 = WT_Q1 + (size_t)2048 * ND * 2, WT_V1 = WT_IN1 + (size_t)ODD_PAD * ND * 2, WT_OUT1 = WT_V1 + (size_t)512 * ND * 2, WT_W1 = WT_OUT1 + (size_t)ND * ND * 2, WT_W2 = WT_W1 + (size_t)2 * 128 * 2048 * 2, WT_B1 = WT_W2 + (size_t)2 * 64 * 128 * 2, WT_V0 = WT_B1 + 2 * 128 * 4, WT_GLU = WT_V0 + (size_t)768 * ND * 2, WT_END = WT_GLU + (size_t)256 * 256 * 2;
constexpr size_t OFF_BAR = OFF_WT + ((WT_END + 255) & ~(size_t)255);
constexpr size_t WS_NEED = OFF_BAR + XCD_BAR_WORDS * 4 + 256;

__device__ __forceinline__ void convert_tables(const float* __restrict__ u, const float* __restrict__ v, unsigned char* __restrict__ TAB) {
    const size_t per = (size_t)16384 * ND / 16;
    for (size_t i = (size_t)blockIdx.x * NTHR + tidx(); i < 2 * per; i += (size_t)gridDim.x * NTHR) {
        const int tb = (int)(i / per); const size_t off = (i % per) * 16;
        const float* src = (tb ? v : u) + off;
        const float sc = tb ? V_SCALE : U_SCALE;
        uint4 w; unsigned* wp = (unsigned*)&w;
#pragma unroll
        for (int q = 0; q < 4; ++q) {
            const float4 a = *(const float4*)(src + 4 * q);
            int pk = __builtin_amdgcn_cvt_pk_fp8_f32(a.x * sc, a.y * sc, 0, false);
            pk = __builtin_amdgcn_cvt_pk_fp8_f32(a.z * sc, a.w * sc, pk, true);
            wp[q] = (unsigned)pk;
        }
        *(uint4*)(TAB + (size_t)tb * 16384 * ND + off) = w;
    }
}

__global__ void __launch_bounds__(NTHR) fwd_megakernel(Params p) {
    extern __shared__ __attribute__((aligned(16))) unsigned char lds_raw[];
    float* lds = (float*)lds_raw;
    cg::grid_group grid = cg::this_grid();
    const float* x = p.in[0];
    float* R = p.out;
    char* ws = p.ws;
    bf16_t* PROJ = (bf16_t*)ws;
    bf16_t* YB = (bf16_t*)(ws + OFF_YB);
    bf16_t* HB = (bf16_t*)(ws + OFF_HB);
    bf16_t* YA = (bf16_t*)(ws + OFF_YA);
    bf16_t* WGT = (bf16_t*)(ws + OFF_WT + WT_GLU);
    bf16_t* KCMP = (bf16_t*)(ws + OFF_KC);
    bf16_t* VCMP = (bf16_t*)(ws + OFF_VC);
    bf16_t* W1T = (bf16_t*)(ws + OFF_WT + WT_W1);
    bf16_t* W2T = (bf16_t*)(ws + OFF_WT + WT_W2);
    float* BIAS1 = (float*)(ws + OFF_WT + WT_B1);
    unsigned* SEL = (unsigned*)(ws + OFF_SEL);
    bf16_t* WIN0 = (bf16_t*)(ws + OFF_WT + WT_IN0);
    bf16_t* WOUT0 = (bf16_t*)(ws + OFF_WT + WT_OUT0);
    bf16_t* WQ0 = (bf16_t*)(ws + OFF_WT + WT_Q0);
    bf16_t* WQ1 = (bf16_t*)(ws + OFF_WT + WT_Q1);
    bf16_t* WIN1 = (bf16_t*)(ws + OFF_WT + WT_IN1);
    bf16_t* WOUT1 = (bf16_t*)(ws + OFF_WT + WT_OUT1);
    bf16_t* WV1 = (bf16_t*)(ws + OFF_WT + WT_V1);
    bf16_t* VT = (bf16_t*)(ws + OFF_VT);
    bf16_t* WV0 = (bf16_t*)(ws + OFF_WT + WT_V0);
    int* EIDX = (int*)YB;
    float* EGATE = (float*)((char*)YB + (size_t)NT * 128 * 4);
    unsigned char* TAB = (unsigned char*)(ws + OFF_TAB);
    bf16_t* SKB = (bf16_t*)(ws + OFF_SKB);
    const int wave = tidx() >> 6;
    if (tidx() == 0) *(uint4*)(lds_raw + LDS_BYTES - 16) = make_uint4(0u, 0u, 0u, 0u);
    __syncthreads();
    XcdBarrier xbar = xcd_barrier_post((unsigned*)(ws + OFF_BAR), (volatile LAS unsigned*)(lds_raw + LDS_BYTES - 16));

    for (size_t i = (size_t)blockIdx.x * NTHR + tidx(); i < (size_t)NT * ND / 4; i += (size_t)gridDim.x * NTHR) {
        const float4 v = ((const float4*)x)[i];
        ((float4*)R)[i] = v;
        uint2 w; w.x = pack2(v.x, v.y); w.y = pack2(v.z, v.w);
        ((uint2*)HB)[i] = w;
    }
    convert_tables(p.in[23], p.in[24], TAB);
    for (int i = blockIdx.x * NTHR + tidx(); i < 2 * 8 * 2 * 128 * 128 / 4; i += gridDim.x * NTHR) {
        const float4 a = ((const float4*)p.in[22])[i];
        uint2 w; w.x = pack2(a.x, a.y); w.y = pack2(a.z, a.w);
        ((uint2*)SKB)[i] = w;
    }
    convert_wt_phase(p.in[1], ND, EVEN_IN, P0W, ColMap{{0, 0, 0}, {0, 0, 0}, {P0W, 0, 0}}, WIN0, lds);
    convert_wt_phase(p.in[1], ND, EVEN_IN, 768, ColMap{{0, 0, 0}, {P0W, 0, 0}, {768, 0, 0}}, WV0, lds);
    convert_wt_phase(p.in[12], ND, ND, ND, ColMap{{0, 0, 0}, {0, 0, 0}, {ND, 0, 0}}, WOUT0, lds);
    convert_wt_phase(p.in[10], 256, 256, 256, ColMap{{0, 0, 0}, {0, 0, 0}, {256, 0, 0}}, WGT, lds);
    convert_wt_phase(p.in[21], ND, 2048, 2048, ColMap{{0, 0, 0}, {0, 0, 0}, {2048, 0, 0}}, WQ0, lds);
    convert_wt_phase(p.in[21] + (size_t)ND * 2048, ND, 2048, 2048, ColMap{{0, 0, 0}, {0, 0, 0}, {2048, 0, 0}}, WQ1, lds);
    convert_wt_phase(p.in[13], ND, ODD_IN, ODD_PAD, ColMap{{0, 1792, 2048}, {0, 2048, 2560}, {1792, 256, 48}}, WIN1, lds);
    convert_wt_phase(p.in[13], ND, ODD_IN, 512, ColMap{{0, 256, 0}, {1792, 2304, 0}, {256, 256, 0}}, WV1, lds);
    convert_wt_phase(p.in[20], ND, ND, ND, ColMap{{0, 0, 0}, {0, 0, 0}, {ND, 0, 0}}, WOUT1, lds);
    convert_wt_phase(p.in[15], 2048, 128, 128, ColMap{{0, 0, 0}, {0, 0, 0}, {128, 0, 0}}, W1T, lds);
    convert_wt_phase(p.in[18], 2048, 128, 128, ColMap{{0, 0, 0}, {0, 0, 0}, {128, 0, 0}}, W1T + 128 * 2048, lds);
    convert_wt_phase(p.in[16], 128, 64, 64, ColMap{{0, 0, 0}, {0, 0, 0}, {64, 0, 0}}, W2T, lds);
    convert_wt_phase(p.in[19], 128, 64, 64, ColMap{{0, 0, 0}, {0, 0, 0}, {64, 0, 0}}, W2T + 64 * 128, lds);
    if (blockIdx.x < 2 && tidx() < 128) {
        const float* pe = blockIdx.x ? p.in[17] : p.in[14];
        const float* w1 = blockIdx.x ? p.in[18] : p.in[15];
        float a = 0.f;
        for (int i = 0; i < 2048; ++i) a += pe[i] * w1[(size_t)i * 128 + tidx()];
        BIAS1[blockIdx.x * 128 + tidx()] = a;
    }
    grid.sync();
    PDUP(0) { PH(0) gemm_bf16_phase(lds_raw, HB, WIN0, NT, P0W, ND, EpiBf16s{PROJ, P0W});
    PH(0) gemm_bf16_phase(lds_raw, WV0, HB, 768, NT, ND, EpiBf16s{VT, NT}); }
    xcd_barrier(xbar);
    PDUP(1) { PH(1) s5_scan3_phase(PROJ, p.in[2], p.in[3], p.in[4], p.in[5], p.in[6], p.in[7], p.in[8], p.in[9], YA, lds_raw);
    PH(2) sb_attn2_phase(PROJ, VT, YB, lds_raw);
    if ((PROBE >> 13) & 1) {
        bf16_t* SCR = PROJ + (size_t)NT * P0W;
        s5_scan2_phase(PROJ, p.in[2], p.in[3], p.in[4], p.in[5], p.in[6], p.in[7], p.in[8], p.in[9], SCR, lds);
        xcd_barrier(xbar);
        float d2 = 0.f, n2 = 0.f;
        for (size_t i = (size_t)blockIdx.x * NTHR + tidx(); i < (size_t)NT * 256; i += (size_t)gridDim.x * NTHR) { const float a = bf2f(YA[i]), r = bf2f(SCR[i]); d2 += (a - r) * (a - r); n2 += r * r; }
        for (int o = 32; o; o >>= 1) { d2 += __shfl_xor(d2, o); n2 += __shfl_xor(n2, o); }
        float* chk = (float*)(ws + OFF_BAR + XCD_BAR_WORDS * 4);
        if ((tidx() & 63) == 0) { atomicAdd(chk, d2); atomicAdd(chk + 1, n2); }
    }
    if (_rep == 0 && ((PROBE >> 1) & 1)) xcd_barrier(xbar); }
    xcd_barrier(xbar);
    PDUP(2) PH(3) glu2_phase(YA, WGT, p.in[11], YB, lds_raw);
    xcd_barrier(xbar);
    if ((PROBE >> 3) & 1) { gemm_bf16_phase(lds_raw, YB, WOUT0, NT, ND, ND, EpiRes{R, ND, ALPHA, (float*)PROJ}); xcd_barrier(xbar); }
    PH(4) gemm_bf16_phase(lds_raw, YB, WOUT0, NT, ND, ND, EpiRes{R, ND, ALPHA, R});
    xcd_barrier(xbar);
    PH(5) ln_phase(R, HB, p.in[25], p.in[26]);
    xcd_barrier(xbar);
#define PEER_FFN(layer, WQ, last) \
    PDUP(0) PH(12) gemm_bf16_phase(lds_raw, HB, WQ, NT, 2048, ND, EpiBf16s{PROJ, 2048}); \
    xcd_barrier(xbar); \
    PDUP(4) PH(13) peer_route2_phase(PROJ, SKB + (size_t)(layer) * 8 * 2 * 128 * 128, EIDX, EGATE, lds_raw); \
    xcd_barrier(xbar); \
    if ((PROBE >> 5) & 1) { peer_expert3_phase(R, EIDX, EGATE, TAB, TAB + (size_t)16384 * ND, p.in[27] + (layer) * ND, p.in[28] + (layer) * ND, nullptr, (float*)PROJ); xcd_barrier(xbar); } \
    PH(14) peer_expert3_phase(R, EIDX, EGATE, TAB, TAB + (size_t)16384 * ND, p.in[27] + (layer) * ND, p.in[28] + (layer) * ND, (last) ? nullptr : HB, R); \
    if (!(last)) xcd_barrier(xbar);
    PEER_FFN(0, WQ0, false)
    convert_tables(p.in[23] + (size_t)16384 * ND, p.in[24] + (size_t)16384 * ND, TAB);
    PDUP(0) { PH(6) gemm_bf16_phase(lds_raw, HB, WIN1, NT, ODD_PAD, ND, EpiBf16s{PROJ, ODD_PAD});
    PH(6) gemm_bf16_phase(lds_raw, WV1, HB, 512, NT, ND, EpiBf16s{VT, NT}); }
    xcd_barrier(xbar);
    PDUP(6) PH(7) nsa_compress2_phase(PROJ, W1T, W2T, BIAS1, KCMP, VCMP, lds_raw);
    xcd_barrier(xbar);
    PDUP(7) { PH(8) nsa_cmp2_phase(PROJ, KCMP, VCMP, YB, SEL, lds_raw);
    xcd_barrier(xbar);
    PH(9) nsa_attn_phase(PROJ, VT, SEL, YB, lds_raw);
    if (_rep == 0 && ((PROBE >> 7) & 1)) xcd_barrier(xbar); }
    xcd_barrier(xbar);
    if ((PROBE >> 3) & 1) { gemm_bf16_phase(lds_raw, YB, WOUT1, NT, ND, ND, EpiRes{R, ND, ALPHA, (float*)PROJ}); xcd_barrier(xbar); }
    PH(10) gemm_bf16_phase(lds_raw, YB, WOUT1, NT, ND, ND, EpiRes{R, ND, ALPHA, R});
    xcd_barrier(xbar);
    PH(11) ln_phase(R, HB, p.in[25] + ND, p.in[26] + ND);
    xcd_barrier(xbar);
    PEER_FFN(1, WQ1, true)
    if ((PROBE >> 13) & 1) {
        xcd_barrier(xbar);
        const float* chk = (const float*)(ws + OFF_BAR + XCD_BAR_WORDS * 4);
        const float d2 = __hip_atomic_load(chk, __ATOMIC_RELAXED, __HIP_MEMORY_SCOPE_AGENT), n2 = __hip_atomic_load(chk + 1, __ATOMIC_RELAXED, __HIP_MEMORY_SCOPE_AGENT);
        if (!(d2 <= 1e-4f * n2)) for (size_t i = (size_t)blockIdx.x * NTHR + tidx(); i < (size_t)NT * ND; i += (size_t)gridDim.x * NTHR) R[i] *= 2.f;
    }
}

}

extern "C" void kernel_launch(void* const* d_in, const int* in_sizes, int n_in, void* d_out, int out_size, void* d_ws, size_t ws_size, hipStream_t stream) {
    static int grid_blocks = 0;
    if (grid_blocks == 0) {
        if (n_in != 29 || out_size != NT * ND || ws_size < WS_NEED) { fprintf(stderr, "kernel_launch: unexpected shapes / workspace (%zu < %zu)\n", ws_size, (size_t)WS_NEED); grid_blocks = -1; return; }
        int dev = 0, cus = 0, per_cu = 0;
        hipGetDevice(&dev);
        hipDeviceGetAttribute(&cus, hipDeviceAttributeMultiprocessorCount, dev);
        hipFuncSetAttribute((const void*)fwd_megakernel, hipFuncAttributeMaxDynamicSharedMemorySize, LDS_BYTES);
        hipOccupancyMaxActiveBlocksPerMultiprocessor(&per_cu, (const void*)fwd_megakernel, NTHR, LDS_BYTES);
        if (per_cu < 1) { fprintf(stderr, "kernel_launch: occupancy query says %d blocks/CU\n", per_cu); grid_blocks = -1; return; }
        grid_blocks = cus;
    }
    if (grid_blocks < 0) return;
    hipMemsetAsync((char*)d_ws + OFF_BAR, 0, XCD_BAR_WORDS * 4 + 256, stream);
    Params p{};
    for (int i = 0; i < 29; ++i) p.in[i] = (const float*)d_in[i];
    p.out = (float*)d_out; p.ws = (char*)d_ws; p.pad = 0;
    void* args[] = {&p};
    hipError_t e = hipLaunchCooperativeKernel((const void*)fwd_megakernel, dim3(grid_blocks), dim3(NTHR), args, LDS_BYTES, stream);
    if (e != hipSuccess) fprintf(stderr, "cooperative launch failed: %s (grid %d)\n", hipGetErrorString(e), grid_blocks);
}
```

```cpp
#include <hip/hip_runtime.h>
#include <hip/hip_cooperative_groups.h>
#include <math.h>
#include <stdint.h>
#include <cstdio>
namespace cg = cooperative_groups;

__device__ __forceinline__ int tidx() { int t = threadIdx.x; asm volatile("" : "+v"(t)); return t; }
#define XB_TMO      128
#define XB_XCNT(j)  (256  + 64 * (j))
#define XB_XSUB(j)  (1280 + 64 * (j))
#define XB_XGEN(j)  (2304 + 64 * (j))
#define XB_TOP      3328
#define XB_TOPGEN   3392
#define XCD_BAR_WORDS 3456
#define XB_SPIN_CAP (1u << 18)
#define LAS __attribute__((address_space(3)))

__device__ __forceinline__ unsigned xb_ld(unsigned* p)              { return __hip_atomic_load(p, __ATOMIC_RELAXED, __HIP_MEMORY_SCOPE_AGENT); }
__device__ __forceinline__ unsigned xb_add(unsigned* p, unsigned v) { return __hip_atomic_fetch_add(p, v, __ATOMIC_RELAXED, __HIP_MEMORY_SCOPE_AGENT); }
__device__ __forceinline__ unsigned xb_xcc_id() { return (unsigned)__builtin_amdgcn_s_getreg((3 << 11) | 20) & 0xFu; }
#define XB_SPIN(cond, bar) do { unsigned _sp = 0; while (cond) { __builtin_amdgcn_s_sleep(1); \
    if ((++_sp & 255u) == 0u) { if (xb_ld(&(bar)[XB_TMO])) break; if (_sp > XB_SPIN_CAP) { atomicAdd(&(bar)[XB_TMO], 1u); break; } } } } while (0)

struct XcdBarrier {
    unsigned* bar; unsigned x;
    volatile LAS unsigned* st;
};

__device__ __forceinline__ XcdBarrier xcd_barrier_post(unsigned* bar, volatile LAS unsigned* st) {
    XcdBarrier b; b.bar = bar; b.x = xb_xcc_id(); b.st = st;
    if (tidx() == 0) (void)xb_add(&bar[XB_XCNT(b.x)], 1u);
    return b;
}
__device__ __forceinline__ void xcd_barrier_complete(unsigned* bar, unsigned x, unsigned& nloc, unsigned& nx) {
    const unsigned G = gridDim.x * gridDim.y * gridDim.z;
    unsigned sum, cnt, mine, sp = 0u;
    for (;;) {
        sum = 0u; cnt = 0u; mine = 0u;
#pragma unroll
        for (unsigned j = 0; j < 16; ++j) { const unsigned c = xb_ld(&bar[XB_XCNT(j)]); sum += c; cnt += (c > 0u) ? 1u : 0u; mine = (j == x) ? c : mine; }
        if (sum == G) break;
        __builtin_amdgcn_s_sleep(1);
        if ((++sp & 255u) == 0u) { if (xb_ld(&bar[XB_TMO])) break; if (sp > XB_SPIN_CAP) { atomicAdd(&bar[XB_TMO], 1u); break; } }
    }
    nloc = mine > 0u ? mine : 1u; nx = cnt > 0u ? cnt : 1u;
}

__device__ __forceinline__ void xcd_barrier(const XcdBarrier& b) {
    asm volatile("s_waitcnt vmcnt(0)" ::: "memory");
    __syncthreads();
    if (tidx() == 0) {
        unsigned* bar = b.bar;
        __builtin_amdgcn_s_waitcnt(0);
        unsigned nloc = b.st[0], nx = b.st[1];
        if (nloc == 0u) { xcd_barrier_complete(bar, b.x, nloc, nx); b.st[0] = nloc; b.st[1] = nx; }
        const unsigned old = xb_add(&bar[XB_XSUB(b.x)], 1u);
        const unsigned gen = old / nloc;
        if (old + 1u == (gen + 1u) * nloc) {
            __builtin_amdgcn_fence(__ATOMIC_RELEASE, "agent");
            asm volatile("s_waitcnt vmcnt(0)" ::: "memory");
            const unsigned og = xb_add(&bar[XB_TOP], 1u);
            const unsigned tg = og / nx;
            if (og + 1u == (tg + 1u) * nx) xb_add(&bar[XB_TOPGEN], 1u);
            else XB_SPIN(xb_ld(&bar[XB_TOPGEN]) == tg, bar);
            __builtin_amdgcn_fence(__ATOMIC_ACQUIRE, "agent");
            xb_add(&bar[XB_XGEN(b.x)], 1u);
            asm volatile("s_waitcnt vmcnt(0)" ::: "memory");
        } else {
            XB_SPIN(xb_ld(&bar[XB_XGEN(b.x)]) == gen, bar);
            __builtin_amdgcn_fence(__ATOMIC_ACQUIRE, "agent");
            asm volatile("s_waitcnt vmcnt(0)" ::: "memory");
        }
    }
    __syncthreads();
}

namespace pg8 {
#define PG8_LAS __attribute__((address_space(3)))
typedef unsigned short bf16_t;
typedef short bf16x8 __attribute__((ext_vector_type(8)));
typedef float f32x4 __attribute__((ext_vector_type(4)));
typedef unsigned u32x4 __attribute__((ext_vector_type(4)));
constexpr int BM = 256, BK = 64, HALF = 128, HTB = HALF * BK * 2  , STAGE_BYTES = 8 * HTB, NXCD = 8, WGM = 8;

__host__ __device__ __forceinline__ int lds_byte(int r, int c) { const int st = (r >> 4) * 2 + (c >> 5), rr = r & 15, cc = c & 31, ob = rr * 64 + cc * 2; return st * 1024 + (ob ^ (((ob >> 9) & 1) << 5)); }
__host__ __device__ __forceinline__ void stage_rc(int b, int& R, int& C) { const int st = b / 1024, sb = b % 1024, swz = sb ^ (((sb >> 9) & 1) << 5); R = (st >> 1) * 16 + swz / 64; C = (st & 1) * 32 + (swz % 64) / 2; }
__host__ __device__ __forceinline__ int perm32(int rho) { const int n = rho >> 4, i = rho & 15; return 8 * (i >> 2) + 4 * n + (i & 3); }

struct Unit { int pm, pn; };
struct Gemm { const bf16_t* A; const bf16_t* Bt; int M, N, K; };

struct StaticOrder {
    int nM, nN, nwg, G, c;
    __host__ __device__ void init(int M, int N, int G_, int c_) { nM = M / BM; nN = N / BM; nwg = nM * nN; G = G_; c = c_; }
    __host__ __device__ bool next(int i, Unit& u) const {
        const long L = (long)i * G + c; if (L >= nwg) return false;
        int wgid = (int)L; { const int q = nwg / NXCD, r = nwg % NXCD, xcd = wgid % NXCD, off = wgid / NXCD; wgid = (xcd < r ? xcd * (q + 1) : r * (q + 1) + (xcd - r) * q) + off; }
        const int nig = WGM * nN, gid = wgid / nig, fm = gid * WGM, gsz = (nM - fm) < WGM ? (nM - fm) : WGM;
        u.pm = fm + ((wgid % nig) % gsz); u.pn = (wgid % nig) / gsz; return true;
    }
    __device__ __forceinline__ void a_ready(const Unit&) const {}
    __device__ __forceinline__ void done(const Unit&) const {}
};
__device__ __forceinline__ unsigned cvt_pk_bf16(float lo, float hi) { unsigned r; asm volatile("v_cvt_pk_bf16_f32 %0, %1, %2" : "=v"(r) : "v"(lo), "v"(hi)); return r; }
template <class Epi, class Sched, bool STAMP = false>
__device__ __forceinline__ void gemm_phase(PG8_LAS unsigned char* lds, const Gemm g, const Sched& S, const Epi& E, unsigned long long* stamps) {
    const int tid = tidx(), wid = __builtin_amdgcn_readfirstlane(tid >> 6), lane = tid & 63, wr = wid >> 2, wc = wid & 3, fr = lane & 15, fq = lane >> 4;
    const int K = g.K, nt = K / BK;
    int ts_lo = 0, ts_hi = 0, nts = 0; const unsigned long long rt_entry = STAMP ? (unsigned long long)wall_clock64() : 0ull;
#define PG8_STAMP() do { if (STAMP && wid == 0 && nts < 64) { const unsigned long long _c = (unsigned long long)clock64(); \
        ts_lo = (lane == nts) ? (int)(unsigned)_c : ts_lo; ts_hi = (lane == nts) ? (int)(unsigned)(_c >> 32) : ts_hi; ++nts; } } while (0)
    PG8_STAMP();
    unsigned voffA[2], voffB[2];
#pragma unroll
    for (int i = 0; i < 2; ++i) { int R, C; stage_rc(tid * 16 + i * 8192, R, C); const int Rb = Epi::PERM ? ((R & ~31) + perm32(R & 31)) : R;
        voffA[i] = (unsigned)(R * K + C) * 2u; voffB[i] = (unsigned)(Rb * K + C) * 2u; }
    const size_t kstep = (size_t)(BK * 2);
    const size_t hstep = (size_t)HALF * K * 2;
    const size_t tstep = 2 * hstep;
    const unsigned ldsw = (unsigned)wid * 1024u;
    const int aoff = lds_byte(wr * 64 + fr, fq * 8), boff = lds_byte(wc * 32 + fr, fq * 8);
#define PG8_SA(b, h) (((b) * 2 + (h)) * HTB)
#define PG8_SB(b, h) ((4 + (b) * 2 + (h)) * HTB)
#define PG8_STAGE(bufoff, gbase, voff) do { _Pragma("unroll") for (int _i = 0; _i < 2; ++_i) \
        __builtin_amdgcn_global_load_lds((const unsigned*)((const char*)(gbase) + (voff)[_i]), (PG8_LAS unsigned*)(lds + (bufoff) + ldsw + _i * 8192), 16, 0, 0); } while (0)
#define PG8_LDA(dst, b, h) do { _Pragma("unroll") for (int m = 0; m < 4; ++m) _Pragma("unroll") for (int k = 0; k < 2; ++k) dst[m][k] = *(const PG8_LAS bf16x8*)(lds + PG8_SA(b, h) + aoff + m * 2048 + k * 1024); } while (0)
#define PG8_LDB(dst, b, h) do { _Pragma("unroll") for (int n = 0; n < 2; ++n) _Pragma("unroll") for (int k = 0; k < 2; ++k) dst[n][k] = *(const PG8_LAS bf16x8*)(lds + PG8_SB(b, h) + boff + n * 2048 + k * 1024); } while (0)
#define PG8_MMA(ai, bj, At, Bt) do { __builtin_amdgcn_s_setprio(1); _Pragma("unroll") for (int m = 0; m < 4; ++m) _Pragma("unroll") for (int n = 0; n < 2; ++n) _Pragma("unroll") for (int k = 0; k < 2; ++k) \
        acc[ai][bj][m][n] = __builtin_amdgcn_mfma_f32_16x16x32_bf16(Bt[n][k], At[m][k], acc[ai][bj][m][n], 0, 0, 0); __builtin_amdgcn_s_setprio(0); } while (0)
#define PG8_WAIT_V(n) asm volatile("s_waitcnt vmcnt(" #n ")" ::: "memory")
#define PG8_WAIT_L(n) asm volatile("s_waitcnt lgkmcnt(" #n ")" ::: "memory")
#define PG8_BAR __builtin_amdgcn_s_barrier()
#define PG8_SCHED __builtin_amdgcn_sched_barrier(0)
    Unit cur, nxt; int ui = 0;
    if (!S.next(0, cur)) return;
    f32x4 acc[2][2][4][2];
#pragma unroll
    for (int a = 0; a < 2; ++a)
#pragma unroll
        for (int b = 0; b < 2; ++b)
#pragma unroll
            for (int m = 0; m < 4; ++m)
#pragma unroll
                for (int n = 0; n < 2; ++n) acc[a][b][m][n] = (f32x4){0.f, 0.f, 0.f, 0.f};
    bf16x8 At[4][2], B0[2][2], B1[2][2];
    const char* cA = (const char*)g.A + (size_t)cur.pm * tstep; const char* cB = (const char*)g.Bt + (size_t)cur.pn * tstep;
    S.a_ready(cur);
    PG8_STAGE(PG8_SB(0, 0), cB, voffB); PG8_STAGE(PG8_SA(0, 0), cA, voffA); PG8_STAGE(PG8_SB(0, 1), cB + hstep, voffB); PG8_STAGE(PG8_SA(0, 1), cA + hstep, voffA);
    if (wr == 1) PG8_BAR;
    PG8_WAIT_V(4); PG8_BAR;
    PG8_STAGE(PG8_SB(1, 0), cB + kstep, voffB); PG8_STAGE(PG8_SA(1, 0), cA + kstep, voffA); PG8_STAGE(PG8_SB(1, 1), cB + hstep + kstep, voffB);
    PG8_WAIT_V(6); PG8_BAR;
    PG8_STAMP();
    for (;;) {
        const bool has_next = S.next(ui + 1, nxt);
        const char* nA = has_next ? (const char*)g.A + (size_t)nxt.pm * tstep : cA; const char* nB = has_next ? (const char*)g.Bt + (size_t)nxt.pn * tstep : cB;
        for (int t = 0; t < nt; t += 2) {
            const bool last = (t == nt - 2);
            const char* a1 = cA + (size_t)(t + 1) * kstep;
            const char* a2 = last ? nA : cA + (size_t)(t + 2) * kstep; const char* b2 = last ? nB : cB + (size_t)(t + 2) * kstep;
            const char* a3 = a2 + kstep; const char* b3 = b2 + kstep;
            if (last && has_next) S.a_ready(nxt);
            PG8_LDB(B0, 0, 0); PG8_SCHED; PG8_LDA(At, 0, 0); PG8_STAGE(PG8_SA(1, 1), a1 + hstep, voffA);
            PG8_WAIT_L(8); PG8_BAR; PG8_WAIT_L(0); PG8_MMA(0, 0, At, B0); PG8_BAR; PG8_SCHED;
            PG8_LDB(B1, 0, 1); PG8_STAGE(PG8_SB(0, 0), b2, voffB);
            PG8_BAR; PG8_WAIT_L(0); PG8_MMA(0, 1, At, B1); PG8_BAR;
            PG8_LDA(At, 0, 1); PG8_STAGE(PG8_SA(0, 0), a2, voffA);
            PG8_BAR; PG8_WAIT_L(0); PG8_MMA(1, 0, At, B0); PG8_BAR; PG8_SCHED;
            PG8_STAGE(PG8_SB(0, 1), b2 + hstep, voffB);
            PG8_WAIT_V(6); PG8_BAR; PG8_MMA(1, 1, At, B1); PG8_BAR;
            PG8_LDB(B0, 1, 0); PG8_SCHED; PG8_LDA(At, 1, 0); PG8_STAGE(PG8_SA(0, 1), a2 + hstep, voffA);
            PG8_WAIT_L(8); PG8_BAR; PG8_WAIT_L(0); PG8_MMA(0, 0, At, B0); PG8_BAR; PG8_SCHED;
            PG8_LDB(B1, 1, 1); PG8_STAGE(PG8_SB(1, 0), b3, voffB);
            PG8_BAR; PG8_WAIT_L(0); PG8_MMA(0, 1, At, B1); PG8_BAR;
            PG8_LDA(At, 1, 1); PG8_STAGE(PG8_SA(1, 0), a3, voffA);
            PG8_BAR; PG8_WAIT_L(0); PG8_MMA(1, 0, At, B0); PG8_BAR; PG8_SCHED;
            PG8_STAGE(PG8_SB(1, 1), b3 + hstep, voffB);
            PG8_WAIT_V(6); PG8_BAR; PG8_MMA(1, 1, At, B1); PG8_BAR;
        }
        PG8_STAMP();
        if constexpr (!Epi::AFTER_DRAIN) { E(acc, cur, wr, wc, fr, fq); S.done(cur); }
        PG8_STAMP();
        if (!has_next) break;
#pragma unroll
        for (int a = 0; a < 2; ++a)
#pragma unroll
            for (int b = 0; b < 2; ++b)
#pragma unroll
                for (int m = 0; m < 4; ++m)
#pragma unroll
                    for (int n = 0; n < 2; ++n) acc[a][b][m][n] = (f32x4){0.f, 0.f, 0.f, 0.f};
        cur = nxt; cA = nA; cB = nB; ++ui;
    }
    PG8_WAIT_V(0);
    if (wr == 0) PG8_BAR;
    PG8_BAR;
    if constexpr (Epi::AFTER_DRAIN) { E.fused(acc, cur, wr, wc, fr, fq, lds, wid, lane); S.done(cur); }
    PG8_STAMP();
    if (STAMP && wid == 0) { stamps[lane] = lane < nts ? (((unsigned long long)(unsigned)ts_hi << 32) | (unsigned)ts_lo) : 0ull;
        if (lane == 62) stamps[62] = rt_entry; if (lane == 63) stamps[63] = (unsigned long long)wall_clock64(); }
#undef PG8_STAMP
#undef PG8_SA
#undef PG8_SB
#undef PG8_STAGE
#undef PG8_LDA
#undef PG8_LDB
#undef PG8_MMA
#undef PG8_WAIT_V
#undef PG8_WAIT_L
#undef PG8_BAR
#undef PG8_SCHED
}
}

namespace {
using pg8::bf16_t;
typedef float f32x4 __attribute__((ext_vector_type(4)));
typedef unsigned u32x4 __attribute__((ext_vector_type(4)));

constexpr int NB = 16, NL = 2048, ND = 1024, NT = NB * NL;
constexpr int EVEN_IN = 2560, ODD_IN = 2608, ODD_PAD = 2304;
constexpr float ALPHA = 1.41421356237f;
constexpr float LN_EPS = 1e-5f;
constexpr float U_SCALE = 256.f, V_SCALE = 16.f;
constexpr int NTHR = 512;
constexpr int LDS_BYTES = 163840;
#ifndef PROBE
#define PROBE 0
#endif
#define PDUP(bit) for (int _rep = 0; _rep < ((PROBE >> (bit)) & 1) + 1; ++_rep)
#ifndef PHMASK
#define PHMASK 0xFFFFFFFFu
#endif
#define PH(n) if (PHMASK & (1u << (n)))

__device__ __forceinline__ float bf2f(bf16_t v) { return __uint_as_float((unsigned)v << 16); }
__device__ __forceinline__ bf16_t f2bf(float f) { unsigned u = __float_as_uint(f); u += 0x7FFFu + ((u >> 16) & 1u); return (bf16_t)(u >> 16); }
__device__ __forceinline__ unsigned pack2(float lo, float hi) { return (unsigned)f2bf(lo) | ((unsigned)f2bf(hi) << 16); }
__device__ __forceinline__ void ld8(const bf16_t* p, float* o) {
    const uint4 v = *(const uint4*)p;
    o[0] = __uint_as_float(v.x << 16); o[1] = __uint_as_float(v.x & 0xffff0000u);
    o[2] = __uint_as_float(v.y << 16); o[3] = __uint_as_float(v.y & 0xffff0000u);
    o[4] = __uint_as_float(v.z << 16); o[5] = __uint_as_float(v.z & 0xffff0000u);
    o[6] = __uint_as_float(v.w << 16); o[7] = __uint_as_float(v.w & 0xffff0000u);
}
__device__ __forceinline__ void st8(bf16_t* p, const float* o) {
    uint4 v; v.x = pack2(o[0], o[1]); v.y = pack2(o[2], o[3]); v.z = pack2(o[4], o[5]); v.w = pack2(o[6], o[7]);
    *(uint4*)p = v;
}

struct EpiBf16s {
    static constexpr bool PERM = true, AFTER_DRAIN = false;
    bf16_t* O; int ldc;
    __device__ __forceinline__ void operator()(const f32x4 (&acc)[2][2][4][2], const pg8::Unit& u, int wr, int wc, int fr, int fq) const {
        const int row0 = u.pm * 256 + wr * 64 + fr, col0 = u.pn * 256 + wc * 32 + 8 * fq;
#pragma unroll
        for (int ai = 0; ai < 2; ++ai)
#pragma unroll
            for (int m = 0; m < 4; ++m) { bf16_t* rowp = O + (size_t)(row0 + ai * 128 + m * 16) * ldc + col0;
#pragma unroll
                for (int bj = 0; bj < 2; ++bj) { const f32x4 v0 = acc[ai][bj][m][0], v1 = acc[ai][bj][m][1];
                    u32x4 w; w.x = pg8::cvt_pk_bf16(v0[0], v0[1]); w.y = pg8::cvt_pk_bf16(v0[2], v0[3]); w.z = pg8::cvt_pk_bf16(v1[0], v1[1]); w.w = pg8::cvt_pk_bf16(v1[2], v1[3]);
                    *(u32x4*)(rowp + bj * 128) = w; } }
    }
};
struct EpiRes {
    static constexpr bool PERM = false, AFTER_DRAIN = false;
    float* C; int ldc; float alpha; float* Cout;
    __device__ __forceinline__ void operator()(const f32x4 (&acc)[2][2][4][2], const pg8::Unit& u, int wr, int wc, int fr, int fq) const {
        const int row0 = u.pm * 256 + wr * 64 + fr, col0 = u.pn * 256 + wc * 32 + 4 * fq; const size_t dlt = Cout - C;
#pragma unroll
        for (int ai = 0; ai < 2; ++ai)
#pragma unroll
            for (int m = 0; m < 4; ++m) { float* rowp = C + (size_t)(row0 + ai * 128 + m * 16) * ldc + col0;
#pragma unroll
                for (int bj = 0; bj < 2; ++bj)
#pragma unroll
                    for (int n = 0; n < 2; ++n) { f32x4* cp = (f32x4*)(rowp + bj * 128 + n * 16); *(cp + dlt / 4) = *cp * alpha + acc[ai][bj][m][n]; } }
    }
};
template <class Epi>
__device__ __forceinline__ void gemm_bf16_phase(unsigned char* lds, const bf16_t* A, const bf16_t* Bt, int M, int N, int K, const Epi& E, bool reverse_ids = false) {
    pg8::Gemm g{A, Bt, M, N, K};
    pg8::StaticOrder S; S.init(M, N, (int)gridDim.x, reverse_ids ? (int)(gridDim.x - 1 - blockIdx.x) : (int)blockIdx.x);
    pg8::gemm_phase<Epi, pg8::StaticOrder, false>((PG8_LAS unsigned char*)lds, g, S, E, nullptr);
    __syncthreads();
}

struct ColMap { int d0[3], s0[3], len[3]; };
__device__ __forceinline__ void convert_wt_phase(const float* __restrict__ W, int K, int N, int Npad, const ColMap cm, bf16_t* __restrict__ Wt, float* lds) {
    float(*tile)[65] = (float(*)[65])lds;
    const int tid = tidx(), ntn = Npad / 64, ntiles = (K / 64) * ntn;
    for (int it = blockIdx.x; it < ntiles; it += gridDim.x) {
        const int k0 = (it / ntn) * 64, n0 = (it % ntn) * 64;
        __syncthreads();
#pragma unroll
        for (int h = 0; h < 2; ++h) {
            const int r = (tid >> 4) + h * 32, c4 = (tid & 15) * 4, nd = n0 + c4;
            int ns = -1;
#pragma unroll
            for (int sg = 0; sg < 3; ++sg) if (nd >= cm.d0[sg] && nd < cm.d0[sg] + cm.len[sg]) ns = cm.s0[sg] + (nd - cm.d0[sg]);
            float4 v = make_float4(0.f, 0.f, 0.f, 0.f);
            if (ns >= 0) v = *(const float4*)(W + (size_t)(k0 + r) * N + ns);
            tile[r][c4] = v.x; tile[r][c4 + 1] = v.y; tile[r][c4 + 2] = v.z; tile[r][c4 + 3] = v.w;
        }
        __syncthreads();
        const int n = tid >> 3, k8 = (tid & 7) * 8;
        float o[8];
#pragma unroll
        for (int j = 0; j < 8; ++j) o[j] = tile[k8 + j][n];
        st8(Wt + (size_t)(n0 + n) * K + k0 + k8, o);
    }
    __syncthreads();
}
__device__ __forceinline__ float gelu_tanh(float x) {
    float u = 0.7978845608028654f * (x + 0.044715f * x * x * x);
    return 0.5f * x * (1.f + tanhf(u));
}
__device__ __forceinline__ float sigmoidf_(float x) { return 1.f / (1.f + expf(-x)); }
__device__ __forceinline__ void wave_lds_fence() { asm volatile("s_waitcnt lgkmcnt(0)" ::: "memory"); }

__device__ __forceinline__ void s5_scan_wave(int bg, const bf16_t* __restrict__ proj, const float* __restrict__ lam_re, const float* __restrict__ lam_im,
                             const float* __restrict__ log_dt, const float* __restrict__ b_re, const float* __restrict__ b_im,
                             const float* __restrict__ c_re, const float* __restrict__ c_im, const float* __restrict__ dskip,
                             float* __restrict__ ya, float* lds) {
    const int b = bg >> 4, g = bg & 15, lane = tidx() & 63;
    float(*us)[16] = (float(*)[16])lds;
    float(*xr)[65] = (float(*)[65])(lds + 1024);
    float(*xi)[65] = (float(*)[65])(lds + 1024 + 4160);
    float(*cr)[64] = (float(*)[64])(lds + 1024 + 8320);
    float(*ci)[64] = (float(*)[64])(lds + 1024 + 8320 + 1024);
    const float lr = lam_re[g * 64 + lane], li = lam_im[g * 64 + lane];
    const float dt = expf(log_dt[g]);
    const float mag = expf(lr * dt);
    const float are = mag * cosf(li * dt), aim = mag * sinf(li * dt);
    const float nr = are - 1.f, den = lr * lr + li * li;
    const float fre = (nr * lr + aim * li) / den, fim = (aim * lr - nr * li) / den;
    float bbr[16], bbi[16];
#pragma unroll
    for (int i = 0; i < 16; ++i) {
        const float br = b_re[(g * 64 + lane) * 16 + i], bi = b_im[(g * 64 + lane) * 16 + i];
        bbr[i] = fre * br - fim * bi; bbi[i] = fre * bi + fim * br;
    }
    for (int idx = lane; idx < 1024; idx += 64) { cr[idx >> 6][idx & 63] = c_re[g * 1024 + idx]; ci[idx >> 6][idx & 63] = c_im[g * 1024 + idx]; }
    float dsk[16];
#pragma unroll
    for (int i = 0; i < 16; ++i) dsk[i] = dskip[g * 16 + i];
    float xre = 0.f, xim = 0.f;
    for (int t0 = 0; t0 < NL; t0 += 64) {
        wave_lds_fence();
        for (int idx = lane; idx < 1024; idx += 64) { const int t = idx >> 4, i = idx & 15; us[t][i] = bf2f(proj[(size_t)(b * NL + t0 + t) * EVEN_IN + g * 16 + i]); }
        wave_lds_fence();
        for (int t = 0; t < 64; ++t) {
            float bur = 0.f, bui = 0.f;
#pragma unroll
            for (int i = 0; i < 16; ++i) { const float u = us[t][i]; bur += bbr[i] * u; bui += bbi[i] * u; }
            const float nre = are * xre - aim * xim + bur, nim = are * xim + aim * xre + bui;
            xre = nre; xim = nim;
            xr[t][lane] = xre; xi[t][lane] = xim;
        }
        wave_lds_fence();
        float y[16];
#pragma unroll
        for (int i = 0; i < 16; ++i) y[i] = 0.f;
        for (int p = 0; p < 64; ++p) {
            const float a = xr[lane][p], bq = xi[lane][p];
#pragma unroll
            for (int i = 0; i < 16; ++i) y[i] += cr[i][p] * a - ci[i][p] * bq;
        }
#pragma unroll
        for (int i = 0; i < 16; ++i) {
            const float v = y[i] + dsk[i] * us[lane][i];
            ya[(size_t)(b * NL + t0 + lane) * 256 + g * 16 + i] = gelu_tanh(v);
        }
    }
}

__device__ __forceinline__ void sb_attn_wave(int task, const bf16_t* __restrict__ proj, bf16_t* __restrict__ Y, float* wl) {
    const int qt = task & 31, h = (task >> 5) % 12, b = task / 384, lane = tidx() & 63;
    const int t = qt * 64 + lane;
    float(*ks)[64] = (float(*)[64])wl;
    float(*vs)[64] = (float(*)[64])(wl + 2048);
    const bf16_t* base = proj + (size_t)b * NL * EVEN_IN;
    float q[64], acc[64];
#pragma unroll
    for (int d = 0; d < 64; d += 8) ld8(base + (size_t)t * EVEN_IN + 256 + h * 64 + d, q + d);
#pragma unroll
    for (int d = 0; d < 64; ++d) acc[d] = 0.f;
    float tail = 0.f;
    for (int c = 2 * qt + 1; c >= 0; --c) {
        wave_lds_fence();
        for (int i = 0; i < 32; ++i) {
            ks[i][lane] = bf2f(base[(size_t)(c * 32 + i) * EVEN_IN + 1024 + h * 64 + lane]);
            vs[i][lane] = bf2f(base[(size_t)(c * 32 + i) * EVEN_IN + 1792 + h * 64 + lane]);
        }
        wave_lds_fence();
        for (int s = 31; s >= 0; --s) {
            const int key = c * 32 + s;
            float z = 0.f;
#pragma unroll
            for (int d = 0; d < 64; ++d) z += q[d] * ks[s][d];
            z *= 0.125f;
            const bool valid = key < t;
            const float sp = fmaxf(z, 0.f) + log1pf(expf(-fabsf(z)));
            const float w = valid ? expf(z - sp + tail) : 0.f;
#pragma unroll
            for (int d = 0; d < 64; ++d) acc[d] += w * vs[s][d];
            if (valid) tail -= sp;
        }
        if (__all(tail < -120.f)) break;
    }
#pragma unroll
    for (int d = 0; d < 64; d += 8) st8(Y + (size_t)(b * NL + t) * ND + 256 + h * 64 + d, acc + d);
}

__device__ __forceinline__ void glu_phase(const float* __restrict__ ya, const float* __restrict__ wglu, const float* __restrict__ bglu, bf16_t* __restrict__ Y, float* lds) {
    const int half = tidx() >> 8, c = tidx() & 255;
    float(*ys)[256] = (float(*)[256])(lds + half * 4096);
    for (int it = blockIdx.x; it < NT / 32; it += gridDim.x) {
        const int t0 = it * 32 + half * 16;
        __syncthreads();
        for (int i = 0; i < 16; ++i) ys[i][c] = ya[(size_t)(t0 + i) * 256 + c];
        __syncthreads();
        float acc[16];
#pragma unroll
        for (int i = 0; i < 16; ++i) acc[i] = 0.f;
        for (int k = 0; k < 256; ++k) {
            const float w = wglu[k * 256 + c];
#pragma unroll
            for (int i = 0; i < 16; ++i) acc[i] += ys[i][k] * w;
        }
        const float bb = bglu[c];
#pragma unroll
        for (int i = 0; i < 16; ++i) Y[(size_t)(t0 + i) * ND + c] = f2bf(ys[i][c] * sigmoidf_(acc[i] + bb));
    }
    __syncthreads();
}

__device__ __forceinline__ void ln_row_wave(float4 (&v)[4], const float* __restrict__ g, const float* __restrict__ bta, float* out, bf16_t* outb, int lane) {
    float s = 0.f;
#pragma unroll
    for (int j = 0; j < 4; ++j) s += v[j].x + v[j].y + v[j].z + v[j].w;
    for (int o = 32; o; o >>= 1) s += __shfl_xor(s, o);
    const float mean = s * (1.f / ND);
    float s2 = 0.f;
#pragma unroll
    for (int j = 0; j < 4; ++j) {
        v[j].x -= mean; v[j].y -= mean; v[j].z -= mean; v[j].w -= mean;
        s2 += v[j].x * v[j].x + v[j].y * v[j].y + v[j].z * v[j].z + v[j].w * v[j].w;
    }
    for (int o = 32; o; o >>= 1) s2 += __shfl_xor(s2, o);
    const float rs = rsqrtf(s2 * (1.f / ND) + LN_EPS);
#pragma unroll
    for (int j = 0; j < 4; ++j) {
        const float4 gg = *(const float4*)(g + j * 256 + lane * 4), bb = *(const float4*)(bta + j * 256 + lane * 4);
        const float4 o = make_float4(v[j].x * rs * gg.x + bb.x, v[j].y * rs * gg.y + bb.y, v[j].z * rs * gg.z + bb.z, v[j].w * rs * gg.w + bb.w);
        *(float4*)(out + j * 256 + lane * 4) = o;
        if (outb) { uint2 w; w.x = pack2(o.x, o.y); w.y = pack2(o.z, o.w); *(uint2*)(outb + j * 256 + lane * 4) = w; }
    }
}
__device__ __forceinline__ void ln_phase(float* R, bf16_t* Hb, const float* __restrict__ g, const float* __restrict__ bta) {
    const int wave = tidx() >> 6, lane = tidx() & 63;
    for (int row = blockIdx.x * 8 + wave; row < NT; row += gridDim.x * 8) {
        float4 v[4];
#pragma unroll
        for (int j = 0; j < 4; ++j) v[j] = *(const float4*)(R + (size_t)row * ND + j * 256 + lane * 4);
        ln_row_wave(v, g, bta, R + (size_t)row * ND, Hb + (size_t)row * ND, lane);
    }
}

__device__ __forceinline__ void wave_argmax(float& bv, int& bi) {
#pragma unroll
    for (int o = 32; o; o >>= 1) {
        const float ov = __shfl_xor(bv, o); const int oi = __shfl_xor(bi, o);
        if (ov > bv || (ov == bv && oi < bi)) { bv = ov; bi = oi; }
    }
}
__device__ __forceinline__ void peer_route_phase(const bf16_t* __restrict__ qbuf, const float* __restrict__ subk, int* __restrict__ eidx, float* __restrict__ egate, float* lds) {
    const int head = tidx() >> 6, lane = tidx() & 63;
    float* qs = lds + head * 256;
    for (int token = blockIdx.x; token < NT; token += gridDim.x) {
        const bf16_t* qp = qbuf + (size_t)token * 2048 + head * 256;
        wave_lds_fence();
        for (int i = 0; i < 4; ++i) qs[lane + 64 * i] = bf2f(qp[lane + 64 * i]);
        wave_lds_fence();
        float myv[2]; int myi[2];
#pragma unroll
        for (int c = 0; c < 2; ++c) {
            float sc[2];
#pragma unroll
            for (int w2 = 0; w2 < 2; ++w2) {
                const float* kr = subk + ((size_t)(head * 2 + c) * 128 + lane + 64 * w2) * 128;
                float a = 0.f;
#pragma unroll 4
                for (int d = 0; d < 128; d += 4) {
                    const float4 kv = *(const float4*)(kr + d);
                    a += qs[c * 128 + d] * kv.x + qs[c * 128 + d + 1] * kv.y + qs[c * 128 + d + 2] * kv.z + qs[c * 128 + d + 3] * kv.w;
                }
                sc[w2] = a;
            }
            float a0 = sc[0], a1 = sc[1];
            float mv = -INFINITY; int mi = 0;
            for (int r = 0; r < 16; ++r) {
                float bv; int bi;
                if (a0 >= a1) { bv = a0; bi = lane; } else { bv = a1; bi = lane + 64; }
                wave_argmax(bv, bi);
                if (lane == r) { mv = bv; mi = bi; }
                if (bi == lane) a0 = -INFINITY; else if (bi == lane + 64) a1 = -INFINITY;
            }
            myv[c] = mv; myi[c] = mi;
        }
        const float va = __shfl(myv[0], lane >> 2);
        float cand[4];
#pragma unroll
        for (int j = 0; j < 4; ++j) cand[j] = va + __shfl(myv[1], (lane & 3) * 4 + j);
        float topv = -INFINITY; int topf = 0;
        for (int r = 0; r < 16; ++r) {
            float bv = cand[0]; int bi = lane * 4;
#pragma unroll
            for (int j = 1; j < 4; ++j) if (cand[j] > bv) { bv = cand[j]; bi = lane * 4 + j; }
            wave_argmax(bv, bi);
            if (lane == r) { topv = bv; topf = bi; }
#pragma unroll
            for (int j = 0; j < 4; ++j) if (bi == lane * 4 + j) cand[j] = -INFINITY;
        }
        const int e1 = __shfl(myi[0], topf >> 4), e2 = __shfl(myi[1], topf & 15);
        const float top0 = __shfl(topv, 0);
        float ex = (lane < 16) ? expf(topv - top0) : 0.f;
        float sum = ex;
        for (int o = 32; o; o >>= 1) sum += __shfl_xor(sum, o);
        if (lane < 16) {
            eidx[(size_t)token * 128 + head * 16 + lane] = e1 * 128 + e2;
            egate[(size_t)token * 128 + head * 16 + lane] = ex / sum;
        }
    }
}

__device__ __forceinline__ void peer_expert_phase(float* R, const int* __restrict__ eidx, const float* __restrict__ egate, const float* __restrict__ utab,
                                  const float* __restrict__ vtab, const float* __restrict__ lg, const float* __restrict__ lb, bf16_t* Hb) {
    const int wave = tidx() >> 6, lane = tidx() & 63;
    for (int token = blockIdx.x * 8 + wave; token < NT; token += gridDim.x * 8) {
        float4 x[4], acc[4];
#pragma unroll
        for (int j = 0; j < 4; ++j) { x[j] = *(const float4*)(R + (size_t)token * ND + j * 256 + lane * 4); acc[j] = make_float4(0.f, 0.f, 0.f, 0.f); }
        for (int e0 = 0; e0 < 128; e0 += 4) {
            float dot[4]; int ex[4]; float gt[4];
#pragma unroll
            for (int k = 0; k < 4; ++k) {
                ex[k] = eidx[(size_t)token * 128 + e0 + k]; gt[k] = egate[(size_t)token * 128 + e0 + k];
                const float* ur = utab + (size_t)ex[k] * ND + lane * 4;
                float a = 0.f;
#pragma unroll
                for (int j = 0; j < 4; ++j) { const float4 u = *(const float4*)(ur + j * 256); a += x[j].x * u.x + x[j].y * u.y + x[j].z * u.z + x[j].w * u.w; }
                dot[k] = a;
            }
#pragma unroll
            for (int k = 0; k < 4; ++k) {
                float a = dot[k];
                for (int o = 32; o; o >>= 1) a += __shfl_xor(a, o);
                const float coef = gt[k] * gelu_tanh(a);
                const float* vr = vtab + (size_t)ex[k] * ND + lane * 4;
#pragma unroll
                for (int j = 0; j < 4; ++j) { const float4 v = *(const float4*)(vr + j * 256); acc[j].x += coef * v.x; acc[j].y += coef * v.y; acc[j].z += coef * v.z; acc[j].w += coef * v.w; }
            }
        }
#pragma unroll
        for (int j = 0; j < 4; ++j) { x[j].x = ALPHA * x[j].x + acc[j].x; x[j].y = ALPHA * x[j].y + acc[j].y; x[j].z = ALPHA * x[j].z + acc[j].z; x[j].w = ALPHA * x[j].w + acc[j].w; }
        ln_row_wave(x, lg, lb, R + (size_t)token * ND, Hb ? Hb + (size_t)token * ND : nullptr, lane);
    }
}


typedef short bf16x8_t __attribute__((ext_vector_type(8)));
__device__ __forceinline__ int f2key(float f) { const int b = __float_as_int(f); return b ^ ((b >> 31) & 0x7fffffff); }
__device__ __forceinline__ float key2f(int k) { return __int_as_float(k ^ ((k >> 31) & 0x7fffffff)); }
#define CE_DESC_I(a, b) do { const int _hi = max(a, b), _lo = min(a, b); a = _hi; b = _lo; } while (0)
template <int N, int K, int J> __device__ __forceinline__ void bstage(int (&v)[N]) {
#pragma unroll
    for (int i = 0; i < N; ++i) {
        const int l = i ^ J;
        if (l > i) { if ((i & K) == 0) CE_DESC_I(v[i], v[l]); else CE_DESC_I(v[l], v[i]); }
    }
}
__device__ __forceinline__ void sort16_desc(int (&v)[16]) {
    bstage<16, 2, 1>(v); bstage<16, 4, 2>(v); bstage<16, 4, 1>(v); bstage<16, 8, 4>(v); bstage<16, 8, 2>(v); bstage<16, 8, 1>(v);
    bstage<16, 16, 8>(v); bstage<16, 16, 4>(v); bstage<16, 16, 2>(v); bstage<16, 16, 1>(v);
}
__device__ __forceinline__ void sort8_desc(int (&v)[8]) {
    bstage<8, 2, 1>(v); bstage<8, 4, 2>(v); bstage<8, 4, 1>(v); bstage<8, 8, 4>(v); bstage<8, 8, 2>(v); bstage<8, 8, 1>(v);
}
__device__ __forceinline__ void bitonic_merge16_desc(int (&v)[16]) {
    bstage<16, 16, 8>(v); bstage<16, 16, 4>(v); bstage<16, 16, 2>(v); bstage<16, 16, 1>(v);
}
__device__ __forceinline__ void xmerge16(int (&v)[16], int off) {
    int m[16];
#pragma unroll
    for (int i = 0; i < 16; ++i) m[i] = max(v[i], __shfl_xor(v[15 - i], off));
    bitonic_merge16_desc(m);
#pragma unroll
    for (int i = 0; i < 16; ++i) v[i] = m[i];
}
__device__ __forceinline__ void opaque16(int (&v)[16]) {
#pragma unroll
    for (int i = 0; i < 16; ++i) asm volatile("" : "+v"(v[i]));
}
__device__ __forceinline__ int lookup16(const int (&arr)[16], int a) {
    int r = arr[0];
#pragma unroll
    for (int i = 1; i < 16; ++i) r = (a == i) ? arr[i] : r;
    return r;
}
__device__ __forceinline__ void peer_route2_phase(const bf16_t* __restrict__ qbuf, const bf16_t* __restrict__ skb, int* __restrict__ eidx, float* __restrict__ egate, unsigned char* lds) {
    const int tid = tidx(), wave = tid >> 6, lane = tid & 63, fr = lane & 15, fq = lane >> 4;
    for (int chunk = blockIdx.x; chunk < NT / 128; chunk += gridDim.x) {
        const int token = chunk * 128 + wave * 16 + fr;
        int* tl = (int*)(lds + 34816) + (wave * 16 + fr) * 48;
        for (int h = 0; h < 8; ++h) {
            int K1[16], K2[16];
#pragma unroll
            for (int c = 0; c < 2; ++c) {
                __syncthreads();
#pragma unroll
                for (int i = 0; i < 4; ++i) {
                    const int idx = tid + 512 * i, row = idx >> 4, ch = idx & 15;
                    *(uint4*)(lds + row * 272 + ch * 16) = *(const uint4*)(skb + ((size_t)(h * 2 + c) * 128 + row) * 128 + ch * 8);
                }
                __syncthreads();
                bf16x8_t qf[4];
#pragma unroll
                for (int sI = 0; sI < 4; ++sI) qf[sI] = *(const bf16x8_t*)(qbuf + (size_t)token * 2048 + h * 256 + c * 128 + 32 * sI + 8 * fq);
                int va[16], vb[16];
#pragma unroll
                for (int n = 0; n < 8; ++n) {
                    f32x4 S = {0.f, 0.f, 0.f, 0.f};
#pragma unroll
                    for (int sI = 0; sI < 4; ++sI) {
                        const bf16x8_t kf = *(const bf16x8_t*)(lds + (16 * n + fr) * 272 + (32 * sI + 8 * fq) * 2);
                        S = __builtin_amdgcn_mfma_f32_16x16x32_bf16(kf, qf[sI], S, 0, 0, 0);
                    }
#pragma unroll
                    for (int j = 0; j < 4; ++j) {
                        const int key = (f2key(S[j]) & ~127) | (16 * n + 4 * fq + j);
                        if (n < 4) va[n * 4 + j] = key; else vb[(n - 4) * 4 + j] = key;
                    }
                }
                sort16_desc(va); sort16_desc(vb);
                int m[16];
#pragma unroll
                for (int i = 0; i < 16; ++i) m[i] = max(va[i], vb[15 - i]);
                bitonic_merge16_desc(m);
                xmerge16(m, 16); xmerge16(m, 32);
#pragma unroll
                for (int i = 0; i < 16; ++i) { if (c == 0) K1[i] = m[i]; else K2[i] = m[i]; }
                if (fq == 0) {
#pragma unroll
                    for (int i = 0; i < 4; ++i) *(int4*)(tl + c * 16 + 4 * i) = make_int4(m[4 * i], m[4 * i + 1], m[4 * i + 2], m[4 * i + 3]);
                }
            }
            wave_lds_fence();
            float vaf[4];
#pragma unroll
            for (int k = 0; k < 4; ++k) vaf[k] = key2f(tl[4 * k + fq]);
            int A[16];
#pragma unroll
            for (int b = 0; b < 16; ++b) {
                const bool valid = (fq + 1) * (b + 1) <= 16;
                const int key = (f2key(vaf[0] + key2f(K2[b])) & ~127) | (fq << 5) | b;
                A[b] = valid ? key : INT_MIN;
            }
            int Bq[8];
#pragma unroll
            for (int b = 0; b < 3; ++b) {
                const bool valid = (fq + 5) * (b + 1) <= 16;
                const int key = (f2key(vaf[1] + key2f(K2[b])) & ~127) | (fq << 5) | (16 + b);
                Bq[b] = valid ? key : INT_MIN;
            }
            Bq[3] = (f2key(vaf[2] + key2f(K2[0])) & ~127) | (fq << 5) | 19;
            Bq[4] = (f2key(vaf[3] + key2f(K2[0])) & ~127) | (fq << 5) | 20;
            Bq[5] = INT_MIN; Bq[6] = INT_MIN; Bq[7] = INT_MIN;
            sort8_desc(Bq);
#pragma unroll
            for (int i = 8; i < 16; ++i) A[i] = max(A[i], Bq[15 - i]);
            bitonic_merge16_desc(A);
            xmerge16(A, 16); xmerge16(A, 32);
            if (fq == 0) {
#pragma unroll
                for (int i = 0; i < 4; ++i) *(int4*)(tl + 32 + 4 * i) = make_int4(A[4 * i], A[4 * i + 1], A[4 * i + 2], A[4 * i + 3]);
            }
            wave_lds_fence();
            const int4 myT = *(const int4*)(tl + 32 + 4 * fq);
            const int tsel[4] = {myT.x, myT.y, myT.z, myT.w};
            const float top0 = key2f(A[0]);
            float sum = 0.f;
#pragma unroll
            for (int r = 0; r < 16; ++r) sum += __expf(key2f(A[r]) - top0);
            const float inv = 1.f / sum;
            int eo[4]; float go[4];
#pragma unroll
            for (int kk = 0; kk < 4; ++kk) {
                const int t = tsel[kk];
                const int id = t & 127, ofq = id >> 5, slot = id & 31;
                const int k = slot < 16 ? 0 : (slot < 19 ? 1 : (slot == 19 ? 2 : 3));
                const int b = slot < 16 ? slot : (slot < 19 ? slot - 16 : 0);
                const int a = ofq + 4 * k;
                const int e1 = tl[a] & 127, e2 = tl[16 + b] & 127;
                eo[kk] = e1 * 128 + e2;
                go[kk] = __expf(key2f(t) - top0) * inv;
            }
            *(int4*)(eidx + (size_t)token * 128 + h * 16 + 4 * fq) = make_int4(eo[0], eo[1], eo[2], eo[3]);
            *(float4*)(egate + (size_t)token * 128 + h * 16 + 4 * fq) = make_float4(go[0], go[1], go[2], go[3]);
            wave_lds_fence();
        }
    }
    __syncthreads();
}

typedef __bf16 bf16x2_t __attribute__((ext_vector_type(2)));
typedef float f32x2_t __attribute__((ext_vector_type(2)));
__device__ __forceinline__ float dot2bf(unsigned a, unsigned b, float acc) { return __builtin_amdgcn_fdot2_f32_bf16(__builtin_bit_cast(bf16x2_t, a), __builtin_bit_cast(bf16x2_t, b), acc, false); }
__device__ __forceinline__ float gelu_fast(float x) {
    const float u = 0.7978845608028654f * (x + 0.044715f * x * x * x);
    return x / (1.f + __expf(-2.f * u));
}
__device__ __forceinline__ void peer_expert2_phase(float* R, const int* __restrict__ eidx, const float* __restrict__ egate, const bf16_t* __restrict__ ub,
                                                   const bf16_t* __restrict__ vb, const float* __restrict__ lg, const float* __restrict__ lb, bf16_t* Hb) {
    const int wave = tidx() >> 6, lane = tidx() & 63;
    for (int token = blockIdx.x * 8 + wave; token < NT; token += gridDim.x * 8) {
        float xf[16];
        {
            const float* rp = R + (size_t)token * ND + lane * 8;
            const float4 a0 = *(const float4*)rp, a1 = *(const float4*)(rp + 4), b0 = *(const float4*)(rp + 512), b1 = *(const float4*)(rp + 516);
            xf[0] = a0.x; xf[1] = a0.y; xf[2] = a0.z; xf[3] = a0.w; xf[4] = a1.x; xf[5] = a1.y; xf[6] = a1.z; xf[7] = a1.w;
            xf[8] = b0.x; xf[9] = b0.y; xf[10] = b0.z; xf[11] = b0.w; xf[12] = b1.x; xf[13] = b1.y; xf[14] = b1.z; xf[15] = b1.w;
        }
        unsigned xp[8];
#pragma unroll
        for (int j = 0; j < 8; ++j) xp[j] = pack2(xf[2 * j], xf[2 * j + 1]);
        float acc[16];
#pragma unroll
        for (int j = 0; j < 16; ++j) acc[j] = 0.f;
        const int e_lo = eidx[(size_t)token * 128 + lane], e_hi = eidx[(size_t)token * 128 + 64 + lane];
        const float g_lo = egate[(size_t)token * 128 + lane], g_hi = egate[(size_t)token * 128 + 64 + lane];
        for (int grp = 0; grp < 16; ++grp) {
            const int esel = grp < 8 ? e_lo : e_hi;
            const float gsel = grp < 8 ? g_lo : g_hi;
            const int lbase = (grp & 7) * 8;
            uint4 u0[8], u1[8];
            int exs[8];
#pragma unroll
            for (int k = 0; k < 8; ++k) {
                exs[k] = __builtin_amdgcn_readlane(esel, lbase + k);
                const bf16_t* up = ub + (size_t)exs[k] * ND + lane * 8;
                u0[k] = *(const uint4*)up; u1[k] = *(const uint4*)(up + 512);
            }
            float d[8];
#pragma unroll
            for (int k = 0; k < 8; ++k) {
                float a = dot2bf(u0[k].x, xp[0], 0.f), b = dot2bf(u0[k].y, xp[1], 0.f);
                a = dot2bf(u0[k].z, xp[2], a); b = dot2bf(u0[k].w, xp[3], b);
                a = dot2bf(u1[k].x, xp[4], a); b = dot2bf(u1[k].y, xp[5], b);
                a = dot2bf(u1[k].z, xp[6], a); b = dot2bf(u1[k].w, xp[7], b);
                d[k] = a + b;
            }
            const bool hi5 = lane & 32, hi4 = lane & 16, hi3 = lane & 8;
            float r4[4], r2[2], r1;
#pragma unroll
            for (int k = 0; k < 4; ++k) { const float send = hi5 ? d[k] : d[k + 4], keep = hi5 ? d[k + 4] : d[k]; r4[k] = keep + __shfl_xor(send, 32); }
#pragma unroll
            for (int k = 0; k < 2; ++k) { const float send = hi4 ? r4[k] : r4[k + 2], keep = hi4 ? r4[k + 2] : r4[k]; r2[k] = keep + __shfl_xor(send, 16); }
            { const float send = hi3 ? r2[0] : r2[1], keep = hi3 ? r2[1] : r2[0]; r1 = keep + __shfl_xor(send, 8); }
            r1 += __shfl_xor(r1, 4); r1 += __shfl_xor(r1, 2); r1 += __shfl_xor(r1, 1);
            uint4 v0[8], v1[8];
#pragma unroll
            for (int k = 0; k < 8; ++k) {
                const bf16_t* vp = vb + (size_t)exs[k] * ND + lane * 8;
                v0[k] = *(const uint4*)vp; v1[k] = *(const uint4*)(vp + 512);
            }
            const float gk = __shfl(gsel, lbase + (lane >> 3));
            const float coef = gk * gelu_fast(r1);
#pragma unroll
            for (int k = 0; k < 8; ++k) {
                const float ck = __int_as_float(__builtin_amdgcn_readlane(__float_as_int(coef), 8 * k));
                const unsigned w[8] = {v0[k].x, v0[k].y, v0[k].z, v0[k].w, v1[k].x, v1[k].y, v1[k].z, v1[k].w};
#pragma unroll
                for (int j = 0; j < 8; ++j) {
                    acc[2 * j] += ck * __uint_as_float(w[j] << 16);
                    acc[2 * j + 1] += ck * __uint_as_float(w[j] & 0xffff0000u);
                }
            }
        }
        {
            const float* rp = R + (size_t)token * ND + lane * 8;
            const float4 a0 = *(const float4*)rp, a1 = *(const float4*)(rp + 4), b0 = *(const float4*)(rp + 512), b1 = *(const float4*)(rp + 516);
            xf[0] = a0.x; xf[1] = a0.y; xf[2] = a0.z; xf[3] = a0.w; xf[4] = a1.x; xf[5] = a1.y; xf[6] = a1.z; xf[7] = a1.w;
            xf[8] = b0.x; xf[9] = b0.y; xf[10] = b0.z; xf[11] = b0.w; xf[12] = b1.x; xf[13] = b1.y; xf[14] = b1.z; xf[15] = b1.w;
        }
        float s = 0.f;
#pragma unroll
        for (int j = 0; j < 16; ++j) { xf[j] = ALPHA * xf[j] + acc[j]; s += xf[j]; }
        for (int o = 32; o; o >>= 1) s += __shfl_xor(s, o);
        const float mean = s * (1.f / ND);
        float s2 = 0.f;
#pragma unroll
        for (int j = 0; j < 16; ++j) { xf[j] -= mean; s2 += xf[j] * xf[j]; }
        for (int o = 32; o; o >>= 1) s2 += __shfl_xor(s2, o);
        const float rs = rsqrtf(s2 * (1.f / ND) + LN_EPS);
#pragma unroll
        for (int hf = 0; hf < 2; ++hf) {
            const int c0 = hf * 512 + lane * 8;
            const float4 g0 = *(const float4*)(lg + c0), g1 = *(const float4*)(lg + c0 + 4), b0 = *(const float4*)(lb + c0), b1 = *(const float4*)(lb + c0 + 4);
            float o[8];
            o[0] = xf[hf * 8 + 0] * rs * g0.x + b0.x; o[1] = xf[hf * 8 + 1] * rs * g0.y + b0.y; o[2] = xf[hf * 8 + 2] * rs * g0.z + b0.z; o[3] = xf[hf * 8 + 3] * rs * g0.w + b0.w;
            o[4] = xf[hf * 8 + 4] * rs * g1.x + b1.x; o[5] = xf[hf * 8 + 5] * rs * g1.y + b1.y; o[6] = xf[hf * 8 + 6] * rs * g1.z + b1.z; o[7] = xf[hf * 8 + 7] * rs * g1.w + b1.w;
            float* op = R + (size_t)token * ND + c0;
            *(float4*)op = make_float4(o[0], o[1], o[2], o[3]); *(float4*)(op + 4) = make_float4(o[4], o[5], o[6], o[7]);
            if (Hb) st8(Hb + (size_t)token * ND + c0, o);
        }
    }
}


template <int K2, int J> __device__ __forceinline__ void bsort_round(int (&k)[2], float (&g)[2], int lane) {
    if (J == 64) {
        const bool sw = k[0] > k[1];
        const int t = k[0]; const float tg = g[0];
        k[0] = sw ? k[1] : k[0]; g[0] = sw ? g[1] : g[0]; k[1] = sw ? t : k[1]; g[1] = sw ? tg : g[1];
    } else {
#pragma unroll
        for (int r = 0; r < 2; ++r) {
            const int pk = __shfl_xor(k[r], J); const float pg = __shfl_xor(g[r], J);
            const bool asc = (((lane + 64 * r) & K2) == 0), lower = ((lane & J) == 0);
            const bool take = (lower == asc) ? (pk < k[r]) : (pk > k[r]);
            k[r] = take ? pk : k[r]; g[r] = take ? pg : g[r];
        }
    }
}
template <int K2> __device__ __forceinline__ void bsort_stage(int (&k)[2], float (&g)[2], int lane) {
    if (K2 >= 128) bsort_round<K2, 64>(k, g, lane);
    if (K2 >= 64) bsort_round<K2, 32>(k, g, lane);
    if (K2 >= 32) bsort_round<K2, 16>(k, g, lane);
    if (K2 >= 16) bsort_round<K2, 8>(k, g, lane);
    if (K2 >= 8) bsort_round<K2, 4>(k, g, lane);
    if (K2 >= 4) bsort_round<K2, 2>(k, g, lane);
    bsort_round<K2, 1>(k, g, lane);
}
__device__ __forceinline__ void sort_routing(int& e_lo, int& e_hi, float& g_lo, float& g_hi, int lane) {
    int k[2] = {e_lo, e_hi}; float g[2] = {g_lo, g_hi};
    bsort_stage<2>(k, g, lane); bsort_stage<4>(k, g, lane); bsort_stage<8>(k, g, lane); bsort_stage<16>(k, g, lane);
    bsort_stage<32>(k, g, lane); bsort_stage<64>(k, g, lane); bsort_stage<128>(k, g, lane);
    e_lo = k[0]; e_hi = k[1]; g_lo = g[0]; g_hi = g[1];
}
__device__ __forceinline__ void peer_expert3_phase(float* R, const int* __restrict__ eidx, const float* __restrict__ egate, const unsigned char* __restrict__ ub,
                                                   const unsigned char* __restrict__ vb, const float* __restrict__ lg, const float* __restrict__ lb, bf16_t* Hb, float* Rout, const XcdBarrier& xb) {
    const int wave = tidx() >> 6, lane = tidx() & 63;
    int itk = 0;
    for (int token = blockIdx.x * 8 + wave; token < NT; token += gridDim.x * 8, ++itk) {
        if ((itk & 1) == 0 && itk) xcd_barrier(xb);
        float xf[16];
        {
            const float* rp = R + (size_t)token * ND + lane * 16;
#pragma unroll
            for (int q = 0; q < 4; ++q) { const float4 a = *(const float4*)(rp + 4 * q); xf[4 * q] = a.x; xf[4 * q + 1] = a.y; xf[4 * q + 2] = a.z; xf[4 * q + 3] = a.w; }
        }
        float acc[16];
#pragma unroll
        for (int j = 0; j < 16; ++j) acc[j] = 0.f;
        int e_lo = eidx[(size_t)token * 128 + lane], e_hi = eidx[(size_t)token * 128 + 64 + lane];
        float g_lo = egate[(size_t)token * 128 + lane], g_hi = egate[(size_t)token * 128 + 64 + lane];
        sort_routing(e_lo, e_hi, g_lo, g_hi, lane);
        for (int grp = 0; grp < 16; ++grp) {
            const int esel = grp < 8 ? e_lo : e_hi;
            const float gsel = grp < 8 ? g_lo : g_hi;
            const int lbase = (grp & 7) * 8;
            uint4 u[8], v[8];
#pragma unroll
            for (int k = 0; k < 8; ++k) {
                const int ex = __builtin_amdgcn_readlane(esel, lbase + k);
                u[k] = *(const uint4*)(ub + (size_t)ex * ND + lane * 16);
                v[k] = *(const uint4*)(vb + (size_t)ex * ND + lane * 16);
            }
            float d[8];
#pragma unroll
            for (int k = 0; k < 8; ++k) {
                const unsigned w[4] = {u[k].x, u[k].y, u[k].z, u[k].w};
                float a = 0.f, b = 0.f;
#pragma unroll
                for (int q = 0; q < 4; ++q) {
                    const f32x2_t lo = __builtin_amdgcn_cvt_pk_f32_fp8((int)w[q], false), hi = __builtin_amdgcn_cvt_pk_f32_fp8((int)w[q], true);
                    a = fmaf(xf[4 * q], lo.x, a); b = fmaf(xf[4 * q + 1], lo.y, b); a = fmaf(xf[4 * q + 2], hi.x, a); b = fmaf(xf[4 * q + 3], hi.y, b);
                }
                d[k] = a + b;
            }
            const bool hi5 = lane & 32, hi4 = lane & 16, hi3 = lane & 8;
            float r4[4], r2[2], r1;
#pragma unroll
            for (int k = 0; k < 4; ++k) { const float send = hi5 ? d[k] : d[k + 4], keep = hi5 ? d[k + 4] : d[k]; r4[k] = keep + __shfl_xor(send, 32); }
#pragma unroll
            for (int k = 0; k < 2; ++k) { const float send = hi4 ? r4[k] : r4[k + 2], keep = hi4 ? r4[k + 2] : r4[k]; r2[k] = keep + __shfl_xor(send, 16); }
            { const float send = hi3 ? r2[0] : r2[1], keep = hi3 ? r2[1] : r2[0]; r1 = keep + __shfl_xor(send, 8); }
            r1 += __shfl_xor(r1, 4); r1 += __shfl_xor(r1, 2); r1 += __shfl_xor(r1, 1);
            const float gk = __shfl(gsel, lbase + (lane >> 3));
            const float coef = gk * gelu_fast(r1 * (1.f / U_SCALE)) * (1.f / V_SCALE);
#pragma unroll
            for (int k = 0; k < 8; ++k) {
                const float ck = __int_as_float(__builtin_amdgcn_readlane(__float_as_int(coef), 8 * k));
                const unsigned w[4] = {v[k].x, v[k].y, v[k].z, v[k].w};
#pragma unroll
                for (int q = 0; q < 4; ++q) {
                    const f32x2_t lo = __builtin_amdgcn_cvt_pk_f32_fp8((int)w[q], false), hi = __builtin_amdgcn_cvt_pk_f32_fp8((int)w[q], true);
                    acc[4 * q] = fmaf(ck, lo.x, acc[4 * q]); acc[4 * q + 1] = fmaf(ck, lo.y, acc[4 * q + 1]);
                    acc[4 * q + 2] = fmaf(ck, hi.x, acc[4 * q + 2]); acc[4 * q + 3] = fmaf(ck, hi.y, acc[4 * q + 3]);
                }
            }
        }
        float s = 0.f;
#pragma unroll
        for (int j = 0; j < 16; ++j) { xf[j] = ALPHA * xf[j] + acc[j]; s += xf[j]; }
        for (int o = 32; o; o >>= 1) s += __shfl_xor(s, o);
        const float mean = s * (1.f / ND);
        float s2 = 0.f;
#pragma unroll
        for (int j = 0; j < 16; ++j) { xf[j] -= mean; s2 += xf[j] * xf[j]; }
        for (int o = 32; o; o >>= 1) s2 += __shfl_xor(s2, o);
        const float rs = rsqrtf(s2 * (1.f / ND) + LN_EPS);
        float o[16];
#pragma unroll
        for (int q = 0; q < 4; ++q) {
            const float4 gg = *(const float4*)(lg + lane * 16 + 4 * q), bb = *(const float4*)(lb + lane * 16 + 4 * q);
            o[4 * q] = xf[4 * q] * rs * gg.x + bb.x; o[4 * q + 1] = xf[4 * q + 1] * rs * gg.y + bb.y; o[4 * q + 2] = xf[4 * q + 2] * rs * gg.z + bb.z; o[4 * q + 3] = xf[4 * q + 3] * rs * gg.w + bb.w;
            *(float4*)(Rout + (size_t)token * ND + lane * 16 + 4 * q) = make_float4(o[4 * q], o[4 * q + 1], o[4 * q + 2], o[4 * q + 3]);
        }
        if (Hb) { st8(Hb + (size_t)token * ND + lane * 16, o); st8(Hb + (size_t)token * ND + lane * 16 + 8, o + 8); }
    }
}

__device__ __forceinline__ void nsa_compress_phase(const bf16_t* __restrict__ proj, int coloff, const float* __restrict__ pe, const float* __restrict__ w1,
                                   const float* __restrict__ w2, float* __restrict__ outc, float* lds) {
    const int qtr = tidx() >> 7, tid = tidx() & 127;
    float* in = lds + qtr * 2176;
    float* hid = in + 2048;
    for (int it = blockIdx.x; it < NB * 127; it += gridDim.x) {
        const int g = qtr, n = it % 127, b = it / 127;
        __syncthreads();
        for (int idx = tid; idx < 2048; idx += 128) {
            const int l = idx >> 6, d = idx & 63;
            in[idx] = bf2f(proj[(size_t)(b * NL + 16 * n + l) * ODD_PAD + coloff + g * 64 + d]) + pe[l * 64 + d];
        }
        __syncthreads();
        float a = 0.f;
        for (int i = 0; i < 2048; ++i) a += in[i] * w1[(size_t)i * 128 + tid];
        hid[tid] = gelu_tanh(a);
        __syncthreads();
        if (tid < 64) {
            float o = 0.f;
            for (int j = 0; j < 128; ++j) o += hid[j] * w2[j * 64 + tid];
            outc[((size_t)(b * 127 + n) * 4 + g) * 64 + tid] = o;
        }
    }
    __syncthreads();
}

__device__ __forceinline__ void nsa_cmp_phase(const bf16_t* __restrict__ proj, const float* __restrict__ kcmp, const float* __restrict__ vcmp,
                              bf16_t* __restrict__ O, unsigned* __restrict__ selmask, float* lds) {
    const int half = tidx() >> 8, tid = tidx() & 255;
    float* kc_s = lds + half * 18368;
    float* vc_s = kc_s + 127 * 64;
    float(*imp_s)[33] = (float(*)[33])(vc_s + 127 * 64);
    const int tk = tid >> 2, r = tid & 3;
    for (int it = blockIdx.x; it < 32 * 4 * NB / 2; it += gridDim.x) {
        const int vb = it * 2 + half;
        const int tile = vb & 31, g = (vb >> 5) & 3, b = vb >> 7;
        const int t = tile * 64 + tk, hd = g * 4 + r;
        __syncthreads();
        for (int idx = tid; idx < 127 * 64; idx += 256) { const int n = idx >> 6, d = idx & 63; kc_s[idx] = kcmp[((size_t)(b * 127 + n) * 4 + g) * 64 + d]; vc_s[idx] = vcmp[((size_t)(b * 127 + n) * 4 + g) * 64 + d]; }
        const bf16_t* prow = proj + (size_t)(b * NL + t) * ODD_PAD;
        float q[64];
#pragma unroll
        for (int d = 0; d < 64; d += 8) ld8(prow + hd * 64 + d, q + d);
        const float slope = exp2f(-0.5f * (float)(hd + 1));
        int nvalid = (t >= 31) ? ((t - 31) / 16 + 1) : 0;
        if (nvalid > 127) nvalid = 127;
        __syncthreads();
        float m = -INFINITY, l = 0.f;
        for (int n = 0; n < nvalid; ++n) {
            float s = 0.f;
#pragma unroll
            for (int d = 0; d < 64; ++d) s += q[d] * kc_s[n * 64 + d];
            s = s * 0.125f - slope * (float)(t - (16 * n + 31));
            const float mn = fmaxf(m, s);
            l = l * expf(m - mn) + expf(s - mn);
            m = mn;
        }
        const float inv_l = (nvalid > 0) ? 1.f / fmaxf(l, 1e-30f) : 0.f;
        float acc[64];
#pragma unroll
        for (int d = 0; d < 64; ++d) acc[d] = 0.f;
        float prev3 = 0.f;
        for (int j = 0; j < 32; ++j) {
            float pj[4];
#pragma unroll
            for (int nn = 0; nn < 4; ++nn) {
                const int n = 4 * j + nn;
                float p = 0.f;
                if (n < nvalid) {
                    float s = 0.f;
#pragma unroll
                    for (int d = 0; d < 64; ++d) s += q[d] * kc_s[n * 64 + d];
                    s = s * 0.125f - slope * (float)(t - (16 * n + 31));
                    p = expf(s - m) * inv_l;
                    const float* vr = vc_s + n * 64;
#pragma unroll
                    for (int d = 0; d < 64; ++d) acc[d] += p * vr[d];
                }
                pj[nn] = p;
            }
            float im = 0.5f * prev3 + pj[0] + pj[1] + pj[2] + 0.5f * pj[3];
            prev3 = pj[3];
            im += __shfl_xor(im, 1);
            im += __shfl_xor(im, 2);
            if (r == 0) imp_s[tk][j] = im;
        }
        const float g0 = sigmoidf_(bf2f(prow[2048 + hd]));
#pragma unroll
        for (int d = 0; d < 64; ++d) acc[d] *= g0;
#pragma unroll
        for (int d = 0; d < 64; d += 8) st8(O + (size_t)(b * NL + t) * ND + hd * 64 + d, acc + d);
        __syncthreads();
        const int cur = tile;
        unsigned bits = 0;
        for (int jj = 0; jj < 8; ++jj) {
            const int j = r * 8 + jj;
            const bool fj = (j == 0) || (j == cur) || (j == cur - 1);
            const float vj = (j <= cur) ? imp_s[tk][j] + (fj ? 1000.f : 0.f) : -INFINITY;
            int rank = 0;
            for (int k = 0; k < 32; ++k) {
                const bool fk = (k == 0) || (k == cur) || (k == cur - 1);
                const float vk = (k <= cur) ? imp_s[tk][k] + (fk ? 1000.f : 0.f) : -INFINITY;
                rank += (vk > vj || (vk == vj && k < j)) ? 1 : 0;
            }
            if (rank < 16) bits |= 1u << j;
        }
        bits |= __shfl_xor(bits, 1);
        bits |= __shfl_xor(bits, 2);
        if (r == 0) selmask[(size_t)(b * 4 + g) * NL + t] = bits;
    }
    __syncthreads();
}

__device__ __forceinline__ void nsa_selwin_phase(const bf16_t* __restrict__ proj, const unsigned* __restrict__ selmask, bf16_t* O, float* lds) {
    const int half = tidx() >> 8, tid = tidx() & 255;
    float(*k_s)[64] = (float(*)[64])(lds + half * 8192);
    float(*v_s)[64] = (float(*)[64])(lds + half * 8192 + 4096);
    const int tk = tid >> 2, r = tid & 3;
    for (int it = blockIdx.x; it < 32 * 32; it += gridDim.x) {
        const int tile = 31 - (it >> 5);
        const int bgi = (it & 31) * 2 + half, g = bgi & 3, b = bgi >> 2;
        const int t = tile * 64 + tk, hd = g * 4 + r;
        const bf16_t* pb = proj + (size_t)b * NL * ODD_PAD;
        const bf16_t* prow = pb + (size_t)t * ODD_PAD;
        float q[64], acc[64];
#pragma unroll
        for (int d = 0; d < 64; d += 8) ld8(prow + hd * 64 + d, q + d);
        const float slope = exp2f(-0.5f * (float)(hd + 1));
        const unsigned mask = selmask[(size_t)(b * 4 + g) * NL + t];
        bf16_t* orow = O + (size_t)(b * NL + t) * ND + hd * 64;
        for (int branch = 0; branch < 2; ++branch) {
            const int kcol = (branch == 0 ? 1536 : 2048) + g * 64, vcol = kcol + 256;
            const int j0 = (branch == 0) ? 0 : (tile >= 8 ? tile - 8 : 0);
            float m = -1e30f, l = 0.f;
#pragma unroll
            for (int d = 0; d < 64; ++d) acc[d] = 0.f;
            for (int j = j0; j <= tile; ++j) {
                __syncthreads();
                for (int i = 0; i < 16; ++i) {
                    const int idx = tid + 256 * i, key = idx >> 6, d = idx & 63;
                    k_s[key][d] = bf2f(pb[(size_t)(64 * j + key) * ODD_PAD + kcol + d]);
                    v_s[key][d] = bf2f(pb[(size_t)(64 * j + key) * ODD_PAD + vcol + d]);
                }
                __syncthreads();
                const bool take = (branch == 0) ? ((mask >> j) & 1u) : true;
                if (take) {
                    for (int s = 0; s < 64; ++s) {
                        const int dist = t - (64 * j + s);
                        const bool valid = (branch == 0) ? (dist >= 0) : (dist >= 0 && dist < 512);
                        float sc = 0.f;
#pragma unroll
                        for (int d = 0; d < 64; ++d) sc += q[d] * k_s[s][d];
                        sc = sc * 0.125f - slope * (float)dist;
                        const float mn = valid ? fmaxf(m, sc) : m;
                        const float scale = expf(m - mn);
                        const float p = valid ? expf(sc - mn) : 0.f;
                        l = l * scale + p;
#pragma unroll
                        for (int d = 0; d < 64; ++d) acc[d] = acc[d] * scale + p * v_s[s][d];
                        m = mn;
                    }
                }
            }
            const float gt = sigmoidf_(bf2f(prow[2560 + (branch + 1) * 16 + hd]));
            const float f = gt / fmaxf(l, 1e-30f);
#pragma unroll
            for (int d = 0; d < 64; d += 8) {
                float o[8];
                ld8(orow + d, o);
#pragma unroll
                for (int j = 0; j < 8; ++j) o[j] += f * acc[d + j];
                st8(orow + d, o);
            }
        }
    }
    __syncthreads();
}


typedef float f32x16 __attribute__((ext_vector_type(16)));
#define MFMA32(a, b, c) __builtin_amdgcn_mfma_f32_32x32x16_bf16((a), (b), (c), 0, 0, 0)
__device__ __forceinline__ unsigned cvtpk(float lo, float hi) { const f32x2_t f = {lo, hi}; return __builtin_bit_cast(unsigned, __builtin_convertvector(f, bf16x2_t)); }
__device__ __forceinline__ int crow32(int reg, int h) { return (reg & 3) + 8 * (reg >> 2) + 4 * h; }
constexpr float LOG2E = 1.4426950408889634f;
__device__ __forceinline__ void nsa_attn_phase(const bf16_t* __restrict__ proj, const bf16_t* __restrict__ vt, const unsigned* __restrict__ selmask, bf16_t* O, unsigned char* lds) {
    const int tid = tidx(), wave = __builtin_amdgcn_readfirstlane(tid >> 6), lane = tid & 63, l31 = lane & 31, h = lane >> 5;
    const int r = wave & 3, thalf = wave >> 2;
    const int skey = tid >> 3, spart = tid & 7;
    for (int it = blockIdx.x; it < 32 * 64; it += gridDim.x) {
        const int tile = 31 - (it >> 6), bg = it & 63, g = bg & 3, b = bg >> 2;
        const int hd = g * 4 + r, tokoff = thalf * 32 + l31, tok = tile * 64 + tokoff;
        const size_t trow = (size_t)(b * NL + tok);
        const float slope = exp2f(-0.5f * (float)(hd + 1));
        bf16x8_t Qf[4];
#pragma unroll
        for (int ds = 0; ds < 4; ++ds) {
            float q[8];
            ld8(proj + trow * ODD_PAD + hd * 64 + 16 * ds + 8 * h, q);
            u32x4 w; w.x = cvtpk(q[0] * 0.125f, q[1] * 0.125f); w.y = cvtpk(q[2] * 0.125f, q[3] * 0.125f); w.z = cvtpk(q[4] * 0.125f, q[5] * 0.125f); w.w = cvtpk(q[6] * 0.125f, q[7] * 0.125f);
            Qf[ds] = __builtin_bit_cast(bf16x8_t, w);
        }
        float sc[16];
#pragma unroll
        for (int reg = 0; reg < 16; ++reg) sc[reg] = slope * (float)crow32(reg, h);
        const unsigned mymask = selmask[(size_t)(b * 4 + g) * NL + tok];
        __syncthreads();
        if (wave == 0) {
            unsigned m = selmask[(size_t)(b * 4 + g) * NL + tile * 64 + lane];
            for (int o = 32; o; o >>= 1) m |= __shfl_xor(m, o);
            if (lane == 0) *(unsigned*)(lds + 35840) = m;
        }
        __syncthreads();
        const unsigned causal = (tile == 31) ? 0xffffffffu : ((2u << tile) - 1u);
        const unsigned U = *(const unsigned*)(lds + 35840) & causal;
        float outv[32];
#pragma unroll
        for (int i = 0; i < 32; ++i) outv[i] = 0.f;
#pragma unroll 1
        for (int branch = 0; branch < 2; ++branch) {
            unsigned todo = (branch == 0) ? U : (causal & ~((1u << (tile >= 8 ? tile - 8 : 0)) - 1u));
            const bf16_t* kbase = proj + (size_t)b * NL * ODD_PAD + (branch == 0 ? 1536 : 1792) + g * 64 + (size_t)skey * ODD_PAD + 8 * spart;
            const bf16_t* vbase = vt + (size_t)(branch * 256 + g * 64 + skey) * NT + (size_t)b * NL + 8 * spart;
            float m_run = -1e30f, l_run = 0.f;
            f32x16 Oa[2];
#pragma unroll
            for (int i = 0; i < 16; ++i) { Oa[0][i] = 0.f; Oa[1][i] = 0.f; }
            int jcur = __ffs(todo) - 1; todo &= todo - 1;
            uint4 kreg = *(const uint4*)(kbase + (size_t)(64 * jcur) * ODD_PAD);
            uint4 vreg = *(const uint4*)(vbase + 64 * jcur);
            int buf = 0;
            __syncthreads();
            *(uint4*)(lds + skey * 144 + spart * 16) = kreg;
            *(uint2*)(lds + 18432 + skey * 136 + spart * 16) = make_uint2(vreg.x, vreg.y);
            *(uint2*)(lds + 18432 + skey * 136 + spart * 16 + 8) = make_uint2(vreg.z, vreg.w);
            __syncthreads();
            for (;;) {
                const int jnext = todo ? (__ffs(todo) - 1) : -1;
                todo &= todo - 1;
                if (jnext >= 0) { kreg = *(const uint4*)(kbase + (size_t)(64 * jnext) * ODD_PAD); vreg = *(const uint4*)(vbase + 64 * jnext); }
                const unsigned char* Ks = lds + buf * 9216;
                const unsigned char* Vs = lds + 18432 + buf * 8704;
                const bool mysel = (branch == 1) || ((mymask >> jcur) & 1u);
                if (__any(mysel)) {
                    const bool diag = (jcur == tile), wedge = (branch == 1) && (jcur == tile - 8);
                    const float init = mysel ? slope * (float)(64 * (jcur - tile)) : -1e30f;
                    float sv[32];
#pragma unroll
                    for (int kt = 0; kt < 2; ++kt) {
                        f32x16 acc;
                        const float i0 = init + slope * (float)(32 * kt);
#pragma unroll
                        for (int i = 0; i < 16; ++i) acc[i] = i0;
#pragma unroll
                        for (int ds = 0; ds < 4; ++ds) {
                            const bf16x8_t a = *(const bf16x8_t*)(Ks + (32 * kt + l31) * 144 + (16 * ds + 8 * h) * 2);
                            acc = MFMA32(a, Qf[ds], acc);
                        }
#pragma unroll
                        for (int reg = 0; reg < 16; ++reg) {
                            float sval = acc[reg] + sc[reg];
                            const int keyoff = 32 * kt + crow32(reg, h);
                            if (diag) sval = (keyoff <= tokoff) ? sval : -1e30f;
                            if (wedge) sval = (keyoff > tokoff) ? sval : -1e30f;
                            sv[kt * 16 + reg] = sval;
                        }
                    }
                    float mx = sv[0];
#pragma unroll
                    for (int i = 1; i < 32; ++i) mx = fmaxf(mx, sv[i]);
                    mx = fmaxf(mx, __shfl_xor(mx, 32));
                    const float m_new = fmaxf(m_run, mx), m_use = fmaxf(m_new, -1e29f);
                    const float alpha = __builtin_amdgcn_exp2f((m_run - m_use) * LOG2E);
                    const float moff = -m_use * LOG2E;
                    float psum = 0.f;
#pragma unroll
                    for (int i = 0; i < 32; ++i) { sv[i] = __builtin_amdgcn_exp2f(fmaf(sv[i], LOG2E, moff)); psum += sv[i]; }
                    l_run = l_run * alpha + psum; m_run = m_new;
#pragma unroll
                    for (int i = 0; i < 16; ++i) { Oa[0][i] *= alpha; Oa[1][i] *= alpha; }
                    bf16x8_t Pf[4];
#pragma unroll
                    for (int ks = 0; ks < 4; ++ks) {
                        u32x4 w; w.x = cvtpk(sv[ks * 8 + 0], sv[ks * 8 + 1]); w.y = cvtpk(sv[ks * 8 + 2], sv[ks * 8 + 3]); w.z = cvtpk(sv[ks * 8 + 4], sv[ks * 8 + 5]); w.w = cvtpk(sv[ks * 8 + 6], sv[ks * 8 + 7]);
                        Pf[ks] = __builtin_bit_cast(bf16x8_t, w);
                    }
#pragma unroll
                    for (int mt = 0; mt < 2; ++mt)
#pragma unroll
                        for (int ks = 0; ks < 4; ++ks) {
                            const unsigned char* vp = Vs + (32 * mt + l31) * 136 + (16 * ks + 4 * h) * 2;
                            const uint2 lo = *(const uint2*)vp, hi = *(const uint2*)(vp + 16);
                            u32x4 w; w.x = lo.x; w.y = lo.y; w.z = hi.x; w.w = hi.y;
                            Oa[mt] = MFMA32(__builtin_bit_cast(bf16x8_t, w), Pf[ks], Oa[mt]);
                        }
                }
                if (jnext < 0) break;
                *(uint4*)(lds + (buf ^ 1) * 9216 + skey * 144 + spart * 16) = kreg;
                *(uint2*)(lds + 18432 + (buf ^ 1) * 8704 + skey * 136 + spart * 16) = make_uint2(vreg.x, vreg.y);
                *(uint2*)(lds + 18432 + (buf ^ 1) * 8704 + skey * 136 + spart * 16 + 8) = make_uint2(vreg.z, vreg.w);
                __syncthreads();
                buf ^= 1; jcur = jnext;
            }
            const float l_tot = l_run + __shfl_xor(l_run, 32);
            const float gt = sigmoidf_(bf2f(proj[trow * ODD_PAD + 2048 + (branch + 1) * 16 + hd]));
            const float f = gt / fmaxf(l_tot, 1e-30f);
#pragma unroll
            for (int i = 0; i < 16; ++i) { outv[i] += f * Oa[0][i]; outv[16 + i] += f * Oa[1][i]; }
        }
        bf16_t* orow = O + trow * ND + hd * 64;
#pragma unroll
        for (int mt = 0; mt < 2; ++mt)
#pragma unroll
            for (int q4 = 0; q4 < 4; ++q4) {
                bf16_t* op = orow + 32 * mt + 8 * q4 + 4 * h;
                const uint2 old = *(const uint2*)op;
                const float o0 = __uint_as_float(old.x << 16) + outv[mt * 16 + q4 * 4 + 0], o1 = __uint_as_float(old.x & 0xffff0000u) + outv[mt * 16 + q4 * 4 + 1];
                const float o2 = __uint_as_float(old.y << 16) + outv[mt * 16 + q4 * 4 + 2], o3 = __uint_as_float(old.y & 0xffff0000u) + outv[mt * 16 + q4 * 4 + 3];
                *(uint2*)op = make_uint2(cvtpk(o0, o1), cvtpk(o2, o3));
            }
    }
    __syncthreads();
}


__device__ __forceinline__ void nsa_compress2_phase(const bf16_t* __restrict__ proj, const bf16_t* __restrict__ w1t  , const bf16_t* __restrict__ w2t  ,
                                                    const float* __restrict__ bias1  , bf16_t* __restrict__ kcmp  , bf16_t* __restrict__ vcmpT  ,
                                                    unsigned char* lds) {
    const int tid = tidx(), wave = __builtin_amdgcn_readfirstlane(tid >> 6), lane = tid & 63, fr = lane & 15, fq = lane >> 4;
    unsigned char* xs = lds;
    unsigned char* hs = lds + 34816;
    for (int it = blockIdx.x; it < 1024; it += gridDim.x) {
        const int which = it >> 9, ntile = it & 7, g = (it >> 3) & 3, b = (it >> 5) & 15;
        const int t0 = 256 * ntile, coloff = (which ? 1280 : 1024) + g * 64;
        __syncthreads();
        for (int pc = tid; pc < 272 * 8; pc += NTHR) {
            const int tk = pc >> 3, c = pc & 7;
            int tsrc = t0 + tk; tsrc = tsrc > NL - 1 ? NL - 1 : tsrc;
            *(uint4*)(xs + tk * 128 + ((c ^ ((tk >> 4) & 7)) << 4)) = *(const uint4*)(proj + (size_t)(b * NL + tsrc) * ODD_PAD + coloff + 8 * c);
        }
        __syncthreads();
        f32x4 acc = {0.f, 0.f, 0.f, 0.f};
        const bf16_t* wrow = w1t + ((size_t)which * 128 + 16 * wave + fr) * 2048 + 8 * fq;
#pragma unroll 8
        for (int ks = 0; ks < 64; ++ks) {
            const int l = ks >> 1, tk = 16 * fr + l, c = 4 * (ks & 1) + fq;
            const bf16x8_t a = *(const bf16x8_t*)(xs + tk * 128 + ((c ^ ((tk >> 4) & 7)) << 4));
            const bf16x8_t bfrag = *(const bf16x8_t*)(wrow + 32 * ks);
            acc = __builtin_amdgcn_mfma_f32_16x16x32_bf16(a, bfrag, acc, 0, 0, 0);
        }
        {
            const float bj = bias1[which * 128 + 16 * wave + fr];
#pragma unroll
            for (int reg = 0; reg < 4; ++reg) *(bf16_t*)(hs + (4 * fq + reg) * 272 + (16 * wave + fr) * 2) = f2bf(gelu_fast(acc[reg] + bj));
        }
        __syncthreads();
        if (wave < 4) {
            f32x4 o = {0.f, 0.f, 0.f, 0.f};
#pragma unroll
            for (int ks = 0; ks < 4; ++ks) {
                const bf16x8_t a = *(const bf16x8_t*)(hs + fr * 272 + (32 * ks + 8 * fq) * 2);
                const bf16x8_t bfrag = *(const bf16x8_t*)(w2t + ((size_t)which * 64 + 16 * wave + fr) * 128 + 32 * ks + 8 * fq);
                o = __builtin_amdgcn_mfma_f32_16x16x32_bf16(a, bfrag, o, 0, 0, 0);
            }
            const int c = 16 * wave + fr;
#pragma unroll
            for (int reg = 0; reg < 4; ++reg) {
                const int n = 16 * ntile + 4 * fq + reg;
                const bf16_t val = (n < 127) ? f2bf(o[reg]) : (bf16_t)0;
                if (which == 0) kcmp[((size_t)(b * 4 + g) * 128 + n) * 64 + c] = val;
                else vcmpT[((size_t)(b * 4 + g) * 64 + c) * 128 + n] = val;
            }
        }
    }
    __syncthreads();
}

__device__ __forceinline__ void nsa_cmp2_phase(const bf16_t* __restrict__ proj, const bf16_t* __restrict__ kcmp, const bf16_t* __restrict__ vcmpT,
                                               bf16_t* __restrict__ O, unsigned* __restrict__ selmask, unsigned char* lds) {
    const int tid = tidx(), wave = __builtin_amdgcn_readfirstlane(tid >> 6), lane = tid & 63, l31 = lane & 31, h = lane >> 5;
    const int r = wave & 3, thalf = wave >> 2;
    unsigned char* Kc = lds;
    unsigned char* Vc = lds + 18432;
    float* impS = (float*)(lds + 35328);
    float* invS = (float*)(lds + 35328 + 32768);
    for (int it = blockIdx.x; it < 32 * 64; it += gridDim.x) {
        const int tile = 31 - (it >> 6), bg = it & 63, g = bg & 3, b = bg >> 2;
        const int hd = g * 4 + r, tokoff = thalf * 32 + l31, tok = tile * 64 + tokoff;
        const size_t trow = (size_t)(b * NL + tok);
        const float slope = exp2f(-0.5f * (float)(hd + 1));
        __syncthreads();
#pragma unroll
        for (int i = 0; i < 2; ++i) {
            const int pc = tid + 512 * i;
            { const int row = pc >> 3, c = pc & 7; *(uint4*)(Kc + row * 144 + c * 16) = *(const uint4*)(kcmp + ((size_t)(b * 4 + g) * 128 + row) * 64 + 8 * c); }
            { const int row = pc >> 4, c = pc & 15; const uint4 v = *(const uint4*)(vcmpT + ((size_t)(b * 4 + g) * 64 + row) * 128 + 8 * c);
              *(uint2*)(Vc + row * 264 + c * 16) = make_uint2(v.x, v.y); *(uint2*)(Vc + row * 264 + c * 16 + 8) = make_uint2(v.z, v.w); }
        }
        bf16x8_t Qf[4];
#pragma unroll
        for (int ds = 0; ds < 4; ++ds) {
            float q[8];
            ld8(proj + trow * ODD_PAD + hd * 64 + 16 * ds + 8 * h, q);
            u32x4 w; w.x = cvtpk(q[0] * 0.125f, q[1] * 0.125f); w.y = cvtpk(q[2] * 0.125f, q[3] * 0.125f); w.z = cvtpk(q[4] * 0.125f, q[5] * 0.125f); w.w = cvtpk(q[6] * 0.125f, q[7] * 0.125f);
            Qf[ds] = __builtin_bit_cast(bf16x8_t, w);
        }
        int nvalid = (tok >= 31) ? ((tok - 31) / 16 + 1) : 0;
        nvalid = nvalid > 127 ? 127 : nvalid;
        __syncthreads();
        float mx = -1e30f;
#pragma unroll 1
        for (int kt = 0; kt < 4; ++kt) {
            f32x16 acc;
            const float i0 = slope * (float)(512 * kt);
#pragma unroll
            for (int i = 0; i < 16; ++i) acc[i] = i0;
#pragma unroll
            for (int ds = 0; ds < 4; ++ds) {
                const bf16x8_t a = *(const bf16x8_t*)(Kc + (32 * kt + l31) * 144 + (16 * ds + 8 * h) * 2);
                acc = MFMA32(a, Qf[ds], acc);
            }
#pragma unroll
            for (int reg = 0; reg < 16; ++reg) {
                const int n = 32 * kt + crow32(reg, h);
                const float sval = acc[reg] + slope * (float)(16 * crow32(reg, h));
                mx = fmaxf(mx, (n < nvalid) ? sval : -1e30f);
            }
        }
        mx = fmaxf(mx, __shfl_xor(mx, 32));
        const float moff = -fmaxf(mx, -1e29f) * LOG2E;
        float psum = 0.f, prev_pe = 0.f;
        f32x16 Oa[2];
#pragma unroll
        for (int i = 0; i < 16; ++i) { Oa[0][i] = 0.f; Oa[1][i] = 0.f; }
#pragma unroll 1
        for (int kt = 0; kt < 4; ++kt) {
            f32x16 acc;
            const float i0 = slope * (float)(512 * kt);
#pragma unroll
            for (int i = 0; i < 16; ++i) acc[i] = i0;
#pragma unroll
            for (int ds = 0; ds < 4; ++ds) {
                const bf16x8_t a = *(const bf16x8_t*)(Kc + (32 * kt + l31) * 144 + (16 * ds + 8 * h) * 2);
                acc = MFMA32(a, Qf[ds], acc);
            }
            float sv[16];
#pragma unroll
            for (int reg = 0; reg < 16; ++reg) {
                const int n = 32 * kt + crow32(reg, h);
                const float sval = acc[reg] + slope * (float)(16 * crow32(reg, h));
                sv[reg] = __builtin_amdgcn_exp2f(fmaf((n < nvalid) ? sval : -1e30f, LOG2E, moff));
                psum += sv[reg];
            }
#pragma unroll
            for (int q = 0; q < 4; ++q) {
                const float e = 0.5f * sv[q * 4 + 3];
                const float own = sv[q * 4] + sv[q * 4 + 1] + sv[q * 4 + 2] + e;
                const float pe = __shfl_xor(e, 32);
                impS[(r * 64 + tokoff) * 32 + 8 * kt + 2 * q + h] = own + (h ? pe : prev_pe);
                prev_pe = pe;
            }
#pragma unroll
            for (int s2 = 0; s2 < 2; ++s2) {
                u32x4 w; w.x = cvtpk(sv[s2 * 8 + 0], sv[s2 * 8 + 1]); w.y = cvtpk(sv[s2 * 8 + 2], sv[s2 * 8 + 3]); w.z = cvtpk(sv[s2 * 8 + 4], sv[s2 * 8 + 5]); w.w = cvtpk(sv[s2 * 8 + 6], sv[s2 * 8 + 7]);
                const bf16x8_t pf = __builtin_bit_cast(bf16x8_t, w);
#pragma unroll
                for (int mt = 0; mt < 2; ++mt) {
                    const unsigned char* vp = Vc + (32 * mt + l31) * 264 + (32 * kt + 16 * s2 + 4 * h) * 2;
                    const uint2 lo = *(const uint2*)vp, hi = *(const uint2*)(vp + 16);
                    u32x4 a; a.x = lo.x; a.y = lo.y; a.z = hi.x; a.w = hi.y;
                    Oa[mt] = MFMA32(__builtin_bit_cast(bf16x8_t, a), pf, Oa[mt]);
                }
            }
        }
        psum += __shfl_xor(psum, 32);
        const float inv = (nvalid > 0) ? 1.f / fmaxf(psum, 1e-30f) : 0.f;
        if (h == 0) invS[r * 64 + tokoff] = inv;
        const float g0 = sigmoidf_(bf2f(proj[trow * ODD_PAD + 2048 + hd])) * inv;
        bf16_t* orow = O + trow * ND + hd * 64;
#pragma unroll
        for (int mt = 0; mt < 2; ++mt)
#pragma unroll
            for (int q4 = 0; q4 < 4; ++q4)
                *(uint2*)(orow + 32 * mt + 8 * q4 + 4 * h) = make_uint2(cvtpk(g0 * Oa[mt][q4 * 4], g0 * Oa[mt][q4 * 4 + 1]), cvtpk(g0 * Oa[mt][q4 * 4 + 2], g0 * Oa[mt][q4 * 4 + 3]));
        __syncthreads();
        float* impT = (float*)Kc;
#pragma unroll
        for (int i = 0; i < 4; ++i) {
            const int pc = tid + 512 * i, tk = pc >> 5, j = pc & 31, cur = tile;
            const float ij = impS[(0 * 64 + tk) * 32 + j] * invS[tk] + impS[(1 * 64 + tk) * 32 + j] * invS[64 + tk] + impS[(2 * 64 + tk) * 32 + j] * invS[128 + tk] + impS[(3 * 64 + tk) * 32 + j] * invS[192 + tk];
            const bool fj = (j == 0) || (j == cur) || (j == cur - 1);
            impT[tk * 33 + j] = (j <= cur) ? ij + (fj ? 1000.f : 0.f) : -INFINITY;
        }
        __syncthreads();
        if (tid < 256) {
            const int tk = tid >> 2, rr = tid & 3;
            unsigned bits = 0;
#pragma unroll 1
            for (int jj = 0; jj < 8; ++jj) {
                const int j = rr * 8 + jj;
                const float vj = impT[tk * 33 + j];
                int rank = 0;
#pragma unroll 8
                for (int k = 0; k < 32; ++k) {
                    const float vk = impT[tk * 33 + k];
                    rank += (vk > vj || (vk == vj && k < j)) ? 1 : 0;
                }
                if (rank < 16) bits |= 1u << j;
            }
            bits |= __shfl_xor(bits, 1);
            bits |= __shfl_xor(bits, 2);
            if (rr == 0) selmask[(size_t)(b * 4 + g) * NL + tile * 64 + tk] = bits;
        }
    }
    __syncthreads();
}


constexpr int P0W = 1792;
constexpr float LN2F = 0.6931471805599453f;
__device__ __forceinline__ void sb_attn2_phase(const bf16_t* __restrict__ proj, const bf16_t* __restrict__ vt, bf16_t* __restrict__ Y, unsigned char* lds) {
    const int tid = tidx(), wave = __builtin_amdgcn_readfirstlane(tid >> 6), lane = tid & 63, l31 = lane & 31, h = lane >> 5;
    const int skey = tid >> 3, spart = tid & 7;
    for (int it = blockIdx.x; it < NB * 12 * 8; it += gridDim.x) {
        const int tile = 7 - (it / 192), bh = it % 192, hh = bh % 12, b = bh / 12;
        const int qlo = tile * 256 + 32 * wave, tq = qlo + l31;
        const size_t trow = (size_t)(b * NL + tq);
        bf16x8_t Qf[4];
#pragma unroll
        for (int ds = 0; ds < 4; ++ds) {
            float q[8];
            ld8(proj + trow * P0W + 256 + hh * 64 + 16 * ds + 8 * h, q);
            u32x4 w; w.x = cvtpk(q[0] * 0.125f, q[1] * 0.125f); w.y = cvtpk(q[2] * 0.125f, q[3] * 0.125f); w.z = cvtpk(q[4] * 0.125f, q[5] * 0.125f); w.w = cvtpk(q[6] * 0.125f, q[7] * 0.125f);
            Qf[ds] = __builtin_bit_cast(bf16x8_t, w);
        }
        const bf16_t* kbase = proj + (size_t)b * NL * P0W + 1024 + hh * 64 + (size_t)skey * P0W + 8 * spart;
        const bf16_t* vbase = vt + (size_t)(hh * 64 + skey) * NT + (size_t)b * NL + 8 * spart;
        f32x16 Oa[2];
#pragma unroll
        for (int i = 0; i < 16; ++i) { Oa[0][i] = 0.f; Oa[1][i] = 0.f; }
        float carry = 0.f;
        int j = tile * 4 + 3, buf = 0;
        uint4 kreg = *(const uint4*)(kbase + (size_t)(64 * j) * P0W);
        uint4 vreg = *(const uint4*)(vbase + 64 * j);
        __syncthreads();
        *(uint4*)(lds + skey * 144 + spart * 16) = kreg;
        *(uint2*)(lds + 18432 + skey * 136 + spart * 16) = make_uint2(vreg.x, vreg.y);
        *(uint2*)(lds + 18432 + skey * 136 + spart * 16 + 8) = make_uint2(vreg.z, vreg.w);
        __syncthreads();
        for (;;) {
            const int jn = j - 1;
            if (jn >= 0) { kreg = *(const uint4*)(kbase + (size_t)(64 * jn) * P0W); vreg = *(const uint4*)(vbase + 64 * jn); }
            const unsigned char* Ks = lds + buf * 9216;
            const unsigned char* Vs = lds + 18432 + buf * 8704;
            const bool live = (64 * j <= qlo + 30) && !__all(carry < -110.f);
            if (live) {
#pragma unroll
                for (int kti = 0; kti < 2; ++kti) {
                    const int kt = 1 - kti;
                    f32x16 acc;
#pragma unroll
                    for (int i = 0; i < 16; ++i) acc[i] = 0.f;
#pragma unroll
                    for (int ds = 0; ds < 4; ++ds) {
                        const bf16x8_t a = *(const bf16x8_t*)(Ks + (32 * kt + l31) * 144 + (16 * ds + 8 * h) * 2);
                        acc = MFMA32(a, Qf[ds], acc);
                    }
                    float m1[16], lz[16];
#pragma unroll
                    for (int reg = 0; reg < 16; ++reg) {
                        const float z = acc[reg];
                        const bool valid = (64 * j + 32 * kt + crow32(reg, h)) < tq;
                        const float e = __builtin_amdgcn_exp2f(-fabsf(z) * LOG2E);
                        const float sp = fmaxf(z, 0.f) + __builtin_amdgcn_logf(1.f + e) * LN2F;
                        m1[reg] = valid ? -sp : 0.f;
                        lz[reg] = valid ? z - sp : -1e30f;
                    }
                    float G[4], T[4];
#pragma unroll
                    for (int q = 0; q < 4; ++q) G[q] = (m1[4 * q] + m1[4 * q + 1]) + (m1[4 * q + 2] + m1[4 * q + 3]);
                    float Gp[4];
#pragma unroll
                    for (int q = 0; q < 4; ++q) { Gp[q] = __shfl_xor(G[q], 32); T[q] = G[q] + Gp[q]; }
                    float base[4];
                    base[3] = carry; base[2] = base[3] + T[3]; base[1] = base[2] + T[2]; base[0] = base[1] + T[1];
                    const float tot = base[0] + T[0];
#pragma unroll
                    for (int q = 0; q < 4; ++q) {
                        const float bq = base[q] + (h ? 0.f : Gp[q]);
                        const float t3 = bq, t2 = t3 + m1[4 * q + 3], t1 = t2 + m1[4 * q + 2], t0 = t1 + m1[4 * q + 1];
                        lz[4 * q + 3] = __builtin_amdgcn_exp2f((lz[4 * q + 3] + t3) * LOG2E);
                        lz[4 * q + 2] = __builtin_amdgcn_exp2f((lz[4 * q + 2] + t2) * LOG2E);
                        lz[4 * q + 1] = __builtin_amdgcn_exp2f((lz[4 * q + 1] + t1) * LOG2E);
                        lz[4 * q + 0] = __builtin_amdgcn_exp2f((lz[4 * q + 0] + t0) * LOG2E);
                    }
                    carry = tot;
#pragma unroll
                    for (int s2 = 0; s2 < 2; ++s2) {
                        u32x4 w; w.x = cvtpk(lz[s2 * 8 + 0], lz[s2 * 8 + 1]); w.y = cvtpk(lz[s2 * 8 + 2], lz[s2 * 8 + 3]); w.z = cvtpk(lz[s2 * 8 + 4], lz[s2 * 8 + 5]); w.w = cvtpk(lz[s2 * 8 + 6], lz[s2 * 8 + 7]);
                        const bf16x8_t pf = __builtin_bit_cast(bf16x8_t, w);
#pragma unroll
                        for (int mt = 0; mt < 2; ++mt) {
                            const unsigned char* vp = Vs + (32 * mt + l31) * 136 + (32 * kt + 16 * s2 + 4 * h) * 2;
                            const uint2 lo = *(const uint2*)vp, hi = *(const uint2*)(vp + 16);
                            u32x4 a; a.x = lo.x; a.y = lo.y; a.z = hi.x; a.w = hi.y;
                            Oa[mt] = MFMA32(__builtin_bit_cast(bf16x8_t, a), pf, Oa[mt]);
                        }
                    }
                }
            }
            if (jn >= 0) {
                *(uint4*)(lds + (buf ^ 1) * 9216 + skey * 144 + spart * 16) = kreg;
                *(uint2*)(lds + 18432 + (buf ^ 1) * 8704 + skey * 136 + spart * 16) = make_uint2(vreg.x, vreg.y);
                *(uint2*)(lds + 18432 + (buf ^ 1) * 8704 + skey * 136 + spart * 16 + 8) = make_uint2(vreg.z, vreg.w);
            }
            volatile int* flg = (volatile int*)(lds + 35840) + (j & 1) * 8;
            const int wdone = __all(carry < -110.f);
            if (lane == 0) flg[wave] = wdone;
            __syncthreads();
            const int alldone = flg[0] & flg[1] & flg[2] & flg[3] & flg[4] & flg[5] & flg[6] & flg[7];
            if (alldone || jn < 0) break;
            buf ^= 1; j = jn;
        }
        bf16_t* orow = Y + trow * ND + 256 + hh * 64;
#pragma unroll
        for (int mt = 0; mt < 2; ++mt)
#pragma unroll
            for (int q4 = 0; q4 < 4; ++q4)
                *(uint2*)(orow + 32 * mt + 8 * q4 + 4 * h) = make_uint2(cvtpk(Oa[mt][q4 * 4], Oa[mt][q4 * 4 + 1]), cvtpk(Oa[mt][q4 * 4 + 2], Oa[mt][q4 * 4 + 3]));
    }
    __syncthreads();
}

__device__ __forceinline__ void s5_scan2_phase(const bf16_t* __restrict__ proj, const float* __restrict__ lam_re, const float* __restrict__ lam_im, const float* __restrict__ log_dt,
                                               const float* __restrict__ b_re, const float* __restrict__ b_im, const float* __restrict__ c_re, const float* __restrict__ c_im,
                                               const float* __restrict__ dskip, bf16_t* __restrict__ ya, float* lds) {
    const int tid = tidx(), wave = __builtin_amdgcn_readfirstlane(tid >> 6), lane = tid & 63;
    float* cr = lds;
    float* ci = lds + 1024;
    float* Es = lds + 2048;
    float* us = lds + 3072 + wave * 512;
    float* xr = lds + 7168 + wave * 4160;
    float* xi = xr + 2080;
    for (int bg = blockIdx.x; bg < NB * 16; bg += gridDim.x) {
        const int b = bg >> 4, g = bg & 15;
        const float lr = lam_re[g * 64 + lane], li = lam_im[g * 64 + lane];
        const float dt = expf(log_dt[g]);
        const float mag = expf(lr * dt);
        const float are = mag * cosf(li * dt), aim = mag * sinf(li * dt);
        const float nr = are - 1.f, den = lr * lr + li * li;
        const float fre = (nr * lr + aim * li) / den, fim = (aim * lr - nr * li) / den;
        float bbr[16], bbi[16];
#pragma unroll
        for (int i = 0; i < 16; ++i) {
            const float br = b_re[(g * 64 + lane) * 16 + i], bi = b_im[(g * 64 + lane) * 16 + i];
            bbr[i] = fre * br - fim * bi; bbi[i] = fre * bi + fim * br;
        }
        __syncthreads();
        for (int idx = tid; idx < 1024; idx += NTHR) { cr[idx] = c_re[g * 1024 + idx]; ci[idx] = c_im[g * 1024 + idx]; }
        const bf16_t* ub = proj + (size_t)(b * NL + 256 * wave) * P0W + g * 16;
        float xre = 0.f, xim = 0.f;
        for (int c0 = 0; c0 < 256; c0 += 32) {
            wave_lds_fence();
            { float u8[8]; const int t = lane >> 1, hf = lane & 1; ld8(ub + (size_t)(c0 + t) * P0W + 8 * hf, u8);
#pragma unroll
              for (int i = 0; i < 8; ++i) us[t * 16 + 8 * hf + i] = u8[i]; }
            wave_lds_fence();
            for (int t = 0; t < 32; ++t) {
                float bur = 0.f, bui = 0.f;
#pragma unroll
                for (int i = 0; i < 16; ++i) { const float u = us[t * 16 + i]; bur += bbr[i] * u; bui += bbi[i] * u; }
                const float nre = are * xre - aim * xim + bur, nim = are * xim + aim * xre + bui;
                xre = nre; xim = nim;
            }
        }
        Es[(wave * 64 + lane) * 2] = xre; Es[(wave * 64 + lane) * 2 + 1] = xim;
        float pr = are, pi = aim;
#pragma unroll
        for (int i = 0; i < 8; ++i) { const float nr2 = pr * pr - pi * pi, ni2 = 2.f * pr * pi; pr = nr2; pi = ni2; }
        __syncthreads();
        xre = 0.f; xim = 0.f;
        for (int w2 = 0; w2 < wave; ++w2) {
            const float er = Es[(w2 * 64 + lane) * 2], ei = Es[(w2 * 64 + lane) * 2 + 1];
            const float nre = pr * xre - pi * xim + er, nim = pr * xim + pi * xre + ei;
            xre = nre; xim = nim;
        }
        const int tt = lane & 31, ih = lane >> 5;
        float dsk[8];
#pragma unroll
        for (int i = 0; i < 8; ++i) dsk[i] = dskip[g * 16 + 8 * ih + i];
        for (int c0 = 0; c0 < 256; c0 += 32) {
            wave_lds_fence();
            { float u8[8]; const int t = lane >> 1, hf = lane & 1; ld8(ub + (size_t)(c0 + t) * P0W + 8 * hf, u8);
#pragma unroll
              for (int i = 0; i < 8; ++i) us[t * 16 + 8 * hf + i] = u8[i]; }
            wave_lds_fence();
            for (int t = 0; t < 32; ++t) {
                float bur = 0.f, bui = 0.f;
#pragma unroll
                for (int i = 0; i < 16; ++i) { const float u = us[t * 16 + i]; bur += bbr[i] * u; bui += bbi[i] * u; }
                const float nre = are * xre - aim * xim + bur, nim = are * xim + aim * xre + bui;
                xre = nre; xim = nim;
                xr[t * 65 + lane] = xre; xi[t * 65 + lane] = xim;
            }
            wave_lds_fence();
            float y[8];
#pragma unroll
            for (int i = 0; i < 8; ++i) y[i] = 0.f;
            for (int p = 0; p < 64; ++p) {
                const float a = xr[tt * 65 + p], bq = xi[tt * 65 + p];
#pragma unroll
                for (int i = 0; i < 8; ++i) y[i] += cr[(8 * ih + i) * 64 + p] * a - ci[(8 * ih + i) * 64 + p] * bq;
            }
            float o[8];
#pragma unroll
            for (int i = 0; i < 8; ++i) o[i] = gelu_fast(y[i] + dsk[i] * us[tt * 16 + 8 * ih + i]);
            st8(ya + (size_t)(b * NL + 256 * wave + c0 + tt) * 256 + g * 16 + 8 * ih, o);
        }
    }
    __syncthreads();
}


__device__ __forceinline__ void glu2_phase(const bf16_t* __restrict__ ya, const bf16_t* __restrict__ wgt, const float* __restrict__ bglu, bf16_t* __restrict__ Y, unsigned char* lds) {
    const int tid = tidx(), wave = __builtin_amdgcn_readfirstlane(tid >> 6), lane = tid & 63, fr = lane & 15, fq = lane >> 4;
    __syncthreads();
    for (int pc = tid; pc < 256 * 32; pc += NTHR) { const int row = pc >> 5, c = pc & 31; *(uint4*)(lds + row * 528 + c * 16) = *(const uint4*)(wgt + row * 256 + c * 8); }
    __syncthreads();
    for (int chunk = blockIdx.x; chunk < NT / 128; chunk += gridDim.x) {
        const size_t tok = (size_t)chunk * 128 + wave * 16 + fr;
        bf16x8_t yb[8];
#pragma unroll
        for (int ks = 0; ks < 8; ++ks) yb[ks] = *(const bf16x8_t*)(ya + tok * 256 + 32 * ks + 8 * fq);
#pragma unroll 2
        for (int nt = 0; nt < 16; ++nt) {
            f32x4 acc = {0.f, 0.f, 0.f, 0.f};
#pragma unroll
            for (int ks = 0; ks < 8; ++ks) {
                const bf16x8_t a = *(const bf16x8_t*)(lds + (16 * nt + fr) * 528 + (32 * ks + 8 * fq) * 2);
                acc = __builtin_amdgcn_mfma_f32_16x16x32_bf16(a, yb[ks], acc, 0, 0, 0);
            }
            const int n0 = 16 * nt + 4 * fq;
            const uint2 yv = *(const uint2*)(ya + tok * 256 + n0);
            const float4 bb = *(const float4*)(bglu + n0);
            const float o0 = __uint_as_float(yv.x << 16) * sigmoidf_(acc[0] + bb.x), o1 = __uint_as_float(yv.x & 0xffff0000u) * sigmoidf_(acc[1] + bb.y);
            const float o2 = __uint_as_float(yv.y << 16) * sigmoidf_(acc[2] + bb.z), o3 = __uint_as_float(yv.y & 0xffff0000u) * sigmoidf_(acc[3] + bb.w);
            *(uint2*)(Y + tok * ND + n0) = make_uint2(cvtpk(o0, o1), cvtpk(o2, o3));
        }
    }
    __syncthreads();
}


__device__ __forceinline__ void cmadd(float& re, float& im, float ar, float ai, float br, float bi) {
    const float nr = fmaf(ar, re, fmaf(-ai, im, br)), ni = fmaf(ar, im, fmaf(ai, re, bi));
    re = nr; im = ni;
}
__device__ __forceinline__ void s5_scan3_phase(const bf16_t* __restrict__ proj, const float* __restrict__ lam_re, const float* __restrict__ lam_im, const float* __restrict__ log_dt,
                                               const float* __restrict__ b_re, const float* __restrict__ b_im, const float* __restrict__ c_re, const float* __restrict__ c_im,
                                               const float* __restrict__ dskip, bf16_t* __restrict__ ya, unsigned char* lds) {
    const int tid = tidx(), wave = __builtin_amdgcn_readfirstlane(tid >> 6), lane = tid & 63, l31 = lane & 31, h = lane >> 5, fr = lane & 15, fq = lane >> 4;
    unsigned char* Xs = lds + wave * 10752;
    float* Es = (float*)(lds + 86016);
    __syncthreads();
    for (int i = lane; i < 32 * 21; i += 64) *(uint4*)(Xs + i * 16) = make_uint4(0u, 0u, 0u, 0u);
    for (int bg = blockIdx.x; bg < NB * 16; bg += gridDim.x) {
        const int b = bg >> 4, g = bg & 15;
        const float dt = expf(log_dt[g]);
        float are[2], aim[2]; bf16x8_t Bre[2], Bim[2];
#pragma unroll
        for (int k = 0; k < 2; ++k) {
            const int p = 32 * k + l31;
            const float lr = lam_re[g * 64 + p], li = lam_im[g * 64 + p];
            const float mag = expf(lr * dt);
            are[k] = mag * cosf(li * dt); aim[k] = mag * sinf(li * dt);
            const float nr = are[k] - 1.f, den = lr * lr + li * li;
            const float fre = (nr * lr + aim[k] * li) / den, fim = (aim[k] * lr - nr * li) / den;
            float vr[8], vi[8];
#pragma unroll
            for (int j = 0; j < 8; ++j) {
                const float br = b_re[(g * 64 + p) * 16 + 8 * h + j], bi = b_im[(g * 64 + p) * 16 + 8 * h + j];
                vr[j] = fre * br - fim * bi; vi[j] = fre * bi + fim * br;
            }
            u32x4 w; w.x = cvtpk(vr[0], vr[1]); w.y = cvtpk(vr[2], vr[3]); w.z = cvtpk(vr[4], vr[5]); w.w = cvtpk(vr[6], vr[7]); Bre[k] = __builtin_bit_cast(bf16x8_t, w);
            w.x = cvtpk(vi[0], vi[1]); w.y = cvtpk(vi[2], vi[3]); w.z = cvtpk(vi[4], vi[5]); w.w = cvtpk(vi[6], vi[7]); Bim[k] = __builtin_bit_cast(bf16x8_t, w);
        }
        bf16x8_t Cm[5];
        {
            const float di = dskip[g * 16 + fr];
#pragma unroll
            for (int ks = 0; ks < 5; ++ks) {
                float cv[8];
#pragma unroll
                for (int j = 0; j < 8; ++j) {
                    const int kk = 32 * ks + 8 * fq + j;
                    cv[j] = kk < 64 ? c_re[(g * 16 + fr) * 64 + kk] : (kk < 128 ? -c_im[(g * 16 + fr) * 64 + kk - 64] : ((kk - 128) == fr ? di : 0.f));
                }
                u32x4 w; w.x = cvtpk(cv[0], cv[1]); w.y = cvtpk(cv[2], cv[3]); w.z = cvtpk(cv[4], cv[5]); w.w = cvtpk(cv[6], cv[7]); Cm[ks] = __builtin_bit_cast(bf16x8_t, w);
            }
        }
        float a4r[2], a4i[2], a5r[2], a5i[2], a32r[2], a32i[2], a256r[2], a256i[2];
#pragma unroll
        for (int k = 0; k < 2; ++k) {
            float pr = are[k], pi = aim[k], t;
            t = pr * pr - pi * pi; pi = 2.f * pr * pi; pr = t;
            t = pr * pr - pi * pi; pi = 2.f * pr * pi; pr = t;
            a4r[k] = pr; a4i[k] = pi;
            a5r[k] = pr * are[k] - pi * aim[k]; a5i[k] = pr * aim[k] + pi * are[k];
#pragma unroll
            for (int i = 0; i < 3; ++i) { t = pr * pr - pi * pi; pi = 2.f * pr * pi; pr = t; }
            a32r[k] = pr; a32i[k] = pi;
#pragma unroll
            for (int i = 0; i < 3; ++i) { t = pr * pr - pi * pi; pi = 2.f * pr * pi; pr = t; }
            a256r[k] = pr; a256i[k] = pi;
        }
        const bf16_t* ub = proj + (size_t)(b * NL + 256 * wave) * P0W + g * 16 + 8 * h;
        float sre[2] = {0.f, 0.f}, sim[2] = {0.f, 0.f};
#pragma unroll 1
        for (int c0 = 0; c0 < 256; c0 += 32) {
            const bf16x8_t uf = *(const bf16x8_t*)(ub + (size_t)(c0 + l31) * P0W);
#pragma unroll
            for (int k = 0; k < 2; ++k) {
                f32x16 z;
#pragma unroll
                for (int i = 0; i < 16; ++i) z[i] = 0.f;
                const f32x16 bur = MFMA32(uf, Bre[k], z), bui = MFMA32(uf, Bim[k], z);
                float er = 0.f, ei = 0.f;
#pragma unroll
                for (int reg = 0; reg < 16; ++reg) {
                    if (reg == 0) { er = bur[0]; ei = bui[0]; }
                    else if ((reg & 3) == 0) cmadd(er, ei, a5r[k], a5i[k], bur[reg], bui[reg]);
                    else cmadd(er, ei, are[k], aim[k], bur[reg], bui[reg]);
                }
                { float tr = er, ti = ei; cmadd(tr, ti, a4r[k], a4i[k], 0.f, 0.f); er = h ? er : tr; ei = h ? ei : ti; }
                er += __shfl_xor(er, 32); ei += __shfl_xor(ei, 32);
                cmadd(sre[k], sim[k], a32r[k], a32i[k], er, ei);
            }
        }
        __syncthreads();
        if (h == 0) {
#pragma unroll
            for (int k = 0; k < 2; ++k) { Es[(wave * 64 + 32 * k + l31) * 2] = sre[k]; Es[(wave * 64 + 32 * k + l31) * 2 + 1] = sim[k]; }
        }
        __syncthreads();
        float xre[2] = {0.f, 0.f}, xim[2] = {0.f, 0.f};
        for (int w2 = 0; w2 < wave; ++w2) {
#pragma unroll
            for (int k = 0; k < 2; ++k) cmadd(xre[k], xim[k], a256r[k], a256i[k], Es[(w2 * 64 + 32 * k + l31) * 2], Es[(w2 * 64 + 32 * k + l31) * 2 + 1]);
        }
#pragma unroll 1
        for (int c0 = 0; c0 < 256; c0 += 32) {
            const bf16x8_t uf = *(const bf16x8_t*)(ub + (size_t)(c0 + l31) * P0W);
            wave_lds_fence();
            *(bf16x8_t*)(Xs + l31 * 336 + 256 + 16 * h) = uf;
#pragma unroll
            for (int k = 0; k < 2; ++k) {
                f32x16 z;
#pragma unroll
                for (int i = 0; i < 16; ++i) z[i] = 0.f;
                const f32x16 bur = MFMA32(uf, Bre[k], z), bui = MFMA32(uf, Bim[k], z);
                float cr = xre[k], ci = xim[k];
#pragma unroll
                for (int q = 0; q < 4; ++q) {
                    float ar_[4], ai_[4], br_[4], bi_[4];
                    float xr_ = cr, xi_ = ci;
#pragma unroll
                    for (int r2 = 0; r2 < 4; ++r2) { cmadd(xr_, xi_, are[k], aim[k], bur[4 * q + r2], bui[4 * q + r2]); ar_[r2] = xr_; ai_[r2] = xi_; }
                    float yr_ = __shfl_xor(xr_, 32), yi_ = __shfl_xor(xi_, 32);
#pragma unroll
                    for (int r2 = 0; r2 < 4; ++r2) { cmadd(yr_, yi_, are[k], aim[k], bur[4 * q + r2], bui[4 * q + r2]); br_[r2] = yr_; bi_[r2] = yi_; }
                    const float zr_ = __shfl_xor(yr_, 32), zi_ = __shfl_xor(yi_, 32);
                    cr = h ? yr_ : zr_; ci = h ? yi_ : zi_;
#pragma unroll
                    for (int r2 = 0; r2 < 4; ++r2) {
                        const int t = 8 * q + 4 * h + r2;
                        *(bf16_t*)(Xs + t * 336 + (32 * k + l31) * 2) = f2bf(h ? br_[r2] : ar_[r2]);
                        *(bf16_t*)(Xs + t * 336 + (64 + 32 * k + l31) * 2) = f2bf(h ? bi_[r2] : ai_[r2]);
                    }
                }
                xre[k] = cr; xim[k] = ci;
            }
            wave_lds_fence();
#pragma unroll
            for (int mt = 0; mt < 2; ++mt) {
                f32x4 y = {0.f, 0.f, 0.f, 0.f};
#pragma unroll
                for (int ks = 0; ks < 5; ++ks) {
                    const bf16x8_t a = *(const bf16x8_t*)(Xs + (16 * mt + fr) * 336 + (32 * ks + 8 * fq) * 2);
                    y = __builtin_amdgcn_mfma_f32_16x16x32_bf16(a, Cm[ks], y, 0, 0, 0);
                }
#pragma unroll
                for (int reg = 0; reg < 4; ++reg)
                    ya[(size_t)(b * NL + 256 * wave + c0 + 16 * mt + 4 * fq + reg) * 256 + g * 16 + fr] = f2bf(gelu_fast(y[reg]));
            }
        }
    }
    __syncthreads();
}

struct Params {
    const float* in[29];
    float* out;
    char* ws;
    unsigned long long pad;
};

constexpr size_t SZ_PROJ = (size_t)NT * EVEN_IN * 2;
constexpr size_t SZ_VT = (size_t)768 * NT * 2;
constexpr size_t SZ_YB = (size_t)NT * ND * 2;
constexpr size_t SZ_HB = (size_t)NT * ND * 2;
constexpr size_t SZ_YA = (size_t)NT * 256 * 2;
constexpr size_t SZ_CMP = (size_t)NB * 4 * 128 * 64 * 2;
constexpr size_t SZ_SEL = (size_t)NB * 4 * NL * 4;
constexpr size_t SZ_TAB = (size_t)16384 * ND;
constexpr size_t SZ_SKB = (size_t)2 * 8 * 2 * 128 * 128 * 2;
constexpr size_t OFF_VT = SZ_PROJ, OFF_YB = OFF_VT + SZ_VT, OFF_HB = OFF_YB + SZ_YB, OFF_YA = OFF_HB + SZ_HB, OFF_KC = OFF_YA + SZ_YA, OFF_VC = OFF_KC + SZ_CMP,
                 OFF_SEL = OFF_VC + SZ_CMP, OFF_TAB = OFF_SEL + SZ_SEL, OFF_SKB = OFF_TAB + 2 * SZ_TAB, OFF_WT = OFF_SKB + SZ_SKB;
constexpr size_t WT_IN0 = 0, WT_OUT0 = WT_IN0 + (size_t)EVEN_IN * ND * 2, WT_Q0 = WT_OUT0 + (size_t)ND * ND * 2, WT_Q1 = WT_Q0 + (size_t)2048 * ND * 2,
                 WT_IN1 = WT_Q1 + (size_t)2048 * ND * 2, WT_V1 = WT_IN1 + (size_t)ODD_PAD * ND * 2, WT_OUT1 = WT_V1 + (size_t)512 * ND * 2, WT_W1 = WT_OUT1 + (size_t)ND * ND * 2, WT_W2 = WT_W1 + (size_t)2 * 128 * 2048 * 2, WT_B1 = WT_W2 + (size_t)2 * 64 * 128 * 2, WT_V0 = WT_B1 + 2 * 128 * 4, WT_GLU = WT_V0 + (size_t)768 * ND * 2, WT_END = WT_GLU + (size_t)256 * 256 * 2;
constexpr size_t OFF_BAR = OFF_WT + ((WT_END + 255) & ~(size_t)255);
constexpr size_t WS_NEED = OFF_BAR + XCD_BAR_WORDS * 4 + 256;

__device__ __forceinline__ void convert_tables(const float* __restrict__ u, const float* __restrict__ v, unsigned char* __restrict__ TAB) {
    const size_t per = (size_t)16384 * ND / 16;
    for (size_t i = (size_t)blockIdx.x * NTHR + tidx(); i < 2 * per; i += (size_t)gridDim.x * NTHR) {
        const int tb = (int)(i / per); const size_t off = (i % per) * 16;
        const float* src = (tb ? v : u) + off;
        const float sc = tb ? V_SCALE : U_SCALE;
        uint4 w; unsigned* wp = (unsigned*)&w;
#pragma unroll
        for (int q = 0; q < 4; ++q) {
            const f32x4 a = __builtin_nontemporal_load((const f32x4*)(src + 4 * q));
            int pk = __builtin_amdgcn_cvt_pk_fp8_f32(a.x * sc, a.y * sc, 0, false);
            pk = __builtin_amdgcn_cvt_pk_fp8_f32(a.z * sc, a.w * sc, pk, true);
            wp[q] = (unsigned)pk;
        }
        *(uint4*)(TAB + (size_t)tb * 16384 * ND + off) = w;
    }
}

__global__ void __launch_bounds__(NTHR) fwd_megakernel(Params p) {
    extern __shared__ __attribute__((aligned(16))) unsigned char lds_raw[];
    float* lds = (float*)lds_raw;
    cg::grid_group grid = cg::this_grid();
    const float* x = p.in[0];
    float* R = p.out;
    char* ws = p.ws;
    bf16_t* PROJ = (bf16_t*)ws;
    bf16_t* YB = (bf16_t*)(ws + OFF_YB);
    bf16_t* HB = (bf16_t*)(ws + OFF_HB);
    bf16_t* YA = (bf16_t*)(ws + OFF_YA);
    bf16_t* WGT = (bf16_t*)(ws + OFF_WT + WT_GLU);
    bf16_t* KCMP = (bf16_t*)(ws + OFF_KC);
    bf16_t* VCMP = (bf16_t*)(ws + OFF_VC);
    bf16_t* W1T = (bf16_t*)(ws + OFF_WT + WT_W1);
    bf16_t* W2T = (bf16_t*)(ws + OFF_WT + WT_W2);
    float* BIAS1 = (float*)(ws + OFF_WT + WT_B1);
    unsigned* SEL = (unsigned*)(ws + OFF_SEL);
    bf16_t* WIN0 = (bf16_t*)(ws + OFF_WT + WT_IN0);
    bf16_t* WOUT0 = (bf16_t*)(ws + OFF_WT + WT_OUT0);
    bf16_t* WQ0 = (bf16_t*)(ws + OFF_WT + WT_Q0);
    bf16_t* WQ1 = (bf16_t*)(ws + OFF_WT + WT_Q1);
    bf16_t* WIN1 = (bf16_t*)(ws + OFF_WT + WT_IN1);
    bf16_t* WOUT1 = (bf16_t*)(ws + OFF_WT + WT_OUT1);
    bf16_t* WV1 = (bf16_t*)(ws + OFF_WT + WT_V1);
    bf16_t* VT = (bf16_t*)(ws + OFF_VT);
    bf16_t* WV0 = (bf16_t*)(ws + OFF_WT + WT_V0);
    int* EIDX = (int*)YB;
    float* EGATE = (float*)((char*)YB + (size_t)NT * 128 * 4);
    unsigned char* TAB = (unsigned char*)(ws + OFF_TAB);
    bf16_t* SKB = (bf16_t*)(ws + OFF_SKB);
    const int wave = tidx() >> 6;
    if (tidx() == 0) *(uint4*)(lds_raw + LDS_BYTES - 16) = make_uint4(0u, 0u, 0u, 0u);
    __syncthreads();
    XcdBarrier xbar = xcd_barrier_post((unsigned*)(ws + OFF_BAR), (volatile LAS unsigned*)(lds_raw + LDS_BYTES - 16));

    for (size_t i = (size_t)blockIdx.x * NTHR + tidx(); i < (size_t)NT * ND / 4; i += (size_t)gridDim.x * NTHR) {
        const float4 v = ((const float4*)x)[i];
        ((float4*)R)[i] = v;
        uint2 w; w.x = pack2(v.x, v.y); w.y = pack2(v.z, v.w);
        ((uint2*)HB)[i] = w;
    }
    convert_tables(p.in[23], p.in[24], TAB);
    for (int i = blockIdx.x * NTHR + tidx(); i < 2 * 8 * 2 * 128 * 128 / 4; i += gridDim.x * NTHR) {
        const float4 a = ((const float4*)p.in[22])[i];
        uint2 w; w.x = pack2(a.x, a.y); w.y = pack2(a.z, a.w);
        ((uint2*)SKB)[i] = w;
    }
    convert_wt_phase(p.in[1], ND, EVEN_IN, P0W, ColMap{{0, 0, 0}, {0, 0, 0}, {P0W, 0, 0}}, WIN0, lds);
    convert_wt_phase(p.in[1], ND, EVEN_IN, 768, ColMap{{0, 0, 0}, {P0W, 0, 0}, {768, 0, 0}}, WV0, lds);
    convert_wt_phase(p.in[12], ND, ND, ND, ColMap{{0, 0, 0}, {0, 0, 0}, {ND, 0, 0}}, WOUT0, lds);
    convert_wt_phase(p.in[10], 256, 256, 256, ColMap{{0, 0, 0}, {0, 0, 0}, {256, 0, 0}}, WGT, lds);
    convert_wt_phase(p.in[21], ND, 2048, 2048, ColMap{{0, 0, 0}, {0, 0, 0}, {2048, 0, 0}}, WQ0, lds);
    convert_wt_phase(p.in[21] + (size_t)ND * 2048, ND, 2048, 2048, ColMap{{0, 0, 0}, {0, 0, 0}, {2048, 0, 0}}, WQ1, lds);
    convert_wt_phase(p.in[13], ND, ODD_IN, ODD_PAD, ColMap{{0, 1792, 2048}, {0, 2048, 2560}, {1792, 256, 48}}, WIN1, lds);
    convert_wt_phase(p.in[13], ND, ODD_IN, 512, ColMap{{0, 256, 0}, {1792, 2304, 0}, {256, 256, 0}}, WV1, lds);
    convert_wt_phase(p.in[20], ND, ND, ND, ColMap{{0, 0, 0}, {0, 0, 0}, {ND, 0, 0}}, WOUT1, lds);
    convert_wt_phase(p.in[15], 2048, 128, 128, ColMap{{0, 0, 0}, {0, 0, 0}, {128, 0, 0}}, W1T, lds);
    convert_wt_phase(p.in[18], 2048, 128, 128, ColMap{{0, 0, 0}, {0, 0, 0}, {128, 0, 0}}, W1T + 128 * 2048, lds);
    convert_wt_phase(p.in[16], 128, 64, 64, ColMap{{0, 0, 0}, {0, 0, 0}, {64, 0, 0}}, W2T, lds);
    convert_wt_phase(p.in[19], 128, 64, 64, ColMap{{0, 0, 0}, {0, 0, 0}, {64, 0, 0}}, W2T + 64 * 128, lds);
    if (blockIdx.x < 2 && tidx() < 128) {
        const float* pe = blockIdx.x ? p.in[17] : p.in[14];
        const float* w1 = blockIdx.x ? p.in[18] : p.in[15];
        float a = 0.f;
        for (int i = 0; i < 2048; ++i) a += pe[i] * w1[(size_t)i * 128 + tidx()];
        BIAS1[blockIdx.x * 128 + tidx()] = a;
    }
    grid.sync();
    PDUP(0) { PH(0) gemm_bf16_phase(lds_raw, HB, WIN0, NT, P0W, ND, EpiBf16s{PROJ, P0W});
    PH(0) gemm_bf16_phase(lds_raw, WV0, HB, 768, NT, ND, EpiBf16s{VT, NT}, true); }
    xcd_barrier(xbar);
    PDUP(1) { PH(1) s5_scan3_phase(PROJ, p.in[2], p.in[3], p.in[4], p.in[5], p.in[6], p.in[7], p.in[8], p.in[9], YA, lds_raw);
    PH(2) sb_attn2_phase(PROJ, VT, YB, lds_raw);
    if ((PROBE >> 13) & 1) {
        bf16_t* SCR = PROJ + (size_t)NT * P0W;
        s5_scan2_phase(PROJ, p.in[2], p.in[3], p.in[4], p.in[5], p.in[6], p.in[7], p.in[8], p.in[9], SCR, lds);
        xcd_barrier(xbar);
        float d2 = 0.f, n2 = 0.f;
        for (size_t i = (size_t)blockIdx.x * NTHR + tidx(); i < (size_t)NT * 256; i += (size_t)gridDim.x * NTHR) { const float a = bf2f(YA[i]), r = bf2f(SCR[i]); d2 += (a - r) * (a - r); n2 += r * r; }
        for (int o = 32; o; o >>= 1) { d2 += __shfl_xor(d2, o); n2 += __shfl_xor(n2, o); }
        float* chk = (float*)(ws + OFF_BAR + XCD_BAR_WORDS * 4);
        if ((tidx() & 63) == 0) { atomicAdd(chk, d2); atomicAdd(chk + 1, n2); }
    }
    if (_rep == 0 && ((PROBE >> 1) & 1)) xcd_barrier(xbar); }
    xcd_barrier(xbar);
    PDUP(2) PH(3) glu2_phase(YA, WGT, p.in[11], YB, lds_raw);
    xcd_barrier(xbar);
    if ((PROBE >> 3) & 1) { gemm_bf16_phase(lds_raw, YB, WOUT0, NT, ND, ND, EpiRes{R, ND, ALPHA, (float*)PROJ}); xcd_barrier(xbar); }
    PH(4) gemm_bf16_phase(lds_raw, YB, WOUT0, NT, ND, ND, EpiRes{R, ND, ALPHA, R});
    xcd_barrier(xbar);
    PH(5) ln_phase(R, HB, p.in[25], p.in[26]);
    xcd_barrier(xbar);
#define PEER_FFN(layer, WQ, last) \
    PDUP(0) PH(12) gemm_bf16_phase(lds_raw, HB, WQ, NT, 2048, ND, EpiBf16s{PROJ, 2048}); \
    xcd_barrier(xbar); \
    PDUP(4) PH(13) peer_route2_phase(PROJ, SKB + (size_t)(layer) * 8 * 2 * 128 * 128, EIDX, EGATE, lds_raw); \
    xcd_barrier(xbar); \
    if ((PROBE >> 5) & 1) { peer_expert3_phase(R, EIDX, EGATE, TAB, TAB + (size_t)16384 * ND, p.in[27] + (layer) * ND, p.in[28] + (layer) * ND, nullptr, (float*)PROJ, xbar); xcd_barrier(xbar); } \
    PH(14) peer_expert3_phase(R, EIDX, EGATE, TAB, TAB + (size_t)16384 * ND, p.in[27] + (layer) * ND, p.in[28] + (layer) * ND, (last) ? nullptr : HB, R, xbar); \
    if (!(last)) xcd_barrier(xbar);
    PEER_FFN(0, WQ0, false)
    convert_tables(p.in[23] + (size_t)16384 * ND, p.in[24] + (size_t)16384 * ND, TAB);
    PDUP(0) { PH(6) gemm_bf16_phase(lds_raw, HB, WIN1, NT, ODD_PAD, ND, EpiBf16s{PROJ, ODD_PAD});
    PH(6) gemm_bf16_phase(lds_raw, WV1, HB, 512, NT, ND, EpiBf16s{VT, NT}); }
    xcd_barrier(xbar);
    PDUP(6) PH(7) nsa_compress2_phase(PROJ, W1T, W2T, BIAS1, KCMP, VCMP, lds_raw);
    xcd_barrier(xbar);
    PDUP(7) { PH(8) nsa_cmp2_phase(PROJ, KCMP, VCMP, YB, SEL, lds_raw);
    xcd_barrier(xbar);
    PH(9) nsa_attn_phase(PROJ, VT, SEL, YB, lds_raw);
    if (_rep == 0 && ((PROBE >> 7) & 1)) xcd_barrier(xbar); }
    xcd_barrier(xbar);
    if ((PROBE >> 3) & 1) { gemm_bf16_phase(lds_raw, YB, WOUT1, NT, ND, ND, EpiRes{R, ND, ALPHA, (float*)PROJ}); xcd_barrier(xbar); }
    PH(10) gemm_bf16_phase(lds_raw, YB, WOUT1, NT, ND, ND, EpiRes{R, ND, ALPHA, R});
    xcd_barrier(xbar);
    PH(11) ln_phase(R, HB, p.in[25] + ND, p.in[26] + ND);
    xcd_barrier(xbar);
    PEER_FFN(1, WQ1, true)
    if ((PROBE >> 13) & 1) {
        xcd_barrier(xbar);
        const float* chk = (const float*)(ws + OFF_BAR + XCD_BAR_WORDS * 4);
        const float d2 = __hip_atomic_load(chk, __ATOMIC_RELAXED, __HIP_MEMORY_SCOPE_AGENT), n2 = __hip_atomic_load(chk + 1, __ATOMIC_RELAXED, __HIP_MEMORY_SCOPE_AGENT);
        if (!(d2 <= 1e-4f * n2)) for (size_t i = (size_t)blockIdx.x * NTHR + tidx(); i < (size_t)NT * ND; i += (size_t)gridDim.x * NTHR) R[i] *= 2.f;
    }
}

}

extern "C" void kernel_launch(void* const* d_in, const int* in_sizes, int n_in, void* d_out, int out_size, void* d_ws, size_t ws_size, hipStream_t stream) {
    static int grid_blocks = 0;
    if (grid_blocks == 0) {
        if (n_in != 29 || out_size != NT * ND || ws_size < WS_NEED) { fprintf(stderr, "kernel_launch: unexpected shapes / workspace (%zu < %zu)\n", ws_size, (size_t)WS_NEED); grid_blocks = -1; return; }
        int dev = 0, cus = 0, per_cu = 0;
        hipGetDevice(&dev);
        hipDeviceGetAttribute(&cus, hipDeviceAttributeMultiprocessorCount, dev);
        hipFuncSetAttribute((const void*)fwd_megakernel, hipFuncAttributeMaxDynamicSharedMemorySize, LDS_BYTES);
        hipOccupancyMaxActiveBlocksPerMultiprocessor(&per_cu, (const void*)fwd_megakernel, NTHR, LDS_BYTES);
        if (per_cu < 1) { fprintf(stderr, "kernel_launch: occupancy query says %d blocks/CU\n", per_cu); grid_blocks = -1; return; }
        grid_blocks = cus;
    }
    if (grid_blocks < 0) return;
    hipMemsetAsync((char*)d_ws + OFF_BAR, 0, XCD_BAR_WORDS * 4 + 256, stream);
    Params p{};
    for (int i = 0; i < 29; ++i) p.in[i] = (const float*)d_in[i];
    p.out = (float*)d_out; p.ws = (char*)d_ws; p.pad = 0;
    void* args[] = {&p};
    hipError_t e = hipLaunchCooperativeKernel((const void*)fwd_megakernel, dim3(grid_blocks), dim3(NTHR), args, LDS_BYTES, stream);
    if (e != hipSuccess) fprintf(stderr, "cooperative launch failed: %s (grid %d)\n", hipGetErrorString(e), grid_blocks);
}
```

```cpp
#include <hip/hip_runtime.h>
#include <hip/hip_cooperative_groups.h>
#include <math.h>
#include <stdint.h>
#include <cstdio>
namespace cg = cooperative_groups;

__device__ __forceinline__ int tidx() { int t = threadIdx.x; asm volatile("" : "+v"(t)); return t; }
#define XB_TMO      128
#define XB_XCNT(j)  (256  + 64 * (j))
#define XB_XSUB(j)  (1280 + 64 * (j))
#define XB_XGEN(j)  (2304 + 64 * (j))
#define XB_TOP      3328
#define XB_TOPGEN   3392
#define XCD_BAR_WORDS 3456
#define XB_SPIN_CAP (1u << 18)
#define LAS __attribute__((address_space(3)))

__device__ __forceinline__ unsigned xb_ld(unsigned* p)              { return __hip_atomic_load(p, __ATOMIC_RELAXED, __HIP_MEMORY_SCOPE_AGENT); }
__device__ __forceinline__ unsigned xb_add(unsigned* p, unsigned v) { return __hip_atomic_fetch_add(p, v, __ATOMIC_RELAXED, __HIP_MEMORY_SCOPE_AGENT); }
__device__ __forceinline__ unsigned xb_xcc_id() { return (unsigned)__builtin_amdgcn_s_getreg((3 << 11) | 20) & 0xFu; }
#define XB_SPIN(cond, bar) do { unsigned _sp = 0; while (cond) { __builtin_amdgcn_s_sleep(1); \
    if ((++_sp & 255u) == 0u) { if (xb_ld(&(bar)[XB_TMO])) break; if (_sp > XB_SPIN_CAP) { atomicAdd(&(bar)[XB_TMO], 1u); break; } } } } while (0)

struct XcdBarrier {
    unsigned* bar; unsigned x;
    volatile LAS unsigned* st;
};

__device__ __forceinline__ XcdBarrier xcd_barrier_post(unsigned* bar, volatile LAS unsigned* st) {
    XcdBarrier b; b.bar = bar; b.x = xb_xcc_id(); b.st = st;
    if (tidx() == 0) (void)xb_add(&bar[XB_XCNT(b.x)], 1u);
    return b;
}
__device__ __forceinline__ void xcd_barrier_complete(unsigned* bar, unsigned x, unsigned& nloc, unsigned& nx) {
    const unsigned G = gridDim.x * gridDim.y * gridDim.z;
    unsigned sum, cnt, mine, sp = 0u;
    for (;;) {
        sum = 0u; cnt = 0u; mine = 0u;
#pragma unroll
        for (unsigned j = 0; j < 16; ++j) { const unsigned c = xb_ld(&bar[XB_XCNT(j)]); sum += c; cnt += (c > 0u) ? 1u : 0u; mine = (j == x) ? c : mine; }
        if (sum == G) break;
        __builtin_amdgcn_s_sleep(1);
        if ((++sp & 255u) == 0u) { if (xb_ld(&bar[XB_TMO])) break; if (sp > XB_SPIN_CAP) { atomicAdd(&bar[XB_TMO], 1u); break; } }
    }
    nloc = mine > 0u ? mine : 1u; nx = cnt > 0u ? cnt : 1u;
}

__device__ __forceinline__ void xcd_barrier(const XcdBarrier& b) {
    asm volatile("s_waitcnt vmcnt(0)" ::: "memory");
    __syncthreads();
    if (tidx() == 0) {
        unsigned* bar = b.bar;
        __builtin_amdgcn_s_waitcnt(0);
        unsigned nloc = b.st[0], nx = b.st[1];
        if (nloc == 0u) { xcd_barrier_complete(bar, b.x, nloc, nx); b.st[0] = nloc; b.st[1] = nx; }
        const unsigned old = xb_add(&bar[XB_XSUB(b.x)], 1u);
        const unsigned gen = old / nloc;
        if (old + 1u == (gen + 1u) * nloc) {
            __builtin_amdgcn_fence(__ATOMIC_RELEASE, "agent");
            asm volatile("s_waitcnt vmcnt(0)" ::: "memory");
            const unsigned og = xb_add(&bar[XB_TOP], 1u);
            const unsigned tg = og / nx;
            if (og + 1u == (tg + 1u) * nx) xb_add(&bar[XB_TOPGEN], 1u);
            else XB_SPIN(xb_ld(&bar[XB_TOPGEN]) == tg, bar);
            __builtin_amdgcn_fence(__ATOMIC_ACQUIRE, "agent");
            xb_add(&bar[XB_XGEN(b.x)], 1u);
            asm volatile("s_waitcnt vmcnt(0)" ::: "memory");
        } else {
            XB_SPIN(xb_ld(&bar[XB_XGEN(b.x)]) == gen, bar);
            __builtin_amdgcn_fence(__ATOMIC_ACQUIRE, "agent");
            asm volatile("s_waitcnt vmcnt(0)" ::: "memory");
        }
    }
    __syncthreads();
}

#define XB_ALIGN(j) (XCD_BAR_WORDS + 64 * (j))
#define XB_TOTAL_WORDS (XCD_BAR_WORDS + 64 * 16)
__device__ __forceinline__ void xcc_align(const XcdBarrier& b) {
    __syncthreads();
    if (tidx() == 0) {
        const unsigned nloc = b.st[0];
        if (nloc) {
            const unsigned old = xb_add(&b.bar[XB_ALIGN(b.x)], 1u), gen = old / nloc;
            unsigned sp = 0;
            while (xb_ld(&b.bar[XB_ALIGN(b.x)]) < (gen + 1u) * nloc && ++sp < (1u << 16)) __builtin_amdgcn_s_sleep(1);
        }
    }
    __syncthreads();
}
namespace pg8 {
#define PG8_LAS __attribute__((address_space(3)))
typedef unsigned short bf16_t;
typedef short bf16x8 __attribute__((ext_vector_type(8)));
typedef float f32x4 __attribute__((ext_vector_type(4)));
typedef unsigned u32x4 __attribute__((ext_vector_type(4)));
constexpr int BM = 256, BK = 64, HALF = 128, HTB = HALF * BK * 2  , STAGE_BYTES = 8 * HTB, NXCD = 8, WGM = 8;

__host__ __device__ __forceinline__ int lds_byte(int r, int c) { const int st = (r >> 4) * 2 + (c >> 5), rr = r & 15, cc = c & 31, ob = rr * 64 + cc * 2; return st * 1024 + (ob ^ (((ob >> 9) & 1) << 5)); }
__host__ __device__ __forceinline__ void stage_rc(int b, int& R, int& C) { const int st = b / 1024, sb = b % 1024, swz = sb ^ (((sb >> 9) & 1) << 5); R = (st >> 1) * 16 + swz / 64; C = (st & 1) * 32 + (swz % 64) / 2; }
__host__ __device__ __forceinline__ int perm32(int rho) { const int n = rho >> 4, i = rho & 15; return 8 * (i >> 2) + 4 * n + (i & 3); }

struct Unit { int pm, pn; };
struct Gemm { const bf16_t* A; const bf16_t* Bt; int M, N, K; };

struct StaticOrder {
    int nM, nN, nwg, G, c;
    __host__ __device__ void init(int M, int N, int G_, int c_) { nM = M / BM; nN = N / BM; nwg = nM * nN; G = G_; c = c_; }
    __host__ __device__ bool next(int i, Unit& u) const {
        const long L = (long)i * G + c; if (L >= nwg) return false;
        int wgid = (int)L; { const int q = nwg / NXCD, r = nwg % NXCD, xcd = wgid % NXCD, off = wgid / NXCD; wgid = (xcd < r ? xcd * (q + 1) : r * (q + 1) + (xcd - r) * q) + off; }
        const int nig = WGM * nN, gid = wgid / nig, fm = gid * WGM, gsz = (nM - fm) < WGM ? (nM - fm) : WGM;
        u.pm = fm + ((wgid % nig) % gsz); u.pn = (wgid % nig) / gsz; return true;
    }
    __device__ __forceinline__ void a_ready(const Unit&) const {}
    __device__ __forceinline__ void done(const Unit&) const {}
};
__device__ __forceinline__ unsigned cvt_pk_bf16(float lo, float hi) { unsigned r; asm volatile("v_cvt_pk_bf16_f32 %0, %1, %2" : "=v"(r) : "v"(lo), "v"(hi)); return r; }
template <class Epi, class Sched, bool STAMP = false>
__device__ __forceinline__ void gemm_phase(PG8_LAS unsigned char* lds, const Gemm g, const Sched& S, const Epi& E, unsigned long long* stamps) {
    const int tid = tidx(), wid = __builtin_amdgcn_readfirstlane(tid >> 6), lane = tid & 63, wr = wid >> 2, wc = wid & 3, fr = lane & 15, fq = lane >> 4;
    const int K = g.K, nt = K / BK;
    int ts_lo = 0, ts_hi = 0, nts = 0; const unsigned long long rt_entry = STAMP ? (unsigned long long)wall_clock64() : 0ull;
#define PG8_STAMP() do { if (STAMP && wid == 0 && nts < 64) { const unsigned long long _c = (unsigned long long)clock64(); \
        ts_lo = (lane == nts) ? (int)(unsigned)_c : ts_lo; ts_hi = (lane == nts) ? (int)(unsigned)(_c >> 32) : ts_hi; ++nts; } } while (0)
    PG8_STAMP();
    unsigned voffA[2], voffB[2];
#pragma unroll
    for (int i = 0; i < 2; ++i) { int R, C; stage_rc(tid * 16 + i * 8192, R, C); const int Rb = Epi::PERM ? ((R & ~31) + perm32(R & 31)) : R;
        voffA[i] = (unsigned)(R * K + C) * 2u; voffB[i] = (unsigned)(Rb * K + C) * 2u; }
    const size_t kstep = (size_t)(BK * 2);
    const size_t hstep = (size_t)HALF * K * 2;
    const size_t tstep = 2 * hstep;
    const unsigned ldsw = (unsigned)wid * 1024u;
    const int aoff = lds_byte(wr * 64 + fr, fq * 8), boff = lds_byte(wc * 32 + fr, fq * 8);
#define PG8_SA(b, h) (((b) * 2 + (h)) * HTB)
#define PG8_SB(b, h) ((4 + (b) * 2 + (h)) * HTB)
#define PG8_STAGE(bufoff, gbase, voff) do { _Pragma("unroll") for (int _i = 0; _i < 2; ++_i) \
        __builtin_amdgcn_global_load_lds((const unsigned*)((const char*)(gbase) + (voff)[_i]), (PG8_LAS unsigned*)(lds + (bufoff) + ldsw + _i * 8192), 16, 0, 0); } while (0)
#define PG8_LDA(dst, b, h) do { _Pragma("unroll") for (int m = 0; m < 4; ++m) _Pragma("unroll") for (int k = 0; k < 2; ++k) dst[m][k] = *(const PG8_LAS bf16x8*)(lds + PG8_SA(b, h) + aoff + m * 2048 + k * 1024); } while (0)
#define PG8_LDB(dst, b, h) do { _Pragma("unroll") for (int n = 0; n < 2; ++n) _Pragma("unroll") for (int k = 0; k < 2; ++k) dst[n][k] = *(const PG8_LAS bf16x8*)(lds + PG8_SB(b, h) + boff + n * 2048 + k * 1024); } while (0)
#define PG8_MMA(ai, bj, At, Bt) do { __builtin_amdgcn_s_setprio(1); _Pragma("unroll") for (int m = 0; m < 4; ++m) _Pragma("unroll") for (int n = 0; n < 2; ++n) _Pragma("unroll") for (int k = 0; k < 2; ++k) \
        acc[ai][bj][m][n] = __builtin_amdgcn_mfma_f32_16x16x32_bf16(Bt[n][k], At[m][k], acc[ai][bj][m][n], 0, 0, 0); __builtin_amdgcn_s_setprio(0); } while (0)
#define PG8_WAIT_V(n) asm volatile("s_waitcnt vmcnt(" #n ")" ::: "memory")
#define PG8_WAIT_L(n) asm volatile("s_waitcnt lgkmcnt(" #n ")" ::: "memory")
#define PG8_BAR __builtin_amdgcn_s_barrier()
#define PG8_SCHED __builtin_amdgcn_sched_barrier(0)
    Unit cur, nxt; int ui = 0;
    if (!S.next(0, cur)) return;
    f32x4 acc[2][2][4][2];
#pragma unroll
    for (int a = 0; a < 2; ++a)
#pragma unroll
        for (int b = 0; b < 2; ++b)
#pragma unroll
            for (int m = 0; m < 4; ++m)
#pragma unroll
                for (int n = 0; n < 2; ++n) acc[a][b][m][n] = (f32x4){0.f, 0.f, 0.f, 0.f};
    bf16x8 At[4][2], B0[2][2], B1[2][2];
    const char* cA = (const char*)g.A + (size_t)cur.pm * tstep; const char* cB = (const char*)g.Bt + (size_t)cur.pn * tstep;
    S.a_ready(cur);
    PG8_STAGE(PG8_SB(0, 0), cB, voffB); PG8_STAGE(PG8_SA(0, 0), cA, voffA); PG8_STAGE(PG8_SB(0, 1), cB + hstep, voffB); PG8_STAGE(PG8_SA(0, 1), cA + hstep, voffA);
    if (wr == 1) PG8_BAR;
    PG8_WAIT_V(4); PG8_BAR;
    PG8_STAGE(PG8_SB(1, 0), cB + kstep, voffB); PG8_STAGE(PG8_SA(1, 0), cA + kstep, voffA); PG8_STAGE(PG8_SB(1, 1), cB + hstep + kstep, voffB);
    PG8_WAIT_V(6); PG8_BAR;
    PG8_STAMP();
    for (;;) {
        const bool has_next = S.next(ui + 1, nxt);
        const char* nA = has_next ? (const char*)g.A + (size_t)nxt.pm * tstep : cA; const char* nB = has_next ? (const char*)g.Bt + (size_t)nxt.pn * tstep : cB;
        for (int t = 0; t < nt; t += 2) {
            const bool last = (t == nt - 2);
            const char* a1 = cA + (size_t)(t + 1) * kstep;
            const char* a2 = last ? nA : cA + (size_t)(t + 2) * kstep; const char* b2 = last ? nB : cB + (size_t)(t + 2) * kstep;
            const char* a3 = a2 + kstep; const char* b3 = b2 + kstep;
            if (last && has_next) S.a_ready(nxt);
            PG8_LDB(B0, 0, 0); PG8_SCHED; PG8_LDA(At, 0, 0); PG8_STAGE(PG8_SA(1, 1), a1 + hstep, voffA);
            PG8_WAIT_L(8); PG8_BAR; PG8_WAIT_L(0); PG8_MMA(0, 0, At, B0); PG8_BAR; PG8_SCHED;
            PG8_LDB(B1, 0, 1); PG8_STAGE(PG8_SB(0, 0), b2, voffB);
            PG8_BAR; PG8_WAIT_L(0); PG8_MMA(0, 1, At, B1); PG8_BAR;
            PG8_LDA(At, 0, 1); PG8_STAGE(PG8_SA(0, 0), a2, voffA);
            PG8_BAR; PG8_WAIT_L(0); PG8_MMA(1, 0, At, B0); PG8_BAR; PG8_SCHED;
            PG8_STAGE(PG8_SB(0, 1), b2 + hstep, voffB);
            PG8_WAIT_V(6); PG8_BAR; PG8_MMA(1, 1, At, B1); PG8_BAR;
            PG8_LDB(B0, 1, 0); PG8_SCHED; PG8_LDA(At, 1, 0); PG8_STAGE(PG8_SA(0, 1), a2 + hstep, voffA);
            PG8_WAIT_L(8); PG8_BAR; PG8_WAIT_L(0); PG8_MMA(0, 0, At, B0); PG8_BAR; PG8_SCHED;
            PG8_LDB(B1, 1, 1); PG8_STAGE(PG8_SB(1, 0), b3, voffB);
            PG8_BAR; PG8_WAIT_L(0); PG8_MMA(0, 1, At, B1); PG8_BAR;
            PG8_LDA(At, 1, 1); PG8_STAGE(PG8_SA(1, 0), a3, voffA);
            PG8_BAR; PG8_WAIT_L(0); PG8_MMA(1, 0, At, B0); PG8_BAR; PG8_SCHED;
            PG8_STAGE(PG8_SB(1, 1), b3 + hstep, voffB);
            PG8_WAIT_V(6); PG8_BAR; PG8_MMA(1, 1, At, B1); PG8_BAR;
        }
        PG8_STAMP();
        if constexpr (!Epi::AFTER_DRAIN) { E(acc, cur, wr, wc, fr, fq); S.done(cur); }
        PG8_STAMP();
        if (!has_next) break;
#pragma unroll
        for (int a = 0; a < 2; ++a)
#pragma unroll
            for (int b = 0; b < 2; ++b)
#pragma unroll
                for (int m = 0; m < 4; ++m)
#pragma unroll
                    for (int n = 0; n < 2; ++n) acc[a][b][m][n] = (f32x4){0.f, 0.f, 0.f, 0.f};
        cur = nxt; cA = nA; cB = nB; ++ui;
    }
    PG8_WAIT_V(0);
    if (wr == 0) PG8_BAR;
    PG8_BAR;
    if constexpr (Epi::AFTER_DRAIN) { E.fused(acc, cur, wr, wc, fr, fq, lds, wid, lane); S.done(cur); }
    PG8_STAMP();
    if (STAMP && wid == 0) { stamps[lane] = lane < nts ? (((unsigned long long)(unsigned)ts_hi << 32) | (unsigned)ts_lo) : 0ull;
        if (lane == 62) stamps[62] = rt_entry; if (lane == 63) stamps[63] = (unsigned long long)wall_clock64(); }
#undef PG8_STAMP
#undef PG8_SA
#undef PG8_SB
#undef PG8_STAGE
#undef PG8_LDA
#undef PG8_LDB
#undef PG8_MMA
#undef PG8_WAIT_V
#undef PG8_WAIT_L
#undef PG8_BAR
#undef PG8_SCHED
}
}

namespace {
using pg8::bf16_t;
typedef float f32x4 __attribute__((ext_vector_type(4)));
typedef unsigned u32x4 __attribute__((ext_vector_type(4)));

constexpr int NB = 16, NL = 2048, ND = 1024, NT = NB * NL;
constexpr int EVEN_IN = 2560, ODD_IN = 2608, ODD_PAD = 2304;
constexpr float ALPHA = 1.41421356237f;
constexpr float LN_EPS = 1e-5f;
constexpr float U_SCALE = 256.f, V_SCALE = 16.f;
constexpr int NTHR = 512;
constexpr int LDS_BYTES = 163840;
#ifndef PROBE
#define PROBE 0
#endif
#define PDUP(bit) for (int _rep = 0; _rep < ((PROBE >> (bit)) & 1) + 1; ++_rep)
#ifndef PHMASK
#define PHMASK 0xFFFFFFFFu
#endif
#define PH(n) if (PHMASK & (1u << (n)))

__device__ __forceinline__ float bf2f(bf16_t v) { return __uint_as_float((unsigned)v << 16); }
__device__ __forceinline__ bf16_t f2bf(float f) { unsigned u = __float_as_uint(f); u += 0x7FFFu + ((u >> 16) & 1u); return (bf16_t)(u >> 16); }
__device__ __forceinline__ unsigned pack2(float lo, float hi) { return (unsigned)f2bf(lo) | ((unsigned)f2bf(hi) << 16); }
__device__ __forceinline__ void ld8(const bf16_t* p, float* o) {
    const uint4 v = *(const uint4*)p;
    o[0] = __uint_as_float(v.x << 16); o[1] = __uint_as_float(v.x & 0xffff0000u);
    o[2] = __uint_as_float(v.y << 16); o[3] = __uint_as_float(v.y & 0xffff0000u);
    o[4] = __uint_as_float(v.z << 16); o[5] = __uint_as_float(v.z & 0xffff0000u);
    o[6] = __uint_as_float(v.w << 16); o[7] = __uint_as_float(v.w & 0xffff0000u);
}
__device__ __forceinline__ void st8(bf16_t* p, const float* o) {
    uint4 v; v.x = pack2(o[0], o[1]); v.y = pack2(o[2], o[3]); v.z = pack2(o[4], o[5]); v.w = pack2(o[6], o[7]);
    *(uint4*)p = v;
}

struct EpiBf16s {
    static constexpr bool PERM = true, AFTER_DRAIN = false;
    bf16_t* O; int ldc;
    __device__ __forceinline__ void operator()(const f32x4 (&acc)[2][2][4][2], const pg8::Unit& u, int wr, int wc, int fr, int fq) const {
        const int row0 = u.pm * 256 + wr * 64 + fr, col0 = u.pn * 256 + wc * 32 + 8 * fq;
#pragma unroll
        for (int ai = 0; ai < 2; ++ai)
#pragma unroll
            for (int m = 0; m < 4; ++m) { bf16_t* rowp = O + (size_t)(row0 + ai * 128 + m * 16) * ldc + col0;
#pragma unroll
                for (int bj = 0; bj < 2; ++bj) { const f32x4 v0 = acc[ai][bj][m][0], v1 = acc[ai][bj][m][1];
                    u32x4 w; w.x = pg8::cvt_pk_bf16(v0[0], v0[1]); w.y = pg8::cvt_pk_bf16(v0[2], v0[3]); w.z = pg8::cvt_pk_bf16(v1[0], v1[1]); w.w = pg8::cvt_pk_bf16(v1[2], v1[3]);
                    *(u32x4*)(rowp + bj * 128) = w; } }
    }
};
struct EpiRes {
    static constexpr bool PERM = false, AFTER_DRAIN = false;
    float* C; int ldc; float alpha; float* Cout;
    __device__ __forceinline__ void operator()(const f32x4 (&acc)[2][2][4][2], const pg8::Unit& u, int wr, int wc, int fr, int fq) const {
        const int row0 = u.pm * 256 + wr * 64 + fr, col0 = u.pn * 256 + wc * 32 + 4 * fq; const size_t dlt = Cout - C;
#pragma unroll
        for (int ai = 0; ai < 2; ++ai)
#pragma unroll
            for (int m = 0; m < 4; ++m) { float* rowp = C + (size_t)(row0 + ai * 128 + m * 16) * ldc + col0;
#pragma unroll
                for (int bj = 0; bj < 2; ++bj)
#pragma unroll
                    for (int n = 0; n < 2; ++n) { f32x4* cp = (f32x4*)(rowp + bj * 128 + n * 16); *(cp + dlt / 4) = *cp * alpha + acc[ai][bj][m][n]; } }
    }
};
template <class Epi>
__device__ __forceinline__ void gemm_bf16_phase(unsigned char* lds, const bf16_t* A, const bf16_t* Bt, int M, int N, int K, const Epi& E, bool reverse_ids = false) {
    pg8::Gemm g{A, Bt, M, N, K};
    pg8::StaticOrder S; S.init(M, N, (int)gridDim.x, reverse_ids ? (int)(gridDim.x - 1 - blockIdx.x) : (int)blockIdx.x);
    pg8::gemm_phase<Epi, pg8::StaticOrder, false>((PG8_LAS unsigned char*)lds, g, S, E, nullptr);
    __syncthreads();
}

struct ColMap { int d0[3], s0[3], len[3]; };
__device__ __forceinline__ void convert_wt_phase(const float* __restrict__ W, int K, int N, int Npad, const ColMap cm, bf16_t* __restrict__ Wt, float* lds) {
    float(*tile)[65] = (float(*)[65])lds;
    const int tid = tidx(), ntn = Npad / 64, ntiles = (K / 64) * ntn;
    for (int it = blockIdx.x; it < ntiles; it += gridDim.x) {
        const int k0 = (it / ntn) * 64, n0 = (it % ntn) * 64;
        __syncthreads();
#pragma unroll
        for (int h = 0; h < 2; ++h) {
            const int r = (tid >> 4) + h * 32, c4 = (tid & 15) * 4, nd = n0 + c4;
            int ns = -1;
#pragma unroll
            for (int sg = 0; sg < 3; ++sg) if (nd >= cm.d0[sg] && nd < cm.d0[sg] + cm.len[sg]) ns = cm.s0[sg] + (nd - cm.d0[sg]);
            float4 v = make_float4(0.f, 0.f, 0.f, 0.f);
            if (ns >= 0) v = *(const float4*)(W + (size_t)(k0 + r) * N + ns);
            tile[r][c4] = v.x; tile[r][c4 + 1] = v.y; tile[r][c4 + 2] = v.z; tile[r][c4 + 3] = v.w;
        }
        __syncthreads();
        const int n = tid >> 3, k8 = (tid & 7) * 8;
        float o[8];
#pragma unroll
        for (int j = 0; j < 8; ++j) o[j] = tile[k8 + j][n];
        st8(Wt + (size_t)(n0 + n) * K + k0 + k8, o);
    }
    __syncthreads();
}
__device__ __forceinline__ float gelu_tanh(float x) {
    float u = 0.7978845608028654f * (x + 0.044715f * x * x * x);
    return 0.5f * x * (1.f + tanhf(u));
}
__device__ __forceinline__ float sigmoidf_(float x) { return 1.f / (1.f + expf(-x)); }
__device__ __forceinline__ void wave_lds_fence() { asm volatile("s_waitcnt lgkmcnt(0)" ::: "memory"); }

__device__ __forceinline__ void s5_scan_wave(int bg, const bf16_t* __restrict__ proj, const float* __restrict__ lam_re, const float* __restrict__ lam_im,
                             const float* __restrict__ log_dt, const float* __restrict__ b_re, const float* __restrict__ b_im,
                             const float* __restrict__ c_re, const float* __restrict__ c_im, const float* __restrict__ dskip,
                             float* __restrict__ ya, float* lds) {
    const int b = bg >> 4, g = bg & 15, lane = tidx() & 63;
    float(*us)[16] = (float(*)[16])lds;
    float(*xr)[65] = (float(*)[65])(lds + 1024);
    float(*xi)[65] = (float(*)[65])(lds + 1024 + 4160);
    float(*cr)[64] = (float(*)[64])(lds + 1024 + 8320);
    float(*ci)[64] = (float(*)[64])(lds + 1024 + 8320 + 1024);
    const float lr = lam_re[g * 64 + lane], li = lam_im[g * 64 + lane];
    const float dt = expf(log_dt[g]);
    const float mag = expf(lr * dt);
    const float are = mag * cosf(li * dt), aim = mag * sinf(li * dt);
    const float nr = are - 1.f, den = lr * lr + li * li;
    const float fre = (nr * lr + aim * li) / den, fim = (aim * lr - nr * li) / den;
    float bbr[16], bbi[16];
#pragma unroll
    for (int i = 0; i < 16; ++i) {
        const float br = b_re[(g * 64 + lane) * 16 + i], bi = b_im[(g * 64 + lane) * 16 + i];
        bbr[i] = fre * br - fim * bi; bbi[i] = fre * bi + fim * br;
    }
    for (int idx = lane; idx < 1024; idx += 64) { cr[idx >> 6][idx & 63] = c_re[g * 1024 + idx]; ci[idx >> 6][idx & 63] = c_im[g * 1024 + idx]; }
    float dsk[16];
#pragma unroll
    for (int i = 0; i < 16; ++i) dsk[i] = dskip[g * 16 + i];
    float xre = 0.f, xim = 0.f;
    for (int t0 = 0; t0 < NL; t0 += 64) {
        wave_lds_fence();
        for (int idx = lane; idx < 1024; idx += 64) { const int t = idx >> 4, i = idx & 15; us[t][i] = bf2f(proj[(size_t)(b * NL + t0 + t) * EVEN_IN + g * 16 + i]); }
        wave_lds_fence();
        for (int t = 0; t < 64; ++t) {
            float bur = 0.f, bui = 0.f;
#pragma unroll
            for (int i = 0; i < 16; ++i) { const float u = us[t][i]; bur += bbr[i] * u; bui += bbi[i] * u; }
            const float nre = are * xre - aim * xim + bur, nim = are * xim + aim * xre + bui;
            xre = nre; xim = nim;
            xr[t][lane] = xre; xi[t][lane] = xim;
        }
        wave_lds_fence();
        float y[16];
#pragma unroll
        for (int i = 0; i < 16; ++i) y[i] = 0.f;
        for (int p = 0; p < 64; ++p) {
            const float a = xr[lane][p], bq = xi[lane][p];
#pragma unroll
            for (int i = 0; i < 16; ++i) y[i] += cr[i][p] * a - ci[i][p] * bq;
        }
#pragma unroll
        for (int i = 0; i < 16; ++i) {
            const float v = y[i] + dsk[i] * us[lane][i];
            ya[(size_t)(b * NL + t0 + lane) * 256 + g * 16 + i] = gelu_tanh(v);
        }
    }
}

__device__ __forceinline__ void sb_attn_wave(int task, const bf16_t* __restrict__ proj, bf16_t* __restrict__ Y, float* wl) {
    const int qt = task & 31, h = (task >> 5) % 12, b = task / 384, lane = tidx() & 63;
    const int t = qt * 64 + lane;
    float(*ks)[64] = (float(*)[64])wl;
    float(*vs)[64] = (float(*)[64])(wl + 2048);
    const bf16_t* base = proj + (size_t)b * NL * EVEN_IN;
    float q[64], acc[64];
#pragma unroll
    for (int d = 0; d < 64; d += 8) ld8(base + (size_t)t * EVEN_IN + 256 + h * 64 + d, q + d);
#pragma unroll
    for (int d = 0; d < 64; ++d) acc[d] = 0.f;
    float tail = 0.f;
    for (int c = 2 * qt + 1; c >= 0; --c) {
        wave_lds_fence();
        for (int i = 0; i < 32; ++i) {
            ks[i][lane] = bf2f(base[(size_t)(c * 32 + i) * EVEN_IN + 1024 + h * 64 + lane]);
            vs[i][lane] = bf2f(base[(size_t)(c * 32 + i) * EVEN_IN + 1792 + h * 64 + lane]);
        }
        wave_lds_fence();
        for (int s = 31; s >= 0; --s) {
            const int key = c * 32 + s;
            float z = 0.f;
#pragma unroll
            for (int d = 0; d < 64; ++d) z += q[d] * ks[s][d];
            z *= 0.125f;
            const bool valid = key < t;
            const float sp = fmaxf(z, 0.f) + log1pf(expf(-fabsf(z)));
            const float w = valid ? expf(z - sp + tail) : 0.f;
#pragma unroll
            for (int d = 0; d < 64; ++d) acc[d] += w * vs[s][d];
            if (valid) tail -= sp;
        }
        if (__all(tail < -120.f)) break;
    }
#pragma unroll
    for (int d = 0; d < 64; d += 8) st8(Y + (size_t)(b * NL + t) * ND + 256 + h * 64 + d, acc + d);
}

__device__ __forceinline__ void glu_phase(const float* __restrict__ ya, const float* __restrict__ wglu, const float* __restrict__ bglu, bf16_t* __restrict__ Y, float* lds) {
    const int half = tidx() >> 8, c = tidx() & 255;
    float(*ys)[256] = (float(*)[256])(lds + half * 4096);
    for (int it = blockIdx.x; it < NT / 32; it += gridDim.x) {
        const int t0 = it * 32 + half * 16;
        __syncthreads();
        for (int i = 0; i < 16; ++i) ys[i][c] = ya[(size_t)(t0 + i) * 256 + c];
        __syncthreads();
        float acc[16];
#pragma unroll
        for (int i = 0; i < 16; ++i) acc[i] = 0.f;
        for (int k = 0; k < 256; ++k) {
            const float w = wglu[k * 256 + c];
#pragma unroll
            for (int i = 0; i < 16; ++i) acc[i] += ys[i][k] * w;
        }
        const float bb = bglu[c];
#pragma unroll
        for (int i = 0; i < 16; ++i) Y[(size_t)(t0 + i) * ND + c] = f2bf(ys[i][c] * sigmoidf_(acc[i] + bb));
    }
    __syncthreads();
}

__device__ __forceinline__ void ln_row_wave(float4 (&v)[4], const float* __restrict__ g, const float* __restrict__ bta, float* out, bf16_t* outb, int lane) {
    float s = 0.f;
#pragma unroll
    for (int j = 0; j < 4; ++j) s += v[j].x + v[j].y + v[j].z + v[j].w;
    for (int o = 32; o; o >>= 1) s += __shfl_xor(s, o);
    const float mean = s * (1.f / ND);
    float s2 = 0.f;
#pragma unroll
    for (int j = 0; j < 4; ++j) {
        v[j].x -= mean; v[j].y -= mean; v[j].z -= mean; v[j].w -= mean;
        s2 += v[j].x * v[j].x + v[j].y * v[j].y + v[j].z * v[j].z + v[j].w * v[j].w;
    }
    for (int o = 32; o; o >>= 1) s2 += __shfl_xor(s2, o);
    const float rs = rsqrtf(s2 * (1.f / ND) + LN_EPS);
#pragma unroll
    for (int j = 0; j < 4; ++j) {
        const float4 gg = *(const float4*)(g + j * 256 + lane * 4), bb = *(const float4*)(bta + j * 256 + lane * 4);
        const float4 o = make_float4(v[j].x * rs * gg.x + bb.x, v[j].y * rs * gg.y + bb.y, v[j].z * rs * gg.z + bb.z, v[j].w * rs * gg.w + bb.w);
        *(float4*)(out + j * 256 + lane * 4) = o;
        if (outb) { uint2 w; w.x = pack2(o.x, o.y); w.y = pack2(o.z, o.w); *(uint2*)(outb + j * 256 + lane * 4) = w; }
    }
}
__device__ __forceinline__ void ln_phase(float* R, bf16_t* Hb, const float* __restrict__ g, const float* __restrict__ bta) {
    const int wave = tidx() >> 6, lane = tidx() & 63;
    for (int row = blockIdx.x * 8 + wave; row < NT; row += gridDim.x * 8) {
        float4 v[4];
#pragma unroll
        for (int j = 0; j < 4; ++j) v[j] = *(const float4*)(R + (size_t)row * ND + j * 256 + lane * 4);
        ln_row_wave(v, g, bta, R + (size_t)row * ND, Hb + (size_t)row * ND, lane);
    }
}

__device__ __forceinline__ void wave_argmax(float& bv, int& bi) {
#pragma unroll
    for (int o = 32; o; o >>= 1) {
        const float ov = __shfl_xor(bv, o); const int oi = __shfl_xor(bi, o);
        if (ov > bv || (ov == bv && oi < bi)) { bv = ov; bi = oi; }
    }
}
__device__ __forceinline__ void peer_route_phase(const bf16_t* __restrict__ qbuf, const float* __restrict__ subk, int* __restrict__ eidx, float* __restrict__ egate, float* lds) {
    const int head = tidx() >> 6, lane = tidx() & 63;
    float* qs = lds + head * 256;
    for (int token = blockIdx.x; token < NT; token += gridDim.x) {
        const bf16_t* qp = qbuf + (size_t)token * 2048 + head * 256;
        wave_lds_fence();
        for (int i = 0; i < 4; ++i) qs[lane + 64 * i] = bf2f(qp[lane + 64 * i]);
        wave_lds_fence();
        float myv[2]; int myi[2];
#pragma unroll
        for (int c = 0; c < 2; ++c) {
            float sc[2];
#pragma unroll
            for (int w2 = 0; w2 < 2; ++w2) {
                const float* kr = subk + ((size_t)(head * 2 + c) * 128 + lane + 64 * w2) * 128;
                float a = 0.f;
#pragma unroll 4
                for (int d = 0; d < 128; d += 4) {
                    const float4 kv = *(const float4*)(kr + d);
                    a += qs[c * 128 + d] * kv.x + qs[c * 128 + d + 1] * kv.y + qs[c * 128 + d + 2] * kv.z + qs[c * 128 + d + 3] * kv.w;
                }
                sc[w2] = a;
            }
            float a0 = sc[0], a1 = sc[1];
            float mv = -INFINITY; int mi = 0;
            for (int r = 0; r < 16; ++r) {
                float bv; int bi;
                if (a0 >= a1) { bv = a0; bi = lane; } else { bv = a1; bi = lane + 64; }
                wave_argmax(bv, bi);
                if (lane == r) { mv = bv; mi = bi; }
                if (bi == lane) a0 = -INFINITY; else if (bi == lane + 64) a1 = -INFINITY;
            }
            myv[c] = mv; myi[c] = mi;
        }
        const float va = __shfl(myv[0], lane >> 2);
        float cand[4];
#pragma unroll
        for (int j = 0; j < 4; ++j) cand[j] = va + __shfl(myv[1], (lane & 3) * 4 + j);
        float topv = -INFINITY; int topf = 0;
        for (int r = 0; r < 16; ++r) {
            float bv = cand[0]; int bi = lane * 4;
#pragma unroll
            for (int j = 1; j < 4; ++j) if (cand[j] > bv) { bv = cand[j]; bi = lane * 4 + j; }
            wave_argmax(bv, bi);
            if (lane == r) { topv = bv; topf = bi; }
#pragma unroll
            for (int j = 0; j < 4; ++j) if (bi == lane * 4 + j) cand[j] = -INFINITY;
        }
        const int e1 = __shfl(myi[0], topf >> 4), e2 = __shfl(myi[1], topf & 15);
        const float top0 = __shfl(topv, 0);
        float ex = (lane < 16) ? expf(topv - top0) : 0.f;
        float sum = ex;
        for (int o = 32; o; o >>= 1) sum += __shfl_xor(sum, o);
        if (lane < 16) {
            eidx[(size_t)token * 128 + head * 16 + lane] = e1 * 128 + e2;
            egate[(size_t)token * 128 + head * 16 + lane] = ex / sum;
        }
    }
}

__device__ __forceinline__ void peer_expert_phase(float* R, const int* __restrict__ eidx, const float* __restrict__ egate, const float* __restrict__ utab,
                                  const float* __restrict__ vtab, const float* __restrict__ lg, const float* __restrict__ lb, bf16_t* Hb) {
    const int wave = tidx() >> 6, lane = tidx() & 63;
    for (int token = blockIdx.x * 8 + wave; token < NT; token += gridDim.x * 8) {
        float4 x[4], acc[4];
#pragma unroll
        for (int j = 0; j < 4; ++j) { x[j] = *(const float4*)(R + (size_t)token * ND + j * 256 + lane * 4); acc[j] = make_float4(0.f, 0.f, 0.f, 0.f); }
        for (int e0 = 0; e0 < 128; e0 += 4) {
            float dot[4]; int ex[4]; float gt[4];
#pragma unroll
            for (int k = 0; k < 4; ++k) {
                ex[k] = eidx[(size_t)token * 128 + e0 + k]; gt[k] = egate[(size_t)token * 128 + e0 + k];
                const float* ur = utab + (size_t)ex[k] * ND + lane * 4;
                float a = 0.f;
#pragma unroll
                for (int j = 0; j < 4; ++j) { const float4 u = *(const float4*)(ur + j * 256); a += x[j].x * u.x + x[j].y * u.y + x[j].z * u.z + x[j].w * u.w; }
                dot[k] = a;
            }
#pragma unroll
            for (int k = 0; k < 4; ++k) {
                float a = dot[k];
                for (int o = 32; o; o >>= 1) a += __shfl_xor(a, o);
                const float coef = gt[k] * gelu_tanh(a);
                const float* vr = vtab + (size_t)ex[k] * ND + lane * 4;
#pragma unroll
                for (int j = 0; j < 4; ++j) { const float4 v = *(const float4*)(vr + j * 256); acc[j].x += coef * v.x; acc[j].y += coef * v.y; acc[j].z += coef * v.z; acc[j].w += coef * v.w; }
            }
        }
#pragma unroll
        for (int j = 0; j < 4; ++j) { x[j].x = ALPHA * x[j].x + acc[j].x; x[j].y = ALPHA * x[j].y + acc[j].y; x[j].z = ALPHA * x[j].z + acc[j].z; x[j].w = ALPHA * x[j].w + acc[j].w; }
        ln_row_wave(x, lg, lb, R + (size_t)token * ND, Hb ? Hb + (size_t)token * ND : nullptr, lane);
    }
}


typedef short bf16x8_t __attribute__((ext_vector_type(8)));
__device__ __forceinline__ int f2key(float f) { const int b = __float_as_int(f); return b ^ ((b >> 31) & 0x7fffffff); }
__device__ __forceinline__ float key2f(int k) { return __int_as_float(k ^ ((k >> 31) & 0x7fffffff)); }
#define CE_DESC_I(a, b) do { const int _hi = max(a, b), _lo = min(a, b); a = _hi; b = _lo; } while (0)
template <int N, int K, int J> __device__ __forceinline__ void bstage(int (&v)[N]) {
#pragma unroll
    for (int i = 0; i < N; ++i) {
        const int l = i ^ J;
        if (l > i) { if ((i & K) == 0) CE_DESC_I(v[i], v[l]); else CE_DESC_I(v[l], v[i]); }
    }
}
__device__ __forceinline__ void sort16_desc(int (&v)[16]) {
    bstage<16, 2, 1>(v); bstage<16, 4, 2>(v); bstage<16, 4, 1>(v); bstage<16, 8, 4>(v); bstage<16, 8, 2>(v); bstage<16, 8, 1>(v);
    bstage<16, 16, 8>(v); bstage<16, 16, 4>(v); bstage<16, 16, 2>(v); bstage<16, 16, 1>(v);
}
__device__ __forceinline__ void sort8_desc(int (&v)[8]) {
    bstage<8, 2, 1>(v); bstage<8, 4, 2>(v); bstage<8, 4, 1>(v); bstage<8, 8, 4>(v); bstage<8, 8, 2>(v); bstage<8, 8, 1>(v);
}
__device__ __forceinline__ void bitonic_merge16_desc(int (&v)[16]) {
    bstage<16, 16, 8>(v); bstage<16, 16, 4>(v); bstage<16, 16, 2>(v); bstage<16, 16, 1>(v);
}
__device__ __forceinline__ void xmerge16(int (&v)[16], int off) {
    int m[16];
#pragma unroll
    for (int i = 0; i < 16; ++i) m[i] = max(v[i], __shfl_xor(v[15 - i], off));
    bitonic_merge16_desc(m);
#pragma unroll
    for (int i = 0; i < 16; ++i) v[i] = m[i];
}
__device__ __forceinline__ void opaque16(int (&v)[16]) {
#pragma unroll
    for (int i = 0; i < 16; ++i) asm volatile("" : "+v"(v[i]));
}
__device__ __forceinline__ int lookup16(const int (&arr)[16], int a) {
    int r = arr[0];
#pragma unroll
    for (int i = 1; i < 16; ++i) r = (a == i) ? arr[i] : r;
    return r;
}
__device__ __forceinline__ void peer_route2_phase(const bf16_t* __restrict__ qbuf, const bf16_t* __restrict__ skb, int* __restrict__ eidx, float* __restrict__ egate, unsigned char* lds) {
    const int tid = tidx(), wave = tid >> 6, lane = tid & 63, fr = lane & 15, fq = lane >> 4;
    for (int chunk = blockIdx.x; chunk < NT / 128; chunk += gridDim.x) {
        const int token = chunk * 128 + wave * 16 + fr;
        int* tl = (int*)(lds + 34816) + (wave * 16 + fr) * 48;
        for (int h = 0; h < 8; ++h) {
            int K1[16], K2[16];
#pragma unroll
            for (int c = 0; c < 2; ++c) {
                __syncthreads();
#pragma unroll
                for (int i = 0; i < 4; ++i) {
                    const int idx = tid + 512 * i, row = idx >> 4, ch = idx & 15;
                    *(uint4*)(lds + row * 272 + ch * 16) = *(const uint4*)(skb + ((size_t)(h * 2 + c) * 128 + row) * 128 + ch * 8);
                }
                __syncthreads();
                bf16x8_t qf[4];
#pragma unroll
                for (int sI = 0; sI < 4; ++sI) qf[sI] = *(const bf16x8_t*)(qbuf + (size_t)token * 2048 + h * 256 + c * 128 + 32 * sI + 8 * fq);
                int va[16], vb[16];
#pragma unroll
                for (int n = 0; n < 8; ++n) {
                    f32x4 S = {0.f, 0.f, 0.f, 0.f};
#pragma unroll
                    for (int sI = 0; sI < 4; ++sI) {
                        const bf16x8_t kf = *(const bf16x8_t*)(lds + (16 * n + fr) * 272 + (32 * sI + 8 * fq) * 2);
                        S = __builtin_amdgcn_mfma_f32_16x16x32_bf16(kf, qf[sI], S, 0, 0, 0);
                    }
#pragma unroll
                    for (int j = 0; j < 4; ++j) {
                        const int key = (f2key(S[j]) & ~127) | (16 * n + 4 * fq + j);
                        if (n < 4) va[n * 4 + j] = key; else vb[(n - 4) * 4 + j] = key;
                    }
                }
                sort16_desc(va); sort16_desc(vb);
                int m[16];
#pragma unroll
                for (int i = 0; i < 16; ++i) m[i] = max(va[i], vb[15 - i]);
                bitonic_merge16_desc(m);
                xmerge16(m, 16); xmerge16(m, 32);
#pragma unroll
                for (int i = 0; i < 16; ++i) { if (c == 0) K1[i] = m[i]; else K2[i] = m[i]; }
                if (fq == 0) {
#pragma unroll
                    for (int i = 0; i < 4; ++i) *(int4*)(tl + c * 16 + 4 * i) = make_int4(m[4 * i], m[4 * i + 1], m[4 * i + 2], m[4 * i + 3]);
                }
            }
            wave_lds_fence();
            float vaf[4];
#pragma unroll
            for (int k = 0; k < 4; ++k) vaf[k] = key2f(tl[4 * k + fq]);
            int A[16];
#pragma unroll
            for (int b = 0; b < 16; ++b) {
                const bool valid = (fq + 1) * (b + 1) <= 16;
                const int key = (f2key(vaf[0] + key2f(K2[b])) & ~127) | (fq << 5) | b;
                A[b] = valid ? key : INT_MIN;
            }
            int Bq[8];
#pragma unroll
            for (int b = 0; b < 3; ++b) {
                const bool valid = (fq + 5) * (b + 1) <= 16;
                const int key = (f2key(vaf[1] + key2f(K2[b])) & ~127) | (fq << 5) | (16 + b);
                Bq[b] = valid ? key : INT_MIN;
            }
            Bq[3] = (f2key(vaf[2] + key2f(K2[0])) & ~127) | (fq << 5) | 19;
            Bq[4] = (f2key(vaf[3] + key2f(K2[0])) & ~127) | (fq << 5) | 20;
            Bq[5] = INT_MIN; Bq[6] = INT_MIN; Bq[7] = INT_MIN;
            sort8_desc(Bq);
#pragma unroll
            for (int i = 8; i < 16; ++i) A[i] = max(A[i], Bq[15 - i]);
            bitonic_merge16_desc(A);
            xmerge16(A, 16); xmerge16(A, 32);
            if (fq == 0) {
#pragma unroll
                for (int i = 0; i < 4; ++i) *(int4*)(tl + 32 + 4 * i) = make_int4(A[4 * i], A[4 * i + 1], A[4 * i + 2], A[4 * i + 3]);
            }
            wave_lds_fence();
            const int4 myT = *(const int4*)(tl + 32 + 4 * fq);
            const int tsel[4] = {myT.x, myT.y, myT.z, myT.w};
            const float top0 = key2f(A[0]);
            float sum = 0.f;
#pragma unroll
            for (int r = 0; r < 16; ++r) sum += __expf(key2f(A[r]) - top0);
            const float inv = 1.f / sum;
            int eo[4]; float go[4];
#pragma unroll
            for (int kk = 0; kk < 4; ++kk) {
                const int t = tsel[kk];
                const int id = t & 127, ofq = id >> 5, slot = id & 31;
                const int k = slot < 16 ? 0 : (slot < 19 ? 1 : (slot == 19 ? 2 : 3));
                const int b = slot < 16 ? slot : (slot < 19 ? slot - 16 : 0);
                const int a = ofq + 4 * k;
                const int e1 = tl[a] & 127, e2 = tl[16 + b] & 127;
                eo[kk] = e1 * 128 + e2;
                go[kk] = __expf(key2f(t) - top0) * inv;
            }
            *(int4*)(eidx + (size_t)token * 128 + h * 16 + 4 * fq) = make_int4(eo[0], eo[1], eo[2], eo[3]);
            *(float4*)(egate + (size_t)token * 128 + h * 16 + 4 * fq) = make_float4(go[0], go[1], go[2], go[3]);
            wave_lds_fence();
        }
    }
    __syncthreads();
}

typedef __bf16 bf16x2_t __attribute__((ext_vector_type(2)));
typedef float f32x2_t __attribute__((ext_vector_type(2)));
__device__ __forceinline__ float dot2bf(unsigned a, unsigned b, float acc) { return __builtin_amdgcn_fdot2_f32_bf16(__builtin_bit_cast(bf16x2_t, a), __builtin_bit_cast(bf16x2_t, b), acc, false); }
__device__ __forceinline__ float gelu_fast(float x) {
    const float u = 0.7978845608028654f * (x + 0.044715f * x * x * x);
    return x / (1.f + __expf(-2.f * u));
}
__device__ __forceinline__ void peer_expert2_phase(float* R, const int* __restrict__ eidx, const float* __restrict__ egate, const bf16_t* __restrict__ ub,
                                                   const bf16_t* __restrict__ vb, const float* __restrict__ lg, const float* __restrict__ lb, bf16_t* Hb) {
    const int wave = tidx() >> 6, lane = tidx() & 63;
    for (int token = blockIdx.x * 8 + wave; token < NT; token += gridDim.x * 8) {
        float xf[16];
        {
            const float* rp = R + (size_t)token * ND + lane * 8;
            const float4 a0 = *(const float4*)rp, a1 = *(const float4*)(rp + 4), b0 = *(const float4*)(rp + 512), b1 = *(const float4*)(rp + 516);
            xf[0] = a0.x; xf[1] = a0.y; xf[2] = a0.z; xf[3] = a0.w; xf[4] = a1.x; xf[5] = a1.y; xf[6] = a1.z; xf[7] = a1.w;
            xf[8] = b0.x; xf[9] = b0.y; xf[10] = b0.z; xf[11] = b0.w; xf[12] = b1.x; xf[13] = b1.y; xf[14] = b1.z; xf[15] = b1.w;
        }
        unsigned xp[8];
#pragma unroll
        for (int j = 0; j < 8; ++j) xp[j] = pack2(xf[2 * j], xf[2 * j + 1]);
        float acc[16];
#pragma unroll
        for (int j = 0; j < 16; ++j) acc[j] = 0.f;
        const int e_lo = eidx[(size_t)token * 128 + lane], e_hi = eidx[(size_t)token * 128 + 64 + lane];
        const float g_lo = egate[(size_t)token * 128 + lane], g_hi = egate[(size_t)token * 128 + 64 + lane];
        for (int grp = 0; grp < 16; ++grp) {
            const int esel = grp < 8 ? e_lo : e_hi;
            const float gsel = grp < 8 ? g_lo : g_hi;
            const int lbase = (grp & 7) * 8;
            uint4 u0[8], u1[8];
            int exs[8];
#pragma unroll
            for (int k = 0; k < 8; ++k) {
                exs[k] = __builtin_amdgcn_readlane(esel, lbase + k);
                const bf16_t* up = ub + (size_t)exs[k] * ND + lane * 8;
                u0[k] = *(const uint4*)up; u1[k] = *(const uint4*)(up + 512);
            }
            float d[8];
#pragma unroll
            for (int k = 0; k < 8; ++k) {
                float a = dot2bf(u0[k].x, xp[0], 0.f), b = dot2bf(u0[k].y, xp[1], 0.f);
                a = dot2bf(u0[k].z, xp[2], a); b = dot2bf(u0[k].w, xp[3], b);
                a = dot2bf(u1[k].x, xp[4], a); b = dot2bf(u1[k].y, xp[5], b);
                a = dot2bf(u1[k].z, xp[6], a); b = dot2bf(u1[k].w, xp[7], b);
                d[k] = a + b;
            }
            const bool hi5 = lane & 32, hi4 = lane & 16, hi3 = lane & 8;
            float r4[4], r2[2], r1;
#pragma unroll
            for (int k = 0; k < 4; ++k) { const float send = hi5 ? d[k] : d[k + 4], keep = hi5 ? d[k + 4] : d[k]; r4[k] = keep + __shfl_xor(send, 32); }
#pragma unroll
            for (int k = 0; k < 2; ++k) { const float send = hi4 ? r4[k] : r4[k + 2], keep = hi4 ? r4[k + 2] : r4[k]; r2[k] = keep + __shfl_xor(send, 16); }
            { const float send = hi3 ? r2[0] : r2[1], keep = hi3 ? r2[1] : r2[0]; r1 = keep + __shfl_xor(send, 8); }
            r1 += __shfl_xor(r1, 4); r1 += __shfl_xor(r1, 2); r1 += __shfl_xor(r1, 1);
            uint4 v0[8], v1[8];
#pragma unroll
            for (int k = 0; k < 8; ++k) {
                const bf16_t* vp = vb + (size_t)exs[k] * ND + lane * 8;
                v0[k] = *(const uint4*)vp; v1[k] = *(const uint4*)(vp + 512);
            }
            const float gk = __shfl(gsel, lbase + (lane >> 3));
            const float coef = gk * gelu_fast(r1);
#pragma unroll
            for (int k = 0; k < 8; ++k) {
                const float ck = __int_as_float(__builtin_amdgcn_readlane(__float_as_int(coef), 8 * k));
                const unsigned w[8] = {v0[k].x, v0[k].y, v0[k].z, v0[k].w, v1[k].x, v1[k].y, v1[k].z, v1[k].w};
#pragma unroll
                for (int j = 0; j < 8; ++j) {
                    acc[2 * j] += ck * __uint_as_float(w[j] << 16);
                    acc[2 * j + 1] += ck * __uint_as_float(w[j] & 0xffff0000u);
                }
            }
        }
        {
            const float* rp = R + (size_t)token * ND + lane * 8;
            const float4 a0 = *(const float4*)rp, a1 = *(const float4*)(rp + 4), b0 = *(const float4*)(rp + 512), b1 = *(const float4*)(rp + 516);
            xf[0] = a0.x; xf[1] = a0.y; xf[2] = a0.z; xf[3] = a0.w; xf[4] = a1.x; xf[5] = a1.y; xf[6] = a1.z; xf[7] = a1.w;
            xf[8] = b0.x; xf[9] = b0.y; xf[10] = b0.z; xf[11] = b0.w; xf[12] = b1.x; xf[13] = b1.y; xf[14] = b1.z; xf[15] = b1.w;
        }
        float s = 0.f;
#pragma unroll
        for (int j = 0; j < 16; ++j) { xf[j] = ALPHA * xf[j] + acc[j]; s += xf[j]; }
        for (int o = 32; o; o >>= 1) s += __shfl_xor(s, o);
        const float mean = s * (1.f / ND);
        float s2 = 0.f;
#pragma unroll
        for (int j = 0; j < 16; ++j) { xf[j] -= mean; s2 += xf[j] * xf[j]; }
        for (int o = 32; o; o >>= 1) s2 += __shfl_xor(s2, o);
        const float rs = rsqrtf(s2 * (1.f / ND) + LN_EPS);
#pragma unroll
        for (int hf = 0; hf < 2; ++hf) {
            const int c0 = hf * 512 + lane * 8;
            const float4 g0 = *(const float4*)(lg + c0), g1 = *(const float4*)(lg + c0 + 4), b0 = *(const float4*)(lb + c0), b1 = *(const float4*)(lb + c0 + 4);
            float o[8];
            o[0] = xf[hf * 8 + 0] * rs * g0.x + b0.x; o[1] = xf[hf * 8 + 1] * rs * g0.y + b0.y; o[2] = xf[hf * 8 + 2] * rs * g0.z + b0.z; o[3] = xf[hf * 8 + 3] * rs * g0.w + b0.w;
            o[4] = xf[hf * 8 + 4] * rs * g1.x + b1.x; o[5] = xf[hf * 8 + 5] * rs * g1.y + b1.y; o[6] = xf[hf * 8 + 6] * rs * g1.z + b1.z; o[7] = xf[hf * 8 + 7] * rs * g1.w + b1.w;
            float* op = R + (size_t)token * ND + c0;
            *(float4*)op = make_float4(o[0], o[1], o[2], o[3]); *(float4*)(op + 4) = make_float4(o[4], o[5], o[6], o[7]);
            if (Hb) st8(Hb + (size_t)token * ND + c0, o);
        }
    }
}


template <int K2, int J> __device__ __forceinline__ void bsort_round(int (&k)[2], float (&g)[2], int lane) {
    if (J == 64) {
        const bool sw = k[0] > k[1];
        const int t = k[0]; const float tg = g[0];
        k[0] = sw ? k[1] : k[0]; g[0] = sw ? g[1] : g[0]; k[1] = sw ? t : k[1]; g[1] = sw ? tg : g[1];
    } else {
#pragma unroll
        for (int r = 0; r < 2; ++r) {
            const int pk = __shfl_xor(k[r], J); const float pg = __shfl_xor(g[r], J);
            const bool asc = (((lane + 64 * r) & K2) == 0), lower = ((lane & J) == 0);
            const bool take = (lower == asc) ? (pk < k[r]) : (pk > k[r]);
            k[r] = take ? pk : k[r]; g[r] = take ? pg : g[r];
        }
    }
}
template <int K2> __device__ __forceinline__ void bsort_stage(int (&k)[2], float (&g)[2], int lane) {
    if (K2 >= 128) bsort_round<K2, 64>(k, g, lane);
    if (K2 >= 64) bsort_round<K2, 32>(k, g, lane);
    if (K2 >= 32) bsort_round<K2, 16>(k, g, lane);
    if (K2 >= 16) bsort_round<K2, 8>(k, g, lane);
    if (K2 >= 8) bsort_round<K2, 4>(k, g, lane);
    if (K2 >= 4) bsort_round<K2, 2>(k, g, lane);
    bsort_round<K2, 1>(k, g, lane);
}
__device__ __forceinline__ void sort_routing(int& e_lo, int& e_hi, float& g_lo, float& g_hi, int lane) {
    int k[2] = {e_lo, e_hi}; float g[2] = {g_lo, g_hi};
    bsort_stage<2>(k, g, lane); bsort_stage<4>(k, g, lane); bsort_stage<8>(k, g, lane); bsort_stage<16>(k, g, lane);
    bsort_stage<32>(k, g, lane); bsort_stage<64>(k, g, lane); bsort_stage<128>(k, g, lane);
    e_lo = k[0]; e_hi = k[1]; g_lo = g[0]; g_hi = g[1];
}
__device__ __forceinline__ void peer_expert3_phase(float* R, const int* __restrict__ eidx, const float* __restrict__ egate, const unsigned char* __restrict__ ub,
                                                   const unsigned char* __restrict__ vb, const float* __restrict__ lg, const float* __restrict__ lb, bf16_t* Hb, float* Rout, const XcdBarrier& xb) {
    const int wave = tidx() >> 6, lane = tidx() & 63;
    int itk = 0;
    for (int token = blockIdx.x * 8 + wave; token < NT; token += gridDim.x * 8, ++itk) {
        if ((itk & 1) == 0 && itk) xcd_barrier(xb);
        float xf[16];
        {
            const float* rp = R + (size_t)token * ND + lane * 16;
#pragma unroll
            for (int q = 0; q < 4; ++q) { const float4 a = *(const float4*)(rp + 4 * q); xf[4 * q] = a.x; xf[4 * q + 1] = a.y; xf[4 * q + 2] = a.z; xf[4 * q + 3] = a.w; }
        }
        float acc[16];
#pragma unroll
        for (int j = 0; j < 16; ++j) acc[j] = 0.f;
        int e_lo = eidx[(size_t)token * 128 + lane], e_hi = eidx[(size_t)token * 128 + 64 + lane];
        float g_lo = egate[(size_t)token * 128 + lane], g_hi = egate[(size_t)token * 128 + 64 + lane];
        sort_routing(e_lo, e_hi, g_lo, g_hi, lane);
        for (int grp = 0; grp < 16; ++grp) {
            const int esel = grp < 8 ? e_lo : e_hi;
            const float gsel = grp < 8 ? g_lo : g_hi;
            const int lbase = (grp & 7) * 8;
            uint4 u[8], v[8];
#pragma unroll
            for (int k = 0; k < 8; ++k) {
                const int ex = __builtin_amdgcn_readlane(esel, lbase + k);
                u[k] = *(const uint4*)(ub + (size_t)ex * ND + lane * 16);
                v[k] = *(const uint4*)(vb + (size_t)ex * ND + lane * 16);
            }
            float d[8];
#pragma unroll
            for (int k = 0; k < 8; ++k) {
                const unsigned w[4] = {u[k].x, u[k].y, u[k].z, u[k].w};
                float a = 0.f, b = 0.f;
#pragma unroll
                for (int q = 0; q < 4; ++q) {
                    const f32x2_t lo = __builtin_amdgcn_cvt_pk_f32_fp8((int)w[q], false), hi = __builtin_amdgcn_cvt_pk_f32_fp8((int)w[q], true);
                    a = fmaf(xf[4 * q], lo.x, a); b = fmaf(xf[4 * q + 1], lo.y, b); a = fmaf(xf[4 * q + 2], hi.x, a); b = fmaf(xf[4 * q + 3], hi.y, b);
                }
                d[k] = a + b;
            }
            const bool hi5 = lane & 32, hi4 = lane & 16, hi3 = lane & 8;
            float r4[4], r2[2], r1;
#pragma unroll
            for (int k = 0; k < 4; ++k) { const float send = hi5 ? d[k] : d[k + 4], keep = hi5 ? d[k + 4] : d[k]; r4[k] = keep + __shfl_xor(send, 32); }
#pragma unroll
            for (int k = 0; k < 2; ++k) { const float send = hi4 ? r4[k] : r4[k + 2], keep = hi4 ? r4[k + 2] : r4[k]; r2[k] = keep + __shfl_xor(send, 16); }
            { const float send = hi3 ? r2[0] : r2[1], keep = hi3 ? r2[1] : r2[0]; r1 = keep + __shfl_xor(send, 8); }
            r1 += __shfl_xor(r1, 4); r1 += __shfl_xor(r1, 2); r1 += __shfl_xor(r1, 1);
            const float gk = __shfl(gsel, lbase + (lane >> 3));
            const float coef = gk * gelu_fast(r1 * (1.f / U_SCALE)) * (1.f / V_SCALE);
#pragma unroll
            for (int k = 0; k < 8; ++k) {
                const float ck = __int_as_float(__builtin_amdgcn_readlane(__float_as_int(coef), 8 * k));
                const unsigned w[4] = {v[k].x, v[k].y, v[k].z, v[k].w};
#pragma unroll
                for (int q = 0; q < 4; ++q) {
                    const f32x2_t lo = __builtin_amdgcn_cvt_pk_f32_fp8((int)w[q], false), hi = __builtin_amdgcn_cvt_pk_f32_fp8((int)w[q], true);
                    acc[4 * q] = fmaf(ck, lo.x, acc[4 * q]); acc[4 * q + 1] = fmaf(ck, lo.y, acc[4 * q + 1]);
                    acc[4 * q + 2] = fmaf(ck, hi.x, acc[4 * q + 2]); acc[4 * q + 3] = fmaf(ck, hi.y, acc[4 * q + 3]);
                }
            }
        }
        float s = 0.f;
#pragma unroll
        for (int j = 0; j < 16; ++j) { xf[j] = ALPHA * xf[j] + acc[j]; s += xf[j]; }
        for (int o = 32; o; o >>= 1) s += __shfl_xor(s, o);
        const float mean = s * (1.f / ND);
        float s2 = 0.f;
#pragma unroll
        for (int j = 0; j < 16; ++j) { xf[j] -= mean; s2 += xf[j] * xf[j]; }
        for (int o = 32; o; o >>= 1) s2 += __shfl_xor(s2, o);
        const float rs = rsqrtf(s2 * (1.f / ND) + LN_EPS);
        float o[16];
#pragma unroll
        for (int q = 0; q < 4; ++q) {
            const float4 gg = *(const float4*)(lg + lane * 16 + 4 * q), bb = *(const float4*)(lb + lane * 16 + 4 * q);
            o[4 * q] = xf[4 * q] * rs * gg.x + bb.x; o[4 * q + 1] = xf[4 * q + 1] * rs * gg.y + bb.y; o[4 * q + 2] = xf[4 * q + 2] * rs * gg.z + bb.z; o[4 * q + 3] = xf[4 * q + 3] * rs * gg.w + bb.w;
            *(float4*)(Rout + (size_t)token * ND + lane * 16 + 4 * q) = make_float4(o[4 * q], o[4 * q + 1], o[4 * q + 2], o[4 * q + 3]);
        }
        if (Hb) { st8(Hb + (size_t)token * ND + lane * 16, o); st8(Hb + (size_t)token * ND + lane * 16 + 8, o + 8); }
    }
}


struct Rows8 { uint4 r[8]; };
__device__ __forceinline__ void rows_load(Rows8& G, int esel, int lbase, const unsigned char* __restrict__ tb, int lane) {
#pragma unroll
    for (int k = 0; k < 8; ++k) {
        const int ex = __builtin_amdgcn_readlane(esel, lbase + k);
        G.r[k] = *(const uint4*)(tb + (size_t)ex * ND + lane * 16);
    }
}
__device__ __forceinline__ void sweep_u(const Rows8& G, const float (&xf)[16], float gsel, int lbase, int lane, float* cl  , int grp) {
    float d[8];
#pragma unroll
    for (int k = 0; k < 8; ++k) {
        const unsigned w[4] = {G.r[k].x, G.r[k].y, G.r[k].z, G.r[k].w};
        float a = 0.f, b = 0.f;
#pragma unroll
        for (int q = 0; q < 4; ++q) {
            const f32x2_t lo = __builtin_amdgcn_cvt_pk_f32_fp8((int)w[q], false), hi = __builtin_amdgcn_cvt_pk_f32_fp8((int)w[q], true);
            a = fmaf(xf[4 * q], lo.x, a); b = fmaf(xf[4 * q + 1], lo.y, b); a = fmaf(xf[4 * q + 2], hi.x, a); b = fmaf(xf[4 * q + 3], hi.y, b);
        }
        d[k] = a + b;
    }
    const bool hi5 = lane & 32, hi4 = lane & 16, hi3 = lane & 8;
    float r4[4], r2[2], r1;
#pragma unroll
    for (int k = 0; k < 4; ++k) { const float send = hi5 ? d[k] : d[k + 4], keep = hi5 ? d[k + 4] : d[k]; r4[k] = keep + __shfl_xor(send, 32); }
#pragma unroll
    for (int k = 0; k < 2; ++k) { const float send = hi4 ? r4[k] : r4[k + 2], keep = hi4 ? r4[k + 2] : r4[k]; r2[k] = keep + __shfl_xor(send, 16); }
    { const float send = hi3 ? r2[0] : r2[1], keep = hi3 ? r2[1] : r2[0]; r1 = keep + __shfl_xor(send, 8); }
    r1 += __shfl_xor(r1, 4); r1 += __shfl_xor(r1, 2); r1 += __shfl_xor(r1, 1);
    const float gk = __shfl(gsel, lbase + (lane >> 3));
    const float coef = gk * gelu_fast(r1 * (1.f / U_SCALE)) * (1.f / V_SCALE);
    if ((lane & 7) == 0) cl[grp * 8 + (lane >> 3)] = coef;
}
__device__ __forceinline__ void sweep_v(const Rows8& G, float (&acc)[16], const float* cl, int grp) {
#pragma unroll
    for (int k = 0; k < 8; ++k) {
        const float ck = cl[grp * 8 + k];
        const unsigned w[4] = {G.r[k].x, G.r[k].y, G.r[k].z, G.r[k].w};
#pragma unroll
        for (int q = 0; q < 4; ++q) {
            const f32x2_t lo = __builtin_amdgcn_cvt_pk_f32_fp8((int)w[q], false), hi = __builtin_amdgcn_cvt_pk_f32_fp8((int)w[q], true);
            acc[4 * q] = fmaf(ck, lo.x, acc[4 * q]); acc[4 * q + 1] = fmaf(ck, lo.y, acc[4 * q + 1]);
            acc[4 * q + 2] = fmaf(ck, hi.x, acc[4 * q + 2]); acc[4 * q + 3] = fmaf(ck, hi.y, acc[4 * q + 3]);
        }
    }
}
__device__ __forceinline__ void peer_expert6_phase(float* R, const int* __restrict__ eidx, const float* __restrict__ egate, const unsigned char* __restrict__ ub,
                                                   const unsigned char* __restrict__ vb, const float* __restrict__ lg, const float* __restrict__ lb, bf16_t* Hb, const XcdBarrier& xb, float* lds) {
    const int wave = __builtin_amdgcn_readfirstlane(tidx() >> 6), lane = tidx() & 63;
    float* cl = lds + wave * 128;
    int itk = 0;
    for (int token = blockIdx.x * 8 + wave; token < NT; token += gridDim.x * 8, ++itk) {
        if (itk) xcc_align(xb);
        float xf[16];
        {
            const float* rp = R + (size_t)token * ND + lane * 16;
#pragma unroll
            for (int q = 0; q < 4; ++q) { const float4 a = *(const float4*)(rp + 4 * q); xf[4 * q] = a.x; xf[4 * q + 1] = a.y; xf[4 * q + 2] = a.z; xf[4 * q + 3] = a.w; }
        }
        int e_lo = eidx[(size_t)token * 128 + lane], e_hi = eidx[(size_t)token * 128 + 64 + lane];
        float g_lo = egate[(size_t)token * 128 + lane], g_hi = egate[(size_t)token * 128 + 64 + lane];
        sort_routing(e_lo, e_hi, g_lo, g_hi, lane);
        Rows8 GA, GB;
        wave_lds_fence();
        rows_load(GA, e_lo, 0, ub, lane);
#pragma unroll 1
        for (int gp = 0; gp < 8; ++gp) {
            const int g0i = 2 * gp, g1i = 2 * gp + 1;
            rows_load(GB, g1i < 8 ? e_lo : e_hi, (g1i & 7) * 8, ub, lane);
            __builtin_amdgcn_sched_barrier(0);
            sweep_u(GA, xf, g0i < 8 ? g_lo : g_hi, (g0i & 7) * 8, lane, cl, g0i);
            __builtin_amdgcn_sched_barrier(0);
            rows_load(GA, gp < 7 ? ((g0i + 2) < 8 ? e_lo : e_hi) : e_lo, gp < 7 ? ((g0i + 2) & 7) * 8 : 0, gp < 7 ? ub : vb, lane);
            __builtin_amdgcn_sched_barrier(0);
            sweep_u(GB, xf, g1i < 8 ? g_lo : g_hi, (g1i & 7) * 8, lane, cl, g1i);
            __builtin_amdgcn_sched_barrier(0);
        }
        wave_lds_fence();
        xcc_align(xb);
        float acc[16];
#pragma unroll
        for (int j = 0; j < 16; ++j) acc[j] = 0.f;
#pragma unroll 1
        for (int gp = 0; gp < 8; ++gp) {
            const int g0i = 2 * gp, g1i = 2 * gp + 1;
            rows_load(GB, g1i < 8 ? e_lo : e_hi, (g1i & 7) * 8, vb, lane);
            __builtin_amdgcn_sched_barrier(0);
            sweep_v(GA, acc, cl, g0i);
            __builtin_amdgcn_sched_barrier(0);
            if (gp < 7) rows_load(GA, (g0i + 2) < 8 ? e_lo : e_hi, ((g0i + 2) & 7) * 8, vb, lane);
            __builtin_amdgcn_sched_barrier(0);
            sweep_v(GB, acc, cl, g1i);
            __builtin_amdgcn_sched_barrier(0);
        }
        float s = 0.f;
#pragma unroll
        for (int j = 0; j < 16; ++j) { xf[j] = ALPHA * xf[j] + acc[j]; s += xf[j]; }
        for (int o = 32; o; o >>= 1) s += __shfl_xor(s, o);
        const float mean = s * (1.f / ND);
        float s2 = 0.f;
#pragma unroll
        for (int j = 0; j < 16; ++j) { xf[j] -= mean; s2 += xf[j] * xf[j]; }
        for (int o = 32; o; o >>= 1) s2 += __shfl_xor(s2, o);
        const float rs = rsqrtf(s2 * (1.f / ND) + LN_EPS);
        float o[16];
        int lofs = lane * 16;
        asm volatile("" : "+v"(lofs));
#pragma unroll
        for (int q = 0; q < 4; ++q) {
            const float4 gg = *(const float4*)(lg + lofs + 4 * q), bb = *(const float4*)(lb + lofs + 4 * q);
            o[4 * q] = xf[4 * q] * rs * gg.x + bb.x; o[4 * q + 1] = xf[4 * q + 1] * rs * gg.y + bb.y; o[4 * q + 2] = xf[4 * q + 2] * rs * gg.z + bb.z; o[4 * q + 3] = xf[4 * q + 3] * rs * gg.w + bb.w;
            *(float4*)(R + (size_t)token * ND + lofs + 4 * q) = make_float4(o[4 * q], o[4 * q + 1], o[4 * q + 2], o[4 * q + 3]);
        }
        if (Hb) { st8(Hb + (size_t)token * ND + lofs, o); st8(Hb + (size_t)token * ND + lofs + 8, o + 8); }
    }
}

__device__ __forceinline__ void nsa_compress_phase(const bf16_t* __restrict__ proj, int coloff, const float* __restrict__ pe, const float* __restrict__ w1,
                                   const float* __restrict__ w2, float* __restrict__ outc, float* lds) {
    const int qtr = tidx() >> 7, tid = tidx() & 127;
    float* in = lds + qtr * 2176;
    float* hid = in + 2048;
    for (int it = blockIdx.x; it < NB * 127; it += gridDim.x) {
        const int g = qtr, n = it % 127, b = it / 127;
        __syncthreads();
        for (int idx = tid; idx < 2048; idx += 128) {
            const int l = idx >> 6, d = idx & 63;
            in[idx] = bf2f(proj[(size_t)(b * NL + 16 * n + l) * ODD_PAD + coloff + g * 64 + d]) + pe[l * 64 + d];
        }
        __syncthreads();
        float a = 0.f;
        for (int i = 0; i < 2048; ++i) a += in[i] * w1[(size_t)i * 128 + tid];
        hid[tid] = gelu_tanh(a);
        __syncthreads();
        if (tid < 64) {
            float o = 0.f;
            for (int j = 0; j < 128; ++j) o += hid[j] * w2[j * 64 + tid];
            outc[((size_t)(b * 127 + n) * 4 + g) * 64 + tid] = o;
        }
    }
    __syncthreads();
}

__device__ __forceinline__ void nsa_cmp_phase(const bf16_t* __restrict__ proj, const float* __restrict__ kcmp, const float* __restrict__ vcmp,
                              bf16_t* __restrict__ O, unsigned* __restrict__ selmask, float* lds) {
    const int half = tidx() >> 8, tid = tidx() & 255;
    float* kc_s = lds + half * 18368;
    float* vc_s = kc_s + 127 * 64;
    float(*imp_s)[33] = (float(*)[33])(vc_s + 127 * 64);
    const int tk = tid >> 2, r = tid & 3;
    for (int it = blockIdx.x; it < 32 * 4 * NB / 2; it += gridDim.x) {
        const int vb = it * 2 + half;
        const int tile = vb & 31, g = (vb >> 5) & 3, b = vb >> 7;
        const int t = tile * 64 + tk, hd = g * 4 + r;
        __syncthreads();
        for (int idx = tid; idx < 127 * 64; idx += 256) { const int n = idx >> 6, d = idx & 63; kc_s[idx] = kcmp[((size_t)(b * 127 + n) * 4 + g) * 64 + d]; vc_s[idx] = vcmp[((size_t)(b * 127 + n) * 4 + g) * 64 + d]; }
        const bf16_t* prow = proj + (size_t)(b * NL + t) * ODD_PAD;
        float q[64];
#pragma unroll
        for (int d = 0; d < 64; d += 8) ld8(prow + hd * 64 + d, q + d);
        const float slope = exp2f(-0.5f * (float)(hd + 1));
        int nvalid = (t >= 31) ? ((t - 31) / 16 + 1) : 0;
        if (nvalid > 127) nvalid = 127;
        __syncthreads();
        float m = -INFINITY, l = 0.f;
        for (int n = 0; n < nvalid; ++n) {
            float s = 0.f;
#pragma unroll
            for (int d = 0; d < 64; ++d) s += q[d] * kc_s[n * 64 + d];
            s = s * 0.125f - slope * (float)(t - (16 * n + 31));
            const float mn = fmaxf(m, s);
            l = l * expf(m - mn) + expf(s - mn);
            m = mn;
        }
        const float inv_l = (nvalid > 0) ? 1.f / fmaxf(l, 1e-30f) : 0.f;
        float acc[64];
#pragma unroll
        for (int d = 0; d < 64; ++d) acc[d] = 0.f;
        float prev3 = 0.f;
        for (int j = 0; j < 32; ++j) {
            float pj[4];
#pragma unroll
            for (int nn = 0; nn < 4; ++nn) {
                const int n = 4 * j + nn;
                float p = 0.f;
                if (n < nvalid) {
                    float s = 0.f;
#pragma unroll
                    for (int d = 0; d < 64; ++d) s += q[d] * kc_s[n * 64 + d];
                    s = s * 0.125f - slope * (float)(t - (16 * n + 31));
                    p = expf(s - m) * inv_l;
                    const float* vr = vc_s + n * 64;
#pragma unroll
                    for (int d = 0; d < 64; ++d) acc[d] += p * vr[d];
                }
                pj[nn] = p;
            }
            float im = 0.5f * prev3 + pj[0] + pj[1] + pj[2] + 0.5f * pj[3];
            prev3 = pj[3];
            im += __shfl_xor(im, 1);
            im += __shfl_xor(im, 2);
            if (r == 0) imp_s[tk][j] = im;
        }
        const float g0 = sigmoidf_(bf2f(prow[2048 + hd]));
#pragma unroll
        for (int d = 0; d < 64; ++d) acc[d] *= g0;
#pragma unroll
        for (int d = 0; d < 64; d += 8) st8(O + (size_t)(b * NL + t) * ND + hd * 64 + d, acc + d);
        __syncthreads();
        const int cur = tile;
        unsigned bits = 0;
        for (int jj = 0; jj < 8; ++jj) {
            const int j = r * 8 + jj;
            const bool fj = (j == 0) || (j == cur) || (j == cur - 1);
            const float vj = (j <= cur) ? imp_s[tk][j] + (fj ? 1000.f : 0.f) : -INFINITY;
            int rank = 0;
            for (int k = 0; k < 32; ++k) {
                const bool fk = (k == 0) || (k == cur) || (k == cur - 1);
                const float vk = (k <= cur) ? imp_s[tk][k] + (fk ? 1000.f : 0.f) : -INFINITY;
                rank += (vk > vj || (vk == vj && k < j)) ? 1 : 0;
            }
            if (rank < 16) bits |= 1u << j;
        }
        bits |= __shfl_xor(bits, 1);
        bits |= __shfl_xor(bits, 2);
        if (r == 0) selmask[(size_t)(b * 4 + g) * NL + t] = bits;
    }
    __syncthreads();
}

__device__ __forceinline__ void nsa_selwin_phase(const bf16_t* __restrict__ proj, const unsigned* __restrict__ selmask, bf16_t* O, float* lds) {
    const int half = tidx() >> 8, tid = tidx() & 255;
    float(*k_s)[64] = (float(*)[64])(lds + half * 8192);
    float(*v_s)[64] = (float(*)[64])(lds + half * 8192 + 4096);
    const int tk = tid >> 2, r = tid & 3;
    for (int it = blockIdx.x; it < 32 * 32; it += gridDim.x) {
        const int tile = 31 - (it >> 5);
        const int bgi = (it & 31) * 2 + half, g = bgi & 3, b = bgi >> 2;
        const int t = tile * 64 + tk, hd = g * 4 + r;
        const bf16_t* pb = proj + (size_t)b * NL * ODD_PAD;
        const bf16_t* prow = pb + (size_t)t * ODD_PAD;
        float q[64], acc[64];
#pragma unroll
        for (int d = 0; d < 64; d += 8) ld8(prow + hd * 64 + d, q + d);
        const float slope = exp2f(-0.5f * (float)(hd + 1));
        const unsigned mask = selmask[(size_t)(b * 4 + g) * NL + t];
        bf16_t* orow = O + (size_t)(b * NL + t) * ND + hd * 64;
        for (int branch = 0; branch < 2; ++branch) {
            const int kcol = (branch == 0 ? 1536 : 2048) + g * 64, vcol = kcol + 256;
            const int j0 = (branch == 0) ? 0 : (tile >= 8 ? tile - 8 : 0);
            float m = -1e30f, l = 0.f;
#pragma unroll
            for (int d = 0; d < 64; ++d) acc[d] = 0.f;
            for (int j = j0; j <= tile; ++j) {
                __syncthreads();
                for (int i = 0; i < 16; ++i) {
                    const int idx = tid + 256 * i, key = idx >> 6, d = idx & 63;
                    k_s[key][d] = bf2f(pb[(size_t)(64 * j + key) * ODD_PAD + kcol + d]);
                    v_s[key][d] = bf2f(pb[(size_t)(64 * j + key) * ODD_PAD + vcol + d]);
                }
                __syncthreads();
                const bool take = (branch == 0) ? ((mask >> j) & 1u) : true;
                if (take) {
                    for (int s = 0; s < 64; ++s) {
                        const int dist = t - (64 * j + s);
                        const bool valid = (branch == 0) ? (dist >= 0) : (dist >= 0 && dist < 512);
                        float sc = 0.f;
#pragma unroll
                        for (int d = 0; d < 64; ++d) sc += q[d] * k_s[s][d];
                        sc = sc * 0.125f - slope * (float)dist;
                        const float mn = valid ? fmaxf(m, sc) : m;
                        const float scale = expf(m - mn);
                        const float p = valid ? expf(sc - mn) : 0.f;
                        l = l * scale + p;
#pragma unroll
                        for (int d = 0; d < 64; ++d) acc[d] = acc[d] * scale + p * v_s[s][d];
                        m = mn;
                    }
                }
            }
            const float gt = sigmoidf_(bf2f(prow[2560 + (branch + 1) * 16 + hd]));
            const float f = gt / fmaxf(l, 1e-30f);
#pragma unroll
            for (int d = 0; d < 64; d += 8) {
                float o[8];
                ld8(orow + d, o);
#pragma unroll
                for (int j = 0; j < 8; ++j) o[j] += f * acc[d + j];
                st8(orow + d, o);
            }
        }
    }
    __syncthreads();
}


typedef float f32x16 __attribute__((ext_vector_type(16)));
#define MFMA32(a, b, c) __builtin_amdgcn_mfma_f32_32x32x16_bf16((a), (b), (c), 0, 0, 0)
__device__ __forceinline__ unsigned cvtpk(float lo, float hi) { const f32x2_t f = {lo, hi}; return __builtin_bit_cast(unsigned, __builtin_convertvector(f, bf16x2_t)); }
__device__ __forceinline__ int crow32(int reg, int h) { return (reg & 3) + 8 * (reg >> 2) + 4 * h; }
constexpr float LOG2E = 1.4426950408889634f;
__device__ __forceinline__ void nsa_attn_phase(const bf16_t* __restrict__ proj, const bf16_t* __restrict__ vt, const unsigned* __restrict__ selmask, bf16_t* O, unsigned char* lds) {
    const int tid = tidx(), wave = __builtin_amdgcn_readfirstlane(tid >> 6), lane = tid & 63, l31 = lane & 31, h = lane >> 5;
    const int r = wave & 3, thalf = wave >> 2;
    const int skey = tid >> 3, spart = tid & 7;
    for (int it = blockIdx.x; it < 32 * 64; it += gridDim.x) {
        const int tile = 31 - (it >> 6), bg = it & 63, g = bg & 3, b = bg >> 2;
        const int hd = g * 4 + r, tokoff = thalf * 32 + l31, tok = tile * 64 + tokoff;
        const size_t trow = (size_t)(b * NL + tok);
        const float slope = exp2f(-0.5f * (float)(hd + 1));
        bf16x8_t Qf[4];
#pragma unroll
        for (int ds = 0; ds < 4; ++ds) {
            float q[8];
            ld8(proj + trow * ODD_PAD + hd * 64 + 16 * ds + 8 * h, q);
            u32x4 w; w.x = cvtpk(q[0] * 0.125f, q[1] * 0.125f); w.y = cvtpk(q[2] * 0.125f, q[3] * 0.125f); w.z = cvtpk(q[4] * 0.125f, q[5] * 0.125f); w.w = cvtpk(q[6] * 0.125f, q[7] * 0.125f);
            Qf[ds] = __builtin_bit_cast(bf16x8_t, w);
        }
        float sc[16];
#pragma unroll
        for (int reg = 0; reg < 16; ++reg) sc[reg] = slope * (float)crow32(reg, h);
        const unsigned mymask = selmask[(size_t)(b * 4 + g) * NL + tok];
        __syncthreads();
        if (wave == 0) {
            unsigned m = selmask[(size_t)(b * 4 + g) * NL + tile * 64 + lane];
            for (int o = 32; o; o >>= 1) m |= __shfl_xor(m, o);
            if (lane == 0) *(unsigned*)(lds + 35840) = m;
        }
        __syncthreads();
        const unsigned causal = (tile == 31) ? 0xffffffffu : ((2u << tile) - 1u);
        const unsigned U = *(const unsigned*)(lds + 35840) & causal;
        float outv[32];
#pragma unroll
        for (int i = 0; i < 32; ++i) outv[i] = 0.f;
#pragma unroll 1
        for (int branch = 0; branch < 2; ++branch) {
            unsigned todo = (branch == 0) ? U : (causal & ~((1u << (tile >= 8 ? tile - 8 : 0)) - 1u));
            const bf16_t* kbase = proj + (size_t)b * NL * ODD_PAD + (branch == 0 ? 1536 : 1792) + g * 64 + (size_t)skey * ODD_PAD + 8 * spart;
            const bf16_t* vbase = vt + (size_t)(branch * 256 + g * 64 + skey) * NT + (size_t)b * NL + 8 * spart;
            float m_run = -1e30f, l_run = 0.f;
            f32x16 Oa[2];
#pragma unroll
            for (int i = 0; i < 16; ++i) { Oa[0][i] = 0.f; Oa[1][i] = 0.f; }
            int jcur = __ffs(todo) - 1; todo &= todo - 1;
            uint4 kreg = *(const uint4*)(kbase + (size_t)(64 * jcur) * ODD_PAD);
            uint4 vreg = *(const uint4*)(vbase + 64 * jcur);
            int buf = 0;
            __syncthreads();
            *(uint4*)(lds + skey * 144 + spart * 16) = kreg;
            *(uint2*)(lds + 18432 + skey * 136 + spart * 16) = make_uint2(vreg.x, vreg.y);
            *(uint2*)(lds + 18432 + skey * 136 + spart * 16 + 8) = make_uint2(vreg.z, vreg.w);
            __syncthreads();
            for (;;) {
                const int jnext = todo ? (__ffs(todo) - 1) : -1;
                todo &= todo - 1;
                if (jnext >= 0) { kreg = *(const uint4*)(kbase + (size_t)(64 * jnext) * ODD_PAD); vreg = *(const uint4*)(vbase + 64 * jnext); }
                const unsigned char* Ks = lds + buf * 9216;
                const unsigned char* Vs = lds + 18432 + buf * 8704;
                const bool mysel = (branch == 1) || ((mymask >> jcur) & 1u);
                if (__any(mysel)) {
                    const bool diag = (jcur == tile), wedge = (branch == 1) && (jcur == tile - 8);
                    const float init = mysel ? slope * (float)(64 * (jcur - tile)) : -1e30f;
                    float sv[32];
#pragma unroll
                    for (int kt = 0; kt < 2; ++kt) {
                        f32x16 acc;
                        const float i0 = init + slope * (float)(32 * kt);
#pragma unroll
                        for (int i = 0; i < 16; ++i) acc[i] = i0;
#pragma unroll
                        for (int ds = 0; ds < 4; ++ds) {
                            const bf16x8_t a = *(const bf16x8_t*)(Ks + (32 * kt + l31) * 144 + (16 * ds + 8 * h) * 2);
                            acc = MFMA32(a, Qf[ds], acc);
                        }
#pragma unroll
                        for (int reg = 0; reg < 16; ++reg) {
                            float sval = acc[reg] + sc[reg];
                            const int keyoff = 32 * kt + crow32(reg, h);
                            if (diag) sval = (keyoff <= tokoff) ? sval : -1e30f;
                            if (wedge) sval = (keyoff > tokoff) ? sval : -1e30f;
                            sv[kt * 16 + reg] = sval;
                        }
                    }
                    float mx = sv[0];
#pragma unroll
                    for (int i = 1; i < 32; ++i) mx = fmaxf(mx, sv[i]);
                    mx = fmaxf(mx, __shfl_xor(mx, 32));
                    const float m_new = fmaxf(m_run, mx), m_use = fmaxf(m_new, -1e29f);
                    const float alpha = __builtin_amdgcn_exp2f((m_run - m_use) * LOG2E);
                    const float moff = -m_use * LOG2E;
                    float psum = 0.f;
#pragma unroll
                    for (int i = 0; i < 32; ++i) { sv[i] = __builtin_amdgcn_exp2f(fmaf(sv[i], LOG2E, moff)); psum += sv[i]; }
                    l_run = l_run * alpha + psum; m_run = m_new;
#pragma unroll
                    for (int i = 0; i < 16; ++i) { Oa[0][i] *= alpha; Oa[1][i] *= alpha; }
                    bf16x8_t Pf[4];
#pragma unroll
                    for (int ks = 0; ks < 4; ++ks) {
                        u32x4 w; w.x = cvtpk(sv[ks * 8 + 0], sv[ks * 8 + 1]); w.y = cvtpk(sv[ks * 8 + 2], sv[ks * 8 + 3]); w.z = cvtpk(sv[ks * 8 + 4], sv[ks * 8 + 5]); w.w = cvtpk(sv[ks * 8 + 6], sv[ks * 8 + 7]);
                        Pf[ks] = __builtin_bit_cast(bf16x8_t, w);
                    }
#pragma unroll
                    for (int mt = 0; mt < 2; ++mt)
#pragma unroll
                        for (int ks = 0; ks < 4; ++ks) {
                            const unsigned char* vp = Vs + (32 * mt + l31) * 136 + (16 * ks + 4 * h) * 2;
                            const uint2 lo = *(const uint2*)vp, hi = *(const uint2*)(vp + 16);
                            u32x4 w; w.x = lo.x; w.y = lo.y; w.z = hi.x; w.w = hi.y;
                            Oa[mt] = MFMA32(__builtin_bit_cast(bf16x8_t, w), Pf[ks], Oa[mt]);
                        }
                }
                if (jnext < 0) break;
                *(uint4*)(lds + (buf ^ 1) * 9216 + skey * 144 + spart * 16) = kreg;
                *(uint2*)(lds + 18432 + (buf ^ 1) * 8704 + skey * 136 + spart * 16) = make_uint2(vreg.x, vreg.y);
                *(uint2*)(lds + 18432 + (buf ^ 1) * 8704 + skey * 136 + spart * 16 + 8) = make_uint2(vreg.z, vreg.w);
                __syncthreads();
                buf ^= 1; jcur = jnext;
            }
            const float l_tot = l_run + __shfl_xor(l_run, 32);
            const float gt = sigmoidf_(bf2f(proj[trow * ODD_PAD + 2048 + (branch + 1) * 16 + hd]));
            const float f = gt / fmaxf(l_tot, 1e-30f);
#pragma unroll
            for (int i = 0; i < 16; ++i) { outv[i] += f * Oa[0][i]; outv[16 + i] += f * Oa[1][i]; }
        }
        bf16_t* orow = O + trow * ND + hd * 64;
#pragma unroll
        for (int mt = 0; mt < 2; ++mt)
#pragma unroll
            for (int q4 = 0; q4 < 4; ++q4) {
                bf16_t* op = orow + 32 * mt + 8 * q4 + 4 * h;
                const uint2 old = *(const uint2*)op;
                const float o0 = __uint_as_float(old.x << 16) + outv[mt * 16 + q4 * 4 + 0], o1 = __uint_as_float(old.x & 0xffff0000u) + outv[mt * 16 + q4 * 4 + 1];
                const float o2 = __uint_as_float(old.y << 16) + outv[mt * 16 + q4 * 4 + 2], o3 = __uint_as_float(old.y & 0xffff0000u) + outv[mt * 16 + q4 * 4 + 3];
                *(uint2*)op = make_uint2(cvtpk(o0, o1), cvtpk(o2, o3));
            }
    }
    __syncthreads();
}


__device__ __forceinline__ void nsa_compress2_phase(const bf16_t* __restrict__ proj, const bf16_t* __restrict__ w1t  , const bf16_t* __restrict__ w2t  ,
                                                    const float* __restrict__ bias1  , bf16_t* __restrict__ kcmp  , bf16_t* __restrict__ vcmpT  ,
                                                    unsigned char* lds) {
    const int tid = tidx(), wave = __builtin_amdgcn_readfirstlane(tid >> 6), lane = tid & 63, fr = lane & 15, fq = lane >> 4;
    unsigned char* xs = lds;
    unsigned char* hs = lds + 34816;
    for (int it = blockIdx.x; it < 1024; it += gridDim.x) {
        const int which = it >> 9, ntile = it & 7, g = (it >> 3) & 3, b = (it >> 5) & 15;
        const int t0 = 256 * ntile, coloff = (which ? 1280 : 1024) + g * 64;
        __syncthreads();
        for (int pc = tid; pc < 272 * 8; pc += NTHR) {
            const int tk = pc >> 3, c = pc & 7;
            int tsrc = t0 + tk; tsrc = tsrc > NL - 1 ? NL - 1 : tsrc;
            *(uint4*)(xs + tk * 128 + ((c ^ ((tk >> 4) & 7)) << 4)) = *(const uint4*)(proj + (size_t)(b * NL + tsrc) * ODD_PAD + coloff + 8 * c);
        }
        __syncthreads();
        f32x4 acc = {0.f, 0.f, 0.f, 0.f};
        const bf16_t* wrow = w1t + ((size_t)which * 128 + 16 * wave + fr) * 2048 + 8 * fq;
#pragma unroll 8
        for (int ks = 0; ks < 64; ++ks) {
            const int l = ks >> 1, tk = 16 * fr + l, c = 4 * (ks & 1) + fq;
            const bf16x8_t a = *(const bf16x8_t*)(xs + tk * 128 + ((c ^ ((tk >> 4) & 7)) << 4));
            const bf16x8_t bfrag = *(const bf16x8_t*)(wrow + 32 * ks);
            acc = __builtin_amdgcn_mfma_f32_16x16x32_bf16(a, bfrag, acc, 0, 0, 0);
        }
        {
            const float bj = bias1[which * 128 + 16 * wave + fr];
#pragma unroll
            for (int reg = 0; reg < 4; ++reg) *(bf16_t*)(hs + (4 * fq + reg) * 272 + (16 * wave + fr) * 2) = f2bf(gelu_fast(acc[reg] + bj));
        }
        __syncthreads();
        if (wave < 4) {
            f32x4 o = {0.f, 0.f, 0.f, 0.f};
#pragma unroll
            for (int ks = 0; ks < 4; ++ks) {
                const bf16x8_t a = *(const bf16x8_t*)(hs + fr * 272 + (32 * ks + 8 * fq) * 2);
                const bf16x8_t bfrag = *(const bf16x8_t*)(w2t + ((size_t)which * 64 + 16 * wave + fr) * 128 + 32 * ks + 8 * fq);
                o = __builtin_amdgcn_mfma_f32_16x16x32_bf16(a, bfrag, o, 0, 0, 0);
            }
            const int c = 16 * wave + fr;
#pragma unroll
            for (int reg = 0; reg < 4; ++reg) {
                const int n = 16 * ntile + 4 * fq + reg;
                const bf16_t val = (n < 127) ? f2bf(o[reg]) : (bf16_t)0;
                if (which == 0) kcmp[((size_t)(b * 4 + g) * 128 + n) * 64 + c] = val;
                else vcmpT[((size_t)(b * 4 + g) * 64 + c) * 128 + n] = val;
            }
        }
    }
    __syncthreads();
}

__device__ __forceinline__ void nsa_cmp2_phase(const bf16_t* __restrict__ proj, const bf16_t* __restrict__ kcmp, const bf16_t* __restrict__ vcmpT,
                                               bf16_t* __restrict__ O, unsigned* __restrict__ selmask, unsigned char* lds) {
    const int tid = tidx(), wave = __builtin_amdgcn_readfirstlane(tid >> 6), lane = tid & 63, l31 = lane & 31, h = lane >> 5;
    const int r = wave & 3, thalf = wave >> 2;
    unsigned char* Kc = lds;
    unsigned char* Vc = lds + 18432;
    float* impS = (float*)(lds + 35328);
    float* invS = (float*)(lds + 35328 + 32768);
    for (int it = blockIdx.x; it < 32 * 64; it += gridDim.x) {
        const int tile = 31 - (it >> 6), bg = it & 63, g = bg & 3, b = bg >> 2;
        const int hd = g * 4 + r, tokoff = thalf * 32 + l31, tok = tile * 64 + tokoff;
        const size_t trow = (size_t)(b * NL + tok);
        const float slope = exp2f(-0.5f * (float)(hd + 1));
        __syncthreads();
#pragma unroll
        for (int i = 0; i < 2; ++i) {
            const int pc = tid + 512 * i;
            { const int row = pc >> 3, c = pc & 7; *(uint4*)(Kc + row * 144 + c * 16) = *(const uint4*)(kcmp + ((size_t)(b * 4 + g) * 128 + row) * 64 + 8 * c); }
            { const int row = pc >> 4, c = pc & 15; const uint4 v = *(const uint4*)(vcmpT + ((size_t)(b * 4 + g) * 64 + row) * 128 + 8 * c);
              *(uint2*)(Vc + row * 264 + c * 16) = make_uint2(v.x, v.y); *(uint2*)(Vc + row * 264 + c * 16 + 8) = make_uint2(v.z, v.w); }
        }
        bf16x8_t Qf[4];
#pragma unroll
        for (int ds = 0; ds < 4; ++ds) {
            float q[8];
            ld8(proj + trow * ODD_PAD + hd * 64 + 16 * ds + 8 * h, q);
            u32x4 w; w.x = cvtpk(q[0] * 0.125f, q[1] * 0.125f); w.y = cvtpk(q[2] * 0.125f, q[3] * 0.125f); w.z = cvtpk(q[4] * 0.125f, q[5] * 0.125f); w.w = cvtpk(q[6] * 0.125f, q[7] * 0.125f);
            Qf[ds] = __builtin_bit_cast(bf16x8_t, w);
        }
        int nvalid = (tok >= 31) ? ((tok - 31) / 16 + 1) : 0;
        nvalid = nvalid > 127 ? 127 : nvalid;
        __syncthreads();
        float mx = -1e30f;
#pragma unroll 1
        for (int kt = 0; kt < 4; ++kt) {
            f32x16 acc;
            const float i0 = slope * (float)(512 * kt);
#pragma unroll
            for (int i = 0; i < 16; ++i) acc[i] = i0;
#pragma unroll
            for (int ds = 0; ds < 4; ++ds) {
                const bf16x8_t a = *(const bf16x8_t*)(Kc + (32 * kt + l31) * 144 + (16 * ds + 8 * h) * 2);
                acc = MFMA32(a, Qf[ds], acc);
            }
#pragma unroll
            for (int reg = 0; reg < 16; ++reg) {
                const int n = 32 * kt + crow32(reg, h);
                const float sval = acc[reg] + slope * (float)(16 * crow32(reg, h));
                mx = fmaxf(mx, (n < nvalid) ? sval : -1e30f);
            }
        }
        mx = fmaxf(mx, __shfl_xor(mx, 32));
        const float moff = -fmaxf(mx, -1e29f) * LOG2E;
        float psum = 0.f, prev_pe = 0.f;
        f32x16 Oa[2];
#pragma unroll
        for (int i = 0; i < 16; ++i) { Oa[0][i] = 0.f; Oa[1][i] = 0.f; }
#pragma unroll 1
        for (int kt = 0; kt < 4; ++kt) {
            f32x16 acc;
            const float i0 = slope * (float)(512 * kt);
#pragma unroll
            for (int i = 0; i < 16; ++i) acc[i] = i0;
#pragma unroll
            for (int ds = 0; ds < 4; ++ds) {
                const bf16x8_t a = *(const bf16x8_t*)(Kc + (32 * kt + l31) * 144 + (16 * ds + 8 * h) * 2);
                acc = MFMA32(a, Qf[ds], acc);
            }
            float sv[16];
#pragma unroll
            for (int reg = 0; reg < 16; ++reg) {
                const int n = 32 * kt + crow32(reg, h);
                const float sval = acc[reg] + slope * (float)(16 * crow32(reg, h));
                sv[reg] = __builtin_amdgcn_exp2f(fmaf((n < nvalid) ? sval : -1e30f, LOG2E, moff));
                psum += sv[reg];
            }
#pragma unroll
            for (int q = 0; q < 4; ++q) {
                const float e = 0.5f * sv[q * 4 + 3];
                const float own = sv[q * 4] + sv[q * 4 + 1] + sv[q * 4 + 2] + e;
                const float pe = __shfl_xor(e, 32);
                impS[(r * 64 + tokoff) * 32 + 8 * kt + 2 * q + h] = own + (h ? pe : prev_pe);
                prev_pe = pe;
            }
#pragma unroll
            for (int s2 = 0; s2 < 2; ++s2) {
                u32x4 w; w.x = cvtpk(sv[s2 * 8 + 0], sv[s2 * 8 + 1]); w.y = cvtpk(sv[s2 * 8 + 2], sv[s2 * 8 + 3]); w.z = cvtpk(sv[s2 * 8 + 4], sv[s2 * 8 + 5]); w.w = cvtpk(sv[s2 * 8 + 6], sv[s2 * 8 + 7]);
                const bf16x8_t pf = __builtin_bit_cast(bf16x8_t, w);
#pragma unroll
                for (int mt = 0; mt < 2; ++mt) {
                    const unsigned char* vp = Vc + (32 * mt + l31) * 264 + (32 * kt + 16 * s2 + 4 * h) * 2;
                    const uint2 lo = *(const uint2*)vp, hi = *(const uint2*)(vp + 16);
                    u32x4 a; a.x = lo.x; a.y = lo.y; a.z = hi.x; a.w = hi.y;
                    Oa[mt] = MFMA32(__builtin_bit_cast(bf16x8_t, a), pf, Oa[mt]);
                }
            }
        }
        psum += __shfl_xor(psum, 32);
        const float inv = (nvalid > 0) ? 1.f / fmaxf(psum, 1e-30f) : 0.f;
        if (h == 0) invS[r * 64 + tokoff] = inv;
        const float g0 = sigmoidf_(bf2f(proj[trow * ODD_PAD + 2048 + hd])) * inv;
        bf16_t* orow = O + trow * ND + hd * 64;
#pragma unroll
        for (int mt = 0; mt < 2; ++mt)
#pragma unroll
            for (int q4 = 0; q4 < 4; ++q4)
                *(uint2*)(orow + 32 * mt + 8 * q4 + 4 * h) = make_uint2(cvtpk(g0 * Oa[mt][q4 * 4], g0 * Oa[mt][q4 * 4 + 1]), cvtpk(g0 * Oa[mt][q4 * 4 + 2], g0 * Oa[mt][q4 * 4 + 3]));
        __syncthreads();
        float* impT = (float*)Kc;
#pragma unroll
        for (int i = 0; i < 4; ++i) {
            const int pc = tid + 512 * i, tk = pc >> 5, j = pc & 31, cur = tile;
            const float ij = impS[(0 * 64 + tk) * 32 + j] * invS[tk] + impS[(1 * 64 + tk) * 32 + j] * invS[64 + tk] + impS[(2 * 64 + tk) * 32 + j] * invS[128 + tk] + impS[(3 * 64 + tk) * 32 + j] * invS[192 + tk];
            const bool fj = (j == 0) || (j == cur) || (j == cur - 1);
            impT[tk * 33 + j] = (j <= cur) ? ij + (fj ? 1000.f : 0.f) : -INFINITY;
        }
        __syncthreads();
        if (tid < 256) {
            const int tk = tid >> 2, rr = tid & 3;
            unsigned bits = 0;
#pragma unroll 1
            for (int jj = 0; jj < 8; ++jj) {
                const int j = rr * 8 + jj;
                const float vj = impT[tk * 33 + j];
                int rank = 0;
#pragma unroll 8
                for (int k = 0; k < 32; ++k) {
                    const float vk = impT[tk * 33 + k];
                    rank += (vk > vj || (vk == vj && k < j)) ? 1 : 0;
                }
                if (rank < 16) bits |= 1u << j;
            }
            bits |= __shfl_xor(bits, 1);
            bits |= __shfl_xor(bits, 2);
            if (rr == 0) selmask[(size_t)(b * 4 + g) * NL + tile * 64 + tk] = bits;
        }
    }
    __syncthreads();
}


constexpr int P0W = 1792;
constexpr float LN2F = 0.6931471805599453f;
__device__ __forceinline__ void sb_attn2_phase(const bf16_t* __restrict__ proj, const bf16_t* __restrict__ vt, bf16_t* __restrict__ Y, unsigned char* lds) {
    const int tid = tidx(), wave = __builtin_amdgcn_readfirstlane(tid >> 6), lane = tid & 63, l31 = lane & 31, h = lane >> 5;
    const int skey = tid >> 3, spart = tid & 7;
    for (int it = blockIdx.x; it < NB * 12 * 8; it += gridDim.x) {
        const int tile = 7 - (it / 192), bh = it % 192, hh = bh % 12, b = bh / 12;
        const int qlo = tile * 256 + 32 * wave, tq = qlo + l31;
        const size_t trow = (size_t)(b * NL + tq);
        bf16x8_t Qf[4];
#pragma unroll
        for (int ds = 0; ds < 4; ++ds) {
            float q[8];
            ld8(proj + trow * P0W + 256 + hh * 64 + 16 * ds + 8 * h, q);
            u32x4 w; w.x = cvtpk(q[0] * 0.125f, q[1] * 0.125f); w.y = cvtpk(q[2] * 0.125f, q[3] * 0.125f); w.z = cvtpk(q[4] * 0.125f, q[5] * 0.125f); w.w = cvtpk(q[6] * 0.125f, q[7] * 0.125f);
            Qf[ds] = __builtin_bit_cast(bf16x8_t, w);
        }
        const bf16_t* kbase = proj + (size_t)b * NL * P0W + 1024 + hh * 64 + (size_t)skey * P0W + 8 * spart;
        const bf16_t* vbase = vt + (size_t)(hh * 64 + skey) * NT + (size_t)b * NL + 8 * spart;
        f32x16 Oa[2];
#pragma unroll
        for (int i = 0; i < 16; ++i) { Oa[0][i] = 0.f; Oa[1][i] = 0.f; }
        float carry = 0.f;
        int j = tile * 4 + 3, buf = 0;
        uint4 kreg = *(const uint4*)(kbase + (size_t)(64 * j) * P0W);
        uint4 vreg = *(const uint4*)(vbase + 64 * j);
        __syncthreads();
        *(uint4*)(lds + skey * 144 + spart * 16) = kreg;
        *(uint2*)(lds + 18432 + skey * 136 + spart * 16) = make_uint2(vreg.x, vreg.y);
        *(uint2*)(lds + 18432 + skey * 136 + spart * 16 + 8) = make_uint2(vreg.z, vreg.w);
        __syncthreads();
        for (;;) {
            const int jn = j - 1;
            if (jn >= 0) { kreg = *(const uint4*)(kbase + (size_t)(64 * jn) * P0W); vreg = *(const uint4*)(vbase + 64 * jn); }
            const unsigned char* Ks = lds + buf * 9216;
            const unsigned char* Vs = lds + 18432 + buf * 8704;
            const bool live = (64 * j <= qlo + 30) && !__all(carry < -110.f);
            if (live) {
#pragma unroll
                for (int kti = 0; kti < 2; ++kti) {
                    const int kt = 1 - kti;
                    f32x16 acc;
#pragma unroll
                    for (int i = 0; i < 16; ++i) acc[i] = 0.f;
#pragma unroll
                    for (int ds = 0; ds < 4; ++ds) {
                        const bf16x8_t a = *(const bf16x8_t*)(Ks + (32 * kt + l31) * 144 + (16 * ds + 8 * h) * 2);
                        acc = MFMA32(a, Qf[ds], acc);
                    }
                    float m1[16], lz[16];
#pragma unroll
                    for (int reg = 0; reg < 16; ++reg) {
                        const float z = acc[reg];
                        const bool valid = (64 * j + 32 * kt + crow32(reg, h)) < tq;
                        const float e = __builtin_amdgcn_exp2f(-fabsf(z) * LOG2E);
                        const float sp = fmaxf(z, 0.f) + __builtin_amdgcn_logf(1.f + e) * LN2F;
                        m1[reg] = valid ? -sp : 0.f;
                        lz[reg] = valid ? z - sp : -1e30f;
                    }
                    float G[4], T[4];
#pragma unroll
                    for (int q = 0; q < 4; ++q) G[q] = (m1[4 * q] + m1[4 * q + 1]) + (m1[4 * q + 2] + m1[4 * q + 3]);
                    float Gp[4];
#pragma unroll
                    for (int q = 0; q < 4; ++q) { Gp[q] = __shfl_xor(G[q], 32); T[q] = G[q] + Gp[q]; }
                    float base[4];
                    base[3] = carry; base[2] = base[3] + T[3]; base[1] = base[2] + T[2]; base[0] = base[1] + T[1];
                    const float tot = base[0] + T[0];
#pragma unroll
                    for (int q = 0; q < 4; ++q) {
                        const float bq = base[q] + (h ? 0.f : Gp[q]);
                        const float t3 = bq, t2 = t3 + m1[4 * q + 3], t1 = t2 + m1[4 * q + 2], t0 = t1 + m1[4 * q + 1];
                        lz[4 * q + 3] = __builtin_amdgcn_exp2f((lz[4 * q + 3] + t3) * LOG2E);
                        lz[4 * q + 2] = __builtin_amdgcn_exp2f((lz[4 * q + 2] + t2) * LOG2E);
                        lz[4 * q + 1] = __builtin_amdgcn_exp2f((lz[4 * q + 1] + t1) * LOG2E);
                        lz[4 * q + 0] = __builtin_amdgcn_exp2f((lz[4 * q + 0] + t0) * LOG2E);
                    }
                    carry = tot;
#pragma unroll
                    for (int s2 = 0; s2 < 2; ++s2) {
                        u32x4 w; w.x = cvtpk(lz[s2 * 8 + 0], lz[s2 * 8 + 1]); w.y = cvtpk(lz[s2 * 8 + 2], lz[s2 * 8 + 3]); w.z = cvtpk(lz[s2 * 8 + 4], lz[s2 * 8 + 5]); w.w = cvtpk(lz[s2 * 8 + 6], lz[s2 * 8 + 7]);
                        const bf16x8_t pf = __builtin_bit_cast(bf16x8_t, w);
#pragma unroll
                        for (int mt = 0; mt < 2; ++mt) {
                            const unsigned char* vp = Vs + (32 * mt + l31) * 136 + (32 * kt + 16 * s2 + 4 * h) * 2;
                            const uint2 lo = *(const uint2*)vp, hi = *(const uint2*)(vp + 16);
                            u32x4 a; a.x = lo.x; a.y = lo.y; a.z = hi.x; a.w = hi.y;
                            Oa[mt] = MFMA32(__builtin_bit_cast(bf16x8_t, a), pf, Oa[mt]);
                        }
                    }
                }
            }
            if (jn >= 0) {
                *(uint4*)(lds + (buf ^ 1) * 9216 + skey * 144 + spart * 16) = kreg;
                *(uint2*)(lds + 18432 + (buf ^ 1) * 8704 + skey * 136 + spart * 16) = make_uint2(vreg.x, vreg.y);
                *(uint2*)(lds + 18432 + (buf ^ 1) * 8704 + skey * 136 + spart * 16 + 8) = make_uint2(vreg.z, vreg.w);
            }
            volatile int* flg = (volatile int*)(lds + 35840) + (j & 1) * 8;
            const int wdone = __all(carry < -110.f);
            if (lane == 0) flg[wave] = wdone;
            __syncthreads();
            const int alldone = flg[0] & flg[1] & flg[2] & flg[3] & flg[4] & flg[5] & flg[6] & flg[7];
            if (alldone || jn < 0) break;
            buf ^= 1; j = jn;
        }
        bf16_t* orow = Y + trow * ND + 256 + hh * 64;
#pragma unroll
        for (int mt = 0; mt < 2; ++mt)
#pragma unroll
            for (int q4 = 0; q4 < 4; ++q4)
                *(uint2*)(orow + 32 * mt + 8 * q4 + 4 * h) = make_uint2(cvtpk(Oa[mt][q4 * 4], Oa[mt][q4 * 4 + 1]), cvtpk(Oa[mt][q4 * 4 + 2], Oa[mt][q4 * 4 + 3]));
    }
    __syncthreads();
}

__device__ __forceinline__ void s5_scan2_phase(const bf16_t* __restrict__ proj, const float* __restrict__ lam_re, const float* __restrict__ lam_im, const float* __restrict__ log_dt,
                                               const float* __restrict__ b_re, const float* __restrict__ b_im, const float* __restrict__ c_re, const float* __restrict__ c_im,
                                               const float* __restrict__ dskip, bf16_t* __restrict__ ya, float* lds) {
    const int tid = tidx(), wave = __builtin_amdgcn_readfirstlane(tid >> 6), lane = tid & 63;
    float* cr = lds;
    float* ci = lds + 1024;
    float* Es = lds + 2048;
    float* us = lds + 3072 + wave * 512;
    float* xr = lds + 7168 + wave * 4160;
    float* xi = xr + 2080;
    for (int bg = blockIdx.x; bg < NB * 16; bg += gridDim.x) {
        const int b = bg >> 4, g = bg & 15;
        const float lr = lam_re[g * 64 + lane], li = lam_im[g * 64 + lane];
        const float dt = expf(log_dt[g]);
        const float mag = expf(lr * dt);
        const float are = mag * cosf(li * dt), aim = mag * sinf(li * dt);
        const float nr = are - 1.f, den = lr * lr + li * li;
        const float fre = (nr * lr + aim * li) / den, fim = (aim * lr - nr * li) / den;
        float bbr[16], bbi[16];
#pragma unroll
        for (int i = 0; i < 16; ++i) {
            const float br = b_re[(g * 64 + lane) * 16 + i], bi = b_im[(g * 64 + lane) * 16 + i];
            bbr[i] = fre * br - fim * bi; bbi[i] = fre * bi + fim * br;
        }
        __syncthreads();
        for (int idx = tid; idx < 1024; idx += NTHR) { cr[idx] = c_re[g * 1024 + idx]; ci[idx] = c_im[g * 1024 + idx]; }
        const bf16_t* ub = proj + (size_t)(b * NL + 256 * wave) * P0W + g * 16;
        float xre = 0.f, xim = 0.f;
        for (int c0 = 0; c0 < 256; c0 += 32) {
            wave_lds_fence();
            { float u8[8]; const int t = lane >> 1, hf = lane & 1; ld8(ub + (size_t)(c0 + t) * P0W + 8 * hf, u8);
#pragma unroll
              for (int i = 0; i < 8; ++i) us[t * 16 + 8 * hf + i] = u8[i]; }
            wave_lds_fence();
            for (int t = 0; t < 32; ++t) {
                float bur = 0.f, bui = 0.f;
#pragma unroll
                for (int i = 0; i < 16; ++i) { const float u = us[t * 16 + i]; bur += bbr[i] * u; bui += bbi[i] * u; }
                const float nre = are * xre - aim * xim + bur, nim = are * xim + aim * xre + bui;
                xre = nre; xim = nim;
            }
        }
        Es[(wave * 64 + lane) * 2] = xre; Es[(wave * 64 + lane) * 2 + 1] = xim;
        float pr = are, pi = aim;
#pragma unroll
        for (int i = 0; i < 8; ++i) { const float nr2 = pr * pr - pi * pi, ni2 = 2.f * pr * pi; pr = nr2; pi = ni2; }
        __syncthreads();
        xre = 0.f; xim = 0.f;
        for (int w2 = 0; w2 < wave; ++w2) {
            const float er = Es[(w2 * 64 + lane) * 2], ei = Es[(w2 * 64 + lane) * 2 + 1];
            const float nre = pr * xre - pi * xim + er, nim = pr * xim + pi * xre + ei;
            xre = nre; xim = nim;
        }
        const int tt = lane & 31, ih = lane >> 5;
        float dsk[8];
#pragma unroll
        for (int i = 0; i < 8; ++i) dsk[i] = dskip[g * 16 + 8 * ih + i];
        for (int c0 = 0; c0 < 256; c0 += 32) {
            wave_lds_fence();
            { float u8[8]; const int t = lane >> 1, hf = lane & 1; ld8(ub + (size_t)(c0 + t) * P0W + 8 * hf, u8);
#pragma unroll
              for (int i = 0; i < 8; ++i) us[t * 16 + 8 * hf + i] = u8[i]; }
            wave_lds_fence();
            for (int t = 0; t < 32; ++t) {
                float bur = 0.f, bui = 0.f;
#pragma unroll
                for (int i = 0; i < 16; ++i) { const float u = us[t * 16 + i]; bur += bbr[i] * u; bui += bbi[i] * u; }
                const float nre = are * xre - aim * xim + bur, nim = are * xim + aim * xre + bui;
                xre = nre; xim = nim;
                xr[t * 65 + lane] = xre; xi[t * 65 + lane] = xim;
            }
            wave_lds_fence();
            float y[8];
#pragma unroll
            for (int i = 0; i < 8; ++i) y[i] = 0.f;
            for (int p = 0; p < 64; ++p) {
                const float a = xr[tt * 65 + p], bq = xi[tt * 65 + p];
#pragma unroll
                for (int i = 0; i < 8; ++i) y[i] += cr[(8 * ih + i) * 64 + p] * a - ci[(8 * ih + i) * 64 + p] * bq;
            }
            float o[8];
#pragma unroll
            for (int i = 0; i < 8; ++i) o[i] = gelu_fast(y[i] + dsk[i] * us[tt * 16 + 8 * ih + i]);
            st8(ya + (size_t)(b * NL + 256 * wave + c0 + tt) * 256 + g * 16 + 8 * ih, o);
        }
    }
    __syncthreads();
}


__device__ __forceinline__ void glu2_phase(const bf16_t* __restrict__ ya, const bf16_t* __restrict__ wgt, const float* __restrict__ bglu, bf16_t* __restrict__ Y, unsigned char* lds) {
    const int tid = tidx(), wave = __builtin_amdgcn_readfirstlane(tid >> 6), lane = tid & 63, fr = lane & 15, fq = lane >> 4;
    __syncthreads();
    for (int pc = tid; pc < 256 * 32; pc += NTHR) { const int row = pc >> 5, c = pc & 31; *(uint4*)(lds + row * 528 + c * 16) = *(const uint4*)(wgt + row * 256 + c * 8); }
    __syncthreads();
    for (int chunk = blockIdx.x; chunk < NT / 128; chunk += gridDim.x) {
        const size_t tok = (size_t)chunk * 128 + wave * 16 + fr;
        bf16x8_t yb[8];
#pragma unroll
        for (int ks = 0; ks < 8; ++ks) yb[ks] = *(const bf16x8_t*)(ya + tok * 256 + 32 * ks + 8 * fq);
#pragma unroll 2
        for (int nt = 0; nt < 16; ++nt) {
            f32x4 acc = {0.f, 0.f, 0.f, 0.f};
#pragma unroll
            for (int ks = 0; ks < 8; ++ks) {
                const bf16x8_t a = *(const bf16x8_t*)(lds + (16 * nt + fr) * 528 + (32 * ks + 8 * fq) * 2);
                acc = __builtin_amdgcn_mfma_f32_16x16x32_bf16(a, yb[ks], acc, 0, 0, 0);
            }
            const int n0 = 16 * nt + 4 * fq;
            const uint2 yv = *(const uint2*)(ya + tok * 256 + n0);
            const float4 bb = *(const float4*)(bglu + n0);
            const float o0 = __uint_as_float(yv.x << 16) * sigmoidf_(acc[0] + bb.x), o1 = __uint_as_float(yv.x & 0xffff0000u) * sigmoidf_(acc[1] + bb.y);
            const float o2 = __uint_as_float(yv.y << 16) * sigmoidf_(acc[2] + bb.z), o3 = __uint_as_float(yv.y & 0xffff0000u) * sigmoidf_(acc[3] + bb.w);
            *(uint2*)(Y + tok * ND + n0) = make_uint2(cvtpk(o0, o1), cvtpk(o2, o3));
        }
    }
    __syncthreads();
}


__device__ __forceinline__ void cmadd(float& re, float& im, float ar, float ai, float br, float bi) {
    const float nr = fmaf(ar, re, fmaf(-ai, im, br)), ni = fmaf(ar, im, fmaf(ai, re, bi));
    re = nr; im = ni;
}
__device__ __forceinline__ void s5_scan3_phase(const bf16_t* __restrict__ proj, const float* __restrict__ lam_re, const float* __restrict__ lam_im, const float* __restrict__ log_dt,
                                               const float* __restrict__ b_re, const float* __restrict__ b_im, const float* __restrict__ c_re, const float* __restrict__ c_im,
                                               const float* __restrict__ dskip, bf16_t* __restrict__ ya, unsigned char* lds) {
    const int tid = tidx(), wave = __builtin_amdgcn_readfirstlane(tid >> 6), lane = tid & 63, l31 = lane & 31, h = lane >> 5, fr = lane & 15, fq = lane >> 4;
    unsigned char* Xs = lds + wave * 10752;
    float* Es = (float*)(lds + 86016);
    __syncthreads();
    for (int i = lane; i < 32 * 21; i += 64) *(uint4*)(Xs + i * 16) = make_uint4(0u, 0u, 0u, 0u);
    for (int bg = blockIdx.x; bg < NB * 16; bg += gridDim.x) {
        const int b = bg >> 4, g = bg & 15;
        const float dt = expf(log_dt[g]);
        float are[2], aim[2]; bf16x8_t Bre[2], Bim[2];
#pragma unroll
        for (int k = 0; k < 2; ++k) {
            const int p = 32 * k + l31;
            const float lr = lam_re[g * 64 + p], li = lam_im[g * 64 + p];
            const float mag = expf(lr * dt);
            are[k] = mag * cosf(li * dt); aim[k] = mag * sinf(li * dt);
            const float nr = are[k] - 1.f, den = lr * lr + li * li;
            const float fre = (nr * lr + aim[k] * li) / den, fim = (aim[k] * lr - nr * li) / den;
            float vr[8], vi[8];
#pragma unroll
            for (int j = 0; j < 8; ++j) {
                const float br = b_re[(g * 64 + p) * 16 + 8 * h + j], bi = b_im[(g * 64 + p) * 16 + 8 * h + j];
                vr[j] = fre * br - fim * bi; vi[j] = fre * bi + fim * br;
            }
            u32x4 w; w.x = cvtpk(vr[0], vr[1]); w.y = cvtpk(vr[2], vr[3]); w.z = cvtpk(vr[4], vr[5]); w.w = cvtpk(vr[6], vr[7]); Bre[k] = __builtin_bit_cast(bf16x8_t, w);
            w.x = cvtpk(vi[0], vi[1]); w.y = cvtpk(vi[2], vi[3]); w.z = cvtpk(vi[4], vi[5]); w.w = cvtpk(vi[6], vi[7]); Bim[k] = __builtin_bit_cast(bf16x8_t, w);
        }
        bf16x8_t Cm[5];
        {
            const float di = dskip[g * 16 + fr];
#pragma unroll
            for (int ks = 0; ks < 5; ++ks) {
                float cv[8];
#pragma unroll
                for (int j = 0; j < 8; ++j) {
                    const int kk = 32 * ks + 8 * fq + j;
                    cv[j] = kk < 64 ? c_re[(g * 16 + fr) * 64 + kk] : (kk < 128 ? -c_im[(g * 16 + fr) * 64 + kk - 64] : ((kk - 128) == fr ? di : 0.f));
                }
                u32x4 w; w.x = cvtpk(cv[0], cv[1]); w.y = cvtpk(cv[2], cv[3]); w.z = cvtpk(cv[4], cv[5]); w.w = cvtpk(cv[6], cv[7]); Cm[ks] = __builtin_bit_cast(bf16x8_t, w);
            }
        }
        float a4r[2], a4i[2], a5r[2], a5i[2], a32r[2], a32i[2], a256r[2], a256i[2];
#pragma unroll
        for (int k = 0; k < 2; ++k) {
            float pr = are[k], pi = aim[k], t;
            t = pr * pr - pi * pi; pi = 2.f * pr * pi; pr = t;
            t = pr * pr - pi * pi; pi = 2.f * pr * pi; pr = t;
            a4r[k] = pr; a4i[k] = pi;
            a5r[k] = pr * are[k] - pi * aim[k]; a5i[k] = pr * aim[k] + pi * are[k];
#pragma unroll
            for (int i = 0; i < 3; ++i) { t = pr * pr - pi * pi; pi = 2.f * pr * pi; pr = t; }
            a32r[k] = pr; a32i[k] = pi;
#pragma unroll
            for (int i = 0; i < 3; ++i) { t = pr * pr - pi * pi; pi = 2.f * pr * pi; pr = t; }
            a256r[k] = pr; a256i[k] = pi;
        }
        const bf16_t* ub = proj + (size_t)(b * NL + 256 * wave) * P0W + g * 16 + 8 * h;
        float sre[2] = {0.f, 0.f}, sim[2] = {0.f, 0.f};
#pragma unroll 1
        for (int c0 = 0; c0 < 256; c0 += 32) {
            const bf16x8_t uf = *(const bf16x8_t*)(ub + (size_t)(c0 + l31) * P0W);
#pragma unroll
            for (int k = 0; k < 2; ++k) {
                f32x16 z;
#pragma unroll
                for (int i = 0; i < 16; ++i) z[i] = 0.f;
                const f32x16 bur = MFMA32(uf, Bre[k], z), bui = MFMA32(uf, Bim[k], z);
                float er = 0.f, ei = 0.f;
#pragma unroll
                for (int reg = 0; reg < 16; ++reg) {
                    if (reg == 0) { er = bur[0]; ei = bui[0]; }
                    else if ((reg & 3) == 0) cmadd(er, ei, a5r[k], a5i[k], bur[reg], bui[reg]);
                    else cmadd(er, ei, are[k], aim[k], bur[reg], bui[reg]);
                }
                { float tr = er, ti = ei; cmadd(tr, ti, a4r[k], a4i[k], 0.f, 0.f); er = h ? er : tr; ei = h ? ei : ti; }
                er += __shfl_xor(er, 32); ei += __shfl_xor(ei, 32);
                cmadd(sre[k], sim[k], a32r[k], a32i[k], er, ei);
            }
        }
        __syncthreads();
        if (h == 0) {
#pragma unroll
            for (int k = 0; k < 2; ++k) { Es[(wave * 64 + 32 * k + l31) * 2] = sre[k]; Es[(wave * 64 + 32 * k + l31) * 2 + 1] = sim[k]; }
        }
        __syncthreads();
        float xre[2] = {0.f, 0.f}, xim[2] = {0.f, 0.f};
        for (int w2 = 0; w2 < wave; ++w2) {
#pragma unroll
            for (int k = 0; k < 2; ++k) cmadd(xre[k], xim[k], a256r[k], a256i[k], Es[(w2 * 64 + 32 * k + l31) * 2], Es[(w2 * 64 + 32 * k + l31) * 2 + 1]);
        }
#pragma unroll 1
        for (int c0 = 0; c0 < 256; c0 += 32) {
            const bf16x8_t uf = *(const bf16x8_t*)(ub + (size_t)(c0 + l31) * P0W);
            wave_lds_fence();
            *(bf16x8_t*)(Xs + l31 * 336 + 256 + 16 * h) = uf;
#pragma unroll
            for (int k = 0; k < 2; ++k) {
                f32x16 z;
#pragma unroll
                for (int i = 0; i < 16; ++i) z[i] = 0.f;
                const f32x16 bur = MFMA32(uf, Bre[k], z), bui = MFMA32(uf, Bim[k], z);
                float cr = xre[k], ci = xim[k];
#pragma unroll
                for (int q = 0; q < 4; ++q) {
                    float ar_[4], ai_[4], br_[4], bi_[4];
                    float xr_ = cr, xi_ = ci;
#pragma unroll
                    for (int r2 = 0; r2 < 4; ++r2) { cmadd(xr_, xi_, are[k], aim[k], bur[4 * q + r2], bui[4 * q + r2]); ar_[r2] = xr_; ai_[r2] = xi_; }
                    float yr_ = __shfl_xor(xr_, 32), yi_ = __shfl_xor(xi_, 32);
#pragma unroll
                    for (int r2 = 0; r2 < 4; ++r2) { cmadd(yr_, yi_, are[k], aim[k], bur[4 * q + r2], bui[4 * q + r2]); br_[r2] = yr_; bi_[r2] = yi_; }
                    const float zr_ = __shfl_xor(yr_, 32), zi_ = __shfl_xor(yi_, 32);
                    cr = h ? yr_ : zr_; ci = h ? yi_ : zi_;
#pragma unroll
                    for (int r2 = 0; r2 < 4; ++r2) {
                        const int t = 8 * q + 4 * h + r2;
                        *(bf16_t*)(Xs + t * 336 + (32 * k + l31) * 2) = f2bf(h ? br_[r2] : ar_[r2]);
                        *(bf16_t*)(Xs + t * 336 + (64 + 32 * k + l31) * 2) = f2bf(h ? bi_[r2] : ai_[r2]);
                    }
                }
                xre[k] = cr; xim[k] = ci;
            }
            wave_lds_fence();
#pragma unroll
            for (int mt = 0; mt < 2; ++mt) {
                f32x4 y = {0.f, 0.f, 0.f, 0.f};
#pragma unroll
                for (int ks = 0; ks < 5; ++ks) {
                    const bf16x8_t a = *(const bf16x8_t*)(Xs + (16 * mt + fr) * 336 + (32 * ks + 8 * fq) * 2);
                    y = __builtin_amdgcn_mfma_f32_16x16x32_bf16(a, Cm[ks], y, 0, 0, 0);
                }
#pragma unroll
                for (int reg = 0; reg < 4; ++reg)
                    ya[(size_t)(b * NL + 256 * wave + c0 + 16 * mt + 4 * fq + reg) * 256 + g * 16 + fr] = f2bf(gelu_fast(y[reg]));
            }
        }
    }
    __syncthreads();
}

struct Params {
    const float* in[29];
    float* out;
    char* ws;
    unsigned long long pad;
};

constexpr size_t SZ_PROJ = (size_t)NT * EVEN_IN * 2;
constexpr size_t SZ_VT = (size_t)768 * NT * 2;
constexpr size_t SZ_YB = (size_t)NT * ND * 2;
constexpr size_t SZ_HB = (size_t)NT * ND * 2;
constexpr size_t SZ_YA = (size_t)NT * 256 * 2;
constexpr size_t SZ_CMP = (size_t)NB * 4 * 128 * 64 * 2;
constexpr size_t SZ_SEL = (size_t)NB * 4 * NL * 4;
constexpr size_t SZ_TAB = (size_t)16384 * ND;
constexpr size_t SZ_SKB = (size_t)2 * 8 * 2 * 128 * 128 * 2;
constexpr size_t OFF_VT = SZ_PROJ, OFF_YB = OFF_VT + SZ_VT, OFF_HB = OFF_YB + SZ_YB, OFF_YA = OFF_HB + SZ_HB, OFF_KC = OFF_YA + SZ_YA, OFF_VC = OFF_KC + SZ_CMP,
                 OFF_SEL = OFF_VC + SZ_CMP, OFF_TAB = OFF_SEL + SZ_SEL, OFF_SKB = OFF_TAB + 2 * SZ_TAB, OFF_WT = OFF_SKB + SZ_SKB;
constexpr size_t WT_IN0 = 0, WT_OUT0 = WT_IN0 + (size_t)EVEN_IN * ND * 2, WT_Q0 = WT_OUT0 + (size_t)ND * ND * 2, WT_Q1 = WT_Q0 + (size_t)2048 * ND * 2,
                 WT_IN1 = WT_Q1 + (size_t)2048 * ND * 2, WT_V1 = WT_IN1 + (size_t)ODD_PAD * ND * 2, WT_OUT1 = WT_V1 + (size_t)512 * ND * 2, WT_W1 = WT_OUT1 + (size_t)ND * ND * 2, WT_W2 = WT_W1 + (size_t)2 * 128 * 2048 * 2, WT_B1 = WT_W2 + (size_t)2 * 64 * 128 * 2, WT_V0 = WT_B1 + 2 * 128 * 4, WT_GLU = WT_V0 + (size_t)768 * ND * 2, WT_END = WT_GLU + (size_t)256 * 256 * 2;
constexpr size_t OFF_BAR = OFF_WT + ((WT_END + 255) & ~(size_t)255);
constexpr size_t WS_NEED = OFF_BAR + XB_TOTAL_WORDS * 4 + 256;

__device__ __forceinline__ void convert_tables(const float* __restrict__ u, const float* __restrict__ v, unsigned char* __restrict__ TAB) {
    const size_t per = (size_t)16384 * ND / 16;
    for (size_t i = (size_t)blockIdx.x * NTHR + tidx(); i < 2 * per; i += (size_t)gridDim.x * NTHR) {
        const int tb = (int)(i / per); const size_t off = (i % per) * 16;
        const float* src = (tb ? v : u) + off;
        const float sc = tb ? V_SCALE : U_SCALE;
        uint4 w; unsigned* wp = (unsigned*)&w;
#pragma unroll
        for (int q = 0; q < 4; ++q) {
            const f32x4 a = __builtin_nontemporal_load((const f32x4*)(src + 4 * q));
            int pk = __builtin_amdgcn_cvt_pk_fp8_f32(a.x * sc, a.y * sc, 0, false);
            pk = __builtin_amdgcn_cvt_pk_fp8_f32(a.z * sc, a.w * sc, pk, true);
            wp[q] = (unsigned)pk;
        }
        *(uint4*)(TAB + (size_t)tb * 16384 * ND + off) = w;
    }
}

__global__ void __launch_bounds__(NTHR) fwd_megakernel(Params p) {
    extern __shared__ __attribute__((aligned(16))) unsigned char lds_raw[];
    float* lds = (float*)lds_raw;
    cg::grid_group grid = cg::this_grid();
    const float* x = p.in[0];
    float* R = p.out;
    char* ws = p.ws;
    bf16_t* PROJ = (bf16_t*)ws;
    bf16_t* YB = (bf16_t*)(ws + OFF_YB);
    bf16_t* HB = (bf16_t*)(ws + OFF_HB);
    bf16_t* YA = (bf16_t*)(ws + OFF_YA);
    bf16_t* WGT = (bf16_t*)(ws + OFF_WT + WT_GLU);
    bf16_t* KCMP = (bf16_t*)(ws + OFF_KC);
    bf16_t* VCMP = (bf16_t*)(ws + OFF_VC);
    bf16_t* W1T = (bf16_t*)(ws + OFF_WT + WT_W1);
    bf16_t* W2T = (bf16_t*)(ws + OFF_WT + WT_W2);
    float* BIAS1 = (float*)(ws + OFF_WT + WT_B1);
    unsigned* SEL = (unsigned*)(ws + OFF_SEL);
    bf16_t* WIN0 = (bf16_t*)(ws + OFF_WT + WT_IN0);
    bf16_t* WOUT0 = (bf16_t*)(ws + OFF_WT + WT_OUT0);
    bf16_t* WQ0 = (bf16_t*)(ws + OFF_WT + WT_Q0);
    bf16_t* WQ1 = (bf16_t*)(ws + OFF_WT + WT_Q1);
    bf16_t* WIN1 = (bf16_t*)(ws + OFF_WT + WT_IN1);
    bf16_t* WOUT1 = (bf16_t*)(ws + OFF_WT + WT_OUT1);
    bf16_t* WV1 = (bf16_t*)(ws + OFF_WT + WT_V1);
    bf16_t* VT = (bf16_t*)(ws + OFF_VT);
    bf16_t* WV0 = (bf16_t*)(ws + OFF_WT + WT_V0);
    int* EIDX = (int*)YB;
    float* EGATE = (float*)((char*)YB + (size_t)NT * 128 * 4);
    unsigned char* TAB = (unsigned char*)(ws + OFF_TAB);
    bf16_t* SKB = (bf16_t*)(ws + OFF_SKB);
    const int wave = tidx() >> 6;
    if (tidx() == 0) *(uint4*)(lds_raw + LDS_BYTES - 16) = make_uint4(0u, 0u, 0u, 0u);
    __syncthreads();
    XcdBarrier xbar = xcd_barrier_post((unsigned*)(ws + OFF_BAR), (volatile LAS unsigned*)(lds_raw + LDS_BYTES - 16));

    for (size_t i = (size_t)blockIdx.x * NTHR + tidx(); i < (size_t)NT * ND / 4; i += (size_t)gridDim.x * NTHR) {
        const float4 v = ((const float4*)x)[i];
        ((float4*)R)[i] = v;
        uint2 w; w.x = pack2(v.x, v.y); w.y = pack2(v.z, v.w);
        ((uint2*)HB)[i] = w;
    }
    convert_tables(p.in[23], p.in[24], TAB);
    for (int i = blockIdx.x * NTHR + tidx(); i < 2 * 8 * 2 * 128 * 128 / 4; i += gridDim.x * NTHR) {
        const float4 a = ((const float4*)p.in[22])[i];
        uint2 w; w.x = pack2(a.x, a.y); w.y = pack2(a.z, a.w);
        ((uint2*)SKB)[i] = w;
    }
    convert_wt_phase(p.in[1], ND, EVEN_IN, P0W, ColMap{{0, 0, 0}, {0, 0, 0}, {P0W, 0, 0}}, WIN0, lds);
    convert_wt_phase(p.in[1], ND, EVEN_IN, 768, ColMap{{0, 0, 0}, {P0W, 0, 0}, {768, 0, 0}}, WV0, lds);
    convert_wt_phase(p.in[12], ND, ND, ND, ColMap{{0, 0, 0}, {0, 0, 0}, {ND, 0, 0}}, WOUT0, lds);
    convert_wt_phase(p.in[10], 256, 256, 256, ColMap{{0, 0, 0}, {0, 0, 0}, {256, 0, 0}}, WGT, lds);
    convert_wt_phase(p.in[21], ND, 2048, 2048, ColMap{{0, 0, 0}, {0, 0, 0}, {2048, 0, 0}}, WQ0, lds);
    convert_wt_phase(p.in[21] + (size_t)ND * 2048, ND, 2048, 2048, ColMap{{0, 0, 0}, {0, 0, 0}, {2048, 0, 0}}, WQ1, lds);
    convert_wt_phase(p.in[13], ND, ODD_IN, ODD_PAD, ColMap{{0, 1792, 2048}, {0, 2048, 2560}, {1792, 256, 48}}, WIN1, lds);
    convert_wt_phase(p.in[13], ND, ODD_IN, 512, ColMap{{0, 256, 0}, {1792, 2304, 0}, {256, 256, 0}}, WV1, lds);
    convert_wt_phase(p.in[20], ND, ND, ND, ColMap{{0, 0, 0}, {0, 0, 0}, {ND, 0, 0}}, WOUT1, lds);
    convert_wt_phase(p.in[15], 2048, 128, 128, ColMap{{0, 0, 0}, {0, 0, 0}, {128, 0, 0}}, W1T, lds);
    convert_wt_phase(p.in[18], 2048, 128, 128, ColMap{{0, 0, 0}, {0, 0, 0}, {128, 0, 0}}, W1T + 128 * 2048, lds);
    convert_wt_phase(p.in[16], 128, 64, 64, ColMap{{0, 0, 0}, {0, 0, 0}, {64, 0, 0}}, W2T, lds);
    convert_wt_phase(p.in[19], 128, 64, 64, ColMap{{0, 0, 0}, {0, 0, 0}, {64, 0, 0}}, W2T + 64 * 128, lds);
    if (blockIdx.x < 2 && tidx() < 128) {
        const float* pe = blockIdx.x ? p.in[17] : p.in[14];
        const float* w1 = blockIdx.x ? p.in[18] : p.in[15];
        float a = 0.f;
        for (int i = 0; i < 2048; ++i) a += pe[i] * w1[(size_t)i * 128 + tidx()];
        BIAS1[blockIdx.x * 128 + tidx()] = a;
    }
    grid.sync();
    PDUP(0) { PH(0) gemm_bf16_phase(lds_raw, HB, WIN0, NT, P0W, ND, EpiBf16s{PROJ, P0W});
    PH(0) gemm_bf16_phase(lds_raw, WV0, HB, 768, NT, ND, EpiBf16s{VT, NT}, true); }
    xcd_barrier(xbar);
    PDUP(1) { PH(1) s5_scan3_phase(PROJ, p.in[2], p.in[3], p.in[4], p.in[5], p.in[6], p.in[7], p.in[8], p.in[9], YA, lds_raw);
    PH(2) sb_attn2_phase(PROJ, VT, YB, lds_raw);
    if ((PROBE >> 13) & 1) {
        bf16_t* SCR = PROJ + (size_t)NT * P0W;
        s5_scan2_phase(PROJ, p.in[2], p.in[3], p.in[4], p.in[5], p.in[6], p.in[7], p.in[8], p.in[9], SCR, lds);
        xcd_barrier(xbar);
        float d2 = 0.f, n2 = 0.f;
        for (size_t i = (size_t)blockIdx.x * NTHR + tidx(); i < (size_t)NT * 256; i += (size_t)gridDim.x * NTHR) { const float a = bf2f(YA[i]), r = bf2f(SCR[i]); d2 += (a - r) * (a - r); n2 += r * r; }
        for (int o = 32; o; o >>= 1) { d2 += __shfl_xor(d2, o); n2 += __shfl_xor(n2, o); }
        float* chk = (float*)(ws + OFF_BAR + XB_TOTAL_WORDS * 4);
        if ((tidx() & 63) == 0) { atomicAdd(chk, d2); atomicAdd(chk + 1, n2); }
    }
    if (_rep == 0 && ((PROBE >> 1) & 1)) xcd_barrier(xbar); }
    xcd_barrier(xbar);
    PDUP(2) PH(3) glu2_phase(YA, WGT, p.in[11], YB, lds_raw);
    xcd_barrier(xbar);
    if ((PROBE >> 3) & 1) { gemm_bf16_phase(lds_raw, YB, WOUT0, NT, ND, ND, EpiRes{R, ND, ALPHA, (float*)PROJ}); xcd_barrier(xbar); }
    PH(4) gemm_bf16_phase(lds_raw, YB, WOUT0, NT, ND, ND, EpiRes{R, ND, ALPHA, R});
    xcd_barrier(xbar);
    PH(5) ln_phase(R, HB, p.in[25], p.in[26]);
    xcd_barrier(xbar);
#define PEER_FFN(layer, WQ, last) \
    PDUP(0) PH(12) gemm_bf16_phase(lds_raw, HB, WQ, NT, 2048, ND, EpiBf16s{PROJ, 2048}); \
    xcd_barrier(xbar); \
    PDUP(4) PH(13) peer_route2_phase(PROJ, SKB + (size_t)(layer) * 8 * 2 * 128 * 128, EIDX, EGATE, lds_raw); \
    xcd_barrier(xbar); \
    if ((PROBE >> 5) & 1) { peer_expert3_phase(R, EIDX, EGATE, TAB, TAB + (size_t)16384 * ND, p.in[27] + (layer) * ND, p.in[28] + (layer) * ND, nullptr, (float*)PROJ, xbar); xcd_barrier(xbar); } \
    PH(14) peer_expert6_phase(R, EIDX, EGATE, TAB, TAB + (size_t)16384 * ND, p.in[27] + (layer) * ND, p.in[28] + (layer) * ND, (last) ? nullptr : HB, xbar, lds); \
    if (!(last)) xcd_barrier(xbar);
    PEER_FFN(0, WQ0, false)
    convert_tables(p.in[23] + (size_t)16384 * ND, p.in[24] + (size_t)16384 * ND, TAB);
    PDUP(0) { PH(6) gemm_bf16_phase(lds_raw, HB, WIN1, NT, ODD_PAD, ND, EpiBf16s{PROJ, ODD_PAD});
    PH(6) gemm_bf16_phase(lds_raw, WV1, HB, 512, NT, ND, EpiBf16s{VT, NT}); }
    xcd_barrier(xbar);
    PDUP(6) PH(7) nsa_compress2_phase(PROJ, W1T, W2T, BIAS1, KCMP, VCMP, lds_raw);
    xcd_barrier(xbar);
    PDUP(7) { PH(8) nsa_cmp2_phase(PROJ, KCMP, VCMP, YB, SEL, lds_raw);
    xcd_barrier(xbar);
    PH(9) nsa_attn_phase(PROJ, VT, SEL, YB, lds_raw);
    if (_rep == 0 && ((PROBE >> 7) & 1)) xcd_barrier(xbar); }
    xcd_barrier(xbar);
    if ((PROBE >> 3) & 1) { gemm_bf16_phase(lds_raw, YB, WOUT1, NT, ND, ND, EpiRes{R, ND, ALPHA, (float*)PROJ}); xcd_barrier(xbar); }
    PH(10) gemm_bf16_phase(lds_raw, YB, WOUT1, NT, ND, ND, EpiRes{R, ND, ALPHA, R});
    xcd_barrier(xbar);
    PH(11) ln_phase(R, HB, p.in[25] + ND, p.in[26] + ND);
    xcd_barrier(xbar);
    PEER_FFN(1, WQ1, true)
    if ((PROBE >> 13) & 1) {
        xcd_barrier(xbar);
        const float* chk = (const float*)(ws + OFF_BAR + XB_TOTAL_WORDS * 4);
        const float d2 = __hip_atomic_load(chk, __ATOMIC_RELAXED, __HIP_MEMORY_SCOPE_AGENT), n2 = __hip_atomic_load(chk + 1, __ATOMIC_RELAXED, __HIP_MEMORY_SCOPE_AGENT);
        if (!(d2 <= 1e-4f * n2)) for (size_t i = (size_t)blockIdx.x * NTHR + tidx(); i < (size_t)NT * ND; i += (size_t)gridDim.x * NTHR) R[i] *= 2.f;
    }
}

}

extern "C" void kernel_launch(void* const* d_in, const int* in_sizes, int n_in, void* d_out, int out_size, void* d_ws, size_t ws_size, hipStream_t stream) {
    static int grid_blocks = 0;
    if (grid_blocks == 0) {
        if (n_in != 29 || out_size != NT * ND || ws_size < WS_NEED) { fprintf(stderr, "kernel_launch: unexpected shapes / workspace (%zu < %zu)\n", ws_size, (size_t)WS_NEED); grid_blocks = -1; return; }
        int dev = 0, cus = 0, per_cu = 0;
        hipGetDevice(&dev);
        hipDeviceGetAttribute(&cus, hipDeviceAttributeMultiprocessorCount, dev);
        hipFuncSetAttribute((const void*)fwd_megakernel, hipFuncAttributeMaxDynamicSharedMemorySize, LDS_BYTES);
        hipOccupancyMaxActiveBlocksPerMultiprocessor(&per_cu, (const void*)fwd_megakernel, NTHR, LDS_BYTES);
        if (per_cu < 1) { fprintf(stderr, "kernel_launch: occupancy query says %d blocks/CU\n", per_cu); grid_blocks = -1; return; }
        grid_blocks = cus;
    }
    if (grid_blocks < 0) return;
    hipMemsetAsync((char*)d_ws + OFF_BAR, 0, XB_TOTAL_WORDS * 4 + 256, stream);
    Params p{};
    for (int i = 0; i < 29; ++i) p.in[i] = (const float*)d_in[i];
    p.out = (float*)d_out; p.ws = (char*)d_ws; p.pad = 0;
    void* args[] = {&p};
    hipError_t e = hipLaunchCooperativeKernel((const void*)fwd_megakernel, dim3(grid_blocks), dim3(NTHR), args, LDS_BYTES, stream);
    if (e != hipSuccess) fprintf(stderr, "cooperative launch failed: %s (grid %d)\n", hipGetErrorString(e), grid_blocks);
}
```

```cpp
#include <hip/hip_runtime.h>
#include <hip/hip_cooperative_groups.h>
#include <math.h>
#include <stdint.h>
#include <cstdio>
namespace cg = cooperative_groups;

__device__ __forceinline__ int tidx() { int t = threadIdx.x; asm volatile("" : "+v"(t)); return t; }
#define XB_TMO      128
#define XB_XCNT(j)  (256  + 64 * (j))
#define XB_XSUB(j)  (1280 + 64 * (j))
#define XB_XGEN(j)  (2304 + 64 * (j))
#define XB_TOP      3328
#define XB_TOPGEN   3392
#define XCD_BAR_WORDS 3456
#define XB_SPIN_CAP (1u << 18)
#define LAS __attribute__((address_space(3)))

__device__ __forceinline__ unsigned xb_ld(unsigned* p)              { return __hip_atomic_load(p, __ATOMIC_RELAXED, __HIP_MEMORY_SCOPE_AGENT); }
__device__ __forceinline__ unsigned xb_add(unsigned* p, unsigned v) { return __hip_atomic_fetch_add(p, v, __ATOMIC_RELAXED, __HIP_MEMORY_SCOPE_AGENT); }
__device__ __forceinline__ unsigned xb_xcc_id() { return (unsigned)__builtin_amdgcn_s_getreg((3 << 11) | 20) & 0xFu; }
#define XB_SPIN(cond, bar) do { unsigned _sp = 0; while (cond) { __builtin_amdgcn_s_sleep(1); \
    if ((++_sp & 255u) == 0u) { if (xb_ld(&(bar)[XB_TMO])) break; if (_sp > XB_SPIN_CAP) { atomicAdd(&(bar)[XB_TMO], 1u); break; } } } } while (0)

struct XcdBarrier {
    unsigned* bar; unsigned x;
    volatile LAS unsigned* st;
};

__device__ __forceinline__ XcdBarrier xcd_barrier_post(unsigned* bar, volatile LAS unsigned* st) {
    XcdBarrier b; b.bar = bar; b.x = xb_xcc_id(); b.st = st;
    if (tidx() == 0) (void)xb_add(&bar[XB_XCNT(b.x)], 1u);
    return b;
}
__device__ __forceinline__ void xcd_barrier_complete(unsigned* bar, unsigned x, unsigned& nloc, unsigned& nx) {
    const unsigned G = gridDim.x * gridDim.y * gridDim.z;
    unsigned sum, cnt, mine, sp = 0u;
    for (;;) {
        sum = 0u; cnt = 0u; mine = 0u;
#pragma unroll
        for (unsigned j = 0; j < 16; ++j) { const unsigned c = xb_ld(&bar[XB_XCNT(j)]); sum += c; cnt += (c > 0u) ? 1u : 0u; mine = (j == x) ? c : mine; }
        if (sum == G) break;
        __builtin_amdgcn_s_sleep(1);
        if ((++sp & 255u) == 0u) { if (xb_ld(&bar[XB_TMO])) break; if (sp > XB_SPIN_CAP) { atomicAdd(&bar[XB_TMO], 1u); break; } }
    }
    nloc = mine > 0u ? mine : 1u; nx = cnt > 0u ? cnt : 1u;
}

__device__ __forceinline__ void xcd_barrier(const XcdBarrier& b) {
    asm volatile("s_waitcnt vmcnt(0)" ::: "memory");
    __syncthreads();
    if (tidx() == 0) {
        unsigned* bar = b.bar;
        __builtin_amdgcn_s_waitcnt(0);
        unsigned nloc = b.st[0], nx = b.st[1];
        if (nloc == 0u) { xcd_barrier_complete(bar, b.x, nloc, nx); b.st[0] = nloc; b.st[1] = nx; }
        const unsigned old = xb_add(&bar[XB_XSUB(b.x)], 1u);
        const unsigned gen = old / nloc;
        if (old + 1u == (gen + 1u) * nloc) {
            __builtin_amdgcn_fence(__ATOMIC_RELEASE, "agent");
            asm volatile("s_waitcnt vmcnt(0)" ::: "memory");
            const unsigned og = xb_add(&bar[XB_TOP], 1u);
            const unsigned tg = og / nx;
            if (og + 1u == (tg + 1u) * nx) xb_add(&bar[XB_TOPGEN], 1u);
            else XB_SPIN(xb_ld(&bar[XB_TOPGEN]) == tg, bar);
            __builtin_amdgcn_fence(__ATOMIC_ACQUIRE, "agent");
            xb_add(&bar[XB_XGEN(b.x)], 1u);
            asm volatile("s_waitcnt vmcnt(0)" ::: "memory");
        } else {
            XB_SPIN(xb_ld(&bar[XB_XGEN(b.x)]) == gen, bar);
            __builtin_amdgcn_fence(__ATOMIC_ACQUIRE, "agent");
            asm volatile("s_waitcnt vmcnt(0)" ::: "memory");
        }
    }
    __syncthreads();
}

#define XB_ALIGN(j) (XCD_BAR_WORDS + 64 * (j))
#define XB_TOTAL_WORDS (XCD_BAR_WORDS + 64 * 16)
__device__ __forceinline__ void xcc_align(const XcdBarrier& b) {
    __syncthreads();
    if (tidx() == 0) {
        const unsigned nloc = b.st[0];
        if (nloc) {
            const unsigned old = xb_add(&b.bar[XB_ALIGN(b.x)], 1u), gen = old / nloc;
            unsigned sp = 0;
            while (xb_ld(&b.bar[XB_ALIGN(b.x)]) < (gen + 1u) * nloc && ++sp < (1u << 16)) __builtin_amdgcn_s_sleep(1);
        }
    }
    __syncthreads();
}
namespace pg8 {
#define PG8_LAS __attribute__((address_space(3)))
typedef unsigned short bf16_t;
typedef short bf16x8 __attribute__((ext_vector_type(8)));
typedef float f32x4 __attribute__((ext_vector_type(4)));
typedef unsigned u32x4 __attribute__((ext_vector_type(4)));
constexpr int BM = 256, BK = 64, HALF = 128, HTB = HALF * BK * 2  , STAGE_BYTES = 8 * HTB, NXCD = 8, WGM = 8;

__host__ __device__ __forceinline__ int lds_byte(int r, int c) { const int st = (r >> 4) * 2 + (c >> 5), rr = r & 15, cc = c & 31, ob = rr * 64 + cc * 2; return st * 1024 + (ob ^ (((ob >> 9) & 1) << 5)); }
__host__ __device__ __forceinline__ void stage_rc(int b, int& R, int& C) { const int st = b / 1024, sb = b % 1024, swz = sb ^ (((sb >> 9) & 1) << 5); R = (st >> 1) * 16 + swz / 64; C = (st & 1) * 32 + (swz % 64) / 2; }
__host__ __device__ __forceinline__ int perm32(int rho) { const int n = rho >> 4, i = rho & 15; return 8 * (i >> 2) + 4 * n + (i & 3); }

struct Unit { int pm, pn; };
struct Gemm { const bf16_t* A; const bf16_t* Bt; int M, N, K; };

struct StaticOrder {
    int nM, nN, nwg, G, c;
    __host__ __device__ void init(int M, int N, int G_, int c_) { nM = M / BM; nN = N / BM; nwg = nM * nN; G = G_; c = c_; }
    __host__ __device__ bool next(int i, Unit& u) const {
        const long L = (long)i * G + c; if (L >= nwg) return false;
        int wgid = (int)L; { const int q = nwg / NXCD, r = nwg % NXCD, xcd = wgid % NXCD, off = wgid / NXCD; wgid = (xcd < r ? xcd * (q + 1) : r * (q + 1) + (xcd - r) * q) + off; }
        const int nig = WGM * nN, gid = wgid / nig, fm = gid * WGM, gsz = (nM - fm) < WGM ? (nM - fm) : WGM;
        u.pm = fm + ((wgid % nig) % gsz); u.pn = (wgid % nig) / gsz; return true;
    }
    __device__ __forceinline__ void a_ready(const Unit&) const {}
    __device__ __forceinline__ void done(const Unit&) const {}
};
__device__ __forceinline__ unsigned cvt_pk_bf16(float lo, float hi) { unsigned r; asm volatile("v_cvt_pk_bf16_f32 %0, %1, %2" : "=v"(r) : "v"(lo), "v"(hi)); return r; }
template <class Epi, class Sched, bool STAMP = false>
__device__ __forceinline__ void gemm_phase(PG8_LAS unsigned char* lds, const Gemm g, const Sched& S, const Epi& E, unsigned long long* stamps) {
    const int tid = tidx(), wid = __builtin_amdgcn_readfirstlane(tid >> 6), lane = tid & 63, wr = wid >> 2, wc = wid & 3, fr = lane & 15, fq = lane >> 4;
    const int K = g.K, nt = K / BK;
    int ts_lo = 0, ts_hi = 0, nts = 0; const unsigned long long rt_entry = STAMP ? (unsigned long long)wall_clock64() : 0ull;
#define PG8_STAMP() do { if (STAMP && wid == 0 && nts < 64) { const unsigned long long _c = (unsigned long long)clock64(); \
        ts_lo = (lane == nts) ? (int)(unsigned)_c : ts_lo; ts_hi = (lane == nts) ? (int)(unsigned)(_c >> 32) : ts_hi; ++nts; } } while (0)
    PG8_STAMP();
    unsigned voffA[2], voffB[2];
#pragma unroll
    for (int i = 0; i < 2; ++i) { int R, C; stage_rc(tid * 16 + i * 8192, R, C); const int Rb = Epi::PERM ? ((R & ~31) + perm32(R & 31)) : R;
        voffA[i] = (unsigned)(R * K + C) * 2u; voffB[i] = (unsigned)(Rb * K + C) * 2u; }
    const size_t kstep = (size_t)(BK * 2);
    const size_t hstep = (size_t)HALF * K * 2;
    const size_t tstep = 2 * hstep;
    const unsigned ldsw = (unsigned)wid * 1024u;
    const int aoff = lds_byte(wr * 64 + fr, fq * 8), boff = lds_byte(wc * 32 + fr, fq * 8);
#define PG8_SA(b, h) (((b) * 2 + (h)) * HTB)
#define PG8_SB(b, h) ((4 + (b) * 2 + (h)) * HTB)
#define PG8_STAGE(bufoff, gbase, voff) do { _Pragma("unroll") for (int _i = 0; _i < 2; ++_i) \
        __builtin_amdgcn_global_load_lds((const unsigned*)((const char*)(gbase) + (voff)[_i]), (PG8_LAS unsigned*)(lds + (bufoff) + ldsw + _i * 8192), 16, 0, 0); } while (0)
#define PG8_LDA(dst, b, h) do { _Pragma("unroll") for (int m = 0; m < 4; ++m) _Pragma("unroll") for (int k = 0; k < 2; ++k) dst[m][k] = *(const PG8_LAS bf16x8*)(lds + PG8_SA(b, h) + aoff + m * 2048 + k * 1024); } while (0)
#define PG8_LDB(dst, b, h) do { _Pragma("unroll") for (int n = 0; n < 2; ++n) _Pragma("unroll") for (int k = 0; k < 2; ++k) dst[n][k] = *(const PG8_LAS bf16x8*)(lds + PG8_SB(b, h) + boff + n * 2048 + k * 1024); } while (0)
#define PG8_MMA(ai, bj, At, Bt) do { __builtin_amdgcn_s_setprio(1); _Pragma("unroll") for (int m = 0; m < 4; ++m) _Pragma("unroll") for (int n = 0; n < 2; ++n) _Pragma("unroll") for (int k = 0; k < 2; ++k) \
        acc[ai][bj][m][n] = __builtin_amdgcn_mfma_f32_16x16x32_bf16(Bt[n][k], At[m][k], acc[ai][bj][m][n], 0, 0, 0); __builtin_amdgcn_s_setprio(0); } while (0)
#define PG8_WAIT_V(n) asm volatile("s_waitcnt vmcnt(" #n ")" ::: "memory")
#define PG8_WAIT_L(n) asm volatile("s_waitcnt lgkmcnt(" #n ")" ::: "memory")
#define PG8_BAR __builtin_amdgcn_s_barrier()
#define PG8_SCHED __builtin_amdgcn_sched_barrier(0)
    Unit cur, nxt; int ui = 0;
    if (!S.next(0, cur)) return;
    f32x4 acc[2][2][4][2];
#pragma unroll
    for (int a = 0; a < 2; ++a)
#pragma unroll
        for (int b = 0; b < 2; ++b)
#pragma unroll
            for (int m = 0; m < 4; ++m)
#pragma unroll
                for (int n = 0; n < 2; ++n) acc[a][b][m][n] = (f32x4){0.f, 0.f, 0.f, 0.f};
    bf16x8 At[4][2], B0[2][2], B1[2][2];
    const char* cA = (const char*)g.A + (size_t)cur.pm * tstep; const char* cB = (const char*)g.Bt + (size_t)cur.pn * tstep;
    S.a_ready(cur);
    PG8_STAGE(PG8_SB(0, 0), cB, voffB); PG8_STAGE(PG8_SA(0, 0), cA, voffA); PG8_STAGE(PG8_SB(0, 1), cB + hstep, voffB); PG8_STAGE(PG8_SA(0, 1), cA + hstep, voffA);
    if (wr == 1) PG8_BAR;
    PG8_WAIT_V(4); PG8_BAR;
    PG8_STAGE(PG8_SB(1, 0), cB + kstep, voffB); PG8_STAGE(PG8_SA(1, 0), cA + kstep, voffA); PG8_STAGE(PG8_SB(1, 1), cB + hstep + kstep, voffB);
    PG8_WAIT_V(6); PG8_BAR;
    PG8_STAMP();
    for (;;) {
        const bool has_next = S.next(ui + 1, nxt);
        const char* nA = has_next ? (const char*)g.A + (size_t)nxt.pm * tstep : cA; const char* nB = has_next ? (const char*)g.Bt + (size_t)nxt.pn * tstep : cB;
        for (int t = 0; t < nt; t += 2) {
            const bool last = (t == nt - 2);
            const char* a1 = cA + (size_t)(t + 1) * kstep;
            const char* a2 = last ? nA : cA + (size_t)(t + 2) * kstep; const char* b2 = last ? nB : cB + (size_t)(t + 2) * kstep;
            const char* a3 = a2 + kstep; const char* b3 = b2 + kstep;
            if (last && has_next) S.a_ready(nxt);
            PG8_LDB(B0, 0, 0); PG8_SCHED; PG8_LDA(At, 0, 0); PG8_STAGE(PG8_SA(1, 1), a1 + hstep, voffA);
            PG8_WAIT_L(8); PG8_BAR; PG8_WAIT_L(0); PG8_MMA(0, 0, At, B0); PG8_BAR; PG8_SCHED;
            PG8_LDB(B1, 0, 1); PG8_STAGE(PG8_SB(0, 0), b2, voffB);
            PG8_BAR; PG8_WAIT_L(0); PG8_MMA(0, 1, At, B1); PG8_BAR;
            PG8_LDA(At, 0, 1); PG8_STAGE(PG8_SA(0, 0), a2, voffA);
            PG8_BAR; PG8_WAIT_L(0); PG8_MMA(1, 0, At, B0); PG8_BAR; PG8_SCHED;
            PG8_STAGE(PG8_SB(0, 1), b2 + hstep, voffB);
            PG8_WAIT_V(6); PG8_BAR; PG8_MMA(1, 1, At, B1); PG8_BAR;
            PG8_LDB(B0, 1, 0); PG8_SCHED; PG8_LDA(At, 1, 0); PG8_STAGE(PG8_SA(0, 1), a2 + hstep, voffA);
            PG8_WAIT_L(8); PG8_BAR; PG8_WAIT_L(0); PG8_MMA(0, 0, At, B0); PG8_BAR; PG8_SCHED;
            PG8_LDB(B1, 1, 1); PG8_STAGE(PG8_SB(1, 0), b3, voffB);
            PG8_BAR; PG8_WAIT_L(0); PG8_MMA(0, 1, At, B1); PG8_BAR;
            PG8_LDA(At, 1, 1); PG8_STAGE(PG8_SA(1, 0), a3, voffA);
            PG8_BAR; PG8_WAIT_L(0); PG8_MMA(1, 0, At, B0); PG8_BAR; PG8_SCHED;
            PG8_STAGE(PG8_SB(1, 1), b3 + hstep, voffB);
            PG8_WAIT_V(6); PG8_BAR; PG8_MMA(1, 1, At, B1); PG8_BAR;
        }
        PG8_STAMP();
        if constexpr (!Epi::AFTER_DRAIN) { E(acc, cur, wr, wc, fr, fq); S.done(cur); }
        PG8_STAMP();
        if (!has_next) break;
#pragma unroll
        for (int a = 0; a < 2; ++a)
#pragma unroll
            for (int b = 0; b < 2; ++b)
#pragma unroll
                for (int m = 0; m < 4; ++m)
#pragma unroll
                    for (int n = 0; n < 2; ++n) acc[a][b][m][n] = (f32x4){0.f, 0.f, 0.f, 0.f};
        cur = nxt; cA = nA; cB = nB; ++ui;
    }
    PG8_WAIT_V(0);
    if (wr == 0) PG8_BAR;
    PG8_BAR;
    if constexpr (Epi::AFTER_DRAIN) { E.fused(acc, cur, wr, wc, fr, fq, lds, wid, lane); S.done(cur); }
    PG8_STAMP();
    if (STAMP && wid == 0) { stamps[lane] = lane < nts ? (((unsigned long long)(unsigned)ts_hi << 32) | (unsigned)ts_lo) : 0ull;
        if (lane == 62) stamps[62] = rt_entry; if (lane == 63) stamps[63] = (unsigned long long)wall_clock64(); }
#undef PG8_STAMP
#undef PG8_SA
#undef PG8_SB
#undef PG8_STAGE
#undef PG8_LDA
#undef PG8_LDB
#undef PG8_MMA
#undef PG8_WAIT_V
#undef PG8_WAIT_L
#undef PG8_BAR
#undef PG8_SCHED
}
}

namespace {
using pg8::bf16_t;
typedef float f32x4 __attribute__((ext_vector_type(4)));
typedef unsigned u32x4 __attribute__((ext_vector_type(4)));

constexpr int NB = 16, NL = 2048, ND = 1024, NT = NB * NL;
constexpr int EVEN_IN = 2560, ODD_IN = 2608, ODD_PAD = 2304;
constexpr float ALPHA = 1.41421356237f;
constexpr float LN_EPS = 1e-5f;
constexpr float U_SCALE = 256.f, V_SCALE = 16.f;
constexpr int NTHR = 512;
constexpr int LDS_BYTES = 163840;
#ifndef PROBE
#define PROBE 0
#endif
#define PDUP(bit) for (int _rep = 0; _rep < ((PROBE >> (bit)) & 1) + 1; ++_rep)
#ifndef PHMASK
#define PHMASK 0xFFFFFFFFu
#endif
#define PH(n) if (PHMASK & (1u << (n)))

__device__ __forceinline__ float bf2f(bf16_t v) { return __uint_as_float((unsigned)v << 16); }
__device__ __forceinline__ bf16_t f2bf(float f) { unsigned u = __float_as_uint(f); u += 0x7FFFu + ((u >> 16) & 1u); return (bf16_t)(u >> 16); }
__device__ __forceinline__ unsigned pack2(float lo, float hi) { return (unsigned)f2bf(lo) | ((unsigned)f2bf(hi) << 16); }
__device__ __forceinline__ void ld8(const bf16_t* p, float* o) {
    const uint4 v = *(const uint4*)p;
    o[0] = __uint_as_float(v.x << 16); o[1] = __uint_as_float(v.x & 0xffff0000u);
    o[2] = __uint_as_float(v.y << 16); o[3] = __uint_as_float(v.y & 0xffff0000u);
    o[4] = __uint_as_float(v.z << 16); o[5] = __uint_as_float(v.z & 0xffff0000u);
    o[6] = __uint_as_float(v.w << 16); o[7] = __uint_as_float(v.w & 0xffff0000u);
}
__device__ __forceinline__ void st8(bf16_t* p, const float* o) {
    uint4 v; v.x = pack2(o[0], o[1]); v.y = pack2(o[2], o[3]); v.z = pack2(o[4], o[5]); v.w = pack2(o[6], o[7]);
    *(uint4*)p = v;
}

struct EpiBf16s {
    static constexpr bool PERM = true, AFTER_DRAIN = false;
    bf16_t* O; int ldc;
    __device__ __forceinline__ void operator()(const f32x4 (&acc)[2][2][4][2], const pg8::Unit& u, int wr, int wc, int fr, int fq) const {
        const int row0 = u.pm * 256 + wr * 64 + fr, col0 = u.pn * 256 + wc * 32 + 8 * fq;
#pragma unroll
        for (int ai = 0; ai < 2; ++ai)
#pragma unroll
            for (int m = 0; m < 4; ++m) { bf16_t* rowp = O + (size_t)(row0 + ai * 128 + m * 16) * ldc + col0;
#pragma unroll
                for (int bj = 0; bj < 2; ++bj) { const f32x4 v0 = acc[ai][bj][m][0], v1 = acc[ai][bj][m][1];
                    u32x4 w; w.x = pg8::cvt_pk_bf16(v0[0], v0[1]); w.y = pg8::cvt_pk_bf16(v0[2], v0[3]); w.z = pg8::cvt_pk_bf16(v1[0], v1[1]); w.w = pg8::cvt_pk_bf16(v1[2], v1[3]);
                    *(u32x4*)(rowp + bj * 128) = w; } }
    }
};
struct EpiRes {
    static constexpr bool PERM = false, AFTER_DRAIN = false;
    float* C; int ldc; float alpha; float* Cout;
    __device__ __forceinline__ void operator()(const f32x4 (&acc)[2][2][4][2], const pg8::Unit& u, int wr, int wc, int fr, int fq) const {
        const int row0 = u.pm * 256 + wr * 64 + fr, col0 = u.pn * 256 + wc * 32 + 4 * fq; const size_t dlt = Cout - C;
#pragma unroll
        for (int ai = 0; ai < 2; ++ai)
#pragma unroll
            for (int m = 0; m < 4; ++m) { float* rowp = C + (size_t)(row0 + ai * 128 + m * 16) * ldc + col0;
#pragma unroll
                for (int bj = 0; bj < 2; ++bj)
#pragma unroll
                    for (int n = 0; n < 2; ++n) { f32x4* cp = (f32x4*)(rowp + bj * 128 + n * 16); *(cp + dlt / 4) = *cp * alpha + acc[ai][bj][m][n]; } }
    }
};

struct EpiResStats {
    static constexpr bool PERM = false, AFTER_DRAIN = false;
    float* C; int ldc; float alpha; bf16_t* Vb; float* part;
    __device__ __forceinline__ void operator()(const f32x4 (&acc)[2][2][4][2], const pg8::Unit& u, int wr, int wc, int fr, int fq) const {
        const int row0 = u.pm * 256 + wr * 64 + fr, col0 = u.pn * 256 + wc * 32 + 4 * fq;
#pragma unroll
        for (int ai = 0; ai < 2; ++ai)
#pragma unroll
            for (int m = 0; m < 4; ++m) {
                const int row = row0 + ai * 128 + m * 16;
                float* rowp = C + (size_t)row * ldc + col0;
                bf16_t* rowb = Vb + (size_t)row * ldc + col0;
                float s1 = 0.f, s2 = 0.f;
#pragma unroll
                for (int bj = 0; bj < 2; ++bj)
#pragma unroll
                    for (int n = 0; n < 2; ++n) {
                        f32x4* cp = (f32x4*)(rowp + bj * 128 + n * 16);
                        const f32x4 v = *cp * alpha + acc[ai][bj][m][n];
                        *cp = v;
                        *(uint2*)(rowb + bj * 128 + n * 16) = make_uint2(pg8::cvt_pk_bf16(v[0], v[1]), pg8::cvt_pk_bf16(v[2], v[3]));
                        s1 += (v[0] + v[1]) + (v[2] + v[3]);
                        s2 += (v[0] * v[0] + v[1] * v[1]) + (v[2] * v[2] + v[3] * v[3]);
                    }
                s1 += __shfl_xor(s1, 16); s2 += __shfl_xor(s2, 16);
                s1 += __shfl_xor(s1, 32); s2 += __shfl_xor(s2, 32);
                if (fq == 0) *(float2*)(part + ((size_t)row * 16 + u.pn * 4 + wc) * 2) = make_float2(s1, s2);
            }
    }
};
struct EpiBf16LN {
    static constexpr bool PERM = true, AFTER_DRAIN = false;
    bf16_t* O; int ldc; const float* csum; const float* dvec; const float2* stats  ; int pm0, pm1, pm2, pm3;
    __device__ __forceinline__ void operator()(const f32x4 (&acc)[2][2][4][2], const pg8::Unit& u, int wr, int wc, int fr, int fq) const {
        const int slot = (u.pm == pm0) ? 0 : ((u.pm == pm1) ? 1 : ((u.pm == pm2) ? 2 : 3));
        const float2* st = stats + slot * 256;
        const int lrow0 = wr * 64 + fr, col0 = u.pn * 256 + wc * 32 + 8 * fq;
        f32x4 cv[2][2], dv[2][2];
#pragma unroll
        for (int bj = 0; bj < 2; ++bj)
#pragma unroll
            for (int n = 0; n < 2; ++n) { cv[bj][n] = *(const f32x4*)(csum + col0 + bj * 128 + 4 * n); dv[bj][n] = *(const f32x4*)(dvec + col0 + bj * 128 + 4 * n); }
#pragma unroll
        for (int ai = 0; ai < 2; ++ai)
#pragma unroll
            for (int m = 0; m < 4; ++m) {
                const int lrow = lrow0 + ai * 128 + m * 16;
                const float2 ms = st[lrow];
                bf16_t* rowp = O + (size_t)(u.pm * 256 + lrow) * ldc + col0;
#pragma unroll
                for (int bj = 0; bj < 2; ++bj) {
                    const f32x4 v0 = (acc[ai][bj][m][0] - cv[bj][0] * ms.x) * ms.y + dv[bj][0], v1 = (acc[ai][bj][m][1] - cv[bj][1] * ms.x) * ms.y + dv[bj][1];
                    u32x4 w; w.x = pg8::cvt_pk_bf16(v0[0], v0[1]); w.y = pg8::cvt_pk_bf16(v0[2], v0[3]); w.z = pg8::cvt_pk_bf16(v1[0], v1[1]); w.w = pg8::cvt_pk_bf16(v1[2], v1[3]);
                    *(u32x4*)(rowp + bj * 128) = w;
                }
            }
    }
};
__device__ __forceinline__ void gemm_q_phase(unsigned char* lds, const bf16_t* Vb, const bf16_t* Wt, const float* __restrict__ part, const float* csum, const float* dvec, bf16_t* Q) {
    pg8::StaticOrder S; S.init(NT, 2048, (int)gridDim.x, (int)blockIdx.x);
    int pms[4] = {-1, -1, -1, -1};
    float2* st = (float2*)(lds + 131072);
    __syncthreads();
#pragma unroll
    for (int i = 0; i < 4; ++i) {
        pg8::Unit u;
        if (S.next(i, u)) {
            bool seen = false;
#pragma unroll
            for (int j = 0; j < 4; ++j) if (j < i && pms[j] == u.pm) seen = true;
            pms[i] = seen ? -2 - i : u.pm;
            if (!seen && tidx() < 256) {
                const int row = u.pm * 256 + tidx();
                const float4* pp = (const float4*)(part + (size_t)row * 32);
                float s1 = 0.f, s2 = 0.f;
#pragma unroll
                for (int k = 0; k < 8; ++k) { const float4 a = pp[k]; s1 += a.x; s2 += a.y; s1 += a.z; s2 += a.w; }
                const float mean = s1 * (1.f / ND), var = fmaxf(s2 * (1.f / ND) - mean * mean, 0.f);
                st[i * 256 + tidx()] = make_float2(mean, rsqrtf(var + LN_EPS));
            }
        }
    }
    __syncthreads();
    pg8::Gemm g{Vb, Wt, NT, 2048, ND};
    EpiBf16LN E{Q, 2048, csum, dvec, st, pms[0], pms[1], pms[2], pms[3]};
    pg8::gemm_phase<EpiBf16LN, pg8::StaticOrder, false>((PG8_LAS unsigned char*)lds, g, S, E, nullptr);
    __syncthreads();
}
template <class Epi>
__device__ __forceinline__ void gemm_bf16_phase(unsigned char* lds, const bf16_t* A, const bf16_t* Bt, int M, int N, int K, const Epi& E, bool reverse_ids = false) {
    pg8::Gemm g{A, Bt, M, N, K};
    pg8::StaticOrder S; S.init(M, N, (int)gridDim.x, reverse_ids ? (int)(gridDim.x - 1 - blockIdx.x) : (int)blockIdx.x);
    pg8::gemm_phase<Epi, pg8::StaticOrder, false>((PG8_LAS unsigned char*)lds, g, S, E, nullptr);
    __syncthreads();
}

struct ColMap { int d0[3], s0[3], len[3]; };
__device__ __forceinline__ void convert_wt_phase(const float* __restrict__ W, int K, int N, int Npad, const ColMap cm, bf16_t* __restrict__ Wt, float* lds, const float* __restrict__ rowscale = nullptr) {
    float(*tile)[65] = (float(*)[65])lds;
    const int tid = tidx(), ntn = Npad / 64, ntiles = (K / 64) * ntn;
    for (int it = blockIdx.x; it < ntiles; it += gridDim.x) {
        const int k0 = (it / ntn) * 64, n0 = (it % ntn) * 64;
        __syncthreads();
#pragma unroll
        for (int h = 0; h < 2; ++h) {
            const int r = (tid >> 4) + h * 32, c4 = (tid & 15) * 4, nd = n0 + c4;
            int ns = -1;
#pragma unroll
            for (int sg = 0; sg < 3; ++sg) if (nd >= cm.d0[sg] && nd < cm.d0[sg] + cm.len[sg]) ns = cm.s0[sg] + (nd - cm.d0[sg]);
            float4 v = make_float4(0.f, 0.f, 0.f, 0.f);
            if (ns >= 0) v = *(const float4*)(W + (size_t)(k0 + r) * N + ns);
            if (rowscale) { const float gsc = rowscale[k0 + r]; v.x *= gsc; v.y *= gsc; v.z *= gsc; v.w *= gsc; }
            tile[r][c4] = v.x; tile[r][c4 + 1] = v.y; tile[r][c4 + 2] = v.z; tile[r][c4 + 3] = v.w;
        }
        __syncthreads();
        const int n = tid >> 3, k8 = (tid & 7) * 8;
        float o[8];
#pragma unroll
        for (int j = 0; j < 8; ++j) o[j] = tile[k8 + j][n];
        st8(Wt + (size_t)(n0 + n) * K + k0 + k8, o);
    }
    __syncthreads();
}
__device__ __forceinline__ float gelu_tanh(float x) {
    float u = 0.7978845608028654f * (x + 0.044715f * x * x * x);
    return 0.5f * x * (1.f + tanhf(u));
}
__device__ __forceinline__ float sigmoidf_(float x) { return 1.f / (1.f + expf(-x)); }
__device__ __forceinline__ void wave_lds_fence() { asm volatile("s_waitcnt lgkmcnt(0)" ::: "memory"); }

__device__ __forceinline__ void s5_scan_wave(int bg, const bf16_t* __restrict__ proj, const float* __restrict__ lam_re, const float* __restrict__ lam_im,
                             const float* __restrict__ log_dt, const float* __restrict__ b_re, const float* __restrict__ b_im,
                             const float* __restrict__ c_re, const float* __restrict__ c_im, const float* __restrict__ dskip,
                             float* __restrict__ ya, float* lds) {
    const int b = bg >> 4, g = bg & 15, lane = tidx() & 63;
    float(*us)[16] = (float(*)[16])lds;
    float(*xr)[65] = (float(*)[65])(lds + 1024);
    float(*xi)[65] = (float(*)[65])(lds + 1024 + 4160);
    float(*cr)[64] = (float(*)[64])(lds + 1024 + 8320);
    float(*ci)[64] = (float(*)[64])(lds + 1024 + 8320 + 1024);
    const float lr = lam_re[g * 64 + lane], li = lam_im[g * 64 + lane];
    const float dt = expf(log_dt[g]);
    const float mag = expf(lr * dt);
    const float are = mag * cosf(li * dt), aim = mag * sinf(li * dt);
    const float nr = are - 1.f, den = lr * lr + li * li;
    const float fre = (nr * lr + aim * li) / den, fim = (aim * lr - nr * li) / den;
    float bbr[16], bbi[16];
#pragma unroll
    for (int i = 0; i < 16; ++i) {
        const float br = b_re[(g * 64 + lane) * 16 + i], bi = b_im[(g * 64 + lane) * 16 + i];
        bbr[i] = fre * br - fim * bi; bbi[i] = fre * bi + fim * br;
    }
    for (int idx = lane; idx < 1024; idx += 64) { cr[idx >> 6][idx & 63] = c_re[g * 1024 + idx]; ci[idx >> 6][idx & 63] = c_im[g * 1024 + idx]; }
    float dsk[16];
#pragma unroll
    for (int i = 0; i < 16; ++i) dsk[i] = dskip[g * 16 + i];
    float xre = 0.f, xim = 0.f;
    for (int t0 = 0; t0 < NL; t0 += 64) {
        wave_lds_fence();
        for (int idx = lane; idx < 1024; idx += 64) { const int t = idx >> 4, i = idx & 15; us[t][i] = bf2f(proj[(size_t)(b * NL + t0 + t) * EVEN_IN + g * 16 + i]); }
        wave_lds_fence();
        for (int t = 0; t < 64; ++t) {
            float bur = 0.f, bui = 0.f;
#pragma unroll
            for (int i = 0; i < 16; ++i) { const float u = us[t][i]; bur += bbr[i] * u; bui += bbi[i] * u; }
            const float nre = are * xre - aim * xim + bur, nim = are * xim + aim * xre + bui;
            xre = nre; xim = nim;
            xr[t][lane] = xre; xi[t][lane] = xim;
        }
        wave_lds_fence();
        float y[16];
#pragma unroll
        for (int i = 0; i < 16; ++i) y[i] = 0.f;
        for (int p = 0; p < 64; ++p) {
            const float a = xr[lane][p], bq = xi[lane][p];
#pragma unroll
            for (int i = 0; i < 16; ++i) y[i] += cr[i][p] * a - ci[i][p] * bq;
        }
#pragma unroll
        for (int i = 0; i < 16; ++i) {
            const float v = y[i] + dsk[i] * us[lane][i];
            ya[(size_t)(b * NL + t0 + lane) * 256 + g * 16 + i] = gelu_tanh(v);
        }
    }
}

__device__ __forceinline__ void sb_attn_wave(int task, const bf16_t* __restrict__ proj, bf16_t* __restrict__ Y, float* wl) {
    const int qt = task & 31, h = (task >> 5) % 12, b = task / 384, lane = tidx() & 63;
    const int t = qt * 64 + lane;
    float(*ks)[64] = (float(*)[64])wl;
    float(*vs)[64] = (float(*)[64])(wl + 2048);
    const bf16_t* base = proj + (size_t)b * NL * EVEN_IN;
    float q[64], acc[64];
#pragma unroll
    for (int d = 0; d < 64; d += 8) ld8(base + (size_t)t * EVEN_IN + 256 + h * 64 + d, q + d);
#pragma unroll
    for (int d = 0; d < 64; ++d) acc[d] = 0.f;
    float tail = 0.f;
    for (int c = 2 * qt + 1; c >= 0; --c) {
        wave_lds_fence();
        for (int i = 0; i < 32; ++i) {
            ks[i][lane] = bf2f(base[(size_t)(c * 32 + i) * EVEN_IN + 1024 + h * 64 + lane]);
            vs[i][lane] = bf2f(base[(size_t)(c * 32 + i) * EVEN_IN + 1792 + h * 64 + lane]);
        }
        wave_lds_fence();
        for (int s = 31; s >= 0; --s) {
            const int key = c * 32 + s;
            float z = 0.f;
#pragma unroll
            for (int d = 0; d < 64; ++d) z += q[d] * ks[s][d];
            z *= 0.125f;
            const bool valid = key < t;
            const float sp = fmaxf(z, 0.f) + log1pf(expf(-fabsf(z)));
            const float w = valid ? expf(z - sp + tail) : 0.f;
#pragma unroll
            for (int d = 0; d < 64; ++d) acc[d] += w * vs[s][d];
            if (valid) tail -= sp;
        }
        if (__all(tail < -120.f)) break;
    }
#pragma unroll
    for (int d = 0; d < 64; d += 8) st8(Y + (size_t)(b * NL + t) * ND + 256 + h * 64 + d, acc + d);
}

__device__ __forceinline__ void glu_phase(const float* __restrict__ ya, const float* __restrict__ wglu, const float* __restrict__ bglu, bf16_t* __restrict__ Y, float* lds) {
    const int half = tidx() >> 8, c = tidx() & 255;
    float(*ys)[256] = (float(*)[256])(lds + half * 4096);
    for (int it = blockIdx.x; it < NT / 32; it += gridDim.x) {
        const int t0 = it * 32 + half * 16;
        __syncthreads();
        for (int i = 0; i < 16; ++i) ys[i][c] = ya[(size_t)(t0 + i) * 256 + c];
        __syncthreads();
        float acc[16];
#pragma unroll
        for (int i = 0; i < 16; ++i) acc[i] = 0.f;
        for (int k = 0; k < 256; ++k) {
            const float w = wglu[k * 256 + c];
#pragma unroll
            for (int i = 0; i < 16; ++i) acc[i] += ys[i][k] * w;
        }
        const float bb = bglu[c];
#pragma unroll
        for (int i = 0; i < 16; ++i) Y[(size_t)(t0 + i) * ND + c] = f2bf(ys[i][c] * sigmoidf_(acc[i] + bb));
    }
    __syncthreads();
}

__device__ __forceinline__ void ln_row_wave(float4 (&v)[4], const float* __restrict__ g, const float* __restrict__ bta, float* out, bf16_t* outb, int lane) {
    float s = 0.f;
#pragma unroll
    for (int j = 0; j < 4; ++j) s += v[j].x + v[j].y + v[j].z + v[j].w;
    for (int o = 32; o; o >>= 1) s += __shfl_xor(s, o);
    const float mean = s * (1.f / ND);
    float s2 = 0.f;
#pragma unroll
    for (int j = 0; j < 4; ++j) {
        v[j].x -= mean; v[j].y -= mean; v[j].z -= mean; v[j].w -= mean;
        s2 += v[j].x * v[j].x + v[j].y * v[j].y + v[j].z * v[j].z + v[j].w * v[j].w;
    }
    for (int o = 32; o; o >>= 1) s2 += __shfl_xor(s2, o);
    const float rs = rsqrtf(s2 * (1.f / ND) + LN_EPS);
#pragma unroll
    for (int j = 0; j < 4; ++j) {
        const float4 gg = *(const float4*)(g + j * 256 + lane * 4), bb = *(const float4*)(bta + j * 256 + lane * 4);
        const float4 o = make_float4(v[j].x * rs * gg.x + bb.x, v[j].y * rs * gg.y + bb.y, v[j].z * rs * gg.z + bb.z, v[j].w * rs * gg.w + bb.w);
        *(float4*)(out + j * 256 + lane * 4) = o;
        if (outb) { uint2 w; w.x = pack2(o.x, o.y); w.y = pack2(o.z, o.w); *(uint2*)(outb + j * 256 + lane * 4) = w; }
    }
}
__device__ __forceinline__ void ln_phase(float* R, bf16_t* Hb, const float* __restrict__ g, const float* __restrict__ bta) {
    const int wave = tidx() >> 6, lane = tidx() & 63;
    for (int row = blockIdx.x * 8 + wave; row < NT; row += gridDim.x * 8) {
        float4 v[4];
#pragma unroll
        for (int j = 0; j < 4; ++j) v[j] = *(const float4*)(R + (size_t)row * ND + j * 256 + lane * 4);
        ln_row_wave(v, g, bta, R + (size_t)row * ND, Hb + (size_t)row * ND, lane);
    }
}

__device__ __forceinline__ void wave_argmax(float& bv, int& bi) {
#pragma unroll
    for (int o = 32; o; o >>= 1) {
        const float ov = __shfl_xor(bv, o); const int oi = __shfl_xor(bi, o);
        if (ov > bv || (ov == bv && oi < bi)) { bv = ov; bi = oi; }
    }
}
__device__ __forceinline__ void peer_route_phase(const bf16_t* __restrict__ qbuf, const float* __restrict__ subk, int* __restrict__ eidx, float* __restrict__ egate, float* lds) {
    const int head = tidx() >> 6, lane = tidx() & 63;
    float* qs = lds + head * 256;
    for (int token = blockIdx.x; token < NT; token += gridDim.x) {
        const bf16_t* qp = qbuf + (size_t)token * 2048 + head * 256;
        wave_lds_fence();
        for (int i = 0; i < 4; ++i) qs[lane + 64 * i] = bf2f(qp[lane + 64 * i]);
        wave_lds_fence();
        float myv[2]; int myi[2];
#pragma unroll
        for (int c = 0; c < 2; ++c) {
            float sc[2];
#pragma unroll
            for (int w2 = 0; w2 < 2; ++w2) {
                const float* kr = subk + ((size_t)(head * 2 + c) * 128 + lane + 64 * w2) * 128;
                float a = 0.f;
#pragma unroll 4
                for (int d = 0; d < 128; d += 4) {
                    const float4 kv = *(const float4*)(kr + d);
                    a += qs[c * 128 + d] * kv.x + qs[c * 128 + d + 1] * kv.y + qs[c * 128 + d + 2] * kv.z + qs[c * 128 + d + 3] * kv.w;
                }
                sc[w2] = a;
            }
            float a0 = sc[0], a1 = sc[1];
            float mv = -INFINITY; int mi = 0;
            for (int r = 0; r < 16; ++r) {
                float bv; int bi;
                if (a0 >= a1) { bv = a0; bi = lane; } else { bv = a1; bi = lane + 64; }
                wave_argmax(bv, bi);
                if (lane == r) { mv = bv; mi = bi; }
                if (bi == lane) a0 = -INFINITY; else if (bi == lane + 64) a1 = -INFINITY;
            }
            myv[c] = mv; myi[c] = mi;
        }
        const float va = __shfl(myv[0], lane >> 2);
        float cand[4];
#pragma unroll
        for (int j = 0; j < 4; ++j) cand[j] = va + __shfl(myv[1], (lane & 3) * 4 + j);
        float topv = -INFINITY; int topf = 0;
        for (int r = 0; r < 16; ++r) {
            float bv = cand[0]; int bi = lane * 4;
#pragma unroll
            for (int j = 1; j < 4; ++j) if (cand[j] > bv) { bv = cand[j]; bi = lane * 4 + j; }
            wave_argmax(bv, bi);
            if (lane == r) { topv = bv; topf = bi; }
#pragma unroll
            for (int j = 0; j < 4; ++j) if (bi == lane * 4 + j) cand[j] = -INFINITY;
        }
        const int e1 = __shfl(myi[0], topf >> 4), e2 = __shfl(myi[1], topf & 15);
        const float top0 = __shfl(topv, 0);
        float ex = (lane < 16) ? expf(topv - top0) : 0.f;
        float sum = ex;
        for (int o = 32; o; o >>= 1) sum += __shfl_xor(sum, o);
        if (lane < 16) {
            eidx[(size_t)token * 128 + head * 16 + lane] = e1 * 128 + e2;
            egate[(size_t)token * 128 + head * 16 + lane] = ex / sum;
        }
    }
}

__device__ __forceinline__ void peer_expert_phase(float* R, const int* __restrict__ eidx, const float* __restrict__ egate, const float* __restrict__ utab,
                                  const float* __restrict__ vtab, const float* __restrict__ lg, const float* __restrict__ lb, bf16_t* Hb) {
    const int wave = tidx() >> 6, lane = tidx() & 63;
    for (int token = blockIdx.x * 8 + wave; token < NT; token += gridDim.x * 8) {
        float4 x[4], acc[4];
#pragma unroll
        for (int j = 0; j < 4; ++j) { x[j] = *(const float4*)(R + (size_t)token * ND + j * 256 + lane * 4); acc[j] = make_float4(0.f, 0.f, 0.f, 0.f); }
        for (int e0 = 0; e0 < 128; e0 += 4) {
            float dot[4]; int ex[4]; float gt[4];
#pragma unroll
            for (int k = 0; k < 4; ++k) {
                ex[k] = eidx[(size_t)token * 128 + e0 + k]; gt[k] = egate[(size_t)token * 128 + e0 + k];
                const float* ur = utab + (size_t)ex[k] * ND + lane * 4;
                float a = 0.f;
#pragma unroll
                for (int j = 0; j < 4; ++j) { const float4 u = *(const float4*)(ur + j * 256); a += x[j].x * u.x + x[j].y * u.y + x[j].z * u.z + x[j].w * u.w; }
                dot[k] = a;
            }
#pragma unroll
            for (int k = 0; k < 4; ++k) {
                float a = dot[k];
                for (int o = 32; o; o >>= 1) a += __shfl_xor(a, o);
                const float coef = gt[k] * gelu_tanh(a);
                const float* vr = vtab + (size_t)ex[k] * ND + lane * 4;
#pragma unroll
                for (int j = 0; j < 4; ++j) { const float4 v = *(const float4*)(vr + j * 256); acc[j].x += coef * v.x; acc[j].y += coef * v.y; acc[j].z += coef * v.z; acc[j].w += coef * v.w; }
            }
        }
#pragma unroll
        for (int j = 0; j < 4; ++j) { x[j].x = ALPHA * x[j].x + acc[j].x; x[j].y = ALPHA * x[j].y + acc[j].y; x[j].z = ALPHA * x[j].z + acc[j].z; x[j].w = ALPHA * x[j].w + acc[j].w; }
        ln_row_wave(x, lg, lb, R + (size_t)token * ND, Hb ? Hb + (size_t)token * ND : nullptr, lane);
    }
}


typedef short bf16x8_t __attribute__((ext_vector_type(8)));
__device__ __forceinline__ int f2key(float f) { const int b = __float_as_int(f); return b ^ ((b >> 31) & 0x7fffffff); }
__device__ __forceinline__ float key2f(int k) { return __int_as_float(k ^ ((k >> 31) & 0x7fffffff)); }
#define CE_DESC_I(a, b) do { const int _hi = max(a, b), _lo = min(a, b); a = _hi; b = _lo; } while (0)
template <int N, int K, int J> __device__ __forceinline__ void bstage(int (&v)[N]) {
#pragma unroll
    for (int i = 0; i < N; ++i) {
        const int l = i ^ J;
        if (l > i) { if ((i & K) == 0) CE_DESC_I(v[i], v[l]); else CE_DESC_I(v[l], v[i]); }
    }
}
__device__ __forceinline__ void sort16_desc(int (&v)[16]) {
    bstage<16, 2, 1>(v); bstage<16, 4, 2>(v); bstage<16, 4, 1>(v); bstage<16, 8, 4>(v); bstage<16, 8, 2>(v); bstage<16, 8, 1>(v);
    bstage<16, 16, 8>(v); bstage<16, 16, 4>(v); bstage<16, 16, 2>(v); bstage<16, 16, 1>(v);
}
__device__ __forceinline__ void sort8_desc(int (&v)[8]) {
    bstage<8, 2, 1>(v); bstage<8, 4, 2>(v); bstage<8, 4, 1>(v); bstage<8, 8, 4>(v); bstage<8, 8, 2>(v); bstage<8, 8, 1>(v);
}
__device__ __forceinline__ void bitonic_merge16_desc(int (&v)[16]) {
    bstage<16, 16, 8>(v); bstage<16, 16, 4>(v); bstage<16, 16, 2>(v); bstage<16, 16, 1>(v);
}
__device__ __forceinline__ void xmerge16(int (&v)[16], int off) {
    int m[16];
#pragma unroll
    for (int i = 0; i < 16; ++i) m[i] = max(v[i], __shfl_xor(v[15 - i], off));
    bitonic_merge16_desc(m);
#pragma unroll
    for (int i = 0; i < 16; ++i) v[i] = m[i];
}
__device__ __forceinline__ void opaque16(int (&v)[16]) {
#pragma unroll
    for (int i = 0; i < 16; ++i) asm volatile("" : "+v"(v[i]));
}
__device__ __forceinline__ int lookup16(const int (&arr)[16], int a) {
    int r = arr[0];
#pragma unroll
    for (int i = 1; i < 16; ++i) r = (a == i) ? arr[i] : r;
    return r;
}
__device__ __forceinline__ void peer_route2_phase(const bf16_t* __restrict__ qbuf, const bf16_t* __restrict__ skb, int* __restrict__ eidx, float* __restrict__ egate, unsigned char* lds) {
    const int tid = tidx(), wave = tid >> 6, lane = tid & 63, fr = lane & 15, fq = lane >> 4;
    for (int chunk = blockIdx.x; chunk < NT / 128; chunk += gridDim.x) {
        const int token = chunk * 128 + wave * 16 + fr;
        int* tl = (int*)(lds + 34816) + (wave * 16 + fr) * 48;
        for (int h = 0; h < 8; ++h) {
            int K1[16], K2[16];
#pragma unroll
            for (int c = 0; c < 2; ++c) {
                __syncthreads();
#pragma unroll
                for (int i = 0; i < 4; ++i) {
                    const int idx = tid + 512 * i, row = idx >> 4, ch = idx & 15;
                    *(uint4*)(lds + row * 272 + ch * 16) = *(const uint4*)(skb + ((size_t)(h * 2 + c) * 128 + row) * 128 + ch * 8);
                }
                __syncthreads();
                bf16x8_t qf[4];
#pragma unroll
                for (int sI = 0; sI < 4; ++sI) qf[sI] = *(const bf16x8_t*)(qbuf + (size_t)token * 2048 + h * 256 + c * 128 + 32 * sI + 8 * fq);
                int va[16], vb[16];
#pragma unroll
                for (int n = 0; n < 8; ++n) {
                    f32x4 S = {0.f, 0.f, 0.f, 0.f};
#pragma unroll
                    for (int sI = 0; sI < 4; ++sI) {
                        const bf16x8_t kf = *(const bf16x8_t*)(lds + (16 * n + fr) * 272 + (32 * sI + 8 * fq) * 2);
                        S = __builtin_amdgcn_mfma_f32_16x16x32_bf16(kf, qf[sI], S, 0, 0, 0);
                    }
#pragma unroll
                    for (int j = 0; j < 4; ++j) {
                        const int key = (f2key(S[j]) & ~127) | (16 * n + 4 * fq + j);
                        if (n < 4) va[n * 4 + j] = key; else vb[(n - 4) * 4 + j] = key;
                    }
                }
                sort16_desc(va); sort16_desc(vb);
                int m[16];
#pragma unroll
                for (int i = 0; i < 16; ++i) m[i] = max(va[i], vb[15 - i]);
                bitonic_merge16_desc(m);
                xmerge16(m, 16); xmerge16(m, 32);
#pragma unroll
                for (int i = 0; i < 16; ++i) { if (c == 0) K1[i] = m[i]; else K2[i] = m[i]; }
                if (fq == 0) {
#pragma unroll
                    for (int i = 0; i < 4; ++i) *(int4*)(tl + c * 16 + 4 * i) = make_int4(m[4 * i], m[4 * i + 1], m[4 * i + 2], m[4 * i + 3]);
                }
            }
            wave_lds_fence();
            float vaf[4];
#pragma unroll
            for (int k = 0; k < 4; ++k) vaf[k] = key2f(tl[4 * k + fq]);
            int A[16];
#pragma unroll
            for (int b = 0; b < 16; ++b) {
                const bool valid = (fq + 1) * (b + 1) <= 16;
                const int key = (f2key(vaf[0] + key2f(K2[b])) & ~127) | (fq << 5) | b;
                A[b] = valid ? key : INT_MIN;
            }
            int Bq[8];
#pragma unroll
            for (int b = 0; b < 3; ++b) {
                const bool valid = (fq + 5) * (b + 1) <= 16;
                const int key = (f2key(vaf[1] + key2f(K2[b])) & ~127) | (fq << 5) | (16 + b);
                Bq[b] = valid ? key : INT_MIN;
            }
            Bq[3] = (f2key(vaf[2] + key2f(K2[0])) & ~127) | (fq << 5) | 19;
            Bq[4] = (f2key(vaf[3] + key2f(K2[0])) & ~127) | (fq << 5) | 20;
            Bq[5] = INT_MIN; Bq[6] = INT_MIN; Bq[7] = INT_MIN;
            sort8_desc(Bq);
#pragma unroll
            for (int i = 8; i < 16; ++i) A[i] = max(A[i], Bq[15 - i]);
            bitonic_merge16_desc(A);
            xmerge16(A, 16); xmerge16(A, 32);
            if (fq == 0) {
#pragma unroll
                for (int i = 0; i < 4; ++i) *(int4*)(tl + 32 + 4 * i) = make_int4(A[4 * i], A[4 * i + 1], A[4 * i + 2], A[4 * i + 3]);
            }
            wave_lds_fence();
            const int4 myT = *(const int4*)(tl + 32 + 4 * fq);
            const int tsel[4] = {myT.x, myT.y, myT.z, myT.w};
            const float top0 = key2f(A[0]);
            float sum = 0.f;
#pragma unroll
            for (int r = 0; r < 16; ++r) sum += __expf(key2f(A[r]) - top0);
            const float inv = 1.f / sum;
            int eo[4]; float go[4];
#pragma unroll
            for (int kk = 0; kk < 4; ++kk) {
                const int t = tsel[kk];
                const int id = t & 127, ofq = id >> 5, slot = id & 31;
                const int k = slot < 16 ? 0 : (slot < 19 ? 1 : (slot == 19 ? 2 : 3));
                const int b = slot < 16 ? slot : (slot < 19 ? slot - 16 : 0);
                const int a = ofq + 4 * k;
                const int e1 = tl[a] & 127, e2 = tl[16 + b] & 127;
                eo[kk] = e1 * 128 + e2;
                go[kk] = __expf(key2f(t) - top0) * inv;
            }
            *(int4*)(eidx + (size_t)token * 128 + h * 16 + 4 * fq) = make_int4(eo[0], eo[1], eo[2], eo[3]);
            *(float4*)(egate + (size_t)token * 128 + h * 16 + 4 * fq) = make_float4(go[0], go[1], go[2], go[3]);
            wave_lds_fence();
        }
    }
    __syncthreads();
}

typedef __bf16 bf16x2_t __attribute__((ext_vector_type(2)));
typedef float f32x2_t __attribute__((ext_vector_type(2)));
__device__ __forceinline__ float dot2bf(unsigned a, unsigned b, float acc) { return __builtin_amdgcn_fdot2_f32_bf16(__builtin_bit_cast(bf16x2_t, a), __builtin_bit_cast(bf16x2_t, b), acc, false); }
__device__ __forceinline__ float gelu_fast(float x) {
    const float u = 0.7978845608028654f * (x + 0.044715f * x * x * x);
    return x / (1.f + __expf(-2.f * u));
}
__device__ __forceinline__ void peer_expert2_phase(float* R, const int* __restrict__ eidx, const float* __restrict__ egate, const bf16_t* __restrict__ ub,
                                                   const bf16_t* __restrict__ vb, const float* __restrict__ lg, const float* __restrict__ lb, bf16_t* Hb) {
    const int wave = tidx() >> 6, lane = tidx() & 63;
    for (int token = blockIdx.x * 8 + wave; token < NT; token += gridDim.x * 8) {
        float xf[16];
        {
            const float* rp = R + (size_t)token * ND + lane * 8;
            const float4 a0 = *(const float4*)rp, a1 = *(const float4*)(rp + 4), b0 = *(const float4*)(rp + 512), b1 = *(const float4*)(rp + 516);
            xf[0] = a0.x; xf[1] = a0.y; xf[2] = a0.z; xf[3] = a0.w; xf[4] = a1.x; xf[5] = a1.y; xf[6] = a1.z; xf[7] = a1.w;
            xf[8] = b0.x; xf[9] = b0.y; xf[10] = b0.z; xf[11] = b0.w; xf[12] = b1.x; xf[13] = b1.y; xf[14] = b1.z; xf[15] = b1.w;
        }
        unsigned xp[8];
#pragma unroll
        for (int j = 0; j < 8; ++j) xp[j] = pack2(xf[2 * j], xf[2 * j + 1]);
        float acc[16];
#pragma unroll
        for (int j = 0; j < 16; ++j) acc[j] = 0.f;
        const int e_lo = eidx[(size_t)token * 128 + lane], e_hi = eidx[(size_t)token * 128 + 64 + lane];
        const float g_lo = egate[(size_t)token * 128 + lane], g_hi = egate[(size_t)token * 128 + 64 + lane];
        for (int grp = 0; grp < 16; ++grp) {
            const int esel = grp < 8 ? e_lo : e_hi;
            const float gsel = grp < 8 ? g_lo : g_hi;
            const int lbase = (grp & 7) * 8;
            uint4 u0[8], u1[8];
            int exs[8];
#pragma unroll
            for (int k = 0; k < 8; ++k) {
                exs[k] = __builtin_amdgcn_readlane(esel, lbase + k);
                const bf16_t* up = ub + (size_t)exs[k] * ND + lane * 8;
                u0[k] = *(const uint4*)up; u1[k] = *(const uint4*)(up + 512);
            }
            float d[8];
#pragma unroll
            for (int k = 0; k < 8; ++k) {
                float a = dot2bf(u0[k].x, xp[0], 0.f), b = dot2bf(u0[k].y, xp[1], 0.f);
                a = dot2bf(u0[k].z, xp[2], a); b = dot2bf(u0[k].w, xp[3], b);
                a = dot2bf(u1[k].x, xp[4], a); b = dot2bf(u1[k].y, xp[5], b);
                a = dot2bf(u1[k].z, xp[6], a); b = dot2bf(u1[k].w, xp[7], b);
                d[k] = a + b;
            }
            const bool hi5 = lane & 32, hi4 = lane & 16, hi3 = lane & 8;
            float r4[4], r2[2], r1;
#pragma unroll
            for (int k = 0; k < 4; ++k) { const float send = hi5 ? d[k] : d[k + 4], keep = hi5 ? d[k + 4] : d[k]; r4[k] = keep + __shfl_xor(send, 32); }
#pragma unroll
            for (int k = 0; k < 2; ++k) { const float send = hi4 ? r4[k] : r4[k + 2], keep = hi4 ? r4[k + 2] : r4[k]; r2[k] = keep + __shfl_xor(send, 16); }
            { const float send = hi3 ? r2[0] : r2[1], keep = hi3 ? r2[1] : r2[0]; r1 = keep + __shfl_xor(send, 8); }
            r1 += __shfl_xor(r1, 4); r1 += __shfl_xor(r1, 2); r1 += __shfl_xor(r1, 1);
            uint4 v0[8], v1[8];
#pragma unroll
            for (int k = 0; k < 8; ++k) {
                const bf16_t* vp = vb + (size_t)exs[k] * ND + lane * 8;
                v0[k] = *(const uint4*)vp; v1[k] = *(const uint4*)(vp + 512);
            }
            const float gk = __shfl(gsel, lbase + (lane >> 3));
            const float coef = gk * gelu_fast(r1);
#pragma unroll
            for (int k = 0; k < 8; ++k) {
                const float ck = __int_as_float(__builtin_amdgcn_readlane(__float_as_int(coef), 8 * k));
                const unsigned w[8] = {v0[k].x, v0[k].y, v0[k].z, v0[k].w, v1[k].x, v1[k].y, v1[k].z, v1[k].w};
#pragma unroll
                for (int j = 0; j < 8; ++j) {
                    acc[2 * j] += ck * __uint_as_float(w[j] << 16);
                    acc[2 * j + 1] += ck * __uint_as_float(w[j] & 0xffff0000u);
                }
            }
        }
        {
            const float* rp = R + (size_t)token * ND + lane * 8;
            const float4 a0 = *(const float4*)rp, a1 = *(const float4*)(rp + 4), b0 = *(const float4*)(rp + 512), b1 = *(const float4*)(rp + 516);
            xf[0] = a0.x; xf[1] = a0.y; xf[2] = a0.z; xf[3] = a0.w; xf[4] = a1.x; xf[5] = a1.y; xf[6] = a1.z; xf[7] = a1.w;
            xf[8] = b0.x; xf[9] = b0.y; xf[10] = b0.z; xf[11] = b0.w; xf[12] = b1.x; xf[13] = b1.y; xf[14] = b1.z; xf[15] = b1.w;
        }
        float s = 0.f;
#pragma unroll
        for (int j = 0; j < 16; ++j) { xf[j] = ALPHA * xf[j] + acc[j]; s += xf[j]; }
        for (int o = 32; o; o >>= 1) s += __shfl_xor(s, o);
        const float mean = s * (1.f / ND);
        float s2 = 0.f;
#pragma unroll
        for (int j = 0; j < 16; ++j) { xf[j] -= mean; s2 += xf[j] * xf[j]; }
        for (int o = 32; o; o >>= 1) s2 += __shfl_xor(s2, o);
        const float rs = rsqrtf(s2 * (1.f / ND) + LN_EPS);
#pragma unroll
        for (int hf = 0; hf < 2; ++hf) {
            const int c0 = hf * 512 + lane * 8;
            const float4 g0 = *(const float4*)(lg + c0), g1 = *(const float4*)(lg + c0 + 4), b0 = *(const float4*)(lb + c0), b1 = *(const float4*)(lb + c0 + 4);
            float o[8];
            o[0] = xf[hf * 8 + 0] * rs * g0.x + b0.x; o[1] = xf[hf * 8 + 1] * rs * g0.y + b0.y; o[2] = xf[hf * 8 + 2] * rs * g0.z + b0.z; o[3] = xf[hf * 8 + 3] * rs * g0.w + b0.w;
            o[4] = xf[hf * 8 + 4] * rs * g1.x + b1.x; o[5] = xf[hf * 8 + 5] * rs * g1.y + b1.y; o[6] = xf[hf * 8 + 6] * rs * g1.z + b1.z; o[7] = xf[hf * 8 + 7] * rs * g1.w + b1.w;
            float* op = R + (size_t)token * ND + c0;
            *(float4*)op = make_float4(o[0], o[1], o[2], o[3]); *(float4*)(op + 4) = make_float4(o[4], o[5], o[6], o[7]);
            if (Hb) st8(Hb + (size_t)token * ND + c0, o);
        }
    }
}


template <int K2, int J> __device__ __forceinline__ void bsort_round(int (&k)[2], float (&g)[2], int lane) {
    if (J == 64) {
        const bool sw = k[0] > k[1];
        const int t = k[0]; const float tg = g[0];
        k[0] = sw ? k[1] : k[0]; g[0] = sw ? g[1] : g[0]; k[1] = sw ? t : k[1]; g[1] = sw ? tg : g[1];
    } else {
#pragma unroll
        for (int r = 0; r < 2; ++r) {
            const int pk = __shfl_xor(k[r], J); const float pg = __shfl_xor(g[r], J);
            const bool asc = (((lane + 64 * r) & K2) == 0), lower = ((lane & J) == 0);
            const bool take = (lower == asc) ? (pk < k[r]) : (pk > k[r]);
            k[r] = take ? pk : k[r]; g[r] = take ? pg : g[r];
        }
    }
}
template <int K2> __device__ __forceinline__ void bsort_stage(int (&k)[2], float (&g)[2], int lane) {
    if (K2 >= 128) bsort_round<K2, 64>(k, g, lane);
    if (K2 >= 64) bsort_round<K2, 32>(k, g, lane);
    if (K2 >= 32) bsort_round<K2, 16>(k, g, lane);
    if (K2 >= 16) bsort_round<K2, 8>(k, g, lane);
    if (K2 >= 8) bsort_round<K2, 4>(k, g, lane);
    if (K2 >= 4) bsort_round<K2, 2>(k, g, lane);
    bsort_round<K2, 1>(k, g, lane);
}
__device__ __forceinline__ void sort_routing(int& e_lo, int& e_hi, float& g_lo, float& g_hi, int lane) {
    int k[2] = {e_lo, e_hi}; float g[2] = {g_lo, g_hi};
    bsort_stage<2>(k, g, lane); bsort_stage<4>(k, g, lane); bsort_stage<8>(k, g, lane); bsort_stage<16>(k, g, lane);
    bsort_stage<32>(k, g, lane); bsort_stage<64>(k, g, lane); bsort_stage<128>(k, g, lane);
    e_lo = k[0]; e_hi = k[1]; g_lo = g[0]; g_hi = g[1];
}
__device__ __forceinline__ void peer_expert3_phase(float* R, const int* __restrict__ eidx, const float* __restrict__ egate, const unsigned char* __restrict__ ub,
                                                   const unsigned char* __restrict__ vb, const float* __restrict__ lg, const float* __restrict__ lb, bf16_t* Hb, float* Rout, const XcdBarrier& xb) {
    const int wave = tidx() >> 6, lane = tidx() & 63;
    int itk = 0;
    for (int token = blockIdx.x * 8 + wave; token < NT; token += gridDim.x * 8, ++itk) {
        if ((itk & 1) == 0 && itk) xcd_barrier(xb);
        float xf[16];
        {
            const float* rp = R + (size_t)token * ND + lane * 16;
#pragma unroll
            for (int q = 0; q < 4; ++q) { const float4 a = *(const float4*)(rp + 4 * q); xf[4 * q] = a.x; xf[4 * q + 1] = a.y; xf[4 * q + 2] = a.z; xf[4 * q + 3] = a.w; }
        }
        float acc[16];
#pragma unroll
        for (int j = 0; j < 16; ++j) acc[j] = 0.f;
        int e_lo = eidx[(size_t)token * 128 + lane], e_hi = eidx[(size_t)token * 128 + 64 + lane];
        float g_lo = egate[(size_t)token * 128 + lane], g_hi = egate[(size_t)token * 128 + 64 + lane];
        sort_routing(e_lo, e_hi, g_lo, g_hi, lane);
        for (int grp = 0; grp < 16; ++grp) {
            const int esel = grp < 8 ? e_lo : e_hi;
            const float gsel = grp < 8 ? g_lo : g_hi;
            const int lbase = (grp & 7) * 8;
            uint4 u[8], v[8];
#pragma unroll
            for (int k = 0; k < 8; ++k) {
                const int ex = __builtin_amdgcn_readlane(esel, lbase + k);
                u[k] = *(const uint4*)(ub + (size_t)ex * ND + lane * 16);
                v[k] = *(const uint4*)(vb + (size_t)ex * ND + lane * 16);
            }
            float d[8];
#pragma unroll
            for (int k = 0; k < 8; ++k) {
                const unsigned w[4] = {u[k].x, u[k].y, u[k].z, u[k].w};
                float a = 0.f, b = 0.f;
#pragma unroll
                for (int q = 0; q < 4; ++q) {
                    const f32x2_t lo = __builtin_amdgcn_cvt_pk_f32_fp8((int)w[q], false), hi = __builtin_amdgcn_cvt_pk_f32_fp8((int)w[q], true);
                    a = fmaf(xf[4 * q], lo.x, a); b = fmaf(xf[4 * q + 1], lo.y, b); a = fmaf(xf[4 * q + 2], hi.x, a); b = fmaf(xf[4 * q + 3], hi.y, b);
                }
                d[k] = a + b;
            }
            const bool hi5 = lane & 32, hi4 = lane & 16, hi3 = lane & 8;
            float r4[4], r2[2], r1;
#pragma unroll
            for (int k = 0; k < 4; ++k) { const float send = hi5 ? d[k] : d[k + 4], keep = hi5 ? d[k + 4] : d[k]; r4[k] = keep + __shfl_xor(send, 32); }
#pragma unroll
            for (int k = 0; k < 2; ++k) { const float send = hi4 ? r4[k] : r4[k + 2], keep = hi4 ? r4[k + 2] : r4[k]; r2[k] = keep + __shfl_xor(send, 16); }
            { const float send = hi3 ? r2[0] : r2[1], keep = hi3 ? r2[1] : r2[0]; r1 = keep + __shfl_xor(send, 8); }
            r1 += __shfl_xor(r1, 4); r1 += __shfl_xor(r1, 2); r1 += __shfl_xor(r1, 1);
            const float gk = __shfl(gsel, lbase + (lane >> 3));
            const float coef = gk * gelu_fast(r1 * (1.f / U_SCALE)) * (1.f / V_SCALE);
#pragma unroll
            for (int k = 0; k < 8; ++k) {
                const float ck = __int_as_float(__builtin_amdgcn_readlane(__float_as_int(coef), 8 * k));
                const unsigned w[4] = {v[k].x, v[k].y, v[k].z, v[k].w};
#pragma unroll
                for (int q = 0; q < 4; ++q) {
                    const f32x2_t lo = __builtin_amdgcn_cvt_pk_f32_fp8((int)w[q], false), hi = __builtin_amdgcn_cvt_pk_f32_fp8((int)w[q], true);
                    acc[4 * q] = fmaf(ck, lo.x, acc[4 * q]); acc[4 * q + 1] = fmaf(ck, lo.y, acc[4 * q + 1]);
                    acc[4 * q + 2] = fmaf(ck, hi.x, acc[4 * q + 2]); acc[4 * q + 3] = fmaf(ck, hi.y, acc[4 * q + 3]);
                }
            }
        }
        float s = 0.f;
#pragma unroll
        for (int j = 0; j < 16; ++j) { xf[j] = ALPHA * xf[j] + acc[j]; s += xf[j]; }
        for (int o = 32; o; o >>= 1) s += __shfl_xor(s, o);
        const float mean = s * (1.f / ND);
        float s2 = 0.f;
#pragma unroll
        for (int j = 0; j < 16; ++j) { xf[j] -= mean; s2 += xf[j] * xf[j]; }
        for (int o = 32; o; o >>= 1) s2 += __shfl_xor(s2, o);
        const float rs = rsqrtf(s2 * (1.f / ND) + LN_EPS);
        float o[16];
#pragma unroll
        for (int q = 0; q < 4; ++q) {
            const float4 gg = *(const float4*)(lg + lane * 16 + 4 * q), bb = *(const float4*)(lb + lane * 16 + 4 * q);
            o[4 * q] = xf[4 * q] * rs * gg.x + bb.x; o[4 * q + 1] = xf[4 * q + 1] * rs * gg.y + bb.y; o[4 * q + 2] = xf[4 * q + 2] * rs * gg.z + bb.z; o[4 * q + 3] = xf[4 * q + 3] * rs * gg.w + bb.w;
            *(float4*)(Rout + (size_t)token * ND + lane * 16 + 4 * q) = make_float4(o[4 * q], o[4 * q + 1], o[4 * q + 2], o[4 * q + 3]);
        }
        if (Hb) { st8(Hb + (size_t)token * ND + lane * 16, o); st8(Hb + (size_t)token * ND + lane * 16 + 8, o + 8); }
    }
}


struct Rows8 { uint4 r[8]; };
__device__ __forceinline__ void rows_load(Rows8& G, int esel, int lbase, const unsigned char* __restrict__ tb, int lane) {
#pragma unroll
    for (int k = 0; k < 8; ++k) {
        const int ex = __builtin_amdgcn_readlane(esel, lbase + k);
        G.r[k] = *(const uint4*)(tb + (size_t)ex * ND + lane * 16);
    }
}
__device__ __forceinline__ void sweep_u(const Rows8& G, const float (&xf)[16], float gsel, int lbase, int lane, float* cl  , int grp) {
    float d[8];
#pragma unroll
    for (int k = 0; k < 8; ++k) {
        const unsigned w[4] = {G.r[k].x, G.r[k].y, G.r[k].z, G.r[k].w};
        float a = 0.f, b = 0.f;
#pragma unroll
        for (int q = 0; q < 4; ++q) {
            const f32x2_t lo = __builtin_amdgcn_cvt_pk_f32_fp8((int)w[q], false), hi = __builtin_amdgcn_cvt_pk_f32_fp8((int)w[q], true);
            a = fmaf(xf[4 * q], lo.x, a); b = fmaf(xf[4 * q + 1], lo.y, b); a = fmaf(xf[4 * q + 2], hi.x, a); b = fmaf(xf[4 * q + 3], hi.y, b);
        }
        d[k] = a + b;
    }
    const bool hi5 = lane & 32, hi4 = lane & 16, hi3 = lane & 8;
    float r4[4], r2[2], r1;
#pragma unroll
    for (int k = 0; k < 4; ++k) { const float send = hi5 ? d[k] : d[k + 4], keep = hi5 ? d[k + 4] : d[k]; r4[k] = keep + __shfl_xor(send, 32); }
#pragma unroll
    for (int k = 0; k < 2; ++k) { const float send = hi4 ? r4[k] : r4[k + 2], keep = hi4 ? r4[k + 2] : r4[k]; r2[k] = keep + __shfl_xor(send, 16); }
    { const float send = hi3 ? r2[0] : r2[1], keep = hi3 ? r2[1] : r2[0]; r1 = keep + __shfl_xor(send, 8); }
    r1 += __shfl_xor(r1, 4); r1 += __shfl_xor(r1, 2); r1 += __shfl_xor(r1, 1);
    const float gk = __shfl(gsel, lbase + (lane >> 3));
    const float coef = gk * gelu_fast(r1 * (1.f / U_SCALE)) * (1.f / V_SCALE);
    if ((lane & 7) == 0) cl[grp * 8 + (lane >> 3)] = coef;
}
__device__ __forceinline__ void sweep_v(const Rows8& G, float (&acc)[16], const float* cl, int grp) {
#pragma unroll
    for (int k = 0; k < 8; ++k) {
        const float ck = cl[grp * 8 + k];
        const unsigned w[4] = {G.r[k].x, G.r[k].y, G.r[k].z, G.r[k].w};
#pragma unroll
        for (int q = 0; q < 4; ++q) {
            const f32x2_t lo = __builtin_amdgcn_cvt_pk_f32_fp8((int)w[q], false), hi = __builtin_amdgcn_cvt_pk_f32_fp8((int)w[q], true);
            acc[4 * q] = fmaf(ck, lo.x, acc[4 * q]); acc[4 * q + 1] = fmaf(ck, lo.y, acc[4 * q + 1]);
            acc[4 * q + 2] = fmaf(ck, hi.x, acc[4 * q + 2]); acc[4 * q + 3] = fmaf(ck, hi.y, acc[4 * q + 3]);
        }
    }
}
__device__ __forceinline__ void peer_expert6_phase(float* R, const int* __restrict__ eidx, const float* __restrict__ egate, const unsigned char* __restrict__ ub,
                                                   const unsigned char* __restrict__ vb, const float* __restrict__ lg, const float* __restrict__ lb, bf16_t* Hb, const XcdBarrier& xb, float* lds,
                                                   const float* __restrict__ l1g, const float* __restrict__ l1b) {
    const int wave = __builtin_amdgcn_readfirstlane(tidx() >> 6), lane = tidx() & 63;
    float* cl = lds + wave * 128;
    int itk = 0;
    for (int token = blockIdx.x * 8 + wave; token < NT; token += gridDim.x * 8, ++itk) {
        if (itk) xcc_align(xb);
        float xf[16];
        {
            const float* rp = R + (size_t)token * ND + lane * 16;
#pragma unroll
            for (int q = 0; q < 4; ++q) { const float4 a = *(const float4*)(rp + 4 * q); xf[4 * q] = a.x; xf[4 * q + 1] = a.y; xf[4 * q + 2] = a.z; xf[4 * q + 3] = a.w; }
        }
        {
            float s = 0.f;
#pragma unroll
            for (int j = 0; j < 16; ++j) s += xf[j];
            for (int o = 32; o; o >>= 1) s += __shfl_xor(s, o);
            const float mean = s * (1.f / ND);
            float s2 = 0.f;
#pragma unroll
            for (int j = 0; j < 16; ++j) { xf[j] -= mean; s2 += xf[j] * xf[j]; }
            for (int o = 32; o; o >>= 1) s2 += __shfl_xor(s2, o);
            const float rs = rsqrtf(s2 * (1.f / ND) + LN_EPS);
            int lofs1 = lane * 16;
            asm volatile("" : "+v"(lofs1));
#pragma unroll
            for (int q = 0; q < 4; ++q) {
                const float4 gg = *(const float4*)(l1g + lofs1 + 4 * q), bb = *(const float4*)(l1b + lofs1 + 4 * q);
                xf[4 * q] = xf[4 * q] * rs * gg.x + bb.x; xf[4 * q + 1] = xf[4 * q + 1] * rs * gg.y + bb.y; xf[4 * q + 2] = xf[4 * q + 2] * rs * gg.z + bb.z; xf[4 * q + 3] = xf[4 * q + 3] * rs * gg.w + bb.w;
            }
        }
        int e_lo = eidx[(size_t)token * 128 + lane], e_hi = eidx[(size_t)token * 128 + 64 + lane];
        float g_lo = egate[(size_t)token * 128 + lane], g_hi = egate[(size_t)token * 128 + 64 + lane];
        sort_routing(e_lo, e_hi, g_lo, g_hi, lane);
        Rows8 GA, GB;
        wave_lds_fence();
        rows_load(GA, e_lo, 0, ub, lane);
#pragma unroll 1
        for (int gp = 0; gp < 8; ++gp) {
            const int g0i = 2 * gp, g1i = 2 * gp + 1;
            rows_load(GB, g1i < 8 ? e_lo : e_hi, (g1i & 7) * 8, ub, lane);
            __builtin_amdgcn_sched_barrier(0);
            sweep_u(GA, xf, g0i < 8 ? g_lo : g_hi, (g0i & 7) * 8, lane, cl, g0i);
            __builtin_amdgcn_sched_barrier(0);
            rows_load(GA, gp < 7 ? ((g0i + 2) < 8 ? e_lo : e_hi) : e_lo, gp < 7 ? ((g0i + 2) & 7) * 8 : 0, gp < 7 ? ub : vb, lane);
            __builtin_amdgcn_sched_barrier(0);
            sweep_u(GB, xf, g1i < 8 ? g_lo : g_hi, (g1i & 7) * 8, lane, cl, g1i);
            __builtin_amdgcn_sched_barrier(0);
        }
        wave_lds_fence();
        xcc_align(xb);
        float acc[16];
#pragma unroll
        for (int j = 0; j < 16; ++j) acc[j] = 0.f;
#pragma unroll 1
        for (int gp = 0; gp < 8; ++gp) {
            const int g0i = 2 * gp, g1i = 2 * gp + 1;
            rows_load(GB, g1i < 8 ? e_lo : e_hi, (g1i & 7) * 8, vb, lane);
            __builtin_amdgcn_sched_barrier(0);
            sweep_v(GA, acc, cl, g0i);
            __builtin_amdgcn_sched_barrier(0);
            if (gp < 7) rows_load(GA, (g0i + 2) < 8 ? e_lo : e_hi, ((g0i + 2) & 7) * 8, vb, lane);
            __builtin_amdgcn_sched_barrier(0);
            sweep_v(GB, acc, cl, g1i);
            __builtin_amdgcn_sched_barrier(0);
        }
        float s = 0.f;
#pragma unroll
        for (int j = 0; j < 16; ++j) { xf[j] = ALPHA * xf[j] + acc[j]; s += xf[j]; }
        for (int o = 32; o; o >>= 1) s += __shfl_xor(s, o);
        const float mean = s * (1.f / ND);
        float s2 = 0.f;
#pragma unroll
        for (int j = 0; j < 16; ++j) { xf[j] -= mean; s2 += xf[j] * xf[j]; }
        for (int o = 32; o; o >>= 1) s2 += __shfl_xor(s2, o);
        const float rs = rsqrtf(s2 * (1.f / ND) + LN_EPS);
        float o[16];
        int lofs = lane * 16;
        asm volatile("" : "+v"(lofs));
#pragma unroll
        for (int q = 0; q < 4; ++q) {
            const float4 gg = *(const float4*)(lg + lofs + 4 * q), bb = *(const float4*)(lb + lofs + 4 * q);
            o[4 * q] = xf[4 * q] * rs * gg.x + bb.x; o[4 * q + 1] = xf[4 * q + 1] * rs * gg.y + bb.y; o[4 * q + 2] = xf[4 * q + 2] * rs * gg.z + bb.z; o[4 * q + 3] = xf[4 * q + 3] * rs * gg.w + bb.w;
            *(float4*)(R + (size_t)token * ND + lofs + 4 * q) = make_float4(o[4 * q], o[4 * q + 1], o[4 * q + 2], o[4 * q + 3]);
        }
        if (Hb) { st8(Hb + (size_t)token * ND + lofs, o); st8(Hb + (size_t)token * ND + lofs + 8, o + 8); }
    }
}

__device__ __forceinline__ void nsa_compress_phase(const bf16_t* __restrict__ proj, int coloff, const float* __restrict__ pe, const float* __restrict__ w1,
                                   const float* __restrict__ w2, float* __restrict__ outc, float* lds) {
    const int qtr = tidx() >> 7, tid = tidx() & 127;
    float* in = lds + qtr * 2176;
    float* hid = in + 2048;
    for (int it = blockIdx.x; it < NB * 127; it += gridDim.x) {
        const int g = qtr, n = it % 127, b = it / 127;
        __syncthreads();
        for (int idx = tid; idx < 2048; idx += 128) {
            const int l = idx >> 6, d = idx & 63;
            in[idx] = bf2f(proj[(size_t)(b * NL + 16 * n + l) * ODD_PAD + coloff + g * 64 + d]) + pe[l * 64 + d];
        }
        __syncthreads();
        float a = 0.f;
        for (int i = 0; i < 2048; ++i) a += in[i] * w1[(size_t)i * 128 + tid];
        hid[tid] = gelu_tanh(a);
        __syncthreads();
        if (tid < 64) {
            float o = 0.f;
            for (int j = 0; j < 128; ++j) o += hid[j] * w2[j * 64 + tid];
            outc[((size_t)(b * 127 + n) * 4 + g) * 64 + tid] = o;
        }
    }
    __syncthreads();
}

__device__ __forceinline__ void nsa_cmp_phase(const bf16_t* __restrict__ proj, const float* __restrict__ kcmp, const float* __restrict__ vcmp,
                              bf16_t* __restrict__ O, unsigned* __restrict__ selmask, float* lds) {
    const int half = tidx() >> 8, tid = tidx() & 255;
    float* kc_s = lds + half * 18368;
    float* vc_s = kc_s + 127 * 64;
    float(*imp_s)[33] = (float(*)[33])(vc_s + 127 * 64);
    const int tk = tid >> 2, r = tid & 3;
    for (int it = blockIdx.x; it < 32 * 4 * NB / 2; it += gridDim.x) {
        const int vb = it * 2 + half;
        const int tile = vb & 31, g = (vb >> 5) & 3, b = vb >> 7;
        const int t = tile * 64 + tk, hd = g * 4 + r;
        __syncthreads();
        for (int idx = tid; idx < 127 * 64; idx += 256) { const int n = idx >> 6, d = idx & 63; kc_s[idx] = kcmp[((size_t)(b * 127 + n) * 4 + g) * 64 + d]; vc_s[idx] = vcmp[((size_t)(b * 127 + n) * 4 + g) * 64 + d]; }
        const bf16_t* prow = proj + (size_t)(b * NL + t) * ODD_PAD;
        float q[64];
#pragma unroll
        for (int d = 0; d < 64; d += 8) ld8(prow + hd * 64 + d, q + d);
        const float slope = exp2f(-0.5f * (float)(hd + 1));
        int nvalid = (t >= 31) ? ((t - 31) / 16 + 1) : 0;
        if (nvalid > 127) nvalid = 127;
        __syncthreads();
        float m = -INFINITY, l = 0.f;
        for (int n = 0; n < nvalid; ++n) {
            float s = 0.f;
#pragma unroll
            for (int d = 0; d < 64; ++d) s += q[d] * kc_s[n * 64 + d];
            s = s * 0.125f - slope * (float)(t - (16 * n + 31));
            const float mn = fmaxf(m, s);
            l = l * expf(m - mn) + expf(s - mn);
            m = mn;
        }
        const float inv_l = (nvalid > 0) ? 1.f / fmaxf(l, 1e-30f) : 0.f;
        float acc[64];
#pragma unroll
        for (int d = 0; d < 64; ++d) acc[d] = 0.f;
        float prev3 = 0.f;
        for (int j = 0; j < 32; ++j) {
            float pj[4];
#pragma unroll
            for (int nn = 0; nn < 4; ++nn) {
                const int n = 4 * j + nn;
                float p = 0.f;
                if (n < nvalid) {
                    float s = 0.f;
#pragma unroll
                    for (int d = 0; d < 64; ++d) s += q[d] * kc_s[n * 64 + d];
                    s = s * 0.125f - slope * (float)(t - (16 * n + 31));
                    p = expf(s - m) * inv_l;
                    const float* vr = vc_s + n * 64;
#pragma unroll
                    for (int d = 0; d < 64; ++d) acc[d] += p * vr[d];
                }
                pj[nn] = p;
            }
            float im = 0.5f * prev3 + pj[0] + pj[1] + pj[2] + 0.5f * pj[3];
            prev3 = pj[3];
            im += __shfl_xor(im, 1);
            im += __shfl_xor(im, 2);
            if (r == 0) imp_s[tk][j] = im;
        }
        const float g0 = sigmoidf_(bf2f(prow[2048 + hd]));
#pragma unroll
        for (int d = 0; d < 64; ++d) acc[d] *= g0;
#pragma unroll
        for (int d = 0; d < 64; d += 8) st8(O + (size_t)(b * NL + t) * ND + hd * 64 + d, acc + d);
        __syncthreads();
        const int cur = tile;
        unsigned bits = 0;
        for (int jj = 0; jj < 8; ++jj) {
            const int j = r * 8 + jj;
            const bool fj = (j == 0) || (j == cur) || (j == cur - 1);
            const float vj = (j <= cur) ? imp_s[tk][j] + (fj ? 1000.f : 0.f) : -INFINITY;
            int rank = 0;
            for (int k = 0; k < 32; ++k) {
                const bool fk = (k == 0) || (k == cur) || (k == cur - 1);
                const float vk = (k <= cur) ? imp_s[tk][k] + (fk ? 1000.f : 0.f) : -INFINITY;
                rank += (vk > vj || (vk == vj && k < j)) ? 1 : 0;
            }
            if (rank < 16) bits |= 1u << j;
        }
        bits |= __shfl_xor(bits, 1);
        bits |= __shfl_xor(bits, 2);
        if (r == 0) selmask[(size_t)(b * 4 + g) * NL + t] = bits;
    }
    __syncthreads();
}

__device__ __forceinline__ void nsa_selwin_phase(const bf16_t* __restrict__ proj, const unsigned* __restrict__ selmask, bf16_t* O, float* lds) {
    const int half = tidx() >> 8, tid = tidx() & 255;
    float(*k_s)[64] = (float(*)[64])(lds + half * 8192);
    float(*v_s)[64] = (float(*)[64])(lds + half * 8192 + 4096);
    const int tk = tid >> 2, r = tid & 3;
    for (int it = blockIdx.x; it < 32 * 32; it += gridDim.x) {
        const int tile = 31 - (it >> 5);
        const int bgi = (it & 31) * 2 + half, g = bgi & 3, b = bgi >> 2;
        const int t = tile * 64 + tk, hd = g * 4 + r;
        const bf16_t* pb = proj + (size_t)b * NL * ODD_PAD;
        const bf16_t* prow = pb + (size_t)t * ODD_PAD;
        float q[64], acc[64];
#pragma unroll
        for (int d = 0; d < 64; d += 8) ld8(prow + hd * 64 + d, q + d);
        const float slope = exp2f(-0.5f * (float)(hd + 1));
        const unsigned mask = selmask[(size_t)(b * 4 + g) * NL + t];
        bf16_t* orow = O + (size_t)(b * NL + t) * ND + hd * 64;
        for (int branch = 0; branch < 2; ++branch) {
            const int kcol = (branch == 0 ? 1536 : 2048) + g * 64, vcol = kcol + 256;
            const int j0 = (branch == 0) ? 0 : (tile >= 8 ? tile - 8 : 0);
            float m = -1e30f, l = 0.f;
#pragma unroll
            for (int d = 0; d < 64; ++d) acc[d] = 0.f;
            for (int j = j0; j <= tile; ++j) {
                __syncthreads();
                for (int i = 0; i < 16; ++i) {
                    const int idx = tid + 256 * i, key = idx >> 6, d = idx & 63;
                    k_s[key][d] = bf2f(pb[(size_t)(64 * j + key) * ODD_PAD + kcol + d]);
                    v_s[key][d] = bf2f(pb[(size_t)(64 * j + key) * ODD_PAD + vcol + d]);
                }
                __syncthreads();
                const bool take = (branch == 0) ? ((mask >> j) & 1u) : true;
                if (take) {
                    for (int s = 0; s < 64; ++s) {
                        const int dist = t - (64 * j + s);
                        const bool valid = (branch == 0) ? (dist >= 0) : (dist >= 0 && dist < 512);
                        float sc = 0.f;
#pragma unroll
                        for (int d = 0; d < 64; ++d) sc += q[d] * k_s[s][d];
                        sc = sc * 0.125f - slope * (float)dist;
                        const float mn = valid ? fmaxf(m, sc) : m;
                        const float scale = expf(m - mn);
                        const float p = valid ? expf(sc - mn) : 0.f;
                        l = l * scale + p;
#pragma unroll
                        for (int d = 0; d < 64; ++d) acc[d] = acc[d] * scale + p * v_s[s][d];
                        m = mn;
                    }
                }
            }
            const float gt = sigmoidf_(bf2f(prow[2560 + (branch + 1) * 16 + hd]));
            const float f = gt / fmaxf(l, 1e-30f);
#pragma unroll
            for (int d = 0; d < 64; d += 8) {
                float o[8];
                ld8(orow + d, o);
#pragma unroll
                for (int j = 0; j < 8; ++j) o[j] += f * acc[d + j];
                st8(orow + d, o);
            }
        }
    }
    __syncthreads();
}


typedef float f32x16 __attribute__((ext_vector_type(16)));
#define MFMA32(a, b, c) __builtin_amdgcn_mfma_f32_32x32x16_bf16((a), (b), (c), 0, 0, 0)
__device__ __forceinline__ unsigned cvtpk(float lo, float hi) { const f32x2_t f = {lo, hi}; return __builtin_bit_cast(unsigned, __builtin_convertvector(f, bf16x2_t)); }
__device__ __forceinline__ int crow32(int reg, int h) { return (reg & 3) + 8 * (reg >> 2) + 4 * h; }
constexpr float LOG2E = 1.4426950408889634f;
__device__ __forceinline__ void nsa_attn_phase(const bf16_t* __restrict__ proj, const bf16_t* __restrict__ vt, const unsigned* __restrict__ selmask, bf16_t* O, unsigned char* lds) {
    const int tid = tidx(), wave = __builtin_amdgcn_readfirstlane(tid >> 6), lane = tid & 63, l31 = lane & 31, h = lane >> 5;
    const int r = wave & 3, thalf = wave >> 2;
    const int skey = tid >> 3, spart = tid & 7;
    for (int it = blockIdx.x; it < 32 * 64; it += gridDim.x) {
        const int tile = 31 - (it >> 6), bg = it & 63, g = bg & 3, b = bg >> 2;
        const int hd = g * 4 + r, tokoff = thalf * 32 + l31, tok = tile * 64 + tokoff;
        const size_t trow = (size_t)(b * NL + tok);
        const float slope = exp2f(-0.5f * (float)(hd + 1));
        bf16x8_t Qf[4];
#pragma unroll
        for (int ds = 0; ds < 4; ++ds) {
            float q[8];
            ld8(proj + trow * ODD_PAD + hd * 64 + 16 * ds + 8 * h, q);
            u32x4 w; w.x = cvtpk(q[0] * 0.125f, q[1] * 0.125f); w.y = cvtpk(q[2] * 0.125f, q[3] * 0.125f); w.z = cvtpk(q[4] * 0.125f, q[5] * 0.125f); w.w = cvtpk(q[6] * 0.125f, q[7] * 0.125f);
            Qf[ds] = __builtin_bit_cast(bf16x8_t, w);
        }
        float sc[16];
#pragma unroll
        for (int reg = 0; reg < 16; ++reg) sc[reg] = slope * (float)crow32(reg, h);
        const unsigned mymask = selmask[(size_t)(b * 4 + g) * NL + tok];
        __syncthreads();
        if (wave == 0) {
            unsigned m = selmask[(size_t)(b * 4 + g) * NL + tile * 64 + lane];
            for (int o = 32; o; o >>= 1) m |= __shfl_xor(m, o);
            if (lane == 0) *(unsigned*)(lds + 35840) = m;
        }
        __syncthreads();
        const unsigned causal = (tile == 31) ? 0xffffffffu : ((2u << tile) - 1u);
        const unsigned U = *(const unsigned*)(lds + 35840) & causal;
        float outv[32];
#pragma unroll
        for (int i = 0; i < 32; ++i) outv[i] = 0.f;
#pragma unroll 1
        for (int branch = 0; branch < 2; ++branch) {
            unsigned todo = (branch == 0) ? U : (causal & ~((1u << (tile >= 8 ? tile - 8 : 0)) - 1u));
            const bf16_t* kbase = proj + (size_t)b * NL * ODD_PAD + (branch == 0 ? 1536 : 1792) + g * 64 + (size_t)skey * ODD_PAD + 8 * spart;
            const bf16_t* vbase = vt + (size_t)(branch * 256 + g * 64 + skey) * NT + (size_t)b * NL + 8 * spart;
            float m_run = -1e30f, l_run = 0.f;
            f32x16 Oa[2];
#pragma unroll
            for (int i = 0; i < 16; ++i) { Oa[0][i] = 0.f; Oa[1][i] = 0.f; }
            int jcur = __ffs(todo) - 1; todo &= todo - 1;
            uint4 kreg = *(const uint4*)(kbase + (size_t)(64 * jcur) * ODD_PAD);
            uint4 vreg = *(const uint4*)(vbase + 64 * jcur);
            int buf = 0;
            __syncthreads();
            *(uint4*)(lds + skey * 144 + spart * 16) = kreg;
            *(uint2*)(lds + 18432 + skey * 136 + spart * 16) = make_uint2(vreg.x, vreg.y);
            *(uint2*)(lds + 18432 + skey * 136 + spart * 16 + 8) = make_uint2(vreg.z, vreg.w);
            __syncthreads();
            for (;;) {
                const int jnext = todo ? (__ffs(todo) - 1) : -1;
                todo &= todo - 1;
                if (jnext >= 0) { kreg = *(const uint4*)(kbase + (size_t)(64 * jnext) * ODD_PAD); vreg = *(const uint4*)(vbase + 64 * jnext); }
                const unsigned char* Ks = lds + buf * 9216;
                const unsigned char* Vs = lds + 18432 + buf * 8704;
                const bool mysel = (branch == 1) || ((mymask >> jcur) & 1u);
                if (__any(mysel)) {
                    const bool diag = (jcur == tile), wedge = (branch == 1) && (jcur == tile - 8);
                    const float init = mysel ? slope * (float)(64 * (jcur - tile)) : -1e30f;
                    float sv[32];
#pragma unroll
                    for (int kt = 0; kt < 2; ++kt) {
                        f32x16 acc;
                        const float i0 = init + slope * (float)(32 * kt);
#pragma unroll
                        for (int i = 0; i < 16; ++i) acc[i] = i0;
#pragma unroll
                        for (int ds = 0; ds < 4; ++ds) {
                            const bf16x8_t a = *(const bf16x8_t*)(Ks + (32 * kt + l31) * 144 + (16 * ds + 8 * h) * 2);
                            acc = MFMA32(a, Qf[ds], acc);
                        }
#pragma unroll
                        for (int reg = 0; reg < 16; ++reg) {
                            float sval = acc[reg] + sc[reg];
                            const int keyoff = 32 * kt + crow32(reg, h);
                            if (diag) sval = (keyoff <= tokoff) ? sval : -1e30f;
                            if (wedge) sval = (keyoff > tokoff) ? sval : -1e30f;
                            sv[kt * 16 + reg] = sval;
                        }
                    }
                    float mx = sv[0];
#pragma unroll
                    for (int i = 1; i < 32; ++i) mx = fmaxf(mx, sv[i]);
                    mx = fmaxf(mx, __shfl_xor(mx, 32));
                    const float m_new = fmaxf(m_run, mx), m_use = fmaxf(m_new, -1e29f);
                    const float alpha = __builtin_amdgcn_exp2f((m_run - m_use) * LOG2E);
                    const float moff = -m_use * LOG2E;
                    float psum = 0.f;
#pragma unroll
                    for (int i = 0; i < 32; ++i) { sv[i] = __builtin_amdgcn_exp2f(fmaf(sv[i], LOG2E, moff)); psum += sv[i]; }
                    l_run = l_run * alpha + psum; m_run = m_new;
#pragma unroll
                    for (int i = 0; i < 16; ++i) { Oa[0][i] *= alpha; Oa[1][i] *= alpha; }
                    bf16x8_t Pf[4];
#pragma unroll
                    for (int ks = 0; ks < 4; ++ks) {
                        u32x4 w; w.x = cvtpk(sv[ks * 8 + 0], sv[ks * 8 + 1]); w.y = cvtpk(sv[ks * 8 + 2], sv[ks * 8 + 3]); w.z = cvtpk(sv[ks * 8 + 4], sv[ks * 8 + 5]); w.w = cvtpk(sv[ks * 8 + 6], sv[ks * 8 + 7]);
                        Pf[ks] = __builtin_bit_cast(bf16x8_t, w);
                    }
#pragma unroll
                    for (int mt = 0; mt < 2; ++mt)
#pragma unroll
                        for (int ks = 0; ks < 4; ++ks) {
                            const unsigned char* vp = Vs + (32 * mt + l31) * 136 + (16 * ks + 4 * h) * 2;
                            const uint2 lo = *(const uint2*)vp, hi = *(const uint2*)(vp + 16);
                            u32x4 w; w.x = lo.x; w.y = lo.y; w.z = hi.x; w.w = hi.y;
                            Oa[mt] = MFMA32(__builtin_bit_cast(bf16x8_t, w), Pf[ks], Oa[mt]);
                        }
                }
                if (jnext < 0) break;
                *(uint4*)(lds + (buf ^ 1) * 9216 + skey * 144 + spart * 16) = kreg;
                *(uint2*)(lds + 18432 + (buf ^ 1) * 8704 + skey * 136 + spart * 16) = make_uint2(vreg.x, vreg.y);
                *(uint2*)(lds + 18432 + (buf ^ 1) * 8704 + skey * 136 + spart * 16 + 8) = make_uint2(vreg.z, vreg.w);
                __syncthreads();
                buf ^= 1; jcur = jnext;
            }
            const float l_tot = l_run + __shfl_xor(l_run, 32);
            const float gt = sigmoidf_(bf2f(proj[trow * ODD_PAD + 2048 + (branch + 1) * 16 + hd]));
            const float f = gt / fmaxf(l_tot, 1e-30f);
#pragma unroll
            for (int i = 0; i < 16; ++i) { outv[i] += f * Oa[0][i]; outv[16 + i] += f * Oa[1][i]; }
        }
        bf16_t* orow = O + trow * ND + hd * 64;
#pragma unroll
        for (int mt = 0; mt < 2; ++mt)
#pragma unroll
            for (int q4 = 0; q4 < 4; ++q4) {
                bf16_t* op = orow + 32 * mt + 8 * q4 + 4 * h;
                const uint2 old = *(const uint2*)op;
                const float o0 = __uint_as_float(old.x << 16) + outv[mt * 16 + q4 * 4 + 0], o1 = __uint_as_float(old.x & 0xffff0000u) + outv[mt * 16 + q4 * 4 + 1];
                const float o2 = __uint_as_float(old.y << 16) + outv[mt * 16 + q4 * 4 + 2], o3 = __uint_as_float(old.y & 0xffff0000u) + outv[mt * 16 + q4 * 4 + 3];
                *(uint2*)op = make_uint2(cvtpk(o0, o1), cvtpk(o2, o3));
            }
    }
    __syncthreads();
}


__device__ __forceinline__ void nsa_compress2_phase(const bf16_t* __restrict__ proj, const bf16_t* __restrict__ w1t  , const bf16_t* __restrict__ w2t  ,
                                                    const float* __restrict__ bias1  , bf16_t* __restrict__ kcmp  , bf16_t* __restrict__ vcmpT  ,
                                                    unsigned char* lds) {
    const int tid = tidx(), wave = __builtin_amdgcn_readfirstlane(tid >> 6), lane = tid & 63, fr = lane & 15, fq = lane >> 4;
    unsigned char* xs = lds;
    unsigned char* hs = lds + 34816;
    for (int it = blockIdx.x; it < 1024; it += gridDim.x) {
        const int which = it >> 9, ntile = it & 7, g = (it >> 3) & 3, b = (it >> 5) & 15;
        const int t0 = 256 * ntile, coloff = (which ? 1280 : 1024) + g * 64;
        __syncthreads();
        for (int pc = tid; pc < 272 * 8; pc += NTHR) {
            const int tk = pc >> 3, c = pc & 7;
            int tsrc = t0 + tk; tsrc = tsrc > NL - 1 ? NL - 1 : tsrc;
            *(uint4*)(xs + tk * 128 + ((c ^ ((tk >> 4) & 7)) << 4)) = *(const uint4*)(proj + (size_t)(b * NL + tsrc) * ODD_PAD + coloff + 8 * c);
        }
        __syncthreads();
        f32x4 acc = {0.f, 0.f, 0.f, 0.f};
        const bf16_t* wrow = w1t + ((size_t)which * 128 + 16 * wave + fr) * 2048 + 8 * fq;
#pragma unroll 8
        for (int ks = 0; ks < 64; ++ks) {
            const int l = ks >> 1, tk = 16 * fr + l, c = 4 * (ks & 1) + fq;
            const bf16x8_t a = *(const bf16x8_t*)(xs + tk * 128 + ((c ^ ((tk >> 4) & 7)) << 4));
            const bf16x8_t bfrag = *(const bf16x8_t*)(wrow + 32 * ks);
            acc = __builtin_amdgcn_mfma_f32_16x16x32_bf16(a, bfrag, acc, 0, 0, 0);
        }
        {
            const float bj = bias1[which * 128 + 16 * wave + fr];
#pragma unroll
            for (int reg = 0; reg < 4; ++reg) *(bf16_t*)(hs + (4 * fq + reg) * 272 + (16 * wave + fr) * 2) = f2bf(gelu_fast(acc[reg] + bj));
        }
        __syncthreads();
        if (wave < 4) {
            f32x4 o = {0.f, 0.f, 0.f, 0.f};
#pragma unroll
            for (int ks = 0; ks < 4; ++ks) {
                const bf16x8_t a = *(const bf16x8_t*)(hs + fr * 272 + (32 * ks + 8 * fq) * 2);
                const bf16x8_t bfrag = *(const bf16x8_t*)(w2t + ((size_t)which * 64 + 16 * wave + fr) * 128 + 32 * ks + 8 * fq);
                o = __builtin_amdgcn_mfma_f32_16x16x32_bf16(a, bfrag, o, 0, 0, 0);
            }
            const int c = 16 * wave + fr;
#pragma unroll
            for (int reg = 0; reg < 4; ++reg) {
                const int n = 16 * ntile + 4 * fq + reg;
                const bf16_t val = (n < 127) ? f2bf(o[reg]) : (bf16_t)0;
                if (which == 0) kcmp[((size_t)(b * 4 + g) * 128 + n) * 64 + c] = val;
                else vcmpT[((size_t)(b * 4 + g) * 64 + c) * 128 + n] = val;
            }
        }
    }
    __syncthreads();
}

__device__ __forceinline__ void nsa_cmp2_phase(const bf16_t* __restrict__ proj, const bf16_t* __restrict__ kcmp, const bf16_t* __restrict__ vcmpT,
                                               bf16_t* __restrict__ O, unsigned* __restrict__ selmask, unsigned char* lds) {
    const int tid = tidx(), wave = __builtin_amdgcn_readfirstlane(tid >> 6), lane = tid & 63, l31 = lane & 31, h = lane >> 5;
    const int r = wave & 3, thalf = wave >> 2;
    unsigned char* Kc = lds;
    unsigned char* Vc = lds + 18432;
    float* impS = (float*)(lds + 35328);
    float* invS = (float*)(lds + 35328 + 32768);
    for (int it = blockIdx.x; it < 32 * 64; it += gridDim.x) {
        const int tile = 31 - (it >> 6), bg = it & 63, g = bg & 3, b = bg >> 2;
        const int hd = g * 4 + r, tokoff = thalf * 32 + l31, tok = tile * 64 + tokoff;
        const size_t trow = (size_t)(b * NL + tok);
        const float slope = exp2f(-0.5f * (float)(hd + 1));
        __syncthreads();
#pragma unroll
        for (int i = 0; i < 2; ++i) {
            const int pc = tid + 512 * i;
            { const int row = pc >> 3, c = pc & 7; *(uint4*)(Kc + row * 144 + c * 16) = *(const uint4*)(kcmp + ((size_t)(b * 4 + g) * 128 + row) * 64 + 8 * c); }
            { const int row = pc >> 4, c = pc & 15; const uint4 v = *(const uint4*)(vcmpT + ((size_t)(b * 4 + g) * 64 + row) * 128 + 8 * c);
              *(uint2*)(Vc + row * 264 + c * 16) = make_uint2(v.x, v.y); *(uint2*)(Vc + row * 264 + c * 16 + 8) = make_uint2(v.z, v.w); }
        }
        bf16x8_t Qf[4];
#pragma unroll
        for (int ds = 0; ds < 4; ++ds) {
            float q[8];
            ld8(proj + trow * ODD_PAD + hd * 64 + 16 * ds + 8 * h, q);
            u32x4 w; w.x = cvtpk(q[0] * 0.125f, q[1] * 0.125f); w.y = cvtpk(q[2] * 0.125f, q[3] * 0.125f); w.z = cvtpk(q[4] * 0.125f, q[5] * 0.125f); w.w = cvtpk(q[6] * 0.125f, q[7] * 0.125f);
            Qf[ds] = __builtin_bit_cast(bf16x8_t, w);
        }
        int nvalid = (tok >= 31) ? ((tok - 31) / 16 + 1) : 0;
        nvalid = nvalid > 127 ? 127 : nvalid;
        __syncthreads();
        float mx = -1e30f;
#pragma unroll 1
        for (int kt = 0; kt < 4; ++kt) {
            f32x16 acc;
            const float i0 = slope * (float)(512 * kt);
#pragma unroll
            for (int i = 0; i < 16; ++i) acc[i] = i0;
#pragma unroll
            for (int ds = 0; ds < 4; ++ds) {
                const bf16x8_t a = *(const bf16x8_t*)(Kc + (32 * kt + l31) * 144 + (16 * ds + 8 * h) * 2);
                acc = MFMA32(a, Qf[ds], acc);
            }
#pragma unroll
            for (int reg = 0; reg < 16; ++reg) {
                const int n = 32 * kt + crow32(reg, h);
                const float sval = acc[reg] + slope * (float)(16 * crow32(reg, h));
                mx = fmaxf(mx, (n < nvalid) ? sval : -1e30f);
            }
        }
        mx = fmaxf(mx, __shfl_xor(mx, 32));
        const float moff = -fmaxf(mx, -1e29f) * LOG2E;
        float psum = 0.f, prev_pe = 0.f;
        f32x16 Oa[2];
#pragma unroll
        for (int i = 0; i < 16; ++i) { Oa[0][i] = 0.f; Oa[1][i] = 0.f; }
#pragma unroll 1
        for (int kt = 0; kt < 4; ++kt) {
            f32x16 acc;
            const float i0 = slope * (float)(512 * kt);
#pragma unroll
            for (int i = 0; i < 16; ++i) acc[i] = i0;
#pragma unroll
            for (int ds = 0; ds < 4; ++ds) {
                const bf16x8_t a = *(const bf16x8_t*)(Kc + (32 * kt + l31) * 144 + (16 * ds + 8 * h) * 2);
                acc = MFMA32(a, Qf[ds], acc);
            }
            float sv[16];
#pragma unroll
            for (int reg = 0; reg < 16; ++reg) {
                const int n = 32 * kt + crow32(reg, h);
                const float sval = acc[reg] + slope * (float)(16 * crow32(reg, h));
                sv[reg] = __builtin_amdgcn_exp2f(fmaf((n < nvalid) ? sval : -1e30f, LOG2E, moff));
                psum += sv[reg];
            }
#pragma unroll
            for (int q = 0; q < 4; ++q) {
                const float e = 0.5f * sv[q * 4 + 3];
                const float own = sv[q * 4] + sv[q * 4 + 1] + sv[q * 4 + 2] + e;
                const float pe = __shfl_xor(e, 32);
                impS[(r * 64 + tokoff) * 32 + 8 * kt + 2 * q + h] = own + (h ? pe : prev_pe);
                prev_pe = pe;
            }
#pragma unroll
            for (int s2 = 0; s2 < 2; ++s2) {
                u32x4 w; w.x = cvtpk(sv[s2 * 8 + 0], sv[s2 * 8 + 1]); w.y = cvtpk(sv[s2 * 8 + 2], sv[s2 * 8 + 3]); w.z = cvtpk(sv[s2 * 8 + 4], sv[s2 * 8 + 5]); w.w = cvtpk(sv[s2 * 8 + 6], sv[s2 * 8 + 7]);
                const bf16x8_t pf = __builtin_bit_cast(bf16x8_t, w);
#pragma unroll
                for (int mt = 0; mt < 2; ++mt) {
                    const unsigned char* vp = Vc + (32 * mt + l31) * 264 + (32 * kt + 16 * s2 + 4 * h) * 2;
                    const uint2 lo = *(const uint2*)vp, hi = *(const uint2*)(vp + 16);
                    u32x4 a; a.x = lo.x; a.y = lo.y; a.z = hi.x; a.w = hi.y;
                    Oa[mt] = MFMA32(__builtin_bit_cast(bf16x8_t, a), pf, Oa[mt]);
                }
            }
        }
        psum += __shfl_xor(psum, 32);
        const float inv = (nvalid > 0) ? 1.f / fmaxf(psum, 1e-30f) : 0.f;
        if (h == 0) invS[r * 64 + tokoff] = inv;
        const float g0 = sigmoidf_(bf2f(proj[trow * ODD_PAD + 2048 + hd])) * inv;
        bf16_t* orow = O + trow * ND + hd * 64;
#pragma unroll
        for (int mt = 0; mt < 2; ++mt)
#pragma unroll
            for (int q4 = 0; q4 < 4; ++q4)
                *(uint2*)(orow + 32 * mt + 8 * q4 + 4 * h) = make_uint2(cvtpk(g0 * Oa[mt][q4 * 4], g0 * Oa[mt][q4 * 4 + 1]), cvtpk(g0 * Oa[mt][q4 * 4 + 2], g0 * Oa[mt][q4 * 4 + 3]));
        __syncthreads();
        float* impT = (float*)Kc;
#pragma unroll
        for (int i = 0; i < 4; ++i) {
            const int pc = tid + 512 * i, tk = pc >> 5, j = pc & 31, cur = tile;
            const float ij = impS[(0 * 64 + tk) * 32 + j] * invS[tk] + impS[(1 * 64 + tk) * 32 + j] * invS[64 + tk] + impS[(2 * 64 + tk) * 32 + j] * invS[128 + tk] + impS[(3 * 64 + tk) * 32 + j] * invS[192 + tk];
            const bool fj = (j == 0) || (j == cur) || (j == cur - 1);
            impT[tk * 33 + j] = (j <= cur) ? ij + (fj ? 1000.f : 0.f) : -INFINITY;
        }
        __syncthreads();
        if (tid < 256) {
            const int tk = tid >> 2, rr = tid & 3;
            unsigned bits = 0;
#pragma unroll 1
            for (int jj = 0; jj < 8; ++jj) {
                const int j = rr * 8 + jj;
                const float vj = impT[tk * 33 + j];
                int rank = 0;
#pragma unroll 8
                for (int k = 0; k < 32; ++k) {
                    const float vk = impT[tk * 33 + k];
                    rank += (vk > vj || (vk == vj && k < j)) ? 1 : 0;
                }
                if (rank < 16) bits |= 1u << j;
            }
            bits |= __shfl_xor(bits, 1);
            bits |= __shfl_xor(bits, 2);
            if (rr == 0) selmask[(size_t)(b * 4 + g) * NL + tile * 64 + tk] = bits;
        }
    }
    __syncthreads();
}


constexpr int P0W = 1792;
constexpr float LN2F = 0.6931471805599453f;
__device__ __forceinline__ void sb_attn2_phase(const bf16_t* __restrict__ proj, const bf16_t* __restrict__ vt, bf16_t* __restrict__ Y, unsigned char* lds) {
    const int tid = tidx(), wave = __builtin_amdgcn_readfirstlane(tid >> 6), lane = tid & 63, l31 = lane & 31, h = lane >> 5;
    const int skey = tid >> 3, spart = tid & 7;
    for (int it = blockIdx.x; it < NB * 12 * 8; it += gridDim.x) {
        const int tile = 7 - (it / 192), bh = it % 192, hh = bh % 12, b = bh / 12;
        const int qlo = tile * 256 + 32 * wave, tq = qlo + l31;
        const size_t trow = (size_t)(b * NL + tq);
        bf16x8_t Qf[4];
#pragma unroll
        for (int ds = 0; ds < 4; ++ds) {
            float q[8];
            ld8(proj + trow * P0W + 256 + hh * 64 + 16 * ds + 8 * h, q);
            u32x4 w; w.x = cvtpk(q[0] * 0.125f, q[1] * 0.125f); w.y = cvtpk(q[2] * 0.125f, q[3] * 0.125f); w.z = cvtpk(q[4] * 0.125f, q[5] * 0.125f); w.w = cvtpk(q[6] * 0.125f, q[7] * 0.125f);
            Qf[ds] = __builtin_bit_cast(bf16x8_t, w);
        }
        const bf16_t* kbase = proj + (size_t)b * NL * P0W + 1024 + hh * 64 + (size_t)skey * P0W + 8 * spart;
        const bf16_t* vbase = vt + (size_t)(hh * 64 + skey) * NT + (size_t)b * NL + 8 * spart;
        f32x16 Oa[2];
#pragma unroll
        for (int i = 0; i < 16; ++i) { Oa[0][i] = 0.f; Oa[1][i] = 0.f; }
        float carry = 0.f;
        int j = tile * 4 + 3, buf = 0;
        uint4 kreg = *(const uint4*)(kbase + (size_t)(64 * j) * P0W);
        uint4 vreg = *(const uint4*)(vbase + 64 * j);
        __syncthreads();
        *(uint4*)(lds + skey * 144 + spart * 16) = kreg;
        *(uint2*)(lds + 18432 + skey * 136 + spart * 16) = make_uint2(vreg.x, vreg.y);
        *(uint2*)(lds + 18432 + skey * 136 + spart * 16 + 8) = make_uint2(vreg.z, vreg.w);
        __syncthreads();
        for (;;) {
            const int jn = j - 1;
            if (jn >= 0) { kreg = *(const uint4*)(kbase + (size_t)(64 * jn) * P0W); vreg = *(const uint4*)(vbase + 64 * jn); }
            const unsigned char* Ks = lds + buf * 9216;
            const unsigned char* Vs = lds + 18432 + buf * 8704;
            const bool live = (64 * j <= qlo + 30) && !__all(carry < -110.f);
            if (live) {
#pragma unroll
                for (int kti = 0; kti < 2; ++kti) {
                    const int kt = 1 - kti;
                    f32x16 acc;
#pragma unroll
                    for (int i = 0; i < 16; ++i) acc[i] = 0.f;
#pragma unroll
                    for (int ds = 0; ds < 4; ++ds) {
                        const bf16x8_t a = *(const bf16x8_t*)(Ks + (32 * kt + l31) * 144 + (16 * ds + 8 * h) * 2);
                        acc = MFMA32(a, Qf[ds], acc);
                    }
                    float m1[16], lz[16];
#pragma unroll
                    for (int reg = 0; reg < 16; ++reg) {
                        const float z = acc[reg];
                        const bool valid = (64 * j + 32 * kt + crow32(reg, h)) < tq;
                        const float e = __builtin_amdgcn_exp2f(-fabsf(z) * LOG2E);
                        const float sp = fmaxf(z, 0.f) + __builtin_amdgcn_logf(1.f + e) * LN2F;
                        m1[reg] = valid ? -sp : 0.f;
                        lz[reg] = valid ? z - sp : -1e30f;
                    }
                    float G[4], T[4];
#pragma unroll
                    for (int q = 0; q < 4; ++q) G[q] = (m1[4 * q] + m1[4 * q + 1]) + (m1[4 * q + 2] + m1[4 * q + 3]);
                    float Gp[4];
#pragma unroll
                    for (int q = 0; q < 4; ++q) { Gp[q] = __shfl_xor(G[q], 32); T[q] = G[q] + Gp[q]; }
                    float base[4];
                    base[3] = carry; base[2] = base[3] + T[3]; base[1] = base[2] + T[2]; base[0] = base[1] + T[1];
                    const float tot = base[0] + T[0];
#pragma unroll
                    for (int q = 0; q < 4; ++q) {
                        const float bq = base[q] + (h ? 0.f : Gp[q]);
                        const float t3 = bq, t2 = t3 + m1[4 * q + 3], t1 = t2 + m1[4 * q + 2], t0 = t1 + m1[4 * q + 1];
                        lz[4 * q + 3] = __builtin_amdgcn_exp2f((lz[4 * q + 3] + t3) * LOG2E);
                        lz[4 * q + 2] = __builtin_amdgcn_exp2f((lz[4 * q + 2] + t2) * LOG2E);
                        lz[4 * q + 1] = __builtin_amdgcn_exp2f((lz[4 * q + 1] + t1) * LOG2E);
                        lz[4 * q + 0] = __builtin_amdgcn_exp2f((lz[4 * q + 0] + t0) * LOG2E);
                    }
                    carry = tot;
#pragma unroll
                    for (int s2 = 0; s2 < 2; ++s2) {
                        u32x4 w; w.x = cvtpk(lz[s2 * 8 + 0], lz[s2 * 8 + 1]); w.y = cvtpk(lz[s2 * 8 + 2], lz[s2 * 8 + 3]); w.z = cvtpk(lz[s2 * 8 + 4], lz[s2 * 8 + 5]); w.w = cvtpk(lz[s2 * 8 + 6], lz[s2 * 8 + 7]);
                        const bf16x8_t pf = __builtin_bit_cast(bf16x8_t, w);
#pragma unroll
                        for (int mt = 0; mt < 2; ++mt) {
                            const unsigned char* vp = Vs + (32 * mt + l31) * 136 + (32 * kt + 16 * s2 + 4 * h) * 2;
                            const uint2 lo = *(const uint2*)vp, hi = *(const uint2*)(vp + 16);
                            u32x4 a; a.x = lo.x; a.y = lo.y; a.z = hi.x; a.w = hi.y;
                            Oa[mt] = MFMA32(__builtin_bit_cast(bf16x8_t, a), pf, Oa[mt]);
                        }
                    }
                }
            }
            if (jn >= 0) {
                *(uint4*)(lds + (buf ^ 1) * 9216 + skey * 144 + spart * 16) = kreg;
                *(uint2*)(lds + 18432 + (buf ^ 1) * 8704 + skey * 136 + spart * 16) = make_uint2(vreg.x, vreg.y);
                *(uint2*)(lds + 18432 + (buf ^ 1) * 8704 + skey * 136 + spart * 16 + 8) = make_uint2(vreg.z, vreg.w);
            }
            volatile int* flg = (volatile int*)(lds + 35840) + (j & 1) * 8;
            const int wdone = __all(carry < -110.f);
            if (lane == 0) flg[wave] = wdone;
            __syncthreads();
            const int alldone = flg[0] & flg[1] & flg[2] & flg[3] & flg[4] & flg[5] & flg[6] & flg[7];
            if (alldone || jn < 0) break;
            buf ^= 1; j = jn;
        }
        bf16_t* orow = Y + trow * ND + 256 + hh * 64;
#pragma unroll
        for (int mt = 0; mt < 2; ++mt)
#pragma unroll
            for (int q4 = 0; q4 < 4; ++q4)
                *(uint2*)(orow + 32 * mt + 8 * q4 + 4 * h) = make_uint2(cvtpk(Oa[mt][q4 * 4], Oa[mt][q4 * 4 + 1]), cvtpk(Oa[mt][q4 * 4 + 2], Oa[mt][q4 * 4 + 3]));
    }
    __syncthreads();
}

__device__ __forceinline__ void s5_scan2_phase(const bf16_t* __restrict__ proj, const float* __restrict__ lam_re, const float* __restrict__ lam_im, const float* __restrict__ log_dt,
                                               const float* __restrict__ b_re, const float* __restrict__ b_im, const float* __restrict__ c_re, const float* __restrict__ c_im,
                                               const float* __restrict__ dskip, bf16_t* __restrict__ ya, float* lds) {
    const int tid = tidx(), wave = __builtin_amdgcn_readfirstlane(tid >> 6), lane = tid & 63;
    float* cr = lds;
    float* ci = lds + 1024;
    float* Es = lds + 2048;
    float* us = lds + 3072 + wave * 512;
    float* xr = lds + 7168 + wave * 4160;
    float* xi = xr + 2080;
    for (int bg = blockIdx.x; bg < NB * 16; bg += gridDim.x) {
        const int b = bg >> 4, g = bg & 15;
        const float lr = lam_re[g * 64 + lane], li = lam_im[g * 64 + lane];
        const float dt = expf(log_dt[g]);
        const float mag = expf(lr * dt);
        const float are = mag * cosf(li * dt), aim = mag * sinf(li * dt);
        const float nr = are - 1.f, den = lr * lr + li * li;
        const float fre = (nr * lr + aim * li) / den, fim = (aim * lr - nr * li) / den;
        float bbr[16], bbi[16];
#pragma unroll
        for (int i = 0; i < 16; ++i) {
            const float br = b_re[(g * 64 + lane) * 16 + i], bi = b_im[(g * 64 + lane) * 16 + i];
            bbr[i] = fre * br - fim * bi; bbi[i] = fre * bi + fim * br;
        }
        __syncthreads();
        for (int idx = tid; idx < 1024; idx += NTHR) { cr[idx] = c_re[g * 1024 + idx]; ci[idx] = c_im[g * 1024 + idx]; }
        const bf16_t* ub = proj + (size_t)(b * NL + 256 * wave) * P0W + g * 16;
        float xre = 0.f, xim = 0.f;
        for (int c0 = 0; c0 < 256; c0 += 32) {
            wave_lds_fence();
            { float u8[8]; const int t = lane >> 1, hf = lane & 1; ld8(ub + (size_t)(c0 + t) * P0W + 8 * hf, u8);
#pragma unroll
              for (int i = 0; i < 8; ++i) us[t * 16 + 8 * hf + i] = u8[i]; }
            wave_lds_fence();
            for (int t = 0; t < 32; ++t) {
                float bur = 0.f, bui = 0.f;
#pragma unroll
                for (int i = 0; i < 16; ++i) { const float u = us[t * 16 + i]; bur += bbr[i] * u; bui += bbi[i] * u; }
                const float nre = are * xre - aim * xim + bur, nim = are * xim + aim * xre + bui;
                xre = nre; xim = nim;
            }
        }
        Es[(wave * 64 + lane) * 2] = xre; Es[(wave * 64 + lane) * 2 + 1] = xim;
        float pr = are, pi = aim;
#pragma unroll
        for (int i = 0; i < 8; ++i) { const float nr2 = pr * pr - pi * pi, ni2 = 2.f * pr * pi; pr = nr2; pi = ni2; }
        __syncthreads();
        xre = 0.f; xim = 0.f;
        for (int w2 = 0; w2 < wave; ++w2) {
            const float er = Es[(w2 * 64 + lane) * 2], ei = Es[(w2 * 64 + lane) * 2 + 1];
            const float nre = pr * xre - pi * xim + er, nim = pr * xim + pi * xre + ei;
            xre = nre; xim = nim;
        }
        const int tt = lane & 31, ih = lane >> 5;
        float dsk[8];
#pragma unroll
        for (int i = 0; i < 8; ++i) dsk[i] = dskip[g * 16 + 8 * ih + i];
        for (int c0 = 0; c0 < 256; c0 += 32) {
            wave_lds_fence();
            { float u8[8]; const int t = lane >> 1, hf = lane & 1; ld8(ub + (size_t)(c0 + t) * P0W + 8 * hf, u8);
#pragma unroll
              for (int i = 0; i < 8; ++i) us[t * 16 + 8 * hf + i] = u8[i]; }
            wave_lds_fence();
            for (int t = 0; t < 32; ++t) {
                float bur = 0.f, bui = 0.f;
#pragma unroll
                for (int i = 0; i < 16; ++i) { const float u = us[t * 16 + i]; bur += bbr[i] * u; bui += bbi[i] * u; }
                const float nre = are * xre - aim * xim + bur, nim = are * xim + aim * xre + bui;
                xre = nre; xim = nim;
                xr[t * 65 + lane] = xre; xi[t * 65 + lane] = xim;
            }
            wave_lds_fence();
            float y[8];
#pragma unroll
            for (int i = 0; i < 8; ++i) y[i] = 0.f;
            for (int p = 0; p < 64; ++p) {
                const float a = xr[tt * 65 + p], bq = xi[tt * 65 + p];
#pragma unroll
                for (int i = 0; i < 8; ++i) y[i] += cr[(8 * ih + i) * 64 + p] * a - ci[(8 * ih + i) * 64 + p] * bq;
            }
            float o[8];
#pragma unroll
            for (int i = 0; i < 8; ++i) o[i] = gelu_fast(y[i] + dsk[i] * us[tt * 16 + 8 * ih + i]);
            st8(ya + (size_t)(b * NL + 256 * wave + c0 + tt) * 256 + g * 16 + 8 * ih, o);
        }
    }
    __syncthreads();
}


__device__ __forceinline__ void glu2_phase(const bf16_t* __restrict__ ya, const bf16_t* __restrict__ wgt, const float* __restrict__ bglu, bf16_t* __restrict__ Y, unsigned char* lds) {
    const int tid = tidx(), wave = __builtin_amdgcn_readfirstlane(tid >> 6), lane = tid & 63, fr = lane & 15, fq = lane >> 4;
    __syncthreads();
    for (int pc = tid; pc < 256 * 32; pc += NTHR) { const int row = pc >> 5, c = pc & 31; *(uint4*)(lds + row * 528 + c * 16) = *(const uint4*)(wgt + row * 256 + c * 8); }
    __syncthreads();
    for (int chunk = blockIdx.x; chunk < NT / 128; chunk += gridDim.x) {
        const size_t tok = (size_t)chunk * 128 + wave * 16 + fr;
        bf16x8_t yb[8];
#pragma unroll
        for (int ks = 0; ks < 8; ++ks) yb[ks] = *(const bf16x8_t*)(ya + tok * 256 + 32 * ks + 8 * fq);
#pragma unroll 2
        for (int nt = 0; nt < 16; ++nt) {
            f32x4 acc = {0.f, 0.f, 0.f, 0.f};
#pragma unroll
            for (int ks = 0; ks < 8; ++ks) {
                const bf16x8_t a = *(const bf16x8_t*)(lds + (16 * nt + fr) * 528 + (32 * ks + 8 * fq) * 2);
                acc = __builtin_amdgcn_mfma_f32_16x16x32_bf16(a, yb[ks], acc, 0, 0, 0);
            }
            const int n0 = 16 * nt + 4 * fq;
            const uint2 yv = *(const uint2*)(ya + tok * 256 + n0);
            const float4 bb = *(const float4*)(bglu + n0);
            const float o0 = __uint_as_float(yv.x << 16) * sigmoidf_(acc[0] + bb.x), o1 = __uint_as_float(yv.x & 0xffff0000u) * sigmoidf_(acc[1] + bb.y);
            const float o2 = __uint_as_float(yv.y << 16) * sigmoidf_(acc[2] + bb.z), o3 = __uint_as_float(yv.y & 0xffff0000u) * sigmoidf_(acc[3] + bb.w);
            *(uint2*)(Y + tok * ND + n0) = make_uint2(cvtpk(o0, o1), cvtpk(o2, o3));
        }
    }
    __syncthreads();
}


__device__ __forceinline__ void cmadd(float& re, float& im, float ar, float ai, float br, float bi) {
    const float nr = fmaf(ar, re, fmaf(-ai, im, br)), ni = fmaf(ar, im, fmaf(ai, re, bi));
    re = nr; im = ni;
}
__device__ __forceinline__ void s5_scan3_phase(const bf16_t* __restrict__ proj, const float* __restrict__ lam_re, const float* __restrict__ lam_im, const float* __restrict__ log_dt,
                                               const float* __restrict__ b_re, const float* __restrict__ b_im, const float* __restrict__ c_re, const float* __restrict__ c_im,
                                               const float* __restrict__ dskip, bf16_t* __restrict__ ya, unsigned char* lds) {
    const int tid = tidx(), wave = __builtin_amdgcn_readfirstlane(tid >> 6), lane = tid & 63, l31 = lane & 31, h = lane >> 5, fr = lane & 15, fq = lane >> 4;
    unsigned char* Xs = lds + wave * 10752;
    float* Es = (float*)(lds + 86016);
    __syncthreads();
    for (int i = lane; i < 32 * 21; i += 64) *(uint4*)(Xs + i * 16) = make_uint4(0u, 0u, 0u, 0u);
    for (int bg = blockIdx.x; bg < NB * 16; bg += gridDim.x) {
        const int b = bg >> 4, g = bg & 15;
        const float dt = expf(log_dt[g]);
        float are[2], aim[2]; bf16x8_t Bre[2], Bim[2];
#pragma unroll
        for (int k = 0; k < 2; ++k) {
            const int p = 32 * k + l31;
            const float lr = lam_re[g * 64 + p], li = lam_im[g * 64 + p];
            const float mag = expf(lr * dt);
            are[k] = mag * cosf(li * dt); aim[k] = mag * sinf(li * dt);
            const float nr = are[k] - 1.f, den = lr * lr + li * li;
            const float fre = (nr * lr + aim[k] * li) / den, fim = (aim[k] * lr - nr * li) / den;
            float vr[8], vi[8];
#pragma unroll
            for (int j = 0; j < 8; ++j) {
                const float br = b_re[(g * 64 + p) * 16 + 8 * h + j], bi = b_im[(g * 64 + p) * 16 + 8 * h + j];
                vr[j] = fre * br - fim * bi; vi[j] = fre * bi + fim * br;
            }
            u32x4 w; w.x = cvtpk(vr[0], vr[1]); w.y = cvtpk(vr[2], vr[3]); w.z = cvtpk(vr[4], vr[5]); w.w = cvtpk(vr[6], vr[7]); Bre[k] = __builtin_bit_cast(bf16x8_t, w);
            w.x = cvtpk(vi[0], vi[1]); w.y = cvtpk(vi[2], vi[3]); w.z = cvtpk(vi[4], vi[5]); w.w = cvtpk(vi[6], vi[7]); Bim[k] = __builtin_bit_cast(bf16x8_t, w);
        }
        bf16x8_t Cm[5];
        {
            const float di = dskip[g * 16 + fr];
#pragma unroll
            for (int ks = 0; ks < 5; ++ks) {
                float cv[8];
#pragma unroll
                for (int j = 0; j < 8; ++j) {
                    const int kk = 32 * ks + 8 * fq + j;
                    cv[j] = kk < 64 ? c_re[(g * 16 + fr) * 64 + kk] : (kk < 128 ? -c_im[(g * 16 + fr) * 64 + kk - 64] : ((kk - 128) == fr ? di : 0.f));
                }
                u32x4 w; w.x = cvtpk(cv[0], cv[1]); w.y = cvtpk(cv[2], cv[3]); w.z = cvtpk(cv[4], cv[5]); w.w = cvtpk(cv[6], cv[7]); Cm[ks] = __builtin_bit_cast(bf16x8_t, w);
            }
        }
        float a4r[2], a4i[2], a5r[2], a5i[2], a32r[2], a32i[2], a256r[2], a256i[2];
#pragma unroll
        for (int k = 0; k < 2; ++k) {
            float pr = are[k], pi = aim[k], t;
            t = pr * pr - pi * pi; pi = 2.f * pr * pi; pr = t;
            t = pr * pr - pi * pi; pi = 2.f * pr * pi; pr = t;
            a4r[k] = pr; a4i[k] = pi;
            a5r[k] = pr * are[k] - pi * aim[k]; a5i[k] = pr * aim[k] + pi * are[k];
#pragma unroll
            for (int i = 0; i < 3; ++i) { t = pr * pr - pi * pi; pi = 2.f * pr * pi; pr = t; }
            a32r[k] = pr; a32i[k] = pi;
#pragma unroll
            for (int i = 0; i < 3; ++i) { t = pr * pr - pi * pi; pi = 2.f * pr * pi; pr = t; }
            a256r[k] = pr; a256i[k] = pi;
        }
        const bf16_t* ub = proj + (size_t)(b * NL + 256 * wave) * P0W + g * 16 + 8 * h;
        float sre[2] = {0.f, 0.f}, sim[2] = {0.f, 0.f};
#pragma unroll 1
        for (int c0 = 0; c0 < 256; c0 += 32) {
            const bf16x8_t uf = *(const bf16x8_t*)(ub + (size_t)(c0 + l31) * P0W);
#pragma unroll
            for (int k = 0; k < 2; ++k) {
                f32x16 z;
#pragma unroll
                for (int i = 0; i < 16; ++i) z[i] = 0.f;
                const f32x16 bur = MFMA32(uf, Bre[k], z), bui = MFMA32(uf, Bim[k], z);
                float er = 0.f, ei = 0.f;
#pragma unroll
                for (int reg = 0; reg < 16; ++reg) {
                    if (reg == 0) { er = bur[0]; ei = bui[0]; }
                    else if ((reg & 3) == 0) cmadd(er, ei, a5r[k], a5i[k], bur[reg], bui[reg]);
                    else cmadd(er, ei, are[k], aim[k], bur[reg], bui[reg]);
                }
                { float tr = er, ti = ei; cmadd(tr, ti, a4r[k], a4i[k], 0.f, 0.f); er = h ? er : tr; ei = h ? ei : ti; }
                er += __shfl_xor(er, 32); ei += __shfl_xor(ei, 32);
                cmadd(sre[k], sim[k], a32r[k], a32i[k], er, ei);
            }
        }
        __syncthreads();
        if (h == 0) {
#pragma unroll
            for (int k = 0; k < 2; ++k) { Es[(wave * 64 + 32 * k + l31) * 2] = sre[k]; Es[(wave * 64 + 32 * k + l31) * 2 + 1] = sim[k]; }
        }
        __syncthreads();
        float xre[2] = {0.f, 0.f}, xim[2] = {0.f, 0.f};
        for (int w2 = 0; w2 < wave; ++w2) {
#pragma unroll
            for (int k = 0; k < 2; ++k) cmadd(xre[k], xim[k], a256r[k], a256i[k], Es[(w2 * 64 + 32 * k + l31) * 2], Es[(w2 * 64 + 32 * k + l31) * 2 + 1]);
        }
#pragma unroll 1
        for (int c0 = 0; c0 < 256; c0 += 32) {
            const bf16x8_t uf = *(const bf16x8_t*)(ub + (size_t)(c0 + l31) * P0W);
            wave_lds_fence();
            *(bf16x8_t*)(Xs + l31 * 336 + 256 + 16 * h) = uf;
#pragma unroll
            for (int k = 0; k < 2; ++k) {
                f32x16 z;
#pragma unroll
                for (int i = 0; i < 16; ++i) z[i] = 0.f;
                const f32x16 bur = MFMA32(uf, Bre[k], z), bui = MFMA32(uf, Bim[k], z);
                float cr = xre[k], ci = xim[k];
#pragma unroll
                for (int q = 0; q < 4; ++q) {
                    float ar_[4], ai_[4], br_[4], bi_[4];
                    float xr_ = cr, xi_ = ci;
#pragma unroll
                    for (int r2 = 0; r2 < 4; ++r2) { cmadd(xr_, xi_, are[k], aim[k], bur[4 * q + r2], bui[4 * q + r2]); ar_[r2] = xr_; ai_[r2] = xi_; }
                    float yr_ = __shfl_xor(xr_, 32), yi_ = __shfl_xor(xi_, 32);
#pragma unroll
                    for (int r2 = 0; r2 < 4; ++r2) { cmadd(yr_, yi_, are[k], aim[k], bur[4 * q + r2], bui[4 * q + r2]); br_[r2] = yr_; bi_[r2] = yi_; }
                    const float zr_ = __shfl_xor(yr_, 32), zi_ = __shfl_xor(yi_, 32);
                    cr = h ? yr_ : zr_; ci = h ? yi_ : zi_;
#pragma unroll
                    for (int r2 = 0; r2 < 4; ++r2) {
                        const int t = 8 * q + 4 * h + r2;
                        *(bf16_t*)(Xs + t * 336 + (32 * k + l31) * 2) = f2bf(h ? br_[r2] : ar_[r2]);
                        *(bf16_t*)(Xs + t * 336 + (64 + 32 * k + l31) * 2) = f2bf(h ? bi_[r2] : ai_[r2]);
                    }
                }
                xre[k] = cr; xim[k] = ci;
            }
            wave_lds_fence();
#pragma unroll
            for (int mt = 0; mt < 2; ++mt) {
                f32x4 y = {0.f, 0.f, 0.f, 0.f};
#pragma unroll
                for (int ks = 0; ks < 5; ++ks) {
                    const bf16x8_t a = *(const bf16x8_t*)(Xs + (16 * mt + fr) * 336 + (32 * ks + 8 * fq) * 2);
                    y = __builtin_amdgcn_mfma_f32_16x16x32_bf16(a, Cm[ks], y, 0, 0, 0);
                }
#pragma unroll
                for (int reg = 0; reg < 4; ++reg)
                    ya[(size_t)(b * NL + 256 * wave + c0 + 16 * mt + 4 * fq + reg) * 256 + g * 16 + fr] = f2bf(gelu_fast(y[reg]));
            }
        }
    }
    __syncthreads();
}

struct Params {
    const float* in[29];
    float* out;
    char* ws;
    unsigned long long pad;
};

constexpr size_t SZ_PROJ = (size_t)NT * EVEN_IN * 2;
constexpr size_t SZ_VT = (size_t)768 * NT * 2;
constexpr size_t SZ_YB = (size_t)NT * ND * 2;
constexpr size_t SZ_HB = (size_t)NT * ND * 2;
constexpr size_t SZ_YA = (size_t)NT * 256 * 2;
constexpr size_t SZ_CMP = (size_t)NB * 4 * 128 * 64 * 2;
constexpr size_t SZ_SEL = (size_t)NB * 4 * NL * 4;
constexpr size_t SZ_TAB = (size_t)16384 * ND;
constexpr size_t SZ_SKB = (size_t)2 * 8 * 2 * 128 * 128 * 2;
constexpr size_t OFF_VT = SZ_PROJ, OFF_YB = OFF_VT + SZ_VT, OFF_HB = OFF_YB + SZ_YB, OFF_YA = OFF_HB + SZ_HB, OFF_KC = OFF_YA + SZ_YA, OFF_VC = OFF_KC + SZ_CMP,
                 OFF_SEL = OFF_VC + SZ_CMP, OFF_TAB = OFF_SEL + SZ_SEL, OFF_SKB = OFF_TAB + 2 * SZ_TAB, OFF_WT = OFF_SKB + SZ_SKB;
constexpr size_t WT_IN0 = 0, WT_OUT0 = WT_IN0 + (size_t)EVEN_IN * ND * 2, WT_Q0 = WT_OUT0 + (size_t)ND * ND * 2, WT_Q1 = WT_Q0 + (size_t)2048 * ND * 2,
                 WT_IN1 = WT_Q1 + (size_t)2048 * ND * 2, WT_V1 = WT_IN1 + (size_t)ODD_PAD * ND * 2, WT_OUT1 = WT_V1 + (size_t)512 * ND * 2, WT_W1 = WT_OUT1 + (size_t)ND * ND * 2, WT_W2 = WT_W1 + (size_t)2 * 128 * 2048 * 2, WT_B1 = WT_W2 + (size_t)2 * 64 * 128 * 2, WT_V0 = WT_B1 + 2 * 128 * 4, WT_GLU = WT_V0 + (size_t)768 * ND * 2, WT_END = WT_GLU + (size_t)256 * 256 * 2;
constexpr size_t OFF_PART = OFF_WT + ((WT_END + 255) & ~(size_t)255);
constexpr size_t OFF_CQ = OFF_PART + (size_t)NT * 32 * 4;
constexpr size_t OFF_BAR = OFF_CQ + 4 * 2048 * 4;
constexpr size_t WS_NEED = OFF_BAR + XB_TOTAL_WORDS * 4 + 256;

__device__ __forceinline__ void convert_tables(const float* __restrict__ u, const float* __restrict__ v, unsigned char* __restrict__ TAB) {
    const size_t per = (size_t)16384 * ND / 16;
    for (size_t i = (size_t)blockIdx.x * NTHR + tidx(); i < 2 * per; i += (size_t)gridDim.x * NTHR) {
        const int tb = (int)(i / per); const size_t off = (i % per) * 16;
        const float* src = (tb ? v : u) + off;
        const float sc = tb ? V_SCALE : U_SCALE;
        uint4 w; unsigned* wp = (unsigned*)&w;
#pragma unroll
        for (int q = 0; q < 4; ++q) {
            const f32x4 a = __builtin_nontemporal_load((const f32x4*)(src + 4 * q));
            int pk = __builtin_amdgcn_cvt_pk_fp8_f32(a.x * sc, a.y * sc, 0, false);
            pk = __builtin_amdgcn_cvt_pk_fp8_f32(a.z * sc, a.w * sc, pk, true);
            wp[q] = (unsigned)pk;
        }
        *(uint4*)(TAB + (size_t)tb * 16384 * ND + off) = w;
    }
}

__global__ void __launch_bounds__(NTHR) fwd_megakernel(Params p) {
    extern __shared__ __attribute__((aligned(16))) unsigned char lds_raw[];
    float* lds = (float*)lds_raw;
    cg::grid_group grid = cg::this_grid();
    const float* x = p.in[0];
    float* R = p.out;
    char* ws = p.ws;
    bf16_t* PROJ = (bf16_t*)ws;
    bf16_t* YB = (bf16_t*)(ws + OFF_YB);
    bf16_t* HB = (bf16_t*)(ws + OFF_HB);
    bf16_t* YA = (bf16_t*)(ws + OFF_YA);
    bf16_t* WGT = (bf16_t*)(ws + OFF_WT + WT_GLU);
    bf16_t* KCMP = (bf16_t*)(ws + OFF_KC);
    bf16_t* VCMP = (bf16_t*)(ws + OFF_VC);
    bf16_t* W1T = (bf16_t*)(ws + OFF_WT + WT_W1);
    bf16_t* W2T = (bf16_t*)(ws + OFF_WT + WT_W2);
    float* BIAS1 = (float*)(ws + OFF_WT + WT_B1);
    unsigned* SEL = (unsigned*)(ws + OFF_SEL);
    bf16_t* WIN0 = (bf16_t*)(ws + OFF_WT + WT_IN0);
    bf16_t* WOUT0 = (bf16_t*)(ws + OFF_WT + WT_OUT0);
    bf16_t* WQ0 = (bf16_t*)(ws + OFF_WT + WT_Q0);
    bf16_t* WQ1 = (bf16_t*)(ws + OFF_WT + WT_Q1);
    bf16_t* WIN1 = (bf16_t*)(ws + OFF_WT + WT_IN1);
    bf16_t* WOUT1 = (bf16_t*)(ws + OFF_WT + WT_OUT1);
    bf16_t* WV1 = (bf16_t*)(ws + OFF_WT + WT_V1);
    bf16_t* VT = (bf16_t*)(ws + OFF_VT);
    bf16_t* WV0 = (bf16_t*)(ws + OFF_WT + WT_V0);
    int* EIDX = (int*)YB;
    float* EGATE = (float*)((char*)YB + (size_t)NT * 128 * 4);
    unsigned char* TAB = (unsigned char*)(ws + OFF_TAB);
    bf16_t* SKB = (bf16_t*)(ws + OFF_SKB);
    const int wave = tidx() >> 6;
    if (tidx() == 0) *(uint4*)(lds_raw + LDS_BYTES - 16) = make_uint4(0u, 0u, 0u, 0u);
    __syncthreads();
    XcdBarrier xbar = xcd_barrier_post((unsigned*)(ws + OFF_BAR), (volatile LAS unsigned*)(lds_raw + LDS_BYTES - 16));

    for (size_t i = (size_t)blockIdx.x * NTHR + tidx(); i < (size_t)NT * ND / 4; i += (size_t)gridDim.x * NTHR) {
        const float4 v = ((const float4*)x)[i];
        ((float4*)R)[i] = v;
        uint2 w; w.x = pack2(v.x, v.y); w.y = pack2(v.z, v.w);
        ((uint2*)HB)[i] = w;
    }
    convert_tables(p.in[23], p.in[24], TAB);
    for (int i = blockIdx.x * NTHR + tidx(); i < 2 * 8 * 2 * 128 * 128 / 4; i += gridDim.x * NTHR) {
        const float4 a = ((const float4*)p.in[22])[i];
        uint2 w; w.x = pack2(a.x, a.y); w.y = pack2(a.z, a.w);
        ((uint2*)SKB)[i] = w;
    }
    convert_wt_phase(p.in[1], ND, EVEN_IN, P0W, ColMap{{0, 0, 0}, {0, 0, 0}, {P0W, 0, 0}}, WIN0, lds);
    convert_wt_phase(p.in[1], ND, EVEN_IN, 768, ColMap{{0, 0, 0}, {P0W, 0, 0}, {768, 0, 0}}, WV0, lds);
    convert_wt_phase(p.in[12], ND, ND, ND, ColMap{{0, 0, 0}, {0, 0, 0}, {ND, 0, 0}}, WOUT0, lds);
    convert_wt_phase(p.in[10], 256, 256, 256, ColMap{{0, 0, 0}, {0, 0, 0}, {256, 0, 0}}, WGT, lds);
    convert_wt_phase(p.in[21], ND, 2048, 2048, ColMap{{0, 0, 0}, {0, 0, 0}, {2048, 0, 0}}, WQ0, lds, p.in[25]);
    convert_wt_phase(p.in[21] + (size_t)ND * 2048, ND, 2048, 2048, ColMap{{0, 0, 0}, {0, 0, 0}, {2048, 0, 0}}, WQ1, lds, p.in[25] + ND);
    {
        float* CQ = (float*)(ws + OFF_CQ);
        const int kp = tidx() >> 4, cl16 = tidx() & 15, gcol = blockIdx.x * 16 + cl16;
        if (gcol < 4096) {
            const int layer = gcol >> 11, n = gcol & 2047;
            const float* W = p.in[21] + (size_t)layer * ND * 2048;
            const float* gam = p.in[25] + layer * ND; const float* bet = p.in[26] + layer * ND;
            float c = 0.f, d = 0.f;
            for (int k = kp; k < ND; k += 32) { const float w = W[(size_t)k * 2048 + n]; c += bf2f(f2bf(gam[k] * w)); d += bet[k] * w; }
            c += __shfl_xor(c, 16); d += __shfl_xor(d, 16); c += __shfl_xor(c, 32); d += __shfl_xor(d, 32);
            __syncthreads();
            if ((tidx() & 63) < 16) { lds[(tidx() >> 6) * 32 + cl16] = c; lds[(tidx() >> 6) * 32 + 16 + cl16] = d; }
            __syncthreads();
            if (tidx() < 16) {
                float cs = 0.f, ds = 0.f;
#pragma unroll
                for (int w8 = 0; w8 < 8; ++w8) { cs += lds[w8 * 32 + tidx()]; ds += lds[w8 * 32 + 16 + tidx()]; }
                CQ[layer * 2048 + n] = cs; CQ[4096 + layer * 2048 + n] = ds;
            }
            __syncthreads();
        }
    }
    convert_wt_phase(p.in[13], ND, ODD_IN, ODD_PAD, ColMap{{0, 1792, 2048}, {0, 2048, 2560}, {1792, 256, 48}}, WIN1, lds);
    convert_wt_phase(p.in[13], ND, ODD_IN, 512, ColMap{{0, 256, 0}, {1792, 2304, 0}, {256, 256, 0}}, WV1, lds);
    convert_wt_phase(p.in[20], ND, ND, ND, ColMap{{0, 0, 0}, {0, 0, 0}, {ND, 0, 0}}, WOUT1, lds);
    convert_wt_phase(p.in[15], 2048, 128, 128, ColMap{{0, 0, 0}, {0, 0, 0}, {128, 0, 0}}, W1T, lds);
    convert_wt_phase(p.in[18], 2048, 128, 128, ColMap{{0, 0, 0}, {0, 0, 0}, {128, 0, 0}}, W1T + 128 * 2048, lds);
    convert_wt_phase(p.in[16], 128, 64, 64, ColMap{{0, 0, 0}, {0, 0, 0}, {64, 0, 0}}, W2T, lds);
    convert_wt_phase(p.in[19], 128, 64, 64, ColMap{{0, 0, 0}, {0, 0, 0}, {64, 0, 0}}, W2T + 64 * 128, lds);
    if (blockIdx.x < 32) {
        const int which = blockIdx.x >> 4, j = (blockIdx.x & 15) * 8 + (tidx() >> 6), part = tidx() & 63;
        const float* pe = which ? p.in[17] : p.in[14];
        const float* w1 = which ? p.in[18] : p.in[15];
        float a = 0.f;
#pragma unroll 8
        for (int i = part; i < 2048; i += 64) a += pe[i] * w1[(size_t)i * 128 + j];
        for (int o = 32; o; o >>= 1) a += __shfl_xor(a, o);
        if (part == 0) BIAS1[which * 128 + j] = a;
    }
    xcd_barrier(xbar);
    if (p.pad == 0x5eedull) grid.sync();
    PDUP(0) { PH(0) gemm_bf16_phase(lds_raw, HB, WIN0, NT, P0W, ND, EpiBf16s{PROJ, P0W});
    PH(0) gemm_bf16_phase(lds_raw, WV0, HB, 768, NT, ND, EpiBf16s{VT, NT}, true); }
    xcd_barrier(xbar);
    PDUP(1) { PH(1) s5_scan3_phase(PROJ, p.in[2], p.in[3], p.in[4], p.in[5], p.in[6], p.in[7], p.in[8], p.in[9], YA, lds_raw);
    PH(2) sb_attn2_phase(PROJ, VT, YB, lds_raw);
    if ((PROBE >> 13) & 1) {
        bf16_t* SCR = PROJ + (size_t)NT * P0W;
        s5_scan2_phase(PROJ, p.in[2], p.in[3], p.in[4], p.in[5], p.in[6], p.in[7], p.in[8], p.in[9], SCR, lds);
        xcd_barrier(xbar);
        float d2 = 0.f, n2 = 0.f;
        for (size_t i = (size_t)blockIdx.x * NTHR + tidx(); i < (size_t)NT * 256; i += (size_t)gridDim.x * NTHR) { const float a = bf2f(YA[i]), r = bf2f(SCR[i]); d2 += (a - r) * (a - r); n2 += r * r; }
        for (int o = 32; o; o >>= 1) { d2 += __shfl_xor(d2, o); n2 += __shfl_xor(n2, o); }
        float* chk = (float*)(ws + OFF_BAR + XB_TOTAL_WORDS * 4);
        if ((tidx() & 63) == 0) { atomicAdd(chk, d2); atomicAdd(chk + 1, n2); }
    }
    if (_rep == 0 && ((PROBE >> 1) & 1)) xcd_barrier(xbar); }
    xcd_barrier(xbar);
    PDUP(2) PH(3) glu2_phase(YA, WGT, p.in[11], YB, lds_raw);
    xcd_barrier(xbar);
    PH(4) gemm_bf16_phase(lds_raw, YB, WOUT0, NT, ND, ND, EpiResStats{R, ND, ALPHA, HB, (float*)(ws + OFF_PART)});
    xcd_barrier(xbar);
#define PEER_FFN(layer, WQ, last) \
    PH(12) gemm_q_phase(lds_raw, HB, WQ, (const float*)(ws + OFF_PART), (const float*)(ws + OFF_CQ) + (layer) * 2048, (const float*)(ws + OFF_CQ) + 4096 + (layer) * 2048, PROJ); \
    xcd_barrier(xbar); \
    PDUP(4) PH(13) peer_route2_phase(PROJ, SKB + (size_t)(layer) * 8 * 2 * 128 * 128, EIDX, EGATE, lds_raw); \
    xcd_barrier(xbar); \
    if ((PROBE >> 5) & 1) { peer_expert3_phase(R, EIDX, EGATE, TAB, TAB + (size_t)16384 * ND, p.in[27] + (layer) * ND, p.in[28] + (layer) * ND, nullptr, (float*)PROJ, xbar); xcd_barrier(xbar); } \
    PH(14) peer_expert6_phase(R, EIDX, EGATE, TAB, TAB + (size_t)16384 * ND, p.in[27] + (layer) * ND, p.in[28] + (layer) * ND, (last) ? nullptr : HB, xbar, lds, p.in[25] + (layer) * ND, p.in[26] + (layer) * ND); \
    if (!(last)) xcd_barrier(xbar);
    PEER_FFN(0, WQ0, false)
    convert_tables(p.in[23] + (size_t)16384 * ND, p.in[24] + (size_t)16384 * ND, TAB);
    PDUP(0) { PH(6) gemm_bf16_phase(lds_raw, HB, WIN1, NT, ODD_PAD, ND, EpiBf16s{PROJ, ODD_PAD});
    PH(6) gemm_bf16_phase(lds_raw, WV1, HB, 512, NT, ND, EpiBf16s{VT, NT}); }
    xcd_barrier(xbar);
    PDUP(6) PH(7) nsa_compress2_phase(PROJ, W1T, W2T, BIAS1, KCMP, VCMP, lds_raw);
    xcd_barrier(xbar);
    PDUP(7) { PH(8) nsa_cmp2_phase(PROJ, KCMP, VCMP, YB, SEL, lds_raw);
    xcd_barrier(xbar);
    PH(9) nsa_attn_phase(PROJ, VT, SEL, YB, lds_raw);
    if (_rep == 0 && ((PROBE >> 7) & 1)) xcd_barrier(xbar); }
    xcd_barrier(xbar);
    PH(10) gemm_bf16_phase(lds_raw, YB, WOUT1, NT, ND, ND, EpiResStats{R, ND, ALPHA, HB, (float*)(ws + OFF_PART)});
    xcd_barrier(xbar);
    PEER_FFN(1, WQ1, true)
    if ((PROBE >> 13) & 1) {
        xcd_barrier(xbar);
        const float* chk = (const float*)(ws + OFF_BAR + XB_TOTAL_WORDS * 4);
        const float d2 = __hip_atomic_load(chk, __ATOMIC_RELAXED, __HIP_MEMORY_SCOPE_AGENT), n2 = __hip_atomic_load(chk + 1, __ATOMIC_RELAXED, __HIP_MEMORY_SCOPE_AGENT);
        if (!(d2 <= 1e-4f * n2)) for (size_t i = (size_t)blockIdx.x * NTHR + tidx(); i < (size_t)NT * ND; i += (size_t)gridDim.x * NTHR) R[i] *= 2.f;
    }
}

}

extern "C" void kernel_launch(void* const* d_in, const int* in_sizes, int n_in, void* d_out, int out_size, void* d_ws, size_t ws_size, hipStream_t stream) {
    static int grid_blocks = 0;
    if (grid_blocks == 0) {
        if (n_in != 29 || out_size != NT * ND || ws_size < WS_NEED) { fprintf(stderr, "kernel_launch: unexpected shapes / workspace (%zu < %zu)\n", ws_size, (size_t)WS_NEED); grid_blocks = -1; return; }
        int dev = 0, cus = 0, per_cu = 0;
        hipGetDevice(&dev);
        hipDeviceGetAttribute(&cus, hipDeviceAttributeMultiprocessorCount, dev);
        hipFuncSetAttribute((const void*)fwd_megakernel, hipFuncAttributeMaxDynamicSharedMemorySize, LDS_BYTES);
        hipOccupancyMaxActiveBlocksPerMultiprocessor(&per_cu, (const void*)fwd_megakernel, NTHR, LDS_BYTES);
        if (per_cu < 1) { fprintf(stderr, "kernel_launch: occupancy query says %d blocks/CU\n", per_cu); grid_blocks = -1; return; }
        grid_blocks = cus;
    }
    if (grid_blocks < 0) return;
    hipMemsetAsync((char*)d_ws + OFF_BAR, 0, XB_TOTAL_WORDS * 4 + 256, stream);
    Params p{};
    for (int i = 0; i < 29; ++i) p.in[i] = (const float*)d_in[i];
    p.out = (float*)d_out; p.ws = (char*)d_ws; p.pad = 0;
    void* args[] = {&p};
    hipError_t e = hipLaunchCooperativeKernel((const void*)fwd_megakernel, dim3(grid_blocks), dim3(NTHR), args, LDS_BYTES, stream);
    if (e != hipSuccess) fprintf(stderr, "cooperative launch failed: %s (grid %d)\n", hipGetErrorString(e), grid_blocks);
}
```

```cpp
#include <hip/hip_runtime.h>
#include <hip/hip_cooperative_groups.h>
#include <math.h>
#include <stdint.h>
#include <cstdio>
namespace cg = cooperative_groups;

__device__ __forceinline__ int tidx() { int t = threadIdx.x; asm volatile("" : "+v"(t)); return t; }
#define XB_TMO      128
#define XB_XCNT(j)  (256  + 64 * (j))
#define XB_XSUB(j)  (1280 + 64 * (j))
#define XB_XGEN(j)  (2304 + 64 * (j))
#define XB_TOP      3328
#define XB_TOPGEN   3392
#define XCD_BAR_WORDS 3456
#define XB_SPIN_CAP (1u << 18)
#define LAS __attribute__((address_space(3)))

__device__ __forceinline__ unsigned xb_ld(unsigned* p)              { return __hip_atomic_load(p, __ATOMIC_RELAXED, __HIP_MEMORY_SCOPE_AGENT); }
__device__ __forceinline__ unsigned xb_add(unsigned* p, unsigned v) { return __hip_atomic_fetch_add(p, v, __ATOMIC_RELAXED, __HIP_MEMORY_SCOPE_AGENT); }
__device__ __forceinline__ unsigned xb_xcc_id() { return (unsigned)__builtin_amdgcn_s_getreg((3 << 11) | 20) & 0xFu; }
#define XB_SPIN(cond, bar) do { unsigned _sp = 0; while (cond) { __builtin_amdgcn_s_sleep(1); \
    if ((++_sp & 255u) == 0u) { if (xb_ld(&(bar)[XB_TMO])) break; if (_sp > XB_SPIN_CAP) { atomicAdd(&(bar)[XB_TMO], 1u); break; } } } } while (0)

struct XcdBarrier {
    unsigned* bar; unsigned x;
    volatile LAS unsigned* st;
};

__device__ __forceinline__ XcdBarrier xcd_barrier_post(unsigned* bar, volatile LAS unsigned* st) {
    XcdBarrier b; b.bar = bar; b.x = xb_xcc_id(); b.st = st;
    if (tidx() == 0) (void)xb_add(&bar[XB_XCNT(b.x)], 1u);
    return b;
}
__device__ __forceinline__ void xcd_barrier_complete(unsigned* bar, unsigned x, unsigned& nloc, unsigned& nx) {
    const unsigned G = gridDim.x * gridDim.y * gridDim.z;
    unsigned sum, cnt, mine, sp = 0u;
    for (;;) {
        sum = 0u; cnt = 0u; mine = 0u;
#pragma unroll
        for (unsigned j = 0; j < 16; ++j) { const unsigned c = xb_ld(&bar[XB_XCNT(j)]); sum += c; cnt += (c > 0u) ? 1u : 0u; mine = (j == x) ? c : mine; }
        if (sum == G) break;
        __builtin_amdgcn_s_sleep(1);
        if ((++sp & 255u) == 0u) { if (xb_ld(&bar[XB_TMO])) break; if (sp > XB_SPIN_CAP) { atomicAdd(&bar[XB_TMO], 1u); break; } }
    }
    nloc = mine > 0u ? mine : 1u; nx = cnt > 0u ? cnt : 1u;
}

__device__ __forceinline__ void xcd_barrier(const XcdBarrier& b) {
    asm volatile("s_waitcnt vmcnt(0)" ::: "memory");
    __syncthreads();
    if (tidx() == 0) {
        unsigned* bar = b.bar;
        __builtin_amdgcn_s_waitcnt(0);
        unsigned nloc = b.st[0], nx = b.st[1];
        if (nloc == 0u) { xcd_barrier_complete(bar, b.x, nloc, nx); b.st[0] = nloc; b.st[1] = nx; }
        const unsigned old = xb_add(&bar[XB_XSUB(b.x)], 1u);
        const unsigned gen = old / nloc;
        if (old + 1u == (gen + 1u) * nloc) {
            __builtin_amdgcn_fence(__ATOMIC_RELEASE, "agent");
            asm volatile("s_waitcnt vmcnt(0)" ::: "memory");
            const unsigned og = xb_add(&bar[XB_TOP], 1u);
            const unsigned tg = og / nx;
            if (og + 1u == (tg + 1u) * nx) xb_add(&bar[XB_TOPGEN], 1u);
            else XB_SPIN(xb_ld(&bar[XB_TOPGEN]) == tg, bar);
            __builtin_amdgcn_fence(__ATOMIC_ACQUIRE, "agent");
            xb_add(&bar[XB_XGEN(b.x)], 1u);
            asm volatile("s_waitcnt vmcnt(0)" ::: "memory");
        } else {
            XB_SPIN(xb_ld(&bar[XB_XGEN(b.x)]) == gen, bar);
            __builtin_amdgcn_fence(__ATOMIC_ACQUIRE, "agent");
            asm volatile("s_waitcnt vmcnt(0)" ::: "memory");
        }
    }
    __syncthreads();
}

#define XB_ALIGN(j) (XCD_BAR_WORDS + 64 * (j))
#define XB_TOTAL_WORDS (XCD_BAR_WORDS + 64 * 16)
__device__ __forceinline__ void xcc_align(const XcdBarrier& b) {
    __syncthreads();
    if (tidx() == 0) {
        const unsigned nloc = b.st[0];
        if (nloc) {
            const unsigned old = xb_add(&b.bar[XB_ALIGN(b.x)], 1u), gen = old / nloc;
            unsigned sp = 0;
            while (xb_ld(&b.bar[XB_ALIGN(b.x)]) < (gen + 1u) * nloc && ++sp < (1u << 16)) __builtin_amdgcn_s_sleep(1);
        }
    }
    __syncthreads();
}
namespace pg8 {
#define PG8_LAS __attribute__((address_space(3)))
typedef unsigned short bf16_t;
typedef short bf16x8 __attribute__((ext_vector_type(8)));
typedef float f32x4 __attribute__((ext_vector_type(4)));
typedef unsigned u32x4 __attribute__((ext_vector_type(4)));
constexpr int BM = 256, BK = 64, HALF = 128, HTB = HALF * BK * 2  , STAGE_BYTES = 8 * HTB, NXCD = 8, WGM = 8;

__host__ __device__ __forceinline__ int lds_byte(int r, int c) { const int st = (r >> 4) * 2 + (c >> 5), rr = r & 15, cc = c & 31, ob = rr * 64 + cc * 2; return st * 1024 + (ob ^ (((ob >> 9) & 1) << 5)); }
__host__ __device__ __forceinline__ void stage_rc(int b, int& R, int& C) { const int st = b / 1024, sb = b % 1024, swz = sb ^ (((sb >> 9) & 1) << 5); R = (st >> 1) * 16 + swz / 64; C = (st & 1) * 32 + (swz % 64) / 2; }
__host__ __device__ __forceinline__ int perm32(int rho) { const int n = rho >> 4, i = rho & 15; return 8 * (i >> 2) + 4 * n + (i & 3); }

struct Unit { int pm, pn; };
struct Gemm { const bf16_t* A; const bf16_t* Bt; int M, N, K; };

struct StaticOrder {
    int nM, nN, nwg, G, c;
    __host__ __device__ void init(int M, int N, int G_, int c_) { nM = M / BM; nN = N / BM; nwg = nM * nN; G = G_; c = c_; }
    __host__ __device__ bool next(int i, Unit& u) const {
        const long L = (long)i * G + c; if (L >= nwg) return false;
        int wgid = (int)L; { const int q = nwg / NXCD, r = nwg % NXCD, xcd = wgid % NXCD, off = wgid / NXCD; wgid = (xcd < r ? xcd * (q + 1) : r * (q + 1) + (xcd - r) * q) + off; }
        const int nig = WGM * nN, gid = wgid / nig, fm = gid * WGM, gsz = (nM - fm) < WGM ? (nM - fm) : WGM;
        u.pm = fm + ((wgid % nig) % gsz); u.pn = (wgid % nig) / gsz; return true;
    }
    __device__ __forceinline__ void a_ready(const Unit&) const {}
    __device__ __forceinline__ void done(const Unit&) const {}
};
__device__ __forceinline__ unsigned cvt_pk_bf16(float lo, float hi) { unsigned r; asm volatile("v_cvt_pk_bf16_f32 %0, %1, %2" : "=v"(r) : "v"(lo), "v"(hi)); return r; }
template <class Epi, class Sched, bool STAMP = false>
__device__ __forceinline__ void gemm_phase(PG8_LAS unsigned char* lds, const Gemm g, const Sched& S, const Epi& E, unsigned long long* stamps) {
    const int tid = tidx(), wid = __builtin_amdgcn_readfirstlane(tid >> 6), lane = tid & 63, wr = wid >> 2, wc = wid & 3, fr = lane & 15, fq = lane >> 4;
    const int K = g.K, nt = K / BK;
    int ts_lo = 0, ts_hi = 0, nts = 0; const unsigned long long rt_entry = STAMP ? (unsigned long long)wall_clock64() : 0ull;
#define PG8_STAMP() do { if (STAMP && wid == 0 && nts < 64) { const unsigned long long _c = (unsigned long long)clock64(); \
        ts_lo = (lane == nts) ? (int)(unsigned)_c : ts_lo; ts_hi = (lane == nts) ? (int)(unsigned)(_c >> 32) : ts_hi; ++nts; } } while (0)
    PG8_STAMP();
    unsigned voffA[2], voffB[2];
#pragma unroll
    for (int i = 0; i < 2; ++i) { int R, C; stage_rc(tid * 16 + i * 8192, R, C); const int Rb = Epi::PERM ? ((R & ~31) + perm32(R & 31)) : R;
        voffA[i] = (unsigned)(R * K + C) * 2u; voffB[i] = (unsigned)(Rb * K + C) * 2u; }
    const size_t kstep = (size_t)(BK * 2);
    const size_t hstep = (size_t)HALF * K * 2;
    const size_t tstep = 2 * hstep;
    const unsigned ldsw = (unsigned)wid * 1024u;
    const int aoff = lds_byte(wr * 64 + fr, fq * 8), boff = lds_byte(wc * 32 + fr, fq * 8);
#define PG8_SA(b, h) (((b) * 2 + (h)) * HTB)
#define PG8_SB(b, h) ((4 + (b) * 2 + (h)) * HTB)
#define PG8_STAGE(bufoff, gbase, voff) do { _Pragma("unroll") for (int _i = 0; _i < 2; ++_i) \
        __builtin_amdgcn_global_load_lds((const unsigned*)((const char*)(gbase) + (voff)[_i]), (PG8_LAS unsigned*)(lds + (bufoff) + ldsw + _i * 8192), 16, 0, 0); } while (0)
#define PG8_LDA(dst, b, h) do { _Pragma("unroll") for (int m = 0; m < 4; ++m) _Pragma("unroll") for (int k = 0; k < 2; ++k) dst[m][k] = *(const PG8_LAS bf16x8*)(lds + PG8_SA(b, h) + aoff + m * 2048 + k * 1024); } while (0)
#define PG8_LDB(dst, b, h) do { _Pragma("unroll") for (int n = 0; n < 2; ++n) _Pragma("unroll") for (int k = 0; k < 2; ++k) dst[n][k] = *(const PG8_LAS bf16x8*)(lds + PG8_SB(b, h) + boff + n * 2048 + k * 1024); } while (0)
#define PG8_MMA(ai, bj, At, Bt) do { __builtin_amdgcn_s_setprio(1); _Pragma("unroll") for (int m = 0; m < 4; ++m) _Pragma("unroll") for (int n = 0; n < 2; ++n) _Pragma("unroll") for (int k = 0; k < 2; ++k) \
        acc[ai][bj][m][n] = __builtin_amdgcn_mfma_f32_16x16x32_bf16(Bt[n][k], At[m][k], acc[ai][bj][m][n], 0, 0, 0); __builtin_amdgcn_s_setprio(0); } while (0)
#define PG8_WAIT_V(n) asm volatile("s_waitcnt vmcnt(" #n ")" ::: "memory")
#define PG8_WAIT_L(n) asm volatile("s_waitcnt lgkmcnt(" #n ")" ::: "memory")
#define PG8_BAR __builtin_amdgcn_s_barrier()
#define PG8_SCHED __builtin_amdgcn_sched_barrier(0)
    Unit cur, nxt; int ui = 0;
    if (!S.next(0, cur)) return;
    f32x4 acc[2][2][4][2];
#pragma unroll
    for (int a = 0; a < 2; ++a)
#pragma unroll
        for (int b = 0; b < 2; ++b)
#pragma unroll
            for (int m = 0; m < 4; ++m)
#pragma unroll
                for (int n = 0; n < 2; ++n) acc[a][b][m][n] = (f32x4){0.f, 0.f, 0.f, 0.f};
    bf16x8 At[4][2], B0[2][2], B1[2][2];
    const char* cA = (const char*)g.A + (size_t)cur.pm * tstep; const char* cB = (const char*)g.Bt + (size_t)cur.pn * tstep;
    S.a_ready(cur);
    PG8_STAGE(PG8_SB(0, 0), cB, voffB); PG8_STAGE(PG8_SA(0, 0), cA, voffA); PG8_STAGE(PG8_SB(0, 1), cB + hstep, voffB); PG8_STAGE(PG8_SA(0, 1), cA + hstep, voffA);
    if (wr == 1) PG8_BAR;
    PG8_WAIT_V(4); PG8_BAR;
    PG8_STAGE(PG8_SB(1, 0), cB + kstep, voffB); PG8_STAGE(PG8_SA(1, 0), cA + kstep, voffA); PG8_STAGE(PG8_SB(1, 1), cB + hstep + kstep, voffB);
    PG8_WAIT_V(6); PG8_BAR;
    PG8_STAMP();
    for (;;) {
        const bool has_next = S.next(ui + 1, nxt);
        const char* nA = has_next ? (const char*)g.A + (size_t)nxt.pm * tstep : cA; const char* nB = has_next ? (const char*)g.Bt + (size_t)nxt.pn * tstep : cB;
        for (int t = 0; t < nt; t += 2) {
            const bool last = (t == nt - 2);
            const char* a1 = cA + (size_t)(t + 1) * kstep;
            const char* a2 = last ? nA : cA + (size_t)(t + 2) * kstep; const char* b2 = last ? nB : cB + (size_t)(t + 2) * kstep;
            const char* a3 = a2 + kstep; const char* b3 = b2 + kstep;
            if (last && has_next) S.a_ready(nxt);
            PG8_LDB(B0, 0, 0); PG8_SCHED; PG8_LDA(At, 0, 0); PG8_STAGE(PG8_SA(1, 1), a1 + hstep, voffA);
            PG8_WAIT_L(8); PG8_BAR; PG8_WAIT_L(0); PG8_MMA(0, 0, At, B0); PG8_BAR; PG8_SCHED;
            PG8_LDB(B1, 0, 1); PG8_STAGE(PG8_SB(0, 0), b2, voffB);
            PG8_BAR; PG8_WAIT_L(0); PG8_MMA(0, 1, At, B1); PG8_BAR;
            PG8_LDA(At, 0, 1); PG8_STAGE(PG8_SA(0, 0), a2, voffA);
            PG8_BAR; PG8_WAIT_L(0); PG8_MMA(1, 0, At, B0); PG8_BAR; PG8_SCHED;
            PG8_STAGE(PG8_SB(0, 1), b2 + hstep, voffB);
            PG8_WAIT_V(6); PG8_BAR; PG8_MMA(1, 1, At, B1); PG8_BAR;
            PG8_LDB(B0, 1, 0); PG8_SCHED; PG8_LDA(At, 1, 0); PG8_STAGE(PG8_SA(0, 1), a2 + hstep, voffA);
            PG8_WAIT_L(8); PG8_BAR; PG8_WAIT_L(0); PG8_MMA(0, 0, At, B0); PG8_BAR; PG8_SCHED;
            PG8_LDB(B1, 1, 1); PG8_STAGE(PG8_SB(1, 0), b3, voffB);
            PG8_BAR; PG8_WAIT_L(0); PG8_MMA(0, 1, At, B1); PG8_BAR;
            PG8_LDA(At, 1, 1); PG8_STAGE(PG8_SA(1, 0), a3, voffA);
            PG8_BAR; PG8_WAIT_L(0); PG8_MMA(1, 0, At, B0); PG8_BAR; PG8_SCHED;
            PG8_STAGE(PG8_SB(1, 1), b3 + hstep, voffB);
            PG8_WAIT_V(6); PG8_BAR; PG8_MMA(1, 1, At, B1); PG8_BAR;
        }
        PG8_STAMP();
        if constexpr (!Epi::AFTER_DRAIN) { E(acc, cur, wr, wc, fr, fq); S.done(cur); }
        PG8_STAMP();
        if (!has_next) break;
#pragma unroll
        for (int a = 0; a < 2; ++a)
#pragma unroll
            for (int b = 0; b < 2; ++b)
#pragma unroll
                for (int m = 0; m < 4; ++m)
#pragma unroll
                    for (int n = 0; n < 2; ++n) acc[a][b][m][n] = (f32x4){0.f, 0.f, 0.f, 0.f};
        cur = nxt; cA = nA; cB = nB; ++ui;
    }
    PG8_WAIT_V(0);
    if (wr == 0) PG8_BAR;
    PG8_BAR;
    if constexpr (Epi::AFTER_DRAIN) { E.fused(acc, cur, wr, wc, fr, fq, lds, wid, lane); S.done(cur); }
    PG8_STAMP();
    if (STAMP && wid == 0) { stamps[lane] = lane < nts ? (((unsigned long long)(unsigned)ts_hi << 32) | (unsigned)ts_lo) : 0ull;
        if (lane == 62) stamps[62] = rt_entry; if (lane == 63) stamps[63] = (unsigned long long)wall_clock64(); }
#undef PG8_STAMP
#undef PG8_SA
#undef PG8_SB
#undef PG8_STAGE
#undef PG8_LDA
#undef PG8_LDB
#undef PG8_MMA
#undef PG8_WAIT_V
#undef PG8_WAIT_L
#undef PG8_BAR
#undef PG8_SCHED
}
}

namespace {
using pg8::bf16_t;
typedef float f32x4 __attribute__((ext_vector_type(4)));
typedef unsigned u32x4 __attribute__((ext_vector_type(4)));

constexpr int NB = 16, NL = 2048, ND = 1024, NT = NB * NL;
constexpr int EVEN_IN = 2560, ODD_IN = 2608, ODD_PAD = 2304;
constexpr float ALPHA = 1.41421356237f;
constexpr float LN_EPS = 1e-5f;
constexpr float U_SCALE = 256.f, V_SCALE = 16.f;
constexpr int NTHR = 512;
constexpr int LDS_BYTES = 163840;
#ifndef PROBE
#define PROBE 0
#endif
#define PDUP(bit) for (int _rep = 0; _rep < ((PROBE >> (bit)) & 1) + 1; ++_rep)
#ifndef PHMASK
#define PHMASK 0xFFFFFFFFu
#endif
#define PH(n) if (PHMASK & (1u << (n)))

__device__ __forceinline__ float bf2f(bf16_t v) { return __uint_as_float((unsigned)v << 16); }
__device__ __forceinline__ bf16_t f2bf(float f) { unsigned u = __float_as_uint(f); u += 0x7FFFu + ((u >> 16) & 1u); return (bf16_t)(u >> 16); }
__device__ __forceinline__ unsigned pack2(float lo, float hi) { return (unsigned)f2bf(lo) | ((unsigned)f2bf(hi) << 16); }
__device__ __forceinline__ void ld8(const bf16_t* p, float* o) {
    const uint4 v = *(const uint4*)p;
    o[0] = __uint_as_float(v.x << 16); o[1] = __uint_as_float(v.x & 0xffff0000u);
    o[2] = __uint_as_float(v.y << 16); o[3] = __uint_as_float(v.y & 0xffff0000u);
    o[4] = __uint_as_float(v.z << 16); o[5] = __uint_as_float(v.z & 0xffff0000u);
    o[6] = __uint_as_float(v.w << 16); o[7] = __uint_as_float(v.w & 0xffff0000u);
}
__device__ __forceinline__ void st8(bf16_t* p, const float* o) {
    uint4 v; v.x = pack2(o[0], o[1]); v.y = pack2(o[2], o[3]); v.z = pack2(o[4], o[5]); v.w = pack2(o[6], o[7]);
    *(uint4*)p = v;
}

struct EpiBf16s {
    static constexpr bool PERM = true, AFTER_DRAIN = false;
    bf16_t* O; int ldc;
    __device__ __forceinline__ void operator()(const f32x4 (&acc)[2][2][4][2], const pg8::Unit& u, int wr, int wc, int fr, int fq) const {
        const int row0 = u.pm * 256 + wr * 64 + fr, col0 = u.pn * 256 + wc * 32 + 8 * fq;
#pragma unroll
        for (int ai = 0; ai < 2; ++ai)
#pragma unroll
            for (int m = 0; m < 4; ++m) { bf16_t* rowp = O + (size_t)(row0 + ai * 128 + m * 16) * ldc + col0;
#pragma unroll
                for (int bj = 0; bj < 2; ++bj) { const f32x4 v0 = acc[ai][bj][m][0], v1 = acc[ai][bj][m][1];
                    u32x4 w; w.x = pg8::cvt_pk_bf16(v0[0], v0[1]); w.y = pg8::cvt_pk_bf16(v0[2], v0[3]); w.z = pg8::cvt_pk_bf16(v1[0], v1[1]); w.w = pg8::cvt_pk_bf16(v1[2], v1[3]);
                    *(u32x4*)(rowp + bj * 128) = w; } }
    }
};
struct EpiRes {
    static constexpr bool PERM = false, AFTER_DRAIN = false;
    float* C; int ldc; float alpha; float* Cout;
    __device__ __forceinline__ void operator()(const f32x4 (&acc)[2][2][4][2], const pg8::Unit& u, int wr, int wc, int fr, int fq) const {
        const int row0 = u.pm * 256 + wr * 64 + fr, col0 = u.pn * 256 + wc * 32 + 4 * fq; const size_t dlt = Cout - C;
#pragma unroll
        for (int ai = 0; ai < 2; ++ai)
#pragma unroll
            for (int m = 0; m < 4; ++m) { float* rowp = C + (size_t)(row0 + ai * 128 + m * 16) * ldc + col0;
#pragma unroll
                for (int bj = 0; bj < 2; ++bj)
#pragma unroll
                    for (int n = 0; n < 2; ++n) { f32x4* cp = (f32x4*)(rowp + bj * 128 + n * 16); *(cp + dlt / 4) = *cp * alpha + acc[ai][bj][m][n]; } }
    }
};

struct EpiResStats {
    static constexpr bool PERM = false, AFTER_DRAIN = false;
    const float* Cin; float* C; int ldc; float alpha; bf16_t* Vb; float* part;
    __device__ __forceinline__ void operator()(const f32x4 (&acc)[2][2][4][2], const pg8::Unit& u, int wr, int wc, int fr, int fq) const {
        const int row0 = u.pm * 256 + wr * 64 + fr, col0 = u.pn * 256 + wc * 32 + 4 * fq;
#pragma unroll
        for (int ai = 0; ai < 2; ++ai)
#pragma unroll
            for (int m = 0; m < 4; ++m) {
                const int row = row0 + ai * 128 + m * 16;
                float* rowp = C + (size_t)row * ldc + col0;
                const float* rowi = Cin + (size_t)row * ldc + col0;
                bf16_t* rowb = Vb + (size_t)row * ldc + col0;
                float s1 = 0.f, s2 = 0.f;
#pragma unroll
                for (int bj = 0; bj < 2; ++bj)
#pragma unroll
                    for (int n = 0; n < 2; ++n) {
                        f32x4* cp = (f32x4*)(rowp + bj * 128 + n * 16);
                        const f32x4 v = *(const f32x4*)(rowi + bj * 128 + n * 16) * alpha + acc[ai][bj][m][n];
                        *cp = v;
                        *(uint2*)(rowb + bj * 128 + n * 16) = make_uint2(pg8::cvt_pk_bf16(v[0], v[1]), pg8::cvt_pk_bf16(v[2], v[3]));
                        s1 += (v[0] + v[1]) + (v[2] + v[3]);
                        s2 += (v[0] * v[0] + v[1] * v[1]) + (v[2] * v[2] + v[3] * v[3]);
                    }
                s1 += __shfl_xor(s1, 16); s2 += __shfl_xor(s2, 16);
                s1 += __shfl_xor(s1, 32); s2 += __shfl_xor(s2, 32);
                if (fq == 0) *(float2*)(part + ((size_t)row * 16 + u.pn * 4 + wc) * 2) = make_float2(s1, s2);
            }
    }
};
struct EpiBf16LN {
    static constexpr bool PERM = true, AFTER_DRAIN = false;
    bf16_t* O; int ldc; const float* csum; const float* dvec; const float2* stats  ; int pm0, pm1, pm2, pm3;
    __device__ __forceinline__ void operator()(const f32x4 (&acc)[2][2][4][2], const pg8::Unit& u, int wr, int wc, int fr, int fq) const {
        const int slot = (u.pm == pm0) ? 0 : ((u.pm == pm1) ? 1 : ((u.pm == pm2) ? 2 : 3));
        const float2* st = stats + slot * 256;
        const int lrow0 = wr * 64 + fr, col0 = u.pn * 256 + wc * 32 + 8 * fq;
        f32x4 cv[2][2], dv[2][2];
#pragma unroll
        for (int bj = 0; bj < 2; ++bj)
#pragma unroll
            for (int n = 0; n < 2; ++n) { cv[bj][n] = *(const f32x4*)(csum + col0 + bj * 128 + 4 * n); dv[bj][n] = *(const f32x4*)(dvec + col0 + bj * 128 + 4 * n); }
#pragma unroll
        for (int ai = 0; ai < 2; ++ai)
#pragma unroll
            for (int m = 0; m < 4; ++m) {
                const int lrow = lrow0 + ai * 128 + m * 16;
                const float2 ms = st[lrow];
                bf16_t* rowp = O + (size_t)(u.pm * 256 + lrow) * ldc + col0;
#pragma unroll
                for (int bj = 0; bj < 2; ++bj) {
                    const f32x4 v0 = (acc[ai][bj][m][0] - cv[bj][0] * ms.x) * ms.y + dv[bj][0], v1 = (acc[ai][bj][m][1] - cv[bj][1] * ms.x) * ms.y + dv[bj][1];
                    u32x4 w; w.x = pg8::cvt_pk_bf16(v0[0], v0[1]); w.y = pg8::cvt_pk_bf16(v0[2], v0[3]); w.z = pg8::cvt_pk_bf16(v1[0], v1[1]); w.w = pg8::cvt_pk_bf16(v1[2], v1[3]);
                    *(u32x4*)(rowp + bj * 128) = w;
                }
            }
    }
};
__device__ __forceinline__ void gemm_q_phase(unsigned char* lds, const bf16_t* Vb, const bf16_t* Wt, const float* __restrict__ part, const float* csum, const float* dvec, bf16_t* Q) {
    pg8::StaticOrder S; S.init(NT, 2048, (int)gridDim.x, (int)blockIdx.x);
    int pms[4] = {-1, -1, -1, -1};
    float2* st = (float2*)(lds + 131072);
    __syncthreads();
#pragma unroll
    for (int i = 0; i < 4; ++i) {
        pg8::Unit u;
        if (S.next(i, u)) {
            bool seen = false;
#pragma unroll
            for (int j = 0; j < 4; ++j) if (j < i && pms[j] == u.pm) seen = true;
            pms[i] = seen ? -2 - i : u.pm;
            if (!seen && tidx() < 256) {
                const int row = u.pm * 256 + tidx();
                const float4* pp = (const float4*)(part + (size_t)row * 32);
                float s1 = 0.f, s2 = 0.f;
#pragma unroll
                for (int k = 0; k < 8; ++k) { const float4 a = pp[k]; s1 += a.x; s2 += a.y; s1 += a.z; s2 += a.w; }
                const float mean = s1 * (1.f / ND), var = fmaxf(s2 * (1.f / ND) - mean * mean, 0.f);
                st[i * 256 + tidx()] = make_float2(mean, rsqrtf(var + LN_EPS));
            }
        }
    }
    __syncthreads();
    pg8::Gemm g{Vb, Wt, NT, 2048, ND};
    EpiBf16LN E{Q, 2048, csum, dvec, st, pms[0], pms[1], pms[2], pms[3]};
    pg8::gemm_phase<EpiBf16LN, pg8::StaticOrder, false>((PG8_LAS unsigned char*)lds, g, S, E, nullptr);
    __syncthreads();
}
template <class Epi>
__device__ __forceinline__ void gemm_bf16_phase(unsigned char* lds, const bf16_t* A, const bf16_t* Bt, int M, int N, int K, const Epi& E, bool reverse_ids = false) {
    pg8::Gemm g{A, Bt, M, N, K};
    pg8::StaticOrder S; S.init(M, N, (int)gridDim.x, reverse_ids ? (int)(gridDim.x - 1 - blockIdx.x) : (int)blockIdx.x);
    pg8::gemm_phase<Epi, pg8::StaticOrder, false>((PG8_LAS unsigned char*)lds, g, S, E, nullptr);
    __syncthreads();
}

struct ColMap { int d0[3], s0[3], len[3]; };
__device__ __forceinline__ void convert_wt_phase(const float* __restrict__ W, int K, int N, int Npad, const ColMap cm, bf16_t* __restrict__ Wt, float* lds, const float* __restrict__ rowscale = nullptr) {
    float(*tile)[65] = (float(*)[65])lds;
    const int tid = tidx(), ntn = Npad / 64, ntiles = (K / 64) * ntn;
    for (int it = blockIdx.x; it < ntiles; it += gridDim.x) {
        const int k0 = (it / ntn) * 64, n0 = (it % ntn) * 64;
        __syncthreads();
#pragma unroll
        for (int h = 0; h < 2; ++h) {
            const int r = (tid >> 4) + h * 32, c4 = (tid & 15) * 4, nd = n0 + c4;
            int ns = -1;
#pragma unroll
            for (int sg = 0; sg < 3; ++sg) if (nd >= cm.d0[sg] && nd < cm.d0[sg] + cm.len[sg]) ns = cm.s0[sg] + (nd - cm.d0[sg]);
            float4 v = make_float4(0.f, 0.f, 0.f, 0.f);
            if (ns >= 0) v = *(const float4*)(W + (size_t)(k0 + r) * N + ns);
            if (rowscale) { const float gsc = rowscale[k0 + r]; v.x *= gsc; v.y *= gsc; v.z *= gsc; v.w *= gsc; }
            tile[r][c4] = v.x; tile[r][c4 + 1] = v.y; tile[r][c4 + 2] = v.z; tile[r][c4 + 3] = v.w;
        }
        __syncthreads();
        const int n = tid >> 3, k8 = (tid & 7) * 8;
        float o[8];
#pragma unroll
        for (int j = 0; j < 8; ++j) o[j] = tile[k8 + j][n];
        st8(Wt + (size_t)(n0 + n) * K + k0 + k8, o);
    }
    __syncthreads();
}
__device__ __forceinline__ float gelu_tanh(float x) {
    float u = 0.7978845608028654f * (x + 0.044715f * x * x * x);
    return 0.5f * x * (1.f + tanhf(u));
}
__device__ __forceinline__ float sigmoidf_(float x) { return 1.f / (1.f + expf(-x)); }
__device__ __forceinline__ void wave_lds_fence() { asm volatile("s_waitcnt lgkmcnt(0)" ::: "memory"); }

__device__ __forceinline__ void s5_scan_wave(int bg, const bf16_t* __restrict__ proj, const float* __restrict__ lam_re, const float* __restrict__ lam_im,
                             const float* __restrict__ log_dt, const float* __restrict__ b_re, const float* __restrict__ b_im,
                             const float* __restrict__ c_re, const float* __restrict__ c_im, const float* __restrict__ dskip,
                             float* __restrict__ ya, float* lds) {
    const int b = bg >> 4, g = bg & 15, lane = tidx() & 63;
    float(*us)[16] = (float(*)[16])lds;
    float(*xr)[65] = (float(*)[65])(lds + 1024);
    float(*xi)[65] = (float(*)[65])(lds + 1024 + 4160);
    float(*cr)[64] = (float(*)[64])(lds + 1024 + 8320);
    float(*ci)[64] = (float(*)[64])(lds + 1024 + 8320 + 1024);
    const float lr = lam_re[g * 64 + lane], li = lam_im[g * 64 + lane];
    const float dt = expf(log_dt[g]);
    const float mag = expf(lr * dt);
    const float are = mag * cosf(li * dt), aim = mag * sinf(li * dt);
    const float nr = are - 1.f, den = lr * lr + li * li;
    const float fre = (nr * lr + aim * li) / den, fim = (aim * lr - nr * li) / den;
    float bbr[16], bbi[16];
#pragma unroll
    for (int i = 0; i < 16; ++i) {
        const float br = b_re[(g * 64 + lane) * 16 + i], bi = b_im[(g * 64 + lane) * 16 + i];
        bbr[i] = fre * br - fim * bi; bbi[i] = fre * bi + fim * br;
    }
    for (int idx = lane; idx < 1024; idx += 64) { cr[idx >> 6][idx & 63] = c_re[g * 1024 + idx]; ci[idx >> 6][idx & 63] = c_im[g * 1024 + idx]; }
    float dsk[16];
#pragma unroll
    for (int i = 0; i < 16; ++i) dsk[i] = dskip[g * 16 + i];
    float xre = 0.f, xim = 0.f;
    for (int t0 = 0; t0 < NL; t0 += 64) {
        wave_lds_fence();
        for (int idx = lane; idx < 1024; idx += 64) { const int t = idx >> 4, i = idx & 15; us[t][i] = bf2f(proj[(size_t)(b * NL + t0 + t) * EVEN_IN + g * 16 + i]); }
        wave_lds_fence();
        for (int t = 0; t < 64; ++t) {
            float bur = 0.f, bui = 0.f;
#pragma unroll
            for (int i = 0; i < 16; ++i) { const float u = us[t][i]; bur += bbr[i] * u; bui += bbi[i] * u; }
            const float nre = are * xre - aim * xim + bur, nim = are * xim + aim * xre + bui;
            xre = nre; xim = nim;
            xr[t][lane] = xre; xi[t][lane] = xim;
        }
        wave_lds_fence();
        float y[16];
#pragma unroll
        for (int i = 0; i < 16; ++i) y[i] = 0.f;
        for (int p = 0; p < 64; ++p) {
            const float a = xr[lane][p], bq = xi[lane][p];
#pragma unroll
            for (int i = 0; i < 16; ++i) y[i] += cr[i][p] * a - ci[i][p] * bq;
        }
#pragma unroll
        for (int i = 0; i < 16; ++i) {
            const float v = y[i] + dsk[i] * us[lane][i];
            ya[(size_t)(b * NL + t0 + lane) * 256 + g * 16 + i] = gelu_tanh(v);
        }
    }
}

__device__ __forceinline__ void sb_attn_wave(int task, const bf16_t* __restrict__ proj, bf16_t* __restrict__ Y, float* wl) {
    const int qt = task & 31, h = (task >> 5) % 12, b = task / 384, lane = tidx() & 63;
    const int t = qt * 64 + lane;
    float(*ks)[64] = (float(*)[64])wl;
    float(*vs)[64] = (float(*)[64])(wl + 2048);
    const bf16_t* base = proj + (size_t)b * NL * EVEN_IN;
    float q[64], acc[64];
#pragma unroll
    for (int d = 0; d < 64; d += 8) ld8(base + (size_t)t * EVEN_IN + 256 + h * 64 + d, q + d);
#pragma unroll
    for (int d = 0; d < 64; ++d) acc[d] = 0.f;
    float tail = 0.f;
    for (int c = 2 * qt + 1; c >= 0; --c) {
        wave_lds_fence();
        for (int i = 0; i < 32; ++i) {
            ks[i][lane] = bf2f(base[(size_t)(c * 32 + i) * EVEN_IN + 1024 + h * 64 + lane]);
            vs[i][lane] = bf2f(base[(size_t)(c * 32 + i) * EVEN_IN + 1792 + h * 64 + lane]);
        }
        wave_lds_fence();
        for (int s = 31; s >= 0; --s) {
            const int key = c * 32 + s;
            float z = 0.f;
#pragma unroll
            for (int d = 0; d < 64; ++d) z += q[d] * ks[s][d];
            z *= 0.125f;
            const bool valid = key < t;
            const float sp = fmaxf(z, 0.f) + log1pf(expf(-fabsf(z)));
            const float w = valid ? expf(z - sp + tail) : 0.f;
#pragma unroll
            for (int d = 0; d < 64; ++d) acc[d] += w * vs[s][d];
            if (valid) tail -= sp;
        }
        if (__all(tail < -120.f)) break;
    }
#pragma unroll
    for (int d = 0; d < 64; d += 8) st8(Y + (size_t)(b * NL + t) * ND + 256 + h * 64 + d, acc + d);
}

__device__ __forceinline__ void glu_phase(const float* __restrict__ ya, const float* __restrict__ wglu, const float* __restrict__ bglu, bf16_t* __restrict__ Y, float* lds) {
    const int half = tidx() >> 8, c = tidx() & 255;
    float(*ys)[256] = (float(*)[256])(lds + half * 4096);
    for (int it = blockIdx.x; it < NT / 32; it += gridDim.x) {
        const int t0 = it * 32 + half * 16;
        __syncthreads();
        for (int i = 0; i < 16; ++i) ys[i][c] = ya[(size_t)(t0 + i) * 256 + c];
        __syncthreads();
        float acc[16];
#pragma unroll
        for (int i = 0; i < 16; ++i) acc[i] = 0.f;
        for (int k = 0; k < 256; ++k) {
            const float w = wglu[k * 256 + c];
#pragma unroll
            for (int i = 0; i < 16; ++i) acc[i] += ys[i][k] * w;
        }
        const float bb = bglu[c];
#pragma unroll
        for (int i = 0; i < 16; ++i) Y[(size_t)(t0 + i) * ND + c] = f2bf(ys[i][c] * sigmoidf_(acc[i] + bb));
    }
    __syncthreads();
}

__device__ __forceinline__ void ln_row_wave(float4 (&v)[4], const float* __restrict__ g, const float* __restrict__ bta, float* out, bf16_t* outb, int lane) {
    float s = 0.f;
#pragma unroll
    for (int j = 0; j < 4; ++j) s += v[j].x + v[j].y + v[j].z + v[j].w;
    for (int o = 32; o; o >>= 1) s += __shfl_xor(s, o);
    const float mean = s * (1.f / ND);
    float s2 = 0.f;
#pragma unroll
    for (int j = 0; j < 4; ++j) {
        v[j].x -= mean; v[j].y -= mean; v[j].z -= mean; v[j].w -= mean;
        s2 += v[j].x * v[j].x + v[j].y * v[j].y + v[j].z * v[j].z + v[j].w * v[j].w;
    }
    for (int o = 32; o; o >>= 1) s2 += __shfl_xor(s2, o);
    const float rs = rsqrtf(s2 * (1.f / ND) + LN_EPS);
#pragma unroll
    for (int j = 0; j < 4; ++j) {
        const float4 gg = *(const float4*)(g + j * 256 + lane * 4), bb = *(const float4*)(bta + j * 256 + lane * 4);
        const float4 o = make_float4(v[j].x * rs * gg.x + bb.x, v[j].y * rs * gg.y + bb.y, v[j].z * rs * gg.z + bb.z, v[j].w * rs * gg.w + bb.w);
        *(float4*)(out + j * 256 + lane * 4) = o;
        if (outb) { uint2 w; w.x = pack2(o.x, o.y); w.y = pack2(o.z, o.w); *(uint2*)(outb + j * 256 + lane * 4) = w; }
    }
}
__device__ __forceinline__ void ln_phase(float* R, bf16_t* Hb, const float* __restrict__ g, const float* __restrict__ bta) {
    const int wave = tidx() >> 6, lane = tidx() & 63;
    for (int row = blockIdx.x * 8 + wave; row < NT; row += gridDim.x * 8) {
        float4 v[4];
#pragma unroll
        for (int j = 0; j < 4; ++j) v[j] = *(const float4*)(R + (size_t)row * ND + j * 256 + lane * 4);
        ln_row_wave(v, g, bta, R + (size_t)row * ND, Hb + (size_t)row * ND, lane);
    }
}

__device__ __forceinline__ void wave_argmax(float& bv, int& bi) {
#pragma unroll
    for (int o = 32; o; o >>= 1) {
        const float ov = __shfl_xor(bv, o); const int oi = __shfl_xor(bi, o);
        if (ov > bv || (ov == bv && oi < bi)) { bv = ov; bi = oi; }
    }
}
__device__ __forceinline__ void peer_route_phase(const bf16_t* __restrict__ qbuf, const float* __restrict__ subk, int* __restrict__ eidx, float* __restrict__ egate, float* lds) {
    const int head = tidx() >> 6, lane = tidx() & 63;
    float* qs = lds + head * 256;
    for (int token = blockIdx.x; token < NT; token += gridDim.x) {
        const bf16_t* qp = qbuf + (size_t)token * 2048 + head * 256;
        wave_lds_fence();
        for (int i = 0; i < 4; ++i) qs[lane + 64 * i] = bf2f(qp[lane + 64 * i]);
        wave_lds_fence();
        float myv[2]; int myi[2];
#pragma unroll
        for (int c = 0; c < 2; ++c) {
            float sc[2];
#pragma unroll
            for (int w2 = 0; w2 < 2; ++w2) {
                const float* kr = subk + ((size_t)(head * 2 + c) * 128 + lane + 64 * w2) * 128;
                float a = 0.f;
#pragma unroll 4
                for (int d = 0; d < 128; d += 4) {
                    const float4 kv = *(const float4*)(kr + d);
                    a += qs[c * 128 + d] * kv.x + qs[c * 128 + d + 1] * kv.y + qs[c * 128 + d + 2] * kv.z + qs[c * 128 + d + 3] * kv.w;
                }
                sc[w2] = a;
            }
            float a0 = sc[0], a1 = sc[1];
            float mv = -INFINITY; int mi = 0;
            for (int r = 0; r < 16; ++r) {
                float bv; int bi;
                if (a0 >= a1) { bv = a0; bi = lane; } else { bv = a1; bi = lane + 64; }
                wave_argmax(bv, bi);
                if (lane == r) { mv = bv; mi = bi; }
                if (bi == lane) a0 = -INFINITY; else if (bi == lane + 64) a1 = -INFINITY;
            }
            myv[c] = mv; myi[c] = mi;
        }
        const float va = __shfl(myv[0], lane >> 2);
        float cand[4];
#pragma unroll
        for (int j = 0; j < 4; ++j) cand[j] = va + __shfl(myv[1], (lane & 3) * 4 + j);
        float topv = -INFINITY; int topf = 0;
        for (int r = 0; r < 16; ++r) {
            float bv = cand[0]; int bi = lane * 4;
#pragma unroll
            for (int j = 1; j < 4; ++j) if (cand[j] > bv) { bv = cand[j]; bi = lane * 4 + j; }
            wave_argmax(bv, bi);
            if (lane == r) { topv = bv; topf = bi; }
#pragma unroll
            for (int j = 0; j < 4; ++j) if (bi == lane * 4 + j) cand[j] = -INFINITY;
        }
        const int e1 = __shfl(myi[0], topf >> 4), e2 = __shfl(myi[1], topf & 15);
        const float top0 = __shfl(topv, 0);
        float ex = (lane < 16) ? expf(topv - top0) : 0.f;
        float sum = ex;
        for (int o = 32; o; o >>= 1) sum += __shfl_xor(sum, o);
        if (lane < 16) {
            eidx[(size_t)token * 128 + head * 16 + lane] = e1 * 128 + e2;
            egate[(size_t)token * 128 + head * 16 + lane] = ex / sum;
        }
    }
}

__device__ __forceinline__ void peer_expert_phase(float* R, const int* __restrict__ eidx, const float* __restrict__ egate, const float* __restrict__ utab,
                                  const float* __restrict__ vtab, const float* __restrict__ lg, const float* __restrict__ lb, bf16_t* Hb) {
    const int wave = tidx() >> 6, lane = tidx() & 63;
    for (int token = blockIdx.x * 8 + wave; token < NT; token += gridDim.x * 8) {
        float4 x[4], acc[4];
#pragma unroll
        for (int j = 0; j < 4; ++j) { x[j] = *(const float4*)(R + (size_t)token * ND + j * 256 + lane * 4); acc[j] = make_float4(0.f, 0.f, 0.f, 0.f); }
        for (int e0 = 0; e0 < 128; e0 += 4) {
            float dot[4]; int ex[4]; float gt[4];
#pragma unroll
            for (int k = 0; k < 4; ++k) {
                ex[k] = eidx[(size_t)token * 128 + e0 + k]; gt[k] = egate[(size_t)token * 128 + e0 + k];
                const float* ur = utab + (size_t)ex[k] * ND + lane * 4;
                float a = 0.f;
#pragma unroll
                for (int j = 0; j < 4; ++j) { const float4 u = *(const float4*)(ur + j * 256); a += x[j].x * u.x + x[j].y * u.y + x[j].z * u.z + x[j].w * u.w; }
                dot[k] = a;
            }
#pragma unroll
            for (int k = 0; k < 4; ++k) {
                float a = dot[k];
                for (int o = 32; o; o >>= 1) a += __shfl_xor(a, o);
                const float coef = gt[k] * gelu_tanh(a);
                const float* vr = vtab + (size_t)ex[k] * ND + lane * 4;
#pragma unroll
                for (int j = 0; j < 4; ++j) { const float4 v = *(const float4*)(vr + j * 256); acc[j].x += coef * v.x; acc[j].y += coef * v.y; acc[j].z += coef * v.z; acc[j].w += coef * v.w; }
            }
        }
#pragma unroll
        for (int j = 0; j < 4; ++j) { x[j].x = ALPHA * x[j].x + acc[j].x; x[j].y = ALPHA * x[j].y + acc[j].y; x[j].z = ALPHA * x[j].z + acc[j].z; x[j].w = ALPHA * x[j].w + acc[j].w; }
        ln_row_wave(x, lg, lb, R + (size_t)token * ND, Hb ? Hb + (size_t)token * ND : nullptr, lane);
    }
}


typedef short bf16x8_t __attribute__((ext_vector_type(8)));
__device__ __forceinline__ int f2key(float f) { const int b = __float_as_int(f); return b ^ ((b >> 31) & 0x7fffffff); }
__device__ __forceinline__ float key2f(int k) { return __int_as_float(k ^ ((k >> 31) & 0x7fffffff)); }
#define CE_DESC_I(a, b) do { const int _hi = max(a, b), _lo = min(a, b); a = _hi; b = _lo; } while (0)
template <int N, int K, int J> __device__ __forceinline__ void bstage(int (&v)[N]) {
#pragma unroll
    for (int i = 0; i < N; ++i) {
        const int l = i ^ J;
        if (l > i) { if ((i & K) == 0) CE_DESC_I(v[i], v[l]); else CE_DESC_I(v[l], v[i]); }
    }
}
__device__ __forceinline__ void sort16_desc(int (&v)[16]) {
    bstage<16, 2, 1>(v); bstage<16, 4, 2>(v); bstage<16, 4, 1>(v); bstage<16, 8, 4>(v); bstage<16, 8, 2>(v); bstage<16, 8, 1>(v);
    bstage<16, 16, 8>(v); bstage<16, 16, 4>(v); bstage<16, 16, 2>(v); bstage<16, 16, 1>(v);
}
__device__ __forceinline__ void sort8_desc(int (&v)[8]) {
    bstage<8, 2, 1>(v); bstage<8, 4, 2>(v); bstage<8, 4, 1>(v); bstage<8, 8, 4>(v); bstage<8, 8, 2>(v); bstage<8, 8, 1>(v);
}
__device__ __forceinline__ void bitonic_merge16_desc(int (&v)[16]) {
    bstage<16, 16, 8>(v); bstage<16, 16, 4>(v); bstage<16, 16, 2>(v); bstage<16, 16, 1>(v);
}
__device__ __forceinline__ void xmerge16(int (&v)[16], int off) {
    int m[16];
#pragma unroll
    for (int i = 0; i < 16; ++i) m[i] = max(v[i], __shfl_xor(v[15 - i], off));
    bitonic_merge16_desc(m);
#pragma unroll
    for (int i = 0; i < 16; ++i) v[i] = m[i];
}
__device__ __forceinline__ void opaque16(int (&v)[16]) {
#pragma unroll
    for (int i = 0; i < 16; ++i) asm volatile("" : "+v"(v[i]));
}
__device__ __forceinline__ int lookup16(const int (&arr)[16], int a) {
    int r = arr[0];
#pragma unroll
    for (int i = 1; i < 16; ++i) r = (a == i) ? arr[i] : r;
    return r;
}
__device__ __forceinline__ void peer_route2_phase(const bf16_t* __restrict__ qbuf, const bf16_t* __restrict__ skb, int* __restrict__ eidx, float* __restrict__ egate, unsigned char* lds) {
    const int tid = tidx(), wave = tid >> 6, lane = tid & 63, fr = lane & 15, fq = lane >> 4;
    for (int chunk = blockIdx.x; chunk < NT / 128; chunk += gridDim.x) {
        const int token = chunk * 128 + wave * 16 + fr;
        int* tl = (int*)(lds + 34816) + (wave * 16 + fr) * 48;
        for (int h = 0; h < 8; ++h) {
            int K1[16], K2[16];
#pragma unroll
            for (int c = 0; c < 2; ++c) {
                __syncthreads();
#pragma unroll
                for (int i = 0; i < 4; ++i) {
                    const int idx = tid + 512 * i, row = idx >> 4, ch = idx & 15;
                    *(uint4*)(lds + row * 272 + ch * 16) = *(const uint4*)(skb + ((size_t)(h * 2 + c) * 128 + row) * 128 + ch * 8);
                }
                __syncthreads();
                bf16x8_t qf[4];
#pragma unroll
                for (int sI = 0; sI < 4; ++sI) qf[sI] = *(const bf16x8_t*)(qbuf + (size_t)token * 2048 + h * 256 + c * 128 + 32 * sI + 8 * fq);
                int va[16], vb[16];
#pragma unroll
                for (int n = 0; n < 8; ++n) {
                    f32x4 S = {0.f, 0.f, 0.f, 0.f};
#pragma unroll
                    for (int sI = 0; sI < 4; ++sI) {
                        const bf16x8_t kf = *(const bf16x8_t*)(lds + (16 * n + fr) * 272 + (32 * sI + 8 * fq) * 2);
                        S = __builtin_amdgcn_mfma_f32_16x16x32_bf16(kf, qf[sI], S, 0, 0, 0);
                    }
#pragma unroll
                    for (int j = 0; j < 4; ++j) {
                        const int key = (f2key(S[j]) & ~127) | (16 * n + 4 * fq + j);
                        if (n < 4) va[n * 4 + j] = key; else vb[(n - 4) * 4 + j] = key;
                    }
                }
                sort16_desc(va); sort16_desc(vb);
                int m[16];
#pragma unroll
                for (int i = 0; i < 16; ++i) m[i] = max(va[i], vb[15 - i]);
                bitonic_merge16_desc(m);
                xmerge16(m, 16); xmerge16(m, 32);
#pragma unroll
                for (int i = 0; i < 16; ++i) { if (c == 0) K1[i] = m[i]; else K2[i] = m[i]; }
                if (fq == 0) {
#pragma unroll
                    for (int i = 0; i < 4; ++i) *(int4*)(tl + c * 16 + 4 * i) = make_int4(m[4 * i], m[4 * i + 1], m[4 * i + 2], m[4 * i + 3]);
                }
            }
            wave_lds_fence();
            float vaf[4];
#pragma unroll
            for (int k = 0; k < 4; ++k) vaf[k] = key2f(tl[4 * k + fq]);
            int A[16];
#pragma unroll
            for (int b = 0; b < 16; ++b) {
                const bool valid = (fq + 1) * (b + 1) <= 16;
                const int key = (f2key(vaf[0] + key2f(K2[b])) & ~127) | (fq << 5) | b;
                A[b] = valid ? key : INT_MIN;
            }
            int Bq[8];
#pragma unroll
            for (int b = 0; b < 3; ++b) {
                const bool valid = (fq + 5) * (b + 1) <= 16;
                const int key = (f2key(vaf[1] + key2f(K2[b])) & ~127) | (fq << 5) | (16 + b);
                Bq[b] = valid ? key : INT_MIN;
            }
            Bq[3] = (f2key(vaf[2] + key2f(K2[0])) & ~127) | (fq << 5) | 19;
            Bq[4] = (f2key(vaf[3] + key2f(K2[0])) & ~127) | (fq << 5) | 20;
            Bq[5] = INT_MIN; Bq[6] = INT_MIN; Bq[7] = INT_MIN;
            sort8_desc(Bq);
#pragma unroll
            for (int i = 8; i < 16; ++i) A[i] = max(A[i], Bq[15 - i]);
            bitonic_merge16_desc(A);
            xmerge16(A, 16); xmerge16(A, 32);
            if (fq == 0) {
#pragma unroll
                for (int i = 0; i < 4; ++i) *(int4*)(tl + 32 + 4 * i) = make_int4(A[4 * i], A[4 * i + 1], A[4 * i + 2], A[4 * i + 3]);
            }
            wave_lds_fence();
            const int4 myT = *(const int4*)(tl + 32 + 4 * fq);
            const int tsel[4] = {myT.x, myT.y, myT.z, myT.w};
            const float top0 = key2f(A[0]);
            float sum = 0.f;
#pragma unroll
            for (int r = 0; r < 16; ++r) sum += __expf(key2f(A[r]) - top0);
            const float inv = 1.f / sum;
            int eo[4]; float go[4];
#pragma unroll
            for (int kk = 0; kk < 4; ++kk) {
                const int t = tsel[kk];
                const int id = t & 127, ofq = id >> 5, slot = id & 31;
                const int k = slot < 16 ? 0 : (slot < 19 ? 1 : (slot == 19 ? 2 : 3));
                const int b = slot < 16 ? slot : (slot < 19 ? slot - 16 : 0);
                const int a = ofq + 4 * k;
                const int e1 = tl[a] & 127, e2 = tl[16 + b] & 127;
                eo[kk] = e1 * 128 + e2;
                go[kk] = __expf(key2f(t) - top0) * inv;
            }
            *(int4*)(eidx + (size_t)token * 128 + h * 16 + 4 * fq) = make_int4(eo[0], eo[1], eo[2], eo[3]);
            *(float4*)(egate + (size_t)token * 128 + h * 16 + 4 * fq) = make_float4(go[0], go[1], go[2], go[3]);
            wave_lds_fence();
        }
    }
    __syncthreads();
}

typedef __bf16 bf16x2_t __attribute__((ext_vector_type(2)));
typedef float f32x2_t __attribute__((ext_vector_type(2)));
__device__ __forceinline__ float dot2bf(unsigned a, unsigned b, float acc) { return __builtin_amdgcn_fdot2_f32_bf16(__builtin_bit_cast(bf16x2_t, a), __builtin_bit_cast(bf16x2_t, b), acc, false); }
__device__ __forceinline__ float gelu_fast(float x) {
    const float u = 0.7978845608028654f * (x + 0.044715f * x * x * x);
    return x / (1.f + __expf(-2.f * u));
}
__device__ __forceinline__ void peer_expert2_phase(float* R, const int* __restrict__ eidx, const float* __restrict__ egate, const bf16_t* __restrict__ ub,
                                                   const bf16_t* __restrict__ vb, const float* __restrict__ lg, const float* __restrict__ lb, bf16_t* Hb) {
    const int wave = tidx() >> 6, lane = tidx() & 63;
    for (int token = blockIdx.x * 8 + wave; token < NT; token += gridDim.x * 8) {
        float xf[16];
        {
            const float* rp = R + (size_t)token * ND + lane * 8;
            const float4 a0 = *(const float4*)rp, a1 = *(const float4*)(rp + 4), b0 = *(const float4*)(rp + 512), b1 = *(const float4*)(rp + 516);
            xf[0] = a0.x; xf[1] = a0.y; xf[2] = a0.z; xf[3] = a0.w; xf[4] = a1.x; xf[5] = a1.y; xf[6] = a1.z; xf[7] = a1.w;
            xf[8] = b0.x; xf[9] = b0.y; xf[10] = b0.z; xf[11] = b0.w; xf[12] = b1.x; xf[13] = b1.y; xf[14] = b1.z; xf[15] = b1.w;
        }
        unsigned xp[8];
#pragma unroll
        for (int j = 0; j < 8; ++j) xp[j] = pack2(xf[2 * j], xf[2 * j + 1]);
        float acc[16];
#pragma unroll
        for (int j = 0; j < 16; ++j) acc[j] = 0.f;
        const int e_lo = eidx[(size_t)token * 128 + lane], e_hi = eidx[(size_t)token * 128 + 64 + lane];
        const float g_lo = egate[(size_t)token * 128 + lane], g_hi = egate[(size_t)token * 128 + 64 + lane];
        for (int grp = 0; grp < 16; ++grp) {
            const int esel = grp < 8 ? e_lo : e_hi;
            const float gsel = grp < 8 ? g_lo : g_hi;
            const int lbase = (grp & 7) * 8;
            uint4 u0[8], u1[8];
            int exs[8];
#pragma unroll
            for (int k = 0; k < 8; ++k) {
                exs[k] = __builtin_amdgcn_readlane(esel, lbase + k);
                const bf16_t* up = ub + (size_t)exs[k] * ND + lane * 8;
                u0[k] = *(const uint4*)up; u1[k] = *(const uint4*)(up + 512);
            }
            float d[8];
#pragma unroll
            for (int k = 0; k < 8; ++k) {
                float a = dot2bf(u0[k].x, xp[0], 0.f), b = dot2bf(u0[k].y, xp[1], 0.f);
                a = dot2bf(u0[k].z, xp[2], a); b = dot2bf(u0[k].w, xp[3], b);
                a = dot2bf(u1[k].x, xp[4], a); b = dot2bf(u1[k].y, xp[5], b);
                a = dot2bf(u1[k].z, xp[6], a); b = dot2bf(u1[k].w, xp[7], b);
                d[k] = a + b;
            }
            const bool hi5 = lane & 32, hi4 = lane & 16, hi3 = lane & 8;
            float r4[4], r2[2], r1;
#pragma unroll
            for (int k = 0; k < 4; ++k) { const float send = hi5 ? d[k] : d[k + 4], keep = hi5 ? d[k + 4] : d[k]; r4[k] = keep + __shfl_xor(send, 32); }
#pragma unroll
            for (int k = 0; k < 2; ++k) { const float send = hi4 ? r4[k] : r4[k + 2], keep = hi4 ? r4[k + 2] : r4[k]; r2[k] = keep + __shfl_xor(send, 16); }
            { const float send = hi3 ? r2[0] : r2[1], keep = hi3 ? r2[1] : r2[0]; r1 = keep + __shfl_xor(send, 8); }
            r1 += __shfl_xor(r1, 4); r1 += __shfl_xor(r1, 2); r1 += __shfl_xor(r1, 1);
            uint4 v0[8], v1[8];
#pragma unroll
            for (int k = 0; k < 8; ++k) {
                const bf16_t* vp = vb + (size_t)exs[k] * ND + lane * 8;
                v0[k] = *(const uint4*)vp; v1[k] = *(const uint4*)(vp + 512);
            }
            const float gk = __shfl(gsel, lbase + (lane >> 3));
            const float coef = gk * gelu_fast(r1);
#pragma unroll
            for (int k = 0; k < 8; ++k) {
                const float ck = __int_as_float(__builtin_amdgcn_readlane(__float_as_int(coef), 8 * k));
                const unsigned w[8] = {v0[k].x, v0[k].y, v0[k].z, v0[k].w, v1[k].x, v1[k].y, v1[k].z, v1[k].w};
#pragma unroll
                for (int j = 0; j < 8; ++j) {
                    acc[2 * j] += ck * __uint_as_float(w[j] << 16);
                    acc[2 * j + 1] += ck * __uint_as_float(w[j] & 0xffff0000u);
                }
            }
        }
        {
            const float* rp = R + (size_t)token * ND + lane * 8;
            const float4 a0 = *(const float4*)rp, a1 = *(const float4*)(rp + 4), b0 = *(const float4*)(rp + 512), b1 = *(const float4*)(rp + 516);
            xf[0] = a0.x; xf[1] = a0.y; xf[2] = a0.z; xf[3] = a0.w; xf[4] = a1.x; xf[5] = a1.y; xf[6] = a1.z; xf[7] = a1.w;
            xf[8] = b0.x; xf[9] = b0.y; xf[10] = b0.z; xf[11] = b0.w; xf[12] = b1.x; xf[13] = b1.y; xf[14] = b1.z; xf[15] = b1.w;
        }
        float s = 0.f;
#pragma unroll
        for (int j = 0; j < 16; ++j) { xf[j] = ALPHA * xf[j] + acc[j]; s += xf[j]; }
        for (int o = 32; o; o >>= 1) s += __shfl_xor(s, o);
        const float mean = s * (1.f / ND);
        float s2 = 0.f;
#pragma unroll
        for (int j = 0; j < 16; ++j) { xf[j] -= mean; s2 += xf[j] * xf[j]; }
        for (int o = 32; o; o >>= 1) s2 += __shfl_xor(s2, o);
        const float rs = rsqrtf(s2 * (1.f / ND) + LN_EPS);
#pragma unroll
        for (int hf = 0; hf < 2; ++hf) {
            const int c0 = hf * 512 + lane * 8;
            const float4 g0 = *(const float4*)(lg + c0), g1 = *(const float4*)(lg + c0 + 4), b0 = *(const float4*)(lb + c0), b1 = *(const float4*)(lb + c0 + 4);
            float o[8];
            o[0] = xf[hf * 8 + 0] * rs * g0.x + b0.x; o[1] = xf[hf * 8 + 1] * rs * g0.y + b0.y; o[2] = xf[hf * 8 + 2] * rs * g0.z + b0.z; o[3] = xf[hf * 8 + 3] * rs * g0.w + b0.w;
            o[4] = xf[hf * 8 + 4] * rs * g1.x + b1.x; o[5] = xf[hf * 8 + 5] * rs * g1.y + b1.y; o[6] = xf[hf * 8 + 6] * rs * g1.z + b1.z; o[7] = xf[hf * 8 + 7] * rs * g1.w + b1.w;
            float* op = R + (size_t)token * ND + c0;
            *(float4*)op = make_float4(o[0], o[1], o[2], o[3]); *(float4*)(op + 4) = make_float4(o[4], o[5], o[6], o[7]);
            if (Hb) st8(Hb + (size_t)token * ND + c0, o);
        }
    }
}


template <int K2, int J> __device__ __forceinline__ void bsort_round(int (&k)[2], float (&g)[2], int lane) {
    if (J == 64) {
        const bool sw = k[0] > k[1];
        const int t = k[0]; const float tg = g[0];
        k[0] = sw ? k[1] : k[0]; g[0] = sw ? g[1] : g[0]; k[1] = sw ? t : k[1]; g[1] = sw ? tg : g[1];
    } else {
#pragma unroll
        for (int r = 0; r < 2; ++r) {
            const int pk = __shfl_xor(k[r], J); const float pg = __shfl_xor(g[r], J);
            const bool asc = (((lane + 64 * r) & K2) == 0), lower = ((lane & J) == 0);
            const bool take = (lower == asc) ? (pk < k[r]) : (pk > k[r]);
            k[r] = take ? pk : k[r]; g[r] = take ? pg : g[r];
        }
    }
}
template <int K2> __device__ __forceinline__ void bsort_stage(int (&k)[2], float (&g)[2], int lane) {
    if (K2 >= 128) bsort_round<K2, 64>(k, g, lane);
    if (K2 >= 64) bsort_round<K2, 32>(k, g, lane);
    if (K2 >= 32) bsort_round<K2, 16>(k, g, lane);
    if (K2 >= 16) bsort_round<K2, 8>(k, g, lane);
    if (K2 >= 8) bsort_round<K2, 4>(k, g, lane);
    if (K2 >= 4) bsort_round<K2, 2>(k, g, lane);
    bsort_round<K2, 1>(k, g, lane);
}
__device__ __forceinline__ void sort_routing(int& e_lo, int& e_hi, float& g_lo, float& g_hi, int lane) {
    int k[2] = {e_lo, e_hi}; float g[2] = {g_lo, g_hi};
    bsort_stage<2>(k, g, lane); bsort_stage<4>(k, g, lane); bsort_stage<8>(k, g, lane); bsort_stage<16>(k, g, lane);
    bsort_stage<32>(k, g, lane); bsort_stage<64>(k, g, lane); bsort_stage<128>(k, g, lane);
    e_lo = k[0]; e_hi = k[1]; g_lo = g[0]; g_hi = g[1];
}
__device__ __forceinline__ void peer_expert3_phase(float* R, const int* __restrict__ eidx, const float* __restrict__ egate, const unsigned char* __restrict__ ub,
                                                   const unsigned char* __restrict__ vb, const float* __restrict__ lg, const float* __restrict__ lb, bf16_t* Hb, float* Rout, const XcdBarrier& xb) {
    const int wave = tidx() >> 6, lane = tidx() & 63;
    int itk = 0;
    for (int token = blockIdx.x * 8 + wave; token < NT; token += gridDim.x * 8, ++itk) {
        if ((itk & 1) == 0 && itk) xcd_barrier(xb);
        float xf[16];
        {
            const float* rp = R + (size_t)token * ND + lane * 16;
#pragma unroll
            for (int q = 0; q < 4; ++q) { const float4 a = *(const float4*)(rp + 4 * q); xf[4 * q] = a.x; xf[4 * q + 1] = a.y; xf[4 * q + 2] = a.z; xf[4 * q + 3] = a.w; }
        }
        float acc[16];
#pragma unroll
        for (int j = 0; j < 16; ++j) acc[j] = 0.f;
        int e_lo = eidx[(size_t)token * 128 + lane], e_hi = eidx[(size_t)token * 128 + 64 + lane];
        float g_lo = egate[(size_t)token * 128 + lane], g_hi = egate[(size_t)token * 128 + 64 + lane];
        sort_routing(e_lo, e_hi, g_lo, g_hi, lane);
        for (int grp = 0; grp < 16; ++grp) {
            const int esel = grp < 8 ? e_lo : e_hi;
            const float gsel = grp < 8 ? g_lo : g_hi;
            const int lbase = (grp & 7) * 8;
            uint4 u[8], v[8];
#pragma unroll
            for (int k = 0; k < 8; ++k) {
                const int ex = __builtin_amdgcn_readlane(esel, lbase + k);
                u[k] = *(const uint4*)(ub + (size_t)ex * ND + lane * 16);
                v[k] = *(const uint4*)(vb + (size_t)ex * ND + lane * 16);
            }
            float d[8];
#pragma unroll
            for (int k = 0; k < 8; ++k) {
                const unsigned w[4] = {u[k].x, u[k].y, u[k].z, u[k].w};
                float a = 0.f, b = 0.f;
#pragma unroll
                for (int q = 0; q < 4; ++q) {
                    const f32x2_t lo = __builtin_amdgcn_cvt_pk_f32_fp8((int)w[q], false), hi = __builtin_amdgcn_cvt_pk_f32_fp8((int)w[q], true);
                    a = fmaf(xf[4 * q], lo.x, a); b = fmaf(xf[4 * q + 1], lo.y, b); a = fmaf(xf[4 * q + 2], hi.x, a); b = fmaf(xf[4 * q + 3], hi.y, b);
                }
                d[k] = a + b;
            }
            const bool hi5 = lane & 32, hi4 = lane & 16, hi3 = lane & 8;
            float r4[4], r2[2], r1;
#pragma unroll
            for (int k = 0; k < 4; ++k) { const float send = hi5 ? d[k] : d[k + 4], keep = hi5 ? d[k + 4] : d[k]; r4[k] = keep + __shfl_xor(send, 32); }
#pragma unroll
            for (int k = 0; k < 2; ++k) { const float send = hi4 ? r4[k] : r4[k + 2], keep = hi4 ? r4[k + 2] : r4[k]; r2[k] = keep + __shfl_xor(send, 16); }
            { const float send = hi3 ? r2[0] : r2[1], keep = hi3 ? r2[1] : r2[0]; r1 = keep + __shfl_xor(send, 8); }
            r1 += __shfl_xor(r1, 4); r1 += __shfl_xor(r1, 2); r1 += __shfl_xor(r1, 1);
            const float gk = __shfl(gsel, lbase + (lane >> 3));
            const float coef = gk * gelu_fast(r1 * (1.f / U_SCALE)) * (1.f / V_SCALE);
#pragma unroll
            for (int k = 0; k < 8; ++k) {
                const float ck = __int_as_float(__builtin_amdgcn_readlane(__float_as_int(coef), 8 * k));
                const unsigned w[4] = {v[k].x, v[k].y, v[k].z, v[k].w};
#pragma unroll
                for (int q = 0; q < 4; ++q) {
                    const f32x2_t lo = __builtin_amdgcn_cvt_pk_f32_fp8((int)w[q], false), hi = __builtin_amdgcn_cvt_pk_f32_fp8((int)w[q], true);
                    acc[4 * q] = fmaf(ck, lo.x, acc[4 * q]); acc[4 * q + 1] = fmaf(ck, lo.y, acc[4 * q + 1]);
                    acc[4 * q + 2] = fmaf(ck, hi.x, acc[4 * q + 2]); acc[4 * q + 3] = fmaf(ck, hi.y, acc[4 * q + 3]);
                }
            }
        }
        float s = 0.f;
#pragma unroll
        for (int j = 0; j < 16; ++j) { xf[j] = ALPHA * xf[j] + acc[j]; s += xf[j]; }
        for (int o = 32; o; o >>= 1) s += __shfl_xor(s, o);
        const float mean = s * (1.f / ND);
        float s2 = 0.f;
#pragma unroll
        for (int j = 0; j < 16; ++j) { xf[j] -= mean; s2 += xf[j] * xf[j]; }
        for (int o = 32; o; o >>= 1) s2 += __shfl_xor(s2, o);
        const float rs = rsqrtf(s2 * (1.f / ND) + LN_EPS);
        float o[16];
#pragma unroll
        for (int q = 0; q < 4; ++q) {
            const float4 gg = *(const float4*)(lg + lane * 16 + 4 * q), bb = *(const float4*)(lb + lane * 16 + 4 * q);
            o[4 * q] = xf[4 * q] * rs * gg.x + bb.x; o[4 * q + 1] = xf[4 * q + 1] * rs * gg.y + bb.y; o[4 * q + 2] = xf[4 * q + 2] * rs * gg.z + bb.z; o[4 * q + 3] = xf[4 * q + 3] * rs * gg.w + bb.w;
            *(float4*)(Rout + (size_t)token * ND + lane * 16 + 4 * q) = make_float4(o[4 * q], o[4 * q + 1], o[4 * q + 2], o[4 * q + 3]);
        }
        if (Hb) { st8(Hb + (size_t)token * ND + lane * 16, o); st8(Hb + (size_t)token * ND + lane * 16 + 8, o + 8); }
    }
}


struct Rows8 { uint4 r[8]; };
__device__ __forceinline__ void rows_load(Rows8& G, int esel, int lbase, const unsigned char* __restrict__ tb, int lane) {
#pragma unroll
    for (int k = 0; k < 8; ++k) {
        const int ex = __builtin_amdgcn_readlane(esel, lbase + k);
        G.r[k] = *(const uint4*)(tb + (size_t)ex * ND + lane * 16);
    }
}
__device__ __forceinline__ void sweep_u(const Rows8& G, const float (&xf)[16], float gsel, int lbase, int lane, float* cl  , int grp) {
    float d[8];
#pragma unroll
    for (int k = 0; k < 8; ++k) {
        const unsigned w[4] = {G.r[k].x, G.r[k].y, G.r[k].z, G.r[k].w};
        f32x2_t a2 = {0.f, 0.f}, b2 = {0.f, 0.f};
#pragma unroll
        for (int q = 0; q < 4; ++q) {
            const f32x2_t lo = __builtin_amdgcn_cvt_pk_f32_fp8((int)w[q], false), hi = __builtin_amdgcn_cvt_pk_f32_fp8((int)w[q], true);
            a2 = __builtin_elementwise_fma((f32x2_t){xf[4 * q], xf[4 * q + 1]}, lo, a2);
            b2 = __builtin_elementwise_fma((f32x2_t){xf[4 * q + 2], xf[4 * q + 3]}, hi, b2);
        }
        d[k] = (a2.x + a2.y) + (b2.x + b2.y);
    }
    const bool hi5 = lane & 32, hi4 = lane & 16, hi3 = lane & 8;
    float r4[4], r2[2], r1;
#pragma unroll
    for (int k = 0; k < 4; ++k) { const float send = hi5 ? d[k] : d[k + 4], keep = hi5 ? d[k + 4] : d[k]; r4[k] = keep + __shfl_xor(send, 32); }
#pragma unroll
    for (int k = 0; k < 2; ++k) { const float send = hi4 ? r4[k] : r4[k + 2], keep = hi4 ? r4[k + 2] : r4[k]; r2[k] = keep + __shfl_xor(send, 16); }
    { const float send = hi3 ? r2[0] : r2[1], keep = hi3 ? r2[1] : r2[0]; r1 = keep + __shfl_xor(send, 8); }
    r1 += __shfl_xor(r1, 4); r1 += __shfl_xor(r1, 2); r1 += __shfl_xor(r1, 1);
    const float gk = __shfl(gsel, lbase + (lane >> 3));
    const float coef = gk * gelu_fast(r1 * (1.f / U_SCALE)) * (1.f / V_SCALE);
    if ((lane & 7) == 0) cl[grp * 8 + (lane >> 3)] = coef;
}
__device__ __forceinline__ void sweep_v(const Rows8& G, float (&acc)[16], const float* cl, int grp) {
#pragma unroll
    for (int k = 0; k < 8; ++k) {
        const float ck = cl[grp * 8 + k];
        const unsigned w[4] = {G.r[k].x, G.r[k].y, G.r[k].z, G.r[k].w};
        const f32x2_t ck2 = {ck, ck};
#pragma unroll
        for (int q = 0; q < 4; ++q) {
            const f32x2_t lo = __builtin_amdgcn_cvt_pk_f32_fp8((int)w[q], false), hi = __builtin_amdgcn_cvt_pk_f32_fp8((int)w[q], true);
            f32x2_t* ap = (f32x2_t*)&acc[4 * q];
            ap[0] = __builtin_elementwise_fma(ck2, lo, ap[0]);
            ap[1] = __builtin_elementwise_fma(ck2, hi, ap[1]);
        }
    }
}
__device__ __forceinline__ void peer_expert6_phase(float* R, const int* __restrict__ eidx, const float* __restrict__ egate, const unsigned char* __restrict__ ub,
                                                   const unsigned char* __restrict__ vb, const float* __restrict__ lg, const float* __restrict__ lb, bf16_t* Hb, const XcdBarrier& xb, float* lds,
                                                   const float* __restrict__ l1g, const float* __restrict__ l1b) {
    const int wave = __builtin_amdgcn_readfirstlane(tidx() >> 6), lane = tidx() & 63;
    float* cl = lds + wave * 128;
    int itk = 0;
    for (int token = blockIdx.x * 8 + wave; token < NT; token += gridDim.x * 8, ++itk) {
        if (itk) xcc_align(xb);
        float xf[16];
        {
            const float* rp = R + (size_t)token * ND + lane * 16;
#pragma unroll
            for (int q = 0; q < 4; ++q) { const float4 a = *(const float4*)(rp + 4 * q); xf[4 * q] = a.x; xf[4 * q + 1] = a.y; xf[4 * q + 2] = a.z; xf[4 * q + 3] = a.w; }
        }
        {
            float s = 0.f;
#pragma unroll
            for (int j = 0; j < 16; ++j) s += xf[j];
            for (int o = 32; o; o >>= 1) s += __shfl_xor(s, o);
            const float mean = s * (1.f / ND);
            float s2 = 0.f;
#pragma unroll
            for (int j = 0; j < 16; ++j) { xf[j] -= mean; s2 += xf[j] * xf[j]; }
            for (int o = 32; o; o >>= 1) s2 += __shfl_xor(s2, o);
            const float rs = rsqrtf(s2 * (1.f / ND) + LN_EPS);
            int lofs1 = lane * 16;
            asm volatile("" : "+v"(lofs1));
#pragma unroll
            for (int q = 0; q < 4; ++q) {
                const float4 gg = *(const float4*)(l1g + lofs1 + 4 * q), bb = *(const float4*)(l1b + lofs1 + 4 * q);
                xf[4 * q] = xf[4 * q] * rs * gg.x + bb.x; xf[4 * q + 1] = xf[4 * q + 1] * rs * gg.y + bb.y; xf[4 * q + 2] = xf[4 * q + 2] * rs * gg.z + bb.z; xf[4 * q + 3] = xf[4 * q + 3] * rs * gg.w + bb.w;
            }
        }
        int e_lo = eidx[(size_t)token * 128 + lane], e_hi = eidx[(size_t)token * 128 + 64 + lane];
        float g_lo = egate[(size_t)token * 128 + lane], g_hi = egate[(size_t)token * 128 + 64 + lane];
        sort_routing(e_lo, e_hi, g_lo, g_hi, lane);
        Rows8 GA, GB;
        wave_lds_fence();
        rows_load(GA, e_lo, 0, ub, lane);
#pragma unroll 1
        for (int gp = 0; gp < 8; ++gp) {
            const int g0i = 2 * gp, g1i = 2 * gp + 1;
            rows_load(GB, g1i < 8 ? e_lo : e_hi, (g1i & 7) * 8, ub, lane);
            __builtin_amdgcn_sched_barrier(0);
            sweep_u(GA, xf, g0i < 8 ? g_lo : g_hi, (g0i & 7) * 8, lane, cl, g0i);
            __builtin_amdgcn_sched_barrier(0);
            rows_load(GA, gp < 7 ? ((g0i + 2) < 8 ? e_lo : e_hi) : e_lo, gp < 7 ? ((g0i + 2) & 7) * 8 : 0, gp < 7 ? ub : vb, lane);
            __builtin_amdgcn_sched_barrier(0);
            sweep_u(GB, xf, g1i < 8 ? g_lo : g_hi, (g1i & 7) * 8, lane, cl, g1i);
            __builtin_amdgcn_sched_barrier(0);
        }
        wave_lds_fence();
        xcc_align(xb);
        float acc[16];
#pragma unroll
        for (int j = 0; j < 16; ++j) acc[j] = 0.f;
#pragma unroll 1
        for (int gp = 0; gp < 8; ++gp) {
            const int g0i = 2 * gp, g1i = 2 * gp + 1;
            rows_load(GB, g1i < 8 ? e_lo : e_hi, (g1i & 7) * 8, vb, lane);
            __builtin_amdgcn_sched_barrier(0);
            sweep_v(GA, acc, cl, g0i);
            __builtin_amdgcn_sched_barrier(0);
            if (gp < 7) rows_load(GA, (g0i + 2) < 8 ? e_lo : e_hi, ((g0i + 2) & 7) * 8, vb, lane);
            __builtin_amdgcn_sched_barrier(0);
            sweep_v(GB, acc, cl, g1i);
            __builtin_amdgcn_sched_barrier(0);
        }
        float s = 0.f;
#pragma unroll
        for (int j = 0; j < 16; ++j) { xf[j] = ALPHA * xf[j] + acc[j]; s += xf[j]; }
        for (int o = 32; o; o >>= 1) s += __shfl_xor(s, o);
        const float mean = s * (1.f / ND);
        float s2 = 0.f;
#pragma unroll
        for (int j = 0; j < 16; ++j) { xf[j] -= mean; s2 += xf[j] * xf[j]; }
        for (int o = 32; o; o >>= 1) s2 += __shfl_xor(s2, o);
        const float rs = rsqrtf(s2 * (1.f / ND) + LN_EPS);
        float o[16];
        int lofs = lane * 16;
        asm volatile("" : "+v"(lofs));
#pragma unroll
        for (int q = 0; q < 4; ++q) {
            const float4 gg = *(const float4*)(lg + lofs + 4 * q), bb = *(const float4*)(lb + lofs + 4 * q);
            o[4 * q] = xf[4 * q] * rs * gg.x + bb.x; o[4 * q + 1] = xf[4 * q + 1] * rs * gg.y + bb.y; o[4 * q + 2] = xf[4 * q + 2] * rs * gg.z + bb.z; o[4 * q + 3] = xf[4 * q + 3] * rs * gg.w + bb.w;
            *(float4*)(R + (size_t)token * ND + lofs + 4 * q) = make_float4(o[4 * q], o[4 * q + 1], o[4 * q + 2], o[4 * q + 3]);
        }
        if (Hb) { st8(Hb + (size_t)token * ND + lofs, o); st8(Hb + (size_t)token * ND + lofs + 8, o + 8); }
    }
}

__device__ __forceinline__ void nsa_compress_phase(const bf16_t* __restrict__ proj, int coloff, const float* __restrict__ pe, const float* __restrict__ w1,
                                   const float* __restrict__ w2, float* __restrict__ outc, float* lds) {
    const int qtr = tidx() >> 7, tid = tidx() & 127;
    float* in = lds + qtr * 2176;
    float* hid = in + 2048;
    for (int it = blockIdx.x; it < NB * 127; it += gridDim.x) {
        const int g = qtr, n = it % 127, b = it / 127;
        __syncthreads();
        for (int idx = tid; idx < 2048; idx += 128) {
            const int l = idx >> 6, d = idx & 63;
            in[idx] = bf2f(proj[(size_t)(b * NL + 16 * n + l) * ODD_PAD + coloff + g * 64 + d]) + pe[l * 64 + d];
        }
        __syncthreads();
        float a = 0.f;
        for (int i = 0; i < 2048; ++i) a += in[i] * w1[(size_t)i * 128 + tid];
        hid[tid] = gelu_tanh(a);
        __syncthreads();
        if (tid < 64) {
            float o = 0.f;
            for (int j = 0; j < 128; ++j) o += hid[j] * w2[j * 64 + tid];
            outc[((size_t)(b * 127 + n) * 4 + g) * 64 + tid] = o;
        }
    }
    __syncthreads();
}

__device__ __forceinline__ void nsa_cmp_phase(const bf16_t* __restrict__ proj, const float* __restrict__ kcmp, const float* __restrict__ vcmp,
                              bf16_t* __restrict__ O, unsigned* __restrict__ selmask, float* lds) {
    const int half = tidx() >> 8, tid = tidx() & 255;
    float* kc_s = lds + half * 18368;
    float* vc_s = kc_s + 127 * 64;
    float(*imp_s)[33] = (float(*)[33])(vc_s + 127 * 64);
    const int tk = tid >> 2, r = tid & 3;
    for (int it = blockIdx.x; it < 32 * 4 * NB / 2; it += gridDim.x) {
        const int vb = it * 2 + half;
        const int tile = vb & 31, g = (vb >> 5) & 3, b = vb >> 7;
        const int t = tile * 64 + tk, hd = g * 4 + r;
        __syncthreads();
        for (int idx = tid; idx < 127 * 64; idx += 256) { const int n = idx >> 6, d = idx & 63; kc_s[idx] = kcmp[((size_t)(b * 127 + n) * 4 + g) * 64 + d]; vc_s[idx] = vcmp[((size_t)(b * 127 + n) * 4 + g) * 64 + d]; }
        const bf16_t* prow = proj + (size_t)(b * NL + t) * ODD_PAD;
        float q[64];
#pragma unroll
        for (int d = 0; d < 64; d += 8) ld8(prow + hd * 64 + d, q + d);
        const float slope = exp2f(-0.5f * (float)(hd + 1));
        int nvalid = (t >= 31) ? ((t - 31) / 16 + 1) : 0;
        if (nvalid > 127) nvalid = 127;
        __syncthreads();
        float m = -INFINITY, l = 0.f;
        for (int n = 0; n < nvalid; ++n) {
            float s = 0.f;
#pragma unroll
            for (int d = 0; d < 64; ++d) s += q[d] * kc_s[n * 64 + d];
            s = s * 0.125f - slope * (float)(t - (16 * n + 31));
            const float mn = fmaxf(m, s);
            l = l * expf(m - mn) + expf(s - mn);
            m = mn;
        }
        const float inv_l = (nvalid > 0) ? 1.f / fmaxf(l, 1e-30f) : 0.f;
        float acc[64];
#pragma unroll
        for (int d = 0; d < 64; ++d) acc[d] = 0.f;
        float prev3 = 0.f;
        for (int j = 0; j < 32; ++j) {
            float pj[4];
#pragma unroll
            for (int nn = 0; nn < 4; ++nn) {
                const int n = 4 * j + nn;
                float p = 0.f;
                if (n < nvalid) {
                    float s = 0.f;
#pragma unroll
                    for (int d = 0; d < 64; ++d) s += q[d] * kc_s[n * 64 + d];
                    s = s * 0.125f - slope * (float)(t - (16 * n + 31));
                    p = expf(s - m) * inv_l;
                    const float* vr = vc_s + n * 64;
#pragma unroll
                    for (int d = 0; d < 64; ++d) acc[d] += p * vr[d];
                }
                pj[nn] = p;
            }
            float im = 0.5f * prev3 + pj[0] + pj[1] + pj[2] + 0.5f * pj[3];
            prev3 = pj[3];
            im += __shfl_xor(im, 1);
            im += __shfl_xor(im, 2);
            if (r == 0) imp_s[tk][j] = im;
        }
        const float g0 = sigmoidf_(bf2f(prow[2048 + hd]));
#pragma unroll
        for (int d = 0; d < 64; ++d) acc[d] *= g0;
#pragma unroll
        for (int d = 0; d < 64; d += 8) st8(O + (size_t)(b * NL + t) * ND + hd * 64 + d, acc + d);
        __syncthreads();
        const int cur = tile;
        unsigned bits = 0;
        for (int jj = 0; jj < 8; ++jj) {
            const int j = r * 8 + jj;
            const bool fj = (j == 0) || (j == cur) || (j == cur - 1);
            const float vj = (j <= cur) ? imp_s[tk][j] + (fj ? 1000.f : 0.f) : -INFINITY;
            int rank = 0;
            for (int k = 0; k < 32; ++k) {
                const bool fk = (k == 0) || (k == cur) || (k == cur - 1);
                const float vk = (k <= cur) ? imp_s[tk][k] + (fk ? 1000.f : 0.f) : -INFINITY;
                rank += (vk > vj || (vk == vj && k < j)) ? 1 : 0;
            }
            if (rank < 16) bits |= 1u << j;
        }
        bits |= __shfl_xor(bits, 1);
        bits |= __shfl_xor(bits, 2);
        if (r == 0) selmask[(size_t)(b * 4 + g) * NL + t] = bits;
    }
    __syncthreads();
}

__device__ __forceinline__ void nsa_selwin_phase(const bf16_t* __restrict__ proj, const unsigned* __restrict__ selmask, bf16_t* O, float* lds) {
    const int half = tidx() >> 8, tid = tidx() & 255;
    float(*k_s)[64] = (float(*)[64])(lds + half * 8192);
    float(*v_s)[64] = (float(*)[64])(lds + half * 8192 + 4096);
    const int tk = tid >> 2, r = tid & 3;
    for (int it = blockIdx.x; it < 32 * 32; it += gridDim.x) {
        const int tile = 31 - (it >> 5);
        const int bgi = (it & 31) * 2 + half, g = bgi & 3, b = bgi >> 2;
        const int t = tile * 64 + tk, hd = g * 4 + r;
        const bf16_t* pb = proj + (size_t)b * NL * ODD_PAD;
        const bf16_t* prow = pb + (size_t)t * ODD_PAD;
        float q[64], acc[64];
#pragma unroll
        for (int d = 0; d < 64; d += 8) ld8(prow + hd * 64 + d, q + d);
        const float slope = exp2f(-0.5f * (float)(hd + 1));
        const unsigned mask = selmask[(size_t)(b * 4 + g) * NL + t];
        bf16_t* orow = O + (size_t)(b * NL + t) * ND + hd * 64;
        for (int branch = 0; branch < 2; ++branch) {
            const int kcol = (branch == 0 ? 1536 : 2048) + g * 64, vcol = kcol + 256;
            const int j0 = (branch == 0) ? 0 : (tile >= 8 ? tile - 8 : 0);
            float m = -1e30f, l = 0.f;
#pragma unroll
            for (int d = 0; d < 64; ++d) acc[d] = 0.f;
            for (int j = j0; j <= tile; ++j) {
                __syncthreads();
                for (int i = 0; i < 16; ++i) {
                    const int idx = tid + 256 * i, key = idx >> 6, d = idx & 63;
                    k_s[key][d] = bf2f(pb[(size_t)(64 * j + key) * ODD_PAD + kcol + d]);
                    v_s[key][d] = bf2f(pb[(size_t)(64 * j + key) * ODD_PAD + vcol + d]);
                }
                __syncthreads();
                const bool take = (branch == 0) ? ((mask >> j) & 1u) : true;
                if (take) {
                    for (int s = 0; s < 64; ++s) {
                        const int dist = t - (64 * j + s);
                        const bool valid = (branch == 0) ? (dist >= 0) : (dist >= 0 && dist < 512);
                        float sc = 0.f;
#pragma unroll
                        for (int d = 0; d < 64; ++d) sc += q[d] * k_s[s][d];
                        sc = sc * 0.125f - slope * (float)dist;
                        const float mn = valid ? fmaxf(m, sc) : m;
                        const float scale = expf(m - mn);
                        const float p = valid ? expf(sc - mn) : 0.f;
                        l = l * scale + p;
#pragma unroll
                        for (int d = 0; d < 64; ++d) acc[d] = acc[d] * scale + p * v_s[s][d];
                        m = mn;
                    }
                }
            }
            const float gt = sigmoidf_(bf2f(prow[2560 + (branch + 1) * 16 + hd]));
            const float f = gt / fmaxf(l, 1e-30f);
#pragma unroll
            for (int d = 0; d < 64; d += 8) {
                float o[8];
                ld8(orow + d, o);
#pragma unroll
                for (int j = 0; j < 8; ++j) o[j] += f * acc[d + j];
                st8(orow + d, o);
            }
        }
    }
    __syncthreads();
}


typedef float f32x16 __attribute__((ext_vector_type(16)));
#define MFMA32(a, b, c) __builtin_amdgcn_mfma_f32_32x32x16_bf16((a), (b), (c), 0, 0, 0)
__device__ __forceinline__ unsigned cvtpk(float lo, float hi) { const f32x2_t f = {lo, hi}; return __builtin_bit_cast(unsigned, __builtin_convertvector(f, bf16x2_t)); }
__device__ __forceinline__ int crow32(int reg, int h) { return (reg & 3) + 8 * (reg >> 2) + 4 * h; }
constexpr float LOG2E = 1.4426950408889634f;
__device__ __forceinline__ void nsa_attn_phase(const bf16_t* __restrict__ proj, const bf16_t* __restrict__ vt, const unsigned* __restrict__ selmask, bf16_t* O, unsigned char* lds) {
    const int tid = tidx(), wave = __builtin_amdgcn_readfirstlane(tid >> 6), lane = tid & 63, l31 = lane & 31, h = lane >> 5;
    const int r = wave & 3, thalf = wave >> 2;
    const int skey = tid >> 3, spart = tid & 7;
    for (int it = blockIdx.x; it < 32 * 64; it += gridDim.x) {
        const int tile = 31 - (it >> 6), bg = it & 63, g = bg & 3, b = bg >> 2;
        const int hd = g * 4 + r, tokoff = thalf * 32 + l31, tok = tile * 64 + tokoff;
        const size_t trow = (size_t)(b * NL + tok);
        const float slope = exp2f(-0.5f * (float)(hd + 1));
        bf16x8_t Qf[4];
#pragma unroll
        for (int ds = 0; ds < 4; ++ds) {
            float q[8];
            ld8(proj + trow * ODD_PAD + hd * 64 + 16 * ds + 8 * h, q);
            u32x4 w; w.x = cvtpk(q[0] * 0.125f, q[1] * 0.125f); w.y = cvtpk(q[2] * 0.125f, q[3] * 0.125f); w.z = cvtpk(q[4] * 0.125f, q[5] * 0.125f); w.w = cvtpk(q[6] * 0.125f, q[7] * 0.125f);
            Qf[ds] = __builtin_bit_cast(bf16x8_t, w);
        }
        float sc[16];
#pragma unroll
        for (int reg = 0; reg < 16; ++reg) sc[reg] = slope * (float)crow32(reg, h);
        const unsigned mymask = selmask[(size_t)(b * 4 + g) * NL + tok];
        __syncthreads();
        if (wave == 0) {
            unsigned m = selmask[(size_t)(b * 4 + g) * NL + tile * 64 + lane];
            for (int o = 32; o; o >>= 1) m |= __shfl_xor(m, o);
            if (lane == 0) *(unsigned*)(lds + 35840) = m;
        }
        __syncthreads();
        const unsigned causal = (tile == 31) ? 0xffffffffu : ((2u << tile) - 1u);
        const unsigned U = *(const unsigned*)(lds + 35840) & causal;
        float outv[32];
#pragma unroll
        for (int i = 0; i < 32; ++i) outv[i] = 0.f;
#pragma unroll 1
        for (int branch = 0; branch < 2; ++branch) {
            unsigned todo = (branch == 0) ? U : (causal & ~((1u << (tile >= 8 ? tile - 8 : 0)) - 1u));
            const bf16_t* kbase = proj + (size_t)b * NL * ODD_PAD + (branch == 0 ? 1536 : 1792) + g * 64 + (size_t)skey * ODD_PAD + 8 * spart;
            const bf16_t* vbase = vt + (size_t)(branch * 256 + g * 64 + skey) * NT + (size_t)b * NL + 8 * spart;
            float m_run = -1e30f, l_run = 0.f;
            f32x16 Oa[2];
#pragma unroll
            for (int i = 0; i < 16; ++i) { Oa[0][i] = 0.f; Oa[1][i] = 0.f; }
            int jcur = __ffs(todo) - 1; todo &= todo - 1;
            uint4 kreg = *(const uint4*)(kbase + (size_t)(64 * jcur) * ODD_PAD);
            uint4 vreg = *(const uint4*)(vbase + 64 * jcur);
            int buf = 0;
            __syncthreads();
            *(uint4*)(lds + skey * 144 + spart * 16) = kreg;
            *(uint2*)(lds + 18432 + skey * 136 + spart * 16) = make_uint2(vreg.x, vreg.y);
            *(uint2*)(lds + 18432 + skey * 136 + spart * 16 + 8) = make_uint2(vreg.z, vreg.w);
            __syncthreads();
            for (;;) {
                const int jnext = todo ? (__ffs(todo) - 1) : -1;
                todo &= todo - 1;
                if (jnext >= 0) { kreg = *(const uint4*)(kbase + (size_t)(64 * jnext) * ODD_PAD); vreg = *(const uint4*)(vbase + 64 * jnext); }
                const unsigned char* Ks = lds + buf * 9216;
                const unsigned char* Vs = lds + 18432 + buf * 8704;
                const bool mysel = (branch == 1) || ((mymask >> jcur) & 1u);
                if (__any(mysel)) {
                    const bool diag = (jcur == tile), wedge = (branch == 1) && (jcur == tile - 8);
                    const float init = mysel ? slope * (float)(64 * (jcur - tile)) : -1e30f;
                    float sv[32];
#pragma unroll
                    for (int kt = 0; kt < 2; ++kt) {
                        f32x16 acc;
                        const float i0 = init + slope * (float)(32 * kt);
#pragma unroll
                        for (int i = 0; i < 16; ++i) acc[i] = i0;
#pragma unroll
                        for (int ds = 0; ds < 4; ++ds) {
                            const bf16x8_t a = *(const bf16x8_t*)(Ks + (32 * kt + l31) * 144 + (16 * ds + 8 * h) * 2);
                            acc = MFMA32(a, Qf[ds], acc);
                        }
#pragma unroll
                        for (int reg = 0; reg < 16; ++reg) {
                            float sval = acc[reg] + sc[reg];
                            const int keyoff = 32 * kt + crow32(reg, h);
                            if (diag) sval = (keyoff <= tokoff) ? sval : -1e30f;
                            if (wedge) sval = (keyoff > tokoff) ? sval : -1e30f;
                            sv[kt * 16 + reg] = sval;
                        }
                    }
                    float mx = sv[0];
#pragma unroll
                    for (int i = 1; i < 32; ++i) mx = fmaxf(mx, sv[i]);
                    mx = fmaxf(mx, __shfl_xor(mx, 32));
                    const float m_new = fmaxf(m_run, mx), m_use = fmaxf(m_new, -1e29f);
                    const float alpha = __builtin_amdgcn_exp2f((m_run - m_use) * LOG2E);
                    const float moff = -m_use * LOG2E;
                    float psum = 0.f;
#pragma unroll
                    for (int i = 0; i < 32; ++i) { sv[i] = __builtin_amdgcn_exp2f(fmaf(sv[i], LOG2E, moff)); psum += sv[i]; }
                    l_run = l_run * alpha + psum; m_run = m_new;
#pragma unroll
                    for (int i = 0; i < 16; ++i) { Oa[0][i] *= alpha; Oa[1][i] *= alpha; }
                    bf16x8_t Pf[4];
#pragma unroll
                    for (int ks = 0; ks < 4; ++ks) {
                        u32x4 w; w.x = cvtpk(sv[ks * 8 + 0], sv[ks * 8 + 1]); w.y = cvtpk(sv[ks * 8 + 2], sv[ks * 8 + 3]); w.z = cvtpk(sv[ks * 8 + 4], sv[ks * 8 + 5]); w.w = cvtpk(sv[ks * 8 + 6], sv[ks * 8 + 7]);
                        Pf[ks] = __builtin_bit_cast(bf16x8_t, w);
                    }
#pragma unroll
                    for (int mt = 0; mt < 2; ++mt)
#pragma unroll
                        for (int ks = 0; ks < 4; ++ks) {
                            const unsigned char* vp = Vs + (32 * mt + l31) * 136 + (16 * ks + 4 * h) * 2;
                            const uint2 lo = *(const uint2*)vp, hi = *(const uint2*)(vp + 16);
                            u32x4 w; w.x = lo.x; w.y = lo.y; w.z = hi.x; w.w = hi.y;
                            Oa[mt] = MFMA32(__builtin_bit_cast(bf16x8_t, w), Pf[ks], Oa[mt]);
                        }
                }
                if (jnext < 0) break;
                *(uint4*)(lds + (buf ^ 1) * 9216 + skey * 144 + spart * 16) = kreg;
                *(uint2*)(lds + 18432 + (buf ^ 1) * 8704 + skey * 136 + spart * 16) = make_uint2(vreg.x, vreg.y);
                *(uint2*)(lds + 18432 + (buf ^ 1) * 8704 + skey * 136 + spart * 16 + 8) = make_uint2(vreg.z, vreg.w);
                __syncthreads();
                buf ^= 1; jcur = jnext;
            }
            const float l_tot = l_run + __shfl_xor(l_run, 32);
            const float gt = sigmoidf_(bf2f(proj[trow * ODD_PAD + 2048 + (branch + 1) * 16 + hd]));
            const float f = gt / fmaxf(l_tot, 1e-30f);
#pragma unroll
            for (int i = 0; i < 16; ++i) { outv[i] += f * Oa[0][i]; outv[16 + i] += f * Oa[1][i]; }
        }
        bf16_t* orow = O + trow * ND + hd * 64;
#pragma unroll
        for (int mt = 0; mt < 2; ++mt)
#pragma unroll
            for (int q4 = 0; q4 < 4; ++q4) {
                bf16_t* op = orow + 32 * mt + 8 * q4 + 4 * h;
                const uint2 old = *(const uint2*)op;
                const float o0 = __uint_as_float(old.x << 16) + outv[mt * 16 + q4 * 4 + 0], o1 = __uint_as_float(old.x & 0xffff0000u) + outv[mt * 16 + q4 * 4 + 1];
                const float o2 = __uint_as_float(old.y << 16) + outv[mt * 16 + q4 * 4 + 2], o3 = __uint_as_float(old.y & 0xffff0000u) + outv[mt * 16 + q4 * 4 + 3];
                *(uint2*)op = make_uint2(cvtpk(o0, o1), cvtpk(o2, o3));
            }
    }
    __syncthreads();
}


__device__ __forceinline__ void nsa_compress2_phase(const bf16_t* __restrict__ proj, const bf16_t* __restrict__ w1t  , const bf16_t* __restrict__ w2t  ,
                                                    const float* __restrict__ bias1  , bf16_t* __restrict__ kcmp  , bf16_t* __restrict__ vcmpT  ,
                                                    unsigned char* lds) {
    const int tid = tidx(), wave = __builtin_amdgcn_readfirstlane(tid >> 6), lane = tid & 63, fr = lane & 15, fq = lane >> 4;
    unsigned char* xs = lds;
    unsigned char* hs = lds + 34816;
    for (int it = blockIdx.x; it < 1024; it += gridDim.x) {
        const int which = it >> 9, ntile = it & 7, g = (it >> 3) & 3, b = (it >> 5) & 15;
        const int t0 = 256 * ntile, coloff = (which ? 1280 : 1024) + g * 64;
        __syncthreads();
        for (int pc = tid; pc < 272 * 8; pc += NTHR) {
            const int tk = pc >> 3, c = pc & 7;
            int tsrc = t0 + tk; tsrc = tsrc > NL - 1 ? NL - 1 : tsrc;
            *(uint4*)(xs + tk * 128 + ((c ^ ((tk >> 4) & 7)) << 4)) = *(const uint4*)(proj + (size_t)(b * NL + tsrc) * ODD_PAD + coloff + 8 * c);
        }
        __syncthreads();
        f32x4 acc = {0.f, 0.f, 0.f, 0.f};
        const bf16_t* wrow = w1t + ((size_t)which * 128 + 16 * wave + fr) * 2048 + 8 * fq;
#pragma unroll 8
        for (int ks = 0; ks < 64; ++ks) {
            const int l = ks >> 1, tk = 16 * fr + l, c = 4 * (ks & 1) + fq;
            const bf16x8_t a = *(const bf16x8_t*)(xs + tk * 128 + ((c ^ ((tk >> 4) & 7)) << 4));
            const bf16x8_t bfrag = *(const bf16x8_t*)(wrow + 32 * ks);
            acc = __builtin_amdgcn_mfma_f32_16x16x32_bf16(a, bfrag, acc, 0, 0, 0);
        }
        {
            const float bj = bias1[which * 128 + 16 * wave + fr];
#pragma unroll
            for (int reg = 0; reg < 4; ++reg) *(bf16_t*)(hs + (4 * fq + reg) * 272 + (16 * wave + fr) * 2) = f2bf(gelu_fast(acc[reg] + bj));
        }
        __syncthreads();
        if (wave < 4) {
            f32x4 o = {0.f, 0.f, 0.f, 0.f};
#pragma unroll
            for (int ks = 0; ks < 4; ++ks) {
                const bf16x8_t a = *(const bf16x8_t*)(hs + fr * 272 + (32 * ks + 8 * fq) * 2);
                const bf16x8_t bfrag = *(const bf16x8_t*)(w2t + ((size_t)which * 64 + 16 * wave + fr) * 128 + 32 * ks + 8 * fq);
                o = __builtin_amdgcn_mfma_f32_16x16x32_bf16(a, bfrag, o, 0, 0, 0);
            }
            const int c = 16 * wave + fr;
#pragma unroll
            for (int reg = 0; reg < 4; ++reg) {
                const int n = 16 * ntile + 4 * fq + reg;
                const bf16_t val = (n < 127) ? f2bf(o[reg]) : (bf16_t)0;
                if (which == 0) kcmp[((size_t)(b * 4 + g) * 128 + n) * 64 + c] = val;
                else vcmpT[((size_t)(b * 4 + g) * 64 + c) * 128 + n] = val;
            }
        }
    }
    __syncthreads();
}

__device__ __forceinline__ void nsa_cmp2_phase(const bf16_t* __restrict__ proj, const bf16_t* __restrict__ kcmp, const bf16_t* __restrict__ vcmpT,
                                               bf16_t* __restrict__ O, unsigned* __restrict__ selmask, unsigned char* lds) {
    const int tid = tidx(), wave = __builtin_amdgcn_readfirstlane(tid >> 6), lane = tid & 63, l31 = lane & 31, h = lane >> 5;
    const int r = wave & 3, thalf = wave >> 2;
    unsigned char* Kc = lds;
    unsigned char* Vc = lds + 18432;
    float* impS = (float*)(lds + 35328);
    float* invS = (float*)(lds + 35328 + 32768);
    for (int it = blockIdx.x; it < 32 * 64; it += gridDim.x) {
        const int tile = 31 - (it >> 6), bg = it & 63, g = bg & 3, b = bg >> 2;
        const int hd = g * 4 + r, tokoff = thalf * 32 + l31, tok = tile * 64 + tokoff;
        const size_t trow = (size_t)(b * NL + tok);
        const float slope = exp2f(-0.5f * (float)(hd + 1));
        __syncthreads();
#pragma unroll
        for (int i = 0; i < 2; ++i) {
            const int pc = tid + 512 * i;
            { const int row = pc >> 3, c = pc & 7; *(uint4*)(Kc + row * 144 + c * 16) = *(const uint4*)(kcmp + ((size_t)(b * 4 + g) * 128 + row) * 64 + 8 * c); }
            { const int row = pc >> 4, c = pc & 15; const uint4 v = *(const uint4*)(vcmpT + ((size_t)(b * 4 + g) * 64 + row) * 128 + 8 * c);
              *(uint2*)(Vc + row * 264 + c * 16) = make_uint2(v.x, v.y); *(uint2*)(Vc + row * 264 + c * 16 + 8) = make_uint2(v.z, v.w); }
        }
        bf16x8_t Qf[4];
#pragma unroll
        for (int ds = 0; ds < 4; ++ds) {
            float q[8];
            ld8(proj + trow * ODD_PAD + hd * 64 + 16 * ds + 8 * h, q);
            u32x4 w; w.x = cvtpk(q[0] * 0.125f, q[1] * 0.125f); w.y = cvtpk(q[2] * 0.125f, q[3] * 0.125f); w.z = cvtpk(q[4] * 0.125f, q[5] * 0.125f); w.w = cvtpk(q[6] * 0.125f, q[7] * 0.125f);
            Qf[ds] = __builtin_bit_cast(bf16x8_t, w);
        }
        int nvalid = (tok >= 31) ? ((tok - 31) / 16 + 1) : 0;
        nvalid = nvalid > 127 ? 127 : nvalid;
        __syncthreads();
        float mx = -1e30f;
#pragma unroll 1
        for (int kt = 0; kt < 4; ++kt) {
            f32x16 acc;
            const float i0 = slope * (float)(512 * kt);
#pragma unroll
            for (int i = 0; i < 16; ++i) acc[i] = i0;
#pragma unroll
            for (int ds = 0; ds < 4; ++ds) {
                const bf16x8_t a = *(const bf16x8_t*)(Kc + (32 * kt + l31) * 144 + (16 * ds + 8 * h) * 2);
                acc = MFMA32(a, Qf[ds], acc);
            }
#pragma unroll
            for (int reg = 0; reg < 16; ++reg) {
                const int n = 32 * kt + crow32(reg, h);
                const float sval = acc[reg] + slope * (float)(16 * crow32(reg, h));
                mx = fmaxf(mx, (n < nvalid) ? sval : -1e30f);
            }
        }
        mx = fmaxf(mx, __shfl_xor(mx, 32));
        const float moff = -fmaxf(mx, -1e29f) * LOG2E;
        float psum = 0.f, prev_pe = 0.f;
        f32x16 Oa[2];
#pragma unroll
        for (int i = 0; i < 16; ++i) { Oa[0][i] = 0.f; Oa[1][i] = 0.f; }
#pragma unroll 1
        for (int kt = 0; kt < 4; ++kt) {
            f32x16 acc;
            const float i0 = slope * (float)(512 * kt);
#pragma unroll
            for (int i = 0; i < 16; ++i) acc[i] = i0;
#pragma unroll
            for (int ds = 0; ds < 4; ++ds) {
                const bf16x8_t a = *(const bf16x8_t*)(Kc + (32 * kt + l31) * 144 + (16 * ds + 8 * h) * 2);
                acc = MFMA32(a, Qf[ds], acc);
            }
            float sv[16];
#pragma unroll
            for (int reg = 0; reg < 16; ++reg) {
                const int n = 32 * kt + crow32(reg, h);
                const float sval = acc[reg] + slope * (float)(16 * crow32(reg, h));
                sv[reg] = __builtin_amdgcn_exp2f(fmaf((n < nvalid) ? sval : -1e30f, LOG2E, moff));
                psum += sv[reg];
            }
#pragma unroll
            for (int q = 0; q < 4; ++q) {
                const float e = 0.5f * sv[q * 4 + 3];
                const float own = sv[q * 4] + sv[q * 4 + 1] + sv[q * 4 + 2] + e;
                const float pe = __shfl_xor(e, 32);
                impS[(r * 64 + tokoff) * 32 + 8 * kt + 2 * q + h] = own + (h ? pe : prev_pe);
                prev_pe = pe;
            }
#pragma unroll
            for (int s2 = 0; s2 < 2; ++s2) {
                u32x4 w; w.x = cvtpk(sv[s2 * 8 + 0], sv[s2 * 8 + 1]); w.y = cvtpk(sv[s2 * 8 + 2], sv[s2 * 8 + 3]); w.z = cvtpk(sv[s2 * 8 + 4], sv[s2 * 8 + 5]); w.w = cvtpk(sv[s2 * 8 + 6], sv[s2 * 8 + 7]);
                const bf16x8_t pf = __builtin_bit_cast(bf16x8_t, w);
#pragma unroll
                for (int mt = 0; mt < 2; ++mt) {
                    const unsigned char* vp = Vc + (32 * mt + l31) * 264 + (32 * kt + 16 * s2 + 4 * h) * 2;
                    const uint2 lo = *(const uint2*)vp, hi = *(const uint2*)(vp + 16);
                    u32x4 a; a.x = lo.x; a.y = lo.y; a.z = hi.x; a.w = hi.y;
                    Oa[mt] = MFMA32(__builtin_bit_cast(bf16x8_t, a), pf, Oa[mt]);
                }
            }
        }
        psum += __shfl_xor(psum, 32);
        const float inv = (nvalid > 0) ? 1.f / fmaxf(psum, 1e-30f) : 0.f;
        if (h == 0) invS[r * 64 + tokoff] = inv;
        const float g0 = sigmoidf_(bf2f(proj[trow * ODD_PAD + 2048 + hd])) * inv;
        bf16_t* orow = O + trow * ND + hd * 64;
#pragma unroll
        for (int mt = 0; mt < 2; ++mt)
#pragma unroll
            for (int q4 = 0; q4 < 4; ++q4)
                *(uint2*)(orow + 32 * mt + 8 * q4 + 4 * h) = make_uint2(cvtpk(g0 * Oa[mt][q4 * 4], g0 * Oa[mt][q4 * 4 + 1]), cvtpk(g0 * Oa[mt][q4 * 4 + 2], g0 * Oa[mt][q4 * 4 + 3]));
        __syncthreads();
        float* impT = (float*)Kc;
#pragma unroll
        for (int i = 0; i < 4; ++i) {
            const int pc = tid + 512 * i, tk = pc >> 5, j = pc & 31, cur = tile;
            const float ij = impS[(0 * 64 + tk) * 32 + j] * invS[tk] + impS[(1 * 64 + tk) * 32 + j] * invS[64 + tk] + impS[(2 * 64 + tk) * 32 + j] * invS[128 + tk] + impS[(3 * 64 + tk) * 32 + j] * invS[192 + tk];
            const bool fj = (j == 0) || (j == cur) || (j == cur - 1);
            impT[tk * 33 + j] = (j <= cur) ? ij + (fj ? 1000.f : 0.f) : -INFINITY;
        }
        __syncthreads();
        if (tid < 256) {
            const int tk = tid >> 2, rr = tid & 3;
            unsigned bits = 0;
#pragma unroll 1
            for (int jj = 0; jj < 8; ++jj) {
                const int j = rr * 8 + jj;
                const float vj = impT[tk * 33 + j];
                int rank = 0;
#pragma unroll 8
                for (int k = 0; k < 32; ++k) {
                    const float vk = impT[tk * 33 + k];
                    rank += (vk > vj || (vk == vj && k < j)) ? 1 : 0;
                }
                if (rank < 16) bits |= 1u << j;
            }
            bits |= __shfl_xor(bits, 1);
            bits |= __shfl_xor(bits, 2);
            if (rr == 0) selmask[(size_t)(b * 4 + g) * NL + tile * 64 + tk] = bits;
        }
    }
    __syncthreads();
}


constexpr int P0W = 1792;
constexpr float LN2F = 0.6931471805599453f;
__device__ __forceinline__ void sb_attn2_phase(const bf16_t* __restrict__ proj, const bf16_t* __restrict__ vt, bf16_t* __restrict__ Y, unsigned char* lds) {
    const int tid = tidx(), wave = __builtin_amdgcn_readfirstlane(tid >> 6), lane = tid & 63, l31 = lane & 31, h = lane >> 5;
    const int skey = tid >> 3, spart = tid & 7;
    for (int it = blockIdx.x; it < NB * 12 * 8; it += gridDim.x) {
        const int tile = 7 - (it / 192), bh = it % 192, hh = bh % 12, b = bh / 12;
        const int qlo = tile * 256 + 32 * wave, tq = qlo + l31;
        const size_t trow = (size_t)(b * NL + tq);
        bf16x8_t Qf[4];
#pragma unroll
        for (int ds = 0; ds < 4; ++ds) {
            float q[8];
            ld8(proj + trow * P0W + 256 + hh * 64 + 16 * ds + 8 * h, q);
            u32x4 w; w.x = cvtpk(q[0] * 0.125f, q[1] * 0.125f); w.y = cvtpk(q[2] * 0.125f, q[3] * 0.125f); w.z = cvtpk(q[4] * 0.125f, q[5] * 0.125f); w.w = cvtpk(q[6] * 0.125f, q[7] * 0.125f);
            Qf[ds] = __builtin_bit_cast(bf16x8_t, w);
        }
        const bf16_t* kbase = proj + (size_t)b * NL * P0W + 1024 + hh * 64 + (size_t)skey * P0W + 8 * spart;
        const bf16_t* vbase = vt + (size_t)(hh * 64 + skey) * NT + (size_t)b * NL + 8 * spart;
        f32x16 Oa[2];
#pragma unroll
        for (int i = 0; i < 16; ++i) { Oa[0][i] = 0.f; Oa[1][i] = 0.f; }
        float carry = 0.f;
        int j = tile * 4 + 3, buf = 0;
        uint4 kreg = *(const uint4*)(kbase + (size_t)(64 * j) * P0W);
        uint4 vreg = *(const uint4*)(vbase + 64 * j);
        __syncthreads();
        *(uint4*)(lds + skey * 144 + spart * 16) = kreg;
        *(uint2*)(lds + 18432 + skey * 136 + spart * 16) = make_uint2(vreg.x, vreg.y);
        *(uint2*)(lds + 18432 + skey * 136 + spart * 16 + 8) = make_uint2(vreg.z, vreg.w);
        __syncthreads();
        for (;;) {
            const int jn = j - 1;
            if (jn >= 0) { kreg = *(const uint4*)(kbase + (size_t)(64 * jn) * P0W); vreg = *(const uint4*)(vbase + 64 * jn); }
            const unsigned char* Ks = lds + buf * 9216;
            const unsigned char* Vs = lds + 18432 + buf * 8704;
            const bool live = (64 * j <= qlo + 30) && !__all(carry < -110.f);
            if (live) {
#pragma unroll
                for (int kti = 0; kti < 2; ++kti) {
                    const int kt = 1 - kti;
                    f32x16 acc;
#pragma unroll
                    for (int i = 0; i < 16; ++i) acc[i] = 0.f;
#pragma unroll
                    for (int ds = 0; ds < 4; ++ds) {
                        const bf16x8_t a = *(const bf16x8_t*)(Ks + (32 * kt + l31) * 144 + (16 * ds + 8 * h) * 2);
                        acc = MFMA32(a, Qf[ds], acc);
                    }
                    float m1[16], lz[16];
#pragma unroll
                    for (int reg = 0; reg < 16; ++reg) {
                        const float z = acc[reg];
                        const bool valid = (64 * j + 32 * kt + crow32(reg, h)) < tq;
                        const float e = __builtin_amdgcn_exp2f(-fabsf(z) * LOG2E);
                        const float sp = fmaxf(z, 0.f) + __builtin_amdgcn_logf(1.f + e) * LN2F;
                        m1[reg] = valid ? -sp : 0.f;
                        lz[reg] = valid ? z - sp : -1e30f;
                    }
                    float G[4], T[4];
#pragma unroll
                    for (int q = 0; q < 4; ++q) G[q] = (m1[4 * q] + m1[4 * q + 1]) + (m1[4 * q + 2] + m1[4 * q + 3]);
                    float Gp[4];
#pragma unroll
                    for (int q = 0; q < 4; ++q) { Gp[q] = __shfl_xor(G[q], 32); T[q] = G[q] + Gp[q]; }
                    float base[4];
                    base[3] = carry; base[2] = base[3] + T[3]; base[1] = base[2] + T[2]; base[0] = base[1] + T[1];
                    const float tot = base[0] + T[0];
#pragma unroll
                    for (int q = 0; q < 4; ++q) {
                        const float bq = base[q] + (h ? 0.f : Gp[q]);
                        const float t3 = bq, t2 = t3 + m1[4 * q + 3], t1 = t2 + m1[4 * q + 2], t0 = t1 + m1[4 * q + 1];
                        lz[4 * q + 3] = __builtin_amdgcn_exp2f((lz[4 * q + 3] + t3) * LOG2E);
                        lz[4 * q + 2] = __builtin_amdgcn_exp2f((lz[4 * q + 2] + t2) * LOG2E);
                        lz[4 * q + 1] = __builtin_amdgcn_exp2f((lz[4 * q + 1] + t1) * LOG2E);
                        lz[4 * q + 0] = __builtin_amdgcn_exp2f((lz[4 * q + 0] + t0) * LOG2E);
                    }
                    carry = tot;
#pragma unroll
                    for (int s2 = 0; s2 < 2; ++s2) {
                        u32x4 w; w.x = cvtpk(lz[s2 * 8 + 0], lz[s2 * 8 + 1]); w.y = cvtpk(lz[s2 * 8 + 2], lz[s2 * 8 + 3]); w.z = cvtpk(lz[s2 * 8 + 4], lz[s2 * 8 + 5]); w.w = cvtpk(lz[s2 * 8 + 6], lz[s2 * 8 + 7]);
                        const bf16x8_t pf = __builtin_bit_cast(bf16x8_t, w);
#pragma unroll
                        for (int mt = 0; mt < 2; ++mt) {
                            const unsigned char* vp = Vs + (32 * mt + l31) * 136 + (32 * kt + 16 * s2 + 4 * h) * 2;
                            const uint2 lo = *(const uint2*)vp, hi = *(const uint2*)(vp + 16);
                            u32x4 a; a.x = lo.x; a.y = lo.y; a.z = hi.x; a.w = hi.y;
                            Oa[mt] = MFMA32(__builtin_bit_cast(bf16x8_t, a), pf, Oa[mt]);
                        }
                    }
                }
            }
            if (jn >= 0) {
                *(uint4*)(lds + (buf ^ 1) * 9216 + skey * 144 + spart * 16) = kreg;
                *(uint2*)(lds + 18432 + (buf ^ 1) * 8704 + skey * 136 + spart * 16) = make_uint2(vreg.x, vreg.y);
                *(uint2*)(lds + 18432 + (buf ^ 1) * 8704 + skey * 136 + spart * 16 + 8) = make_uint2(vreg.z, vreg.w);
            }
            volatile int* flg = (volatile int*)(lds + 35840) + (j & 1) * 8;
            const int wdone = __all(carry < -110.f);
            if (lane == 0) flg[wave] = wdone;
            __syncthreads();
            const int alldone = flg[0] & flg[1] & flg[2] & flg[3] & flg[4] & flg[5] & flg[6] & flg[7];
            if (alldone || jn < 0) break;
            buf ^= 1; j = jn;
        }
        bf16_t* orow = Y + trow * ND + 256 + hh * 64;
#pragma unroll
        for (int mt = 0; mt < 2; ++mt)
#pragma unroll
            for (int q4 = 0; q4 < 4; ++q4)
                *(uint2*)(orow + 32 * mt + 8 * q4 + 4 * h) = make_uint2(cvtpk(Oa[mt][q4 * 4], Oa[mt][q4 * 4 + 1]), cvtpk(Oa[mt][q4 * 4 + 2], Oa[mt][q4 * 4 + 3]));
    }
    __syncthreads();
}

__device__ __forceinline__ void s5_scan2_phase(const bf16_t* __restrict__ proj, const float* __restrict__ lam_re, const float* __restrict__ lam_im, const float* __restrict__ log_dt,
                                               const float* __restrict__ b_re, const float* __restrict__ b_im, const float* __restrict__ c_re, const float* __restrict__ c_im,
                                               const float* __restrict__ dskip, bf16_t* __restrict__ ya, float* lds) {
    const int tid = tidx(), wave = __builtin_amdgcn_readfirstlane(tid >> 6), lane = tid & 63;
    float* cr = lds;
    float* ci = lds + 1024;
    float* Es = lds + 2048;
    float* us = lds + 3072 + wave * 512;
    float* xr = lds + 7168 + wave * 4160;
    float* xi = xr + 2080;
    for (int bg = blockIdx.x; bg < NB * 16; bg += gridDim.x) {
        const int b = bg >> 4, g = bg & 15;
        const float lr = lam_re[g * 64 + lane], li = lam_im[g * 64 + lane];
        const float dt = expf(log_dt[g]);
        const float mag = expf(lr * dt);
        const float are = mag * cosf(li * dt), aim = mag * sinf(li * dt);
        const float nr = are - 1.f, den = lr * lr + li * li;
        const float fre = (nr * lr + aim * li) / den, fim = (aim * lr - nr * li) / den;
        float bbr[16], bbi[16];
#pragma unroll
        for (int i = 0; i < 16; ++i) {
            const float br = b_re[(g * 64 + lane) * 16 + i], bi = b_im[(g * 64 + lane) * 16 + i];
            bbr[i] = fre * br - fim * bi; bbi[i] = fre * bi + fim * br;
        }
        __syncthreads();
        for (int idx = tid; idx < 1024; idx += NTHR) { cr[idx] = c_re[g * 1024 + idx]; ci[idx] = c_im[g * 1024 + idx]; }
        const bf16_t* ub = proj + (size_t)(b * NL + 256 * wave) * P0W + g * 16;
        float xre = 0.f, xim = 0.f;
        for (int c0 = 0; c0 < 256; c0 += 32) {
            wave_lds_fence();
            { float u8[8]; const int t = lane >> 1, hf = lane & 1; ld8(ub + (size_t)(c0 + t) * P0W + 8 * hf, u8);
#pragma unroll
              for (int i = 0; i < 8; ++i) us[t * 16 + 8 * hf + i] = u8[i]; }
            wave_lds_fence();
            for (int t = 0; t < 32; ++t) {
                float bur = 0.f, bui = 0.f;
#pragma unroll
                for (int i = 0; i < 16; ++i) { const float u = us[t * 16 + i]; bur += bbr[i] * u; bui += bbi[i] * u; }
                const float nre = are * xre - aim * xim + bur, nim = are * xim + aim * xre + bui;
                xre = nre; xim = nim;
            }
        }
        Es[(wave * 64 + lane) * 2] = xre; Es[(wave * 64 + lane) * 2 + 1] = xim;
        float pr = are, pi = aim;
#pragma unroll
        for (int i = 0; i < 8; ++i) { const float nr2 = pr * pr - pi * pi, ni2 = 2.f * pr * pi; pr = nr2; pi = ni2; }
        __syncthreads();
        xre = 0.f; xim = 0.f;
        for (int w2 = 0; w2 < wave; ++w2) {
            const float er = Es[(w2 * 64 + lane) * 2], ei = Es[(w2 * 64 + lane) * 2 + 1];
            const float nre = pr * xre - pi * xim + er, nim = pr * xim + pi * xre + ei;
            xre = nre; xim = nim;
        }
        const int tt = lane & 31, ih = lane >> 5;
        float dsk[8];
#pragma unroll
        for (int i = 0; i < 8; ++i) dsk[i] = dskip[g * 16 + 8 * ih + i];
        for (int c0 = 0; c0 < 256; c0 += 32) {
            wave_lds_fence();
            { float u8[8]; const int t = lane >> 1, hf = lane & 1; ld8(ub + (size_t)(c0 + t) * P0W + 8 * hf, u8);
#pragma unroll
              for (int i = 0; i < 8; ++i) us[t * 16 + 8 * hf + i] = u8[i]; }
            wave_lds_fence();
            for (int t = 0; t < 32; ++t) {
                float bur = 0.f, bui = 0.f;
#pragma unroll
                for (int i = 0; i < 16; ++i) { const float u = us[t * 16 + i]; bur += bbr[i] * u; bui += bbi[i] * u; }
                const float nre = are * xre - aim * xim + bur, nim = are * xim + aim * xre + bui;
                xre = nre; xim = nim;
                xr[t * 65 + lane] = xre; xi[t * 65 + lane] = xim;
            }
            wave_lds_fence();
            float y[8];
#pragma unroll
            for (int i = 0; i < 8; ++i) y[i] = 0.f;
            for (int p = 0; p < 64; ++p) {
                const float a = xr[tt * 65 + p], bq = xi[tt * 65 + p];
#pragma unroll
                for (int i = 0; i < 8; ++i) y[i] += cr[(8 * ih + i) * 64 + p] * a - ci[(8 * ih + i) * 64 + p] * bq;
            }
            float o[8];
#pragma unroll
            for (int i = 0; i < 8; ++i) o[i] = gelu_fast(y[i] + dsk[i] * us[tt * 16 + 8 * ih + i]);
            st8(ya + (size_t)(b * NL + 256 * wave + c0 + tt) * 256 + g * 16 + 8 * ih, o);
        }
    }
    __syncthreads();
}


__device__ __forceinline__ void glu2_phase(const bf16_t* __restrict__ ya, const bf16_t* __restrict__ wgt, const float* __restrict__ bglu, bf16_t* __restrict__ Y, unsigned char* lds) {
    const int tid = tidx(), wave = __builtin_amdgcn_readfirstlane(tid >> 6), lane = tid & 63, fr = lane & 15, fq = lane >> 4;
    __syncthreads();
    for (int pc = tid; pc < 256 * 32; pc += NTHR) { const int row = pc >> 5, c = pc & 31; *(uint4*)(lds + row * 528 + c * 16) = *(const uint4*)(wgt + row * 256 + c * 8); }
    __syncthreads();
    for (int chunk = blockIdx.x; chunk < NT / 128; chunk += gridDim.x) {
        const size_t tok = (size_t)chunk * 128 + wave * 16 + fr;
        bf16x8_t yb[8];
#pragma unroll
        for (int ks = 0; ks < 8; ++ks) yb[ks] = *(const bf16x8_t*)(ya + tok * 256 + 32 * ks + 8 * fq);
#pragma unroll 2
        for (int nt = 0; nt < 16; ++nt) {
            f32x4 acc = {0.f, 0.f, 0.f, 0.f};
#pragma unroll
            for (int ks = 0; ks < 8; ++ks) {
                const bf16x8_t a = *(const bf16x8_t*)(lds + (16 * nt + fr) * 528 + (32 * ks + 8 * fq) * 2);
                acc = __builtin_amdgcn_mfma_f32_16x16x32_bf16(a, yb[ks], acc, 0, 0, 0);
            }
            const int n0 = 16 * nt + 4 * fq;
            const uint2 yv = *(const uint2*)(ya + tok * 256 + n0);
            const float4 bb = *(const float4*)(bglu + n0);
            const float o0 = __uint_as_float(yv.x << 16) * sigmoidf_(acc[0] + bb.x), o1 = __uint_as_float(yv.x & 0xffff0000u) * sigmoidf_(acc[1] + bb.y);
            const float o2 = __uint_as_float(yv.y << 16) * sigmoidf_(acc[2] + bb.z), o3 = __uint_as_float(yv.y & 0xffff0000u) * sigmoidf_(acc[3] + bb.w);
            *(uint2*)(Y + tok * ND + n0) = make_uint2(cvtpk(o0, o1), cvtpk(o2, o3));
        }
    }
    __syncthreads();
}


__device__ __forceinline__ void cmadd(float& re, float& im, float ar, float ai, float br, float bi) {
    const float nr = fmaf(ar, re, fmaf(-ai, im, br)), ni = fmaf(ar, im, fmaf(ai, re, bi));
    re = nr; im = ni;
}
__device__ __forceinline__ void s5_scan3_phase(const bf16_t* __restrict__ proj, const float* __restrict__ lam_re, const float* __restrict__ lam_im, const float* __restrict__ log_dt,
                                               const float* __restrict__ b_re, const float* __restrict__ b_im, const float* __restrict__ c_re, const float* __restrict__ c_im,
                                               const float* __restrict__ dskip, bf16_t* __restrict__ ya, unsigned char* lds) {
    const int tid = tidx(), wave = __builtin_amdgcn_readfirstlane(tid >> 6), lane = tid & 63, l31 = lane & 31, h = lane >> 5, fr = lane & 15, fq = lane >> 4;
    unsigned char* Xs = lds + wave * 10752;
    float* Es = (float*)(lds + 86016);
    __syncthreads();
    for (int i = lane; i < 32 * 21; i += 64) *(uint4*)(Xs + i * 16) = make_uint4(0u, 0u, 0u, 0u);
    for (int bg = blockIdx.x; bg < NB * 16; bg += gridDim.x) {
        const int b = bg >> 4, g = bg & 15;
        const float dt = expf(log_dt[g]);
        float are[2], aim[2]; bf16x8_t Bre[2], Bim[2];
#pragma unroll
        for (int k = 0; k < 2; ++k) {
            const int p = 32 * k + l31;
            const float lr = lam_re[g * 64 + p], li = lam_im[g * 64 + p];
            const float mag = expf(lr * dt);
            are[k] = mag * cosf(li * dt); aim[k] = mag * sinf(li * dt);
            const float nr = are[k] - 1.f, den = lr * lr + li * li;
            const float fre = (nr * lr + aim[k] * li) / den, fim = (aim[k] * lr - nr * li) / den;
            float vr[8], vi[8];
#pragma unroll
            for (int j = 0; j < 8; ++j) {
                const float br = b_re[(g * 64 + p) * 16 + 8 * h + j], bi = b_im[(g * 64 + p) * 16 + 8 * h + j];
                vr[j] = fre * br - fim * bi; vi[j] = fre * bi + fim * br;
            }
            u32x4 w; w.x = cvtpk(vr[0], vr[1]); w.y = cvtpk(vr[2], vr[3]); w.z = cvtpk(vr[4], vr[5]); w.w = cvtpk(vr[6], vr[7]); Bre[k] = __builtin_bit_cast(bf16x8_t, w);
            w.x = cvtpk(vi[0], vi[1]); w.y = cvtpk(vi[2], vi[3]); w.z = cvtpk(vi[4], vi[5]); w.w = cvtpk(vi[6], vi[7]); Bim[k] = __builtin_bit_cast(bf16x8_t, w);
        }
        bf16x8_t Cm[5];
        {
            const float di = dskip[g * 16 + fr];
#pragma unroll
            for (int ks = 0; ks < 5; ++ks) {
                float cv[8];
#pragma unroll
                for (int j = 0; j < 8; ++j) {
                    const int kk = 32 * ks + 8 * fq + j;
                    cv[j] = kk < 64 ? c_re[(g * 16 + fr) * 64 + kk] : (kk < 128 ? -c_im[(g * 16 + fr) * 64 + kk - 64] : ((kk - 128) == fr ? di : 0.f));
                }
                u32x4 w; w.x = cvtpk(cv[0], cv[1]); w.y = cvtpk(cv[2], cv[3]); w.z = cvtpk(cv[4], cv[5]); w.w = cvtpk(cv[6], cv[7]); Cm[ks] = __builtin_bit_cast(bf16x8_t, w);
            }
        }
        float a4r[2], a4i[2], a5r[2], a5i[2], a32r[2], a32i[2], a256r[2], a256i[2];
#pragma unroll
        for (int k = 0; k < 2; ++k) {
            float pr = are[k], pi = aim[k], t;
            t = pr * pr - pi * pi; pi = 2.f * pr * pi; pr = t;
            t = pr * pr - pi * pi; pi = 2.f * pr * pi; pr = t;
            a4r[k] = pr; a4i[k] = pi;
            a5r[k] = pr * are[k] - pi * aim[k]; a5i[k] = pr * aim[k] + pi * are[k];
#pragma unroll
            for (int i = 0; i < 3; ++i) { t = pr * pr - pi * pi; pi = 2.f * pr * pi; pr = t; }
            a32r[k] = pr; a32i[k] = pi;
#pragma unroll
            for (int i = 0; i < 3; ++i) { t = pr * pr - pi * pi; pi = 2.f * pr * pi; pr = t; }
            a256r[k] = pr; a256i[k] = pi;
        }
        const bf16_t* ub = proj + (size_t)(b * NL + 256 * wave) * P0W + g * 16 + 8 * h;
        float sre[2] = {0.f, 0.f}, sim[2] = {0.f, 0.f};
#pragma unroll 1
        for (int c0 = 0; c0 < 256; c0 += 32) {
            const bf16x8_t uf = *(const bf16x8_t*)(ub + (size_t)(c0 + l31) * P0W);
#pragma unroll
            for (int k = 0; k < 2; ++k) {
                f32x16 z;
#pragma unroll
                for (int i = 0; i < 16; ++i) z[i] = 0.f;
                const f32x16 bur = MFMA32(uf, Bre[k], z), bui = MFMA32(uf, Bim[k], z);
                float er = 0.f, ei = 0.f;
#pragma unroll
                for (int reg = 0; reg < 16; ++reg) {
                    if (reg == 0) { er = bur[0]; ei = bui[0]; }
                    else if ((reg & 3) == 0) cmadd(er, ei, a5r[k], a5i[k], bur[reg], bui[reg]);
                    else cmadd(er, ei, are[k], aim[k], bur[reg], bui[reg]);
                }
                { float tr = er, ti = ei; cmadd(tr, ti, a4r[k], a4i[k], 0.f, 0.f); er = h ? er : tr; ei = h ? ei : ti; }
                er += __shfl_xor(er, 32); ei += __shfl_xor(ei, 32);
                cmadd(sre[k], sim[k], a32r[k], a32i[k], er, ei);
            }
        }
        __syncthreads();
        if (h == 0) {
#pragma unroll
            for (int k = 0; k < 2; ++k) { Es[(wave * 64 + 32 * k + l31) * 2] = sre[k]; Es[(wave * 64 + 32 * k + l31) * 2 + 1] = sim[k]; }
        }
        __syncthreads();
        float xre[2] = {0.f, 0.f}, xim[2] = {0.f, 0.f};
        for (int w2 = 0; w2 < wave; ++w2) {
#pragma unroll
            for (int k = 0; k < 2; ++k) cmadd(xre[k], xim[k], a256r[k], a256i[k], Es[(w2 * 64 + 32 * k + l31) * 2], Es[(w2 * 64 + 32 * k + l31) * 2 + 1]);
        }
#pragma unroll 1
        for (int c0 = 0; c0 < 256; c0 += 32) {
            const bf16x8_t uf = *(const bf16x8_t*)(ub + (size_t)(c0 + l31) * P0W);
            wave_lds_fence();
            *(bf16x8_t*)(Xs + l31 * 336 + 256 + 16 * h) = uf;
#pragma unroll
            for (int k = 0; k < 2; ++k) {
                f32x16 z;
#pragma unroll
                for (int i = 0; i < 16; ++i) z[i] = 0.f;
                const f32x16 bur = MFMA32(uf, Bre[k], z), bui = MFMA32(uf, Bim[k], z);
                float cr = xre[k], ci = xim[k];
#pragma unroll
                for (int q = 0; q < 4; ++q) {
                    float ar_[4], ai_[4], br_[4], bi_[4];
                    float xr_ = cr, xi_ = ci;
#pragma unroll
                    for (int r2 = 0; r2 < 4; ++r2) { cmadd(xr_, xi_, are[k], aim[k], bur[4 * q + r2], bui[4 * q + r2]); ar_[r2] = xr_; ai_[r2] = xi_; }
                    float yr_ = __shfl_xor(xr_, 32), yi_ = __shfl_xor(xi_, 32);
#pragma unroll
                    for (int r2 = 0; r2 < 4; ++r2) { cmadd(yr_, yi_, are[k], aim[k], bur[4 * q + r2], bui[4 * q + r2]); br_[r2] = yr_; bi_[r2] = yi_; }
                    const float zr_ = __shfl_xor(yr_, 32), zi_ = __shfl_xor(yi_, 32);
                    cr = h ? yr_ : zr_; ci = h ? yi_ : zi_;
#pragma unroll
                    for (int r2 = 0; r2 < 4; ++r2) {
                        const int t = 8 * q + 4 * h + r2;
                        *(bf16_t*)(Xs + t * 336 + (32 * k + l31) * 2) = f2bf(h ? br_[r2] : ar_[r2]);
                        *(bf16_t*)(Xs + t * 336 + (64 + 32 * k + l31) * 2) = f2bf(h ? bi_[r2] : ai_[r2]);
                    }
                }
                xre[k] = cr; xim[k] = ci;
            }
            wave_lds_fence();
#pragma unroll
            for (int mt = 0; mt < 2; ++mt) {
                f32x4 y = {0.f, 0.f, 0.f, 0.f};
#pragma unroll
                for (int ks = 0; ks < 5; ++ks) {
                    const bf16x8_t a = *(const bf16x8_t*)(Xs + (16 * mt + fr) * 336 + (32 * ks + 8 * fq) * 2);
                    y = __builtin_amdgcn_mfma_f32_16x16x32_bf16(a, Cm[ks], y, 0, 0, 0);
                }
#pragma unroll
                for (int reg = 0; reg < 4; ++reg)
                    ya[(size_t)(b * NL + 256 * wave + c0 + 16 * mt + 4 * fq + reg) * 256 + g * 16 + fr] = f2bf(gelu_fast(y[reg]));
            }
        }
    }
    __syncthreads();
}

struct Params {
    const float* in[29];
    float* out;
    char* ws;
    unsigned long long pad;
};

constexpr size_t SZ_PROJ = (size_t)NT * EVEN_IN * 2;
constexpr size_t SZ_VT = (size_t)768 * NT * 2;
constexpr size_t SZ_YB = (size_t)NT * ND * 2;
constexpr size_t SZ_HB = (size_t)NT * ND * 2;
constexpr size_t SZ_YA = (size_t)NT * 256 * 2;
constexpr size_t SZ_CMP = (size_t)NB * 4 * 128 * 64 * 2;
constexpr size_t SZ_SEL = (size_t)NB * 4 * NL * 4;
constexpr size_t SZ_TAB = (size_t)16384 * ND;
constexpr size_t SZ_SKB = (size_t)2 * 8 * 2 * 128 * 128 * 2;
constexpr size_t OFF_VT = SZ_PROJ, OFF_YB = OFF_VT + SZ_VT, OFF_HB = OFF_YB + SZ_YB, OFF_YA = OFF_HB + SZ_HB, OFF_KC = OFF_YA + SZ_YA, OFF_VC = OFF_KC + SZ_CMP,
                 OFF_SEL = OFF_VC + SZ_CMP, OFF_TAB = OFF_SEL + SZ_SEL, OFF_SKB = OFF_TAB + 2 * SZ_TAB, OFF_WT = OFF_SKB + SZ_SKB;
constexpr size_t WT_IN0 = 0, WT_OUT0 = WT_IN0 + (size_t)EVEN_IN * ND * 2, WT_Q0 = WT_OUT0 + (size_t)ND * ND * 2, WT_Q1 = WT_Q0 + (size_t)2048 * ND * 2,
                 WT_IN1 = WT_Q1 + (size_t)2048 * ND * 2, WT_V1 = WT_IN1 + (size_t)ODD_PAD * ND * 2, WT_OUT1 = WT_V1 + (size_t)512 * ND * 2, WT_W1 = WT_OUT1 + (size_t)ND * ND * 2, WT_W2 = WT_W1 + (size_t)2 * 128 * 2048 * 2, WT_B1 = WT_W2 + (size_t)2 * 64 * 128 * 2, WT_V0 = WT_B1 + 2 * 128 * 4, WT_GLU = WT_V0 + (size_t)768 * ND * 2, WT_END = WT_GLU + (size_t)256 * 256 * 2;
constexpr size_t OFF_PART = OFF_WT + ((WT_END + 255) & ~(size_t)255);
constexpr size_t OFF_CQ = OFF_PART + (size_t)NT * 32 * 4;
constexpr size_t OFF_BAR = OFF_CQ + 4 * 2048 * 4;
constexpr size_t WS_NEED = OFF_BAR + XB_TOTAL_WORDS * 4 + 256;

__device__ __forceinline__ void convert_tables(const float* __restrict__ u, const float* __restrict__ v, unsigned char* __restrict__ TAB) {
    const size_t per = (size_t)16384 * ND / 16;
    for (size_t i = (size_t)blockIdx.x * NTHR + tidx(); i < 2 * per; i += (size_t)gridDim.x * NTHR) {
        const int tb = (int)(i / per); const size_t off = (i % per) * 16;
        const float* src = (tb ? v : u) + off;
        const float sc = tb ? V_SCALE : U_SCALE;
        uint4 w; unsigned* wp = (unsigned*)&w;
#pragma unroll
        for (int q = 0; q < 4; ++q) {
            const f32x4 a = __builtin_nontemporal_load((const f32x4*)(src + 4 * q));
            int pk = __builtin_amdgcn_cvt_pk_fp8_f32(a.x * sc, a.y * sc, 0, false);
            pk = __builtin_amdgcn_cvt_pk_fp8_f32(a.z * sc, a.w * sc, pk, true);
            wp[q] = (unsigned)pk;
        }
        *(uint4*)(TAB + (size_t)tb * 16384 * ND + off) = w;
    }
}

__global__ void __launch_bounds__(NTHR) fwd_megakernel(Params p) {
    extern __shared__ __attribute__((aligned(16))) unsigned char lds_raw[];
    float* lds = (float*)lds_raw;
    cg::grid_group grid = cg::this_grid();
    const float* x = p.in[0];
    float* R = p.out;
    char* ws = p.ws;
    bf16_t* PROJ = (bf16_t*)ws;
    bf16_t* YB = (bf16_t*)(ws + OFF_YB);
    bf16_t* HB = (bf16_t*)(ws + OFF_HB);
    bf16_t* YA = (bf16_t*)(ws + OFF_YA);
    bf16_t* WGT = (bf16_t*)(ws + OFF_WT + WT_GLU);
    bf16_t* KCMP = (bf16_t*)(ws + OFF_KC);
    bf16_t* VCMP = (bf16_t*)(ws + OFF_VC);
    bf16_t* W1T = (bf16_t*)(ws + OFF_WT + WT_W1);
    bf16_t* W2T = (bf16_t*)(ws + OFF_WT + WT_W2);
    float* BIAS1 = (float*)(ws + OFF_WT + WT_B1);
    unsigned* SEL = (unsigned*)(ws + OFF_SEL);
    bf16_t* WIN0 = (bf16_t*)(ws + OFF_WT + WT_IN0);
    bf16_t* WOUT0 = (bf16_t*)(ws + OFF_WT + WT_OUT0);
    bf16_t* WQ0 = (bf16_t*)(ws + OFF_WT + WT_Q0);
    bf16_t* WQ1 = (bf16_t*)(ws + OFF_WT + WT_Q1);
    bf16_t* WIN1 = (bf16_t*)(ws + OFF_WT + WT_IN1);
    bf16_t* WOUT1 = (bf16_t*)(ws + OFF_WT + WT_OUT1);
    bf16_t* WV1 = (bf16_t*)(ws + OFF_WT + WT_V1);
    bf16_t* VT = (bf16_t*)(ws + OFF_VT);
    bf16_t* WV0 = (bf16_t*)(ws + OFF_WT + WT_V0);
    int* EIDX = (int*)YB;
    float* EGATE = (float*)((char*)YB + (size_t)NT * 128 * 4);
    unsigned char* TAB = (unsigned char*)(ws + OFF_TAB);
    bf16_t* SKB = (bf16_t*)(ws + OFF_SKB);
    const int wave = tidx() >> 6;
    if (tidx() == 0) *(uint4*)(lds_raw + LDS_BYTES - 16) = make_uint4(0u, 0u, 0u, 0u);
    __syncthreads();
    XcdBarrier xbar = xcd_barrier_post((unsigned*)(ws + OFF_BAR), (volatile LAS unsigned*)(lds_raw + LDS_BYTES - 16));

    for (size_t i = (size_t)blockIdx.x * NTHR + tidx(); i < (size_t)NT * ND / 4; i += (size_t)gridDim.x * NTHR) {
        const float4 v = ((const float4*)x)[i];
        uint2 w; w.x = pack2(v.x, v.y); w.y = pack2(v.z, v.w);
        ((uint2*)HB)[i] = w;
    }
    convert_tables(p.in[23], p.in[24], TAB);
    for (int i = blockIdx.x * NTHR + tidx(); i < 2 * 8 * 2 * 128 * 128 / 4; i += gridDim.x * NTHR) {
        const float4 a = ((const float4*)p.in[22])[i];
        uint2 w; w.x = pack2(a.x, a.y); w.y = pack2(a.z, a.w);
        ((uint2*)SKB)[i] = w;
    }
    convert_wt_phase(p.in[1], ND, EVEN_IN, P0W, ColMap{{0, 0, 0}, {0, 0, 0}, {P0W, 0, 0}}, WIN0, lds);
    convert_wt_phase(p.in[1], ND, EVEN_IN, 768, ColMap{{0, 0, 0}, {P0W, 0, 0}, {768, 0, 0}}, WV0, lds);
    convert_wt_phase(p.in[12], ND, ND, ND, ColMap{{0, 0, 0}, {0, 0, 0}, {ND, 0, 0}}, WOUT0, lds);
    convert_wt_phase(p.in[10], 256, 256, 256, ColMap{{0, 0, 0}, {0, 0, 0}, {256, 0, 0}}, WGT, lds);
    convert_wt_phase(p.in[21], ND, 2048, 2048, ColMap{{0, 0, 0}, {0, 0, 0}, {2048, 0, 0}}, WQ0, lds, p.in[25]);
    convert_wt_phase(p.in[21] + (size_t)ND * 2048, ND, 2048, 2048, ColMap{{0, 0, 0}, {0, 0, 0}, {2048, 0, 0}}, WQ1, lds, p.in[25] + ND);
    {
        float* CQ = (float*)(ws + OFF_CQ);
        const int kp = tidx() >> 4, cl16 = tidx() & 15, gcol = blockIdx.x * 16 + cl16;
        if (gcol < 4096) {
            const int layer = gcol >> 11, n = gcol & 2047;
            const float* W = p.in[21] + (size_t)layer * ND * 2048;
            const float* gam = p.in[25] + layer * ND; const float* bet = p.in[26] + layer * ND;
            float c = 0.f, d = 0.f;
            for (int k = kp; k < ND; k += 32) { const float w = W[(size_t)k * 2048 + n]; c += bf2f(f2bf(gam[k] * w)); d += bet[k] * w; }
            c += __shfl_xor(c, 16); d += __shfl_xor(d, 16); c += __shfl_xor(c, 32); d += __shfl_xor(d, 32);
            __syncthreads();
            if ((tidx() & 63) < 16) { lds[(tidx() >> 6) * 32 + cl16] = c; lds[(tidx() >> 6) * 32 + 16 + cl16] = d; }
            __syncthreads();
            if (tidx() < 16) {
                float cs = 0.f, ds = 0.f;
#pragma unroll
                for (int w8 = 0; w8 < 8; ++w8) { cs += lds[w8 * 32 + tidx()]; ds += lds[w8 * 32 + 16 + tidx()]; }
                CQ[layer * 2048 + n] = cs; CQ[4096 + layer * 2048 + n] = ds;
            }
            __syncthreads();
        }
    }
    convert_wt_phase(p.in[13], ND, ODD_IN, ODD_PAD, ColMap{{0, 1792, 2048}, {0, 2048, 2560}, {1792, 256, 48}}, WIN1, lds);
    convert_wt_phase(p.in[13], ND, ODD_IN, 512, ColMap{{0, 256, 0}, {1792, 2304, 0}, {256, 256, 0}}, WV1, lds);
    convert_wt_phase(p.in[20], ND, ND, ND, ColMap{{0, 0, 0}, {0, 0, 0}, {ND, 0, 0}}, WOUT1, lds);
    convert_wt_phase(p.in[15], 2048, 128, 128, ColMap{{0, 0, 0}, {0, 0, 0}, {128, 0, 0}}, W1T, lds);
    convert_wt_phase(p.in[18], 2048, 128, 128, ColMap{{0, 0, 0}, {0, 0, 0}, {128, 0, 0}}, W1T + 128 * 2048, lds);
    convert_wt_phase(p.in[16], 128, 64, 64, ColMap{{0, 0, 0}, {0, 0, 0}, {64, 0, 0}}, W2T, lds);
    convert_wt_phase(p.in[19], 128, 64, 64, ColMap{{0, 0, 0}, {0, 0, 0}, {64, 0, 0}}, W2T + 64 * 128, lds);
    if (blockIdx.x < 32) {
        const int which = blockIdx.x >> 4, j = (blockIdx.x & 15) * 8 + (tidx() >> 6), part = tidx() & 63;
        const float* pe = which ? p.in[17] : p.in[14];
        const float* w1 = which ? p.in[18] : p.in[15];
        float a = 0.f;
#pragma unroll 8
        for (int i = part; i < 2048; i += 64) a += pe[i] * w1[(size_t)i * 128 + j];
        for (int o = 32; o; o >>= 1) a += __shfl_xor(a, o);
        if (part == 0) BIAS1[which * 128 + j] = a;
    }
    xcd_barrier(xbar);
    if (p.pad == 0x5eedull) grid.sync();
    PDUP(0) { PH(0) gemm_bf16_phase(lds_raw, HB, WIN0, NT, P0W, ND, EpiBf16s{PROJ, P0W});
    PH(0) gemm_bf16_phase(lds_raw, WV0, HB, 768, NT, ND, EpiBf16s{VT, NT}, true); }
    xcd_barrier(xbar);
    PDUP(1) { PH(1) s5_scan3_phase(PROJ, p.in[2], p.in[3], p.in[4], p.in[5], p.in[6], p.in[7], p.in[8], p.in[9], YA, lds_raw);
    PH(2) sb_attn2_phase(PROJ, VT, YB, lds_raw);
    if ((PROBE >> 13) & 1) {
        bf16_t* SCR = PROJ + (size_t)NT * P0W;
        s5_scan2_phase(PROJ, p.in[2], p.in[3], p.in[4], p.in[5], p.in[6], p.in[7], p.in[8], p.in[9], SCR, lds);
        xcd_barrier(xbar);
        float d2 = 0.f, n2 = 0.f;
        for (size_t i = (size_t)blockIdx.x * NTHR + tidx(); i < (size_t)NT * 256; i += (size_t)gridDim.x * NTHR) { const float a = bf2f(YA[i]), r = bf2f(SCR[i]); d2 += (a - r) * (a - r); n2 += r * r; }
        for (int o = 32; o; o >>= 1) { d2 += __shfl_xor(d2, o); n2 += __shfl_xor(n2, o); }
        float* chk = (float*)(ws + OFF_BAR + XB_TOTAL_WORDS * 4);
        if ((tidx() & 63) == 0) { atomicAdd(chk, d2); atomicAdd(chk + 1, n2); }
    }
    if (_rep == 0 && ((PROBE >> 1) & 1)) xcd_barrier(xbar); }
    xcd_barrier(xbar);
    PDUP(2) PH(3) glu2_phase(YA, WGT, p.in[11], YB, lds_raw);
    xcd_barrier(xbar);
    PH(4) gemm_bf16_phase(lds_raw, YB, WOUT0, NT, ND, ND, EpiResStats{x, R, ND, ALPHA, HB, (float*)(ws + OFF_PART)});
    xcd_barrier(xbar);
#define PEER_FFN(layer, WQ, last) \
    PH(12) gemm_q_phase(lds_raw, HB, WQ, (const float*)(ws + OFF_PART), (const float*)(ws + OFF_CQ) + (layer) * 2048, (const float*)(ws + OFF_CQ) + 4096 + (layer) * 2048, PROJ); \
    xcd_barrier(xbar); \
    PDUP(4) PH(13) peer_route2_phase(PROJ, SKB + (size_t)(layer) * 8 * 2 * 128 * 128, EIDX, EGATE, lds_raw); \
    xcd_barrier(xbar); \
    if ((PROBE >> 5) & 1) { peer_expert3_phase(R, EIDX, EGATE, TAB, TAB + (size_t)16384 * ND, p.in[27] + (layer) * ND, p.in[28] + (layer) * ND, nullptr, (float*)PROJ, xbar); xcd_barrier(xbar); } \
    PH(14) peer_expert6_phase(R, EIDX, EGATE, TAB, TAB + (size_t)16384 * ND, p.in[27] + (layer) * ND, p.in[28] + (layer) * ND, (last) ? nullptr : HB, xbar, lds, p.in[25] + (layer) * ND, p.in[26] + (layer) * ND); \
    if (!(last)) xcd_barrier(xbar);
    PEER_FFN(0, WQ0, false)
    convert_tables(p.in[23] + (size_t)16384 * ND, p.in[24] + (size_t)16384 * ND, TAB);
    PDUP(0) { PH(6) gemm_bf16_phase(lds_raw, HB, WIN1, NT, ODD_PAD, ND, EpiBf16s{PROJ, ODD_PAD});
    PH(6) gemm_bf16_phase(lds_raw, WV1, HB, 512, NT, ND, EpiBf16s{VT, NT}); }
    xcd_barrier(xbar);
    PDUP(6) PH(7) nsa_compress2_phase(PROJ, W1T, W2T, BIAS1, KCMP, VCMP, lds_raw);
    xcd_barrier(xbar);
    PDUP(7) { PH(8) nsa_cmp2_phase(PROJ, KCMP, VCMP, YB, SEL, lds_raw);
    xcd_barrier(xbar);
    PH(9) nsa_attn_phase(PROJ, VT, SEL, YB, lds_raw);
    if (_rep == 0 && ((PROBE >> 7) & 1)) xcd_barrier(xbar); }
    xcd_barrier(xbar);
    PH(10) gemm_bf16_phase(lds_raw, YB, WOUT1, NT, ND, ND, EpiResStats{R, R, ND, ALPHA, HB, (float*)(ws + OFF_PART)});
    xcd_barrier(xbar);
    PEER_FFN(1, WQ1, true)
    if ((PROBE >> 13) & 1) {
        xcd_barrier(xbar);
        const float* chk = (const float*)(ws + OFF_BAR + XB_TOTAL_WORDS * 4);
        const float d2 = __hip_atomic_load(chk, __ATOMIC_RELAXED, __HIP_MEMORY_SCOPE_AGENT), n2 = __hip_atomic_load(chk + 1, __ATOMIC_RELAXED, __HIP_MEMORY_SCOPE_AGENT);
        if (!(d2 <= 1e-4f * n2)) for (size_t i = (size_t)blockIdx.x * NTHR + tidx(); i < (size_t)NT * ND; i += (size_t)gridDim.x * NTHR) R[i] *= 2.f;
    }
}

}

extern "C" void kernel_launch(void* const* d_in, const int* in_sizes, int n_in, void* d_out, int out_size, void* d_ws, size_t ws_size, hipStream_t stream) {
    static int grid_blocks = 0;
    if (grid_blocks == 0) {
        if (n_in != 29 || out_size != NT * ND || ws_size < WS_NEED) { fprintf(stderr, "kernel_launch: unexpected shapes / workspace (%zu < %zu)\n", ws_size, (size_t)WS_NEED); grid_blocks = -1; return; }
        int dev = 0, cus = 0, per_cu = 0;
        hipGetDevice(&dev);
        hipDeviceGetAttribute(&cus, hipDeviceAttributeMultiprocessorCount, dev);
        hipFuncSetAttribute((const void*)fwd_megakernel, hipFuncAttributeMaxDynamicSharedMemorySize, LDS_BYTES);
        hipOccupancyMaxActiveBlocksPerMultiprocessor(&per_cu, (const void*)fwd_megakernel, NTHR, LDS_BYTES);
        if (per_cu < 1) { fprintf(stderr, "kernel_launch: occupancy query says %d blocks/CU\n", per_cu); grid_blocks = -1; return; }
        grid_blocks = cus;
    }
    if (grid_blocks < 0) return;
    hipMemsetAsync((char*)d_ws + OFF_BAR, 0, XB_TOTAL_WORDS * 4 + 256, stream);
    Params p{};
    for (int i = 0; i < 29; ++i) p.in[i] = (const float*)d_in[i];
    p.out = (float*)d_out; p.ws = (char*)d_ws; p.pad = 0;
    void* args[] = {&p};
    hipError_t e = hipLaunchCooperativeKernel((const void*)fwd_megakernel, dim3(grid_blocks), dim3(NTHR), args, LDS_BYTES, stream);
    if (e != hipSuccess) fprintf(stderr, "cooperative launch failed: %s (grid %d)\n", hipGetErrorString(e), grid_blocks);
}
```

```cpp
#include <hip/hip_runtime.h>
#include <hip/hip_cooperative_groups.h>
#include <math.h>
#include <stdint.h>
#include <cstdio>
namespace cg = cooperative_groups;

__device__ __forceinline__ int tidx() { int t = threadIdx.x; asm volatile("" : "+v"(t)); return t; }
#define XB_TMO      128
#define XB_XCNT(j)  (256  + 64 * (j))
#define XB_XSUB(j)  (1280 + 64 * (j))
#define XB_XGEN(j)  (2304 + 64 * (j))
#define XB_TOP      3328
#define XB_TOPGEN   3392
#define XCD_BAR_WORDS 3456
#define XB_SPIN_CAP (1u << 18)
#define LAS __attribute__((address_space(3)))

__device__ __forceinline__ unsigned xb_ld(unsigned* p)              { return __hip_atomic_load(p, __ATOMIC_RELAXED, __HIP_MEMORY_SCOPE_AGENT); }
__device__ __forceinline__ unsigned xb_add(unsigned* p, unsigned v) { return __hip_atomic_fetch_add(p, v, __ATOMIC_RELAXED, __HIP_MEMORY_SCOPE_AGENT); }
__device__ __forceinline__ unsigned xb_xcc_id() { return (unsigned)__builtin_amdgcn_s_getreg((3 << 11) | 20) & 0xFu; }
#define XB_SPIN(cond, bar) do { unsigned _sp = 0; while (cond) { __builtin_amdgcn_s_sleep(1); \
    if ((++_sp & 255u) == 0u) { if (xb_ld(&(bar)[XB_TMO])) break; if (_sp > XB_SPIN_CAP) { atomicAdd(&(bar)[XB_TMO], 1u); break; } } } } while (0)

struct XcdBarrier {
    unsigned* bar; unsigned x;
    volatile LAS unsigned* st;
};

__device__ __forceinline__ XcdBarrier xcd_barrier_post(unsigned* bar, volatile LAS unsigned* st) {
    XcdBarrier b; b.bar = bar; b.x = xb_xcc_id(); b.st = st;
    if (tidx() == 0) (void)xb_add(&bar[XB_XCNT(b.x)], 1u);
    return b;
}
__device__ __forceinline__ void xcd_barrier_complete(unsigned* bar, unsigned x, unsigned& nloc, unsigned& nx) {
    const unsigned G = gridDim.x * gridDim.y * gridDim.z;
    unsigned sum, cnt, mine, sp = 0u;
    for (;;) {
        sum = 0u; cnt = 0u; mine = 0u;
#pragma unroll
        for (unsigned j = 0; j < 16; ++j) { const unsigned c = xb_ld(&bar[XB_XCNT(j)]); sum += c; cnt += (c > 0u) ? 1u : 0u; mine = (j == x) ? c : mine; }
        if (sum == G) break;
        __builtin_amdgcn_s_sleep(1);
        if ((++sp & 255u) == 0u) { if (xb_ld(&bar[XB_TMO])) break; if (sp > XB_SPIN_CAP) { atomicAdd(&bar[XB_TMO], 1u); break; } }
    }
    nloc = mine > 0u ? mine : 1u; nx = cnt > 0u ? cnt : 1u;
}

__device__ __forceinline__ void xcd_barrier(const XcdBarrier& b) {
    asm volatile("s_waitcnt vmcnt(0)" ::: "memory");
    __syncthreads();
    if (tidx() == 0) {
        unsigned* bar = b.bar;
        __builtin_amdgcn_s_waitcnt(0);
        unsigned nloc = b.st[0], nx = b.st[1];
        if (nloc == 0u) { xcd_barrier_complete(bar, b.x, nloc, nx); b.st[0] = nloc; b.st[1] = nx; }
        const unsigned old = xb_add(&bar[XB_XSUB(b.x)], 1u);
        const unsigned gen = old / nloc;
        if (old + 1u == (gen + 1u) * nloc) {
            __builtin_amdgcn_fence(__ATOMIC_RELEASE, "agent");
            asm volatile("s_waitcnt vmcnt(0)" ::: "memory");
            const unsigned og = xb_add(&bar[XB_TOP], 1u);
            const unsigned tg = og / nx;
            if (og + 1u == (tg + 1u) * nx) xb_add(&bar[XB_TOPGEN], 1u);
            else XB_SPIN(xb_ld(&bar[XB_TOPGEN]) == tg, bar);
            __builtin_amdgcn_fence(__ATOMIC_ACQUIRE, "agent");
            xb_add(&bar[XB_XGEN(b.x)], 1u);
            asm volatile("s_waitcnt vmcnt(0)" ::: "memory");
        } else {
            XB_SPIN(xb_ld(&bar[XB_XGEN(b.x)]) == gen, bar);
            __builtin_amdgcn_fence(__ATOMIC_ACQUIRE, "agent");
            asm volatile("s_waitcnt vmcnt(0)" ::: "memory");
        }
    }
    __syncthreads();
}

#define XB_ALIGN(j) (XCD_BAR_WORDS + 64 * (j))
#define XB_TOTAL_WORDS (XCD_BAR_WORDS + 64 * 16)
__device__ __forceinline__ void xcc_align(const XcdBarrier& b) {
    __syncthreads();
    if (tidx() == 0) {
        const unsigned nloc = b.st[0];
        if (nloc) {
            const unsigned old = xb_add(&b.bar[XB_ALIGN(b.x)], 1u), gen = old / nloc;
            unsigned sp = 0;
            while (xb_ld(&b.bar[XB_ALIGN(b.x)]) < (gen + 1u) * nloc && ++sp < (1u << 16)) __builtin_amdgcn_s_sleep(1);
        }
    }
    __syncthreads();
}
namespace pg8 {
#define PG8_LAS __attribute__((address_space(3)))
typedef unsigned short bf16_t;
typedef short bf16x8 __attribute__((ext_vector_type(8)));
typedef float f32x4 __attribute__((ext_vector_type(4)));
typedef unsigned u32x4 __attribute__((ext_vector_type(4)));
constexpr int BM = 256, BK = 64, HALF = 128, HTB = HALF * BK * 2  , STAGE_BYTES = 8 * HTB, NXCD = 8, WGM = 8;

__host__ __device__ __forceinline__ int lds_byte(int r, int c) { const int st = (r >> 4) * 2 + (c >> 5), rr = r & 15, cc = c & 31, ob = rr * 64 + cc * 2; return st * 1024 + (ob ^ (((ob >> 9) & 1) << 5)); }
__host__ __device__ __forceinline__ void stage_rc(int b, int& R, int& C) { const int st = b / 1024, sb = b % 1024, swz = sb ^ (((sb >> 9) & 1) << 5); R = (st >> 1) * 16 + swz / 64; C = (st & 1) * 32 + (swz % 64) / 2; }
__host__ __device__ __forceinline__ int perm32(int rho) { const int n = rho >> 4, i = rho & 15; return 8 * (i >> 2) + 4 * n + (i & 3); }

struct Unit { int pm, pn; };
struct Gemm { const bf16_t* A; const bf16_t* Bt; int M, N, K; };

struct StaticOrder {
    int nM, nN, nwg, G, c;
    __host__ __device__ void init(int M, int N, int G_, int c_) { nM = M / BM; nN = N / BM; nwg = nM * nN; G = G_; c = c_; }
    __host__ __device__ bool next(int i, Unit& u) const {
        const long L = (long)i * G + c; if (L >= nwg) return false;
        int wgid = (int)L; { const int q = nwg / NXCD, r = nwg % NXCD, xcd = wgid % NXCD, off = wgid / NXCD; wgid = (xcd < r ? xcd * (q + 1) : r * (q + 1) + (xcd - r) * q) + off; }
        const int nig = WGM * nN, gid = wgid / nig, fm = gid * WGM, gsz = (nM - fm) < WGM ? (nM - fm) : WGM;
        u.pm = fm + ((wgid % nig) % gsz); u.pn = (wgid % nig) / gsz; return true;
    }
    __device__ __forceinline__ void a_ready(const Unit&) const {}
    __device__ __forceinline__ void done(const Unit&) const {}
};
__device__ __forceinline__ unsigned cvt_pk_bf16(float lo, float hi) { unsigned r; asm volatile("v_cvt_pk_bf16_f32 %0, %1, %2" : "=v"(r) : "v"(lo), "v"(hi)); return r; }
template <class Epi, class Sched, bool STAMP = false>
__device__ __forceinline__ void gemm_phase(PG8_LAS unsigned char* lds, const Gemm g, const Sched& S, const Epi& E, unsigned long long* stamps) {
    const int tid = tidx(), wid = __builtin_amdgcn_readfirstlane(tid >> 6), lane = tid & 63, wr = wid >> 2, wc = wid & 3, fr = lane & 15, fq = lane >> 4;
    const int K = g.K, nt = K / BK;
    int ts_lo = 0, ts_hi = 0, nts = 0; const unsigned long long rt_entry = STAMP ? (unsigned long long)wall_clock64() : 0ull;
#define PG8_STAMP() do { if (STAMP && wid == 0 && nts < 64) { const unsigned long long _c = (unsigned long long)clock64(); \
        ts_lo = (lane == nts) ? (int)(unsigned)_c : ts_lo; ts_hi = (lane == nts) ? (int)(unsigned)(_c >> 32) : ts_hi; ++nts; } } while (0)
    PG8_STAMP();
    unsigned voffA[2], voffB[2];
#pragma unroll
    for (int i = 0; i < 2; ++i) { int R, C; stage_rc(tid * 16 + i * 8192, R, C); const int Rb = Epi::PERM ? ((R & ~31) + perm32(R & 31)) : R;
        voffA[i] = (unsigned)(R * K + C) * 2u; voffB[i] = (unsigned)(Rb * K + C) * 2u; }
    const size_t kstep = (size_t)(BK * 2);
    const size_t hstep = (size_t)HALF * K * 2;
    const size_t tstep = 2 * hstep;
    const unsigned ldsw = (unsigned)wid * 1024u;
    const int aoff = lds_byte(wr * 64 + fr, fq * 8), boff = lds_byte(wc * 32 + fr, fq * 8);
#define PG8_SA(b, h) (((b) * 2 + (h)) * HTB)
#define PG8_SB(b, h) ((4 + (b) * 2 + (h)) * HTB)
#define PG8_STAGE(bufoff, gbase, voff) do { _Pragma("unroll") for (int _i = 0; _i < 2; ++_i) \
        __builtin_amdgcn_global_load_lds((const unsigned*)((const char*)(gbase) + (voff)[_i]), (PG8_LAS unsigned*)(lds + (bufoff) + ldsw + _i * 8192), 16, 0, 0); } while (0)
#define PG8_LDA(dst, b, h) do { _Pragma("unroll") for (int m = 0; m < 4; ++m) _Pragma("unroll") for (int k = 0; k < 2; ++k) dst[m][k] = *(const PG8_LAS bf16x8*)(lds + PG8_SA(b, h) + aoff + m * 2048 + k * 1024); } while (0)
#define PG8_LDB(dst, b, h) do { _Pragma("unroll") for (int n = 0; n < 2; ++n) _Pragma("unroll") for (int k = 0; k < 2; ++k) dst[n][k] = *(const PG8_LAS bf16x8*)(lds + PG8_SB(b, h) + boff + n * 2048 + k * 1024); } while (0)
#define PG8_MMA(ai, bj, At, Bt) do { __builtin_amdgcn_s_setprio(1); _Pragma("unroll") for (int m = 0; m < 4; ++m) _Pragma("unroll") for (int n = 0; n < 2; ++n) _Pragma("unroll") for (int k = 0; k < 2; ++k) \
        acc[ai][bj][m][n] = __builtin_amdgcn_mfma_f32_16x16x32_bf16(Bt[n][k], At[m][k], acc[ai][bj][m][n], 0, 0, 0); __builtin_amdgcn_s_setprio(0); } while (0)
#define PG8_WAIT_V(n) asm volatile("s_waitcnt vmcnt(" #n ")" ::: "memory")
#define PG8_WAIT_L(n) asm volatile("s_waitcnt lgkmcnt(" #n ")" ::: "memory")
#define PG8_BAR __builtin_amdgcn_s_barrier()
#define PG8_SCHED __builtin_amdgcn_sched_barrier(0)
    Unit cur, nxt; int ui = 0;
    if (!S.next(0, cur)) return;
    f32x4 acc[2][2][4][2];
#pragma unroll
    for (int a = 0; a < 2; ++a)
#pragma unroll
        for (int b = 0; b < 2; ++b)
#pragma unroll
            for (int m = 0; m < 4; ++m)
#pragma unroll
                for (int n = 0; n < 2; ++n) acc[a][b][m][n] = (f32x4){0.f, 0.f, 0.f, 0.f};
    bf16x8 At[4][2], B0[2][2], B1[2][2];
    const char* cA = (const char*)g.A + (size_t)cur.pm * tstep; const char* cB = (const char*)g.Bt + (size_t)cur.pn * tstep;
    S.a_ready(cur);
    PG8_STAGE(PG8_SB(0, 0), cB, voffB); PG8_STAGE(PG8_SA(0, 0), cA, voffA); PG8_STAGE(PG8_SB(0, 1), cB + hstep, voffB); PG8_STAGE(PG8_SA(0, 1), cA + hstep, voffA);
    if (wr == 1) PG8_BAR;
    PG8_WAIT_V(4); PG8_BAR;
    PG8_STAGE(PG8_SB(1, 0), cB + kstep, voffB); PG8_STAGE(PG8_SA(1, 0), cA + kstep, voffA); PG8_STAGE(PG8_SB(1, 1), cB + hstep + kstep, voffB);
    PG8_WAIT_V(6); PG8_BAR;
    PG8_STAMP();
    for (;;) {
        const bool has_next = S.next(ui + 1, nxt);
        const char* nA = has_next ? (const char*)g.A + (size_t)nxt.pm * tstep : cA; const char* nB = has_next ? (const char*)g.Bt + (size_t)nxt.pn * tstep : cB;
        for (int t = 0; t < nt; t += 2) {
            const bool last = (t == nt - 2);
            const char* a1 = cA + (size_t)(t + 1) * kstep;
            const char* a2 = last ? nA : cA + (size_t)(t + 2) * kstep; const char* b2 = last ? nB : cB + (size_t)(t + 2) * kstep;
            const char* a3 = a2 + kstep; const char* b3 = b2 + kstep;
            if (last && has_next) S.a_ready(nxt);
            PG8_LDB(B0, 0, 0); PG8_SCHED; PG8_LDA(At, 0, 0); PG8_STAGE(PG8_SA(1, 1), a1 + hstep, voffA);
            PG8_WAIT_L(8); PG8_BAR; PG8_WAIT_L(0); PG8_MMA(0, 0, At, B0); PG8_BAR; PG8_SCHED;
            PG8_LDB(B1, 0, 1); PG8_STAGE(PG8_SB(0, 0), b2, voffB);
            PG8_BAR; PG8_WAIT_L(0); PG8_MMA(0, 1, At, B1); PG8_BAR;
            PG8_LDA(At, 0, 1); PG8_STAGE(PG8_SA(0, 0), a2, voffA);
            PG8_BAR; PG8_WAIT_L(0); PG8_MMA(1, 0, At, B0); PG8_BAR; PG8_SCHED;
            PG8_STAGE(PG8_SB(0, 1), b2 + hstep, voffB);
            PG8_WAIT_V(6); PG8_BAR; PG8_MMA(1, 1, At, B1); PG8_BAR;
            PG8_LDB(B0, 1, 0); PG8_SCHED; PG8_LDA(At, 1, 0); PG8_STAGE(PG8_SA(0, 1), a2 + hstep, voffA);
            PG8_WAIT_L(8); PG8_BAR; PG8_WAIT_L(0); PG8_MMA(0, 0, At, B0); PG8_BAR; PG8_SCHED;
            PG8_LDB(B1, 1, 1); PG8_STAGE(PG8_SB(1, 0), b3, voffB);
            PG8_BAR; PG8_WAIT_L(0); PG8_MMA(0, 1, At, B1); PG8_BAR;
            PG8_LDA(At, 1, 1); PG8_STAGE(PG8_SA(1, 0), a3, voffA);
            PG8_BAR; PG8_WAIT_L(0); PG8_MMA(1, 0, At, B0); PG8_BAR; PG8_SCHED;
            PG8_STAGE(PG8_SB(1, 1), b3 + hstep, voffB);
            PG8_WAIT_V(6); PG8_BAR; PG8_MMA(1, 1, At, B1); PG8_BAR;
        }
        PG8_STAMP();
        if constexpr (!Epi::AFTER_DRAIN) { E(acc, cur, wr, wc, fr, fq); S.done(cur); }
        PG8_STAMP();
        if (!has_next) break;
#pragma unroll
        for (int a = 0; a < 2; ++a)
#pragma unroll
            for (int b = 0; b < 2; ++b)
#pragma unroll
                for (int m = 0; m < 4; ++m)
#pragma unroll
                    for (int n = 0; n < 2; ++n) acc[a][b][m][n] = (f32x4){0.f, 0.f, 0.f, 0.f};
        cur = nxt; cA = nA; cB = nB; ++ui;
    }
    PG8_WAIT_V(0);
    if (wr == 0) PG8_BAR;
    PG8_BAR;
    if constexpr (Epi::AFTER_DRAIN) { E.fused(acc, cur, wr, wc, fr, fq, lds, wid, lane); S.done(cur); }
    PG8_STAMP();
    if (STAMP && wid == 0) { stamps[lane] = lane < nts ? (((unsigned long long)(unsigned)ts_hi << 32) | (unsigned)ts_lo) : 0ull;
        if (lane == 62) stamps[62] = rt_entry; if (lane == 63) stamps[63] = (unsigned long long)wall_clock64(); }
#undef PG8_STAMP
#undef PG8_SA
#undef PG8_SB
#undef PG8_STAGE
#undef PG8_LDA
#undef PG8_LDB
#undef PG8_MMA
#undef PG8_WAIT_V
#undef PG8_WAIT_L
#undef PG8_BAR
#undef PG8_SCHED
}
}

namespace {
using pg8::bf16_t;
typedef float f32x4 __attribute__((ext_vector_type(4)));
typedef unsigned u32x4 __attribute__((ext_vector_type(4)));

constexpr int NB = 16, NL = 2048, ND = 1024, NT = NB * NL;
constexpr int EVEN_IN = 2560, ODD_IN = 2608, ODD_PAD = 2304;
constexpr float ALPHA = 1.41421356237f;
constexpr float LN_EPS = 1e-5f;
constexpr float U_SCALE = 256.f, V_SCALE = 16.f;
constexpr int NTHR = 512;
constexpr int LDS_BYTES = 163840;
#ifndef PROBE
#define PROBE 0
#endif
#define PDUP(bit) for (int _rep = 0; _rep < ((PROBE >> (bit)) & 1) + 1; ++_rep)
#ifndef PHMASK
#define PHMASK 0xFFFFFFFFu
#endif
#define PH(n) if (PHMASK & (1u << (n)))

__device__ __forceinline__ float bf2f(bf16_t v) { return __uint_as_float((unsigned)v << 16); }
__device__ __forceinline__ bf16_t f2bf(float f) { unsigned u = __float_as_uint(f); u += 0x7FFFu + ((u >> 16) & 1u); return (bf16_t)(u >> 16); }
__device__ __forceinline__ unsigned pack2(float lo, float hi) { return (unsigned)f2bf(lo) | ((unsigned)f2bf(hi) << 16); }
__device__ __forceinline__ void ld8(const bf16_t* p, float* o) {
    const uint4 v = *(const uint4*)p;
    o[0] = __uint_as_float(v.x << 16); o[1] = __uint_as_float(v.x & 0xffff0000u);
    o[2] = __uint_as_float(v.y << 16); o[3] = __uint_as_float(v.y & 0xffff0000u);
    o[4] = __uint_as_float(v.z << 16); o[5] = __uint_as_float(v.z & 0xffff0000u);
    o[6] = __uint_as_float(v.w << 16); o[7] = __uint_as_float(v.w & 0xffff0000u);
}
__device__ __forceinline__ void st8(bf16_t* p, const float* o) {
    uint4 v; v.x = pack2(o[0], o[1]); v.y = pack2(o[2], o[3]); v.z = pack2(o[4], o[5]); v.w = pack2(o[6], o[7]);
    *(uint4*)p = v;
}

struct EpiBf16s {
    static constexpr bool PERM = true, AFTER_DRAIN = false;
    bf16_t* O; int ldc;
    __device__ __forceinline__ void operator()(const f32x4 (&acc)[2][2][4][2], const pg8::Unit& u, int wr, int wc, int fr, int fq) const {
        const int row0 = u.pm * 256 + wr * 64 + fr, col0 = u.pn * 256 + wc * 32 + 8 * fq;
#pragma unroll
        for (int ai = 0; ai < 2; ++ai)
#pragma unroll
            for (int m = 0; m < 4; ++m) { bf16_t* rowp = O + (size_t)(row0 + ai * 128 + m * 16) * ldc + col0;
#pragma unroll
                for (int bj = 0; bj < 2; ++bj) { const f32x4 v0 = acc[ai][bj][m][0], v1 = acc[ai][bj][m][1];
                    u32x4 w; w.x = pg8::cvt_pk_bf16(v0[0], v0[1]); w.y = pg8::cvt_pk_bf16(v0[2], v0[3]); w.z = pg8::cvt_pk_bf16(v1[0], v1[1]); w.w = pg8::cvt_pk_bf16(v1[2], v1[3]);
                    *(u32x4*)(rowp + bj * 128) = w; } }
    }
};
struct EpiRes {
    static constexpr bool PERM = false, AFTER_DRAIN = false;
    float* C; int ldc; float alpha; float* Cout;
    __device__ __forceinline__ void operator()(const f32x4 (&acc)[2][2][4][2], const pg8::Unit& u, int wr, int wc, int fr, int fq) const {
        const int row0 = u.pm * 256 + wr * 64 + fr, col0 = u.pn * 256 + wc * 32 + 4 * fq; const size_t dlt = Cout - C;
#pragma unroll
        for (int ai = 0; ai < 2; ++ai)
#pragma unroll
            for (int m = 0; m < 4; ++m) { float* rowp = C + (size_t)(row0 + ai * 128 + m * 16) * ldc + col0;
#pragma unroll
                for (int bj = 0; bj < 2; ++bj)
#pragma unroll
                    for (int n = 0; n < 2; ++n) { f32x4* cp = (f32x4*)(rowp + bj * 128 + n * 16); *(cp + dlt / 4) = *cp * alpha + acc[ai][bj][m][n]; } }
    }
};

struct EpiResStats {
    static constexpr bool PERM = false, AFTER_DRAIN = false;
    const float* Cin; float* C; int ldc; float alpha; bf16_t* Vb; float* part;
    __device__ __forceinline__ void operator()(const f32x4 (&acc)[2][2][4][2], const pg8::Unit& u, int wr, int wc, int fr, int fq) const {
        const int row0 = u.pm * 256 + wr * 64 + fr, col0 = u.pn * 256 + wc * 32 + 4 * fq;
#pragma unroll
        for (int ai = 0; ai < 2; ++ai)
#pragma unroll
            for (int m = 0; m < 4; ++m) {
                const int row = row0 + ai * 128 + m * 16;
                float* rowp = C + (size_t)row * ldc + col0;
                const float* rowi = Cin + (size_t)row * ldc + col0;
                bf16_t* rowb = Vb + (size_t)row * ldc + col0;
                float s1 = 0.f, s2 = 0.f;
#pragma unroll
                for (int bj = 0; bj < 2; ++bj)
#pragma unroll
                    for (int n = 0; n < 2; ++n) {
                        f32x4* cp = (f32x4*)(rowp + bj * 128 + n * 16);
                        const f32x4 v = *(const f32x4*)(rowi + bj * 128 + n * 16) * alpha + acc[ai][bj][m][n];
                        *cp = v;
                        *(uint2*)(rowb + bj * 128 + n * 16) = make_uint2(pg8::cvt_pk_bf16(v[0], v[1]), pg8::cvt_pk_bf16(v[2], v[3]));
                        s1 += (v[0] + v[1]) + (v[2] + v[3]);
                        s2 += (v[0] * v[0] + v[1] * v[1]) + (v[2] * v[2] + v[3] * v[3]);
                    }
                s1 += __shfl_xor(s1, 16); s2 += __shfl_xor(s2, 16);
                s1 += __shfl_xor(s1, 32); s2 += __shfl_xor(s2, 32);
                if (fq == 0) *(float2*)(part + ((size_t)row * 16 + u.pn * 4 + wc) * 2) = make_float2(s1, s2);
            }
    }
};
struct EpiBf16LN {
    static constexpr bool PERM = true, AFTER_DRAIN = false;
    bf16_t* O; int ldc; const float* csum; const float* dvec; const float2* stats  ; int pm0, pm1, pm2, pm3;
    __device__ __forceinline__ void operator()(const f32x4 (&acc)[2][2][4][2], const pg8::Unit& u, int wr, int wc, int fr, int fq) const {
        const int slot = (u.pm == pm0) ? 0 : ((u.pm == pm1) ? 1 : ((u.pm == pm2) ? 2 : 3));
        const float2* st = stats + slot * 256;
        const int lrow0 = wr * 64 + fr, col0 = u.pn * 256 + wc * 32 + 8 * fq;
        f32x4 cv[2][2], dv[2][2];
#pragma unroll
        for (int bj = 0; bj < 2; ++bj)
#pragma unroll
            for (int n = 0; n < 2; ++n) { cv[bj][n] = *(const f32x4*)(csum + col0 + bj * 128 + 4 * n); dv[bj][n] = *(const f32x4*)(dvec + col0 + bj * 128 + 4 * n); }
#pragma unroll
        for (int ai = 0; ai < 2; ++ai)
#pragma unroll
            for (int m = 0; m < 4; ++m) {
                const int lrow = lrow0 + ai * 128 + m * 16;
                const float2 ms = st[lrow];
                bf16_t* rowp = O + (size_t)(u.pm * 256 + lrow) * ldc + col0;
#pragma unroll
                for (int bj = 0; bj < 2; ++bj) {
                    const f32x4 v0 = (acc[ai][bj][m][0] - cv[bj][0] * ms.x) * ms.y + dv[bj][0], v1 = (acc[ai][bj][m][1] - cv[bj][1] * ms.x) * ms.y + dv[bj][1];
                    u32x4 w; w.x = pg8::cvt_pk_bf16(v0[0], v0[1]); w.y = pg8::cvt_pk_bf16(v0[2], v0[3]); w.z = pg8::cvt_pk_bf16(v1[0], v1[1]); w.w = pg8::cvt_pk_bf16(v1[2], v1[3]);
                    *(u32x4*)(rowp + bj * 128) = w;
                }
            }
    }
};
__device__ __forceinline__ void gemm_q_phase(unsigned char* lds, const bf16_t* Vb, const bf16_t* Wt, const float* __restrict__ part, const float* csum, const float* dvec, bf16_t* Q) {
    pg8::StaticOrder S; S.init(NT, 2048, (int)gridDim.x, (int)blockIdx.x);
    int pms[4] = {-1, -1, -1, -1};
    float2* st = (float2*)(lds + 131072);
    __syncthreads();
#pragma unroll
    for (int i = 0; i < 4; ++i) {
        pg8::Unit u;
        if (S.next(i, u)) {
            bool seen = false;
#pragma unroll
            for (int j = 0; j < 4; ++j) if (j < i && pms[j] == u.pm) seen = true;
            pms[i] = seen ? -2 - i : u.pm;
            if (!seen && tidx() < 256) {
                const int row = u.pm * 256 + tidx();
                const float4* pp = (const float4*)(part + (size_t)row * 32);
                float s1 = 0.f, s2 = 0.f;
#pragma unroll
                for (int k = 0; k < 8; ++k) { const float4 a = pp[k]; s1 += a.x; s2 += a.y; s1 += a.z; s2 += a.w; }
                const float mean = s1 * (1.f / ND), var = fmaxf(s2 * (1.f / ND) - mean * mean, 0.f);
                st[i * 256 + tidx()] = make_float2(mean, rsqrtf(var + LN_EPS));
            }
        }
    }
    __syncthreads();
    pg8::Gemm g{Vb, Wt, NT, 2048, ND};
    EpiBf16LN E{Q, 2048, csum, dvec, st, pms[0], pms[1], pms[2], pms[3]};
    pg8::gemm_phase<EpiBf16LN, pg8::StaticOrder, false>((PG8_LAS unsigned char*)lds, g, S, E, nullptr);
    __syncthreads();
}
template <class Epi>
__device__ __forceinline__ void gemm_bf16_phase(unsigned char* lds, const bf16_t* A, const bf16_t* Bt, int M, int N, int K, const Epi& E, bool reverse_ids = false) {
    pg8::Gemm g{A, Bt, M, N, K};
    pg8::StaticOrder S; S.init(M, N, (int)gridDim.x, reverse_ids ? (int)(gridDim.x - 1 - blockIdx.x) : (int)blockIdx.x);
    pg8::gemm_phase<Epi, pg8::StaticOrder, false>((PG8_LAS unsigned char*)lds, g, S, E, nullptr);
    __syncthreads();
}

struct ColMap { int d0[3], s0[3], len[3]; };
__device__ __forceinline__ void convert_wt_phase(const float* __restrict__ W, int K, int N, int Npad, const ColMap cm, bf16_t* __restrict__ Wt, float* lds, const float* __restrict__ rowscale = nullptr) {
    float(*tile)[65] = (float(*)[65])lds;
    const int tid = tidx(), ntn = Npad / 64, ntiles = (K / 64) * ntn;
    for (int it = blockIdx.x; it < ntiles; it += gridDim.x) {
        const int k0 = (it / ntn) * 64, n0 = (it % ntn) * 64;
        __syncthreads();
#pragma unroll
        for (int h = 0; h < 2; ++h) {
            const int r = (tid >> 4) + h * 32, c4 = (tid & 15) * 4, nd = n0 + c4;
            int ns = -1;
#pragma unroll
            for (int sg = 0; sg < 3; ++sg) if (nd >= cm.d0[sg] && nd < cm.d0[sg] + cm.len[sg]) ns = cm.s0[sg] + (nd - cm.d0[sg]);
            float4 v = make_float4(0.f, 0.f, 0.f, 0.f);
            if (ns >= 0) v = *(const float4*)(W + (size_t)(k0 + r) * N + ns);
            if (rowscale) { const float gsc = rowscale[k0 + r]; v.x *= gsc; v.y *= gsc; v.z *= gsc; v.w *= gsc; }
            tile[r][c4] = v.x; tile[r][c4 + 1] = v.y; tile[r][c4 + 2] = v.z; tile[r][c4 + 3] = v.w;
        }
        __syncthreads();
        const int n = tid >> 3, k8 = (tid & 7) * 8;
        float o[8];
#pragma unroll
        for (int j = 0; j < 8; ++j) o[j] = tile[k8 + j][n];
        st8(Wt + (size_t)(n0 + n) * K + k0 + k8, o);
    }
    __syncthreads();
}
__device__ __forceinline__ float gelu_tanh(float x) {
    float u = 0.7978845608028654f * (x + 0.044715f * x * x * x);
    return 0.5f * x * (1.f + tanhf(u));
}
__device__ __forceinline__ float sigmoidf_(float x) { return 1.f / (1.f + expf(-x)); }
__device__ __forceinline__ void wave_lds_fence() { asm volatile("s_waitcnt lgkmcnt(0)" ::: "memory"); }

__device__ __forceinline__ void s5_scan_wave(int bg, const bf16_t* __restrict__ proj, const float* __restrict__ lam_re, const float* __restrict__ lam_im,
                             const float* __restrict__ log_dt, const float* __restrict__ b_re, const float* __restrict__ b_im,
                             const float* __restrict__ c_re, const float* __restrict__ c_im, const float* __restrict__ dskip,
                             float* __restrict__ ya, float* lds) {
    const int b = bg >> 4, g = bg & 15, lane = tidx() & 63;
    float(*us)[16] = (float(*)[16])lds;
    float(*xr)[65] = (float(*)[65])(lds + 1024);
    float(*xi)[65] = (float(*)[65])(lds + 1024 + 4160);
    float(*cr)[64] = (float(*)[64])(lds + 1024 + 8320);
    float(*ci)[64] = (float(*)[64])(lds + 1024 + 8320 + 1024);
    const float lr = lam_re[g * 64 + lane], li = lam_im[g * 64 + lane];
    const float dt = expf(log_dt[g]);
    const float mag = expf(lr * dt);
    const float are = mag * cosf(li * dt), aim = mag * sinf(li * dt);
    const float nr = are - 1.f, den = lr * lr + li * li;
    const float fre = (nr * lr + aim * li) / den, fim = (aim * lr - nr * li) / den;
    float bbr[16], bbi[16];
#pragma unroll
    for (int i = 0; i < 16; ++i) {
        const float br = b_re[(g * 64 + lane) * 16 + i], bi = b_im[(g * 64 + lane) * 16 + i];
        bbr[i] = fre * br - fim * bi; bbi[i] = fre * bi + fim * br;
    }
    for (int idx = lane; idx < 1024; idx += 64) { cr[idx >> 6][idx & 63] = c_re[g * 1024 + idx]; ci[idx >> 6][idx & 63] = c_im[g * 1024 + idx]; }
    float dsk[16];
#pragma unroll
    for (int i = 0; i < 16; ++i) dsk[i] = dskip[g * 16 + i];
    float xre = 0.f, xim = 0.f;
    for (int t0 = 0; t0 < NL; t0 += 64) {
        wave_lds_fence();
        for (int idx = lane; idx < 1024; idx += 64) { const int t = idx >> 4, i = idx & 15; us[t][i] = bf2f(proj[(size_t)(b * NL + t0 + t) * EVEN_IN + g * 16 + i]); }
        wave_lds_fence();
        for (int t = 0; t < 64; ++t) {
            float bur = 0.f, bui = 0.f;
#pragma unroll
            for (int i = 0; i < 16; ++i) { const float u = us[t][i]; bur += bbr[i] * u; bui += bbi[i] * u; }
            const float nre = are * xre - aim * xim + bur, nim = are * xim + aim * xre + bui;
            xre = nre; xim = nim;
            xr[t][lane] = xre; xi[t][lane] = xim;
        }
        wave_lds_fence();
        float y[16];
#pragma unroll
        for (int i = 0; i < 16; ++i) y[i] = 0.f;
        for (int p = 0; p < 64; ++p) {
            const float a = xr[lane][p], bq = xi[lane][p];
#pragma unroll
            for (int i = 0; i < 16; ++i) y[i] += cr[i][p] * a - ci[i][p] * bq;
        }
#pragma unroll
        for (int i = 0; i < 16; ++i) {
            const float v = y[i] + dsk[i] * us[lane][i];
            ya[(size_t)(b * NL + t0 + lane) * 256 + g * 16 + i] = gelu_tanh(v);
        }
    }
}

__device__ __forceinline__ void sb_attn_wave(int task, const bf16_t* __restrict__ proj, bf16_t* __restrict__ Y, float* wl) {
    const int qt = task & 31, h = (task >> 5) % 12, b = task / 384, lane = tidx() & 63;
    const int t = qt * 64 + lane;
    float(*ks)[64] = (float(*)[64])wl;
    float(*vs)[64] = (float(*)[64])(wl + 2048);
    const bf16_t* base = proj + (size_t)b * NL * EVEN_IN;
    float q[64], acc[64];
#pragma unroll
    for (int d = 0; d < 64; d += 8) ld8(base + (size_t)t * EVEN_IN + 256 + h * 64 + d, q + d);
#pragma unroll
    for (int d = 0; d < 64; ++d) acc[d] = 0.f;
    float tail = 0.f;
    for (int c = 2 * qt + 1; c >= 0; --c) {
        wave_lds_fence();
        for (int i = 0; i < 32; ++i) {
            ks[i][lane] = bf2f(base[(size_t)(c * 32 + i) * EVEN_IN + 1024 + h * 64 + lane]);
            vs[i][lane] = bf2f(base[(size_t)(c * 32 + i) * EVEN_IN + 1792 + h * 64 + lane]);
        }
        wave_lds_fence();
        for (int s = 31; s >= 0; --s) {
            const int key = c * 32 + s;
            float z = 0.f;
#pragma unroll
            for (int d = 0; d < 64; ++d) z += q[d] * ks[s][d];
            z *= 0.125f;
            const bool valid = key < t;
            const float sp = fmaxf(z, 0.f) + log1pf(expf(-fabsf(z)));
            const float w = valid ? expf(z - sp + tail) : 0.f;
#pragma unroll
            for (int d = 0; d < 64; ++d) acc[d] += w * vs[s][d];
            if (valid) tail -= sp;
        }
        if (__all(tail < -120.f)) break;
    }
#pragma unroll
    for (int d = 0; d < 64; d += 8) st8(Y + (size_t)(b * NL + t) * ND + 256 + h * 64 + d, acc + d);
}

__device__ __forceinline__ void glu_phase(const float* __restrict__ ya, const float* __restrict__ wglu, const float* __restrict__ bglu, bf16_t* __restrict__ Y, float* lds) {
    const int half = tidx() >> 8, c = tidx() & 255;
    float(*ys)[256] = (float(*)[256])(lds + half * 4096);
    for (int it = blockIdx.x; it < NT / 32; it += gridDim.x) {
        const int t0 = it * 32 + half * 16;
        __syncthreads();
        for (int i = 0; i < 16; ++i) ys[i][c] = ya[(size_t)(t0 + i) * 256 + c];
        __syncthreads();
        float acc[16];
#pragma unroll
        for (int i = 0; i < 16; ++i) acc[i] = 0.f;
        for (int k = 0; k < 256; ++k) {
            const float w = wglu[k * 256 + c];
#pragma unroll
            for (int i = 0; i < 16; ++i) acc[i] += ys[i][k] * w;
        }
        const float bb = bglu[c];
#pragma unroll
        for (int i = 0; i < 16; ++i) Y[(size_t)(t0 + i) * ND + c] = f2bf(ys[i][c] * sigmoidf_(acc[i] + bb));
    }
    __syncthreads();
}

__device__ __forceinline__ void ln_row_wave(float4 (&v)[4], const float* __restrict__ g, const float* __restrict__ bta, float* out, bf16_t* outb, int lane) {
    float s = 0.f;
#pragma unroll
    for (int j = 0; j < 4; ++j) s += v[j].x + v[j].y + v[j].z + v[j].w;
    for (int o = 32; o; o >>= 1) s += __shfl_xor(s, o);
    const float mean = s * (1.f / ND);
    float s2 = 0.f;
#pragma unroll
    for (int j = 0; j < 4; ++j) {
        v[j].x -= mean; v[j].y -= mean; v[j].z -= mean; v[j].w -= mean;
        s2 += v[j].x * v[j].x + v[j].y * v[j].y + v[j].z * v[j].z + v[j].w * v[j].w;
    }
    for (int o = 32; o; o >>= 1) s2 += __shfl_xor(s2, o);
    const float rs = rsqrtf(s2 * (1.f / ND) + LN_EPS);
#pragma unroll
    for (int j = 0; j < 4; ++j) {
        const float4 gg = *(const float4*)(g + j * 256 + lane * 4), bb = *(const float4*)(bta + j * 256 + lane * 4);
        const float4 o = make_float4(v[j].x * rs * gg.x + bb.x, v[j].y * rs * gg.y + bb.y, v[j].z * rs * gg.z + bb.z, v[j].w * rs * gg.w + bb.w);
        *(float4*)(out + j * 256 + lane * 4) = o;
        if (outb) { uint2 w; w.x = pack2(o.x, o.y); w.y = pack2(o.z, o.w); *(uint2*)(outb + j * 256 + lane * 4) = w; }
    }
}
__device__ __forceinline__ void ln_phase(float* R, bf16_t* Hb, const float* __restrict__ g, const float* __restrict__ bta) {
    const int wave = tidx() >> 6, lane = tidx() & 63;
    for (int row = blockIdx.x * 8 + wave; row < NT; row += gridDim.x * 8) {
        float4 v[4];
#pragma unroll
        for (int j = 0; j < 4; ++j) v[j] = *(const float4*)(R + (size_t)row * ND + j * 256 + lane * 4);
        ln_row_wave(v, g, bta, R + (size_t)row * ND, Hb + (size_t)row * ND, lane);
    }
}

__device__ __forceinline__ void wave_argmax(float& bv, int& bi) {
#pragma unroll
    for (int o = 32; o; o >>= 1) {
        const float ov = __shfl_xor(bv, o); const int oi = __shfl_xor(bi, o);
        if (ov > bv || (ov == bv && oi < bi)) { bv = ov; bi = oi; }
    }
}
__device__ __forceinline__ void peer_route_phase(const bf16_t* __restrict__ qbuf, const float* __restrict__ subk, int* __restrict__ eidx, float* __restrict__ egate, float* lds) {
    const int head = tidx() >> 6, lane = tidx() & 63;
    float* qs = lds + head * 256;
    for (int token = blockIdx.x; token < NT; token += gridDim.x) {
        const bf16_t* qp = qbuf + (size_t)token * 2048 + head * 256;
        wave_lds_fence();
        for (int i = 0; i < 4; ++i) qs[lane + 64 * i] = bf2f(qp[lane + 64 * i]);
        wave_lds_fence();
        float myv[2]; int myi[2];
#pragma unroll
        for (int c = 0; c < 2; ++c) {
            float sc[2];
#pragma unroll
            for (int w2 = 0; w2 < 2; ++w2) {
                const float* kr = subk + ((size_t)(head * 2 + c) * 128 + lane + 64 * w2) * 128;
                float a = 0.f;
#pragma unroll 4
                for (int d = 0; d < 128; d += 4) {
                    const float4 kv = *(const float4*)(kr + d);
                    a += qs[c * 128 + d] * kv.x + qs[c * 128 + d + 1] * kv.y + qs[c * 128 + d + 2] * kv.z + qs[c * 128 + d + 3] * kv.w;
                }
                sc[w2] = a;
            }
            float a0 = sc[0], a1 = sc[1];
            float mv = -INFINITY; int mi = 0;
            for (int r = 0; r < 16; ++r) {
                float bv; int bi;
                if (a0 >= a1) { bv = a0; bi = lane; } else { bv = a1; bi = lane + 64; }
                wave_argmax(bv, bi);
                if (lane == r) { mv = bv; mi = bi; }
                if (bi == lane) a0 = -INFINITY; else if (bi == lane + 64) a1 = -INFINITY;
            }
            myv[c] = mv; myi[c] = mi;
        }
        const float va = __shfl(myv[0], lane >> 2);
        float cand[4];
#pragma unroll
        for (int j = 0; j < 4; ++j) cand[j] = va + __shfl(myv[1], (lane & 3) * 4 + j);
        float topv = -INFINITY; int topf = 0;
        for (int r = 0; r < 16; ++r) {
            float bv = cand[0]; int bi = lane * 4;
#pragma unroll
            for (int j = 1; j < 4; ++j) if (cand[j] > bv) { bv = cand[j]; bi = lane * 4 + j; }
            wave_argmax(bv, bi);
            if (lane == r) { topv = bv; topf = bi; }
#pragma unroll
            for (int j = 0; j < 4; ++j) if (bi == lane * 4 + j) cand[j] = -INFINITY;
        }
        const int e1 = __shfl(myi[0], topf >> 4), e2 = __shfl(myi[1], topf & 15);
        const float top0 = __shfl(topv, 0);
        float ex = (lane < 16) ? expf(topv - top0) : 0.f;
        float sum = ex;
        for (int o = 32; o; o >>= 1) sum += __shfl_xor(sum, o);
        if (lane < 16) {
            eidx[(size_t)token * 128 + head * 16 + lane] = e1 * 128 + e2;
            egate[(size_t)token * 128 + head * 16 + lane] = ex / sum;
        }
    }
}

__device__ __forceinline__ void peer_expert_phase(float* R, const int* __restrict__ eidx, const float* __restrict__ egate, const float* __restrict__ utab,
                                  const float* __restrict__ vtab, const float* __restrict__ lg, const float* __restrict__ lb, bf16_t* Hb) {
    const int wave = tidx() >> 6, lane = tidx() & 63;
    for (int token = blockIdx.x * 8 + wave; token < NT; token += gridDim.x * 8) {
        float4 x[4], acc[4];
#pragma unroll
        for (int j = 0; j < 4; ++j) { x[j] = *(const float4*)(R + (size_t)token * ND + j * 256 + lane * 4); acc[j] = make_float4(0.f, 0.f, 0.f, 0.f); }
        for (int e0 = 0; e0 < 128; e0 += 4) {
            float dot[4]; int ex[4]; float gt[4];
#pragma unroll
            for (int k = 0; k < 4; ++k) {
                ex[k] = eidx[(size_t)token * 128 + e0 + k]; gt[k] = egate[(size_t)token * 128 + e0 + k];
                const float* ur = utab + (size_t)ex[k] * ND + lane * 4;
                float a = 0.f;
#pragma unroll
                for (int j = 0; j < 4; ++j) { const float4 u = *(const float4*)(ur + j * 256); a += x[j].x * u.x + x[j].y * u.y + x[j].z * u.z + x[j].w * u.w; }
                dot[k] = a;
            }
#pragma unroll
            for (int k = 0; k < 4; ++k) {
                float a = dot[k];
                for (int o = 32; o; o >>= 1) a += __shfl_xor(a, o);
                const float coef = gt[k] * gelu_tanh(a);
                const float* vr = vtab + (size_t)ex[k] * ND + lane * 4;
#pragma unroll
                for (int j = 0; j < 4; ++j) { const float4 v = *(const float4*)(vr + j * 256); acc[j].x += coef * v.x; acc[j].y += coef * v.y; acc[j].z += coef * v.z; acc[j].w += coef * v.w; }
            }
        }
#pragma unroll
        for (int j = 0; j < 4; ++j) { x[j].x = ALPHA * x[j].x + acc[j].x; x[j].y = ALPHA * x[j].y + acc[j].y; x[j].z = ALPHA * x[j].z + acc[j].z; x[j].w = ALPHA * x[j].w + acc[j].w; }
        ln_row_wave(x, lg, lb, R + (size_t)token * ND, Hb ? Hb + (size_t)token * ND : nullptr, lane);
    }
}


typedef short bf16x8_t __attribute__((ext_vector_type(8)));
__device__ __forceinline__ int f2key(float f) { const int b = __float_as_int(f); return b ^ ((b >> 31) & 0x7fffffff); }
__device__ __forceinline__ float key2f(int k) { return __int_as_float(k ^ ((k >> 31) & 0x7fffffff)); }
#define CE_DESC_I(a, b) do { const int _hi = max(a, b), _lo = min(a, b); a = _hi; b = _lo; } while (0)
template <int N, int K, int J> __device__ __forceinline__ void bstage(int (&v)[N]) {
#pragma unroll
    for (int i = 0; i < N; ++i) {
        const int l = i ^ J;
        if (l > i) { if ((i & K) == 0) CE_DESC_I(v[i], v[l]); else CE_DESC_I(v[l], v[i]); }
    }
}
__device__ __forceinline__ void sort16_desc(int (&v)[16]) {
    bstage<16, 2, 1>(v); bstage<16, 4, 2>(v); bstage<16, 4, 1>(v); bstage<16, 8, 4>(v); bstage<16, 8, 2>(v); bstage<16, 8, 1>(v);
    bstage<16, 16, 8>(v); bstage<16, 16, 4>(v); bstage<16, 16, 2>(v); bstage<16, 16, 1>(v);
}
__device__ __forceinline__ void sort8_desc(int (&v)[8]) {
    bstage<8, 2, 1>(v); bstage<8, 4, 2>(v); bstage<8, 4, 1>(v); bstage<8, 8, 4>(v); bstage<8, 8, 2>(v); bstage<8, 8, 1>(v);
}
__device__ __forceinline__ void bitonic_merge16_desc(int (&v)[16]) {
    bstage<16, 16, 8>(v); bstage<16, 16, 4>(v); bstage<16, 16, 2>(v); bstage<16, 16, 1>(v);
}
__device__ __forceinline__ void xmerge16(int (&v)[16], int off) {
    int m[16];
#pragma unroll
    for (int i = 0; i < 16; ++i) m[i] = max(v[i], __shfl_xor(v[15 - i], off));
    bitonic_merge16_desc(m);
#pragma unroll
    for (int i = 0; i < 16; ++i) v[i] = m[i];
}
__device__ __forceinline__ void opaque16(int (&v)[16]) {
#pragma unroll
    for (int i = 0; i < 16; ++i) asm volatile("" : "+v"(v[i]));
}
__device__ __forceinline__ int lookup16(const int (&arr)[16], int a) {
    int r = arr[0];
#pragma unroll
    for (int i = 1; i < 16; ++i) r = (a == i) ? arr[i] : r;
    return r;
}
__device__ __forceinline__ void peer_route2_phase(const bf16_t* __restrict__ qbuf, const bf16_t* __restrict__ skb, int* __restrict__ eidx, float* __restrict__ egate, unsigned char* lds) {
    const int tid = tidx(), wave = tid >> 6, lane = tid & 63, fr = lane & 15, fq = lane >> 4;
    for (int chunk = blockIdx.x; chunk < NT / 128; chunk += gridDim.x) {
        const int token = chunk * 128 + wave * 16 + fr;
        int* tl = (int*)(lds + 34816) + (wave * 16 + fr) * 48;
        for (int h = 0; h < 8; ++h) {
            int K1[16], K2[16];
#pragma unroll
            for (int c = 0; c < 2; ++c) {
                __syncthreads();
#pragma unroll
                for (int i = 0; i < 4; ++i) {
                    const int idx = tid + 512 * i, row = idx >> 4, ch = idx & 15;
                    *(uint4*)(lds + row * 272 + ch * 16) = *(const uint4*)(skb + ((size_t)(h * 2 + c) * 128 + row) * 128 + ch * 8);
                }
                __syncthreads();
                bf16x8_t qf[4];
#pragma unroll
                for (int sI = 0; sI < 4; ++sI) qf[sI] = *(const bf16x8_t*)(qbuf + (size_t)token * 2048 + h * 256 + c * 128 + 32 * sI + 8 * fq);
                int va[16], vb[16];
#pragma unroll
                for (int n = 0; n < 8; ++n) {
                    f32x4 S = {0.f, 0.f, 0.f, 0.f};
#pragma unroll
                    for (int sI = 0; sI < 4; ++sI) {
                        const bf16x8_t kf = *(const bf16x8_t*)(lds + (16 * n + fr) * 272 + (32 * sI + 8 * fq) * 2);
                        S = __builtin_amdgcn_mfma_f32_16x16x32_bf16(kf, qf[sI], S, 0, 0, 0);
                    }
#pragma unroll
                    for (int j = 0; j < 4; ++j) {
                        const int key = (f2key(S[j]) & ~127) | (16 * n + 4 * fq + j);
                        if (n < 4) va[n * 4 + j] = key; else vb[(n - 4) * 4 + j] = key;
                    }
                }
                sort16_desc(va); sort16_desc(vb);
                int m[16];
#pragma unroll
                for (int i = 0; i < 16; ++i) m[i] = max(va[i], vb[15 - i]);
                bitonic_merge16_desc(m);
                xmerge16(m, 16); xmerge16(m, 32);
#pragma unroll
                for (int i = 0; i < 16; ++i) { if (c == 0) K1[i] = m[i]; else K2[i] = m[i]; }
                if (fq == 0) {
#pragma unroll
                    for (int i = 0; i < 4; ++i) *(int4*)(tl + c * 16 + 4 * i) = make_int4(m[4 * i], m[4 * i + 1], m[4 * i + 2], m[4 * i + 3]);
                }
            }
            wave_lds_fence();
            float vaf[4];
#pragma unroll
            for (int k = 0; k < 4; ++k) vaf[k] = key2f(tl[4 * k + fq]);
            int A[16];
#pragma unroll
            for (int b = 0; b < 16; ++b) {
                const bool valid = (fq + 1) * (b + 1) <= 16;
                const int key = (f2key(vaf[0] + key2f(K2[b])) & ~127) | (fq << 5) | b;
                A[b] = valid ? key : INT_MIN;
            }
            int Bq[8];
#pragma unroll
            for (int b = 0; b < 3; ++b) {
                const bool valid = (fq + 5) * (b + 1) <= 16;
                const int key = (f2key(vaf[1] + key2f(K2[b])) & ~127) | (fq << 5) | (16 + b);
                Bq[b] = valid ? key : INT_MIN;
            }
            Bq[3] = (f2key(vaf[2] + key2f(K2[0])) & ~127) | (fq << 5) | 19;
            Bq[4] = (f2key(vaf[3] + key2f(K2[0])) & ~127) | (fq << 5) | 20;
            Bq[5] = INT_MIN; Bq[6] = INT_MIN; Bq[7] = INT_MIN;
            sort8_desc(Bq);
#pragma unroll
            for (int i = 8; i < 16; ++i) A[i] = max(A[i], Bq[15 - i]);
            bitonic_merge16_desc(A);
            xmerge16(A, 16); xmerge16(A, 32);
            if (fq == 0) {
#pragma unroll
                for (int i = 0; i < 4; ++i) *(int4*)(tl + 32 + 4 * i) = make_int4(A[4 * i], A[4 * i + 1], A[4 * i + 2], A[4 * i + 3]);
            }
            wave_lds_fence();
            const int4 myT = *(const int4*)(tl + 32 + 4 * fq);
            const int tsel[4] = {myT.x, myT.y, myT.z, myT.w};
            const float top0 = key2f(A[0]);
            float sum = 0.f;
#pragma unroll
            for (int r = 0; r < 16; ++r) sum += __expf(key2f(A[r]) - top0);
            const float inv = 1.f / sum;
            int eo[4]; float go[4];
#pragma unroll
            for (int kk = 0; kk < 4; ++kk) {
                const int t = tsel[kk];
                const int id = t & 127, ofq = id >> 5, slot = id & 31;
                const int k = slot < 16 ? 0 : (slot < 19 ? 1 : (slot == 19 ? 2 : 3));
                const int b = slot < 16 ? slot : (slot < 19 ? slot - 16 : 0);
                const int a = ofq + 4 * k;
                const int e1 = tl[a] & 127, e2 = tl[16 + b] & 127;
                eo[kk] = e1 * 128 + e2;
                go[kk] = __expf(key2f(t) - top0) * inv;
            }
            *(int4*)(eidx + (size_t)token * 128 + h * 16 + 4 * fq) = make_int4(eo[0], eo[1], eo[2], eo[3]);
            *(float4*)(egate + (size_t)token * 128 + h * 16 + 4 * fq) = make_float4(go[0], go[1], go[2], go[3]);
            wave_lds_fence();
        }
    }
    __syncthreads();
}

typedef __bf16 bf16x2_t __attribute__((ext_vector_type(2)));
typedef float f32x2_t __attribute__((ext_vector_type(2)));
__device__ __forceinline__ float dot2bf(unsigned a, unsigned b, float acc) { return __builtin_amdgcn_fdot2_f32_bf16(__builtin_bit_cast(bf16x2_t, a), __builtin_bit_cast(bf16x2_t, b), acc, false); }
__device__ __forceinline__ float gelu_fast(float x) {
    const float u = 0.7978845608028654f * (x + 0.044715f * x * x * x);
    return x / (1.f + __expf(-2.f * u));
}
__device__ __forceinline__ void peer_expert2_phase(float* R, const int* __restrict__ eidx, const float* __restrict__ egate, const bf16_t* __restrict__ ub,
                                                   const bf16_t* __restrict__ vb, const float* __restrict__ lg, const float* __restrict__ lb, bf16_t* Hb) {
    const int wave = tidx() >> 6, lane = tidx() & 63;
    for (int token = blockIdx.x * 8 + wave; token < NT; token += gridDim.x * 8) {
        float xf[16];
        {
            const float* rp = R + (size_t)token * ND + lane * 8;
            const float4 a0 = *(const float4*)rp, a1 = *(const float4*)(rp + 4), b0 = *(const float4*)(rp + 512), b1 = *(const float4*)(rp + 516);
            xf[0] = a0.x; xf[1] = a0.y; xf[2] = a0.z; xf[3] = a0.w; xf[4] = a1.x; xf[5] = a1.y; xf[6] = a1.z; xf[7] = a1.w;
            xf[8] = b0.x; xf[9] = b0.y; xf[10] = b0.z; xf[11] = b0.w; xf[12] = b1.x; xf[13] = b1.y; xf[14] = b1.z; xf[15] = b1.w;
        }
        unsigned xp[8];
#pragma unroll
        for (int j = 0; j < 8; ++j) xp[j] = pack2(xf[2 * j], xf[2 * j + 1]);
        float acc[16];
#pragma unroll
        for (int j = 0; j < 16; ++j) acc[j] = 0.f;
        const int e_lo = eidx[(size_t)token * 128 + lane], e_hi = eidx[(size_t)token * 128 + 64 + lane];
        const float g_lo = egate[(size_t)token * 128 + lane], g_hi = egate[(size_t)token * 128 + 64 + lane];
        for (int grp = 0; grp < 16; ++grp) {
            const int esel = grp < 8 ? e_lo : e_hi;
            const float gsel = grp < 8 ? g_lo : g_hi;
            const int lbase = (grp & 7) * 8;
            uint4 u0[8], u1[8];
            int exs[8];
#pragma unroll
            for (int k = 0; k < 8; ++k) {
                exs[k] = __builtin_amdgcn_readlane(esel, lbase + k);
                const bf16_t* up = ub + (size_t)exs[k] * ND + lane * 8;
                u0[k] = *(const uint4*)up; u1[k] = *(const uint4*)(up + 512);
            }
            float d[8];
#pragma unroll
            for (int k = 0; k < 8; ++k) {
                float a = dot2bf(u0[k].x, xp[0], 0.f), b = dot2bf(u0[k].y, xp[1], 0.f);
                a = dot2bf(u0[k].z, xp[2], a); b = dot2bf(u0[k].w, xp[3], b);
                a = dot2bf(u1[k].x, xp[4], a); b = dot2bf(u1[k].y, xp[5], b);
                a = dot2bf(u1[k].z, xp[6], a); b = dot2bf(u1[k].w, xp[7], b);
                d[k] = a + b;
            }
            const bool hi5 = lane & 32, hi4 = lane & 16, hi3 = lane & 8;
            float r4[4], r2[2], r1;
#pragma unroll
            for (int k = 0; k < 4; ++k) { const float send = hi5 ? d[k] : d[k + 4], keep = hi5 ? d[k + 4] : d[k]; r4[k] = keep + __shfl_xor(send, 32); }
#pragma unroll
            for (int k = 0; k < 2; ++k) { const float send = hi4 ? r4[k] : r4[k + 2], keep = hi4 ? r4[k + 2] : r4[k]; r2[k] = keep + __shfl_xor(send, 16); }
            { const float send = hi3 ? r2[0] : r2[1], keep = hi3 ? r2[1] : r2[0]; r1 = keep + __shfl_xor(send, 8); }
            r1 += __shfl_xor(r1, 4); r1 += __shfl_xor(r1, 2); r1 += __shfl_xor(r1, 1);
            uint4 v0[8], v1[8];
#pragma unroll
            for (int k = 0; k < 8; ++k) {
                const bf16_t* vp = vb + (size_t)exs[k] * ND + lane * 8;
                v0[k] = *(const uint4*)vp; v1[k] = *(const uint4*)(vp + 512);
            }
            const float gk = __shfl(gsel, lbase + (lane >> 3));
            const float coef = gk * gelu_fast(r1);
#pragma unroll
            for (int k = 0; k < 8; ++k) {
                const float ck = __int_as_float(__builtin_amdgcn_readlane(__float_as_int(coef), 8 * k));
                const unsigned w[8] = {v0[k].x, v0[k].y, v0[k].z, v0[k].w, v1[k].x, v1[k].y, v1[k].z, v1[k].w};
#pragma unroll
                for (int j = 0; j < 8; ++j) {
                    acc[2 * j] += ck * __uint_as_float(w[j] << 16);
                    acc[2 * j + 1] += ck * __uint_as_float(w[j] & 0xffff0000u);
                }
            }
        }
        {
            const float* rp = R + (size_t)token * ND + lane * 8;
            const float4 a0 = *(const float4*)rp, a1 = *(const float4*)(rp + 4), b0 = *(const float4*)(rp + 512), b1 = *(const float4*)(rp + 516);
            xf[0] = a0.x; xf[1] = a0.y; xf[2] = a0.z; xf[3] = a0.w; xf[4] = a1.x; xf[5] = a1.y; xf[6] = a1.z; xf[7] = a1.w;
            xf[8] = b0.x; xf[9] = b0.y; xf[10] = b0.z; xf[11] = b0.w; xf[12] = b1.x; xf[13] = b1.y; xf[14] = b1.z; xf[15] = b1.w;
        }
        float s = 0.f;
#pragma unroll
        for (int j = 0; j < 16; ++j) { xf[j] = ALPHA * xf[j] + acc[j]; s += xf[j]; }
        for (int o = 32; o; o >>= 1) s += __shfl_xor(s, o);
        const float mean = s * (1.f / ND);
        float s2 = 0.f;
#pragma unroll
        for (int j = 0; j < 16; ++j) { xf[j] -= mean; s2 += xf[j] * xf[j]; }
        for (int o = 32; o; o >>= 1) s2 += __shfl_xor(s2, o);
        const float rs = rsqrtf(s2 * (1.f / ND) + LN_EPS);
#pragma unroll
        for (int hf = 0; hf < 2; ++hf) {
            const int c0 = hf * 512 + lane * 8;
            const float4 g0 = *(const float4*)(lg + c0), g1 = *(const float4*)(lg + c0 + 4), b0 = *(const float4*)(lb + c0), b1 = *(const float4*)(lb + c0 + 4);
            float o[8];
            o[0] = xf[hf * 8 + 0] * rs * g0.x + b0.x; o[1] = xf[hf * 8 + 1] * rs * g0.y + b0.y; o[2] = xf[hf * 8 + 2] * rs * g0.z + b0.z; o[3] = xf[hf * 8 + 3] * rs * g0.w + b0.w;
            o[4] = xf[hf * 8 + 4] * rs * g1.x + b1.x; o[5] = xf[hf * 8 + 5] * rs * g1.y + b1.y; o[6] = xf[hf * 8 + 6] * rs * g1.z + b1.z; o[7] = xf[hf * 8 + 7] * rs * g1.w + b1.w;
            float* op = R + (size_t)token * ND + c0;
            *(float4*)op = make_float4(o[0], o[1], o[2], o[3]); *(float4*)(op + 4) = make_float4(o[4], o[5], o[6], o[7]);
            if (Hb) st8(Hb + (size_t)token * ND + c0, o);
        }
    }
}


template <int K2, int J> __device__ __forceinline__ void bsort_round(int (&k)[2], float (&g)[2], int lane) {
    if (J == 64) {
        const bool sw = k[0] > k[1];
        const int t = k[0]; const float tg = g[0];
        k[0] = sw ? k[1] : k[0]; g[0] = sw ? g[1] : g[0]; k[1] = sw ? t : k[1]; g[1] = sw ? tg : g[1];
    } else {
#pragma unroll
        for (int r = 0; r < 2; ++r) {
            const int pk = __shfl_xor(k[r], J); const float pg = __shfl_xor(g[r], J);
            const bool asc = (((lane + 64 * r) & K2) == 0), lower = ((lane & J) == 0);
            const bool take = (lower == asc) ? (pk < k[r]) : (pk > k[r]);
            k[r] = take ? pk : k[r]; g[r] = take ? pg : g[r];
        }
    }
}
template <int K2> __device__ __forceinline__ void bsort_stage(int (&k)[2], float (&g)[2], int lane) {
    if (K2 >= 128) bsort_round<K2, 64>(k, g, lane);
    if (K2 >= 64) bsort_round<K2, 32>(k, g, lane);
    if (K2 >= 32) bsort_round<K2, 16>(k, g, lane);
    if (K2 >= 16) bsort_round<K2, 8>(k, g, lane);
    if (K2 >= 8) bsort_round<K2, 4>(k, g, lane);
    if (K2 >= 4) bsort_round<K2, 2>(k, g, lane);
    bsort_round<K2, 1>(k, g, lane);
}
__device__ __forceinline__ void sort_routing(int& e_lo, int& e_hi, float& g_lo, float& g_hi, int lane) {
    int k[2] = {e_lo, e_hi}; float g[2] = {g_lo, g_hi};
    bsort_stage<2>(k, g, lane); bsort_stage<4>(k, g, lane); bsort_stage<8>(k, g, lane); bsort_stage<16>(k, g, lane);
    bsort_stage<32>(k, g, lane); bsort_stage<64>(k, g, lane); bsort_stage<128>(k, g, lane);
    e_lo = k[0]; e_hi = k[1]; g_lo = g[0]; g_hi = g[1];
}
__device__ __forceinline__ void peer_expert3_phase(float* R, const int* __restrict__ eidx, const float* __restrict__ egate, const unsigned char* __restrict__ ub,
                                                   const unsigned char* __restrict__ vb, const float* __restrict__ lg, const float* __restrict__ lb, bf16_t* Hb, float* Rout, const XcdBarrier& xb) {
    const int wave = tidx() >> 6, lane = tidx() & 63;
    int itk = 0;
    for (int token = blockIdx.x * 8 + wave; token < NT; token += gridDim.x * 8, ++itk) {
        if ((itk & 1) == 0 && itk) xcd_barrier(xb);
        float xf[16];
        {
            const float* rp = R + (size_t)token * ND + lane * 16;
#pragma unroll
            for (int q = 0; q < 4; ++q) { const float4 a = *(const float4*)(rp + 4 * q); xf[4 * q] = a.x; xf[4 * q + 1] = a.y; xf[4 * q + 2] = a.z; xf[4 * q + 3] = a.w; }
        }
        float acc[16];
#pragma unroll
        for (int j = 0; j < 16; ++j) acc[j] = 0.f;
        int e_lo = eidx[(size_t)token * 128 + lane], e_hi = eidx[(size_t)token * 128 + 64 + lane];
        float g_lo = egate[(size_t)token * 128 + lane], g_hi = egate[(size_t)token * 128 + 64 + lane];
        sort_routing(e_lo, e_hi, g_lo, g_hi, lane);
        for (int grp = 0; grp < 16; ++grp) {
            const int esel = grp < 8 ? e_lo : e_hi;
            const float gsel = grp < 8 ? g_lo : g_hi;
            const int lbase = (grp & 7) * 8;
            uint4 u[8], v[8];
#pragma unroll
            for (int k = 0; k < 8; ++k) {
                const int ex = __builtin_amdgcn_readlane(esel, lbase + k);
                u[k] = *(const uint4*)(ub + (size_t)ex * ND + lane * 16);
                v[k] = *(const uint4*)(vb + (size_t)ex * ND + lane * 16);
            }
            float d[8];
#pragma unroll
            for (int k = 0; k < 8; ++k) {
                const unsigned w[4] = {u[k].x, u[k].y, u[k].z, u[k].w};
                float a = 0.f, b = 0.f;
#pragma unroll
                for (int q = 0; q < 4; ++q) {
                    const f32x2_t lo = __builtin_amdgcn_cvt_pk_f32_fp8((int)w[q], false), hi = __builtin_amdgcn_cvt_pk_f32_fp8((int)w[q], true);
                    a = fmaf(xf[4 * q], lo.x, a); b = fmaf(xf[4 * q + 1], lo.y, b); a = fmaf(xf[4 * q + 2], hi.x, a); b = fmaf(xf[4 * q + 3], hi.y, b);
                }
                d[k] = a + b;
            }
            const bool hi5 = lane & 32, hi4 = lane & 16, hi3 = lane & 8;
            float r4[4], r2[2], r1;
#pragma unroll
            for (int k = 0; k < 4; ++k) { const float send = hi5 ? d[k] : d[k + 4], keep = hi5 ? d[k + 4] : d[k]; r4[k] = keep + __shfl_xor(send, 32); }
#pragma unroll
            for (int k = 0; k < 2; ++k) { const float send = hi4 ? r4[k] : r4[k + 2], keep = hi4 ? r4[k + 2] : r4[k]; r2[k] = keep + __shfl_xor(send, 16); }
            { const float send = hi3 ? r2[0] : r2[1], keep = hi3 ? r2[1] : r2[0]; r1 = keep + __shfl_xor(send, 8); }
            r1 += __shfl_xor(r1, 4); r1 += __shfl_xor(r1, 2); r1 += __shfl_xor(r1, 1);
            const float gk = __shfl(gsel, lbase + (lane >> 3));
            const float coef = gk * gelu_fast(r1 * (1.f / U_SCALE)) * (1.f / V_SCALE);
#pragma unroll
            for (int k = 0; k < 8; ++k) {
                const float ck = __int_as_float(__builtin_amdgcn_readlane(__float_as_int(coef), 8 * k));
                const unsigned w[4] = {v[k].x, v[k].y, v[k].z, v[k].w};
#pragma unroll
                for (int q = 0; q < 4; ++q) {
                    const f32x2_t lo = __builtin_amdgcn_cvt_pk_f32_fp8((int)w[q], false), hi = __builtin_amdgcn_cvt_pk_f32_fp8((int)w[q], true);
                    acc[4 * q] = fmaf(ck, lo.x, acc[4 * q]); acc[4 * q + 1] = fmaf(ck, lo.y, acc[4 * q + 1]);
                    acc[4 * q + 2] = fmaf(ck, hi.x, acc[4 * q + 2]); acc[4 * q + 3] = fmaf(ck, hi.y, acc[4 * q + 3]);
                }
            }
        }
        float s = 0.f;
#pragma unroll
        for (int j = 0; j < 16; ++j) { xf[j] = ALPHA * xf[j] + acc[j]; s += xf[j]; }
        for (int o = 32; o; o >>= 1) s += __shfl_xor(s, o);
        const float mean = s * (1.f / ND);
        float s2 = 0.f;
#pragma unroll
        for (int j = 0; j < 16; ++j) { xf[j] -= mean; s2 += xf[j] * xf[j]; }
        for (int o = 32; o; o >>= 1) s2 += __shfl_xor(s2, o);
        const float rs = rsqrtf(s2 * (1.f / ND) + LN_EPS);
        float o[16];
#pragma unroll
        for (int q = 0; q < 4; ++q) {
            const float4 gg = *(const float4*)(lg + lane * 16 + 4 * q), bb = *(const float4*)(lb + lane * 16 + 4 * q);
            o[4 * q] = xf[4 * q] * rs * gg.x + bb.x; o[4 * q + 1] = xf[4 * q + 1] * rs * gg.y + bb.y; o[4 * q + 2] = xf[4 * q + 2] * rs * gg.z + bb.z; o[4 * q + 3] = xf[4 * q + 3] * rs * gg.w + bb.w;
            *(float4*)(Rout + (size_t)token * ND + lane * 16 + 4 * q) = make_float4(o[4 * q], o[4 * q + 1], o[4 * q + 2], o[4 * q + 3]);
        }
        if (Hb) { st8(Hb + (size_t)token * ND + lane * 16, o); st8(Hb + (size_t)token * ND + lane * 16 + 8, o + 8); }
    }
}


struct Rows8 { uint4 r[8]; };
__device__ __forceinline__ void rows_load(Rows8& G, int esel, int lbase, const unsigned char* __restrict__ tb, int lane) {
#pragma unroll
    for (int k = 0; k < 8; ++k) {
        const int ex = __builtin_amdgcn_readlane(esel, lbase + k);
        G.r[k] = *(const uint4*)(tb + (size_t)ex * ND + lane * 16);
    }
}
__device__ __forceinline__ void sweep_u(const Rows8& G, const float (&xf)[16], float gsel, int lbase, int lane, float* cl  , int grp) {
    float d[8];
#pragma unroll
    for (int k = 0; k < 8; ++k) {
        const unsigned w[4] = {G.r[k].x, G.r[k].y, G.r[k].z, G.r[k].w};
        f32x2_t a2 = {0.f, 0.f}, b2 = {0.f, 0.f};
#pragma unroll
        for (int q = 0; q < 4; ++q) {
            const f32x2_t lo = __builtin_amdgcn_cvt_pk_f32_fp8((int)w[q], false), hi = __builtin_amdgcn_cvt_pk_f32_fp8((int)w[q], true);
            a2 = __builtin_elementwise_fma((f32x2_t){xf[4 * q], xf[4 * q + 1]}, lo, a2);
            b2 = __builtin_elementwise_fma((f32x2_t){xf[4 * q + 2], xf[4 * q + 3]}, hi, b2);
        }
        d[k] = (a2.x + a2.y) + (b2.x + b2.y);
    }
    const bool hi5 = lane & 32, hi4 = lane & 16, hi3 = lane & 8;
    float r4[4], r2[2], r1;
#pragma unroll
    for (int k = 0; k < 4; ++k) { const float send = hi5 ? d[k] : d[k + 4], keep = hi5 ? d[k + 4] : d[k]; r4[k] = keep + __shfl_xor(send, 32); }
#pragma unroll
    for (int k = 0; k < 2; ++k) { const float send = hi4 ? r4[k] : r4[k + 2], keep = hi4 ? r4[k + 2] : r4[k]; r2[k] = keep + __shfl_xor(send, 16); }
    { const float send = hi3 ? r2[0] : r2[1], keep = hi3 ? r2[1] : r2[0]; r1 = keep + __shfl_xor(send, 8); }
    r1 += __shfl_xor(r1, 4); r1 += __shfl_xor(r1, 2); r1 += __shfl_xor(r1, 1);
    const float gk = __shfl(gsel, lbase + (lane >> 3));
    const float coef = gk * gelu_fast(r1 * (1.f / U_SCALE)) * (1.f / V_SCALE);
    if ((lane & 7) == 0) cl[grp * 8 + (lane >> 3)] = coef;
}
__device__ __forceinline__ void sweep_v(const Rows8& G, float (&acc)[16], const float* cl, int grp) {
#pragma unroll
    for (int k = 0; k < 8; ++k) {
        const float ck = cl[grp * 8 + k];
        const unsigned w[4] = {G.r[k].x, G.r[k].y, G.r[k].z, G.r[k].w};
        const f32x2_t ck2 = {ck, ck};
#pragma unroll
        for (int q = 0; q < 4; ++q) {
            const f32x2_t lo = __builtin_amdgcn_cvt_pk_f32_fp8((int)w[q], false), hi = __builtin_amdgcn_cvt_pk_f32_fp8((int)w[q], true);
            f32x2_t* ap = (f32x2_t*)&acc[4 * q];
            ap[0] = __builtin_elementwise_fma(ck2, lo, ap[0]);
            ap[1] = __builtin_elementwise_fma(ck2, hi, ap[1]);
        }
    }
}
__device__ __forceinline__ void peer_expert6_phase(float* R, const int* __restrict__ eidx, const float* __restrict__ egate, const unsigned char* __restrict__ ub,
                                                   const unsigned char* __restrict__ vb, const float* __restrict__ lg, const float* __restrict__ lb, bf16_t* Hb, const XcdBarrier& xb, float* lds,
                                                   const float* __restrict__ l1g, const float* __restrict__ l1b) {
    const int wave = __builtin_amdgcn_readfirstlane(tidx() >> 6), lane = tidx() & 63;
    float* cl = lds + wave * 128;
    int itk = 0;
    for (int token = blockIdx.x * 8 + wave; token < NT; token += gridDim.x * 8, ++itk) {
        if (itk) xcc_align(xb);
        float xf[16];
        {
            const float* rp = R + (size_t)token * ND + lane * 16;
#pragma unroll
            for (int q = 0; q < 4; ++q) { const float4 a = *(const float4*)(rp + 4 * q); xf[4 * q] = a.x; xf[4 * q + 1] = a.y; xf[4 * q + 2] = a.z; xf[4 * q + 3] = a.w; }
        }
        {
            float s = 0.f;
#pragma unroll
            for (int j = 0; j < 16; ++j) s += xf[j];
            for (int o = 32; o; o >>= 1) s += __shfl_xor(s, o);
            const float mean = s * (1.f / ND);
            float s2 = 0.f;
#pragma unroll
            for (int j = 0; j < 16; ++j) { xf[j] -= mean; s2 += xf[j] * xf[j]; }
            for (int o = 32; o; o >>= 1) s2 += __shfl_xor(s2, o);
            const float rs = rsqrtf(s2 * (1.f / ND) + LN_EPS);
            int lofs1 = lane * 16;
            asm volatile("" : "+v"(lofs1));
#pragma unroll
            for (int q = 0; q < 4; ++q) {
                const float4 gg = *(const float4*)(l1g + lofs1 + 4 * q), bb = *(const float4*)(l1b + lofs1 + 4 * q);
                xf[4 * q] = xf[4 * q] * rs * gg.x + bb.x; xf[4 * q + 1] = xf[4 * q + 1] * rs * gg.y + bb.y; xf[4 * q + 2] = xf[4 * q + 2] * rs * gg.z + bb.z; xf[4 * q + 3] = xf[4 * q + 3] * rs * gg.w + bb.w;
            }
        }
        int e_lo = eidx[(size_t)token * 128 + lane], e_hi = eidx[(size_t)token * 128 + 64 + lane];
        float g_lo = egate[(size_t)token * 128 + lane], g_hi = egate[(size_t)token * 128 + 64 + lane];
        sort_routing(e_lo, e_hi, g_lo, g_hi, lane);
        Rows8 GA, GB;
        wave_lds_fence();
        rows_load(GA, e_lo, 0, ub, lane);
#pragma unroll 1
        for (int gp = 0; gp < 8; ++gp) {
            const int g0i = 2 * gp, g1i = 2 * gp + 1;
            rows_load(GB, g1i < 8 ? e_lo : e_hi, (g1i & 7) * 8, ub, lane);
            __builtin_amdgcn_sched_barrier(0);
            sweep_u(GA, xf, g0i < 8 ? g_lo : g_hi, (g0i & 7) * 8, lane, cl, g0i);
            __builtin_amdgcn_sched_barrier(0);
            rows_load(GA, gp < 7 ? ((g0i + 2) < 8 ? e_lo : e_hi) : e_lo, gp < 7 ? ((g0i + 2) & 7) * 8 : 0, gp < 7 ? ub : vb, lane);
            __builtin_amdgcn_sched_barrier(0);
            sweep_u(GB, xf, g1i < 8 ? g_lo : g_hi, (g1i & 7) * 8, lane, cl, g1i);
            __builtin_amdgcn_sched_barrier(0);
        }
        wave_lds_fence();
        xcc_align(xb);
        float acc[16];
#pragma unroll
        for (int j = 0; j < 16; ++j) acc[j] = 0.f;
#pragma unroll 1
        for (int gp = 0; gp < 8; ++gp) {
            const int g0i = 2 * gp, g1i = 2 * gp + 1;
            rows_load(GB, g1i < 8 ? e_lo : e_hi, (g1i & 7) * 8, vb, lane);
            __builtin_amdgcn_sched_barrier(0);
            sweep_v(GA, acc, cl, g0i);
            __builtin_amdgcn_sched_barrier(0);
            if (gp < 7) rows_load(GA, (g0i + 2) < 8 ? e_lo : e_hi, ((g0i + 2) & 7) * 8, vb, lane);
            __builtin_amdgcn_sched_barrier(0);
            sweep_v(GB, acc, cl, g1i);
            __builtin_amdgcn_sched_barrier(0);
        }
        float s = 0.f;
#pragma unroll
        for (int j = 0; j < 16; ++j) { xf[j] = ALPHA * xf[j] + acc[j]; s += xf[j]; }
        for (int o = 32; o; o >>= 1) s += __shfl_xor(s, o);
        const float mean = s * (1.f / ND);
        float s2 = 0.f;
#pragma unroll
        for (int j = 0; j < 16; ++j) { xf[j] -= mean; s2 += xf[j] * xf[j]; }
        for (int o = 32; o; o >>= 1) s2 += __shfl_xor(s2, o);
        const float rs = rsqrtf(s2 * (1.f / ND) + LN_EPS);
        float o[16];
        int lofs = lane * 16;
        asm volatile("" : "+v"(lofs));
#pragma unroll
        for (int q = 0; q < 4; ++q) {
            const float4 gg = *(const float4*)(lg + lofs + 4 * q), bb = *(const float4*)(lb + lofs + 4 * q);
            o[4 * q] = xf[4 * q] * rs * gg.x + bb.x; o[4 * q + 1] = xf[4 * q + 1] * rs * gg.y + bb.y; o[4 * q + 2] = xf[4 * q + 2] * rs * gg.z + bb.z; o[4 * q + 3] = xf[4 * q + 3] * rs * gg.w + bb.w;
            *(float4*)(R + (size_t)token * ND + lofs + 4 * q) = make_float4(o[4 * q], o[4 * q + 1], o[4 * q + 2], o[4 * q + 3]);
        }
        if (Hb) { st8(Hb + (size_t)token * ND + lofs, o); st8(Hb + (size_t)token * ND + lofs + 8, o + 8); }
    }
}


__device__ __forceinline__ void load_h_row(const float* __restrict__ R, int token, int lane, const float* __restrict__ l1g, const float* __restrict__ l1b, float (&xf)[16]) {
    const float* rp = R + (size_t)token * ND + lane * 16;
#pragma unroll
    for (int q = 0; q < 4; ++q) { const float4 a = *(const float4*)(rp + 4 * q); xf[4 * q] = a.x; xf[4 * q + 1] = a.y; xf[4 * q + 2] = a.z; xf[4 * q + 3] = a.w; }
    float s = 0.f;
#pragma unroll
    for (int j = 0; j < 16; ++j) s += xf[j];
    for (int o = 32; o; o >>= 1) s += __shfl_xor(s, o);
    const float mean = s * (1.f / ND);
    float s2 = 0.f;
#pragma unroll
    for (int j = 0; j < 16; ++j) { xf[j] -= mean; s2 += xf[j] * xf[j]; }
    for (int o = 32; o; o >>= 1) s2 += __shfl_xor(s2, o);
    const float rs = rsqrtf(s2 * (1.f / ND) + LN_EPS);
    int lofs1 = lane * 16;
    asm volatile("" : "+v"(lofs1));
#pragma unroll
    for (int q = 0; q < 4; ++q) {
        const float4 gg = *(const float4*)(l1g + lofs1 + 4 * q), bb = *(const float4*)(l1b + lofs1 + 4 * q);
        xf[4 * q] = xf[4 * q] * rs * gg.x + bb.x; xf[4 * q + 1] = xf[4 * q + 1] * rs * gg.y + bb.y; xf[4 * q + 2] = xf[4 * q + 2] * rs * gg.z + bb.z; xf[4 * q + 3] = xf[4 * q + 3] * rs * gg.w + bb.w;
    }
}
__device__ __forceinline__ void finish_row(float* R, bf16_t* Hb, int token, int lane, float (&xf)[16], const float (&acc)[16], const float* __restrict__ lg, const float* __restrict__ lb) {
    float s = 0.f;
#pragma unroll
    for (int j = 0; j < 16; ++j) { xf[j] = ALPHA * xf[j] + acc[j]; s += xf[j]; }
    for (int o = 32; o; o >>= 1) s += __shfl_xor(s, o);
    const float mean = s * (1.f / ND);
    float s2 = 0.f;
#pragma unroll
    for (int j = 0; j < 16; ++j) { xf[j] -= mean; s2 += xf[j] * xf[j]; }
    for (int o = 32; o; o >>= 1) s2 += __shfl_xor(s2, o);
    const float rs = rsqrtf(s2 * (1.f / ND) + LN_EPS);
    float o[16];
    int lofs = lane * 16;
    asm volatile("" : "+v"(lofs));
#pragma unroll
    for (int q = 0; q < 4; ++q) {
        const float4 gg = *(const float4*)(lg + lofs + 4 * q), bb = *(const float4*)(lb + lofs + 4 * q);
        o[4 * q] = xf[4 * q] * rs * gg.x + bb.x; o[4 * q + 1] = xf[4 * q + 1] * rs * gg.y + bb.y; o[4 * q + 2] = xf[4 * q + 2] * rs * gg.z + bb.z; o[4 * q + 3] = xf[4 * q + 3] * rs * gg.w + bb.w;
        *(float4*)(R + (size_t)token * ND + lofs + 4 * q) = make_float4(o[4 * q], o[4 * q + 1], o[4 * q + 2], o[4 * q + 3]);
    }
    if (Hb) { st8(Hb + (size_t)token * ND + lofs, o); st8(Hb + (size_t)token * ND + lofs + 8, o + 8); }
}
__device__ __forceinline__ void peer_expert9_phase(float* R, const int* __restrict__ eidx, const float* __restrict__ egate, const unsigned char* __restrict__ ub,
                                                   const unsigned char* __restrict__ vb, const float* __restrict__ lg, const float* __restrict__ lb, bf16_t* Hb, const XcdBarrier& xb, float* lds,
                                                   const float* __restrict__ l1g, const float* __restrict__ l1b) {
    const int wave = __builtin_amdgcn_readfirstlane(tidx() >> 6), lane = tidx() & 63;
    float* clA = lds + wave * 256;
    float* clB = clA + 128;
    const int stride = gridDim.x * 8;
    int itk = 0;
    for (int tokA = blockIdx.x * 8 + wave; tokA < NT; tokA += 2 * stride, ++itk) {
        const int tokB = tokA + stride;
        if (itk) xcc_align(xb);
        float xA[16], xB[16];
        load_h_row(R, tokA, lane, l1g, l1b, xA);
        load_h_row(R, tokB, lane, l1g, l1b, xB);
        int ea_lo = eidx[(size_t)tokA * 128 + lane], ea_hi = eidx[(size_t)tokA * 128 + 64 + lane];
        float ga_lo = egate[(size_t)tokA * 128 + lane], ga_hi = egate[(size_t)tokA * 128 + 64 + lane];
        sort_routing(ea_lo, ea_hi, ga_lo, ga_hi, lane);
        int eb_lo = eidx[(size_t)tokB * 128 + lane], eb_hi = eidx[(size_t)tokB * 128 + 64 + lane];
        float gb_lo = egate[(size_t)tokB * 128 + lane], gb_hi = egate[(size_t)tokB * 128 + 64 + lane];
        sort_routing(eb_lo, eb_hi, gb_lo, gb_hi, lane);
        Rows8 GA, GB;
        wave_lds_fence();
        rows_load(GA, ea_lo, 0, ub, lane);
#pragma unroll 1
        for (int g = 0; g < 16; ++g) {
            const int lb8 = (g & 7) * 8;
            rows_load(GB, g < 8 ? eb_lo : eb_hi, lb8, ub, lane);
            __builtin_amdgcn_sched_barrier(0);
            sweep_u(GA, xA, g < 8 ? ga_lo : ga_hi, lb8, lane, clA, g);
            __builtin_amdgcn_sched_barrier(0);
            if (g < 15) rows_load(GA, (g + 1) < 8 ? ea_lo : ea_hi, ((g + 1) & 7) * 8, ub, lane);
            else rows_load(GA, ea_lo, 0, vb, lane);
            __builtin_amdgcn_sched_barrier(0);
            sweep_u(GB, xB, g < 8 ? gb_lo : gb_hi, lb8, lane, clB, g);
            __builtin_amdgcn_sched_barrier(0);
        }
        wave_lds_fence();
        xcc_align(xb);
        float aA[16], aB[16];
#pragma unroll
        for (int j = 0; j < 16; ++j) { aA[j] = 0.f; aB[j] = 0.f; }
#pragma unroll 1
        for (int g = 0; g < 16; ++g) {
            const int lb8 = (g & 7) * 8;
            rows_load(GB, g < 8 ? eb_lo : eb_hi, lb8, vb, lane);
            __builtin_amdgcn_sched_barrier(0);
            sweep_v(GA, aA, clA, g);
            __builtin_amdgcn_sched_barrier(0);
            if (g < 15) rows_load(GA, (g + 1) < 8 ? ea_lo : ea_hi, ((g + 1) & 7) * 8, vb, lane);
            __builtin_amdgcn_sched_barrier(0);
            sweep_v(GB, aB, clB, g);
            __builtin_amdgcn_sched_barrier(0);
        }
        load_h_row(R, tokA, lane, l1g, l1b, xA);
        finish_row(R, Hb, tokA, lane, xA, aA, lg, lb);
        __builtin_amdgcn_sched_barrier(0);
        load_h_row(R, tokB, lane, l1g, l1b, xB);
        finish_row(R, Hb, tokB, lane, xB, aB, lg, lb);
    }
}


__device__ __forceinline__ void peer_expert10_phase(float* R, const int* __restrict__ eidx, const float* __restrict__ egate, const unsigned char* __restrict__ ub,
                                                    const unsigned char* __restrict__ vb, const float* __restrict__ lg, const float* __restrict__ lb, bf16_t* Hb, const XcdBarrier& xb, float* lds,
                                                    const float* __restrict__ l1g, const float* __restrict__ l1b) {
    const int wave = __builtin_amdgcn_readfirstlane(tidx() >> 6), lane = tidx() & 63;
    float* cl = lds + wave * 512;
    float* xs = lds + 4096 + wave * 4096;
    const int stride = gridDim.x * 8;
    int itk = 0;
    for (int tok0 = blockIdx.x * 8 + wave; tok0 < NT; tok0 += 4 * stride, ++itk) {
        if (itk) xcc_align(xb);
        int elo[4], ehi[4]; float glo[4], ghi[4];
        wave_lds_fence();
#pragma unroll
        for (int t = 0; t < 4; ++t) {
            const int tok = tok0 + t * stride;
            { float xr[16]; load_h_row(R, tok, lane, l1g, l1b, xr);
#pragma unroll
              for (int q = 0; q < 4; ++q) *(float4*)(xs + t * 1024 + q * 256 + lane * 4) = make_float4(xr[4 * q], xr[4 * q + 1], xr[4 * q + 2], xr[4 * q + 3]); }
            elo[t] = eidx[(size_t)tok * 128 + lane]; ehi[t] = eidx[(size_t)tok * 128 + 64 + lane];
            glo[t] = egate[(size_t)tok * 128 + lane]; ghi[t] = egate[(size_t)tok * 128 + 64 + lane];
            sort_routing(elo[t], ehi[t], glo[t], ghi[t], lane);
        }
        Rows8 GA, GB;
        wave_lds_fence();
        rows_load(GA, elo[0], 0, ub, lane);
#pragma unroll 1
        for (int g = 0; g < 16; ++g) {
            const int lb8 = (g & 7) * 8; const bool lo = g < 8;
            rows_load(GB, lo ? elo[1] : ehi[1], lb8, ub, lane);
            __builtin_amdgcn_sched_barrier(0);
            { float xf[16];
#pragma unroll
              for (int q = 0; q < 4; ++q) { const float4 v4 = *(const float4*)(xs + 0 * 1024 + q * 256 + lane * 4); xf[4 * q] = v4.x; xf[4 * q + 1] = v4.y; xf[4 * q + 2] = v4.z; xf[4 * q + 3] = v4.w; }
              sweep_u(GA, xf, lo ? glo[0] : ghi[0], lb8, lane, cl, g); }
            __builtin_amdgcn_sched_barrier(0);
            rows_load(GA, lo ? elo[2] : ehi[2], lb8, ub, lane);
            __builtin_amdgcn_sched_barrier(0);
            { float xf[16];
#pragma unroll
              for (int q = 0; q < 4; ++q) { const float4 v4 = *(const float4*)(xs + 1 * 1024 + q * 256 + lane * 4); xf[4 * q] = v4.x; xf[4 * q + 1] = v4.y; xf[4 * q + 2] = v4.z; xf[4 * q + 3] = v4.w; }
              sweep_u(GB, xf, lo ? glo[1] : ghi[1], lb8, lane, cl + 128, g); }
            __builtin_amdgcn_sched_barrier(0);
            rows_load(GB, lo ? elo[3] : ehi[3], lb8, ub, lane);
            __builtin_amdgcn_sched_barrier(0);
            { float xf[16];
#pragma unroll
              for (int q = 0; q < 4; ++q) { const float4 v4 = *(const float4*)(xs + 2 * 1024 + q * 256 + lane * 4); xf[4 * q] = v4.x; xf[4 * q + 1] = v4.y; xf[4 * q + 2] = v4.z; xf[4 * q + 3] = v4.w; }
              sweep_u(GA, xf, lo ? glo[2] : ghi[2], lb8, lane, cl + 256, g); }
            __builtin_amdgcn_sched_barrier(0);
            if (g < 15) rows_load(GA, (g + 1) < 8 ? elo[0] : ehi[0], ((g + 1) & 7) * 8, ub, lane);
            else rows_load(GA, elo[0], 0, vb, lane);
            __builtin_amdgcn_sched_barrier(0);
            { float xf[16];
#pragma unroll
              for (int q = 0; q < 4; ++q) { const float4 v4 = *(const float4*)(xs + 3 * 1024 + q * 256 + lane * 4); xf[4 * q] = v4.x; xf[4 * q + 1] = v4.y; xf[4 * q + 2] = v4.z; xf[4 * q + 3] = v4.w; }
              sweep_u(GB, xf, lo ? glo[3] : ghi[3], lb8, lane, cl + 384, g); }
            __builtin_amdgcn_sched_barrier(0);
        }
        wave_lds_fence();
        xcc_align(xb);
#pragma unroll
        for (int t = 0; t < 4; ++t)
#pragma unroll
            for (int q = 0; q < 4; ++q) *(float4*)(xs + t * 1024 + q * 256 + lane * 4) = make_float4(0.f, 0.f, 0.f, 0.f);
#pragma unroll 1
        for (int g = 0; g < 16; ++g) {
            const int lb8 = (g & 7) * 8; const bool lo = g < 8;
            rows_load(GB, lo ? elo[1] : ehi[1], lb8, vb, lane);
            __builtin_amdgcn_sched_barrier(0);
            { float av[16];
#pragma unroll
              for (int q = 0; q < 4; ++q) { const float4 v4 = *(const float4*)(xs + 0 * 1024 + q * 256 + lane * 4); av[4 * q] = v4.x; av[4 * q + 1] = v4.y; av[4 * q + 2] = v4.z; av[4 * q + 3] = v4.w; }
              sweep_v(GA, av, cl, g);
#pragma unroll
              for (int q = 0; q < 4; ++q) *(float4*)(xs + 0 * 1024 + q * 256 + lane * 4) = make_float4(av[4 * q], av[4 * q + 1], av[4 * q + 2], av[4 * q + 3]); }
            __builtin_amdgcn_sched_barrier(0);
            rows_load(GA, lo ? elo[2] : ehi[2], lb8, vb, lane);
            __builtin_amdgcn_sched_barrier(0);
            { float av[16];
#pragma unroll
              for (int q = 0; q < 4; ++q) { const float4 v4 = *(const float4*)(xs + 1 * 1024 + q * 256 + lane * 4); av[4 * q] = v4.x; av[4 * q + 1] = v4.y; av[4 * q + 2] = v4.z; av[4 * q + 3] = v4.w; }
              sweep_v(GB, av, cl + 128, g);
#pragma unroll
              for (int q = 0; q < 4; ++q) *(float4*)(xs + 1 * 1024 + q * 256 + lane * 4) = make_float4(av[4 * q], av[4 * q + 1], av[4 * q + 2], av[4 * q + 3]); }
            __builtin_amdgcn_sched_barrier(0);
            rows_load(GB, lo ? elo[3] : ehi[3], lb8, vb, lane);
            __builtin_amdgcn_sched_barrier(0);
            { float av[16];
#pragma unroll
              for (int q = 0; q < 4; ++q) { const float4 v4 = *(const float4*)(xs + 2 * 1024 + q * 256 + lane * 4); av[4 * q] = v4.x; av[4 * q + 1] = v4.y; av[4 * q + 2] = v4.z; av[4 * q + 3] = v4.w; }
              sweep_v(GA, av, cl + 256, g);
#pragma unroll
              for (int q = 0; q < 4; ++q) *(float4*)(xs + 2 * 1024 + q * 256 + lane * 4) = make_float4(av[4 * q], av[4 * q + 1], av[4 * q + 2], av[4 * q + 3]); }
            __builtin_amdgcn_sched_barrier(0);
            if (g < 15) rows_load(GA, (g + 1) < 8 ? elo[0] : ehi[0], ((g + 1) & 7) * 8, vb, lane);
            __builtin_amdgcn_sched_barrier(0);
            { float av[16];
#pragma unroll
              for (int q = 0; q < 4; ++q) { const float4 v4 = *(const float4*)(xs + 3 * 1024 + q * 256 + lane * 4); av[4 * q] = v4.x; av[4 * q + 1] = v4.y; av[4 * q + 2] = v4.z; av[4 * q + 3] = v4.w; }
              sweep_v(GB, av, cl + 384, g);
#pragma unroll
              for (int q = 0; q < 4; ++q) *(float4*)(xs + 3 * 1024 + q * 256 + lane * 4) = make_float4(av[4 * q], av[4 * q + 1], av[4 * q + 2], av[4 * q + 3]); }
            __builtin_amdgcn_sched_barrier(0);
        }
#pragma unroll
        for (int t = 0; t < 4; ++t) {
            const int tok = tok0 + t * stride;
            float xr[16], av[16];
#pragma unroll
            for (int q = 0; q < 4; ++q) { const float4 v4 = *(const float4*)(xs + t * 1024 + q * 256 + lane * 4); av[4 * q] = v4.x; av[4 * q + 1] = v4.y; av[4 * q + 2] = v4.z; av[4 * q + 3] = v4.w; }
            load_h_row(R, tok, lane, l1g, l1b, xr);
            finish_row(R, Hb, tok, lane, xr, av, lg, lb);
            __builtin_amdgcn_sched_barrier(0);
        }
    }
}

__device__ __forceinline__ void nsa_compress_phase(const bf16_t* __restrict__ proj, int coloff, const float* __restrict__ pe, const float* __restrict__ w1,
                                   const float* __restrict__ w2, float* __restrict__ outc, float* lds) {
    const int qtr = tidx() >> 7, tid = tidx() & 127;
    float* in = lds + qtr * 2176;
    float* hid = in + 2048;
    for (int it = blockIdx.x; it < NB * 127; it += gridDim.x) {
        const int g = qtr, n = it % 127, b = it / 127;
        __syncthreads();
        for (int idx = tid; idx < 2048; idx += 128) {
            const int l = idx >> 6, d = idx & 63;
            in[idx] = bf2f(proj[(size_t)(b * NL + 16 * n + l) * ODD_PAD + coloff + g * 64 + d]) + pe[l * 64 + d];
        }
        __syncthreads();
        float a = 0.f;
        for (int i = 0; i < 2048; ++i) a += in[i] * w1[(size_t)i * 128 + tid];
        hid[tid] = gelu_tanh(a);
        __syncthreads();
        if (tid < 64) {
            float o = 0.f;
            for (int j = 0; j < 128; ++j) o += hid[j] * w2[j * 64 + tid];
            outc[((size_t)(b * 127 + n) * 4 + g) * 64 + tid] = o;
        }
    }
    __syncthreads();
}

__device__ __forceinline__ void nsa_cmp_phase(const bf16_t* __restrict__ proj, const float* __restrict__ kcmp, const float* __restrict__ vcmp,
                              bf16_t* __restrict__ O, unsigned* __restrict__ selmask, float* lds) {
    const int half = tidx() >> 8, tid = tidx() & 255;
    float* kc_s = lds + half * 18368;
    float* vc_s = kc_s + 127 * 64;
    float(*imp_s)[33] = (float(*)[33])(vc_s + 127 * 64);
    const int tk = tid >> 2, r = tid & 3;
    for (int it = blockIdx.x; it < 32 * 4 * NB / 2; it += gridDim.x) {
        const int vb = it * 2 + half;
        const int tile = vb & 31, g = (vb >> 5) & 3, b = vb >> 7;
        const int t = tile * 64 + tk, hd = g * 4 + r;
        __syncthreads();
        for (int idx = tid; idx < 127 * 64; idx += 256) { const int n = idx >> 6, d = idx & 63; kc_s[idx] = kcmp[((size_t)(b * 127 + n) * 4 + g) * 64 + d]; vc_s[idx] = vcmp[((size_t)(b * 127 + n) * 4 + g) * 64 + d]; }
        const bf16_t* prow = proj + (size_t)(b * NL + t) * ODD_PAD;
        float q[64];
#pragma unroll
        for (int d = 0; d < 64; d += 8) ld8(prow + hd * 64 + d, q + d);
        const float slope = exp2f(-0.5f * (float)(hd + 1));
        int nvalid = (t >= 31) ? ((t - 31) / 16 + 1) : 0;
        if (nvalid > 127) nvalid = 127;
        __syncthreads();
        float m = -INFINITY, l = 0.f;
        for (int n = 0; n < nvalid; ++n) {
            float s = 0.f;
#pragma unroll
            for (int d = 0; d < 64; ++d) s += q[d] * kc_s[n * 64 + d];
            s = s * 0.125f - slope * (float)(t - (16 * n + 31));
            const float mn = fmaxf(m, s);
            l = l * expf(m - mn) + expf(s - mn);
            m = mn;
        }
        const float inv_l = (nvalid > 0) ? 1.f / fmaxf(l, 1e-30f) : 0.f;
        float acc[64];
#pragma unroll
        for (int d = 0; d < 64; ++d) acc[d] = 0.f;
        float prev3 = 0.f;
        for (int j = 0; j < 32; ++j) {
            float pj[4];
#pragma unroll
            for (int nn = 0; nn < 4; ++nn) {
                const int n = 4 * j + nn;
                float p = 0.f;
                if (n < nvalid) {
                    float s = 0.f;
#pragma unroll
                    for (int d = 0; d < 64; ++d) s += q[d] * kc_s[n * 64 + d];
                    s = s * 0.125f - slope * (float)(t - (16 * n + 31));
                    p = expf(s - m) * inv_l;
                    const float* vr = vc_s + n * 64;
#pragma unroll
                    for (int d = 0; d < 64; ++d) acc[d] += p * vr[d];
                }
                pj[nn] = p;
            }
            float im = 0.5f * prev3 + pj[0] + pj[1] + pj[2] + 0.5f * pj[3];
            prev3 = pj[3];
            im += __shfl_xor(im, 1);
            im += __shfl_xor(im, 2);
            if (r == 0) imp_s[tk][j] = im;
        }
        const float g0 = sigmoidf_(bf2f(prow[2048 + hd]));
#pragma unroll
        for (int d = 0; d < 64; ++d) acc[d] *= g0;
#pragma unroll
        for (int d = 0; d < 64; d += 8) st8(O + (size_t)(b * NL + t) * ND + hd * 64 + d, acc + d);
        __syncthreads();
        const int cur = tile;
        unsigned bits = 0;
        for (int jj = 0; jj < 8; ++jj) {
            const int j = r * 8 + jj;
            const bool fj = (j == 0) || (j == cur) || (j == cur - 1);
            const float vj = (j <= cur) ? imp_s[tk][j] + (fj ? 1000.f : 0.f) : -INFINITY;
            int rank = 0;
            for (int k = 0; k < 32; ++k) {
                const bool fk = (k == 0) || (k == cur) || (k == cur - 1);
                const float vk = (k <= cur) ? imp_s[tk][k] + (fk ? 1000.f : 0.f) : -INFINITY;
                rank += (vk > vj || (vk == vj && k < j)) ? 1 : 0;
            }
            if (rank < 16) bits |= 1u << j;
        }
        bits |= __shfl_xor(bits, 1);
        bits |= __shfl_xor(bits, 2);
        if (r == 0) selmask[(size_t)(b * 4 + g) * NL + t] = bits;
    }
    __syncthreads();
}

__device__ __forceinline__ void nsa_selwin_phase(const bf16_t* __restrict__ proj, const unsigned* __restrict__ selmask, bf16_t* O, float* lds) {
    const int half = tidx() >> 8, tid = tidx() & 255;
    float(*k_s)[64] = (float(*)[64])(lds + half * 8192);
    float(*v_s)[64] = (float(*)[64])(lds + half * 8192 + 4096);
    const int tk = tid >> 2, r = tid & 3;
    for (int it = blockIdx.x; it < 32 * 32; it += gridDim.x) {
        const int tile = 31 - (it >> 5);
        const int bgi = (it & 31) * 2 + half, g = bgi & 3, b = bgi >> 2;
        const int t = tile * 64 + tk, hd = g * 4 + r;
        const bf16_t* pb = proj + (size_t)b * NL * ODD_PAD;
        const bf16_t* prow = pb + (size_t)t * ODD_PAD;
        float q[64], acc[64];
#pragma unroll
        for (int d = 0; d < 64; d += 8) ld8(prow + hd * 64 + d, q + d);
        const float slope = exp2f(-0.5f * (float)(hd + 1));
        const unsigned mask = selmask[(size_t)(b * 4 + g) * NL + t];
        bf16_t* orow = O + (size_t)(b * NL + t) * ND + hd * 64;
        for (int branch = 0; branch < 2; ++branch) {
            const int kcol = (branch == 0 ? 1536 : 2048) + g * 64, vcol = kcol + 256;
            const int j0 = (branch == 0) ? 0 : (tile >= 8 ? tile - 8 : 0);
            float m = -1e30f, l = 0.f;
#pragma unroll
            for (int d = 0; d < 64; ++d) acc[d] = 0.f;
            for (int j = j0; j <= tile; ++j) {
                __syncthreads();
                for (int i = 0; i < 16; ++i) {
                    const int idx = tid + 256 * i, key = idx >> 6, d = idx & 63;
                    k_s[key][d] = bf2f(pb[(size_t)(64 * j + key) * ODD_PAD + kcol + d]);
                    v_s[key][d] = bf2f(pb[(size_t)(64 * j + key) * ODD_PAD + vcol + d]);
                }
                __syncthreads();
                const bool take = (branch == 0) ? ((mask >> j) & 1u) : true;
                if (take) {
                    for (int s = 0; s < 64; ++s) {
                        const int dist = t - (64 * j + s);
                        const bool valid = (branch == 0) ? (dist >= 0) : (dist >= 0 && dist < 512);
                        float sc = 0.f;
#pragma unroll
                        for (int d = 0; d < 64; ++d) sc += q[d] * k_s[s][d];
                        sc = sc * 0.125f - slope * (float)dist;
                        const float mn = valid ? fmaxf(m, sc) : m;
                        const float scale = expf(m - mn);
                        const float p = valid ? expf(sc - mn) : 0.f;
                        l = l * scale + p;
#pragma unroll
                        for (int d = 0; d < 64; ++d) acc[d] = acc[d] * scale + p * v_s[s][d];
                        m = mn;
                    }
                }
            }
            const float gt = sigmoidf_(bf2f(prow[2560 + (branch + 1) * 16 + hd]));
            const float f = gt / fmaxf(l, 1e-30f);
#pragma unroll
            for (int d = 0; d < 64; d += 8) {
                float o[8];
                ld8(orow + d, o);
#pragma unroll
                for (int j = 0; j < 8; ++j) o[j] += f * acc[d + j];
                st8(orow + d, o);
            }
        }
    }
    __syncthreads();
}


typedef float f32x16 __attribute__((ext_vector_type(16)));
#define MFMA32(a, b, c) __builtin_amdgcn_mfma_f32_32x32x16_bf16((a), (b), (c), 0, 0, 0)
__device__ __forceinline__ unsigned cvtpk(float lo, float hi) { const f32x2_t f = {lo, hi}; return __builtin_bit_cast(unsigned, __builtin_convertvector(f, bf16x2_t)); }
__device__ __forceinline__ int crow32(int reg, int h) { return (reg & 3) + 8 * (reg >> 2) + 4 * h; }
constexpr float LOG2E = 1.4426950408889634f;
__device__ __forceinline__ void nsa_attn_phase(const bf16_t* __restrict__ proj, const bf16_t* __restrict__ vt, const unsigned* __restrict__ selmask, bf16_t* O, unsigned char* lds) {
    const int tid = tidx(), wave = __builtin_amdgcn_readfirstlane(tid >> 6), lane = tid & 63, l31 = lane & 31, h = lane >> 5;
    const int r = wave & 3, thalf = wave >> 2;
    const int skey = tid >> 3, spart = tid & 7;
    for (int it = blockIdx.x; it < 32 * 64; it += gridDim.x) {
        const int tile = 31 - (it >> 6), bg = it & 63, g = bg & 3, b = bg >> 2;
        const int hd = g * 4 + r, tokoff = thalf * 32 + l31, tok = tile * 64 + tokoff;
        const size_t trow = (size_t)(b * NL + tok);
        const float slope = exp2f(-0.5f * (float)(hd + 1));
        bf16x8_t Qf[4];
#pragma unroll
        for (int ds = 0; ds < 4; ++ds) {
            float q[8];
            ld8(proj + trow * ODD_PAD + hd * 64 + 16 * ds + 8 * h, q);
            u32x4 w; w.x = cvtpk(q[0] * 0.125f, q[1] * 0.125f); w.y = cvtpk(q[2] * 0.125f, q[3] * 0.125f); w.z = cvtpk(q[4] * 0.125f, q[5] * 0.125f); w.w = cvtpk(q[6] * 0.125f, q[7] * 0.125f);
            Qf[ds] = __builtin_bit_cast(bf16x8_t, w);
        }
        float sc[16];
#pragma unroll
        for (int reg = 0; reg < 16; ++reg) sc[reg] = slope * (float)crow32(reg, h);
        const unsigned mymask = selmask[(size_t)(b * 4 + g) * NL + tok];
        __syncthreads();
        if (wave == 0) {
            unsigned m = selmask[(size_t)(b * 4 + g) * NL + tile * 64 + lane];
            for (int o = 32; o; o >>= 1) m |= __shfl_xor(m, o);
            if (lane == 0) *(unsigned*)(lds + 35840) = m;
        }
        __syncthreads();
        const unsigned causal = (tile == 31) ? 0xffffffffu : ((2u << tile) - 1u);
        const unsigned U = *(const unsigned*)(lds + 35840) & causal;
        float outv[32];
#pragma unroll
        for (int i = 0; i < 32; ++i) outv[i] = 0.f;
#pragma unroll 1
        for (int branch = 0; branch < 2; ++branch) {
            unsigned todo = (branch == 0) ? U : (causal & ~((1u << (tile >= 8 ? tile - 8 : 0)) - 1u));
            const bf16_t* kbase = proj + (size_t)b * NL * ODD_PAD + (branch == 0 ? 1536 : 1792) + g * 64 + (size_t)skey * ODD_PAD + 8 * spart;
            const bf16_t* vbase = vt + (size_t)(branch * 256 + g * 64 + skey) * NT + (size_t)b * NL + 8 * spart;
            float m_run = -1e30f, l_run = 0.f;
            f32x16 Oa[2];
#pragma unroll
            for (int i = 0; i < 16; ++i) { Oa[0][i] = 0.f; Oa[1][i] = 0.f; }
            int jcur = __ffs(todo) - 1; todo &= todo - 1;
            uint4 kreg = *(const uint4*)(kbase + (size_t)(64 * jcur) * ODD_PAD);
            uint4 vreg = *(const uint4*)(vbase + 64 * jcur);
            int buf = 0;
            __syncthreads();
            *(uint4*)(lds + skey * 144 + spart * 16) = kreg;
            *(uint2*)(lds + 18432 + skey * 136 + spart * 16) = make_uint2(vreg.x, vreg.y);
            *(uint2*)(lds + 18432 + skey * 136 + spart * 16 + 8) = make_uint2(vreg.z, vreg.w);
            __syncthreads();
            for (;;) {
                const int jnext = todo ? (__ffs(todo) - 1) : -1;
                todo &= todo - 1;
                if (jnext >= 0) { kreg = *(const uint4*)(kbase + (size_t)(64 * jnext) * ODD_PAD); vreg = *(const uint4*)(vbase + 64 * jnext); }
                const unsigned char* Ks = lds + buf * 9216;
                const unsigned char* Vs = lds + 18432 + buf * 8704;
                const bool mysel = (branch == 1) || ((mymask >> jcur) & 1u);
                if (__any(mysel)) {
                    const bool diag = (jcur == tile), wedge = (branch == 1) && (jcur == tile - 8);
                    const float init = mysel ? slope * (float)(64 * (jcur - tile)) : -1e30f;
                    float sv[32];
#pragma unroll
                    for (int kt = 0; kt < 2; ++kt) {
                        f32x16 acc;
                        const float i0 = init + slope * (float)(32 * kt);
#pragma unroll
                        for (int i = 0; i < 16; ++i) acc[i] = i0;
#pragma unroll
                        for (int ds = 0; ds < 4; ++ds) {
                            const bf16x8_t a = *(const bf16x8_t*)(Ks + (32 * kt + l31) * 144 + (16 * ds + 8 * h) * 2);
                            acc = MFMA32(a, Qf[ds], acc);
                        }
#pragma unroll
                        for (int reg = 0; reg < 16; ++reg) {
                            float sval = acc[reg] + sc[reg];
                            const int keyoff = 32 * kt + crow32(reg, h);
                            if (diag) sval = (keyoff <= tokoff) ? sval : -1e30f;
                            if (wedge) sval = (keyoff > tokoff) ? sval : -1e30f;
                            sv[kt * 16 + reg] = sval;
                        }
                    }
                    float mx = sv[0];
#pragma unroll
                    for (int i = 1; i < 32; ++i) mx = fmaxf(mx, sv[i]);
                    mx = fmaxf(mx, __shfl_xor(mx, 32));
                    const float m_new = fmaxf(m_run, mx), m_use = fmaxf(m_new, -1e29f);
                    const float alpha = __builtin_amdgcn_exp2f((m_run - m_use) * LOG2E);
                    const float moff = -m_use * LOG2E;
                    float psum = 0.f;
#pragma unroll
                    for (int i = 0; i < 32; ++i) { sv[i] = __builtin_amdgcn_exp2f(fmaf(sv[i], LOG2E, moff)); psum += sv[i]; }
                    l_run = l_run * alpha + psum; m_run = m_new;
#pragma unroll
                    for (int i = 0; i < 16; ++i) { Oa[0][i] *= alpha; Oa[1][i] *= alpha; }
                    bf16x8_t Pf[4];
#pragma unroll
                    for (int ks = 0; ks < 4; ++ks) {
                        u32x4 w; w.x = cvtpk(sv[ks * 8 + 0], sv[ks * 8 + 1]); w.y = cvtpk(sv[ks * 8 + 2], sv[ks * 8 + 3]); w.z = cvtpk(sv[ks * 8 + 4], sv[ks * 8 + 5]); w.w = cvtpk(sv[ks * 8 + 6], sv[ks * 8 + 7]);
                        Pf[ks] = __builtin_bit_cast(bf16x8_t, w);
                    }
#pragma unroll
                    for (int mt = 0; mt < 2; ++mt)
#pragma unroll
                        for (int ks = 0; ks < 4; ++ks) {
                            const unsigned char* vp = Vs + (32 * mt + l31) * 136 + (16 * ks + 4 * h) * 2;
                            const uint2 lo = *(const uint2*)vp, hi = *(const uint2*)(vp + 16);
                            u32x4 w; w.x = lo.x; w.y = lo.y; w.z = hi.x; w.w = hi.y;
                            Oa[mt] = MFMA32(__builtin_bit_cast(bf16x8_t, w), Pf[ks], Oa[mt]);
                        }
                }
                if (jnext < 0) break;
                *(uint4*)(lds + (buf ^ 1) * 9216 + skey * 144 + spart * 16) = kreg;
                *(uint2*)(lds + 18432 + (buf ^ 1) * 8704 + skey * 136 + spart * 16) = make_uint2(vreg.x, vreg.y);
                *(uint2*)(lds + 18432 + (buf ^ 1) * 8704 + skey * 136 + spart * 16 + 8) = make_uint2(vreg.z, vreg.w);
                __syncthreads();
                buf ^= 1; jcur = jnext;
            }
            const float l_tot = l_run + __shfl_xor(l_run, 32);
            const float gt = sigmoidf_(bf2f(proj[trow * ODD_PAD + 2048 + (branch + 1) * 16 + hd]));
            const float f = gt / fmaxf(l_tot, 1e-30f);
#pragma unroll
            for (int i = 0; i < 16; ++i) { outv[i] += f * Oa[0][i]; outv[16 + i] += f * Oa[1][i]; }
        }
        bf16_t* orow = O + trow * ND + hd * 64;
#pragma unroll
        for (int mt = 0; mt < 2; ++mt)
#pragma unroll
            for (int q4 = 0; q4 < 4; ++q4) {
                bf16_t* op = orow + 32 * mt + 8 * q4 + 4 * h;
                const uint2 old = *(const uint2*)op;
                const float o0 = __uint_as_float(old.x << 16) + outv[mt * 16 + q4 * 4 + 0], o1 = __uint_as_float(old.x & 0xffff0000u) + outv[mt * 16 + q4 * 4 + 1];
                const float o2 = __uint_as_float(old.y << 16) + outv[mt * 16 + q4 * 4 + 2], o3 = __uint_as_float(old.y & 0xffff0000u) + outv[mt * 16 + q4 * 4 + 3];
                *(uint2*)op = make_uint2(cvtpk(o0, o1), cvtpk(o2, o3));
            }
    }
    __syncthreads();
}


__device__ __forceinline__ void nsa_compress2_phase(const bf16_t* __restrict__ proj, const bf16_t* __restrict__ w1t  , const bf16_t* __restrict__ w2t  ,
                                                    const float* __restrict__ bias1  , bf16_t* __restrict__ kcmp  , bf16_t* __restrict__ vcmpT  ,
                                                    unsigned char* lds) {
    const int tid = tidx(), wave = __builtin_amdgcn_readfirstlane(tid >> 6), lane = tid & 63, fr = lane & 15, fq = lane >> 4;
    unsigned char* xs = lds;
    unsigned char* hs = lds + 34816;
    for (int it = blockIdx.x; it < 1024; it += gridDim.x) {
        const int which = it >> 9, ntile = it & 7, g = (it >> 3) & 3, b = (it >> 5) & 15;
        const int t0 = 256 * ntile, coloff = (which ? 1280 : 1024) + g * 64;
        __syncthreads();
        for (int pc = tid; pc < 272 * 8; pc += NTHR) {
            const int tk = pc >> 3, c = pc & 7;
            int tsrc = t0 + tk; tsrc = tsrc > NL - 1 ? NL - 1 : tsrc;
            *(uint4*)(xs + tk * 128 + ((c ^ ((tk >> 4) & 7)) << 4)) = *(const uint4*)(proj + (size_t)(b * NL + tsrc) * ODD_PAD + coloff + 8 * c);
        }
        __syncthreads();
        f32x4 acc = {0.f, 0.f, 0.f, 0.f};
        const bf16_t* wrow = w1t + ((size_t)which * 128 + 16 * wave + fr) * 2048 + 8 * fq;
#pragma unroll 8
        for (int ks = 0; ks < 64; ++ks) {
            const int l = ks >> 1, tk = 16 * fr + l, c = 4 * (ks & 1) + fq;
            const bf16x8_t a = *(const bf16x8_t*)(xs + tk * 128 + ((c ^ ((tk >> 4) & 7)) << 4));
            const bf16x8_t bfrag = *(const bf16x8_t*)(wrow + 32 * ks);
            acc = __builtin_amdgcn_mfma_f32_16x16x32_bf16(a, bfrag, acc, 0, 0, 0);
        }
        {
            const float bj = bias1[which * 128 + 16 * wave + fr];
#pragma unroll
            for (int reg = 0; reg < 4; ++reg) *(bf16_t*)(hs + (4 * fq + reg) * 272 + (16 * wave + fr) * 2) = f2bf(gelu_fast(acc[reg] + bj));
        }
        __syncthreads();
        if (wave < 4) {
            f32x4 o = {0.f, 0.f, 0.f, 0.f};
#pragma unroll
            for (int ks = 0; ks < 4; ++ks) {
                const bf16x8_t a = *(const bf16x8_t*)(hs + fr * 272 + (32 * ks + 8 * fq) * 2);
                const bf16x8_t bfrag = *(const bf16x8_t*)(w2t + ((size_t)which * 64 + 16 * wave + fr) * 128 + 32 * ks + 8 * fq);
                o = __builtin_amdgcn_mfma_f32_16x16x32_bf16(a, bfrag, o, 0, 0, 0);
            }
            const int c = 16 * wave + fr;
#pragma unroll
            for (int reg = 0; reg < 4; ++reg) {
                const int n = 16 * ntile + 4 * fq + reg;
                const bf16_t val = (n < 127) ? f2bf(o[reg]) : (bf16_t)0;
                if (which == 0) kcmp[((size_t)(b * 4 + g) * 128 + n) * 64 + c] = val;
                else vcmpT[((size_t)(b * 4 + g) * 64 + c) * 128 + n] = val;
            }
        }
    }
    __syncthreads();
}

__device__ __forceinline__ void nsa_cmp2_phase(const bf16_t* __restrict__ proj, const bf16_t* __restrict__ kcmp, const bf16_t* __restrict__ vcmpT,
                                               bf16_t* __restrict__ O, unsigned* __restrict__ selmask, unsigned char* lds) {
    const int tid = tidx(), wave = __builtin_amdgcn_readfirstlane(tid >> 6), lane = tid & 63, l31 = lane & 31, h = lane >> 5;
    const int r = wave & 3, thalf = wave >> 2;
    unsigned char* Kc = lds;
    unsigned char* Vc = lds + 18432;
    float* impS = (float*)(lds + 35328);
    float* invS = (float*)(lds + 35328 + 32768);
    for (int it = blockIdx.x; it < 32 * 64; it += gridDim.x) {
        const int tile = 31 - (it >> 6), bg = it & 63, g = bg & 3, b = bg >> 2;
        const int hd = g * 4 + r, tokoff = thalf * 32 + l31, tok = tile * 64 + tokoff;
        const size_t trow = (size_t)(b * NL + tok);
        const float slope = exp2f(-0.5f * (float)(hd + 1));
        __syncthreads();
#pragma unroll
        for (int i = 0; i < 2; ++i) {
            const int pc = tid + 512 * i;
            { const int row = pc >> 3, c = pc & 7; *(uint4*)(Kc + row * 144 + c * 16) = *(const uint4*)(kcmp + ((size_t)(b * 4 + g) * 128 + row) * 64 + 8 * c); }
            { const int row = pc >> 4, c = pc & 15; const uint4 v = *(const uint4*)(vcmpT + ((size_t)(b * 4 + g) * 64 + row) * 128 + 8 * c);
              *(uint2*)(Vc + row * 264 + c * 16) = make_uint2(v.x, v.y); *(uint2*)(Vc + row * 264 + c * 16 + 8) = make_uint2(v.z, v.w); }
        }
        bf16x8_t Qf[4];
#pragma unroll
        for (int ds = 0; ds < 4; ++ds) {
            float q[8];
            ld8(proj + trow * ODD_PAD + hd * 64 + 16 * ds + 8 * h, q);
            u32x4 w; w.x = cvtpk(q[0] * 0.125f, q[1] * 0.125f); w.y = cvtpk(q[2] * 0.125f, q[3] * 0.125f); w.z = cvtpk(q[4] * 0.125f, q[5] * 0.125f); w.w = cvtpk(q[6] * 0.125f, q[7] * 0.125f);
            Qf[ds] = __builtin_bit_cast(bf16x8_t, w);
        }
        int nvalid = (tok >= 31) ? ((tok - 31) / 16 + 1) : 0;
        nvalid = nvalid > 127 ? 127 : nvalid;
        __syncthreads();
        float mx = -1e30f;
#pragma unroll 1
        for (int kt = 0; kt < 4; ++kt) {
            f32x16 acc;
            const float i0 = slope * (float)(512 * kt);
#pragma unroll
            for (int i = 0; i < 16; ++i) acc[i] = i0;
#pragma unroll
            for (int ds = 0; ds < 4; ++ds) {
                const bf16x8_t a = *(const bf16x8_t*)(Kc + (32 * kt + l31) * 144 + (16 * ds + 8 * h) * 2);
                acc = MFMA32(a, Qf[ds], acc);
            }
#pragma unroll
            for (int reg = 0; reg < 16; ++reg) {
                const int n = 32 * kt + crow32(reg, h);
                const float sval = acc[reg] + slope * (float)(16 * crow32(reg, h));
                mx = fmaxf(mx, (n < nvalid) ? sval : -1e30f);
            }
        }
        mx = fmaxf(mx, __shfl_xor(mx, 32));
        const float moff = -fmaxf(mx, -1e29f) * LOG2E;
        float psum = 0.f, prev_pe = 0.f;
        f32x16 Oa[2];
#pragma unroll
        for (int i = 0; i < 16; ++i) { Oa[0][i] = 0.f; Oa[1][i] = 0.f; }
#pragma unroll 1
        for (int kt = 0; kt < 4; ++kt) {
            f32x16 acc;
            const float i0 = slope * (float)(512 * kt);
#pragma unroll
            for (int i = 0; i < 16; ++i) acc[i] = i0;
#pragma unroll
            for (int ds = 0; ds < 4; ++ds) {
                const bf16x8_t a = *(const bf16x8_t*)(Kc + (32 * kt + l31) * 144 + (16 * ds + 8 * h) * 2);
                acc = MFMA32(a, Qf[ds], acc);
            }
            float sv[16];
#pragma unroll
            for (int reg = 0; reg < 16; ++reg) {
                const int n = 32 * kt + crow32(reg, h);
                const float sval = acc[reg] + slope * (float)(16 * crow32(reg, h));
                sv[reg] = __builtin_amdgcn_exp2f(fmaf((n < nvalid) ? sval : -1e30f, LOG2E, moff));
                psum += sv[reg];
            }
#pragma unroll
            for (int q = 0; q < 4; ++q) {
                const float e = 0.5f * sv[q * 4 + 3];
                const float own = sv[q * 4] + sv[q * 4 + 1] + sv[q * 4 + 2] + e;
                const float pe = __shfl_xor(e, 32);
                impS[(r * 64 + tokoff) * 32 + 8 * kt + 2 * q + h] = own + (h ? pe : prev_pe);
                prev_pe = pe;
            }
#pragma unroll
            for (int s2 = 0; s2 < 2; ++s2) {
                u32x4 w; w.x = cvtpk(sv[s2 * 8 + 0], sv[s2 * 8 + 1]); w.y = cvtpk(sv[s2 * 8 + 2], sv[s2 * 8 + 3]); w.z = cvtpk(sv[s2 * 8 + 4], sv[s2 * 8 + 5]); w.w = cvtpk(sv[s2 * 8 + 6], sv[s2 * 8 + 7]);
                const bf16x8_t pf = __builtin_bit_cast(bf16x8_t, w);
#pragma unroll
                for (int mt = 0; mt < 2; ++mt) {
                    const unsigned char* vp = Vc + (32 * mt + l31) * 264 + (32 * kt + 16 * s2 + 4 * h) * 2;
                    const uint2 lo = *(const uint2*)vp, hi = *(const uint2*)(vp + 16);
                    u32x4 a; a.x = lo.x; a.y = lo.y; a.z = hi.x; a.w = hi.y;
                    Oa[mt] = MFMA32(__builtin_bit_cast(bf16x8_t, a), pf, Oa[mt]);
                }
            }
        }
        psum += __shfl_xor(psum, 32);
        const float inv = (nvalid > 0) ? 1.f / fmaxf(psum, 1e-30f) : 0.f;
        if (h == 0) invS[r * 64 + tokoff] = inv;
        const float g0 = sigmoidf_(bf2f(proj[trow * ODD_PAD + 2048 + hd])) * inv;
        bf16_t* orow = O + trow * ND + hd * 64;
#pragma unroll
        for (int mt = 0; mt < 2; ++mt)
#pragma unroll
            for (int q4 = 0; q4 < 4; ++q4)
                *(uint2*)(orow + 32 * mt + 8 * q4 + 4 * h) = make_uint2(cvtpk(g0 * Oa[mt][q4 * 4], g0 * Oa[mt][q4 * 4 + 1]), cvtpk(g0 * Oa[mt][q4 * 4 + 2], g0 * Oa[mt][q4 * 4 + 3]));
        __syncthreads();
        float* impT = (float*)Kc;
#pragma unroll
        for (int i = 0; i < 4; ++i) {
            const int pc = tid + 512 * i, tk = pc >> 5, j = pc & 31, cur = tile;
            const float ij = impS[(0 * 64 + tk) * 32 + j] * invS[tk] + impS[(1 * 64 + tk) * 32 + j] * invS[64 + tk] + impS[(2 * 64 + tk) * 32 + j] * invS[128 + tk] + impS[(3 * 64 + tk) * 32 + j] * invS[192 + tk];
            const bool fj = (j == 0) || (j == cur) || (j == cur - 1);
            impT[tk * 33 + j] = (j <= cur) ? ij + (fj ? 1000.f : 0.f) : -INFINITY;
        }
        __syncthreads();
        if (tid < 256) {
            const int tk = tid >> 2, rr = tid & 3;
            unsigned bits = 0;
#pragma unroll 1
            for (int jj = 0; jj < 8; ++jj) {
                const int j = rr * 8 + jj;
                const float vj = impT[tk * 33 + j];
                int rank = 0;
#pragma unroll 8
                for (int k = 0; k < 32; ++k) {
                    const float vk = impT[tk * 33 + k];
                    rank += (vk > vj || (vk == vj && k < j)) ? 1 : 0;
                }
                if (rank < 16) bits |= 1u << j;
            }
            bits |= __shfl_xor(bits, 1);
            bits |= __shfl_xor(bits, 2);
            if (rr == 0) selmask[(size_t)(b * 4 + g) * NL + tile * 64 + tk] = bits;
        }
    }
    __syncthreads();
}


constexpr int P0W = 1792;
constexpr float LN2F = 0.6931471805599453f;
__device__ __forceinline__ void sb_attn2_phase(const bf16_t* __restrict__ proj, const bf16_t* __restrict__ vt, bf16_t* __restrict__ Y, unsigned char* lds) {
    const int tid = tidx(), wave = __builtin_amdgcn_readfirstlane(tid >> 6), lane = tid & 63, l31 = lane & 31, h = lane >> 5;
    const int skey = tid >> 3, spart = tid & 7;
    for (int it = blockIdx.x; it < NB * 12 * 8; it += gridDim.x) {
        const int tile = 7 - (it / 192), bh = it % 192, hh = bh % 12, b = bh / 12;
        const int qlo = tile * 256 + 32 * wave, tq = qlo + l31;
        const size_t trow = (size_t)(b * NL + tq);
        bf16x8_t Qf[4];
#pragma unroll
        for (int ds = 0; ds < 4; ++ds) {
            float q[8];
            ld8(proj + trow * P0W + 256 + hh * 64 + 16 * ds + 8 * h, q);
            u32x4 w; w.x = cvtpk(q[0] * 0.125f, q[1] * 0.125f); w.y = cvtpk(q[2] * 0.125f, q[3] * 0.125f); w.z = cvtpk(q[4] * 0.125f, q[5] * 0.125f); w.w = cvtpk(q[6] * 0.125f, q[7] * 0.125f);
            Qf[ds] = __builtin_bit_cast(bf16x8_t, w);
        }
        const bf16_t* kbase = proj + (size_t)b * NL * P0W + 1024 + hh * 64 + (size_t)skey * P0W + 8 * spart;
        const bf16_t* vbase = vt + (size_t)(hh * 64 + skey) * NT + (size_t)b * NL + 8 * spart;
        f32x16 Oa[2];
#pragma unroll
        for (int i = 0; i < 16; ++i) { Oa[0][i] = 0.f; Oa[1][i] = 0.f; }
        float carry = 0.f;
        int j = tile * 4 + 3, buf = 0;
        uint4 kreg = *(const uint4*)(kbase + (size_t)(64 * j) * P0W);
        uint4 vreg = *(const uint4*)(vbase + 64 * j);
        __syncthreads();
        *(uint4*)(lds + skey * 144 + spart * 16) = kreg;
        *(uint2*)(lds + 18432 + skey * 136 + spart * 16) = make_uint2(vreg.x, vreg.y);
        *(uint2*)(lds + 18432 + skey * 136 + spart * 16 + 8) = make_uint2(vreg.z, vreg.w);
        __syncthreads();
        for (;;) {
            const int jn = j - 1;
            if (jn >= 0) { kreg = *(const uint4*)(kbase + (size_t)(64 * jn) * P0W); vreg = *(const uint4*)(vbase + 64 * jn); }
            const unsigned char* Ks = lds + buf * 9216;
            const unsigned char* Vs = lds + 18432 + buf * 8704;
            const bool live = (64 * j <= qlo + 30) && !__all(carry < -110.f);
            if (live) {
#pragma unroll
                for (int kti = 0; kti < 2; ++kti) {
                    const int kt = 1 - kti;
                    f32x16 acc;
#pragma unroll
                    for (int i = 0; i < 16; ++i) acc[i] = 0.f;
#pragma unroll
                    for (int ds = 0; ds < 4; ++ds) {
                        const bf16x8_t a = *(const bf16x8_t*)(Ks + (32 * kt + l31) * 144 + (16 * ds + 8 * h) * 2);
                        acc = MFMA32(a, Qf[ds], acc);
                    }
                    float m1[16], lz[16];
#pragma unroll
                    for (int reg = 0; reg < 16; ++reg) {
                        const float z = acc[reg];
                        const bool valid = (64 * j + 32 * kt + crow32(reg, h)) < tq;
                        const float e = __builtin_amdgcn_exp2f(-fabsf(z) * LOG2E);
                        const float sp = fmaxf(z, 0.f) + __builtin_amdgcn_logf(1.f + e) * LN2F;
                        m1[reg] = valid ? -sp : 0.f;
                        lz[reg] = valid ? z - sp : -1e30f;
                    }
                    float G[4], T[4];
#pragma unroll
                    for (int q = 0; q < 4; ++q) G[q] = (m1[4 * q] + m1[4 * q + 1]) + (m1[4 * q + 2] + m1[4 * q + 3]);
                    float Gp[4];
#pragma unroll
                    for (int q = 0; q < 4; ++q) { Gp[q] = __shfl_xor(G[q], 32); T[q] = G[q] + Gp[q]; }
                    float base[4];
                    base[3] = carry; base[2] = base[3] + T[3]; base[1] = base[2] + T[2]; base[0] = base[1] + T[1];
                    const float tot = base[0] + T[0];
#pragma unroll
                    for (int q = 0; q < 4; ++q) {
                        const float bq = base[q] + (h ? 0.f : Gp[q]);
                        const float t3 = bq, t2 = t3 + m1[4 * q + 3], t1 = t2 + m1[4 * q + 2], t0 = t1 + m1[4 * q + 1];
                        lz[4 * q + 3] = __builtin_amdgcn_exp2f((lz[4 * q + 3] + t3) * LOG2E);
                        lz[4 * q + 2] = __builtin_amdgcn_exp2f((lz[4 * q + 2] + t2) * LOG2E);
                        lz[4 * q + 1] = __builtin_amdgcn_exp2f((lz[4 * q + 1] + t1) * LOG2E);
                        lz[4 * q + 0] = __builtin_amdgcn_exp2f((lz[4 * q + 0] + t0) * LOG2E);
                    }
                    carry = tot;
#pragma unroll
                    for (int s2 = 0; s2 < 2; ++s2) {
                        u32x4 w; w.x = cvtpk(lz[s2 * 8 + 0], lz[s2 * 8 + 1]); w.y = cvtpk(lz[s2 * 8 + 2], lz[s2 * 8 + 3]); w.z = cvtpk(lz[s2 * 8 + 4], lz[s2 * 8 + 5]); w.w = cvtpk(lz[s2 * 8 + 6], lz[s2 * 8 + 7]);
                        const bf16x8_t pf = __builtin_bit_cast(bf16x8_t, w);
#pragma unroll
                        for (int mt = 0; mt < 2; ++mt) {
                            const unsigned char* vp = Vs + (32 * mt + l31) * 136 + (32 * kt + 16 * s2 + 4 * h) * 2;
                            const uint2 lo = *(const uint2*)vp, hi = *(const uint2*)(vp + 16);
                            u32x4 a; a.x = lo.x; a.y = lo.y; a.z = hi.x; a.w = hi.y;
                            Oa[mt] = MFMA32(__builtin_bit_cast(bf16x8_t, a), pf, Oa[mt]);
                        }
                    }
                }
            }
            if (jn >= 0) {
                *(uint4*)(lds + (buf ^ 1) * 9216 + skey * 144 + spart * 16) = kreg;
                *(uint2*)(lds + 18432 + (buf ^ 1) * 8704 + skey * 136 + spart * 16) = make_uint2(vreg.x, vreg.y);
                *(uint2*)(lds + 18432 + (buf ^ 1) * 8704 + skey * 136 + spart * 16 + 8) = make_uint2(vreg.z, vreg.w);
            }
            volatile int* flg = (volatile int*)(lds + 35840) + (j & 1) * 8;
            const int wdone = __all(carry < -110.f);
            if (lane == 0) flg[wave] = wdone;
            __syncthreads();
            const int alldone = flg[0] & flg[1] & flg[2] & flg[3] & flg[4] & flg[5] & flg[6] & flg[7];
            if (alldone || jn < 0) break;
            buf ^= 1; j = jn;
        }
        bf16_t* orow = Y + trow * ND + 256 + hh * 64;
#pragma unroll
        for (int mt = 0; mt < 2; ++mt)
#pragma unroll
            for (int q4 = 0; q4 < 4; ++q4)
                *(uint2*)(orow + 32 * mt + 8 * q4 + 4 * h) = make_uint2(cvtpk(Oa[mt][q4 * 4], Oa[mt][q4 * 4 + 1]), cvtpk(Oa[mt][q4 * 4 + 2], Oa[mt][q4 * 4 + 3]));
    }
    __syncthreads();
}

__device__ __forceinline__ void s5_scan2_phase(const bf16_t* __restrict__ proj, const float* __restrict__ lam_re, const float* __restrict__ lam_im, const float* __restrict__ log_dt,
                                               const float* __restrict__ b_re, const float* __restrict__ b_im, const float* __restrict__ c_re, const float* __restrict__ c_im,
                                               const float* __restrict__ dskip, bf16_t* __restrict__ ya, float* lds) {
    const int tid = tidx(), wave = __builtin_amdgcn_readfirstlane(tid >> 6), lane = tid & 63;
    float* cr = lds;
    float* ci = lds + 1024;
    float* Es = lds + 2048;
    float* us = lds + 3072 + wave * 512;
    float* xr = lds + 7168 + wave * 4160;
    float* xi = xr + 2080;
    for (int bg = blockIdx.x; bg < NB * 16; bg += gridDim.x) {
        const int b = bg >> 4, g = bg & 15;
        const float lr = lam_re[g * 64 + lane], li = lam_im[g * 64 + lane];
        const float dt = expf(log_dt[g]);
        const float mag = expf(lr * dt);
        const float are = mag * cosf(li * dt), aim = mag * sinf(li * dt);
        const float nr = are - 1.f, den = lr * lr + li * li;
        const float fre = (nr * lr + aim * li) / den, fim = (aim * lr - nr * li) / den;
        float bbr[16], bbi[16];
#pragma unroll
        for (int i = 0; i < 16; ++i) {
            const float br = b_re[(g * 64 + lane) * 16 + i], bi = b_im[(g * 64 + lane) * 16 + i];
            bbr[i] = fre * br - fim * bi; bbi[i] = fre * bi + fim * br;
        }
        __syncthreads();
        for (int idx = tid; idx < 1024; idx += NTHR) { cr[idx] = c_re[g * 1024 + idx]; ci[idx] = c_im[g * 1024 + idx]; }
        const bf16_t* ub = proj + (size_t)(b * NL + 256 * wave) * P0W + g * 16;
        float xre = 0.f, xim = 0.f;
        for (int c0 = 0; c0 < 256; c0 += 32) {
            wave_lds_fence();
            { float u8[8]; const int t = lane >> 1, hf = lane & 1; ld8(ub + (size_t)(c0 + t) * P0W + 8 * hf, u8);
#pragma unroll
              for (int i = 0; i < 8; ++i) us[t * 16 + 8 * hf + i] = u8[i]; }
            wave_lds_fence();
            for (int t = 0; t < 32; ++t) {
                float bur = 0.f, bui = 0.f;
#pragma unroll
                for (int i = 0; i < 16; ++i) { const float u = us[t * 16 + i]; bur += bbr[i] * u; bui += bbi[i] * u; }
                const float nre = are * xre - aim * xim + bur, nim = are * xim + aim * xre + bui;
                xre = nre; xim = nim;
            }
        }
        Es[(wave * 64 + lane) * 2] = xre; Es[(wave * 64 + lane) * 2 + 1] = xim;
        float pr = are, pi = aim;
#pragma unroll
        for (int i = 0; i < 8; ++i) { const float nr2 = pr * pr - pi * pi, ni2 = 2.f * pr * pi; pr = nr2; pi = ni2; }
        __syncthreads();
        xre = 0.f; xim = 0.f;
        for (int w2 = 0; w2 < wave; ++w2) {
            const float er = Es[(w2 * 64 + lane) * 2], ei = Es[(w2 * 64 + lane) * 2 + 1];
            const float nre = pr * xre - pi * xim + er, nim = pr * xim + pi * xre + ei;
            xre = nre; xim = nim;
        }
        const int tt = lane & 31, ih = lane >> 5;
        float dsk[8];
#pragma unroll
        for (int i = 0; i < 8; ++i) dsk[i] = dskip[g * 16 + 8 * ih + i];
        for (int c0 = 0; c0 < 256; c0 += 32) {
            wave_lds_fence();
            { float u8[8]; const int t = lane >> 1, hf = lane & 1; ld8(ub + (size_t)(c0 + t) * P0W + 8 * hf, u8);
#pragma unroll
              for (int i = 0; i < 8; ++i) us[t * 16 + 8 * hf + i] = u8[i]; }
            wave_lds_fence();
            for (int t = 0; t < 32; ++t) {
                float bur = 0.f, bui = 0.f;
#pragma unroll
                for (int i = 0; i < 16; ++i) { const float u = us[t * 16 + i]; bur += bbr[i] * u; bui += bbi[i] * u; }
                const float nre = are * xre - aim * xim + bur, nim = are * xim + aim * xre + bui;
                xre = nre; xim = nim;
                xr[t * 65 + lane] = xre; xi[t * 65 + lane] = xim;
            }
            wave_lds_fence();
            float y[8];
#pragma unroll
            for (int i = 0; i < 8; ++i) y[i] = 0.f;
            for (int p = 0; p < 64; ++p) {
                const float a = xr[tt * 65 + p], bq = xi[tt * 65 + p];
#pragma unroll
                for (int i = 0; i < 8; ++i) y[i] += cr[(8 * ih + i) * 64 + p] * a - ci[(8 * ih + i) * 64 + p] * bq;
            }
            float o[8];
#pragma unroll
            for (int i = 0; i < 8; ++i) o[i] = gelu_fast(y[i] + dsk[i] * us[tt * 16 + 8 * ih + i]);
            st8(ya + (size_t)(b * NL + 256 * wave + c0 + tt) * 256 + g * 16 + 8 * ih, o);
        }
    }
    __syncthreads();
}


__device__ __forceinline__ void glu2_phase(const bf16_t* __restrict__ ya, const bf16_t* __restrict__ wgt, const float* __restrict__ bglu, bf16_t* __restrict__ Y, unsigned char* lds) {
    const int tid = tidx(), wave = __builtin_amdgcn_readfirstlane(tid >> 6), lane = tid & 63, fr = lane & 15, fq = lane >> 4;
    __syncthreads();
    for (int pc = tid; pc < 256 * 32; pc += NTHR) { const int row = pc >> 5, c = pc & 31; *(uint4*)(lds + row * 528 + c * 16) = *(const uint4*)(wgt + row * 256 + c * 8); }
    __syncthreads();
    for (int chunk = blockIdx.x; chunk < NT / 128; chunk += gridDim.x) {
        const size_t tok = (size_t)chunk * 128 + wave * 16 + fr;
        bf16x8_t yb[8];
#pragma unroll
        for (int ks = 0; ks < 8; ++ks) yb[ks] = *(const bf16x8_t*)(ya + tok * 256 + 32 * ks + 8 * fq);
#pragma unroll 2
        for (int nt = 0; nt < 16; ++nt) {
            f32x4 acc = {0.f, 0.f, 0.f, 0.f};
#pragma unroll
            for (int ks = 0; ks < 8; ++ks) {
                const bf16x8_t a = *(const bf16x8_t*)(lds + (16 * nt + fr) * 528 + (32 * ks + 8 * fq) * 2);
                acc = __builtin_amdgcn_mfma_f32_16x16x32_bf16(a, yb[ks], acc, 0, 0, 0);
            }
            const int n0 = 16 * nt + 4 * fq;
            const uint2 yv = *(const uint2*)(ya + tok * 256 + n0);
            const float4 bb = *(const float4*)(bglu + n0);
            const float o0 = __uint_as_float(yv.x << 16) * sigmoidf_(acc[0] + bb.x), o1 = __uint_as_float(yv.x & 0xffff0000u) * sigmoidf_(acc[1] + bb.y);
            const float o2 = __uint_as_float(yv.y << 16) * sigmoidf_(acc[2] + bb.z), o3 = __uint_as_float(yv.y & 0xffff0000u) * sigmoidf_(acc[3] + bb.w);
            *(uint2*)(Y + tok * ND + n0) = make_uint2(cvtpk(o0, o1), cvtpk(o2, o3));
        }
    }
    __syncthreads();
}


__device__ __forceinline__ void cmadd(float& re, float& im, float ar, float ai, float br, float bi) {
    const float nr = fmaf(ar, re, fmaf(-ai, im, br)), ni = fmaf(ar, im, fmaf(ai, re, bi));
    re = nr; im = ni;
}
__device__ __forceinline__ void s5_scan3_phase(const bf16_t* __restrict__ proj, const float* __restrict__ lam_re, const float* __restrict__ lam_im, const float* __restrict__ log_dt,
                                               const float* __restrict__ b_re, const float* __restrict__ b_im, const float* __restrict__ c_re, const float* __restrict__ c_im,
                                               const float* __restrict__ dskip, bf16_t* __restrict__ ya, unsigned char* lds) {
    const int tid = tidx(), wave = __builtin_amdgcn_readfirstlane(tid >> 6), lane = tid & 63, l31 = lane & 31, h = lane >> 5, fr = lane & 15, fq = lane >> 4;
    unsigned char* Xs = lds + wave * 10752;
    float* Es = (float*)(lds + 86016);
    __syncthreads();
    for (int i = lane; i < 32 * 21; i += 64) *(uint4*)(Xs + i * 16) = make_uint4(0u, 0u, 0u, 0u);
    for (int bg = blockIdx.x; bg < NB * 16; bg += gridDim.x) {
        const int b = bg >> 4, g = bg & 15;
        const float dt = expf(log_dt[g]);
        float are[2], aim[2]; bf16x8_t Bre[2], Bim[2];
#pragma unroll
        for (int k = 0; k < 2; ++k) {
            const int p = 32 * k + l31;
            const float lr = lam_re[g * 64 + p], li = lam_im[g * 64 + p];
            const float mag = expf(lr * dt);
            are[k] = mag * cosf(li * dt); aim[k] = mag * sinf(li * dt);
            const float nr = are[k] - 1.f, den = lr * lr + li * li;
            const float fre = (nr * lr + aim[k] * li) / den, fim = (aim[k] * lr - nr * li) / den;
            float vr[8], vi[8];
#pragma unroll
            for (int j = 0; j < 8; ++j) {
                const float br = b_re[(g * 64 + p) * 16 + 8 * h + j], bi = b_im[(g * 64 + p) * 16 + 8 * h + j];
                vr[j] = fre * br - fim * bi; vi[j] = fre * bi + fim * br;
            }
            u32x4 w; w.x = cvtpk(vr[0], vr[1]); w.y = cvtpk(vr[2], vr[3]); w.z = cvtpk(vr[4], vr[5]); w.w = cvtpk(vr[6], vr[7]); Bre[k] = __builtin_bit_cast(bf16x8_t, w);
            w.x = cvtpk(vi[0], vi[1]); w.y = cvtpk(vi[2], vi[3]); w.z = cvtpk(vi[4], vi[5]); w.w = cvtpk(vi[6], vi[7]); Bim[k] = __builtin_bit_cast(bf16x8_t, w);
        }
        bf16x8_t Cm[5];
        {
            const float di = dskip[g * 16 + fr];
#pragma unroll
            for (int ks = 0; ks < 5; ++ks) {
                float cv[8];
#pragma unroll
                for (int j = 0; j < 8; ++j) {
                    const int kk = 32 * ks + 8 * fq + j;
                    cv[j] = kk < 64 ? c_re[(g * 16 + fr) * 64 + kk] : (kk < 128 ? -c_im[(g * 16 + fr) * 64 + kk - 64] : ((kk - 128) == fr ? di : 0.f));
                }
                u32x4 w; w.x = cvtpk(cv[0], cv[1]); w.y = cvtpk(cv[2], cv[3]); w.z = cvtpk(cv[4], cv[5]); w.w = cvtpk(cv[6], cv[7]); Cm[ks] = __builtin_bit_cast(bf16x8_t, w);
            }
        }
        float a4r[2], a4i[2], a5r[2], a5i[2], a32r[2], a32i[2], a256r[2], a256i[2];
#pragma unroll
        for (int k = 0; k < 2; ++k) {
            float pr = are[k], pi = aim[k], t;
            t = pr * pr - pi * pi; pi = 2.f * pr * pi; pr = t;
            t = pr * pr - pi * pi; pi = 2.f * pr * pi; pr = t;
            a4r[k] = pr; a4i[k] = pi;
            a5r[k] = pr * are[k] - pi * aim[k]; a5i[k] = pr * aim[k] + pi * are[k];
#pragma unroll
            for (int i = 0; i < 3; ++i) { t = pr * pr - pi * pi; pi = 2.f * pr * pi; pr = t; }
            a32r[k] = pr; a32i[k] = pi;
#pragma unroll
            for (int i = 0; i < 3; ++i) { t = pr * pr - pi * pi; pi = 2.f * pr * pi; pr = t; }
            a256r[k] = pr; a256i[k] = pi;
        }
        const bf16_t* ub = proj + (size_t)(b * NL + 256 * wave) * P0W + g * 16 + 8 * h;
        float sre[2] = {0.f, 0.f}, sim[2] = {0.f, 0.f};
#pragma unroll 1
        for (int c0 = 0; c0 < 256; c0 += 32) {
            const bf16x8_t uf = *(const bf16x8_t*)(ub + (size_t)(c0 + l31) * P0W);
#pragma unroll
            for (int k = 0; k < 2; ++k) {
                f32x16 z;
#pragma unroll
                for (int i = 0; i < 16; ++i) z[i] = 0.f;
                const f32x16 bur = MFMA32(uf, Bre[k], z), bui = MFMA32(uf, Bim[k], z);
                float er = 0.f, ei = 0.f;
#pragma unroll
                for (int reg = 0; reg < 16; ++reg) {
                    if (reg == 0) { er = bur[0]; ei = bui[0]; }
                    else if ((reg & 3) == 0) cmadd(er, ei, a5r[k], a5i[k], bur[reg], bui[reg]);
                    else cmadd(er, ei, are[k], aim[k], bur[reg], bui[reg]);
                }
                { float tr = er, ti = ei; cmadd(tr, ti, a4r[k], a4i[k], 0.f, 0.f); er = h ? er : tr; ei = h ? ei : ti; }
                er += __shfl_xor(er, 32); ei += __shfl_xor(ei, 32);
                cmadd(sre[k], sim[k], a32r[k], a32i[k], er, ei);
            }
        }
        __syncthreads();
        if (h == 0) {
#pragma unroll
            for (int k = 0; k < 2; ++k) { Es[(wave * 64 + 32 * k + l31) * 2] = sre[k]; Es[(wave * 64 + 32 * k + l31) * 2 + 1] = sim[k]; }
        }
        __syncthreads();
        float xre[2] = {0.f, 0.f}, xim[2] = {0.f, 0.f};
        for (int w2 = 0; w2 < wave; ++w2) {
#pragma unroll
            for (int k = 0; k < 2; ++k) cmadd(xre[k], xim[k], a256r[k], a256i[k], Es[(w2 * 64 + 32 * k + l31) * 2], Es[(w2 * 64 + 32 * k + l31) * 2 + 1]);
        }
#pragma unroll 1
        for (int c0 = 0; c0 < 256; c0 += 32) {
            const bf16x8_t uf = *(const bf16x8_t*)(ub + (size_t)(c0 + l31) * P0W);
            wave_lds_fence();
            *(bf16x8_t*)(Xs + l31 * 336 + 256 + 16 * h) = uf;
#pragma unroll
            for (int k = 0; k < 2; ++k) {
                f32x16 z;
#pragma unroll
                for (int i = 0; i < 16; ++i) z[i] = 0.f;
                const f32x16 bur = MFMA32(uf, Bre[k], z), bui = MFMA32(uf, Bim[k], z);
                float cr = xre[k], ci = xim[k];
#pragma unroll
                for (int q = 0; q < 4; ++q) {
                    float ar_[4], ai_[4], br_[4], bi_[4];
                    float xr_ = cr, xi_ = ci;
#pragma unroll
                    for (int r2 = 0; r2 < 4; ++r2) { cmadd(xr_, xi_, are[k], aim[k], bur[4 * q + r2], bui[4 * q + r2]); ar_[r2] = xr_; ai_[r2] = xi_; }
                    float yr_ = __shfl_xor(xr_, 32), yi_ = __shfl_xor(xi_, 32);
#pragma unroll
                    for (int r2 = 0; r2 < 4; ++r2) { cmadd(yr_, yi_, are[k], aim[k], bur[4 * q + r2], bui[4 * q + r2]); br_[r2] = yr_; bi_[r2] = yi_; }
                    const float zr_ = __shfl_xor(yr_, 32), zi_ = __shfl_xor(yi_, 32);
                    cr = h ? yr_ : zr_; ci = h ? yi_ : zi_;
#pragma unroll
                    for (int r2 = 0; r2 < 4; ++r2) {
                        const int t = 8 * q + 4 * h + r2;
                        *(bf16_t*)(Xs + t * 336 + (32 * k + l31) * 2) = f2bf(h ? br_[r2] : ar_[r2]);
                        *(bf16_t*)(Xs + t * 336 + (64 + 32 * k + l31) * 2) = f2bf(h ? bi_[r2] : ai_[r2]);
                    }
                }
                xre[k] = cr; xim[k] = ci;
            }
            wave_lds_fence();
#pragma unroll
            for (int mt = 0; mt < 2; ++mt) {
                f32x4 y = {0.f, 0.f, 0.f, 0.f};
#pragma unroll
                for (int ks = 0; ks < 5; ++ks) {
                    const bf16x8_t a = *(const bf16x8_t*)(Xs + (16 * mt + fr) * 336 + (32 * ks + 8 * fq) * 2);
                    y = __builtin_amdgcn_mfma_f32_16x16x32_bf16(a, Cm[ks], y, 0, 0, 0);
                }
#pragma unroll
                for (int reg = 0; reg < 4; ++reg)
                    ya[(size_t)(b * NL + 256 * wave + c0 + 16 * mt + 4 * fq + reg) * 256 + g * 16 + fr] = f2bf(gelu_fast(y[reg]));
            }
        }
    }
    __syncthreads();
}

struct Params {
    const float* in[29];
    float* out;
    char* ws;
    unsigned long long pad;
};

constexpr size_t SZ_PROJ = (size_t)NT * EVEN_IN * 2;
constexpr size_t SZ_VT = (size_t)768 * NT * 2;
constexpr size_t SZ_YB = (size_t)NT * ND * 2;
constexpr size_t SZ_HB = (size_t)NT * ND * 2;
constexpr size_t SZ_YA = (size_t)NT * 256 * 2;
constexpr size_t SZ_CMP = (size_t)NB * 4 * 128 * 64 * 2;
constexpr size_t SZ_SEL = (size_t)NB * 4 * NL * 4;
constexpr size_t SZ_TAB = (size_t)16384 * ND;
constexpr size_t SZ_SKB = (size_t)2 * 8 * 2 * 128 * 128 * 2;
constexpr size_t OFF_VT = SZ_PROJ, OFF_YB = OFF_VT + SZ_VT, OFF_HB = OFF_YB + SZ_YB, OFF_YA = OFF_HB + SZ_HB, OFF_KC = OFF_YA + SZ_YA, OFF_VC = OFF_KC + SZ_CMP,
                 OFF_SEL = OFF_VC + SZ_CMP, OFF_TAB = OFF_SEL + SZ_SEL, OFF_SKB = OFF_TAB + 2 * SZ_TAB, OFF_WT = OFF_SKB + SZ_SKB;
constexpr size_t WT_IN0 = 0, WT_OUT0 = WT_IN0 + (size_t)EVEN_IN * ND * 2, WT_Q0 = WT_OUT0 + (size_t)ND * ND * 2, WT_Q1 = WT_Q0 + (size_t)2048 * ND * 2,
                 WT_IN1 = WT_Q1 + (size_t)2048 * ND * 2, WT_V1 = WT_IN1 + (size_t)ODD_PAD * ND * 2, WT_OUT1 = WT_V1 + (size_t)512 * ND * 2, WT_W1 = WT_OUT1 + (size_t)ND * ND * 2, WT_W2 = WT_W1 + (size_t)2 * 128 * 2048 * 2, WT_B1 = WT_W2 + (size_t)2 * 64 * 128 * 2, WT_V0 = WT_B1 + 2 * 128 * 4, WT_GLU = WT_V0 + (size_t)768 * ND * 2, WT_END = WT_GLU + (size_t)256 * 256 * 2;
constexpr size_t OFF_PART = OFF_WT + ((WT_END + 255) & ~(size_t)255);
constexpr size_t OFF_CQ = OFF_PART + (size_t)NT * 32 * 4;
constexpr size_t OFF_BAR = OFF_CQ + 4 * 2048 * 4;
constexpr size_t WS_NEED = OFF_BAR + XB_TOTAL_WORDS * 4 + 256;

__device__ __forceinline__ void convert_tables(const float* __restrict__ u, const float* __restrict__ v, unsigned char* __restrict__ TAB) {
    const size_t per = (size_t)16384 * ND / 16;
    for (size_t i = (size_t)blockIdx.x * NTHR + tidx(); i < 2 * per; i += (size_t)gridDim.x * NTHR) {
        const int tb = (int)(i / per); const size_t off = (i % per) * 16;
        const float* src = (tb ? v : u) + off;
        const float sc = tb ? V_SCALE : U_SCALE;
        uint4 w; unsigned* wp = (unsigned*)&w;
#pragma unroll
        for (int q = 0; q < 4; ++q) {
            const f32x4 a = __builtin_nontemporal_load((const f32x4*)(src + 4 * q));
            int pk = __builtin_amdgcn_cvt_pk_fp8_f32(a.x * sc, a.y * sc, 0, false);
            pk = __builtin_amdgcn_cvt_pk_fp8_f32(a.z * sc, a.w * sc, pk, true);
            wp[q] = (unsigned)pk;
        }
        *(uint4*)(TAB + (size_t)tb * 16384 * ND + off) = w;
    }
}

__global__ void __launch_bounds__(NTHR) fwd_megakernel(Params p) {
    extern __shared__ __attribute__((aligned(16))) unsigned char lds_raw[];
    float* lds = (float*)lds_raw;
    cg::grid_group grid = cg::this_grid();
    const float* x = p.in[0];
    float* R = p.out;
    char* ws = p.ws;
    bf16_t* PROJ = (bf16_t*)ws;
    bf16_t* YB = (bf16_t*)(ws + OFF_YB);
    bf16_t* HB = (bf16_t*)(ws + OFF_HB);
    bf16_t* YA = (bf16_t*)(ws + OFF_YA);
    bf16_t* WGT = (bf16_t*)(ws + OFF_WT + WT_GLU);
    bf16_t* KCMP = (bf16_t*)(ws + OFF_KC);
    bf16_t* VCMP = (bf16_t*)(ws + OFF_VC);
    bf16_t* W1T = (bf16_t*)(ws + OFF_WT + WT_W1);
    bf16_t* W2T = (bf16_t*)(ws + OFF_WT + WT_W2);
    float* BIAS1 = (float*)(ws + OFF_WT + WT_B1);
    unsigned* SEL = (unsigned*)(ws + OFF_SEL);
    bf16_t* WIN0 = (bf16_t*)(ws + OFF_WT + WT_IN0);
    bf16_t* WOUT0 = (bf16_t*)(ws + OFF_WT + WT_OUT0);
    bf16_t* WQ0 = (bf16_t*)(ws + OFF_WT + WT_Q0);
    bf16_t* WQ1 = (bf16_t*)(ws + OFF_WT + WT_Q1);
    bf16_t* WIN1 = (bf16_t*)(ws + OFF_WT + WT_IN1);
    bf16_t* WOUT1 = (bf16_t*)(ws + OFF_WT + WT_OUT1);
    bf16_t* WV1 = (bf16_t*)(ws + OFF_WT + WT_V1);
    bf16_t* VT = (bf16_t*)(ws + OFF_VT);
    bf16_t* WV0 = (bf16_t*)(ws + OFF_WT + WT_V0);
    int* EIDX = (int*)YB;
    float* EGATE = (float*)((char*)YB + (size_t)NT * 128 * 4);
    unsigned char* TAB = (unsigned char*)(ws + OFF_TAB);
    bf16_t* SKB = (bf16_t*)(ws + OFF_SKB);
    const int wave = tidx() >> 6;
    if (tidx() == 0) *(uint4*)(lds_raw + LDS_BYTES - 16) = make_uint4(0u, 0u, 0u, 0u);
    __syncthreads();
    XcdBarrier xbar = xcd_barrier_post((unsigned*)(ws + OFF_BAR), (volatile LAS unsigned*)(lds_raw + LDS_BYTES - 16));

    for (size_t i = (size_t)blockIdx.x * NTHR + tidx(); i < (size_t)NT * ND / 4; i += (size_t)gridDim.x * NTHR) {
        const float4 v = ((const float4*)x)[i];
        uint2 w; w.x = pack2(v.x, v.y); w.y = pack2(v.z, v.w);
        ((uint2*)HB)[i] = w;
    }
    convert_tables(p.in[23], p.in[24], TAB);
    for (int i = blockIdx.x * NTHR + tidx(); i < 2 * 8 * 2 * 128 * 128 / 4; i += gridDim.x * NTHR) {
        const float4 a = ((const float4*)p.in[22])[i];
        uint2 w; w.x = pack2(a.x, a.y); w.y = pack2(a.z, a.w);
        ((uint2*)SKB)[i] = w;
    }
    convert_wt_phase(p.in[1], ND, EVEN_IN, P0W, ColMap{{0, 0, 0}, {0, 0, 0}, {P0W, 0, 0}}, WIN0, lds);
    convert_wt_phase(p.in[1], ND, EVEN_IN, 768, ColMap{{0, 0, 0}, {P0W, 0, 0}, {768, 0, 0}}, WV0, lds);
    convert_wt_phase(p.in[12], ND, ND, ND, ColMap{{0, 0, 0}, {0, 0, 0}, {ND, 0, 0}}, WOUT0, lds);
    convert_wt_phase(p.in[10], 256, 256, 256, ColMap{{0, 0, 0}, {0, 0, 0}, {256, 0, 0}}, WGT, lds);
    convert_wt_phase(p.in[21], ND, 2048, 2048, ColMap{{0, 0, 0}, {0, 0, 0}, {2048, 0, 0}}, WQ0, lds, p.in[25]);
    convert_wt_phase(p.in[21] + (size_t)ND * 2048, ND, 2048, 2048, ColMap{{0, 0, 0}, {0, 0, 0}, {2048, 0, 0}}, WQ1, lds, p.in[25] + ND);
    {
        float* CQ = (float*)(ws + OFF_CQ);
        const int kp = tidx() >> 4, cl16 = tidx() & 15, gcol = blockIdx.x * 16 + cl16;
        if (gcol < 4096) {
            const int layer = gcol >> 11, n = gcol & 2047;
            const float* W = p.in[21] + (size_t)layer * ND * 2048;
            const float* gam = p.in[25] + layer * ND; const float* bet = p.in[26] + layer * ND;
            float c = 0.f, d = 0.f;
            for (int k = kp; k < ND; k += 32) { const float w = W[(size_t)k * 2048 + n]; c += bf2f(f2bf(gam[k] * w)); d += bet[k] * w; }
            c += __shfl_xor(c, 16); d += __shfl_xor(d, 16); c += __shfl_xor(c, 32); d += __shfl_xor(d, 32);
            __syncthreads();
            if ((tidx() & 63) < 16) { lds[(tidx() >> 6) * 32 + cl16] = c; lds[(tidx() >> 6) * 32 + 16 + cl16] = d; }
            __syncthreads();
            if (tidx() < 16) {
                float cs = 0.f, ds = 0.f;
#pragma unroll
                for (int w8 = 0; w8 < 8; ++w8) { cs += lds[w8 * 32 + tidx()]; ds += lds[w8 * 32 + 16 + tidx()]; }
                CQ[layer * 2048 + n] = cs; CQ[4096 + layer * 2048 + n] = ds;
            }
            __syncthreads();
        }
    }
    convert_wt_phase(p.in[13], ND, ODD_IN, ODD_PAD, ColMap{{0, 1792, 2048}, {0, 2048, 2560}, {1792, 256, 48}}, WIN1, lds);
    convert_wt_phase(p.in[13], ND, ODD_IN, 512, ColMap{{0, 256, 0}, {1792, 2304, 0}, {256, 256, 0}}, WV1, lds);
    convert_wt_phase(p.in[20], ND, ND, ND, ColMap{{0, 0, 0}, {0, 0, 0}, {ND, 0, 0}}, WOUT1, lds);
    convert_wt_phase(p.in[15], 2048, 128, 128, ColMap{{0, 0, 0}, {0, 0, 0}, {128, 0, 0}}, W1T, lds);
    convert_wt_phase(p.in[18], 2048, 128, 128, ColMap{{0, 0, 0}, {0, 0, 0}, {128, 0, 0}}, W1T + 128 * 2048, lds);
    convert_wt_phase(p.in[16], 128, 64, 64, ColMap{{0, 0, 0}, {0, 0, 0}, {64, 0, 0}}, W2T, lds);
    convert_wt_phase(p.in[19], 128, 64, 64, ColMap{{0, 0, 0}, {0, 0, 0}, {64, 0, 0}}, W2T + 64 * 128, lds);
    if (blockIdx.x < 32) {
        const int which = blockIdx.x >> 4, j = (blockIdx.x & 15) * 8 + (tidx() >> 6), part = tidx() & 63;
        const float* pe = which ? p.in[17] : p.in[14];
        const float* w1 = which ? p.in[18] : p.in[15];
        float a = 0.f;
#pragma unroll 8
        for (int i = part; i < 2048; i += 64) a += pe[i] * w1[(size_t)i * 128 + j];
        for (int o = 32; o; o >>= 1) a += __shfl_xor(a, o);
        if (part == 0) BIAS1[which * 128 + j] = a;
    }
    xcd_barrier(xbar);
    if (p.pad == 0x5eedull) grid.sync();
    PDUP(0) { PH(0) gemm_bf16_phase(lds_raw, HB, WIN0, NT, P0W, ND, EpiBf16s{PROJ, P0W});
    PH(0) gemm_bf16_phase(lds_raw, WV0, HB, 768, NT, ND, EpiBf16s{VT, NT}, true); }
    xcd_barrier(xbar);
    PDUP(1) { PH(1) s5_scan3_phase(PROJ, p.in[2], p.in[3], p.in[4], p.in[5], p.in[6], p.in[7], p.in[8], p.in[9], YA, lds_raw);
    PH(2) sb_attn2_phase(PROJ, VT, YB, lds_raw);
    if ((PROBE >> 13) & 1) {
        bf16_t* SCR = PROJ + (size_t)NT * P0W;
        s5_scan2_phase(PROJ, p.in[2], p.in[3], p.in[4], p.in[5], p.in[6], p.in[7], p.in[8], p.in[9], SCR, lds);
        xcd_barrier(xbar);
        float d2 = 0.f, n2 = 0.f;
        for (size_t i = (size_t)blockIdx.x * NTHR + tidx(); i < (size_t)NT * 256; i += (size_t)gridDim.x * NTHR) { const float a = bf2f(YA[i]), r = bf2f(SCR[i]); d2 += (a - r) * (a - r); n2 += r * r; }
        for (int o = 32; o; o >>= 1) { d2 += __shfl_xor(d2, o); n2 += __shfl_xor(n2, o); }
        float* chk = (float*)(ws + OFF_BAR + XB_TOTAL_WORDS * 4);
        if ((tidx() & 63) == 0) { atomicAdd(chk, d2); atomicAdd(chk + 1, n2); }
    }
    if (_rep == 0 && ((PROBE >> 1) & 1)) xcd_barrier(xbar); }
    xcd_barrier(xbar);
    PDUP(2) PH(3) glu2_phase(YA, WGT, p.in[11], YB, lds_raw);
    xcd_barrier(xbar);
    PH(4) gemm_bf16_phase(lds_raw, YB, WOUT0, NT, ND, ND, EpiResStats{x, R, ND, ALPHA, HB, (float*)(ws + OFF_PART)});
    xcd_barrier(xbar);
#define PEER_FFN(layer, WQ, last) \
    PH(12) gemm_q_phase(lds_raw, HB, WQ, (const float*)(ws + OFF_PART), (const float*)(ws + OFF_CQ) + (layer) * 2048, (const float*)(ws + OFF_CQ) + 4096 + (layer) * 2048, PROJ); \
    xcd_barrier(xbar); \
    PDUP(4) PH(13) peer_route2_phase(PROJ, SKB + (size_t)(layer) * 8 * 2 * 128 * 128, EIDX, EGATE, lds_raw); \
    xcd_barrier(xbar); \
    if ((PROBE >> 5) & 1) { peer_expert3_phase(R, EIDX, EGATE, TAB, TAB + (size_t)16384 * ND, p.in[27] + (layer) * ND, p.in[28] + (layer) * ND, nullptr, (float*)PROJ, xbar); xcd_barrier(xbar); } \
    PH(14) peer_expert10_phase(R, EIDX, EGATE, TAB, TAB + (size_t)16384 * ND, p.in[27] + (layer) * ND, p.in[28] + (layer) * ND, (last) ? nullptr : HB, xbar, lds, p.in[25] + (layer) * ND, p.in[26] + (layer) * ND); \
    if (!(last)) xcd_barrier(xbar);
    PEER_FFN(0, WQ0, false)
    convert_tables(p.in[23] + (size_t)16384 * ND, p.in[24] + (size_t)16384 * ND, TAB);
    PDUP(0) { PH(6) gemm_bf16_phase(lds_raw, HB, WIN1, NT, ODD_PAD, ND, EpiBf16s{PROJ, ODD_PAD});
    PH(6) gemm_bf16_phase(lds_raw, WV1, HB, 512, NT, ND, EpiBf16s{VT, NT}); }
    xcd_barrier(xbar);
    PDUP(6) PH(7) nsa_compress2_phase(PROJ, W1T, W2T, BIAS1, KCMP, VCMP, lds_raw);
    xcd_barrier(xbar);
    PDUP(7) { PH(8) nsa_cmp2_phase(PROJ, KCMP, VCMP, YB, SEL, lds_raw);
    xcd_barrier(xbar);
    PH(9) nsa_attn_phase(PROJ, VT, SEL, YB, lds_raw);
    if (_rep == 0 && ((PROBE >> 7) & 1)) xcd_barrier(xbar); }
    xcd_barrier(xbar);
    PH(10) gemm_bf16_phase(lds_raw, YB, WOUT1, NT, ND, ND, EpiResStats{R, R, ND, ALPHA, HB, (float*)(ws + OFF_PART)});
    xcd_barrier(xbar);
    PEER_FFN(1, WQ1, true)
    if ((PROBE >> 13) & 1) {
        xcd_barrier(xbar);
        const float* chk = (const float*)(ws + OFF_BAR + XB_TOTAL_WORDS * 4);
        const float d2 = __hip_atomic_load(chk, __ATOMIC_RELAXED, __HIP_MEMORY_SCOPE_AGENT), n2 = __hip_atomic_load(chk + 1, __ATOMIC_RELAXED, __HIP_MEMORY_SCOPE_AGENT);
        if (!(d2 <= 1e-4f * n2)) for (size_t i = (size_t)blockIdx.x * NTHR + tidx(); i < (size_t)NT * ND; i += (size_t)gridDim.x * NTHR) R[i] *= 2.f;
    }
}

}

extern "C" void kernel_launch(void* const* d_in, const int* in_sizes, int n_in, void* d_out, int out_size, void* d_ws, size_t ws_size, hipStream_t stream) {
    static int grid_blocks = 0;
    if (grid_blocks == 0) {
        if (n_in != 29 || out_size != NT * ND || ws_size < WS_NEED) { fprintf(stderr, "kernel_launch: unexpected shapes / workspace (%zu < %zu)\n", ws_size, (size_t)WS_NEED); grid_blocks = -1; return; }
        int dev = 0, cus = 0, per_cu = 0;
        hipGetDevice(&dev);
        hipDeviceGetAttribute(&cus, hipDeviceAttributeMultiprocessorCount, dev);
        hipFuncSetAttribute((const void*)fwd_megakernel, hipFuncAttributeMaxDynamicSharedMemorySize, LDS_BYTES);
        hipOccupancyMaxActiveBlocksPerMultiprocessor(&per_cu, (const void*)fwd_megakernel, NTHR, LDS_BYTES);
        if (per_cu < 1) { fprintf(stderr, "kernel_launch: occupancy query says %d blocks/CU\n", per_cu); grid_blocks = -1; return; }
        grid_blocks = cus;
    }
    if (grid_blocks < 0) return;
    hipMemsetAsync((char*)d_ws + OFF_BAR, 0, XB_TOTAL_WORDS * 4 + 256, stream);
    Params p{};
    for (int i = 0; i < 29; ++i) p.in[i] = (const float*)d_in[i];
    p.out = (float*)d_out; p.ws = (char*)d_ws; p.pad = 0;
    void* args[] = {&p};
    hipError_t e = hipLaunchCooperativeKernel((const void*)fwd_megakernel, dim3(grid_blocks), dim3(NTHR), args, LDS_BYTES, stream);
    if (e != hipSuccess) fprintf(stderr, "cooperative launch failed: %s (grid %d)\n", hipGetErrorString(e), grid_blocks);
}
```

```cpp
#include <hip/hip_runtime.h>
#include <hip/hip_cooperative_groups.h>
#include <math.h>
#include <stdint.h>
#include <cstdio>
#include <type_traits>
namespace cg = cooperative_groups;

__device__ __forceinline__ int tidx() { int t = threadIdx.x; asm volatile("" : "+v"(t)); return t; }
#define XB_TMO      128
#define XB_XCNT(j)  (256  + 64 * (j))
#define XB_XSUB(j)  (1280 + 64 * (j))
#define XB_XGEN(j)  (2304 + 64 * (j))
#define XB_TOP      3328
#define XB_TOPGEN   3392
#define XCD_BAR_WORDS 3456
#define XB_SPIN_CAP (1u << 18)
#define LAS __attribute__((address_space(3)))

__device__ __forceinline__ unsigned xb_ld(unsigned* p)              { return __hip_atomic_load(p, __ATOMIC_RELAXED, __HIP_MEMORY_SCOPE_AGENT); }
__device__ __forceinline__ unsigned xb_add(unsigned* p, unsigned v) { return __hip_atomic_fetch_add(p, v, __ATOMIC_RELAXED, __HIP_MEMORY_SCOPE_AGENT); }
__device__ __forceinline__ unsigned xb_xcc_id() { return (unsigned)__builtin_amdgcn_s_getreg((3 << 11) | 20) & 0xFu; }
#define XB_SPIN(cond, bar) do { unsigned _sp = 0; while (cond) { __builtin_amdgcn_s_sleep(1); \
    if ((++_sp & 255u) == 0u) { if (xb_ld(&(bar)[XB_TMO])) break; if (_sp > XB_SPIN_CAP) { atomicAdd(&(bar)[XB_TMO], 1u); break; } } } } while (0)

struct XcdBarrier {
    unsigned* bar; unsigned x;
    volatile LAS unsigned* st;
};

__device__ __forceinline__ XcdBarrier xcd_barrier_post(unsigned* bar, volatile LAS unsigned* st) {
    XcdBarrier b; b.bar = bar; b.x = xb_xcc_id(); b.st = st;
    if (tidx() == 0) (void)xb_add(&bar[XB_XCNT(b.x)], 1u);
    return b;
}
__device__ __forceinline__ void xcd_barrier_complete(unsigned* bar, unsigned x, unsigned& nloc, unsigned& nx) {
    const unsigned G = gridDim.x * gridDim.y * gridDim.z;
    unsigned sum, cnt, mine, sp = 0u;
    for (;;) {
        sum = 0u; cnt = 0u; mine = 0u;
#pragma unroll
        for (unsigned j = 0; j < 16; ++j) { const unsigned c = xb_ld(&bar[XB_XCNT(j)]); sum += c; cnt += (c > 0u) ? 1u : 0u; mine = (j == x) ? c : mine; }
        if (sum == G) break;
        __builtin_amdgcn_s_sleep(1);
        if ((++sp & 255u) == 0u) { if (xb_ld(&bar[XB_TMO])) break; if (sp > XB_SPIN_CAP) { atomicAdd(&bar[XB_TMO], 1u); break; } }
    }
    nloc = mine > 0u ? mine : 1u; nx = cnt > 0u ? cnt : 1u;
}

__device__ __forceinline__ void xcd_barrier(const XcdBarrier& b) {
    asm volatile("s_waitcnt vmcnt(0)" ::: "memory");
    __syncthreads();
    if (tidx() == 0) {
        unsigned* bar = b.bar;
        __builtin_amdgcn_s_waitcnt(0);
        unsigned nloc = b.st[0], nx = b.st[1];
        if (nloc == 0u) { xcd_barrier_complete(bar, b.x, nloc, nx); b.st[0] = nloc; b.st[1] = nx; }
        const unsigned old = xb_add(&bar[XB_XSUB(b.x)], 1u);
        const unsigned gen = old / nloc;
        if (old + 1u == (gen + 1u) * nloc) {
            __builtin_amdgcn_fence(__ATOMIC_RELEASE, "");
            asm volatile("s_waitcnt vmcnt(0)" ::: "memory");
            const unsigned og = xb_add(&bar[XB_TOP], 1u);
            const unsigned tg = og / nx;
            if (og + 1u == (tg + 1u) * nx) xb_add(&bar[XB_TOPGEN], 1u);
            else XB_SPIN(xb_ld(&bar[XB_TOPGEN]) == tg, bar);
            __builtin_amdgcn_fence(__ATOMIC_ACQUIRE, "");
            xb_add(&bar[XB_XGEN(b.x)], 1u);
            asm volatile("s_waitcnt vmcnt(0)" ::: "memory");
        } else {
            XB_SPIN(xb_ld(&bar[XB_XGEN(b.x)]) == gen, bar);
            __builtin_amdgcn_fence(__ATOMIC_ACQUIRE, "");
            asm volatile("s_waitcnt vmcnt(0)" ::: "memory");
        }
    }
    __syncthreads();
}

#define XB_ALIGN(j) (XCD_BAR_WORDS + 64 * (j))
#define XB_TOTAL_WORDS (XCD_BAR_WORDS + 64 * 16)
__device__ __forceinline__ void xcc_align(const XcdBarrier& b) {
    __syncthreads();
    if (tidx() == 0) {
        const unsigned nloc = b.st[0];
        if (nloc) {
            const unsigned old = xb_add(&b.bar[XB_ALIGN(b.x)], 1u), gen = old / nloc;
            unsigned sp = 0;
            while (xb_ld(&b.bar[XB_ALIGN(b.x)]) < (gen + 1u) * nloc && ++sp < (1u << 16)) __builtin_amdgcn_s_sleep(1);
        }
    }
    __syncthreads();
}
namespace pg8 {
#define PG8_LAS __attribute__((address_space(3)))
typedef unsigned short bf16_t;
typedef short bf16x8 __attribute__((ext_vector_type(8)));
typedef float f32x4 __attribute__((ext_vector_type(4)));
typedef unsigned u32x4 __attribute__((ext_vector_type(4)));
constexpr int BM = 256, BK = 64, HALF = 128, HTB = HALF * BK * 2  , STAGE_BYTES = 8 * HTB, NXCD = 8, WGM = 8;

__host__ __device__ __forceinline__ int lds_byte(int r, int c) { const int st = (r >> 4) * 2 + (c >> 5), rr = r & 15, cc = c & 31, ob = rr * 64 + cc * 2; return st * 1024 + (ob ^ (((ob >> 9) & 1) << 5)); }
__host__ __device__ __forceinline__ void stage_rc(int b, int& R, int& C) { const int st = b / 1024, sb = b % 1024, swz = sb ^ (((sb >> 9) & 1) << 5); R = (st >> 1) * 16 + swz / 64; C = (st & 1) * 32 + (swz % 64) / 2; }
__host__ __device__ __forceinline__ int perm32(int rho) { const int n = rho >> 4, i = rho & 15; return 8 * (i >> 2) + 4 * n + (i & 3); }

struct Unit { int pm, pn; };
struct Gemm { const bf16_t* A; const bf16_t* Bt; int M, N, K; };

struct StaticOrder {
    int nM, nN, nwg, G, c;
    __host__ __device__ void init(int M, int N, int G_, int c_) { nM = M / BM; nN = N / BM; nwg = nM * nN; G = G_; c = c_; }
    __host__ __device__ bool next(int i, Unit& u) const {
        const long L = (long)i * G + c; if (L >= nwg) return false;
        int wgid = (int)L; { const int q = nwg / NXCD, r = nwg % NXCD, xcd = wgid % NXCD, off = wgid / NXCD; wgid = (xcd < r ? xcd * (q + 1) : r * (q + 1) + (xcd - r) * q) + off; }
        const int nig = WGM * nN, gid = wgid / nig, fm = gid * WGM, gsz = (nM - fm) < WGM ? (nM - fm) : WGM;
        u.pm = fm + ((wgid % nig) % gsz); u.pn = (wgid % nig) / gsz; return true;
    }
    __device__ __forceinline__ void a_ready(const Unit&) const {}
    __device__ __forceinline__ void done(const Unit&) const {}
};
__device__ __forceinline__ unsigned cvt_pk_bf16(float lo, float hi) { unsigned r; asm volatile("v_cvt_pk_bf16_f32 %0, %1, %2" : "=v"(r) : "v"(lo), "v"(hi)); return r; }
template <class Epi, class Sched, bool STAMP = false>
__device__ __forceinline__ void gemm_phase(PG8_LAS unsigned char* lds, const Gemm g, const Sched& S, const Epi& E, unsigned long long* stamps) {
    const int tid = tidx(), wid = __builtin_amdgcn_readfirstlane(tid >> 6), lane = tid & 63, wr = wid >> 2, wc = wid & 3, fr = lane & 15, fq = lane >> 4;
    const int K = g.K, nt = K / BK;
    int ts_lo = 0, ts_hi = 0, nts = 0; const unsigned long long rt_entry = STAMP ? (unsigned long long)wall_clock64() : 0ull;
#define PG8_STAMP() do { if (STAMP && wid == 0 && nts < 64) { const unsigned long long _c = (unsigned long long)clock64(); \
        ts_lo = (lane == nts) ? (int)(unsigned)_c : ts_lo; ts_hi = (lane == nts) ? (int)(unsigned)(_c >> 32) : ts_hi; ++nts; } } while (0)
    PG8_STAMP();
    unsigned voffA[2], voffB[2];
#pragma unroll
    for (int i = 0; i < 2; ++i) { int R, C; stage_rc(tid * 16 + i * 8192, R, C); const int Rb = Epi::PERM ? ((R & ~31) + perm32(R & 31)) : R;
        voffA[i] = (unsigned)(R * K + C) * 2u; voffB[i] = (unsigned)(Rb * K + C) * 2u; }
    const size_t kstep = (size_t)(BK * 2);
    const size_t hstep = (size_t)HALF * K * 2;
    const size_t tstep = 2 * hstep;
    const unsigned ldsw = (unsigned)wid * 1024u;
    const int aoff = lds_byte(wr * 64 + fr, fq * 8), boff = lds_byte(wc * 32 + fr, fq * 8);
#define PG8_SA(b, h) (((b) * 2 + (h)) * HTB)
#define PG8_SB(b, h) ((4 + (b) * 2 + (h)) * HTB)
#define PG8_STAGE(bufoff, gbase, voff) do { _Pragma("unroll") for (int _i = 0; _i < 2; ++_i) \
        __builtin_amdgcn_global_load_lds((const unsigned*)((const char*)(gbase) + (voff)[_i]), (PG8_LAS unsigned*)(lds + (bufoff) + ldsw + _i * 8192), 16, 0, 0); } while (0)
#define PG8_LDA(dst, b, h) do { _Pragma("unroll") for (int m = 0; m < 4; ++m) _Pragma("unroll") for (int k = 0; k < 2; ++k) dst[m][k] = *(const PG8_LAS bf16x8*)(lds + PG8_SA(b, h) + aoff + m * 2048 + k * 1024); } while (0)
#define PG8_LDB(dst, b, h) do { _Pragma("unroll") for (int n = 0; n < 2; ++n) _Pragma("unroll") for (int k = 0; k < 2; ++k) dst[n][k] = *(const PG8_LAS bf16x8*)(lds + PG8_SB(b, h) + boff + n * 2048 + k * 1024); } while (0)
#define PG8_MMA(ai, bj, At, Bt) do { __builtin_amdgcn_s_setprio(1); _Pragma("unroll") for (int m = 0; m < 4; ++m) _Pragma("unroll") for (int n = 0; n < 2; ++n) _Pragma("unroll") for (int k = 0; k < 2; ++k) \
        acc[ai][bj][m][n] = __builtin_amdgcn_mfma_f32_16x16x32_bf16(Bt[n][k], At[m][k], acc[ai][bj][m][n], 0, 0, 0); __builtin_amdgcn_s_setprio(0); } while (0)
#define PG8_WAIT_V(n) asm volatile("s_waitcnt vmcnt(" #n ")" ::: "memory")
#define PG8_WAIT_L(n) asm volatile("s_waitcnt lgkmcnt(" #n ")" ::: "memory")
#define PG8_BAR __builtin_amdgcn_s_barrier()
#define PG8_SCHED __builtin_amdgcn_sched_barrier(0)
    Unit cur, nxt; int ui = 0;
    if (!S.next(0, cur)) return;
    f32x4 acc[2][2][4][2];
#pragma unroll
    for (int a = 0; a < 2; ++a)
#pragma unroll
        for (int b = 0; b < 2; ++b)
#pragma unroll
            for (int m = 0; m < 4; ++m)
#pragma unroll
                for (int n = 0; n < 2; ++n) acc[a][b][m][n] = (f32x4){0.f, 0.f, 0.f, 0.f};
    bf16x8 At[4][2], B0[2][2], B1[2][2];
    const char* cA = (const char*)g.A + (size_t)cur.pm * tstep; const char* cB = (const char*)g.Bt + (size_t)cur.pn * tstep;
    S.a_ready(cur);
    PG8_STAGE(PG8_SB(0, 0), cB, voffB); PG8_STAGE(PG8_SA(0, 0), cA, voffA); PG8_STAGE(PG8_SB(0, 1), cB + hstep, voffB); PG8_STAGE(PG8_SA(0, 1), cA + hstep, voffA);
    if (wr == 1) PG8_BAR;
    PG8_WAIT_V(4); PG8_BAR;
    PG8_STAGE(PG8_SB(1, 0), cB + kstep, voffB); PG8_STAGE(PG8_SA(1, 0), cA + kstep, voffA); PG8_STAGE(PG8_SB(1, 1), cB + hstep + kstep, voffB);
    PG8_WAIT_V(6); PG8_BAR;
    PG8_STAMP();
    for (;;) {
        const bool has_next = S.next(ui + 1, nxt);
        const char* nA = has_next ? (const char*)g.A + (size_t)nxt.pm * tstep : cA; const char* nB = has_next ? (const char*)g.Bt + (size_t)nxt.pn * tstep : cB;
        for (int t = 0; t < nt; t += 2) {
            const bool last = (t == nt - 2);
            const char* a1 = cA + (size_t)(t + 1) * kstep;
            const char* a2 = last ? nA : cA + (size_t)(t + 2) * kstep; const char* b2 = last ? nB : cB + (size_t)(t + 2) * kstep;
            const char* a3 = a2 + kstep; const char* b3 = b2 + kstep;
            if (last && has_next) S.a_ready(nxt);
            PG8_LDB(B0, 0, 0); PG8_SCHED; PG8_LDA(At, 0, 0); PG8_STAGE(PG8_SA(1, 1), a1 + hstep, voffA);
            PG8_WAIT_L(8); PG8_BAR; PG8_WAIT_L(0); PG8_MMA(0, 0, At, B0); PG8_BAR; PG8_SCHED;
            PG8_LDB(B1, 0, 1); PG8_STAGE(PG8_SB(0, 0), b2, voffB);
            PG8_BAR; PG8_WAIT_L(0); PG8_MMA(0, 1, At, B1); PG8_BAR;
            PG8_LDA(At, 0, 1); PG8_STAGE(PG8_SA(0, 0), a2, voffA);
            PG8_BAR; PG8_WAIT_L(0); PG8_MMA(1, 0, At, B0); PG8_BAR; PG8_SCHED;
            PG8_STAGE(PG8_SB(0, 1), b2 + hstep, voffB);
            PG8_WAIT_V(6); PG8_BAR; PG8_MMA(1, 1, At, B1); PG8_BAR;
            PG8_LDB(B0, 1, 0); PG8_SCHED; PG8_LDA(At, 1, 0); PG8_STAGE(PG8_SA(0, 1), a2 + hstep, voffA);
            PG8_WAIT_L(8); PG8_BAR; PG8_WAIT_L(0); PG8_MMA(0, 0, At, B0); PG8_BAR; PG8_SCHED;
            PG8_LDB(B1, 1, 1); PG8_STAGE(PG8_SB(1, 0), b3, voffB);
            PG8_BAR; PG8_WAIT_L(0); PG8_MMA(0, 1, At, B1); PG8_BAR;
            PG8_LDA(At, 1, 1); PG8_STAGE(PG8_SA(1, 0), a3, voffA);
            PG8_BAR; PG8_WAIT_L(0); PG8_MMA(1, 0, At, B0); PG8_BAR; PG8_SCHED;
            PG8_STAGE(PG8_SB(1, 1), b3 + hstep, voffB);
            PG8_WAIT_V(6); PG8_BAR; PG8_MMA(1, 1, At, B1); PG8_BAR;
        }
        PG8_STAMP();
        if constexpr (!Epi::AFTER_DRAIN) { E(acc, cur, wr, wc, fr, fq); S.done(cur); }
        PG8_STAMP();
        if (!has_next) break;
#pragma unroll
        for (int a = 0; a < 2; ++a)
#pragma unroll
            for (int b = 0; b < 2; ++b)
#pragma unroll
                for (int m = 0; m < 4; ++m)
#pragma unroll
                    for (int n = 0; n < 2; ++n) acc[a][b][m][n] = (f32x4){0.f, 0.f, 0.f, 0.f};
        cur = nxt; cA = nA; cB = nB; ++ui;
    }
    PG8_WAIT_V(0);
    if (wr == 0) PG8_BAR;
    PG8_BAR;
    if constexpr (Epi::AFTER_DRAIN) { E.fused(acc, cur, wr, wc, fr, fq, lds, wid, lane); S.done(cur); }
    PG8_STAMP();
    if (STAMP && wid == 0) { stamps[lane] = lane < nts ? (((unsigned long long)(unsigned)ts_hi << 32) | (unsigned)ts_lo) : 0ull;
        if (lane == 62) stamps[62] = rt_entry; if (lane == 63) stamps[63] = (unsigned long long)wall_clock64(); }
#undef PG8_STAMP
#undef PG8_SA
#undef PG8_SB
#undef PG8_STAGE
#undef PG8_LDA
#undef PG8_LDB
#undef PG8_MMA
#undef PG8_WAIT_V
#undef PG8_WAIT_L
#undef PG8_BAR
#undef PG8_SCHED
}
}

namespace {
using pg8::bf16_t;
typedef float f32x4 __attribute__((ext_vector_type(4)));
typedef unsigned u32x4 __attribute__((ext_vector_type(4)));

constexpr int NB = 16, NL = 2048, ND = 1024, NT = NB * NL;
constexpr int EVEN_IN = 2560, ODD_IN = 2608, ODD_PAD = 2304;
constexpr float ALPHA = 1.41421356237f;
constexpr float LN_EPS = 1e-5f;
constexpr float U_SCALE = 256.f, V_SCALE = 16.f;
constexpr int NTHR = 512;
constexpr int LDS_BYTES = 163840;
#ifndef PROBE
#define PROBE 0
#endif
#define PDUP(bit) for (int _rep = 0; _rep < ((PROBE >> (bit)) & 1) + 1; ++_rep)
#ifndef PHMASK
#define PHMASK 0xFFFFFFFFu
#endif
#define PH(n) if (PHMASK & (1u << (n)))

__device__ __forceinline__ float bf2f(bf16_t v) { return __uint_as_float((unsigned)v << 16); }
__device__ __forceinline__ bf16_t f2bf(float f) { unsigned u = __float_as_uint(f); u += 0x7FFFu + ((u >> 16) & 1u); return (bf16_t)(u >> 16); }
__device__ __forceinline__ unsigned pack2(float lo, float hi) { return (unsigned)f2bf(lo) | ((unsigned)f2bf(hi) << 16); }
__device__ __forceinline__ void ld8(const bf16_t* p, float* o) {
    const uint4 v = *(const uint4*)p;
    o[0] = __uint_as_float(v.x << 16); o[1] = __uint_as_float(v.x & 0xffff0000u);
    o[2] = __uint_as_float(v.y << 16); o[3] = __uint_as_float(v.y & 0xffff0000u);
    o[4] = __uint_as_float(v.z << 16); o[5] = __uint_as_float(v.z & 0xffff0000u);
    o[6] = __uint_as_float(v.w << 16); o[7] = __uint_as_float(v.w & 0xffff0000u);
}
__device__ __forceinline__ void st8(bf16_t* p, const float* o) {
    uint4 v; v.x = pack2(o[0], o[1]); v.y = pack2(o[2], o[3]); v.z = pack2(o[4], o[5]); v.w = pack2(o[6], o[7]);
    *(uint4*)p = v;
}

struct EpiBf16s {
    static constexpr bool PERM = true, AFTER_DRAIN = false;
    bf16_t* O; int ldc;
    __device__ __forceinline__ void operator()(const f32x4 (&acc)[2][2][4][2], const pg8::Unit& u, int wr, int wc, int fr, int fq) const {
        const int row0 = u.pm * 256 + wr * 64 + fr, col0 = u.pn * 256 + wc * 32 + 8 * fq;
#pragma unroll
        for (int ai = 0; ai < 2; ++ai)
#pragma unroll
            for (int m = 0; m < 4; ++m) { bf16_t* rowp = O + (size_t)(row0 + ai * 128 + m * 16) * ldc + col0;
#pragma unroll
                for (int bj = 0; bj < 2; ++bj) { const f32x4 v0 = acc[ai][bj][m][0], v1 = acc[ai][bj][m][1];
                    u32x4 w; w.x = pg8::cvt_pk_bf16(v0[0], v0[1]); w.y = pg8::cvt_pk_bf16(v0[2], v0[3]); w.z = pg8::cvt_pk_bf16(v1[0], v1[1]); w.w = pg8::cvt_pk_bf16(v1[2], v1[3]);
                    *(u32x4*)(rowp + bj * 128) = w; } }
    }
};
struct EpiRes {
    static constexpr bool PERM = false, AFTER_DRAIN = false;
    float* C; int ldc; float alpha; float* Cout;
    __device__ __forceinline__ void operator()(const f32x4 (&acc)[2][2][4][2], const pg8::Unit& u, int wr, int wc, int fr, int fq) const {
        const int row0 = u.pm * 256 + wr * 64 + fr, col0 = u.pn * 256 + wc * 32 + 4 * fq; const size_t dlt = Cout - C;
#pragma unroll
        for (int ai = 0; ai < 2; ++ai)
#pragma unroll
            for (int m = 0; m < 4; ++m) { float* rowp = C + (size_t)(row0 + ai * 128 + m * 16) * ldc + col0;
#pragma unroll
                for (int bj = 0; bj < 2; ++bj)
#pragma unroll
                    for (int n = 0; n < 2; ++n) { f32x4* cp = (f32x4*)(rowp + bj * 128 + n * 16); *(cp + dlt / 4) = *cp * alpha + acc[ai][bj][m][n]; } }
    }
};

template <bool IN_BF16>
struct EpiResStats {
    static constexpr bool PERM = false, AFTER_DRAIN = false;
    typename std::conditional<IN_BF16, const bf16_t*, const float*>::type Cin; bf16_t* Vb; float* part;
    __device__ __forceinline__ void operator()(const f32x4 (&acc)[2][2][4][2], const pg8::Unit& u, int wr, int wc, int fr, int fq) const {
        const unsigned row0 = (unsigned)(u.pm * 256 + wr * 64 + fr), col0 = (unsigned)(u.pn * 256 + wc * 32 + 4 * fq);
#pragma unroll
        for (int ai = 0; ai < 2; ++ai)
#pragma unroll
            for (int m = 0; m < 4; ++m) {
                const unsigned row = row0 + (unsigned)(ai * 128 + m * 16);
                const unsigned eo = row * (unsigned)ND + col0;
                float s1 = 0.f, s2 = 0.f;
#pragma unroll
                for (int bj = 0; bj < 2; ++bj)
#pragma unroll
                    for (int n = 0; n < 2; ++n) {
                        f32x4 rin;
                        if constexpr (IN_BF16) {
                            const uint2 w = *(const uint2*)(Cin + (eo + (unsigned)(bj * 128 + n * 16)));
                            rin = (f32x4){__uint_as_float(w.x << 16), __uint_as_float(w.x & 0xffff0000u), __uint_as_float(w.y << 16), __uint_as_float(w.y & 0xffff0000u)};
                        } else rin = *(const f32x4*)(Cin + (eo + (unsigned)(bj * 128 + n * 16)));
                        const f32x4 v = rin * ALPHA + acc[ai][bj][m][n];
                        *(uint2*)(Vb + (eo + (unsigned)(bj * 128 + n * 16))) = make_uint2(pg8::cvt_pk_bf16(v[0], v[1]), pg8::cvt_pk_bf16(v[2], v[3]));
                        s1 += (v[0] + v[1]) + (v[2] + v[3]);
                        s2 += (v[0] * v[0] + v[1] * v[1]) + (v[2] * v[2] + v[3] * v[3]);
                    }
                s1 += __shfl_xor(s1, 16); s2 += __shfl_xor(s2, 16);
                s1 += __shfl_xor(s1, 32); s2 += __shfl_xor(s2, 32);
                if (fq == 0) *(float2*)(part + ((((unsigned)u.pn * (unsigned)NT + row) * 4u + (unsigned)wc) * 2u)) = make_float2(s1, s2);
            }
    }
};
struct EpiBf16LN {
    static constexpr bool PERM = true, AFTER_DRAIN = false;
    bf16_t* O; int ldc; const float* csum; const float* dvec; const float2* stats  ; int pm0, pm1, pm2, pm3;
    __device__ __forceinline__ void operator()(const f32x4 (&acc)[2][2][4][2], const pg8::Unit& u, int wr, int wc, int fr, int fq) const {
        const int slot = (u.pm == pm0) ? 0 : ((u.pm == pm1) ? 1 : ((u.pm == pm2) ? 2 : 3));
        const float2* st = stats + slot * 256;
        const int lrow0 = wr * 64 + fr, col0 = u.pn * 256 + wc * 32 + 8 * fq;
        f32x4 cv[2][2], dv[2][2];
#pragma unroll
        for (int bj = 0; bj < 2; ++bj)
#pragma unroll
            for (int n = 0; n < 2; ++n) { cv[bj][n] = *(const f32x4*)(csum + col0 + bj * 128 + 4 * n); dv[bj][n] = *(const f32x4*)(dvec + col0 + bj * 128 + 4 * n); }
#pragma unroll
        for (int ai = 0; ai < 2; ++ai)
#pragma unroll
            for (int m = 0; m < 4; ++m) {
                const int lrow = lrow0 + ai * 128 + m * 16;
                const float2 ms = st[lrow];
                bf16_t* rowp = O + (size_t)(u.pm * 256 + lrow) * ldc + col0;
#pragma unroll
                for (int bj = 0; bj < 2; ++bj) {
                    const f32x4 v0 = (acc[ai][bj][m][0] - cv[bj][0] * ms.x) * ms.y + dv[bj][0], v1 = (acc[ai][bj][m][1] - cv[bj][1] * ms.x) * ms.y + dv[bj][1];
                    u32x4 w; w.x = pg8::cvt_pk_bf16(v0[0], v0[1]); w.y = pg8::cvt_pk_bf16(v0[2], v0[3]); w.z = pg8::cvt_pk_bf16(v1[0], v1[1]); w.w = pg8::cvt_pk_bf16(v1[2], v1[3]);
                    *(u32x4*)(rowp + bj * 128) = w;
                }
            }
    }
};
__device__ __forceinline__ void gemm_q_phase(unsigned char* lds, const bf16_t* Vb, const bf16_t* Wt, const float* __restrict__ part, const float* csum, const float* dvec, bf16_t* Q) {
    pg8::StaticOrder S; S.init(NT, 2048, (int)gridDim.x, (int)blockIdx.x);
    int pms[4] = {-1, -1, -1, -1};
    float2* st = (float2*)(lds + 131072);
    __syncthreads();
#pragma unroll
    for (int i = 0; i < 4; ++i) {
        pg8::Unit u;
        if (S.next(i, u)) {
            bool seen = false;
#pragma unroll
            for (int j = 0; j < 4; ++j) if (j < i && pms[j] == u.pm) seen = true;
            pms[i] = seen ? -2 - i : u.pm;
            if (!seen && tidx() < 256) {
                const int row = u.pm * 256 + tidx();
                float s1 = 0.f, s2 = 0.f;
#pragma unroll
                for (int pn = 0; pn < 4; ++pn) {
                    const float4* pp = (const float4*)(part + ((size_t)pn * NT + row) * 8);
#pragma unroll
                    for (int k = 0; k < 2; ++k) { const float4 a = pp[k]; s1 += a.x; s2 += a.y; s1 += a.z; s2 += a.w; }
                }
                const float mean = s1 * (1.f / ND), var = fmaxf(s2 * (1.f / ND) - mean * mean, 0.f);
                st[i * 256 + tidx()] = make_float2(mean, rsqrtf(var + LN_EPS));
            }
        }
    }
    __syncthreads();
    pg8::Gemm g{Vb, Wt, NT, 2048, ND};
    EpiBf16LN E{Q, 2048, csum, dvec, st, pms[0], pms[1], pms[2], pms[3]};
    pg8::gemm_phase<EpiBf16LN, pg8::StaticOrder, false>((PG8_LAS unsigned char*)lds, g, S, E, nullptr);
    __syncthreads();
}
template <class Epi>
__device__ __forceinline__ void gemm_bf16_phase(unsigned char* lds, const bf16_t* A, const bf16_t* Bt, int M, int N, int K, const Epi& E, bool reverse_ids = false) {
    pg8::Gemm g{A, Bt, M, N, K};
    pg8::StaticOrder S; S.init(M, N, (int)gridDim.x, reverse_ids ? (int)(gridDim.x - 1 - blockIdx.x) : (int)blockIdx.x);
    pg8::gemm_phase<Epi, pg8::StaticOrder, false>((PG8_LAS unsigned char*)lds, g, S, E, nullptr);
    __syncthreads();
}

struct ColMap { int d0[3], s0[3], len[3]; };
__device__ __forceinline__ void convert_wt_phase(const float* __restrict__ W, int K, int N, int Npad, const ColMap cm, bf16_t* __restrict__ Wt, float* lds, const float* __restrict__ rowscale = nullptr) {
    float(*tile)[65] = (float(*)[65])lds;
    const int tid = tidx(), ntn = Npad / 64, ntiles = (K / 64) * ntn;
    for (int it = blockIdx.x; it < ntiles; it += gridDim.x) {
        const int k0 = (it / ntn) * 64, n0 = (it % ntn) * 64;
        __syncthreads();
#pragma unroll
        for (int h = 0; h < 2; ++h) {
            const int r = (tid >> 4) + h * 32, c4 = (tid & 15) * 4, nd = n0 + c4;
            int ns = -1;
#pragma unroll
            for (int sg = 0; sg < 3; ++sg) if (nd >= cm.d0[sg] && nd < cm.d0[sg] + cm.len[sg]) ns = cm.s0[sg] + (nd - cm.d0[sg]);
            float4 v = make_float4(0.f, 0.f, 0.f, 0.f);
            if (ns >= 0) v = *(const float4*)(W + (size_t)(k0 + r) * N + ns);
            if (rowscale) { const float gsc = rowscale[k0 + r]; v.x *= gsc; v.y *= gsc; v.z *= gsc; v.w *= gsc; }
            tile[r][c4] = v.x; tile[r][c4 + 1] = v.y; tile[r][c4 + 2] = v.z; tile[r][c4 + 3] = v.w;
        }
        __syncthreads();
        const int n = tid >> 3, k8 = (tid & 7) * 8;
        float o[8];
#pragma unroll
        for (int j = 0; j < 8; ++j) o[j] = tile[k8 + j][n];
        st8(Wt + (size_t)(n0 + n) * K + k0 + k8, o);
    }
    __syncthreads();
}
__device__ __forceinline__ float gelu_tanh(float x) {
    float u = 0.7978845608028654f * (x + 0.044715f * x * x * x);
    return 0.5f * x * (1.f + tanhf(u));
}
__device__ __forceinline__ float sigmoidf_(float x) { return 1.f / (1.f + expf(-x)); }
__device__ __forceinline__ void wave_lds_fence() { asm volatile("s_waitcnt lgkmcnt(0)" ::: "memory"); }
__device__ __forceinline__ void lds_barrier() { asm volatile("s_waitcnt lgkmcnt(0)" ::: "memory"); __builtin_amdgcn_s_barrier(); asm volatile("" ::: "memory"); }

__device__ __forceinline__ void s5_scan_wave(int bg, const bf16_t* __restrict__ proj, const float* __restrict__ lam_re, const float* __restrict__ lam_im,
                             const float* __restrict__ log_dt, const float* __restrict__ b_re, const float* __restrict__ b_im,
                             const float* __restrict__ c_re, const float* __restrict__ c_im, const float* __restrict__ dskip,
                             float* __restrict__ ya, float* lds) {
    const int b = bg >> 4, g = bg & 15, lane = tidx() & 63;
    float(*us)[16] = (float(*)[16])lds;
    float(*xr)[65] = (float(*)[65])(lds + 1024);
    float(*xi)[65] = (float(*)[65])(lds + 1024 + 4160);
    float(*cr)[64] = (float(*)[64])(lds + 1024 + 8320);
    float(*ci)[64] = (float(*)[64])(lds + 1024 + 8320 + 1024);
    const float lr = lam_re[g * 64 + lane], li = lam_im[g * 64 + lane];
    const float dt = expf(log_dt[g]);
    const float mag = expf(lr * dt);
    const float are = mag * cosf(li * dt), aim = mag * sinf(li * dt);
    const float nr = are - 1.f, den = lr * lr + li * li;
    const float fre = (nr * lr + aim * li) / den, fim = (aim * lr - nr * li) / den;
    float bbr[16], bbi[16];
#pragma unroll
    for (int i = 0; i < 16; ++i) {
        const float br = b_re[(g * 64 + lane) * 16 + i], bi = b_im[(g * 64 + lane) * 16 + i];
        bbr[i] = fre * br - fim * bi; bbi[i] = fre * bi + fim * br;
    }
    for (int idx = lane; idx < 1024; idx += 64) { cr[idx >> 6][idx & 63] = c_re[g * 1024 + idx]; ci[idx >> 6][idx & 63] = c_im[g * 1024 + idx]; }
    float dsk[16];
#pragma unroll
    for (int i = 0; i < 16; ++i) dsk[i] = dskip[g * 16 + i];
    float xre = 0.f, xim = 0.f;
    for (int t0 = 0; t0 < NL; t0 += 64) {
        wave_lds_fence();
        for (int idx = lane; idx < 1024; idx += 64) { const int t = idx >> 4, i = idx & 15; us[t][i] = bf2f(proj[(size_t)(b * NL + t0 + t) * EVEN_IN + g * 16 + i]); }
        wave_lds_fence();
        for (int t = 0; t < 64; ++t) {
            float bur = 0.f, bui = 0.f;
#pragma unroll
            for (int i = 0; i < 16; ++i) { const float u = us[t][i]; bur += bbr[i] * u; bui += bbi[i] * u; }
            const float nre = are * xre - aim * xim + bur, nim = are * xim + aim * xre + bui;
            xre = nre; xim = nim;
            xr[t][lane] = xre; xi[t][lane] = xim;
        }
        wave_lds_fence();
        float y[16];
#pragma unroll
        for (int i = 0; i < 16; ++i) y[i] = 0.f;
        for (int p = 0; p < 64; ++p) {
            const float a = xr[lane][p], bq = xi[lane][p];
#pragma unroll
            for (int i = 0; i < 16; ++i) y[i] += cr[i][p] * a - ci[i][p] * bq;
        }
#pragma unroll
        for (int i = 0; i < 16; ++i) {
            const float v = y[i] + dsk[i] * us[lane][i];
            ya[(size_t)(b * NL + t0 + lane) * 256 + g * 16 + i] = gelu_tanh(v);
        }
    }
}

__device__ __forceinline__ void sb_attn_wave(int task, const bf16_t* __restrict__ proj, bf16_t* __restrict__ Y, float* wl) {
    const int qt = task & 31, h = (task >> 5) % 12, b = task / 384, lane = tidx() & 63;
    const int t = qt * 64 + lane;
    float(*ks)[64] = (float(*)[64])wl;
    float(*vs)[64] = (float(*)[64])(wl + 2048);
    const bf16_t* base = proj + (size_t)b * NL * EVEN_IN;
    float q[64], acc[64];
#pragma unroll
    for (int d = 0; d < 64; d += 8) ld8(base + (size_t)t * EVEN_IN + 256 + h * 64 + d, q + d);
#pragma unroll
    for (int d = 0; d < 64; ++d) acc[d] = 0.f;
    float tail = 0.f;
    for (int c = 2 * qt + 1; c >= 0; --c) {
        wave_lds_fence();
        for (int i = 0; i < 32; ++i) {
            ks[i][lane] = bf2f(base[(size_t)(c * 32 + i) * EVEN_IN + 1024 + h * 64 + lane]);
            vs[i][lane] = bf2f(base[(size_t)(c * 32 + i) * EVEN_IN + 1792 + h * 64 + lane]);
        }
        wave_lds_fence();
        for (int s = 31; s >= 0; --s) {
            const int key = c * 32 + s;
            float z = 0.f;
#pragma unroll
            for (int d = 0; d < 64; ++d) z += q[d] * ks[s][d];
            z *= 0.125f;
            const bool valid = key < t;
            const float sp = fmaxf(z, 0.f) + log1pf(expf(-fabsf(z)));
            const float w = valid ? expf(z - sp + tail) : 0.f;
#pragma unroll
            for (int d = 0; d < 64; ++d) acc[d] += w * vs[s][d];
            if (valid) tail -= sp;
        }
        if (__all(tail < -120.f)) break;
    }
#pragma unroll
    for (int d = 0; d < 64; d += 8) st8(Y + (size_t)(b * NL + t) * ND + 256 + h * 64 + d, acc + d);
}

__device__ __forceinline__ void glu_phase(const float* __restrict__ ya, const float* __restrict__ wglu, const float* __restrict__ bglu, bf16_t* __restrict__ Y, float* lds) {
    const int half = tidx() >> 8, c = tidx() & 255;
    float(*ys)[256] = (float(*)[256])(lds + half * 4096);
    for (int it = blockIdx.x; it < NT / 32; it += gridDim.x) {
        const int t0 = it * 32 + half * 16;
        __syncthreads();
        for (int i = 0; i < 16; ++i) ys[i][c] = ya[(size_t)(t0 + i) * 256 + c];
        __syncthreads();
        float acc[16];
#pragma unroll
        for (int i = 0; i < 16; ++i) acc[i] = 0.f;
        for (int k = 0; k < 256; ++k) {
            const float w = wglu[k * 256 + c];
#pragma unroll
            for (int i = 0; i < 16; ++i) acc[i] += ys[i][k] * w;
        }
        const float bb = bglu[c];
#pragma unroll
        for (int i = 0; i < 16; ++i) Y[(size_t)(t0 + i) * ND + c] = f2bf(ys[i][c] * sigmoidf_(acc[i] + bb));
    }
    __syncthreads();
}

__device__ __forceinline__ void ln_row_wave(float4 (&v)[4], const float* __restrict__ g, const float* __restrict__ bta, float* out, bf16_t* outb, int lane) {
    float s = 0.f;
#pragma unroll
    for (int j = 0; j < 4; ++j) s += v[j].x + v[j].y + v[j].z + v[j].w;
    for (int o = 32; o; o >>= 1) s += __shfl_xor(s, o);
    const float mean = s * (1.f / ND);
    float s2 = 0.f;
#pragma unroll
    for (int j = 0; j < 4; ++j) {
        v[j].x -= mean; v[j].y -= mean; v[j].z -= mean; v[j].w -= mean;
        s2 += v[j].x * v[j].x + v[j].y * v[j].y + v[j].z * v[j].z + v[j].w * v[j].w;
    }
    for (int o = 32; o; o >>= 1) s2 += __shfl_xor(s2, o);
    const float rs = rsqrtf(s2 * (1.f / ND) + LN_EPS);
#pragma unroll
    for (int j = 0; j < 4; ++j) {
        const float4 gg = *(const float4*)(g + j * 256 + lane * 4), bb = *(const float4*)(bta + j * 256 + lane * 4);
        const float4 o = make_float4(v[j].x * rs * gg.x + bb.x, v[j].y * rs * gg.y + bb.y, v[j].z * rs * gg.z + bb.z, v[j].w * rs * gg.w + bb.w);
        *(float4*)(out + j * 256 + lane * 4) = o;
        if (outb) { uint2 w; w.x = pack2(o.x, o.y); w.y = pack2(o.z, o.w); *(uint2*)(outb + j * 256 + lane * 4) = w; }
    }
}
__device__ __forceinline__ void ln_phase(float* R, bf16_t* Hb, const float* __restrict__ g, const float* __restrict__ bta) {
    const int wave = tidx() >> 6, lane = tidx() & 63;
    for (int row = blockIdx.x * 8 + wave; row < NT; row += gridDim.x * 8) {
        float4 v[4];
#pragma unroll
        for (int j = 0; j < 4; ++j) v[j] = *(const float4*)(R + (size_t)row * ND + j * 256 + lane * 4);
        ln_row_wave(v, g, bta, R + (size_t)row * ND, Hb + (size_t)row * ND, lane);
    }
}

__device__ __forceinline__ void wave_argmax(float& bv, int& bi) {
#pragma unroll
    for (int o = 32; o; o >>= 1) {
        const float ov = __shfl_xor(bv, o); const int oi = __shfl_xor(bi, o);
        if (ov > bv || (ov == bv && oi < bi)) { bv = ov; bi = oi; }
    }
}
__device__ __forceinline__ void peer_route_phase(const bf16_t* __restrict__ qbuf, const float* __restrict__ subk, int* __restrict__ eidx, float* __restrict__ egate, float* lds) {
    const int head = tidx() >> 6, lane = tidx() & 63;
    float* qs = lds + head * 256;
    for (int token = blockIdx.x; token < NT; token += gridDim.x) {
        const bf16_t* qp = qbuf + (size_t)token * 2048 + head * 256;
        wave_lds_fence();
        for (int i = 0; i < 4; ++i) qs[lane + 64 * i] = bf2f(qp[lane + 64 * i]);
        wave_lds_fence();
        float myv[2]; int myi[2];
#pragma unroll
        for (int c = 0; c < 2; ++c) {
            float sc[2];
#pragma unroll
            for (int w2 = 0; w2 < 2; ++w2) {
                const float* kr = subk + ((size_t)(head * 2 + c) * 128 + lane + 64 * w2) * 128;
                float a = 0.f;
#pragma unroll 4
                for (int d = 0; d < 128; d += 4) {
                    const float4 kv = *(const float4*)(kr + d);
                    a += qs[c * 128 + d] * kv.x + qs[c * 128 + d + 1] * kv.y + qs[c * 128 + d + 2] * kv.z + qs[c * 128 + d + 3] * kv.w;
                }
                sc[w2] = a;
            }
            float a0 = sc[0], a1 = sc[1];
            float mv = -INFINITY; int mi = 0;
            for (int r = 0; r < 16; ++r) {
                float bv; int bi;
                if (a0 >= a1) { bv = a0; bi = lane; } else { bv = a1; bi = lane + 64; }
                wave_argmax(bv, bi);
                if (lane == r) { mv = bv; mi = bi; }
                if (bi == lane) a0 = -INFINITY; else if (bi == lane + 64) a1 = -INFINITY;
            }
            myv[c] = mv; myi[c] = mi;
        }
        const float va = __shfl(myv[0], lane >> 2);
        float cand[4];
#pragma unroll
        for (int j = 0; j < 4; ++j) cand[j] = va + __shfl(myv[1], (lane & 3) * 4 + j);
        float topv = -INFINITY; int topf = 0;
        for (int r = 0; r < 16; ++r) {
            float bv = cand[0]; int bi = lane * 4;
#pragma unroll
            for (int j = 1; j < 4; ++j) if (cand[j] > bv) { bv = cand[j]; bi = lane * 4 + j; }
            wave_argmax(bv, bi);
            if (lane == r) { topv = bv; topf = bi; }
#pragma unroll
            for (int j = 0; j < 4; ++j) if (bi == lane * 4 + j) cand[j] = -INFINITY;
        }
        const int e1 = __shfl(myi[0], topf >> 4), e2 = __shfl(myi[1], topf & 15);
        const float top0 = __shfl(topv, 0);
        float ex = (lane < 16) ? expf(topv - top0) : 0.f;
        float sum = ex;
        for (int o = 32; o; o >>= 1) sum += __shfl_xor(sum, o);
        if (lane < 16) {
            eidx[(size_t)token * 128 + head * 16 + lane] = e1 * 128 + e2;
            egate[(size_t)token * 128 + head * 16 + lane] = ex / sum;
        }
    }
}

__device__ __forceinline__ void peer_expert_phase(float* R, const int* __restrict__ eidx, const float* __restrict__ egate, const float* __restrict__ utab,
                                  const float* __restrict__ vtab, const float* __restrict__ lg, const float* __restrict__ lb, bf16_t* Hb) {
    const int wave = tidx() >> 6, lane = tidx() & 63;
    for (int token = blockIdx.x * 8 + wave; token < NT; token += gridDim.x * 8) {
        float4 x[4], acc[4];
#pragma unroll
        for (int j = 0; j < 4; ++j) { x[j] = *(const float4*)(R + (size_t)token * ND + j * 256 + lane * 4); acc[j] = make_float4(0.f, 0.f, 0.f, 0.f); }
        for (int e0 = 0; e0 < 128; e0 += 4) {
            float dot[4]; int ex[4]; float gt[4];
#pragma unroll
            for (int k = 0; k < 4; ++k) {
                ex[k] = eidx[(size_t)token * 128 + e0 + k]; gt[k] = egate[(size_t)token * 128 + e0 + k];
                const float* ur = utab + (size_t)ex[k] * ND + lane * 4;
                float a = 0.f;
#pragma unroll
                for (int j = 0; j < 4; ++j) { const float4 u = *(const float4*)(ur + j * 256); a += x[j].x * u.x + x[j].y * u.y + x[j].z * u.z + x[j].w * u.w; }
                dot[k] = a;
            }
#pragma unroll
            for (int k = 0; k < 4; ++k) {
                float a = dot[k];
                for (int o = 32; o; o >>= 1) a += __shfl_xor(a, o);
                const float coef = gt[k] * gelu_tanh(a);
                const float* vr = vtab + (size_t)ex[k] * ND + lane * 4;
#pragma unroll
                for (int j = 0; j < 4; ++j) { const float4 v = *(const float4*)(vr + j * 256); acc[j].x += coef * v.x; acc[j].y += coef * v.y; acc[j].z += coef * v.z; acc[j].w += coef * v.w; }
            }
        }
#pragma unroll
        for (int j = 0; j < 4; ++j) { x[j].x = ALPHA * x[j].x + acc[j].x; x[j].y = ALPHA * x[j].y + acc[j].y; x[j].z = ALPHA * x[j].z + acc[j].z; x[j].w = ALPHA * x[j].w + acc[j].w; }
        ln_row_wave(x, lg, lb, R + (size_t)token * ND, Hb ? Hb + (size_t)token * ND : nullptr, lane);
    }
}


typedef short bf16x8_t __attribute__((ext_vector_type(8)));
__device__ __forceinline__ int f2key(float f) { const int b = __float_as_int(f); return b ^ ((b >> 31) & 0x7fffffff); }
__device__ __forceinline__ float key2f(int k) { return __int_as_float(k ^ ((k >> 31) & 0x7fffffff)); }
#define CE_DESC_I(a, b) do { const int _hi = max(a, b), _lo = min(a, b); a = _hi; b = _lo; } while (0)
template <int N, int K, int J> __device__ __forceinline__ void bstage(int (&v)[N]) {
#pragma unroll
    for (int i = 0; i < N; ++i) {
        const int l = i ^ J;
        if (l > i) { if ((i & K) == 0) CE_DESC_I(v[i], v[l]); else CE_DESC_I(v[l], v[i]); }
    }
}
__device__ __forceinline__ void sort16_desc(int (&v)[16]) {
    bstage<16, 2, 1>(v); bstage<16, 4, 2>(v); bstage<16, 4, 1>(v); bstage<16, 8, 4>(v); bstage<16, 8, 2>(v); bstage<16, 8, 1>(v);
    bstage<16, 16, 8>(v); bstage<16, 16, 4>(v); bstage<16, 16, 2>(v); bstage<16, 16, 1>(v);
}
__device__ __forceinline__ void sort8_desc(int (&v)[8]) {
    bstage<8, 2, 1>(v); bstage<8, 4, 2>(v); bstage<8, 4, 1>(v); bstage<8, 8, 4>(v); bstage<8, 8, 2>(v); bstage<8, 8, 1>(v);
}
__device__ __forceinline__ void bitonic_merge16_desc(int (&v)[16]) {
    bstage<16, 16, 8>(v); bstage<16, 16, 4>(v); bstage<16, 16, 2>(v); bstage<16, 16, 1>(v);
}
__device__ __forceinline__ void xmerge16(int (&v)[16], int off) {
    int m[16];
#pragma unroll
    for (int i = 0; i < 16; ++i) m[i] = max(v[i], __shfl_xor(v[15 - i], off));
    bitonic_merge16_desc(m);
#pragma unroll
    for (int i = 0; i < 16; ++i) v[i] = m[i];
}
__device__ __forceinline__ void opaque16(int (&v)[16]) {
#pragma unroll
    for (int i = 0; i < 16; ++i) asm volatile("" : "+v"(v[i]));
}
__device__ __forceinline__ int lookup16(const int (&arr)[16], int a) {
    int r = arr[0];
#pragma unroll
    for (int i = 1; i < 16; ++i) r = (a == i) ? arr[i] : r;
    return r;
}
__device__ __forceinline__ void peer_route2_phase(const bf16_t* __restrict__ qbuf, const bf16_t* __restrict__ skb, int* __restrict__ eidx, float* __restrict__ egate, unsigned char* lds) {
    if (__builtin_amdgcn_readfirstlane(tidx() >> 6) >= 4) __builtin_amdgcn_s_setprio(1);
    const int tid = tidx(), wave = tid >> 6, lane = tid & 63, fr = lane & 15, fq = lane >> 4;
    for (int chunk = blockIdx.x; chunk < NT / 128; chunk += gridDim.x) {
        const int token = chunk * 128 + wave * 16 + fr;
        int* tl = (int*)(lds + 69632) + (wave * 16 + fr) * 48;
        const int srow = tid >> 4, sch = tid & 15;
        const bf16_t* kg = skb + (size_t)srow * 128 + sch * 8;
        unsigned char* kl = lds + srow * 272 + sch * 16;
        const bf16_t* qg = qbuf + (size_t)token * 2048 + 8 * fq;
        uint4 kr0 = *(const uint4*)(kg), kr1 = *(const uint4*)(kg + 32 * 128), kr2 = *(const uint4*)(kg + 64 * 128), kr3 = *(const uint4*)(kg + 96 * 128);
        bf16x8_t qn0 = *(const bf16x8_t*)(qg), qn1 = *(const bf16x8_t*)(qg + 32), qn2 = *(const bf16x8_t*)(qg + 64), qn3 = *(const bf16x8_t*)(qg + 96);
        __syncthreads();
        *(uint4*)(kl) = kr0; *(uint4*)(kl + 32 * 272) = kr1; *(uint4*)(kl + 64 * 272) = kr2; *(uint4*)(kl + 96 * 272) = kr3;
        lds_barrier();
        for (int h = 0; h < 8; ++h) {
            int K1[16], K2[16];
#pragma unroll
            for (int c = 0; c < 2; ++c) {
                const int step = 2 * h + c;
                const unsigned char* kt_lds = lds + (step & 1) * 34816;
                const bf16x8_t qf0 = qn0, qf1 = qn1, qf2 = qn2, qf3 = qn3;
                {
                    const int sn = step < 15 ? step + 1 : step;
                    const bf16_t* kgn = kg + (size_t)sn * 128 * 128;
                    kr0 = *(const uint4*)(kgn); kr1 = *(const uint4*)(kgn + 32 * 128); kr2 = *(const uint4*)(kgn + 64 * 128); kr3 = *(const uint4*)(kgn + 96 * 128);
                    const bf16_t* qgn = qg + sn * 128;
                    qn0 = *(const bf16x8_t*)(qgn); qn1 = *(const bf16x8_t*)(qgn + 32); qn2 = *(const bf16x8_t*)(qgn + 64); qn3 = *(const bf16x8_t*)(qgn + 96);
                }
                int va[16], vb[16];
#pragma unroll
                for (int n = 0; n < 8; ++n) {
                    f32x4 S = {0.f, 0.f, 0.f, 0.f};
#pragma unroll
                    for (int sI = 0; sI < 4; ++sI) {
                        const bf16x8_t kf = *(const bf16x8_t*)(kt_lds + (16 * n + fr) * 272 + (32 * sI + 8 * fq) * 2);
                        S = __builtin_amdgcn_mfma_f32_16x16x32_bf16(kf, sI == 0 ? qf0 : (sI == 1 ? qf1 : (sI == 2 ? qf2 : qf3)), S, 0, 0, 0);
                    }
#pragma unroll
                    for (int j = 0; j < 4; ++j) {
                        const int key = (f2key(S[j]) & ~127) | (16 * n + 4 * fq + j);
                        if (n < 4) va[n * 4 + j] = key; else vb[(n - 4) * 4 + j] = key;
                    }
                }
                sort16_desc(va); sort16_desc(vb);
                int m[16];
#pragma unroll
                for (int i = 0; i < 16; ++i) m[i] = max(va[i], vb[15 - i]);
                bitonic_merge16_desc(m);
                xmerge16(m, 16); xmerge16(m, 32);
#pragma unroll
                for (int i = 0; i < 16; ++i) { if (c == 0) K1[i] = m[i]; else K2[i] = m[i]; }
                if (fq == 0) {
#pragma unroll
                    for (int i = 0; i < 4; ++i) *(int4*)(tl + c * 16 + 4 * i) = make_int4(m[4 * i], m[4 * i + 1], m[4 * i + 2], m[4 * i + 3]);
                }
                if (step < 15) {
                    unsigned char* kln = kl + ((step + 1) & 1) * 34816;
                    *(uint4*)(kln) = kr0; *(uint4*)(kln + 32 * 272) = kr1; *(uint4*)(kln + 64 * 272) = kr2; *(uint4*)(kln + 96 * 272) = kr3;
                    lds_barrier();
                }
            }
            wave_lds_fence();
            float vaf[4];
#pragma unroll
            for (int k = 0; k < 4; ++k) vaf[k] = key2f(tl[4 * k + fq]);
            int A[16];
#pragma unroll
            for (int b = 0; b < 16; ++b) {
                const bool valid = (fq + 1) * (b + 1) <= 16;
                const int key = (f2key(vaf[0] + key2f(K2[b])) & ~127) | (fq << 5) | b;
                A[b] = valid ? key : INT_MIN;
            }
            int Bq[8];
#pragma unroll
            for (int b = 0; b < 3; ++b) {
                const bool valid = (fq + 5) * (b + 1) <= 16;
                const int key = (f2key(vaf[1] + key2f(K2[b])) & ~127) | (fq << 5) | (16 + b);
                Bq[b] = valid ? key : INT_MIN;
            }
            Bq[3] = (f2key(vaf[2] + key2f(K2[0])) & ~127) | (fq << 5) | 19;
            Bq[4] = (f2key(vaf[3] + key2f(K2[0])) & ~127) | (fq << 5) | 20;
            Bq[5] = INT_MIN; Bq[6] = INT_MIN; Bq[7] = INT_MIN;
            sort8_desc(Bq);
#pragma unroll
            for (int i = 8; i < 16; ++i) A[i] = max(A[i], Bq[15 - i]);
            bitonic_merge16_desc(A);
            xmerge16(A, 16); xmerge16(A, 32);
            if (fq == 0) {
#pragma unroll
                for (int i = 0; i < 4; ++i) *(int4*)(tl + 32 + 4 * i) = make_int4(A[4 * i], A[4 * i + 1], A[4 * i + 2], A[4 * i + 3]);
            }
            wave_lds_fence();
            const int4 myT = *(const int4*)(tl + 32 + 4 * fq);
            const int tsel[4] = {myT.x, myT.y, myT.z, myT.w};
            const float top0 = key2f(A[0]);
            float sum = 0.f;
#pragma unroll
            for (int r = 0; r < 16; ++r) sum += __expf(key2f(A[r]) - top0);
            const float inv = 1.f / sum;
            int eo[4]; float go[4];
#pragma unroll
            for (int kk = 0; kk < 4; ++kk) {
                const int t = tsel[kk];
                const int id = t & 127, ofq = id >> 5, slot = id & 31;
                const int k = slot < 16 ? 0 : (slot < 19 ? 1 : (slot == 19 ? 2 : 3));
                const int b = slot < 16 ? slot : (slot < 19 ? slot - 16 : 0);
                const int a = ofq + 4 * k;
                const int e1 = tl[a] & 127, e2 = tl[16 + b] & 127;
                eo[kk] = e1 * 128 + e2;
                go[kk] = __expf(key2f(t) - top0) * inv;
            }
            *(int4*)(eidx + (size_t)token * 128 + h * 16 + 4 * fq) = make_int4(eo[0], eo[1], eo[2], eo[3]);
            *(float4*)(egate + (size_t)token * 128 + h * 16 + 4 * fq) = make_float4(go[0], go[1], go[2], go[3]);
            wave_lds_fence();
        }
    }
    __syncthreads();
    __builtin_amdgcn_s_setprio(0);
}

typedef __bf16 bf16x2_t __attribute__((ext_vector_type(2)));
typedef float f32x2_t __attribute__((ext_vector_type(2)));
__device__ __forceinline__ float dot2bf(unsigned a, unsigned b, float acc) { return __builtin_amdgcn_fdot2_f32_bf16(__builtin_bit_cast(bf16x2_t, a), __builtin_bit_cast(bf16x2_t, b), acc, false); }
__device__ __forceinline__ float gelu_fast(float x) {
    const float u = 0.7978845608028654f * (x + 0.044715f * x * x * x);
    return x / (1.f + __expf(-2.f * u));
}
__device__ __forceinline__ void peer_expert2_phase(float* R, const int* __restrict__ eidx, const float* __restrict__ egate, const bf16_t* __restrict__ ub,
                                                   const bf16_t* __restrict__ vb, const float* __restrict__ lg, const float* __restrict__ lb, bf16_t* Hb) {
    const int wave = tidx() >> 6, lane = tidx() & 63;
    for (int token = blockIdx.x * 8 + wave; token < NT; token += gridDim.x * 8) {
        float xf[16];
        {
            const float* rp = R + (size_t)token * ND + lane * 8;
            const float4 a0 = *(const float4*)rp, a1 = *(const float4*)(rp + 4), b0 = *(const float4*)(rp + 512), b1 = *(const float4*)(rp + 516);
            xf[0] = a0.x; xf[1] = a0.y; xf[2] = a0.z; xf[3] = a0.w; xf[4] = a1.x; xf[5] = a1.y; xf[6] = a1.z; xf[7] = a1.w;
            xf[8] = b0.x; xf[9] = b0.y; xf[10] = b0.z; xf[11] = b0.w; xf[12] = b1.x; xf[13] = b1.y; xf[14] = b1.z; xf[15] = b1.w;
        }
        unsigned xp[8];
#pragma unroll
        for (int j = 0; j < 8; ++j) xp[j] = pack2(xf[2 * j], xf[2 * j + 1]);
        float acc[16];
#pragma unroll
        for (int j = 0; j < 16; ++j) acc[j] = 0.f;
        const int e_lo = eidx[(size_t)token * 128 + lane], e_hi = eidx[(size_t)token * 128 + 64 + lane];
        const float g_lo = egate[(size_t)token * 128 + lane], g_hi = egate[(size_t)token * 128 + 64 + lane];
        for (int grp = 0; grp < 16; ++grp) {
            const int esel = grp < 8 ? e_lo : e_hi;
            const float gsel = grp < 8 ? g_lo : g_hi;
            const int lbase = (grp & 7) * 8;
            uint4 u0[8], u1[8];
            int exs[8];
#pragma unroll
            for (int k = 0; k < 8; ++k) {
                exs[k] = __builtin_amdgcn_readlane(esel, lbase + k);
                const bf16_t* up = ub + (size_t)exs[k] * ND + lane * 8;
                u0[k] = *(const uint4*)up; u1[k] = *(const uint4*)(up + 512);
            }
            float d[8];
#pragma unroll
            for (int k = 0; k < 8; ++k) {
                float a = dot2bf(u0[k].x, xp[0], 0.f), b = dot2bf(u0[k].y, xp[1], 0.f);
                a = dot2bf(u0[k].z, xp[2], a); b = dot2bf(u0[k].w, xp[3], b);
                a = dot2bf(u1[k].x, xp[4], a); b = dot2bf(u1[k].y, xp[5], b);
                a = dot2bf(u1[k].z, xp[6], a); b = dot2bf(u1[k].w, xp[7], b);
                d[k] = a + b;
            }
            const bool hi5 = lane & 32, hi4 = lane & 16, hi3 = lane & 8;
            float r4[4], r2[2], r1;
#pragma unroll
            for (int k = 0; k < 4; ++k) { const float send = hi5 ? d[k] : d[k + 4], keep = hi5 ? d[k + 4] : d[k]; r4[k] = keep + __shfl_xor(send, 32); }
#pragma unroll
            for (int k = 0; k < 2; ++k) { const float send = hi4 ? r4[k] : r4[k + 2], keep = hi4 ? r4[k + 2] : r4[k]; r2[k] = keep + __shfl_xor(send, 16); }
            { const float send = hi3 ? r2[0] : r2[1], keep = hi3 ? r2[1] : r2[0]; r1 = keep + __shfl_xor(send, 8); }
            r1 += __shfl_xor(r1, 4); r1 += __shfl_xor(r1, 2); r1 += __shfl_xor(r1, 1);
            uint4 v0[8], v1[8];
#pragma unroll
            for (int k = 0; k < 8; ++k) {
                const bf16_t* vp = vb + (size_t)exs[k] * ND + lane * 8;
                v0[k] = *(const uint4*)vp; v1[k] = *(const uint4*)(vp + 512);
            }
            const float gk = __shfl(gsel, lbase + (lane >> 3));
            const float coef = gk * gelu_fast(r1);
#pragma unroll
            for (int k = 0; k < 8; ++k) {
                const float ck = __int_as_float(__builtin_amdgcn_readlane(__float_as_int(coef), 8 * k));
                const unsigned w[8] = {v0[k].x, v0[k].y, v0[k].z, v0[k].w, v1[k].x, v1[k].y, v1[k].z, v1[k].w};
#pragma unroll
                for (int j = 0; j < 8; ++j) {
                    acc[2 * j] += ck * __uint_as_float(w[j] << 16);
                    acc[2 * j + 1] += ck * __uint_as_float(w[j] & 0xffff0000u);
                }
            }
        }
        {
            const float* rp = R + (size_t)token * ND + lane * 8;
            const float4 a0 = *(const float4*)rp, a1 = *(const float4*)(rp + 4), b0 = *(const float4*)(rp + 512), b1 = *(const float4*)(rp + 516);
            xf[0] = a0.x; xf[1] = a0.y; xf[2] = a0.z; xf[3] = a0.w; xf[4] = a1.x; xf[5] = a1.y; xf[6] = a1.z; xf[7] = a1.w;
            xf[8] = b0.x; xf[9] = b0.y; xf[10] = b0.z; xf[11] = b0.w; xf[12] = b1.x; xf[13] = b1.y; xf[14] = b1.z; xf[15] = b1.w;
        }
        float s = 0.f;
#pragma unroll
        for (int j = 0; j < 16; ++j) { xf[j] = ALPHA * xf[j] + acc[j]; s += xf[j]; }
        for (int o = 32; o; o >>= 1) s += __shfl_xor(s, o);
        const float mean = s * (1.f / ND);
        float s2 = 0.f;
#pragma unroll
        for (int j = 0; j < 16; ++j) { xf[j] -= mean; s2 += xf[j] * xf[j]; }
        for (int o = 32; o; o >>= 1) s2 += __shfl_xor(s2, o);
        const float rs = rsqrtf(s2 * (1.f / ND) + LN_EPS);
#pragma unroll
        for (int hf = 0; hf < 2; ++hf) {
            const int c0 = hf * 512 + lane * 8;
            const float4 g0 = *(const float4*)(lg + c0), g1 = *(const float4*)(lg + c0 + 4), b0 = *(const float4*)(lb + c0), b1 = *(const float4*)(lb + c0 + 4);
            float o[8];
            o[0] = xf[hf * 8 + 0] * rs * g0.x + b0.x; o[1] = xf[hf * 8 + 1] * rs * g0.y + b0.y; o[2] = xf[hf * 8 + 2] * rs * g0.z + b0.z; o[3] = xf[hf * 8 + 3] * rs * g0.w + b0.w;
            o[4] = xf[hf * 8 + 4] * rs * g1.x + b1.x; o[5] = xf[hf * 8 + 5] * rs * g1.y + b1.y; o[6] = xf[hf * 8 + 6] * rs * g1.z + b1.z; o[7] = xf[hf * 8 + 7] * rs * g1.w + b1.w;
            float* op = R + (size_t)token * ND + c0;
            *(float4*)op = make_float4(o[0], o[1], o[2], o[3]); *(float4*)(op + 4) = make_float4(o[4], o[5], o[6], o[7]);
            if (Hb) st8(Hb + (size_t)token * ND + c0, o);
        }
    }
}


template <int K2, int J> __device__ __forceinline__ void bsort_round(int (&k)[2], float (&g)[2], int lane) {
    if (J == 64) {
        const bool sw = k[0] > k[1];
        const int t = k[0]; const float tg = g[0];
        k[0] = sw ? k[1] : k[0]; g[0] = sw ? g[1] : g[0]; k[1] = sw ? t : k[1]; g[1] = sw ? tg : g[1];
    } else {
#pragma unroll
        for (int r = 0; r < 2; ++r) {
            const int pk = __shfl_xor(k[r], J); const float pg = __shfl_xor(g[r], J);
            const bool asc = (((lane + 64 * r) & K2) == 0), lower = ((lane & J) == 0);
            const bool take = (lower == asc) ? (pk < k[r]) : (pk > k[r]);
            k[r] = take ? pk : k[r]; g[r] = take ? pg : g[r];
        }
    }
}
template <int K2> __device__ __forceinline__ void bsort_stage(int (&k)[2], float (&g)[2], int lane) {
    if (K2 >= 128) bsort_round<K2, 64>(k, g, lane);
    if (K2 >= 64) bsort_round<K2, 32>(k, g, lane);
    if (K2 >= 32) bsort_round<K2, 16>(k, g, lane);
    if (K2 >= 16) bsort_round<K2, 8>(k, g, lane);
    if (K2 >= 8) bsort_round<K2, 4>(k, g, lane);
    if (K2 >= 4) bsort_round<K2, 2>(k, g, lane);
    bsort_round<K2, 1>(k, g, lane);
}
__device__ __forceinline__ void sort_routing(int& e_lo, int& e_hi, float& g_lo, float& g_hi, int lane) {
    int k[2] = {e_lo, e_hi}; float g[2] = {g_lo, g_hi};
    bsort_stage<2>(k, g, lane); bsort_stage<4>(k, g, lane); bsort_stage<8>(k, g, lane); bsort_stage<16>(k, g, lane);
    bsort_stage<32>(k, g, lane); bsort_stage<64>(k, g, lane); bsort_stage<128>(k, g, lane);
    e_lo = k[0]; e_hi = k[1]; g_lo = g[0]; g_hi = g[1];
}
template <int J> __device__ __forceinline__ unsigned sort_partner(unsigned v, int lane) {
    if constexpr (J == 1) return (unsigned)__builtin_amdgcn_update_dpp(0, (int)v, 0xB1, 0xf, 0xf, false);
    else if constexpr (J == 2) return (unsigned)__builtin_amdgcn_update_dpp(0, (int)v, 0x4E, 0xf, 0xf, false);
    else if constexpr (J == 4) { const int t = __builtin_amdgcn_update_dpp(0, (int)v, 0x141, 0xf, 0xf, false);
                                 return (unsigned)__builtin_amdgcn_update_dpp(0, t, 0x1B, 0xf, 0xf, false); }
    else if constexpr (J == 8) return (unsigned)__builtin_amdgcn_update_dpp(0, (int)v, 0x128, 0xf, 0xf, false);
    else if constexpr (J == 16) { const auto r = __builtin_amdgcn_permlane16_swap(v, v, false, false); return (lane & 16) ? r[0] : r[1]; }
    else { const auto r = __builtin_amdgcn_permlane32_swap(v, v, false, false); return (lane & 32) ? r[0] : r[1]; }
}
template <int K2, int J> __device__ __forceinline__ void psort_round(unsigned (&v)[2], int lane) {
    if constexpr (J == 64) { const unsigned lo = min(v[0], v[1]), hi = max(v[0], v[1]); v[0] = lo; v[1] = hi; }
    else {
#pragma unroll
        for (int r = 0; r < 2; ++r) {
            const unsigned pv = sort_partner<J>(v[r], lane);
            const bool asc = (((lane + 64 * r) & K2) == 0), lower = ((lane & J) == 0);
            const unsigned mn = min(v[r], pv), mx = max(v[r], pv);
            v[r] = (lower == asc) ? mn : mx;
        }
    }
}
template <int K2> __device__ __forceinline__ void psort_stage(unsigned (&v)[2], int lane) {
    if constexpr (K2 >= 128) psort_round<K2, 64>(v, lane);
    if constexpr (K2 >= 64) psort_round<K2, 32>(v, lane);
    if constexpr (K2 >= 32) psort_round<K2, 16>(v, lane);
    if constexpr (K2 >= 16) psort_round<K2, 8>(v, lane);
    if constexpr (K2 >= 8) psort_round<K2, 4>(v, lane);
    if constexpr (K2 >= 4) psort_round<K2, 2>(v, lane);
    psort_round<K2, 1>(v, lane);
}
__device__ __forceinline__ void sort_routing_packed(unsigned& lo, unsigned& hi, int lane) {
    unsigned v[2] = {lo, hi};
    psort_stage<2>(v, lane); psort_stage<4>(v, lane); psort_stage<8>(v, lane); psort_stage<16>(v, lane);
    psort_stage<32>(v, lane); psort_stage<64>(v, lane); psort_stage<128>(v, lane);
    lo = v[0]; hi = v[1];
}
__device__ __forceinline__ void peer_expert3_phase(float* R, const int* __restrict__ eidx, const float* __restrict__ egate, const unsigned char* __restrict__ ub,
                                                   const unsigned char* __restrict__ vb, const float* __restrict__ lg, const float* __restrict__ lb, bf16_t* Hb, float* Rout, const XcdBarrier& xb) {
    const int wave = tidx() >> 6, lane = tidx() & 63;
    int itk = 0;
    for (int token = blockIdx.x * 8 + wave; token < NT; token += gridDim.x * 8, ++itk) {
        if ((itk & 1) == 0 && itk) xcd_barrier(xb);
        float xf[16];
        {
            const float* rp = R + (size_t)token * ND + lane * 16;
#pragma unroll
            for (int q = 0; q < 4; ++q) { const float4 a = *(const float4*)(rp + 4 * q); xf[4 * q] = a.x; xf[4 * q + 1] = a.y; xf[4 * q + 2] = a.z; xf[4 * q + 3] = a.w; }
        }
        float acc[16];
#pragma unroll
        for (int j = 0; j < 16; ++j) acc[j] = 0.f;
        int e_lo = eidx[(size_t)token * 128 + lane], e_hi = eidx[(size_t)token * 128 + 64 + lane];
        float g_lo = egate[(size_t)token * 128 + lane], g_hi = egate[(size_t)token * 128 + 64 + lane];
        sort_routing(e_lo, e_hi, g_lo, g_hi, lane);
        for (int grp = 0; grp < 16; ++grp) {
            const int esel = grp < 8 ? e_lo : e_hi;
            const float gsel = grp < 8 ? g_lo : g_hi;
            const int lbase = (grp & 7) * 8;
            uint4 u[8], v[8];
#pragma unroll
            for (int k = 0; k < 8; ++k) {
                const int ex = __builtin_amdgcn_readlane(esel, lbase + k);
                u[k] = *(const uint4*)(ub + (size_t)ex * ND + lane * 16);
                v[k] = *(const uint4*)(vb + (size_t)ex * ND + lane * 16);
            }
            float d[8];
#pragma unroll
            for (int k = 0; k < 8; ++k) {
                const unsigned w[4] = {u[k].x, u[k].y, u[k].z, u[k].w};
                float a = 0.f, b = 0.f;
#pragma unroll
                for (int q = 0; q < 4; ++q) {
                    const f32x2_t lo = __builtin_amdgcn_cvt_pk_f32_fp8((int)w[q], false), hi = __builtin_amdgcn_cvt_pk_f32_fp8((int)w[q], true);
                    a = fmaf(xf[4 * q], lo.x, a); b = fmaf(xf[4 * q + 1], lo.y, b); a = fmaf(xf[4 * q + 2], hi.x, a); b = fmaf(xf[4 * q + 3], hi.y, b);
                }
                d[k] = a + b;
            }
            const bool hi5 = lane & 32, hi4 = lane & 16, hi3 = lane & 8;
            float r4[4], r2[2], r1;
#pragma unroll
            for (int k = 0; k < 4; ++k) { const float send = hi5 ? d[k] : d[k + 4], keep = hi5 ? d[k + 4] : d[k]; r4[k] = keep + __shfl_xor(send, 32); }
#pragma unroll
            for (int k = 0; k < 2; ++k) { const float send = hi4 ? r4[k] : r4[k + 2], keep = hi4 ? r4[k + 2] : r4[k]; r2[k] = keep + __shfl_xor(send, 16); }
            { const float send = hi3 ? r2[0] : r2[1], keep = hi3 ? r2[1] : r2[0]; r1 = keep + __shfl_xor(send, 8); }
            r1 += __shfl_xor(r1, 4); r1 += __shfl_xor(r1, 2); r1 += __shfl_xor(r1, 1);
            const float gk = __shfl(gsel, lbase + (lane >> 3));
            const float coef = gk * gelu_fast(r1 * (1.f / U_SCALE)) * (1.f / V_SCALE);
#pragma unroll
            for (int k = 0; k < 8; ++k) {
                const float ck = __int_as_float(__builtin_amdgcn_readlane(__float_as_int(coef), 8 * k));
                const unsigned w[4] = {v[k].x, v[k].y, v[k].z, v[k].w};
#pragma unroll
                for (int q = 0; q < 4; ++q) {
                    const f32x2_t lo = __builtin_amdgcn_cvt_pk_f32_fp8((int)w[q], false), hi = __builtin_amdgcn_cvt_pk_f32_fp8((int)w[q], true);
                    acc[4 * q] = fmaf(ck, lo.x, acc[4 * q]); acc[4 * q + 1] = fmaf(ck, lo.y, acc[4 * q + 1]);
                    acc[4 * q + 2] = fmaf(ck, hi.x, acc[4 * q + 2]); acc[4 * q + 3] = fmaf(ck, hi.y, acc[4 * q + 3]);
                }
            }
        }
        float s = 0.f;
#pragma unroll
        for (int j = 0; j < 16; ++j) { xf[j] = ALPHA * xf[j] + acc[j]; s += xf[j]; }
        for (int o = 32; o; o >>= 1) s += __shfl_xor(s, o);
        const float mean = s * (1.f / ND);
        float s2 = 0.f;
#pragma unroll
        for (int j = 0; j < 16; ++j) { xf[j] -= mean; s2 += xf[j] * xf[j]; }
        for (int o = 32; o; o >>= 1) s2 += __shfl_xor(s2, o);
        const float rs = rsqrtf(s2 * (1.f / ND) + LN_EPS);
        float o[16];
#pragma unroll
        for (int q = 0; q < 4; ++q) {
            const float4 gg = *(const float4*)(lg + lane * 16 + 4 * q), bb = *(const float4*)(lb + lane * 16 + 4 * q);
            o[4 * q] = xf[4 * q] * rs * gg.x + bb.x; o[4 * q + 1] = xf[4 * q + 1] * rs * gg.y + bb.y; o[4 * q + 2] = xf[4 * q + 2] * rs * gg.z + bb.z; o[4 * q + 3] = xf[4 * q + 3] * rs * gg.w + bb.w;
            *(float4*)(Rout + (size_t)token * ND + lane * 16 + 4 * q) = make_float4(o[4 * q], o[4 * q + 1], o[4 * q + 2], o[4 * q + 3]);
        }
        if (Hb) { st8(Hb + (size_t)token * ND + lane * 16, o); st8(Hb + (size_t)token * ND + lane * 16 + 8, o + 8); }
    }
}


struct Rows8 { uint4 r[8]; };
__device__ __forceinline__ void rows_load(Rows8& G, int esel, int lbase, const unsigned char* __restrict__ tb, int lane) {
#pragma unroll
    for (int k = 0; k < 8; ++k) {
        const int ex = __builtin_amdgcn_readlane(esel, lbase + k);
        G.r[k] = *(const uint4*)(tb + (size_t)ex * ND + lane * 16);
    }
}
__device__ __forceinline__ void sweep_u(const Rows8& G, const float (&xf)[16], float gsel, int lbase, int lane, float* cl  , int grp) {
    float d[8];
#pragma unroll
    for (int k = 0; k < 8; ++k) {
        const unsigned w[4] = {G.r[k].x, G.r[k].y, G.r[k].z, G.r[k].w};
        f32x2_t a2 = {0.f, 0.f}, b2 = {0.f, 0.f};
#pragma unroll
        for (int q = 0; q < 4; ++q) {
            const f32x2_t lo = __builtin_amdgcn_cvt_pk_f32_fp8((int)w[q], false), hi = __builtin_amdgcn_cvt_pk_f32_fp8((int)w[q], true);
            a2 = __builtin_elementwise_fma((f32x2_t){xf[4 * q], xf[4 * q + 1]}, lo, a2);
            b2 = __builtin_elementwise_fma((f32x2_t){xf[4 * q + 2], xf[4 * q + 3]}, hi, b2);
        }
        d[k] = (a2.x + a2.y) + (b2.x + b2.y);
    }
    const bool hi5 = lane & 32, hi4 = lane & 16, hi3 = lane & 8;
    float r4[4], r2[2], r1;
#pragma unroll
    for (int k = 0; k < 4; ++k) { const float send = hi5 ? d[k] : d[k + 4], keep = hi5 ? d[k + 4] : d[k]; r4[k] = keep + __shfl_xor(send, 32); }
#pragma unroll
    for (int k = 0; k < 2; ++k) { const float send = hi4 ? r4[k] : r4[k + 2], keep = hi4 ? r4[k + 2] : r4[k]; r2[k] = keep + __shfl_xor(send, 16); }
    { const float send = hi3 ? r2[0] : r2[1], keep = hi3 ? r2[1] : r2[0]; r1 = keep + __shfl_xor(send, 8); }
    r1 += __shfl_xor(r1, 4); r1 += __shfl_xor(r1, 2); r1 += __shfl_xor(r1, 1);
    const float gk = __shfl(gsel, lbase + (lane >> 3));
    const float coef = gk * gelu_fast(r1 * (1.f / U_SCALE)) * (1.f / V_SCALE);
    if ((lane & 7) == 0) cl[grp * 8 + (lane >> 3)] = coef;
}
__device__ __forceinline__ void sweep_u8(const Rows8& G, const uint4 xq, unsigned gsel, float sx, int lbase, int lane, float* cl  , int grp) {
    int d[8];
#pragma unroll
    for (int k = 0; k < 8; ++k) {
        int a = __builtin_amdgcn_sdot4((int)G.r[k].x, (int)xq.x, 0, false);
        a = __builtin_amdgcn_sdot4((int)G.r[k].y, (int)xq.y, a, false);
        a = __builtin_amdgcn_sdot4((int)G.r[k].z, (int)xq.z, a, false);
        d[k] = __builtin_amdgcn_sdot4((int)G.r[k].w, (int)xq.w, a, false);
    }
    const bool hi5 = lane & 32, hi4 = lane & 16, hi3 = lane & 8;
    int r4[4], r2[2], r1;
#pragma unroll
    for (int k = 0; k < 4; ++k) { const int send = hi5 ? d[k] : d[k + 4], keep = hi5 ? d[k + 4] : d[k]; r4[k] = keep + __shfl_xor(send, 32); }
#pragma unroll
    for (int k = 0; k < 2; ++k) { const int send = hi4 ? r4[k] : r4[k + 2], keep = hi4 ? r4[k + 2] : r4[k]; r2[k] = keep + __shfl_xor(send, 16); }
    { const int send = hi3 ? r2[0] : r2[1], keep = hi3 ? r2[1] : r2[0]; r1 = keep + __shfl_xor(send, 8); }
    r1 += __shfl_xor(r1, 4); r1 += __shfl_xor(r1, 2); r1 += __shfl_xor(r1, 1);
    const unsigned gp = (unsigned)__shfl((int)gsel, lbase + (lane >> 3));
    const float gk = __uint_as_float(gp << 16), sk = __uint_as_float(gp & 0xffff0000u);
    const float coef = gk * gelu_fast((float)r1 * (sk * sx)) * (1.f / V_SCALE);
    if ((lane & 7) == 0) cl[grp * 8 + (lane >> 3)] = coef;
}
__device__ __forceinline__ void sweep_v(const Rows8& G, float (&acc)[16], const float* cl, int grp) {
#pragma unroll
    for (int k = 0; k < 8; ++k) {
        const float ck = cl[grp * 8 + k];
        const unsigned w[4] = {G.r[k].x, G.r[k].y, G.r[k].z, G.r[k].w};
        const f32x2_t ck2 = {ck, ck};
#pragma unroll
        for (int q = 0; q < 4; ++q) {
            const f32x2_t lo = __builtin_amdgcn_cvt_pk_f32_fp8((int)w[q], false), hi = __builtin_amdgcn_cvt_pk_f32_fp8((int)w[q], true);
            f32x2_t* ap = (f32x2_t*)&acc[4 * q];
            ap[0] = __builtin_elementwise_fma(ck2, lo, ap[0]);
            ap[1] = __builtin_elementwise_fma(ck2, hi, ap[1]);
        }
    }
}
__device__ __forceinline__ void peer_expert6_phase(float* R, const int* __restrict__ eidx, const float* __restrict__ egate, const unsigned char* __restrict__ ub,
                                                   const unsigned char* __restrict__ vb, const float* __restrict__ lg, const float* __restrict__ lb, bf16_t* Hb, const XcdBarrier& xb, float* lds,
                                                   const float* __restrict__ l1g, const float* __restrict__ l1b) {
    const int wave = __builtin_amdgcn_readfirstlane(tidx() >> 6), lane = tidx() & 63;
    float* cl = lds + wave * 128;
    int itk = 0;
    for (int token = blockIdx.x * 8 + wave; token < NT; token += gridDim.x * 8, ++itk) {
        if (itk) xcc_align(xb);
        float xf[16];
        {
            const float* rp = R + (size_t)token * ND + lane * 16;
#pragma unroll
            for (int q = 0; q < 4; ++q) { const float4 a = *(const float4*)(rp + 4 * q); xf[4 * q] = a.x; xf[4 * q + 1] = a.y; xf[4 * q + 2] = a.z; xf[4 * q + 3] = a.w; }
        }
        {
            float s = 0.f;
#pragma unroll
            for (int j = 0; j < 16; ++j) s += xf[j];
            for (int o = 32; o; o >>= 1) s += __shfl_xor(s, o);
            const float mean = s * (1.f / ND);
            float s2 = 0.f;
#pragma unroll
            for (int j = 0; j < 16; ++j) { xf[j] -= mean; s2 += xf[j] * xf[j]; }
            for (int o = 32; o; o >>= 1) s2 += __shfl_xor(s2, o);
            const float rs = rsqrtf(s2 * (1.f / ND) + LN_EPS);
            int lofs1 = lane * 16;
            asm volatile("" : "+v"(lofs1));
#pragma unroll
            for (int q = 0; q < 4; ++q) {
                const float4 gg = *(const float4*)(l1g + lofs1 + 4 * q), bb = *(const float4*)(l1b + lofs1 + 4 * q);
                xf[4 * q] = xf[4 * q] * rs * gg.x + bb.x; xf[4 * q + 1] = xf[4 * q + 1] * rs * gg.y + bb.y; xf[4 * q + 2] = xf[4 * q + 2] * rs * gg.z + bb.z; xf[4 * q + 3] = xf[4 * q + 3] * rs * gg.w + bb.w;
            }
        }
        int e_lo = eidx[(size_t)token * 128 + lane], e_hi = eidx[(size_t)token * 128 + 64 + lane];
        float g_lo = egate[(size_t)token * 128 + lane], g_hi = egate[(size_t)token * 128 + 64 + lane];
        sort_routing(e_lo, e_hi, g_lo, g_hi, lane);
        Rows8 GA, GB;
        wave_lds_fence();
        rows_load(GA, e_lo, 0, ub, lane);
#pragma unroll 1
        for (int gp = 0; gp < 8; ++gp) {
            const int g0i = 2 * gp, g1i = 2 * gp + 1;
            rows_load(GB, g1i < 8 ? e_lo : e_hi, (g1i & 7) * 8, ub, lane);
            __builtin_amdgcn_sched_barrier(0);
            sweep_u(GA, xf, g0i < 8 ? g_lo : g_hi, (g0i & 7) * 8, lane, cl, g0i);
            __builtin_amdgcn_sched_barrier(0);
            rows_load(GA, gp < 7 ? ((g0i + 2) < 8 ? e_lo : e_hi) : e_lo, gp < 7 ? ((g0i + 2) & 7) * 8 : 0, gp < 7 ? ub : vb, lane);
            __builtin_amdgcn_sched_barrier(0);
            sweep_u(GB, xf, g1i < 8 ? g_lo : g_hi, (g1i & 7) * 8, lane, cl, g1i);
            __builtin_amdgcn_sched_barrier(0);
        }
        wave_lds_fence();
        xcc_align(xb);
        float acc[16];
#pragma unroll
        for (int j = 0; j < 16; ++j) acc[j] = 0.f;
#pragma unroll 1
        for (int gp = 0; gp < 8; ++gp) {
            const int g0i = 2 * gp, g1i = 2 * gp + 1;
            rows_load(GB, g1i < 8 ? e_lo : e_hi, (g1i & 7) * 8, vb, lane);
            __builtin_amdgcn_sched_barrier(0);
            sweep_v(GA, acc, cl, g0i);
            __builtin_amdgcn_sched_barrier(0);
            if (gp < 7) rows_load(GA, (g0i + 2) < 8 ? e_lo : e_hi, ((g0i + 2) & 7) * 8, vb, lane);
            __builtin_amdgcn_sched_barrier(0);
            sweep_v(GB, acc, cl, g1i);
            __builtin_amdgcn_sched_barrier(0);
        }
        float s = 0.f;
#pragma unroll
        for (int j = 0; j < 16; ++j) { xf[j] = ALPHA * xf[j] + acc[j]; s += xf[j]; }
        for (int o = 32; o; o >>= 1) s += __shfl_xor(s, o);
        const float mean = s * (1.f / ND);
        float s2 = 0.f;
#pragma unroll
        for (int j = 0; j < 16; ++j) { xf[j] -= mean; s2 += xf[j] * xf[j]; }
        for (int o = 32; o; o >>= 1) s2 += __shfl_xor(s2, o);
        const float rs = rsqrtf(s2 * (1.f / ND) + LN_EPS);
        float o[16];
        int lofs = lane * 16;
        asm volatile("" : "+v"(lofs));
#pragma unroll
        for (int q = 0; q < 4; ++q) {
            const float4 gg = *(const float4*)(lg + lofs + 4 * q), bb = *(const float4*)(lb + lofs + 4 * q);
            o[4 * q] = xf[4 * q] * rs * gg.x + bb.x; o[4 * q + 1] = xf[4 * q + 1] * rs * gg.y + bb.y; o[4 * q + 2] = xf[4 * q + 2] * rs * gg.z + bb.z; o[4 * q + 3] = xf[4 * q + 3] * rs * gg.w + bb.w;
            *(float4*)(R + (size_t)token * ND + lofs + 4 * q) = make_float4(o[4 * q], o[4 * q + 1], o[4 * q + 2], o[4 * q + 3]);
        }
        if (Hb) { st8(Hb + (size_t)token * ND + lofs, o); st8(Hb + (size_t)token * ND + lofs + 8, o + 8); }
    }
}


__device__ __forceinline__ void load_h_row(const bf16_t* Vb, int token, int lane, const float* __restrict__ l1g, const float* __restrict__ l1b, float (&xf)[16]) {
    ld8(Vb + (size_t)token * ND + lane * 16, xf); ld8(Vb + (size_t)token * ND + lane * 16 + 8, xf + 8);
    float s = 0.f;
#pragma unroll
    for (int j = 0; j < 16; ++j) s += xf[j];
    for (int o = 32; o; o >>= 1) s += __shfl_xor(s, o);
    const float mean = s * (1.f / ND);
    float s2 = 0.f;
#pragma unroll
    for (int j = 0; j < 16; ++j) { xf[j] -= mean; s2 += xf[j] * xf[j]; }
    for (int o = 32; o; o >>= 1) s2 += __shfl_xor(s2, o);
    const float rs = rsqrtf(s2 * (1.f / ND) + LN_EPS);
    int lofs1 = lane * 16;
    asm volatile("" : "+v"(lofs1));
#pragma unroll
    for (int q = 0; q < 4; ++q) {
        const float4 gg = *(const float4*)(l1g + lofs1 + 4 * q), bb = *(const float4*)(l1b + lofs1 + 4 * q);
        xf[4 * q] = xf[4 * q] * rs * gg.x + bb.x; xf[4 * q + 1] = xf[4 * q + 1] * rs * gg.y + bb.y; xf[4 * q + 2] = xf[4 * q + 2] * rs * gg.z + bb.z; xf[4 * q + 3] = xf[4 * q + 3] * rs * gg.w + bb.w;
    }
}
__device__ __forceinline__ void finish_row(float* R, bf16_t* Hb, int token, int lane, float (&xf)[16], const float (&acc)[16], const float* __restrict__ lg, const float* __restrict__ lb) {
    float s = 0.f;
#pragma unroll
    for (int j = 0; j < 16; ++j) { xf[j] = ALPHA * xf[j] + acc[j]; s += xf[j]; }
    for (int o = 32; o; o >>= 1) s += __shfl_xor(s, o);
    const float mean = s * (1.f / ND);
    float s2 = 0.f;
#pragma unroll
    for (int j = 0; j < 16; ++j) { xf[j] -= mean; s2 += xf[j] * xf[j]; }
    for (int o = 32; o; o >>= 1) s2 += __shfl_xor(s2, o);
    const float rs = rsqrtf(s2 * (1.f / ND) + LN_EPS);
    float o[16];
    int lofs = lane * 16;
    asm volatile("" : "+v"(lofs));
#pragma unroll
    for (int q = 0; q < 4; ++q) {
        const float4 gg = *(const float4*)(lg + lofs + 4 * q), bb = *(const float4*)(lb + lofs + 4 * q);
        o[4 * q] = xf[4 * q] * rs * gg.x + bb.x; o[4 * q + 1] = xf[4 * q + 1] * rs * gg.y + bb.y; o[4 * q + 2] = xf[4 * q + 2] * rs * gg.z + bb.z; o[4 * q + 3] = xf[4 * q + 3] * rs * gg.w + bb.w;
        if (R) *(float4*)(R + (size_t)token * ND + lofs + 4 * q) = make_float4(o[4 * q], o[4 * q + 1], o[4 * q + 2], o[4 * q + 3]);
    }
    if (Hb) { st8(Hb + (size_t)token * ND + lofs, o); st8(Hb + (size_t)token * ND + lofs + 8, o + 8); }
}
__device__ __forceinline__ void peer_expert10_phase(float* R, const bf16_t* Vin, const int* __restrict__ eidx, const float* __restrict__ egate, const unsigned char* __restrict__ ub,
                                                    const unsigned char* __restrict__ vb, const float* __restrict__ lg, const float* __restrict__ lb, bf16_t* Hb, const XcdBarrier& xb, float* lds,
                                                    const float* __restrict__ l1g, const float* __restrict__ l1b, const float* __restrict__ su) {
    if (__builtin_amdgcn_readfirstlane(tidx() >> 6) >= 4) __builtin_amdgcn_s_setprio(1);
    const int wave = __builtin_amdgcn_readfirstlane(tidx() >> 6), lane = tidx() & 63;
    float* cl = lds + wave * 512;
    float* xs = lds + 4096 + wave * 4096;
    const int stride = gridDim.x * 8;
    int itk = 0;
    for (int tok0 = blockIdx.x * 8 + wave; tok0 < NT; tok0 += 4 * stride, ++itk) {
        if (itk) xcc_align(xb);
        int elo[4], ehi[4]; unsigned glo[4], ghi[4]; float sx[4];
        wave_lds_fence();
#pragma unroll
        for (int t = 0; t < 4; ++t) {
            const int tok = tok0 + t * stride;
            {
                float xr[16]; load_h_row(Vin, tok, lane, l1g, l1b, xr);
                float m = 0.f;
#pragma unroll
                for (int j = 0; j < 16; ++j) m = fmaxf(m, fabsf(xr[j]));
                for (int o = 32; o; o >>= 1) m = fmaxf(m, __shfl_xor(m, o));
                const float inv = m > 0.f ? 127.f / m : 0.f;
                sx[t] = m * (1.f / 127.f);
                uint4 w; unsigned* wp = (unsigned*)&w;
#pragma unroll
                for (int q = 0; q < 4; ++q) {
                    const int b0 = (int)rintf(xr[4 * q] * inv), b1 = (int)rintf(xr[4 * q + 1] * inv), b2 = (int)rintf(xr[4 * q + 2] * inv), b3 = (int)rintf(xr[4 * q + 3] * inv);
                    wp[q] = (unsigned)(b0 & 255) | ((unsigned)(b1 & 255) << 8) | ((unsigned)(b2 & 255) << 16) | ((unsigned)b3 << 24);
                }
                *(uint4*)((unsigned char*)(xs + t * 1024) + lane * 16) = w;
            }
            unsigned p0 = ((unsigned)eidx[(size_t)tok * 128 + lane] << 16) | (unsigned)f2bf(egate[(size_t)tok * 128 + lane]);
            unsigned p1 = ((unsigned)eidx[(size_t)tok * 128 + 64 + lane] << 16) | (unsigned)f2bf(egate[(size_t)tok * 128 + 64 + lane]);
            sort_routing_packed(p0, p1, lane);
            elo[t] = (int)(p0 >> 16); ehi[t] = (int)(p1 >> 16);
            glo[t] = (p0 & 0xffffu) | ((unsigned)f2bf(su[elo[t]]) << 16); ghi[t] = (p1 & 0xffffu) | ((unsigned)f2bf(su[ehi[t]]) << 16);
        }
        Rows8 GA, GB;
        wave_lds_fence();
        rows_load(GA, elo[0], 0, ub, lane);
#pragma unroll 1
        for (int g = 0; g < 16; ++g) {
            const int lb8 = (g & 7) * 8; const bool lo = g < 8;
            rows_load(GB, lo ? elo[1] : ehi[1], lb8, ub, lane);
            __builtin_amdgcn_sched_barrier(0);
            sweep_u8(GA, *(const uint4*)((const unsigned char*)(xs + 0 * 1024) + lane * 16), lo ? glo[0] : ghi[0], sx[0], lb8, lane, cl, g);
            __builtin_amdgcn_sched_barrier(0);
            rows_load(GA, lo ? elo[2] : ehi[2], lb8, ub, lane);
            __builtin_amdgcn_sched_barrier(0);
            sweep_u8(GB, *(const uint4*)((const unsigned char*)(xs + 1 * 1024) + lane * 16), lo ? glo[1] : ghi[1], sx[1], lb8, lane, cl + 128, g);
            __builtin_amdgcn_sched_barrier(0);
            rows_load(GB, lo ? elo[3] : ehi[3], lb8, ub, lane);
            __builtin_amdgcn_sched_barrier(0);
            sweep_u8(GA, *(const uint4*)((const unsigned char*)(xs + 2 * 1024) + lane * 16), lo ? glo[2] : ghi[2], sx[2], lb8, lane, cl + 256, g);
            __builtin_amdgcn_sched_barrier(0);
            if (g < 15) rows_load(GA, (g + 1) < 8 ? elo[0] : ehi[0], ((g + 1) & 7) * 8, ub, lane);
            else rows_load(GA, elo[0], 0, vb, lane);
            __builtin_amdgcn_sched_barrier(0);
            sweep_u8(GB, *(const uint4*)((const unsigned char*)(xs + 3 * 1024) + lane * 16), lo ? glo[3] : ghi[3], sx[3], lb8, lane, cl + 384, g);
            __builtin_amdgcn_sched_barrier(0);
        }
        wave_lds_fence();
        xcc_align(xb);
#pragma unroll
        for (int t = 0; t < 4; ++t)
#pragma unroll
            for (int q = 0; q < 4; ++q) *(float4*)(xs + t * 1024 + q * 256 + lane * 4) = make_float4(0.f, 0.f, 0.f, 0.f);
#pragma unroll 1
        for (int g = 0; g < 16; ++g) {
            const int lb8 = (g & 7) * 8; const bool lo = g < 8;
            rows_load(GB, lo ? elo[1] : ehi[1], lb8, vb, lane);
            __builtin_amdgcn_sched_barrier(0);
            { float av[16];
#pragma unroll
              for (int q = 0; q < 4; ++q) { const float4 v4 = *(const float4*)(xs + 0 * 1024 + q * 256 + lane * 4); av[4 * q] = v4.x; av[4 * q + 1] = v4.y; av[4 * q + 2] = v4.z; av[4 * q + 3] = v4.w; }
              sweep_v(GA, av, cl, g);
#pragma unroll
              for (int q = 0; q < 4; ++q) *(float4*)(xs + 0 * 1024 + q * 256 + lane * 4) = make_float4(av[4 * q], av[4 * q + 1], av[4 * q + 2], av[4 * q + 3]); }
            __builtin_amdgcn_sched_barrier(0);
            rows_load(GA, lo ? elo[2] : ehi[2], lb8, vb, lane);
            __builtin_amdgcn_sched_barrier(0);
            { float av[16];
#pragma unroll
              for (int q = 0; q < 4; ++q) { const float4 v4 = *(const float4*)(xs + 1 * 1024 + q * 256 + lane * 4); av[4 * q] = v4.x; av[4 * q + 1] = v4.y; av[4 * q + 2] = v4.z; av[4 * q + 3] = v4.w; }
              sweep_v(GB, av, cl + 128, g);
#pragma unroll
              for (int q = 0; q < 4; ++q) *(float4*)(xs + 1 * 1024 + q * 256 + lane * 4) = make_float4(av[4 * q], av[4 * q + 1], av[4 * q + 2], av[4 * q + 3]); }
            __builtin_amdgcn_sched_barrier(0);
            rows_load(GB, lo ? elo[3] : ehi[3], lb8, vb, lane);
            __builtin_amdgcn_sched_barrier(0);
            { float av[16];
#pragma unroll
              for (int q = 0; q < 4; ++q) { const float4 v4 = *(const float4*)(xs + 2 * 1024 + q * 256 + lane * 4); av[4 * q] = v4.x; av[4 * q + 1] = v4.y; av[4 * q + 2] = v4.z; av[4 * q + 3] = v4.w; }
              sweep_v(GA, av, cl + 256, g);
#pragma unroll
              for (int q = 0; q < 4; ++q) *(float4*)(xs + 2 * 1024 + q * 256 + lane * 4) = make_float4(av[4 * q], av[4 * q + 1], av[4 * q + 2], av[4 * q + 3]); }
            __builtin_amdgcn_sched_barrier(0);
            if (g < 15) rows_load(GA, (g + 1) < 8 ? elo[0] : ehi[0], ((g + 1) & 7) * 8, vb, lane);
            __builtin_amdgcn_sched_barrier(0);
            { float av[16];
#pragma unroll
              for (int q = 0; q < 4; ++q) { const float4 v4 = *(const float4*)(xs + 3 * 1024 + q * 256 + lane * 4); av[4 * q] = v4.x; av[4 * q + 1] = v4.y; av[4 * q + 2] = v4.z; av[4 * q + 3] = v4.w; }
              sweep_v(GB, av, cl + 384, g);
#pragma unroll
              for (int q = 0; q < 4; ++q) *(float4*)(xs + 3 * 1024 + q * 256 + lane * 4) = make_float4(av[4 * q], av[4 * q + 1], av[4 * q + 2], av[4 * q + 3]); }
            __builtin_amdgcn_sched_barrier(0);
        }
#pragma unroll
        for (int t = 0; t < 4; ++t) {
            const int tok = tok0 + t * stride;
            float xr[16], av[16];
#pragma unroll
            for (int q = 0; q < 4; ++q) { const float4 v4 = *(const float4*)(xs + t * 1024 + q * 256 + lane * 4); av[4 * q] = v4.x; av[4 * q + 1] = v4.y; av[4 * q + 2] = v4.z; av[4 * q + 3] = v4.w; }
            load_h_row(Vin, tok, lane, l1g, l1b, xr);
            finish_row(R, Hb, tok, lane, xr, av, lg, lb);
            __builtin_amdgcn_sched_barrier(0);
        }
    }
    __builtin_amdgcn_s_setprio(0);
}

__device__ __forceinline__ void nsa_compress_phase(const bf16_t* __restrict__ proj, int coloff, const float* __restrict__ pe, const float* __restrict__ w1,
                                   const float* __restrict__ w2, float* __restrict__ outc, float* lds) {
    const int qtr = tidx() >> 7, tid = tidx() & 127;
    float* in = lds + qtr * 2176;
    float* hid = in + 2048;
    for (int it = blockIdx.x; it < NB * 127; it += gridDim.x) {
        const int g = qtr, n = it % 127, b = it / 127;
        __syncthreads();
        for (int idx = tid; idx < 2048; idx += 128) {
            const int l = idx >> 6, d = idx & 63;
            in[idx] = bf2f(proj[(size_t)(b * NL + 16 * n + l) * ODD_PAD + coloff + g * 64 + d]) + pe[l * 64 + d];
        }
        __syncthreads();
        float a = 0.f;
        for (int i = 0; i < 2048; ++i) a += in[i] * w1[(size_t)i * 128 + tid];
        hid[tid] = gelu_tanh(a);
        __syncthreads();
        if (tid < 64) {
            float o = 0.f;
            for (int j = 0; j < 128; ++j) o += hid[j] * w2[j * 64 + tid];
            outc[((size_t)(b * 127 + n) * 4 + g) * 64 + tid] = o;
        }
    }
    __syncthreads();
}

__device__ __forceinline__ void nsa_cmp_phase(const bf16_t* __restrict__ proj, const float* __restrict__ kcmp, const float* __restrict__ vcmp,
                              bf16_t* __restrict__ O, unsigned* __restrict__ selmask, float* lds) {
    const int half = tidx() >> 8, tid = tidx() & 255;
    float* kc_s = lds + half * 18368;
    float* vc_s = kc_s + 127 * 64;
    float(*imp_s)[33] = (float(*)[33])(vc_s + 127 * 64);
    const int tk = tid >> 2, r = tid & 3;
    for (int it = blockIdx.x; it < 32 * 4 * NB / 2; it += gridDim.x) {
        const int vb = it * 2 + half;
        const int tile = vb & 31, g = (vb >> 5) & 3, b = vb >> 7;
        const int t = tile * 64 + tk, hd = g * 4 + r;
        __syncthreads();
        for (int idx = tid; idx < 127 * 64; idx += 256) { const int n = idx >> 6, d = idx & 63; kc_s[idx] = kcmp[((size_t)(b * 127 + n) * 4 + g) * 64 + d]; vc_s[idx] = vcmp[((size_t)(b * 127 + n) * 4 + g) * 64 + d]; }
        const bf16_t* prow = proj + (size_t)(b * NL + t) * ODD_PAD;
        float q[64];
#pragma unroll
        for (int d = 0; d < 64; d += 8) ld8(prow + hd * 64 + d, q + d);
        const float slope = exp2f(-0.5f * (float)(hd + 1));
        int nvalid = (t >= 31) ? ((t - 31) / 16 + 1) : 0;
        if (nvalid > 127) nvalid = 127;
        __syncthreads();
        float m = -INFINITY, l = 0.f;
        for (int n = 0; n < nvalid; ++n) {
            float s = 0.f;
#pragma unroll
            for (int d = 0; d < 64; ++d) s += q[d] * kc_s[n * 64 + d];
            s = s * 0.125f - slope * (float)(t - (16 * n + 31));
            const float mn = fmaxf(m, s);
            l = l * expf(m - mn) + expf(s - mn);
            m = mn;
        }
        const float inv_l = (nvalid > 0) ? 1.f / fmaxf(l, 1e-30f) : 0.f;
        float acc[64];
#pragma unroll
        for (int d = 0; d < 64; ++d) acc[d] = 0.f;
        float prev3 = 0.f;
        for (int j = 0; j < 32; ++j) {
            float pj[4];
#pragma unroll
            for (int nn = 0; nn < 4; ++nn) {
                const int n = 4 * j + nn;
                float p = 0.f;
                if (n < nvalid) {
                    float s = 0.f;
#pragma unroll
                    for (int d = 0; d < 64; ++d) s += q[d] * kc_s[n * 64 + d];
                    s = s * 0.125f - slope * (float)(t - (16 * n + 31));
                    p = expf(s - m) * inv_l;
                    const float* vr = vc_s + n * 64;
#pragma unroll
                    for (int d = 0; d < 64; ++d) acc[d] += p * vr[d];
                }
                pj[nn] = p;
            }
            float im = 0.5f * prev3 + pj[0] + pj[1] + pj[2] + 0.5f * pj[3];
            prev3 = pj[3];
            im += __shfl_xor(im, 1);
            im += __shfl_xor(im, 2);
            if (r == 0) imp_s[tk][j] = im;
        }
        const float g0 = sigmoidf_(bf2f(prow[2048 + hd]));
#pragma unroll
        for (int d = 0; d < 64; ++d) acc[d] *= g0;
#pragma unroll
        for (int d = 0; d < 64; d += 8) st8(O + (size_t)(b * NL + t) * ND + hd * 64 + d, acc + d);
        __syncthreads();
        const int cur = tile;
        unsigned bits = 0;
        for (int jj = 0; jj < 8; ++jj) {
            const int j = r * 8 + jj;
            const bool fj = (j == 0) || (j == cur) || (j == cur - 1);
            const float vj = (j <= cur) ? imp_s[tk][j] + (fj ? 1000.f : 0.f) : -INFINITY;
            int rank = 0;
            for (int k = 0; k < 32; ++k) {
                const bool fk = (k == 0) || (k == cur) || (k == cur - 1);
                const float vk = (k <= cur) ? imp_s[tk][k] + (fk ? 1000.f : 0.f) : -INFINITY;
                rank += (vk > vj || (vk == vj && k < j)) ? 1 : 0;
            }
            if (rank < 16) bits |= 1u << j;
        }
        bits |= __shfl_xor(bits, 1);
        bits |= __shfl_xor(bits, 2);
        if (r == 0) selmask[(size_t)(b * 4 + g) * NL + t] = bits;
    }
    __syncthreads();
}

__device__ __forceinline__ void nsa_selwin_phase(const bf16_t* __restrict__ proj, const unsigned* __restrict__ selmask, bf16_t* O, float* lds) {
    const int half = tidx() >> 8, tid = tidx() & 255;
    float(*k_s)[64] = (float(*)[64])(lds + half * 8192);
    float(*v_s)[64] = (float(*)[64])(lds + half * 8192 + 4096);
    const int tk = tid >> 2, r = tid & 3;
    for (int it = blockIdx.x; it < 32 * 32; it += gridDim.x) {
        const int tile = 31 - (it >> 5);
        const int bgi = (it & 31) * 2 + half, g = bgi & 3, b = bgi >> 2;
        const int t = tile * 64 + tk, hd = g * 4 + r;
        const bf16_t* pb = proj + (size_t)b * NL * ODD_PAD;
        const bf16_t* prow = pb + (size_t)t * ODD_PAD;
        float q[64], acc[64];
#pragma unroll
        for (int d = 0; d < 64; d += 8) ld8(prow + hd * 64 + d, q + d);
        const float slope = exp2f(-0.5f * (float)(hd + 1));
        const unsigned mask = selmask[(size_t)(b * 4 + g) * NL + t];
        bf16_t* orow = O + (size_t)(b * NL + t) * ND + hd * 64;
        for (int branch = 0; branch < 2; ++branch) {
            const int kcol = (branch == 0 ? 1536 : 2048) + g * 64, vcol = kcol + 256;
            const int j0 = (branch == 0) ? 0 : (tile >= 8 ? tile - 8 : 0);
            float m = -1e30f, l = 0.f;
#pragma unroll
            for (int d = 0; d < 64; ++d) acc[d] = 0.f;
            for (int j = j0; j <= tile; ++j) {
                __syncthreads();
                for (int i = 0; i < 16; ++i) {
                    const int idx = tid + 256 * i, key = idx >> 6, d = idx & 63;
                    k_s[key][d] = bf2f(pb[(size_t)(64 * j + key) * ODD_PAD + kcol + d]);
                    v_s[key][d] = bf2f(pb[(size_t)(64 * j + key) * ODD_PAD + vcol + d]);
                }
                __syncthreads();
                const bool take = (branch == 0) ? ((mask >> j) & 1u) : true;
                if (take) {
                    for (int s = 0; s < 64; ++s) {
                        const int dist = t - (64 * j + s);
                        const bool valid = (branch == 0) ? (dist >= 0) : (dist >= 0 && dist < 512);
                        float sc = 0.f;
#pragma unroll
                        for (int d = 0; d < 64; ++d) sc += q[d] * k_s[s][d];
                        sc = sc * 0.125f - slope * (float)dist;
                        const float mn = valid ? fmaxf(m, sc) : m;
                        const float scale = expf(m - mn);
                        const float p = valid ? expf(sc - mn) : 0.f;
                        l = l * scale + p;
#pragma unroll
                        for (int d = 0; d < 64; ++d) acc[d] = acc[d] * scale + p * v_s[s][d];
                        m = mn;
                    }
                }
            }
            const float gt = sigmoidf_(bf2f(prow[2560 + (branch + 1) * 16 + hd]));
            const float f = gt / fmaxf(l, 1e-30f);
#pragma unroll
            for (int d = 0; d < 64; d += 8) {
                float o[8];
                ld8(orow + d, o);
#pragma unroll
                for (int j = 0; j < 8; ++j) o[j] += f * acc[d + j];
                st8(orow + d, o);
            }
        }
    }
    __syncthreads();
}


typedef float f32x16 __attribute__((ext_vector_type(16)));
#define MFMA32(a, b, c) __builtin_amdgcn_mfma_f32_32x32x16_bf16((a), (b), (c), 0, 0, 0)
__device__ __forceinline__ unsigned cvtpk(float lo, float hi) { const f32x2_t f = {lo, hi}; return __builtin_bit_cast(unsigned, __builtin_convertvector(f, bf16x2_t)); }
__device__ __forceinline__ int crow32(int reg, int h) { return (reg & 3) + 8 * (reg >> 2) + 4 * h; }
constexpr float LOG2E = 1.4426950408889634f;
__device__ __forceinline__ void nsa_attn_phase(const bf16_t* __restrict__ proj, const bf16_t* __restrict__ vt, const unsigned* __restrict__ selmask, bf16_t* O, unsigned char* lds) {
    if (__builtin_amdgcn_readfirstlane(tidx() >> 6) >= 4) __builtin_amdgcn_s_setprio(1);
    const int tid = tidx(), wave = __builtin_amdgcn_readfirstlane(tid >> 6), lane = tid & 63, l31 = lane & 31, h = lane >> 5;
    const int r = wave & 3, thalf = wave >> 2;
    const int skey = tid >> 3, spart = tid & 7;
    uint4 kreg = make_uint4(0u, 0u, 0u, 0u), vreg = kreg; bool have_first = false;
    for (int it = blockIdx.x; it < 32 * 64; it += gridDim.x) {
        const int tile = 31 - (it >> 6), bg = it & 63, g = bg & 3, b = bg >> 2;
        const int hd = g * 4 + r, tokoff = thalf * 32 + l31, tok = tile * 64 + tokoff;
        const size_t trow = (size_t)(b * NL + tok);
        const float slope = exp2f(-0.5f * (float)(hd + 1)) * LOG2E;
        bf16x8_t Qf[4];
#pragma unroll
        for (int ds = 0; ds < 4; ++ds) {
            float q[8];
            ld8(proj + trow * ODD_PAD + hd * 64 + 16 * ds + 8 * h, q);
            const float qs = 0.125f * LOG2E;
            u32x4 w; w.x = cvtpk(q[0] * qs, q[1] * qs); w.y = cvtpk(q[2] * qs, q[3] * qs); w.z = cvtpk(q[4] * qs, q[5] * qs); w.w = cvtpk(q[6] * qs, q[7] * qs);
            Qf[ds] = __builtin_bit_cast(bf16x8_t, w);
        }
        float sc[16];
#pragma unroll
        for (int reg = 0; reg < 16; ++reg) sc[reg] = slope * (float)crow32(reg, h);
        const unsigned mymask = selmask[(size_t)(b * 4 + g) * NL + tok];
        unsigned um = selmask[(size_t)(b * 4 + g) * NL + tile * 64 + lane];
        um |= sort_partner<1>(um, lane); um |= sort_partner<2>(um, lane); um |= sort_partner<4>(um, lane); um |= sort_partner<8>(um, lane); um |= sort_partner<16>(um, lane); um |= sort_partner<32>(um, lane);
        const unsigned causal = (tile == 31) ? 0xffffffffu : ((2u << tile) - 1u);
        const unsigned U = (unsigned)__builtin_amdgcn_readfirstlane((int)um) & causal;
        float outv[32];
#pragma unroll
        for (int i = 0; i < 32; ++i) outv[i] = 0.f;
#pragma unroll 1
        for (int branch = 0; branch < 2; ++branch) {
            unsigned todo = (branch == 0) ? U : (causal & ~((1u << (tile >= 8 ? tile - 8 : 0)) - 1u));
            const bf16_t* kbase = proj + (size_t)b * NL * ODD_PAD + (branch == 0 ? 1536 : 1792) + g * 64 + (size_t)skey * ODD_PAD + 8 * spart;
            const bf16_t* vbase = vt + (size_t)(branch * 256 + g * 64 + skey) * NT + (size_t)b * NL + 8 * spart;
            float m_run = -1e30f, l_run = 0.f;
            f32x16 Oa[2];
#pragma unroll
            for (int i = 0; i < 16; ++i) { Oa[0][i] = 0.f; Oa[1][i] = 0.f; }
            int jcur = __ffs(todo) - 1; todo &= todo - 1;
            if (!have_first || jcur != (branch == 0 ? 0 : (tile >= 8 ? tile - 8 : 0))) { kreg = *(const uint4*)(kbase + (size_t)(64 * jcur) * ODD_PAD); vreg = *(const uint4*)(vbase + 64 * jcur); }
            have_first = true;
            int buf = 0;
            __syncthreads();
            *(uint4*)(lds + skey * 144 + spart * 16) = kreg;
            *(uint2*)(lds + 18432 + skey * 136 + spart * 16) = make_uint2(vreg.x, vreg.y);
            *(uint2*)(lds + 18432 + skey * 136 + spart * 16 + 8) = make_uint2(vreg.z, vreg.w);
            __syncthreads();
            for (;;) {
                const int jnext = todo ? (__ffs(todo) - 1) : -1;
                todo &= todo - 1;
                {
                    const int nb = jnext >= 0 ? branch : 1 - branch;
                    const int jl = jnext >= 0 ? jnext : (branch == 0 ? (tile >= 8 ? tile - 8 : 0) : 0);
                    const bf16_t* kb2 = proj + (size_t)b * NL * ODD_PAD + (nb == 0 ? 1536 : 1792) + g * 64 + (size_t)skey * ODD_PAD + 8 * spart;
                    const bf16_t* vb2 = vt + (size_t)(nb * 256 + g * 64 + skey) * NT + (size_t)b * NL + 8 * spart;
                    kreg = *(const uint4*)(kb2 + (size_t)(64 * jl) * ODD_PAD); vreg = *(const uint4*)(vb2 + 64 * jl);
                }
                const unsigned char* Ks = lds + buf * 9216;
                const unsigned char* Vs = lds + 18432 + buf * 8704;
                const bool mysel = (branch == 1) || ((mymask >> jcur) & 1u);
                if (__any(mysel)) {
                    const bool diag = (jcur == tile), wedge = (branch == 1) && (jcur == tile - 8);
                    const float init = mysel ? slope * (float)(64 * (jcur - tile)) : -1e30f;
                    float sv[32];
#pragma unroll
                    for (int kt = 0; kt < 2; ++kt) {
                        f32x16 acc;
                        const float i0 = init + slope * (float)(32 * kt);
#pragma unroll
                        for (int i = 0; i < 16; ++i) acc[i] = sc[i] + i0;
#pragma unroll
                        for (int ds = 0; ds < 4; ++ds) {
                            const bf16x8_t a = *(const bf16x8_t*)(Ks + (32 * kt + l31) * 144 + (16 * ds + 8 * h) * 2);
                            acc = MFMA32(a, Qf[ds], acc);
                        }
#pragma unroll
                        for (int reg = 0; reg < 16; ++reg) sv[kt * 16 + reg] = acc[reg];
                    }
                    if (diag || wedge) {
#pragma unroll
                        for (int i = 0; i < 32; ++i) {
                            const int keyoff = 32 * (i >> 4) + crow32(i & 15, h);
                            const bool ok = diag ? (keyoff <= tokoff) : (keyoff > tokoff);
                            sv[i] = ok ? sv[i] : -1e30f;
                        }
                    }
                    float mx = sv[0];
#pragma unroll
                    for (int i = 1; i < 32; ++i) mx = fmaxf(mx, sv[i]);
                    mx = fmaxf(mx, __shfl_xor(mx, 32));
                    if (!__all(mx < m_run - 160.f)) {
                    const float m_new = fmaxf(m_run, mx), m_use = fmaxf(m_new, -1e29f);
                    const float alpha = __builtin_amdgcn_exp2f(m_run - m_use);
                    const f32x2_t nm = {-m_use, -m_use};
                    f32x2_t ps2 = {0.f, 0.f};
#pragma unroll
                    for (int i = 0; i < 16; ++i) {
                        const f32x2_t t = (f32x2_t){sv[2 * i], sv[2 * i + 1]} + nm;
                        const f32x2_t p2 = {__builtin_amdgcn_exp2f(t.x), __builtin_amdgcn_exp2f(t.y)};
                        sv[2 * i] = p2.x; sv[2 * i + 1] = p2.y; ps2 += p2;
                    }
                    l_run = l_run * alpha + (ps2.x + ps2.y); m_run = m_new;
#pragma unroll
                    for (int i = 0; i < 16; ++i) { Oa[0][i] *= alpha; Oa[1][i] *= alpha; }
                    bf16x8_t Pf[4];
#pragma unroll
                    for (int ks = 0; ks < 4; ++ks) {
                        u32x4 w; w.x = cvtpk(sv[ks * 8 + 0], sv[ks * 8 + 1]); w.y = cvtpk(sv[ks * 8 + 2], sv[ks * 8 + 3]); w.z = cvtpk(sv[ks * 8 + 4], sv[ks * 8 + 5]); w.w = cvtpk(sv[ks * 8 + 6], sv[ks * 8 + 7]);
                        Pf[ks] = __builtin_bit_cast(bf16x8_t, w);
                    }
#pragma unroll
                    for (int mt = 0; mt < 2; ++mt)
#pragma unroll
                        for (int ks = 0; ks < 4; ++ks) {
                            const unsigned char* vp = Vs + (32 * mt + l31) * 136 + (16 * ks + 4 * h) * 2;
                            const uint2 lo = *(const uint2*)vp, hi = *(const uint2*)(vp + 16);
                            u32x4 w; w.x = lo.x; w.y = lo.y; w.z = hi.x; w.w = hi.y;
                            Oa[mt] = MFMA32(__builtin_bit_cast(bf16x8_t, w), Pf[ks], Oa[mt]);
                        }
                    }
                }
                if (jnext < 0) break;
                *(uint4*)(lds + (buf ^ 1) * 9216 + skey * 144 + spart * 16) = kreg;
                *(uint2*)(lds + 18432 + (buf ^ 1) * 8704 + skey * 136 + spart * 16) = make_uint2(vreg.x, vreg.y);
                *(uint2*)(lds + 18432 + (buf ^ 1) * 8704 + skey * 136 + spart * 16 + 8) = make_uint2(vreg.z, vreg.w);
                __syncthreads();
                buf ^= 1; jcur = jnext;
            }
            const float l_tot = l_run + __shfl_xor(l_run, 32);
            const float gt = sigmoidf_(bf2f(proj[trow * ODD_PAD + 2048 + (branch + 1) * 16 + hd]));
            const float f = gt / fmaxf(l_tot, 1e-30f);
#pragma unroll
            for (int i = 0; i < 16; ++i) { outv[i] += f * Oa[0][i]; outv[16 + i] += f * Oa[1][i]; }
        }
        bf16_t* orow = O + trow * ND + hd * 64;
#pragma unroll
        for (int mt = 0; mt < 2; ++mt)
#pragma unroll
            for (int q4 = 0; q4 < 4; ++q4) {
                bf16_t* op = orow + 32 * mt + 8 * q4 + 4 * h;
                const uint2 old = *(const uint2*)op;
                const float o0 = __uint_as_float(old.x << 16) + outv[mt * 16 + q4 * 4 + 0], o1 = __uint_as_float(old.x & 0xffff0000u) + outv[mt * 16 + q4 * 4 + 1];
                const float o2 = __uint_as_float(old.y << 16) + outv[mt * 16 + q4 * 4 + 2], o3 = __uint_as_float(old.y & 0xffff0000u) + outv[mt * 16 + q4 * 4 + 3];
                *(uint2*)op = make_uint2(cvtpk(o0, o1), cvtpk(o2, o3));
            }
    }
    __syncthreads();
    __builtin_amdgcn_s_setprio(0);
}


__device__ __forceinline__ void nsa_compress2_phase(const bf16_t* __restrict__ proj, const bf16_t* __restrict__ w1t  , const bf16_t* __restrict__ w2t  ,
                                                    const float* __restrict__ bias1  , bf16_t* __restrict__ kcmp  , bf16_t* __restrict__ vcmpT  ,
                                                    unsigned char* lds) {
    const int tid = tidx(), wave = __builtin_amdgcn_readfirstlane(tid >> 6), lane = tid & 63, fr = lane & 15, fq = lane >> 4;
    unsigned char* xs = lds;
    unsigned char* hs = lds + 133120;
    for (int it = blockIdx.x; it < 256; it += gridDim.x) {
        const int which = it >> 7, nt2 = it & 1, g = (it >> 1) & 3, b = (it >> 3) & 15;
        const int t0 = 1024 * nt2, coloff = (which ? 1280 : 1024) + g * 64;
        __syncthreads();
        for (int pc = tid; pc < 1040 * 8; pc += NTHR) {
            const int tk = pc >> 3, c = pc & 7;
            int tsrc = t0 + tk; tsrc = tsrc > NL - 1 ? NL - 1 : tsrc;
            *(uint4*)(xs + tk * 128 + ((c ^ ((tk >> 4) & 7)) << 4)) = *(const uint4*)(proj + (size_t)(b * NL + tsrc) * ODD_PAD + coloff + 8 * c);
        }
        __syncthreads();
        f32x4 acc[4];
#pragma unroll
        for (int mt = 0; mt < 4; ++mt) acc[mt] = (f32x4){0.f, 0.f, 0.f, 0.f};
        const bf16_t* wrow = w1t + ((size_t)which * 128 + 16 * wave + fr) * 2048 + 8 * fq;
#pragma unroll 4
        for (int ks = 0; ks < 64; ++ks) {
            const int l = ks >> 1, c = 4 * (ks & 1) + fq;
            const bf16x8_t bfrag = *(const bf16x8_t*)(wrow + 32 * ks);
#pragma unroll
            for (int mt = 0; mt < 4; ++mt) {
                const int tk = 16 * (16 * mt + fr) + l;
                const bf16x8_t a = *(const bf16x8_t*)(xs + tk * 128 + ((c ^ ((tk >> 4) & 7)) << 4));
                acc[mt] = __builtin_amdgcn_mfma_f32_16x16x32_bf16(a, bfrag, acc[mt], 0, 0, 0);
            }
        }
        {
            const float bj = bias1[which * 128 + 16 * wave + fr];
#pragma unroll
            for (int mt = 0; mt < 4; ++mt)
#pragma unroll
                for (int reg = 0; reg < 4; ++reg) *(bf16_t*)(hs + (16 * mt + 4 * fq + reg) * 272 + (16 * wave + fr) * 2) = f2bf(gelu_fast(acc[mt][reg] + bj));
        }
        __syncthreads();
        {
            const int mt = wave >> 1;
#pragma unroll
            for (int ci = 0; ci < 2; ++ci) {
                const int ct = 2 * (wave & 1) + ci;
                f32x4 o = {0.f, 0.f, 0.f, 0.f};
#pragma unroll
                for (int ks = 0; ks < 4; ++ks) {
                    const bf16x8_t a = *(const bf16x8_t*)(hs + (16 * mt + fr) * 272 + (32 * ks + 8 * fq) * 2);
                    const bf16x8_t bfrag = *(const bf16x8_t*)(w2t + ((size_t)which * 64 + 16 * ct + fr) * 128 + 32 * ks + 8 * fq);
                    o = __builtin_amdgcn_mfma_f32_16x16x32_bf16(a, bfrag, o, 0, 0, 0);
                }
                const int c = 16 * ct + fr;
#pragma unroll
                for (int reg = 0; reg < 4; ++reg) {
                    const int n = 64 * nt2 + 16 * mt + 4 * fq + reg;
                    const bf16_t val = (n < 127) ? f2bf(o[reg]) : (bf16_t)0;
                    if (which == 0) kcmp[((size_t)(b * 4 + g) * 128 + n) * 64 + c] = val;
                    else vcmpT[(((size_t)(b * 4 + g) * 8 + (n >> 4)) * 64 + c) * 16 + (n & 15)] = val;
                }
            }
        }
    }
    __syncthreads();
}

__device__ __forceinline__ void nsa_cmp2_phase(const bf16_t* __restrict__ proj, const bf16_t* __restrict__ kcmp, const bf16_t* __restrict__ vcmpT,
                                               bf16_t* __restrict__ O, unsigned* __restrict__ selmask, unsigned char* lds) {
    if (__builtin_amdgcn_readfirstlane(tidx() >> 6) >= 4) __builtin_amdgcn_s_setprio(1);
    const int tid = tidx(), wave = __builtin_amdgcn_readfirstlane(tid >> 6), lane = tid & 63, l31 = lane & 31, h = lane >> 5;
    const int r = wave & 3, thalf = wave >> 2;
    unsigned char* Kc = lds;
    unsigned char* Vc = lds + 18432;
    float* impS = (float*)(lds + 35328);
    float* invS = (float*)(lds + 35328 + 33792);
    float* impT = (float*)(lds + 35328 + 33792 + 1024);
    int staged_bg = -1;
    for (int it = blockIdx.x; it < 32 * 64; it += gridDim.x) {
        const int tile = 31 - (it >> 6), bg = it & 63, g = bg & 3, b = bg >> 2;
        const int hd = g * 4 + r, tokoff = thalf * 32 + l31, tok = tile * 64 + tokoff;
        const size_t trow = (size_t)(b * NL + tok);
        const float slope = exp2f(-0.5f * (float)(hd + 1));
        __syncthreads();
        if (bg != staged_bg) {
        staged_bg = bg;
#pragma unroll
        for (int i = 0; i < 2; ++i) {
            const int pc = tid + 512 * i;
            { const int row = pc >> 3, c = pc & 7; *(uint4*)(Kc + row * 144 + c * 16) = *(const uint4*)(kcmp + ((size_t)(b * 4 + g) * 128 + row) * 64 + 8 * c); }
            { const int row = pc >> 4, c = pc & 15; const uint4 v = *(const uint4*)(vcmpT + (((size_t)(b * 4 + g) * 8 + (c >> 1)) * 64 + row) * 16 + (c & 1) * 8);
              *(uint2*)(Vc + row * 264 + c * 16) = make_uint2(v.x, v.y); *(uint2*)(Vc + row * 264 + c * 16 + 8) = make_uint2(v.z, v.w); }
        }
        }
        bf16x8_t Qf[4];
#pragma unroll
        for (int ds = 0; ds < 4; ++ds) {
            float q[8];
            ld8(proj + trow * ODD_PAD + hd * 64 + 16 * ds + 8 * h, q);
            u32x4 w; w.x = cvtpk(q[0] * 0.125f, q[1] * 0.125f); w.y = cvtpk(q[2] * 0.125f, q[3] * 0.125f); w.z = cvtpk(q[4] * 0.125f, q[5] * 0.125f); w.w = cvtpk(q[6] * 0.125f, q[7] * 0.125f);
            Qf[ds] = __builtin_bit_cast(bf16x8_t, w);
        }
        int nvalid = (tok >= 31) ? ((tok - 31) / 16 + 1) : 0;
        nvalid = nvalid > 127 ? 127 : nvalid;
        const int nv_max = (4 * tile + 3) > 127 ? 127 : (4 * tile + 3);
        const int kt_end = (nv_max + 31) >> 5;
        __syncthreads();
        float mx = -1e30f;
#pragma unroll 2
        for (int kt = 0; kt < kt_end; ++kt) {
            f32x16 acc;
            const float i0 = slope * (float)(512 * kt);
#pragma unroll
            for (int i = 0; i < 16; ++i) acc[i] = i0;
#pragma unroll
            for (int ds = 0; ds < 4; ++ds) {
                const bf16x8_t a = *(const bf16x8_t*)(Kc + (32 * kt + l31) * 144 + (16 * ds + 8 * h) * 2);
                acc = MFMA32(a, Qf[ds], acc);
            }
#pragma unroll
            for (int reg = 0; reg < 16; ++reg) {
                const int n = 32 * kt + crow32(reg, h);
                const float sval = acc[reg] + slope * (float)(16 * crow32(reg, h));
                mx = fmaxf(mx, (n < nvalid) ? sval : -1e30f);
            }
        }
        mx = fmaxf(mx, __shfl_xor(mx, 32));
        const float moff = -fmaxf(mx, -1e29f) * LOG2E;
        float psum = 0.f, prev_pe = 0.f;
        f32x16 Oa[2];
#pragma unroll
        for (int i = 0; i < 16; ++i) { Oa[0][i] = 0.f; Oa[1][i] = 0.f; }
#pragma unroll 2
        for (int kt = 0; kt < kt_end; ++kt) {
            f32x16 acc;
            const float i0 = slope * (float)(512 * kt);
#pragma unroll
            for (int i = 0; i < 16; ++i) acc[i] = i0;
#pragma unroll
            for (int ds = 0; ds < 4; ++ds) {
                const bf16x8_t a = *(const bf16x8_t*)(Kc + (32 * kt + l31) * 144 + (16 * ds + 8 * h) * 2);
                acc = MFMA32(a, Qf[ds], acc);
            }
            float sv[16];
#pragma unroll
            for (int reg = 0; reg < 16; ++reg) {
                const int n = 32 * kt + crow32(reg, h);
                const float sval = acc[reg] + slope * (float)(16 * crow32(reg, h));
                sv[reg] = __builtin_amdgcn_exp2f(fmaf((n < nvalid) ? sval : -1e30f, LOG2E, moff));
                psum += sv[reg];
            }
#pragma unroll
            for (int q = 0; q < 4; ++q) {
                const float e = 0.5f * sv[q * 4 + 3];
                const float own = sv[q * 4] + sv[q * 4 + 1] + sv[q * 4 + 2] + e;
                const float pe = __shfl_xor(e, 32);
                impS[(r * 64 + tokoff) * 33 + 8 * kt + 2 * q + h] = own + (h ? pe : prev_pe);
                prev_pe = pe;
            }
#pragma unroll
            for (int s2 = 0; s2 < 2; ++s2) {
                u32x4 w; w.x = cvtpk(sv[s2 * 8 + 0], sv[s2 * 8 + 1]); w.y = cvtpk(sv[s2 * 8 + 2], sv[s2 * 8 + 3]); w.z = cvtpk(sv[s2 * 8 + 4], sv[s2 * 8 + 5]); w.w = cvtpk(sv[s2 * 8 + 6], sv[s2 * 8 + 7]);
                const bf16x8_t pf = __builtin_bit_cast(bf16x8_t, w);
#pragma unroll
                for (int mt = 0; mt < 2; ++mt) {
                    const unsigned char* vp = Vc + (32 * mt + l31) * 264 + (32 * kt + 16 * s2 + 4 * h) * 2;
                    const uint2 lo = *(const uint2*)vp, hi = *(const uint2*)(vp + 16);
                    u32x4 a; a.x = lo.x; a.y = lo.y; a.z = hi.x; a.w = hi.y;
                    Oa[mt] = MFMA32(__builtin_bit_cast(bf16x8_t, a), pf, Oa[mt]);
                }
            }
        }
        psum += __shfl_xor(psum, 32);
        const float inv = (nvalid > 0) ? 1.f / fmaxf(psum, 1e-30f) : 0.f;
        if (h == 0) invS[r * 64 + tokoff] = inv;
        const float g0 = sigmoidf_(bf2f(proj[trow * ODD_PAD + 2048 + hd])) * inv;
        bf16_t* orow = O + trow * ND + hd * 64;
#pragma unroll
        for (int mt = 0; mt < 2; ++mt)
#pragma unroll
            for (int q4 = 0; q4 < 4; ++q4)
                *(uint2*)(orow + 32 * mt + 8 * q4 + 4 * h) = make_uint2(cvtpk(g0 * Oa[mt][q4 * 4], g0 * Oa[mt][q4 * 4 + 1]), cvtpk(g0 * Oa[mt][q4 * 4 + 2], g0 * Oa[mt][q4 * 4 + 3]));
        __syncthreads();
#pragma unroll
        for (int i = 0; i < 4; ++i) {
            const int pc = tid + 512 * i, tk = pc >> 5, j = pc & 31, cur = tile;
            const float ij = (j < 8 * kt_end) ? impS[(0 * 64 + tk) * 33 + j] * invS[tk] + impS[(1 * 64 + tk) * 33 + j] * invS[64 + tk] + impS[(2 * 64 + tk) * 33 + j] * invS[128 + tk] + impS[(3 * 64 + tk) * 33 + j] * invS[192 + tk] : 0.f;
            const bool fj = (j == 0) || (j == cur) || (j == cur - 1);
            impT[tk * 33 + j] = (j <= cur) ? ij + (fj ? 1000.f : 0.f) : -INFINITY;
        }
        __syncthreads();
        {
            const int tk = tid >> 3, rr = tid & 7;
            float vk[32];
#pragma unroll
            for (int k = 0; k < 32; ++k) vk[k] = impT[tk * 33 + k];
            unsigned bits = 0;
#pragma unroll
            for (int jj = 0; jj < 4; ++jj) {
                const int j = rr * 4 + jj;
                const float vj = impT[tk * 33 + j];
                int rank = 0;
#pragma unroll
                for (int k = 0; k < 32; ++k) rank += (vk[k] > vj || (vk[k] == vj && k < j)) ? 1 : 0;
                if (rank < 16) bits |= 1u << j;
            }
            bits |= __shfl_xor(bits, 1);
            bits |= __shfl_xor(bits, 2);
            bits |= __shfl_xor(bits, 4);
            if (rr == 0) selmask[(size_t)(b * 4 + g) * NL + tile * 64 + tk] = bits;
        }
    }
    __syncthreads();
    __builtin_amdgcn_s_setprio(0);
}


constexpr int P0W = 1792;
constexpr float LN2F = 0.6931471805599453f;
__device__ __forceinline__ void sb_attn2_phase(const bf16_t* __restrict__ proj, const bf16_t* __restrict__ vt, bf16_t* __restrict__ Y, unsigned char* lds) {
    if (__builtin_amdgcn_readfirstlane(tidx() >> 6) >= 4) __builtin_amdgcn_s_setprio(1);
    const int tid = tidx(), wave = __builtin_amdgcn_readfirstlane(tid >> 6), lane = tid & 63, l31 = lane & 31, h = lane >> 5;
    const int skey = tid >> 3, spart = tid & 7;
    for (int it = blockIdx.x; it < NB * 12 * 8; it += gridDim.x) {
        const int tile = 7 - (it / 192), bh = it % 192, hh = bh % 12, b = bh / 12;
        const int qlo = tile * 256 + 32 * wave, tq = qlo + l31;
        const size_t trow = (size_t)(b * NL + tq);
        bf16x8_t Qf[4];
#pragma unroll
        for (int ds = 0; ds < 4; ++ds) {
            float q[8];
            ld8(proj + trow * P0W + 256 + hh * 64 + 16 * ds + 8 * h, q);
            u32x4 w; w.x = cvtpk(q[0] * 0.125f, q[1] * 0.125f); w.y = cvtpk(q[2] * 0.125f, q[3] * 0.125f); w.z = cvtpk(q[4] * 0.125f, q[5] * 0.125f); w.w = cvtpk(q[6] * 0.125f, q[7] * 0.125f);
            Qf[ds] = __builtin_bit_cast(bf16x8_t, w);
        }
        const bf16_t* kbase = proj + (size_t)b * NL * P0W + 1024 + hh * 64 + (size_t)skey * P0W + 8 * spart;
        const bf16_t* vbase = vt + (size_t)(hh * 64 + skey) * NT + (size_t)b * NL + 8 * spart;
        f32x16 Oa[2];
#pragma unroll
        for (int i = 0; i < 16; ++i) { Oa[0][i] = 0.f; Oa[1][i] = 0.f; }
        float carry = 0.f;
        int j = tile * 4 + 3, buf = 0;
        uint4 kreg = *(const uint4*)(kbase + (size_t)(64 * j) * P0W);
        uint4 vreg = *(const uint4*)(vbase + 64 * j);
        __syncthreads();
        *(uint4*)(lds + skey * 144 + spart * 16) = kreg;
        *(uint2*)(lds + 18432 + skey * 136 + spart * 16) = make_uint2(vreg.x, vreg.y);
        *(uint2*)(lds + 18432 + skey * 136 + spart * 16 + 8) = make_uint2(vreg.z, vreg.w);
        __syncthreads();
        for (;;) {
            const int jn = j - 1;
            if (jn >= 0) { kreg = *(const uint4*)(kbase + (size_t)(64 * jn) * P0W); vreg = *(const uint4*)(vbase + 64 * jn); }
            const unsigned char* Ks = lds + buf * 9216;
            const unsigned char* Vs = lds + 18432 + buf * 8704;
            const bool live = (64 * j <= qlo + 30) && !__all(carry < -110.f);
            if (live) {
#pragma unroll
                for (int kti = 0; kti < 2; ++kti) {
                    const int kt = 1 - kti;
                    f32x16 acc;
#pragma unroll
                    for (int i = 0; i < 16; ++i) acc[i] = 0.f;
#pragma unroll
                    for (int ds = 0; ds < 4; ++ds) {
                        const bf16x8_t a = *(const bf16x8_t*)(Ks + (32 * kt + l31) * 144 + (16 * ds + 8 * h) * 2);
                        acc = MFMA32(a, Qf[ds], acc);
                    }
                    float m1[16], lz[16];
#pragma unroll
                    for (int reg = 0; reg < 16; ++reg) {
                        const float z = acc[reg];
                        const bool valid = (64 * j + 32 * kt + crow32(reg, h)) < tq;
                        const float e = __builtin_amdgcn_exp2f(-fabsf(z) * LOG2E);
                        const float sp = fmaxf(z, 0.f) + __builtin_amdgcn_logf(1.f + e) * LN2F;
                        m1[reg] = valid ? -sp : 0.f;
                        lz[reg] = valid ? z - sp : -1e30f;
                    }
                    float G[4], T[4];
#pragma unroll
                    for (int q = 0; q < 4; ++q) G[q] = (m1[4 * q] + m1[4 * q + 1]) + (m1[4 * q + 2] + m1[4 * q + 3]);
                    float Gp[4];
#pragma unroll
                    for (int q = 0; q < 4; ++q) { Gp[q] = __shfl_xor(G[q], 32); T[q] = G[q] + Gp[q]; }
                    float base[4];
                    base[3] = carry; base[2] = base[3] + T[3]; base[1] = base[2] + T[2]; base[0] = base[1] + T[1];
                    const float tot = base[0] + T[0];
#pragma unroll
                    for (int q = 0; q < 4; ++q) {
                        const float bq = base[q] + (h ? 0.f : Gp[q]);
                        const float t3 = bq, t2 = t3 + m1[4 * q + 3], t1 = t2 + m1[4 * q + 2], t0 = t1 + m1[4 * q + 1];
                        lz[4 * q + 3] = __builtin_amdgcn_exp2f((lz[4 * q + 3] + t3) * LOG2E);
                        lz[4 * q + 2] = __builtin_amdgcn_exp2f((lz[4 * q + 2] + t2) * LOG2E);
                        lz[4 * q + 1] = __builtin_amdgcn_exp2f((lz[4 * q + 1] + t1) * LOG2E);
                        lz[4 * q + 0] = __builtin_amdgcn_exp2f((lz[4 * q + 0] + t0) * LOG2E);
                    }
                    carry = tot;
#pragma unroll
                    for (int s2 = 0; s2 < 2; ++s2) {
                        u32x4 w; w.x = cvtpk(lz[s2 * 8 + 0], lz[s2 * 8 + 1]); w.y = cvtpk(lz[s2 * 8 + 2], lz[s2 * 8 + 3]); w.z = cvtpk(lz[s2 * 8 + 4], lz[s2 * 8 + 5]); w.w = cvtpk(lz[s2 * 8 + 6], lz[s2 * 8 + 7]);
                        const bf16x8_t pf = __builtin_bit_cast(bf16x8_t, w);
#pragma unroll
                        for (int mt = 0; mt < 2; ++mt) {
                            const unsigned char* vp = Vs + (32 * mt + l31) * 136 + (32 * kt + 16 * s2 + 4 * h) * 2;
                            const uint2 lo = *(const uint2*)vp, hi = *(const uint2*)(vp + 16);
                            u32x4 a; a.x = lo.x; a.y = lo.y; a.z = hi.x; a.w = hi.y;
                            Oa[mt] = MFMA32(__builtin_bit_cast(bf16x8_t, a), pf, Oa[mt]);
                        }
                    }
                }
            }
            if (jn >= 0) {
                *(uint4*)(lds + (buf ^ 1) * 9216 + skey * 144 + spart * 16) = kreg;
                *(uint2*)(lds + 18432 + (buf ^ 1) * 8704 + skey * 136 + spart * 16) = make_uint2(vreg.x, vreg.y);
                *(uint2*)(lds + 18432 + (buf ^ 1) * 8704 + skey * 136 + spart * 16 + 8) = make_uint2(vreg.z, vreg.w);
            }
            volatile int* flg = (volatile int*)(lds + 35840) + (j & 1) * 8;
            const int wdone = __all(carry < -110.f);
            if (lane == 0) flg[wave] = wdone;
            __syncthreads();
            const int alldone = flg[0] & flg[1] & flg[2] & flg[3] & flg[4] & flg[5] & flg[6] & flg[7];
            if (alldone || jn < 0) break;
            buf ^= 1; j = jn;
        }
        bf16_t* orow = Y + trow * ND + 256 + hh * 64;
#pragma unroll
        for (int mt = 0; mt < 2; ++mt)
#pragma unroll
            for (int q4 = 0; q4 < 4; ++q4)
                *(uint2*)(orow + 32 * mt + 8 * q4 + 4 * h) = make_uint2(cvtpk(Oa[mt][q4 * 4], Oa[mt][q4 * 4 + 1]), cvtpk(Oa[mt][q4 * 4 + 2], Oa[mt][q4 * 4 + 3]));
    }
    __syncthreads();
    __builtin_amdgcn_s_setprio(0);
}

__device__ __forceinline__ void s5_scan2_phase(const bf16_t* __restrict__ proj, const float* __restrict__ lam_re, const float* __restrict__ lam_im, const float* __restrict__ log_dt,
                                               const float* __restrict__ b_re, const float* __restrict__ b_im, const float* __restrict__ c_re, const float* __restrict__ c_im,
                                               const float* __restrict__ dskip, bf16_t* __restrict__ ya, float* lds) {
    const int tid = tidx(), wave = __builtin_amdgcn_readfirstlane(tid >> 6), lane = tid & 63;
    float* cr = lds;
    float* ci = lds + 1024;
    float* Es = lds + 2048;
    float* us = lds + 3072 + wave * 512;
    float* xr = lds + 7168 + wave * 4160;
    float* xi = xr + 2080;
    for (int bg = blockIdx.x; bg < NB * 16; bg += gridDim.x) {
        const int b = bg >> 4, g = bg & 15;
        const float lr = lam_re[g * 64 + lane], li = lam_im[g * 64 + lane];
        const float dt = expf(log_dt[g]);
        const float mag = expf(lr * dt);
        const float are = mag * cosf(li * dt), aim = mag * sinf(li * dt);
        const float nr = are - 1.f, den = lr * lr + li * li;
        const float fre = (nr * lr + aim * li) / den, fim = (aim * lr - nr * li) / den;
        float bbr[16], bbi[16];
#pragma unroll
        for (int i = 0; i < 16; ++i) {
            const float br = b_re[(g * 64 + lane) * 16 + i], bi = b_im[(g * 64 + lane) * 16 + i];
            bbr[i] = fre * br - fim * bi; bbi[i] = fre * bi + fim * br;
        }
        __syncthreads();
        for (int idx = tid; idx < 1024; idx += NTHR) { cr[idx] = c_re[g * 1024 + idx]; ci[idx] = c_im[g * 1024 + idx]; }
        const bf16_t* ub = proj + (size_t)(b * NL + 256 * wave) * P0W + g * 16;
        float xre = 0.f, xim = 0.f;
        for (int c0 = 0; c0 < 256; c0 += 32) {
            wave_lds_fence();
            { float u8[8]; const int t = lane >> 1, hf = lane & 1; ld8(ub + (size_t)(c0 + t) * P0W + 8 * hf, u8);
#pragma unroll
              for (int i = 0; i < 8; ++i) us[t * 16 + 8 * hf + i] = u8[i]; }
            wave_lds_fence();
            for (int t = 0; t < 32; ++t) {
                float bur = 0.f, bui = 0.f;
#pragma unroll
                for (int i = 0; i < 16; ++i) { const float u = us[t * 16 + i]; bur += bbr[i] * u; bui += bbi[i] * u; }
                const float nre = are * xre - aim * xim + bur, nim = are * xim + aim * xre + bui;
                xre = nre; xim = nim;
            }
        }
        Es[(wave * 64 + lane) * 2] = xre; Es[(wave * 64 + lane) * 2 + 1] = xim;
        float pr = are, pi = aim;
#pragma unroll
        for (int i = 0; i < 8; ++i) { const float nr2 = pr * pr - pi * pi, ni2 = 2.f * pr * pi; pr = nr2; pi = ni2; }
        __syncthreads();
        xre = 0.f; xim = 0.f;
        for (int w2 = 0; w2 < wave; ++w2) {
            const float er = Es[(w2 * 64 + lane) * 2], ei = Es[(w2 * 64 + lane) * 2 + 1];
            const float nre = pr * xre - pi * xim + er, nim = pr * xim + pi * xre + ei;
            xre = nre; xim = nim;
        }
        const int tt = lane & 31, ih = lane >> 5;
        float dsk[8];
#pragma unroll
        for (int i = 0; i < 8; ++i) dsk[i] = dskip[g * 16 + 8 * ih + i];
        for (int c0 = 0; c0 < 256; c0 += 32) {
            wave_lds_fence();
            { float u8[8]; const int t = lane >> 1, hf = lane & 1; ld8(ub + (size_t)(c0 + t) * P0W + 8 * hf, u8);
#pragma unroll
              for (int i = 0; i < 8; ++i) us[t * 16 + 8 * hf + i] = u8[i]; }
            wave_lds_fence();
            for (int t = 0; t < 32; ++t) {
                float bur = 0.f, bui = 0.f;
#pragma unroll
                for (int i = 0; i < 16; ++i) { const float u = us[t * 16 + i]; bur += bbr[i] * u; bui += bbi[i] * u; }
                const float nre = are * xre - aim * xim + bur, nim = are * xim + aim * xre + bui;
                xre = nre; xim = nim;
                xr[t * 65 + lane] = xre; xi[t * 65 + lane] = xim;
            }
            wave_lds_fence();
            float y[8];
#pragma unroll
            for (int i = 0; i < 8; ++i) y[i] = 0.f;
            for (int p = 0; p < 64; ++p) {
                const float a = xr[tt * 65 + p], bq = xi[tt * 65 + p];
#pragma unroll
                for (int i = 0; i < 8; ++i) y[i] += cr[(8 * ih + i) * 64 + p] * a - ci[(8 * ih + i) * 64 + p] * bq;
            }
            float o[8];
#pragma unroll
            for (int i = 0; i < 8; ++i) o[i] = gelu_fast(y[i] + dsk[i] * us[tt * 16 + 8 * ih + i]);
            st8(ya + (size_t)(b * NL + 256 * wave + c0 + tt) * 256 + g * 16 + 8 * ih, o);
        }
    }
    __syncthreads();
}


__device__ __forceinline__ void glu2_phase(const bf16_t* __restrict__ ya, const bf16_t* __restrict__ wgt, const float* __restrict__ bglu, bf16_t* __restrict__ Y, unsigned char* lds) {
    const int tid = tidx(), wave = __builtin_amdgcn_readfirstlane(tid >> 6), lane = tid & 63, fr = lane & 15, fq = lane >> 4;
    __syncthreads();
    for (int pc = tid; pc < 256 * 32; pc += NTHR) { const int row = pc >> 5, c = pc & 31; *(uint4*)(lds + row * 528 + c * 16) = *(const uint4*)(wgt + row * 256 + c * 8); }
    __syncthreads();
    for (int chunk = blockIdx.x; chunk < NT / 128; chunk += gridDim.x) {
        const size_t tok = (size_t)chunk * 128 + wave * 16 + fr;
        const size_t yb_b = (tok / NL) * 16, yt = tok % NL;
        bf16x8_t yb[8];
#pragma unroll
        for (int ks = 0; ks < 8; ++ks) yb[ks] = *(const bf16x8_t*)(ya + ((yb_b + 2 * ks + (fq >> 1)) * NL + yt) * 16 + (fq & 1) * 8);
#pragma unroll 2
        for (int nt = 0; nt < 16; ++nt) {
            f32x4 acc = {0.f, 0.f, 0.f, 0.f};
#pragma unroll
            for (int ks = 0; ks < 8; ++ks) {
                const bf16x8_t a = *(const bf16x8_t*)(lds + (16 * nt + fr) * 528 + (32 * ks + 8 * fq) * 2);
                acc = __builtin_amdgcn_mfma_f32_16x16x32_bf16(a, yb[ks], acc, 0, 0, 0);
            }
            const int n0 = 16 * nt + 4 * fq;
            const uint2 yv = *(const uint2*)(ya + ((yb_b + nt) * NL + yt) * 16 + 4 * fq);
            const float4 bb = *(const float4*)(bglu + n0);
            const float o0 = __uint_as_float(yv.x << 16) * sigmoidf_(acc[0] + bb.x), o1 = __uint_as_float(yv.x & 0xffff0000u) * sigmoidf_(acc[1] + bb.y);
            const float o2 = __uint_as_float(yv.y << 16) * sigmoidf_(acc[2] + bb.z), o3 = __uint_as_float(yv.y & 0xffff0000u) * sigmoidf_(acc[3] + bb.w);
            *(uint2*)(Y + tok * ND + n0) = make_uint2(cvtpk(o0, o1), cvtpk(o2, o3));
        }
    }
    __syncthreads();
}


__device__ __forceinline__ void cmadd(float& re, float& im, float ar, float ai, float br, float bi) {
    const float nr = fmaf(ar, re, fmaf(-ai, im, br)), ni = fmaf(ar, im, fmaf(ai, re, bi));
    re = nr; im = ni;
}
__device__ __forceinline__ void s5_scan3_phase(const bf16_t* __restrict__ proj, const float* __restrict__ lam_re, const float* __restrict__ lam_im, const float* __restrict__ log_dt,
                                               const float* __restrict__ b_re, const float* __restrict__ b_im, const float* __restrict__ c_re, const float* __restrict__ c_im,
                                               const float* __restrict__ dskip, bf16_t* __restrict__ ya, unsigned char* lds) {
    const int tid = tidx(), wave = __builtin_amdgcn_readfirstlane(tid >> 6), lane = tid & 63, l31 = lane & 31, h = lane >> 5, fr = lane & 15, fq = lane >> 4;
    unsigned char* Xs = lds + wave * 10752;
    float* Es = (float*)(lds + 86016);
    __syncthreads();
    for (int i = lane; i < 32 * 21; i += 64) *(uint4*)(Xs + i * 16) = make_uint4(0u, 0u, 0u, 0u);
    for (int bg = blockIdx.x; bg < NB * 16; bg += gridDim.x) {
        const int b = bg >> 4, g = bg & 15;
        const float dt = expf(log_dt[g]);
        float are[2], aim[2]; bf16x8_t Bre[2], Bim[2];
#pragma unroll
        for (int k = 0; k < 2; ++k) {
            const int p = 32 * k + l31;
            const float lr = lam_re[g * 64 + p], li = lam_im[g * 64 + p];
            const float mag = expf(lr * dt);
            are[k] = mag * cosf(li * dt); aim[k] = mag * sinf(li * dt);
            const float nr = are[k] - 1.f, den = lr * lr + li * li;
            const float fre = (nr * lr + aim[k] * li) / den, fim = (aim[k] * lr - nr * li) / den;
            float vr[8], vi[8];
#pragma unroll
            for (int j = 0; j < 8; ++j) {
                const float br = b_re[(g * 64 + p) * 16 + 8 * h + j], bi = b_im[(g * 64 + p) * 16 + 8 * h + j];
                vr[j] = fre * br - fim * bi; vi[j] = fre * bi + fim * br;
            }
            u32x4 w; w.x = cvtpk(vr[0], vr[1]); w.y = cvtpk(vr[2], vr[3]); w.z = cvtpk(vr[4], vr[5]); w.w = cvtpk(vr[6], vr[7]); Bre[k] = __builtin_bit_cast(bf16x8_t, w);
            w.x = cvtpk(vi[0], vi[1]); w.y = cvtpk(vi[2], vi[3]); w.z = cvtpk(vi[4], vi[5]); w.w = cvtpk(vi[6], vi[7]); Bim[k] = __builtin_bit_cast(bf16x8_t, w);
        }
        bf16x8_t Cm[5];
        {
            const float di = dskip[g * 16 + fr];
#pragma unroll
            for (int ks = 0; ks < 5; ++ks) {
                float cv[8];
#pragma unroll
                for (int j = 0; j < 8; ++j) {
                    const int kk = 32 * ks + 8 * fq + j;
                    cv[j] = kk < 64 ? c_re[(g * 16 + fr) * 64 + kk] : (kk < 128 ? -c_im[(g * 16 + fr) * 64 + kk - 64] : ((kk - 128) == fr ? di : 0.f));
                }
                u32x4 w; w.x = cvtpk(cv[0], cv[1]); w.y = cvtpk(cv[2], cv[3]); w.z = cvtpk(cv[4], cv[5]); w.w = cvtpk(cv[6], cv[7]); Cm[ks] = __builtin_bit_cast(bf16x8_t, w);
            }
        }
        float a4r[2], a4i[2], a5r[2], a5i[2], a32r[2], a32i[2], a256r[2], a256i[2];
#pragma unroll
        for (int k = 0; k < 2; ++k) {
            float pr = are[k], pi = aim[k], t;
            t = pr * pr - pi * pi; pi = 2.f * pr * pi; pr = t;
            t = pr * pr - pi * pi; pi = 2.f * pr * pi; pr = t;
            a4r[k] = pr; a4i[k] = pi;
            a5r[k] = pr * are[k] - pi * aim[k]; a5i[k] = pr * aim[k] + pi * are[k];
#pragma unroll
            for (int i = 0; i < 3; ++i) { t = pr * pr - pi * pi; pi = 2.f * pr * pi; pr = t; }
            a32r[k] = pr; a32i[k] = pi;
#pragma unroll
            for (int i = 0; i < 3; ++i) { t = pr * pr - pi * pi; pi = 2.f * pr * pi; pr = t; }
            a256r[k] = pr; a256i[k] = pi;
        }
        const bf16_t* ub = proj + (size_t)(b * NL + 256 * wave) * P0W + g * 16 + 8 * h;
        float sre[2] = {0.f, 0.f}, sim[2] = {0.f, 0.f};
        bf16x8_t ufn = *(const bf16x8_t*)(ub + (size_t)l31 * P0W);
#pragma unroll 1
        for (int c0 = 0; c0 < 256; c0 += 32) {
            const bf16x8_t uf = ufn;
            ufn = *(const bf16x8_t*)(ub + (size_t)(((c0 + 32) & 255) + l31) * P0W);
#pragma unroll
            for (int k = 0; k < 2; ++k) {
                f32x16 z;
#pragma unroll
                for (int i = 0; i < 16; ++i) z[i] = 0.f;
                const f32x16 bur = MFMA32(uf, Bre[k], z), bui = MFMA32(uf, Bim[k], z);
                float er = 0.f, ei = 0.f;
#pragma unroll
                for (int reg = 0; reg < 16; ++reg) {
                    if (reg == 0) { er = bur[0]; ei = bui[0]; }
                    else if ((reg & 3) == 0) cmadd(er, ei, a5r[k], a5i[k], bur[reg], bui[reg]);
                    else cmadd(er, ei, are[k], aim[k], bur[reg], bui[reg]);
                }
                { float tr = er, ti = ei; cmadd(tr, ti, a4r[k], a4i[k], 0.f, 0.f); er = h ? er : tr; ei = h ? ei : ti; }
                er += __shfl_xor(er, 32); ei += __shfl_xor(ei, 32);
                cmadd(sre[k], sim[k], a32r[k], a32i[k], er, ei);
            }
        }
        __syncthreads();
        if (h == 0) {
#pragma unroll
            for (int k = 0; k < 2; ++k) { Es[(wave * 64 + 32 * k + l31) * 2] = sre[k]; Es[(wave * 64 + 32 * k + l31) * 2 + 1] = sim[k]; }
        }
        __syncthreads();
        float xre[2] = {0.f, 0.f}, xim[2] = {0.f, 0.f};
        for (int w2 = 0; w2 < wave; ++w2) {
#pragma unroll
            for (int k = 0; k < 2; ++k) cmadd(xre[k], xim[k], a256r[k], a256i[k], Es[(w2 * 64 + 32 * k + l31) * 2], Es[(w2 * 64 + 32 * k + l31) * 2 + 1]);
        }
#pragma unroll 1
        for (int c0 = 0; c0 < 256; c0 += 32) {
            const bf16x8_t uf = ufn;
            ufn = *(const bf16x8_t*)(ub + (size_t)(((c0 + 32) & 255) + l31) * P0W);
            wave_lds_fence();
            *(bf16x8_t*)(Xs + l31 * 336 + 256 + 16 * h) = uf;
#pragma unroll
            for (int k = 0; k < 2; ++k) {
                f32x16 z;
#pragma unroll
                for (int i = 0; i < 16; ++i) z[i] = 0.f;
                const f32x16 bur = MFMA32(uf, Bre[k], z), bui = MFMA32(uf, Bim[k], z);
                float cr = xre[k], ci = xim[k];
#pragma unroll
                for (int q = 0; q < 4; ++q) {
                    float ar_[4], ai_[4], br_[4], bi_[4];
                    float xr_ = cr, xi_ = ci;
#pragma unroll
                    for (int r2 = 0; r2 < 4; ++r2) { cmadd(xr_, xi_, are[k], aim[k], bur[4 * q + r2], bui[4 * q + r2]); ar_[r2] = xr_; ai_[r2] = xi_; }
                    float yr_ = __shfl_xor(xr_, 32), yi_ = __shfl_xor(xi_, 32);
#pragma unroll
                    for (int r2 = 0; r2 < 4; ++r2) { cmadd(yr_, yi_, are[k], aim[k], bur[4 * q + r2], bui[4 * q + r2]); br_[r2] = yr_; bi_[r2] = yi_; }
                    const float zr_ = __shfl_xor(yr_, 32), zi_ = __shfl_xor(yi_, 32);
                    cr = h ? yr_ : zr_; ci = h ? yi_ : zi_;
#pragma unroll
                    for (int r2 = 0; r2 < 4; ++r2) {
                        const int t = 8 * q + 4 * h + r2;
                        *(bf16_t*)(Xs + t * 336 + (32 * k + l31) * 2) = f2bf(h ? br_[r2] : ar_[r2]);
                        *(bf16_t*)(Xs + t * 336 + (64 + 32 * k + l31) * 2) = f2bf(h ? bi_[r2] : ai_[r2]);
                    }
                }
                xre[k] = cr; xim[k] = ci;
            }
            wave_lds_fence();
#pragma unroll
            for (int mt = 0; mt < 2; ++mt) {
                f32x4 y = {0.f, 0.f, 0.f, 0.f};
#pragma unroll
                for (int ks = 0; ks < 5; ++ks) {
                    const bf16x8_t a = *(const bf16x8_t*)(Xs + (16 * mt + fr) * 336 + (32 * ks + 8 * fq) * 2);
                    y = __builtin_amdgcn_mfma_f32_16x16x32_bf16(a, Cm[ks], y, 0, 0, 0);
                }
#pragma unroll
                for (int reg = 0; reg < 4; ++reg)
                    ya[((size_t)(b * 16 + g) * NL + 256 * wave + c0 + 16 * mt + 4 * fq + reg) * 16 + fr] = f2bf(gelu_fast(y[reg]));
            }
        }
    }
    __syncthreads();
}

struct Params {
    const float* in[29];
    float* out;
    char* ws;
    unsigned long long pad;
};

constexpr size_t SZ_PROJ = (size_t)NT * EVEN_IN * 2;
constexpr size_t SZ_VT = (size_t)768 * NT * 2;
constexpr size_t SZ_YB = (size_t)NT * ND * 2;
constexpr size_t SZ_HB = (size_t)NT * ND * 2;
constexpr size_t SZ_YA = (size_t)NT * 256 * 2;
constexpr size_t SZ_CMP = (size_t)NB * 4 * 128 * 64 * 2;
constexpr size_t SZ_SEL = (size_t)NB * 4 * NL * 4;
constexpr size_t SZ_TAB = (size_t)16384 * ND;
constexpr size_t SZ_SKB = (size_t)2 * 8 * 2 * 128 * 128 * 2;
constexpr size_t OFF_VT = SZ_PROJ, OFF_YB = OFF_VT + SZ_VT, OFF_HB = OFF_YB + SZ_YB, OFF_YA = OFF_HB + SZ_HB, OFF_KC = OFF_YA + SZ_YA, OFF_VC = OFF_KC + SZ_CMP,
                 OFF_SEL = OFF_VC + SZ_CMP, OFF_TAB = OFF_SEL + SZ_SEL, OFF_SKB = OFF_TAB + 2 * SZ_TAB, OFF_WT = OFF_SKB + SZ_SKB;
constexpr size_t WT_IN0 = 0, WT_OUT0 = WT_IN0 + (size_t)EVEN_IN * ND * 2, WT_Q0 = WT_OUT0 + (size_t)ND * ND * 2, WT_Q1 = WT_Q0 + (size_t)2048 * ND * 2,
                 WT_IN1 = WT_Q1 + (size_t)2048 * ND * 2, WT_V1 = WT_IN1 + (size_t)ODD_PAD * ND * 2, WT_OUT1 = WT_V1 + (size_t)512 * ND * 2, WT_W1 = WT_OUT1 + (size_t)ND * ND * 2, WT_W2 = WT_W1 + (size_t)2 * 128 * 2048 * 2, WT_B1 = WT_W2 + (size_t)2 * 64 * 128 * 2, WT_V0 = WT_B1 + 2 * 128 * 4, WT_GLU = WT_V0 + (size_t)768 * ND * 2, WT_END = WT_GLU + (size_t)256 * 256 * 2;
constexpr size_t OFF_PART = OFF_WT + ((WT_END + 255) & ~(size_t)255);
constexpr size_t OFF_CQ = OFF_PART + (size_t)NT * 32 * 4;
constexpr size_t OFF_SU = OFF_CQ + 4 * 2048 * 4;
constexpr size_t OFF_BAR = OFF_SU + 16384 * 4;
constexpr size_t WS_NEED = OFF_BAR + XB_TOTAL_WORDS * 4 + 256;

__device__ __forceinline__ void convert_tables(const float* __restrict__ u, const float* __restrict__ v, unsigned char* __restrict__ TAB, float* __restrict__ SU) {
    {
        const int wave = tidx() >> 6, lane = tidx() & 63;
        for (int r0 = blockIdx.x * 32 + wave * 4; r0 < 16384; r0 += gridDim.x * 32) {
            f32x4 a[4][4];
#pragma unroll
            for (int rr = 0; rr < 4; ++rr)
#pragma unroll
                for (int q = 0; q < 4; ++q) a[rr][q] = __builtin_nontemporal_load((const f32x4*)(u + (size_t)(r0 + rr) * ND + lane * 16 + 4 * q));
#pragma unroll
            for (int rr = 0; rr < 4; ++rr) {
                const int row = r0 + rr;
                float m = 0.f;
#pragma unroll
                for (int q = 0; q < 4; ++q) m = fmaxf(fmaxf(m, fmaxf(fabsf(a[rr][q].x), fabsf(a[rr][q].y))), fmaxf(fabsf(a[rr][q].z), fabsf(a[rr][q].w)));
                for (int o = 32; o; o >>= 1) m = fmaxf(m, __shfl_xor(m, o));
                const float inv = m > 0.f ? 127.f / m : 0.f;
                uint4 w; unsigned* wp = (unsigned*)&w;
#pragma unroll
                for (int q = 0; q < 4; ++q) {
                    const int b0 = (int)rintf(a[rr][q].x * inv), b1 = (int)rintf(a[rr][q].y * inv), b2 = (int)rintf(a[rr][q].z * inv), b3 = (int)rintf(a[rr][q].w * inv);
                    wp[q] = (unsigned)(b0 & 255) | ((unsigned)(b1 & 255) << 8) | ((unsigned)(b2 & 255) << 16) | ((unsigned)b3 << 24);
                }
                *(uint4*)(TAB + (size_t)row * ND + lane * 16) = w;
                if (lane == 0) SU[row] = m * (1.f / 127.f);
            }
        }
    }
    const size_t per = (size_t)16384 * ND / 16;
    const size_t vstride = (size_t)gridDim.x * NTHR;
    for (size_t i = (size_t)blockIdx.x * NTHR + tidx(); i < per; i += 2 * vstride) {
        f32x4 a[2][4];
#pragma unroll
        for (int k = 0; k < 2; ++k)
#pragma unroll
            for (int q = 0; q < 4; ++q) a[k][q] = __builtin_nontemporal_load((const f32x4*)(v + (i + k * vstride) * 16 + 4 * q));
#pragma unroll
        for (int k = 0; k < 2; ++k) {
            uint4 w; unsigned* wp = (unsigned*)&w;
#pragma unroll
            for (int q = 0; q < 4; ++q) {
                int pk = __builtin_amdgcn_cvt_pk_fp8_f32(a[k][q].x * V_SCALE, a[k][q].y * V_SCALE, 0, false);
                pk = __builtin_amdgcn_cvt_pk_fp8_f32(a[k][q].z * V_SCALE, a[k][q].w * V_SCALE, pk, true);
                wp[q] = (unsigned)pk;
            }
            *(uint4*)(TAB + (size_t)16384 * ND + (i + k * vstride) * 16) = w;
        }
    }
}

__device__ __forceinline__ char* wsb(const Params& p) { char* w = p.ws; asm volatile("" : "+s"(w)); return w; }
#define PROJ ((bf16_t*)wsb(p))
#define YB ((bf16_t*)(wsb(p) + OFF_YB))
#define HB ((bf16_t*)(wsb(p) + OFF_HB))
#define YA ((bf16_t*)(wsb(p) + OFF_YA))
#define WGT ((bf16_t*)(wsb(p) + OFF_WT + WT_GLU))
#define KCMP ((bf16_t*)(wsb(p) + OFF_KC))
#define VCMP ((bf16_t*)(wsb(p) + OFF_VC))
#define W1T ((bf16_t*)(wsb(p) + OFF_WT + WT_W1))
#define W2T ((bf16_t*)(wsb(p) + OFF_WT + WT_W2))
#define BIAS1 ((float*)(wsb(p) + OFF_WT + WT_B1))
#define SEL ((unsigned*)(wsb(p) + OFF_SEL))
#define WIN0 ((bf16_t*)(wsb(p) + OFF_WT + WT_IN0))
#define WOUT0 ((bf16_t*)(wsb(p) + OFF_WT + WT_OUT0))
#define WQ0 ((bf16_t*)(wsb(p) + OFF_WT + WT_Q0))
#define WQ1 ((bf16_t*)(wsb(p) + OFF_WT + WT_Q1))
#define WIN1 ((bf16_t*)(wsb(p) + OFF_WT + WT_IN1))
#define WOUT1 ((bf16_t*)(wsb(p) + OFF_WT + WT_OUT1))
#define WV1 ((bf16_t*)(wsb(p) + OFF_WT + WT_V1))
#define VT ((bf16_t*)(wsb(p) + OFF_VT))
#define WV0 ((bf16_t*)(wsb(p) + OFF_WT + WT_V0))
#define EIDX ((int*)YB)
#define EGATE ((float*)((char*)YB + (size_t)NT * 128 * 4))
#define TAB ((unsigned char*)(wsb(p) + OFF_TAB))
#define SKB ((bf16_t*)(wsb(p) + OFF_SKB))
__global__ void __launch_bounds__(NTHR) fwd_megakernel(Params p) {
    extern __shared__ __attribute__((aligned(16))) unsigned char lds_raw[];
    float* lds = (float*)lds_raw;
    cg::grid_group grid = cg::this_grid();
    const float* x = p.in[0];
    float* R = p.out;
    char* ws = wsb(p);
    const int wave = tidx() >> 6;
    if (tidx() == 0) *(uint4*)(lds_raw + LDS_BYTES - 16) = make_uint4(0u, 0u, 0u, 0u);
    __syncthreads();
    XcdBarrier xbar = xcd_barrier_post((unsigned*)(ws + OFF_BAR), (volatile LAS unsigned*)(lds_raw + LDS_BYTES - 16));

    {
        const size_t nvec = (size_t)NT * ND / 4, stride = (size_t)gridDim.x * NTHR;
        for (size_t i = (size_t)blockIdx.x * NTHR + tidx(); i < nvec; i += 8 * stride) {
            f32x4 v[8];
#pragma unroll
            for (int k = 0; k < 8; ++k) v[k] = __builtin_nontemporal_load((const f32x4*)x + i + k * stride);
#pragma unroll
            for (int k = 0; k < 8; ++k) { uint2 w; w.x = pack2(v[k][0], v[k][1]); w.y = pack2(v[k][2], v[k][3]); ((uint2*)HB)[i + k * stride] = w; }
        }
    }
    convert_tables(p.in[23], p.in[24], TAB, (float*)(ws + OFF_SU));
    for (int i = blockIdx.x * NTHR + tidx(); i < 2 * 8 * 2 * 128 * 128 / 4; i += gridDim.x * NTHR) {
        const float4 a = ((const float4*)p.in[22])[i];
        uint2 w; w.x = pack2(a.x, a.y); w.y = pack2(a.z, a.w);
        ((uint2*)SKB)[i] = w;
    }
    convert_wt_phase(p.in[1], ND, EVEN_IN, P0W, ColMap{{0, 0, 0}, {0, 0, 0}, {P0W, 0, 0}}, WIN0, lds);
    convert_wt_phase(p.in[1], ND, EVEN_IN, 768, ColMap{{0, 0, 0}, {P0W, 0, 0}, {768, 0, 0}}, WV0, lds);
    convert_wt_phase(p.in[12], ND, ND, ND, ColMap{{0, 0, 0}, {0, 0, 0}, {ND, 0, 0}}, WOUT0, lds);
    convert_wt_phase(p.in[10], 256, 256, 256, ColMap{{0, 0, 0}, {0, 0, 0}, {256, 0, 0}}, WGT, lds);
    convert_wt_phase(p.in[21], ND, 2048, 2048, ColMap{{0, 0, 0}, {0, 0, 0}, {2048, 0, 0}}, WQ0, lds, p.in[25]);
    convert_wt_phase(p.in[21] + (size_t)ND * 2048, ND, 2048, 2048, ColMap{{0, 0, 0}, {0, 0, 0}, {2048, 0, 0}}, WQ1, lds, p.in[25] + ND);
    {
        float* CQ = (float*)(ws + OFF_CQ);
        const int kp = tidx() >> 5, cl32 = tidx() & 31, gcol = blockIdx.x * 32 + cl32;
        if (blockIdx.x < 128) {
            const int layer = gcol >> 11, n = gcol & 2047;
            const float* W = p.in[21] + (size_t)layer * ND * 2048;
            const float* gam = p.in[25] + layer * ND; const float* bet = p.in[26] + layer * ND;
            float c = 0.f, d = 0.f;
            for (int k = kp; k < ND; k += 16) { const float w = W[(size_t)k * 2048 + n]; c += bf2f(f2bf(gam[k] * w)); d += bet[k] * w; }
            c += __shfl_xor(c, 32); d += __shfl_xor(d, 32);
            __syncthreads();
            if ((tidx() & 63) < 32) { lds[(tidx() >> 6) * 64 + cl32] = c; lds[(tidx() >> 6) * 64 + 32 + cl32] = d; }
            __syncthreads();
            if (tidx() < 32) {
                float cs = 0.f, ds = 0.f;
#pragma unroll
                for (int w8 = 0; w8 < 8; ++w8) { cs += lds[w8 * 64 + tidx()]; ds += lds[w8 * 64 + 32 + tidx()]; }
                CQ[layer * 2048 + n] = cs; CQ[4096 + layer * 2048 + n] = ds;
            }
            __syncthreads();
        }
    }
    convert_wt_phase(p.in[13], ND, ODD_IN, ODD_PAD, ColMap{{0, 1792, 2048}, {0, 2048, 2560}, {1792, 256, 48}}, WIN1, lds);
    convert_wt_phase(p.in[13], ND, ODD_IN, 512, ColMap{{0, 256, 0}, {1792, 2304, 0}, {256, 256, 0}}, WV1, lds);
    convert_wt_phase(p.in[20], ND, ND, ND, ColMap{{0, 0, 0}, {0, 0, 0}, {ND, 0, 0}}, WOUT1, lds);
    convert_wt_phase(p.in[15], 2048, 128, 128, ColMap{{0, 0, 0}, {0, 0, 0}, {128, 0, 0}}, W1T, lds);
    convert_wt_phase(p.in[18], 2048, 128, 128, ColMap{{0, 0, 0}, {0, 0, 0}, {128, 0, 0}}, W1T + 128 * 2048, lds);
    convert_wt_phase(p.in[16], 128, 64, 64, ColMap{{0, 0, 0}, {0, 0, 0}, {64, 0, 0}}, W2T, lds);
    convert_wt_phase(p.in[19], 128, 64, 64, ColMap{{0, 0, 0}, {0, 0, 0}, {64, 0, 0}}, W2T + 64 * 128, lds);
    if (blockIdx.x < 8) {
        const int which = blockIdx.x >> 2, j = (blockIdx.x & 3) * 32 + (tidx() >> 4), part = tidx() & 15;
        const float* pe = which ? p.in[17] : p.in[14];
        const float* w1 = which ? p.in[18] : p.in[15];
        float a = 0.f;
#pragma unroll 8
        for (int i = part; i < 2048; i += 16) a += pe[i] * w1[(size_t)i * 128 + j];
        for (int o = 8; o; o >>= 1) a += __shfl_xor(a, o);
        if (part == 0) BIAS1[which * 128 + j] = a;
    }
    xcd_barrier(xbar);
    if (p.pad == 0x5eedull) grid.sync();
    PDUP(0) { PH(0) gemm_bf16_phase(lds_raw, HB, WIN0, NT, P0W, ND, EpiBf16s{PROJ, P0W});
    PH(0) gemm_bf16_phase(lds_raw, WV0, HB, 768, NT, ND, EpiBf16s{VT, NT}, true); }
    xcd_barrier(xbar);
    PDUP(1) { PH(1) s5_scan3_phase(PROJ, p.in[2], p.in[3], p.in[4], p.in[5], p.in[6], p.in[7], p.in[8], p.in[9], YA, lds_raw);
    PH(2) sb_attn2_phase(PROJ, VT, YB, lds_raw);
    if ((PROBE >> 13) & 1) {
        bf16_t* SCR = PROJ + (size_t)NT * P0W;
        s5_scan2_phase(PROJ, p.in[2], p.in[3], p.in[4], p.in[5], p.in[6], p.in[7], p.in[8], p.in[9], SCR, lds);
        xcd_barrier(xbar);
        float d2 = 0.f, n2 = 0.f;
        for (size_t i = (size_t)blockIdx.x * NTHR + tidx(); i < (size_t)NT * 256; i += (size_t)gridDim.x * NTHR) { const float a = bf2f(YA[i]), r = bf2f(SCR[i]); d2 += (a - r) * (a - r); n2 += r * r; }
        for (int o = 32; o; o >>= 1) { d2 += __shfl_xor(d2, o); n2 += __shfl_xor(n2, o); }
        float* chk = (float*)(ws + OFF_BAR + XB_TOTAL_WORDS * 4);
        if ((tidx() & 63) == 0) { atomicAdd(chk, d2); atomicAdd(chk + 1, n2); }
    }
    if (_rep == 0 && ((PROBE >> 1) & 1)) xcd_barrier(xbar); }
    xcd_barrier(xbar);
    PDUP(2) PH(3) glu2_phase(YA, WGT, p.in[11], YB, lds_raw);
    xcd_barrier(xbar);
    PH(4) gemm_bf16_phase(lds_raw, YB, WOUT0, NT, ND, ND, EpiResStats<false>{x, HB, (float*)(ws + OFF_PART)});
    xcd_barrier(xbar);
#define PEER_FFN(layer, WQ, last) \
    PH(12) gemm_q_phase(lds_raw, HB, WQ, (const float*)(ws + OFF_PART), (const float*)(ws + OFF_CQ) + (layer) * 2048, (const float*)(ws + OFF_CQ) + 4096 + (layer) * 2048, PROJ); \
    xcd_barrier(xbar); \
    PDUP(4) PH(13) peer_route2_phase(PROJ, SKB + (size_t)(layer) * 8 * 2 * 128 * 128, EIDX, EGATE, lds_raw); \
    xcd_barrier(xbar); \
    if ((PROBE >> 5) & 1) { peer_expert3_phase(R, EIDX, EGATE, TAB, TAB + (size_t)16384 * ND, p.in[27] + (layer) * ND, p.in[28] + (layer) * ND, nullptr, (float*)PROJ, xbar); xcd_barrier(xbar); } \
    PH(14) peer_expert10_phase((last) ? R : nullptr, HB, EIDX, EGATE, TAB, TAB + (size_t)16384 * ND, p.in[27] + (layer) * ND, p.in[28] + (layer) * ND, (last) ? nullptr : HB, xbar, lds, p.in[25] + (layer) * ND, p.in[26] + (layer) * ND, (const float*)(ws + OFF_SU)); \
    if (!(last)) xcd_barrier(xbar);
    PEER_FFN(0, WQ0, false)
    convert_tables(p.in[23] + (size_t)16384 * ND, p.in[24] + (size_t)16384 * ND, TAB, (float*)(ws + OFF_SU));
    PDUP(0) { PH(6) gemm_bf16_phase(lds_raw, HB, WIN1, NT, ODD_PAD, ND, EpiBf16s{PROJ, ODD_PAD});
    PH(6) gemm_bf16_phase(lds_raw, WV1, HB, 512, NT, ND, EpiBf16s{VT, NT}); }
    xcd_barrier(xbar);
    PDUP(6) PH(7) nsa_compress2_phase(PROJ, W1T, W2T, BIAS1, KCMP, VCMP, lds_raw);
    xcd_barrier(xbar);
    PDUP(7) { PH(8) nsa_cmp2_phase(PROJ, KCMP, VCMP, YB, SEL, lds_raw);
    xcd_barrier(xbar);
    PH(9) nsa_attn_phase(PROJ, VT, SEL, YB, lds_raw);
    if (_rep == 0 && ((PROBE >> 7) & 1)) xcd_barrier(xbar); }
    xcd_barrier(xbar);
    PH(10) gemm_bf16_phase(lds_raw, YB, WOUT1, NT, ND, ND, EpiResStats<true>{HB, HB, (float*)(ws + OFF_PART)});
    xcd_barrier(xbar);
    PEER_FFN(1, WQ1, true)
    if ((PROBE >> 13) & 1) {
        xcd_barrier(xbar);
        const float* chk = (const float*)(ws + OFF_BAR + XB_TOTAL_WORDS * 4);
        const float d2 = __hip_atomic_load(chk, __ATOMIC_RELAXED, __HIP_MEMORY_SCOPE_AGENT), n2 = __hip_atomic_load(chk + 1, __ATOMIC_RELAXED, __HIP_MEMORY_SCOPE_AGENT);
        if (!(d2 <= 1e-4f * n2)) for (size_t i = (size_t)blockIdx.x * NTHR + tidx(); i < (size_t)NT * ND; i += (size_t)gridDim.x * NTHR) R[i] *= 2.f;
    }
}

}

extern "C" void kernel_launch(void* const* d_in, const int* in_sizes, int n_in, void* d_out, int out_size, void* d_ws, size_t ws_size, hipStream_t stream) {
    static int grid_blocks = 0;
    if (grid_blocks == 0) {
        if (n_in != 29 || out_size != NT * ND || ws_size < WS_NEED) { fprintf(stderr, "kernel_launch: unexpected shapes / workspace (%zu < %zu)\n", ws_size, (size_t)WS_NEED); grid_blocks = -1; return; }
        int dev = 0, cus = 0, per_cu = 0;
        hipGetDevice(&dev);
        hipDeviceGetAttribute(&cus, hipDeviceAttributeMultiprocessorCount, dev);
        hipFuncSetAttribute((const void*)fwd_megakernel, hipFuncAttributeMaxDynamicSharedMemorySize, LDS_BYTES);
        hipOccupancyMaxActiveBlocksPerMultiprocessor(&per_cu, (const void*)fwd_megakernel, NTHR, LDS_BYTES);
        if (per_cu < 1) { fprintf(stderr, "kernel_launch: occupancy query says %d blocks/CU\n", per_cu); grid_blocks = -1; return; }
        grid_blocks = cus;
    }
    if (grid_blocks < 0) return;
    hipMemsetAsync((char*)d_ws + OFF_BAR, 0, XB_TOTAL_WORDS * 4 + 256, stream);
    Params p{};
    for (int i = 0; i < 29; ++i) p.in[i] = (const float*)d_in[i];
    p.out = (float*)d_out; p.ws = (char*)d_ws; p.pad = 0;
    void* args[] = {&p};
    hipError_t e = hipLaunchCooperativeKernel((const void*)fwd_megakernel, dim3(grid_blocks), dim3(NTHR), args, LDS_BYTES, stream);
    if (e != hipSuccess) fprintf(stderr, "cooperative launch failed: %s (grid %d)\n", hipGetErrorString(e), grid_blocks);
}
```

```cpp
#include <hip/hip_runtime.h>
#include <hip/hip_cooperative_groups.h>
#include <math.h>
#include <stdint.h>
#include <cstdio>
#include <type_traits>
namespace cg = cooperative_groups;

__device__ __forceinline__ int tidx() { int t = threadIdx.x; asm volatile("" : "+v"(t)); return t; }
#define XB_TMO      128
#define XB_XCNT(j)  (256  + 64 * (j))
#define XB_XSUB(j)  (1280 + 64 * (j))
#define XB_XGEN(j)  (2304 + 64 * (j))
#define XB_TOP      3328
#define XB_TOPGEN   3392
#define XCD_BAR_WORDS 3456
#define XB_SPIN_CAP (1u << 18)
#define LAS __attribute__((address_space(3)))

__device__ __forceinline__ unsigned xb_ld(unsigned* p)              { return __hip_atomic_load(p, __ATOMIC_RELAXED, __HIP_MEMORY_SCOPE_AGENT); }
__device__ __forceinline__ unsigned xb_add(unsigned* p, unsigned v) { return __hip_atomic_fetch_add(p, v, __ATOMIC_RELAXED, __HIP_MEMORY_SCOPE_AGENT); }
__device__ __forceinline__ unsigned xb_xcc_id() { return (unsigned)__builtin_amdgcn_s_getreg((3 << 11) | 20) & 0xFu; }
#define XB_SPIN(cond, bar) do { unsigned _sp = 0; while (cond) { __builtin_amdgcn_s_sleep(1); \
    if ((++_sp & 255u) == 0u) { if (xb_ld(&(bar)[XB_TMO])) break; if (_sp > XB_SPIN_CAP) { atomicAdd(&(bar)[XB_TMO], 1u); break; } } } } while (0)

struct XcdBarrier {
    unsigned* bar; unsigned x;
    volatile LAS unsigned* st;
};

__device__ __forceinline__ XcdBarrier xcd_barrier_post(unsigned* bar, volatile LAS unsigned* st) {
    XcdBarrier b; b.bar = bar; b.x = xb_xcc_id(); b.st = st;
    if (tidx() == 0) (void)xb_add(&bar[XB_XCNT(b.x)], 1u);
    return b;
}
__device__ __forceinline__ void xcd_barrier_complete(unsigned* bar, unsigned x, unsigned& nloc, unsigned& nx) {
    const unsigned G = gridDim.x * gridDim.y * gridDim.z;
    unsigned sum, cnt, mine, sp = 0u;
    for (;;) {
        sum = 0u; cnt = 0u; mine = 0u;
#pragma unroll
        for (unsigned j = 0; j < 16; ++j) { const unsigned c = xb_ld(&bar[XB_XCNT(j)]); sum += c; cnt += (c > 0u) ? 1u : 0u; mine = (j == x) ? c : mine; }
        if (sum == G) break;
        __builtin_amdgcn_s_sleep(1);
        if ((++sp & 255u) == 0u) { if (xb_ld(&bar[XB_TMO])) break; if (sp > XB_SPIN_CAP) { atomicAdd(&bar[XB_TMO], 1u); break; } }
    }
    nloc = mine > 0u ? mine : 1u; nx = cnt > 0u ? cnt : 1u;
}

__device__ __forceinline__ void xcd_barrier(const XcdBarrier& b) {
    asm volatile("s_waitcnt vmcnt(0)" ::: "memory");
    __syncthreads();
    if (tidx() == 0) {
        unsigned* bar = b.bar;
        __builtin_amdgcn_s_waitcnt(0);
        unsigned nloc = b.st[0], nx = b.st[1];
        if (nloc == 0u) { xcd_barrier_complete(bar, b.x, nloc, nx); b.st[0] = nloc; b.st[1] = nx; }
        const unsigned old = xb_add(&bar[XB_XSUB(b.x)], 1u);
        const unsigned gen = old / nloc;
        if (old + 1u == (gen + 1u) * nloc) {
            __builtin_amdgcn_fence(__ATOMIC_RELEASE, "");
            asm volatile("s_waitcnt vmcnt(0)" ::: "memory");
            const unsigned og = xb_add(&bar[XB_TOP], 1u);
            const unsigned tg = og / nx;
            if (og + 1u == (tg + 1u) * nx) xb_add(&bar[XB_TOPGEN], 1u);
            else XB_SPIN(xb_ld(&bar[XB_TOPGEN]) == tg, bar);
            __builtin_amdgcn_fence(__ATOMIC_ACQUIRE, "");
            xb_add(&bar[XB_XGEN(b.x)], 1u);
            asm volatile("s_waitcnt vmcnt(0)" ::: "memory");
        } else {
            XB_SPIN(xb_ld(&bar[XB_XGEN(b.x)]) == gen, bar);
            __builtin_amdgcn_fence(__ATOMIC_ACQUIRE, "");
            asm volatile("s_waitcnt vmcnt(0)" ::: "memory");
        }
    }
    __syncthreads();
}

#define XB_ALIGN(j) (XCD_BAR_WORDS + 64 * (j))
#define XB_TOTAL_WORDS (XCD_BAR_WORDS + 64 * 16)
__device__ __forceinline__ void xcc_align(const XcdBarrier& b) {
    __syncthreads();
    if (tidx() == 0) {
        const unsigned nloc = b.st[0];
        if (nloc) {
            const unsigned old = xb_add(&b.bar[XB_ALIGN(b.x)], 1u), gen = old / nloc;
            unsigned sp = 0;
            while (xb_ld(&b.bar[XB_ALIGN(b.x)]) < (gen + 1u) * nloc && ++sp < (1u << 16)) __builtin_amdgcn_s_sleep(1);
        }
    }
    __syncthreads();
}
namespace pg8 {
#define PG8_LAS __attribute__((address_space(3)))
typedef unsigned short bf16_t;
typedef short bf16x8 __attribute__((ext_vector_type(8)));
typedef float f32x4 __attribute__((ext_vector_type(4)));
typedef unsigned u32x4 __attribute__((ext_vector_type(4)));
constexpr int BM = 256, BK = 64, HALF = 128, HTB = HALF * BK * 2  , STAGE_BYTES = 8 * HTB, NXCD = 8, WGM = 8;

__host__ __device__ __forceinline__ int lds_byte(int r, int c) { const int st = (r >> 4) * 2 + (c >> 5), rr = r & 15, cc = c & 31, ob = rr * 64 + cc * 2; return st * 1024 + (ob ^ (((ob >> 9) & 1) << 5)); }
__host__ __device__ __forceinline__ void stage_rc(int b, int& R, int& C) { const int st = b / 1024, sb = b % 1024, swz = sb ^ (((sb >> 9) & 1) << 5); R = (st >> 1) * 16 + swz / 64; C = (st & 1) * 32 + (swz % 64) / 2; }
__host__ __device__ __forceinline__ int perm32(int rho) { const int n = rho >> 4, i = rho & 15; return 8 * (i >> 2) + 4 * n + (i & 3); }

struct Unit { int pm, pn; };
struct Gemm { const bf16_t* A; const bf16_t* Bt; int M, N, K; };

struct StaticOrder {
    int nM, nN, nwg, G, c;
    __host__ __device__ void init(int M, int N, int G_, int c_) { nM = M / BM; nN = N / BM; nwg = nM * nN; G = G_; c = c_; }
    __host__ __device__ bool next(int i, Unit& u) const {
        const long L = (long)i * G + c; if (L >= nwg) return false;
        int wgid = (int)L; { const int q = nwg / NXCD, r = nwg % NXCD, xcd = wgid % NXCD, off = wgid / NXCD; wgid = (xcd < r ? xcd * (q + 1) : r * (q + 1) + (xcd - r) * q) + off; }
        const int nig = WGM * nN, gid = wgid / nig, fm = gid * WGM, gsz = (nM - fm) < WGM ? (nM - fm) : WGM;
        u.pm = fm + ((wgid % nig) % gsz); u.pn = (wgid % nig) / gsz; return true;
    }
    __device__ __forceinline__ void a_ready(const Unit&) const {}
    __device__ __forceinline__ void done(const Unit&) const {}
};
__device__ __forceinline__ unsigned cvt_pk_bf16(float lo, float hi) { unsigned r; asm volatile("v_cvt_pk_bf16_f32 %0, %1, %2" : "=v"(r) : "v"(lo), "v"(hi)); return r; }
template <class Epi, class Sched, bool STAMP = false>
__device__ __forceinline__ void gemm_phase(PG8_LAS unsigned char* lds, const Gemm g, const Sched& S, const Epi& E, unsigned long long* stamps) {
    const int tid = tidx(), wid = __builtin_amdgcn_readfirstlane(tid >> 6), lane = tid & 63, wr = wid >> 2, wc = wid & 3, fr = lane & 15, fq = lane >> 4;
    const int K = g.K, nt = K / BK;
    int ts_lo = 0, ts_hi = 0, nts = 0; const unsigned long long rt_entry = STAMP ? (unsigned long long)wall_clock64() : 0ull;
#define PG8_STAMP() do { if (STAMP && wid == 0 && nts < 64) { const unsigned long long _c = (unsigned long long)clock64(); \
        ts_lo = (lane == nts) ? (int)(unsigned)_c : ts_lo; ts_hi = (lane == nts) ? (int)(unsigned)(_c >> 32) : ts_hi; ++nts; } } while (0)
    PG8_STAMP();
    unsigned voffA[2], voffB[2];
#pragma unroll
    for (int i = 0; i < 2; ++i) { int R, C; stage_rc(tid * 16 + i * 8192, R, C); const int Rb = Epi::PERM ? ((R & ~31) + perm32(R & 31)) : R;
        voffA[i] = (unsigned)(R * K + C) * 2u; voffB[i] = (unsigned)(Rb * K + C) * 2u; }
    const size_t kstep = (size_t)(BK * 2);
    const size_t hstep = (size_t)HALF * K * 2;
    const size_t tstep = 2 * hstep;
    const unsigned ldsw = (unsigned)wid * 1024u;
    const int aoff = lds_byte(wr * 64 + fr, fq * 8), boff = lds_byte(wc * 32 + fr, fq * 8);
#define PG8_SA(b, h) (((b) * 2 + (h)) * HTB)
#define PG8_SB(b, h) ((4 + (b) * 2 + (h)) * HTB)
#define PG8_STAGE(bufoff, gbase, voff) do { _Pragma("unroll") for (int _i = 0; _i < 2; ++_i) \
        __builtin_amdgcn_global_load_lds((const unsigned*)((const char*)(gbase) + (voff)[_i]), (PG8_LAS unsigned*)(lds + (bufoff) + ldsw + _i * 8192), 16, 0, 0); } while (0)
#define PG8_LDA(dst, b, h) do { _Pragma("unroll") for (int m = 0; m < 4; ++m) _Pragma("unroll") for (int k = 0; k < 2; ++k) dst[m][k] = *(const PG8_LAS bf16x8*)(lds + PG8_SA(b, h) + aoff + m * 2048 + k * 1024); } while (0)
#define PG8_LDB(dst, b, h) do { _Pragma("unroll") for (int n = 0; n < 2; ++n) _Pragma("unroll") for (int k = 0; k < 2; ++k) dst[n][k] = *(const PG8_LAS bf16x8*)(lds + PG8_SB(b, h) + boff + n * 2048 + k * 1024); } while (0)
#define PG8_MMA(ai, bj, At, Bt) do { __builtin_amdgcn_s_setprio(1); _Pragma("unroll") for (int m = 0; m < 4; ++m) _Pragma("unroll") for (int n = 0; n < 2; ++n) _Pragma("unroll") for (int k = 0; k < 2; ++k) \
        acc[ai][bj][m][n] = __builtin_amdgcn_mfma_f32_16x16x32_bf16(Bt[n][k], At[m][k], acc[ai][bj][m][n], 0, 0, 0); __builtin_amdgcn_s_setprio(0); } while (0)
#define PG8_WAIT_V(n) asm volatile("s_waitcnt vmcnt(" #n ")" ::: "memory")
#define PG8_WAIT_L(n) asm volatile("s_waitcnt lgkmcnt(" #n ")" ::: "memory")
#define PG8_BAR __builtin_amdgcn_s_barrier()
#define PG8_SCHED __builtin_amdgcn_sched_barrier(0)
    Unit cur, nxt; int ui = 0;
    if (!S.next(0, cur)) return;
    f32x4 acc[2][2][4][2];
#pragma unroll
    for (int a = 0; a < 2; ++a)
#pragma unroll
        for (int b = 0; b < 2; ++b)
#pragma unroll
            for (int m = 0; m < 4; ++m)
#pragma unroll
                for (int n = 0; n < 2; ++n) acc[a][b][m][n] = (f32x4){0.f, 0.f, 0.f, 0.f};
    bf16x8 At[4][2], B0[2][2], B1[2][2];
    const char* cA = (const char*)g.A + (size_t)cur.pm * tstep; const char* cB = (const char*)g.Bt + (size_t)cur.pn * tstep;
    S.a_ready(cur);
    PG8_STAGE(PG8_SB(0, 0), cB, voffB); PG8_STAGE(PG8_SA(0, 0), cA, voffA); PG8_STAGE(PG8_SB(0, 1), cB + hstep, voffB); PG8_STAGE(PG8_SA(0, 1), cA + hstep, voffA);
    if (wr == 1) PG8_BAR;
    PG8_WAIT_V(4); PG8_BAR;
    PG8_STAGE(PG8_SB(1, 0), cB + kstep, voffB); PG8_STAGE(PG8_SA(1, 0), cA + kstep, voffA); PG8_STAGE(PG8_SB(1, 1), cB + hstep + kstep, voffB);
    PG8_WAIT_V(6); PG8_BAR;
    PG8_STAMP();
    for (;;) {
        const bool has_next = S.next(ui + 1, nxt);
        const char* nA = has_next ? (const char*)g.A + (size_t)nxt.pm * tstep : cA; const char* nB = has_next ? (const char*)g.Bt + (size_t)nxt.pn * tstep : cB;
        for (int t = 0; t < nt; t += 2) {
            const bool last = (t == nt - 2);
            const char* a1 = cA + (size_t)(t + 1) * kstep;
            const char* a2 = last ? nA : cA + (size_t)(t + 2) * kstep; const char* b2 = last ? nB : cB + (size_t)(t + 2) * kstep;
            const char* a3 = a2 + kstep; const char* b3 = b2 + kstep;
            if (last && has_next) S.a_ready(nxt);
            PG8_LDB(B0, 0, 0); PG8_SCHED; PG8_LDA(At, 0, 0); PG8_STAGE(PG8_SA(1, 1), a1 + hstep, voffA);
            PG8_WAIT_L(8); PG8_BAR; PG8_WAIT_L(0); PG8_MMA(0, 0, At, B0); PG8_BAR; PG8_SCHED;
            PG8_LDB(B1, 0, 1); PG8_STAGE(PG8_SB(0, 0), b2, voffB);
            PG8_BAR; PG8_WAIT_L(0); PG8_MMA(0, 1, At, B1); PG8_BAR;
            PG8_LDA(At, 0, 1); PG8_STAGE(PG8_SA(0, 0), a2, voffA);
            PG8_BAR; PG8_WAIT_L(0); PG8_MMA(1, 0, At, B0); PG8_BAR; PG8_SCHED;
            PG8_STAGE(PG8_SB(0, 1), b2 + hstep, voffB);
            PG8_WAIT_V(6); PG8_BAR; PG8_MMA(1, 1, At, B1); PG8_BAR;
            PG8_LDB(B0, 1, 0); PG8_SCHED; PG8_LDA(At, 1, 0); PG8_STAGE(PG8_SA(0, 1), a2 + hstep, voffA);
            PG8_WAIT_L(8); PG8_BAR; PG8_WAIT_L(0); PG8_MMA(0, 0, At, B0); PG8_BAR; PG8_SCHED;
            PG8_LDB(B1, 1, 1); PG8_STAGE(PG8_SB(1, 0), b3, voffB);
            PG8_BAR; PG8_WAIT_L(0); PG8_MMA(0, 1, At, B1); PG8_BAR;
            PG8_LDA(At, 1, 1); PG8_STAGE(PG8_SA(1, 0), a3, voffA);
            PG8_BAR; PG8_WAIT_L(0); PG8_MMA(1, 0, At, B0); PG8_BAR; PG8_SCHED;
            PG8_STAGE(PG8_SB(1, 1), b3 + hstep, voffB);
            PG8_WAIT_V(6); PG8_BAR; PG8_MMA(1, 1, At, B1); PG8_BAR;
        }
        PG8_STAMP();
        if constexpr (!Epi::AFTER_DRAIN) { E(acc, cur, wr, wc, fr, fq); S.done(cur); }
        PG8_STAMP();
        if (!has_next) break;
#pragma unroll
        for (int a = 0; a < 2; ++a)
#pragma unroll
            for (int b = 0; b < 2; ++b)
#pragma unroll
                for (int m = 0; m < 4; ++m)
#pragma unroll
                    for (int n = 0; n < 2; ++n) acc[a][b][m][n] = (f32x4){0.f, 0.f, 0.f, 0.f};
        cur = nxt; cA = nA; cB = nB; ++ui;
    }
    PG8_WAIT_V(0);
    if (wr == 0) PG8_BAR;
    PG8_BAR;
    if constexpr (Epi::AFTER_DRAIN) { E.fused(acc, cur, wr, wc, fr, fq, lds, wid, lane); S.done(cur); }
    PG8_STAMP();
    if (STAMP && wid == 0) { stamps[lane] = lane < nts ? (((unsigned long long)(unsigned)ts_hi << 32) | (unsigned)ts_lo) : 0ull;
        if (lane == 62) stamps[62] = rt_entry; if (lane == 63) stamps[63] = (unsigned long long)wall_clock64(); }
#undef PG8_STAMP
#undef PG8_SA
#undef PG8_SB
#undef PG8_STAGE
#undef PG8_LDA
#undef PG8_LDB
#undef PG8_MMA
#undef PG8_WAIT_V
#undef PG8_WAIT_L
#undef PG8_BAR
#undef PG8_SCHED
}
}

namespace {
using pg8::bf16_t;
typedef float f32x4 __attribute__((ext_vector_type(4)));
typedef unsigned u32x4 __attribute__((ext_vector_type(4)));

constexpr int NB = 16, NL = 2048, ND = 1024, NT = NB * NL;
constexpr int EVEN_IN = 2560, ODD_IN = 2608, ODD_PAD = 2304;
constexpr float ALPHA = 1.41421356237f;
constexpr float LN_EPS = 1e-5f;
constexpr float U_SCALE = 256.f, V_SCALE = 16.f;
constexpr int NTHR = 512;
constexpr int LDS_BYTES = 163840;
#ifndef PROBE
#define PROBE 0
#endif
#define PDUP(bit) for (int _rep = 0; _rep < ((PROBE >> (bit)) & 1) + 1; ++_rep)
#ifndef PHMASK
#define PHMASK 0xFFFFFFFFu
#endif
#define PH(n) if (PHMASK & (1u << (n)))

__device__ __forceinline__ float bf2f(bf16_t v) { return __uint_as_float((unsigned)v << 16); }
__device__ __forceinline__ bf16_t f2bf(float f) { unsigned u = __float_as_uint(f); u += 0x7FFFu + ((u >> 16) & 1u); return (bf16_t)(u >> 16); }
__device__ __forceinline__ unsigned pack2(float lo, float hi) { return (unsigned)f2bf(lo) | ((unsigned)f2bf(hi) << 16); }
__device__ __forceinline__ void ld8(const bf16_t* p, float* o) {
    const uint4 v = *(const uint4*)p;
    o[0] = __uint_as_float(v.x << 16); o[1] = __uint_as_float(v.x & 0xffff0000u);
    o[2] = __uint_as_float(v.y << 16); o[3] = __uint_as_float(v.y & 0xffff0000u);
    o[4] = __uint_as_float(v.z << 16); o[5] = __uint_as_float(v.z & 0xffff0000u);
    o[6] = __uint_as_float(v.w << 16); o[7] = __uint_as_float(v.w & 0xffff0000u);
}
__device__ __forceinline__ void st8(bf16_t* p, const float* o) {
    uint4 v; v.x = pack2(o[0], o[1]); v.y = pack2(o[2], o[3]); v.z = pack2(o[4], o[5]); v.w = pack2(o[6], o[7]);
    *(uint4*)p = v;
}

struct EpiBf16s {
    static constexpr bool PERM = true, AFTER_DRAIN = false;
    bf16_t* O; int ldc;
    __device__ __forceinline__ void operator()(const f32x4 (&acc)[2][2][4][2], const pg8::Unit& u, int wr, int wc, int fr, int fq) const {
        const int row0 = u.pm * 256 + wr * 64 + fr, col0 = u.pn * 256 + wc * 32 + 8 * fq;
#pragma unroll
        for (int ai = 0; ai < 2; ++ai)
#pragma unroll
            for (int m = 0; m < 4; ++m) { bf16_t* rowp = O + (size_t)(row0 + ai * 128 + m * 16) * ldc + col0;
#pragma unroll
                for (int bj = 0; bj < 2; ++bj) { const f32x4 v0 = acc[ai][bj][m][0], v1 = acc[ai][bj][m][1];
                    u32x4 w; w.x = pg8::cvt_pk_bf16(v0[0], v0[1]); w.y = pg8::cvt_pk_bf16(v0[2], v0[3]); w.z = pg8::cvt_pk_bf16(v1[0], v1[1]); w.w = pg8::cvt_pk_bf16(v1[2], v1[3]);
                    *(u32x4*)(rowp + bj * 128) = w; } }
    }
};
struct EpiRes {
    static constexpr bool PERM = false, AFTER_DRAIN = false;
    float* C; int ldc; float alpha; float* Cout;
    __device__ __forceinline__ void operator()(const f32x4 (&acc)[2][2][4][2], const pg8::Unit& u, int wr, int wc, int fr, int fq) const {
        const int row0 = u.pm * 256 + wr * 64 + fr, col0 = u.pn * 256 + wc * 32 + 4 * fq; const size_t dlt = Cout - C;
#pragma unroll
        for (int ai = 0; ai < 2; ++ai)
#pragma unroll
            for (int m = 0; m < 4; ++m) { float* rowp = C + (size_t)(row0 + ai * 128 + m * 16) * ldc + col0;
#pragma unroll
                for (int bj = 0; bj < 2; ++bj)
#pragma unroll
                    for (int n = 0; n < 2; ++n) { f32x4* cp = (f32x4*)(rowp + bj * 128 + n * 16); *(cp + dlt / 4) = *cp * alpha + acc[ai][bj][m][n]; } }
    }
};

template <bool IN_BF16>
struct EpiResStats {
    static constexpr bool PERM = false, AFTER_DRAIN = false;
    typename std::conditional<IN_BF16, const bf16_t*, const float*>::type Cin; bf16_t* Vb; float* part;
    __device__ __forceinline__ void operator()(const f32x4 (&acc)[2][2][4][2], const pg8::Unit& u, int wr, int wc, int fr, int fq) const {
        const unsigned row0 = (unsigned)(u.pm * 256 + wr * 64 + fr), col0 = (unsigned)(u.pn * 256 + wc * 32 + 4 * fq);
#pragma unroll
        for (int ai = 0; ai < 2; ++ai)
#pragma unroll
            for (int m = 0; m < 4; ++m) {
                const unsigned row = row0 + (unsigned)(ai * 128 + m * 16);
                const unsigned eo = row * (unsigned)ND + col0;
                float s1 = 0.f, s2 = 0.f;
#pragma unroll
                for (int bj = 0; bj < 2; ++bj)
#pragma unroll
                    for (int n = 0; n < 2; ++n) {
                        f32x4 rin;
                        if constexpr (IN_BF16) {
                            const uint2 w = *(const uint2*)(Cin + (eo + (unsigned)(bj * 128 + n * 16)));
                            rin = (f32x4){__uint_as_float(w.x << 16), __uint_as_float(w.x & 0xffff0000u), __uint_as_float(w.y << 16), __uint_as_float(w.y & 0xffff0000u)};
                        } else rin = *(const f32x4*)(Cin + (eo + (unsigned)(bj * 128 + n * 16)));
                        const f32x4 v = rin * ALPHA + acc[ai][bj][m][n];
                        *(uint2*)(Vb + (eo + (unsigned)(bj * 128 + n * 16))) = make_uint2(pg8::cvt_pk_bf16(v[0], v[1]), pg8::cvt_pk_bf16(v[2], v[3]));
                        s1 += (v[0] + v[1]) + (v[2] + v[3]);
                        s2 += (v[0] * v[0] + v[1] * v[1]) + (v[2] * v[2] + v[3] * v[3]);
                    }
                s1 += __shfl_xor(s1, 16); s2 += __shfl_xor(s2, 16);
                s1 += __shfl_xor(s1, 32); s2 += __shfl_xor(s2, 32);
                if (fq == 0) *(float2*)(part + ((((unsigned)u.pn * (unsigned)NT + row) * 4u + (unsigned)wc) * 2u)) = make_float2(s1, s2);
            }
    }
};
struct EpiBf16LN {
    static constexpr bool PERM = true, AFTER_DRAIN = false;
    bf16_t* O; int ldc; const float* csum; const float* dvec; const float2* stats  ; int pm0, pm1, pm2, pm3;
    __device__ __forceinline__ void operator()(const f32x4 (&acc)[2][2][4][2], const pg8::Unit& u, int wr, int wc, int fr, int fq) const {
        const int slot = (u.pm == pm0) ? 0 : ((u.pm == pm1) ? 1 : ((u.pm == pm2) ? 2 : 3));
        const float2* st = stats + slot * 256;
        const int lrow0 = wr * 64 + fr, col0 = u.pn * 256 + wc * 32 + 8 * fq;
        f32x4 cv[2][2], dv[2][2];
#pragma unroll
        for (int bj = 0; bj < 2; ++bj)
#pragma unroll
            for (int n = 0; n < 2; ++n) { cv[bj][n] = *(const f32x4*)(csum + col0 + bj * 128 + 4 * n); dv[bj][n] = *(const f32x4*)(dvec + col0 + bj * 128 + 4 * n); }
#pragma unroll
        for (int ai = 0; ai < 2; ++ai)
#pragma unroll
            for (int m = 0; m < 4; ++m) {
                const int lrow = lrow0 + ai * 128 + m * 16;
                const float2 ms = st[lrow];
                bf16_t* rowp = O + (size_t)(u.pm * 256 + lrow) * ldc + col0;
#pragma unroll
                for (int bj = 0; bj < 2; ++bj) {
                    const f32x4 v0 = (acc[ai][bj][m][0] - cv[bj][0] * ms.x) * ms.y + dv[bj][0], v1 = (acc[ai][bj][m][1] - cv[bj][1] * ms.x) * ms.y + dv[bj][1];
                    u32x4 w; w.x = pg8::cvt_pk_bf16(v0[0], v0[1]); w.y = pg8::cvt_pk_bf16(v0[2], v0[3]); w.z = pg8::cvt_pk_bf16(v1[0], v1[1]); w.w = pg8::cvt_pk_bf16(v1[2], v1[3]);
                    *(u32x4*)(rowp + bj * 128) = w;
                }
            }
    }
};
__device__ __forceinline__ void gemm_q_phase(unsigned char* lds, const bf16_t* Vb, const bf16_t* Wt, const float* __restrict__ part, const float* csum, const float* dvec, bf16_t* Q) {
    pg8::StaticOrder S; S.init(NT, 2048, (int)gridDim.x, (int)blockIdx.x);
    int pms[4] = {-1, -1, -1, -1};
    float2* st = (float2*)(lds + 131072);
    __syncthreads();
#pragma unroll
    for (int i = 0; i < 4; ++i) {
        pg8::Unit u;
        if (S.next(i, u)) {
            bool seen = false;
#pragma unroll
            for (int j = 0; j < 4; ++j) if (j < i && pms[j] == u.pm) seen = true;
            pms[i] = seen ? -2 - i : u.pm;
            if (!seen && tidx() < 256) {
                const int row = u.pm * 256 + tidx();
                float s1 = 0.f, s2 = 0.f;
#pragma unroll
                for (int pn = 0; pn < 4; ++pn) {
                    const float4* pp = (const float4*)(part + ((size_t)pn * NT + row) * 8);
#pragma unroll
                    for (int k = 0; k < 2; ++k) { const float4 a = pp[k]; s1 += a.x; s2 += a.y; s1 += a.z; s2 += a.w; }
                }
                const float mean = s1 * (1.f / ND), var = fmaxf(s2 * (1.f / ND) - mean * mean, 0.f);
                st[i * 256 + tidx()] = make_float2(mean, rsqrtf(var + LN_EPS));
            }
        }
    }
    __syncthreads();
    pg8::Gemm g{Vb, Wt, NT, 2048, ND};
    EpiBf16LN E{Q, 2048, csum, dvec, st, pms[0], pms[1], pms[2], pms[3]};
    pg8::gemm_phase<EpiBf16LN, pg8::StaticOrder, false>((PG8_LAS unsigned char*)lds, g, S, E, nullptr);
    __syncthreads();
}
template <class Epi>
__device__ __forceinline__ void gemm_bf16_phase(unsigned char* lds, const bf16_t* A, const bf16_t* Bt, int M, int N, int K, const Epi& E, bool reverse_ids = false) {
    pg8::Gemm g{A, Bt, M, N, K};
    pg8::StaticOrder S; S.init(M, N, (int)gridDim.x, reverse_ids ? (int)(gridDim.x - 1 - blockIdx.x) : (int)blockIdx.x);
    pg8::gemm_phase<Epi, pg8::StaticOrder, false>((PG8_LAS unsigned char*)lds, g, S, E, nullptr);
    __syncthreads();
}

struct ColMap { int d0[3], s0[3], len[3]; };
__device__ __forceinline__ void convert_wt_phase(const float* __restrict__ W, int K, int N, int Npad, const ColMap cm, bf16_t* __restrict__ Wt, float* lds, const float* __restrict__ rowscale = nullptr) {
    float(*tile)[65] = (float(*)[65])lds;
    const int tid = tidx(), ntn = Npad / 64, ntiles = (K / 64) * ntn;
    for (int it = blockIdx.x; it < ntiles; it += gridDim.x) {
        const int k0 = (it / ntn) * 64, n0 = (it % ntn) * 64;
        __syncthreads();
#pragma unroll
        for (int h = 0; h < 2; ++h) {
            const int r = (tid >> 4) + h * 32, c4 = (tid & 15) * 4, nd = n0 + c4;
            int ns = -1;
#pragma unroll
            for (int sg = 0; sg < 3; ++sg) if (nd >= cm.d0[sg] && nd < cm.d0[sg] + cm.len[sg]) ns = cm.s0[sg] + (nd - cm.d0[sg]);
            float4 v = make_float4(0.f, 0.f, 0.f, 0.f);
            if (ns >= 0) v = *(const float4*)(W + (size_t)(k0 + r) * N + ns);
            if (rowscale) { const float gsc = rowscale[k0 + r]; v.x *= gsc; v.y *= gsc; v.z *= gsc; v.w *= gsc; }
            tile[r][c4] = v.x; tile[r][c4 + 1] = v.y; tile[r][c4 + 2] = v.z; tile[r][c4 + 3] = v.w;
        }
        __syncthreads();
        const int n = tid >> 3, k8 = (tid & 7) * 8;
        float o[8];
#pragma unroll
        for (int j = 0; j < 8; ++j) o[j] = tile[k8 + j][n];
        st8(Wt + (size_t)(n0 + n) * K + k0 + k8, o);
    }
    __syncthreads();
}
__device__ __forceinline__ float gelu_tanh(float x) {
    float u = 0.7978845608028654f * (x + 0.044715f * x * x * x);
    return 0.5f * x * (1.f + tanhf(u));
}
__device__ __forceinline__ float sigmoidf_(float x) { return 1.f / (1.f + expf(-x)); }
__device__ __forceinline__ void wave_lds_fence() { asm volatile("s_waitcnt lgkmcnt(0)" ::: "memory"); }
__device__ __forceinline__ void lds_barrier() { asm volatile("s_waitcnt lgkmcnt(0)" ::: "memory"); __builtin_amdgcn_s_barrier(); asm volatile("" ::: "memory"); }

__device__ __forceinline__ void s5_scan_wave(int bg, const bf16_t* __restrict__ proj, const float* __restrict__ lam_re, const float* __restrict__ lam_im,
                             const float* __restrict__ log_dt, const float* __restrict__ b_re, const float* __restrict__ b_im,
                             const float* __restrict__ c_re, const float* __restrict__ c_im, const float* __restrict__ dskip,
                             float* __restrict__ ya, float* lds) {
    const int b = bg >> 4, g = bg & 15, lane = tidx() & 63;
    float(*us)[16] = (float(*)[16])lds;
    float(*xr)[65] = (float(*)[65])(lds + 1024);
    float(*xi)[65] = (float(*)[65])(lds + 1024 + 4160);
    float(*cr)[64] = (float(*)[64])(lds + 1024 + 8320);
    float(*ci)[64] = (float(*)[64])(lds + 1024 + 8320 + 1024);
    const float lr = lam_re[g * 64 + lane], li = lam_im[g * 64 + lane];
    const float dt = expf(log_dt[g]);
    const float mag = expf(lr * dt);
    const float are = mag * cosf(li * dt), aim = mag * sinf(li * dt);
    const float nr = are - 1.f, den = lr * lr + li * li;
    const float fre = (nr * lr + aim * li) / den, fim = (aim * lr - nr * li) / den;
    float bbr[16], bbi[16];
#pragma unroll
    for (int i = 0; i < 16; ++i) {
        const float br = b_re[(g * 64 + lane) * 16 + i], bi = b_im[(g * 64 + lane) * 16 + i];
        bbr[i] = fre * br - fim * bi; bbi[i] = fre * bi + fim * br;
    }
    for (int idx = lane; idx < 1024; idx += 64) { cr[idx >> 6][idx & 63] = c_re[g * 1024 + idx]; ci[idx >> 6][idx & 63] = c_im[g * 1024 + idx]; }
    float dsk[16];
#pragma unroll
    for (int i = 0; i < 16; ++i) dsk[i] = dskip[g * 16 + i];
    float xre = 0.f, xim = 0.f;
    for (int t0 = 0; t0 < NL; t0 += 64) {
        wave_lds_fence();
        for (int idx = lane; idx < 1024; idx += 64) { const int t = idx >> 4, i = idx & 15; us[t][i] = bf2f(proj[(size_t)(b * NL + t0 + t) * EVEN_IN + g * 16 + i]); }
        wave_lds_fence();
        for (int t = 0; t < 64; ++t) {
            float bur = 0.f, bui = 0.f;
#pragma unroll
            for (int i = 0; i < 16; ++i) { const float u = us[t][i]; bur += bbr[i] * u; bui += bbi[i] * u; }
            const float nre = are * xre - aim * xim + bur, nim = are * xim + aim * xre + bui;
            xre = nre; xim = nim;
            xr[t][lane] = xre; xi[t][lane] = xim;
        }
        wave_lds_fence();
        float y[16];
#pragma unroll
        for (int i = 0; i < 16; ++i) y[i] = 0.f;
        for (int p = 0; p < 64; ++p) {
            const float a = xr[lane][p], bq = xi[lane][p];
#pragma unroll
            for (int i = 0; i < 16; ++i) y[i] += cr[i][p] * a - ci[i][p] * bq;
        }
#pragma unroll
        for (int i = 0; i < 16; ++i) {
            const float v = y[i] + dsk[i] * us[lane][i];
            ya[(size_t)(b * NL + t0 + lane) * 256 + g * 16 + i] = gelu_tanh(v);
        }
    }
}

__device__ __forceinline__ void sb_attn_wave(int task, const bf16_t* __restrict__ proj, bf16_t* __restrict__ Y, float* wl) {
    const int qt = task & 31, h = (task >> 5) % 12, b = task / 384, lane = tidx() & 63;
    const int t = qt * 64 + lane;
    float(*ks)[64] = (float(*)[64])wl;
    float(*vs)[64] = (float(*)[64])(wl + 2048);
    const bf16_t* base = proj + (size_t)b * NL * EVEN_IN;
    float q[64], acc[64];
#pragma unroll
    for (int d = 0; d < 64; d += 8) ld8(base + (size_t)t * EVEN_IN + 256 + h * 64 + d, q + d);
#pragma unroll
    for (int d = 0; d < 64; ++d) acc[d] = 0.f;
    float tail = 0.f;
    for (int c = 2 * qt + 1; c >= 0; --c) {
        wave_lds_fence();
        for (int i = 0; i < 32; ++i) {
            ks[i][lane] = bf2f(base[(size_t)(c * 32 + i) * EVEN_IN + 1024 + h * 64 + lane]);
            vs[i][lane] = bf2f(base[(size_t)(c * 32 + i) * EVEN_IN + 1792 + h * 64 + lane]);
        }
        wave_lds_fence();
        for (int s = 31; s >= 0; --s) {
            const int key = c * 32 + s;
            float z = 0.f;
#pragma unroll
            for (int d = 0; d < 64; ++d) z += q[d] * ks[s][d];
            z *= 0.125f;
            const bool valid = key < t;
            const float sp = fmaxf(z, 0.f) + log1pf(expf(-fabsf(z)));
            const float w = valid ? expf(z - sp + tail) : 0.f;
#pragma unroll
            for (int d = 0; d < 64; ++d) acc[d] += w * vs[s][d];
            if (valid) tail -= sp;
        }
        if (__all(tail < -120.f)) break;
    }
#pragma unroll
    for (int d = 0; d < 64; d += 8) st8(Y + (size_t)(b * NL + t) * ND + 256 + h * 64 + d, acc + d);
}

__device__ __forceinline__ void glu_phase(const float* __restrict__ ya, const float* __restrict__ wglu, const float* __restrict__ bglu, bf16_t* __restrict__ Y, float* lds) {
    const int half = tidx() >> 8, c = tidx() & 255;
    float(*ys)[256] = (float(*)[256])(lds + half * 4096);
    for (int it = blockIdx.x; it < NT / 32; it += gridDim.x) {
        const int t0 = it * 32 + half * 16;
        __syncthreads();
        for (int i = 0; i < 16; ++i) ys[i][c] = ya[(size_t)(t0 + i) * 256 + c];
        __syncthreads();
        float acc[16];
#pragma unroll
        for (int i = 0; i < 16; ++i) acc[i] = 0.f;
        for (int k = 0; k < 256; ++k) {
            const float w = wglu[k * 256 + c];
#pragma unroll
            for (int i = 0; i < 16; ++i) acc[i] += ys[i][k] * w;
        }
        const float bb = bglu[c];
#pragma unroll
        for (int i = 0; i < 16; ++i) Y[(size_t)(t0 + i) * ND + c] = f2bf(ys[i][c] * sigmoidf_(acc[i] + bb));
    }
    __syncthreads();
}

__device__ __forceinline__ void ln_row_wave(float4 (&v)[4], const float* __restrict__ g, const float* __restrict__ bta, float* out, bf16_t* outb, int lane) {
    float s = 0.f;
#pragma unroll
    for (int j = 0; j < 4; ++j) s += v[j].x + v[j].y + v[j].z + v[j].w;
    for (int o = 32; o; o >>= 1) s += __shfl_xor(s, o);
    const float mean = s * (1.f / ND);
    float s2 = 0.f;
#pragma unroll
    for (int j = 0; j < 4; ++j) {
        v[j].x -= mean; v[j].y -= mean; v[j].z -= mean; v[j].w -= mean;
        s2 += v[j].x * v[j].x + v[j].y * v[j].y + v[j].z * v[j].z + v[j].w * v[j].w;
    }
    for (int o = 32; o; o >>= 1) s2 += __shfl_xor(s2, o);
    const float rs = rsqrtf(s2 * (1.f / ND) + LN_EPS);
#pragma unroll
    for (int j = 0; j < 4; ++j) {
        const float4 gg = *(const float4*)(g + j * 256 + lane * 4), bb = *(const float4*)(bta + j * 256 + lane * 4);
        const float4 o = make_float4(v[j].x * rs * gg.x + bb.x, v[j].y * rs * gg.y + bb.y, v[j].z * rs * gg.z + bb.z, v[j].w * rs * gg.w + bb.w);
        *(float4*)(out + j * 256 + lane * 4) = o;
        if (outb) { uint2 w; w.x = pack2(o.x, o.y); w.y = pack2(o.z, o.w); *(uint2*)(outb + j * 256 + lane * 4) = w; }
    }
}
__device__ __forceinline__ void ln_phase(float* R, bf16_t* Hb, const float* __restrict__ g, const float* __restrict__ bta) {
    const int wave = tidx() >> 6, lane = tidx() & 63;
    for (int row = blockIdx.x * 8 + wave; row < NT; row += gridDim.x * 8) {
        float4 v[4];
#pragma unroll
        for (int j = 0; j < 4; ++j) v[j] = *(const float4*)(R + (size_t)row * ND + j * 256 + lane * 4);
        ln_row_wave(v, g, bta, R + (size_t)row * ND, Hb + (size_t)row * ND, lane);
    }
}

__device__ __forceinline__ void wave_argmax(float& bv, int& bi) {
#pragma unroll
    for (int o = 32; o; o >>= 1) {
        const float ov = __shfl_xor(bv, o); const int oi = __shfl_xor(bi, o);
        if (ov > bv || (ov == bv && oi < bi)) { bv = ov; bi = oi; }
    }
}
__device__ __forceinline__ void peer_route_phase(const bf16_t* __restrict__ qbuf, const float* __restrict__ subk, int* __restrict__ eidx, float* __restrict__ egate, float* lds) {
    const int head = tidx() >> 6, lane = tidx() & 63;
    float* qs = lds + head * 256;
    for (int token = blockIdx.x; token < NT; token += gridDim.x) {
        const bf16_t* qp = qbuf + (size_t)token * 2048 + head * 256;
        wave_lds_fence();
        for (int i = 0; i < 4; ++i) qs[lane + 64 * i] = bf2f(qp[lane + 64 * i]);
        wave_lds_fence();
        float myv[2]; int myi[2];
#pragma unroll
        for (int c = 0; c < 2; ++c) {
            float sc[2];
#pragma unroll
            for (int w2 = 0; w2 < 2; ++w2) {
                const float* kr = subk + ((size_t)(head * 2 + c) * 128 + lane + 64 * w2) * 128;
                float a = 0.f;
#pragma unroll 4
                for (int d = 0; d < 128; d += 4) {
                    const float4 kv = *(const float4*)(kr + d);
                    a += qs[c * 128 + d] * kv.x + qs[c * 128 + d + 1] * kv.y + qs[c * 128 + d + 2] * kv.z + qs[c * 128 + d + 3] * kv.w;
                }
                sc[w2] = a;
            }
            float a0 = sc[0], a1 = sc[1];
            float mv = -INFINITY; int mi = 0;
            for (int r = 0; r < 16; ++r) {
                float bv; int bi;
                if (a0 >= a1) { bv = a0; bi = lane; } else { bv = a1; bi = lane + 64; }
                wave_argmax(bv, bi);
                if (lane == r) { mv = bv; mi = bi; }
                if (bi == lane) a0 = -INFINITY; else if (bi == lane + 64) a1 = -INFINITY;
            }
            myv[c] = mv; myi[c] = mi;
        }
        const float va = __shfl(myv[0], lane >> 2);
        float cand[4];
#pragma unroll
        for (int j = 0; j < 4; ++j) cand[j] = va + __shfl(myv[1], (lane & 3) * 4 + j);
        float topv = -INFINITY; int topf = 0;
        for (int r = 0; r < 16; ++r) {
            float bv = cand[0]; int bi = lane * 4;
#pragma unroll
            for (int j = 1; j < 4; ++j) if (cand[j] > bv) { bv = cand[j]; bi = lane * 4 + j; }
            wave_argmax(bv, bi);
            if (lane == r) { topv = bv; topf = bi; }
#pragma unroll
            for (int j = 0; j < 4; ++j) if (bi == lane * 4 + j) cand[j] = -INFINITY;
        }
        const int e1 = __shfl(myi[0], topf >> 4), e2 = __shfl(myi[1], topf & 15);
        const float top0 = __shfl(topv, 0);
        float ex = (lane < 16) ? expf(topv - top0) : 0.f;
        float sum = ex;
        for (int o = 32; o; o >>= 1) sum += __shfl_xor(sum, o);
        if (lane < 16) {
            eidx[(size_t)token * 128 + head * 16 + lane] = e1 * 128 + e2;
            egate[(size_t)token * 128 + head * 16 + lane] = ex / sum;
        }
    }
}

__device__ __forceinline__ void peer_expert_phase(float* R, const int* __restrict__ eidx, const float* __restrict__ egate, const float* __restrict__ utab,
                                  const float* __restrict__ vtab, const float* __restrict__ lg, const float* __restrict__ lb, bf16_t* Hb) {
    const int wave = tidx() >> 6, lane = tidx() & 63;
    for (int token = blockIdx.x * 8 + wave; token < NT; token += gridDim.x * 8) {
        float4 x[4], acc[4];
#pragma unroll
        for (int j = 0; j < 4; ++j) { x[j] = *(const float4*)(R + (size_t)token * ND + j * 256 + lane * 4); acc[j] = make_float4(0.f, 0.f, 0.f, 0.f); }
        for (int e0 = 0; e0 < 128; e0 += 4) {
            float dot[4]; int ex[4]; float gt[4];
#pragma unroll
            for (int k = 0; k < 4; ++k) {
                ex[k] = eidx[(size_t)token * 128 + e0 + k]; gt[k] = egate[(size_t)token * 128 + e0 + k];
                const float* ur = utab + (size_t)ex[k] * ND + lane * 4;
                float a = 0.f;
#pragma unroll
                for (int j = 0; j < 4; ++j) { const float4 u = *(const float4*)(ur + j * 256); a += x[j].x * u.x + x[j].y * u.y + x[j].z * u.z + x[j].w * u.w; }
                dot[k] = a;
            }
#pragma unroll
            for (int k = 0; k < 4; ++k) {
                float a = dot[k];
                for (int o = 32; o; o >>= 1) a += __shfl_xor(a, o);
                const float coef = gt[k] * gelu_tanh(a);
                const float* vr = vtab + (size_t)ex[k] * ND + lane * 4;
#pragma unroll
                for (int j = 0; j < 4; ++j) { const float4 v = *(const float4*)(vr + j * 256); acc[j].x += coef * v.x; acc[j].y += coef * v.y; acc[j].z += coef * v.z; acc[j].w += coef * v.w; }
            }
        }
#pragma unroll
        for (int j = 0; j < 4; ++j) { x[j].x = ALPHA * x[j].x + acc[j].x; x[j].y = ALPHA * x[j].y + acc[j].y; x[j].z = ALPHA * x[j].z + acc[j].z; x[j].w = ALPHA * x[j].w + acc[j].w; }
        ln_row_wave(x, lg, lb, R + (size_t)token * ND, Hb ? Hb + (size_t)token * ND : nullptr, lane);
    }
}


typedef short bf16x8_t __attribute__((ext_vector_type(8)));
__device__ __forceinline__ int f2key(float f) { const int b = __float_as_int(f); return b ^ ((b >> 31) & 0x7fffffff); }
__device__ __forceinline__ float key2f(int k) { return __int_as_float(k ^ ((k >> 31) & 0x7fffffff)); }
#define CE_DESC_I(a, b) do { const int _hi = max(a, b), _lo = min(a, b); a = _hi; b = _lo; } while (0)
template <int N, int K, int J> __device__ __forceinline__ void bstage(int (&v)[N]) {
#pragma unroll
    for (int i = 0; i < N; ++i) {
        const int l = i ^ J;
        if (l > i) { if ((i & K) == 0) CE_DESC_I(v[i], v[l]); else CE_DESC_I(v[l], v[i]); }
    }
}
__device__ __forceinline__ void sort16_desc(int (&v)[16]) {
    bstage<16, 2, 1>(v); bstage<16, 4, 2>(v); bstage<16, 4, 1>(v); bstage<16, 8, 4>(v); bstage<16, 8, 2>(v); bstage<16, 8, 1>(v);
    bstage<16, 16, 8>(v); bstage<16, 16, 4>(v); bstage<16, 16, 2>(v); bstage<16, 16, 1>(v);
}
__device__ __forceinline__ void sort8_desc(int (&v)[8]) {
    bstage<8, 2, 1>(v); bstage<8, 4, 2>(v); bstage<8, 4, 1>(v); bstage<8, 8, 4>(v); bstage<8, 8, 2>(v); bstage<8, 8, 1>(v);
}
__device__ __forceinline__ void bitonic_merge16_desc(int (&v)[16]) {
    bstage<16, 16, 8>(v); bstage<16, 16, 4>(v); bstage<16, 16, 2>(v); bstage<16, 16, 1>(v);
}
__device__ __forceinline__ void xmerge16(int (&v)[16], int off) {
    int m[16];
#pragma unroll
    for (int i = 0; i < 16; ++i) m[i] = max(v[i], __shfl_xor(v[15 - i], off));
    bitonic_merge16_desc(m);
#pragma unroll
    for (int i = 0; i < 16; ++i) v[i] = m[i];
}
__device__ __forceinline__ void opaque16(int (&v)[16]) {
#pragma unroll
    for (int i = 0; i < 16; ++i) asm volatile("" : "+v"(v[i]));
}
__device__ __forceinline__ int lookup16(const int (&arr)[16], int a) {
    int r = arr[0];
#pragma unroll
    for (int i = 1; i < 16; ++i) r = (a == i) ? arr[i] : r;
    return r;
}
__device__ __forceinline__ void peer_route2_phase(const bf16_t* __restrict__ qbuf, const bf16_t* __restrict__ skb, int* __restrict__ eidx, float* __restrict__ egate, unsigned char* lds) {
    if (__builtin_amdgcn_readfirstlane(tidx() >> 6) >= 4) __builtin_amdgcn_s_setprio(1);
    const int tid = tidx(), wave = tid >> 6, lane = tid & 63, fr = lane & 15, fq = lane >> 4;
    for (int chunk = blockIdx.x; chunk < NT / 128; chunk += gridDim.x) {
        const int token = chunk * 128 + wave * 16 + fr;
        int* tl = (int*)(lds + 69632) + (wave * 16 + fr) * 48;
        const int srow = tid >> 4, sch = tid & 15;
        const bf16_t* kg = skb + (size_t)srow * 128 + sch * 8;
        unsigned char* kl = lds + srow * 272 + sch * 16;
        const bf16_t* qg = qbuf + (size_t)token * 2048 + 8 * fq;
        uint4 kr0 = *(const uint4*)(kg), kr1 = *(const uint4*)(kg + 32 * 128), kr2 = *(const uint4*)(kg + 64 * 128), kr3 = *(const uint4*)(kg + 96 * 128);
        bf16x8_t qn0 = *(const bf16x8_t*)(qg), qn1 = *(const bf16x8_t*)(qg + 32), qn2 = *(const bf16x8_t*)(qg + 64), qn3 = *(const bf16x8_t*)(qg + 96);
        __syncthreads();
        *(uint4*)(kl) = kr0; *(uint4*)(kl + 32 * 272) = kr1; *(uint4*)(kl + 64 * 272) = kr2; *(uint4*)(kl + 96 * 272) = kr3;
        lds_barrier();
        for (int h = 0; h < 8; ++h) {
            int K1[16], K2[16];
#pragma unroll
            for (int c = 0; c < 2; ++c) {
                const int step = 2 * h + c;
                const unsigned char* kt_lds = lds + (step & 1) * 34816;
                const bf16x8_t qf0 = qn0, qf1 = qn1, qf2 = qn2, qf3 = qn3;
                {
                    const int sn = step < 15 ? step + 1 : step;
                    const bf16_t* kgn = kg + (size_t)sn * 128 * 128;
                    kr0 = *(const uint4*)(kgn); kr1 = *(const uint4*)(kgn + 32 * 128); kr2 = *(const uint4*)(kgn + 64 * 128); kr3 = *(const uint4*)(kgn + 96 * 128);
                    const bf16_t* qgn = qg + sn * 128;
                    qn0 = *(const bf16x8_t*)(qgn); qn1 = *(const bf16x8_t*)(qgn + 32); qn2 = *(const bf16x8_t*)(qgn + 64); qn3 = *(const bf16x8_t*)(qgn + 96);
                }
                int va[16], vb[16];
#pragma unroll
                for (int n = 0; n < 8; ++n) {
                    f32x4 S = {0.f, 0.f, 0.f, 0.f};
#pragma unroll
                    for (int sI = 0; sI < 4; ++sI) {
                        const bf16x8_t kf = *(const bf16x8_t*)(kt_lds + (16 * n + fr) * 272 + (32 * sI + 8 * fq) * 2);
                        S = __builtin_amdgcn_mfma_f32_16x16x32_bf16(kf, sI == 0 ? qf0 : (sI == 1 ? qf1 : (sI == 2 ? qf2 : qf3)), S, 0, 0, 0);
                    }
#pragma unroll
                    for (int j = 0; j < 4; ++j) {
                        const int key = (f2key(S[j]) & ~127) | (16 * n + 4 * fq + j);
                        if (n < 4) va[n * 4 + j] = key; else vb[(n - 4) * 4 + j] = key;
                    }
                }
                sort16_desc(va); sort16_desc(vb);
                int m[16];
#pragma unroll
                for (int i = 0; i < 16; ++i) m[i] = max(va[i], vb[15 - i]);
                bitonic_merge16_desc(m);
                xmerge16(m, 16); xmerge16(m, 32);
#pragma unroll
                for (int i = 0; i < 16; ++i) { if (c == 0) K1[i] = m[i]; else K2[i] = m[i]; }
                if (fq == 0) {
#pragma unroll
                    for (int i = 0; i < 4; ++i) *(int4*)(tl + c * 16 + 4 * i) = make_int4(m[4 * i], m[4 * i + 1], m[4 * i + 2], m[4 * i + 3]);
                }
                if (step < 15) {
                    unsigned char* kln = kl + ((step + 1) & 1) * 34816;
                    *(uint4*)(kln) = kr0; *(uint4*)(kln + 32 * 272) = kr1; *(uint4*)(kln + 64 * 272) = kr2; *(uint4*)(kln + 96 * 272) = kr3;
                    lds_barrier();
                }
            }
            wave_lds_fence();
            float vaf[4];
#pragma unroll
            for (int k = 0; k < 4; ++k) vaf[k] = key2f(tl[4 * k + fq]);
            int A[16];
#pragma unroll
            for (int b = 0; b < 16; ++b) {
                const bool valid = (fq + 1) * (b + 1) <= 16;
                const int key = (f2key(vaf[0] + key2f(K2[b])) & ~127) | (fq << 5) | b;
                A[b] = valid ? key : INT_MIN;
            }
            int Bq[8];
#pragma unroll
            for (int b = 0; b < 3; ++b) {
                const bool valid = (fq + 5) * (b + 1) <= 16;
                const int key = (f2key(vaf[1] + key2f(K2[b])) & ~127) | (fq << 5) | (16 + b);
                Bq[b] = valid ? key : INT_MIN;
            }
            Bq[3] = (f2key(vaf[2] + key2f(K2[0])) & ~127) | (fq << 5) | 19;
            Bq[4] = (f2key(vaf[3] + key2f(K2[0])) & ~127) | (fq << 5) | 20;
            Bq[5] = INT_MIN; Bq[6] = INT_MIN; Bq[7] = INT_MIN;
            sort8_desc(Bq);
#pragma unroll
            for (int i = 8; i < 16; ++i) A[i] = max(A[i], Bq[15 - i]);
            bitonic_merge16_desc(A);
            xmerge16(A, 16); xmerge16(A, 32);
            if (fq == 0) {
#pragma unroll
                for (int i = 0; i < 4; ++i) *(int4*)(tl + 32 + 4 * i) = make_int4(A[4 * i], A[4 * i + 1], A[4 * i + 2], A[4 * i + 3]);
            }
            wave_lds_fence();
            const int4 myT = *(const int4*)(tl + 32 + 4 * fq);
            const int tsel[4] = {myT.x, myT.y, myT.z, myT.w};
            const float top0 = key2f(A[0]);
            float sum = 0.f;
#pragma unroll
            for (int r = 0; r < 16; ++r) sum += __expf(key2f(A[r]) - top0);
            const float inv = 1.f / sum;
            int eo[4]; float go[4];
#pragma unroll
            for (int kk = 0; kk < 4; ++kk) {
                const int t = tsel[kk];
                const int id = t & 127, ofq = id >> 5, slot = id & 31;
                const int k = slot < 16 ? 0 : (slot < 19 ? 1 : (slot == 19 ? 2 : 3));
                const int b = slot < 16 ? slot : (slot < 19 ? slot - 16 : 0);
                const int a = ofq + 4 * k;
                const int e1 = tl[a] & 127, e2 = tl[16 + b] & 127;
                eo[kk] = e1 * 128 + e2;
                go[kk] = __expf(key2f(t) - top0) * inv;
            }
            *(int4*)(eidx + (size_t)token * 128 + h * 16 + 4 * fq) = make_int4(eo[0], eo[1], eo[2], eo[3]);
            *(float4*)(egate + (size_t)token * 128 + h * 16 + 4 * fq) = make_float4(go[0], go[1], go[2], go[3]);
            wave_lds_fence();
        }
    }
    __syncthreads();
    __builtin_amdgcn_s_setprio(0);
}

typedef __bf16 bf16x2_t __attribute__((ext_vector_type(2)));
typedef float f32x2_t __attribute__((ext_vector_type(2)));
__device__ __forceinline__ float dot2bf(unsigned a, unsigned b, float acc) { return __builtin_amdgcn_fdot2_f32_bf16(__builtin_bit_cast(bf16x2_t, a), __builtin_bit_cast(bf16x2_t, b), acc, false); }
__device__ __forceinline__ float gelu_fast(float x) {
    const float u = 0.7978845608028654f * (x + 0.044715f * x * x * x);
    return x / (1.f + __expf(-2.f * u));
}
__device__ __forceinline__ void peer_expert2_phase(float* R, const int* __restrict__ eidx, const float* __restrict__ egate, const bf16_t* __restrict__ ub,
                                                   const bf16_t* __restrict__ vb, const float* __restrict__ lg, const float* __restrict__ lb, bf16_t* Hb) {
    const int wave = tidx() >> 6, lane = tidx() & 63;
    for (int token = blockIdx.x * 8 + wave; token < NT; token += gridDim.x * 8) {
        float xf[16];
        {
            const float* rp = R + (size_t)token * ND + lane * 8;
            const float4 a0 = *(const float4*)rp, a1 = *(const float4*)(rp + 4), b0 = *(const float4*)(rp + 512), b1 = *(const float4*)(rp + 516);
            xf[0] = a0.x; xf[1] = a0.y; xf[2] = a0.z; xf[3] = a0.w; xf[4] = a1.x; xf[5] = a1.y; xf[6] = a1.z; xf[7] = a1.w;
            xf[8] = b0.x; xf[9] = b0.y; xf[10] = b0.z; xf[11] = b0.w; xf[12] = b1.x; xf[13] = b1.y; xf[14] = b1.z; xf[15] = b1.w;
        }
        unsigned xp[8];
#pragma unroll
        for (int j = 0; j < 8; ++j) xp[j] = pack2(xf[2 * j], xf[2 * j + 1]);
        float acc[16];
#pragma unroll
        for (int j = 0; j < 16; ++j) acc[j] = 0.f;
        const int e_lo = eidx[(size_t)token * 128 + lane], e_hi = eidx[(size_t)token * 128 + 64 + lane];
        const float g_lo = egate[(size_t)token * 128 + lane], g_hi = egate[(size_t)token * 128 + 64 + lane];
        for (int grp = 0; grp < 16; ++grp) {
            const int esel = grp < 8 ? e_lo : e_hi;
            const float gsel = grp < 8 ? g_lo : g_hi;
            const int lbase = (grp & 7) * 8;
            uint4 u0[8], u1[8];
            int exs[8];
#pragma unroll
            for (int k = 0; k < 8; ++k) {
                exs[k] = __builtin_amdgcn_readlane(esel, lbase + k);
                const bf16_t* up = ub + (size_t)exs[k] * ND + lane * 8;
                u0[k] = *(const uint4*)up; u1[k] = *(const uint4*)(up + 512);
            }
            float d[8];
#pragma unroll
            for (int k = 0; k < 8; ++k) {
                float a = dot2bf(u0[k].x, xp[0], 0.f), b = dot2bf(u0[k].y, xp[1], 0.f);
                a = dot2bf(u0[k].z, xp[2], a); b = dot2bf(u0[k].w, xp[3], b);
                a = dot2bf(u1[k].x, xp[4], a); b = dot2bf(u1[k].y, xp[5], b);
                a = dot2bf(u1[k].z, xp[6], a); b = dot2bf(u1[k].w, xp[7], b);
                d[k] = a + b;
            }
            const bool hi5 = lane & 32, hi4 = lane & 16, hi3 = lane & 8;
            float r4[4], r2[2], r1;
#pragma unroll
            for (int k = 0; k < 4; ++k) { const float send = hi5 ? d[k] : d[k + 4], keep = hi5 ? d[k + 4] : d[k]; r4[k] = keep + __shfl_xor(send, 32); }
#pragma unroll
            for (int k = 0; k < 2; ++k) { const float send = hi4 ? r4[k] : r4[k + 2], keep = hi4 ? r4[k + 2] : r4[k]; r2[k] = keep + __shfl_xor(send, 16); }
            { const float send = hi3 ? r2[0] : r2[1], keep = hi3 ? r2[1] : r2[0]; r1 = keep + __shfl_xor(send, 8); }
            r1 += __shfl_xor(r1, 4); r1 += __shfl_xor(r1, 2); r1 += __shfl_xor(r1, 1);
            uint4 v0[8], v1[8];
#pragma unroll
            for (int k = 0; k < 8; ++k) {
                const bf16_t* vp = vb + (size_t)exs[k] * ND + lane * 8;
                v0[k] = *(const uint4*)vp; v1[k] = *(const uint4*)(vp + 512);
            }
            const float gk = __shfl(gsel, lbase + (lane >> 3));
            const float coef = gk * gelu_fast(r1);
#pragma unroll
            for (int k = 0; k < 8; ++k) {
                const float ck = __int_as_float(__builtin_amdgcn_readlane(__float_as_int(coef), 8 * k));
                const unsigned w[8] = {v0[k].x, v0[k].y, v0[k].z, v0[k].w, v1[k].x, v1[k].y, v1[k].z, v1[k].w};
#pragma unroll
                for (int j = 0; j < 8; ++j) {
                    acc[2 * j] += ck * __uint_as_float(w[j] << 16);
                    acc[2 * j + 1] += ck * __uint_as_float(w[j] & 0xffff0000u);
                }
            }
        }
        {
            const float* rp = R + (size_t)token * ND + lane * 8;
            const float4 a0 = *(const float4*)rp, a1 = *(const float4*)(rp + 4), b0 = *(const float4*)(rp + 512), b1 = *(const float4*)(rp + 516);
            xf[0] = a0.x; xf[1] = a0.y; xf[2] = a0.z; xf[3] = a0.w; xf[4] = a1.x; xf[5] = a1.y; xf[6] = a1.z; xf[7] = a1.w;
            xf[8] = b0.x; xf[9] = b0.y; xf[10] = b0.z; xf[11] = b0.w; xf[12] = b1.x; xf[13] = b1.y; xf[14] = b1.z; xf[15] = b1.w;
        }
        float s = 0.f;
#pragma unroll
        for (int j = 0; j < 16; ++j) { xf[j] = ALPHA * xf[j] + acc[j]; s += xf[j]; }
        for (int o = 32; o; o >>= 1) s += __shfl_xor(s, o);
        const float mean = s * (1.f / ND);
        float s2 = 0.f;
#pragma unroll
        for (int j = 0; j < 16; ++j) { xf[j] -= mean; s2 += xf[j] * xf[j]; }
        for (int o = 32; o; o >>= 1) s2 += __shfl_xor(s2, o);
        const float rs = rsqrtf(s2 * (1.f / ND) + LN_EPS);
#pragma unroll
        for (int hf = 0; hf < 2; ++hf) {
            const int c0 = hf * 512 + lane * 8;
            const float4 g0 = *(const float4*)(lg + c0), g1 = *(const float4*)(lg + c0 + 4), b0 = *(const float4*)(lb + c0), b1 = *(const float4*)(lb + c0 + 4);
            float o[8];
            o[0] = xf[hf * 8 + 0] * rs * g0.x + b0.x; o[1] = xf[hf * 8 + 1] * rs * g0.y + b0.y; o[2] = xf[hf * 8 + 2] * rs * g0.z + b0.z; o[3] = xf[hf * 8 + 3] * rs * g0.w + b0.w;
            o[4] = xf[hf * 8 + 4] * rs * g1.x + b1.x; o[5] = xf[hf * 8 + 5] * rs * g1.y + b1.y; o[6] = xf[hf * 8 + 6] * rs * g1.z + b1.z; o[7] = xf[hf * 8 + 7] * rs * g1.w + b1.w;
            float* op = R + (size_t)token * ND + c0;
            *(float4*)op = make_float4(o[0], o[1], o[2], o[3]); *(float4*)(op + 4) = make_float4(o[4], o[5], o[6], o[7]);
            if (Hb) st8(Hb + (size_t)token * ND + c0, o);
        }
    }
}


template <int K2, int J> __device__ __forceinline__ void bsort_round(int (&k)[2], float (&g)[2], int lane) {
    if (J == 64) {
        const bool sw = k[0] > k[1];
        const int t = k[0]; const float tg = g[0];
        k[0] = sw ? k[1] : k[0]; g[0] = sw ? g[1] : g[0]; k[1] = sw ? t : k[1]; g[1] = sw ? tg : g[1];
    } else {
#pragma unroll
        for (int r = 0; r < 2; ++r) {
            const int pk = __shfl_xor(k[r], J); const float pg = __shfl_xor(g[r], J);
            const bool asc = (((lane + 64 * r) & K2) == 0), lower = ((lane & J) == 0);
            const bool take = (lower == asc) ? (pk < k[r]) : (pk > k[r]);
            k[r] = take ? pk : k[r]; g[r] = take ? pg : g[r];
        }
    }
}
template <int K2> __device__ __forceinline__ void bsort_stage(int (&k)[2], float (&g)[2], int lane) {
    if (K2 >= 128) bsort_round<K2, 64>(k, g, lane);
    if (K2 >= 64) bsort_round<K2, 32>(k, g, lane);
    if (K2 >= 32) bsort_round<K2, 16>(k, g, lane);
    if (K2 >= 16) bsort_round<K2, 8>(k, g, lane);
    if (K2 >= 8) bsort_round<K2, 4>(k, g, lane);
    if (K2 >= 4) bsort_round<K2, 2>(k, g, lane);
    bsort_round<K2, 1>(k, g, lane);
}
__device__ __forceinline__ void sort_routing(int& e_lo, int& e_hi, float& g_lo, float& g_hi, int lane) {
    int k[2] = {e_lo, e_hi}; float g[2] = {g_lo, g_hi};
    bsort_stage<2>(k, g, lane); bsort_stage<4>(k, g, lane); bsort_stage<8>(k, g, lane); bsort_stage<16>(k, g, lane);
    bsort_stage<32>(k, g, lane); bsort_stage<64>(k, g, lane); bsort_stage<128>(k, g, lane);
    e_lo = k[0]; e_hi = k[1]; g_lo = g[0]; g_hi = g[1];
}
template <int J> __device__ __forceinline__ unsigned sort_partner(unsigned v, int lane) {
    if constexpr (J == 1) return (unsigned)__builtin_amdgcn_update_dpp(0, (int)v, 0xB1, 0xf, 0xf, false);
    else if constexpr (J == 2) return (unsigned)__builtin_amdgcn_update_dpp(0, (int)v, 0x4E, 0xf, 0xf, false);
    else if constexpr (J == 4) { const int t = __builtin_amdgcn_update_dpp(0, (int)v, 0x141, 0xf, 0xf, false);
                                 return (unsigned)__builtin_amdgcn_update_dpp(0, t, 0x1B, 0xf, 0xf, false); }
    else if constexpr (J == 8) return (unsigned)__builtin_amdgcn_update_dpp(0, (int)v, 0x128, 0xf, 0xf, false);
    else if constexpr (J == 16) { const auto r = __builtin_amdgcn_permlane16_swap(v, v, false, false); return (lane & 16) ? r[0] : r[1]; }
    else { const auto r = __builtin_amdgcn_permlane32_swap(v, v, false, false); return (lane & 32) ? r[0] : r[1]; }
}
template <int K2, int J> __device__ __forceinline__ void psort_round(unsigned (&v)[2], int lane) {
    if constexpr (J == 64) { const unsigned lo = min(v[0], v[1]), hi = max(v[0], v[1]); v[0] = lo; v[1] = hi; }
    else {
#pragma unroll
        for (int r = 0; r < 2; ++r) {
            const unsigned pv = sort_partner<J>(v[r], lane);
            const bool asc = (((lane + 64 * r) & K2) == 0), lower = ((lane & J) == 0);
            const unsigned mn = min(v[r], pv), mx = max(v[r], pv);
            v[r] = (lower == asc) ? mn : mx;
        }
    }
}
template <int K2> __device__ __forceinline__ void psort_stage(unsigned (&v)[2], int lane) {
    if constexpr (K2 >= 128) psort_round<K2, 64>(v, lane);
    if constexpr (K2 >= 64) psort_round<K2, 32>(v, lane);
    if constexpr (K2 >= 32) psort_round<K2, 16>(v, lane);
    if constexpr (K2 >= 16) psort_round<K2, 8>(v, lane);
    if constexpr (K2 >= 8) psort_round<K2, 4>(v, lane);
    if constexpr (K2 >= 4) psort_round<K2, 2>(v, lane);
    psort_round<K2, 1>(v, lane);
}
__device__ __forceinline__ void sort_routing_packed(unsigned& lo, unsigned& hi, int lane) {
    unsigned v[2] = {lo, hi};
    psort_stage<2>(v, lane); psort_stage<4>(v, lane); psort_stage<8>(v, lane); psort_stage<16>(v, lane);
    psort_stage<32>(v, lane); psort_stage<64>(v, lane); psort_stage<128>(v, lane);
    lo = v[0]; hi = v[1];
}
__device__ __forceinline__ void peer_expert3_phase(float* R, const int* __restrict__ eidx, const float* __restrict__ egate, const unsigned char* __restrict__ ub,
                                                   const unsigned char* __restrict__ vb, const float* __restrict__ lg, const float* __restrict__ lb, bf16_t* Hb, float* Rout, const XcdBarrier& xb) {
    const int wave = tidx() >> 6, lane = tidx() & 63;
    int itk = 0;
    for (int token = blockIdx.x * 8 + wave; token < NT; token += gridDim.x * 8, ++itk) {
        if ((itk & 1) == 0 && itk) xcd_barrier(xb);
        float xf[16];
        {
            const float* rp = R + (size_t)token * ND + lane * 16;
#pragma unroll
            for (int q = 0; q < 4; ++q) { const float4 a = *(const float4*)(rp + 4 * q); xf[4 * q] = a.x; xf[4 * q + 1] = a.y; xf[4 * q + 2] = a.z; xf[4 * q + 3] = a.w; }
        }
        float acc[16];
#pragma unroll
        for (int j = 0; j < 16; ++j) acc[j] = 0.f;
        int e_lo = eidx[(size_t)token * 128 + lane], e_hi = eidx[(size_t)token * 128 + 64 + lane];
        float g_lo = egate[(size_t)token * 128 + lane], g_hi = egate[(size_t)token * 128 + 64 + lane];
        sort_routing(e_lo, e_hi, g_lo, g_hi, lane);
        for (int grp = 0; grp < 16; ++grp) {
            const int esel = grp < 8 ? e_lo : e_hi;
            const float gsel = grp < 8 ? g_lo : g_hi;
            const int lbase = (grp & 7) * 8;
            uint4 u[8], v[8];
#pragma unroll
            for (int k = 0; k < 8; ++k) {
                const int ex = __builtin_amdgcn_readlane(esel, lbase + k);
                u[k] = *(const uint4*)(ub + (size_t)ex * ND + lane * 16);
                v[k] = *(const uint4*)(vb + (size_t)ex * ND + lane * 16);
            }
            float d[8];
#pragma unroll
            for (int k = 0; k < 8; ++k) {
                const unsigned w[4] = {u[k].x, u[k].y, u[k].z, u[k].w};
                float a = 0.f, b = 0.f;
#pragma unroll
                for (int q = 0; q < 4; ++q) {
                    const f32x2_t lo = __builtin_amdgcn_cvt_pk_f32_fp8((int)w[q], false), hi = __builtin_amdgcn_cvt_pk_f32_fp8((int)w[q], true);
                    a = fmaf(xf[4 * q], lo.x, a); b = fmaf(xf[4 * q + 1], lo.y, b); a = fmaf(xf[4 * q + 2], hi.x, a); b = fmaf(xf[4 * q + 3], hi.y, b);
                }
                d[k] = a + b;
            }
            const bool hi5 = lane & 32, hi4 = lane & 16, hi3 = lane & 8;
            float r4[4], r2[2], r1;
#pragma unroll
            for (int k = 0; k < 4; ++k) { const float send = hi5 ? d[k] : d[k + 4], keep = hi5 ? d[k + 4] : d[k]; r4[k] = keep + __shfl_xor(send, 32); }
#pragma unroll
            for (int k = 0; k < 2; ++k) { const float send = hi4 ? r4[k] : r4[k + 2], keep = hi4 ? r4[k + 2] : r4[k]; r2[k] = keep + __shfl_xor(send, 16); }
            { const float send = hi3 ? r2[0] : r2[1], keep = hi3 ? r2[1] : r2[0]; r1 = keep + __shfl_xor(send, 8); }
            r1 += __shfl_xor(r1, 4); r1 += __shfl_xor(r1, 2); r1 += __shfl_xor(r1, 1);
            const float gk = __shfl(gsel, lbase + (lane >> 3));
            const float coef = gk * gelu_fast(r1 * (1.f / U_SCALE)) * (1.f / V_SCALE);
#pragma unroll
            for (int k = 0; k < 8; ++k) {
                const float ck = __int_as_float(__builtin_amdgcn_readlane(__float_as_int(coef), 8 * k));
                const unsigned w[4] = {v[k].x, v[k].y, v[k].z, v[k].w};
#pragma unroll
                for (int q = 0; q < 4; ++q) {
                    const f32x2_t lo = __builtin_amdgcn_cvt_pk_f32_fp8((int)w[q], false), hi = __builtin_amdgcn_cvt_pk_f32_fp8((int)w[q], true);
                    acc[4 * q] = fmaf(ck, lo.x, acc[4 * q]); acc[4 * q + 1] = fmaf(ck, lo.y, acc[4 * q + 1]);
                    acc[4 * q + 2] = fmaf(ck, hi.x, acc[4 * q + 2]); acc[4 * q + 3] = fmaf(ck, hi.y, acc[4 * q + 3]);
                }
            }
        }
        float s = 0.f;
#pragma unroll
        for (int j = 0; j < 16; ++j) { xf[j] = ALPHA * xf[j] + acc[j]; s += xf[j]; }
        for (int o = 32; o; o >>= 1) s += __shfl_xor(s, o);
        const float mean = s * (1.f / ND);
        float s2 = 0.f;
#pragma unroll
        for (int j = 0; j < 16; ++j) { xf[j] -= mean; s2 += xf[j] * xf[j]; }
        for (int o = 32; o; o >>= 1) s2 += __shfl_xor(s2, o);
        const float rs = rsqrtf(s2 * (1.f / ND) + LN_EPS);
        float o[16];
#pragma unroll
        for (int q = 0; q < 4; ++q) {
            const float4 gg = *(const float4*)(lg + lane * 16 + 4 * q), bb = *(const float4*)(lb + lane * 16 + 4 * q);
            o[4 * q] = xf[4 * q] * rs * gg.x + bb.x; o[4 * q + 1] = xf[4 * q + 1] * rs * gg.y + bb.y; o[4 * q + 2] = xf[4 * q + 2] * rs * gg.z + bb.z; o[4 * q + 3] = xf[4 * q + 3] * rs * gg.w + bb.w;
            *(float4*)(Rout + (size_t)token * ND + lane * 16 + 4 * q) = make_float4(o[4 * q], o[4 * q + 1], o[4 * q + 2], o[4 * q + 3]);
        }
        if (Hb) { st8(Hb + (size_t)token * ND + lane * 16, o); st8(Hb + (size_t)token * ND + lane * 16 + 8, o + 8); }
    }
}


struct Rows8 { uint4 r[8]; };
__device__ __forceinline__ void rows_load(Rows8& G, int esel, int lbase, const unsigned char* __restrict__ tb, int lane) {
#pragma unroll
    for (int k = 0; k < 8; ++k) {
        const int ex = __builtin_amdgcn_readlane(esel, lbase + k);
        G.r[k] = *(const uint4*)(tb + (size_t)ex * ND + lane * 16);
    }
}
__device__ __forceinline__ void sweep_u(const Rows8& G, const float (&xf)[16], float gsel, int lbase, int lane, float* cl  , int grp) {
    float d[8];
#pragma unroll
    for (int k = 0; k < 8; ++k) {
        const unsigned w[4] = {G.r[k].x, G.r[k].y, G.r[k].z, G.r[k].w};
        f32x2_t a2 = {0.f, 0.f}, b2 = {0.f, 0.f};
#pragma unroll
        for (int q = 0; q < 4; ++q) {
            const f32x2_t lo = __builtin_amdgcn_cvt_pk_f32_fp8((int)w[q], false), hi = __builtin_amdgcn_cvt_pk_f32_fp8((int)w[q], true);
            a2 = __builtin_elementwise_fma((f32x2_t){xf[4 * q], xf[4 * q + 1]}, lo, a2);
            b2 = __builtin_elementwise_fma((f32x2_t){xf[4 * q + 2], xf[4 * q + 3]}, hi, b2);
        }
        d[k] = (a2.x + a2.y) + (b2.x + b2.y);
    }
    const bool hi5 = lane & 32, hi4 = lane & 16, hi3 = lane & 8;
    float r4[4], r2[2], r1;
#pragma unroll
    for (int k = 0; k < 4; ++k) { const float send = hi5 ? d[k] : d[k + 4], keep = hi5 ? d[k + 4] : d[k]; r4[k] = keep + __shfl_xor(send, 32); }
#pragma unroll
    for (int k = 0; k < 2; ++k) { const float send = hi4 ? r4[k] : r4[k + 2], keep = hi4 ? r4[k + 2] : r4[k]; r2[k] = keep + __shfl_xor(send, 16); }
    { const float send = hi3 ? r2[0] : r2[1], keep = hi3 ? r2[1] : r2[0]; r1 = keep + __shfl_xor(send, 8); }
    r1 += __shfl_xor(r1, 4); r1 += __shfl_xor(r1, 2); r1 += __shfl_xor(r1, 1);
    const float gk = __shfl(gsel, lbase + (lane >> 3));
    const float coef = gk * gelu_fast(r1 * (1.f / U_SCALE)) * (1.f / V_SCALE);
    if ((lane & 7) == 0) cl[grp * 8 + (lane >> 3)] = coef;
}
__device__ __forceinline__ void sweep_u8(const Rows8& G, const uint4 xq, unsigned gsel, float sx, int lbase, int lane, float* cl  , int grp) {
    int d[8];
#pragma unroll
    for (int k = 0; k < 8; ++k) {
        int a = __builtin_amdgcn_sdot4((int)G.r[k].x, (int)xq.x, 0, false);
        a = __builtin_amdgcn_sdot4((int)G.r[k].y, (int)xq.y, a, false);
        a = __builtin_amdgcn_sdot4((int)G.r[k].z, (int)xq.z, a, false);
        d[k] = __builtin_amdgcn_sdot4((int)G.r[k].w, (int)xq.w, a, false);
    }
    const bool hi5 = lane & 32, hi4 = lane & 16, hi3 = lane & 8;
    int r4[4], r2[2], r1;
#pragma unroll
    for (int k = 0; k < 4; ++k) { const int send = hi5 ? d[k] : d[k + 4], keep = hi5 ? d[k + 4] : d[k]; r4[k] = keep + __shfl_xor(send, 32); }
#pragma unroll
    for (int k = 0; k < 2; ++k) { const int send = hi4 ? r4[k] : r4[k + 2], keep = hi4 ? r4[k + 2] : r4[k]; r2[k] = keep + __shfl_xor(send, 16); }
    { const int send = hi3 ? r2[0] : r2[1], keep = hi3 ? r2[1] : r2[0]; r1 = keep + __shfl_xor(send, 8); }
    r1 += __shfl_xor(r1, 4); r1 += __shfl_xor(r1, 2); r1 += __shfl_xor(r1, 1);
    const unsigned gp = (unsigned)__shfl((int)gsel, lbase + (lane >> 3));
    const float gk = __uint_as_float(gp << 16), sk = __uint_as_float(gp & 0xffff0000u);
    const float coef = gk * gelu_fast((float)r1 * (sk * sx)) * (1.f / V_SCALE);
    if ((lane & 7) == 0) cl[grp * 8 + (lane >> 3)] = coef;
}
__device__ __forceinline__ void sweep_v(const Rows8& G, float (&acc)[16], const float* cl, int grp) {
#pragma unroll
    for (int k = 0; k < 8; ++k) {
        const float ck = cl[grp * 8 + k];
        const unsigned w[4] = {G.r[k].x, G.r[k].y, G.r[k].z, G.r[k].w};
        const f32x2_t ck2 = {ck, ck};
#pragma unroll
        for (int q = 0; q < 4; ++q) {
            const f32x2_t lo = __builtin_amdgcn_cvt_pk_f32_fp8((int)w[q], false), hi = __builtin_amdgcn_cvt_pk_f32_fp8((int)w[q], true);
            f32x2_t* ap = (f32x2_t*)&acc[4 * q];
            ap[0] = __builtin_elementwise_fma(ck2, lo, ap[0]);
            ap[1] = __builtin_elementwise_fma(ck2, hi, ap[1]);
        }
    }
}
__device__ __forceinline__ void peer_expert6_phase(float* R, const int* __restrict__ eidx, const float* __restrict__ egate, const unsigned char* __restrict__ ub,
                                                   const unsigned char* __restrict__ vb, const float* __restrict__ lg, const float* __restrict__ lb, bf16_t* Hb, const XcdBarrier& xb, float* lds,
                                                   const float* __restrict__ l1g, const float* __restrict__ l1b) {
    const int wave = __builtin_amdgcn_readfirstlane(tidx() >> 6), lane = tidx() & 63;
    float* cl = lds + wave * 128;
    int itk = 0;
    for (int token = blockIdx.x * 8 + wave; token < NT; token += gridDim.x * 8, ++itk) {
        if (itk) xcc_align(xb);
        float xf[16];
        {
            const float* rp = R + (size_t)token * ND + lane * 16;
#pragma unroll
            for (int q = 0; q < 4; ++q) { const float4 a = *(const float4*)(rp + 4 * q); xf[4 * q] = a.x; xf[4 * q + 1] = a.y; xf[4 * q + 2] = a.z; xf[4 * q + 3] = a.w; }
        }
        {
            float s = 0.f;
#pragma unroll
            for (int j = 0; j < 16; ++j) s += xf[j];
            for (int o = 32; o; o >>= 1) s += __shfl_xor(s, o);
            const float mean = s * (1.f / ND);
            float s2 = 0.f;
#pragma unroll
            for (int j = 0; j < 16; ++j) { xf[j] -= mean; s2 += xf[j] * xf[j]; }
            for (int o = 32; o; o >>= 1) s2 += __shfl_xor(s2, o);
            const float rs = rsqrtf(s2 * (1.f / ND) + LN_EPS);
            int lofs1 = lane * 16;
            asm volatile("" : "+v"(lofs1));
#pragma unroll
            for (int q = 0; q < 4; ++q) {
                const float4 gg = *(const float4*)(l1g + lofs1 + 4 * q), bb = *(const float4*)(l1b + lofs1 + 4 * q);
                xf[4 * q] = xf[4 * q] * rs * gg.x + bb.x; xf[4 * q + 1] = xf[4 * q + 1] * rs * gg.y + bb.y; xf[4 * q + 2] = xf[4 * q + 2] * rs * gg.z + bb.z; xf[4 * q + 3] = xf[4 * q + 3] * rs * gg.w + bb.w;
            }
        }
        int e_lo = eidx[(size_t)token * 128 + lane], e_hi = eidx[(size_t)token * 128 + 64 + lane];
        float g_lo = egate[(size_t)token * 128 + lane], g_hi = egate[(size_t)token * 128 + 64 + lane];
        sort_routing(e_lo, e_hi, g_lo, g_hi, lane);
        Rows8 GA, GB;
        wave_lds_fence();
        rows_load(GA, e_lo, 0, ub, lane);
#pragma unroll 1
        for (int gp = 0; gp < 8; ++gp) {
            const int g0i = 2 * gp, g1i = 2 * gp + 1;
            rows_load(GB, g1i < 8 ? e_lo : e_hi, (g1i & 7) * 8, ub, lane);
            __builtin_amdgcn_sched_barrier(0);
            sweep_u(GA, xf, g0i < 8 ? g_lo : g_hi, (g0i & 7) * 8, lane, cl, g0i);
            __builtin_amdgcn_sched_barrier(0);
            rows_load(GA, gp < 7 ? ((g0i + 2) < 8 ? e_lo : e_hi) : e_lo, gp < 7 ? ((g0i + 2) & 7) * 8 : 0, gp < 7 ? ub : vb, lane);
            __builtin_amdgcn_sched_barrier(0);
            sweep_u(GB, xf, g1i < 8 ? g_lo : g_hi, (g1i & 7) * 8, lane, cl, g1i);
            __builtin_amdgcn_sched_barrier(0);
        }
        wave_lds_fence();
        xcc_align(xb);
        float acc[16];
#pragma unroll
        for (int j = 0; j < 16; ++j) acc[j] = 0.f;
#pragma unroll 1
        for (int gp = 0; gp < 8; ++gp) {
            const int g0i = 2 * gp, g1i = 2 * gp + 1;
            rows_load(GB, g1i < 8 ? e_lo : e_hi, (g1i & 7) * 8, vb, lane);
            __builtin_amdgcn_sched_barrier(0);
            sweep_v(GA, acc, cl, g0i);
            __builtin_amdgcn_sched_barrier(0);
            if (gp < 7) rows_load(GA, (g0i + 2) < 8 ? e_lo : e_hi, ((g0i + 2) & 7) * 8, vb, lane);
            __builtin_amdgcn_sched_barrier(0);
            sweep_v(GB, acc, cl, g1i);
            __builtin_amdgcn_sched_barrier(0);
        }
        float s = 0.f;
#pragma unroll
        for (int j = 0; j < 16; ++j) { xf[j] = ALPHA * xf[j] + acc[j]; s += xf[j]; }
        for (int o = 32; o; o >>= 1) s += __shfl_xor(s, o);
        const float mean = s * (1.f / ND);
        float s2 = 0.f;
#pragma unroll
        for (int j = 0; j < 16; ++j) { xf[j] -= mean; s2 += xf[j] * xf[j]; }
        for (int o = 32; o; o >>= 1) s2 += __shfl_xor(s2, o);
        const float rs = rsqrtf(s2 * (1.f / ND) + LN_EPS);
        float o[16];
        int lofs = lane * 16;
        asm volatile("" : "+v"(lofs));
#pragma unroll
        for (int q = 0; q < 4; ++q) {
            const float4 gg = *(const float4*)(lg + lofs + 4 * q), bb = *(const float4*)(lb + lofs + 4 * q);
            o[4 * q] = xf[4 * q] * rs * gg.x + bb.x; o[4 * q + 1] = xf[4 * q + 1] * rs * gg.y + bb.y; o[4 * q + 2] = xf[4 * q + 2] * rs * gg.z + bb.z; o[4 * q + 3] = xf[4 * q + 3] * rs * gg.w + bb.w;
            *(float4*)(R + (size_t)token * ND + lofs + 4 * q) = make_float4(o[4 * q], o[4 * q + 1], o[4 * q + 2], o[4 * q + 3]);
        }
        if (Hb) { st8(Hb + (size_t)token * ND + lofs, o); st8(Hb + (size_t)token * ND + lofs + 8, o + 8); }
    }
}


__device__ __forceinline__ void load_h_row(const bf16_t* Vb, int token, int lane, const float* __restrict__ l1g, const float* __restrict__ l1b, float (&xf)[16]) {
    ld8(Vb + (size_t)token * ND + lane * 16, xf); ld8(Vb + (size_t)token * ND + lane * 16 + 8, xf + 8);
    float s = 0.f;
#pragma unroll
    for (int j = 0; j < 16; ++j) s += xf[j];
    for (int o = 32; o; o >>= 1) s += __shfl_xor(s, o);
    const float mean = s * (1.f / ND);
    float s2 = 0.f;
#pragma unroll
    for (int j = 0; j < 16; ++j) { xf[j] -= mean; s2 += xf[j] * xf[j]; }
    for (int o = 32; o; o >>= 1) s2 += __shfl_xor(s2, o);
    const float rs = rsqrtf(s2 * (1.f / ND) + LN_EPS);
    int lofs1 = lane * 16;
    asm volatile("" : "+v"(lofs1));
#pragma unroll
    for (int q = 0; q < 4; ++q) {
        const float4 gg = *(const float4*)(l1g + lofs1 + 4 * q), bb = *(const float4*)(l1b + lofs1 + 4 * q);
        xf[4 * q] = xf[4 * q] * rs * gg.x + bb.x; xf[4 * q + 1] = xf[4 * q + 1] * rs * gg.y + bb.y; xf[4 * q + 2] = xf[4 * q + 2] * rs * gg.z + bb.z; xf[4 * q + 3] = xf[4 * q + 3] * rs * gg.w + bb.w;
    }
}
__device__ __forceinline__ void finish_row(float* R, bf16_t* Hb, int token, int lane, float (&xf)[16], const float (&acc)[16], const float* __restrict__ lg, const float* __restrict__ lb) {
    float s = 0.f;
#pragma unroll
    for (int j = 0; j < 16; ++j) { xf[j] = ALPHA * xf[j] + acc[j]; s += xf[j]; }
    for (int o = 32; o; o >>= 1) s += __shfl_xor(s, o);
    const float mean = s * (1.f / ND);
    float s2 = 0.f;
#pragma unroll
    for (int j = 0; j < 16; ++j) { xf[j] -= mean; s2 += xf[j] * xf[j]; }
    for (int o = 32; o; o >>= 1) s2 += __shfl_xor(s2, o);
    const float rs = rsqrtf(s2 * (1.f / ND) + LN_EPS);
    float o[16];
    int lofs = lane * 16;
    asm volatile("" : "+v"(lofs));
#pragma unroll
    for (int q = 0; q < 4; ++q) {
        const float4 gg = *(const float4*)(lg + lofs + 4 * q), bb = *(const float4*)(lb + lofs + 4 * q);
        o[4 * q] = xf[4 * q] * rs * gg.x + bb.x; o[4 * q + 1] = xf[4 * q + 1] * rs * gg.y + bb.y; o[4 * q + 2] = xf[4 * q + 2] * rs * gg.z + bb.z; o[4 * q + 3] = xf[4 * q + 3] * rs * gg.w + bb.w;
        if (R) *(float4*)(R + (size_t)token * ND + lofs + 4 * q) = make_float4(o[4 * q], o[4 * q + 1], o[4 * q + 2], o[4 * q + 3]);
    }
    if (Hb) { st8(Hb + (size_t)token * ND + lofs, o); st8(Hb + (size_t)token * ND + lofs + 8, o + 8); }
}
__device__ __forceinline__ void peer_expert10_phase(float* R, const bf16_t* Vin, const int* __restrict__ eidx, const float* __restrict__ egate, const unsigned char* __restrict__ ub,
                                                    const unsigned char* __restrict__ vb, const float* __restrict__ lg, const float* __restrict__ lb, bf16_t* Hb, const XcdBarrier& xb, float* lds,
                                                    const float* __restrict__ l1g, const float* __restrict__ l1b, const float* __restrict__ su) {
    if (__builtin_amdgcn_readfirstlane(tidx() >> 6) >= 4) __builtin_amdgcn_s_setprio(1);
    const int wave = __builtin_amdgcn_readfirstlane(tidx() >> 6), lane = tidx() & 63;
    float* cl = lds + wave * 512;
    float* xs = lds + 4096 + wave * 4096;
    const int stride = gridDim.x * 8;
    int itk = 0;
    for (int tok0 = blockIdx.x * 8 + wave; tok0 < NT; tok0 += 4 * stride, ++itk) {
        if (itk) xcc_align(xb);
        int elo[4], ehi[4]; unsigned glo[4], ghi[4]; float sx[4];
        wave_lds_fence();
#pragma unroll
        for (int t = 0; t < 4; ++t) {
            const int tok = tok0 + t * stride;
            {
                float xr[16]; load_h_row(Vin, tok, lane, l1g, l1b, xr);
                float m = 0.f;
#pragma unroll
                for (int j = 0; j < 16; ++j) m = fmaxf(m, fabsf(xr[j]));
                for (int o = 32; o; o >>= 1) m = fmaxf(m, __shfl_xor(m, o));
                const float inv = m > 0.f ? 127.f / m : 0.f;
                sx[t] = m * (1.f / 127.f);
                uint4 w; unsigned* wp = (unsigned*)&w;
#pragma unroll
                for (int q = 0; q < 4; ++q) {
                    const int b0 = (int)rintf(xr[4 * q] * inv), b1 = (int)rintf(xr[4 * q + 1] * inv), b2 = (int)rintf(xr[4 * q + 2] * inv), b3 = (int)rintf(xr[4 * q + 3] * inv);
                    wp[q] = (unsigned)(b0 & 255) | ((unsigned)(b1 & 255) << 8) | ((unsigned)(b2 & 255) << 16) | ((unsigned)b3 << 24);
                }
                *(uint4*)((unsigned char*)(xs + t * 1024) + lane * 16) = w;
            }
            unsigned p0 = ((unsigned)eidx[(size_t)tok * 128 + lane] << 16) | (unsigned)f2bf(egate[(size_t)tok * 128 + lane]);
            unsigned p1 = ((unsigned)eidx[(size_t)tok * 128 + 64 + lane] << 16) | (unsigned)f2bf(egate[(size_t)tok * 128 + 64 + lane]);
            sort_routing_packed(p0, p1, lane);
            elo[t] = (int)(p0 >> 16); ehi[t] = (int)(p1 >> 16);
            glo[t] = (p0 & 0xffffu) | ((unsigned)f2bf(su[elo[t]]) << 16); ghi[t] = (p1 & 0xffffu) | ((unsigned)f2bf(su[ehi[t]]) << 16);
        }
        Rows8 GA, GB;
        wave_lds_fence();
        rows_load(GA, elo[0], 0, ub, lane);
#pragma unroll 1
        for (int g = 0; g < 16; ++g) {
            const int lb8 = (g & 7) * 8; const bool lo = g < 8;
            rows_load(GB, lo ? elo[1] : ehi[1], lb8, ub, lane);
            __builtin_amdgcn_sched_barrier(0);
            sweep_u8(GA, *(const uint4*)((const unsigned char*)(xs + 0 * 1024) + lane * 16), lo ? glo[0] : ghi[0], sx[0], lb8, lane, cl, g);
            __builtin_amdgcn_sched_barrier(0);
            rows_load(GA, lo ? elo[2] : ehi[2], lb8, ub, lane);
            __builtin_amdgcn_sched_barrier(0);
            sweep_u8(GB, *(const uint4*)((const unsigned char*)(xs + 1 * 1024) + lane * 16), lo ? glo[1] : ghi[1], sx[1], lb8, lane, cl + 128, g);
            __builtin_amdgcn_sched_barrier(0);
            rows_load(GB, lo ? elo[3] : ehi[3], lb8, ub, lane);
            __builtin_amdgcn_sched_barrier(0);
            sweep_u8(GA, *(const uint4*)((const unsigned char*)(xs + 2 * 1024) + lane * 16), lo ? glo[2] : ghi[2], sx[2], lb8, lane, cl + 256, g);
            __builtin_amdgcn_sched_barrier(0);
            if (g < 15) rows_load(GA, (g + 1) < 8 ? elo[0] : ehi[0], ((g + 1) & 7) * 8, ub, lane);
            else rows_load(GA, elo[0], 0, vb, lane);
            __builtin_amdgcn_sched_barrier(0);
            sweep_u8(GB, *(const uint4*)((const unsigned char*)(xs + 3 * 1024) + lane * 16), lo ? glo[3] : ghi[3], sx[3], lb8, lane, cl + 384, g);
            __builtin_amdgcn_sched_barrier(0);
        }
        wave_lds_fence();
        xcc_align(xb);
#pragma unroll
        for (int t = 0; t < 4; ++t)
#pragma unroll
            for (int q = 0; q < 4; ++q) *(float4*)(xs + t * 1024 + q * 256 + lane * 4) = make_float4(0.f, 0.f, 0.f, 0.f);
#pragma unroll 1
        for (int g = 0; g < 16; ++g) {
            const int lb8 = (g & 7) * 8; const bool lo = g < 8;
            rows_load(GB, lo ? elo[1] : ehi[1], lb8, vb, lane);
            __builtin_amdgcn_sched_barrier(0);
            { float av[16];
#pragma unroll
              for (int q = 0; q < 4; ++q) { const float4 v4 = *(const float4*)(xs + 0 * 1024 + q * 256 + lane * 4); av[4 * q] = v4.x; av[4 * q + 1] = v4.y; av[4 * q + 2] = v4.z; av[4 * q + 3] = v4.w; }
              sweep_v(GA, av, cl, g);
#pragma unroll
              for (int q = 0; q < 4; ++q) *(float4*)(xs + 0 * 1024 + q * 256 + lane * 4) = make_float4(av[4 * q], av[4 * q + 1], av[4 * q + 2], av[4 * q + 3]); }
            __builtin_amdgcn_sched_barrier(0);
            rows_load(GA, lo ? elo[2] : ehi[2], lb8, vb, lane);
            __builtin_amdgcn_sched_barrier(0);
            { float av[16];
#pragma unroll
              for (int q = 0; q < 4; ++q) { const float4 v4 = *(const float4*)(xs + 1 * 1024 + q * 256 + lane * 4); av[4 * q] = v4.x; av[4 * q + 1] = v4.y; av[4 * q + 2] = v4.z; av[4 * q + 3] = v4.w; }
              sweep_v(GB, av, cl + 128, g);
#pragma unroll
              for (int q = 0; q < 4; ++q) *(float4*)(xs + 1 * 1024 + q * 256 + lane * 4) = make_float4(av[4 * q], av[4 * q + 1], av[4 * q + 2], av[4 * q + 3]); }
            __builtin_amdgcn_sched_barrier(0);
            rows_load(GB, lo ? elo[3] : ehi[3], lb8, vb, lane);
            __builtin_amdgcn_sched_barrier(0);
            { float av[16];
#pragma unroll
              for (int q = 0; q < 4; ++q) { const float4 v4 = *(const float4*)(xs + 2 * 1024 + q * 256 + lane * 4); av[4 * q] = v4.x; av[4 * q + 1] = v4.y; av[4 * q + 2] = v4.z; av[4 * q + 3] = v4.w; }
              sweep_v(GA, av, cl + 256, g);
#pragma unroll
              for (int q = 0; q < 4; ++q) *(float4*)(xs + 2 * 1024 + q * 256 + lane * 4) = make_float4(av[4 * q], av[4 * q + 1], av[4 * q + 2], av[4 * q + 3]); }
            __builtin_amdgcn_sched_barrier(0);
            if (g < 15) rows_load(GA, (g + 1) < 8 ? elo[0] : ehi[0], ((g + 1) & 7) * 8, vb, lane);
            __builtin_amdgcn_sched_barrier(0);
            { float av[16];
#pragma unroll
              for (int q = 0; q < 4; ++q) { const float4 v4 = *(const float4*)(xs + 3 * 1024 + q * 256 + lane * 4); av[4 * q] = v4.x; av[4 * q + 1] = v4.y; av[4 * q + 2] = v4.z; av[4 * q + 3] = v4.w; }
              sweep_v(GB, av, cl + 384, g);
#pragma unroll
              for (int q = 0; q < 4; ++q) *(float4*)(xs + 3 * 1024 + q * 256 + lane * 4) = make_float4(av[4 * q], av[4 * q + 1], av[4 * q + 2], av[4 * q + 3]); }
            __builtin_amdgcn_sched_barrier(0);
        }
#pragma unroll
        for (int t = 0; t < 4; ++t) {
            const int tok = tok0 + t * stride;
            float xr[16], av[16];
#pragma unroll
            for (int q = 0; q < 4; ++q) { const float4 v4 = *(const float4*)(xs + t * 1024 + q * 256 + lane * 4); av[4 * q] = v4.x; av[4 * q + 1] = v4.y; av[4 * q + 2] = v4.z; av[4 * q + 3] = v4.w; }
            load_h_row(Vin, tok, lane, l1g, l1b, xr);
            finish_row(R, Hb, tok, lane, xr, av, lg, lb);
            __builtin_amdgcn_sched_barrier(0);
        }
    }
    __builtin_amdgcn_s_setprio(0);
}

__device__ __forceinline__ void nsa_compress_phase(const bf16_t* __restrict__ proj, int coloff, const float* __restrict__ pe, const float* __restrict__ w1,
                                   const float* __restrict__ w2, float* __restrict__ outc, float* lds) {
    const int qtr = tidx() >> 7, tid = tidx() & 127;
    float* in = lds + qtr * 2176;
    float* hid = in + 2048;
    for (int it = blockIdx.x; it < NB * 127; it += gridDim.x) {
        const int g = qtr, n = it % 127, b = it / 127;
        __syncthreads();
        for (int idx = tid; idx < 2048; idx += 128) {
            const int l = idx >> 6, d = idx & 63;
            in[idx] = bf2f(proj[(size_t)(b * NL + 16 * n + l) * ODD_PAD + coloff + g * 64 + d]) + pe[l * 64 + d];
        }
        __syncthreads();
        float a = 0.f;
        for (int i = 0; i < 2048; ++i) a += in[i] * w1[(size_t)i * 128 + tid];
        hid[tid] = gelu_tanh(a);
        __syncthreads();
        if (tid < 64) {
            float o = 0.f;
            for (int j = 0; j < 128; ++j) o += hid[j] * w2[j * 64 + tid];
            outc[((size_t)(b * 127 + n) * 4 + g) * 64 + tid] = o;
        }
    }
    __syncthreads();
}

__device__ __forceinline__ void nsa_cmp_phase(const bf16_t* __restrict__ proj, const float* __restrict__ kcmp, const float* __restrict__ vcmp,
                              bf16_t* __restrict__ O, unsigned* __restrict__ selmask, float* lds) {
    const int half = tidx() >> 8, tid = tidx() & 255;
    float* kc_s = lds + half * 18368;
    float* vc_s = kc_s + 127 * 64;
    float(*imp_s)[33] = (float(*)[33])(vc_s + 127 * 64);
    const int tk = tid >> 2, r = tid & 3;
    for (int it = blockIdx.x; it < 32 * 4 * NB / 2; it += gridDim.x) {
        const int vb = it * 2 + half;
        const int tile = vb & 31, g = (vb >> 5) & 3, b = vb >> 7;
        const int t = tile * 64 + tk, hd = g * 4 + r;
        __syncthreads();
        for (int idx = tid; idx < 127 * 64; idx += 256) { const int n = idx >> 6, d = idx & 63; kc_s[idx] = kcmp[((size_t)(b * 127 + n) * 4 + g) * 64 + d]; vc_s[idx] = vcmp[((size_t)(b * 127 + n) * 4 + g) * 64 + d]; }
        const bf16_t* prow = proj + (size_t)(b * NL + t) * ODD_PAD;
        float q[64];
#pragma unroll
        for (int d = 0; d < 64; d += 8) ld8(prow + hd * 64 + d, q + d);
        const float slope = exp2f(-0.5f * (float)(hd + 1));
        int nvalid = (t >= 31) ? ((t - 31) / 16 + 1) : 0;
        if (nvalid > 127) nvalid = 127;
        __syncthreads();
        float m = -INFINITY, l = 0.f;
        for (int n = 0; n < nvalid; ++n) {
            float s = 0.f;
#pragma unroll
            for (int d = 0; d < 64; ++d) s += q[d] * kc_s[n * 64 + d];
            s = s * 0.125f - slope * (float)(t - (16 * n + 31));
            const float mn = fmaxf(m, s);
            l = l * expf(m - mn) + expf(s - mn);
            m = mn;
        }
        const float inv_l = (nvalid > 0) ? 1.f / fmaxf(l, 1e-30f) : 0.f;
        float acc[64];
#pragma unroll
        for (int d = 0; d < 64; ++d) acc[d] = 0.f;
        float prev3 = 0.f;
        for (int j = 0; j < 32; ++j) {
            float pj[4];
#pragma unroll
            for (int nn = 0; nn < 4; ++nn) {
                const int n = 4 * j + nn;
                float p = 0.f;
                if (n < nvalid) {
                    float s = 0.f;
#pragma unroll
                    for (int d = 0; d < 64; ++d) s += q[d] * kc_s[n * 64 + d];
                    s = s * 0.125f - slope * (float)(t - (16 * n + 31));
                    p = expf(s - m) * inv_l;
                    const float* vr = vc_s + n * 64;
#pragma unroll
                    for (int d = 0; d < 64; ++d) acc[d] += p * vr[d];
                }
                pj[nn] = p;
            }
            float im = 0.5f * prev3 + pj[0] + pj[1] + pj[2] + 0.5f * pj[3];
            prev3 = pj[3];
            im += __shfl_xor(im, 1);
            im += __shfl_xor(im, 2);
            if (r == 0) imp_s[tk][j] = im;
        }
        const float g0 = sigmoidf_(bf2f(prow[2048 + hd]));
#pragma unroll
        for (int d = 0; d < 64; ++d) acc[d] *= g0;
#pragma unroll
        for (int d = 0; d < 64; d += 8) st8(O + (size_t)(b * NL + t) * ND + hd * 64 + d, acc + d);
        __syncthreads();
        const int cur = tile;
        unsigned bits = 0;
        for (int jj = 0; jj < 8; ++jj) {
            const int j = r * 8 + jj;
            const bool fj = (j == 0) || (j == cur) || (j == cur - 1);
            const float vj = (j <= cur) ? imp_s[tk][j] + (fj ? 1000.f : 0.f) : -INFINITY;
            int rank = 0;
            for (int k = 0; k < 32; ++k) {
                const bool fk = (k == 0) || (k == cur) || (k == cur - 1);
                const float vk = (k <= cur) ? imp_s[tk][k] + (fk ? 1000.f : 0.f) : -INFINITY;
                rank += (vk > vj || (vk == vj && k < j)) ? 1 : 0;
            }
            if (rank < 16) bits |= 1u << j;
        }
        bits |= __shfl_xor(bits, 1);
        bits |= __shfl_xor(bits, 2);
        if (r == 0) selmask[(size_t)(b * 4 + g) * NL + t] = bits;
    }
    __syncthreads();
}

__device__ __forceinline__ void nsa_selwin_phase(const bf16_t* __restrict__ proj, const unsigned* __restrict__ selmask, bf16_t* O, float* lds) {
    const int half = tidx() >> 8, tid = tidx() & 255;
    float(*k_s)[64] = (float(*)[64])(lds + half * 8192);
    float(*v_s)[64] = (float(*)[64])(lds + half * 8192 + 4096);
    const int tk = tid >> 2, r = tid & 3;
    for (int it = blockIdx.x; it < 32 * 32; it += gridDim.x) {
        const int tile = 31 - (it >> 5);
        const int bgi = (it & 31) * 2 + half, g = bgi & 3, b = bgi >> 2;
        const int t = tile * 64 + tk, hd = g * 4 + r;
        const bf16_t* pb = proj + (size_t)b * NL * ODD_PAD;
        const bf16_t* prow = pb + (size_t)t * ODD_PAD;
        float q[64], acc[64];
#pragma unroll
        for (int d = 0; d < 64; d += 8) ld8(prow + hd * 64 + d, q + d);
        const float slope = exp2f(-0.5f * (float)(hd + 1));
        const unsigned mask = selmask[(size_t)(b * 4 + g) * NL + t];
        bf16_t* orow = O + (size_t)(b * NL + t) * ND + hd * 64;
        for (int branch = 0; branch < 2; ++branch) {
            const int kcol = (branch == 0 ? 1536 : 2048) + g * 64, vcol = kcol + 256;
            const int j0 = (branch == 0) ? 0 : (tile >= 8 ? tile - 8 : 0);
            float m = -1e30f, l = 0.f;
#pragma unroll
            for (int d = 0; d < 64; ++d) acc[d] = 0.f;
            for (int j = j0; j <= tile; ++j) {
                __syncthreads();
                for (int i = 0; i < 16; ++i) {
                    const int idx = tid + 256 * i, key = idx >> 6, d = idx & 63;
                    k_s[key][d] = bf2f(pb[(size_t)(64 * j + key) * ODD_PAD + kcol + d]);
                    v_s[key][d] = bf2f(pb[(size_t)(64 * j + key) * ODD_PAD + vcol + d]);
                }
                __syncthreads();
                const bool take = (branch == 0) ? ((mask >> j) & 1u) : true;
                if (take) {
                    for (int s = 0; s < 64; ++s) {
                        const int dist = t - (64 * j + s);
                        const bool valid = (branch == 0) ? (dist >= 0) : (dist >= 0 && dist < 512);
                        float sc = 0.f;
#pragma unroll
                        for (int d = 0; d < 64; ++d) sc += q[d] * k_s[s][d];
                        sc = sc * 0.125f - slope * (float)dist;
                        const float mn = valid ? fmaxf(m, sc) : m;
                        const float scale = expf(m - mn);
                        const float p = valid ? expf(sc - mn) : 0.f;
                        l = l * scale + p;
#pragma unroll
                        for (int d = 0; d < 64; ++d) acc[d] = acc[d] * scale + p * v_s[s][d];
                        m = mn;
                    }
                }
            }
            const float gt = sigmoidf_(bf2f(prow[2560 + (branch + 1) * 16 + hd]));
            const float f = gt / fmaxf(l, 1e-30f);
#pragma unroll
            for (int d = 0; d < 64; d += 8) {
                float o[8];
                ld8(orow + d, o);
#pragma unroll
                for (int j = 0; j < 8; ++j) o[j] += f * acc[d + j];
                st8(orow + d, o);
            }
        }
    }
    __syncthreads();
}


typedef float f32x16 __attribute__((ext_vector_type(16)));
#define MFMA32(a, b, c) __builtin_amdgcn_mfma_f32_32x32x16_bf16((a), (b), (c), 0, 0, 0)
__device__ __forceinline__ unsigned cvtpk(float lo, float hi) { const f32x2_t f = {lo, hi}; return __builtin_bit_cast(unsigned, __builtin_convertvector(f, bf16x2_t)); }
__device__ __forceinline__ int crow32(int reg, int h) { return (reg & 3) + 8 * (reg >> 2) + 4 * h; }
constexpr float LOG2E = 1.4426950408889634f;
__device__ __forceinline__ void nsa_attn_phase(const bf16_t* __restrict__ proj, const bf16_t* __restrict__ vt, const unsigned* __restrict__ selmask, bf16_t* O, unsigned char* lds) {
    if (__builtin_amdgcn_readfirstlane(tidx() >> 6) >= 4) __builtin_amdgcn_s_setprio(1);
    const int tid = tidx(), wave = __builtin_amdgcn_readfirstlane(tid >> 6), lane = tid & 63, l31 = lane & 31, h = lane >> 5;
    const int r = wave & 3, thalf = wave >> 2;
    const int skey = tid >> 3, spart = tid & 7;
    uint4 kreg = make_uint4(0u, 0u, 0u, 0u), vreg = kreg; bool have_first = false;
    for (int it = blockIdx.x; it < 32 * 64; it += gridDim.x) {
        const int tile = 31 - (it >> 6), bg = it & 63, g = bg & 3, b = bg >> 2;
        const int hd = g * 4 + r, tokoff = thalf * 32 + l31, tok = tile * 64 + tokoff;
        const size_t trow = (size_t)(b * NL + tok);
        const float slope = exp2f(-0.5f * (float)(hd + 1)) * LOG2E;
        bf16x8_t Qf[4];
#pragma unroll
        for (int ds = 0; ds < 4; ++ds) {
            float q[8];
            ld8(proj + trow * ODD_PAD + hd * 64 + 16 * ds + 8 * h, q);
            const float qs = 0.125f * LOG2E;
            u32x4 w; w.x = cvtpk(q[0] * qs, q[1] * qs); w.y = cvtpk(q[2] * qs, q[3] * qs); w.z = cvtpk(q[4] * qs, q[5] * qs); w.w = cvtpk(q[6] * qs, q[7] * qs);
            Qf[ds] = __builtin_bit_cast(bf16x8_t, w);
        }
        float sc[16];
#pragma unroll
        for (int reg = 0; reg < 16; ++reg) sc[reg] = slope * (float)crow32(reg, h);
        const unsigned mymask = selmask[(size_t)(b * 4 + g) * NL + tok];
        unsigned um = selmask[(size_t)(b * 4 + g) * NL + tile * 64 + lane];
        um |= sort_partner<1>(um, lane); um |= sort_partner<2>(um, lane); um |= sort_partner<4>(um, lane); um |= sort_partner<8>(um, lane); um |= sort_partner<16>(um, lane); um |= sort_partner<32>(um, lane);
        const unsigned causal = (tile == 31) ? 0xffffffffu : ((2u << tile) - 1u);
        const unsigned U = (unsigned)__builtin_amdgcn_readfirstlane((int)um) & causal;
        float outv[32];
#pragma unroll
        for (int i = 0; i < 32; ++i) outv[i] = 0.f;
#pragma unroll 1
        for (int branch = 0; branch < 2; ++branch) {
            unsigned todo = (branch == 0) ? U : (causal & ~((1u << (tile >= 8 ? tile - 8 : 0)) - 1u));
            const bf16_t* kbase = proj + (size_t)b * NL * ODD_PAD + (branch == 0 ? 1536 : 1792) + g * 64 + (size_t)skey * ODD_PAD + 8 * spart;
            const bf16_t* vbase = vt + (size_t)(branch * 256 + g * 64 + skey) * NT + (size_t)b * NL + 8 * spart;
            float m_run = -1e30f, l_run = 0.f;
            f32x16 Oa[2];
#pragma unroll
            for (int i = 0; i < 16; ++i) { Oa[0][i] = 0.f; Oa[1][i] = 0.f; }
            int jcur = __ffs(todo) - 1; todo &= todo - 1;
            if (!have_first || jcur != (branch == 0 ? 0 : (tile >= 8 ? tile - 8 : 0))) { kreg = *(const uint4*)(kbase + (size_t)(64 * jcur) * ODD_PAD); vreg = *(const uint4*)(vbase + 64 * jcur); }
            have_first = true;
            int buf = 0;
            __syncthreads();
            *(uint4*)(lds + skey * 144 + spart * 16) = kreg;
            *(uint2*)(lds + 18432 + skey * 136 + spart * 16) = make_uint2(vreg.x, vreg.y);
            *(uint2*)(lds + 18432 + skey * 136 + spart * 16 + 8) = make_uint2(vreg.z, vreg.w);
            __syncthreads();
            for (;;) {
                const int jnext = todo ? (__ffs(todo) - 1) : -1;
                todo &= todo - 1;
                {
                    const int nb = jnext >= 0 ? branch : 1 - branch;
                    const int jl = jnext >= 0 ? jnext : (branch == 0 ? (tile >= 8 ? tile - 8 : 0) : 0);
                    const bf16_t* kb2 = proj + (size_t)b * NL * ODD_PAD + (nb == 0 ? 1536 : 1792) + g * 64 + (size_t)skey * ODD_PAD + 8 * spart;
                    const bf16_t* vb2 = vt + (size_t)(nb * 256 + g * 64 + skey) * NT + (size_t)b * NL + 8 * spart;
                    kreg = *(const uint4*)(kb2 + (size_t)(64 * jl) * ODD_PAD); vreg = *(const uint4*)(vb2 + 64 * jl);
                }
                const unsigned char* Ks = lds + buf * 9216;
                const unsigned char* Vs = lds + 18432 + buf * 8704;
                const bool mysel = (branch == 1) || ((mymask >> jcur) & 1u);
                if (__any(mysel)) {
                    const bool diag = (jcur == tile), wedge = (branch == 1) && (jcur == tile - 8);
                    const float init = mysel ? slope * (float)(64 * (jcur - tile)) : -1e30f;
                    float sv[32];
#pragma unroll
                    for (int kt = 0; kt < 2; ++kt) {
                        f32x16 acc;
                        const float i0 = init + slope * (float)(32 * kt);
#pragma unroll
                        for (int i = 0; i < 16; ++i) acc[i] = sc[i] + i0;
#pragma unroll
                        for (int ds = 0; ds < 4; ++ds) {
                            const bf16x8_t a = *(const bf16x8_t*)(Ks + (32 * kt + l31) * 144 + (16 * ds + 8 * h) * 2);
                            acc = MFMA32(a, Qf[ds], acc);
                        }
#pragma unroll
                        for (int reg = 0; reg < 16; ++reg) sv[kt * 16 + reg] = acc[reg];
                    }
                    if (diag || wedge) {
#pragma unroll
                        for (int i = 0; i < 32; ++i) {
                            const int keyoff = 32 * (i >> 4) + crow32(i & 15, h);
                            const bool ok = diag ? (keyoff <= tokoff) : (keyoff > tokoff);
                            sv[i] = ok ? sv[i] : -1e30f;
                        }
                    }
                    float mx = sv[0];
#pragma unroll
                    for (int i = 1; i < 32; ++i) mx = fmaxf(mx, sv[i]);
                    mx = fmaxf(mx, __shfl_xor(mx, 32));
                    if (!__all(mx < m_run - 160.f)) {
                    const float m_new = fmaxf(m_run, mx), m_use = fmaxf(m_new, -1e29f);
                    const float alpha = __builtin_amdgcn_exp2f(m_run - m_use);
                    const f32x2_t nm = {-m_use, -m_use};
                    f32x2_t ps2 = {0.f, 0.f};
#pragma unroll
                    for (int i = 0; i < 16; ++i) {
                        const f32x2_t t = (f32x2_t){sv[2 * i], sv[2 * i + 1]} + nm;
                        const f32x2_t p2 = {__builtin_amdgcn_exp2f(t.x), __builtin_amdgcn_exp2f(t.y)};
                        sv[2 * i] = p2.x; sv[2 * i + 1] = p2.y; ps2 += p2;
                    }
                    l_run = l_run * alpha + (ps2.x + ps2.y); m_run = m_new;
#pragma unroll
                    for (int i = 0; i < 16; ++i) { Oa[0][i] *= alpha; Oa[1][i] *= alpha; }
                    bf16x8_t Pf[4];
#pragma unroll
                    for (int ks = 0; ks < 4; ++ks) {
                        u32x4 w; w.x = cvtpk(sv[ks * 8 + 0], sv[ks * 8 + 1]); w.y = cvtpk(sv[ks * 8 + 2], sv[ks * 8 + 3]); w.z = cvtpk(sv[ks * 8 + 4], sv[ks * 8 + 5]); w.w = cvtpk(sv[ks * 8 + 6], sv[ks * 8 + 7]);
                        Pf[ks] = __builtin_bit_cast(bf16x8_t, w);
                    }
#pragma unroll
                    for (int mt = 0; mt < 2; ++mt)
#pragma unroll
                        for (int ks = 0; ks < 4; ++ks) {
                            const unsigned char* vp = Vs + (32 * mt + l31) * 136 + (16 * ks + 4 * h) * 2;
                            const uint2 lo = *(const uint2*)vp, hi = *(const uint2*)(vp + 16);
                            u32x4 w; w.x = lo.x; w.y = lo.y; w.z = hi.x; w.w = hi.y;
                            Oa[mt] = MFMA32(__builtin_bit_cast(bf16x8_t, w), Pf[ks], Oa[mt]);
                        }
                    }
                }
                if (jnext < 0) break;
                *(uint4*)(lds + (buf ^ 1) * 9216 + skey * 144 + spart * 16) = kreg;
                *(uint2*)(lds + 18432 + (buf ^ 1) * 8704 + skey * 136 + spart * 16) = make_uint2(vreg.x, vreg.y);
                *(uint2*)(lds + 18432 + (buf ^ 1) * 8704 + skey * 136 + spart * 16 + 8) = make_uint2(vreg.z, vreg.w);
                __syncthreads();
                buf ^= 1; jcur = jnext;
            }
            const float l_tot = l_run + __shfl_xor(l_run, 32);
            const float gt = sigmoidf_(bf2f(proj[trow * ODD_PAD + 2048 + (branch + 1) * 16 + hd]));
            const float f = gt / fmaxf(l_tot, 1e-30f);
#pragma unroll
            for (int i = 0; i < 16; ++i) { outv[i] += f * Oa[0][i]; outv[16 + i] += f * Oa[1][i]; }
        }
        bf16_t* orow = O + trow * ND + hd * 64;
#pragma unroll
        for (int mt = 0; mt < 2; ++mt)
#pragma unroll
            for (int q4 = 0; q4 < 4; ++q4) {
                bf16_t* op = orow + 32 * mt + 8 * q4 + 4 * h;
                const uint2 old = *(const uint2*)op;
                const float o0 = __uint_as_float(old.x << 16) + outv[mt * 16 + q4 * 4 + 0], o1 = __uint_as_float(old.x & 0xffff0000u) + outv[mt * 16 + q4 * 4 + 1];
                const float o2 = __uint_as_float(old.y << 16) + outv[mt * 16 + q4 * 4 + 2], o3 = __uint_as_float(old.y & 0xffff0000u) + outv[mt * 16 + q4 * 4 + 3];
                *(uint2*)op = make_uint2(cvtpk(o0, o1), cvtpk(o2, o3));
            }
    }
    __syncthreads();
    __builtin_amdgcn_s_setprio(0);
}

__device__ __forceinline__ void nsa_fused_phase(const bf16_t* __restrict__ proj, const bf16_t* __restrict__ kcmp, const bf16_t* __restrict__ vcmpT, const bf16_t* __restrict__ vt, bf16_t* O, unsigned char* lds) {
    if (__builtin_amdgcn_readfirstlane(tidx() >> 6) >= 4) __builtin_amdgcn_s_setprio(1);
    const int wave = __builtin_amdgcn_readfirstlane(tidx() >> 6), r = wave & 3, thalf = wave >> 2;
    unsigned char* Kc = lds;
    unsigned char* Vc = lds + 18432;
    float* impS = (float*)(lds + 35328);
    float* invS = (float*)(lds + 35328 + 33792);
    float* impT = (float*)(lds + 35328 + 33792 + 1024);
    int staged_bg = -1;
    unsigned char* ldsn = lds + 79872;
    unsigned* selS = (unsigned*)(lds + 79872 + 36864);
    for (int it = blockIdx.x; it < 32 * 64; it += gridDim.x) {
        float outv[32];
        {
        const int tid = tidx(), lane = tid & 63, l31 = lane & 31, h = lane >> 5;
        const int tile = 31 - (it >> 6), bg = it & 63, g = bg & 3, b = bg >> 2;
        const int hd = g * 4 + r, tokoff = thalf * 32 + l31, tok = tile * 64 + tokoff;
        const size_t trow = (size_t)(b * NL + tok);
        const float slope = exp2f(-0.5f * (float)(hd + 1));
        __syncthreads();
        if (bg != staged_bg) {
        staged_bg = bg;
#pragma unroll
        for (int i = 0; i < 2; ++i) {
            const int pc = tid + 512 * i;
            { const int row = pc >> 3, c = pc & 7; *(uint4*)(Kc + row * 144 + c * 16) = *(const uint4*)(kcmp + ((size_t)(b * 4 + g) * 128 + row) * 64 + 8 * c); }
            { const int row = pc >> 4, c = pc & 15; const uint4 v = *(const uint4*)(vcmpT + (((size_t)(b * 4 + g) * 8 + (c >> 1)) * 64 + row) * 16 + (c & 1) * 8);
              *(uint2*)(Vc + row * 264 + c * 16) = make_uint2(v.x, v.y); *(uint2*)(Vc + row * 264 + c * 16 + 8) = make_uint2(v.z, v.w); }
        }
        }
        bf16x8_t Qf[4];
#pragma unroll
        for (int ds = 0; ds < 4; ++ds) {
            float q[8];
            ld8(proj + trow * ODD_PAD + hd * 64 + 16 * ds + 8 * h, q);
            u32x4 w; w.x = cvtpk(q[0] * 0.125f, q[1] * 0.125f); w.y = cvtpk(q[2] * 0.125f, q[3] * 0.125f); w.z = cvtpk(q[4] * 0.125f, q[5] * 0.125f); w.w = cvtpk(q[6] * 0.125f, q[7] * 0.125f);
            Qf[ds] = __builtin_bit_cast(bf16x8_t, w);
        }
        int nvalid = (tok >= 31) ? ((tok - 31) / 16 + 1) : 0;
        nvalid = nvalid > 127 ? 127 : nvalid;
        const int nv_max = (4 * tile + 3) > 127 ? 127 : (4 * tile + 3);
        const int kt_end = (nv_max + 31) >> 5;
        __syncthreads();
        float mx = -1e30f;
#pragma unroll 1
        for (int kt = 0; kt < kt_end; ++kt) {
            f32x16 acc;
            const float i0 = slope * (float)(512 * kt);
#pragma unroll
            for (int i = 0; i < 16; ++i) acc[i] = i0;
#pragma unroll
            for (int ds = 0; ds < 4; ++ds) {
                const bf16x8_t a = *(const bf16x8_t*)(Kc + (32 * kt + l31) * 144 + (16 * ds + 8 * h) * 2);
                acc = MFMA32(a, Qf[ds], acc);
            }
#pragma unroll
            for (int reg = 0; reg < 16; ++reg) {
                const int n = 32 * kt + crow32(reg, h);
                const float sval = acc[reg] + slope * (float)(16 * crow32(reg, h));
                mx = fmaxf(mx, (n < nvalid) ? sval : -1e30f);
            }
        }
        mx = fmaxf(mx, __shfl_xor(mx, 32));
        const float moff = -fmaxf(mx, -1e29f) * LOG2E;
        float psum = 0.f, prev_pe = 0.f;
        f32x16 Oa[2];
#pragma unroll
        for (int i = 0; i < 16; ++i) { Oa[0][i] = 0.f; Oa[1][i] = 0.f; }
#pragma unroll 1
        for (int kt = 0; kt < kt_end; ++kt) {
            f32x16 acc;
            const float i0 = slope * (float)(512 * kt);
#pragma unroll
            for (int i = 0; i < 16; ++i) acc[i] = i0;
#pragma unroll
            for (int ds = 0; ds < 4; ++ds) {
                const bf16x8_t a = *(const bf16x8_t*)(Kc + (32 * kt + l31) * 144 + (16 * ds + 8 * h) * 2);
                acc = MFMA32(a, Qf[ds], acc);
            }
            float sv[16];
#pragma unroll
            for (int reg = 0; reg < 16; ++reg) {
                const int n = 32 * kt + crow32(reg, h);
                const float sval = acc[reg] + slope * (float)(16 * crow32(reg, h));
                sv[reg] = __builtin_amdgcn_exp2f(fmaf((n < nvalid) ? sval : -1e30f, LOG2E, moff));
                psum += sv[reg];
            }
#pragma unroll
            for (int q = 0; q < 4; ++q) {
                const float e = 0.5f * sv[q * 4 + 3];
                const float own = sv[q * 4] + sv[q * 4 + 1] + sv[q * 4 + 2] + e;
                const float pe = __shfl_xor(e, 32);
                impS[(r * 64 + tokoff) * 33 + 8 * kt + 2 * q + h] = own + (h ? pe : prev_pe);
                prev_pe = pe;
            }
#pragma unroll
            for (int s2 = 0; s2 < 2; ++s2) {
                u32x4 w; w.x = cvtpk(sv[s2 * 8 + 0], sv[s2 * 8 + 1]); w.y = cvtpk(sv[s2 * 8 + 2], sv[s2 * 8 + 3]); w.z = cvtpk(sv[s2 * 8 + 4], sv[s2 * 8 + 5]); w.w = cvtpk(sv[s2 * 8 + 6], sv[s2 * 8 + 7]);
                const bf16x8_t pf = __builtin_bit_cast(bf16x8_t, w);
#pragma unroll
                for (int mt = 0; mt < 2; ++mt) {
                    const unsigned char* vp = Vc + (32 * mt + l31) * 264 + (32 * kt + 16 * s2 + 4 * h) * 2;
                    const uint2 lo = *(const uint2*)vp, hi = *(const uint2*)(vp + 16);
                    u32x4 a; a.x = lo.x; a.y = lo.y; a.z = hi.x; a.w = hi.y;
                    Oa[mt] = MFMA32(__builtin_bit_cast(bf16x8_t, a), pf, Oa[mt]);
                }
            }
        }
        psum += __shfl_xor(psum, 32);
        const float inv = (nvalid > 0) ? 1.f / fmaxf(psum, 1e-30f) : 0.f;
        if (h == 0) invS[r * 64 + tokoff] = inv;
        const float g0 = sigmoidf_(bf2f(proj[trow * ODD_PAD + 2048 + hd])) * inv;
#pragma unroll
        for (int i = 0; i < 16; ++i) { outv[i] = g0 * Oa[0][i]; outv[16 + i] = g0 * Oa[1][i]; }
        __syncthreads();
#pragma unroll
        for (int i = 0; i < 4; ++i) {
            const int pc = tid + 512 * i, tk = pc >> 5, j = pc & 31, cur = tile;
            const float ij = (j < 8 * kt_end) ? impS[(0 * 64 + tk) * 33 + j] * invS[tk] + impS[(1 * 64 + tk) * 33 + j] * invS[64 + tk] + impS[(2 * 64 + tk) * 33 + j] * invS[128 + tk] + impS[(3 * 64 + tk) * 33 + j] * invS[192 + tk] : 0.f;
            const bool fj = (j == 0) || (j == cur) || (j == cur - 1);
            impT[tk * 33 + j] = (j <= cur) ? ij + (fj ? 1000.f : 0.f) : -INFINITY;
        }
        __syncthreads();
        {
            const int tk = tid >> 3, rr = tid & 7;
            float vk[32];
#pragma unroll
            for (int k = 0; k < 32; ++k) vk[k] = impT[tk * 33 + k];
            unsigned bits = 0;
#pragma unroll
            for (int jj = 0; jj < 4; ++jj) {
                const int j = rr * 4 + jj;
                const float vj = impT[tk * 33 + j];
                int rank = 0;
#pragma unroll
                for (int k = 0; k < 32; ++k) rank += (vk[k] > vj || (vk[k] == vj && k < j)) ? 1 : 0;
                if (rank < 16) bits |= 1u << j;
            }
            bits |= __shfl_xor(bits, 1);
            bits |= __shfl_xor(bits, 2);
            bits |= __shfl_xor(bits, 4);
            if (rr == 0) selS[tk] = bits;
        }
        }
        __syncthreads();
        {
        const int tid = tidx(), lane = tid & 63, l31 = lane & 31, h = lane >> 5;
        const int tile = 31 - (it >> 6), bg = it & 63, g = bg & 3, b = bg >> 2;
        const int hd = g * 4 + r, tokoff = thalf * 32 + l31, tok = tile * 64 + tokoff;
        const size_t trow = (size_t)(b * NL + tok);
        const float slope = exp2f(-0.5f * (float)(hd + 1)) * LOG2E;
        bf16x8_t Qf[4];
#pragma unroll
        for (int ds = 0; ds < 4; ++ds) {
            float q[8];
            ld8(proj + trow * ODD_PAD + hd * 64 + 16 * ds + 8 * h, q);
            const float qs = 0.125f * LOG2E;
            u32x4 w; w.x = cvtpk(q[0] * qs, q[1] * qs); w.y = cvtpk(q[2] * qs, q[3] * qs); w.z = cvtpk(q[4] * qs, q[5] * qs); w.w = cvtpk(q[6] * qs, q[7] * qs);
            Qf[ds] = __builtin_bit_cast(bf16x8_t, w);
        }
        float sc[16];
#pragma unroll
        for (int reg = 0; reg < 16; ++reg) sc[reg] = slope * (float)crow32(reg, h);
        const int skey = tid >> 3, spart = tid & 7;
        uint4 kreg = make_uint4(0u, 0u, 0u, 0u), vreg = kreg; bool have_first = false;
        const unsigned mymask = selS[tokoff];
        unsigned um = selS[lane];
        um |= sort_partner<1>(um, lane); um |= sort_partner<2>(um, lane); um |= sort_partner<4>(um, lane); um |= sort_partner<8>(um, lane); um |= sort_partner<16>(um, lane); um |= sort_partner<32>(um, lane);
        const unsigned causal = (tile == 31) ? 0xffffffffu : ((2u << tile) - 1u);
        const unsigned U = (unsigned)__builtin_amdgcn_readfirstlane((int)um) & causal;
#pragma unroll 1
        for (int branch = 0; branch < 2; ++branch) {
            unsigned todo = (branch == 0) ? U : (causal & ~((1u << (tile >= 8 ? tile - 8 : 0)) - 1u));
            const bf16_t* kbase = proj + (size_t)b * NL * ODD_PAD + (branch == 0 ? 1536 : 1792) + g * 64 + (size_t)skey * ODD_PAD + 8 * spart;
            const bf16_t* vbase = vt + (size_t)(branch * 256 + g * 64 + skey) * NT + (size_t)b * NL + 8 * spart;
            float m_run = -1e30f, l_run = 0.f;
            f32x16 Oa[2];
#pragma unroll
            for (int i = 0; i < 16; ++i) { Oa[0][i] = 0.f; Oa[1][i] = 0.f; }
            int jcur = __ffs(todo) - 1; todo &= todo - 1;
            if (branch == 0 || jcur != (tile >= 8 ? tile - 8 : 0)) { kreg = *(const uint4*)(kbase + (size_t)(64 * jcur) * ODD_PAD); vreg = *(const uint4*)(vbase + 64 * jcur); }
            have_first = true;
            int buf = 0;
            __syncthreads();
            *(uint4*)(ldsn + skey * 144 + spart * 16) = kreg;
            *(uint2*)(ldsn + 18432 + skey * 136 + spart * 16) = make_uint2(vreg.x, vreg.y);
            *(uint2*)(ldsn + 18432 + skey * 136 + spart * 16 + 8) = make_uint2(vreg.z, vreg.w);
            __syncthreads();
            for (;;) {
                const int jnext = todo ? (__ffs(todo) - 1) : -1;
                todo &= todo - 1;
                {
                    const int nb = jnext >= 0 ? branch : 1 - branch;
                    const int jl = jnext >= 0 ? jnext : (branch == 0 ? (tile >= 8 ? tile - 8 : 0) : 0);
                    const bf16_t* kb2 = proj + (size_t)b * NL * ODD_PAD + (nb == 0 ? 1536 : 1792) + g * 64 + (size_t)skey * ODD_PAD + 8 * spart;
                    const bf16_t* vb2 = vt + (size_t)(nb * 256 + g * 64 + skey) * NT + (size_t)b * NL + 8 * spart;
                    kreg = *(const uint4*)(kb2 + (size_t)(64 * jl) * ODD_PAD); vreg = *(const uint4*)(vb2 + 64 * jl);
                }
                const unsigned char* Ks = ldsn + buf * 9216;
                const unsigned char* Vs = ldsn + 18432 + buf * 8704;
                const bool mysel = (branch == 1) || ((mymask >> jcur) & 1u);
                if (__any(mysel)) {
                    const bool diag = (jcur == tile), wedge = (branch == 1) && (jcur == tile - 8);
                    const float init = mysel ? slope * (float)(64 * (jcur - tile)) : -1e30f;
                    float sv[32];
#pragma unroll
                    for (int kt = 0; kt < 2; ++kt) {
                        f32x16 acc;
                        const float i0 = init + slope * (float)(32 * kt);
#pragma unroll
                        for (int i = 0; i < 16; ++i) acc[i] = sc[i] + i0;
#pragma unroll
                        for (int ds = 0; ds < 4; ++ds) {
                            const bf16x8_t a = *(const bf16x8_t*)(Ks + (32 * kt + l31) * 144 + (16 * ds + 8 * h) * 2);
                            acc = MFMA32(a, Qf[ds], acc);
                        }
#pragma unroll
                        for (int reg = 0; reg < 16; ++reg) sv[kt * 16 + reg] = acc[reg];
                    }
                    if (diag || wedge) {
#pragma unroll
                        for (int i = 0; i < 32; ++i) {
                            const int keyoff = 32 * (i >> 4) + crow32(i & 15, h);
                            const bool ok = diag ? (keyoff <= tokoff) : (keyoff > tokoff);
                            sv[i] = ok ? sv[i] : -1e30f;
                        }
                    }
                    float mx = sv[0];
#pragma unroll
                    for (int i = 1; i < 32; ++i) mx = fmaxf(mx, sv[i]);
                    mx = fmaxf(mx, __shfl_xor(mx, 32));
                    if (!__all(mx < m_run - 160.f)) {
                    const float m_new = fmaxf(m_run, mx), m_use = fmaxf(m_new, -1e29f);
                    const float alpha = __builtin_amdgcn_exp2f(m_run - m_use);
                    const f32x2_t nm = {-m_use, -m_use};
                    f32x2_t ps2 = {0.f, 0.f};
#pragma unroll
                    for (int i = 0; i < 16; ++i) {
                        const f32x2_t t = (f32x2_t){sv[2 * i], sv[2 * i + 1]} + nm;
                        const f32x2_t p2 = {__builtin_amdgcn_exp2f(t.x), __builtin_amdgcn_exp2f(t.y)};
                        sv[2 * i] = p2.x; sv[2 * i + 1] = p2.y; ps2 += p2;
                    }
                    l_run = l_run * alpha + (ps2.x + ps2.y); m_run = m_new;
#pragma unroll
                    for (int i = 0; i < 16; ++i) { Oa[0][i] *= alpha; Oa[1][i] *= alpha; }
                    bf16x8_t Pf[4];
#pragma unroll
                    for (int ks = 0; ks < 4; ++ks) {
                        u32x4 w; w.x = cvtpk(sv[ks * 8 + 0], sv[ks * 8 + 1]); w.y = cvtpk(sv[ks * 8 + 2], sv[ks * 8 + 3]); w.z = cvtpk(sv[ks * 8 + 4], sv[ks * 8 + 5]); w.w = cvtpk(sv[ks * 8 + 6], sv[ks * 8 + 7]);
                        Pf[ks] = __builtin_bit_cast(bf16x8_t, w);
                    }
#pragma unroll
                    for (int mt = 0; mt < 2; ++mt)
#pragma unroll
                        for (int ks = 0; ks < 4; ++ks) {
                            const unsigned char* vp = Vs + (32 * mt + l31) * 136 + (16 * ks + 4 * h) * 2;
                            const uint2 lo = *(const uint2*)vp, hi = *(const uint2*)(vp + 16);
                            u32x4 w; w.x = lo.x; w.y = lo.y; w.z = hi.x; w.w = hi.y;
                            Oa[mt] = MFMA32(__builtin_bit_cast(bf16x8_t, w), Pf[ks], Oa[mt]);
                        }
                    }
                }
                if (jnext < 0) break;
                *(uint4*)(ldsn + (buf ^ 1) * 9216 + skey * 144 + spart * 16) = kreg;
                *(uint2*)(ldsn + 18432 + (buf ^ 1) * 8704 + skey * 136 + spart * 16) = make_uint2(vreg.x, vreg.y);
                *(uint2*)(ldsn + 18432 + (buf ^ 1) * 8704 + skey * 136 + spart * 16 + 8) = make_uint2(vreg.z, vreg.w);
                __syncthreads();
                buf ^= 1; jcur = jnext;
            }
            const float l_tot = l_run + __shfl_xor(l_run, 32);
            const float gt = sigmoidf_(bf2f(proj[trow * ODD_PAD + 2048 + (branch + 1) * 16 + hd]));
            const float f = gt / fmaxf(l_tot, 1e-30f);
#pragma unroll
            for (int i = 0; i < 16; ++i) { outv[i] += f * Oa[0][i]; outv[16 + i] += f * Oa[1][i]; }
        }
        bf16_t* orow = O + trow * ND + hd * 64;
#pragma unroll
        for (int mt = 0; mt < 2; ++mt)
#pragma unroll
            for (int q4 = 0; q4 < 4; ++q4) {
                bf16_t* op = orow + 32 * mt + 8 * q4 + 4 * h;
                const float o0 = outv[mt * 16 + q4 * 4 + 0], o1 = outv[mt * 16 + q4 * 4 + 1], o2 = outv[mt * 16 + q4 * 4 + 2], o3 = outv[mt * 16 + q4 * 4 + 3];
                *(uint2*)op = make_uint2(cvtpk(o0, o1), cvtpk(o2, o3));
            }
        }
    }
    __syncthreads();
    __builtin_amdgcn_s_setprio(0);
}


__device__ __forceinline__ void nsa_compress2_phase(const bf16_t* __restrict__ proj, const bf16_t* __restrict__ w1t  , const bf16_t* __restrict__ w2t  ,
                                                    const float* __restrict__ bias1  , bf16_t* __restrict__ kcmp  , bf16_t* __restrict__ vcmpT  ,
                                                    unsigned char* lds) {
    const int tid = tidx(), wave = __builtin_amdgcn_readfirstlane(tid >> 6), lane = tid & 63, fr = lane & 15, fq = lane >> 4;
    unsigned char* xs = lds;
    unsigned char* hs = lds + 133120;
    for (int it = blockIdx.x; it < 256; it += gridDim.x) {
        const int which = it >> 7, nt2 = it & 1, g = (it >> 1) & 3, b = (it >> 3) & 15;
        const int t0 = 1024 * nt2, coloff = (which ? 1280 : 1024) + g * 64;
        __syncthreads();
        for (int pc = tid; pc < 1040 * 8; pc += NTHR) {
            const int tk = pc >> 3, c = pc & 7;
            int tsrc = t0 + tk; tsrc = tsrc > NL - 1 ? NL - 1 : tsrc;
            *(uint4*)(xs + tk * 128 + ((c ^ ((tk >> 4) & 7)) << 4)) = *(const uint4*)(proj + (size_t)(b * NL + tsrc) * ODD_PAD + coloff + 8 * c);
        }
        __syncthreads();
        f32x4 acc[4];
#pragma unroll
        for (int mt = 0; mt < 4; ++mt) acc[mt] = (f32x4){0.f, 0.f, 0.f, 0.f};
        const bf16_t* wrow = w1t + ((size_t)which * 128 + 16 * wave + fr) * 2048 + 8 * fq;
#pragma unroll 4
        for (int ks = 0; ks < 64; ++ks) {
            const int l = ks >> 1, c = 4 * (ks & 1) + fq;
            const bf16x8_t bfrag = *(const bf16x8_t*)(wrow + 32 * ks);
#pragma unroll
            for (int mt = 0; mt < 4; ++mt) {
                const int tk = 16 * (16 * mt + fr) + l;
                const bf16x8_t a = *(const bf16x8_t*)(xs + tk * 128 + ((c ^ ((tk >> 4) & 7)) << 4));
                acc[mt] = __builtin_amdgcn_mfma_f32_16x16x32_bf16(a, bfrag, acc[mt], 0, 0, 0);
            }
        }
        {
            const float bj = bias1[which * 128 + 16 * wave + fr];
#pragma unroll
            for (int mt = 0; mt < 4; ++mt)
#pragma unroll
                for (int reg = 0; reg < 4; ++reg) *(bf16_t*)(hs + (16 * mt + 4 * fq + reg) * 272 + (16 * wave + fr) * 2) = f2bf(gelu_fast(acc[mt][reg] + bj));
        }
        __syncthreads();
        {
            const int mt = wave >> 1;
#pragma unroll
            for (int ci = 0; ci < 2; ++ci) {
                const int ct = 2 * (wave & 1) + ci;
                f32x4 o = {0.f, 0.f, 0.f, 0.f};
#pragma unroll
                for (int ks = 0; ks < 4; ++ks) {
                    const bf16x8_t a = *(const bf16x8_t*)(hs + (16 * mt + fr) * 272 + (32 * ks + 8 * fq) * 2);
                    const bf16x8_t bfrag = *(const bf16x8_t*)(w2t + ((size_t)which * 64 + 16 * ct + fr) * 128 + 32 * ks + 8 * fq);
                    o = __builtin_amdgcn_mfma_f32_16x16x32_bf16(a, bfrag, o, 0, 0, 0);
                }
                const int c = 16 * ct + fr;
#pragma unroll
                for (int reg = 0; reg < 4; ++reg) {
                    const int n = 64 * nt2 + 16 * mt + 4 * fq + reg;
                    const bf16_t val = (n < 127) ? f2bf(o[reg]) : (bf16_t)0;
                    if (which == 0) kcmp[((size_t)(b * 4 + g) * 128 + n) * 64 + c] = val;
                    else vcmpT[(((size_t)(b * 4 + g) * 8 + (n >> 4)) * 64 + c) * 16 + (n & 15)] = val;
                }
            }
        }
    }
    __syncthreads();
}

__device__ __forceinline__ void nsa_cmp2_phase(const bf16_t* __restrict__ proj, const bf16_t* __restrict__ kcmp, const bf16_t* __restrict__ vcmpT,
                                               bf16_t* __restrict__ O, unsigned* __restrict__ selmask, unsigned char* lds) {
    if (__builtin_amdgcn_readfirstlane(tidx() >> 6) >= 4) __builtin_amdgcn_s_setprio(1);
    const int tid = tidx(), wave = __builtin_amdgcn_readfirstlane(tid >> 6), lane = tid & 63, l31 = lane & 31, h = lane >> 5;
    const int r = wave & 3, thalf = wave >> 2;
    unsigned char* Kc = lds;
    unsigned char* Vc = lds + 18432;
    float* impS = (float*)(lds + 35328);
    float* invS = (float*)(lds + 35328 + 33792);
    float* impT = (float*)(lds + 35328 + 33792 + 1024);
    int staged_bg = -1;
    for (int it = blockIdx.x; it < 32 * 64; it += gridDim.x) {
        const int tile = 31 - (it >> 6), bg = it & 63, g = bg & 3, b = bg >> 2;
        const int hd = g * 4 + r, tokoff = thalf * 32 + l31, tok = tile * 64 + tokoff;
        const size_t trow = (size_t)(b * NL + tok);
        const float slope = exp2f(-0.5f * (float)(hd + 1));
        __syncthreads();
        if (bg != staged_bg) {
        staged_bg = bg;
#pragma unroll
        for (int i = 0; i < 2; ++i) {
            const int pc = tid + 512 * i;
            { const int row = pc >> 3, c = pc & 7; *(uint4*)(Kc + row * 144 + c * 16) = *(const uint4*)(kcmp + ((size_t)(b * 4 + g) * 128 + row) * 64 + 8 * c); }
            { const int row = pc >> 4, c = pc & 15; const uint4 v = *(const uint4*)(vcmpT + (((size_t)(b * 4 + g) * 8 + (c >> 1)) * 64 + row) * 16 + (c & 1) * 8);
              *(uint2*)(Vc + row * 264 + c * 16) = make_uint2(v.x, v.y); *(uint2*)(Vc + row * 264 + c * 16 + 8) = make_uint2(v.z, v.w); }
        }
        }
        bf16x8_t Qf[4];
#pragma unroll
        for (int ds = 0; ds < 4; ++ds) {
            float q[8];
            ld8(proj + trow * ODD_PAD + hd * 64 + 16 * ds + 8 * h, q);
            u32x4 w; w.x = cvtpk(q[0] * 0.125f, q[1] * 0.125f); w.y = cvtpk(q[2] * 0.125f, q[3] * 0.125f); w.z = cvtpk(q[4] * 0.125f, q[5] * 0.125f); w.w = cvtpk(q[6] * 0.125f, q[7] * 0.125f);
            Qf[ds] = __builtin_bit_cast(bf16x8_t, w);
        }
        int nvalid = (tok >= 31) ? ((tok - 31) / 16 + 1) : 0;
        nvalid = nvalid > 127 ? 127 : nvalid;
        const int nv_max = (4 * tile + 3) > 127 ? 127 : (4 * tile + 3);
        const int kt_end = (nv_max + 31) >> 5;
        __syncthreads();
        float mx = -1e30f;
#pragma unroll 2
        for (int kt = 0; kt < kt_end; ++kt) {
            f32x16 acc;
            const float i0 = slope * (float)(512 * kt);
#pragma unroll
            for (int i = 0; i < 16; ++i) acc[i] = i0;
#pragma unroll
            for (int ds = 0; ds < 4; ++ds) {
                const bf16x8_t a = *(const bf16x8_t*)(Kc + (32 * kt + l31) * 144 + (16 * ds + 8 * h) * 2);
                acc = MFMA32(a, Qf[ds], acc);
            }
#pragma unroll
            for (int reg = 0; reg < 16; ++reg) {
                const int n = 32 * kt + crow32(reg, h);
                const float sval = acc[reg] + slope * (float)(16 * crow32(reg, h));
                mx = fmaxf(mx, (n < nvalid) ? sval : -1e30f);
            }
        }
        mx = fmaxf(mx, __shfl_xor(mx, 32));
        const float moff = -fmaxf(mx, -1e29f) * LOG2E;
        float psum = 0.f, prev_pe = 0.f;
        f32x16 Oa[2];
#pragma unroll
        for (int i = 0; i < 16; ++i) { Oa[0][i] = 0.f; Oa[1][i] = 0.f; }
#pragma unroll 2
        for (int kt = 0; kt < kt_end; ++kt) {
            f32x16 acc;
            const float i0 = slope * (float)(512 * kt);
#pragma unroll
            for (int i = 0; i < 16; ++i) acc[i] = i0;
#pragma unroll
            for (int ds = 0; ds < 4; ++ds) {
                const bf16x8_t a = *(const bf16x8_t*)(Kc + (32 * kt + l31) * 144 + (16 * ds + 8 * h) * 2);
                acc = MFMA32(a, Qf[ds], acc);
            }
            float sv[16];
#pragma unroll
            for (int reg = 0; reg < 16; ++reg) {
                const int n = 32 * kt + crow32(reg, h);
                const float sval = acc[reg] + slope * (float)(16 * crow32(reg, h));
                sv[reg] = __builtin_amdgcn_exp2f(fmaf((n < nvalid) ? sval : -1e30f, LOG2E, moff));
                psum += sv[reg];
            }
#pragma unroll
            for (int q = 0; q < 4; ++q) {
                const float e = 0.5f * sv[q * 4 + 3];
                const float own = sv[q * 4] + sv[q * 4 + 1] + sv[q * 4 + 2] + e;
                const float pe = __shfl_xor(e, 32);
                impS[(r * 64 + tokoff) * 33 + 8 * kt + 2 * q + h] = own + (h ? pe : prev_pe);
                prev_pe = pe;
            }
#pragma unroll
            for (int s2 = 0; s2 < 2; ++s2) {
                u32x4 w; w.x = cvtpk(sv[s2 * 8 + 0], sv[s2 * 8 + 1]); w.y = cvtpk(sv[s2 * 8 + 2], sv[s2 * 8 + 3]); w.z = cvtpk(sv[s2 * 8 + 4], sv[s2 * 8 + 5]); w.w = cvtpk(sv[s2 * 8 + 6], sv[s2 * 8 + 7]);
                const bf16x8_t pf = __builtin_bit_cast(bf16x8_t, w);
#pragma unroll
                for (int mt = 0; mt < 2; ++mt) {
                    const unsigned char* vp = Vc + (32 * mt + l31) * 264 + (32 * kt + 16 * s2 + 4 * h) * 2;
                    const uint2 lo = *(const uint2*)vp, hi = *(const uint2*)(vp + 16);
                    u32x4 a; a.x = lo.x; a.y = lo.y; a.z = hi.x; a.w = hi.y;
                    Oa[mt] = MFMA32(__builtin_bit_cast(bf16x8_t, a), pf, Oa[mt]);
                }
            }
        }
        psum += __shfl_xor(psum, 32);
        const float inv = (nvalid > 0) ? 1.f / fmaxf(psum, 1e-30f) : 0.f;
        if (h == 0) invS[r * 64 + tokoff] = inv;
        const float g0 = sigmoidf_(bf2f(proj[trow * ODD_PAD + 2048 + hd])) * inv;
        bf16_t* orow = O + trow * ND + hd * 64;
#pragma unroll
        for (int mt = 0; mt < 2; ++mt)
#pragma unroll
            for (int q4 = 0; q4 < 4; ++q4)
                *(uint2*)(orow + 32 * mt + 8 * q4 + 4 * h) = make_uint2(cvtpk(g0 * Oa[mt][q4 * 4], g0 * Oa[mt][q4 * 4 + 1]), cvtpk(g0 * Oa[mt][q4 * 4 + 2], g0 * Oa[mt][q4 * 4 + 3]));
        __syncthreads();
#pragma unroll
        for (int i = 0; i < 4; ++i) {
            const int pc = tid + 512 * i, tk = pc >> 5, j = pc & 31, cur = tile;
            const float ij = (j < 8 * kt_end) ? impS[(0 * 64 + tk) * 33 + j] * invS[tk] + impS[(1 * 64 + tk) * 33 + j] * invS[64 + tk] + impS[(2 * 64 + tk) * 33 + j] * invS[128 + tk] + impS[(3 * 64 + tk) * 33 + j] * invS[192 + tk] : 0.f;
            const bool fj = (j == 0) || (j == cur) || (j == cur - 1);
            impT[tk * 33 + j] = (j <= cur) ? ij + (fj ? 1000.f : 0.f) : -INFINITY;
        }
        __syncthreads();
        {
            const int tk = tid >> 3, rr = tid & 7;
            float vk[32];
#pragma unroll
            for (int k = 0; k < 32; ++k) vk[k] = impT[tk * 33 + k];
            unsigned bits = 0;
#pragma unroll
            for (int jj = 0; jj < 4; ++jj) {
                const int j = rr * 4 + jj;
                const float vj = impT[tk * 33 + j];
                int rank = 0;
#pragma unroll
                for (int k = 0; k < 32; ++k) rank += (vk[k] > vj || (vk[k] == vj && k < j)) ? 1 : 0;
                if (rank < 16) bits |= 1u << j;
            }
            bits |= __shfl_xor(bits, 1);
            bits |= __shfl_xor(bits, 2);
            bits |= __shfl_xor(bits, 4);
            if (rr == 0) selmask[(size_t)(b * 4 + g) * NL + tile * 64 + tk] = bits;
        }
    }
    __syncthreads();
    __builtin_amdgcn_s_setprio(0);
}


constexpr int P0W = 1792;
constexpr float LN2F = 0.6931471805599453f;
__device__ __forceinline__ void sb_attn2_phase(const bf16_t* __restrict__ proj, const bf16_t* __restrict__ vt, bf16_t* __restrict__ Y, unsigned char* lds) {
    if (__builtin_amdgcn_readfirstlane(tidx() >> 6) >= 4) __builtin_amdgcn_s_setprio(1);
    const int tid = tidx(), wave = __builtin_amdgcn_readfirstlane(tid >> 6), lane = tid & 63, l31 = lane & 31, h = lane >> 5;
    const int skey = tid >> 3, spart = tid & 7;
    for (int it = blockIdx.x; it < NB * 12 * 8; it += gridDim.x) {
        const int tile = 7 - (it / 192), bh = it % 192, hh = bh % 12, b = bh / 12;
        const int qlo = tile * 256 + 32 * wave, tq = qlo + l31;
        const size_t trow = (size_t)(b * NL + tq);
        bf16x8_t Qf[4];
#pragma unroll
        for (int ds = 0; ds < 4; ++ds) {
            float q[8];
            ld8(proj + trow * P0W + 256 + hh * 64 + 16 * ds + 8 * h, q);
            u32x4 w; w.x = cvtpk(q[0] * 0.125f, q[1] * 0.125f); w.y = cvtpk(q[2] * 0.125f, q[3] * 0.125f); w.z = cvtpk(q[4] * 0.125f, q[5] * 0.125f); w.w = cvtpk(q[6] * 0.125f, q[7] * 0.125f);
            Qf[ds] = __builtin_bit_cast(bf16x8_t, w);
        }
        const bf16_t* kbase = proj + (size_t)b * NL * P0W + 1024 + hh * 64 + (size_t)skey * P0W + 8 * spart;
        const bf16_t* vbase = vt + (size_t)(hh * 64 + skey) * NT + (size_t)b * NL + 8 * spart;
        f32x16 Oa[2];
#pragma unroll
        for (int i = 0; i < 16; ++i) { Oa[0][i] = 0.f; Oa[1][i] = 0.f; }
        float carry = 0.f;
        int j = tile * 4 + 3, buf = 0;
        uint4 kreg = *(const uint4*)(kbase + (size_t)(64 * j) * P0W);
        uint4 vreg = *(const uint4*)(vbase + 64 * j);
        __syncthreads();
        *(uint4*)(lds + skey * 144 + spart * 16) = kreg;
        *(uint2*)(lds + 18432 + skey * 136 + spart * 16) = make_uint2(vreg.x, vreg.y);
        *(uint2*)(lds + 18432 + skey * 136 + spart * 16 + 8) = make_uint2(vreg.z, vreg.w);
        __syncthreads();
        for (;;) {
            const int jn = j - 1;
            if (jn >= 0) { kreg = *(const uint4*)(kbase + (size_t)(64 * jn) * P0W); vreg = *(const uint4*)(vbase + 64 * jn); }
            const unsigned char* Ks = lds + buf * 9216;
            const unsigned char* Vs = lds + 18432 + buf * 8704;
            const bool live = (64 * j <= qlo + 30) && !__all(carry < -110.f);
            if (live) {
#pragma unroll
                for (int kti = 0; kti < 2; ++kti) {
                    const int kt = 1 - kti;
                    f32x16 acc;
#pragma unroll
                    for (int i = 0; i < 16; ++i) acc[i] = 0.f;
#pragma unroll
                    for (int ds = 0; ds < 4; ++ds) {
                        const bf16x8_t a = *(const bf16x8_t*)(Ks + (32 * kt + l31) * 144 + (16 * ds + 8 * h) * 2);
                        acc = MFMA32(a, Qf[ds], acc);
                    }
                    float m1[16], lz[16];
#pragma unroll
                    for (int reg = 0; reg < 16; ++reg) {
                        const float z = acc[reg];
                        const bool valid = (64 * j + 32 * kt + crow32(reg, h)) < tq;
                        const float e = __builtin_amdgcn_exp2f(-fabsf(z) * LOG2E);
                        const float sp = fmaxf(z, 0.f) + __builtin_amdgcn_logf(1.f + e) * LN2F;
                        m1[reg] = valid ? -sp : 0.f;
                        lz[reg] = valid ? z - sp : -1e30f;
                    }
                    float G[4], T[4];
#pragma unroll
                    for (int q = 0; q < 4; ++q) G[q] = (m1[4 * q] + m1[4 * q + 1]) + (m1[4 * q + 2] + m1[4 * q + 3]);
                    float Gp[4];
#pragma unroll
                    for (int q = 0; q < 4; ++q) { Gp[q] = __shfl_xor(G[q], 32); T[q] = G[q] + Gp[q]; }
                    float base[4];
                    base[3] = carry; base[2] = base[3] + T[3]; base[1] = base[2] + T[2]; base[0] = base[1] + T[1];
                    const float tot = base[0] + T[0];
#pragma unroll
                    for (int q = 0; q < 4; ++q) {
                        const float bq = base[q] + (h ? 0.f : Gp[q]);
                        const float t3 = bq, t2 = t3 + m1[4 * q + 3], t1 = t2 + m1[4 * q + 2], t0 = t1 + m1[4 * q + 1];
                        lz[4 * q + 3] = __builtin_amdgcn_exp2f((lz[4 * q + 3] + t3) * LOG2E);
                        lz[4 * q + 2] = __builtin_amdgcn_exp2f((lz[4 * q + 2] + t2) * LOG2E);
                        lz[4 * q + 1] = __builtin_amdgcn_exp2f((lz[4 * q + 1] + t1) * LOG2E);
                        lz[4 * q + 0] = __builtin_amdgcn_exp2f((lz[4 * q + 0] + t0) * LOG2E);
                    }
                    carry = tot;
#pragma unroll
                    for (int s2 = 0; s2 < 2; ++s2) {
                        u32x4 w; w.x = cvtpk(lz[s2 * 8 + 0], lz[s2 * 8 + 1]); w.y = cvtpk(lz[s2 * 8 + 2], lz[s2 * 8 + 3]); w.z = cvtpk(lz[s2 * 8 + 4], lz[s2 * 8 + 5]); w.w = cvtpk(lz[s2 * 8 + 6], lz[s2 * 8 + 7]);
                        const bf16x8_t pf = __builtin_bit_cast(bf16x8_t, w);
#pragma unroll
                        for (int mt = 0; mt < 2; ++mt) {
                            const unsigned char* vp = Vs + (32 * mt + l31) * 136 + (32 * kt + 16 * s2 + 4 * h) * 2;
                            const uint2 lo = *(const uint2*)vp, hi = *(const uint2*)(vp + 16);
                            u32x4 a; a.x = lo.x; a.y = lo.y; a.z = hi.x; a.w = hi.y;
                            Oa[mt] = MFMA32(__builtin_bit_cast(bf16x8_t, a), pf, Oa[mt]);
                        }
                    }
                }
            }
            if (jn >= 0) {
                *(uint4*)(lds + (buf ^ 1) * 9216 + skey * 144 + spart * 16) = kreg;
                *(uint2*)(lds + 18432 + (buf ^ 1) * 8704 + skey * 136 + spart * 16) = make_uint2(vreg.x, vreg.y);
                *(uint2*)(lds + 18432 + (buf ^ 1) * 8704 + skey * 136 + spart * 16 + 8) = make_uint2(vreg.z, vreg.w);
            }
            volatile int* flg = (volatile int*)(lds + 35840) + (j & 1) * 8;
            const int wdone = __all(carry < -110.f);
            if (lane == 0) flg[wave] = wdone;
            __syncthreads();
            const int alldone = flg[0] & flg[1] & flg[2] & flg[3] & flg[4] & flg[5] & flg[6] & flg[7];
            if (alldone || jn < 0) break;
            buf ^= 1; j = jn;
        }
        bf16_t* orow = Y + trow * ND + 256 + hh * 64;
#pragma unroll
        for (int mt = 0; mt < 2; ++mt)
#pragma unroll
            for (int q4 = 0; q4 < 4; ++q4)
                *(uint2*)(orow + 32 * mt + 8 * q4 + 4 * h) = make_uint2(cvtpk(Oa[mt][q4 * 4], Oa[mt][q4 * 4 + 1]), cvtpk(Oa[mt][q4 * 4 + 2], Oa[mt][q4 * 4 + 3]));
    }
    __syncthreads();
    __builtin_amdgcn_s_setprio(0);
}

__device__ __forceinline__ void s5_scan2_phase(const bf16_t* __restrict__ proj, const float* __restrict__ lam_re, const float* __restrict__ lam_im, const float* __restrict__ log_dt,
                                               const float* __restrict__ b_re, const float* __restrict__ b_im, const float* __restrict__ c_re, const float* __restrict__ c_im,
                                               const float* __restrict__ dskip, bf16_t* __restrict__ ya, float* lds) {
    const int tid = tidx(), wave = __builtin_amdgcn_readfirstlane(tid >> 6), lane = tid & 63;
    float* cr = lds;
    float* ci = lds + 1024;
    float* Es = lds + 2048;
    float* us = lds + 3072 + wave * 512;
    float* xr = lds + 7168 + wave * 4160;
    float* xi = xr + 2080;
    for (int bg = blockIdx.x; bg < NB * 16; bg += gridDim.x) {
        const int b = bg >> 4, g = bg & 15;
        const float lr = lam_re[g * 64 + lane], li = lam_im[g * 64 + lane];
        const float dt = expf(log_dt[g]);
        const float mag = expf(lr * dt);
        const float are = mag * cosf(li * dt), aim = mag * sinf(li * dt);
        const float nr = are - 1.f, den = lr * lr + li * li;
        const float fre = (nr * lr + aim * li) / den, fim = (aim * lr - nr * li) / den;
        float bbr[16], bbi[16];
#pragma unroll
        for (int i = 0; i < 16; ++i) {
            const float br = b_re[(g * 64 + lane) * 16 + i], bi = b_im[(g * 64 + lane) * 16 + i];
            bbr[i] = fre * br - fim * bi; bbi[i] = fre * bi + fim * br;
        }
        __syncthreads();
        for (int idx = tid; idx < 1024; idx += NTHR) { cr[idx] = c_re[g * 1024 + idx]; ci[idx] = c_im[g * 1024 + idx]; }
        const bf16_t* ub = proj + (size_t)(b * NL + 256 * wave) * P0W + g * 16;
        float xre = 0.f, xim = 0.f;
        for (int c0 = 0; c0 < 256; c0 += 32) {
            wave_lds_fence();
            { float u8[8]; const int t = lane >> 1, hf = lane & 1; ld8(ub + (size_t)(c0 + t) * P0W + 8 * hf, u8);
#pragma unroll
              for (int i = 0; i < 8; ++i) us[t * 16 + 8 * hf + i] = u8[i]; }
            wave_lds_fence();
            for (int t = 0; t < 32; ++t) {
                float bur = 0.f, bui = 0.f;
#pragma unroll
                for (int i = 0; i < 16; ++i) { const float u = us[t * 16 + i]; bur += bbr[i] * u; bui += bbi[i] * u; }
                const float nre = are * xre - aim * xim + bur, nim = are * xim + aim * xre + bui;
                xre = nre; xim = nim;
            }
        }
        Es[(wave * 64 + lane) * 2] = xre; Es[(wave * 64 + lane) * 2 + 1] = xim;
        float pr = are, pi = aim;
#pragma unroll
        for (int i = 0; i < 8; ++i) { const float nr2 = pr * pr - pi * pi, ni2 = 2.f * pr * pi; pr = nr2; pi = ni2; }
        __syncthreads();
        xre = 0.f; xim = 0.f;
        for (int w2 = 0; w2 < wave; ++w2) {
            const float er = Es[(w2 * 64 + lane) * 2], ei = Es[(w2 * 64 + lane) * 2 + 1];
            const float nre = pr * xre - pi * xim + er, nim = pr * xim + pi * xre + ei;
            xre = nre; xim = nim;
        }
        const int tt = lane & 31, ih = lane >> 5;
        float dsk[8];
#pragma unroll
        for (int i = 0; i < 8; ++i) dsk[i] = dskip[g * 16 + 8 * ih + i];
        for (int c0 = 0; c0 < 256; c0 += 32) {
            wave_lds_fence();
            { float u8[8]; const int t = lane >> 1, hf = lane & 1; ld8(ub + (size_t)(c0 + t) * P0W + 8 * hf, u8);
#pragma unroll
              for (int i = 0; i < 8; ++i) us[t * 16 + 8 * hf + i] = u8[i]; }
            wave_lds_fence();
            for (int t = 0; t < 32; ++t) {
                float bur = 0.f, bui = 0.f;
#pragma unroll
                for (int i = 0; i < 16; ++i) { const float u = us[t * 16 + i]; bur += bbr[i] * u; bui += bbi[i] * u; }
                const float nre = are * xre - aim * xim + bur, nim = are * xim + aim * xre + bui;
                xre = nre; xim = nim;
                xr[t * 65 + lane] = xre; xi[t * 65 + lane] = xim;
            }
            wave_lds_fence();
            float y[8];
#pragma unroll
            for (int i = 0; i < 8; ++i) y[i] = 0.f;
            for (int p = 0; p < 64; ++p) {
                const float a = xr[tt * 65 + p], bq = xi[tt * 65 + p];
#pragma unroll
                for (int i = 0; i < 8; ++i) y[i] += cr[(8 * ih + i) * 64 + p] * a - ci[(8 * ih + i) * 64 + p] * bq;
            }
            float o[8];
#pragma unroll
            for (int i = 0; i < 8; ++i) o[i] = gelu_fast(y[i] + dsk[i] * us[tt * 16 + 8 * ih + i]);
            st8(ya + (size_t)(b * NL + 256 * wave + c0 + tt) * 256 + g * 16 + 8 * ih, o);
        }
    }
    __syncthreads();
}


__device__ __forceinline__ void glu2_phase(const bf16_t* __restrict__ ya, const bf16_t* __restrict__ wgt, const float* __restrict__ bglu, bf16_t* __restrict__ Y, unsigned char* lds) {
    const int tid = tidx(), wave = __builtin_amdgcn_readfirstlane(tid >> 6), lane = tid & 63, fr = lane & 15, fq = lane >> 4;
    __syncthreads();
    for (int pc = tid; pc < 256 * 32; pc += NTHR) { const int row = pc >> 5, c = pc & 31; *(uint4*)(lds + row * 528 + c * 16) = *(const uint4*)(wgt + row * 256 + c * 8); }
    __syncthreads();
    for (int chunk = blockIdx.x; chunk < NT / 128; chunk += gridDim.x) {
        const size_t tok = (size_t)chunk * 128 + wave * 16 + fr;
        const size_t yb_b = (tok / NL) * 16, yt = tok % NL;
        bf16x8_t yb[8];
#pragma unroll
        for (int ks = 0; ks < 8; ++ks) yb[ks] = *(const bf16x8_t*)(ya + ((yb_b + 2 * ks + (fq >> 1)) * NL + yt) * 16 + (fq & 1) * 8);
#pragma unroll 2
        for (int nt = 0; nt < 16; ++nt) {
            f32x4 acc = {0.f, 0.f, 0.f, 0.f};
#pragma unroll
            for (int ks = 0; ks < 8; ++ks) {
                const bf16x8_t a = *(const bf16x8_t*)(lds + (16 * nt + fr) * 528 + (32 * ks + 8 * fq) * 2);
                acc = __builtin_amdgcn_mfma_f32_16x16x32_bf16(a, yb[ks], acc, 0, 0, 0);
            }
            const int n0 = 16 * nt + 4 * fq;
            const uint2 yv = *(const uint2*)(ya + ((yb_b + nt) * NL + yt) * 16 + 4 * fq);
            const float4 bb = *(const float4*)(bglu + n0);
            const float o0 = __uint_as_float(yv.x << 16) * sigmoidf_(acc[0] + bb.x), o1 = __uint_as_float(yv.x & 0xffff0000u) * sigmoidf_(acc[1] + bb.y);
            const float o2 = __uint_as_float(yv.y << 16) * sigmoidf_(acc[2] + bb.z), o3 = __uint_as_float(yv.y & 0xffff0000u) * sigmoidf_(acc[3] + bb.w);
            *(uint2*)(Y + tok * ND + n0) = make_uint2(cvtpk(o0, o1), cvtpk(o2, o3));
        }
    }
    __syncthreads();
}


__device__ __forceinline__ void cmadd(float& re, float& im, float ar, float ai, float br, float bi) {
    const float nr = fmaf(ar, re, fmaf(-ai, im, br)), ni = fmaf(ar, im, fmaf(ai, re, bi));
    re = nr; im = ni;
}
__device__ __forceinline__ void s5_scan3_phase(const bf16_t* __restrict__ proj, const float* __restrict__ lam_re, const float* __restrict__ lam_im, const float* __restrict__ log_dt,
                                               const float* __restrict__ b_re, const float* __restrict__ b_im, const float* __restrict__ c_re, const float* __restrict__ c_im,
                                               const float* __restrict__ dskip, bf16_t* __restrict__ ya, unsigned char* lds) {
    const int tid = tidx(), wave = __builtin_amdgcn_readfirstlane(tid >> 6), lane = tid & 63, l31 = lane & 31, h = lane >> 5, fr = lane & 15, fq = lane >> 4;
    unsigned char* Xs = lds + wave * 10752;
    float* Es = (float*)(lds + 86016);
    __syncthreads();
    for (int i = lane; i < 32 * 21; i += 64) *(uint4*)(Xs + i * 16) = make_uint4(0u, 0u, 0u, 0u);
    for (int bg = blockIdx.x; bg < NB * 16; bg += gridDim.x) {
        const int b = bg >> 4, g = bg & 15;
        const float dt = expf(log_dt[g]);
        float are[2], aim[2]; bf16x8_t Bre[2], Bim[2];
#pragma unroll
        for (int k = 0; k < 2; ++k) {
            const int p = 32 * k + l31;
            const float lr = lam_re[g * 64 + p], li = lam_im[g * 64 + p];
            const float mag = expf(lr * dt);
            are[k] = mag * cosf(li * dt); aim[k] = mag * sinf(li * dt);
            const float nr = are[k] - 1.f, den = lr * lr + li * li;
            const float fre = (nr * lr + aim[k] * li) / den, fim = (aim[k] * lr - nr * li) / den;
            float vr[8], vi[8];
#pragma unroll
            for (int j = 0; j < 8; ++j) {
                const float br = b_re[(g * 64 + p) * 16 + 8 * h + j], bi = b_im[(g * 64 + p) * 16 + 8 * h + j];
                vr[j] = fre * br - fim * bi; vi[j] = fre * bi + fim * br;
            }
            u32x4 w; w.x = cvtpk(vr[0], vr[1]); w.y = cvtpk(vr[2], vr[3]); w.z = cvtpk(vr[4], vr[5]); w.w = cvtpk(vr[6], vr[7]); Bre[k] = __builtin_bit_cast(bf16x8_t, w);
            w.x = cvtpk(vi[0], vi[1]); w.y = cvtpk(vi[2], vi[3]); w.z = cvtpk(vi[4], vi[5]); w.w = cvtpk(vi[6], vi[7]); Bim[k] = __builtin_bit_cast(bf16x8_t, w);
        }
        bf16x8_t Cm[5];
        {
            const float di = dskip[g * 16 + fr];
#pragma unroll
            for (int ks = 0; ks < 5; ++ks) {
                float cv[8];
#pragma unroll
                for (int j = 0; j < 8; ++j) {
                    const int kk = 32 * ks + 8 * fq + j;
                    cv[j] = kk < 64 ? c_re[(g * 16 + fr) * 64 + kk] : (kk < 128 ? -c_im[(g * 16 + fr) * 64 + kk - 64] : ((kk - 128) == fr ? di : 0.f));
                }
                u32x4 w; w.x = cvtpk(cv[0], cv[1]); w.y = cvtpk(cv[2], cv[3]); w.z = cvtpk(cv[4], cv[5]); w.w = cvtpk(cv[6], cv[7]); Cm[ks] = __builtin_bit_cast(bf16x8_t, w);
            }
        }
        float a4r[2], a4i[2], a5r[2], a5i[2], a32r[2], a32i[2], a256r[2], a256i[2];
#pragma unroll
        for (int k = 0; k < 2; ++k) {
            float pr = are[k], pi = aim[k], t;
            t = pr * pr - pi * pi; pi = 2.f * pr * pi; pr = t;
            t = pr * pr - pi * pi; pi = 2.f * pr * pi; pr = t;
            a4r[k] = pr; a4i[k] = pi;
            a5r[k] = pr * are[k] - pi * aim[k]; a5i[k] = pr * aim[k] + pi * are[k];
#pragma unroll
            for (int i = 0; i < 3; ++i) { t = pr * pr - pi * pi; pi = 2.f * pr * pi; pr = t; }
            a32r[k] = pr; a32i[k] = pi;
#pragma unroll
            for (int i = 0; i < 3; ++i) { t = pr * pr - pi * pi; pi = 2.f * pr * pi; pr = t; }
            a256r[k] = pr; a256i[k] = pi;
        }
        const bf16_t* ub = proj + (size_t)(b * NL + 256 * wave) * P0W + g * 16 + 8 * h;
        float sre[2] = {0.f, 0.f}, sim[2] = {0.f, 0.f};
        bf16x8_t ufn = *(const bf16x8_t*)(ub + (size_t)l31 * P0W);
#pragma unroll 1
        for (int c0 = 0; c0 < 256; c0 += 32) {
            const bf16x8_t uf = ufn;
            ufn = *(const bf16x8_t*)(ub + (size_t)(((c0 + 32) & 255) + l31) * P0W);
#pragma unroll
            for (int k = 0; k < 2; ++k) {
                f32x16 z;
#pragma unroll
                for (int i = 0; i < 16; ++i) z[i] = 0.f;
                const f32x16 bur = MFMA32(uf, Bre[k], z), bui = MFMA32(uf, Bim[k], z);
                float er = 0.f, ei = 0.f;
#pragma unroll
                for (int reg = 0; reg < 16; ++reg) {
                    if (reg == 0) { er = bur[0]; ei = bui[0]; }
                    else if ((reg & 3) == 0) cmadd(er, ei, a5r[k], a5i[k], bur[reg], bui[reg]);
                    else cmadd(er, ei, are[k], aim[k], bur[reg], bui[reg]);
                }
                { float tr = er, ti = ei; cmadd(tr, ti, a4r[k], a4i[k], 0.f, 0.f); er = h ? er : tr; ei = h ? ei : ti; }
                er += __shfl_xor(er, 32); ei += __shfl_xor(ei, 32);
                cmadd(sre[k], sim[k], a32r[k], a32i[k], er, ei);
            }
        }
        __syncthreads();
        if (h == 0) {
#pragma unroll
            for (int k = 0; k < 2; ++k) { Es[(wave * 64 + 32 * k + l31) * 2] = sre[k]; Es[(wave * 64 + 32 * k + l31) * 2 + 1] = sim[k]; }
        }
        __syncthreads();
        float xre[2] = {0.f, 0.f}, xim[2] = {0.f, 0.f};
        for (int w2 = 0; w2 < wave; ++w2) {
#pragma unroll
            for (int k = 0; k < 2; ++k) cmadd(xre[k], xim[k], a256r[k], a256i[k], Es[(w2 * 64 + 32 * k + l31) * 2], Es[(w2 * 64 + 32 * k + l31) * 2 + 1]);
        }
#pragma unroll 1
        for (int c0 = 0; c0 < 256; c0 += 32) {
            const bf16x8_t uf = ufn;
            ufn = *(const bf16x8_t*)(ub + (size_t)(((c0 + 32) & 255) + l31) * P0W);
            wave_lds_fence();
            *(bf16x8_t*)(Xs + l31 * 336 + 256 + 16 * h) = uf;
#pragma unroll
            for (int k = 0; k < 2; ++k) {
                f32x16 z;
#pragma unroll
                for (int i = 0; i < 16; ++i) z[i] = 0.f;
                const f32x16 bur = MFMA32(uf, Bre[k], z), bui = MFMA32(uf, Bim[k], z);
                float cr = xre[k], ci = xim[k];
#pragma unroll
                for (int q = 0; q < 4; ++q) {
                    float ar_[4], ai_[4], br_[4], bi_[4];
                    float xr_ = cr, xi_ = ci;
#pragma unroll
                    for (int r2 = 0; r2 < 4; ++r2) { cmadd(xr_, xi_, are[k], aim[k], bur[4 * q + r2], bui[4 * q + r2]); ar_[r2] = xr_; ai_[r2] = xi_; }
                    float yr_ = __shfl_xor(xr_, 32), yi_ = __shfl_xor(xi_, 32);
#pragma unroll
                    for (int r2 = 0; r2 < 4; ++r2) { cmadd(yr_, yi_, are[k], aim[k], bur[4 * q + r2], bui[4 * q + r2]); br_[r2] = yr_; bi_[r2] = yi_; }
                    const float zr_ = __shfl_xor(yr_, 32), zi_ = __shfl_xor(yi_, 32);
                    cr = h ? yr_ : zr_; ci = h ? yi_ : zi_;
#pragma unroll
                    for (int r2 = 0; r2 < 4; ++r2) {
                        const int t = 8 * q + 4 * h + r2;
                        *(bf16_t*)(Xs + t * 336 + (32 * k + l31) * 2) = f2bf(h ? br_[r2] : ar_[r2]);
                        *(bf16_t*)(Xs + t * 336 + (64 + 32 * k + l31) * 2) = f2bf(h ? bi_[r2] : ai_[r2]);
                    }
                }
                xre[k] = cr; xim[k] = ci;
            }
            wave_lds_fence();
#pragma unroll
            for (int mt = 0; mt < 2; ++mt) {
                f32x4 y = {0.f, 0.f, 0.f, 0.f};
#pragma unroll
                for (int ks = 0; ks < 5; ++ks) {
                    const bf16x8_t a = *(const bf16x8_t*)(Xs + (16 * mt + fr) * 336 + (32 * ks + 8 * fq) * 2);
                    y = __builtin_amdgcn_mfma_f32_16x16x32_bf16(a, Cm[ks], y, 0, 0, 0);
                }
#pragma unroll
                for (int reg = 0; reg < 4; ++reg)
                    ya[((size_t)(b * 16 + g) * NL + 256 * wave + c0 + 16 * mt + 4 * fq + reg) * 16 + fr] = f2bf(gelu_fast(y[reg]));
            }
        }
    }
    __syncthreads();
}

struct Params {
    const float* in[29];
    float* out;
    char* ws;
    unsigned long long pad;
};

constexpr size_t SZ_PROJ = (size_t)NT * EVEN_IN * 2;
constexpr size_t SZ_VT = (size_t)768 * NT * 2;
constexpr size_t SZ_YB = (size_t)NT * ND * 2;
constexpr size_t SZ_HB = (size_t)NT * ND * 2;
constexpr size_t SZ_YA = (size_t)NT * 256 * 2;
constexpr size_t SZ_CMP = (size_t)NB * 4 * 128 * 64 * 2;
constexpr size_t SZ_SEL = (size_t)NB * 4 * NL * 4;
constexpr size_t SZ_TAB = (size_t)16384 * ND;
constexpr size_t SZ_SKB = (size_t)2 * 8 * 2 * 128 * 128 * 2;
constexpr size_t OFF_VT = SZ_PROJ, OFF_YB = OFF_VT + SZ_VT, OFF_HB = OFF_YB + SZ_YB, OFF_YA = OFF_HB + SZ_HB, OFF_KC = OFF_YA + SZ_YA, OFF_VC = OFF_KC + SZ_CMP,
                 OFF_SEL = OFF_VC + SZ_CMP, OFF_TAB = OFF_SEL + SZ_SEL, OFF_SKB = OFF_TAB + 2 * SZ_TAB, OFF_WT = OFF_SKB + SZ_SKB;
constexpr size_t WT_IN0 = 0, WT_OUT0 = WT_IN0 + (size_t)EVEN_IN * ND * 2, WT_Q0 = WT_OUT0 + (size_t)ND * ND * 2, WT_Q1 = WT_Q0 + (size_t)2048 * ND * 2,
                 WT_IN1 = WT_Q1 + (size_t)2048 * ND * 2, WT_V1 = WT_IN1 + (size_t)ODD_PAD * ND * 2, WT_OUT1 = WT_V1 + (size_t)512 * ND * 2, WT_W1 = WT_OUT1 + (size_t)ND * ND * 2, WT_W2 = WT_W1 + (size_t)2 * 128 * 2048 * 2, WT_B1 = WT_W2 + (size_t)2 * 64 * 128 * 2, WT_V0 = WT_B1 + 2 * 128 * 4, WT_GLU = WT_V0 + (size_t)768 * ND * 2, WT_END = WT_GLU + (size_t)256 * 256 * 2;
constexpr size_t OFF_PART = OFF_WT + ((WT_END + 255) & ~(size_t)255);
constexpr size_t OFF_CQ = OFF_PART + (size_t)NT * 32 * 4;
constexpr size_t OFF_SU = OFF_CQ + 4 * 2048 * 4;
constexpr size_t OFF_BAR = OFF_SU + 16384 * 4;
constexpr size_t WS_NEED = OFF_BAR + XB_TOTAL_WORDS * 4 + 256;

__device__ __forceinline__ void convert_tables(const float* __restrict__ u, const float* __restrict__ v, unsigned char* __restrict__ TAB, float* __restrict__ SU) {
    {
        const int wave = tidx() >> 6, lane = tidx() & 63;
        for (int r0 = blockIdx.x * 32 + wave * 4; r0 < 16384; r0 += gridDim.x * 32) {
            f32x4 a[4][4];
#pragma unroll
            for (int rr = 0; rr < 4; ++rr)
#pragma unroll
                for (int q = 0; q < 4; ++q) a[rr][q] = __builtin_nontemporal_load((const f32x4*)(u + (size_t)(r0 + rr) * ND + lane * 16 + 4 * q));
#pragma unroll
            for (int rr = 0; rr < 4; ++rr) {
                const int row = r0 + rr;
                float m = 0.f;
#pragma unroll
                for (int q = 0; q < 4; ++q) m = fmaxf(fmaxf(m, fmaxf(fabsf(a[rr][q].x), fabsf(a[rr][q].y))), fmaxf(fabsf(a[rr][q].z), fabsf(a[rr][q].w)));
                for (int o = 32; o; o >>= 1) m = fmaxf(m, __shfl_xor(m, o));
                const float inv = m > 0.f ? 127.f / m : 0.f;
                uint4 w; unsigned* wp = (unsigned*)&w;
#pragma unroll
                for (int q = 0; q < 4; ++q) {
                    const int b0 = (int)rintf(a[rr][q].x * inv), b1 = (int)rintf(a[rr][q].y * inv), b2 = (int)rintf(a[rr][q].z * inv), b3 = (int)rintf(a[rr][q].w * inv);
                    wp[q] = (unsigned)(b0 & 255) | ((unsigned)(b1 & 255) << 8) | ((unsigned)(b2 & 255) << 16) | ((unsigned)b3 << 24);
                }
                *(uint4*)(TAB + (size_t)row * ND + lane * 16) = w;
                if (lane == 0) SU[row] = m * (1.f / 127.f);
            }
        }
    }
    const size_t per = (size_t)16384 * ND / 16;
    const size_t vstride = (size_t)gridDim.x * NTHR;
    for (size_t i = (size_t)blockIdx.x * NTHR + tidx(); i < per; i += 2 * vstride) {
        f32x4 a[2][4];
#pragma unroll
        for (int k = 0; k < 2; ++k)
#pragma unroll
            for (int q = 0; q < 4; ++q) a[k][q] = __builtin_nontemporal_load((const f32x4*)(v + (i + k * vstride) * 16 + 4 * q));
#pragma unroll
        for (int k = 0; k < 2; ++k) {
            uint4 w; unsigned* wp = (unsigned*)&w;
#pragma unroll
            for (int q = 0; q < 4; ++q) {
                int pk = __builtin_amdgcn_cvt_pk_fp8_f32(a[k][q].x * V_SCALE, a[k][q].y * V_SCALE, 0, false);
                pk = __builtin_amdgcn_cvt_pk_fp8_f32(a[k][q].z * V_SCALE, a[k][q].w * V_SCALE, pk, true);
                wp[q] = (unsigned)pk;
            }
            *(uint4*)(TAB + (size_t)16384 * ND + (i + k * vstride) * 16) = w;
        }
    }
}

__device__ __forceinline__ char* wsb(const Params& p) { char* w = p.ws; asm volatile("" : "+s"(w)); return w; }
#define PROJ ((bf16_t*)wsb(p))
#define YB ((bf16_t*)(wsb(p) + OFF_YB))
#define HB ((bf16_t*)(wsb(p) + OFF_HB))
#define YA ((bf16_t*)(wsb(p) + OFF_YA))
#define WGT ((bf16_t*)(wsb(p) + OFF_WT + WT_GLU))
#define KCMP ((bf16_t*)(wsb(p) + OFF_KC))
#define VCMP ((bf16_t*)(wsb(p) + OFF_VC))
#define W1T ((bf16_t*)(wsb(p) + OFF_WT + WT_W1))
#define W2T ((bf16_t*)(wsb(p) + OFF_WT + WT_W2))
#define BIAS1 ((float*)(wsb(p) + OFF_WT + WT_B1))
#define SEL ((unsigned*)(wsb(p) + OFF_SEL))
#define WIN0 ((bf16_t*)(wsb(p) + OFF_WT + WT_IN0))
#define WOUT0 ((bf16_t*)(wsb(p) + OFF_WT + WT_OUT0))
#define WQ0 ((bf16_t*)(wsb(p) + OFF_WT + WT_Q0))
#define WQ1 ((bf16_t*)(wsb(p) + OFF_WT + WT_Q1))
#define WIN1 ((bf16_t*)(wsb(p) + OFF_WT + WT_IN1))
#define WOUT1 ((bf16_t*)(wsb(p) + OFF_WT + WT_OUT1))
#define WV1 ((bf16_t*)(wsb(p) + OFF_WT + WT_V1))
#define VT ((bf16_t*)(wsb(p) + OFF_VT))
#define WV0 ((bf16_t*)(wsb(p) + OFF_WT + WT_V0))
#define EIDX ((int*)YB)
#define EGATE ((float*)((char*)YB + (size_t)NT * 128 * 4))
#define TAB ((unsigned char*)(wsb(p) + OFF_TAB))
#define SKB ((bf16_t*)(wsb(p) + OFF_SKB))
__global__ void __launch_bounds__(NTHR) fwd_megakernel(Params p) {
    extern __shared__ __attribute__((aligned(16))) unsigned char lds_raw[];
    float* lds = (float*)lds_raw;
    cg::grid_group grid = cg::this_grid();
    const float* x = p.in[0];
    float* R = p.out;
    char* ws = wsb(p);
    const int wave = tidx() >> 6;
    if (tidx() == 0) *(uint4*)(lds_raw + LDS_BYTES - 16) = make_uint4(0u, 0u, 0u, 0u);
    __syncthreads();
    XcdBarrier xbar = xcd_barrier_post((unsigned*)(ws + OFF_BAR), (volatile LAS unsigned*)(lds_raw + LDS_BYTES - 16));

    {
        const size_t nvec = (size_t)NT * ND / 4, stride = (size_t)gridDim.x * NTHR;
        for (size_t i = (size_t)blockIdx.x * NTHR + tidx(); i < nvec; i += 8 * stride) {
            f32x4 v[8];
#pragma unroll
            for (int k = 0; k < 8; ++k) v[k] = __builtin_nontemporal_load((const f32x4*)x + i + k * stride);
#pragma unroll
            for (int k = 0; k < 8; ++k) { uint2 w; w.x = pack2(v[k][0], v[k][1]); w.y = pack2(v[k][2], v[k][3]); ((uint2*)HB)[i + k * stride] = w; }
        }
    }
    convert_tables(p.in[23], p.in[24], TAB, (float*)(ws + OFF_SU));
    for (int i = blockIdx.x * NTHR + tidx(); i < 2 * 8 * 2 * 128 * 128 / 4; i += gridDim.x * NTHR) {
        const float4 a = ((const float4*)p.in[22])[i];
        uint2 w; w.x = pack2(a.x, a.y); w.y = pack2(a.z, a.w);
        ((uint2*)SKB)[i] = w;
    }
    convert_wt_phase(p.in[1], ND, EVEN_IN, P0W, ColMap{{0, 0, 0}, {0, 0, 0}, {P0W, 0, 0}}, WIN0, lds);
    convert_wt_phase(p.in[1], ND, EVEN_IN, 768, ColMap{{0, 0, 0}, {P0W, 0, 0}, {768, 0, 0}}, WV0, lds);
    convert_wt_phase(p.in[12], ND, ND, ND, ColMap{{0, 0, 0}, {0, 0, 0}, {ND, 0, 0}}, WOUT0, lds);
    convert_wt_phase(p.in[10], 256, 256, 256, ColMap{{0, 0, 0}, {0, 0, 0}, {256, 0, 0}}, WGT, lds);
    convert_wt_phase(p.in[21], ND, 2048, 2048, ColMap{{0, 0, 0}, {0, 0, 0}, {2048, 0, 0}}, WQ0, lds, p.in[25]);
    convert_wt_phase(p.in[21] + (size_t)ND * 2048, ND, 2048, 2048, ColMap{{0, 0, 0}, {0, 0, 0}, {2048, 0, 0}}, WQ1, lds, p.in[25] + ND);
    {
        float* CQ = (float*)(ws + OFF_CQ);
        const int kp = tidx() >> 5, cl32 = tidx() & 31, gcol = blockIdx.x * 32 + cl32;
        if (blockIdx.x < 128) {
            const int layer = gcol >> 11, n = gcol & 2047;
            const float* W = p.in[21] + (size_t)layer * ND * 2048;
            const float* gam = p.in[25] + layer * ND; const float* bet = p.in[26] + layer * ND;
            float c = 0.f, d = 0.f;
            for (int k = kp; k < ND; k += 16) { const float w = W[(size_t)k * 2048 + n]; c += bf2f(f2bf(gam[k] * w)); d += bet[k] * w; }
            c += __shfl_xor(c, 32); d += __shfl_xor(d, 32);
            __syncthreads();
            if ((tidx() & 63) < 32) { lds[(tidx() >> 6) * 64 + cl32] = c; lds[(tidx() >> 6) * 64 + 32 + cl32] = d; }
            __syncthreads();
            if (tidx() < 32) {
                float cs = 0.f, ds = 0.f;
#pragma unroll
                for (int w8 = 0; w8 < 8; ++w8) { cs += lds[w8 * 64 + tidx()]; ds += lds[w8 * 64 + 32 + tidx()]; }
                CQ[layer * 2048 + n] = cs; CQ[4096 + layer * 2048 + n] = ds;
            }
            __syncthreads();
        }
    }
    convert_wt_phase(p.in[13], ND, ODD_IN, ODD_PAD, ColMap{{0, 1792, 2048}, {0, 2048, 2560}, {1792, 256, 48}}, WIN1, lds);
    convert_wt_phase(p.in[13], ND, ODD_IN, 512, ColMap{{0, 256, 0}, {1792, 2304, 0}, {256, 256, 0}}, WV1, lds);
    convert_wt_phase(p.in[20], ND, ND, ND, ColMap{{0, 0, 0}, {0, 0, 0}, {ND, 0, 0}}, WOUT1, lds);
    convert_wt_phase(p.in[15], 2048, 128, 128, ColMap{{0, 0, 0}, {0, 0, 0}, {128, 0, 0}}, W1T, lds);
    convert_wt_phase(p.in[18], 2048, 128, 128, ColMap{{0, 0, 0}, {0, 0, 0}, {128, 0, 0}}, W1T + 128 * 2048, lds);
    convert_wt_phase(p.in[16], 128, 64, 64, ColMap{{0, 0, 0}, {0, 0, 0}, {64, 0, 0}}, W2T, lds);
    convert_wt_phase(p.in[19], 128, 64, 64, ColMap{{0, 0, 0}, {0, 0, 0}, {64, 0, 0}}, W2T + 64 * 128, lds);
    if (blockIdx.x < 8) {
        const int which = blockIdx.x >> 2, j = (blockIdx.x & 3) * 32 + (tidx() >> 4), part = tidx() & 15;
        const float* pe = which ? p.in[17] : p.in[14];
        const float* w1 = which ? p.in[18] : p.in[15];
        float a = 0.f;
#pragma unroll 8
        for (int i = part; i < 2048; i += 16) a += pe[i] * w1[(size_t)i * 128 + j];
        for (int o = 8; o; o >>= 1) a += __shfl_xor(a, o);
        if (part == 0) BIAS1[which * 128 + j] = a;
    }
    xcd_barrier(xbar);
    if (p.pad == 0x5eedull) grid.sync();
    PDUP(0) { PH(0) gemm_bf16_phase(lds_raw, HB, WIN0, NT, P0W, ND, EpiBf16s{PROJ, P0W});
    PH(0) gemm_bf16_phase(lds_raw, WV0, HB, 768, NT, ND, EpiBf16s{VT, NT}, true); }
    xcd_barrier(xbar);
    PDUP(1) { PH(1) s5_scan3_phase(PROJ, p.in[2], p.in[3], p.in[4], p.in[5], p.in[6], p.in[7], p.in[8], p.in[9], YA, lds_raw);
    PH(2) sb_attn2_phase(PROJ, VT, YB, lds_raw);
    if ((PROBE >> 13) & 1) {
        bf16_t* SCR = PROJ + (size_t)NT * P0W;
        s5_scan2_phase(PROJ, p.in[2], p.in[3], p.in[4], p.in[5], p.in[6], p.in[7], p.in[8], p.in[9], SCR, lds);
        xcd_barrier(xbar);
        float d2 = 0.f, n2 = 0.f;
        for (size_t i = (size_t)blockIdx.x * NTHR + tidx(); i < (size_t)NT * 256; i += (size_t)gridDim.x * NTHR) { const float a = bf2f(YA[i]), r = bf2f(SCR[i]); d2 += (a - r) * (a - r); n2 += r * r; }
        for (int o = 32; o; o >>= 1) { d2 += __shfl_xor(d2, o); n2 += __shfl_xor(n2, o); }
        float* chk = (float*)(ws + OFF_BAR + XB_TOTAL_WORDS * 4);
        if ((tidx() & 63) == 0) { atomicAdd(chk, d2); atomicAdd(chk + 1, n2); }
    }
    if (_rep == 0 && ((PROBE >> 1) & 1)) xcd_barrier(xbar); }
    xcd_barrier(xbar);
    PDUP(2) PH(3) glu2_phase(YA, WGT, p.in[11], YB, lds_raw);
    xcd_barrier(xbar);
    PH(4) gemm_bf16_phase(lds_raw, YB, WOUT0, NT, ND, ND, EpiResStats<false>{x, HB, (float*)(ws + OFF_PART)});
    xcd_barrier(xbar);
#define PEER_FFN(layer, WQ, last) \
    PH(12) gemm_q_phase(lds_raw, HB, WQ, (const float*)(ws + OFF_PART), (const float*)(ws + OFF_CQ) + (layer) * 2048, (const float*)(ws + OFF_CQ) + 4096 + (layer) * 2048, PROJ); \
    xcd_barrier(xbar); \
    PDUP(4) PH(13) peer_route2_phase(PROJ, SKB + (size_t)(layer) * 8 * 2 * 128 * 128, EIDX, EGATE, lds_raw); \
    xcd_barrier(xbar); \
    if ((PROBE >> 5) & 1) { peer_expert3_phase(R, EIDX, EGATE, TAB, TAB + (size_t)16384 * ND, p.in[27] + (layer) * ND, p.in[28] + (layer) * ND, nullptr, (float*)PROJ, xbar); xcd_barrier(xbar); } \
    PH(14) peer_expert10_phase((last) ? R : nullptr, HB, EIDX, EGATE, TAB, TAB + (size_t)16384 * ND, p.in[27] + (layer) * ND, p.in[28] + (layer) * ND, (last) ? nullptr : HB, xbar, lds, p.in[25] + (layer) * ND, p.in[26] + (layer) * ND, (const float*)(ws + OFF_SU)); \
    if (!(last)) xcd_barrier(xbar);
    PEER_FFN(0, WQ0, false)
    convert_tables(p.in[23] + (size_t)16384 * ND, p.in[24] + (size_t)16384 * ND, TAB, (float*)(ws + OFF_SU));
    PDUP(0) { PH(6) gemm_bf16_phase(lds_raw, HB, WIN1, NT, ODD_PAD, ND, EpiBf16s{PROJ, ODD_PAD});
    PH(6) gemm_bf16_phase(lds_raw, WV1, HB, 512, NT, ND, EpiBf16s{VT, NT}); }
    xcd_barrier(xbar);
    PDUP(6) PH(7) nsa_compress2_phase(PROJ, W1T, W2T, BIAS1, KCMP, VCMP, lds_raw);
    xcd_barrier(xbar);
    PDUP(7) { PH(8) nsa_fused_phase(PROJ, KCMP, VCMP, VT, YB, lds_raw); }
    xcd_barrier(xbar);
    PH(10) gemm_bf16_phase(lds_raw, YB, WOUT1, NT, ND, ND, EpiResStats<true>{HB, HB, (float*)(ws + OFF_PART)});
    xcd_barrier(xbar);
    PEER_FFN(1, WQ1, true)
    if ((PROBE >> 13) & 1) {
        xcd_barrier(xbar);
        const float* chk = (const float*)(ws + OFF_BAR + XB_TOTAL_WORDS * 4);
        const float d2 = __hip_atomic_load(chk, __ATOMIC_RELAXED, __HIP_MEMORY_SCOPE_AGENT), n2 = __hip_atomic_load(chk + 1, __ATOMIC_RELAXED, __HIP_MEMORY_SCOPE_AGENT);
        if (!(d2 <= 1e-4f * n2)) for (size_t i = (size_t)blockIdx.x * NTHR + tidx(); i < (size_t)NT * ND; i += (size_t)gridDim.x * NTHR) R[i] *= 2.f;
    }
}

}

extern "C" void kernel_launch(void* const* d_in, const int* in_sizes, int n_in, void* d_out, int out_size, void* d_ws, size_t ws_size, hipStream_t stream) {
    static int grid_blocks = 0;
    if (grid_blocks == 0) {
        if (n_in != 29 || out_size != NT * ND || ws_size < WS_NEED) { fprintf(stderr, "kernel_launch: unexpected shapes / workspace (%zu < %zu)\n", ws_size, (size_t)WS_NEED); grid_blocks = -1; return; }
        int dev = 0, cus = 0, per_cu = 0;
        hipGetDevice(&dev);
        hipDeviceGetAttribute(&cus, hipDeviceAttributeMultiprocessorCount, dev);
        hipFuncSetAttribute((const void*)fwd_megakernel, hipFuncAttributeMaxDynamicSharedMemorySize, LDS_BYTES);
        hipOccupancyMaxActiveBlocksPerMultiprocessor(&per_cu, (const void*)fwd_megakernel, NTHR, LDS_BYTES);
        if (per_cu < 1) { fprintf(stderr, "kernel_launch: occupancy query says %d blocks/CU\n", per_cu); grid_blocks = -1; return; }
        grid_blocks = cus;
    }
    if (grid_blocks < 0) return;
    hipMemsetAsync((char*)d_ws + OFF_BAR, 0, XB_TOTAL_WORDS * 4 + 256, stream);
    Params p{};
    for (int i = 0; i < 29; ++i) p.in[i] = (const float*)d_in[i];
    p.out = (float*)d_out; p.ws = (char*)d_ws; p.pad = 0;
    void* args[] = {&p};
    hipError_t e = hipLaunchCooperativeKernel((const void*)fwd_megakernel, dim3(grid_blocks), dim3(NTHR), args, LDS_BYTES, stream);
    if (e != hipSuccess) fprintf(stderr, "cooperative launch failed: %s (grid %d)\n", hipGetErrorString(e), grid_blocks);
}
```

```cpp
#include <hip/hip_runtime.h>
#include <hip/hip_cooperative_groups.h>
#include <math.h>
#include <stdint.h>
#include <cstdio>
#include <type_traits>
namespace cg = cooperative_groups;

__device__ __forceinline__ int tidx() { int t = threadIdx.x; asm volatile("" : "+v"(t)); return t; }
#define XB_TMO      128
#define XB_XCNT(j)  (256  + 64 * (j))
#define XB_XSUB(j)  (1280 + 64 * (j))
#define XB_XGEN(j)  (2304 + 64 * (j))
#define XB_TOP      3328
#define XB_TOPGEN   3392
#define XCD_BAR_WORDS 3456
#define XB_SPIN_CAP (1u << 18)
#define LAS __attribute__((address_space(3)))

__device__ __forceinline__ unsigned xb_ld(unsigned* p)              { return __hip_atomic_load(p, __ATOMIC_RELAXED, __HIP_MEMORY_SCOPE_AGENT); }
__device__ __forceinline__ unsigned xb_add(unsigned* p, unsigned v) { return __hip_atomic_fetch_add(p, v, __ATOMIC_RELAXED, __HIP_MEMORY_SCOPE_AGENT); }
__device__ __forceinline__ unsigned xb_xcc_id() { return (unsigned)__builtin_amdgcn_s_getreg((3 << 11) | 20) & 0xFu; }
#define XB_SPIN(cond, bar) do { unsigned _sp = 0; while (cond) { __builtin_amdgcn_s_sleep(1); \
    if ((++_sp & 255u) == 0u) { if (xb_ld(&(bar)[XB_TMO])) break; if (_sp > XB_SPIN_CAP) { atomicAdd(&(bar)[XB_TMO], 1u); break; } } } } while (0)

struct XcdBarrier {
    unsigned* bar; unsigned x;
    volatile LAS unsigned* st;
};

__device__ __forceinline__ XcdBarrier xcd_barrier_post(unsigned* bar, volatile LAS unsigned* st) {
    XcdBarrier b; b.bar = bar; b.x = xb_xcc_id(); b.st = st;
    if (tidx() == 0) (void)xb_add(&bar[XB_XCNT(b.x)], 1u);
    return b;
}
__device__ __forceinline__ void xcd_barrier_complete(unsigned* bar, unsigned x, unsigned& nloc, unsigned& nx) {
    const unsigned G = gridDim.x * gridDim.y * gridDim.z;
    unsigned sum, cnt, mine, sp = 0u;
    for (;;) {
        sum = 0u; cnt = 0u; mine = 0u;
#pragma unroll
        for (unsigned j = 0; j < 16; ++j) { const unsigned c = xb_ld(&bar[XB_XCNT(j)]); sum += c; cnt += (c > 0u) ? 1u : 0u; mine = (j == x) ? c : mine; }
        if (sum == G) break;
        __builtin_amdgcn_s_sleep(1);
        if ((++sp & 255u) == 0u) { if (xb_ld(&bar[XB_TMO])) break; if (sp > XB_SPIN_CAP) { atomicAdd(&bar[XB_TMO], 1u); break; } }
    }
    nloc = mine > 0u ? mine : 1u; nx = cnt > 0u ? cnt : 1u;
}

__device__ __forceinline__ void xcd_barrier(const XcdBarrier& b) {
    asm volatile("s_waitcnt vmcnt(0)" ::: "memory");
    __syncthreads();
    if (tidx() == 0) {
        unsigned* bar = b.bar;
        __builtin_amdgcn_s_waitcnt(0);
        unsigned nloc = b.st[0], nx = b.st[1];
        if (nloc == 0u) { xcd_barrier_complete(bar, b.x, nloc, nx); b.st[0] = nloc; b.st[1] = nx; }
        const unsigned old = xb_add(&bar[XB_XSUB(b.x)], 1u);
        const unsigned gen = old / nloc;
        if (old + 1u == (gen + 1u) * nloc) {
            __builtin_amdgcn_fence(__ATOMIC_RELEASE, "");
            asm volatile("s_waitcnt vmcnt(0)" ::: "memory");
            const unsigned og = xb_add(&bar[XB_TOP], 1u);
            const unsigned tg = og / nx;
            if (og + 1u == (tg + 1u) * nx) xb_add(&bar[XB_TOPGEN], 1u);
            else XB_SPIN(xb_ld(&bar[XB_TOPGEN]) == tg, bar);
            __builtin_amdgcn_fence(__ATOMIC_ACQUIRE, "");
            xb_add(&bar[XB_XGEN(b.x)], 1u);
            asm volatile("s_waitcnt vmcnt(0)" ::: "memory");
        } else {
            XB_SPIN(xb_ld(&bar[XB_XGEN(b.x)]) == gen, bar);
            __builtin_amdgcn_fence(__ATOMIC_ACQUIRE, "");
            asm volatile("s_waitcnt vmcnt(0)" ::: "memory");
        }
    }
    __syncthreads();
}

#define XB_ALIGN(j) (XCD_BAR_WORDS + 64 * (j))
#define XB_TOTAL_WORDS (XCD_BAR_WORDS + 64 * 16)
__device__ __forceinline__ void xcc_align(const XcdBarrier& b) {
    __syncthreads();
    if (tidx() == 0) {
        const unsigned nloc = b.st[0];
        if (nloc) {
            const unsigned old = xb_add(&b.bar[XB_ALIGN(b.x)], 1u), gen = old / nloc;
            unsigned sp = 0;
            while (xb_ld(&b.bar[XB_ALIGN(b.x)]) < (gen + 1u) * nloc && ++sp < (1u << 16)) __builtin_amdgcn_s_sleep(1);
        }
    }
    __syncthreads();
}
namespace pg8 {
#define PG8_LAS __attribute__((address_space(3)))
typedef unsigned short bf16_t;
typedef short bf16x8 __attribute__((ext_vector_type(8)));
typedef float f32x4 __attribute__((ext_vector_type(4)));
typedef unsigned u32x4 __attribute__((ext_vector_type(4)));
constexpr int BM = 256, BK = 64, HALF = 128, HTB = HALF * BK * 2  , STAGE_BYTES = 8 * HTB, NXCD = 8, WGM = 8;

__host__ __device__ __forceinline__ int lds_byte(int r, int c) { const int st = (r >> 4) * 2 + (c >> 5), rr = r & 15, cc = c & 31, ob = rr * 64 + cc * 2; return st * 1024 + (ob ^ (((ob >> 9) & 1) << 5)); }
__host__ __device__ __forceinline__ void stage_rc(int b, int& R, int& C) { const int st = b / 1024, sb = b % 1024, swz = sb ^ (((sb >> 9) & 1) << 5); R = (st >> 1) * 16 + swz / 64; C = (st & 1) * 32 + (swz % 64) / 2; }
__host__ __device__ __forceinline__ int perm32(int rho) { const int n = rho >> 4, i = rho & 15; return 8 * (i >> 2) + 4 * n + (i & 3); }

struct Unit { int pm, pn; };
struct Gemm { const bf16_t* A; const bf16_t* Bt; int M, N, K; };

struct StaticOrder {
    int nM, nN, nwg, G, c;
    __host__ __device__ void init(int M, int N, int G_, int c_) { nM = M / BM; nN = N / BM; nwg = nM * nN; G = G_; c = c_; }
    __host__ __device__ bool next(int i, Unit& u) const {
        const long L = (long)i * G + c; if (L >= nwg) return false;
        int wgid = (int)L; { const int q = nwg / NXCD, r = nwg % NXCD, xcd = wgid % NXCD, off = wgid / NXCD; wgid = (xcd < r ? xcd * (q + 1) : r * (q + 1) + (xcd - r) * q) + off; }
        const int nig = WGM * nN, gid = wgid / nig, fm = gid * WGM, gsz = (nM - fm) < WGM ? (nM - fm) : WGM;
        u.pm = fm + ((wgid % nig) % gsz); u.pn = (wgid % nig) / gsz; return true;
    }
    __device__ __forceinline__ void a_ready(const Unit&) const {}
    __device__ __forceinline__ void done(const Unit&) const {}
};
__device__ __forceinline__ unsigned cvt_pk_bf16(float lo, float hi) { unsigned r; asm volatile("v_cvt_pk_bf16_f32 %0, %1, %2" : "=v"(r) : "v"(lo), "v"(hi)); return r; }
template <class Epi, class Sched, bool STAMP = false>
__device__ __forceinline__ void gemm_phase(PG8_LAS unsigned char* lds, const Gemm g, const Sched& S, const Epi& E, unsigned long long* stamps) {
    const int tid = tidx(), wid = __builtin_amdgcn_readfirstlane(tid >> 6), lane = tid & 63, wr = wid >> 2, wc = wid & 3, fr = lane & 15, fq = lane >> 4;
    const int K = g.K, nt = K / BK;
    int ts_lo = 0, ts_hi = 0, nts = 0; const unsigned long long rt_entry = STAMP ? (unsigned long long)wall_clock64() : 0ull;
#define PG8_STAMP() do { if (STAMP && wid == 0 && nts < 64) { const unsigned long long _c = (unsigned long long)clock64(); \
        ts_lo = (lane == nts) ? (int)(unsigned)_c : ts_lo; ts_hi = (lane == nts) ? (int)(unsigned)(_c >> 32) : ts_hi; ++nts; } } while (0)
    PG8_STAMP();
    unsigned voffA[2], voffB[2];
#pragma unroll
    for (int i = 0; i < 2; ++i) { int R, C; stage_rc(tid * 16 + i * 8192, R, C); const int Rb = Epi::PERM ? ((R & ~31) + perm32(R & 31)) : R;
        voffA[i] = (unsigned)(R * K + C) * 2u; voffB[i] = (unsigned)(Rb * K + C) * 2u; }
    const size_t kstep = (size_t)(BK * 2);
    const size_t hstep = (size_t)HALF * K * 2;
    const size_t tstep = 2 * hstep;
    const unsigned ldsw = (unsigned)wid * 1024u;
    const int aoff = lds_byte(wr * 64 + fr, fq * 8), boff = lds_byte(wc * 32 + fr, fq * 8);
#define PG8_SA(b, h) (((b) * 2 + (h)) * HTB)
#define PG8_SB(b, h) ((4 + (b) * 2 + (h)) * HTB)
#define PG8_STAGE(bufoff, gbase, voff) do { _Pragma("unroll") for (int _i = 0; _i < 2; ++_i) \
        __builtin_amdgcn_global_load_lds((const unsigned*)((const char*)(gbase) + (voff)[_i]), (PG8_LAS unsigned*)(lds + (bufoff) + ldsw + _i * 8192), 16, 0, 0); } while (0)
#define PG8_LDA(dst, b, h) do { _Pragma("unroll") for (int m = 0; m < 4; ++m) _Pragma("unroll") for (int k = 0; k < 2; ++k) dst[m][k] = *(const PG8_LAS bf16x8*)(lds + PG8_SA(b, h) + aoff + m * 2048 + k * 1024); } while (0)
#define PG8_LDB(dst, b, h) do { _Pragma("unroll") for (int n = 0; n < 2; ++n) _Pragma("unroll") for (int k = 0; k < 2; ++k) dst[n][k] = *(const PG8_LAS bf16x8*)(lds + PG8_SB(b, h) + boff + n * 2048 + k * 1024); } while (0)
#define PG8_MMA(ai, bj, At, Bt) do { __builtin_amdgcn_s_setprio(1); _Pragma("unroll") for (int m = 0; m < 4; ++m) _Pragma("unroll") for (int n = 0; n < 2; ++n) _Pragma("unroll") for (int k = 0; k < 2; ++k) \
        acc[ai][bj][m][n] = __builtin_amdgcn_mfma_f32_16x16x32_bf16(Bt[n][k], At[m][k], acc[ai][bj][m][n], 0, 0, 0); __builtin_amdgcn_s_setprio(0); } while (0)
#define PG8_WAIT_V(n) asm volatile("s_waitcnt vmcnt(" #n ")" ::: "memory")
#define PG8_WAIT_L(n) asm volatile("s_waitcnt lgkmcnt(" #n ")" ::: "memory")
#define PG8_BAR __builtin_amdgcn_s_barrier()
#define PG8_SCHED __builtin_amdgcn_sched_barrier(0)
    Unit cur, nxt; int ui = 0;
    if (!S.next(0, cur)) return;
    f32x4 acc[2][2][4][2];
#pragma unroll
    for (int a = 0; a < 2; ++a)
#pragma unroll
        for (int b = 0; b < 2; ++b)
#pragma unroll
            for (int m = 0; m < 4; ++m)
#pragma unroll
                for (int n = 0; n < 2; ++n) acc[a][b][m][n] = (f32x4){0.f, 0.f, 0.f, 0.f};
    bf16x8 At[4][2], B0[2][2], B1[2][2];
    const char* cA = (const char*)g.A + (size_t)cur.pm * tstep; const char* cB = (const char*)g.Bt + (size_t)cur.pn * tstep;
    S.a_ready(cur);
    PG8_STAGE(PG8_SB(0, 0), cB, voffB); PG8_STAGE(PG8_SA(0, 0), cA, voffA); PG8_STAGE(PG8_SB(0, 1), cB + hstep, voffB); PG8_STAGE(PG8_SA(0, 1), cA + hstep, voffA);
    if (wr == 1) PG8_BAR;
    PG8_WAIT_V(4); PG8_BAR;
    PG8_STAGE(PG8_SB(1, 0), cB + kstep, voffB); PG8_STAGE(PG8_SA(1, 0), cA + kstep, voffA); PG8_STAGE(PG8_SB(1, 1), cB + hstep + kstep, voffB);
    PG8_WAIT_V(6); PG8_BAR;
    PG8_STAMP();
    for (;;) {
        const bool has_next = S.next(ui + 1, nxt);
        const char* nA = has_next ? (const char*)g.A + (size_t)nxt.pm * tstep : cA; const char* nB = has_next ? (const char*)g.Bt + (size_t)nxt.pn * tstep : cB;
        for (int t = 0; t < nt; t += 2) {
            const bool last = (t == nt - 2);
            const char* a1 = cA + (size_t)(t + 1) * kstep;
            const char* a2 = last ? nA : cA + (size_t)(t + 2) * kstep; const char* b2 = last ? nB : cB + (size_t)(t + 2) * kstep;
            const char* a3 = a2 + kstep; const char* b3 = b2 + kstep;
            if (last && has_next) S.a_ready(nxt);
            PG8_LDB(B0, 0, 0); PG8_SCHED; PG8_LDA(At, 0, 0); PG8_STAGE(PG8_SA(1, 1), a1 + hstep, voffA);
            PG8_WAIT_L(8); PG8_BAR; PG8_WAIT_L(0); PG8_MMA(0, 0, At, B0); PG8_BAR; PG8_SCHED;
            PG8_LDB(B1, 0, 1); PG8_STAGE(PG8_SB(0, 0), b2, voffB);
            PG8_BAR; PG8_WAIT_L(0); PG8_MMA(0, 1, At, B1); PG8_BAR;
            PG8_LDA(At, 0, 1); PG8_STAGE(PG8_SA(0, 0), a2, voffA);
            PG8_BAR; PG8_WAIT_L(0); PG8_MMA(1, 0, At, B0); PG8_BAR; PG8_SCHED;
            PG8_STAGE(PG8_SB(0, 1), b2 + hstep, voffB);
            PG8_WAIT_V(6); PG8_BAR; PG8_MMA(1, 1, At, B1); PG8_BAR;
            PG8_LDB(B0, 1, 0); PG8_SCHED; PG8_LDA(At, 1, 0); PG8_STAGE(PG8_SA(0, 1), a2 + hstep, voffA);
            PG8_WAIT_L(8); PG8_BAR; PG8_WAIT_L(0); PG8_MMA(0, 0, At, B0); PG8_BAR; PG8_SCHED;
            PG8_LDB(B1, 1, 1); PG8_STAGE(PG8_SB(1, 0), b3, voffB);
            PG8_BAR; PG8_WAIT_L(0); PG8_MMA(0, 1, At, B1); PG8_BAR;
            PG8_LDA(At, 1, 1); PG8_STAGE(PG8_SA(1, 0), a3, voffA);
            PG8_BAR; PG8_WAIT_L(0); PG8_MMA(1, 0, At, B0); PG8_BAR; PG8_SCHED;
            PG8_STAGE(PG8_SB(1, 1), b3 + hstep, voffB);
            PG8_WAIT_V(6); PG8_BAR; PG8_MMA(1, 1, At, B1); PG8_BAR;
        }
        PG8_STAMP();
        if constexpr (!Epi::AFTER_DRAIN) { E(acc, cur, wr, wc, fr, fq); S.done(cur); }
        PG8_STAMP();
        if (!has_next) break;
#pragma unroll
        for (int a = 0; a < 2; ++a)
#pragma unroll
            for (int b = 0; b < 2; ++b)
#pragma unroll
                for (int m = 0; m < 4; ++m)
#pragma unroll
                    for (int n = 0; n < 2; ++n) acc[a][b][m][n] = (f32x4){0.f, 0.f, 0.f, 0.f};
        cur = nxt; cA = nA; cB = nB; ++ui;
    }
    PG8_WAIT_V(0);
    if (wr == 0) PG8_BAR;
    PG8_BAR;
    if constexpr (Epi::AFTER_DRAIN) { E.fused(acc, cur, wr, wc, fr, fq, lds, wid, lane); S.done(cur); }
    PG8_STAMP();
    if (STAMP && wid == 0) { stamps[lane] = lane < nts ? (((unsigned long long)(unsigned)ts_hi << 32) | (unsigned)ts_lo) : 0ull;
        if (lane == 62) stamps[62] = rt_entry; if (lane == 63) stamps[63] = (unsigned long long)wall_clock64(); }
#undef PG8_STAMP
#undef PG8_SA
#undef PG8_SB
#undef PG8_STAGE
#undef PG8_LDA
#undef PG8_LDB
#undef PG8_MMA
#undef PG8_WAIT_V
#undef PG8_WAIT_L
#undef PG8_BAR
#undef PG8_SCHED
}
}

namespace {
using pg8::bf16_t;
typedef float f32x4 __attribute__((ext_vector_type(4)));
typedef unsigned u32x4 __attribute__((ext_vector_type(4)));

constexpr int NB = 16, NL = 2048, ND = 1024, NT = NB * NL;
constexpr int EVEN_IN = 2560, ODD_IN = 2608, ODD_PAD = 2304;
constexpr float ALPHA = 1.41421356237f;
constexpr float LN_EPS = 1e-5f;
constexpr float U_SCALE = 256.f, V_SCALE = 16.f;
constexpr int NTHR = 512;
constexpr int LDS_BYTES = 163840;
#ifndef PROBE
#define PROBE 0
#endif
#define PDUP(bit) for (int _rep = 0; _rep < ((PROBE >> (bit)) & 1) + 1; ++_rep)
#ifndef PHMASK
#define PHMASK 0xFFFFFFFFu
#endif
#define PH(n) if (PHMASK & (1u << (n)))

__device__ __forceinline__ float bf2f(bf16_t v) { return __uint_as_float((unsigned)v << 16); }
__device__ __forceinline__ bf16_t f2bf(float f) { unsigned u = __float_as_uint(f); u += 0x7FFFu + ((u >> 16) & 1u); return (bf16_t)(u >> 16); }
__device__ __forceinline__ unsigned pack2(float lo, float hi) { return (unsigned)f2bf(lo) | ((unsigned)f2bf(hi) << 16); }
__device__ __forceinline__ void ld8(const bf16_t* p, float* o) {
    const uint4 v = *(const uint4*)p;
    o[0] = __uint_as_float(v.x << 16); o[1] = __uint_as_float(v.x & 0xffff0000u);
    o[2] = __uint_as_float(v.y << 16); o[3] = __uint_as_float(v.y & 0xffff0000u);
    o[4] = __uint_as_float(v.z << 16); o[5] = __uint_as_float(v.z & 0xffff0000u);
    o[6] = __uint_as_float(v.w << 16); o[7] = __uint_as_float(v.w & 0xffff0000u);
}
__device__ __forceinline__ void st8(bf16_t* p, const float* o) {
    uint4 v; v.x = pack2(o[0], o[1]); v.y = pack2(o[2], o[3]); v.z = pack2(o[4], o[5]); v.w = pack2(o[6], o[7]);
    *(uint4*)p = v;
}

struct EpiBf16s {
    static constexpr bool PERM = true, AFTER_DRAIN = false;
    bf16_t* O; int ldc;
    __device__ __forceinline__ void operator()(const f32x4 (&acc)[2][2][4][2], const pg8::Unit& u, int wr, int wc, int fr, int fq) const {
        const int row0 = u.pm * 256 + wr * 64 + fr, col0 = u.pn * 256 + wc * 32 + 8 * fq;
#pragma unroll
        for (int ai = 0; ai < 2; ++ai)
#pragma unroll
            for (int m = 0; m < 4; ++m) { bf16_t* rowp = O + (size_t)(row0 + ai * 128 + m * 16) * ldc + col0;
#pragma unroll
                for (int bj = 0; bj < 2; ++bj) { const f32x4 v0 = acc[ai][bj][m][0], v1 = acc[ai][bj][m][1];
                    u32x4 w; w.x = pg8::cvt_pk_bf16(v0[0], v0[1]); w.y = pg8::cvt_pk_bf16(v0[2], v0[3]); w.z = pg8::cvt_pk_bf16(v1[0], v1[1]); w.w = pg8::cvt_pk_bf16(v1[2], v1[3]);
                    *(u32x4*)(rowp + bj * 128) = w; } }
    }
};
struct EpiRes {
    static constexpr bool PERM = false, AFTER_DRAIN = false;
    float* C; int ldc; float alpha; float* Cout;
    __device__ __forceinline__ void operator()(const f32x4 (&acc)[2][2][4][2], const pg8::Unit& u, int wr, int wc, int fr, int fq) const {
        const int row0 = u.pm * 256 + wr * 64 + fr, col0 = u.pn * 256 + wc * 32 + 4 * fq; const size_t dlt = Cout - C;
#pragma unroll
        for (int ai = 0; ai < 2; ++ai)
#pragma unroll
            for (int m = 0; m < 4; ++m) { float* rowp = C + (size_t)(row0 + ai * 128 + m * 16) * ldc + col0;
#pragma unroll
                for (int bj = 0; bj < 2; ++bj)
#pragma unroll
                    for (int n = 0; n < 2; ++n) { f32x4* cp = (f32x4*)(rowp + bj * 128 + n * 16); *(cp + dlt / 4) = *cp * alpha + acc[ai][bj][m][n]; } }
    }
};

template <bool IN_BF16>
struct EpiResStats {
    static constexpr bool PERM = false, AFTER_DRAIN = false;
    typename std::conditional<IN_BF16, const bf16_t*, const float*>::type Cin; bf16_t* Vb; float* part;
    __device__ __forceinline__ void operator()(const f32x4 (&acc)[2][2][4][2], const pg8::Unit& u, int wr, int wc, int fr, int fq) const {
        const unsigned row0 = (unsigned)(u.pm * 256 + wr * 64 + fr), col0 = (unsigned)(u.pn * 256 + wc * 32 + 4 * fq);
#pragma unroll
        for (int ai = 0; ai < 2; ++ai)
#pragma unroll
            for (int m = 0; m < 4; ++m) {
                const unsigned row = row0 + (unsigned)(ai * 128 + m * 16);
                const unsigned eo = row * (unsigned)ND + col0;
                float s1 = 0.f, s2 = 0.f;
#pragma unroll
                for (int bj = 0; bj < 2; ++bj)
#pragma unroll
                    for (int n = 0; n < 2; ++n) {
                        f32x4 rin;
                        if constexpr (IN_BF16) {
                            const uint2 w = *(const uint2*)(Cin + (eo + (unsigned)(bj * 128 + n * 16)));
                            rin = (f32x4){__uint_as_float(w.x << 16), __uint_as_float(w.x & 0xffff0000u), __uint_as_float(w.y << 16), __uint_as_float(w.y & 0xffff0000u)};
                        } else rin = *(const f32x4*)(Cin + (eo + (unsigned)(bj * 128 + n * 16)));
                        const f32x4 v = rin * ALPHA + acc[ai][bj][m][n];
                        *(uint2*)(Vb + (eo + (unsigned)(bj * 128 + n * 16))) = make_uint2(pg8::cvt_pk_bf16(v[0], v[1]), pg8::cvt_pk_bf16(v[2], v[3]));
                        s1 += (v[0] + v[1]) + (v[2] + v[3]);
                        s2 += (v[0] * v[0] + v[1] * v[1]) + (v[2] * v[2] + v[3] * v[3]);
                    }
                s1 += __shfl_xor(s1, 16); s2 += __shfl_xor(s2, 16);
                s1 += __shfl_xor(s1, 32); s2 += __shfl_xor(s2, 32);
                if (fq == 0) *(float2*)(part + ((((unsigned)u.pn * (unsigned)NT + row) * 4u + (unsigned)wc) * 2u)) = make_float2(s1, s2);
            }
    }
};
struct EpiBf16LN {
    static constexpr bool PERM = true, AFTER_DRAIN = false;
    bf16_t* O; int ldc; const float* csum; const float* dvec; const float2* stats  ; int pm0, pm1, pm2, pm3;
    __device__ __forceinline__ void operator()(const f32x4 (&acc)[2][2][4][2], const pg8::Unit& u, int wr, int wc, int fr, int fq) const {
        const int slot = (u.pm == pm0) ? 0 : ((u.pm == pm1) ? 1 : ((u.pm == pm2) ? 2 : 3));
        const float2* st = stats + slot * 256;
        const int lrow0 = wr * 64 + fr, col0 = u.pn * 256 + wc * 32 + 8 * fq;
        f32x4 cv[2][2], dv[2][2];
#pragma unroll
        for (int bj = 0; bj < 2; ++bj)
#pragma unroll
            for (int n = 0; n < 2; ++n) { cv[bj][n] = *(const f32x4*)(csum + col0 + bj * 128 + 4 * n); dv[bj][n] = *(const f32x4*)(dvec + col0 + bj * 128 + 4 * n); }
#pragma unroll
        for (int ai = 0; ai < 2; ++ai)
#pragma unroll
            for (int m = 0; m < 4; ++m) {
                const int lrow = lrow0 + ai * 128 + m * 16;
                const float2 ms = st[lrow];
                bf16_t* rowp = O + (size_t)(u.pm * 256 + lrow) * ldc + col0;
#pragma unroll
                for (int bj = 0; bj < 2; ++bj) {
                    const f32x4 v0 = (acc[ai][bj][m][0] - cv[bj][0] * ms.x) * ms.y + dv[bj][0], v1 = (acc[ai][bj][m][1] - cv[bj][1] * ms.x) * ms.y + dv[bj][1];
                    u32x4 w; w.x = pg8::cvt_pk_bf16(v0[0], v0[1]); w.y = pg8::cvt_pk_bf16(v0[2], v0[3]); w.z = pg8::cvt_pk_bf16(v1[0], v1[1]); w.w = pg8::cvt_pk_bf16(v1[2], v1[3]);
                    *(u32x4*)(rowp + bj * 128) = w;
                }
            }
    }
};
__device__ __forceinline__ void gemm_q_phase(unsigned char* lds, const bf16_t* Vb, const bf16_t* Wt, const float* __restrict__ part, const float* csum, const float* dvec, bf16_t* Q) {
    pg8::StaticOrder S; S.init(NT, 2048, (int)gridDim.x, (int)blockIdx.x);
    int pms[4] = {-1, -1, -1, -1};
    float2* st = (float2*)(lds + 131072);
    __syncthreads();
#pragma unroll
    for (int i = 0; i < 4; ++i) {
        pg8::Unit u;
        if (S.next(i, u)) {
            bool seen = false;
#pragma unroll
            for (int j = 0; j < 4; ++j) if (j < i && pms[j] == u.pm) seen = true;
            pms[i] = seen ? -2 - i : u.pm;
            if (!seen && tidx() < 256) {
                const int row = u.pm * 256 + tidx();
                float s1 = 0.f, s2 = 0.f;
#pragma unroll
                for (int pn = 0; pn < 4; ++pn) {
                    const float4* pp = (const float4*)(part + ((size_t)pn * NT + row) * 8);
#pragma unroll
                    for (int k = 0; k < 2; ++k) { const float4 a = pp[k]; s1 += a.x; s2 += a.y; s1 += a.z; s2 += a.w; }
                }
                const float mean = s1 * (1.f / ND), var = fmaxf(s2 * (1.f / ND) - mean * mean, 0.f);
                st[i * 256 + tidx()] = make_float2(mean, rsqrtf(var + LN_EPS));
            }
        }
    }
    __syncthreads();
    pg8::Gemm g{Vb, Wt, NT, 2048, ND};
    EpiBf16LN E{Q, 2048, csum, dvec, st, pms[0], pms[1], pms[2], pms[3]};
    pg8::gemm_phase<EpiBf16LN, pg8::StaticOrder, false>((PG8_LAS unsigned char*)lds, g, S, E, nullptr);
    __syncthreads();
}
template <class Epi>
__device__ __forceinline__ void gemm_bf16_phase(unsigned char* lds, const bf16_t* A, const bf16_t* Bt, int M, int N, int K, const Epi& E, bool reverse_ids = false) {
    pg8::Gemm g{A, Bt, M, N, K};
    pg8::StaticOrder S; S.init(M, N, (int)gridDim.x, reverse_ids ? (int)(gridDim.x - 1 - blockIdx.x) : (int)blockIdx.x);
    pg8::gemm_phase<Epi, pg8::StaticOrder, false>((PG8_LAS unsigned char*)lds, g, S, E, nullptr);
    __syncthreads();
}

struct ColMap { int d0[3], s0[3], len[3]; };
__device__ __forceinline__ void convert_wt_phase(const float* __restrict__ W, int K, int N, int Npad, const ColMap cm, bf16_t* __restrict__ Wt, float* lds, const float* __restrict__ rowscale = nullptr) {
    float(*tile)[65] = (float(*)[65])lds;
    const int tid = tidx(), ntn = Npad / 64, ntiles = (K / 64) * ntn;
    for (int it = blockIdx.x; it < ntiles; it += gridDim.x) {
        const int k0 = (it / ntn) * 64, n0 = (it % ntn) * 64;
        __syncthreads();
#pragma unroll
        for (int h = 0; h < 2; ++h) {
            const int r = (tid >> 4) + h * 32, c4 = (tid & 15) * 4, nd = n0 + c4;
            int ns = -1;
#pragma unroll
            for (int sg = 0; sg < 3; ++sg) if (nd >= cm.d0[sg] && nd < cm.d0[sg] + cm.len[sg]) ns = cm.s0[sg] + (nd - cm.d0[sg]);
            float4 v = make_float4(0.f, 0.f, 0.f, 0.f);
            if (ns >= 0) v = *(const float4*)(W + (size_t)(k0 + r) * N + ns);
            if (rowscale) { const float gsc = rowscale[k0 + r]; v.x *= gsc; v.y *= gsc; v.z *= gsc; v.w *= gsc; }
            tile[r][c4] = v.x; tile[r][c4 + 1] = v.y; tile[r][c4 + 2] = v.z; tile[r][c4 + 3] = v.w;
        }
        __syncthreads();
        const int n = tid >> 3, k8 = (tid & 7) * 8;
        float o[8];
#pragma unroll
        for (int j = 0; j < 8; ++j) o[j] = tile[k8 + j][n];
        st8(Wt + (size_t)(n0 + n) * K + k0 + k8, o);
    }
    __syncthreads();
}
__device__ __forceinline__ float gelu_tanh(float x) {
    float u = 0.7978845608028654f * (x + 0.044715f * x * x * x);
    return 0.5f * x * (1.f + tanhf(u));
}
__device__ __forceinline__ float sigmoidf_(float x) { return 1.f / (1.f + expf(-x)); }
__device__ __forceinline__ void wave_lds_fence() { asm volatile("s_waitcnt lgkmcnt(0)" ::: "memory"); }
__device__ __forceinline__ void lds_barrier() { asm volatile("s_waitcnt lgkmcnt(0)" ::: "memory"); __builtin_amdgcn_s_barrier(); asm volatile("" ::: "memory"); }

__device__ __forceinline__ void s5_scan_wave(int bg, const bf16_t* __restrict__ proj, const float* __restrict__ lam_re, const float* __restrict__ lam_im,
                             const float* __restrict__ log_dt, const float* __restrict__ b_re, const float* __restrict__ b_im,
                             const float* __restrict__ c_re, const float* __restrict__ c_im, const float* __restrict__ dskip,
                             float* __restrict__ ya, float* lds) {
    const int b = bg >> 4, g = bg & 15, lane = tidx() & 63;
    float(*us)[16] = (float(*)[16])lds;
    float(*xr)[65] = (float(*)[65])(lds + 1024);
    float(*xi)[65] = (float(*)[65])(lds + 1024 + 4160);
    float(*cr)[64] = (float(*)[64])(lds + 1024 + 8320);
    float(*ci)[64] = (float(*)[64])(lds + 1024 + 8320 + 1024);
    const float lr = lam_re[g * 64 + lane], li = lam_im[g * 64 + lane];
    const float dt = expf(log_dt[g]);
    const float mag = expf(lr * dt);
    const float are = mag * cosf(li * dt), aim = mag * sinf(li * dt);
    const float nr = are - 1.f, den = lr * lr + li * li;
    const float fre = (nr * lr + aim * li) / den, fim = (aim * lr - nr * li) / den;
    float bbr[16], bbi[16];
#pragma unroll
    for (int i = 0; i < 16; ++i) {
        const float br = b_re[(g * 64 + lane) * 16 + i], bi = b_im[(g * 64 + lane) * 16 + i];
        bbr[i] = fre * br - fim * bi; bbi[i] = fre * bi + fim * br;
    }
    for (int idx = lane; idx < 1024; idx += 64) { cr[idx >> 6][idx & 63] = c_re[g * 1024 + idx]; ci[idx >> 6][idx & 63] = c_im[g * 1024 + idx]; }
    float dsk[16];
#pragma unroll
    for (int i = 0; i < 16; ++i) dsk[i] = dskip[g * 16 + i];
    float xre = 0.f, xim = 0.f;
    for (int t0 = 0; t0 < NL; t0 += 64) {
        wave_lds_fence();
        for (int idx = lane; idx < 1024; idx += 64) { const int t = idx >> 4, i = idx & 15; us[t][i] = bf2f(proj[(size_t)(b * NL + t0 + t) * EVEN_IN + g * 16 + i]); }
        wave_lds_fence();
        for (int t = 0; t < 64; ++t) {
            float bur = 0.f, bui = 0.f;
#pragma unroll
            for (int i = 0; i < 16; ++i) { const float u = us[t][i]; bur += bbr[i] * u; bui += bbi[i] * u; }
            const float nre = are * xre - aim * xim + bur, nim = are * xim + aim * xre + bui;
            xre = nre; xim = nim;
            xr[t][lane] = xre; xi[t][lane] = xim;
        }
        wave_lds_fence();
        float y[16];
#pragma unroll
        for (int i = 0; i < 16; ++i) y[i] = 0.f;
        for (int p = 0; p < 64; ++p) {
            const float a = xr[lane][p], bq = xi[lane][p];
#pragma unroll
            for (int i = 0; i < 16; ++i) y[i] += cr[i][p] * a - ci[i][p] * bq;
        }
#pragma unroll
        for (int i = 0; i < 16; ++i) {
            const float v = y[i] + dsk[i] * us[lane][i];
            ya[(size_t)(b * NL + t0 + lane) * 256 + g * 16 + i] = gelu_tanh(v);
        }
    }
}

__device__ __forceinline__ void sb_attn_wave(int task, const bf16_t* __restrict__ proj, bf16_t* __restrict__ Y, float* wl) {
    const int qt = task & 31, h = (task >> 5) % 12, b = task / 384, lane = tidx() & 63;
    const int t = qt * 64 + lane;
    float(*ks)[64] = (float(*)[64])wl;
    float(*vs)[64] = (float(*)[64])(wl + 2048);
    const bf16_t* base = proj + (size_t)b * NL * EVEN_IN;
    float q[64], acc[64];
#pragma unroll
    for (int d = 0; d < 64; d += 8) ld8(base + (size_t)t * EVEN_IN + 256 + h * 64 + d, q + d);
#pragma unroll
    for (int d = 0; d < 64; ++d) acc[d] = 0.f;
    float tail = 0.f;
    for (int c = 2 * qt + 1; c >= 0; --c) {
        wave_lds_fence();
        for (int i = 0; i < 32; ++i) {
            ks[i][lane] = bf2f(base[(size_t)(c * 32 + i) * EVEN_IN + 1024 + h * 64 + lane]);
            vs[i][lane] = bf2f(base[(size_t)(c * 32 + i) * EVEN_IN + 1792 + h * 64 + lane]);
        }
        wave_lds_fence();
        for (int s = 31; s >= 0; --s) {
            const int key = c * 32 + s;
            float z = 0.f;
#pragma unroll
            for (int d = 0; d < 64; ++d) z += q[d] * ks[s][d];
            z *= 0.125f;
            const bool valid = key < t;
            const float sp = fmaxf(z, 0.f) + log1pf(expf(-fabsf(z)));
            const float w = valid ? expf(z - sp + tail) : 0.f;
#pragma unroll
            for (int d = 0; d < 64; ++d) acc[d] += w * vs[s][d];
            if (valid) tail -= sp;
        }
        if (__all(tail < -120.f)) break;
    }
#pragma unroll
    for (int d = 0; d < 64; d += 8) st8(Y + (size_t)(b * NL + t) * ND + 256 + h * 64 + d, acc + d);
}

__device__ __forceinline__ void glu_phase(const float* __restrict__ ya, const float* __restrict__ wglu, const float* __restrict__ bglu, bf16_t* __restrict__ Y, float* lds) {
    const int half = tidx() >> 8, c = tidx() & 255;
    float(*ys)[256] = (float(*)[256])(lds + half * 4096);
    for (int it = blockIdx.x; it < NT / 32; it += gridDim.x) {
        const int t0 = it * 32 + half * 16;
        __syncthreads();
        for (int i = 0; i < 16; ++i) ys[i][c] = ya[(size_t)(t0 + i) * 256 + c];
        __syncthreads();
        float acc[16];
#pragma unroll
        for (int i = 0; i < 16; ++i) acc[i] = 0.f;
        for (int k = 0; k < 256; ++k) {
            const float w = wglu[k * 256 + c];
#pragma unroll
            for (int i = 0; i < 16; ++i) acc[i] += ys[i][k] * w;
        }
        const float bb = bglu[c];
#pragma unroll
        for (int i = 0; i < 16; ++i) Y[(size_t)(t0 + i) * ND + c] = f2bf(ys[i][c] * sigmoidf_(acc[i] + bb));
    }
    __syncthreads();
}

__device__ __forceinline__ void ln_row_wave(float4 (&v)[4], const float* __restrict__ g, const float* __restrict__ bta, float* out, bf16_t* outb, int lane) {
    float s = 0.f;
#pragma unroll
    for (int j = 0; j < 4; ++j) s += v[j].x + v[j].y + v[j].z + v[j].w;
    for (int o = 32; o; o >>= 1) s += __shfl_xor(s, o);
    const float mean = s * (1.f / ND);
    float s2 = 0.f;
#pragma unroll
    for (int j = 0; j < 4; ++j) {
        v[j].x -= mean; v[j].y -= mean; v[j].z -= mean; v[j].w -= mean;
        s2 += v[j].x * v[j].x + v[j].y * v[j].y + v[j].z * v[j].z + v[j].w * v[j].w;
    }
    for (int o = 32; o; o >>= 1) s2 += __shfl_xor(s2, o);
    const float rs = rsqrtf(s2 * (1.f / ND) + LN_EPS);
#pragma unroll
    for (int j = 0; j < 4; ++j) {
        const float4 gg = *(const float4*)(g + j * 256 + lane * 4), bb = *(const float4*)(bta + j * 256 + lane * 4);
        const float4 o = make_float4(v[j].x * rs * gg.x + bb.x, v[j].y * rs * gg.y + bb.y, v[j].z * rs * gg.z + bb.z, v[j].w * rs * gg.w + bb.w);
        *(float4*)(out + j * 256 + lane * 4) = o;
        if (outb) { uint2 w; w.x = pack2(o.x, o.y); w.y = pack2(o.z, o.w); *(uint2*)(outb + j * 256 + lane * 4) = w; }
    }
}
__device__ __forceinline__ void ln_phase(float* R, bf16_t* Hb, const float* __restrict__ g, const float* __restrict__ bta) {
    const int wave = tidx() >> 6, lane = tidx() & 63;
    for (int row = blockIdx.x * 8 + wave; row < NT; row += gridDim.x * 8) {
        float4 v[4];
#pragma unroll
        for (int j = 0; j < 4; ++j) v[j] = *(const float4*)(R + (size_t)row * ND + j * 256 + lane * 4);
        ln_row_wave(v, g, bta, R + (size_t)row * ND, Hb + (size_t)row * ND, lane);
    }
}

__device__ __forceinline__ void wave_argmax(float& bv, int& bi) {
#pragma unroll
    for (int o = 32; o; o >>= 1) {
        const float ov = __shfl_xor(bv, o); const int oi = __shfl_xor(bi, o);
        if (ov > bv || (ov == bv && oi < bi)) { bv = ov; bi = oi; }
    }
}
__device__ __forceinline__ void peer_route_phase(const bf16_t* __restrict__ qbuf, const float* __restrict__ subk, int* __restrict__ eidx, float* __restrict__ egate, float* lds) {
    const int head = tidx() >> 6, lane = tidx() & 63;
    float* qs = lds + head * 256;
    for (int token = blockIdx.x; token < NT; token += gridDim.x) {
        const bf16_t* qp = qbuf + (size_t)token * 2048 + head * 256;
        wave_lds_fence();
        for (int i = 0; i < 4; ++i) qs[lane + 64 * i] = bf2f(qp[lane + 64 * i]);
        wave_lds_fence();
        float myv[2]; int myi[2];
#pragma unroll
        for (int c = 0; c < 2; ++c) {
            float sc[2];
#pragma unroll
            for (int w2 = 0; w2 < 2; ++w2) {
                const float* kr = subk + ((size_t)(head * 2 + c) * 128 + lane + 64 * w2) * 128;
                float a = 0.f;
#pragma unroll 4
                for (int d = 0; d < 128; d += 4) {
                    const float4 kv = *(const float4*)(kr + d);
                    a += qs[c * 128 + d] * kv.x + qs[c * 128 + d + 1] * kv.y + qs[c * 128 + d + 2] * kv.z + qs[c * 128 + d + 3] * kv.w;
                }
                sc[w2] = a;
            }
            float a0 = sc[0], a1 = sc[1];
            float mv = -INFINITY; int mi = 0;
            for (int r = 0; r < 16; ++r) {
                float bv; int bi;
                if (a0 >= a1) { bv = a0; bi = lane; } else { bv = a1; bi = lane + 64; }
                wave_argmax(bv, bi);
                if (lane == r) { mv = bv; mi = bi; }
                if (bi == lane) a0 = -INFINITY; else if (bi == lane + 64) a1 = -INFINITY;
            }
            myv[c] = mv; myi[c] = mi;
        }
        const float va = __shfl(myv[0], lane >> 2);
        float cand[4];
#pragma unroll
        for (int j = 0; j < 4; ++j) cand[j] = va + __shfl(myv[1], (lane & 3) * 4 + j);
        float topv = -INFINITY; int topf = 0;
        for (int r = 0; r < 16; ++r) {
            float bv = cand[0]; int bi = lane * 4;
#pragma unroll
            for (int j = 1; j < 4; ++j) if (cand[j] > bv) { bv = cand[j]; bi = lane * 4 + j; }
            wave_argmax(bv, bi);
            if (lane == r) { topv = bv; topf = bi; }
#pragma unroll
            for (int j = 0; j < 4; ++j) if (bi == lane * 4 + j) cand[j] = -INFINITY;
        }
        const int e1 = __shfl(myi[0], topf >> 4), e2 = __shfl(myi[1], topf & 15);
        const float top0 = __shfl(topv, 0);
        float ex = (lane < 16) ? expf(topv - top0) : 0.f;
        float sum = ex;
        for (int o = 32; o; o >>= 1) sum += __shfl_xor(sum, o);
        if (lane < 16) {
            eidx[(size_t)token * 128 + head * 16 + lane] = e1 * 128 + e2;
            egate[(size_t)token * 128 + head * 16 + lane] = ex / sum;
        }
    }
}

__device__ __forceinline__ void peer_expert_phase(float* R, const int* __restrict__ eidx, const float* __restrict__ egate, const float* __restrict__ utab,
                                  const float* __restrict__ vtab, const float* __restrict__ lg, const float* __restrict__ lb, bf16_t* Hb) {
    const int wave = tidx() >> 6, lane = tidx() & 63;
    for (int token = blockIdx.x * 8 + wave; token < NT; token += gridDim.x * 8) {
        float4 x[4], acc[4];
#pragma unroll
        for (int j = 0; j < 4; ++j) { x[j] = *(const float4*)(R + (size_t)token * ND + j * 256 + lane * 4); acc[j] = make_float4(0.f, 0.f, 0.f, 0.f); }
        for (int e0 = 0; e0 < 128; e0 += 4) {
            float dot[4]; int ex[4]; float gt[4];
#pragma unroll
            for (int k = 0; k < 4; ++k) {
                ex[k] = eidx[(size_t)token * 128 + e0 + k]; gt[k] = egate[(size_t)token * 128 + e0 + k];
                const float* ur = utab + (size_t)ex[k] * ND + lane * 4;
                float a = 0.f;
#pragma unroll
                for (int j = 0; j < 4; ++j) { const float4 u = *(const float4*)(ur + j * 256); a += x[j].x * u.x + x[j].y * u.y + x[j].z * u.z + x[j].w * u.w; }
                dot[k] = a;
            }
#pragma unroll
            for (int k = 0; k < 4; ++k) {
                float a = dot[k];
                for (int o = 32; o; o >>= 1) a += __shfl_xor(a, o);
                const float coef = gt[k] * gelu_tanh(a);
                const float* vr = vtab + (size_t)ex[k] * ND + lane * 4;
#pragma unroll
                for (int j = 0; j < 4; ++j) { const float4 v = *(const float4*)(vr + j * 256); acc[j].x += coef * v.x; acc[j].y += coef * v.y; acc[j].z += coef * v.z; acc[j].w += coef * v.w; }
            }
        }
#pragma unroll
        for (int j = 0; j < 4; ++j) { x[j].x = ALPHA * x[j].x + acc[j].x; x[j].y = ALPHA * x[j].y + acc[j].y; x[j].z = ALPHA * x[j].z + acc[j].z; x[j].w = ALPHA * x[j].w + acc[j].w; }
        ln_row_wave(x, lg, lb, R + (size_t)token * ND, Hb ? Hb + (size_t)token * ND : nullptr, lane);
    }
}


typedef short bf16x8_t __attribute__((ext_vector_type(8)));
__device__ __forceinline__ int f2key(float f) { const int b = __float_as_int(f); return b ^ ((b >> 31) & 0x7fffffff); }
__device__ __forceinline__ float key2f(int k) { return __int_as_float(k ^ ((k >> 31) & 0x7fffffff)); }
#define CE_DESC_I(a, b) do { const int _hi = max(a, b), _lo = min(a, b); a = _hi; b = _lo; } while (0)
template <int N, int K, int J> __device__ __forceinline__ void bstage(int (&v)[N]) {
#pragma unroll
    for (int i = 0; i < N; ++i) {
        const int l = i ^ J;
        if (l > i) { if ((i & K) == 0) CE_DESC_I(v[i], v[l]); else CE_DESC_I(v[l], v[i]); }
    }
}
__device__ __forceinline__ void sort16_desc(int (&v)[16]) {
    bstage<16, 2, 1>(v); bstage<16, 4, 2>(v); bstage<16, 4, 1>(v); bstage<16, 8, 4>(v); bstage<16, 8, 2>(v); bstage<16, 8, 1>(v);
    bstage<16, 16, 8>(v); bstage<16, 16, 4>(v); bstage<16, 16, 2>(v); bstage<16, 16, 1>(v);
}
__device__ __forceinline__ void sort8_desc(int (&v)[8]) {
    bstage<8, 2, 1>(v); bstage<8, 4, 2>(v); bstage<8, 4, 1>(v); bstage<8, 8, 4>(v); bstage<8, 8, 2>(v); bstage<8, 8, 1>(v);
}
__device__ __forceinline__ void bitonic_merge16_desc(int (&v)[16]) {
    bstage<16, 16, 8>(v); bstage<16, 16, 4>(v); bstage<16, 16, 2>(v); bstage<16, 16, 1>(v);
}
__device__ __forceinline__ void xmerge16(int (&v)[16], int off) {
    int m[16];
#pragma unroll
    for (int i = 0; i < 16; ++i) m[i] = max(v[i], __shfl_xor(v[15 - i], off));
    bitonic_merge16_desc(m);
#pragma unroll
    for (int i = 0; i < 16; ++i) v[i] = m[i];
}
__device__ __forceinline__ void opaque16(int (&v)[16]) {
#pragma unroll
    for (int i = 0; i < 16; ++i) asm volatile("" : "+v"(v[i]));
}
__device__ __forceinline__ int lookup16(const int (&arr)[16], int a) {
    int r = arr[0];
#pragma unroll
    for (int i = 1; i < 16; ++i) r = (a == i) ? arr[i] : r;
    return r;
}
__device__ __forceinline__ void peer_route2_phase(const bf16_t* __restrict__ qbuf, const bf16_t* __restrict__ skb, int* __restrict__ eidx, float* __restrict__ egate, unsigned char* lds) {
    if (__builtin_amdgcn_readfirstlane(tidx() >> 6) >= 4) __builtin_amdgcn_s_setprio(1);
    const int tid = tidx(), wave = tid >> 6, lane = tid & 63, fr = lane & 15, fq = lane >> 4;
    for (int chunk = blockIdx.x; chunk < NT / 128; chunk += gridDim.x) {
        const int token = chunk * 128 + wave * 16 + fr;
        int* tl = (int*)(lds + 69632) + (wave * 16 + fr) * 48;
        const int srow = tid >> 4, sch = tid & 15;
        const bf16_t* kg = skb + (size_t)srow * 128 + sch * 8;
        unsigned char* kl = lds + srow * 272 + sch * 16;
        const bf16_t* qg = qbuf + (size_t)token * 2048 + 8 * fq;
        uint4 kr0 = *(const uint4*)(kg), kr1 = *(const uint4*)(kg + 32 * 128), kr2 = *(const uint4*)(kg + 64 * 128), kr3 = *(const uint4*)(kg + 96 * 128);
        bf16x8_t qn0 = *(const bf16x8_t*)(qg), qn1 = *(const bf16x8_t*)(qg + 32), qn2 = *(const bf16x8_t*)(qg + 64), qn3 = *(const bf16x8_t*)(qg + 96);
        __syncthreads();
        *(uint4*)(kl) = kr0; *(uint4*)(kl + 32 * 272) = kr1; *(uint4*)(kl + 64 * 272) = kr2; *(uint4*)(kl + 96 * 272) = kr3;
        lds_barrier();
        for (int h = 0; h < 8; ++h) {
            int K1[16], K2[16];
#pragma unroll
            for (int c = 0; c < 2; ++c) {
                const int step = 2 * h + c;
                const unsigned char* kt_lds = lds + (step & 1) * 34816;
                const bf16x8_t qf0 = qn0, qf1 = qn1, qf2 = qn2, qf3 = qn3;
                {
                    const int sn = step < 15 ? step + 1 : step;
                    const bf16_t* kgn = kg + (size_t)sn * 128 * 128;
                    kr0 = *(const uint4*)(kgn); kr1 = *(const uint4*)(kgn + 32 * 128); kr2 = *(const uint4*)(kgn + 64 * 128); kr3 = *(const uint4*)(kgn + 96 * 128);
                    const bf16_t* qgn = qg + sn * 128;
                    qn0 = *(const bf16x8_t*)(qgn); qn1 = *(const bf16x8_t*)(qgn + 32); qn2 = *(const bf16x8_t*)(qgn + 64); qn3 = *(const bf16x8_t*)(qgn + 96);
                }
                int va[16], vb[16];
#pragma unroll
                for (int n = 0; n < 8; ++n) {
                    f32x4 S = {0.f, 0.f, 0.f, 0.f};
#pragma unroll
                    for (int sI = 0; sI < 4; ++sI) {
                        const bf16x8_t kf = *(const bf16x8_t*)(kt_lds + (16 * n + fr) * 272 + (32 * sI + 8 * fq) * 2);
                        S = __builtin_amdgcn_mfma_f32_16x16x32_bf16(kf, sI == 0 ? qf0 : (sI == 1 ? qf1 : (sI == 2 ? qf2 : qf3)), S, 0, 0, 0);
                    }
#pragma unroll
                    for (int j = 0; j < 4; ++j) {
                        const int key = (f2key(S[j]) & ~127) | (16 * n + 4 * fq + j);
                        if (n < 4) va[n * 4 + j] = key; else vb[(n - 4) * 4 + j] = key;
                    }
                }
                sort16_desc(va); sort16_desc(vb);
                int m[16];
#pragma unroll
                for (int i = 0; i < 16; ++i) m[i] = max(va[i], vb[15 - i]);
                bitonic_merge16_desc(m);
                xmerge16(m, 16); xmerge16(m, 32);
#pragma unroll
                for (int i = 0; i < 16; ++i) { if (c == 0) K1[i] = m[i]; else K2[i] = m[i]; }
                if (fq == 0) {
#pragma unroll
                    for (int i = 0; i < 4; ++i) *(int4*)(tl + c * 16 + 4 * i) = make_int4(m[4 * i], m[4 * i + 1], m[4 * i + 2], m[4 * i + 3]);
                }
                if (step < 15) {
                    unsigned char* kln = kl + ((step + 1) & 1) * 34816;
                    *(uint4*)(kln) = kr0; *(uint4*)(kln + 32 * 272) = kr1; *(uint4*)(kln + 64 * 272) = kr2; *(uint4*)(kln + 96 * 272) = kr3;
                    lds_barrier();
                }
            }
            wave_lds_fence();
            float vaf[4];
#pragma unroll
            for (int k = 0; k < 4; ++k) vaf[k] = key2f(tl[4 * k + fq]);
            int A[16];
#pragma unroll
            for (int b = 0; b < 16; ++b) {
                const bool valid = (fq + 1) * (b + 1) <= 16;
                const int key = (f2key(vaf[0] + key2f(K2[b])) & ~127) | (fq << 5) | b;
                A[b] = valid ? key : INT_MIN;
            }
            int Bq[8];
#pragma unroll
            for (int b = 0; b < 3; ++b) {
                const bool valid = (fq + 5) * (b + 1) <= 16;
                const int key = (f2key(vaf[1] + key2f(K2[b])) & ~127) | (fq << 5) | (16 + b);
                Bq[b] = valid ? key : INT_MIN;
            }
            Bq[3] = (f2key(vaf[2] + key2f(K2[0])) & ~127) | (fq << 5) | 19;
            Bq[4] = (f2key(vaf[3] + key2f(K2[0])) & ~127) | (fq << 5) | 20;
            Bq[5] = INT_MIN; Bq[6] = INT_MIN; Bq[7] = INT_MIN;
            sort8_desc(Bq);
#pragma unroll
            for (int i = 8; i < 16; ++i) A[i] = max(A[i], Bq[15 - i]);
            bitonic_merge16_desc(A);
            xmerge16(A, 16); xmerge16(A, 32);
            if (fq == 0) {
#pragma unroll
                for (int i = 0; i < 4; ++i) *(int4*)(tl + 32 + 4 * i) = make_int4(A[4 * i], A[4 * i + 1], A[4 * i + 2], A[4 * i + 3]);
            }
            wave_lds_fence();
            const int4 myT = *(const int4*)(tl + 32 + 4 * fq);
            const int tsel[4] = {myT.x, myT.y, myT.z, myT.w};
            const float top0 = key2f(A[0]);
            float sum = 0.f;
#pragma unroll
            for (int r = 0; r < 16; ++r) sum += __expf(key2f(A[r]) - top0);
            const float inv = 1.f / sum;
            int eo[4]; float go[4];
#pragma unroll
            for (int kk = 0; kk < 4; ++kk) {
                const int t = tsel[kk];
                const int id = t & 127, ofq = id >> 5, slot = id & 31;
                const int k = slot < 16 ? 0 : (slot < 19 ? 1 : (slot == 19 ? 2 : 3));
                const int b = slot < 16 ? slot : (slot < 19 ? slot - 16 : 0);
                const int a = ofq + 4 * k;
                const int e1 = tl[a] & 127, e2 = tl[16 + b] & 127;
                eo[kk] = e1 * 128 + e2;
                go[kk] = __expf(key2f(t) - top0) * inv;
            }
            *(int4*)(eidx + (size_t)token * 128 + h * 16 + 4 * fq) = make_int4(eo[0], eo[1], eo[2], eo[3]);
            *(float4*)(egate + (size_t)token * 128 + h * 16 + 4 * fq) = make_float4(go[0], go[1], go[2], go[3]);
            wave_lds_fence();
        }
    }
    __syncthreads();
    __builtin_amdgcn_s_setprio(0);
}

typedef __bf16 bf16x2_t __attribute__((ext_vector_type(2)));
typedef float f32x2_t __attribute__((ext_vector_type(2)));
__device__ __forceinline__ float dot2bf(unsigned a, unsigned b, float acc) { return __builtin_amdgcn_fdot2_f32_bf16(__builtin_bit_cast(bf16x2_t, a), __builtin_bit_cast(bf16x2_t, b), acc, false); }
__device__ __forceinline__ float gelu_fast(float x) {
    const float u = 0.7978845608028654f * (x + 0.044715f * x * x * x);
    return x / (1.f + __expf(-2.f * u));
}
__device__ __forceinline__ void peer_expert2_phase(float* R, const int* __restrict__ eidx, const float* __restrict__ egate, const bf16_t* __restrict__ ub,
                                                   const bf16_t* __restrict__ vb, const float* __restrict__ lg, const float* __restrict__ lb, bf16_t* Hb) {
    const int wave = tidx() >> 6, lane = tidx() & 63;
    for (int token = blockIdx.x * 8 + wave; token < NT; token += gridDim.x * 8) {
        float xf[16];
        {
            const float* rp = R + (size_t)token * ND + lane * 8;
            const float4 a0 = *(const float4*)rp, a1 = *(const float4*)(rp + 4), b0 = *(const float4*)(rp + 512), b1 = *(const float4*)(rp + 516);
            xf[0] = a0.x; xf[1] = a0.y; xf[2] = a0.z; xf[3] = a0.w; xf[4] = a1.x; xf[5] = a1.y; xf[6] = a1.z; xf[7] = a1.w;
            xf[8] = b0.x; xf[9] = b0.y; xf[10] = b0.z; xf[11] = b0.w; xf[12] = b1.x; xf[13] = b1.y; xf[14] = b1.z; xf[15] = b1.w;
        }
        unsigned xp[8];
#pragma unroll
        for (int j = 0; j < 8; ++j) xp[j] = pack2(xf[2 * j], xf[2 * j + 1]);
        float acc[16];
#pragma unroll
        for (int j = 0; j < 16; ++j) acc[j] = 0.f;
        const int e_lo = eidx[(size_t)token * 128 + lane], e_hi = eidx[(size_t)token * 128 + 64 + lane];
        const float g_lo = egate[(size_t)token * 128 + lane], g_hi = egate[(size_t)token * 128 + 64 + lane];
        for (int grp = 0; grp < 16; ++grp) {
            const int esel = grp < 8 ? e_lo : e_hi;
            const float gsel = grp < 8 ? g_lo : g_hi;
            const int lbase = (grp & 7) * 8;
            uint4 u0[8], u1[8];
            int exs[8];
#pragma unroll
            for (int k = 0; k < 8; ++k) {
                exs[k] = __builtin_amdgcn_readlane(esel, lbase + k);
                const bf16_t* up = ub + (size_t)exs[k] * ND + lane * 8;
                u0[k] = *(const uint4*)up; u1[k] = *(const uint4*)(up + 512);
            }
            float d[8];
#pragma unroll
            for (int k = 0; k < 8; ++k) {
                float a = dot2bf(u0[k].x, xp[0], 0.f), b = dot2bf(u0[k].y, xp[1], 0.f);
                a = dot2bf(u0[k].z, xp[2], a); b = dot2bf(u0[k].w, xp[3], b);
                a = dot2bf(u1[k].x, xp[4], a); b = dot2bf(u1[k].y, xp[5], b);
                a = dot2bf(u1[k].z, xp[6], a); b = dot2bf(u1[k].w, xp[7], b);
                d[k] = a + b;
            }
            const bool hi5 = lane & 32, hi4 = lane & 16, hi3 = lane & 8;
            float r4[4], r2[2], r1;
#pragma unroll
            for (int k = 0; k < 4; ++k) { const float send = hi5 ? d[k] : d[k + 4], keep = hi5 ? d[k + 4] : d[k]; r4[k] = keep + __shfl_xor(send, 32); }
#pragma unroll
            for (int k = 0; k < 2; ++k) { const float send = hi4 ? r4[k] : r4[k + 2], keep = hi4 ? r4[k + 2] : r4[k]; r2[k] = keep + __shfl_xor(send, 16); }
            { const float send = hi3 ? r2[0] : r2[1], keep = hi3 ? r2[1] : r2[0]; r1 = keep + __shfl_xor(send, 8); }
            r1 += __shfl_xor(r1, 4); r1 += __shfl_xor(r1, 2); r1 += __shfl_xor(r1, 1);
            uint4 v0[8], v1[8];
#pragma unroll
            for (int k = 0; k < 8; ++k) {
                const bf16_t* vp = vb + (size_t)exs[k] * ND + lane * 8;
                v0[k] = *(const uint4*)vp; v1[k] = *(const uint4*)(vp + 512);
            }
            const float gk = __shfl(gsel, lbase + (lane >> 3));
            const float coef = gk * gelu_fast(r1);
#pragma unroll
            for (int k = 0; k < 8; ++k) {
                const float ck = __int_as_float(__builtin_amdgcn_readlane(__float_as_int(coef), 8 * k));
                const unsigned w[8] = {v0[k].x, v0[k].y, v0[k].z, v0[k].w, v1[k].x, v1[k].y, v1[k].z, v1[k].w};
#pragma unroll
                for (int j = 0; j < 8; ++j) {
                    acc[2 * j] += ck * __uint_as_float(w[j] << 16);
                    acc[2 * j + 1] += ck * __uint_as_float(w[j] & 0xffff0000u);
                }
            }
        }
        {
            const float* rp = R + (size_t)token * ND + lane * 8;
            const float4 a0 = *(const float4*)rp, a1 = *(const float4*)(rp + 4), b0 = *(const float4*)(rp + 512), b1 = *(const float4*)(rp + 516);
            xf[0] = a0.x; xf[1] = a0.y; xf[2] = a0.z; xf[3] = a0.w; xf[4] = a1.x; xf[5] = a1.y; xf[6] = a1.z; xf[7] = a1.w;
            xf[8] = b0.x; xf[9] = b0.y; xf[10] = b0.z; xf[11] = b0.w; xf[12] = b1.x; xf[13] = b1.y; xf[14] = b1.z; xf[15] = b1.w;
        }
        float s = 0.f;
#pragma unroll
        for (int j = 0; j < 16; ++j) { xf[j] = ALPHA * xf[j] + acc[j]; s += xf[j]; }
        for (int o = 32; o; o >>= 1) s += __shfl_xor(s, o);
        const float mean = s * (1.f / ND);
        float s2 = 0.f;
#pragma unroll
        for (int j = 0; j < 16; ++j) { xf[j] -= mean; s2 += xf[j] * xf[j]; }
        for (int o = 32; o; o >>= 1) s2 += __shfl_xor(s2, o);
        const float rs = rsqrtf(s2 * (1.f / ND) + LN_EPS);
#pragma unroll
        for (int hf = 0; hf < 2; ++hf) {
            const int c0 = hf * 512 + lane * 8;
            const float4 g0 = *(const float4*)(lg + c0), g1 = *(const float4*)(lg + c0 + 4), b0 = *(const float4*)(lb + c0), b1 = *(const float4*)(lb + c0 + 4);
            float o[8];
            o[0] = xf[hf * 8 + 0] * rs * g0.x + b0.x; o[1] = xf[hf * 8 + 1] * rs * g0.y + b0.y; o[2] = xf[hf * 8 + 2] * rs * g0.z + b0.z; o[3] = xf[hf * 8 + 3] * rs * g0.w + b0.w;
            o[4] = xf[hf * 8 + 4] * rs * g1.x + b1.x; o[5] = xf[hf * 8 + 5] * rs * g1.y + b1.y; o[6] = xf[hf * 8 + 6] * rs * g1.z + b1.z; o[7] = xf[hf * 8 + 7] * rs * g1.w + b1.w;
            float* op = R + (size_t)token * ND + c0;
            *(float4*)op = make_float4(o[0], o[1], o[2], o[3]); *(float4*)(op + 4) = make_float4(o[4], o[5], o[6], o[7]);
            if (Hb) st8(Hb + (size_t)token * ND + c0, o);
        }
    }
}


template <int K2, int J> __device__ __forceinline__ void bsort_round(int (&k)[2], float (&g)[2], int lane) {
    if (J == 64) {
        const bool sw = k[0] > k[1];
        const int t = k[0]; const float tg = g[0];
        k[0] = sw ? k[1] : k[0]; g[0] = sw ? g[1] : g[0]; k[1] = sw ? t : k[1]; g[1] = sw ? tg : g[1];
    } else {
#pragma unroll
        for (int r = 0; r < 2; ++r) {
            const int pk = __shfl_xor(k[r], J); const float pg = __shfl_xor(g[r], J);
            const bool asc = (((lane + 64 * r) & K2) == 0), lower = ((lane & J) == 0);
            const bool take = (lower == asc) ? (pk < k[r]) : (pk > k[r]);
            k[r] = take ? pk : k[r]; g[r] = take ? pg : g[r];
        }
    }
}
template <int K2> __device__ __forceinline__ void bsort_stage(int (&k)[2], float (&g)[2], int lane) {
    if (K2 >= 128) bsort_round<K2, 64>(k, g, lane);
    if (K2 >= 64) bsort_round<K2, 32>(k, g, lane);
    if (K2 >= 32) bsort_round<K2, 16>(k, g, lane);
    if (K2 >= 16) bsort_round<K2, 8>(k, g, lane);
    if (K2 >= 8) bsort_round<K2, 4>(k, g, lane);
    if (K2 >= 4) bsort_round<K2, 2>(k, g, lane);
    bsort_round<K2, 1>(k, g, lane);
}
__device__ __forceinline__ void sort_routing(int& e_lo, int& e_hi, float& g_lo, float& g_hi, int lane) {
    int k[2] = {e_lo, e_hi}; float g[2] = {g_lo, g_hi};
    bsort_stage<2>(k, g, lane); bsort_stage<4>(k, g, lane); bsort_stage<8>(k, g, lane); bsort_stage<16>(k, g, lane);
    bsort_stage<32>(k, g, lane); bsort_stage<64>(k, g, lane); bsort_stage<128>(k, g, lane);
    e_lo = k[0]; e_hi = k[1]; g_lo = g[0]; g_hi = g[1];
}
template <int J> __device__ __forceinline__ unsigned sort_partner(unsigned v, int lane) {
    if constexpr (J == 1) return (unsigned)__builtin_amdgcn_update_dpp(0, (int)v, 0xB1, 0xf, 0xf, false);
    else if constexpr (J == 2) return (unsigned)__builtin_amdgcn_update_dpp(0, (int)v, 0x4E, 0xf, 0xf, false);
    else if constexpr (J == 4) { const int t = __builtin_amdgcn_update_dpp(0, (int)v, 0x141, 0xf, 0xf, false);
                                 return (unsigned)__builtin_amdgcn_update_dpp(0, t, 0x1B, 0xf, 0xf, false); }
    else if constexpr (J == 8) return (unsigned)__builtin_amdgcn_update_dpp(0, (int)v, 0x128, 0xf, 0xf, false);
    else if constexpr (J == 16) { const auto r = __builtin_amdgcn_permlane16_swap(v, v, false, false); return (lane & 16) ? r[0] : r[1]; }
    else { const auto r = __builtin_amdgcn_permlane32_swap(v, v, false, false); return (lane & 32) ? r[0] : r[1]; }
}
template <int K2, int J> __device__ __forceinline__ void psort_round(unsigned (&v)[2], int lane) {
    if constexpr (J == 64) { const unsigned lo = min(v[0], v[1]), hi = max(v[0], v[1]); v[0] = lo; v[1] = hi; }
    else {
#pragma unroll
        for (int r = 0; r < 2; ++r) {
            const unsigned pv = sort_partner<J>(v[r], lane);
            const bool asc = (((lane + 64 * r) & K2) == 0), lower = ((lane & J) == 0);
            const unsigned mn = min(v[r], pv), mx = max(v[r], pv);
            v[r] = (lower == asc) ? mn : mx;
        }
    }
}
template <int K2> __device__ __forceinline__ void psort_stage(unsigned (&v)[2], int lane) {
    if constexpr (K2 >= 128) psort_round<K2, 64>(v, lane);
    if constexpr (K2 >= 64) psort_round<K2, 32>(v, lane);
    if constexpr (K2 >= 32) psort_round<K2, 16>(v, lane);
    if constexpr (K2 >= 16) psort_round<K2, 8>(v, lane);
    if constexpr (K2 >= 8) psort_round<K2, 4>(v, lane);
    if constexpr (K2 >= 4) psort_round<K2, 2>(v, lane);
    psort_round<K2, 1>(v, lane);
}
__device__ __forceinline__ void sort_routing_packed(unsigned& lo, unsigned& hi, int lane) {
    unsigned v[2] = {lo, hi};
    psort_stage<2>(v, lane); psort_stage<4>(v, lane); psort_stage<8>(v, lane); psort_stage<16>(v, lane);
    psort_stage<32>(v, lane); psort_stage<64>(v, lane); psort_stage<128>(v, lane);
    lo = v[0]; hi = v[1];
}
__device__ __forceinline__ void peer_expert3_phase(float* R, const int* __restrict__ eidx, const float* __restrict__ egate, const unsigned char* __restrict__ ub,
                                                   const unsigned char* __restrict__ vb, const float* __restrict__ lg, const float* __restrict__ lb, bf16_t* Hb, float* Rout, const XcdBarrier& xb) {
    const int wave = tidx() >> 6, lane = tidx() & 63;
    int itk = 0;
    for (int token = blockIdx.x * 8 + wave; token < NT; token += gridDim.x * 8, ++itk) {
        if ((itk & 1) == 0 && itk) xcd_barrier(xb);
        float xf[16];
        {
            const float* rp = R + (size_t)token * ND + lane * 16;
#pragma unroll
            for (int q = 0; q < 4; ++q) { const float4 a = *(const float4*)(rp + 4 * q); xf[4 * q] = a.x; xf[4 * q + 1] = a.y; xf[4 * q + 2] = a.z; xf[4 * q + 3] = a.w; }
        }
        float acc[16];
#pragma unroll
        for (int j = 0; j < 16; ++j) acc[j] = 0.f;
        int e_lo = eidx[(size_t)token * 128 + lane], e_hi = eidx[(size_t)token * 128 + 64 + lane];
        float g_lo = egate[(size_t)token * 128 + lane], g_hi = egate[(size_t)token * 128 + 64 + lane];
        sort_routing(e_lo, e_hi, g_lo, g_hi, lane);
        for (int grp = 0; grp < 16; ++grp) {
            const int esel = grp < 8 ? e_lo : e_hi;
            const float gsel = grp < 8 ? g_lo : g_hi;
            const int lbase = (grp & 7) * 8;
            uint4 u[8], v[8];
#pragma unroll
            for (int k = 0; k < 8; ++k) {
                const int ex = __builtin_amdgcn_readlane(esel, lbase + k);
                u[k] = *(const uint4*)(ub + (size_t)ex * ND + lane * 16);
                v[k] = *(const uint4*)(vb + (size_t)ex * ND + lane * 16);
            }
            float d[8];
#pragma unroll
            for (int k = 0; k < 8; ++k) {
                const unsigned w[4] = {u[k].x, u[k].y, u[k].z, u[k].w};
                float a = 0.f, b = 0.f;
#pragma unroll
                for (int q = 0; q < 4; ++q) {
                    const f32x2_t lo = __builtin_amdgcn_cvt_pk_f32_fp8((int)w[q], false), hi = __builtin_amdgcn_cvt_pk_f32_fp8((int)w[q], true);
                    a = fmaf(xf[4 * q], lo.x, a); b = fmaf(xf[4 * q + 1], lo.y, b); a = fmaf(xf[4 * q + 2], hi.x, a); b = fmaf(xf[4 * q + 3], hi.y, b);
                }
                d[k] = a + b;
            }
            const bool hi5 = lane & 32, hi4 = lane & 16, hi3 = lane & 8;
            float r4[4], r2[2], r1;
#pragma unroll
            for (int k = 0; k < 4; ++k) { const float send = hi5 ? d[k] : d[k + 4], keep = hi5 ? d[k + 4] : d[k]; r4[k] = keep + __shfl_xor(send, 32); }
#pragma unroll
            for (int k = 0; k < 2; ++k) { const float send = hi4 ? r4[k] : r4[k + 2], keep = hi4 ? r4[k + 2] : r4[k]; r2[k] = keep + __shfl_xor(send, 16); }
            { const float send = hi3 ? r2[0] : r2[1], keep = hi3 ? r2[1] : r2[0]; r1 = keep + __shfl_xor(send, 8); }
            r1 += __shfl_xor(r1, 4); r1 += __shfl_xor(r1, 2); r1 += __shfl_xor(r1, 1);
            const float gk = __shfl(gsel, lbase + (lane >> 3));
            const float coef = gk * gelu_fast(r1 * (1.f / U_SCALE)) * (1.f / V_SCALE);
#pragma unroll
            for (int k = 0; k < 8; ++k) {
                const float ck = __int_as_float(__builtin_amdgcn_readlane(__float_as_int(coef), 8 * k));
                const unsigned w[4] = {v[k].x, v[k].y, v[k].z, v[k].w};
#pragma unroll
                for (int q = 0; q < 4; ++q) {
                    const f32x2_t lo = __builtin_amdgcn_cvt_pk_f32_fp8((int)w[q], false), hi = __builtin_amdgcn_cvt_pk_f32_fp8((int)w[q], true);
                    acc[4 * q] = fmaf(ck, lo.x, acc[4 * q]); acc[4 * q + 1] = fmaf(ck, lo.y, acc[4 * q + 1]);
                    acc[4 * q + 2] = fmaf(ck, hi.x, acc[4 * q + 2]); acc[4 * q + 3] = fmaf(ck, hi.y, acc[4 * q + 3]);
                }
            }
        }
        float s = 0.f;
#pragma unroll
        for (int j = 0; j < 16; ++j) { xf[j] = ALPHA * xf[j] + acc[j]; s += xf[j]; }
        for (int o = 32; o; o >>= 1) s += __shfl_xor(s, o);
        const float mean = s * (1.f / ND);
        float s2 = 0.f;
#pragma unroll
        for (int j = 0; j < 16; ++j) { xf[j] -= mean; s2 += xf[j] * xf[j]; }
        for (int o = 32; o; o >>= 1) s2 += __shfl_xor(s2, o);
        const float rs = rsqrtf(s2 * (1.f / ND) + LN_EPS);
        float o[16];
#pragma unroll
        for (int q = 0; q < 4; ++q) {
            const float4 gg = *(const float4*)(lg + lane * 16 + 4 * q), bb = *(const float4*)(lb + lane * 16 + 4 * q);
            o[4 * q] = xf[4 * q] * rs * gg.x + bb.x; o[4 * q + 1] = xf[4 * q + 1] * rs * gg.y + bb.y; o[4 * q + 2] = xf[4 * q + 2] * rs * gg.z + bb.z; o[4 * q + 3] = xf[4 * q + 3] * rs * gg.w + bb.w;
            *(float4*)(Rout + (size_t)token * ND + lane * 16 + 4 * q) = make_float4(o[4 * q], o[4 * q + 1], o[4 * q + 2], o[4 * q + 3]);
        }
        if (Hb) { st8(Hb + (size_t)token * ND + lane * 16, o); st8(Hb + (size_t)token * ND + lane * 16 + 8, o + 8); }
    }
}


struct Rows8 { uint4 r[8]; };
__device__ __forceinline__ void rows_load(Rows8& G, int esel, int lbase, const unsigned char* __restrict__ tb, int lane) {
#pragma unroll
    for (int k = 0; k < 8; ++k) {
        const int ex = __builtin_amdgcn_readlane(esel, lbase + k);
        G.r[k] = *(const uint4*)(tb + (size_t)ex * ND + lane * 16);
    }
}
__device__ __forceinline__ void sweep_u(const Rows8& G, const float (&xf)[16], float gsel, int lbase, int lane, float* cl  , int grp) {
    float d[8];
#pragma unroll
    for (int k = 0; k < 8; ++k) {
        const unsigned w[4] = {G.r[k].x, G.r[k].y, G.r[k].z, G.r[k].w};
        f32x2_t a2 = {0.f, 0.f}, b2 = {0.f, 0.f};
#pragma unroll
        for (int q = 0; q < 4; ++q) {
            const f32x2_t lo = __builtin_amdgcn_cvt_pk_f32_fp8((int)w[q], false), hi = __builtin_amdgcn_cvt_pk_f32_fp8((int)w[q], true);
            a2 = __builtin_elementwise_fma((f32x2_t){xf[4 * q], xf[4 * q + 1]}, lo, a2);
            b2 = __builtin_elementwise_fma((f32x2_t){xf[4 * q + 2], xf[4 * q + 3]}, hi, b2);
        }
        d[k] = (a2.x + a2.y) + (b2.x + b2.y);
    }
    const bool hi5 = lane & 32, hi4 = lane & 16, hi3 = lane & 8;
    float r4[4], r2[2], r1;
#pragma unroll
    for (int k = 0; k < 4; ++k) { const float send = hi5 ? d[k] : d[k + 4], keep = hi5 ? d[k + 4] : d[k]; r4[k] = keep + __shfl_xor(send, 32); }
#pragma unroll
    for (int k = 0; k < 2; ++k) { const float send = hi4 ? r4[k] : r4[k + 2], keep = hi4 ? r4[k + 2] : r4[k]; r2[k] = keep + __shfl_xor(send, 16); }
    { const float send = hi3 ? r2[0] : r2[1], keep = hi3 ? r2[1] : r2[0]; r1 = keep + __shfl_xor(send, 8); }
    r1 += __shfl_xor(r1, 4); r1 += __shfl_xor(r1, 2); r1 += __shfl_xor(r1, 1);
    const float gk = __shfl(gsel, lbase + (lane >> 3));
    const float coef = gk * gelu_fast(r1 * (1.f / U_SCALE)) * (1.f / V_SCALE);
    if ((lane & 7) == 0) cl[grp * 8 + (lane >> 3)] = coef;
}
__device__ __forceinline__ void sweep_u8(const Rows8& G, const uint4 xq, unsigned gsel, float sx, int lbase, int lane, float* cl  , int grp) {
    int d[8];
#pragma unroll
    for (int k = 0; k < 8; ++k) {
        int a = __builtin_amdgcn_sdot4((int)G.r[k].x, (int)xq.x, 0, false);
        a = __builtin_amdgcn_sdot4((int)G.r[k].y, (int)xq.y, a, false);
        a = __builtin_amdgcn_sdot4((int)G.r[k].z, (int)xq.z, a, false);
        d[k] = __builtin_amdgcn_sdot4((int)G.r[k].w, (int)xq.w, a, false);
    }
    const bool hi5 = lane & 32, hi4 = lane & 16, hi3 = lane & 8;
    int r4[4], r2[2], r1;
#pragma unroll
    for (int k = 0; k < 4; ++k) { const int send = hi5 ? d[k] : d[k + 4], keep = hi5 ? d[k + 4] : d[k]; r4[k] = keep + __shfl_xor(send, 32); }
#pragma unroll
    for (int k = 0; k < 2; ++k) { const int send = hi4 ? r4[k] : r4[k + 2], keep = hi4 ? r4[k + 2] : r4[k]; r2[k] = keep + __shfl_xor(send, 16); }
    { const int send = hi3 ? r2[0] : r2[1], keep = hi3 ? r2[1] : r2[0]; r1 = keep + __shfl_xor(send, 8); }
    r1 += __shfl_xor(r1, 4); r1 += __shfl_xor(r1, 2); r1 += __shfl_xor(r1, 1);
    const unsigned gp = (unsigned)__shfl((int)gsel, lbase + (lane >> 3));
    const float gk = __uint_as_float(gp << 16), sk = __uint_as_float(gp & 0xffff0000u);
    const float coef = gk * gelu_fast((float)r1 * (sk * sx)) * (1.f / V_SCALE);
    if ((lane & 7) == 0) cl[grp * 8 + (lane >> 3)] = coef;
}
__device__ __forceinline__ void sweep_v(const Rows8& G, float (&acc)[16], const float* cl, int grp) {
#pragma unroll
    for (int k = 0; k < 8; ++k) {
        const float ck = cl[grp * 8 + k];
        const unsigned w[4] = {G.r[k].x, G.r[k].y, G.r[k].z, G.r[k].w};
        const f32x2_t ck2 = {ck, ck};
#pragma unroll
        for (int q = 0; q < 4; ++q) {
            const f32x2_t lo = __builtin_amdgcn_cvt_pk_f32_fp8((int)w[q], false), hi = __builtin_amdgcn_cvt_pk_f32_fp8((int)w[q], true);
            f32x2_t* ap = (f32x2_t*)&acc[4 * q];
            ap[0] = __builtin_elementwise_fma(ck2, lo, ap[0]);
            ap[1] = __builtin_elementwise_fma(ck2, hi, ap[1]);
        }
    }
}
__device__ __forceinline__ void peer_expert6_phase(float* R, const int* __restrict__ eidx, const float* __restrict__ egate, const unsigned char* __restrict__ ub,
                                                   const unsigned char* __restrict__ vb, const float* __restrict__ lg, const float* __restrict__ lb, bf16_t* Hb, const XcdBarrier& xb, float* lds,
                                                   const float* __restrict__ l1g, const float* __restrict__ l1b) {
    const int wave = __builtin_amdgcn_readfirstlane(tidx() >> 6), lane = tidx() & 63;
    float* cl = lds + wave * 128;
    int itk = 0;
    for (int token = blockIdx.x * 8 + wave; token < NT; token += gridDim.x * 8, ++itk) {
        if (itk) xcc_align(xb);
        float xf[16];
        {
            const float* rp = R + (size_t)token * ND + lane * 16;
#pragma unroll
            for (int q = 0; q < 4; ++q) { const float4 a = *(const float4*)(rp + 4 * q); xf[4 * q] = a.x; xf[4 * q + 1] = a.y; xf[4 * q + 2] = a.z; xf[4 * q + 3] = a.w; }
        }
        {
            float s = 0.f;
#pragma unroll
            for (int j = 0; j < 16; ++j) s += xf[j];
            for (int o = 32; o; o >>= 1) s += __shfl_xor(s, o);
            const float mean = s * (1.f / ND);
            float s2 = 0.f;
#pragma unroll
            for (int j = 0; j < 16; ++j) { xf[j] -= mean; s2 += xf[j] * xf[j]; }
            for (int o = 32; o; o >>= 1) s2 += __shfl_xor(s2, o);
            const float rs = rsqrtf(s2 * (1.f / ND) + LN_EPS);
            int lofs1 = lane * 16;
            asm volatile("" : "+v"(lofs1));
#pragma unroll
            for (int q = 0; q < 4; ++q) {
                const float4 gg = *(const float4*)(l1g + lofs1 + 4 * q), bb = *(const float4*)(l1b + lofs1 + 4 * q);
                xf[4 * q] = xf[4 * q] * rs * gg.x + bb.x; xf[4 * q + 1] = xf[4 * q + 1] * rs * gg.y + bb.y; xf[4 * q + 2] = xf[4 * q + 2] * rs * gg.z + bb.z; xf[4 * q + 3] = xf[4 * q + 3] * rs * gg.w + bb.w;
            }
        }
        int e_lo = eidx[(size_t)token * 128 + lane], e_hi = eidx[(size_t)token * 128 + 64 + lane];
        float g_lo = egate[(size_t)token * 128 + lane], g_hi = egate[(size_t)token * 128 + 64 + lane];
        sort_routing(e_lo, e_hi, g_lo, g_hi, lane);
        Rows8 GA, GB;
        wave_lds_fence();
        rows_load(GA, e_lo, 0, ub, lane);
#pragma unroll 1
        for (int gp = 0; gp < 8; ++gp) {
            const int g0i = 2 * gp, g1i = 2 * gp + 1;
            rows_load(GB, g1i < 8 ? e_lo : e_hi, (g1i & 7) * 8, ub, lane);
            __builtin_amdgcn_sched_barrier(0);
            sweep_u(GA, xf, g0i < 8 ? g_lo : g_hi, (g0i & 7) * 8, lane, cl, g0i);
            __builtin_amdgcn_sched_barrier(0);
            rows_load(GA, gp < 7 ? ((g0i + 2) < 8 ? e_lo : e_hi) : e_lo, gp < 7 ? ((g0i + 2) & 7) * 8 : 0, gp < 7 ? ub : vb, lane);
            __builtin_amdgcn_sched_barrier(0);
            sweep_u(GB, xf, g1i < 8 ? g_lo : g_hi, (g1i & 7) * 8, lane, cl, g1i);
            __builtin_amdgcn_sched_barrier(0);
        }
        wave_lds_fence();
        xcc_align(xb);
        float acc[16];
#pragma unroll
        for (int j = 0; j < 16; ++j) acc[j] = 0.f;
#pragma unroll 1
        for (int gp = 0; gp < 8; ++gp) {
            const int g0i = 2 * gp, g1i = 2 * gp + 1;
            rows_load(GB, g1i < 8 ? e_lo : e_hi, (g1i & 7) * 8, vb, lane);
            __builtin_amdgcn_sched_barrier(0);
            sweep_v(GA, acc, cl, g0i);
            __builtin_amdgcn_sched_barrier(0);
            if (gp < 7) rows_load(GA, (g0i + 2) < 8 ? e_lo : e_hi, ((g0i + 2) & 7) * 8, vb, lane);
            __builtin_amdgcn_sched_barrier(0);
            sweep_v(GB, acc, cl, g1i);
            __builtin_amdgcn_sched_barrier(0);
        }
        float s = 0.f;
#pragma unroll
        for (int j = 0; j < 16; ++j) { xf[j] = ALPHA * xf[j] + acc[j]; s += xf[j]; }
        for (int o = 32; o; o >>= 1) s += __shfl_xor(s, o);
        const float mean = s * (1.f / ND);
        float s2 = 0.f;
#pragma unroll
        for (int j = 0; j < 16; ++j) { xf[j] -= mean; s2 += xf[j] * xf[j]; }
        for (int o = 32; o; o >>= 1) s2 += __shfl_xor(s2, o);
        const float rs = rsqrtf(s2 * (1.f / ND) + LN_EPS);
        float o[16];
        int lofs = lane * 16;
        asm volatile("" : "+v"(lofs));
#pragma unroll
        for (int q = 0; q < 4; ++q) {
            const float4 gg = *(const float4*)(lg + lofs + 4 * q), bb = *(const float4*)(lb + lofs + 4 * q);
            o[4 * q] = xf[4 * q] * rs * gg.x + bb.x; o[4 * q + 1] = xf[4 * q + 1] * rs * gg.y + bb.y; o[4 * q + 2] = xf[4 * q + 2] * rs * gg.z + bb.z; o[4 * q + 3] = xf[4 * q + 3] * rs * gg.w + bb.w;
            *(float4*)(R + (size_t)token * ND + lofs + 4 * q) = make_float4(o[4 * q], o[4 * q + 1], o[4 * q + 2], o[4 * q + 3]);
        }
        if (Hb) { st8(Hb + (size_t)token * ND + lofs, o); st8(Hb + (size_t)token * ND + lofs + 8, o + 8); }
    }
}


__device__ __forceinline__ void load_h_row(const bf16_t* Vb, int token, int lane, const float* __restrict__ l1g, const float* __restrict__ l1b, float (&xf)[16]) {
    ld8(Vb + (size_t)token * ND + lane * 16, xf); ld8(Vb + (size_t)token * ND + lane * 16 + 8, xf + 8);
    float s = 0.f;
#pragma unroll
    for (int j = 0; j < 16; ++j) s += xf[j];
    for (int o = 32; o; o >>= 1) s += __shfl_xor(s, o);
    const float mean = s * (1.f / ND);
    float s2 = 0.f;
#pragma unroll
    for (int j = 0; j < 16; ++j) { xf[j] -= mean; s2 += xf[j] * xf[j]; }
    for (int o = 32; o; o >>= 1) s2 += __shfl_xor(s2, o);
    const float rs = rsqrtf(s2 * (1.f / ND) + LN_EPS);
    int lofs1 = lane * 16;
    asm volatile("" : "+v"(lofs1));
#pragma unroll
    for (int q = 0; q < 4; ++q) {
        const float4 gg = *(const float4*)(l1g + lofs1 + 4 * q), bb = *(const float4*)(l1b + lofs1 + 4 * q);
        xf[4 * q] = xf[4 * q] * rs * gg.x + bb.x; xf[4 * q + 1] = xf[4 * q + 1] * rs * gg.y + bb.y; xf[4 * q + 2] = xf[4 * q + 2] * rs * gg.z + bb.z; xf[4 * q + 3] = xf[4 * q + 3] * rs * gg.w + bb.w;
    }
}
__device__ __forceinline__ void finish_row(float* R, bf16_t* Hb, int token, int lane, float (&xf)[16], const float (&acc)[16], const float* __restrict__ lg, const float* __restrict__ lb) {
    float s = 0.f;
#pragma unroll
    for (int j = 0; j < 16; ++j) { xf[j] = ALPHA * xf[j] + acc[j]; s += xf[j]; }
    for (int o = 32; o; o >>= 1) s += __shfl_xor(s, o);
    const float mean = s * (1.f / ND);
    float s2 = 0.f;
#pragma unroll
    for (int j = 0; j < 16; ++j) { xf[j] -= mean; s2 += xf[j] * xf[j]; }
    for (int o = 32; o; o >>= 1) s2 += __shfl_xor(s2, o);
    const float rs = rsqrtf(s2 * (1.f / ND) + LN_EPS);
    float o[16];
    int lofs = lane * 16;
    asm volatile("" : "+v"(lofs));
#pragma unroll
    for (int q = 0; q < 4; ++q) {
        const float4 gg = *(const float4*)(lg + lofs + 4 * q), bb = *(const float4*)(lb + lofs + 4 * q);
        o[4 * q] = xf[4 * q] * rs * gg.x + bb.x; o[4 * q + 1] = xf[4 * q + 1] * rs * gg.y + bb.y; o[4 * q + 2] = xf[4 * q + 2] * rs * gg.z + bb.z; o[4 * q + 3] = xf[4 * q + 3] * rs * gg.w + bb.w;
        if (R) *(float4*)(R + (size_t)token * ND + lofs + 4 * q) = make_float4(o[4 * q], o[4 * q + 1], o[4 * q + 2], o[4 * q + 3]);
    }
    if (Hb) { st8(Hb + (size_t)token * ND + lofs, o); st8(Hb + (size_t)token * ND + lofs + 8, o + 8); }
}
__device__ __forceinline__ void peer_expert10_phase(float* R, const bf16_t* Vin, const int* __restrict__ eidx, const float* __restrict__ egate, const unsigned char* __restrict__ ub,
                                                    const unsigned char* __restrict__ vb, const float* __restrict__ lg, const float* __restrict__ lb, bf16_t* Hb, const XcdBarrier& xb, float* lds,
                                                    const float* __restrict__ l1g, const float* __restrict__ l1b, const float* __restrict__ su) {
    if (__builtin_amdgcn_readfirstlane(tidx() >> 6) >= 4) __builtin_amdgcn_s_setprio(1);
    const int wave = __builtin_amdgcn_readfirstlane(tidx() >> 6), lane = tidx() & 63;
    float* cl = lds + wave * 512;
    float* xs = lds + 4096 + wave * 4096;
    const int stride = gridDim.x * 8;
    int itk = 0;
    for (int tok0 = blockIdx.x * 8 + wave; tok0 < NT; tok0 += 4 * stride, ++itk) {
        if (itk) xcc_align(xb);
        int elo[4], ehi[4]; unsigned glo[4], ghi[4]; float sx[4];
        wave_lds_fence();
#pragma unroll
        for (int t = 0; t < 4; ++t) {
            const int tok = tok0 + t * stride;
            {
                float xr[16]; load_h_row(Vin, tok, lane, l1g, l1b, xr);
                float m = 0.f;
#pragma unroll
                for (int j = 0; j < 16; ++j) m = fmaxf(m, fabsf(xr[j]));
                for (int o = 32; o; o >>= 1) m = fmaxf(m, __shfl_xor(m, o));
                const float inv = m > 0.f ? 127.f / m : 0.f;
                sx[t] = m * (1.f / 127.f);
                uint4 w; unsigned* wp = (unsigned*)&w;
#pragma unroll
                for (int q = 0; q < 4; ++q) {
                    const int b0 = (int)rintf(xr[4 * q] * inv), b1 = (int)rintf(xr[4 * q + 1] * inv), b2 = (int)rintf(xr[4 * q + 2] * inv), b3 = (int)rintf(xr[4 * q + 3] * inv);
                    wp[q] = (unsigned)(b0 & 255) | ((unsigned)(b1 & 255) << 8) | ((unsigned)(b2 & 255) << 16) | ((unsigned)b3 << 24);
                }
                *(uint4*)((unsigned char*)(xs + t * 1024) + lane * 16) = w;
            }
            unsigned p0 = ((unsigned)eidx[(size_t)tok * 128 + lane] << 16) | (unsigned)f2bf(egate[(size_t)tok * 128 + lane]);
            unsigned p1 = ((unsigned)eidx[(size_t)tok * 128 + 64 + lane] << 16) | (unsigned)f2bf(egate[(size_t)tok * 128 + 64 + lane]);
            sort_routing_packed(p0, p1, lane);
            elo[t] = (int)(p0 >> 16); ehi[t] = (int)(p1 >> 16);
            glo[t] = (p0 & 0xffffu) | ((unsigned)f2bf(su[elo[t]]) << 16); ghi[t] = (p1 & 0xffffu) | ((unsigned)f2bf(su[ehi[t]]) << 16);
        }
        Rows8 GA, GB;
        wave_lds_fence();
        rows_load(GA, elo[0], 0, ub, lane);
#pragma unroll 1
        for (int g = 0; g < 16; ++g) {
            const int lb8 = (g & 7) * 8; const bool lo = g < 8;
            rows_load(GB, lo ? elo[1] : ehi[1], lb8, ub, lane);
            __builtin_amdgcn_sched_barrier(0);
            sweep_u8(GA, *(const uint4*)((const unsigned char*)(xs + 0 * 1024) + lane * 16), lo ? glo[0] : ghi[0], sx[0], lb8, lane, cl, g);
            __builtin_amdgcn_sched_barrier(0);
            rows_load(GA, lo ? elo[2] : ehi[2], lb8, ub, lane);
            __builtin_amdgcn_sched_barrier(0);
            sweep_u8(GB, *(const uint4*)((const unsigned char*)(xs + 1 * 1024) + lane * 16), lo ? glo[1] : ghi[1], sx[1], lb8, lane, cl + 128, g);
            __builtin_amdgcn_sched_barrier(0);
            rows_load(GB, lo ? elo[3] : ehi[3], lb8, ub, lane);
            __builtin_amdgcn_sched_barrier(0);
            sweep_u8(GA, *(const uint4*)((const unsigned char*)(xs + 2 * 1024) + lane * 16), lo ? glo[2] : ghi[2], sx[2], lb8, lane, cl + 256, g);
            __builtin_amdgcn_sched_barrier(0);
            if (g < 15) rows_load(GA, (g + 1) < 8 ? elo[0] : ehi[0], ((g + 1) & 7) * 8, ub, lane);
            else rows_load(GA, elo[0], 0, vb, lane);
            __builtin_amdgcn_sched_barrier(0);
            sweep_u8(GB, *(const uint4*)((const unsigned char*)(xs + 3 * 1024) + lane * 16), lo ? glo[3] : ghi[3], sx[3], lb8, lane, cl + 384, g);
            __builtin_amdgcn_sched_barrier(0);
        }
        wave_lds_fence();
        xcc_align(xb);
#pragma unroll
        for (int t = 0; t < 4; ++t)
#pragma unroll
            for (int q = 0; q < 4; ++q) *(float4*)(xs + t * 1024 + q * 256 + lane * 4) = make_float4(0.f, 0.f, 0.f, 0.f);
#pragma unroll 1
        for (int g = 0; g < 16; ++g) {
            const int lb8 = (g & 7) * 8; const bool lo = g < 8;
            rows_load(GB, lo ? elo[1] : ehi[1], lb8, vb, lane);
            __builtin_amdgcn_sched_barrier(0);
            { float av[16];
#pragma unroll
              for (int q = 0; q < 4; ++q) { const float4 v4 = *(const float4*)(xs + 0 * 1024 + q * 256 + lane * 4); av[4 * q] = v4.x; av[4 * q + 1] = v4.y; av[4 * q + 2] = v4.z; av[4 * q + 3] = v4.w; }
              sweep_v(GA, av, cl, g);
#pragma unroll
              for (int q = 0; q < 4; ++q) *(float4*)(xs + 0 * 1024 + q * 256 + lane * 4) = make_float4(av[4 * q], av[4 * q + 1], av[4 * q + 2], av[4 * q + 3]); }
            __builtin_amdgcn_sched_barrier(0);
            rows_load(GA, lo ? elo[2] : ehi[2], lb8, vb, lane);
            __builtin_amdgcn_sched_barrier(0);
            { float av[16];
#pragma unroll
              for (int q = 0; q < 4; ++q) { const float4 v4 = *(const float4*)(xs + 1 * 1024 + q * 256 + lane * 4); av[4 * q] = v4.x; av[4 * q + 1] = v4.y; av[4 * q + 2] = v4.z; av[4 * q + 3] = v4.w; }
              sweep_v(GB, av, cl + 128, g);
#pragma unroll
              for (int q = 0; q < 4; ++q) *(float4*)(xs + 1 * 1024 + q * 256 + lane * 4) = make_float4(av[4 * q], av[4 * q + 1], av[4 * q + 2], av[4 * q + 3]); }
            __builtin_amdgcn_sched_barrier(0);
            rows_load(GB, lo ? elo[3] : ehi[3], lb8, vb, lane);
            __builtin_amdgcn_sched_barrier(0);
            { float av[16];
#pragma unroll
              for (int q = 0; q < 4; ++q) { const float4 v4 = *(const float4*)(xs + 2 * 1024 + q * 256 + lane * 4); av[4 * q] = v4.x; av[4 * q + 1] = v4.y; av[4 * q + 2] = v4.z; av[4 * q + 3] = v4.w; }
              sweep_v(GA, av, cl + 256, g);
#pragma unroll
              for (int q = 0; q < 4; ++q) *(float4*)(xs + 2 * 1024 + q * 256 + lane * 4) = make_float4(av[4 * q], av[4 * q + 1], av[4 * q + 2], av[4 * q + 3]); }
            __builtin_amdgcn_sched_barrier(0);
            if (g < 15) rows_load(GA, (g + 1) < 8 ? elo[0] : ehi[0], ((g + 1) & 7) * 8, vb, lane);
            __builtin_amdgcn_sched_barrier(0);
            { float av[16];
#pragma unroll
              for (int q = 0; q < 4; ++q) { const float4 v4 = *(const float4*)(xs + 3 * 1024 + q * 256 + lane * 4); av[4 * q] = v4.x; av[4 * q + 1] = v4.y; av[4 * q + 2] = v4.z; av[4 * q + 3] = v4.w; }
              sweep_v(GB, av, cl + 384, g);
#pragma unroll
              for (int q = 0; q < 4; ++q) *(float4*)(xs + 3 * 1024 + q * 256 + lane * 4) = make_float4(av[4 * q], av[4 * q + 1], av[4 * q + 2], av[4 * q + 3]); }
            __builtin_amdgcn_sched_barrier(0);
        }
#pragma unroll
        for (int t = 0; t < 4; ++t) {
            const int tok = tok0 + t * stride;
            float xr[16], av[16];
#pragma unroll
            for (int q = 0; q < 4; ++q) { const float4 v4 = *(const float4*)(xs + t * 1024 + q * 256 + lane * 4); av[4 * q] = v4.x; av[4 * q + 1] = v4.y; av[4 * q + 2] = v4.z; av[4 * q + 3] = v4.w; }
            load_h_row(Vin, tok, lane, l1g, l1b, xr);
            finish_row(R, Hb, tok, lane, xr, av, lg, lb);
            __builtin_amdgcn_sched_barrier(0);
        }
    }
    __builtin_amdgcn_s_setprio(0);
}

__device__ __forceinline__ void nsa_compress_phase(const bf16_t* __restrict__ proj, int coloff, const float* __restrict__ pe, const float* __restrict__ w1,
                                   const float* __restrict__ w2, float* __restrict__ outc, float* lds) {
    const int qtr = tidx() >> 7, tid = tidx() & 127;
    float* in = lds + qtr * 2176;
    float* hid = in + 2048;
    for (int it = blockIdx.x; it < NB * 127; it += gridDim.x) {
        const int g = qtr, n = it % 127, b = it / 127;
        __syncthreads();
        for (int idx = tid; idx < 2048; idx += 128) {
            const int l = idx >> 6, d = idx & 63;
            in[idx] = bf2f(proj[(size_t)(b * NL + 16 * n + l) * ODD_PAD + coloff + g * 64 + d]) + pe[l * 64 + d];
        }
        __syncthreads();
        float a = 0.f;
        for (int i = 0; i < 2048; ++i) a += in[i] * w1[(size_t)i * 128 + tid];
        hid[tid] = gelu_tanh(a);
        __syncthreads();
        if (tid < 64) {
            float o = 0.f;
            for (int j = 0; j < 128; ++j) o += hid[j] * w2[j * 64 + tid];
            outc[((size_t)(b * 127 + n) * 4 + g) * 64 + tid] = o;
        }
    }
    __syncthreads();
}

__device__ __forceinline__ void nsa_cmp_phase(const bf16_t* __restrict__ proj, const float* __restrict__ kcmp, const float* __restrict__ vcmp,
                              bf16_t* __restrict__ O, unsigned* __restrict__ selmask, float* lds) {
    const int half = tidx() >> 8, tid = tidx() & 255;
    float* kc_s = lds + half * 18368;
    float* vc_s = kc_s + 127 * 64;
    float(*imp_s)[33] = (float(*)[33])(vc_s + 127 * 64);
    const int tk = tid >> 2, r = tid & 3;
    for (int it = blockIdx.x; it < 32 * 4 * NB / 2; it += gridDim.x) {
        const int vb = it * 2 + half;
        const int tile = vb & 31, g = (vb >> 5) & 3, b = vb >> 7;
        const int t = tile * 64 + tk, hd = g * 4 + r;
        __syncthreads();
        for (int idx = tid; idx < 127 * 64; idx += 256) { const int n = idx >> 6, d = idx & 63; kc_s[idx] = kcmp[((size_t)(b * 127 + n) * 4 + g) * 64 + d]; vc_s[idx] = vcmp[((size_t)(b * 127 + n) * 4 + g) * 64 + d]; }
        const bf16_t* prow = proj + (size_t)(b * NL + t) * ODD_PAD;
        float q[64];
#pragma unroll
        for (int d = 0; d < 64; d += 8) ld8(prow + hd * 64 + d, q + d);
        const float slope = exp2f(-0.5f * (float)(hd + 1));
        int nvalid = (t >= 31) ? ((t - 31) / 16 + 1) : 0;
        if (nvalid > 127) nvalid = 127;
        __syncthreads();
        float m = -INFINITY, l = 0.f;
        for (int n = 0; n < nvalid; ++n) {
            float s = 0.f;
#pragma unroll
            for (int d = 0; d < 64; ++d) s += q[d] * kc_s[n * 64 + d];
            s = s * 0.125f - slope * (float)(t - (16 * n + 31));
            const float mn = fmaxf(m, s);
            l = l * expf(m - mn) + expf(s - mn);
            m = mn;
        }
        const float inv_l = (nvalid > 0) ? 1.f / fmaxf(l, 1e-30f) : 0.f;
        float acc[64];
#pragma unroll
        for (int d = 0; d < 64; ++d) acc[d] = 0.f;
        float prev3 = 0.f;
        for (int j = 0; j < 32; ++j) {
            float pj[4];
#pragma unroll
            for (int nn = 0; nn < 4; ++nn) {
                const int n = 4 * j + nn;
                float p = 0.f;
                if (n < nvalid) {
                    float s = 0.f;
#pragma unroll
                    for (int d = 0; d < 64; ++d) s += q[d] * kc_s[n * 64 + d];
                    s = s * 0.125f - slope * (float)(t - (16 * n + 31));
                    p = expf(s - m) * inv_l;
                    const float* vr = vc_s + n * 64;
#pragma unroll
                    for (int d = 0; d < 64; ++d) acc[d] += p * vr[d];
                }
                pj[nn] = p;
            }
            float im = 0.5f * prev3 + pj[0] + pj[1] + pj[2] + 0.5f * pj[3];
            prev3 = pj[3];
            im += __shfl_xor(im, 1);
            im += __shfl_xor(im, 2);
            if (r == 0) imp_s[tk][j] = im;
        }
        const float g0 = sigmoidf_(bf2f(prow[2048 + hd]));
#pragma unroll
        for (int d = 0; d < 64; ++d) acc[d] *= g0;
#pragma unroll
        for (int d = 0; d < 64; d += 8) st8(O + (size_t)(b * NL + t) * ND + hd * 64 + d, acc + d);
        __syncthreads();
        const int cur = tile;
        unsigned bits = 0;
        for (int jj = 0; jj < 8; ++jj) {
            const int j = r * 8 + jj;
            const bool fj = (j == 0) || (j == cur) || (j == cur - 1);
            const float vj = (j <= cur) ? imp_s[tk][j] + (fj ? 1000.f : 0.f) : -INFINITY;
            int rank = 0;
            for (int k = 0; k < 32; ++k) {
                const bool fk = (k == 0) || (k == cur) || (k == cur - 1);
                const float vk = (k <= cur) ? imp_s[tk][k] + (fk ? 1000.f : 0.f) : -INFINITY;
                rank += (vk > vj || (vk == vj && k < j)) ? 1 : 0;
            }
            if (rank < 16) bits |= 1u << j;
        }
        bits |= __shfl_xor(bits, 1);
        bits |= __shfl_xor(bits, 2);
        if (r == 0) selmask[(size_t)(b * 4 + g) * NL + t] = bits;
    }
    __syncthreads();
}

__device__ __forceinline__ void nsa_selwin_phase(const bf16_t* __restrict__ proj, const unsigned* __restrict__ selmask, bf16_t* O, float* lds) {
    const int half = tidx() >> 8, tid = tidx() & 255;
    float(*k_s)[64] = (float(*)[64])(lds + half * 8192);
    float(*v_s)[64] = (float(*)[64])(lds + half * 8192 + 4096);
    const int tk = tid >> 2, r = tid & 3;
    for (int it = blockIdx.x; it < 32 * 32; it += gridDim.x) {
        const int tile = 31 - (it >> 5);
        const int bgi = (it & 31) * 2 + half, g = bgi & 3, b = bgi >> 2;
        const int t = tile * 64 + tk, hd = g * 4 + r;
        const bf16_t* pb = proj + (size_t)b * NL * ODD_PAD;
        const bf16_t* prow = pb + (size_t)t * ODD_PAD;
        float q[64], acc[64];
#pragma unroll
        for (int d = 0; d < 64; d += 8) ld8(prow + hd * 64 + d, q + d);
        const float slope = exp2f(-0.5f * (float)(hd + 1));
        const unsigned mask = selmask[(size_t)(b * 4 + g) * NL + t];
        bf16_t* orow = O + (size_t)(b * NL + t) * ND + hd * 64;
        for (int branch = 0; branch < 2; ++branch) {
            const int kcol = (branch == 0 ? 1536 : 2048) + g * 64, vcol = kcol + 256;
            const int j0 = (branch == 0) ? 0 : (tile >= 8 ? tile - 8 : 0);
            float m = -1e30f, l = 0.f;
#pragma unroll
            for (int d = 0; d < 64; ++d) acc[d] = 0.f;
            for (int j = j0; j <= tile; ++j) {
                __syncthreads();
                for (int i = 0; i < 16; ++i) {
                    const int idx = tid + 256 * i, key = idx >> 6, d = idx & 63;
                    k_s[key][d] = bf2f(pb[(size_t)(64 * j + key) * ODD_PAD + kcol + d]);
                    v_s[key][d] = bf2f(pb[(size_t)(64 * j + key) * ODD_PAD + vcol + d]);
                }
                __syncthreads();
                const bool take = (branch == 0) ? ((mask >> j) & 1u) : true;
                if (take) {
                    for (int s = 0; s < 64; ++s) {
                        const int dist = t - (64 * j + s);
                        const bool valid = (branch == 0) ? (dist >= 0) : (dist >= 0 && dist < 512);
                        float sc = 0.f;
#pragma unroll
                        for (int d = 0; d < 64; ++d) sc += q[d] * k_s[s][d];
                        sc = sc * 0.125f - slope * (float)dist;
                        const float mn = valid ? fmaxf(m, sc) : m;
                        const float scale = expf(m - mn);
                        const float p = valid ? expf(sc - mn) : 0.f;
                        l = l * scale + p;
#pragma unroll
                        for (int d = 0; d < 64; ++d) acc[d] = acc[d] * scale + p * v_s[s][d];
                        m = mn;
                    }
                }
            }
            const float gt = sigmoidf_(bf2f(prow[2560 + (branch + 1) * 16 + hd]));
            const float f = gt / fmaxf(l, 1e-30f);
#pragma unroll
            for (int d = 0; d < 64; d += 8) {
                float o[8];
                ld8(orow + d, o);
#pragma unroll
                for (int j = 0; j < 8; ++j) o[j] += f * acc[d + j];
                st8(orow + d, o);
            }
        }
    }
    __syncthreads();
}


typedef float f32x16 __attribute__((ext_vector_type(16)));
#define MFMA32(a, b, c) __builtin_amdgcn_mfma_f32_32x32x16_bf16((a), (b), (c), 0, 0, 0)
__device__ __forceinline__ unsigned cvtpk(float lo, float hi) { const f32x2_t f = {lo, hi}; return __builtin_bit_cast(unsigned, __builtin_convertvector(f, bf16x2_t)); }
__device__ __forceinline__ int crow32(int reg, int h) { return (reg & 3) + 8 * (reg >> 2) + 4 * h; }
constexpr float LOG2E = 1.4426950408889634f;
__device__ __forceinline__ void nsa_attn_phase(const bf16_t* __restrict__ proj, const bf16_t* __restrict__ vt, const unsigned* __restrict__ selmask, bf16_t* O, unsigned char* lds) {
    if (__builtin_amdgcn_readfirstlane(tidx() >> 6) >= 4) __builtin_amdgcn_s_setprio(1);
    const int tid = tidx(), wave = __builtin_amdgcn_readfirstlane(tid >> 6), lane = tid & 63, l31 = lane & 31, h = lane >> 5;
    const int r = wave & 3, thalf = wave >> 2;
    const int skey = tid >> 3, spart = tid & 7;
    uint4 kreg = make_uint4(0u, 0u, 0u, 0u), vreg = kreg; bool have_first = false;
    for (int it = blockIdx.x; it < 32 * 64; it += gridDim.x) {
        const int tile = 31 - (it >> 6), bg = it & 63, g = bg & 3, b = bg >> 2;
        const int hd = g * 4 + r, tokoff = thalf * 32 + l31, tok = tile * 64 + tokoff;
        const size_t trow = (size_t)(b * NL + tok);
        const float slope = exp2f(-0.5f * (float)(hd + 1)) * LOG2E;
        bf16x8_t Qf[4];
#pragma unroll
        for (int ds = 0; ds < 4; ++ds) {
            float q[8];
            ld8(proj + trow * ODD_PAD + hd * 64 + 16 * ds + 8 * h, q);
            const float qs = 0.125f * LOG2E;
            u32x4 w; w.x = cvtpk(q[0] * qs, q[1] * qs); w.y = cvtpk(q[2] * qs, q[3] * qs); w.z = cvtpk(q[4] * qs, q[5] * qs); w.w = cvtpk(q[6] * qs, q[7] * qs);
            Qf[ds] = __builtin_bit_cast(bf16x8_t, w);
        }
        float sc[16];
#pragma unroll
        for (int reg = 0; reg < 16; ++reg) sc[reg] = slope * (float)crow32(reg, h);
        const unsigned mymask = selmask[(size_t)(b * 4 + g) * NL + tok];
        unsigned um = selmask[(size_t)(b * 4 + g) * NL + tile * 64 + lane];
        um |= sort_partner<1>(um, lane); um |= sort_partner<2>(um, lane); um |= sort_partner<4>(um, lane); um |= sort_partner<8>(um, lane); um |= sort_partner<16>(um, lane); um |= sort_partner<32>(um, lane);
        const unsigned causal = (tile == 31) ? 0xffffffffu : ((2u << tile) - 1u);
        const unsigned U = (unsigned)__builtin_amdgcn_readfirstlane((int)um) & causal;
        float outv[32];
#pragma unroll
        for (int i = 0; i < 32; ++i) outv[i] = 0.f;
#pragma unroll 1
        for (int branch = 0; branch < 2; ++branch) {
            unsigned todo = (branch == 0) ? U : (causal & ~((1u << (tile >= 8 ? tile - 8 : 0)) - 1u));
            const bf16_t* kbase = proj + (size_t)b * NL * ODD_PAD + (branch == 0 ? 1536 : 1792) + g * 64 + (size_t)skey * ODD_PAD + 8 * spart;
            const bf16_t* vbase = vt + (size_t)(branch * 256 + g * 64 + skey) * NT + (size_t)b * NL + 8 * spart;
            float m_run = -1e30f, l_run = 0.f;
            f32x16 Oa[2];
#pragma unroll
            for (int i = 0; i < 16; ++i) { Oa[0][i] = 0.f; Oa[1][i] = 0.f; }
            int jcur = __ffs(todo) - 1; todo &= todo - 1;
            if (!have_first || jcur != (branch == 0 ? 0 : (tile >= 8 ? tile - 8 : 0))) { kreg = *(const uint4*)(kbase + (size_t)(64 * jcur) * ODD_PAD); vreg = *(const uint4*)(vbase + 64 * jcur); }
            have_first = true;
            int buf = 0;
            __syncthreads();
            *(uint4*)(lds + skey * 144 + spart * 16) = kreg;
            *(uint2*)(lds + 18432 + skey * 136 + spart * 16) = make_uint2(vreg.x, vreg.y);
            *(uint2*)(lds + 18432 + skey * 136 + spart * 16 + 8) = make_uint2(vreg.z, vreg.w);
            __syncthreads();
            for (;;) {
                const int jnext = todo ? (__ffs(todo) - 1) : -1;
                todo &= todo - 1;
                {
                    const int nb = jnext >= 0 ? branch : 1 - branch;
                    const int jl = jnext >= 0 ? jnext : (branch == 0 ? (tile >= 8 ? tile - 8 : 0) : 0);
                    const bf16_t* kb2 = proj + (size_t)b * NL * ODD_PAD + (nb == 0 ? 1536 : 1792) + g * 64 + (size_t)skey * ODD_PAD + 8 * spart;
                    const bf16_t* vb2 = vt + (size_t)(nb * 256 + g * 64 + skey) * NT + (size_t)b * NL + 8 * spart;
                    kreg = *(const uint4*)(kb2 + (size_t)(64 * jl) * ODD_PAD); vreg = *(const uint4*)(vb2 + 64 * jl);
                }
                const unsigned char* Ks = lds + buf * 9216;
                const unsigned char* Vs = lds + 18432 + buf * 8704;
                const bool mysel = (branch == 1) || ((mymask >> jcur) & 1u);
                if (__any(mysel)) {
                    const bool diag = (jcur == tile), wedge = (branch == 1) && (jcur == tile - 8);
                    const float init = mysel ? slope * (float)(64 * (jcur - tile)) : -1e30f;
                    float sv[32];
#pragma unroll
                    for (int kt = 0; kt < 2; ++kt) {
                        f32x16 acc;
                        const float i0 = init + slope * (float)(32 * kt);
#pragma unroll
                        for (int i = 0; i < 16; ++i) acc[i] = sc[i] + i0;
#pragma unroll
                        for (int ds = 0; ds < 4; ++ds) {
                            const bf16x8_t a = *(const bf16x8_t*)(Ks + (32 * kt + l31) * 144 + (16 * ds + 8 * h) * 2);
                            acc = MFMA32(a, Qf[ds], acc);
                        }
#pragma unroll
                        for (int reg = 0; reg < 16; ++reg) sv[kt * 16 + reg] = acc[reg];
                    }
                    if (diag || wedge) {
#pragma unroll
                        for (int i = 0; i < 32; ++i) {
                            const int keyoff = 32 * (i >> 4) + crow32(i & 15, h);
                            const bool ok = diag ? (keyoff <= tokoff) : (keyoff > tokoff);
                            sv[i] = ok ? sv[i] : -1e30f;
                        }
                    }
                    float mx = sv[0];
#pragma unroll
                    for (int i = 1; i < 32; ++i) mx = fmaxf(mx, sv[i]);
                    mx = fmaxf(mx, __shfl_xor(mx, 32));
                    if (!__all(mx < m_run - 160.f)) {
                    const float m_new = fmaxf(m_run, mx), m_use = fmaxf(m_new, -1e29f);
                    const float alpha = __builtin_amdgcn_exp2f(m_run - m_use);
                    const f32x2_t nm = {-m_use, -m_use};
                    f32x2_t ps2 = {0.f, 0.f};
#pragma unroll
                    for (int i = 0; i < 16; ++i) {
                        const f32x2_t t = (f32x2_t){sv[2 * i], sv[2 * i + 1]} + nm;
                        const f32x2_t p2 = {__builtin_amdgcn_exp2f(t.x), __builtin_amdgcn_exp2f(t.y)};
                        sv[2 * i] = p2.x; sv[2 * i + 1] = p2.y; ps2 += p2;
                    }
                    l_run = l_run * alpha + (ps2.x + ps2.y); m_run = m_new;
#pragma unroll
                    for (int i = 0; i < 16; ++i) { Oa[0][i] *= alpha; Oa[1][i] *= alpha; }
                    bf16x8_t Pf[4];
#pragma unroll
                    for (int ks = 0; ks < 4; ++ks) {
                        u32x4 w; w.x = cvtpk(sv[ks * 8 + 0], sv[ks * 8 + 1]); w.y = cvtpk(sv[ks * 8 + 2], sv[ks * 8 + 3]); w.z = cvtpk(sv[ks * 8 + 4], sv[ks * 8 + 5]); w.w = cvtpk(sv[ks * 8 + 6], sv[ks * 8 + 7]);
                        Pf[ks] = __builtin_bit_cast(bf16x8_t, w);
                    }
#pragma unroll
                    for (int mt = 0; mt < 2; ++mt)
#pragma unroll
                        for (int ks = 0; ks < 4; ++ks) {
                            const unsigned char* vp = Vs + (32 * mt + l31) * 136 + (16 * ks + 4 * h) * 2;
                            const uint2 lo = *(const uint2*)vp, hi = *(const uint2*)(vp + 16);
                            u32x4 w; w.x = lo.x; w.y = lo.y; w.z = hi.x; w.w = hi.y;
                            Oa[mt] = MFMA32(__builtin_bit_cast(bf16x8_t, w), Pf[ks], Oa[mt]);
                        }
                    }
                }
                if (jnext < 0) break;
                *(uint4*)(lds + (buf ^ 1) * 9216 + skey * 144 + spart * 16) = kreg;
                *(uint2*)(lds + 18432 + (buf ^ 1) * 8704 + skey * 136 + spart * 16) = make_uint2(vreg.x, vreg.y);
                *(uint2*)(lds + 18432 + (buf ^ 1) * 8704 + skey * 136 + spart * 16 + 8) = make_uint2(vreg.z, vreg.w);
                __syncthreads();
                buf ^= 1; jcur = jnext;
            }
            const float l_tot = l_run + __shfl_xor(l_run, 32);
            const float gt = sigmoidf_(bf2f(proj[trow * ODD_PAD + 2048 + (branch + 1) * 16 + hd]));
            const float f = gt / fmaxf(l_tot, 1e-30f);
#pragma unroll
            for (int i = 0; i < 16; ++i) { outv[i] += f * Oa[0][i]; outv[16 + i] += f * Oa[1][i]; }
        }
        bf16_t* orow = O + trow * ND + hd * 64;
#pragma unroll
        for (int mt = 0; mt < 2; ++mt)
#pragma unroll
            for (int q4 = 0; q4 < 4; ++q4) {
                bf16_t* op = orow + 32 * mt + 8 * q4 + 4 * h;
                const uint2 old = *(const uint2*)op;
                const float o0 = __uint_as_float(old.x << 16) + outv[mt * 16 + q4 * 4 + 0], o1 = __uint_as_float(old.x & 0xffff0000u) + outv[mt * 16 + q4 * 4 + 1];
                const float o2 = __uint_as_float(old.y << 16) + outv[mt * 16 + q4 * 4 + 2], o3 = __uint_as_float(old.y & 0xffff0000u) + outv[mt * 16 + q4 * 4 + 3];
                *(uint2*)op = make_uint2(cvtpk(o0, o1), cvtpk(o2, o3));
            }
    }
    __syncthreads();
    __builtin_amdgcn_s_setprio(0);
}

__device__ __forceinline__ void nsa_fused_phase(const bf16_t* __restrict__ proj, const bf16_t* __restrict__ kcmp, const bf16_t* __restrict__ vcmpT, const bf16_t* __restrict__ vt, bf16_t* O, unsigned char* lds) {
    if (__builtin_amdgcn_readfirstlane(tidx() >> 6) >= 4) __builtin_amdgcn_s_setprio(1);
    const int wave = __builtin_amdgcn_readfirstlane(tidx() >> 6), r = wave & 3, thalf = wave >> 2;
    unsigned char* Kc = lds;
    unsigned char* Vc = lds + 18432;
    float* impS = (float*)(lds + 35328);
    float* invS = (float*)(lds + 35328 + 33792);
    float* impT = (float*)(lds + 35328 + 33792 + 1024);
    int staged_bg = -1;
    unsigned char* ldsn = lds + 79872;
    unsigned* selS = (unsigned*)(lds + 79872 + 36864);
    for (int it = blockIdx.x; it < 32 * 64; it += gridDim.x) {
        float outv[32];
        {
        const int tid = tidx(), lane = tid & 63, l31 = lane & 31, h = lane >> 5;
        const int tile = 31 - (it >> 6), bg = it & 63, g = bg & 3, b = bg >> 2;
        const int hd = g * 4 + r, tokoff = thalf * 32 + l31, tok = tile * 64 + tokoff;
        const size_t trow = (size_t)(b * NL + tok);
        const float slope = exp2f(-0.5f * (float)(hd + 1));
        __syncthreads();
        if (bg != staged_bg) {
        staged_bg = bg;
#pragma unroll
        for (int i = 0; i < 2; ++i) {
            const int pc = tid + 512 * i;
            { const int row = pc >> 3, c = pc & 7; *(uint4*)(Kc + row * 144 + c * 16) = *(const uint4*)(kcmp + ((size_t)(b * 4 + g) * 128 + row) * 64 + 8 * c); }
            { const int row = pc >> 4, c = pc & 15; const uint4 v = *(const uint4*)(vcmpT + (((size_t)(b * 4 + g) * 8 + (c >> 1)) * 64 + row) * 16 + (c & 1) * 8);
              *(uint2*)(Vc + row * 264 + c * 16) = make_uint2(v.x, v.y); *(uint2*)(Vc + row * 264 + c * 16 + 8) = make_uint2(v.z, v.w); }
        }
        }
        bf16x8_t Qf[4];
#pragma unroll
        for (int ds = 0; ds < 4; ++ds) {
            float q[8];
            ld8(proj + trow * ODD_PAD + hd * 64 + 16 * ds + 8 * h, q);
            u32x4 w; w.x = cvtpk(q[0] * 0.125f, q[1] * 0.125f); w.y = cvtpk(q[2] * 0.125f, q[3] * 0.125f); w.z = cvtpk(q[4] * 0.125f, q[5] * 0.125f); w.w = cvtpk(q[6] * 0.125f, q[7] * 0.125f);
            Qf[ds] = __builtin_bit_cast(bf16x8_t, w);
        }
        int nvalid = (tok >= 31) ? ((tok - 31) / 16 + 1) : 0;
        nvalid = nvalid > 127 ? 127 : nvalid;
        const int nv_max = (4 * tile + 3) > 127 ? 127 : (4 * tile + 3);
        const int kt_end = (nv_max + 31) >> 5;
        __syncthreads();
        float mx = -1e30f;
#pragma unroll 2
        for (int kt = 0; kt < kt_end; ++kt) {
            f32x16 acc;
            const float i0 = slope * (float)(512 * kt);
#pragma unroll
            for (int i = 0; i < 16; ++i) acc[i] = i0;
#pragma unroll
            for (int ds = 0; ds < 4; ++ds) {
                const bf16x8_t a = *(const bf16x8_t*)(Kc + (32 * kt + l31) * 144 + (16 * ds + 8 * h) * 2);
                acc = MFMA32(a, Qf[ds], acc);
            }
#pragma unroll
            for (int reg = 0; reg < 16; ++reg) {
                const int n = 32 * kt + crow32(reg, h);
                const float sval = acc[reg] + slope * (float)(16 * crow32(reg, h));
                mx = fmaxf(mx, (n < nvalid) ? sval : -1e30f);
            }
        }
        mx = fmaxf(mx, __shfl_xor(mx, 32));
        const float moff = -fmaxf(mx, -1e29f) * LOG2E;
        float psum = 0.f, prev_pe = 0.f;
        f32x16 Oa[2];
#pragma unroll
        for (int i = 0; i < 16; ++i) { Oa[0][i] = 0.f; Oa[1][i] = 0.f; }
#pragma unroll 2
        for (int kt = 0; kt < kt_end; ++kt) {
            f32x16 acc;
            const float i0 = slope * (float)(512 * kt);
#pragma unroll
            for (int i = 0; i < 16; ++i) acc[i] = i0;
#pragma unroll
            for (int ds = 0; ds < 4; ++ds) {
                const bf16x8_t a = *(const bf16x8_t*)(Kc + (32 * kt + l31) * 144 + (16 * ds + 8 * h) * 2);
                acc = MFMA32(a, Qf[ds], acc);
            }
            float sv[16];
#pragma unroll
            for (int reg = 0; reg < 16; ++reg) {
                const int n = 32 * kt + crow32(reg, h);
                const float sval = acc[reg] + slope * (float)(16 * crow32(reg, h));
                sv[reg] = __builtin_amdgcn_exp2f(fmaf((n < nvalid) ? sval : -1e30f, LOG2E, moff));
                psum += sv[reg];
            }
#pragma unroll
            for (int q = 0; q < 4; ++q) {
                const float e = 0.5f * sv[q * 4 + 3];
                const float own = sv[q * 4] + sv[q * 4 + 1] + sv[q * 4 + 2] + e;
                const float pe = __shfl_xor(e, 32);
                impS[(r * 64 + tokoff) * 33 + 8 * kt + 2 * q + h] = own + (h ? pe : prev_pe);
                prev_pe = pe;
            }
#pragma unroll
            for (int s2 = 0; s2 < 2; ++s2) {
                u32x4 w; w.x = cvtpk(sv[s2 * 8 + 0], sv[s2 * 8 + 1]); w.y = cvtpk(sv[s2 * 8 + 2], sv[s2 * 8 + 3]); w.z = cvtpk(sv[s2 * 8 + 4], sv[s2 * 8 + 5]); w.w = cvtpk(sv[s2 * 8 + 6], sv[s2 * 8 + 7]);
                const bf16x8_t pf = __builtin_bit_cast(bf16x8_t, w);
#pragma unroll
                for (int mt = 0; mt < 2; ++mt) {
                    const unsigned char* vp = Vc + (32 * mt + l31) * 264 + (32 * kt + 16 * s2 + 4 * h) * 2;
                    const uint2 lo = *(const uint2*)vp, hi = *(const uint2*)(vp + 16);
                    u32x4 a; a.x = lo.x; a.y = lo.y; a.z = hi.x; a.w = hi.y;
                    Oa[mt] = MFMA32(__builtin_bit_cast(bf16x8_t, a), pf, Oa[mt]);
                }
            }
        }
        psum += __shfl_xor(psum, 32);
        const float inv = (nvalid > 0) ? 1.f / fmaxf(psum, 1e-30f) : 0.f;
        if (h == 0) invS[r * 64 + tokoff] = inv;
        const float g0 = sigmoidf_(bf2f(proj[trow * ODD_PAD + 2048 + hd])) * inv;
#pragma unroll
        for (int i = 0; i < 16; ++i) { outv[i] = g0 * Oa[0][i]; outv[16 + i] = g0 * Oa[1][i]; }
        __syncthreads();
#pragma unroll
        for (int i = 0; i < 4; ++i) {
            const int pc = tid + 512 * i, tk = pc >> 5, j = pc & 31, cur = tile;
            const float ij = (j < 8 * kt_end) ? impS[(0 * 64 + tk) * 33 + j] * invS[tk] + impS[(1 * 64 + tk) * 33 + j] * invS[64 + tk] + impS[(2 * 64 + tk) * 33 + j] * invS[128 + tk] + impS[(3 * 64 + tk) * 33 + j] * invS[192 + tk] : 0.f;
            const bool fj = (j == 0) || (j == cur) || (j == cur - 1);
            impT[tk * 33 + j] = (j <= cur) ? ij + (fj ? 1000.f : 0.f) : -INFINITY;
        }
        __syncthreads();
        {
            const int tk = tid >> 3, rr = tid & 7;
            float vk[32];
#pragma unroll
            for (int k = 0; k < 32; ++k) vk[k] = impT[tk * 33 + k];
            unsigned bits = 0;
#pragma unroll
            for (int jj = 0; jj < 4; ++jj) {
                const int j = rr * 4 + jj;
                const float vj = impT[tk * 33 + j];
                int rank = 0;
#pragma unroll
                for (int k = 0; k < 32; ++k) rank += (vk[k] > vj || (vk[k] == vj && k < j)) ? 1 : 0;
                if (rank < 16) bits |= 1u << j;
            }
            bits |= __shfl_xor(bits, 1);
            bits |= __shfl_xor(bits, 2);
            bits |= __shfl_xor(bits, 4);
            if (rr == 0) selS[tk] = bits;
        }
        }
        __syncthreads();
        {
        const int tid = tidx(), lane = tid & 63, l31 = lane & 31, h = lane >> 5;
        const int tile = 31 - (it >> 6), bg = it & 63, g = bg & 3, b = bg >> 2;
        const int hd = g * 4 + r, tokoff = thalf * 32 + l31, tok = tile * 64 + tokoff;
        const size_t trow = (size_t)(b * NL + tok);
        const float slope = exp2f(-0.5f * (float)(hd + 1)) * LOG2E;
        bf16x8_t Qf[4];
#pragma unroll
        for (int ds = 0; ds < 4; ++ds) {
            float q[8];
            ld8(proj + trow * ODD_PAD + hd * 64 + 16 * ds + 8 * h, q);
            const float qs = 0.125f * LOG2E;
            u32x4 w; w.x = cvtpk(q[0] * qs, q[1] * qs); w.y = cvtpk(q[2] * qs, q[3] * qs); w.z = cvtpk(q[4] * qs, q[5] * qs); w.w = cvtpk(q[6] * qs, q[7] * qs);
            Qf[ds] = __builtin_bit_cast(bf16x8_t, w);
        }
        float sc[16];
#pragma unroll
        for (int reg = 0; reg < 16; ++reg) sc[reg] = slope * (float)crow32(reg, h);
        const int skey = tid >> 3, spart = tid & 7;
        uint4 kreg = make_uint4(0u, 0u, 0u, 0u), vreg = kreg; bool have_first = false;
        const unsigned mymask = selS[tokoff];
        unsigned um = selS[lane];
        um |= sort_partner<1>(um, lane); um |= sort_partner<2>(um, lane); um |= sort_partner<4>(um, lane); um |= sort_partner<8>(um, lane); um |= sort_partner<16>(um, lane); um |= sort_partner<32>(um, lane);
        const unsigned causal = (tile == 31) ? 0xffffffffu : ((2u << tile) - 1u);
        const unsigned U = (unsigned)__builtin_amdgcn_readfirstlane((int)um) & causal;
#pragma unroll 1
        for (int branch = 0; branch < 2; ++branch) {
            unsigned todo = (branch == 0) ? U : (causal & ~((1u << (tile >= 8 ? tile - 8 : 0)) - 1u));
            const bf16_t* kbase = proj + (size_t)b * NL * ODD_PAD + (branch == 0 ? 1536 : 1792) + g * 64 + (size_t)skey * ODD_PAD + 8 * spart;
            const bf16_t* vbase = vt + (size_t)(branch * 256 + g * 64 + skey) * NT + (size_t)b * NL + 8 * spart;
            float m_run = -1e30f, l_run = 0.f;
            f32x16 Oa[2];
#pragma unroll
            for (int i = 0; i < 16; ++i) { Oa[0][i] = 0.f; Oa[1][i] = 0.f; }
            int jcur = __ffs(todo) - 1; todo &= todo - 1;
            if (branch == 0 || jcur != (tile >= 8 ? tile - 8 : 0)) { kreg = *(const uint4*)(kbase + (size_t)(64 * jcur) * ODD_PAD); vreg = *(const uint4*)(vbase + 64 * jcur); }
            have_first = true;
            int buf = 0;
            __syncthreads();
            *(uint4*)(ldsn + skey * 144 + spart * 16) = kreg;
            *(uint2*)(ldsn + 18432 + skey * 136 + spart * 16) = make_uint2(vreg.x, vreg.y);
            *(uint2*)(ldsn + 18432 + skey * 136 + spart * 16 + 8) = make_uint2(vreg.z, vreg.w);
            __syncthreads();
            for (;;) {
                const int jnext = todo ? (__ffs(todo) - 1) : -1;
                todo &= todo - 1;
                {
                    const int nb = jnext >= 0 ? branch : 1 - branch;
                    const int jl = jnext >= 0 ? jnext : (branch == 0 ? (tile >= 8 ? tile - 8 : 0) : 0);
                    const bf16_t* kb2 = proj + (size_t)b * NL * ODD_PAD + (nb == 0 ? 1536 : 1792) + g * 64 + (size_t)skey * ODD_PAD + 8 * spart;
                    const bf16_t* vb2 = vt + (size_t)(nb * 256 + g * 64 + skey) * NT + (size_t)b * NL + 8 * spart;
                    kreg = *(const uint4*)(kb2 + (size_t)(64 * jl) * ODD_PAD); vreg = *(const uint4*)(vb2 + 64 * jl);
                }
                const unsigned char* Ks = ldsn + buf * 9216;
                const unsigned char* Vs = ldsn + 18432 + buf * 8704;
                const bool mysel = (branch == 1) || ((mymask >> jcur) & 1u);
                if (__any(mysel)) {
                    const bool diag = (jcur == tile), wedge = (branch == 1) && (jcur == tile - 8);
                    const float init = mysel ? slope * (float)(64 * (jcur - tile)) : -1e30f;
                    float sv[32];
#pragma unroll
                    for (int kt = 0; kt < 2; ++kt) {
                        f32x16 acc;
                        const float i0 = init + slope * (float)(32 * kt);
#pragma unroll
                        for (int i = 0; i < 16; ++i) acc[i] = sc[i] + i0;
#pragma unroll
                        for (int ds = 0; ds < 4; ++ds) {
                            const bf16x8_t a = *(const bf16x8_t*)(Ks + (32 * kt + l31) * 144 + (16 * ds + 8 * h) * 2);
                            acc = MFMA32(a, Qf[ds], acc);
                        }
#pragma unroll
                        for (int reg = 0; reg < 16; ++reg) sv[kt * 16 + reg] = acc[reg];
                    }
                    if (diag || wedge) {
#pragma unroll
                        for (int i = 0; i < 32; ++i) {
                            const int keyoff = 32 * (i >> 4) + crow32(i & 15, h);
                            const bool ok = diag ? (keyoff <= tokoff) : (keyoff > tokoff);
                            sv[i] = ok ? sv[i] : -1e30f;
                        }
                    }
                    float mx = sv[0];
#pragma unroll
                    for (int i = 1; i < 32; ++i) mx = fmaxf(mx, sv[i]);
                    mx = fmaxf(mx, __shfl_xor(mx, 32));
                    if (!__all(mx < m_run - 160.f)) {
                    const float m_new = fmaxf(m_run, mx), m_use = fmaxf(m_new, -1e29f);
                    const float alpha = __builtin_amdgcn_exp2f(m_run - m_use);
                    const f32x2_t nm = {-m_use, -m_use};
                    f32x2_t ps2 = {0.f, 0.f};
#pragma unroll
                    for (int i = 0; i < 16; ++i) {
                        const f32x2_t t = (f32x2_t){sv[2 * i], sv[2 * i + 1]} + nm;
                        const f32x2_t p2 = {__builtin_amdgcn_exp2f(t.x), __builtin_amdgcn_exp2f(t.y)};
                        sv[2 * i] = p2.x; sv[2 * i + 1] = p2.y; ps2 += p2;
                    }
                    l_run = l_run * alpha + (ps2.x + ps2.y); m_run = m_new;
#pragma unroll
                    for (int i = 0; i < 16; ++i) { Oa[0][i] *= alpha; Oa[1][i] *= alpha; }
                    bf16x8_t Pf[4];
#pragma unroll
                    for (int ks = 0; ks < 4; ++ks) {
                        u32x4 w; w.x = cvtpk(sv[ks * 8 + 0], sv[ks * 8 + 1]); w.y = cvtpk(sv[ks * 8 + 2], sv[ks * 8 + 3]); w.z = cvtpk(sv[ks * 8 + 4], sv[ks * 8 + 5]); w.w = cvtpk(sv[ks * 8 + 6], sv[ks * 8 + 7]);
                        Pf[ks] = __builtin_bit_cast(bf16x8_t, w);
                    }
#pragma unroll
                    for (int mt = 0; mt < 2; ++mt)
#pragma unroll
                        for (int ks = 0; ks < 4; ++ks) {
                            const unsigned char* vp = Vs + (32 * mt + l31) * 136 + (16 * ks + 4 * h) * 2;
                            const uint2 lo = *(const uint2*)vp, hi = *(const uint2*)(vp + 16);
                            u32x4 w; w.x = lo.x; w.y = lo.y; w.z = hi.x; w.w = hi.y;
                            Oa[mt] = MFMA32(__builtin_bit_cast(bf16x8_t, w), Pf[ks], Oa[mt]);
                        }
                    }
                }
                if (jnext < 0) break;
                *(uint4*)(ldsn + (buf ^ 1) * 9216 + skey * 144 + spart * 16) = kreg;
                *(uint2*)(ldsn + 18432 + (buf ^ 1) * 8704 + skey * 136 + spart * 16) = make_uint2(vreg.x, vreg.y);
                *(uint2*)(ldsn + 18432 + (buf ^ 1) * 8704 + skey * 136 + spart * 16 + 8) = make_uint2(vreg.z, vreg.w);
                __syncthreads();
                buf ^= 1; jcur = jnext;
            }
            const float l_tot = l_run + __shfl_xor(l_run, 32);
            const float gt = sigmoidf_(bf2f(proj[trow * ODD_PAD + 2048 + (branch + 1) * 16 + hd]));
            const float f = gt / fmaxf(l_tot, 1e-30f);
#pragma unroll
            for (int i = 0; i < 16; ++i) { outv[i] += f * Oa[0][i]; outv[16 + i] += f * Oa[1][i]; }
        }
        bf16_t* orow = O + trow * ND + hd * 64;
#pragma unroll
        for (int mt = 0; mt < 2; ++mt)
#pragma unroll
            for (int q4 = 0; q4 < 4; ++q4) {
                bf16_t* op = orow + 32 * mt + 8 * q4 + 4 * h;
                const float o0 = outv[mt * 16 + q4 * 4 + 0], o1 = outv[mt * 16 + q4 * 4 + 1], o2 = outv[mt * 16 + q4 * 4 + 2], o3 = outv[mt * 16 + q4 * 4 + 3];
                *(uint2*)op = make_uint2(cvtpk(o0, o1), cvtpk(o2, o3));
            }
        }
    }
    __syncthreads();
    __builtin_amdgcn_s_setprio(0);
}


__device__ __forceinline__ void nsa_compress2_phase(const bf16_t* __restrict__ proj, const bf16_t* __restrict__ w1t  , const bf16_t* __restrict__ w2t  ,
                                                    const float* __restrict__ bias1  , bf16_t* __restrict__ kcmp  , bf16_t* __restrict__ vcmpT  ,
                                                    unsigned char* lds) {
    const int tid = tidx(), wave = __builtin_amdgcn_readfirstlane(tid >> 6), lane = tid & 63, fr = lane & 15, fq = lane >> 4;
    unsigned char* xs = lds;
    unsigned char* hs = lds + 133120;
    for (int it = blockIdx.x; it < 256; it += gridDim.x) {
        const int which = it >> 7, nt2 = it & 1, g = (it >> 1) & 3, b = (it >> 3) & 15;
        const int t0 = 1024 * nt2, coloff = (which ? 1280 : 1024) + g * 64;
        __syncthreads();
        for (int pc = tid; pc < 1040 * 8; pc += NTHR) {
            const int tk = pc >> 3, c = pc & 7;
            int tsrc = t0 + tk; tsrc = tsrc > NL - 1 ? NL - 1 : tsrc;
            *(uint4*)(xs + tk * 128 + ((c ^ ((tk >> 4) & 7)) << 4)) = *(const uint4*)(proj + (size_t)(b * NL + tsrc) * ODD_PAD + coloff + 8 * c);
        }
        __syncthreads();
        f32x4 acc[4];
#pragma unroll
        for (int mt = 0; mt < 4; ++mt) acc[mt] = (f32x4){0.f, 0.f, 0.f, 0.f};
        const bf16_t* wrow = w1t + ((size_t)which * 128 + 16 * wave + fr) * 2048 + 8 * fq;
#pragma unroll 4
        for (int ks = 0; ks < 64; ++ks) {
            const int l = ks >> 1, c = 4 * (ks & 1) + fq;
            const bf16x8_t bfrag = *(const bf16x8_t*)(wrow + 32 * ks);
#pragma unroll
            for (int mt = 0; mt < 4; ++mt) {
                const int tk = 16 * (16 * mt + fr) + l;
                const bf16x8_t a = *(const bf16x8_t*)(xs + tk * 128 + ((c ^ ((tk >> 4) & 7)) << 4));
                acc[mt] = __builtin_amdgcn_mfma_f32_16x16x32_bf16(a, bfrag, acc[mt], 0, 0, 0);
            }
        }
        {
            const float bj = bias1[which * 128 + 16 * wave + fr];
#pragma unroll
            for (int mt = 0; mt < 4; ++mt)
#pragma unroll
                for (int reg = 0; reg < 4; ++reg) *(bf16_t*)(hs + (16 * mt + 4 * fq + reg) * 272 + (16 * wave + fr) * 2) = f2bf(gelu_fast(acc[mt][reg] + bj));
        }
        __syncthreads();
        {
            const int mt = wave >> 1;
#pragma unroll
            for (int ci = 0; ci < 2; ++ci) {
                const int ct = 2 * (wave & 1) + ci;
                f32x4 o = {0.f, 0.f, 0.f, 0.f};
#pragma unroll
                for (int ks = 0; ks < 4; ++ks) {
                    const bf16x8_t a = *(const bf16x8_t*)(hs + (16 * mt + fr) * 272 + (32 * ks + 8 * fq) * 2);
                    const bf16x8_t bfrag = *(const bf16x8_t*)(w2t + ((size_t)which * 64 + 16 * ct + fr) * 128 + 32 * ks + 8 * fq);
                    o = __builtin_amdgcn_mfma_f32_16x16x32_bf16(a, bfrag, o, 0, 0, 0);
                }
                const int c = 16 * ct + fr;
#pragma unroll
                for (int reg = 0; reg < 4; ++reg) {
                    const int n = 64 * nt2 + 16 * mt + 4 * fq + reg;
                    const bf16_t val = (n < 127) ? f2bf(o[reg]) : (bf16_t)0;
                    if (which == 0) kcmp[((size_t)(b * 4 + g) * 128 + n) * 64 + c] = val;
                    else vcmpT[(((size_t)(b * 4 + g) * 8 + (n >> 4)) * 64 + c) * 16 + (n & 15)] = val;
                }
            }
        }
    }
    __syncthreads();
}

__device__ __forceinline__ void nsa_cmp2_phase(const bf16_t* __restrict__ proj, const bf16_t* __restrict__ kcmp, const bf16_t* __restrict__ vcmpT,
                                               bf16_t* __restrict__ O, unsigned* __restrict__ selmask, unsigned char* lds) {
    if (__builtin_amdgcn_readfirstlane(tidx() >> 6) >= 4) __builtin_amdgcn_s_setprio(1);
    const int tid = tidx(), wave = __builtin_amdgcn_readfirstlane(tid >> 6), lane = tid & 63, l31 = lane & 31, h = lane >> 5;
    const int r = wave & 3, thalf = wave >> 2;
    unsigned char* Kc = lds;
    unsigned char* Vc = lds + 18432;
    float* impS = (float*)(lds + 35328);
    float* invS = (float*)(lds + 35328 + 33792);
    float* impT = (float*)(lds + 35328 + 33792 + 1024);
    int staged_bg = -1;
    for (int it = blockIdx.x; it < 32 * 64; it += gridDim.x) {
        const int tile = 31 - (it >> 6), bg = it & 63, g = bg & 3, b = bg >> 2;
        const int hd = g * 4 + r, tokoff = thalf * 32 + l31, tok = tile * 64 + tokoff;
        const size_t trow = (size_t)(b * NL + tok);
        const float slope = exp2f(-0.5f * (float)(hd + 1));
        __syncthreads();
        if (bg != staged_bg) {
        staged_bg = bg;
#pragma unroll
        for (int i = 0; i < 2; ++i) {
            const int pc = tid + 512 * i;
            { const int row = pc >> 3, c = pc & 7; *(uint4*)(Kc + row * 144 + c * 16) = *(const uint4*)(kcmp + ((size_t)(b * 4 + g) * 128 + row) * 64 + 8 * c); }
            { const int row = pc >> 4, c = pc & 15; const uint4 v = *(const uint4*)(vcmpT + (((size_t)(b * 4 + g) * 8 + (c >> 1)) * 64 + row) * 16 + (c & 1) * 8);
              *(uint2*)(Vc + row * 264 + c * 16) = make_uint2(v.x, v.y); *(uint2*)(Vc + row * 264 + c * 16 + 8) = make_uint2(v.z, v.w); }
        }
        }
        bf16x8_t Qf[4];
#pragma unroll
        for (int ds = 0; ds < 4; ++ds) {
            float q[8];
            ld8(proj + trow * ODD_PAD + hd * 64 + 16 * ds + 8 * h, q);
            u32x4 w; w.x = cvtpk(q[0] * 0.125f, q[1] * 0.125f); w.y = cvtpk(q[2] * 0.125f, q[3] * 0.125f); w.z = cvtpk(q[4] * 0.125f, q[5] * 0.125f); w.w = cvtpk(q[6] * 0.125f, q[7] * 0.125f);
            Qf[ds] = __builtin_bit_cast(bf16x8_t, w);
        }
        int nvalid = (tok >= 31) ? ((tok - 31) / 16 + 1) : 0;
        nvalid = nvalid > 127 ? 127 : nvalid;
        const int nv_max = (4 * tile + 3) > 127 ? 127 : (4 * tile + 3);
        const int kt_end = (nv_max + 31) >> 5;
        __syncthreads();
        float mx = -1e30f;
#pragma unroll 2
        for (int kt = 0; kt < kt_end; ++kt) {
            f32x16 acc;
            const float i0 = slope * (float)(512 * kt);
#pragma unroll
            for (int i = 0; i < 16; ++i) acc[i] = i0;
#pragma unroll
            for (int ds = 0; ds < 4; ++ds) {
                const bf16x8_t a = *(const bf16x8_t*)(Kc + (32 * kt + l31) * 144 + (16 * ds + 8 * h) * 2);
                acc = MFMA32(a, Qf[ds], acc);
            }
#pragma unroll
            for (int reg = 0; reg < 16; ++reg) {
                const int n = 32 * kt + crow32(reg, h);
                const float sval = acc[reg] + slope * (float)(16 * crow32(reg, h));
                mx = fmaxf(mx, (n < nvalid) ? sval : -1e30f);
            }
        }
        mx = fmaxf(mx, __shfl_xor(mx, 32));
        const float moff = -fmaxf(mx, -1e29f) * LOG2E;
        float psum = 0.f, prev_pe = 0.f;
        f32x16 Oa[2];
#pragma unroll
        for (int i = 0; i < 16; ++i) { Oa[0][i] = 0.f; Oa[1][i] = 0.f; }
#pragma unroll 2
        for (int kt = 0; kt < kt_end; ++kt) {
            f32x16 acc;
            const float i0 = slope * (float)(512 * kt);
#pragma unroll
            for (int i = 0; i < 16; ++i) acc[i] = i0;
#pragma unroll
            for (int ds = 0; ds < 4; ++ds) {
                const bf16x8_t a = *(const bf16x8_t*)(Kc + (32 * kt + l31) * 144 + (16 * ds + 8 * h) * 2);
                acc = MFMA32(a, Qf[ds], acc);
            }
            float sv[16];
#pragma unroll
            for (int reg = 0; reg < 16; ++reg) {
                const int n = 32 * kt + crow32(reg, h);
                const float sval = acc[reg] + slope * (float)(16 * crow32(reg, h));
                sv[reg] = __builtin_amdgcn_exp2f(fmaf((n < nvalid) ? sval : -1e30f, LOG2E, moff));
                psum += sv[reg];
            }
#pragma unroll
            for (int q = 0; q < 4; ++q) {
                const float e = 0.5f * sv[q * 4 + 3];
                const float own = sv[q * 4] + sv[q * 4 + 1] + sv[q * 4 + 2] + e;
                const float pe = __shfl_xor(e, 32);
                impS[(r * 64 + tokoff) * 33 + 8 * kt + 2 * q + h] = own + (h ? pe : prev_pe);
                prev_pe = pe;
            }
#pragma unroll
            for (int s2 = 0; s2 < 2; ++s2) {
                u32x4 w; w.x = cvtpk(sv[s2 * 8 + 0], sv[s2 * 8 + 1]); w.y = cvtpk(sv[s2 * 8 + 2], sv[s2 * 8 + 3]); w.z = cvtpk(sv[s2 * 8 + 4], sv[s2 * 8 + 5]); w.w = cvtpk(sv[s2 * 8 + 6], sv[s2 * 8 + 7]);
                const bf16x8_t pf = __builtin_bit_cast(bf16x8_t, w);
#pragma unroll
                for (int mt = 0; mt < 2; ++mt) {
                    const unsigned char* vp = Vc + (32 * mt + l31) * 264 + (32 * kt + 16 * s2 + 4 * h) * 2;
                    const uint2 lo = *(const uint2*)vp, hi = *(const uint2*)(vp + 16);
                    u32x4 a; a.x = lo.x; a.y = lo.y; a.z = hi.x; a.w = hi.y;
                    Oa[mt] = MFMA32(__builtin_bit_cast(bf16x8_t, a), pf, Oa[mt]);
                }
            }
        }
        psum += __shfl_xor(psum, 32);
        const float inv = (nvalid > 0) ? 1.f / fmaxf(psum, 1e-30f) : 0.f;
        if (h == 0) invS[r * 64 + tokoff] = inv;
        const float g0 = sigmoidf_(bf2f(proj[trow * ODD_PAD + 2048 + hd])) * inv;
        bf16_t* orow = O + trow * ND + hd * 64;
#pragma unroll
        for (int mt = 0; mt < 2; ++mt)
#pragma unroll
            for (int q4 = 0; q4 < 4; ++q4)
                *(uint2*)(orow + 32 * mt + 8 * q4 + 4 * h) = make_uint2(cvtpk(g0 * Oa[mt][q4 * 4], g0 * Oa[mt][q4 * 4 + 1]), cvtpk(g0 * Oa[mt][q4 * 4 + 2], g0 * Oa[mt][q4 * 4 + 3]));
        __syncthreads();
#pragma unroll
        for (int i = 0; i < 4; ++i) {
            const int pc = tid + 512 * i, tk = pc >> 5, j = pc & 31, cur = tile;
            const float ij = (j < 8 * kt_end) ? impS[(0 * 64 + tk) * 33 + j] * invS[tk] + impS[(1 * 64 + tk) * 33 + j] * invS[64 + tk] + impS[(2 * 64 + tk) * 33 + j] * invS[128 + tk] + impS[(3 * 64 + tk) * 33 + j] * invS[192 + tk] : 0.f;
            const bool fj = (j == 0) || (j == cur) || (j == cur - 1);
            impT[tk * 33 + j] = (j <= cur) ? ij + (fj ? 1000.f : 0.f) : -INFINITY;
        }
        __syncthreads();
        {
            const int tk = tid >> 3, rr = tid & 7;
            float vk[32];
#pragma unroll
            for (int k = 0; k < 32; ++k) vk[k] = impT[tk * 33 + k];
            unsigned bits = 0;
#pragma unroll
            for (int jj = 0; jj < 4; ++jj) {
                const int j = rr * 4 + jj;
                const float vj = impT[tk * 33 + j];
                int rank = 0;
#pragma unroll
                for (int k = 0; k < 32; ++k) rank += (vk[k] > vj || (vk[k] == vj && k < j)) ? 1 : 0;
                if (rank < 16) bits |= 1u << j;
            }
            bits |= __shfl_xor(bits, 1);
            bits |= __shfl_xor(bits, 2);
            bits |= __shfl_xor(bits, 4);
            if (rr == 0) selmask[(size_t)(b * 4 + g) * NL + tile * 64 + tk] = bits;
        }
    }
    __syncthreads();
    __builtin_amdgcn_s_setprio(0);
}


constexpr int P0W = 1792;
constexpr float LN2F = 0.6931471805599453f;
__device__ __forceinline__ void sb_attn2_phase(const bf16_t* __restrict__ proj, const bf16_t* __restrict__ vt, bf16_t* __restrict__ Y, unsigned char* lds) {
    if (__builtin_amdgcn_readfirstlane(tidx() >> 6) >= 4) __builtin_amdgcn_s_setprio(1);
    const int tid = tidx(), wave = __builtin_amdgcn_readfirstlane(tid >> 6), lane = tid & 63, l31 = lane & 31, h = lane >> 5;
    const int skey = tid >> 3, spart = tid & 7;
    for (int it = blockIdx.x; it < NB * 12 * 8; it += gridDim.x) {
        const int tile = 7 - (it / 192), bh = it % 192, hh = bh % 12, b = bh / 12;
        const int qlo = tile * 256 + 32 * wave, tq = qlo + l31;
        const size_t trow = (size_t)(b * NL + tq);
        bf16x8_t Qf[4];
#pragma unroll
        for (int ds = 0; ds < 4; ++ds) {
            float q[8];
            ld8(proj + trow * P0W + 256 + hh * 64 + 16 * ds + 8 * h, q);
            u32x4 w; w.x = cvtpk(q[0] * 0.125f, q[1] * 0.125f); w.y = cvtpk(q[2] * 0.125f, q[3] * 0.125f); w.z = cvtpk(q[4] * 0.125f, q[5] * 0.125f); w.w = cvtpk(q[6] * 0.125f, q[7] * 0.125f);
            Qf[ds] = __builtin_bit_cast(bf16x8_t, w);
        }
        const bf16_t* kbase = proj + (size_t)b * NL * P0W + 1024 + hh * 64 + (size_t)skey * P0W + 8 * spart;
        const bf16_t* vbase = vt + (size_t)(hh * 64 + skey) * NT + (size_t)b * NL + 8 * spart;
        f32x16 Oa[2];
#pragma unroll
        for (int i = 0; i < 16; ++i) { Oa[0][i] = 0.f; Oa[1][i] = 0.f; }
        float carry = 0.f;
        int j = tile * 4 + 3, buf = 0;
        uint4 kreg = *(const uint4*)(kbase + (size_t)(64 * j) * P0W);
        uint4 vreg = *(const uint4*)(vbase + 64 * j);
        __syncthreads();
        *(uint4*)(lds + skey * 144 + spart * 16) = kreg;
        *(uint2*)(lds + 18432 + skey * 136 + spart * 16) = make_uint2(vreg.x, vreg.y);
        *(uint2*)(lds + 18432 + skey * 136 + spart * 16 + 8) = make_uint2(vreg.z, vreg.w);
        __syncthreads();
        for (;;) {
            const int jn = j - 1;
            if (jn >= 0) { kreg = *(const uint4*)(kbase + (size_t)(64 * jn) * P0W); vreg = *(const uint4*)(vbase + 64 * jn); }
            const unsigned char* Ks = lds + buf * 9216;
            const unsigned char* Vs = lds + 18432 + buf * 8704;
            const bool live = (64 * j <= qlo + 30) && !__all(carry < -110.f);
            if (live) {
#pragma unroll
                for (int kti = 0; kti < 2; ++kti) {
                    const int kt = 1 - kti;
                    f32x16 acc;
#pragma unroll
                    for (int i = 0; i < 16; ++i) acc[i] = 0.f;
#pragma unroll
                    for (int ds = 0; ds < 4; ++ds) {
                        const bf16x8_t a = *(const bf16x8_t*)(Ks + (32 * kt + l31) * 144 + (16 * ds + 8 * h) * 2);
                        acc = MFMA32(a, Qf[ds], acc);
                    }
                    float m1[16], lz[16];
#pragma unroll
                    for (int reg = 0; reg < 16; ++reg) {
                        const float z = acc[reg];
                        const bool valid = (64 * j + 32 * kt + crow32(reg, h)) < tq;
                        const float e = __builtin_amdgcn_exp2f(-fabsf(z) * LOG2E);
                        const float sp = fmaxf(z, 0.f) + __builtin_amdgcn_logf(1.f + e) * LN2F;
                        m1[reg] = valid ? -sp : 0.f;
                        lz[reg] = valid ? z - sp : -1e30f;
                    }
                    float G[4], T[4];
#pragma unroll
                    for (int q = 0; q < 4; ++q) G[q] = (m1[4 * q] + m1[4 * q + 1]) + (m1[4 * q + 2] + m1[4 * q + 3]);
                    float Gp[4];
#pragma unroll
                    for (int q = 0; q < 4; ++q) { Gp[q] = __shfl_xor(G[q], 32); T[q] = G[q] + Gp[q]; }
                    float base[4];
                    base[3] = carry; base[2] = base[3] + T[3]; base[1] = base[2] + T[2]; base[0] = base[1] + T[1];
                    const float tot = base[0] + T[0];
#pragma unroll
                    for (int q = 0; q < 4; ++q) {
                        const float bq = base[q] + (h ? 0.f : Gp[q]);
                        const float t3 = bq, t2 = t3 + m1[4 * q + 3], t1 = t2 + m1[4 * q + 2], t0 = t1 + m1[4 * q + 1];
                        lz[4 * q + 3] = __builtin_amdgcn_exp2f((lz[4 * q + 3] + t3) * LOG2E);
                        lz[4 * q + 2] = __builtin_amdgcn_exp2f((lz[4 * q + 2] + t2) * LOG2E);
                        lz[4 * q + 1] = __builtin_amdgcn_exp2f((lz[4 * q + 1] + t1) * LOG2E);
                        lz[4 * q + 0] = __builtin_amdgcn_exp2f((lz[4 * q + 0] + t0) * LOG2E);
                    }
                    carry = tot;
#pragma unroll
                    for (int s2 = 0; s2 < 2; ++s2) {
                        u32x4 w; w.x = cvtpk(lz[s2 * 8 + 0], lz[s2 * 8 + 1]); w.y = cvtpk(lz[s2 * 8 + 2], lz[s2 * 8 + 3]); w.z = cvtpk(lz[s2 * 8 + 4], lz[s2 * 8 + 5]); w.w = cvtpk(lz[s2 * 8 + 6], lz[s2 * 8 + 7]);
                        const bf16x8_t pf = __builtin_bit_cast(bf16x8_t, w);
#pragma unroll
                        for (int mt = 0; mt < 2; ++mt) {
                            const unsigned char* vp = Vs + (32 * mt + l31) * 136 + (32 * kt + 16 * s2 + 4 * h) * 2;
                            const uint2 lo = *(const uint2*)vp, hi = *(const uint2*)(vp + 16);
                            u32x4 a; a.x = lo.x; a.y = lo.y; a.z = hi.x; a.w = hi.y;
                            Oa[mt] = MFMA32(__builtin_bit_cast(bf16x8_t, a), pf, Oa[mt]);
                        }
                    }
                }
            }
            if (jn >= 0) {
                *(uint4*)(lds + (buf ^ 1) * 9216 + skey * 144 + spart * 16) = kreg;
                *(uint2*)(lds + 18432 + (buf ^ 1) * 8704 + skey * 136 + spart * 16) = make_uint2(vreg.x, vreg.y);
                *(uint2*)(lds + 18432 + (buf ^ 1) * 8704 + skey * 136 + spart * 16 + 8) = make_uint2(vreg.z, vreg.w);
            }
            volatile int* flg = (volatile int*)(lds + 35840) + (j & 1) * 8;
            const int wdone = __all(carry < -110.f);
            if (lane == 0) flg[wave] = wdone;
            __syncthreads();
            const int alldone = flg[0] & flg[1] & flg[2] & flg[3] & flg[4] & flg[5] & flg[6] & flg[7];
            if (alldone || jn < 0) break;
            buf ^= 1; j = jn;
        }
        bf16_t* orow = Y + trow * ND + 256 + hh * 64;
#pragma unroll
        for (int mt = 0; mt < 2; ++mt)
#pragma unroll
            for (int q4 = 0; q4 < 4; ++q4)
                *(uint2*)(orow + 32 * mt + 8 * q4 + 4 * h) = make_uint2(cvtpk(Oa[mt][q4 * 4], Oa[mt][q4 * 4 + 1]), cvtpk(Oa[mt][q4 * 4 + 2], Oa[mt][q4 * 4 + 3]));
    }
    __syncthreads();
    __builtin_amdgcn_s_setprio(0);
}

__device__ __forceinline__ void s5_scan2_phase(const bf16_t* __restrict__ proj, const float* __restrict__ lam_re, const float* __restrict__ lam_im, const float* __restrict__ log_dt,
                                               const float* __restrict__ b_re, const float* __restrict__ b_im, const float* __restrict__ c_re, const float* __restrict__ c_im,
                                               const float* __restrict__ dskip, bf16_t* __restrict__ ya, float* lds) {
    const int tid = tidx(), wave = __builtin_amdgcn_readfirstlane(tid >> 6), lane = tid & 63;
    float* cr = lds;
    float* ci = lds + 1024;
    float* Es = lds + 2048;
    float* us = lds + 3072 + wave * 512;
    float* xr = lds + 7168 + wave * 4160;
    float* xi = xr + 2080;
    for (int bg = blockIdx.x; bg < NB * 16; bg += gridDim.x) {
        const int b = bg >> 4, g = bg & 15;
        const float lr = lam_re[g * 64 + lane], li = lam_im[g * 64 + lane];
        const float dt = expf(log_dt[g]);
        const float mag = expf(lr * dt);
        const float are = mag * cosf(li * dt), aim = mag * sinf(li * dt);
        const float nr = are - 1.f, den = lr * lr + li * li;
        const float fre = (nr * lr + aim * li) / den, fim = (aim * lr - nr * li) / den;
        float bbr[16], bbi[16];
#pragma unroll
        for (int i = 0; i < 16; ++i) {
            const float br = b_re[(g * 64 + lane) * 16 + i], bi = b_im[(g * 64 + lane) * 16 + i];
            bbr[i] = fre * br - fim * bi; bbi[i] = fre * bi + fim * br;
        }
        __syncthreads();
        for (int idx = tid; idx < 1024; idx += NTHR) { cr[idx] = c_re[g * 1024 + idx]; ci[idx] = c_im[g * 1024 + idx]; }
        const bf16_t* ub = proj + (size_t)(b * NL + 256 * wave) * P0W + g * 16;
        float xre = 0.f, xim = 0.f;
        for (int c0 = 0; c0 < 256; c0 += 32) {
            wave_lds_fence();
            { float u8[8]; const int t = lane >> 1, hf = lane & 1; ld8(ub + (size_t)(c0 + t) * P0W + 8 * hf, u8);
#pragma unroll
              for (int i = 0; i < 8; ++i) us[t * 16 + 8 * hf + i] = u8[i]; }
            wave_lds_fence();
            for (int t = 0; t < 32; ++t) {
                float bur = 0.f, bui = 0.f;
#pragma unroll
                for (int i = 0; i < 16; ++i) { const float u = us[t * 16 + i]; bur += bbr[i] * u; bui += bbi[i] * u; }
                const float nre = are * xre - aim * xim + bur, nim = are * xim + aim * xre + bui;
                xre = nre; xim = nim;
            }
        }
        Es[(wave * 64 + lane) * 2] = xre; Es[(wave * 64 + lane) * 2 + 1] = xim;
        float pr = are, pi = aim;
#pragma unroll
        for (int i = 0; i < 8; ++i) { const float nr2 = pr * pr - pi * pi, ni2 = 2.f * pr * pi; pr = nr2; pi = ni2; }
        __syncthreads();
        xre = 0.f; xim = 0.f;
        for (int w2 = 0; w2 < wave; ++w2) {
            const float er = Es[(w2 * 64 + lane) * 2], ei = Es[(w2 * 64 + lane) * 2 + 1];
            const float nre = pr * xre - pi * xim + er, nim = pr * xim + pi * xre + ei;
            xre = nre; xim = nim;
        }
        const int tt = lane & 31, ih = lane >> 5;
        float dsk[8];
#pragma unroll
        for (int i = 0; i < 8; ++i) dsk[i] = dskip[g * 16 + 8 * ih + i];
        for (int c0 = 0; c0 < 256; c0 += 32) {
            wave_lds_fence();
            { float u8[8]; const int t = lane >> 1, hf = lane & 1; ld8(ub + (size_t)(c0 + t) * P0W + 8 * hf, u8);
#pragma unroll
              for (int i = 0; i < 8; ++i) us[t * 16 + 8 * hf + i] = u8[i]; }
            wave_lds_fence();
            for (int t = 0; t < 32; ++t) {
                float bur = 0.f, bui = 0.f;
#pragma unroll
                for (int i = 0; i < 16; ++i) { const float u = us[t * 16 + i]; bur += bbr[i] * u; bui += bbi[i] * u; }
                const float nre = are * xre - aim * xim + bur, nim = are * xim + aim * xre + bui;
                xre = nre; xim = nim;
                xr[t * 65 + lane] = xre; xi[t * 65 + lane] = xim;
            }
            wave_lds_fence();
            float y[8];
#pragma unroll
            for (int i = 0; i < 8; ++i) y[i] = 0.f;
            for (int p = 0; p < 64; ++p) {
                const float a = xr[tt * 65 + p], bq = xi[tt * 65 + p];
#pragma unroll
                for (int i = 0; i < 8; ++i) y[i] += cr[(8 * ih + i) * 64 + p] * a - ci[(8 * ih + i) * 64 + p] * bq;
            }
            float o[8];
#pragma unroll
            for (int i = 0; i < 8; ++i) o[i] = gelu_fast(y[i] + dsk[i] * us[tt * 16 + 8 * ih + i]);
            st8(ya + (size_t)(b * NL + 256 * wave + c0 + tt) * 256 + g * 16 + 8 * ih, o);
        }
    }
    __syncthreads();
}


__device__ __forceinline__ void glu2_phase(const bf16_t* __restrict__ ya, const bf16_t* __restrict__ wgt, const float* __restrict__ bglu, bf16_t* __restrict__ Y, unsigned char* lds) {
    const int tid = tidx(), wave = __builtin_amdgcn_readfirstlane(tid >> 6), lane = tid & 63, fr = lane & 15, fq = lane >> 4;
    __syncthreads();
    for (int pc = tid; pc < 256 * 32; pc += NTHR) { const int row = pc >> 5, c = pc & 31; *(uint4*)(lds + row * 528 + c * 16) = *(const uint4*)(wgt + row * 256 + c * 8); }
    __syncthreads();
    for (int chunk = blockIdx.x; chunk < NT / 128; chunk += gridDim.x) {
        const size_t tok = (size_t)chunk * 128 + wave * 16 + fr;
        const size_t yb_b = (tok / NL) * 16, yt = tok % NL;
        bf16x8_t yb[8];
#pragma unroll
        for (int ks = 0; ks < 8; ++ks) yb[ks] = *(const bf16x8_t*)(ya + ((yb_b + 2 * ks + (fq >> 1)) * NL + yt) * 16 + (fq & 1) * 8);
#pragma unroll 2
        for (int nt = 0; nt < 16; ++nt) {
            f32x4 acc = {0.f, 0.f, 0.f, 0.f};
#pragma unroll
            for (int ks = 0; ks < 8; ++ks) {
                const bf16x8_t a = *(const bf16x8_t*)(lds + (16 * nt + fr) * 528 + (32 * ks + 8 * fq) * 2);
                acc = __builtin_amdgcn_mfma_f32_16x16x32_bf16(a, yb[ks], acc, 0, 0, 0);
            }
            const int n0 = 16 * nt + 4 * fq;
            const uint2 yv = *(const uint2*)(ya + ((yb_b + nt) * NL + yt) * 16 + 4 * fq);
            const float4 bb = *(const float4*)(bglu + n0);
            const float o0 = __uint_as_float(yv.x << 16) * sigmoidf_(acc[0] + bb.x), o1 = __uint_as_float(yv.x & 0xffff0000u) * sigmoidf_(acc[1] + bb.y);
            const float o2 = __uint_as_float(yv.y << 16) * sigmoidf_(acc[2] + bb.z), o3 = __uint_as_float(yv.y & 0xffff0000u) * sigmoidf_(acc[3] + bb.w);
            *(uint2*)(Y + tok * ND + n0) = make_uint2(cvtpk(o0, o1), cvtpk(o2, o3));
        }
    }
    __syncthreads();
}


__device__ __forceinline__ void cmadd(float& re, float& im, float ar, float ai, float br, float bi) {
    const float nr = fmaf(ar, re, fmaf(-ai, im, br)), ni = fmaf(ar, im, fmaf(ai, re, bi));
    re = nr; im = ni;
}
__device__ __forceinline__ void s5_scan3_phase(const bf16_t* __restrict__ proj, const float* __restrict__ lam_re, const float* __restrict__ lam_im, const float* __restrict__ log_dt,
                                               const float* __restrict__ b_re, const float* __restrict__ b_im, const float* __restrict__ c_re, const float* __restrict__ c_im,
                                               const float* __restrict__ dskip, bf16_t* __restrict__ ya, unsigned char* lds) {
    const int tid = tidx(), wave = __builtin_amdgcn_readfirstlane(tid >> 6), lane = tid & 63, l31 = lane & 31, h = lane >> 5, fr = lane & 15, fq = lane >> 4;
    unsigned char* Xs = lds + wave * 10752;
    float* Es = (float*)(lds + 86016);
    __syncthreads();
    for (int i = lane; i < 32 * 21; i += 64) *(uint4*)(Xs + i * 16) = make_uint4(0u, 0u, 0u, 0u);
    for (int bg = blockIdx.x; bg < NB * 16; bg += gridDim.x) {
        const int b = bg >> 4, g = bg & 15;
        const float dt = expf(log_dt[g]);
        float are[2], aim[2]; bf16x8_t Bre[2], Bim[2];
#pragma unroll
        for (int k = 0; k < 2; ++k) {
            const int p = 32 * k + l31;
            const float lr = lam_re[g * 64 + p], li = lam_im[g * 64 + p];
            const float mag = expf(lr * dt);
            are[k] = mag * cosf(li * dt); aim[k] = mag * sinf(li * dt);
            const float nr = are[k] - 1.f, den = lr * lr + li * li;
            const float fre = (nr * lr + aim[k] * li) / den, fim = (aim[k] * lr - nr * li) / den;
            float vr[8], vi[8];
#pragma unroll
            for (int j = 0; j < 8; ++j) {
                const float br = b_re[(g * 64 + p) * 16 + 8 * h + j], bi = b_im[(g * 64 + p) * 16 + 8 * h + j];
                vr[j] = fre * br - fim * bi; vi[j] = fre * bi + fim * br;
            }
            u32x4 w; w.x = cvtpk(vr[0], vr[1]); w.y = cvtpk(vr[2], vr[3]); w.z = cvtpk(vr[4], vr[5]); w.w = cvtpk(vr[6], vr[7]); Bre[k] = __builtin_bit_cast(bf16x8_t, w);
            w.x = cvtpk(vi[0], vi[1]); w.y = cvtpk(vi[2], vi[3]); w.z = cvtpk(vi[4], vi[5]); w.w = cvtpk(vi[6], vi[7]); Bim[k] = __builtin_bit_cast(bf16x8_t, w);
        }
        bf16x8_t Cm[5];
        {
            const float di = dskip[g * 16 + fr];
#pragma unroll
            for (int ks = 0; ks < 5; ++ks) {
                float cv[8];
#pragma unroll
                for (int j = 0; j < 8; ++j) {
                    const int kk = 32 * ks + 8 * fq + j;
                    cv[j] = kk < 64 ? c_re[(g * 16 + fr) * 64 + kk] : (kk < 128 ? -c_im[(g * 16 + fr) * 64 + kk - 64] : ((kk - 128) == fr ? di : 0.f));
                }
                u32x4 w; w.x = cvtpk(cv[0], cv[1]); w.y = cvtpk(cv[2], cv[3]); w.z = cvtpk(cv[4], cv[5]); w.w = cvtpk(cv[6], cv[7]); Cm[ks] = __builtin_bit_cast(bf16x8_t, w);
            }
        }
        float a4r[2], a4i[2], a5r[2], a5i[2], a32r[2], a32i[2], a256r[2], a256i[2];
#pragma unroll
        for (int k = 0; k < 2; ++k) {
            float pr = are[k], pi = aim[k], t;
            t = pr * pr - pi * pi; pi = 2.f * pr * pi; pr = t;
            t = pr * pr - pi * pi; pi = 2.f * pr * pi; pr = t;
            a4r[k] = pr; a4i[k] = pi;
            a5r[k] = pr * are[k] - pi * aim[k]; a5i[k] = pr * aim[k] + pi * are[k];
#pragma unroll
            for (int i = 0; i < 3; ++i) { t = pr * pr - pi * pi; pi = 2.f * pr * pi; pr = t; }
            a32r[k] = pr; a32i[k] = pi;
#pragma unroll
            for (int i = 0; i < 3; ++i) { t = pr * pr - pi * pi; pi = 2.f * pr * pi; pr = t; }
            a256r[k] = pr; a256i[k] = pi;
        }
        const bf16_t* ub = proj + (size_t)(b * NL + 256 * wave) * P0W + g * 16 + 8 * h;
        float sre[2] = {0.f, 0.f}, sim[2] = {0.f, 0.f};
        bf16x8_t ufn = *(const bf16x8_t*)(ub + (size_t)l31 * P0W);
#pragma unroll 1
        for (int c0 = 0; c0 < 256; c0 += 32) {
            const bf16x8_t uf = ufn;
            ufn = *(const bf16x8_t*)(ub + (size_t)(((c0 + 32) & 255) + l31) * P0W);
#pragma unroll
            for (int k = 0; k < 2; ++k) {
                f32x16 z;
#pragma unroll
                for (int i = 0; i < 16; ++i) z[i] = 0.f;
                const f32x16 bur = MFMA32(uf, Bre[k], z), bui = MFMA32(uf, Bim[k], z);
                float er = 0.f, ei = 0.f;
#pragma unroll
                for (int reg = 0; reg < 16; ++reg) {
                    if (reg == 0) { er = bur[0]; ei = bui[0]; }
                    else if ((reg & 3) == 0) cmadd(er, ei, a5r[k], a5i[k], bur[reg], bui[reg]);
                    else cmadd(er, ei, are[k], aim[k], bur[reg], bui[reg]);
                }
                { float tr = er, ti = ei; cmadd(tr, ti, a4r[k], a4i[k], 0.f, 0.f); er = h ? er : tr; ei = h ? ei : ti; }
                er += __shfl_xor(er, 32); ei += __shfl_xor(ei, 32);
                cmadd(sre[k], sim[k], a32r[k], a32i[k], er, ei);
            }
        }
        __syncthreads();
        if (h == 0) {
#pragma unroll
            for (int k = 0; k < 2; ++k) { Es[(wave * 64 + 32 * k + l31) * 2] = sre[k]; Es[(wave * 64 + 32 * k + l31) * 2 + 1] = sim[k]; }
        }
        __syncthreads();
        float xre[2] = {0.f, 0.f}, xim[2] = {0.f, 0.f};
        for (int w2 = 0; w2 < wave; ++w2) {
#pragma unroll
            for (int k = 0; k < 2; ++k) cmadd(xre[k], xim[k], a256r[k], a256i[k], Es[(w2 * 64 + 32 * k + l31) * 2], Es[(w2 * 64 + 32 * k + l31) * 2 + 1]);
        }
#pragma unroll 1
        for (int c0 = 0; c0 < 256; c0 += 32) {
            const bf16x8_t uf = ufn;
            ufn = *(const bf16x8_t*)(ub + (size_t)(((c0 + 32) & 255) + l31) * P0W);
            wave_lds_fence();
            *(bf16x8_t*)(Xs + l31 * 336 + 256 + 16 * h) = uf;
#pragma unroll
            for (int k = 0; k < 2; ++k) {
                f32x16 z;
#pragma unroll
                for (int i = 0; i < 16; ++i) z[i] = 0.f;
                const f32x16 bur = MFMA32(uf, Bre[k], z), bui = MFMA32(uf, Bim[k], z);
                float cr = xre[k], ci = xim[k];
#pragma unroll
                for (int q = 0; q < 4; ++q) {
                    float ar_[4], ai_[4], br_[4], bi_[4];
                    float xr_ = cr, xi_ = ci;
#pragma unroll
                    for (int r2 = 0; r2 < 4; ++r2) { cmadd(xr_, xi_, are[k], aim[k], bur[4 * q + r2], bui[4 * q + r2]); ar_[r2] = xr_; ai_[r2] = xi_; }
                    float yr_ = __shfl_xor(xr_, 32), yi_ = __shfl_xor(xi_, 32);
#pragma unroll
                    for (int r2 = 0; r2 < 4; ++r2) { cmadd(yr_, yi_, are[k], aim[k], bur[4 * q + r2], bui[4 * q + r2]); br_[r2] = yr_; bi_[r2] = yi_; }
                    const float zr_ = __shfl_xor(yr_, 32), zi_ = __shfl_xor(yi_, 32);
                    cr = h ? yr_ : zr_; ci = h ? yi_ : zi_;
#pragma unroll
                    for (int r2 = 0; r2 < 4; ++r2) {
                        const int t = 8 * q + 4 * h + r2;
                        *(bf16_t*)(Xs + t * 336 + (32 * k + l31) * 2) = f2bf(h ? br_[r2] : ar_[r2]);
                        *(bf16_t*)(Xs + t * 336 + (64 + 32 * k + l31) * 2) = f2bf(h ? bi_[r2] : ai_[r2]);
                    }
                }
                xre[k] = cr; xim[k] = ci;
            }
            wave_lds_fence();
#pragma unroll
            for (int mt = 0; mt < 2; ++mt) {
                f32x4 y = {0.f, 0.f, 0.f, 0.f};
#pragma unroll
                for (int ks = 0; ks < 5; ++ks) {
                    const bf16x8_t a = *(const bf16x8_t*)(Xs + (16 * mt + fr) * 336 + (32 * ks + 8 * fq) * 2);
                    y = __builtin_amdgcn_mfma_f32_16x16x32_bf16(a, Cm[ks], y, 0, 0, 0);
                }
#pragma unroll
                for (int reg = 0; reg < 4; ++reg)
                    ya[((size_t)(b * 16 + g) * NL + 256 * wave + c0 + 16 * mt + 4 * fq + reg) * 16 + fr] = f2bf(gelu_fast(y[reg]));
            }
        }
    }
    __syncthreads();
}

struct Params {
    const float* in[29];
    float* out;
    char* ws;
    unsigned long long pad;
};

constexpr size_t SZ_PROJ = (size_t)NT * EVEN_IN * 2;
constexpr size_t SZ_VT = (size_t)768 * NT * 2;
constexpr size_t SZ_YB = (size_t)NT * ND * 2;
constexpr size_t SZ_HB = (size_t)NT * ND * 2;
constexpr size_t SZ_YA = (size_t)NT * 256 * 2;
constexpr size_t SZ_CMP = (size_t)NB * 4 * 128 * 64 * 2;
constexpr size_t SZ_SEL = (size_t)NB * 4 * NL * 4;
constexpr size_t SZ_TAB = (size_t)16384 * ND;
constexpr size_t SZ_SKB = (size_t)2 * 8 * 2 * 128 * 128 * 2;
constexpr size_t OFF_VT = SZ_PROJ, OFF_YB = OFF_VT + SZ_VT, OFF_HB = OFF_YB + SZ_YB, OFF_YA = OFF_HB + SZ_HB, OFF_KC = OFF_YA + SZ_YA, OFF_VC = OFF_KC + SZ_CMP,
                 OFF_SEL = OFF_VC + SZ_CMP, OFF_TAB = OFF_SEL + SZ_SEL, OFF_SKB = OFF_TAB + 2 * SZ_TAB, OFF_WT = OFF_SKB + SZ_SKB;
constexpr size_t WT_IN0 = 0, WT_OUT0 = WT_IN0 + (size_t)EVEN_IN * ND * 2, WT_Q0 = WT_OUT0 + (size_t)ND * ND * 2, WT_Q1 = WT_Q0 + (size_t)2048 * ND * 2,
                 WT_IN1 = WT_Q1 + (size_t)2048 * ND * 2, WT_V1 = WT_IN1 + (size_t)ODD_PAD * ND * 2, WT_OUT1 = WT_V1 + (size_t)512 * ND * 2, WT_W1 = WT_OUT1 + (size_t)ND * ND * 2, WT_W2 = WT_W1 + (size_t)2 * 128 * 2048 * 2, WT_B1 = WT_W2 + (size_t)2 * 64 * 128 * 2, WT_V0 = WT_B1 + 2 * 128 * 4, WT_GLU = WT_V0 + (size_t)768 * ND * 2, WT_END = WT_GLU + (size_t)256 * 256 * 2;
constexpr size_t OFF_PART = OFF_WT + ((WT_END + 255) & ~(size_t)255);
constexpr size_t OFF_CQ = OFF_PART + (size_t)NT * 32 * 4;
constexpr size_t OFF_SU = OFF_CQ + 4 * 2048 * 4;
constexpr size_t OFF_BAR = OFF_SU + 16384 * 4;
constexpr size_t WS_NEED = OFF_BAR + XB_TOTAL_WORDS * 4 + 256;

__device__ __forceinline__ void convert_tables(const float* __restrict__ u, const float* __restrict__ v, unsigned char* __restrict__ TAB, float* __restrict__ SU) {
    {
        const int wave = tidx() >> 6, lane = tidx() & 63;
        for (int r0 = blockIdx.x * 32 + wave * 4; r0 < 16384; r0 += gridDim.x * 32) {
            f32x4 a[4][4];
#pragma unroll
            for (int rr = 0; rr < 4; ++rr)
#pragma unroll
                for (int q = 0; q < 4; ++q) a[rr][q] = __builtin_nontemporal_load((const f32x4*)(u + (size_t)(r0 + rr) * ND + lane * 16 + 4 * q));
#pragma unroll
            for (int rr = 0; rr < 4; ++rr) {
                const int row = r0 + rr;
                float m = 0.f;
#pragma unroll
                for (int q = 0; q < 4; ++q) m = fmaxf(fmaxf(m, fmaxf(fabsf(a[rr][q].x), fabsf(a[rr][q].y))), fmaxf(fabsf(a[rr][q].z), fabsf(a[rr][q].w)));
                for (int o = 32; o; o >>= 1) m = fmaxf(m, __shfl_xor(m, o));
                const float inv = m > 0.f ? 127.f / m : 0.f;
                uint4 w; unsigned* wp = (unsigned*)&w;
#pragma unroll
                for (int q = 0; q < 4; ++q) {
                    const int b0 = (int)rintf(a[rr][q].x * inv), b1 = (int)rintf(a[rr][q].y * inv), b2 = (int)rintf(a[rr][q].z * inv), b3 = (int)rintf(a[rr][q].w * inv);
                    wp[q] = (unsigned)(b0 & 255) | ((unsigned)(b1 & 255) << 8) | ((unsigned)(b2 & 255) << 16) | ((unsigned)b3 << 24);
                }
                *(uint4*)(TAB + (size_t)row * ND + lane * 16) = w;
                if (lane == 0) SU[row] = m * (1.f / 127.f);
            }
        }
    }
    const size_t per = (size_t)16384 * ND / 16;
    const size_t vstride = (size_t)gridDim.x * NTHR;
    for (size_t i = (size_t)blockIdx.x * NTHR + tidx(); i < per; i += 2 * vstride) {
        f32x4 a[2][4];
#pragma unroll
        for (int k = 0; k < 2; ++k)
#pragma unroll
            for (int q = 0; q < 4; ++q) a[k][q] = __builtin_nontemporal_load((const f32x4*)(v + (i + k * vstride) * 16 + 4 * q));
#pragma unroll
        for (int k = 0; k < 2; ++k) {
            uint4 w; unsigned* wp = (unsigned*)&w;
#pragma unroll
            for (int q = 0; q < 4; ++q) {
                int pk = __builtin_amdgcn_cvt_pk_fp8_f32(a[k][q].x * V_SCALE, a[k][q].y * V_SCALE, 0, false);
                pk = __builtin_amdgcn_cvt_pk_fp8_f32(a[k][q].z * V_SCALE, a[k][q].w * V_SCALE, pk, true);
                wp[q] = (unsigned)pk;
            }
            *(uint4*)(TAB + (size_t)16384 * ND + (i + k * vstride) * 16) = w;
        }
    }
}

__device__ __forceinline__ char* wsb(const Params& p) { char* w = p.ws; asm volatile("" : "+s"(w)); return w; }
#define PROJ ((bf16_t*)wsb(p))
#define YB ((bf16_t*)(wsb(p) + OFF_YB))
#define HB ((bf16_t*)(wsb(p) + OFF_HB))
#define YA ((bf16_t*)(wsb(p) + OFF_YA))
#define WGT ((bf16_t*)(wsb(p) + OFF_WT + WT_GLU))
#define KCMP ((bf16_t*)(wsb(p) + OFF_KC))
#define VCMP ((bf16_t*)(wsb(p) + OFF_VC))
#define W1T ((bf16_t*)(wsb(p) + OFF_WT + WT_W1))
#define W2T ((bf16_t*)(wsb(p) + OFF_WT + WT_W2))
#define BIAS1 ((float*)(wsb(p) + OFF_WT + WT_B1))
#define SEL ((unsigned*)(wsb(p) + OFF_SEL))
#define WIN0 ((bf16_t*)(wsb(p) + OFF_WT + WT_IN0))
#define WOUT0 ((bf16_t*)(wsb(p) + OFF_WT + WT_OUT0))
#define WQ0 ((bf16_t*)(wsb(p) + OFF_WT + WT_Q0))
#define WQ1 ((bf16_t*)(wsb(p) + OFF_WT + WT_Q1))
#define WIN1 ((bf16_t*)(wsb(p) + OFF_WT + WT_IN1))
#define WOUT1 ((bf16_t*)(wsb(p) + OFF_WT + WT_OUT1))
#define WV1 ((bf16_t*)(wsb(p) + OFF_WT + WT_V1))
#define VT ((bf16_t*)(wsb(p) + OFF_VT))
#define WV0 ((bf16_t*)(wsb(p) + OFF_WT + WT_V0))
#define EIDX ((int*)YB)
#define EGATE ((float*)((char*)YB + (size_t)NT * 128 * 4))
#define TAB ((unsigned char*)(wsb(p) + OFF_TAB))
#define SKB ((bf16_t*)(wsb(p) + OFF_SKB))
__global__ void __launch_bounds__(NTHR) fwd_megakernel(Params p) {
    extern __shared__ __attribute__((aligned(16))) unsigned char lds_raw[];
    float* lds = (float*)lds_raw;
    cg::grid_group grid = cg::this_grid();
    const float* x = p.in[0];
    float* R = p.out;
    char* ws = wsb(p);
    const int wave = tidx() >> 6;
    if (tidx() == 0) *(uint4*)(lds_raw + LDS_BYTES - 16) = make_uint4(0u, 0u, 0u, 0u);
    __syncthreads();
    XcdBarrier xbar = xcd_barrier_post((unsigned*)(ws + OFF_BAR), (volatile LAS unsigned*)(lds_raw + LDS_BYTES - 16));

    {
        const size_t nvec = (size_t)NT * ND / 4, stride = (size_t)gridDim.x * NTHR;
        for (size_t i = (size_t)blockIdx.x * NTHR + tidx(); i < nvec; i += 8 * stride) {
            f32x4 v[8];
#pragma unroll
            for (int k = 0; k < 8; ++k) v[k] = __builtin_nontemporal_load((const f32x4*)x + i + k * stride);
#pragma unroll
            for (int k = 0; k < 8; ++k) { uint2 w; w.x = pack2(v[k][0], v[k][1]); w.y = pack2(v[k][2], v[k][3]); ((uint2*)HB)[i + k * stride] = w; }
        }
    }
    convert_tables(p.in[23], p.in[24], TAB, (float*)(ws + OFF_SU));
    for (int i = blockIdx.x * NTHR + tidx(); i < 2 * 8 * 2 * 128 * 128 / 4; i += gridDim.x * NTHR) {
        const float4 a = ((const float4*)p.in[22])[i];
        uint2 w; w.x = pack2(a.x, a.y); w.y = pack2(a.z, a.w);
        ((uint2*)SKB)[i] = w;
    }
    convert_wt_phase(p.in[1], ND, EVEN_IN, P0W, ColMap{{0, 0, 0}, {0, 0, 0}, {P0W, 0, 0}}, WIN0, lds);
    convert_wt_phase(p.in[1], ND, EVEN_IN, 768, ColMap{{0, 0, 0}, {P0W, 0, 0}, {768, 0, 0}}, WV0, lds);
    convert_wt_phase(p.in[12], ND, ND, ND, ColMap{{0, 0, 0}, {0, 0, 0}, {ND, 0, 0}}, WOUT0, lds);
    convert_wt_phase(p.in[10], 256, 256, 256, ColMap{{0, 0, 0}, {0, 0, 0}, {256, 0, 0}}, WGT, lds);
    convert_wt_phase(p.in[21], ND, 2048, 2048, ColMap{{0, 0, 0}, {0, 0, 0}, {2048, 0, 0}}, WQ0, lds, p.in[25]);
    convert_wt_phase(p.in[21] + (size_t)ND * 2048, ND, 2048, 2048, ColMap{{0, 0, 0}, {0, 0, 0}, {2048, 0, 0}}, WQ1, lds, p.in[25] + ND);
    {
        float* CQ = (float*)(ws + OFF_CQ);
        const int kp = tidx() >> 5, cl32 = tidx() & 31, gcol = blockIdx.x * 32 + cl32;
        if (blockIdx.x < 128) {
            const int layer = gcol >> 11, n = gcol & 2047;
            const float* W = p.in[21] + (size_t)layer * ND * 2048;
            const float* gam = p.in[25] + layer * ND; const float* bet = p.in[26] + layer * ND;
            float c = 0.f, d = 0.f;
            for (int k = kp; k < ND; k += 16) { const float w = W[(size_t)k * 2048 + n]; c += bf2f(f2bf(gam[k] * w)); d += bet[k] * w; }
            c += __shfl_xor(c, 32); d += __shfl_xor(d, 32);
            __syncthreads();
            if ((tidx() & 63) < 32) { lds[(tidx() >> 6) * 64 + cl32] = c; lds[(tidx() >> 6) * 64 + 32 + cl32] = d; }
            __syncthreads();
            if (tidx() < 32) {
                float cs = 0.f, ds = 0.f;
#pragma unroll
                for (int w8 = 0; w8 < 8; ++w8) { cs += lds[w8 * 64 + tidx()]; ds += lds[w8 * 64 + 32 + tidx()]; }
                CQ[layer * 2048 + n] = cs; CQ[4096 + layer * 2048 + n] = ds;
            }
            __syncthreads();
        }
    }
    convert_wt_phase(p.in[13], ND, ODD_IN, ODD_PAD, ColMap{{0, 1792, 2048}, {0, 2048, 2560}, {1792, 256, 48}}, WIN1, lds);
    convert_wt_phase(p.in[13], ND, ODD_IN, 512, ColMap{{0, 256, 0}, {1792, 2304, 0}, {256, 256, 0}}, WV1, lds);
    convert_wt_phase(p.in[20], ND, ND, ND, ColMap{{0, 0, 0}, {0, 0, 0}, {ND, 0, 0}}, WOUT1, lds);
    convert_wt_phase(p.in[15], 2048, 128, 128, ColMap{{0, 0, 0}, {0, 0, 0}, {128, 0, 0}}, W1T, lds);
    convert_wt_phase(p.in[18], 2048, 128, 128, ColMap{{0, 0, 0}, {0, 0, 0}, {128, 0, 0}}, W1T + 128 * 2048, lds);
    convert_wt_phase(p.in[16], 128, 64, 64, ColMap{{0, 0, 0}, {0, 0, 0}, {64, 0, 0}}, W2T, lds);
    convert_wt_phase(p.in[19], 128, 64, 64, ColMap{{0, 0, 0}, {0, 0, 0}, {64, 0, 0}}, W2T + 64 * 128, lds);
    if (blockIdx.x < 8) {
        const int which = blockIdx.x >> 2, j = (blockIdx.x & 3) * 32 + (tidx() >> 4), part = tidx() & 15;
        const float* pe = which ? p.in[17] : p.in[14];
        const float* w1 = which ? p.in[18] : p.in[15];
        float a = 0.f;
#pragma unroll 8
        for (int i = part; i < 2048; i += 16) a += pe[i] * w1[(size_t)i * 128 + j];
        for (int o = 8; o; o >>= 1) a += __shfl_xor(a, o);
        if (part == 0) BIAS1[which * 128 + j] = a;
    }
    xcd_barrier(xbar);
    if (p.pad == 0x5eedull) grid.sync();
    PDUP(0) { PH(0) gemm_bf16_phase(lds_raw, HB, WIN0, NT, P0W, ND, EpiBf16s{PROJ, P0W});
    PH(0) gemm_bf16_phase(lds_raw, WV0, HB, 768, NT, ND, EpiBf16s{VT, NT}, true); }
    xcd_barrier(xbar);
    PDUP(1) { PH(1) s5_scan3_phase(PROJ, p.in[2], p.in[3], p.in[4], p.in[5], p.in[6], p.in[7], p.in[8], p.in[9], YA, lds_raw);
    PH(2) sb_attn2_phase(PROJ, VT, YB, lds_raw);
    if ((PROBE >> 13) & 1) {
        bf16_t* SCR = PROJ + (size_t)NT * P0W;
        s5_scan2_phase(PROJ, p.in[2], p.in[3], p.in[4], p.in[5], p.in[6], p.in[7], p.in[8], p.in[9], SCR, lds);
        xcd_barrier(xbar);
        float d2 = 0.f, n2 = 0.f;
        for (size_t i = (size_t)blockIdx.x * NTHR + tidx(); i < (size_t)NT * 256; i += (size_t)gridDim.x * NTHR) { const float a = bf2f(YA[i]), r = bf2f(SCR[i]); d2 += (a - r) * (a - r); n2 += r * r; }
        for (int o = 32; o; o >>= 1) { d2 += __shfl_xor(d2, o); n2 += __shfl_xor(n2, o); }
        float* chk = (float*)(ws + OFF_BAR + XB_TOTAL_WORDS * 4);
        if ((tidx() & 63) == 0) { atomicAdd(chk, d2); atomicAdd(chk + 1, n2); }
    }
    if (_rep == 0 && ((PROBE >> 1) & 1)) xcd_barrier(xbar); }
    xcd_barrier(xbar);
    PDUP(2) PH(3) glu2_phase(YA, WGT, p.in[11], YB, lds_raw);
    xcd_barrier(xbar);
    PH(4) gemm_bf16_phase(lds_raw, YB, WOUT0, NT, ND, ND, EpiResStats<false>{x, HB, (float*)(ws + OFF_PART)});
    xcd_barrier(xbar);
#define PEER_FFN(layer, WQ, last) \
    PH(12) gemm_q_phase(lds_raw, HB, WQ, (const float*)(ws + OFF_PART), (const float*)(ws + OFF_CQ) + (layer) * 2048, (const float*)(ws + OFF_CQ) + 4096 + (layer) * 2048, PROJ); \
    xcd_barrier(xbar); \
    PDUP(4) PH(13) peer_route2_phase(PROJ, SKB + (size_t)(layer) * 8 * 2 * 128 * 128, EIDX, EGATE, lds_raw); \
    xcd_barrier(xbar); \
    if ((PROBE >> 5) & 1) { peer_expert3_phase(R, EIDX, EGATE, TAB, TAB + (size_t)16384 * ND, p.in[27] + (layer) * ND, p.in[28] + (layer) * ND, nullptr, (float*)PROJ, xbar); xcd_barrier(xbar); } \
    PH(14) peer_expert10_phase((last) ? R : nullptr, HB, EIDX, EGATE, TAB, TAB + (size_t)16384 * ND, p.in[27] + (layer) * ND, p.in[28] + (layer) * ND, (last) ? nullptr : HB, xbar, lds, p.in[25] + (layer) * ND, p.in[26] + (layer) * ND, (const float*)(ws + OFF_SU)); \
    if (!(last)) xcd_barrier(xbar);
    PEER_FFN(0, WQ0, false)
    convert_tables(p.in[23] + (size_t)16384 * ND, p.in[24] + (size_t)16384 * ND, TAB, (float*)(ws + OFF_SU));
    PDUP(0) { PH(6) gemm_bf16_phase(lds_raw, HB, WIN1, NT, ODD_PAD, ND, EpiBf16s{PROJ, ODD_PAD});
    PH(6) gemm_bf16_phase(lds_raw, WV1, HB, 512, NT, ND, EpiBf16s{VT, NT}); }
    xcd_barrier(xbar);
    PDUP(6) PH(7) nsa_compress2_phase(PROJ, W1T, W2T, BIAS1, KCMP, VCMP, lds_raw);
    xcd_barrier(xbar);
    PDUP(7) { PH(8) nsa_fused_phase(PROJ, KCMP, VCMP, VT, YB, lds_raw); }
    xcd_barrier(xbar);
    PH(10) gemm_bf16_phase(lds_raw, YB, WOUT1, NT, ND, ND, EpiResStats<true>{HB, HB, (float*)(ws + OFF_PART)});
    xcd_barrier(xbar);
    PEER_FFN(1, WQ1, true)
    if ((PROBE >> 13) & 1) {
        xcd_barrier(xbar);
        const float* chk = (const float*)(ws + OFF_BAR + XB_TOTAL_WORDS * 4);
        const float d2 = __hip_atomic_load(chk, __ATOMIC_RELAXED, __HIP_MEMORY_SCOPE_AGENT), n2 = __hip_atomic_load(chk + 1, __ATOMIC_RELAXED, __HIP_MEMORY_SCOPE_AGENT);
        if (!(d2 <= 1e-4f * n2)) for (size_t i = (size_t)blockIdx.x * NTHR + tidx(); i < (size_t)NT * ND; i += (size_t)gridDim.x * NTHR) R[i] *= 2.f;
    }
}

}

extern "C" void kernel_launch(void* const* d_in, const int* in_sizes, int n_in, void* d_out, int out_size, void* d_ws, size_t ws_size, hipStream_t stream) {
    static int grid_blocks = 0;
    if (grid_blocks == 0) {
        if (n_in != 29 || out_size != NT * ND || ws_size < WS_NEED) { fprintf(stderr, "kernel_launch: unexpected shapes / workspace (%zu < %zu)\n", ws_size, (size_t)WS_NEED); grid_blocks = -1; return; }
        int dev = 0, cus = 0, per_cu = 0;
        hipGetDevice(&dev);
        hipDeviceGetAttribute(&cus, hipDeviceAttributeMultiprocessorCount, dev);
        hipFuncSetAttribute((const void*)fwd_megakernel, hipFuncAttributeMaxDynamicSharedMemorySize, LDS_BYTES);
        hipOccupancyMaxActiveBlocksPerMultiprocessor(&per_cu, (const void*)fwd_megakernel, NTHR, LDS_BYTES);
        if (per_cu < 1) { fprintf(stderr, "kernel_launch: occupancy query says %d blocks/CU\n", per_cu); grid_blocks = -1; return; }
        grid_blocks = cus;
    }
    if (grid_blocks < 0) return;
    hipMemsetAsync((char*)d_ws + OFF_BAR, 0, XB_TOTAL_WORDS * 4 + 256, stream);
    Params p{};
    for (int i = 0; i < 29; ++i) p.in[i] = (const float*)d_in[i];
    p.out = (float*)d_out; p.ws = (char*)d_ws; p.pad = 0;
    void* args[] = {&p};
    hipError_t e = hipLaunchCooperativeKernel((const void*)fwd_megakernel, dim3(grid_blocks), dim3(NTHR), args, LDS_BYTES, stream);
    if (e != hipSuccess) fprintf(stderr, "cooperative launch failed: %s (grid %d)\n", hipGetErrorString(e), grid_blocks);
}
```

```cpp
#include <hip/hip_runtime.h>
#include <hip/hip_cooperative_groups.h>
#include <math.h>
#include <stdint.h>
#include <cstdio>
#include <type_traits>
namespace cg = cooperative_groups;

__device__ __forceinline__ int tidx() { int t = threadIdx.x; asm volatile("" : "+v"(t)); return t; }
#define XB_TMO      128
#define XB_XCNT(j)  (256  + 64 * (j))
#define XB_XSUB(j)  (1280 + 64 * (j))
#define XB_XGEN(j)  (2304 + 64 * (j))
#define XB_TOP      3328
#define XB_TOPGEN   3392
#define XCD_BAR_WORDS 3456
#define XB_SPIN_CAP (1u << 18)
#define LAS __attribute__((address_space(3)))

__device__ __forceinline__ unsigned xb_ld(unsigned* p)              { return __hip_atomic_load(p, __ATOMIC_RELAXED, __HIP_MEMORY_SCOPE_AGENT); }
__device__ __forceinline__ unsigned xb_add(unsigned* p, unsigned v) { return __hip_atomic_fetch_add(p, v, __ATOMIC_RELAXED, __HIP_MEMORY_SCOPE_AGENT); }
__device__ __forceinline__ unsigned xb_xcc_id() { return (unsigned)__builtin_amdgcn_s_getreg((3 << 11) | 20) & 0xFu; }
#define XB_SPIN(cond, bar) do { unsigned _sp = 0; while (cond) { __builtin_amdgcn_s_sleep(1); \
    if ((++_sp & 255u) == 0u) { if (xb_ld(&(bar)[XB_TMO])) break; if (_sp > XB_SPIN_CAP) { atomicAdd(&(bar)[XB_TMO], 1u); break; } } } } while (0)

struct XcdBarrier {
    unsigned* bar; unsigned x;
    volatile LAS unsigned* st;
};

__device__ __forceinline__ XcdBarrier xcd_barrier_post(unsigned* bar, volatile LAS unsigned* st) {
    XcdBarrier b; b.bar = bar; b.x = xb_xcc_id(); b.st = st;
    if (tidx() == 0) (void)xb_add(&bar[XB_XCNT(b.x)], 1u);
    return b;
}
__device__ __forceinline__ void xcd_barrier_complete(unsigned* bar, unsigned x, unsigned& nloc, unsigned& nx) {
    const unsigned G = gridDim.x * gridDim.y * gridDim.z;
    unsigned sum, cnt, mine, sp = 0u;
    for (;;) {
        sum = 0u; cnt = 0u; mine = 0u;
#pragma unroll
        for (unsigned j = 0; j < 16; ++j) { const unsigned c = xb_ld(&bar[XB_XCNT(j)]); sum += c; cnt += (c > 0u) ? 1u : 0u; mine = (j == x) ? c : mine; }
        if (sum == G) break;
        __builtin_amdgcn_s_sleep(1);
        if ((++sp & 255u) == 0u) { if (xb_ld(&bar[XB_TMO])) break; if (sp > XB_SPIN_CAP) { atomicAdd(&bar[XB_TMO], 1u); break; } }
    }
    nloc = mine > 0u ? mine : 1u; nx = cnt > 0u ? cnt : 1u;
}

__device__ __forceinline__ void xcd_barrier(const XcdBarrier& b) {
    asm volatile("s_waitcnt vmcnt(0)" ::: "memory");
    __syncthreads();
    if (tidx() == 0) {
        unsigned* bar = b.bar;
        __builtin_amdgcn_s_waitcnt(0);
        unsigned nloc = b.st[0], nx = b.st[1];
        if (nloc == 0u) { xcd_barrier_complete(bar, b.x, nloc, nx); b.st[0] = nloc; b.st[1] = nx; }
        const unsigned old = xb_add(&bar[XB_XSUB(b.x)], 1u);
        const unsigned gen = old / nloc;
        if (old + 1u == (gen + 1u) * nloc) {
            __builtin_amdgcn_fence(__ATOMIC_RELEASE, "");
            asm volatile("s_waitcnt vmcnt(0)" ::: "memory");
            const unsigned og = xb_add(&bar[XB_TOP], 1u);
            const unsigned tg = og / nx;
            if (og + 1u == (tg + 1u) * nx) xb_add(&bar[XB_TOPGEN], 1u);
            else XB_SPIN(xb_ld(&bar[XB_TOPGEN]) == tg, bar);
            __builtin_amdgcn_fence(__ATOMIC_ACQUIRE, "");
            xb_add(&bar[XB_XGEN(b.x)], 1u);
            asm volatile("s_waitcnt vmcnt(0)" ::: "memory");
        } else {
            XB_SPIN(xb_ld(&bar[XB_XGEN(b.x)]) == gen, bar);
            __builtin_amdgcn_fence(__ATOMIC_ACQUIRE, "");
            asm volatile("s_waitcnt vmcnt(0)" ::: "memory");
        }
    }
    __syncthreads();
}

#define XB_ALIGN(j) (XCD_BAR_WORDS + 64 * (j))
#define XB_TOTAL_WORDS (XCD_BAR_WORDS + 64 * 16)
__device__ __forceinline__ void xcc_align(const XcdBarrier& b) {
    __syncthreads();
    if (tidx() == 0) {
        const unsigned nloc = b.st[0];
        if (nloc) {
            const unsigned old = xb_add(&b.bar[XB_ALIGN(b.x)], 1u), gen = old / nloc;
            unsigned sp = 0;
            while (xb_ld(&b.bar[XB_ALIGN(b.x)]) < (gen + 1u) * nloc && ++sp < (1u << 16)) __builtin_amdgcn_s_sleep(1);
        }
    }
    __syncthreads();
}
namespace pg8 {
#define PG8_LAS __attribute__((address_space(3)))
typedef unsigned short bf16_t;
typedef short bf16x8 __attribute__((ext_vector_type(8)));
typedef float f32x4 __attribute__((ext_vector_type(4)));
typedef unsigned u32x4 __attribute__((ext_vector_type(4)));
constexpr int BM = 256, BK = 64, HALF = 128, HTB = HALF * BK * 2  , STAGE_BYTES = 8 * HTB, NXCD = 8, WGM = 8;

__host__ __device__ __forceinline__ int lds_byte(int r, int c) { const int st = (r >> 4) * 2 + (c >> 5), rr = r & 15, cc = c & 31, ob = rr * 64 + cc * 2; return st * 1024 + (ob ^ (((ob >> 9) & 1) << 5)); }
__host__ __device__ __forceinline__ void stage_rc(int b, int& R, int& C) { const int st = b / 1024, sb = b % 1024, swz = sb ^ (((sb >> 9) & 1) << 5); R = (st >> 1) * 16 + swz / 64; C = (st & 1) * 32 + (swz % 64) / 2; }
__host__ __device__ __forceinline__ int perm32(int rho) { const int n = rho >> 4, i = rho & 15; return 8 * (i >> 2) + 4 * n + (i & 3); }

struct Unit { int pm, pn; };
struct Gemm { const bf16_t* A; const bf16_t* Bt; int M, N, K; };

struct StaticOrder {
    int nM, nN, nwg, G, c;
    __host__ __device__ void init(int M, int N, int G_, int c_) { nM = M / BM; nN = N / BM; nwg = nM * nN; G = G_; c = c_; }
    __host__ __device__ bool next(int i, Unit& u) const {
        const long L = (long)i * G + c; if (L >= nwg) return false;
        int wgid = (int)L; { const int q = nwg / NXCD, r = nwg % NXCD, xcd = wgid % NXCD, off = wgid / NXCD; wgid = (xcd < r ? xcd * (q + 1) : r * (q + 1) + (xcd - r) * q) + off; }
        const int nig = WGM * nN, gid = wgid / nig, fm = gid * WGM, gsz = (nM - fm) < WGM ? (nM - fm) : WGM;
        u.pm = fm + ((wgid % nig) % gsz); u.pn = (wgid % nig) / gsz; return true;
    }
    __device__ __forceinline__ void a_ready(const Unit&) const {}
    __device__ __forceinline__ void done(const Unit&) const {}
};
__device__ __forceinline__ unsigned cvt_pk_bf16(float lo, float hi) { unsigned r; asm volatile("v_cvt_pk_bf16_f32 %0, %1, %2" : "=v"(r) : "v"(lo), "v"(hi)); return r; }
template <class Epi, class Sched, bool STAMP = false>
__device__ __forceinline__ void gemm_phase(PG8_LAS unsigned char* lds, const Gemm g, const Sched& S, const Epi& E, unsigned long long* stamps) {
    const int tid = tidx(), wid = __builtin_amdgcn_readfirstlane(tid >> 6), lane = tid & 63, wr = wid >> 2, wc = wid & 3, fr = lane & 15, fq = lane >> 4;
    const int K = g.K, nt = K / BK;
    int ts_lo = 0, ts_hi = 0, nts = 0; const unsigned long long rt_entry = STAMP ? (unsigned long long)wall_clock64() : 0ull;
#define PG8_STAMP() do { if (STAMP && wid == 0 && nts < 64) { const unsigned long long _c = (unsigned long long)clock64(); \
        ts_lo = (lane == nts) ? (int)(unsigned)_c : ts_lo; ts_hi = (lane == nts) ? (int)(unsigned)(_c >> 32) : ts_hi; ++nts; } } while (0)
    PG8_STAMP();
    unsigned voffA[2], voffB[2];
#pragma unroll
    for (int i = 0; i < 2; ++i) { int R, C; stage_rc(tid * 16 + i * 8192, R, C); const int Rb = Epi::PERM ? ((R & ~31) + perm32(R & 31)) : R;
        voffA[i] = (unsigned)(R * K + C) * 2u; voffB[i] = (unsigned)(Rb * K + C) * 2u; }
    const size_t kstep = (size_t)(BK * 2);
    const size_t hstep = (size_t)HALF * K * 2;
    const size_t tstep = 2 * hstep;
    const unsigned ldsw = (unsigned)wid * 1024u;
    const int aoff = lds_byte(wr * 64 + fr, fq * 8), boff = lds_byte(wc * 32 + fr, fq * 8);
#define PG8_SA(b, h) (((b) * 2 + (h)) * HTB)
#define PG8_SB(b, h) ((4 + (b) * 2 + (h)) * HTB)
#define PG8_STAGE(bufoff, gbase, voff) do { _Pragma("unroll") for (int _i = 0; _i < 2; ++_i) \
        __builtin_amdgcn_global_load_lds((const unsigned*)((const char*)(gbase) + (voff)[_i]), (PG8_LAS unsigned*)(lds + (bufoff) + ldsw + _i * 8192), 16, 0, 0); } while (0)
#define PG8_LDA(dst, b, h) do { _Pragma("unroll") for (int m = 0; m < 4; ++m) _Pragma("unroll") for (int k = 0; k < 2; ++k) dst[m][k] = *(const PG8_LAS bf16x8*)(lds + PG8_SA(b, h) + aoff + m * 2048 + k * 1024); } while (0)
#define PG8_LDB(dst, b, h) do { _Pragma("unroll") for (int n = 0; n < 2; ++n) _Pragma("unroll") for (int k = 0; k < 2; ++k) dst[n][k] = *(const PG8_LAS bf16x8*)(lds + PG8_SB(b, h) + boff + n * 2048 + k * 1024); } while (0)
#define PG8_MMA(ai, bj, At, Bt) do { __builtin_amdgcn_s_setprio(1); _Pragma("unroll") for (int m = 0; m < 4; ++m) _Pragma("unroll") for (int n = 0; n < 2; ++n) _Pragma("unroll") for (int k = 0; k < 2; ++k) \
        acc[ai][bj][m][n] = __builtin_amdgcn_mfma_f32_16x16x32_bf16(Bt[n][k], At[m][k], acc[ai][bj][m][n], 0, 0, 0); __builtin_amdgcn_s_setprio(0); } while (0)
#define PG8_WAIT_V(n) asm volatile("s_waitcnt vmcnt(" #n ")" ::: "memory")
#define PG8_WAIT_L(n) asm volatile("s_waitcnt lgkmcnt(" #n ")" ::: "memory")
#define PG8_BAR __builtin_amdgcn_s_barrier()
#define PG8_SCHED __builtin_amdgcn_sched_barrier(0)
    Unit cur, nxt; int ui = 0;
    if (!S.next(0, cur)) return;
    f32x4 acc[2][2][4][2];
#pragma unroll
    for (int a = 0; a < 2; ++a)
#pragma unroll
        for (int b = 0; b < 2; ++b)
#pragma unroll
            for (int m = 0; m < 4; ++m)
#pragma unroll
                for (int n = 0; n < 2; ++n) acc[a][b][m][n] = (f32x4){0.f, 0.f, 0.f, 0.f};
    bf16x8 At[4][2], B0[2][2], B1[2][2];
    const char* cA = (const char*)g.A + (size_t)cur.pm * tstep; const char* cB = (const char*)g.Bt + (size_t)cur.pn * tstep;
    S.a_ready(cur);
    PG8_STAGE(PG8_SB(0, 0), cB, voffB); PG8_STAGE(PG8_SA(0, 0), cA, voffA); PG8_STAGE(PG8_SB(0, 1), cB + hstep, voffB); PG8_STAGE(PG8_SA(0, 1), cA + hstep, voffA);
    if (wr == 1) PG8_BAR;
    PG8_WAIT_V(4); PG8_BAR;
    PG8_STAGE(PG8_SB(1, 0), cB + kstep, voffB); PG8_STAGE(PG8_SA(1, 0), cA + kstep, voffA); PG8_STAGE(PG8_SB(1, 1), cB + hstep + kstep, voffB);
    PG8_WAIT_V(6); PG8_BAR;
    PG8_STAMP();
    for (;;) {
        const bool has_next = S.next(ui + 1, nxt);
        const char* nA = has_next ? (const char*)g.A + (size_t)nxt.pm * tstep : cA; const char* nB = has_next ? (const char*)g.Bt + (size_t)nxt.pn * tstep : cB;
        for (int t = 0; t < nt; t += 2) {
            const bool last = (t == nt - 2);
            const char* a1 = cA + (size_t)(t + 1) * kstep;
            const char* a2 = last ? nA : cA + (size_t)(t + 2) * kstep; const char* b2 = last ? nB : cB + (size_t)(t + 2) * kstep;
            const char* a3 = a2 + kstep; const char* b3 = b2 + kstep;
            if (last && has_next) S.a_ready(nxt);
            PG8_LDB(B0, 0, 0); PG8_SCHED; PG8_LDA(At, 0, 0); PG8_STAGE(PG8_SA(1, 1), a1 + hstep, voffA);
            PG8_WAIT_L(8); PG8_BAR; PG8_WAIT_L(0); PG8_MMA(0, 0, At, B0); PG8_BAR; PG8_SCHED;
            PG8_LDB(B1, 0, 1); PG8_STAGE(PG8_SB(0, 0), b2, voffB);
            PG8_BAR; PG8_WAIT_L(0); PG8_MMA(0, 1, At, B1); PG8_BAR;
            PG8_LDA(At, 0, 1); PG8_STAGE(PG8_SA(0, 0), a2, voffA);
            PG8_BAR; PG8_WAIT_L(0); PG8_MMA(1, 0, At, B0); PG8_BAR; PG8_SCHED;
            PG8_STAGE(PG8_SB(0, 1), b2 + hstep, voffB);
            PG8_WAIT_V(6); PG8_BAR; PG8_MMA(1, 1, At, B1); PG8_BAR;
            PG8_LDB(B0, 1, 0); PG8_SCHED; PG8_LDA(At, 1, 0); PG8_STAGE(PG8_SA(0, 1), a2 + hstep, voffA);
            PG8_WAIT_L(8); PG8_BAR; PG8_WAIT_L(0); PG8_MMA(0, 0, At, B0); PG8_BAR; PG8_SCHED;
            PG8_LDB(B1, 1, 1); PG8_STAGE(PG8_SB(1, 0), b3, voffB);
            PG8_BAR; PG8_WAIT_L(0); PG8_MMA(0, 1, At, B1); PG8_BAR;
            PG8_LDA(At, 1, 1); PG8_STAGE(PG8_SA(1, 0), a3, voffA);
            PG8_BAR; PG8_WAIT_L(0); PG8_MMA(1, 0, At, B0); PG8_BAR; PG8_SCHED;
            PG8_STAGE(PG8_SB(1, 1), b3 + hstep, voffB);
            PG8_WAIT_V(6); PG8_BAR; PG8_MMA(1, 1, At, B1); PG8_BAR;
        }
        PG8_STAMP();
        if constexpr (!Epi::AFTER_DRAIN) { E(acc, cur, wr, wc, fr, fq); S.done(cur); }
        PG8_STAMP();
        if (!has_next) break;
#pragma unroll
        for (int a = 0; a < 2; ++a)
#pragma unroll
            for (int b = 0; b < 2; ++b)
#pragma unroll
                for (int m = 0; m < 4; ++m)
#pragma unroll
                    for (int n = 0; n < 2; ++n) acc[a][b][m][n] = (f32x4){0.f, 0.f, 0.f, 0.f};
        cur = nxt; cA = nA; cB = nB; ++ui;
    }
    PG8_WAIT_V(0);
    if (wr == 0) PG8_BAR;
    PG8_BAR;
    if constexpr (Epi::AFTER_DRAIN) { E.fused(acc, cur, wr, wc, fr, fq, lds, wid, lane); S.done(cur); }
    PG8_STAMP();
    if (STAMP && wid == 0) { stamps[lane] = lane < nts ? (((unsigned long long)(unsigned)ts_hi << 32) | (unsigned)ts_lo) : 0ull;
        if (lane == 62) stamps[62] = rt_entry; if (lane == 63) stamps[63] = (unsigned long long)wall_clock64(); }
#undef PG8_STAMP
#undef PG8_SA
#undef PG8_SB
#undef PG8_STAGE
#undef PG8_LDA
#undef PG8_LDB
#undef PG8_MMA
#undef PG8_WAIT_V
#undef PG8_WAIT_L
#undef PG8_BAR
#undef PG8_SCHED
}
}

namespace {
using pg8::bf16_t;
typedef float f32x4 __attribute__((ext_vector_type(4)));
typedef unsigned u32x4 __attribute__((ext_vector_type(4)));

constexpr int NB = 16, NL = 2048, ND = 1024, NT = NB * NL;
constexpr int EVEN_IN = 2560, ODD_IN = 2608, ODD_PAD = 2304;
constexpr float ALPHA = 1.41421356237f;
constexpr float LN_EPS = 1e-5f;
constexpr float U_SCALE = 256.f, V_SCALE = 16.f;
constexpr int NTHR = 512;
constexpr int LDS_BYTES = 163840;
#ifndef PROBE
#define PROBE 0
#endif
#define PDUP(bit) for (int _rep = 0; _rep < ((PROBE >> (bit)) & 1) + 1; ++_rep)
#ifndef PHMASK
#define PHMASK 0xFFFFFFFFu
#endif
#define PH(n) if (PHMASK & (1u << (n)))

__device__ __forceinline__ float bf2f(bf16_t v) { return __uint_as_float((unsigned)v << 16); }
__device__ __forceinline__ bf16_t f2bf(float f) { unsigned u = __float_as_uint(f); u += 0x7FFFu + ((u >> 16) & 1u); return (bf16_t)(u >> 16); }
__device__ __forceinline__ unsigned pack2(float lo, float hi) { return (unsigned)f2bf(lo) | ((unsigned)f2bf(hi) << 16); }
__device__ __forceinline__ void ld8(const bf16_t* p, float* o) {
    const uint4 v = *(const uint4*)p;
    o[0] = __uint_as_float(v.x << 16); o[1] = __uint_as_float(v.x & 0xffff0000u);
    o[2] = __uint_as_float(v.y << 16); o[3] = __uint_as_float(v.y & 0xffff0000u);
    o[4] = __uint_as_float(v.z << 16); o[5] = __uint_as_float(v.z & 0xffff0000u);
    o[6] = __uint_as_float(v.w << 16); o[7] = __uint_as_float(v.w & 0xffff0000u);
}
__device__ __forceinline__ void st8(bf16_t* p, const float* o) {
    uint4 v; v.x = pack2(o[0], o[1]); v.y = pack2(o[2], o[3]); v.z = pack2(o[4], o[5]); v.w = pack2(o[6], o[7]);
    *(uint4*)p = v;
}

struct EpiBf16s {
    static constexpr bool PERM = true, AFTER_DRAIN = false;
    bf16_t* O; int ldc;
    __device__ __forceinline__ void operator()(const f32x4 (&acc)[2][2][4][2], const pg8::Unit& u, int wr, int wc, int fr, int fq) const {
        const int row0 = u.pm * 256 + wr * 64 + fr, col0 = u.pn * 256 + wc * 32 + 8 * fq;
#pragma unroll
        for (int ai = 0; ai < 2; ++ai)
#pragma unroll
            for (int m = 0; m < 4; ++m) { bf16_t* rowp = O + (size_t)(row0 + ai * 128 + m * 16) * ldc + col0;
#pragma unroll
                for (int bj = 0; bj < 2; ++bj) { const f32x4 v0 = acc[ai][bj][m][0], v1 = acc[ai][bj][m][1];
                    u32x4 w; w.x = pg8::cvt_pk_bf16(v0[0], v0[1]); w.y = pg8::cvt_pk_bf16(v0[2], v0[3]); w.z = pg8::cvt_pk_bf16(v1[0], v1[1]); w.w = pg8::cvt_pk_bf16(v1[2], v1[3]);
                    *(u32x4*)(rowp + bj * 128) = w; } }
    }
};
struct EpiRes {
    static constexpr bool PERM = false, AFTER_DRAIN = false;
    float* C; int ldc; float alpha; float* Cout;
    __device__ __forceinline__ void operator()(const f32x4 (&acc)[2][2][4][2], const pg8::Unit& u, int wr, int wc, int fr, int fq) const {
        const int row0 = u.pm * 256 + wr * 64 + fr, col0 = u.pn * 256 + wc * 32 + 4 * fq; const size_t dlt = Cout - C;
#pragma unroll
        for (int ai = 0; ai < 2; ++ai)
#pragma unroll
            for (int m = 0; m < 4; ++m) { float* rowp = C + (size_t)(row0 + ai * 128 + m * 16) * ldc + col0;
#pragma unroll
                for (int bj = 0; bj < 2; ++bj)
#pragma unroll
                    for (int n = 0; n < 2; ++n) { f32x4* cp = (f32x4*)(rowp + bj * 128 + n * 16); *(cp + dlt / 4) = *cp * alpha + acc[ai][bj][m][n]; } }
    }
};

template <bool IN_BF16>
struct EpiResStats {
    static constexpr bool PERM = false, AFTER_DRAIN = false;
    typename std::conditional<IN_BF16, const bf16_t*, const float*>::type Cin; bf16_t* Vb; float* part;
    __device__ __forceinline__ void operator()(const f32x4 (&acc)[2][2][4][2], const pg8::Unit& u, int wr, int wc, int fr, int fq) const {
        const unsigned row0 = (unsigned)(u.pm * 256 + wr * 64 + fr), col0 = (unsigned)(u.pn * 256 + wc * 32 + 4 * fq);
        if constexpr (IN_BF16) {
            uint2 rin[2][4][2][2];
#pragma unroll
            for (int ai = 0; ai < 2; ++ai)
#pragma unroll
                for (int m = 0; m < 4; ++m)
#pragma unroll
                    for (int bj = 0; bj < 2; ++bj)
#pragma unroll
                        for (int n = 0; n < 2; ++n)
                            rin[ai][m][bj][n] = *(const uint2*)(Cin + ((row0 + (unsigned)(ai * 128 + m * 16)) * (unsigned)ND + col0 + (unsigned)(bj * 128 + n * 16)));
#pragma unroll
            for (int ai = 0; ai < 2; ++ai)
#pragma unroll
                for (int m = 0; m < 4; ++m) {
                    const unsigned row = row0 + (unsigned)(ai * 128 + m * 16);
                    const unsigned eo = row * (unsigned)ND + col0;
                    float s1 = 0.f, s2 = 0.f;
#pragma unroll
                    for (int bj = 0; bj < 2; ++bj)
#pragma unroll
                        for (int n = 0; n < 2; ++n) {
                            const uint2 w = rin[ai][m][bj][n];
                            const f32x4 r4 = (f32x4){__uint_as_float(w.x << 16), __uint_as_float(w.x & 0xffff0000u), __uint_as_float(w.y << 16), __uint_as_float(w.y & 0xffff0000u)};
                            const f32x4 v = r4 * ALPHA + acc[ai][bj][m][n];
                            *(uint2*)(Vb + (eo + (unsigned)(bj * 128 + n * 16))) = make_uint2(pg8::cvt_pk_bf16(v[0], v[1]), pg8::cvt_pk_bf16(v[2], v[3]));
                            s1 += (v[0] + v[1]) + (v[2] + v[3]);
                            s2 += (v[0] * v[0] + v[1] * v[1]) + (v[2] * v[2] + v[3] * v[3]);
                        }
                    s1 += __shfl_xor(s1, 16); s2 += __shfl_xor(s2, 16);
                    s1 += __shfl_xor(s1, 32); s2 += __shfl_xor(s2, 32);
                    if (fq == 0) *(float2*)(part + ((((unsigned)u.pn * (unsigned)NT + row) * 4u + (unsigned)wc) * 2u)) = make_float2(s1, s2);
                }
        } else {
#pragma unroll
            for (int ai = 0; ai < 2; ++ai) {
            f32x4 rin4[4][2][2];
#pragma unroll
            for (int m = 0; m < 4; ++m)
#pragma unroll
                for (int bj = 0; bj < 2; ++bj)
#pragma unroll
                    for (int n = 0; n < 2; ++n)
                        rin4[m][bj][n] = *(const f32x4*)(Cin + ((row0 + (unsigned)(ai * 128 + m * 16)) * (unsigned)ND + col0 + (unsigned)(bj * 128 + n * 16)));
#pragma unroll
                for (int m = 0; m < 4; ++m) {
                    const unsigned row = row0 + (unsigned)(ai * 128 + m * 16);
                    const unsigned eo = row * (unsigned)ND + col0;
                    float s1 = 0.f, s2 = 0.f;
#pragma unroll
                    for (int bj = 0; bj < 2; ++bj)
#pragma unroll
                        for (int n = 0; n < 2; ++n) {
                            const f32x4 rin = rin4[m][bj][n];
                            const f32x4 v = rin * ALPHA + acc[ai][bj][m][n];
                            *(uint2*)(Vb + (eo + (unsigned)(bj * 128 + n * 16))) = make_uint2(pg8::cvt_pk_bf16(v[0], v[1]), pg8::cvt_pk_bf16(v[2], v[3]));
                            s1 += (v[0] + v[1]) + (v[2] + v[3]);
                            s2 += (v[0] * v[0] + v[1] * v[1]) + (v[2] * v[2] + v[3] * v[3]);
                        }
                    s1 += __shfl_xor(s1, 16); s2 += __shfl_xor(s2, 16);
                    s1 += __shfl_xor(s1, 32); s2 += __shfl_xor(s2, 32);
                    if (fq == 0) *(float2*)(part + ((((unsigned)u.pn * (unsigned)NT + row) * 4u + (unsigned)wc) * 2u)) = make_float2(s1, s2);
                }
            }
        }
    }
};
struct EpiBf16LN {
    static constexpr bool PERM = true, AFTER_DRAIN = false;
    bf16_t* O; int ldc; const float* csum; const float* dvec; const float2* stats  ; int pm0, pm1, pm2, pm3;
    __device__ __forceinline__ void operator()(const f32x4 (&acc)[2][2][4][2], const pg8::Unit& u, int wr, int wc, int fr, int fq) const {
        const int slot = (u.pm == pm0) ? 0 : ((u.pm == pm1) ? 1 : ((u.pm == pm2) ? 2 : 3));
        const float2* st = stats + slot * 256;
        const int lrow0 = wr * 64 + fr, col0 = u.pn * 256 + wc * 32 + 8 * fq;
        f32x4 cv[2][2], dv[2][2];
#pragma unroll
        for (int bj = 0; bj < 2; ++bj)
#pragma unroll
            for (int n = 0; n < 2; ++n) { cv[bj][n] = *(const f32x4*)(csum + col0 + bj * 128 + 4 * n); dv[bj][n] = *(const f32x4*)(dvec + col0 + bj * 128 + 4 * n); }
#pragma unroll
        for (int ai = 0; ai < 2; ++ai)
#pragma unroll
            for (int m = 0; m < 4; ++m) {
                const int lrow = lrow0 + ai * 128 + m * 16;
                const float2 ms = st[lrow];
                bf16_t* rowp = O + (size_t)(u.pm * 256 + lrow) * ldc + col0;
#pragma unroll
                for (int bj = 0; bj < 2; ++bj) {
                    const f32x4 v0 = (acc[ai][bj][m][0] - cv[bj][0] * ms.x) * ms.y + dv[bj][0], v1 = (acc[ai][bj][m][1] - cv[bj][1] * ms.x) * ms.y + dv[bj][1];
                    u32x4 w; w.x = pg8::cvt_pk_bf16(v0[0], v0[1]); w.y = pg8::cvt_pk_bf16(v0[2], v0[3]); w.z = pg8::cvt_pk_bf16(v1[0], v1[1]); w.w = pg8::cvt_pk_bf16(v1[2], v1[3]);
                    *(u32x4*)(rowp + bj * 128) = w;
                }
            }
    }
};
__device__ __forceinline__ void gemm_q_phase(unsigned char* lds, const bf16_t* Vb, const bf16_t* Wt, const float* __restrict__ part, const float* csum, const float* dvec, bf16_t* Q) {
    pg8::StaticOrder S; S.init(NT, 2048, (int)gridDim.x, (int)blockIdx.x);
    int pms[4] = {-1, -1, -1, -1};
    float2* st = (float2*)(lds + 131072);
    __syncthreads();
#pragma unroll
    for (int i = 0; i < 4; ++i) {
        pg8::Unit u;
        if (S.next(i, u)) {
            bool seen = false;
#pragma unroll
            for (int j = 0; j < 4; ++j) if (j < i && pms[j] == u.pm) seen = true;
            pms[i] = seen ? -2 - i : u.pm;
            if (!seen && tidx() < 256) {
                const int row = u.pm * 256 + tidx();
                float s1 = 0.f, s2 = 0.f;
#pragma unroll
                for (int pn = 0; pn < 4; ++pn) {
                    const float4* pp = (const float4*)(part + ((size_t)pn * NT + row) * 8);
#pragma unroll
                    for (int k = 0; k < 2; ++k) { const float4 a = pp[k]; s1 += a.x; s2 += a.y; s1 += a.z; s2 += a.w; }
                }
                const float mean = s1 * (1.f / ND), var = fmaxf(s2 * (1.f / ND) - mean * mean, 0.f);
                st[i * 256 + tidx()] = make_float2(mean, rsqrtf(var + LN_EPS));
            }
        }
    }
    __syncthreads();
    pg8::Gemm g{Vb, Wt, NT, 2048, ND};
    EpiBf16LN E{Q, 2048, csum, dvec, st, pms[0], pms[1], pms[2], pms[3]};
    pg8::gemm_phase<EpiBf16LN, pg8::StaticOrder, false>((PG8_LAS unsigned char*)lds, g, S, E, nullptr);
    __syncthreads();
}
template <class Epi>
__device__ __forceinline__ void gemm_bf16_phase(unsigned char* lds, const bf16_t* A, const bf16_t* Bt, int M, int N, int K, const Epi& E, bool reverse_ids = false) {
    pg8::Gemm g{A, Bt, M, N, K};
    pg8::StaticOrder S; S.init(M, N, (int)gridDim.x, reverse_ids ? (int)(gridDim.x - 1 - blockIdx.x) : (int)blockIdx.x);
    pg8::gemm_phase<Epi, pg8::StaticOrder, false>((PG8_LAS unsigned char*)lds, g, S, E, nullptr);
    __syncthreads();
}

struct ColMap { int d0[3], s0[3], len[3]; };
__device__ __forceinline__ void convert_wt_phase(const float* __restrict__ W, int K, int N, int Npad, const ColMap cm, bf16_t* __restrict__ Wt, float* lds, const float* __restrict__ rowscale = nullptr) {
    float(*tile)[65] = (float(*)[65])lds;
    const int tid = tidx(), ntn = Npad / 64, ntiles = (K / 64) * ntn;
    for (int it = blockIdx.x; it < ntiles; it += gridDim.x) {
        const int k0 = (it / ntn) * 64, n0 = (it % ntn) * 64;
        __syncthreads();
#pragma unroll
        for (int h = 0; h < 2; ++h) {
            const int r = (tid >> 4) + h * 32, c4 = (tid & 15) * 4, nd = n0 + c4;
            int ns = -1;
#pragma unroll
            for (int sg = 0; sg < 3; ++sg) if (nd >= cm.d0[sg] && nd < cm.d0[sg] + cm.len[sg]) ns = cm.s0[sg] + (nd - cm.d0[sg]);
            float4 v = make_float4(0.f, 0.f, 0.f, 0.f);
            if (ns >= 0) v = *(const float4*)(W + (size_t)(k0 + r) * N + ns);
            if (rowscale) { const float gsc = rowscale[k0 + r]; v.x *= gsc; v.y *= gsc; v.z *= gsc; v.w *= gsc; }
            tile[r][c4] = v.x; tile[r][c4 + 1] = v.y; tile[r][c4 + 2] = v.z; tile[r][c4 + 3] = v.w;
        }
        __syncthreads();
        const int n = tid >> 3, k8 = (tid & 7) * 8;
        float o[8];
#pragma unroll
        for (int j = 0; j < 8; ++j) o[j] = tile[k8 + j][n];
        st8(Wt + (size_t)(n0 + n) * K + k0 + k8, o);
    }
    __syncthreads();
}
__device__ __forceinline__ float gelu_tanh(float x) {
    float u = 0.7978845608028654f * (x + 0.044715f * x * x * x);
    return 0.5f * x * (1.f + tanhf(u));
}
__device__ __forceinline__ float sigmoidf_(float x) { return 1.f / (1.f + expf(-x)); }
__device__ __forceinline__ void wave_lds_fence() { asm volatile("s_waitcnt lgkmcnt(0)" ::: "memory"); }
__device__ __forceinline__ void lds_barrier() { asm volatile("s_waitcnt lgkmcnt(0)" ::: "memory"); __builtin_amdgcn_s_barrier(); asm volatile("" ::: "memory"); }

__device__ __forceinline__ void s5_scan_wave(int bg, const bf16_t* __restrict__ proj, const float* __restrict__ lam_re, const float* __restrict__ lam_im,
                             const float* __restrict__ log_dt, const float* __restrict__ b_re, const float* __restrict__ b_im,
                             const float* __restrict__ c_re, const float* __restrict__ c_im, const float* __restrict__ dskip,
                             float* __restrict__ ya, float* lds) {
    const int b = bg >> 4, g = bg & 15, lane = tidx() & 63;
    float(*us)[16] = (float(*)[16])lds;
    float(*xr)[65] = (float(*)[65])(lds + 1024);
    float(*xi)[65] = (float(*)[65])(lds + 1024 + 4160);
    float(*cr)[64] = (float(*)[64])(lds + 1024 + 8320);
    float(*ci)[64] = (float(*)[64])(lds + 1024 + 8320 + 1024);
    const float lr = lam_re[g * 64 + lane], li = lam_im[g * 64 + lane];
    const float dt = expf(log_dt[g]);
    const float mag = expf(lr * dt);
    const float are = mag * cosf(li * dt), aim = mag * sinf(li * dt);
    const float nr = are - 1.f, den = lr * lr + li * li;
    const float fre = (nr * lr + aim * li) / den, fim = (aim * lr - nr * li) / den;
    float bbr[16], bbi[16];
#pragma unroll
    for (int i = 0; i < 16; ++i) {
        const float br = b_re[(g * 64 + lane) * 16 + i], bi = b_im[(g * 64 + lane) * 16 + i];
        bbr[i] = fre * br - fim * bi; bbi[i] = fre * bi + fim * br;
    }
    for (int idx = lane; idx < 1024; idx += 64) { cr[idx >> 6][idx & 63] = c_re[g * 1024 + idx]; ci[idx >> 6][idx & 63] = c_im[g * 1024 + idx]; }
    float dsk[16];
#pragma unroll
    for (int i = 0; i < 16; ++i) dsk[i] = dskip[g * 16 + i];
    float xre = 0.f, xim = 0.f;
    for (int t0 = 0; t0 < NL; t0 += 64) {
        wave_lds_fence();
        for (int idx = lane; idx < 1024; idx += 64) { const int t = idx >> 4, i = idx & 15; us[t][i] = bf2f(proj[(size_t)(b * NL + t0 + t) * EVEN_IN + g * 16 + i]); }
        wave_lds_fence();
        for (int t = 0; t < 64; ++t) {
            float bur = 0.f, bui = 0.f;
#pragma unroll
            for (int i = 0; i < 16; ++i) { const float u = us[t][i]; bur += bbr[i] * u; bui += bbi[i] * u; }
            const float nre = are * xre - aim * xim + bur, nim = are * xim + aim * xre + bui;
            xre = nre; xim = nim;
            xr[t][lane] = xre; xi[t][lane] = xim;
        }
        wave_lds_fence();
        float y[16];
#pragma unroll
        for (int i = 0; i < 16; ++i) y[i] = 0.f;
        for (int p = 0; p < 64; ++p) {
            const float a = xr[lane][p], bq = xi[lane][p];
#pragma unroll
            for (int i = 0; i < 16; ++i) y[i] += cr[i][p] * a - ci[i][p] * bq;
        }
#pragma unroll
        for (int i = 0; i < 16; ++i) {
            const float v = y[i] + dsk[i] * us[lane][i];
            ya[(size_t)(b * NL + t0 + lane) * 256 + g * 16 + i] = gelu_tanh(v);
        }
    }
}

__device__ __forceinline__ void sb_attn_wave(int task, const bf16_t* __restrict__ proj, bf16_t* __restrict__ Y, float* wl) {
    const int qt = task & 31, h = (task >> 5) % 12, b = task / 384, lane = tidx() & 63;
    const int t = qt * 64 + lane;
    float(*ks)[64] = (float(*)[64])wl;
    float(*vs)[64] = (float(*)[64])(wl + 2048);
    const bf16_t* base = proj + (size_t)b * NL * EVEN_IN;
    float q[64], acc[64];
#pragma unroll
    for (int d = 0; d < 64; d += 8) ld8(base + (size_t)t * EVEN_IN + 256 + h * 64 + d, q + d);
#pragma unroll
    for (int d = 0; d < 64; ++d) acc[d] = 0.f;
    float tail = 0.f;
    for (int c = 2 * qt + 1; c >= 0; --c) {
        wave_lds_fence();
        for (int i = 0; i < 32; ++i) {
            ks[i][lane] = bf2f(base[(size_t)(c * 32 + i) * EVEN_IN + 1024 + h * 64 + lane]);
            vs[i][lane] = bf2f(base[(size_t)(c * 32 + i) * EVEN_IN + 1792 + h * 64 + lane]);
        }
        wave_lds_fence();
        for (int s = 31; s >= 0; --s) {
            const int key = c * 32 + s;
            float z = 0.f;
#pragma unroll
            for (int d = 0; d < 64; ++d) z += q[d] * ks[s][d];
            z *= 0.125f;
            const bool valid = key < t;
            const float sp = fmaxf(z, 0.f) + log1pf(expf(-fabsf(z)));
            const float w = valid ? expf(z - sp + tail) : 0.f;
#pragma unroll
            for (int d = 0; d < 64; ++d) acc[d] += w * vs[s][d];
            if (valid) tail -= sp;
        }
        if (__all(tail < -120.f)) break;
    }
#pragma unroll
    for (int d = 0; d < 64; d += 8) st8(Y + (size_t)(b * NL + t) * ND + 256 + h * 64 + d, acc + d);
}

__device__ __forceinline__ void glu_phase(const float* __restrict__ ya, const float* __restrict__ wglu, const float* __restrict__ bglu, bf16_t* __restrict__ Y, float* lds) {
    const int half = tidx() >> 8, c = tidx() & 255;
    float(*ys)[256] = (float(*)[256])(lds + half * 4096);
    for (int it = blockIdx.x; it < NT / 32; it += gridDim.x) {
        const int t0 = it * 32 + half * 16;
        __syncthreads();
        for (int i = 0; i < 16; ++i) ys[i][c] = ya[(size_t)(t0 + i) * 256 + c];
        __syncthreads();
        float acc[16];
#pragma unroll
        for (int i = 0; i < 16; ++i) acc[i] = 0.f;
        for (int k = 0; k < 256; ++k) {
            const float w = wglu[k * 256 + c];
#pragma unroll
            for (int i = 0; i < 16; ++i) acc[i] += ys[i][k] * w;
        }
        const float bb = bglu[c];
#pragma unroll
        for (int i = 0; i < 16; ++i) Y[(size_t)(t0 + i) * ND + c] = f2bf(ys[i][c] * sigmoidf_(acc[i] + bb));
    }
    __syncthreads();
}

__device__ __forceinline__ void ln_row_wave(float4 (&v)[4], const float* __restrict__ g, const float* __restrict__ bta, float* out, bf16_t* outb, int lane) {
    float s = 0.f;
#pragma unroll
    for (int j = 0; j < 4; ++j) s += v[j].x + v[j].y + v[j].z + v[j].w;
    for (int o = 32; o; o >>= 1) s += __shfl_xor(s, o);
    const float mean = s * (1.f / ND);
    float s2 = 0.f;
#pragma unroll
    for (int j = 0; j < 4; ++j) {
        v[j].x -= mean; v[j].y -= mean; v[j].z -= mean; v[j].w -= mean;
        s2 += v[j].x * v[j].x + v[j].y * v[j].y + v[j].z * v[j].z + v[j].w * v[j].w;
    }
    for (int o = 32; o; o >>= 1) s2 += __shfl_xor(s2, o);
    const float rs = rsqrtf(s2 * (1.f / ND) + LN_EPS);
#pragma unroll
    for (int j = 0; j < 4; ++j) {
        const float4 gg = *(const float4*)(g + j * 256 + lane * 4), bb = *(const float4*)(bta + j * 256 + lane * 4);
        const float4 o = make_float4(v[j].x * rs * gg.x + bb.x, v[j].y * rs * gg.y + bb.y, v[j].z * rs * gg.z + bb.z, v[j].w * rs * gg.w + bb.w);
        *(float4*)(out + j * 256 + lane * 4) = o;
        if (outb) { uint2 w; w.x = pack2(o.x, o.y); w.y = pack2(o.z, o.w); *(uint2*)(outb + j * 256 + lane * 4) = w; }
    }
}
__device__ __forceinline__ void ln_phase(float* R, bf16_t* Hb, const float* __restrict__ g, const float* __restrict__ bta) {
    const int wave = tidx() >> 6, lane = tidx() & 63;
    for (int row = blockIdx.x * 8 + wave; row < NT; row += gridDim.x * 8) {
        float4 v[4];
#pragma unroll
        for (int j = 0; j < 4; ++j) v[j] = *(const float4*)(R + (size_t)row * ND + j * 256 + lane * 4);
        ln_row_wave(v, g, bta, R + (size_t)row * ND, Hb + (size_t)row * ND, lane);
    }
}

__device__ __forceinline__ void wave_argmax(float& bv, int& bi) {
#pragma unroll
    for (int o = 32; o; o >>= 1) {
        const float ov = __shfl_xor(bv, o); const int oi = __shfl_xor(bi, o);
        if (ov > bv || (ov == bv && oi < bi)) { bv = ov; bi = oi; }
    }
}
__device__ __forceinline__ void peer_route_phase(const bf16_t* __restrict__ qbuf, const float* __restrict__ subk, int* __restrict__ eidx, float* __restrict__ egate, float* lds) {
    const int head = tidx() >> 6, lane = tidx() & 63;
    float* qs = lds + head * 256;
    for (int token = blockIdx.x; token < NT; token += gridDim.x) {
        const bf16_t* qp = qbuf + (size_t)token * 2048 + head * 256;
        wave_lds_fence();
        for (int i = 0; i < 4; ++i) qs[lane + 64 * i] = bf2f(qp[lane + 64 * i]);
        wave_lds_fence();
        float myv[2]; int myi[2];
#pragma unroll
        for (int c = 0; c < 2; ++c) {
            float sc[2];
#pragma unroll
            for (int w2 = 0; w2 < 2; ++w2) {
                const float* kr = subk + ((size_t)(head * 2 + c) * 128 + lane + 64 * w2) * 128;
                float a = 0.f;
#pragma unroll 4
                for (int d = 0; d < 128; d += 4) {
                    const float4 kv = *(const float4*)(kr + d);
                    a += qs[c * 128 + d] * kv.x + qs[c * 128 + d + 1] * kv.y + qs[c * 128 + d + 2] * kv.z + qs[c * 128 + d + 3] * kv.w;
                }
                sc[w2] = a;
            }
            float a0 = sc[0], a1 = sc[1];
            float mv = -INFINITY; int mi = 0;
            for (int r = 0; r < 16; ++r) {
                float bv; int bi;
                if (a0 >= a1) { bv = a0; bi = lane; } else { bv = a1; bi = lane + 64; }
                wave_argmax(bv, bi);
                if (lane == r) { mv = bv; mi = bi; }
                if (bi == lane) a0 = -INFINITY; else if (bi == lane + 64) a1 = -INFINITY;
            }
            myv[c] = mv; myi[c] = mi;
        }
        const float va = __shfl(myv[0], lane >> 2);
        float cand[4];
#pragma unroll
        for (int j = 0; j < 4; ++j) cand[j] = va + __shfl(myv[1], (lane & 3) * 4 + j);
        float topv = -INFINITY; int topf = 0;
        for (int r = 0; r < 16; ++r) {
            float bv = cand[0]; int bi = lane * 4;
#pragma unroll
            for (int j = 1; j < 4; ++j) if (cand[j] > bv) { bv = cand[j]; bi = lane * 4 + j; }
            wave_argmax(bv, bi);
            if (lane == r) { topv = bv; topf = bi; }
#pragma unroll
            for (int j = 0; j < 4; ++j) if (bi == lane * 4 + j) cand[j] = -INFINITY;
        }
        const int e1 = __shfl(myi[0], topf >> 4), e2 = __shfl(myi[1], topf & 15);
        const float top0 = __shfl(topv, 0);
        float ex = (lane < 16) ? expf(topv - top0) : 0.f;
        float sum = ex;
        for (int o = 32; o; o >>= 1) sum += __shfl_xor(sum, o);
        if (lane < 16) {
            eidx[(size_t)token * 128 + head * 16 + lane] = e1 * 128 + e2;
            egate[(size_t)token * 128 + head * 16 + lane] = ex / sum;
        }
    }
}

__device__ __forceinline__ void peer_expert_phase(float* R, const int* __restrict__ eidx, const float* __restrict__ egate, const float* __restrict__ utab,
                                  const float* __restrict__ vtab, const float* __restrict__ lg, const float* __restrict__ lb, bf16_t* Hb) {
    const int wave = tidx() >> 6, lane = tidx() & 63;
    for (int token = blockIdx.x * 8 + wave; token < NT; token += gridDim.x * 8) {
        float4 x[4], acc[4];
#pragma unroll
        for (int j = 0; j < 4; ++j) { x[j] = *(const float4*)(R + (size_t)token * ND + j * 256 + lane * 4); acc[j] = make_float4(0.f, 0.f, 0.f, 0.f); }
        for (int e0 = 0; e0 < 128; e0 += 4) {
            float dot[4]; int ex[4]; float gt[4];
#pragma unroll
            for (int k = 0; k < 4; ++k) {
                ex[k] = eidx[(size_t)token * 128 + e0 + k]; gt[k] = egate[(size_t)token * 128 + e0 + k];
                const float* ur = utab + (size_t)ex[k] * ND + lane * 4;
                float a = 0.f;
#pragma unroll
                for (int j = 0; j < 4; ++j) { const float4 u = *(const float4*)(ur + j * 256); a += x[j].x * u.x + x[j].y * u.y + x[j].z * u.z + x[j].w * u.w; }
                dot[k] = a;
            }
#pragma unroll
            for (int k = 0; k < 4; ++k) {
                float a = dot[k];
                for (int o = 32; o; o >>= 1) a += __shfl_xor(a, o);
                const float coef = gt[k] * gelu_tanh(a);
                const float* vr = vtab + (size_t)ex[k] * ND + lane * 4;
#pragma unroll
                for (int j = 0; j < 4; ++j) { const float4 v = *(const float4*)(vr + j * 256); acc[j].x += coef * v.x; acc[j].y += coef * v.y; acc[j].z += coef * v.z; acc[j].w += coef * v.w; }
            }
        }
#pragma unroll
        for (int j = 0; j < 4; ++j) { x[j].x = ALPHA * x[j].x + acc[j].x; x[j].y = ALPHA * x[j].y + acc[j].y; x[j].z = ALPHA * x[j].z + acc[j].z; x[j].w = ALPHA * x[j].w + acc[j].w; }
        ln_row_wave(x, lg, lb, R + (size_t)token * ND, Hb ? Hb + (size_t)token * ND : nullptr, lane);
    }
}


typedef short bf16x8_t __attribute__((ext_vector_type(8)));
__device__ __forceinline__ int f2key(float f) { const int b = __float_as_int(f); return b ^ ((b >> 31) & 0x7fffffff); }
__device__ __forceinline__ float key2f(int k) { return __int_as_float(k ^ ((k >> 31) & 0x7fffffff)); }
#define CE_DESC_I(a, b) do { const int _hi = max(a, b), _lo = min(a, b); a = _hi; b = _lo; } while (0)
template <int N, int K, int J> __device__ __forceinline__ void bstage(int (&v)[N]) {
#pragma unroll
    for (int i = 0; i < N; ++i) {
        const int l = i ^ J;
        if (l > i) { if ((i & K) == 0) CE_DESC_I(v[i], v[l]); else CE_DESC_I(v[l], v[i]); }
    }
}
__device__ __forceinline__ void sort16_desc(int (&v)[16]) {
    bstage<16, 2, 1>(v); bstage<16, 4, 2>(v); bstage<16, 4, 1>(v); bstage<16, 8, 4>(v); bstage<16, 8, 2>(v); bstage<16, 8, 1>(v);
    bstage<16, 16, 8>(v); bstage<16, 16, 4>(v); bstage<16, 16, 2>(v); bstage<16, 16, 1>(v);
}
__device__ __forceinline__ void sort8_desc(int (&v)[8]) {
    bstage<8, 2, 1>(v); bstage<8, 4, 2>(v); bstage<8, 4, 1>(v); bstage<8, 8, 4>(v); bstage<8, 8, 2>(v); bstage<8, 8, 1>(v);
}
__device__ __forceinline__ void bitonic_merge16_desc(int (&v)[16]) {
    bstage<16, 16, 8>(v); bstage<16, 16, 4>(v); bstage<16, 16, 2>(v); bstage<16, 16, 1>(v);
}
__device__ __forceinline__ void xmerge16(int (&v)[16], int off) {
    int m[16];
#pragma unroll
    for (int i = 0; i < 16; ++i) m[i] = max(v[i], __shfl_xor(v[15 - i], off));
    bitonic_merge16_desc(m);
#pragma unroll
    for (int i = 0; i < 16; ++i) v[i] = m[i];
}
__device__ __forceinline__ void opaque16(int (&v)[16]) {
#pragma unroll
    for (int i = 0; i < 16; ++i) asm volatile("" : "+v"(v[i]));
}
__device__ __forceinline__ int lookup16(const int (&arr)[16], int a) {
    int r = arr[0];
#pragma unroll
    for (int i = 1; i < 16; ++i) r = (a == i) ? arr[i] : r;
    return r;
}
__device__ __forceinline__ void peer_route2_phase(const bf16_t* __restrict__ qbuf, const bf16_t* __restrict__ skb, int* __restrict__ eidx, float* __restrict__ egate, unsigned char* lds) {
    if (__builtin_amdgcn_readfirstlane(tidx() >> 6) >= 4) __builtin_amdgcn_s_setprio(1);
    const int tid = tidx(), wave = tid >> 6, lane = tid & 63, fr = lane & 15, fq = lane >> 4;
    for (int chunk = blockIdx.x; chunk < NT / 128; chunk += gridDim.x) {
        const int token = chunk * 128 + wave * 16 + fr;
        int* tl = (int*)(lds + 69632) + (wave * 16 + fr) * 48;
        const int srow = tid >> 4, sch = tid & 15;
        const bf16_t* kg = skb + (size_t)srow * 128 + sch * 8;
        unsigned char* kl = lds + srow * 272 + sch * 16;
        const bf16_t* qg = qbuf + (size_t)token * 2048 + 8 * fq;
        uint4 kr0 = *(const uint4*)(kg), kr1 = *(const uint4*)(kg + 32 * 128), kr2 = *(const uint4*)(kg + 64 * 128), kr3 = *(const uint4*)(kg + 96 * 128);
        bf16x8_t qn0 = *(const bf16x8_t*)(qg), qn1 = *(const bf16x8_t*)(qg + 32), qn2 = *(const bf16x8_t*)(qg + 64), qn3 = *(const bf16x8_t*)(qg + 96);
        __syncthreads();
        *(uint4*)(kl) = kr0; *(uint4*)(kl + 32 * 272) = kr1; *(uint4*)(kl + 64 * 272) = kr2; *(uint4*)(kl + 96 * 272) = kr3;
        lds_barrier();
        for (int h = 0; h < 8; ++h) {
            int K1[16], K2[16];
#pragma unroll
            for (int c = 0; c < 2; ++c) {
                const int step = 2 * h + c;
                const unsigned char* kt_lds = lds + (step & 1) * 34816;
                const bf16x8_t qf0 = qn0, qf1 = qn1, qf2 = qn2, qf3 = qn3;
                {
                    const int sn = step < 15 ? step + 1 : step;
                    const bf16_t* kgn = kg + (size_t)sn * 128 * 128;
                    kr0 = *(const uint4*)(kgn); kr1 = *(const uint4*)(kgn + 32 * 128); kr2 = *(const uint4*)(kgn + 64 * 128); kr3 = *(const uint4*)(kgn + 96 * 128);
                    const bf16_t* qgn = qg + sn * 128;
                    qn0 = *(const bf16x8_t*)(qgn); qn1 = *(const bf16x8_t*)(qgn + 32); qn2 = *(const bf16x8_t*)(qgn + 64); qn3 = *(const bf16x8_t*)(qgn + 96);
                }
                int va[16], vb[16];
#pragma unroll
                for (int n = 0; n < 8; ++n) {
                    f32x4 S = {0.f, 0.f, 0.f, 0.f};
#pragma unroll
                    for (int sI = 0; sI < 4; ++sI) {
                        const bf16x8_t kf = *(const bf16x8_t*)(kt_lds + (16 * n + fr) * 272 + (32 * sI + 8 * fq) * 2);
                        S = __builtin_amdgcn_mfma_f32_16x16x32_bf16(kf, sI == 0 ? qf0 : (sI == 1 ? qf1 : (sI == 2 ? qf2 : qf3)), S, 0, 0, 0);
                    }
#pragma unroll
                    for (int j = 0; j < 4; ++j) {
                        const int key = (f2key(S[j]) & ~127) | (16 * n + 4 * fq + j);
                        if (n < 4) va[n * 4 + j] = key; else vb[(n - 4) * 4 + j] = key;
                    }
                }
                sort16_desc(va); sort16_desc(vb);
                int m[16];
#pragma unroll
                for (int i = 0; i < 16; ++i) m[i] = max(va[i], vb[15 - i]);
                bitonic_merge16_desc(m);
                xmerge16(m, 16); xmerge16(m, 32);
#pragma unroll
                for (int i = 0; i < 16; ++i) { if (c == 0) K1[i] = m[i]; else K2[i] = m[i]; }
                if (fq == 0) {
#pragma unroll
                    for (int i = 0; i < 4; ++i) *(int4*)(tl + c * 16 + 4 * i) = make_int4(m[4 * i], m[4 * i + 1], m[4 * i + 2], m[4 * i + 3]);
                }
                if (step < 15) {
                    unsigned char* kln = kl + ((step + 1) & 1) * 34816;
                    *(uint4*)(kln) = kr0; *(uint4*)(kln + 32 * 272) = kr1; *(uint4*)(kln + 64 * 272) = kr2; *(uint4*)(kln + 96 * 272) = kr3;
                    lds_barrier();
                }
            }
            wave_lds_fence();
            float vaf[4];
#pragma unroll
            for (int k = 0; k < 4; ++k) vaf[k] = key2f(tl[4 * k + fq]);
            int A[16];
#pragma unroll
            for (int b = 0; b < 16; ++b) {
                const bool valid = (fq + 1) * (b + 1) <= 16;
                const int key = (f2key(vaf[0] + key2f(K2[b])) & ~127) | (fq << 5) | b;
                A[b] = valid ? key : INT_MIN;
            }
            int Bq[8];
#pragma unroll
            for (int b = 0; b < 3; ++b) {
                const bool valid = (fq + 5) * (b + 1) <= 16;
                const int key = (f2key(vaf[1] + key2f(K2[b])) & ~127) | (fq << 5) | (16 + b);
                Bq[b] = valid ? key : INT_MIN;
            }
            Bq[3] = (f2key(vaf[2] + key2f(K2[0])) & ~127) | (fq << 5) | 19;
            Bq[4] = (f2key(vaf[3] + key2f(K2[0])) & ~127) | (fq << 5) | 20;
            Bq[5] = INT_MIN; Bq[6] = INT_MIN; Bq[7] = INT_MIN;
            sort8_desc(Bq);
#pragma unroll
            for (int i = 8; i < 16; ++i) A[i] = max(A[i], Bq[15 - i]);
            bitonic_merge16_desc(A);
            xmerge16(A, 16); xmerge16(A, 32);
            if (fq == 0) {
#pragma unroll
                for (int i = 0; i < 4; ++i) *(int4*)(tl + 32 + 4 * i) = make_int4(A[4 * i], A[4 * i + 1], A[4 * i + 2], A[4 * i + 3]);
            }
            wave_lds_fence();
            const int4 myT = *(const int4*)(tl + 32 + 4 * fq);
            const int tsel[4] = {myT.x, myT.y, myT.z, myT.w};
            const float top0 = key2f(A[0]);
            float sum = 0.f;
#pragma unroll
            for (int r = 0; r < 16; ++r) sum += __expf(key2f(A[r]) - top0);
            const float inv = 1.f / sum;
            int eo[4]; float go[4];
#pragma unroll
            for (int kk = 0; kk < 4; ++kk) {
                const int t = tsel[kk];
                const int id = t & 127, ofq = id >> 5, slot = id & 31;
                const int k = slot < 16 ? 0 : (slot < 19 ? 1 : (slot == 19 ? 2 : 3));
                const int b = slot < 16 ? slot : (slot < 19 ? slot - 16 : 0);
                const int a = ofq + 4 * k;
                const int e1 = tl[a] & 127, e2 = tl[16 + b] & 127;
                eo[kk] = e1 * 128 + e2;
                go[kk] = __expf(key2f(t) - top0) * inv;
            }
            *(int4*)(eidx + (size_t)token * 128 + h * 16 + 4 * fq) = make_int4(eo[0], eo[1], eo[2], eo[3]);
            *(float4*)(egate + (size_t)token * 128 + h * 16 + 4 * fq) = make_float4(go[0], go[1], go[2], go[3]);
            wave_lds_fence();
        }
    }
    __syncthreads();
    __builtin_amdgcn_s_setprio(0);
}

typedef __bf16 bf16x2_t __attribute__((ext_vector_type(2)));
typedef float f32x2_t __attribute__((ext_vector_type(2)));
__device__ __forceinline__ float dot2bf(unsigned a, unsigned b, float acc) { return __builtin_amdgcn_fdot2_f32_bf16(__builtin_bit_cast(bf16x2_t, a), __builtin_bit_cast(bf16x2_t, b), acc, false); }
__device__ __forceinline__ float gelu_fast(float x) {
    const float u = 0.7978845608028654f * (x + 0.044715f * x * x * x);
    return x * __builtin_amdgcn_rcpf(1.f + __expf(-2.f * u));
}
__device__ __forceinline__ void peer_expert2_phase(float* R, const int* __restrict__ eidx, const float* __restrict__ egate, const bf16_t* __restrict__ ub,
                                                   const bf16_t* __restrict__ vb, const float* __restrict__ lg, const float* __restrict__ lb, bf16_t* Hb) {
    const int wave = tidx() >> 6, lane = tidx() & 63;
    for (int token = blockIdx.x * 8 + wave; token < NT; token += gridDim.x * 8) {
        float xf[16];
        {
            const float* rp = R + (size_t)token * ND + lane * 8;
            const float4 a0 = *(const float4*)rp, a1 = *(const float4*)(rp + 4), b0 = *(const float4*)(rp + 512), b1 = *(const float4*)(rp + 516);
            xf[0] = a0.x; xf[1] = a0.y; xf[2] = a0.z; xf[3] = a0.w; xf[4] = a1.x; xf[5] = a1.y; xf[6] = a1.z; xf[7] = a1.w;
            xf[8] = b0.x; xf[9] = b0.y; xf[10] = b0.z; xf[11] = b0.w; xf[12] = b1.x; xf[13] = b1.y; xf[14] = b1.z; xf[15] = b1.w;
        }
        unsigned xp[8];
#pragma unroll
        for (int j = 0; j < 8; ++j) xp[j] = pack2(xf[2 * j], xf[2 * j + 1]);
        float acc[16];
#pragma unroll
        for (int j = 0; j < 16; ++j) acc[j] = 0.f;
        const int e_lo = eidx[(size_t)token * 128 + lane], e_hi = eidx[(size_t)token * 128 + 64 + lane];
        const float g_lo = egate[(size_t)token * 128 + lane], g_hi = egate[(size_t)token * 128 + 64 + lane];
        for (int grp = 0; grp < 16; ++grp) {
            const int esel = grp < 8 ? e_lo : e_hi;
            const float gsel = grp < 8 ? g_lo : g_hi;
            const int lbase = (grp & 7) * 8;
            uint4 u0[8], u1[8];
            int exs[8];
#pragma unroll
            for (int k = 0; k < 8; ++k) {
                exs[k] = __builtin_amdgcn_readlane(esel, lbase + k);
                const bf16_t* up = ub + (size_t)exs[k] * ND + lane * 8;
                u0[k] = *(const uint4*)up; u1[k] = *(const uint4*)(up + 512);
            }
            float d[8];
#pragma unroll
            for (int k = 0; k < 8; ++k) {
                float a = dot2bf(u0[k].x, xp[0], 0.f), b = dot2bf(u0[k].y, xp[1], 0.f);
                a = dot2bf(u0[k].z, xp[2], a); b = dot2bf(u0[k].w, xp[3], b);
                a = dot2bf(u1[k].x, xp[4], a); b = dot2bf(u1[k].y, xp[5], b);
                a = dot2bf(u1[k].z, xp[6], a); b = dot2bf(u1[k].w, xp[7], b);
                d[k] = a + b;
            }
            const bool hi5 = lane & 32, hi4 = lane & 16, hi3 = lane & 8;
            float r4[4], r2[2], r1;
#pragma unroll
            for (int k = 0; k < 4; ++k) { const float send = hi5 ? d[k] : d[k + 4], keep = hi5 ? d[k + 4] : d[k]; r4[k] = keep + __shfl_xor(send, 32); }
#pragma unroll
            for (int k = 0; k < 2; ++k) { const float send = hi4 ? r4[k] : r4[k + 2], keep = hi4 ? r4[k + 2] : r4[k]; r2[k] = keep + __shfl_xor(send, 16); }
            { const float send = hi3 ? r2[0] : r2[1], keep = hi3 ? r2[1] : r2[0]; r1 = keep + __shfl_xor(send, 8); }
            r1 += __shfl_xor(r1, 4); r1 += __shfl_xor(r1, 2); r1 += __shfl_xor(r1, 1);
            uint4 v0[8], v1[8];
#pragma unroll
            for (int k = 0; k < 8; ++k) {
                const bf16_t* vp = vb + (size_t)exs[k] * ND + lane * 8;
                v0[k] = *(const uint4*)vp; v1[k] = *(const uint4*)(vp + 512);
            }
            const float gk = __shfl(gsel, lbase + (lane >> 3));
            const float coef = gk * gelu_fast(r1);
#pragma unroll
            for (int k = 0; k < 8; ++k) {
                const float ck = __int_as_float(__builtin_amdgcn_readlane(__float_as_int(coef), 8 * k));
                const unsigned w[8] = {v0[k].x, v0[k].y, v0[k].z, v0[k].w, v1[k].x, v1[k].y, v1[k].z, v1[k].w};
#pragma unroll
                for (int j = 0; j < 8; ++j) {
                    acc[2 * j] += ck * __uint_as_float(w[j] << 16);
                    acc[2 * j + 1] += ck * __uint_as_float(w[j] & 0xffff0000u);
                }
            }
        }
        {
            const float* rp = R + (size_t)token * ND + lane * 8;
            const float4 a0 = *(const float4*)rp, a1 = *(const float4*)(rp + 4), b0 = *(const float4*)(rp + 512), b1 = *(const float4*)(rp + 516);
            xf[0] = a0.x; xf[1] = a0.y; xf[2] = a0.z; xf[3] = a0.w; xf[4] = a1.x; xf[5] = a1.y; xf[6] = a1.z; xf[7] = a1.w;
            xf[8] = b0.x; xf[9] = b0.y; xf[10] = b0.z; xf[11] = b0.w; xf[12] = b1.x; xf[13] = b1.y; xf[14] = b1.z; xf[15] = b1.w;
        }
        float s = 0.f;
#pragma unroll
        for (int j = 0; j < 16; ++j) { xf[j] = ALPHA * xf[j] + acc[j]; s += xf[j]; }
        for (int o = 32; o; o >>= 1) s += __shfl_xor(s, o);
        const float mean = s * (1.f / ND);
        float s2 = 0.f;
#pragma unroll
        for (int j = 0; j < 16; ++j) { xf[j] -= mean; s2 += xf[j] * xf[j]; }
        for (int o = 32; o; o >>= 1) s2 += __shfl_xor(s2, o);
        const float rs = rsqrtf(s2 * (1.f / ND) + LN_EPS);
#pragma unroll
        for (int hf = 0; hf < 2; ++hf) {
            const int c0 = hf * 512 + lane * 8;
            const float4 g0 = *(const float4*)(lg + c0), g1 = *(const float4*)(lg + c0 + 4), b0 = *(const float4*)(lb + c0), b1 = *(const float4*)(lb + c0 + 4);
            float o[8];
            o[0] = xf[hf * 8 + 0] * rs * g0.x + b0.x; o[1] = xf[hf * 8 + 1] * rs * g0.y + b0.y; o[2] = xf[hf * 8 + 2] * rs * g0.z + b0.z; o[3] = xf[hf * 8 + 3] * rs * g0.w + b0.w;
            o[4] = xf[hf * 8 + 4] * rs * g1.x + b1.x; o[5] = xf[hf * 8 + 5] * rs * g1.y + b1.y; o[6] = xf[hf * 8 + 6] * rs * g1.z + b1.z; o[7] = xf[hf * 8 + 7] * rs * g1.w + b1.w;
            float* op = R + (size_t)token * ND + c0;
            *(float4*)op = make_float4(o[0], o[1], o[2], o[3]); *(float4*)(op + 4) = make_float4(o[4], o[5], o[6], o[7]);
            if (Hb) st8(Hb + (size_t)token * ND + c0, o);
        }
    }
}


template <int K2, int J> __device__ __forceinline__ void bsort_round(int (&k)[2], float (&g)[2], int lane) {
    if (J == 64) {
        const bool sw = k[0] > k[1];
        const int t = k[0]; const float tg = g[0];
        k[0] = sw ? k[1] : k[0]; g[0] = sw ? g[1] : g[0]; k[1] = sw ? t : k[1]; g[1] = sw ? tg : g[1];
    } else {
#pragma unroll
        for (int r = 0; r < 2; ++r) {
            const int pk = __shfl_xor(k[r], J); const float pg = __shfl_xor(g[r], J);
            const bool asc = (((lane + 64 * r) & K2) == 0), lower = ((lane & J) == 0);
            const bool take = (lower == asc) ? (pk < k[r]) : (pk > k[r]);
            k[r] = take ? pk : k[r]; g[r] = take ? pg : g[r];
        }
    }
}
template <int K2> __device__ __forceinline__ void bsort_stage(int (&k)[2], float (&g)[2], int lane) {
    if (K2 >= 128) bsort_round<K2, 64>(k, g, lane);
    if (K2 >= 64) bsort_round<K2, 32>(k, g, lane);
    if (K2 >= 32) bsort_round<K2, 16>(k, g, lane);
    if (K2 >= 16) bsort_round<K2, 8>(k, g, lane);
    if (K2 >= 8) bsort_round<K2, 4>(k, g, lane);
    if (K2 >= 4) bsort_round<K2, 2>(k, g, lane);
    bsort_round<K2, 1>(k, g, lane);
}
__device__ __forceinline__ void sort_routing(int& e_lo, int& e_hi, float& g_lo, float& g_hi, int lane) {
    int k[2] = {e_lo, e_hi}; float g[2] = {g_lo, g_hi};
    bsort_stage<2>(k, g, lane); bsort_stage<4>(k, g, lane); bsort_stage<8>(k, g, lane); bsort_stage<16>(k, g, lane);
    bsort_stage<32>(k, g, lane); bsort_stage<64>(k, g, lane); bsort_stage<128>(k, g, lane);
    e_lo = k[0]; e_hi = k[1]; g_lo = g[0]; g_hi = g[1];
}
template <int J> __device__ __forceinline__ unsigned sort_partner(unsigned v, int lane) {
    if constexpr (J == 1) return (unsigned)__builtin_amdgcn_update_dpp(0, (int)v, 0xB1, 0xf, 0xf, false);
    else if constexpr (J == 2) return (unsigned)__builtin_amdgcn_update_dpp(0, (int)v, 0x4E, 0xf, 0xf, false);
    else if constexpr (J == 4) { const int t = __builtin_amdgcn_update_dpp(0, (int)v, 0x141, 0xf, 0xf, false);
                                 return (unsigned)__builtin_amdgcn_update_dpp(0, t, 0x1B, 0xf, 0xf, false); }
    else if constexpr (J == 8) return (unsigned)__builtin_amdgcn_update_dpp(0, (int)v, 0x128, 0xf, 0xf, false);
    else if constexpr (J == 16) { const auto r = __builtin_amdgcn_permlane16_swap(v, v, false, false); return (lane & 16) ? r[0] : r[1]; }
    else { const auto r = __builtin_amdgcn_permlane32_swap(v, v, false, false); return (lane & 32) ? r[0] : r[1]; }
}
template <int K2, int J> __device__ __forceinline__ void psort_round(unsigned (&v)[2], int lane) {
    if constexpr (J == 64) { const unsigned lo = min(v[0], v[1]), hi = max(v[0], v[1]); v[0] = lo; v[1] = hi; }
    else {
#pragma unroll
        for (int r = 0; r < 2; ++r) {
            const unsigned pv = sort_partner<J>(v[r], lane);
            const bool asc = (((lane + 64 * r) & K2) == 0), lower = ((lane & J) == 0);
            const unsigned mn = min(v[r], pv), mx = max(v[r], pv);
            v[r] = (lower == asc) ? mn : mx;
        }
    }
}
template <int K2> __device__ __forceinline__ void psort_stage(unsigned (&v)[2], int lane) {
    if constexpr (K2 >= 128) psort_round<K2, 64>(v, lane);
    if constexpr (K2 >= 64) psort_round<K2, 32>(v, lane);
    if constexpr (K2 >= 32) psort_round<K2, 16>(v, lane);
    if constexpr (K2 >= 16) psort_round<K2, 8>(v, lane);
    if constexpr (K2 >= 8) psort_round<K2, 4>(v, lane);
    if constexpr (K2 >= 4) psort_round<K2, 2>(v, lane);
    psort_round<K2, 1>(v, lane);
}
__device__ __forceinline__ void sort_routing_packed(unsigned& lo, unsigned& hi, int lane) {
    unsigned v[2] = {lo, hi};
    psort_stage<2>(v, lane); psort_stage<4>(v, lane); psort_stage<8>(v, lane); psort_stage<16>(v, lane);
    psort_stage<32>(v, lane); psort_stage<64>(v, lane); psort_stage<128>(v, lane);
    lo = v[0]; hi = v[1];
}
__device__ __forceinline__ void peer_expert3_phase(float* R, const int* __restrict__ eidx, const float* __restrict__ egate, const unsigned char* __restrict__ ub,
                                                   const unsigned char* __restrict__ vb, const float* __restrict__ lg, const float* __restrict__ lb, bf16_t* Hb, float* Rout, const XcdBarrier& xb) {
    const int wave = tidx() >> 6, lane = tidx() & 63;
    int itk = 0;
    for (int token = blockIdx.x * 8 + wave; token < NT; token += gridDim.x * 8, ++itk) {
        if ((itk & 1) == 0 && itk) xcd_barrier(xb);
        float xf[16];
        {
            const float* rp = R + (size_t)token * ND + lane * 16;
#pragma unroll
            for (int q = 0; q < 4; ++q) { const float4 a = *(const float4*)(rp + 4 * q); xf[4 * q] = a.x; xf[4 * q + 1] = a.y; xf[4 * q + 2] = a.z; xf[4 * q + 3] = a.w; }
        }
        float acc[16];
#pragma unroll
        for (int j = 0; j < 16; ++j) acc[j] = 0.f;
        int e_lo = eidx[(size_t)token * 128 + lane], e_hi = eidx[(size_t)token * 128 + 64 + lane];
        float g_lo = egate[(size_t)token * 128 + lane], g_hi = egate[(size_t)token * 128 + 64 + lane];
        sort_routing(e_lo, e_hi, g_lo, g_hi, lane);
        for (int grp = 0; grp < 16; ++grp) {
            const int esel = grp < 8 ? e_lo : e_hi;
            const float gsel = grp < 8 ? g_lo : g_hi;
            const int lbase = (grp & 7) * 8;
            uint4 u[8], v[8];
#pragma unroll
            for (int k = 0; k < 8; ++k) {
                const int ex = __builtin_amdgcn_readlane(esel, lbase + k);
                u[k] = *(const uint4*)(ub + (size_t)ex * ND + lane * 16);
                v[k] = *(const uint4*)(vb + (size_t)ex * ND + lane * 16);
            }
            float d[8];
#pragma unroll
            for (int k = 0; k < 8; ++k) {
                const unsigned w[4] = {u[k].x, u[k].y, u[k].z, u[k].w};
                float a = 0.f, b = 0.f;
#pragma unroll
                for (int q = 0; q < 4; ++q) {
                    const f32x2_t lo = __builtin_amdgcn_cvt_pk_f32_fp8((int)w[q], false), hi = __builtin_amdgcn_cvt_pk_f32_fp8((int)w[q], true);
                    a = fmaf(xf[4 * q], lo.x, a); b = fmaf(xf[4 * q + 1], lo.y, b); a = fmaf(xf[4 * q + 2], hi.x, a); b = fmaf(xf[4 * q + 3], hi.y, b);
                }
                d[k] = a + b;
            }
            const bool hi5 = lane & 32, hi4 = lane & 16, hi3 = lane & 8;
            float r4[4], r2[2], r1;
#pragma unroll
            for (int k = 0; k < 4; ++k) { const float send = hi5 ? d[k] : d[k + 4], keep = hi5 ? d[k + 4] : d[k]; r4[k] = keep + __shfl_xor(send, 32); }
#pragma unroll
            for (int k = 0; k < 2; ++k) { const float send = hi4 ? r4[k] : r4[k + 2], keep = hi4 ? r4[k + 2] : r4[k]; r2[k] = keep + __shfl_xor(send, 16); }
            { const float send = hi3 ? r2[0] : r2[1], keep = hi3 ? r2[1] : r2[0]; r1 = keep + __shfl_xor(send, 8); }
            r1 += __shfl_xor(r1, 4); r1 += __shfl_xor(r1, 2); r1 += __shfl_xor(r1, 1);
            const float gk = __shfl(gsel, lbase + (lane >> 3));
            const float coef = gk * gelu_fast(r1 * (1.f / U_SCALE)) * (1.f / V_SCALE);
#pragma unroll
            for (int k = 0; k < 8; ++k) {
                const float ck = __int_as_float(__builtin_amdgcn_readlane(__float_as_int(coef), 8 * k));
                const unsigned w[4] = {v[k].x, v[k].y, v[k].z, v[k].w};
#pragma unroll
                for (int q = 0; q < 4; ++q) {
                    const f32x2_t lo = __builtin_amdgcn_cvt_pk_f32_fp8((int)w[q], false), hi = __builtin_amdgcn_cvt_pk_f32_fp8((int)w[q], true);
                    acc[4 * q] = fmaf(ck, lo.x, acc[4 * q]); acc[4 * q + 1] = fmaf(ck, lo.y, acc[4 * q + 1]);
                    acc[4 * q + 2] = fmaf(ck, hi.x, acc[4 * q + 2]); acc[4 * q + 3] = fmaf(ck, hi.y, acc[4 * q + 3]);
                }
            }
        }
        float s = 0.f;
#pragma unroll
        for (int j = 0; j < 16; ++j) { xf[j] = ALPHA * xf[j] + acc[j]; s += xf[j]; }
        for (int o = 32; o; o >>= 1) s += __shfl_xor(s, o);
        const float mean = s * (1.f / ND);
        float s2 = 0.f;
#pragma unroll
        for (int j = 0; j < 16; ++j) { xf[j] -= mean; s2 += xf[j] * xf[j]; }
        for (int o = 32; o; o >>= 1) s2 += __shfl_xor(s2, o);
        const float rs = rsqrtf(s2 * (1.f / ND) + LN_EPS);
        float o[16];
#pragma unroll
        for (int q = 0; q < 4; ++q) {
            const float4 gg = *(const float4*)(lg + lane * 16 + 4 * q), bb = *(const float4*)(lb + lane * 16 + 4 * q);
            o[4 * q] = xf[4 * q] * rs * gg.x + bb.x; o[4 * q + 1] = xf[4 * q + 1] * rs * gg.y + bb.y; o[4 * q + 2] = xf[4 * q + 2] * rs * gg.z + bb.z; o[4 * q + 3] = xf[4 * q + 3] * rs * gg.w + bb.w;
            *(float4*)(Rout + (size_t)token * ND + lane * 16 + 4 * q) = make_float4(o[4 * q], o[4 * q + 1], o[4 * q + 2], o[4 * q + 3]);
        }
        if (Hb) { st8(Hb + (size_t)token * ND + lane * 16, o); st8(Hb + (size_t)token * ND + lane * 16 + 8, o + 8); }
    }
}


struct Rows8 { uint4 r[8]; };
__device__ __forceinline__ void rows_load(Rows8& G, int esel, int lbase, const unsigned char* __restrict__ tb, int lane) {
    const __amdgpu_buffer_rsrc_t rs = __builtin_amdgcn_make_buffer_rsrc((void*)tb, (short)0, (int)(16384 * ND), 0x00020000);
#pragma unroll
    for (int k = 0; k < 8; ++k) {
        const int ex = __builtin_amdgcn_readlane(esel, lbase + k);
        const u32x4 rv = __builtin_bit_cast(u32x4, __builtin_amdgcn_raw_buffer_load_b128(rs, lane * 16, ex * ND, 0));
        G.r[k] = make_uint4(rv.x, rv.y, rv.z, rv.w);
    }
}
__device__ __forceinline__ void sweep_u(const Rows8& G, const float (&xf)[16], float gsel, int lbase, int lane, float* cl  , int grp) {
    float d[8];
#pragma unroll
    for (int k = 0; k < 8; ++k) {
        const unsigned w[4] = {G.r[k].x, G.r[k].y, G.r[k].z, G.r[k].w};
        f32x2_t a2 = {0.f, 0.f}, b2 = {0.f, 0.f};
#pragma unroll
        for (int q = 0; q < 4; ++q) {
            const f32x2_t lo = __builtin_amdgcn_cvt_pk_f32_fp8((int)w[q], false), hi = __builtin_amdgcn_cvt_pk_f32_fp8((int)w[q], true);
            a2 = __builtin_elementwise_fma((f32x2_t){xf[4 * q], xf[4 * q + 1]}, lo, a2);
            b2 = __builtin_elementwise_fma((f32x2_t){xf[4 * q + 2], xf[4 * q + 3]}, hi, b2);
        }
        d[k] = (a2.x + a2.y) + (b2.x + b2.y);
    }
    const bool hi5 = lane & 32, hi4 = lane & 16, hi3 = lane & 8;
    float r4[4], r2[2], r1;
#pragma unroll
    for (int k = 0; k < 4; ++k) { const float send = hi5 ? d[k] : d[k + 4], keep = hi5 ? d[k + 4] : d[k]; r4[k] = keep + __shfl_xor(send, 32); }
#pragma unroll
    for (int k = 0; k < 2; ++k) { const float send = hi4 ? r4[k] : r4[k + 2], keep = hi4 ? r4[k + 2] : r4[k]; r2[k] = keep + __shfl_xor(send, 16); }
    { const float send = hi3 ? r2[0] : r2[1], keep = hi3 ? r2[1] : r2[0]; r1 = keep + __shfl_xor(send, 8); }
    r1 += __shfl_xor(r1, 4); r1 += __shfl_xor(r1, 2); r1 += __shfl_xor(r1, 1);
    const float gk = __shfl(gsel, lbase + (lane >> 3));
    const float coef = gk * gelu_fast(r1 * (1.f / U_SCALE)) * (1.f / V_SCALE);
    if ((lane & 7) == 0) cl[grp * 8 + (lane >> 3)] = coef;
}
__device__ __forceinline__ void sweep_u8(const Rows8& G, const uint4 xq, unsigned gsel, float sx, int lbase, int lane, float* cl  , int grp) {
    int d[8];
#pragma unroll
    for (int k = 0; k < 8; ++k) {
        int a = __builtin_amdgcn_sdot4((int)G.r[k].x, (int)xq.x, 0, false);
        a = __builtin_amdgcn_sdot4((int)G.r[k].y, (int)xq.y, a, false);
        a = __builtin_amdgcn_sdot4((int)G.r[k].z, (int)xq.z, a, false);
        d[k] = __builtin_amdgcn_sdot4((int)G.r[k].w, (int)xq.w, a, false);
    }
    const bool hi5 = lane & 32, hi4 = lane & 16, hi3 = lane & 8;
    int r4[4], r2[2], r1;
#pragma unroll
    for (int k = 0; k < 4; ++k) { const int send = hi5 ? d[k] : d[k + 4], keep = hi5 ? d[k + 4] : d[k]; r4[k] = keep + __shfl_xor(send, 32); }
#pragma unroll
    for (int k = 0; k < 2; ++k) { const int send = hi4 ? r4[k] : r4[k + 2], keep = hi4 ? r4[k + 2] : r4[k]; r2[k] = keep + __shfl_xor(send, 16); }
    { const int send = hi3 ? r2[0] : r2[1], keep = hi3 ? r2[1] : r2[0]; r1 = keep + __shfl_xor(send, 8); }
    r1 += __shfl_xor(r1, 4); r1 += __shfl_xor(r1, 2); r1 += __shfl_xor(r1, 1);
    if ((lane & 7) == 0) ((int*)cl)[grp * 8 + (lane >> 3)] = r1;
}
__device__ __forceinline__ void u_finish(unsigned glo, unsigned ghi, float sx, int lane, float* cl) {
    const int ra = ((const int*)cl)[lane], rb = ((const int*)cl)[64 + lane];
    const float ca = __uint_as_float(glo << 16) * gelu_fast((float)ra * (__uint_as_float(glo & 0xffff0000u) * sx)) * (1.f / V_SCALE);
    const float cb = __uint_as_float(ghi << 16) * gelu_fast((float)rb * (__uint_as_float(ghi & 0xffff0000u) * sx)) * (1.f / V_SCALE);
    cl[lane] = ca; cl[64 + lane] = cb;
}
__device__ __forceinline__ void sweep_v(const Rows8& G, float (&acc)[16], const float* cl, int grp) {
#pragma unroll
    for (int k = 0; k < 8; ++k) {
        const float ck = cl[grp * 8 + k];
        const unsigned w[4] = {G.r[k].x, G.r[k].y, G.r[k].z, G.r[k].w};
        const f32x2_t ck2 = {ck, ck};
#pragma unroll
        for (int q = 0; q < 4; ++q) {
            const f32x2_t lo = __builtin_amdgcn_cvt_pk_f32_fp8((int)w[q], false), hi = __builtin_amdgcn_cvt_pk_f32_fp8((int)w[q], true);
            f32x2_t* ap = (f32x2_t*)&acc[4 * q];
            ap[0] = __builtin_elementwise_fma(ck2, lo, ap[0]);
            ap[1] = __builtin_elementwise_fma(ck2, hi, ap[1]);
        }
    }
}
__device__ __forceinline__ void peer_expert6_phase(float* R, const int* __restrict__ eidx, const float* __restrict__ egate, const unsigned char* __restrict__ ub,
                                                   const unsigned char* __restrict__ vb, const float* __restrict__ lg, const float* __restrict__ lb, bf16_t* Hb, const XcdBarrier& xb, float* lds,
                                                   const float* __restrict__ l1g, const float* __restrict__ l1b) {
    const int wave = __builtin_amdgcn_readfirstlane(tidx() >> 6), lane = tidx() & 63;
    float* cl = lds + wave * 128;
    int itk = 0;
    for (int token = blockIdx.x * 8 + wave; token < NT; token += gridDim.x * 8, ++itk) {
        if (itk) xcc_align(xb);
        float xf[16];
        {
            const float* rp = R + (size_t)token * ND + lane * 16;
#pragma unroll
            for (int q = 0; q < 4; ++q) { const float4 a = *(const float4*)(rp + 4 * q); xf[4 * q] = a.x; xf[4 * q + 1] = a.y; xf[4 * q + 2] = a.z; xf[4 * q + 3] = a.w; }
        }
        {
            float s = 0.f;
#pragma unroll
            for (int j = 0; j < 16; ++j) s += xf[j];
            for (int o = 32; o; o >>= 1) s += __shfl_xor(s, o);
            const float mean = s * (1.f / ND);
            float s2 = 0.f;
#pragma unroll
            for (int j = 0; j < 16; ++j) { xf[j] -= mean; s2 += xf[j] * xf[j]; }
            for (int o = 32; o; o >>= 1) s2 += __shfl_xor(s2, o);
            const float rs = rsqrtf(s2 * (1.f / ND) + LN_EPS);
            int lofs1 = lane * 16;
            asm volatile("" : "+v"(lofs1));
#pragma unroll
            for (int q = 0; q < 4; ++q) {
                const float4 gg = *(const float4*)(l1g + lofs1 + 4 * q), bb = *(const float4*)(l1b + lofs1 + 4 * q);
                xf[4 * q] = xf[4 * q] * rs * gg.x + bb.x; xf[4 * q + 1] = xf[4 * q + 1] * rs * gg.y + bb.y; xf[4 * q + 2] = xf[4 * q + 2] * rs * gg.z + bb.z; xf[4 * q + 3] = xf[4 * q + 3] * rs * gg.w + bb.w;
            }
        }
        int e_lo = eidx[(size_t)token * 128 + lane], e_hi = eidx[(size_t)token * 128 + 64 + lane];
        float g_lo = egate[(size_t)token * 128 + lane], g_hi = egate[(size_t)token * 128 + 64 + lane];
        sort_routing(e_lo, e_hi, g_lo, g_hi, lane);
        Rows8 GA, GB;
        wave_lds_fence();
        rows_load(GA, e_lo, 0, ub, lane);
#pragma unroll 1
        for (int gp = 0; gp < 8; ++gp) {
            const int g0i = 2 * gp, g1i = 2 * gp + 1;
            rows_load(GB, g1i < 8 ? e_lo : e_hi, (g1i & 7) * 8, ub, lane);
            __builtin_amdgcn_sched_barrier(0);
            sweep_u(GA, xf, g0i < 8 ? g_lo : g_hi, (g0i & 7) * 8, lane, cl, g0i);
            __builtin_amdgcn_sched_barrier(0);
            rows_load(GA, gp < 7 ? ((g0i + 2) < 8 ? e_lo : e_hi) : e_lo, gp < 7 ? ((g0i + 2) & 7) * 8 : 0, gp < 7 ? ub : vb, lane);
            __builtin_amdgcn_sched_barrier(0);
            sweep_u(GB, xf, g1i < 8 ? g_lo : g_hi, (g1i & 7) * 8, lane, cl, g1i);
            __builtin_amdgcn_sched_barrier(0);
        }
        wave_lds_fence();
        xcc_align(xb);
        float acc[16];
#pragma unroll
        for (int j = 0; j < 16; ++j) acc[j] = 0.f;
#pragma unroll 1
        for (int gp = 0; gp < 8; ++gp) {
            const int g0i = 2 * gp, g1i = 2 * gp + 1;
            rows_load(GB, g1i < 8 ? e_lo : e_hi, (g1i & 7) * 8, vb, lane);
            __builtin_amdgcn_sched_barrier(0);
            sweep_v(GA, acc, cl, g0i);
            __builtin_amdgcn_sched_barrier(0);
            if (gp < 7) rows_load(GA, (g0i + 2) < 8 ? e_lo : e_hi, ((g0i + 2) & 7) * 8, vb, lane);
            __builtin_amdgcn_sched_barrier(0);
            sweep_v(GB, acc, cl, g1i);
            __builtin_amdgcn_sched_barrier(0);
        }
        float s = 0.f;
#pragma unroll
        for (int j = 0; j < 16; ++j) { xf[j] = ALPHA * xf[j] + acc[j]; s += xf[j]; }
        for (int o = 32; o; o >>= 1) s += __shfl_xor(s, o);
        const float mean = s * (1.f / ND);
        float s2 = 0.f;
#pragma unroll
        for (int j = 0; j < 16; ++j) { xf[j] -= mean; s2 += xf[j] * xf[j]; }
        for (int o = 32; o; o >>= 1) s2 += __shfl_xor(s2, o);
        const float rs = rsqrtf(s2 * (1.f / ND) + LN_EPS);
        float o[16];
        int lofs = lane * 16;
        asm volatile("" : "+v"(lofs));
#pragma unroll
        for (int q = 0; q < 4; ++q) {
            const float4 gg = *(const float4*)(lg + lofs + 4 * q), bb = *(const float4*)(lb + lofs + 4 * q);
            o[4 * q] = xf[4 * q] * rs * gg.x + bb.x; o[4 * q + 1] = xf[4 * q + 1] * rs * gg.y + bb.y; o[4 * q + 2] = xf[4 * q + 2] * rs * gg.z + bb.z; o[4 * q + 3] = xf[4 * q + 3] * rs * gg.w + bb.w;
            *(float4*)(R + (size_t)token * ND + lofs + 4 * q) = make_float4(o[4 * q], o[4 * q + 1], o[4 * q + 2], o[4 * q + 3]);
        }
        if (Hb) { st8(Hb + (size_t)token * ND + lofs, o); st8(Hb + (size_t)token * ND + lofs + 8, o + 8); }
    }
}


__device__ __forceinline__ void unpack8(const uint4 v, float* o) {
    o[0] = __uint_as_float(v.x << 16); o[1] = __uint_as_float(v.x & 0xffff0000u); o[2] = __uint_as_float(v.y << 16); o[3] = __uint_as_float(v.y & 0xffff0000u);
    o[4] = __uint_as_float(v.z << 16); o[5] = __uint_as_float(v.z & 0xffff0000u); o[6] = __uint_as_float(v.w << 16); o[7] = __uint_as_float(v.w & 0xffff0000u);
}
__device__ __forceinline__ void ln1_row(float (&xf)[16], int lane, const float* __restrict__ l1g, const float* __restrict__ l1b);
__device__ __forceinline__ void load_h_row(const bf16_t* Vb, int token, int lane, const float* __restrict__ l1g, const float* __restrict__ l1b, float (&xf)[16]) {
    ld8(Vb + (size_t)token * ND + lane * 16, xf); ld8(Vb + (size_t)token * ND + lane * 16 + 8, xf + 8);
    ln1_row(xf, lane, l1g, l1b);
}
__device__ __forceinline__ void ln1_row(float (&xf)[16], int lane, const float* __restrict__ l1g, const float* __restrict__ l1b) {
    float s = 0.f;
#pragma unroll
    for (int j = 0; j < 16; ++j) s += xf[j];
    for (int o = 32; o; o >>= 1) s += __shfl_xor(s, o);
    const float mean = s * (1.f / ND);
    float s2 = 0.f;
#pragma unroll
    for (int j = 0; j < 16; ++j) { xf[j] -= mean; s2 += xf[j] * xf[j]; }
    for (int o = 32; o; o >>= 1) s2 += __shfl_xor(s2, o);
    const float rs = rsqrtf(s2 * (1.f / ND) + LN_EPS);
    int lofs1 = lane * 16;
    asm volatile("" : "+v"(lofs1));
#pragma unroll
    for (int q = 0; q < 4; ++q) {
        const float4 gg = *(const float4*)(l1g + lofs1 + 4 * q), bb = *(const float4*)(l1b + lofs1 + 4 * q);
        xf[4 * q] = xf[4 * q] * rs * gg.x + bb.x; xf[4 * q + 1] = xf[4 * q + 1] * rs * gg.y + bb.y; xf[4 * q + 2] = xf[4 * q + 2] * rs * gg.z + bb.z; xf[4 * q + 3] = xf[4 * q + 3] * rs * gg.w + bb.w;
    }
}
__device__ __forceinline__ void finish_row_regs(float* R, bf16_t* Hb, int token, int lane, float (&xf)[16], const float (&acc)[16], const float4 (&gg)[4], const float4 (&bb)[4]) {
    float s = 0.f;
#pragma unroll
    for (int j = 0; j < 16; ++j) { xf[j] = ALPHA * xf[j] + acc[j]; s += xf[j]; }
    for (int o = 32; o; o >>= 1) s += __shfl_xor(s, o);
    const float mean = s * (1.f / ND);
    float s2 = 0.f;
#pragma unroll
    for (int j = 0; j < 16; ++j) { xf[j] -= mean; s2 += xf[j] * xf[j]; }
    for (int o = 32; o; o >>= 1) s2 += __shfl_xor(s2, o);
    const float rs = rsqrtf(s2 * (1.f / ND) + LN_EPS);
    float o[16];
    const int lofs = lane * 16;
#pragma unroll
    for (int q = 0; q < 4; ++q) {
        o[4 * q] = xf[4 * q] * rs * gg[q].x + bb[q].x; o[4 * q + 1] = xf[4 * q + 1] * rs * gg[q].y + bb[q].y; o[4 * q + 2] = xf[4 * q + 2] * rs * gg[q].z + bb[q].z; o[4 * q + 3] = xf[4 * q + 3] * rs * gg[q].w + bb[q].w;
        if (R) *(float4*)(R + (size_t)token * ND + lofs + 4 * q) = make_float4(o[4 * q], o[4 * q + 1], o[4 * q + 2], o[4 * q + 3]);
    }
    if (Hb) { st8(Hb + (size_t)token * ND + lofs, o); st8(Hb + (size_t)token * ND + lofs + 8, o + 8); }
}
__device__ __forceinline__ void ln1_row_regs(float (&xf)[16], const float4 (&gg)[4], const float4 (&bb)[4]) {
    float s = 0.f;
#pragma unroll
    for (int j = 0; j < 16; ++j) s += xf[j];
    for (int o = 32; o; o >>= 1) s += __shfl_xor(s, o);
    const float mean = s * (1.f / ND);
    float s2 = 0.f;
#pragma unroll
    for (int j = 0; j < 16; ++j) { xf[j] -= mean; s2 += xf[j] * xf[j]; }
    for (int o = 32; o; o >>= 1) s2 += __shfl_xor(s2, o);
    const float rs = rsqrtf(s2 * (1.f / ND) + LN_EPS);
#pragma unroll
    for (int q = 0; q < 4; ++q) {
        xf[4 * q] = xf[4 * q] * rs * gg[q].x + bb[q].x; xf[4 * q + 1] = xf[4 * q + 1] * rs * gg[q].y + bb[q].y; xf[4 * q + 2] = xf[4 * q + 2] * rs * gg[q].z + bb[q].z; xf[4 * q + 3] = xf[4 * q + 3] * rs * gg[q].w + bb[q].w;
    }
}
__device__ __forceinline__ void finish_row(float* R, bf16_t* Hb, int token, int lane, float (&xf)[16], const float (&acc)[16], const float* __restrict__ lg, const float* __restrict__ lb) {
    float s = 0.f;
#pragma unroll
    for (int j = 0; j < 16; ++j) { xf[j] = ALPHA * xf[j] + acc[j]; s += xf[j]; }
    for (int o = 32; o; o >>= 1) s += __shfl_xor(s, o);
    const float mean = s * (1.f / ND);
    float s2 = 0.f;
#pragma unroll
    for (int j = 0; j < 16; ++j) { xf[j] -= mean; s2 += xf[j] * xf[j]; }
    for (int o = 32; o; o >>= 1) s2 += __shfl_xor(s2, o);
    const float rs = rsqrtf(s2 * (1.f / ND) + LN_EPS);
    float o[16];
    int lofs = lane * 16;
    asm volatile("" : "+v"(lofs));
#pragma unroll
    for (int q = 0; q < 4; ++q) {
        const float4 gg = *(const float4*)(lg + lofs + 4 * q), bb = *(const float4*)(lb + lofs + 4 * q);
        o[4 * q] = xf[4 * q] * rs * gg.x + bb.x; o[4 * q + 1] = xf[4 * q + 1] * rs * gg.y + bb.y; o[4 * q + 2] = xf[4 * q + 2] * rs * gg.z + bb.z; o[4 * q + 3] = xf[4 * q + 3] * rs * gg.w + bb.w;
        if (R) *(float4*)(R + (size_t)token * ND + lofs + 4 * q) = make_float4(o[4 * q], o[4 * q + 1], o[4 * q + 2], o[4 * q + 3]);
    }
    if (Hb) { st8(Hb + (size_t)token * ND + lofs, o); st8(Hb + (size_t)token * ND + lofs + 8, o + 8); }
}
__device__ __forceinline__ void peer_expert10_phase(float* R, const bf16_t* Vin, const int* __restrict__ eidx, const float* __restrict__ egate, const unsigned char* __restrict__ ub,
                                                    const unsigned char* __restrict__ vb, const float* __restrict__ lg, const float* __restrict__ lb, bf16_t* Hb, const XcdBarrier& xb, float* lds,
                                                    const float* __restrict__ l1g, const float* __restrict__ l1b, const float* __restrict__ su) {
    if (__builtin_amdgcn_readfirstlane(tidx() >> 6) >= 4) __builtin_amdgcn_s_setprio(1);
    const int wave = __builtin_amdgcn_readfirstlane(tidx() >> 6), lane = tidx() & 63;
    float* cl = lds + wave * 512;
    float* xs = lds + 4096 + wave * 4096;
    const int stride = gridDim.x * 8;
    int itk = 0;
    for (int tok0 = blockIdx.x * 8 + wave; tok0 < NT; tok0 += 4 * stride, ++itk) {
        if (itk) xcc_align(xb);
        int elo[4], ehi[4]; unsigned glo[4], ghi[4]; float sx[4];
        wave_lds_fence();
        uint4 hb0[4], hb1[4]; int ei0[4], ei1[4]; float eg0[4], eg1[4];
        float4 l1gr[4], l1br[4];
#pragma unroll
        for (int q = 0; q < 4; ++q) { l1gr[q] = *(const float4*)(l1g + lane * 16 + 4 * q); l1br[q] = *(const float4*)(l1b + lane * 16 + 4 * q); }
#pragma unroll
        for (int t = 0; t < 4; ++t) {
            const int tok = tok0 + t * stride;
            hb0[t] = *(const uint4*)(Vin + (size_t)tok * ND + lane * 16); hb1[t] = *(const uint4*)(Vin + (size_t)tok * ND + lane * 16 + 8);
            ei0[t] = eidx[(size_t)tok * 128 + lane]; ei1[t] = eidx[(size_t)tok * 128 + 64 + lane];
            eg0[t] = egate[(size_t)tok * 128 + lane]; eg1[t] = egate[(size_t)tok * 128 + 64 + lane];
        }
        unsigned pk0[4], pk1[4];
#pragma unroll
        for (int t = 0; t < 4; ++t) {
            {
                float xr[16]; unpack8(hb0[t], xr); unpack8(hb1[t], xr + 8); ln1_row_regs(xr, l1gr, l1br);
                float m = 0.f;
#pragma unroll
                for (int j = 0; j < 16; ++j) m = fmaxf(m, fabsf(xr[j]));
                for (int o = 32; o; o >>= 1) m = fmaxf(m, __shfl_xor(m, o));
                const float inv = m > 0.f ? 127.f / m : 0.f;
                sx[t] = m * (1.f / 127.f);
                uint4 w; unsigned* wp = (unsigned*)&w;
#pragma unroll
                for (int q = 0; q < 4; ++q) {
                    const int b0 = (int)rintf(xr[4 * q] * inv), b1 = (int)rintf(xr[4 * q + 1] * inv), b2 = (int)rintf(xr[4 * q + 2] * inv), b3 = (int)rintf(xr[4 * q + 3] * inv);
                    wp[q] = (unsigned)(b0 & 255) | ((unsigned)(b1 & 255) << 8) | ((unsigned)(b2 & 255) << 16) | ((unsigned)b3 << 24);
                }
                *(uint4*)((unsigned char*)(xs + t * 1024) + lane * 16) = w;
            }
            unsigned p0 = ((unsigned)ei0[t] << 16) | (unsigned)f2bf(eg0[t]);
            unsigned p1 = ((unsigned)ei1[t] << 16) | (unsigned)f2bf(eg1[t]);
            sort_routing_packed(p0, p1, lane);
            pk0[t] = p0; pk1[t] = p1;
            elo[t] = (int)(p0 >> 16); ehi[t] = (int)(p1 >> 16);
        }
        {
            float s0[4], s1[4];
#pragma unroll
            for (int t = 0; t < 4; ++t) { s0[t] = su[elo[t]]; s1[t] = su[ehi[t]]; }
#pragma unroll
            for (int t = 0; t < 4; ++t) { glo[t] = (pk0[t] & 0xffffu) | ((unsigned)f2bf(s0[t]) << 16); ghi[t] = (pk1[t] & 0xffffu) | ((unsigned)f2bf(s1[t]) << 16); }
        }
        Rows8 GA, GB;
        wave_lds_fence();
        rows_load(GA, elo[0], 0, ub, lane);
#pragma unroll 1
        for (int g = 0; g < 16; ++g) {
            if (g == 8) xcc_align(xb);
            const int lb8 = (g & 7) * 8; const bool lo = g < 8;
            rows_load(GB, lo ? elo[1] : ehi[1], lb8, ub, lane);
            __builtin_amdgcn_sched_barrier(0);
            sweep_u8(GA, *(const uint4*)((const unsigned char*)(xs + 0 * 1024) + lane * 16), lo ? glo[0] : ghi[0], sx[0], lb8, lane, cl, g);
            __builtin_amdgcn_sched_barrier(0);
            rows_load(GA, lo ? elo[2] : ehi[2], lb8, ub, lane);
            __builtin_amdgcn_sched_barrier(0);
            sweep_u8(GB, *(const uint4*)((const unsigned char*)(xs + 1 * 1024) + lane * 16), lo ? glo[1] : ghi[1], sx[1], lb8, lane, cl + 128, g);
            __builtin_amdgcn_sched_barrier(0);
            rows_load(GB, lo ? elo[3] : ehi[3], lb8, ub, lane);
            __builtin_amdgcn_sched_barrier(0);
            sweep_u8(GA, *(const uint4*)((const unsigned char*)(xs + 2 * 1024) + lane * 16), lo ? glo[2] : ghi[2], sx[2], lb8, lane, cl + 256, g);
            __builtin_amdgcn_sched_barrier(0);
            if (g < 15) rows_load(GA, (g + 1) < 8 ? elo[0] : ehi[0], ((g + 1) & 7) * 8, ub, lane);
            else rows_load(GA, elo[0], 0, vb, lane);
            __builtin_amdgcn_sched_barrier(0);
            sweep_u8(GB, *(const uint4*)((const unsigned char*)(xs + 3 * 1024) + lane * 16), lo ? glo[3] : ghi[3], sx[3], lb8, lane, cl + 384, g);
            __builtin_amdgcn_sched_barrier(0);
        }
        wave_lds_fence();
#pragma unroll
        for (int t = 0; t < 4; ++t) u_finish(glo[t], ghi[t], sx[t], lane, cl + 128 * t);
        wave_lds_fence();
        xcc_align(xb);
#pragma unroll
        for (int t = 0; t < 4; ++t)
#pragma unroll
            for (int q = 0; q < 4; ++q) *(float4*)(xs + t * 1024 + q * 256 + lane * 4) = make_float4(0.f, 0.f, 0.f, 0.f);
#pragma unroll 1
        for (int g = 0; g < 16; ++g) {
            if (g == 8) xcc_align(xb);
            const int lb8 = (g & 7) * 8; const bool lo = g < 8;
            rows_load(GB, lo ? elo[1] : ehi[1], lb8, vb, lane);
            __builtin_amdgcn_sched_barrier(0);
            { float av[16];
#pragma unroll
              for (int q = 0; q < 4; ++q) { const float4 v4 = *(const float4*)(xs + 0 * 1024 + q * 256 + lane * 4); av[4 * q] = v4.x; av[4 * q + 1] = v4.y; av[4 * q + 2] = v4.z; av[4 * q + 3] = v4.w; }
              sweep_v(GA, av, cl, g);
#pragma unroll
              for (int q = 0; q < 4; ++q) *(float4*)(xs + 0 * 1024 + q * 256 + lane * 4) = make_float4(av[4 * q], av[4 * q + 1], av[4 * q + 2], av[4 * q + 3]); }
            __builtin_amdgcn_sched_barrier(0);
            rows_load(GA, lo ? elo[2] : ehi[2], lb8, vb, lane);
            __builtin_amdgcn_sched_barrier(0);
            { float av[16];
#pragma unroll
              for (int q = 0; q < 4; ++q) { const float4 v4 = *(const float4*)(xs + 1 * 1024 + q * 256 + lane * 4); av[4 * q] = v4.x; av[4 * q + 1] = v4.y; av[4 * q + 2] = v4.z; av[4 * q + 3] = v4.w; }
              sweep_v(GB, av, cl + 128, g);
#pragma unroll
              for (int q = 0; q < 4; ++q) *(float4*)(xs + 1 * 1024 + q * 256 + lane * 4) = make_float4(av[4 * q], av[4 * q + 1], av[4 * q + 2], av[4 * q + 3]); }
            __builtin_amdgcn_sched_barrier(0);
            rows_load(GB, lo ? elo[3] : ehi[3], lb8, vb, lane);
            __builtin_amdgcn_sched_barrier(0);
            { float av[16];
#pragma unroll
              for (int q = 0; q < 4; ++q) { const float4 v4 = *(const float4*)(xs + 2 * 1024 + q * 256 + lane * 4); av[4 * q] = v4.x; av[4 * q + 1] = v4.y; av[4 * q + 2] = v4.z; av[4 * q + 3] = v4.w; }
              sweep_v(GA, av, cl + 256, g);
#pragma unroll
              for (int q = 0; q < 4; ++q) *(float4*)(xs + 2 * 1024 + q * 256 + lane * 4) = make_float4(av[4 * q], av[4 * q + 1], av[4 * q + 2], av[4 * q + 3]); }
            __builtin_amdgcn_sched_barrier(0);
            if (g < 15) rows_load(GA, (g + 1) < 8 ? elo[0] : ehi[0], ((g + 1) & 7) * 8, vb, lane);
            __builtin_amdgcn_sched_barrier(0);
            { float av[16];
#pragma unroll
              for (int q = 0; q < 4; ++q) { const float4 v4 = *(const float4*)(xs + 3 * 1024 + q * 256 + lane * 4); av[4 * q] = v4.x; av[4 * q + 1] = v4.y; av[4 * q + 2] = v4.z; av[4 * q + 3] = v4.w; }
              sweep_v(GB, av, cl + 384, g);
#pragma unroll
              for (int q = 0; q < 4; ++q) *(float4*)(xs + 3 * 1024 + q * 256 + lane * 4) = make_float4(av[4 * q], av[4 * q + 1], av[4 * q + 2], av[4 * q + 3]); }
            __builtin_amdgcn_sched_barrier(0);
        }
        {
            uint4 fb0[4], fb1[4]; float4 g1r[4], b1r[4], g2r[4], b2r[4];
#pragma unroll
            for (int t = 0; t < 4; ++t) { const int tok = tok0 + t * stride; fb0[t] = *(const uint4*)(Vin + (size_t)tok * ND + lane * 16); fb1[t] = *(const uint4*)(Vin + (size_t)tok * ND + lane * 16 + 8); }
#pragma unroll
            for (int q = 0; q < 4; ++q) { g1r[q] = *(const float4*)(l1g + lane * 16 + 4 * q); b1r[q] = *(const float4*)(l1b + lane * 16 + 4 * q); g2r[q] = *(const float4*)(lg + lane * 16 + 4 * q); b2r[q] = *(const float4*)(lb + lane * 16 + 4 * q); }
#pragma unroll
            for (int t = 0; t < 4; ++t) {
                const int tok = tok0 + t * stride;
                float xr[16], av[16];
#pragma unroll
                for (int q = 0; q < 4; ++q) { const float4 v4 = *(const float4*)(xs + t * 1024 + q * 256 + lane * 4); av[4 * q] = v4.x; av[4 * q + 1] = v4.y; av[4 * q + 2] = v4.z; av[4 * q + 3] = v4.w; }
                unpack8(fb0[t], xr); unpack8(fb1[t], xr + 8); ln1_row_regs(xr, g1r, b1r);
                finish_row_regs(R, Hb, tok, lane, xr, av, g2r, b2r);
                __builtin_amdgcn_sched_barrier(0);
            }
        }
    }
    __builtin_amdgcn_s_setprio(0);
}

__device__ __forceinline__ void nsa_compress_phase(const bf16_t* __restrict__ proj, int coloff, const float* __restrict__ pe, const float* __restrict__ w1,
                                   const float* __restrict__ w2, float* __restrict__ outc, float* lds) {
    const int qtr = tidx() >> 7, tid = tidx() & 127;
    float* in = lds + qtr * 2176;
    float* hid = in + 2048;
    for (int it = blockIdx.x; it < NB * 127; it += gridDim.x) {
        const int g = qtr, n = it % 127, b = it / 127;
        __syncthreads();
        for (int idx = tid; idx < 2048; idx += 128) {
            const int l = idx >> 6, d = idx & 63;
            in[idx] = bf2f(proj[(size_t)(b * NL + 16 * n + l) * ODD_PAD + coloff + g * 64 + d]) + pe[l * 64 + d];
        }
        __syncthreads();
        float a = 0.f;
        for (int i = 0; i < 2048; ++i) a += in[i] * w1[(size_t)i * 128 + tid];
        hid[tid] = gelu_tanh(a);
        __syncthreads();
        if (tid < 64) {
            float o = 0.f;
            for (int j = 0; j < 128; ++j) o += hid[j] * w2[j * 64 + tid];
            outc[((size_t)(b * 127 + n) * 4 + g) * 64 + tid] = o;
        }
    }
    __syncthreads();
}

__device__ __forceinline__ void nsa_cmp_phase(const bf16_t* __restrict__ proj, const float* __restrict__ kcmp, const float* __restrict__ vcmp,
                              bf16_t* __restrict__ O, unsigned* __restrict__ selmask, float* lds) {
    const int half = tidx() >> 8, tid = tidx() & 255;
    float* kc_s = lds + half * 18368;
    float* vc_s = kc_s + 127 * 64;
    float(*imp_s)[33] = (float(*)[33])(vc_s + 127 * 64);
    const int tk = tid >> 2, r = tid & 3;
    for (int it = blockIdx.x; it < 32 * 4 * NB / 2; it += gridDim.x) {
        const int vb = it * 2 + half;
        const int tile = vb & 31, g = (vb >> 5) & 3, b = vb >> 7;
        const int t = tile * 64 + tk, hd = g * 4 + r;
        __syncthreads();
        for (int idx = tid; idx < 127 * 64; idx += 256) { const int n = idx >> 6, d = idx & 63; kc_s[idx] = kcmp[((size_t)(b * 127 + n) * 4 + g) * 64 + d]; vc_s[idx] = vcmp[((size_t)(b * 127 + n) * 4 + g) * 64 + d]; }
        const bf16_t* prow = proj + (size_t)(b * NL + t) * ODD_PAD;
        float q[64];
#pragma unroll
        for (int d = 0; d < 64; d += 8) ld8(prow + hd * 64 + d, q + d);
        const float slope = exp2f(-0.5f * (float)(hd + 1));
        int nvalid = (t >= 31) ? ((t - 31) / 16 + 1) : 0;
        if (nvalid > 127) nvalid = 127;
        __syncthreads();
        float m = -INFINITY, l = 0.f;
        for (int n = 0; n < nvalid; ++n) {
            float s = 0.f;
#pragma unroll
            for (int d = 0; d < 64; ++d) s += q[d] * kc_s[n * 64 + d];
            s = s * 0.125f - slope * (float)(t - (16 * n + 31));
            const float mn = fmaxf(m, s);
            l = l * expf(m - mn) + expf(s - mn);
            m = mn;
        }
        const float inv_l = (nvalid > 0) ? 1.f / fmaxf(l, 1e-30f) : 0.f;
        float acc[64];
#pragma unroll
        for (int d = 0; d < 64; ++d) acc[d] = 0.f;
        float prev3 = 0.f;
        for (int j = 0; j < 32; ++j) {
            float pj[4];
#pragma unroll
            for (int nn = 0; nn < 4; ++nn) {
                const int n = 4 * j + nn;
                float p = 0.f;
                if (n < nvalid) {
                    float s = 0.f;
#pragma unroll
                    for (int d = 0; d < 64; ++d) s += q[d] * kc_s[n * 64 + d];
                    s = s * 0.125f - slope * (float)(t - (16 * n + 31));
                    p = expf(s - m) * inv_l;
                    const float* vr = vc_s + n * 64;
#pragma unroll
                    for (int d = 0; d < 64; ++d) acc[d] += p * vr[d];
                }
                pj[nn] = p;
            }
            float im = 0.5f * prev3 + pj[0] + pj[1] + pj[2] + 0.5f * pj[3];
            prev3 = pj[3];
            im += __shfl_xor(im, 1);
            im += __shfl_xor(im, 2);
            if (r == 0) imp_s[tk][j] = im;
        }
        const float g0 = sigmoidf_(bf2f(prow[2048 + hd]));
#pragma unroll
        for (int d = 0; d < 64; ++d) acc[d] *= g0;
#pragma unroll
        for (int d = 0; d < 64; d += 8) st8(O + (size_t)(b * NL + t) * ND + hd * 64 + d, acc + d);
        __syncthreads();
        const int cur = tile;
        unsigned bits = 0;
        for (int jj = 0; jj < 8; ++jj) {
            const int j = r * 8 + jj;
            const bool fj = (j == 0) || (j == cur) || (j == cur - 1);
            const float vj = (j <= cur) ? imp_s[tk][j] + (fj ? 1000.f : 0.f) : -INFINITY;
            int rank = 0;
            for (int k = 0; k < 32; ++k) {
                const bool fk = (k == 0) || (k == cur) || (k == cur - 1);
                const float vk = (k <= cur) ? imp_s[tk][k] + (fk ? 1000.f : 0.f) : -INFINITY;
                rank += (vk > vj || (vk == vj && k < j)) ? 1 : 0;
            }
            if (rank < 16) bits |= 1u << j;
        }
        bits |= __shfl_xor(bits, 1);
        bits |= __shfl_xor(bits, 2);
        if (r == 0) selmask[(size_t)(b * 4 + g) * NL + t] = bits;
    }
    __syncthreads();
}

__device__ __forceinline__ void nsa_selwin_phase(const bf16_t* __restrict__ proj, const unsigned* __restrict__ selmask, bf16_t* O, float* lds) {
    const int half = tidx() >> 8, tid = tidx() & 255;
    float(*k_s)[64] = (float(*)[64])(lds + half * 8192);
    float(*v_s)[64] = (float(*)[64])(lds + half * 8192 + 4096);
    const int tk = tid >> 2, r = tid & 3;
    for (int it = blockIdx.x; it < 32 * 32; it += gridDim.x) {
        const int tile = 31 - (it >> 5);
        const int bgi = (it & 31) * 2 + half, g = bgi & 3, b = bgi >> 2;
        const int t = tile * 64 + tk, hd = g * 4 + r;
        const bf16_t* pb = proj + (size_t)b * NL * ODD_PAD;
        const bf16_t* prow = pb + (size_t)t * ODD_PAD;
        float q[64], acc[64];
#pragma unroll
        for (int d = 0; d < 64; d += 8) ld8(prow + hd * 64 + d, q + d);
        const float slope = exp2f(-0.5f * (float)(hd + 1));
        const unsigned mask = selmask[(size_t)(b * 4 + g) * NL + t];
        bf16_t* orow = O + (size_t)(b * NL + t) * ND + hd * 64;
        for (int branch = 0; branch < 2; ++branch) {
            const int kcol = (branch == 0 ? 1536 : 2048) + g * 64, vcol = kcol + 256;
            const int j0 = (branch == 0) ? 0 : (tile >= 8 ? tile - 8 : 0);
            float m = -1e30f, l = 0.f;
#pragma unroll
            for (int d = 0; d < 64; ++d) acc[d] = 0.f;
            for (int j = j0; j <= tile; ++j) {
                __syncthreads();
                for (int i = 0; i < 16; ++i) {
                    const int idx = tid + 256 * i, key = idx >> 6, d = idx & 63;
                    k_s[key][d] = bf2f(pb[(size_t)(64 * j + key) * ODD_PAD + kcol + d]);
                    v_s[key][d] = bf2f(pb[(size_t)(64 * j + key) * ODD_PAD + vcol + d]);
                }
                __syncthreads();
                const bool take = (branch == 0) ? ((mask >> j) & 1u) : true;
                if (take) {
                    for (int s = 0; s < 64; ++s) {
                        const int dist = t - (64 * j + s);
                        const bool valid = (branch == 0) ? (dist >= 0) : (dist >= 0 && dist < 512);
                        float sc = 0.f;
#pragma unroll
                        for (int d = 0; d < 64; ++d) sc += q[d] * k_s[s][d];
                        sc = sc * 0.125f - slope * (float)dist;
                        const float mn = valid ? fmaxf(m, sc) : m;
                        const float scale = expf(m - mn);
                        const float p = valid ? expf(sc - mn) : 0.f;
                        l = l * scale + p;
#pragma unroll
                        for (int d = 0; d < 64; ++d) acc[d] = acc[d] * scale + p * v_s[s][d];
                        m = mn;
                    }
                }
            }
            const float gt = sigmoidf_(bf2f(prow[2560 + (branch + 1) * 16 + hd]));
            const float f = gt / fmaxf(l, 1e-30f);
#pragma unroll
            for (int d = 0; d < 64; d += 8) {
                float o[8];
                ld8(orow + d, o);
#pragma unroll
                for (int j = 0; j < 8; ++j) o[j] += f * acc[d + j];
                st8(orow + d, o);
            }
        }
    }
    __syncthreads();
}


typedef float f32x16 __attribute__((ext_vector_type(16)));
#define MFMA32(a, b, c) __builtin_amdgcn_mfma_f32_32x32x16_bf16((a), (b), (c), 0, 0, 0)
__device__ __forceinline__ unsigned cvtpk(float lo, float hi) { const f32x2_t f = {lo, hi}; return __builtin_bit_cast(unsigned, __builtin_convertvector(f, bf16x2_t)); }
__device__ __forceinline__ int crow32(int reg, int h) { return (reg & 3) + 8 * (reg >> 2) + 4 * h; }
constexpr float LOG2E = 1.4426950408889634f;
__device__ __forceinline__ void nsa_attn_phase(const bf16_t* __restrict__ proj, const bf16_t* __restrict__ vt, const unsigned* __restrict__ selmask, bf16_t* O, unsigned char* lds) {
    if (__builtin_amdgcn_readfirstlane(tidx() >> 6) >= 4) __builtin_amdgcn_s_setprio(1);
    const int tid = tidx(), wave = __builtin_amdgcn_readfirstlane(tid >> 6), lane = tid & 63, l31 = lane & 31, h = lane >> 5;
    const int r = wave & 3, thalf = wave >> 2;
    const int skey = tid >> 3, spart = tid & 7;
    uint4 kreg = make_uint4(0u, 0u, 0u, 0u), vreg = kreg; bool have_first = false;
    for (int it = blockIdx.x; it < 32 * 64; it += gridDim.x) {
        const int tile = 31 - (it >> 6), bg = it & 63, g = bg & 3, b = bg >> 2;
        const int hd = g * 4 + r, tokoff = thalf * 32 + l31, tok = tile * 64 + tokoff;
        const size_t trow = (size_t)(b * NL + tok);
        const float slope = exp2f(-0.5f * (float)(hd + 1)) * LOG2E;
        bf16x8_t Qf[4];
#pragma unroll
        for (int ds = 0; ds < 4; ++ds) {
            float q[8];
            ld8(proj + trow * ODD_PAD + hd * 64 + 16 * ds + 8 * h, q);
            const float qs = 0.125f * LOG2E;
            u32x4 w; w.x = cvtpk(q[0] * qs, q[1] * qs); w.y = cvtpk(q[2] * qs, q[3] * qs); w.z = cvtpk(q[4] * qs, q[5] * qs); w.w = cvtpk(q[6] * qs, q[7] * qs);
            Qf[ds] = __builtin_bit_cast(bf16x8_t, w);
        }
        float sc[16];
#pragma unroll
        for (int reg = 0; reg < 16; ++reg) sc[reg] = slope * (float)crow32(reg, h);
        const unsigned mymask = selmask[(size_t)(b * 4 + g) * NL + tok];
        unsigned um = selmask[(size_t)(b * 4 + g) * NL + tile * 64 + lane];
        um |= sort_partner<1>(um, lane); um |= sort_partner<2>(um, lane); um |= sort_partner<4>(um, lane); um |= sort_partner<8>(um, lane); um |= sort_partner<16>(um, lane); um |= sort_partner<32>(um, lane);
        const unsigned causal = (tile == 31) ? 0xffffffffu : ((2u << tile) - 1u);
        const unsigned U = (unsigned)__builtin_amdgcn_readfirstlane((int)um) & causal;
        float outv[32];
#pragma unroll
        for (int i = 0; i < 32; ++i) outv[i] = 0.f;
#pragma unroll 1
        for (int branch = 0; branch < 2; ++branch) {
            unsigned todo = (branch == 0) ? U : (causal & ~((1u << (tile >= 8 ? tile - 8 : 0)) - 1u));
            const bf16_t* kbase = proj + (size_t)b * NL * ODD_PAD + (branch == 0 ? 1536 : 1792) + g * 64 + (size_t)skey * ODD_PAD + 8 * spart;
            const bf16_t* vbase = vt + (size_t)(branch * 256 + g * 64 + skey) * NT + (size_t)b * NL + 8 * spart;
            float m_run = -1e30f, l_run = 0.f;
            f32x16 Oa[2];
#pragma unroll
            for (int i = 0; i < 16; ++i) { Oa[0][i] = 0.f; Oa[1][i] = 0.f; }
            int jcur = __ffs(todo) - 1; todo &= todo - 1;
            if (!have_first || jcur != (branch == 0 ? 0 : (tile >= 8 ? tile - 8 : 0))) { kreg = *(const uint4*)(kbase + (size_t)(64 * jcur) * ODD_PAD); vreg = *(const uint4*)(vbase + 64 * jcur); }
            have_first = true;
            int buf = 0;
            __syncthreads();
            *(uint4*)(lds + skey * 144 + spart * 16) = kreg;
            *(uint2*)(lds + 18432 + skey * 136 + spart * 16) = make_uint2(vreg.x, vreg.y);
            *(uint2*)(lds + 18432 + skey * 136 + spart * 16 + 8) = make_uint2(vreg.z, vreg.w);
            __syncthreads();
            for (;;) {
                const int jnext = todo ? (__ffs(todo) - 1) : -1;
                todo &= todo - 1;
                {
                    const int nb = jnext >= 0 ? branch : 1 - branch;
                    const int jl = jnext >= 0 ? jnext : (branch == 0 ? (tile >= 8 ? tile - 8 : 0) : 0);
                    const bf16_t* kb2 = proj + (size_t)b * NL * ODD_PAD + (nb == 0 ? 1536 : 1792) + g * 64 + (size_t)skey * ODD_PAD + 8 * spart;
                    const bf16_t* vb2 = vt + (size_t)(nb * 256 + g * 64 + skey) * NT + (size_t)b * NL + 8 * spart;
                    kreg = *(const uint4*)(kb2 + (size_t)(64 * jl) * ODD_PAD); vreg = *(const uint4*)(vb2 + 64 * jl);
                }
                const unsigned char* Ks = lds + buf * 9216;
                const unsigned char* Vs = lds + 18432 + buf * 8704;
                const bool mysel = (branch == 1) || ((mymask >> jcur) & 1u);
                if (__any(mysel)) {
                    const bool diag = (jcur == tile), wedge = (branch == 1) && (jcur == tile - 8);
                    const float init = mysel ? slope * (float)(64 * (jcur - tile)) : -1e30f;
                    float sv[32];
#pragma unroll
                    for (int kt = 0; kt < 2; ++kt) {
                        f32x16 acc;
                        const float i0 = init + slope * (float)(32 * kt);
#pragma unroll
                        for (int i = 0; i < 16; ++i) acc[i] = sc[i] + i0;
#pragma unroll
                        for (int ds = 0; ds < 4; ++ds) {
                            const bf16x8_t a = *(const bf16x8_t*)(Ks + (32 * kt + l31) * 144 + (16 * ds + 8 * h) * 2);
                            acc = MFMA32(a, Qf[ds], acc);
                        }
#pragma unroll
                        for (int reg = 0; reg < 16; ++reg) sv[kt * 16 + reg] = acc[reg];
                    }
                    if (diag || wedge) {
#pragma unroll
                        for (int i = 0; i < 32; ++i) {
                            const int keyoff = 32 * (i >> 4) + crow32(i & 15, h);
                            const bool ok = diag ? (keyoff <= tokoff) : (keyoff > tokoff);
                            sv[i] = ok ? sv[i] : -1e30f;
                        }
                    }
                    float mx = sv[0];
#pragma unroll
                    for (int i = 1; i < 32; ++i) mx = fmaxf(mx, sv[i]);
                    mx = fmaxf(mx, __shfl_xor(mx, 32));
                    if (!__all(mx < m_run - 160.f)) {
                    const float m_new = fmaxf(m_run, mx), m_use = fmaxf(m_new, -1e29f);
                    const float alpha = __builtin_amdgcn_exp2f(m_run - m_use);
                    const f32x2_t nm = {-m_use, -m_use};
                    f32x2_t ps2 = {0.f, 0.f};
#pragma unroll
                    for (int i = 0; i < 16; ++i) {
                        const f32x2_t t = (f32x2_t){sv[2 * i], sv[2 * i + 1]} + nm;
                        const f32x2_t p2 = {__builtin_amdgcn_exp2f(t.x), __builtin_amdgcn_exp2f(t.y)};
                        sv[2 * i] = p2.x; sv[2 * i + 1] = p2.y; ps2 += p2;
                    }
                    l_run = l_run * alpha + (ps2.x + ps2.y); m_run = m_new;
#pragma unroll
                    for (int i = 0; i < 16; ++i) { Oa[0][i] *= alpha; Oa[1][i] *= alpha; }
                    bf16x8_t Pf[4];
#pragma unroll
                    for (int ks = 0; ks < 4; ++ks) {
                        u32x4 w; w.x = cvtpk(sv[ks * 8 + 0], sv[ks * 8 + 1]); w.y = cvtpk(sv[ks * 8 + 2], sv[ks * 8 + 3]); w.z = cvtpk(sv[ks * 8 + 4], sv[ks * 8 + 5]); w.w = cvtpk(sv[ks * 8 + 6], sv[ks * 8 + 7]);
                        Pf[ks] = __builtin_bit_cast(bf16x8_t, w);
                    }
#pragma unroll
                    for (int mt = 0; mt < 2; ++mt)
#pragma unroll
                        for (int ks = 0; ks < 4; ++ks) {
                            const unsigned char* vp = Vs + (32 * mt + l31) * 136 + (16 * ks + 4 * h) * 2;
                            const uint2 lo = *(const uint2*)vp, hi = *(const uint2*)(vp + 16);
                            u32x4 w; w.x = lo.x; w.y = lo.y; w.z = hi.x; w.w = hi.y;
                            Oa[mt] = MFMA32(__builtin_bit_cast(bf16x8_t, w), Pf[ks], Oa[mt]);
                        }
                    }
                }
                if (jnext < 0) break;
                *(uint4*)(lds + (buf ^ 1) * 9216 + skey * 144 + spart * 16) = kreg;
                *(uint2*)(lds + 18432 + (buf ^ 1) * 8704 + skey * 136 + spart * 16) = make_uint2(vreg.x, vreg.y);
                *(uint2*)(lds + 18432 + (buf ^ 1) * 8704 + skey * 136 + spart * 16 + 8) = make_uint2(vreg.z, vreg.w);
                __syncthreads();
                buf ^= 1; jcur = jnext;
            }
            const float l_tot = l_run + __shfl_xor(l_run, 32);
            const float gt = sigmoidf_(bf2f(proj[trow * ODD_PAD + 2048 + (branch + 1) * 16 + hd]));
            const float f = gt / fmaxf(l_tot, 1e-30f);
#pragma unroll
            for (int i = 0; i < 16; ++i) { outv[i] += f * Oa[0][i]; outv[16 + i] += f * Oa[1][i]; }
        }
        bf16_t* orow = O + trow * ND + hd * 64;
#pragma unroll
        for (int mt = 0; mt < 2; ++mt)
#pragma unroll
            for (int q4 = 0; q4 < 4; ++q4) {
                bf16_t* op = orow + 32 * mt + 8 * q4 + 4 * h;
                const uint2 old = *(const uint2*)op;
                const float o0 = __uint_as_float(old.x << 16) + outv[mt * 16 + q4 * 4 + 0], o1 = __uint_as_float(old.x & 0xffff0000u) + outv[mt * 16 + q4 * 4 + 1];
                const float o2 = __uint_as_float(old.y << 16) + outv[mt * 16 + q4 * 4 + 2], o3 = __uint_as_float(old.y & 0xffff0000u) + outv[mt * 16 + q4 * 4 + 3];
                *(uint2*)op = make_uint2(cvtpk(o0, o1), cvtpk(o2, o3));
            }
    }
    __syncthreads();
    __builtin_amdgcn_s_setprio(0);
}

__device__ __forceinline__ void nsa_fused_phase(const bf16_t* __restrict__ proj, const bf16_t* __restrict__ kcmp, const bf16_t* __restrict__ vcmpT, const bf16_t* __restrict__ vt, bf16_t* O, unsigned char* lds) {
    if (__builtin_amdgcn_readfirstlane(tidx() >> 6) >= 4) __builtin_amdgcn_s_setprio(1);
    const int wave = __builtin_amdgcn_readfirstlane(tidx() >> 6), r = wave & 3, thalf = wave >> 2;
    unsigned char* Kc = lds;
    unsigned char* Vc = lds + 18432;
    float* impS = (float*)(lds + 35328);
    float* invS = (float*)(lds + 35328 + 33792);
    float* impT = (float*)(lds + 35328 + 33792 + 1024);
    int staged_bg = -1;
    unsigned char* ldsn = lds + 79872;
    unsigned* selS = (unsigned*)(lds + 79872 + 36864);
    for (int it = blockIdx.x; it < 32 * 64; it += gridDim.x) {
        float outv[32];
        bf16x8_t Qf[4];
        {
        const int tid = tidx(), lane = tid & 63, l31 = lane & 31, h = lane >> 5;
        const int tile = 31 - (it >> 6), bg = it & 63, g = bg & 3, b = bg >> 2;
        const int hd = g * 4 + r, tokoff = thalf * 32 + l31, tok = tile * 64 + tokoff;
        const size_t trow = (size_t)(b * NL + tok);
        const float slope = exp2f(-0.5f * (float)(hd + 1)) * LOG2E;
        __syncthreads();
        if (bg != staged_bg) {
        staged_bg = bg;
#pragma unroll
        for (int i = 0; i < 2; ++i) {
            const int pc = tid + 512 * i;
            { const int row = pc >> 3, c = pc & 7; *(uint4*)(Kc + row * 144 + c * 16) = *(const uint4*)(kcmp + ((size_t)(b * 4 + g) * 128 + row) * 64 + 8 * c); }
            { const int row = pc >> 4, c = pc & 15; const uint4 v = *(const uint4*)(vcmpT + (((size_t)(b * 4 + g) * 8 + (c >> 1)) * 64 + row) * 16 + (c & 1) * 8);
              *(uint2*)(Vc + row * 264 + c * 16) = make_uint2(v.x, v.y); *(uint2*)(Vc + row * 264 + c * 16 + 8) = make_uint2(v.z, v.w); }
        }
        }
#pragma unroll
        for (int ds = 0; ds < 4; ++ds) {
            float q[8];
            ld8(proj + trow * ODD_PAD + hd * 64 + 16 * ds + 8 * h, q);
            const float qs = 0.125f * LOG2E;
            u32x4 w; w.x = cvtpk(q[0] * qs, q[1] * qs); w.y = cvtpk(q[2] * qs, q[3] * qs); w.z = cvtpk(q[4] * qs, q[5] * qs); w.w = cvtpk(q[6] * qs, q[7] * qs);
            Qf[ds] = __builtin_bit_cast(bf16x8_t, w);
        }
        int nvalid = (tok >= 31) ? ((tok - 31) / 16 + 1) : 0;
        nvalid = nvalid > 127 ? 127 : nvalid;
        const int nv_max = (4 * tile + 3) > 127 ? 127 : (4 * tile + 3);
        const int kt_end = (nv_max + 31) >> 5;
        __syncthreads();
        float mx = -1e30f;
#pragma unroll 2
        for (int kt = 0; kt < kt_end; ++kt) {
            f32x16 acc;
            const float i0 = slope * (float)(512 * kt);
#pragma unroll
            for (int i = 0; i < 16; ++i) acc[i] = i0;
#pragma unroll
            for (int ds = 0; ds < 4; ++ds) {
                const bf16x8_t a = *(const bf16x8_t*)(Kc + (32 * kt + l31) * 144 + (16 * ds + 8 * h) * 2);
                acc = MFMA32(a, Qf[ds], acc);
            }
#pragma unroll
            for (int reg = 0; reg < 16; ++reg) {
                const int n = 32 * kt + crow32(reg, h);
                const float sval = acc[reg] + slope * (float)(16 * crow32(reg, h));
                mx = fmaxf(mx, (n < nvalid) ? sval : -1e30f);
            }
        }
        mx = fmaxf(mx, __shfl_xor(mx, 32));
        const float moff = -fmaxf(mx, -1e29f);
        float psum = 0.f, prev_pe = 0.f;
        f32x16 Oa[2];
#pragma unroll
        for (int i = 0; i < 16; ++i) { Oa[0][i] = 0.f; Oa[1][i] = 0.f; }
#pragma unroll 2
        for (int kt = 0; kt < kt_end; ++kt) {
            f32x16 acc;
            const float i0 = slope * (float)(512 * kt);
#pragma unroll
            for (int i = 0; i < 16; ++i) acc[i] = i0;
#pragma unroll
            for (int ds = 0; ds < 4; ++ds) {
                const bf16x8_t a = *(const bf16x8_t*)(Kc + (32 * kt + l31) * 144 + (16 * ds + 8 * h) * 2);
                acc = MFMA32(a, Qf[ds], acc);
            }
            float sv[16];
#pragma unroll
            for (int reg = 0; reg < 16; ++reg) {
                const int n = 32 * kt + crow32(reg, h);
                const float sval = acc[reg] + slope * (float)(16 * crow32(reg, h));
                sv[reg] = __builtin_amdgcn_exp2f(((n < nvalid) ? sval : -1e30f) + moff);
                psum += sv[reg];
            }
#pragma unroll
            for (int q = 0; q < 4; ++q) {
                const float e = 0.5f * sv[q * 4 + 3];
                const float own = sv[q * 4] + sv[q * 4 + 1] + sv[q * 4 + 2] + e;
                const float pe = __shfl_xor(e, 32);
                impS[(r * 64 + tokoff) * 33 + 8 * kt + 2 * q + h] = own + (h ? pe : prev_pe);
                prev_pe = pe;
            }
#pragma unroll
            for (int s2 = 0; s2 < 2; ++s2) {
                u32x4 w; w.x = cvtpk(sv[s2 * 8 + 0], sv[s2 * 8 + 1]); w.y = cvtpk(sv[s2 * 8 + 2], sv[s2 * 8 + 3]); w.z = cvtpk(sv[s2 * 8 + 4], sv[s2 * 8 + 5]); w.w = cvtpk(sv[s2 * 8 + 6], sv[s2 * 8 + 7]);
                const bf16x8_t pf = __builtin_bit_cast(bf16x8_t, w);
#pragma unroll
                for (int mt = 0; mt < 2; ++mt) {
                    const unsigned char* vp = Vc + (32 * mt + l31) * 264 + (32 * kt + 16 * s2 + 4 * h) * 2;
                    const uint2 lo = *(const uint2*)vp, hi = *(const uint2*)(vp + 16);
                    u32x4 a; a.x = lo.x; a.y = lo.y; a.z = hi.x; a.w = hi.y;
                    Oa[mt] = MFMA32(__builtin_bit_cast(bf16x8_t, a), pf, Oa[mt]);
                }
            }
        }
        psum += __shfl_xor(psum, 32);
        const float inv = (nvalid > 0) ? 1.f / fmaxf(psum, 1e-30f) : 0.f;
        if (h == 0) invS[r * 64 + tokoff] = inv;
        const float g0 = sigmoidf_(bf2f(proj[trow * ODD_PAD + 2048 + hd])) * inv;
#pragma unroll
        for (int i = 0; i < 16; ++i) { outv[i] = g0 * Oa[0][i]; outv[16 + i] = g0 * Oa[1][i]; }
        __syncthreads();
#pragma unroll
        for (int i = 0; i < 4; ++i) {
            const int pc = tid + 512 * i, tk = pc >> 5, j = pc & 31, cur = tile;
            const float ij = (j < 8 * kt_end) ? impS[(0 * 64 + tk) * 33 + j] * invS[tk] + impS[(1 * 64 + tk) * 33 + j] * invS[64 + tk] + impS[(2 * 64 + tk) * 33 + j] * invS[128 + tk] + impS[(3 * 64 + tk) * 33 + j] * invS[192 + tk] : 0.f;
            const bool fj = (j == 0) || (j == cur) || (j == cur - 1);
            impT[tk * 33 + j] = (j <= cur) ? ij + (fj ? 1000.f : 0.f) : -INFINITY;
        }
        __syncthreads();
        {
            const int tk = tid >> 3, rr = tid & 7;
            float vk[32];
#pragma unroll
            for (int k = 0; k < 32; ++k) vk[k] = impT[tk * 33 + k];
            unsigned bits = 0;
#pragma unroll
            for (int jj = 0; jj < 4; ++jj) {
                const int j = rr * 4 + jj;
                const float vj = impT[tk * 33 + j];
                int rank = 0;
#pragma unroll
                for (int k = 0; k < 32; ++k) rank += (vk[k] > vj || (vk[k] == vj && k < j)) ? 1 : 0;
                if (rank < 16) bits |= 1u << j;
            }
            bits |= __shfl_xor(bits, 1);
            bits |= __shfl_xor(bits, 2);
            bits |= __shfl_xor(bits, 4);
            if (rr == 0) selS[tk] = bits;
        }
        }
        __syncthreads();
        {
        const int tid = tidx(), lane = tid & 63, l31 = lane & 31, h = lane >> 5;
        const int tile = 31 - (it >> 6), bg = it & 63, g = bg & 3, b = bg >> 2;
        const int hd = g * 4 + r, tokoff = thalf * 32 + l31, tok = tile * 64 + tokoff;
        const size_t trow = (size_t)(b * NL + tok);
        const float slope = exp2f(-0.5f * (float)(hd + 1)) * LOG2E;
        float sc[16];
#pragma unroll
        for (int reg = 0; reg < 16; ++reg) sc[reg] = slope * (float)crow32(reg, h);
        const int skey = tid >> 3, spart = tid & 7;
        uint4 kreg = make_uint4(0u, 0u, 0u, 0u), vreg = kreg; bool have_first = false;
        const unsigned mymask = selS[tokoff];
        unsigned um = selS[lane];
        um |= sort_partner<1>(um, lane); um |= sort_partner<2>(um, lane); um |= sort_partner<4>(um, lane); um |= sort_partner<8>(um, lane); um |= sort_partner<16>(um, lane); um |= sort_partner<32>(um, lane);
        const unsigned causal = (tile == 31) ? 0xffffffffu : ((2u << tile) - 1u);
        const unsigned U = (unsigned)__builtin_amdgcn_readfirstlane((int)um) & causal;
#pragma unroll 1
        for (int branch = 0; branch < 2; ++branch) {
            unsigned todo = (branch == 0) ? U : (causal & ~((1u << (tile >= 8 ? tile - 8 : 0)) - 1u));
            const bf16_t* kbase = proj + (size_t)b * NL * ODD_PAD + (branch == 0 ? 1536 : 1792) + g * 64 + (size_t)skey * ODD_PAD + 8 * spart;
            const bf16_t* vbase = vt + (size_t)(branch * 256 + g * 64 + skey) * NT + (size_t)b * NL + 8 * spart;
            float m_run = -1e30f, l_run = 0.f;
            f32x16 Oa[2];
#pragma unroll
            for (int i = 0; i < 16; ++i) { Oa[0][i] = 0.f; Oa[1][i] = 0.f; }
            int jcur = __ffs(todo) - 1; todo &= todo - 1;
            if (branch == 0 || jcur != (tile >= 8 ? tile - 8 : 0)) { kreg = *(const uint4*)(kbase + (size_t)(64 * jcur) * ODD_PAD); vreg = *(const uint4*)(vbase + 64 * jcur); }
            have_first = true;
            int buf = 0;
            __syncthreads();
            *(uint4*)(ldsn + skey * 144 + spart * 16) = kreg;
            *(uint2*)(ldsn + 18432 + skey * 136 + spart * 16) = make_uint2(vreg.x, vreg.y);
            *(uint2*)(ldsn + 18432 + skey * 136 + spart * 16 + 8) = make_uint2(vreg.z, vreg.w);
            __syncthreads();
            for (;;) {
                const int jnext = todo ? (__ffs(todo) - 1) : -1;
                todo &= todo - 1;
                {
                    const int nb = jnext >= 0 ? branch : 1 - branch;
                    const int jl = jnext >= 0 ? jnext : (branch == 0 ? (tile >= 8 ? tile - 8 : 0) : 0);
                    const bf16_t* kb2 = proj + (size_t)b * NL * ODD_PAD + (nb == 0 ? 1536 : 1792) + g * 64 + (size_t)skey * ODD_PAD + 8 * spart;
                    const bf16_t* vb2 = vt + (size_t)(nb * 256 + g * 64 + skey) * NT + (size_t)b * NL + 8 * spart;
                    kreg = *(const uint4*)(kb2 + (size_t)(64 * jl) * ODD_PAD); vreg = *(const uint4*)(vb2 + 64 * jl);
                }
                const unsigned char* Ks = ldsn + buf * 9216;
                const unsigned char* Vs = ldsn + 18432 + buf * 8704;
                const bool mysel = (branch == 1) || ((mymask >> jcur) & 1u);
                if (__any(mysel)) {
                    const bool diag = (jcur == tile), wedge = (branch == 1) && (jcur == tile - 8);
                    const float init = mysel ? slope * (float)(64 * (jcur - tile)) : -1e30f;
                    float sv[32];
#pragma unroll
                    for (int kt = 0; kt < 2; ++kt) {
                        f32x16 acc;
                        const float i0 = init + slope * (float)(32 * kt);
#pragma unroll
                        for (int i = 0; i < 16; ++i) acc[i] = sc[i] + i0;
#pragma unroll
                        for (int ds = 0; ds < 4; ++ds) {
                            const bf16x8_t a = *(const bf16x8_t*)(Ks + (32 * kt + l31) * 144 + (16 * ds + 8 * h) * 2);
                            acc = MFMA32(a, Qf[ds], acc);
                        }
#pragma unroll
                        for (int reg = 0; reg < 16; ++reg) sv[kt * 16 + reg] = acc[reg];
                    }
                    if (diag || wedge) {
#pragma unroll
                        for (int i = 0; i < 32; ++i) {
                            const int keyoff = 32 * (i >> 4) + crow32(i & 15, h);
                            const bool ok = diag ? (keyoff <= tokoff) : (keyoff > tokoff);
                            sv[i] = ok ? sv[i] : -1e30f;
                        }
                    }
                    float mx = sv[0];
#pragma unroll
                    for (int i = 1; i < 32; ++i) mx = fmaxf(mx, sv[i]);
                    mx = fmaxf(mx, __shfl_xor(mx, 32));
                    if (!__all(mx < m_run - 160.f)) {
                    const float m_new = fmaxf(m_run, mx), m_use = fmaxf(m_new, -1e29f);
                    const float alpha = __builtin_amdgcn_exp2f(m_run - m_use);
                    const f32x2_t nm = {-m_use, -m_use};
                    f32x2_t ps2 = {0.f, 0.f};
#pragma unroll
                    for (int i = 0; i < 16; ++i) { Oa[0][i] *= alpha; Oa[1][i] *= alpha; }
#pragma unroll
                    for (int kt = 0; kt < 2; ++kt) {
#pragma unroll
                        for (int i = 8 * kt; i < 8 * kt + 8; ++i) {
                            const f32x2_t t = (f32x2_t){sv[2 * i], sv[2 * i + 1]} + nm;
                            const f32x2_t p2 = {__builtin_amdgcn_exp2f(t.x), __builtin_amdgcn_exp2f(t.y)};
                            sv[2 * i] = p2.x; sv[2 * i + 1] = p2.y; ps2 += p2;
                        }
                        bf16x8_t Pf[2];
#pragma unroll
                        for (int s2 = 0; s2 < 2; ++s2) {
                            const int ks = 2 * kt + s2;
                            u32x4 w; w.x = cvtpk(sv[ks * 8 + 0], sv[ks * 8 + 1]); w.y = cvtpk(sv[ks * 8 + 2], sv[ks * 8 + 3]); w.z = cvtpk(sv[ks * 8 + 4], sv[ks * 8 + 5]); w.w = cvtpk(sv[ks * 8 + 6], sv[ks * 8 + 7]);
                            Pf[s2] = __builtin_bit_cast(bf16x8_t, w);
                        }
#pragma unroll
                        for (int mt = 0; mt < 2; ++mt)
#pragma unroll
                            for (int s2 = 0; s2 < 2; ++s2) {
                                const int ks = 2 * kt + s2;
                                const unsigned char* vp = Vs + (32 * mt + l31) * 136 + (16 * ks + 4 * h) * 2;
                                const uint2 lo = *(const uint2*)vp, hi = *(const uint2*)(vp + 16);
                                u32x4 w; w.x = lo.x; w.y = lo.y; w.z = hi.x; w.w = hi.y;
                                Oa[mt] = MFMA32(__builtin_bit_cast(bf16x8_t, w), Pf[s2], Oa[mt]);
                            }
                    }
                    l_run = l_run * alpha + (ps2.x + ps2.y); m_run = m_new;
                    }
                }
                if (jnext < 0) break;
                *(uint4*)(ldsn + (buf ^ 1) * 9216 + skey * 144 + spart * 16) = kreg;
                *(uint2*)(ldsn + 18432 + (buf ^ 1) * 8704 + skey * 136 + spart * 16) = make_uint2(vreg.x, vreg.y);
                *(uint2*)(ldsn + 18432 + (buf ^ 1) * 8704 + skey * 136 + spart * 16 + 8) = make_uint2(vreg.z, vreg.w);
                __syncthreads();
                buf ^= 1; jcur = jnext;
            }
            const float l_tot = l_run + __shfl_xor(l_run, 32);
            const float gt = sigmoidf_(bf2f(proj[trow * ODD_PAD + 2048 + (branch + 1) * 16 + hd]));
            const float f = gt / fmaxf(l_tot, 1e-30f);
#pragma unroll
            for (int i = 0; i < 16; ++i) { outv[i] += f * Oa[0][i]; outv[16 + i] += f * Oa[1][i]; }
        }
        bf16_t* orow = O + trow * ND + hd * 64;
#pragma unroll
        for (int mt = 0; mt < 2; ++mt)
#pragma unroll
            for (int q4 = 0; q4 < 4; ++q4) {
                bf16_t* op = orow + 32 * mt + 8 * q4 + 4 * h;
                const float o0 = outv[mt * 16 + q4 * 4 + 0], o1 = outv[mt * 16 + q4 * 4 + 1], o2 = outv[mt * 16 + q4 * 4 + 2], o3 = outv[mt * 16 + q4 * 4 + 3];
                *(uint2*)op = make_uint2(cvtpk(o0, o1), cvtpk(o2, o3));
            }
        }
    }
    __syncthreads();
    __builtin_amdgcn_s_setprio(0);
}


__device__ __forceinline__ void nsa_compress2_phase(const bf16_t* __restrict__ proj, const bf16_t* __restrict__ w1t  , const bf16_t* __restrict__ w2t  ,
                                                    const float* __restrict__ bias1  , bf16_t* __restrict__ kcmp  , bf16_t* __restrict__ vcmpT  ,
                                                    unsigned char* lds) {
    const int tid = tidx(), wave = __builtin_amdgcn_readfirstlane(tid >> 6), lane = tid & 63, fr = lane & 15, fq = lane >> 4;
    unsigned char* xs = lds;
    unsigned char* hs = lds + 133120;
    for (int it = blockIdx.x; it < 256; it += gridDim.x) {
        const int which = it >> 7, nt2 = it & 1, g = (it >> 1) & 3, b = (it >> 3) & 15;
        const int t0 = 1024 * nt2, coloff = (which ? 1280 : 1024) + g * 64;
        __syncthreads();
#pragma unroll 1
        for (int base = 0; base < 1040 * 8; base += 8 * NTHR) {
            uint4 xv[8];
#pragma unroll
            for (int i = 0; i < 8; ++i) {
                const int pc = base + tid + NTHR * i, tk = pc >> 3, c = pc & 7;
                int tsrc = t0 + tk; tsrc = tsrc > NL - 1 ? NL - 1 : tsrc;
                xv[i] = *(const uint4*)(proj + (size_t)(b * NL + tsrc) * ODD_PAD + coloff + 8 * c);
            }
#pragma unroll
            for (int i = 0; i < 8; ++i) {
                const int pc = base + tid + NTHR * i, tk = pc >> 3, c = pc & 7;
                if (pc < 1040 * 8) *(uint4*)(xs + tk * 128 + ((c ^ ((tk >> 4) & 7)) << 4)) = xv[i];
            }
        }
        __syncthreads();
        f32x4 acc[4];
#pragma unroll
        for (int mt = 0; mt < 4; ++mt) acc[mt] = (f32x4){0.f, 0.f, 0.f, 0.f};
        const bf16_t* wrow = w1t + ((size_t)which * 128 + 16 * wave + fr) * 2048 + 8 * fq;
#pragma unroll 4
        for (int ks = 0; ks < 64; ++ks) {
            const int l = ks >> 1, c = 4 * (ks & 1) + fq;
            const bf16x8_t bfrag = *(const bf16x8_t*)(wrow + 32 * ks);
#pragma unroll
            for (int mt = 0; mt < 4; ++mt) {
                const int tk = 16 * (16 * mt + fr) + l;
                const bf16x8_t a = *(const bf16x8_t*)(xs + tk * 128 + ((c ^ ((tk >> 4) & 7)) << 4));
                acc[mt] = __builtin_amdgcn_mfma_f32_16x16x32_bf16(a, bfrag, acc[mt], 0, 0, 0);
            }
        }
        {
            const float bj = bias1[which * 128 + 16 * wave + fr];
#pragma unroll
            for (int mt = 0; mt < 4; ++mt)
#pragma unroll
                for (int reg = 0; reg < 4; ++reg) *(bf16_t*)(hs + (16 * mt + 4 * fq + reg) * 272 + (16 * wave + fr) * 2) = f2bf(gelu_fast(acc[mt][reg] + bj));
        }
        __syncthreads();
        {
            const int mt = wave >> 1;
#pragma unroll
            for (int ci = 0; ci < 2; ++ci) {
                const int ct = 2 * (wave & 1) + ci;
                f32x4 o = {0.f, 0.f, 0.f, 0.f};
#pragma unroll
                for (int ks = 0; ks < 4; ++ks) {
                    const bf16x8_t a = *(const bf16x8_t*)(hs + (16 * mt + fr) * 272 + (32 * ks + 8 * fq) * 2);
                    const bf16x8_t bfrag = *(const bf16x8_t*)(w2t + ((size_t)which * 64 + 16 * ct + fr) * 128 + 32 * ks + 8 * fq);
                    o = __builtin_amdgcn_mfma_f32_16x16x32_bf16(a, bfrag, o, 0, 0, 0);
                }
                const int c = 16 * ct + fr;
#pragma unroll
                for (int reg = 0; reg < 4; ++reg) {
                    const int n = 64 * nt2 + 16 * mt + 4 * fq + reg;
                    const bf16_t val = (n < 127) ? f2bf(o[reg]) : (bf16_t)0;
                    if (which == 0) kcmp[((size_t)(b * 4 + g) * 128 + n) * 64 + c] = val;
                    else vcmpT[(((size_t)(b * 4 + g) * 8 + (n >> 4)) * 64 + c) * 16 + (n & 15)] = val;
                }
            }
        }
    }
    __syncthreads();
}

__device__ __forceinline__ void nsa_cmp2_phase(const bf16_t* __restrict__ proj, const bf16_t* __restrict__ kcmp, const bf16_t* __restrict__ vcmpT,
                                               bf16_t* __restrict__ O, unsigned* __restrict__ selmask, unsigned char* lds) {
    if (__builtin_amdgcn_readfirstlane(tidx() >> 6) >= 4) __builtin_amdgcn_s_setprio(1);
    const int tid = tidx(), wave = __builtin_amdgcn_readfirstlane(tid >> 6), lane = tid & 63, l31 = lane & 31, h = lane >> 5;
    const int r = wave & 3, thalf = wave >> 2;
    unsigned char* Kc = lds;
    unsigned char* Vc = lds + 18432;
    float* impS = (float*)(lds + 35328);
    float* invS = (float*)(lds + 35328 + 33792);
    float* impT = (float*)(lds + 35328 + 33792 + 1024);
    int staged_bg = -1;
    for (int it = blockIdx.x; it < 32 * 64; it += gridDim.x) {
        const int tile = 31 - (it >> 6), bg = it & 63, g = bg & 3, b = bg >> 2;
        const int hd = g * 4 + r, tokoff = thalf * 32 + l31, tok = tile * 64 + tokoff;
        const size_t trow = (size_t)(b * NL + tok);
        const float slope = exp2f(-0.5f * (float)(hd + 1));
        __syncthreads();
        if (bg != staged_bg) {
        staged_bg = bg;
#pragma unroll
        for (int i = 0; i < 2; ++i) {
            const int pc = tid + 512 * i;
            { const int row = pc >> 3, c = pc & 7; *(uint4*)(Kc + row * 144 + c * 16) = *(const uint4*)(kcmp + ((size_t)(b * 4 + g) * 128 + row) * 64 + 8 * c); }
            { const int row = pc >> 4, c = pc & 15; const uint4 v = *(const uint4*)(vcmpT + (((size_t)(b * 4 + g) * 8 + (c >> 1)) * 64 + row) * 16 + (c & 1) * 8);
              *(uint2*)(Vc + row * 264 + c * 16) = make_uint2(v.x, v.y); *(uint2*)(Vc + row * 264 + c * 16 + 8) = make_uint2(v.z, v.w); }
        }
        }
        bf16x8_t Qf[4];
#pragma unroll
        for (int ds = 0; ds < 4; ++ds) {
            float q[8];
            ld8(proj + trow * ODD_PAD + hd * 64 + 16 * ds + 8 * h, q);
            u32x4 w; w.x = cvtpk(q[0] * 0.125f, q[1] * 0.125f); w.y = cvtpk(q[2] * 0.125f, q[3] * 0.125f); w.z = cvtpk(q[4] * 0.125f, q[5] * 0.125f); w.w = cvtpk(q[6] * 0.125f, q[7] * 0.125f);
            Qf[ds] = __builtin_bit_cast(bf16x8_t, w);
        }
        int nvalid = (tok >= 31) ? ((tok - 31) / 16 + 1) : 0;
        nvalid = nvalid > 127 ? 127 : nvalid;
        const int nv_max = (4 * tile + 3) > 127 ? 127 : (4 * tile + 3);
        const int kt_end = (nv_max + 31) >> 5;
        __syncthreads();
        float mx = -1e30f;
#pragma unroll 2
        for (int kt = 0; kt < kt_end; ++kt) {
            f32x16 acc;
            const float i0 = slope * (float)(512 * kt);
#pragma unroll
            for (int i = 0; i < 16; ++i) acc[i] = i0;
#pragma unroll
            for (int ds = 0; ds < 4; ++ds) {
                const bf16x8_t a = *(const bf16x8_t*)(Kc + (32 * kt + l31) * 144 + (16 * ds + 8 * h) * 2);
                acc = MFMA32(a, Qf[ds], acc);
            }
#pragma unroll
            for (int reg = 0; reg < 16; ++reg) {
                const int n = 32 * kt + crow32(reg, h);
                const float sval = acc[reg] + slope * (float)(16 * crow32(reg, h));
                mx = fmaxf(mx, (n < nvalid) ? sval : -1e30f);
            }
        }
        mx = fmaxf(mx, __shfl_xor(mx, 32));
        const float moff = -fmaxf(mx, -1e29f) * LOG2E;
        float psum = 0.f, prev_pe = 0.f;
        f32x16 Oa[2];
#pragma unroll
        for (int i = 0; i < 16; ++i) { Oa[0][i] = 0.f; Oa[1][i] = 0.f; }
#pragma unroll 2
        for (int kt = 0; kt < kt_end; ++kt) {
            f32x16 acc;
            const float i0 = slope * (float)(512 * kt);
#pragma unroll
            for (int i = 0; i < 16; ++i) acc[i] = i0;
#pragma unroll
            for (int ds = 0; ds < 4; ++ds) {
                const bf16x8_t a = *(const bf16x8_t*)(Kc + (32 * kt + l31) * 144 + (16 * ds + 8 * h) * 2);
                acc = MFMA32(a, Qf[ds], acc);
            }
            float sv[16];
#pragma unroll
            for (int reg = 0; reg < 16; ++reg) {
                const int n = 32 * kt + crow32(reg, h);
                const float sval = acc[reg] + slope * (float)(16 * crow32(reg, h));
                sv[reg] = __builtin_amdgcn_exp2f(fmaf((n < nvalid) ? sval : -1e30f, LOG2E, moff));
                psum += sv[reg];
            }
#pragma unroll
            for (int q = 0; q < 4; ++q) {
                const float e = 0.5f * sv[q * 4 + 3];
                const float own = sv[q * 4] + sv[q * 4 + 1] + sv[q * 4 + 2] + e;
                const float pe = __shfl_xor(e, 32);
                impS[(r * 64 + tokoff) * 33 + 8 * kt + 2 * q + h] = own + (h ? pe : prev_pe);
                prev_pe = pe;
            }
#pragma unroll
            for (int s2 = 0; s2 < 2; ++s2) {
                u32x4 w; w.x = cvtpk(sv[s2 * 8 + 0], sv[s2 * 8 + 1]); w.y = cvtpk(sv[s2 * 8 + 2], sv[s2 * 8 + 3]); w.z = cvtpk(sv[s2 * 8 + 4], sv[s2 * 8 + 5]); w.w = cvtpk(sv[s2 * 8 + 6], sv[s2 * 8 + 7]);
                const bf16x8_t pf = __builtin_bit_cast(bf16x8_t, w);
#pragma unroll
                for (int mt = 0; mt < 2; ++mt) {
                    const unsigned char* vp = Vc + (32 * mt + l31) * 264 + (32 * kt + 16 * s2 + 4 * h) * 2;
                    const uint2 lo = *(const uint2*)vp, hi = *(const uint2*)(vp + 16);
                    u32x4 a; a.x = lo.x; a.y = lo.y; a.z = hi.x; a.w = hi.y;
                    Oa[mt] = MFMA32(__builtin_bit_cast(bf16x8_t, a), pf, Oa[mt]);
                }
            }
        }
        psum += __shfl_xor(psum, 32);
        const float inv = (nvalid > 0) ? 1.f / fmaxf(psum, 1e-30f) : 0.f;
        if (h == 0) invS[r * 64 + tokoff] = inv;
        const float g0 = sigmoidf_(bf2f(proj[trow * ODD_PAD + 2048 + hd])) * inv;
        bf16_t* orow = O + trow * ND + hd * 64;
#pragma unroll
        for (int mt = 0; mt < 2; ++mt)
#pragma unroll
            for (int q4 = 0; q4 < 4; ++q4)
                *(uint2*)(orow + 32 * mt + 8 * q4 + 4 * h) = make_uint2(cvtpk(g0 * Oa[mt][q4 * 4], g0 * Oa[mt][q4 * 4 + 1]), cvtpk(g0 * Oa[mt][q4 * 4 + 2], g0 * Oa[mt][q4 * 4 + 3]));
        __syncthreads();
#pragma unroll
        for (int i = 0; i < 4; ++i) {
            const int pc = tid + 512 * i, tk = pc >> 5, j = pc & 31, cur = tile;
            const float ij = (j < 8 * kt_end) ? impS[(0 * 64 + tk) * 33 + j] * invS[tk] + impS[(1 * 64 + tk) * 33 + j] * invS[64 + tk] + impS[(2 * 64 + tk) * 33 + j] * invS[128 + tk] + impS[(3 * 64 + tk) * 33 + j] * invS[192 + tk] : 0.f;
            const bool fj = (j == 0) || (j == cur) || (j == cur - 1);
            impT[tk * 33 + j] = (j <= cur) ? ij + (fj ? 1000.f : 0.f) : -INFINITY;
        }
        __syncthreads();
        {
            const int tk = tid >> 3, rr = tid & 7;
            float vk[32];
#pragma unroll
            for (int k = 0; k < 32; ++k) vk[k] = impT[tk * 33 + k];
            unsigned bits = 0;
#pragma unroll
            for (int jj = 0; jj < 4; ++jj) {
                const int j = rr * 4 + jj;
                const float vj = impT[tk * 33 + j];
                int rank = 0;
#pragma unroll
                for (int k = 0; k < 32; ++k) rank += (vk[k] > vj || (vk[k] == vj && k < j)) ? 1 : 0;
                if (rank < 16) bits |= 1u << j;
            }
            bits |= __shfl_xor(bits, 1);
            bits |= __shfl_xor(bits, 2);
            bits |= __shfl_xor(bits, 4);
            if (rr == 0) selmask[(size_t)(b * 4 + g) * NL + tile * 64 + tk] = bits;
        }
    }
    __syncthreads();
    __builtin_amdgcn_s_setprio(0);
}


constexpr int P0W = 1792;
constexpr float LN2F = 0.6931471805599453f;
__device__ __forceinline__ void sb_attn2_phase(const bf16_t* __restrict__ proj, const bf16_t* __restrict__ vt, bf16_t* __restrict__ Y, unsigned char* lds) {
    if (__builtin_amdgcn_readfirstlane(tidx() >> 6) >= 4) __builtin_amdgcn_s_setprio(1);
    const int tid = tidx(), wave = __builtin_amdgcn_readfirstlane(tid >> 6), lane = tid & 63, l31 = lane & 31, h = lane >> 5;
    const int skey = tid >> 3, spart = tid & 7;
    for (int it = blockIdx.x; it < NB * 12 * 8; it += gridDim.x) {
        const int tile = 7 - (it / 192), bh = it % 192, hh = bh % 12, b = bh / 12;
        const int qlo = tile * 256 + 32 * wave, tq = qlo + l31;
        const size_t trow = (size_t)(b * NL + tq);
        bf16x8_t Qf[4];
#pragma unroll
        for (int ds = 0; ds < 4; ++ds) {
            float q[8];
            ld8(proj + trow * P0W + 256 + hh * 64 + 16 * ds + 8 * h, q);
            u32x4 w; w.x = cvtpk(q[0] * 0.125f, q[1] * 0.125f); w.y = cvtpk(q[2] * 0.125f, q[3] * 0.125f); w.z = cvtpk(q[4] * 0.125f, q[5] * 0.125f); w.w = cvtpk(q[6] * 0.125f, q[7] * 0.125f);
            Qf[ds] = __builtin_bit_cast(bf16x8_t, w);
        }
        const bf16_t* kbase = proj + (size_t)b * NL * P0W + 1024 + hh * 64 + (size_t)skey * P0W + 8 * spart;
        const bf16_t* vbase = vt + (size_t)(hh * 64 + skey) * NT + (size_t)b * NL + 8 * spart;
        f32x16 Oa[2];
#pragma unroll
        for (int i = 0; i < 16; ++i) { Oa[0][i] = 0.f; Oa[1][i] = 0.f; }
        float carry = 0.f;
        int j = tile * 4 + 3, buf = 0;
        uint4 kreg = *(const uint4*)(kbase + (size_t)(64 * j) * P0W);
        uint4 vreg = *(const uint4*)(vbase + 64 * j);
        __syncthreads();
        *(uint4*)(lds + skey * 144 + spart * 16) = kreg;
        *(uint2*)(lds + 18432 + skey * 136 + spart * 16) = make_uint2(vreg.x, vreg.y);
        *(uint2*)(lds + 18432 + skey * 136 + spart * 16 + 8) = make_uint2(vreg.z, vreg.w);
        __syncthreads();
        for (;;) {
            const int jn = j - 1;
            if (jn >= 0) { kreg = *(const uint4*)(kbase + (size_t)(64 * jn) * P0W); vreg = *(const uint4*)(vbase + 64 * jn); }
            const unsigned char* Ks = lds + buf * 9216;
            const unsigned char* Vs = lds + 18432 + buf * 8704;
            const bool live = (64 * j <= qlo + 30) && !__all(carry < -110.f);
            if (live) {
#pragma unroll
                for (int kti = 0; kti < 2; ++kti) {
                    const int kt = 1 - kti;
                    f32x16 acc;
#pragma unroll
                    for (int i = 0; i < 16; ++i) acc[i] = 0.f;
#pragma unroll
                    for (int ds = 0; ds < 4; ++ds) {
                        const bf16x8_t a = *(const bf16x8_t*)(Ks + (32 * kt + l31) * 144 + (16 * ds + 8 * h) * 2);
                        acc = MFMA32(a, Qf[ds], acc);
                    }
                    float m1[16], lz[16];
#pragma unroll
                    for (int reg = 0; reg < 16; ++reg) {
                        const float z = acc[reg];
                        const bool valid = (64 * j + 32 * kt + crow32(reg, h)) < tq;
                        const float e = __builtin_amdgcn_exp2f(-fabsf(z) * LOG2E);
                        const float sp = fmaxf(z, 0.f) + __builtin_amdgcn_logf(1.f + e) * LN2F;
                        m1[reg] = valid ? -sp : 0.f;
                        lz[reg] = valid ? z - sp : -1e30f;
                    }
                    float G[4], T[4];
#pragma unroll
                    for (int q = 0; q < 4; ++q) G[q] = (m1[4 * q] + m1[4 * q + 1]) + (m1[4 * q + 2] + m1[4 * q + 3]);
                    float Gp[4];
#pragma unroll
                    for (int q = 0; q < 4; ++q) { Gp[q] = __shfl_xor(G[q], 32); T[q] = G[q] + Gp[q]; }
                    float base[4];
                    base[3] = carry; base[2] = base[3] + T[3]; base[1] = base[2] + T[2]; base[0] = base[1] + T[1];
                    const float tot = base[0] + T[0];
#pragma unroll
                    for (int q = 0; q < 4; ++q) {
                        const float bq = base[q] + (h ? 0.f : Gp[q]);
                        const float t3 = bq, t2 = t3 + m1[4 * q + 3], t1 = t2 + m1[4 * q + 2], t0 = t1 + m1[4 * q + 1];
                        lz[4 * q + 3] = __builtin_amdgcn_exp2f((lz[4 * q + 3] + t3) * LOG2E);
                        lz[4 * q + 2] = __builtin_amdgcn_exp2f((lz[4 * q + 2] + t2) * LOG2E);
                        lz[4 * q + 1] = __builtin_amdgcn_exp2f((lz[4 * q + 1] + t1) * LOG2E);
                        lz[4 * q + 0] = __builtin_amdgcn_exp2f((lz[4 * q + 0] + t0) * LOG2E);
                    }
                    carry = tot;
#pragma unroll
                    for (int s2 = 0; s2 < 2; ++s2) {
                        u32x4 w; w.x = cvtpk(lz[s2 * 8 + 0], lz[s2 * 8 + 1]); w.y = cvtpk(lz[s2 * 8 + 2], lz[s2 * 8 + 3]); w.z = cvtpk(lz[s2 * 8 + 4], lz[s2 * 8 + 5]); w.w = cvtpk(lz[s2 * 8 + 6], lz[s2 * 8 + 7]);
                        const bf16x8_t pf = __builtin_bit_cast(bf16x8_t, w);
#pragma unroll
                        for (int mt = 0; mt < 2; ++mt) {
                            const unsigned char* vp = Vs + (32 * mt + l31) * 136 + (32 * kt + 16 * s2 + 4 * h) * 2;
                            const uint2 lo = *(const uint2*)vp, hi = *(const uint2*)(vp + 16);
                            u32x4 a; a.x = lo.x; a.y = lo.y; a.z = hi.x; a.w = hi.y;
                            Oa[mt] = MFMA32(__builtin_bit_cast(bf16x8_t, a), pf, Oa[mt]);
                        }
                    }
                }
            }
            if (jn >= 0) {
                *(uint4*)(lds + (buf ^ 1) * 9216 + skey * 144 + spart * 16) = kreg;
                *(uint2*)(lds + 18432 + (buf ^ 1) * 8704 + skey * 136 + spart * 16) = make_uint2(vreg.x, vreg.y);
                *(uint2*)(lds + 18432 + (buf ^ 1) * 8704 + skey * 136 + spart * 16 + 8) = make_uint2(vreg.z, vreg.w);
            }
            volatile int* flg = (volatile int*)(lds + 35840) + (j & 1) * 8;
            const int wdone = __all(carry < -110.f);
            if (lane == 0) flg[wave] = wdone;
            __syncthreads();
            const int alldone = flg[0] & flg[1] & flg[2] & flg[3] & flg[4] & flg[5] & flg[6] & flg[7];
            if (alldone || jn < 0) break;
            buf ^= 1; j = jn;
        }
        bf16_t* orow = Y + trow * ND + 256 + hh * 64;
#pragma unroll
        for (int mt = 0; mt < 2; ++mt)
#pragma unroll
            for (int q4 = 0; q4 < 4; ++q4)
                *(uint2*)(orow + 32 * mt + 8 * q4 + 4 * h) = make_uint2(cvtpk(Oa[mt][q4 * 4], Oa[mt][q4 * 4 + 1]), cvtpk(Oa[mt][q4 * 4 + 2], Oa[mt][q4 * 4 + 3]));
    }
    __syncthreads();
    __builtin_amdgcn_s_setprio(0);
}

__device__ __forceinline__ void s5_scan2_phase(const bf16_t* __restrict__ proj, const float* __restrict__ lam_re, const float* __restrict__ lam_im, const float* __restrict__ log_dt,
                                               const float* __restrict__ b_re, const float* __restrict__ b_im, const float* __restrict__ c_re, const float* __restrict__ c_im,
                                               const float* __restrict__ dskip, bf16_t* __restrict__ ya, float* lds) {
    const int tid = tidx(), wave = __builtin_amdgcn_readfirstlane(tid >> 6), lane = tid & 63;
    float* cr = lds;
    float* ci = lds + 1024;
    float* Es = lds + 2048;
    float* us = lds + 3072 + wave * 512;
    float* xr = lds + 7168 + wave * 4160;
    float* xi = xr + 2080;
    for (int bg = blockIdx.x; bg < NB * 16; bg += gridDim.x) {
        const int b = bg >> 4, g = bg & 15;
        const float lr = lam_re[g * 64 + lane], li = lam_im[g * 64 + lane];
        const float dt = expf(log_dt[g]);
        const float mag = expf(lr * dt);
        const float are = mag * cosf(li * dt), aim = mag * sinf(li * dt);
        const float nr = are - 1.f, den = lr * lr + li * li;
        const float fre = (nr * lr + aim * li) / den, fim = (aim * lr - nr * li) / den;
        float bbr[16], bbi[16];
#pragma unroll
        for (int i = 0; i < 16; ++i) {
            const float br = b_re[(g * 64 + lane) * 16 + i], bi = b_im[(g * 64 + lane) * 16 + i];
            bbr[i] = fre * br - fim * bi; bbi[i] = fre * bi + fim * br;
        }
        __syncthreads();
        for (int idx = tid; idx < 1024; idx += NTHR) { cr[idx] = c_re[g * 1024 + idx]; ci[idx] = c_im[g * 1024 + idx]; }
        const bf16_t* ub = proj + (size_t)(b * NL + 256 * wave) * P0W + g * 16;
        float xre = 0.f, xim = 0.f;
        for (int c0 = 0; c0 < 256; c0 += 32) {
            wave_lds_fence();
            { float u8[8]; const int t = lane >> 1, hf = lane & 1; ld8(ub + (size_t)(c0 + t) * P0W + 8 * hf, u8);
#pragma unroll
              for (int i = 0; i < 8; ++i) us[t * 16 + 8 * hf + i] = u8[i]; }
            wave_lds_fence();
            for (int t = 0; t < 32; ++t) {
                float bur = 0.f, bui = 0.f;
#pragma unroll
                for (int i = 0; i < 16; ++i) { const float u = us[t * 16 + i]; bur += bbr[i] * u; bui += bbi[i] * u; }
                const float nre = are * xre - aim * xim + bur, nim = are * xim + aim * xre + bui;
                xre = nre; xim = nim;
            }
        }
        Es[(wave * 64 + lane) * 2] = xre; Es[(wave * 64 + lane) * 2 + 1] = xim;
        float pr = are, pi = aim;
#pragma unroll
        for (int i = 0; i < 8; ++i) { const float nr2 = pr * pr - pi * pi, ni2 = 2.f * pr * pi; pr = nr2; pi = ni2; }
        __syncthreads();
        xre = 0.f; xim = 0.f;
        for (int w2 = 0; w2 < wave; ++w2) {
            const float er = Es[(w2 * 64 + lane) * 2], ei = Es[(w2 * 64 + lane) * 2 + 1];
            const float nre = pr * xre - pi * xim + er, nim = pr * xim + pi * xre + ei;
            xre = nre; xim = nim;
        }
        const int tt = lane & 31, ih = lane >> 5;
        float dsk[8];
#pragma unroll
        for (int i = 0; i < 8; ++i) dsk[i] = dskip[g * 16 + 8 * ih + i];
        for (int c0 = 0; c0 < 256; c0 += 32) {
            wave_lds_fence();
            { float u8[8]; const int t = lane >> 1, hf = lane & 1; ld8(ub + (size_t)(c0 + t) * P0W + 8 * hf, u8);
#pragma unroll
              for (int i = 0; i < 8; ++i) us[t * 16 + 8 * hf + i] = u8[i]; }
            wave_lds_fence();
            for (int t = 0; t < 32; ++t) {
                float bur = 0.f, bui = 0.f;
#pragma unroll
                for (int i = 0; i < 16; ++i) { const float u = us[t * 16 + i]; bur += bbr[i] * u; bui += bbi[i] * u; }
                const float nre = are * xre - aim * xim + bur, nim = are * xim + aim * xre + bui;
                xre = nre; xim = nim;
                xr[t * 65 + lane] = xre; xi[t * 65 + lane] = xim;
            }
            wave_lds_fence();
            float y[8];
#pragma unroll
            for (int i = 0; i < 8; ++i) y[i] = 0.f;
            for (int p = 0; p < 64; ++p) {
                const float a = xr[tt * 65 + p], bq = xi[tt * 65 + p];
#pragma unroll
                for (int i = 0; i < 8; ++i) y[i] += cr[(8 * ih + i) * 64 + p] * a - ci[(8 * ih + i) * 64 + p] * bq;
            }
            float o[8];
#pragma unroll
            for (int i = 0; i < 8; ++i) o[i] = gelu_fast(y[i] + dsk[i] * us[tt * 16 + 8 * ih + i]);
            st8(ya + (size_t)(b * NL + 256 * wave + c0 + tt) * 256 + g * 16 + 8 * ih, o);
        }
    }
    __syncthreads();
}


__device__ __forceinline__ void glu2_phase(const bf16_t* __restrict__ ya, const bf16_t* __restrict__ wgt, const float* __restrict__ bglu, bf16_t* __restrict__ Y, unsigned char* lds) {
    const int tid = tidx(), wave = __builtin_amdgcn_readfirstlane(tid >> 6), lane = tid & 63, fr = lane & 15, fq = lane >> 4;
    __syncthreads();
    {
        uint4 wv[16];
#pragma unroll
        for (int i = 0; i < 16; ++i) { const int pc = tid + NTHR * i, row = pc >> 5, c = pc & 31; wv[i] = *(const uint4*)(wgt + row * 256 + c * 8); }
#pragma unroll
        for (int i = 0; i < 16; ++i) { const int pc = tid + NTHR * i, row = pc >> 5, c = pc & 31; *(uint4*)(lds + row * 528 + c * 16) = wv[i]; }
    }
    __syncthreads();
    for (int chunk = blockIdx.x; chunk < NT / 128; chunk += gridDim.x) {
        const size_t tok = (size_t)chunk * 128 + wave * 16 + fr;
        const size_t yb_b = (tok / NL) * 16, yt = tok % NL;
        bf16x8_t yb[8];
#pragma unroll
        for (int ks = 0; ks < 8; ++ks) yb[ks] = *(const bf16x8_t*)(ya + ((yb_b + 2 * ks + (fq >> 1)) * NL + yt) * 16 + (fq & 1) * 8);
#pragma unroll 2
        for (int nt = 0; nt < 16; ++nt) {
            f32x4 acc = {0.f, 0.f, 0.f, 0.f};
#pragma unroll
            for (int ks = 0; ks < 8; ++ks) {
                const bf16x8_t a = *(const bf16x8_t*)(lds + (16 * nt + fr) * 528 + (32 * ks + 8 * fq) * 2);
                acc = __builtin_amdgcn_mfma_f32_16x16x32_bf16(a, yb[ks], acc, 0, 0, 0);
            }
            const int n0 = 16 * nt + 4 * fq;
            const uint2 yv = *(const uint2*)(ya + ((yb_b + nt) * NL + yt) * 16 + 4 * fq);
            const float4 bb = *(const float4*)(bglu + n0);
            const float o0 = __uint_as_float(yv.x << 16) * sigmoidf_(acc[0] + bb.x), o1 = __uint_as_float(yv.x & 0xffff0000u) * sigmoidf_(acc[1] + bb.y);
            const float o2 = __uint_as_float(yv.y << 16) * sigmoidf_(acc[2] + bb.z), o3 = __uint_as_float(yv.y & 0xffff0000u) * sigmoidf_(acc[3] + bb.w);
            *(uint2*)(Y + tok * ND + n0) = make_uint2(cvtpk(o0, o1), cvtpk(o2, o3));
        }
    }
    __syncthreads();
}


__device__ __forceinline__ void cmadd(float& re, float& im, float ar, float ai, float br, float bi) {
    const float nr = fmaf(ar, re, fmaf(-ai, im, br)), ni = fmaf(ar, im, fmaf(ai, re, bi));
    re = nr; im = ni;
}
__device__ __forceinline__ void s5_scan3_phase(const bf16_t* __restrict__ proj, const float* __restrict__ lam_re, const float* __restrict__ lam_im, const float* __restrict__ log_dt,
                                               const float* __restrict__ b_re, const float* __restrict__ b_im, const float* __restrict__ c_re, const float* __restrict__ c_im,
                                               const float* __restrict__ dskip, bf16_t* __restrict__ ya, unsigned char* lds) {
    const int tid = tidx(), wave = __builtin_amdgcn_readfirstlane(tid >> 6), lane = tid & 63, l31 = lane & 31, h = lane >> 5, fr = lane & 15, fq = lane >> 4;
    unsigned char* Xs = lds + wave * 10752;
    float* Es = (float*)(lds + 86016);
    __syncthreads();
    for (int i = lane; i < 32 * 21; i += 64) *(uint4*)(Xs + i * 16) = make_uint4(0u, 0u, 0u, 0u);
    for (int bg = blockIdx.x; bg < NB * 16; bg += gridDim.x) {
        const int b = bg >> 4, g = bg & 15;
        const float dt = expf(log_dt[g]);
        float are[2], aim[2]; bf16x8_t Bre[2], Bim[2];
#pragma unroll
        for (int k = 0; k < 2; ++k) {
            const int p = 32 * k + l31;
            const float lr = lam_re[g * 64 + p], li = lam_im[g * 64 + p];
            const float mag = expf(lr * dt);
            are[k] = mag * cosf(li * dt); aim[k] = mag * sinf(li * dt);
            const float nr = are[k] - 1.f, den = lr * lr + li * li;
            const float fre = (nr * lr + aim[k] * li) / den, fim = (aim[k] * lr - nr * li) / den;
            float vr[8], vi[8];
#pragma unroll
            for (int j = 0; j < 8; ++j) {
                const float br = b_re[(g * 64 + p) * 16 + 8 * h + j], bi = b_im[(g * 64 + p) * 16 + 8 * h + j];
                vr[j] = fre * br - fim * bi; vi[j] = fre * bi + fim * br;
            }
            u32x4 w; w.x = cvtpk(vr[0], vr[1]); w.y = cvtpk(vr[2], vr[3]); w.z = cvtpk(vr[4], vr[5]); w.w = cvtpk(vr[6], vr[7]); Bre[k] = __builtin_bit_cast(bf16x8_t, w);
            w.x = cvtpk(vi[0], vi[1]); w.y = cvtpk(vi[2], vi[3]); w.z = cvtpk(vi[4], vi[5]); w.w = cvtpk(vi[6], vi[7]); Bim[k] = __builtin_bit_cast(bf16x8_t, w);
        }
        bf16x8_t Cm[5];
        {
            const float di = dskip[g * 16 + fr];
#pragma unroll
            for (int ks = 0; ks < 5; ++ks) {
                float cv[8];
#pragma unroll
                for (int j = 0; j < 8; ++j) {
                    const int kk = 32 * ks + 8 * fq + j;
                    cv[j] = kk < 64 ? c_re[(g * 16 + fr) * 64 + kk] : (kk < 128 ? -c_im[(g * 16 + fr) * 64 + kk - 64] : ((kk - 128) == fr ? di : 0.f));
                }
                u32x4 w; w.x = cvtpk(cv[0], cv[1]); w.y = cvtpk(cv[2], cv[3]); w.z = cvtpk(cv[4], cv[5]); w.w = cvtpk(cv[6], cv[7]); Cm[ks] = __builtin_bit_cast(bf16x8_t, w);
            }
        }
        float a4r[2], a4i[2], a5r[2], a5i[2], a32r[2], a32i[2], a256r[2], a256i[2];
#pragma unroll
        for (int k = 0; k < 2; ++k) {
            float pr = are[k], pi = aim[k], t;
            t = pr * pr - pi * pi; pi = 2.f * pr * pi; pr = t;
            t = pr * pr - pi * pi; pi = 2.f * pr * pi; pr = t;
            a4r[k] = pr; a4i[k] = pi;
            a5r[k] = pr * are[k] - pi * aim[k]; a5i[k] = pr * aim[k] + pi * are[k];
#pragma unroll
            for (int i = 0; i < 3; ++i) { t = pr * pr - pi * pi; pi = 2.f * pr * pi; pr = t; }
            a32r[k] = pr; a32i[k] = pi;
#pragma unroll
            for (int i = 0; i < 3; ++i) { t = pr * pr - pi * pi; pi = 2.f * pr * pi; pr = t; }
            a256r[k] = pr; a256i[k] = pi;
        }
        const bf16_t* ub = proj + (size_t)(b * NL + 256 * wave) * P0W + g * 16 + 8 * h;
        float sre[2] = {0.f, 0.f}, sim[2] = {0.f, 0.f};
        bf16x8_t ufn = *(const bf16x8_t*)(ub + (size_t)l31 * P0W);
#pragma unroll 1
        for (int c0 = 0; c0 < 256; c0 += 32) {
            const bf16x8_t uf = ufn;
            ufn = *(const bf16x8_t*)(ub + (size_t)(((c0 + 32) & 255) + l31) * P0W);
#pragma unroll
            for (int k = 0; k < 2; ++k) {
                f32x16 z;
#pragma unroll
                for (int i = 0; i < 16; ++i) z[i] = 0.f;
                const f32x16 bur = MFMA32(uf, Bre[k], z), bui = MFMA32(uf, Bim[k], z);
                float er = 0.f, ei = 0.f;
#pragma unroll
                for (int reg = 0; reg < 16; ++reg) {
                    if (reg == 0) { er = bur[0]; ei = bui[0]; }
                    else if ((reg & 3) == 0) cmadd(er, ei, a5r[k], a5i[k], bur[reg], bui[reg]);
                    else cmadd(er, ei, are[k], aim[k], bur[reg], bui[reg]);
                }
                { float tr = er, ti = ei; cmadd(tr, ti, a4r[k], a4i[k], 0.f, 0.f); er = h ? er : tr; ei = h ? ei : ti; }
                er += __shfl_xor(er, 32); ei += __shfl_xor(ei, 32);
                cmadd(sre[k], sim[k], a32r[k], a32i[k], er, ei);
            }
        }
        __syncthreads();
        if (h == 0) {
#pragma unroll
            for (int k = 0; k < 2; ++k) { Es[(wave * 64 + 32 * k + l31) * 2] = sre[k]; Es[(wave * 64 + 32 * k + l31) * 2 + 1] = sim[k]; }
        }
        __syncthreads();
        float xre[2] = {0.f, 0.f}, xim[2] = {0.f, 0.f};
        for (int w2 = 0; w2 < wave; ++w2) {
#pragma unroll
            for (int k = 0; k < 2; ++k) cmadd(xre[k], xim[k], a256r[k], a256i[k], Es[(w2 * 64 + 32 * k + l31) * 2], Es[(w2 * 64 + 32 * k + l31) * 2 + 1]);
        }
#pragma unroll 1
        for (int c0 = 0; c0 < 256; c0 += 32) {
            const bf16x8_t uf = ufn;
            ufn = *(const bf16x8_t*)(ub + (size_t)(((c0 + 32) & 255) + l31) * P0W);
            wave_lds_fence();
            *(bf16x8_t*)(Xs + l31 * 336 + 256 + 16 * h) = uf;
#pragma unroll
            for (int k = 0; k < 2; ++k) {
                f32x16 z;
#pragma unroll
                for (int i = 0; i < 16; ++i) z[i] = 0.f;
                const f32x16 bur = MFMA32(uf, Bre[k], z), bui = MFMA32(uf, Bim[k], z);
                float cr = xre[k], ci = xim[k];
#pragma unroll
                for (int q = 0; q < 4; ++q) {
                    float ar_[4], ai_[4], br_[4], bi_[4];
                    float xr_ = cr, xi_ = ci;
#pragma unroll
                    for (int r2 = 0; r2 < 4; ++r2) { cmadd(xr_, xi_, are[k], aim[k], bur[4 * q + r2], bui[4 * q + r2]); ar_[r2] = xr_; ai_[r2] = xi_; }
                    float yr_ = __shfl_xor(xr_, 32), yi_ = __shfl_xor(xi_, 32);
#pragma unroll
                    for (int r2 = 0; r2 < 4; ++r2) { cmadd(yr_, yi_, are[k], aim[k], bur[4 * q + r2], bui[4 * q + r2]); br_[r2] = yr_; bi_[r2] = yi_; }
                    const float zr_ = __shfl_xor(yr_, 32), zi_ = __shfl_xor(yi_, 32);
                    cr = h ? yr_ : zr_; ci = h ? yi_ : zi_;
#pragma unroll
                    for (int r2 = 0; r2 < 4; ++r2) {
                        const int t = 8 * q + 4 * h + r2;
                        *(bf16_t*)(Xs + t * 336 + (32 * k + l31) * 2) = f2bf(h ? br_[r2] : ar_[r2]);
                        *(bf16_t*)(Xs + t * 336 + (64 + 32 * k + l31) * 2) = f2bf(h ? bi_[r2] : ai_[r2]);
                    }
                }
                xre[k] = cr; xim[k] = ci;
            }
            wave_lds_fence();
#pragma unroll
            for (int mt = 0; mt < 2; ++mt) {
                f32x4 y = {0.f, 0.f, 0.f, 0.f};
#pragma unroll
                for (int ks = 0; ks < 5; ++ks) {
                    const bf16x8_t a = *(const bf16x8_t*)(Xs + (16 * mt + fr) * 336 + (32 * ks + 8 * fq) * 2);
                    y = __builtin_amdgcn_mfma_f32_16x16x32_bf16(a, Cm[ks], y, 0, 0, 0);
                }
#pragma unroll
                for (int reg = 0; reg < 4; ++reg)
                    ya[((size_t)(b * 16 + g) * NL + 256 * wave + c0 + 16 * mt + 4 * fq + reg) * 16 + fr] = f2bf(gelu_fast(y[reg]));
            }
        }
    }
    __syncthreads();
}

struct Params {
    const float* in[29];
    float* out;
    char* ws;
    unsigned long long pad;
};

constexpr size_t SZ_PROJ = (size_t)NT * EVEN_IN * 2;
constexpr size_t SZ_VT = (size_t)768 * NT * 2;
constexpr size_t SZ_YB = (size_t)NT * ND * 2;
constexpr size_t SZ_HB = (size_t)NT * ND * 2;
constexpr size_t SZ_YA = (size_t)NT * 256 * 2;
constexpr size_t SZ_CMP = (size_t)NB * 4 * 128 * 64 * 2;
constexpr size_t SZ_SEL = (size_t)NB * 4 * NL * 4;
constexpr size_t SZ_TAB = (size_t)16384 * ND;
constexpr size_t SZ_SKB = (size_t)2 * 8 * 2 * 128 * 128 * 2;
constexpr size_t OFF_VT = SZ_PROJ, OFF_YB = OFF_VT + SZ_VT, OFF_HB = OFF_YB + SZ_YB, OFF_YA = OFF_HB + SZ_HB, OFF_KC = OFF_YA + SZ_YA, OFF_VC = OFF_KC + SZ_CMP,
                 OFF_SEL = OFF_VC + SZ_CMP, OFF_TAB = OFF_SEL + SZ_SEL, OFF_SKB = OFF_TAB + 2 * SZ_TAB, OFF_WT = OFF_SKB + SZ_SKB;
constexpr size_t WT_IN0 = 0, WT_OUT0 = WT_IN0 + (size_t)EVEN_IN * ND * 2, WT_Q0 = WT_OUT0 + (size_t)ND * ND * 2, WT_Q1 = WT_Q0 + (size_t)2048 * ND * 2,
                 WT_IN1 = WT_Q1 + (size_t)2048 * ND * 2, WT_V1 = WT_IN1 + (size_t)ODD_PAD * ND * 2, WT_OUT1 = WT_V1 + (size_t)512 * ND * 2, WT_W1 = WT_OUT1 + (size_t)ND * ND * 2, WT_W2 = WT_W1 + (size_t)2 * 128 * 2048 * 2, WT_B1 = WT_W2 + (size_t)2 * 64 * 128 * 2, WT_V0 = WT_B1 + 2 * 128 * 4, WT_GLU = WT_V0 + (size_t)768 * ND * 2, WT_END = WT_GLU + (size_t)256 * 256 * 2;
constexpr size_t OFF_PART = OFF_WT + ((WT_END + 255) & ~(size_t)255);
constexpr size_t OFF_CQ = OFF_PART + (size_t)NT * 32 * 4;
constexpr size_t OFF_SU = OFF_CQ + 4 * 2048 * 4;
constexpr size_t OFF_BAR = OFF_SU + 16384 * 4;
constexpr size_t WS_NEED = OFF_BAR + XB_TOTAL_WORDS * 4 + 256;

__device__ __forceinline__ void convert_tables(const float* __restrict__ u, const float* __restrict__ v, unsigned char* __restrict__ TAB, float* __restrict__ SU) {
    {
        const int wave = tidx() >> 6, lane = tidx() & 63;
        for (int r0 = blockIdx.x * 32 + wave * 4; r0 < 16384; r0 += gridDim.x * 32) {
            f32x4 a[4][4];
#pragma unroll
            for (int rr = 0; rr < 4; ++rr)
#pragma unroll
                for (int q = 0; q < 4; ++q) a[rr][q] = __builtin_nontemporal_load((const f32x4*)(u + (size_t)(r0 + rr) * ND + lane * 16 + 4 * q));
#pragma unroll
            for (int rr = 0; rr < 4; ++rr) {
                const int row = r0 + rr;
                float m = 0.f;
#pragma unroll
                for (int q = 0; q < 4; ++q) m = fmaxf(fmaxf(m, fmaxf(fabsf(a[rr][q].x), fabsf(a[rr][q].y))), fmaxf(fabsf(a[rr][q].z), fabsf(a[rr][q].w)));
                for (int o = 32; o; o >>= 1) m = fmaxf(m, __shfl_xor(m, o));
                const float inv = m > 0.f ? 127.f / m : 0.f;
                uint4 w; unsigned* wp = (unsigned*)&w;
#pragma unroll
                for (int q = 0; q < 4; ++q) {
                    const int b0 = (int)rintf(a[rr][q].x * inv), b1 = (int)rintf(a[rr][q].y * inv), b2 = (int)rintf(a[rr][q].z * inv), b3 = (int)rintf(a[rr][q].w * inv);
                    wp[q] = (unsigned)(b0 & 255) | ((unsigned)(b1 & 255) << 8) | ((unsigned)(b2 & 255) << 16) | ((unsigned)b3 << 24);
                }
                *(uint4*)(TAB + (size_t)row * ND + lane * 16) = w;
                if (lane == 0) SU[row] = m * (1.f / 127.f);
            }
        }
    }
    const size_t per = (size_t)16384 * ND / 16;
    const size_t vstride = (size_t)gridDim.x * NTHR;
    for (size_t i = (size_t)blockIdx.x * NTHR + tidx(); i < per; i += 2 * vstride) {
        f32x4 a[2][4];
#pragma unroll
        for (int k = 0; k < 2; ++k)
#pragma unroll
            for (int q = 0; q < 4; ++q) a[k][q] = __builtin_nontemporal_load((const f32x4*)(v + (i + k * vstride) * 16 + 4 * q));
#pragma unroll
        for (int k = 0; k < 2; ++k) {
            uint4 w; unsigned* wp = (unsigned*)&w;
#pragma unroll
            for (int q = 0; q < 4; ++q) {
                int pk = __builtin_amdgcn_cvt_pk_fp8_f32(a[k][q].x * V_SCALE, a[k][q].y * V_SCALE, 0, false);
                pk = __builtin_amdgcn_cvt_pk_fp8_f32(a[k][q].z * V_SCALE, a[k][q].w * V_SCALE, pk, true);
                wp[q] = (unsigned)pk;
            }
            *(uint4*)(TAB + (size_t)16384 * ND + (i + k * vstride) * 16) = w;
        }
    }
}

__device__ __forceinline__ char* wsb(const Params& p) { __attribute__((address_space(1))) char* w = (__attribute__((address_space(1))) char*)p.ws; asm volatile("" : "+s"(w)); return (char*)w; }
#define PROJ ((bf16_t*)wsb(p))
#define YB ((bf16_t*)(wsb(p) + OFF_YB))
#define HB ((bf16_t*)(wsb(p) + OFF_HB))
#define YA ((bf16_t*)(wsb(p) + OFF_YA))
#define WGT ((bf16_t*)(wsb(p) + OFF_WT + WT_GLU))
#define KCMP ((bf16_t*)(wsb(p) + OFF_KC))
#define VCMP ((bf16_t*)(wsb(p) + OFF_VC))
#define W1T ((bf16_t*)(wsb(p) + OFF_WT + WT_W1))
#define W2T ((bf16_t*)(wsb(p) + OFF_WT + WT_W2))
#define BIAS1 ((float*)(wsb(p) + OFF_WT + WT_B1))
#define SEL ((unsigned*)(wsb(p) + OFF_SEL))
#define WIN0 ((bf16_t*)(wsb(p) + OFF_WT + WT_IN0))
#define WOUT0 ((bf16_t*)(wsb(p) + OFF_WT + WT_OUT0))
#define WQ0 ((bf16_t*)(wsb(p) + OFF_WT + WT_Q0))
#define WQ1 ((bf16_t*)(wsb(p) + OFF_WT + WT_Q1))
#define WIN1 ((bf16_t*)(wsb(p) + OFF_WT + WT_IN1))
#define WOUT1 ((bf16_t*)(wsb(p) + OFF_WT + WT_OUT1))
#define WV1 ((bf16_t*)(wsb(p) + OFF_WT + WT_V1))
#define VT ((bf16_t*)(wsb(p) + OFF_VT))
#define WV0 ((bf16_t*)(wsb(p) + OFF_WT + WT_V0))
#define EIDX ((int*)YB)
#define EGATE ((float*)((char*)YB + (size_t)NT * 128 * 4))
#define TAB ((unsigned char*)(wsb(p) + OFF_TAB))
#define SKB ((bf16_t*)(wsb(p) + OFF_SKB))
__global__ void __launch_bounds__(NTHR) fwd_megakernel(Params p) {
    extern __shared__ __attribute__((aligned(16))) unsigned char lds_raw[];
    float* lds = (float*)lds_raw;
    cg::grid_group grid = cg::this_grid();
    const float* x = p.in[0];
    float* R = p.out;
    char* ws = wsb(p);
    const int wave = tidx() >> 6;
    if (tidx() == 0) *(uint4*)(lds_raw + LDS_BYTES - 16) = make_uint4(0u, 0u, 0u, 0u);
    __syncthreads();
    XcdBarrier xbar = xcd_barrier_post((unsigned*)(ws + OFF_BAR), (volatile LAS unsigned*)(lds_raw + LDS_BYTES - 16));

    {
        const size_t nvec = (size_t)NT * ND / 4, stride = (size_t)gridDim.x * NTHR;
        for (size_t i = (size_t)blockIdx.x * NTHR + tidx(); i < nvec; i += 8 * stride) {
            f32x4 v[8];
#pragma unroll
            for (int k = 0; k < 8; ++k) v[k] = __builtin_nontemporal_load((const f32x4*)x + i + k * stride);
#pragma unroll
            for (int k = 0; k < 8; ++k) { uint2 w; w.x = pack2(v[k][0], v[k][1]); w.y = pack2(v[k][2], v[k][3]); ((uint2*)HB)[i + k * stride] = w; }
        }
    }
    convert_tables(p.in[23], p.in[24], TAB, (float*)(ws + OFF_SU));
    for (int i = blockIdx.x * NTHR + tidx(); i < 2 * 8 * 2 * 128 * 128 / 4; i += gridDim.x * NTHR) {
        const float4 a = ((const float4*)p.in[22])[i];
        uint2 w; w.x = pack2(a.x, a.y); w.y = pack2(a.z, a.w);
        ((uint2*)SKB)[i] = w;
    }
    convert_wt_phase(p.in[1], ND, EVEN_IN, P0W, ColMap{{0, 0, 0}, {0, 0, 0}, {P0W, 0, 0}}, WIN0, lds);
    convert_wt_phase(p.in[1], ND, EVEN_IN, 768, ColMap{{0, 0, 0}, {P0W, 0, 0}, {768, 0, 0}}, WV0, lds);
    convert_wt_phase(p.in[12], ND, ND, ND, ColMap{{0, 0, 0}, {0, 0, 0}, {ND, 0, 0}}, WOUT0, lds);
    convert_wt_phase(p.in[10], 256, 256, 256, ColMap{{0, 0, 0}, {0, 0, 0}, {256, 0, 0}}, WGT, lds);
    convert_wt_phase(p.in[21], ND, 2048, 2048, ColMap{{0, 0, 0}, {0, 0, 0}, {2048, 0, 0}}, WQ0, lds, p.in[25]);
    convert_wt_phase(p.in[21] + (size_t)ND * 2048, ND, 2048, 2048, ColMap{{0, 0, 0}, {0, 0, 0}, {2048, 0, 0}}, WQ1, lds, p.in[25] + ND);
    {
        float* CQ = (float*)(ws + OFF_CQ);
        const int kp = tidx() >> 5, cl32 = tidx() & 31, gcol = blockIdx.x * 32 + cl32;
        if (blockIdx.x < 128) {
            const int layer = gcol >> 11, n = gcol & 2047;
            const float* W = p.in[21] + (size_t)layer * ND * 2048;
            const float* gam = p.in[25] + layer * ND; const float* bet = p.in[26] + layer * ND;
            float c = 0.f, d = 0.f;
            for (int k = kp; k < ND; k += 16) { const float w = W[(size_t)k * 2048 + n]; c += bf2f(f2bf(gam[k] * w)); d += bet[k] * w; }
            c += __shfl_xor(c, 32); d += __shfl_xor(d, 32);
            __syncthreads();
            if ((tidx() & 63) < 32) { lds[(tidx() >> 6) * 64 + cl32] = c; lds[(tidx() >> 6) * 64 + 32 + cl32] = d; }
            __syncthreads();
            if (tidx() < 32) {
                float cs = 0.f, ds = 0.f;
#pragma unroll
                for (int w8 = 0; w8 < 8; ++w8) { cs += lds[w8 * 64 + tidx()]; ds += lds[w8 * 64 + 32 + tidx()]; }
                CQ[layer * 2048 + n] = cs; CQ[4096 + layer * 2048 + n] = ds;
            }
            __syncthreads();
        }
    }
    convert_wt_phase(p.in[13], ND, ODD_IN, ODD_PAD, ColMap{{0, 1792, 2048}, {0, 2048, 2560}, {1792, 256, 48}}, WIN1, lds);
    convert_wt_phase(p.in[13], ND, ODD_IN, 512, ColMap{{0, 256, 0}, {1792, 2304, 0}, {256, 256, 0}}, WV1, lds);
    convert_wt_phase(p.in[20], ND, ND, ND, ColMap{{0, 0, 0}, {0, 0, 0}, {ND, 0, 0}}, WOUT1, lds);
    convert_wt_phase(p.in[15], 2048, 128, 128, ColMap{{0, 0, 0}, {0, 0, 0}, {128, 0, 0}}, W1T, lds);
    convert_wt_phase(p.in[18], 2048, 128, 128, ColMap{{0, 0, 0}, {0, 0, 0}, {128, 0, 0}}, W1T + 128 * 2048, lds);
    convert_wt_phase(p.in[16], 128, 64, 64, ColMap{{0, 0, 0}, {0, 0, 0}, {64, 0, 0}}, W2T, lds);
    convert_wt_phase(p.in[19], 128, 64, 64, ColMap{{0, 0, 0}, {0, 0, 0}, {64, 0, 0}}, W2T + 64 * 128, lds);
    if (blockIdx.x < 8) {
        const int which = blockIdx.x >> 2, j = (blockIdx.x & 3) * 32 + (tidx() >> 4), part = tidx() & 15;
        const float* pe = which ? p.in[17] : p.in[14];
        const float* w1 = which ? p.in[18] : p.in[15];
        float a = 0.f;
#pragma unroll 8
        for (int i = part; i < 2048; i += 16) a += pe[i] * w1[(size_t)i * 128 + j];
        for (int o = 8; o; o >>= 1) a += __shfl_xor(a, o);
        if (part == 0) BIAS1[which * 128 + j] = a;
    }
    xcd_barrier(xbar);
    if (p.pad == 0x5eedull) grid.sync();
    PDUP(0) { PH(0) gemm_bf16_phase(lds_raw, HB, WIN0, NT, P0W, ND, EpiBf16s{PROJ, P0W});
    PH(0) gemm_bf16_phase(lds_raw, WV0, HB, 768, NT, ND, EpiBf16s{VT, NT}, true); }
    xcd_barrier(xbar);
    PDUP(1) { PH(1) s5_scan3_phase(PROJ, p.in[2], p.in[3], p.in[4], p.in[5], p.in[6], p.in[7], p.in[8], p.in[9], YA, lds_raw);
    PH(2) sb_attn2_phase(PROJ, VT, YB, lds_raw);
    if ((PROBE >> 13) & 1) {
        bf16_t* SCR = PROJ + (size_t)NT * P0W;
        s5_scan2_phase(PROJ, p.in[2], p.in[3], p.in[4], p.in[5], p.in[6], p.in[7], p.in[8], p.in[9], SCR, lds);
        xcd_barrier(xbar);
        float d2 = 0.f, n2 = 0.f;
        for (size_t i = (size_t)blockIdx.x * NTHR + tidx(); i < (size_t)NT * 256; i += (size_t)gridDim.x * NTHR) { const float a = bf2f(YA[i]), r = bf2f(SCR[i]); d2 += (a - r) * (a - r); n2 += r * r; }
        for (int o = 32; o; o >>= 1) { d2 += __shfl_xor(d2, o); n2 += __shfl_xor(n2, o); }
        float* chk = (float*)(ws + OFF_BAR + XB_TOTAL_WORDS * 4);
        if ((tidx() & 63) == 0) { atomicAdd(chk, d2); atomicAdd(chk + 1, n2); }
    }
    if (_rep == 0 && ((PROBE >> 1) & 1)) xcd_barrier(xbar); }
    xcd_barrier(xbar);
    PDUP(2) PH(3) glu2_phase(YA, WGT, p.in[11], YB, lds_raw);
    xcd_barrier(xbar);
    PH(4) gemm_bf16_phase(lds_raw, YB, WOUT0, NT, ND, ND, EpiResStats<false>{x, HB, (float*)(ws + OFF_PART)});
    xcd_barrier(xbar);
#define PEER_FFN(layer, WQ, last) \
    PH(12) gemm_q_phase(lds_raw, HB, WQ, (const float*)(ws + OFF_PART), (const float*)(ws + OFF_CQ) + (layer) * 2048, (const float*)(ws + OFF_CQ) + 4096 + (layer) * 2048, PROJ); \
    xcd_barrier(xbar); \
    PDUP(4) PH(13) peer_route2_phase(PROJ, SKB + (size_t)(layer) * 8 * 2 * 128 * 128, EIDX, EGATE, lds_raw); \
    xcd_barrier(xbar); \
    if ((PROBE >> 5) & 1) { peer_expert3_phase(R, EIDX, EGATE, TAB, TAB + (size_t)16384 * ND, p.in[27] + (layer) * ND, p.in[28] + (layer) * ND, nullptr, (float*)PROJ, xbar); xcd_barrier(xbar); } \
    PH(14) peer_expert10_phase((last) ? R : nullptr, HB, EIDX, EGATE, TAB, TAB + (size_t)16384 * ND, p.in[27] + (layer) * ND, p.in[28] + (layer) * ND, (last) ? nullptr : HB, xbar, lds, p.in[25] + (layer) * ND, p.in[26] + (layer) * ND, (const float*)(ws + OFF_SU)); \
    if (!(last)) xcd_barrier(xbar);
    PEER_FFN(0, WQ0, false)
    convert_tables(p.in[23] + (size_t)16384 * ND, p.in[24] + (size_t)16384 * ND, TAB, (float*)(ws + OFF_SU));
    PDUP(0) { PH(6) gemm_bf16_phase(lds_raw, HB, WIN1, NT, ODD_PAD, ND, EpiBf16s{PROJ, ODD_PAD});
    PH(6) gemm_bf16_phase(lds_raw, WV1, HB, 512, NT, ND, EpiBf16s{VT, NT}); }
    xcd_barrier(xbar);
    PDUP(6) PH(7) nsa_compress2_phase(PROJ, W1T, W2T, BIAS1, KCMP, VCMP, lds_raw);
    xcd_barrier(xbar);
    PDUP(7) { PH(8) nsa_fused_phase(PROJ, KCMP, VCMP, VT, YB, lds_raw); }
    xcd_barrier(xbar);
    PH(10) gemm_bf16_phase(lds_raw, YB, WOUT1, NT, ND, ND, EpiResStats<true>{HB, HB, (float*)(ws + OFF_PART)});
    xcd_barrier(xbar);
    PEER_FFN(1, WQ1, true)
    if ((PROBE >> 13) & 1) {
        xcd_barrier(xbar);
        const float* chk = (const float*)(ws + OFF_BAR + XB_TOTAL_WORDS * 4);
        const float d2 = __hip_atomic_load(chk, __ATOMIC_RELAXED, __HIP_MEMORY_SCOPE_AGENT), n2 = __hip_atomic_load(chk + 1, __ATOMIC_RELAXED, __HIP_MEMORY_SCOPE_AGENT);
        if (!(d2 <= 1e-4f * n2)) for (size_t i = (size_t)blockIdx.x * NTHR + tidx(); i < (size_t)NT * ND; i += (size_t)gridDim.x * NTHR) R[i] *= 2.f;
    }
}

}

extern "C" void kernel_launch(void* const* d_in, const int* in_sizes, int n_in, void* d_out, int out_size, void* d_ws, size_t ws_size, hipStream_t stream) {
    static int grid_blocks = 0;
    if (grid_blocks == 0) {
        if (n_in != 29 || out_size != NT * ND || ws_size < WS_NEED) { fprintf(stderr, "kernel_launch: unexpected shapes / workspace (%zu < %zu)\n", ws_size, (size_t)WS_NEED); grid_blocks = -1; return; }
        int dev = 0, cus = 0, per_cu = 0;
        hipGetDevice(&dev);
        hipDeviceGetAttribute(&cus, hipDeviceAttributeMultiprocessorCount, dev);
        hipFuncSetAttribute((const void*)fwd_megakernel, hipFuncAttributeMaxDynamicSharedMemorySize, LDS_BYTES);
        hipOccupancyMaxActiveBlocksPerMultiprocessor(&per_cu, (const void*)fwd_megakernel, NTHR, LDS_BYTES);
        if (per_cu < 1) { fprintf(stderr, "kernel_launch: occupancy query says %d blocks/CU\n", per_cu); grid_blocks = -1; return; }
        grid_blocks = cus;
    }
    if (grid_blocks < 0) return;
    hipMemsetAsync((char*)d_ws + OFF_BAR, 0, XB_TOTAL_WORDS * 4 + 256, stream);
    Params p{};
    for (int i = 0; i < 29; ++i) p.in[i] = (const float*)d_in[i];
    p.out = (float*)d_out; p.ws = (char*)d_ws; p.pad = 0;
    void* args[] = {&p};
    hipError_t e = hipLaunchCooperativeKernel((const void*)fwd_megakernel, dim3(grid_blocks), dim3(NTHR), args, LDS_BYTES, stream);
    if (e != hipSuccess) fprintf(stderr, "cooperative launch failed: %s (grid %d)\n", hipGetErrorString(e), grid_blocks);
}
```
